# Optimizing an MI355X kernel written in HIP

```python
import jax, jax.numpy as jnp
from jax import lax
import numpy as np

D_MODEL = 1024
BATCH = 4
SEQ = 4096
DEPTH = 1
DEC_BATCH = 32
DEC_SEQ = 8
PAST_LEN = 16384
PAGE_SIZE = 128

D_PLE = 256
NSA_HEADS = 8
NSA_GROUPS = 2
HD = 64
HPG = NSA_HEADS // NSA_GROUPS
W_A = NSA_HEADS * HD
KV_W = NSA_GROUPS * HD
L_CMP = 32
D_CMP = 16
CMP_HID = 128
L_SEL = 64
N_SEL = 16
WIN = 512
Q_BLOCK = 128
FORCE_SCORE = 1e4
NEG_INF = -1e30
R_HEADS = 8
R_HD = 64
W_R = R_HEADS * R_HD
R_W = 64
R_A = 64
C_R = 3 * W_R + R_W + R_A
GN_EPS = 64e-5
ROPE_THETA = 10000.0
NORM_EPS = 1e-6
SPLIT_SIZES = (W_A, 6 * KV_W, 3 * NSA_HEADS, W_A, C_R, W_R, 2 * D_MODEL)
C_IN = sum(SPLIT_SIZES)
SPLIT_OFFSETS = tuple(int(v) for v in np.cumsum(SPLIT_SIZES)[:-1])

kernel_name = 'nsa_rwkv7_hybrid_step'


def rms_norm(x, g):
    xf = x.astype(jnp.float32)
    y = xf * lax.rsqrt(jnp.mean(xf * xf, axis=-1, keepdims=True) + NORM_EPS)
    return (y * g.astype(jnp.float32)).astype(x.dtype)


def rope(x, pos):
    half = HD // 2
    inv = ROPE_THETA ** (-jnp.arange(half, dtype=jnp.float32) / half)
    ang = pos.astype(jnp.float32)[:, None] * inv[None, :]
    shape = (1, pos.shape[0]) + (1,) * (x.ndim - 3) + (half,)
    cos = jnp.cos(ang).reshape(shape)
    sin = jnp.sin(ang).reshape(shape)
    xf = x.astype(jnp.float32)
    x1, x2 = xf[..., :half], xf[..., half:]
    return jnp.concatenate([x1 * cos - x2 * sin, x2 * cos + x1 * sin], axis=-1).astype(x.dtype)


def masked_softmax(s, mask):
    s = jnp.where(mask, s.astype(jnp.float32), NEG_INF)
    return jax.nn.softmax(s, axis=-1) * mask


def compress_rows(raw, pe, w1, b1, w2, b2, n_blocks):
    b, t = raw.shape[:2]
    n_chunk = -(-t // D_CMP)
    raw = jnp.pad(raw, ((0, 0), (0, n_chunk * D_CMP - t), (0, 0), (0, 0)))
    chunks = raw.reshape(b, n_chunk, D_CMP, NSA_GROUPS, HD)
    lo = jnp.einsum('bcjgd,jdf->bcgf', chunks, w1[:D_CMP])
    hi = jnp.einsum('bcjgd,jdf->bcgf', chunks, w1[D_CMP:])
    pos_term = jnp.einsum('jd,jdf->f', pe, w1)
    hid = (lo[:, :-1] + hi[:, 1:])[:, :n_blocks] + pos_term + b1
    return jnp.einsum('bcgf,fd->bcgd', jax.nn.silu(hid), w2) + b2


def nsa_context(cmp_kv, sel_kv, cmp_pe, cmp_w1, cmp_b1, cmp_w2, cmp_b2):
    b, t = cmp_kv.shape[:2]
    n_cmp = (t - L_CMP) // D_CMP + 1
    kc = compress_rows(cmp_kv[:, :, 0], cmp_pe[0], cmp_w1[0], cmp_b1[0], cmp_w2[0], cmp_b2[0], n_cmp)
    vc = compress_rows(cmp_kv[:, :, 1], cmp_pe[1], cmp_w1[1], cmp_b1[1], cmp_w2[1], cmp_b2[1], n_cmp)
    n_sb = -(-t // L_SEL)
    sel = jnp.pad(sel_kv, ((0, 0), (0, n_sb * L_SEL - t), (0, 0), (0, 0), (0, 0)))
    sel = sel.reshape(b, n_sb, L_SEL, 2, NSA_GROUPS, HD).transpose(3, 0, 4, 1, 2, 5)
    c_start = np.arange(n_cmp) * D_CMP
    s_start = np.arange(n_sb) * L_SEL
    overlap = (c_start[:, None] <= s_start[None, :] + L_SEL - 1) & (c_start[:, None] + L_CMP - 1 >= s_start[None, :])
    c_end = jnp.asarray(c_start + L_CMP - 1, dtype=jnp.int32)
    return kc, vc, c_end, sel[0], sel[1], jnp.asarray(overlap, dtype=jnp.float32)


def nsa_query_block(q, gates, qpos, kc, vc, c_end, ks, vs, overlap, kw, vw, kw_pos):
    b, nq = q.shape[:2]
    qg = q.reshape(b, nq, NSA_GROUPS, HPG, HD) * (HD ** -0.5)
    s_c = jnp.einsum('bqghd,bcgd->bqghc', qg, kc)
    p_c = masked_softmax(s_c, (c_end[None, :] <= qpos[:, None])[None, :, None, None, :])
    o_c = jnp.einsum('bqghc,bcgd->bqghd', p_c, vc)
    n_sb = ks.shape[2]
    n_sel = min(N_SEL, n_sb)
    imp = jnp.einsum('bqgc,cn->bqgn', p_c.sum(axis=3), overlap)
    blk = jnp.arange(n_sb)
    cur = (qpos // L_SEL)[:, None]
    forced = (blk[None, :] == 0) | (blk[None, :] == cur) | (blk[None, :] == cur - 1)
    future = blk[None, :] * L_SEL > qpos[:, None]
    imp = jnp.where(forced[None, :, None, :], FORCE_SCORE, imp)
    imp = jnp.where(future[None, :, None, :], -1.0, imp)
    _, idx = lax.top_k(imp, n_sel)
    bi = jnp.arange(b)[:, None, None, None]
    gi = jnp.arange(NSA_GROUPS)[None, None, :, None]
    k_sel = ks[bi, gi, idx]
    v_sel = vs[bi, gi, idx]
    sel_pos = idx[..., None] * L_SEL + jnp.arange(L_SEL)
    m_s = (sel_pos <= qpos[None, :, None, None, None]).reshape(b, nq, NSA_GROUPS, 1, n_sel * L_SEL)
    s_s = jnp.einsum('bqghd,bqgnld->bqghnl', qg, k_sel).reshape(b, nq, NSA_GROUPS, HPG, n_sel * L_SEL)
    p_s = masked_softmax(s_s, m_s).reshape(b, nq, NSA_GROUPS, HPG, n_sel, L_SEL)
    o_s = jnp.einsum('bqghnl,bqgnld->bqghd', p_s, v_sel)
    s_w = jnp.einsum('bqghd,bkgd->bqghk', qg, kw)
    dist = qpos[:, None] - kw_pos[None, :]
    m_w = (dist >= 0) & (dist < WIN) & (kw_pos[None, :] >= 0)
    p_w = masked_softmax(s_w, m_w[None, :, None, None, :])
    o_w = jnp.einsum('bqghk,bkgd->bqghd', p_w, vw)
    g = gates.reshape(b, nq, NSA_GROUPS, HPG, 3)
    o = g[..., 0:1] * o_c + g[..., 1:2] * o_s + g[..., 2:3] * o_w
    return o.reshape(b, nq, W_A).astype(q.dtype)


def rwkv_time_mix(rz, shift0, state0, mu, w0, w_up, a0, a_up, k_k, k_a, r_k, gn_g, gn_b):
    b, t = rz.shape[:2]
    z = rz.astype(jnp.float32)
    prev = jnp.concatenate([shift0.astype(jnp.float32)[:, None], z[:, :-1]], axis=1)
    zs = z + (prev - z) * mu
    r, k, v, wd, ad = jnp.split(zs, (W_R, 2 * W_R, 3 * W_R, 3 * W_R + R_W), axis=-1)
    w = -jax.nn.softplus(-(w0 + jnp.tanh(wd) @ w_up)) - 0.5
    decay = jnp.exp(-jnp.exp(w))
    a = jax.nn.sigmoid(a0 + ad @ a_up)
    heads = lambda u: u.reshape(b, t, R_HEADS, R_HD)
    kk = heads(k * k_k)
    kk = kk / jnp.maximum(jnp.linalg.norm(kk, axis=-1, keepdims=True), 1e-12)
    k = k * (1.0 + (a - 1.0) * k_a)
    r, k, v, decay, a = map(heads, (r, k, v, decay, a))

    def step(s, inp):
        r_t, d_t, k_t, v_t, kk_t, a_t = inp
        sa = jnp.einsum('bhvk,bhk->bhv', s, -kk_t)
        s = s * d_t[:, :, None, :] + sa[..., None] * (kk_t * a_t)[:, :, None, :] + v_t[..., None] * k_t[:, :, None, :]
        return s, jnp.einsum('bhvk,bhk->bhv', s, r_t)

    xs = tuple(jnp.moveaxis(u, 1, 0) for u in (r, decay, k, v, kk, a))
    state, y = lax.scan(step, state0.astype(jnp.float32), xs)
    y = jnp.moveaxis(y, 0, 1)
    mean = jnp.mean(y, axis=-1, keepdims=True)
    var = jnp.mean(jnp.square(y - mean), axis=-1, keepdims=True)
    y = ((y - mean) * lax.rsqrt(var + GN_EPS)).reshape(b, t, W_R) * gn_g + gn_b
    y = y + (jnp.sum(r * k * r_k, axis=-1, keepdims=True) * v).reshape(b, t, W_R)
    return y.astype(rz.dtype), state, z[:, -1]


def mixer_inputs(x, pos, norm_g, w_in):
    b, t = x.shape[:2]
    h = rms_norm(x, norm_g)
    z = jnp.einsum('btd,dc->btc', h, w_in)
    q, kv, nsa_g, a_gate, rz, r_gate, merge = jnp.split(z, SPLIT_OFFSETS, axis=-1)
    q = rope(q.reshape(b, t, NSA_HEADS, HD), pos)
    kv = kv.reshape(b, t, 3, 2, NSA_GROUPS, HD)
    kv = jnp.stack([rope(kv[:, :, :, 0], pos), kv[:, :, :, 1]], axis=3)
    gates = jax.nn.sigmoid(nsa_g.astype(jnp.float32)).reshape(b, t, NSA_HEADS, 3)
    return q, kv, gates, a_gate, rz, r_gate, merge


def mixer_outputs(x, o_a, o_b, a_gate, r_gate, merge, p_in, w_pa, w_pb, w_out, ple_norm_g, w_ple_gate, w_ple_proj):
    y_a = jnp.einsum('btc,cd->btd', o_a * jax.nn.silu(a_gate), w_pa)
    y_b = jnp.einsum('btc,cd->btd', o_b * jax.nn.silu(r_gate), w_pb)
    g_a, g_b = jnp.split(jax.nn.sigmoid(merge), 2, axis=-1)
    x = x + jnp.einsum('btd,de->bte', g_a * y_a + g_b * y_b, w_out).astype(x.dtype)
    gate = jax.nn.sigmoid(jnp.einsum('btd,de->bte', rms_norm(x, ple_norm_g), w_ple_gate))
    return x + (gate * jnp.einsum('btp,pd->btd', p_in, w_ple_proj)).astype(x.dtype)


def setup_inputs(seed: int = 0) -> dict:
    key = jax.random.key(seed)
    ks = jax.random.split(key, 40)
    n_pages = PAST_LEN // PAGE_SIZE
    n_used = DEC_BATCH * n_pages
    n_pool = n_used + max(1, n_used // 4)
    win_buf = min(WIN, PAST_LEN)
    nrm = lambda k, shape, s: s * jax.random.normal(k, shape, jnp.float32)
    uni = lambda k, shape, lo, hi: jax.random.uniform(k, shape, jnp.float32, lo, hi)
    page_table = jax.random.permutation(ks[9], n_pool)[:n_used].reshape(DEC_BATCH, n_pages).astype(jnp.int32)
    return {
        'x_prompt': nrm(ks[0], (BATCH, SEQ, D_MODEL), 1.0),
        'x_sample': nrm(ks[1], (DEC_BATCH, DEC_SEQ, D_MODEL), 1.0),
        'p_prompt': nrm(ks[2], (DEPTH, BATCH, SEQ, D_PLE), 1.0),
        'p_sample': nrm(ks[3], (DEPTH, DEC_BATCH, DEC_SEQ, D_PLE), 1.0),
        'cache_cmp_kv': nrm(ks[4], (DEPTH, n_pool, PAGE_SIZE, 2, NSA_GROUPS, HD), 1.0),
        'cache_sel_kv': nrm(ks[5], (DEPTH, n_pool, PAGE_SIZE, 2, NSA_GROUPS, HD), 1.0),
        'cache_win_kv': nrm(ks[6], (DEPTH, DEC_BATCH, win_buf, 2, NSA_GROUPS, HD), 1.0),
        'state_wkv': nrm(ks[7], (DEPTH, DEC_BATCH, R_HEADS, R_HD, R_HD), 0.1),
        'state_shift': nrm(ks[8], (DEPTH, DEC_BATCH, C_R), 1.0),
        'page_table': page_table,
        'norm_g': 1.0 + nrm(ks[10], (DEPTH, D_MODEL), 0.02),
        'w_in': nrm(ks[11], (DEPTH, D_MODEL, C_IN), D_MODEL ** -0.5),
        'cmp_pe': nrm(ks[12], (DEPTH, 2, L_CMP, HD), 0.02),
        'cmp_w1': nrm(ks[13], (DEPTH, 2, L_CMP, HD, CMP_HID), (L_CMP * HD) ** -0.5),
        'cmp_b1': nrm(ks[14], (DEPTH, 2, CMP_HID), 0.01),
        'cmp_w2': nrm(ks[15], (DEPTH, 2, CMP_HID, HD), CMP_HID ** -0.5),
        'cmp_b2': nrm(ks[16], (DEPTH, 2, HD), 0.01),
        'w_pa': nrm(ks[17], (DEPTH, W_A, D_MODEL), W_A ** -0.5),
        'rwkv_mu': uni(ks[18], (DEPTH, C_R), 0.0, 1.0),
        'rwkv_w0': uni(ks[19], (DEPTH, W_R), -6.0, -1.0),
        'rwkv_w_up': nrm(ks[20], (DEPTH, R_W, W_R), 0.1 * R_W ** -0.5),
        'rwkv_a0': nrm(ks[21], (DEPTH, W_R), 0.1),
        'rwkv_a_up': nrm(ks[22], (DEPTH, R_A, W_R), 0.1 * R_A ** -0.5),
        'rwkv_k_k': 0.85 + nrm(ks[23], (DEPTH, W_R), 0.05),
        'rwkv_k_a': 1.0 + nrm(ks[24], (DEPTH, W_R), 0.05),
        'rwkv_r_k': nrm(ks[25], (DEPTH, R_HEADS, R_HD), 0.1),
        'rwkv_gn_g': 1.0 + nrm(ks[26], (DEPTH, W_R), 0.02),
        'rwkv_gn_b': nrm(ks[27], (DEPTH, W_R), 0.01),
        'w_pb': nrm(ks[28], (DEPTH, W_R, D_MODEL), W_R ** -0.5),
        'w_out': nrm(ks[29], (DEPTH, D_MODEL, D_MODEL), D_MODEL ** -0.5),
        'ple_norm_g': 1.0 + nrm(ks[30], (DEPTH, D_MODEL), 0.02),
        'w_ple_gate': nrm(ks[31], (DEPTH, D_MODEL, D_MODEL), D_MODEL ** -0.5),
        'w_ple_proj': nrm(ks[32], (DEPTH, D_PLE, D_MODEL), D_PLE ** -0.5),
        'final_norm_g': 1.0 + nrm(ks[33], (D_MODEL,), 0.02),
    }


def reference(x_prompt, x_sample, p_prompt, p_sample, cache_cmp_kv, cache_sel_kv, cache_win_kv, state_wkv, state_shift,
              page_table, norm_g, w_in, cmp_pe, cmp_w1, cmp_b1, cmp_w2, cmp_b2, w_pa, rwkv_mu, rwkv_w0, rwkv_w_up,
              rwkv_a0, rwkv_a_up, rwkv_k_k, rwkv_k_a, rwkv_r_k, rwkv_gn_g, rwkv_gn_b, w_pb, w_out, ple_norm_g,
              w_ple_gate, w_ple_proj, final_norm_g):
    b, s_len = x_prompt.shape[:2]
    db, ds = x_sample.shape[:2]
    n_pages = page_table.shape[1]
    past = n_pages * PAGE_SIZE
    win_buf = cache_win_kv.shape[2]
    win_p = min(WIN, s_len)
    pos_p = jnp.arange(s_len, dtype=jnp.int32)
    pos_s = past + jnp.arange(ds, dtype=jnp.int32)
    kw_pos_p = jnp.concatenate([jnp.full((WIN,), -1, jnp.int32), pos_p])
    kw_pos_s = past - win_buf + jnp.arange(win_buf + ds, dtype=jnp.int32)
    xp, xs = x_prompt, x_sample
    cmp_p, cmp_s, sel_p, sel_s, win_p_l, win_s_l = [], [], [], [], [], []
    wkv_p, wkv_s, sh_p, sh_s = [], [], [], []
    for i in range(DEPTH):
        cmp_w = (cmp_pe[i], cmp_w1[i], cmp_b1[i], cmp_w2[i], cmp_b2[i])
        rw = (rwkv_mu[i], rwkv_w0[i], rwkv_w_up[i], rwkv_a0[i], rwkv_a_up[i], rwkv_k_k[i], rwkv_k_a[i],
              rwkv_r_k[i], rwkv_gn_g[i], rwkv_gn_b[i])
        out_w = (w_pa[i], w_pb[i], w_out[i], ple_norm_g[i], w_ple_gate[i], w_ple_proj[i])

        q, kv, gates, a_gate, rz, r_gate, merge = mixer_inputs(xp, pos_p, norm_g[i], w_in[i])
        kc, vc, c_end, k_s, v_s, ov = nsa_context(kv[:, :, 0], kv[:, :, 1], *cmp_w)
        kw = jnp.pad(kv[:, :, 2], ((0, 0), (WIN, 0), (0, 0), (0, 0), (0, 0)))

        def block(j):
            s0 = j * Q_BLOCK
            qb = lax.dynamic_slice_in_dim(q, s0, Q_BLOCK, axis=1)
            gb = lax.dynamic_slice_in_dim(gates, s0, Q_BLOCK, axis=1)
            pb = lax.dynamic_slice_in_dim(pos_p, s0, Q_BLOCK)
            wb = lax.dynamic_slice_in_dim(kw, s0, Q_BLOCK + WIN, axis=1)
            wp = lax.dynamic_slice_in_dim(kw_pos_p, s0, Q_BLOCK + WIN)
            return nsa_query_block(qb, gb, pb, kc, vc, c_end, k_s, v_s, ov, wb[:, :, 0], wb[:, :, 1], wp)

        o_a = lax.map(block, jnp.arange(s_len // Q_BLOCK))
        o_a = jnp.moveaxis(o_a, 0, 1).reshape(b, s_len, W_A)
        o_b, st_p, shift_p = rwkv_time_mix(rz, jnp.zeros((b, C_R), rz.dtype),
                                           jnp.zeros((b, R_HEADS, R_HD, R_HD), jnp.float32), *rw)
        xp = mixer_outputs(xp, o_a, o_b, a_gate, r_gate, merge, p_prompt[i], *out_w)
        cmp_p.append(kv[:, :, 0].astype(cache_cmp_kv.dtype))
        sel_p.append(kv[:, :, 1].astype(cache_sel_kv.dtype))
        win_p_l.append(kv[:, s_len - win_p:, 2].astype(cache_win_kv.dtype))
        wkv_p.append(st_p.astype(state_wkv.dtype))
        sh_p.append(shift_p.astype(state_shift.dtype))

        q, kv, gates, a_gate, rz, r_gate, merge = mixer_inputs(xs, pos_s, norm_g[i], w_in[i])
        past_cmp = cache_cmp_kv[i][page_table].reshape(db, past, 2, NSA_GROUPS, HD)
        past_sel = cache_sel_kv[i][page_table].reshape(db, past, 2, NSA_GROUPS, HD)
        full_cmp = jnp.concatenate([past_cmp, kv[:, :, 0].astype(past_cmp.dtype)], axis=1)
        full_sel = jnp.concatenate([past_sel, kv[:, :, 1].astype(past_sel.dtype)], axis=1)
        kc, vc, c_end, k_s, v_s, ov = nsa_context(full_cmp, full_sel, *cmp_w)
        win = jnp.concatenate([cache_win_kv[i], kv[:, :, 2].astype(cache_win_kv.dtype)], axis=1)
        o_a = nsa_query_block(q, gates, pos_s, kc, vc, c_end, k_s, v_s, ov, win[:, :, 0], win[:, :, 1], kw_pos_s)
        o_b, st_s, shift_s = rwkv_time_mix(rz, state_shift[i], state_wkv[i], *rw)
        xs = mixer_outputs(xs, o_a, o_b, a_gate, r_gate, merge, p_sample[i], *out_w)
        cmp_s.append(kv[:, :, 0].astype(cache_cmp_kv.dtype))
        sel_s.append(kv[:, :, 1].astype(cache_sel_kv.dtype))
        win_s_l.append(win[:, win.shape[1] - win_buf:])
        wkv_s.append(st_s.astype(state_wkv.dtype))
        sh_s.append(shift_s.astype(state_shift.dtype))

    y_prompt = rms_norm(xp, final_norm_g)
    y_sample = rms_norm(xs, final_norm_g)
    return (y_prompt, y_sample, jnp.stack(cmp_p), jnp.stack(cmp_s), jnp.stack(sel_p), jnp.stack(sel_s),
            jnp.stack(win_p_l), jnp.stack(win_s_l), jnp.stack(wkv_p), jnp.stack(wkv_s), jnp.stack(sh_p), jnp.stack(sh_s))
```

```cpp
#include <hip/hip_runtime.h>
#include <stdint.h>
#include <stdio.h>
namespace pg8 {
#define PG8_LAS __attribute__((address_space(3)))
typedef unsigned short bf16_t;
typedef short bf16x8 __attribute__((ext_vector_type(8)));
typedef float f32x4 __attribute__((ext_vector_type(4)));
typedef unsigned u32x4 __attribute__((ext_vector_type(4)));
constexpr int BM = 256, BK = 64, HALF = 128, HTB = HALF * BK * 2  , STAGE_BYTES = 8 * HTB, NXCD = 8, WGM = 8;

__host__ __device__ __forceinline__ int lds_byte(int r, int c) { const int st = (r >> 4) * 2 + (c >> 5), rr = r & 15, cc = c & 31, ob = rr * 64 + cc * 2; return st * 1024 + (ob ^ (((ob >> 9) & 1) << 5)); }
__host__ __device__ __forceinline__ void stage_rc(int b, int& R, int& C) { const int st = b / 1024, sb = b % 1024, swz = sb ^ (((sb >> 9) & 1) << 5); R = (st >> 1) * 16 + swz / 64; C = (st & 1) * 32 + (swz % 64) / 2; }
__host__ __device__ __forceinline__ int perm32(int rho) { const int n = rho >> 4, i = rho & 15; return 8 * (i >> 2) + 4 * n + (i & 3); }

struct Unit { int pm, pn; };
struct Gemm { const bf16_t* A; const bf16_t* Bt; int M, N, K, pad_; };

struct StaticOrder {
    int nM, nN, nwg, G, c;
    __host__ __device__ void init(int M, int N, int G_, int c_) { nM = M / BM; nN = N / BM; nwg = nM * nN; G = G_; c = c_; }
    __host__ __device__ bool next(int i, Unit& u) const {
        const long L = (long)i * G + c; if (L >= nwg) return false;
        int wgid = (int)L; { const int q = nwg / NXCD, r = nwg % NXCD, xcd = wgid % NXCD, off = wgid / NXCD; wgid = (xcd < r ? xcd * (q + 1) : r * (q + 1) + (xcd - r) * q) + off; }
        const int nig = WGM * nN, gid = wgid / nig, fm = gid * WGM, gsz = (nM - fm) < WGM ? (nM - fm) : WGM;
        u.pm = fm + ((wgid % nig) % gsz); u.pn = (wgid % nig) / gsz; return true;
    }
    __device__ __forceinline__ void a_ready(const Unit&) const {}
    __device__ __forceinline__ void done(const Unit&) const {}
};
__device__ __forceinline__ unsigned cvt_pk_bf16(float lo, float hi) { unsigned r; asm volatile("v_cvt_pk_bf16_f32 %0, %1, %2" : "=v"(r) : "v"(lo), "v"(hi)); return r; }
typedef float f32x2 __attribute__((ext_vector_type(2)));
template <class Epi, class Sched, bool STAMP = false>
__device__ __forceinline__ void gemm_phase(PG8_LAS unsigned char* lds, const Gemm g, const Sched& S, const Epi& E, unsigned long long* stamps) {
    const int tid = threadIdx.x, wid = __builtin_amdgcn_readfirstlane(tid >> 6), lane = tid & 63, wr = wid >> 2, wc = wid & 3, fr = lane & 15, fq = lane >> 4;
    const int K = g.K, nt = K / BK;
    int ts_lo = 0, ts_hi = 0, nts = 0; const unsigned long long rt_entry = STAMP ? (unsigned long long)wall_clock64() : 0ull;
#define PG8_STAMP() do { if (STAMP && wid == 0 && nts < 64) { const unsigned long long _c = (unsigned long long)clock64(); \
        ts_lo = (lane == nts) ? (int)(unsigned)_c : ts_lo; ts_hi = (lane == nts) ? (int)(unsigned)(_c >> 32) : ts_hi; ++nts; } } while (0)
    PG8_STAMP();
    unsigned voffA[2], voffB[2];
#pragma unroll
    for (int i = 0; i < 2; ++i) { int R, C; stage_rc(tid * 16 + i * 8192, R, C); const int Rb = Epi::PERM ? ((R & ~31) + perm32(R & 31)) : R;
        voffA[i] = (unsigned)(R * K + C) * 2u; voffB[i] = (unsigned)(Rb * K + C) * 2u; }
    const size_t kstep = (size_t)(BK * 2);
    const size_t hstep = (size_t)HALF * K * 2;
    const size_t tstep = 2 * hstep;
    const unsigned ldsw = (unsigned)wid * 1024u;
    const int aoff = lds_byte(wr * 64 + fr, fq * 8), boff = lds_byte(wc * 32 + fr, fq * 8);
#define PG8_SA(b, h) (((b) * 2 + (h)) * HTB)
#define PG8_SB(b, h) ((4 + (b) * 2 + (h)) * HTB)
#define PG8_STAGE(bufoff, gbase, voff) do { _Pragma("unroll") for (int _i = 0; _i < 2; ++_i) \
        __builtin_amdgcn_global_load_lds((const unsigned*)((const char*)(gbase) + (voff)[_i]), (PG8_LAS unsigned*)(lds + (bufoff) + ldsw + _i * 8192), 16, 0, 0); } while (0)
#define PG8_LDA(dst, b, h) do { _Pragma("unroll") for (int m = 0; m < 4; ++m) _Pragma("unroll") for (int k = 0; k < 2; ++k) dst[m][k] = *(const PG8_LAS bf16x8*)(lds + PG8_SA(b, h) + aoff + m * 2048 + k * 1024); } while (0)
#define PG8_LDB(dst, b, h) do { _Pragma("unroll") for (int n = 0; n < 2; ++n) _Pragma("unroll") for (int k = 0; k < 2; ++k) dst[n][k] = *(const PG8_LAS bf16x8*)(lds + PG8_SB(b, h) + boff + n * 2048 + k * 1024); } while (0)
#define PG8_MMA(ai, bj, At, Bt) do { __builtin_amdgcn_s_setprio(1); _Pragma("unroll") for (int m = 0; m < 4; ++m) _Pragma("unroll") for (int n = 0; n < 2; ++n) _Pragma("unroll") for (int k = 0; k < 2; ++k) \
        acc[ai][bj][m][n] = __builtin_amdgcn_mfma_f32_16x16x32_bf16(Bt[n][k], At[m][k], acc[ai][bj][m][n], 0, 0, 0); __builtin_amdgcn_s_setprio(0); } while (0)
#define PG8_WAIT_V(n) asm volatile("s_waitcnt vmcnt(" #n ")" ::: "memory")
#define PG8_WAIT_L(n) asm volatile("s_waitcnt lgkmcnt(" #n ")" ::: "memory")
#define PG8_BAR __builtin_amdgcn_s_barrier()
#define PG8_SCHED __builtin_amdgcn_sched_barrier(0)
    Unit cur, nxt; int ui = 0;
    if (!S.next(0, cur)) return;
    f32x4 acc[2][2][4][2];
#pragma unroll
    for (int a = 0; a < 2; ++a)
#pragma unroll
        for (int b = 0; b < 2; ++b)
#pragma unroll
            for (int m = 0; m < 4; ++m)
#pragma unroll
                for (int n = 0; n < 2; ++n) acc[a][b][m][n] = (f32x4){0.f, 0.f, 0.f, 0.f};
    bf16x8 At[4][2], B0[2][2], B1[2][2];
    const char* cA = (const char*)g.A + (size_t)cur.pm * tstep; const char* cB = (const char*)g.Bt + (size_t)cur.pn * tstep;
    S.a_ready(cur);
    PG8_STAGE(PG8_SB(0, 0), cB, voffB); PG8_STAGE(PG8_SA(0, 0), cA, voffA); PG8_STAGE(PG8_SB(0, 1), cB + hstep, voffB); PG8_STAGE(PG8_SA(0, 1), cA + hstep, voffA);
    if (wr == 1) PG8_BAR;
    PG8_WAIT_V(4); PG8_BAR;
    PG8_STAGE(PG8_SB(1, 0), cB + kstep, voffB); PG8_STAGE(PG8_SA(1, 0), cA + kstep, voffA); PG8_STAGE(PG8_SB(1, 1), cB + hstep + kstep, voffB);
    PG8_WAIT_V(6); PG8_BAR;
    PG8_STAMP();
    for (;;) {
        const bool has_next = S.next(ui + 1, nxt);
        const char* nA = has_next ? (const char*)g.A + (size_t)nxt.pm * tstep : cA; const char* nB = has_next ? (const char*)g.Bt + (size_t)nxt.pn * tstep : cB;
        for (int t = 0; t < nt; t += 2) {
            const bool last = (t == nt - 2);
            const char* a1 = cA + (size_t)(t + 1) * kstep;
            const char* a2 = last ? nA : cA + (size_t)(t + 2) * kstep; const char* b2 = last ? nB : cB + (size_t)(t + 2) * kstep;
            const char* a3 = a2 + kstep; const char* b3 = b2 + kstep;
            if (last && has_next) S.a_ready(nxt);
            PG8_LDB(B0, 0, 0); PG8_SCHED; PG8_LDA(At, 0, 0); PG8_STAGE(PG8_SA(1, 1), a1 + hstep, voffA);
            PG8_WAIT_L(8); PG8_BAR; PG8_WAIT_L(0); PG8_MMA(0, 0, At, B0); PG8_BAR; PG8_SCHED;
            PG8_LDB(B1, 0, 1); PG8_STAGE(PG8_SB(0, 0), b2, voffB);
            PG8_BAR; PG8_WAIT_L(0); PG8_MMA(0, 1, At, B1); PG8_BAR;
            PG8_LDA(At, 0, 1); PG8_STAGE(PG8_SA(0, 0), a2, voffA);
            PG8_BAR; PG8_WAIT_L(0); PG8_MMA(1, 0, At, B0); PG8_BAR; PG8_SCHED;
            PG8_STAGE(PG8_SB(0, 1), b2 + hstep, voffB);
            PG8_WAIT_V(6); PG8_BAR; PG8_MMA(1, 1, At, B1); PG8_BAR;
            PG8_LDB(B0, 1, 0); PG8_SCHED; PG8_LDA(At, 1, 0); PG8_STAGE(PG8_SA(0, 1), a2 + hstep, voffA);
            PG8_WAIT_L(8); PG8_BAR; PG8_WAIT_L(0); PG8_MMA(0, 0, At, B0); PG8_BAR; PG8_SCHED;
            PG8_LDB(B1, 1, 1); PG8_STAGE(PG8_SB(1, 0), b3, voffB);
            PG8_BAR; PG8_WAIT_L(0); PG8_MMA(0, 1, At, B1); PG8_BAR;
            PG8_LDA(At, 1, 1); PG8_STAGE(PG8_SA(1, 0), a3, voffA);
            PG8_BAR; PG8_WAIT_L(0); PG8_MMA(1, 0, At, B0); PG8_BAR; PG8_SCHED;
            PG8_STAGE(PG8_SB(1, 1), b3 + hstep, voffB);
            PG8_WAIT_V(6); PG8_BAR; PG8_MMA(1, 1, At, B1); PG8_BAR;
        }
        PG8_STAMP();
        if constexpr (!Epi::AFTER_DRAIN) { E(acc, cur, wr, wc, fr, fq); S.done(cur); }
        PG8_STAMP();
        if (!has_next) break;
#pragma unroll
        for (int a = 0; a < 2; ++a)
#pragma unroll
            for (int b = 0; b < 2; ++b)
#pragma unroll
                for (int m = 0; m < 4; ++m)
#pragma unroll
                    for (int n = 0; n < 2; ++n) acc[a][b][m][n] = (f32x4){0.f, 0.f, 0.f, 0.f};
        cur = nxt; cA = nA; cB = nB; ++ui;
    }
    PG8_WAIT_V(0);
    if (wr == 0) PG8_BAR;
    PG8_BAR;
    if constexpr (Epi::AFTER_DRAIN) { E.fused(acc, cur, wr, wc, fr, fq, lds, wid, lane); S.done(cur); }
    PG8_STAMP();
    if (STAMP && wid == 0) { stamps[lane] = lane < nts ? (((unsigned long long)(unsigned)ts_hi << 32) | (unsigned)ts_lo) : 0ull;
        if (lane == 62) stamps[62] = rt_entry; if (lane == 63) stamps[63] = (unsigned long long)wall_clock64(); }
#undef PG8_STAMP
#undef PG8_SA
#undef PG8_SB
#undef PG8_STAGE
#undef PG8_LDA
#undef PG8_LDB
#undef PG8_MMA
#undef PG8_WAIT_V
#undef PG8_WAIT_L
#undef PG8_BAR
#undef PG8_SCHED
}
}

typedef unsigned short bf16_t;
typedef short bf16x8 __attribute__((ext_vector_type(8)));
typedef float f32x4 __attribute__((ext_vector_type(4)));
typedef float f32x16 __attribute__((ext_vector_type(16)));
#define LAS __attribute__((address_space(3)))
#define WAVE_SYNC() do { asm volatile("s_waitcnt lgkmcnt(0)" ::: "memory"); __builtin_amdgcn_wave_barrier(); } while (0)

constexpr int DM = 1024, NP = 16384, NSMP = 256, MR = 16640, SEQ = 4096, NB = 4, DB = 32, DS = 8, PAST = 16384;
constexpr int CIN = 6040, NPAD = 6144, CR = 1664;
constexpr int NTHR = 512;
constexpr size_t O_Y_P = 0, O_Y_S = 16777216, O_CMP_P = 17039360, O_CMP_S = 21233664, O_SEL_P = 21299200, O_SEL_S = 25493504,
                 O_WIN_P = 25559040, O_WIN_S = 26083328, O_WKV_P = 30277632, O_WKV_S = 30408704, O_SH_P = 31457280, O_SH_S = 31463936;

struct P {
    const float *x_prompt, *x_sample, *p_prompt, *p_sample, *cache_cmp, *cache_sel, *cache_win, *state_wkv, *state_shift;
    const int* page_table;
    const float *norm_g, *w_in, *cmp_pe, *cmp_w1, *cmp_b1, *cmp_w2, *cmp_b2, *w_pa, *mu, *w0, *w_up, *a0, *a_up, *k_k, *k_a, *r_k, *gn_g, *gn_b,
        *w_pb, *w_out, *ple_g, *w_gate, *w_proj, *final_g;
    float* out;
    unsigned* bar;
    bf16_t *hb, *WinT, *WpaT, *WpbT, *WoutT, *WgateT, *WprojT, *W1T, *pb;
    float *tabc, *tabs, *pt;
    bf16_t *qb, *kb, *vcr, *vT, *ag, *rg, *mg;
    float *gates, *rz;
    float *LHp, *LHs; bf16_t *cs, *kc_p, *vcT_p, *kc_s, *vcT_s;
    float *rw6, *bonus, *ybuf;
    bf16_t *oa, *ob, *mb, *xg;
    float *tmp, *x1, *ss1, *pp;
};

__device__ __forceinline__ bf16_t f2bf(float f) { unsigned u = __float_as_uint(f); u += 0x7FFFu + ((u >> 16) & 1u); return (bf16_t)(u >> 16); }
__device__ __forceinline__ float bf2f(bf16_t b) { return __uint_as_float(((unsigned)b) << 16); }
typedef __bf16 bf16v2_t __attribute__((ext_vector_type(2)));
typedef float f32x2_t __attribute__((ext_vector_type(2)));
__device__ __forceinline__ unsigned pk2(float lo, float hi) { const f32x2_t v = {lo, hi}; return __builtin_bit_cast(unsigned, __builtin_convertvector(v, bf16v2_t)); }
__device__ __forceinline__ float wave_sum(float v) {
#pragma unroll
    for (int o = 32; o >= 1; o >>= 1) v += __shfl_xor(v, o);
    return v;
}
__device__ __forceinline__ float sigmoidf_(float x) { return 1.0f / (1.0f + __expf(-x)); }
__device__ __forceinline__ float siluf_(float x) { return x / (1.0f + __expf(-x)); }

__device__ __forceinline__ int win_src_col(int np) {
    const int pn = np >> 8, p = np & 255;
    if (pn < 5) {
        const int bj = p >> 7, wc = (p >> 5) & 3, n = (p >> 4) & 1, fq = (p >> 2) & 3, e = p & 3;
        const int d = 32 * n + 16 * (wc & 1) + 4 * fq + e;
        if (pn < 2) { const int head = pn * 4 + bj * 2 + (wc >> 1); return head * 64 + d; }
        const int br = pn - 2, g = wc >> 1;
        return 512 + br * 256 + bj * 128 + g * 64 + d;
    }
    if (pn < 7) return 1304 + (pn - 5) * 256 + p;
    if (pn < 13) return 1816 + (pn - 7) * 256 + p;
    if (pn == 13) { if (p < 128) return 1816 + 1536 + p; if (p < 152) return 1280 + (p - 128); return -1; }
    if (pn < 16) return 3480 + (pn - 14) * 256 + p;
    return 3992 + (pn - 16) * 256 + p;
}

template <class F>
__device__ __forceinline__ void transpose_cvt(bf16_t* dst, int Nd, int K, F f) {
    const int total = Nd * (K >> 3);
    for (int id = blockIdx.x * NTHR + threadIdx.x; id < total; id += gridDim.x * NTHR) {
        const int n = id % Nd, kc = id / Nd;
        float v[8];
#pragma unroll
        for (int j = 0; j < 8; ++j) v[j] = f(n, kc * 8 + j);
        uint4 w; w.x = pk2(v[0], v[1]); w.y = pk2(v[2], v[3]); w.z = pk2(v[4], v[5]); w.w = pk2(v[6], v[7]);
        *(uint4*)(dst + (size_t)n * K + kc * 8) = w;
    }
}

__device__ __forceinline__ void sincos_small(double r, float& s, float& c) {
    const double r2 = r * r;
    double sa = 1.0, ca = 1.0;
    double ts = 1.0, tc = 1.0; sa = 0.0; ca = 0.0;
#pragma unroll
    for (int k = 0; k < 16; ++k) {
        sa += ts; ca += tc;
        ts = -ts * r2 / (double)((2 * k + 2) * (2 * k + 3));
        tc = -tc * r2 / (double)((2 * k + 1) * (2 * k + 2));
    }
    s = (float)(sa * r); c = (float)ca;
}

__device__ __forceinline__ void ph_prep(const P& p) {
    const int tid = threadIdx.x, lane = tid & 63, wid = tid >> 6;
    const int gw = blockIdx.x * 8 + wid, nw = gridDim.x * 8;
    const int gt = blockIdx.x * NTHR + tid, nt = gridDim.x * NTHR;
    for (int row = gw; row < MR; row += nw) {
        const float4* src = (const float4*)(row < NP ? p.x_prompt + (size_t)row * DM : p.x_sample + (size_t)(row - NP) * DM);
        float4 v[4]; float ss = 0.f;
#pragma unroll
        for (int i = 0; i < 4; ++i) { v[i] = src[lane + 64 * i]; ss += v[i].x * v[i].x + v[i].y * v[i].y + v[i].z * v[i].z + v[i].w * v[i].w; }
        ss = wave_sum(ss);
        const float rstd = rsqrtf(ss * (1.0f / DM) + 1e-6f);
#pragma unroll
        for (int i = 0; i < 4; ++i) {
            const float4 g = ((const float4*)p.norm_g)[lane + 64 * i];
            uint2 w; w.x = pk2(v[i].x * rstd * g.x, v[i].y * rstd * g.y); w.y = pk2(v[i].z * rstd * g.z, v[i].w * rstd * g.w);
            *(uint2*)(p.hb + (size_t)row * DM + 4 * (lane + 64 * i)) = w;
        }
    }
    { const float* w = p.w_in; transpose_cvt(p.WinT, NPAD, DM, [=](int n, int k) { const int c = win_src_col(n); return c < 0 ? 0.f : w[(size_t)k * CIN + c]; }); }
    { const float* w = p.w_pa; transpose_cvt(p.WpaT, DM, 512, [=](int n, int k) { return w[(size_t)k * DM + n]; }); }
    { const float* w = p.w_pb; transpose_cvt(p.WpbT, DM, 512, [=](int n, int k) { return w[(size_t)k * DM + n]; }); }
    { const float* w = p.w_out; transpose_cvt(p.WoutT, DM, DM, [=](int n, int k) { return w[(size_t)k * DM + n]; }); }
    { const float* w = p.w_gate; transpose_cvt(p.WgateT, DM, DM, [=](int n, int k) { return w[(size_t)k * DM + n]; }); }
    { const float* w = p.w_proj; transpose_cvt(p.WprojT, DM, 256, [=](int n, int k) { return w[(size_t)k * DM + n]; }); }
    { const float* w = p.cmp_w1; transpose_cvt(p.W1T, 512, 1024, [=](int n, int k) { const int kvi = n >> 8, nn = n & 255; return w[(size_t)kvi * 262144 + (size_t)((nn >> 7) * 1024 + k) * 128 + (nn & 127)]; }); }
    for (int id = gt; id < MR * 64; id += nt) {
        const int row = id >> 6, c4 = id & 63;
        const float4 v = ((const float4*)(row < NP ? p.p_prompt + (size_t)row * 256 : p.p_sample + (size_t)(row - NP) * 256))[c4];
        uint2 w; w.x = pk2(v.x, v.y); w.y = pk2(v.z, v.w);
        *(uint2*)(p.pb + (size_t)row * 256 + c4 * 4) = w;
    }
    for (int id = gt; id < 4104 * 32; id += nt) {
        const int pi = id >> 5, i = id & 31;
        const int pos = pi < 4096 ? pi : PAST + pi - 4096;
        const float inv = (float)exp(-(double)i * (9.210340371976184 / 32.0));
        const float ang = (float)pos * inv;
        const double x = (double)ang;
        const double k = rint(x * 0.15915494309189535);
        const double r = x - k * 6.283185307179586;
        float s, c; sincos_small(r, s, c);
        p.tabc[id] = c; p.tabs[id] = s;
    }
    for (int o = gw; o < 256; o += nw) {
        const int kvi = o >> 7, f = o & 127;
        float acc = 0.f;
        for (int jd = lane; jd < 2048; jd += 64) acc += p.cmp_pe[kvi * 2048 + jd] * p.cmp_w1[(size_t)kvi * 262144 + (size_t)jd * 128 + f];
        acc = wave_sum(acc);
        if (lane == 0) p.pt[o] = acc + p.cmp_b1[o];
    }
    for (int id = gt; id < DB * 504 * 64; id += nt) {
        const int c4 = id & 63, j = (id >> 6) % 504, b = (id >> 6) / 504;
        ((float4*)(p.out + O_WIN_S))[((size_t)b * 512 + j) * 64 + c4] = ((const float4*)p.cache_win)[((size_t)b * 512 + j + 8) * 64 + c4];
    }
}

using pg8::Unit;

__device__ __forceinline__ void st_bf4(bf16_t* dst, f32x4 v) { uint2 w; w.x = pk2(v[0], v[1]); w.y = pk2(v[2], v[3]); *(uint2*)dst = w; }

struct EpiIn {
    static constexpr bool PERM = false, AFTER_DRAIN = false;
    P p;
    __device__ __forceinline__ void operator()(const f32x4 (&acc)[2][2][4][2], const Unit& u, int wr, int wc, int fr, int fq) const {
        const int pn = u.pn;
#pragma unroll
        for (int ai = 0; ai < 2; ++ai)
#pragma unroll
            for (int m = 0; m < 4; ++m) {
                const int row = u.pm * 256 + ai * 128 + wr * 64 + m * 16 + fr;
                if (pn < 5) {
                    const int pi = row < NP ? (row & (SEQ - 1)) : 4096 + ((row - NP) & 7);
                    const int d0 = 16 * (wc & 1) + 4 * fq;
                    const f32x4 cs = *(const f32x4*)(p.tabc + pi * 32 + d0), sn = *(const f32x4*)(p.tabs + pi * 32 + d0);
#pragma unroll
                    for (int bj = 0; bj < 2; ++bj) {
                        const f32x4 x1 = acc[ai][bj][m][0], x2 = acc[ai][bj][m][1];
                        if (pn < 2) {
                            const int head = pn * 4 + bj * 2 + (wc >> 1);
                            const f32x4 o1 = (x1 * cs - x2 * sn) * 0.125f, o2 = (x2 * cs + x1 * sn) * 0.125f;
                            bf16_t* q = p.qb + (size_t)row * 512 + head * 64 + d0;
                            st_bf4(q, o1); st_bf4(q + 32, o2);
                        } else {
                            const int br = pn - 2, g = wc >> 1;
                            f32x4 o1, o2;
                            if (bj == 0) { o1 = x1 * cs - x2 * sn; o2 = x2 * cs + x1 * sn; } else { o1 = x1; o2 = x2; }
                            float* dst = nullptr;
                            if (row < NP) {
                                if (br == 0) dst = p.out + O_CMP_P + (size_t)row * 256;
                                else if (br == 1) dst = p.out + O_SEL_P + (size_t)row * 256;
                                else { const int s = row & (SEQ - 1); if (s >= SEQ - 512) dst = p.out + O_WIN_P + ((size_t)(row >> 12) * 512 + (s - (SEQ - 512))) * 256; }
                            } else {
                                const int rs = row - NP;
                                if (br == 0) dst = p.out + O_CMP_S + (size_t)rs * 256;
                                else if (br == 1) dst = p.out + O_SEL_S + (size_t)rs * 256;
                                else dst = p.out + O_WIN_S + ((size_t)(rs >> 3) * 512 + 504 + (rs & 7)) * 256;
                            }
                            if (dst) { dst += bj * 128 + g * 64 + d0; *(f32x4*)dst = o1; *(f32x4*)(dst + 32) = o2; }
                            if (row < NP) {
                                const int b = row >> 12, s = row & (SEQ - 1);
                                if (bj == 0) {
                                    bf16_t* k = p.kb + ((size_t)((br * NB + b) * 2 + g) * SEQ + s) * 64 + d0;
                                    st_bf4(k, o1); st_bf4(k + 32, o2);
                                } else if (br == 0) {
                                    bf16_t* v = p.vcr + ((size_t)(b * 2 + g) * SEQ + s) * 64 + d0;
                                    st_bf4(v, o1); st_bf4(v + 32, o2);
                                } else {
                                    bf16_t* v = p.vT + ((size_t)(((br - 1) * NB + b) * 2 + g) * 64 + d0) * SEQ + s;
#pragma unroll
                                    for (int e = 0; e < 4; ++e) { v[(size_t)e * SEQ] = f2bf(o1[e]); v[(size_t)(32 + e) * SEQ] = f2bf(o2[e]); }
                                }
                            }
                        }
                    }
                } else {
#pragma unroll
                    for (int bj = 0; bj < 2; ++bj)
#pragma unroll
                        for (int n = 0; n < 2; ++n) {
                            const int c = bj * 128 + wc * 32 + n * 16 + fq * 4;
                            const f32x4 v = acc[ai][bj][m][n];
                            if (pn < 7) {
                                f32x4 o; for (int e = 0; e < 4; ++e) o[e] = siluf_(v[e]);
                                st_bf4(p.ag + (size_t)row * 512 + (pn - 5) * 256 + c, o);
                            } else if (pn < 13) {
                                *(f32x4*)(p.rz + (size_t)row * CR + (pn - 7) * 256 + c) = v;
                            } else if (pn == 13) {
                                if (c < 128) *(f32x4*)(p.rz + (size_t)row * CR + 1536 + c) = v;
                                else if (c < 152) { f32x4 o; for (int e = 0; e < 4; ++e) o[e] = sigmoidf_(v[e]); *(f32x4*)(p.gates + (size_t)row * 32 + (c - 128)) = o; }
                            } else if (pn < 16) {
                                f32x4 o; for (int e = 0; e < 4; ++e) o[e] = siluf_(v[e]);
                                st_bf4(p.rg + (size_t)row * 512 + (pn - 14) * 256 + c, o);
                            } else {
                                f32x4 o; for (int e = 0; e < 4; ++e) o[e] = sigmoidf_(v[e]);
                                st_bf4(p.mg + (size_t)row * 2048 + (pn - 16) * 256 + c, o);
                            }
                        }
                }
            }
    }
};

struct EpiPlain {
    static constexpr bool PERM = false, AFTER_DRAIN = false;
    float* C; int ldc; int pad_;
    __device__ __forceinline__ void operator()(const f32x4 (&acc)[2][2][4][2], const Unit& u, int wr, int wc, int fr, int fq) const {
#pragma unroll
        for (int ai = 0; ai < 2; ++ai)
#pragma unroll
            for (int m = 0; m < 4; ++m) {
                float* rowp = C + (size_t)(u.pm * 256 + ai * 128 + wr * 64 + m * 16 + fr) * ldc + u.pn * 256 + wc * 32 + 4 * fq;
#pragma unroll
                for (int bj = 0; bj < 2; ++bj)
#pragma unroll
                    for (int n = 0; n < 2; ++n) *(f32x4*)(rowp + bj * 128 + n * 16) = acc[ai][bj][m][n];
            }
    }
};

struct EpiYa {
    static constexpr bool PERM = false, AFTER_DRAIN = false;
    P p;
    __device__ __forceinline__ void operator()(const f32x4 (&acc)[2][2][4][2], const Unit& u, int wr, int wc, int fr, int fq) const {
#pragma unroll
        for (int ai = 0; ai < 2; ++ai)
#pragma unroll
            for (int m = 0; m < 4; ++m) {
                const int row = u.pm * 256 + ai * 128 + wr * 64 + m * 16 + fr;
#pragma unroll
                for (int bj = 0; bj < 2; ++bj)
#pragma unroll
                    for (int n = 0; n < 2; ++n) {
                        const int c = u.pn * 256 + bj * 128 + wc * 32 + n * 16 + fq * 4;
                        const uint2 gw = *(const uint2*)(p.mg + (size_t)row * 2048 + c);
                        f32x4 g; g[0] = __uint_as_float(gw.x << 16); g[1] = __uint_as_float(gw.x & 0xffff0000u); g[2] = __uint_as_float(gw.y << 16); g[3] = __uint_as_float(gw.y & 0xffff0000u);
                        *(f32x4*)(p.tmp + (size_t)row * DM + c) = g * acc[ai][bj][m][n];
                    }
            }
    }
};
struct EpiYb {
    static constexpr bool PERM = false, AFTER_DRAIN = false;
    P p;
    __device__ __forceinline__ void operator()(const f32x4 (&acc)[2][2][4][2], const Unit& u, int wr, int wc, int fr, int fq) const {
#pragma unroll
        for (int ai = 0; ai < 2; ++ai)
#pragma unroll
            for (int m = 0; m < 4; ++m) {
                const int row = u.pm * 256 + ai * 128 + wr * 64 + m * 16 + fr;
#pragma unroll
                for (int bj = 0; bj < 2; ++bj)
#pragma unroll
                    for (int n = 0; n < 2; ++n) {
                        const int c = u.pn * 256 + bj * 128 + wc * 32 + n * 16 + fq * 4;
                        const uint2 gw = *(const uint2*)(p.mg + (size_t)row * 2048 + 1024 + c);
                        f32x4 g; g[0] = __uint_as_float(gw.x << 16); g[1] = __uint_as_float(gw.x & 0xffff0000u); g[2] = __uint_as_float(gw.y << 16); g[3] = __uint_as_float(gw.y & 0xffff0000u);
                        const f32x4 t = *(const f32x4*)(p.tmp + (size_t)row * DM + c);
                        st_bf4(p.mb + (size_t)row * DM + c, t + g * acc[ai][bj][m][n]);
                    }
            }
    }
};
struct EpiOut {
    static constexpr bool PERM = false, AFTER_DRAIN = false;
    P p;
    __device__ __forceinline__ void operator()(const f32x4 (&acc)[2][2][4][2], const Unit& u, int wr, int wc, int fr, int fq) const {
#pragma unroll
        for (int ai = 0; ai < 2; ++ai)
#pragma unroll
            for (int m = 0; m < 4; ++m) {
                const int row = u.pm * 256 + ai * 128 + wr * 64 + m * 16 + fr;
                const float* xr = row < NP ? p.x_prompt + (size_t)row * DM : p.x_sample + (size_t)(row - NP) * DM;
                float ss = 0.f;
#pragma unroll
                for (int bj = 0; bj < 2; ++bj)
#pragma unroll
                    for (int n = 0; n < 2; ++n) {
                        const int c = u.pn * 256 + bj * 128 + wc * 32 + n * 16 + fq * 4;
                        const f32x4 v = *(const f32x4*)(xr + c) + acc[ai][bj][m][n];
                        *(f32x4*)(p.x1 + (size_t)row * DM + c) = v;
                        ss += v[0] * v[0] + v[1] * v[1] + v[2] * v[2] + v[3] * v[3];
                        st_bf4(p.xg + (size_t)row * DM + c, v * *(const f32x4*)(p.ple_g + c));
                    }
                ss += __shfl_xor(ss, 16); ss += __shfl_xor(ss, 32);
                if (fq == 0) p.ss1[(size_t)row * 16 + u.pn * 4 + wc] = ss;
            }
    }
};
struct EpiGate {
    static constexpr bool PERM = false, AFTER_DRAIN = false;
    P p;
    __device__ __forceinline__ void operator()(const f32x4 (&acc)[2][2][4][2], const Unit& u, int wr, int wc, int fr, int fq) const {
#pragma unroll
        for (int ai = 0; ai < 2; ++ai)
#pragma unroll
            for (int m = 0; m < 4; ++m) {
                const int row = u.pm * 256 + ai * 128 + wr * 64 + m * 16 + fr;
                float ss = 0.f;
#pragma unroll
                for (int i = 0; i < 4; ++i) { const f32x4 t = *(const f32x4*)(p.ss1 + (size_t)row * 16 + i * 4); ss += (t[0] + t[1]) + (t[2] + t[3]); }
                const float rstd = rsqrtf(ss * (1.0f / DM) + 1e-6f);
#pragma unroll
                for (int bj = 0; bj < 2; ++bj)
#pragma unroll
                    for (int n = 0; n < 2; ++n) {
                        const int c = u.pn * 256 + bj * 128 + wc * 32 + n * 16 + fq * 4;
                        const f32x4 a = acc[ai][bj][m][n] * rstd;
                        f32x4 g; for (int e = 0; e < 4; ++e) g[e] = sigmoidf_(a[e]);
                        float* ppp = p.pp + (size_t)row * DM + c;
                        *(f32x4*)ppp = *(const f32x4*)(p.x1 + (size_t)row * DM + c) + g * *(const f32x4*)ppp;
                    }
            }
    }
};

__device__ __forceinline__ void ph_final(const P& p) {
    const int tid = threadIdx.x, lane = tid & 63, wid = tid >> 6;
    for (int row = blockIdx.x * 8 + wid; row < MR; row += gridDim.x * 8) {
        const float4* src = (const float4*)(p.pp + (size_t)row * DM);
        float4 v[4]; float ss = 0.f;
#pragma unroll
        for (int i = 0; i < 4; ++i) { v[i] = src[lane + 64 * i]; ss += v[i].x * v[i].x + v[i].y * v[i].y + v[i].z * v[i].z + v[i].w * v[i].w; }
        ss = wave_sum(ss);
        const float rstd = rsqrtf(ss * (1.0f / DM) + 1e-6f);
        float4* dst = (float4*)(p.out + (row < NP ? O_Y_P + (size_t)row * DM : O_Y_S + (size_t)(row - NP) * DM));
#pragma unroll
        for (int i = 0; i < 4; ++i) {
            const float4 g = ((const float4*)p.final_g)[lane + 64 * i];
            float4 o; o.x = v[i].x * rstd * g.x; o.y = v[i].y * rstd * g.y; o.z = v[i].z * rstd * g.z; o.w = v[i].w * rstd * g.w;
            dst[lane + 64 * i] = o;
        }
    }
}

__device__ __forceinline__ void ph_compress2(const P& p, const float* LH, int nbg, int nrows, int nblk, bf16_t* kc, bf16_t* vcT, LAS float* lds) {
    const int tid = threadIdx.x, lane = tid & 63, wid = tid >> 6;
    LAS float* sbuf = lds + wid * 128;
    const int total = 2 * nbg * nrows;
    for (int it = blockIdx.x * 8 + wid; it < total; it += gridDim.x * 8) {
        const int i = it % nrows, bg = (it / nrows) % nbg, kvi = it / (nrows * nbg);
        float o = 0.f;
        if (i < nblk) {
            const float* l0 = LH + ((size_t)kvi * nbg * nrows + (size_t)bg * nrows + i) * 256;
            const float* l1 = l0 + 256;
#pragma unroll
            for (int h = 0; h < 2; ++h) {
                const int f = lane + 64 * h;
                const float hid = l0[f] + l1[128 + f] + p.pt[kvi * 128 + f];
                sbuf[f] = siluf_(hid);
            }
            WAVE_SYNC();
            o = p.cmp_b2[kvi * 64 + lane];
            const float* w2 = p.cmp_w2 + kvi * 8192 + lane;
#pragma unroll 8
            for (int f = 0; f < 128; ++f) o += sbuf[f] * w2[f * 64];
            WAVE_SYNC();
        }
        if (kvi == 0) kc[((size_t)bg * nrows + i) * 64 + lane] = f2bf(o);
        else vcT[((size_t)bg * 64 + lane) * nrows + i] = f2bf(o);
    }
}

__device__ __forceinline__ void ph_cvt_cache(const P& p) {
    const size_t total = (size_t)2 * DB * 2 * PAST * 8;
    for (size_t id = (size_t)blockIdx.x * NTHR + threadIdx.x; id < total; id += (size_t)gridDim.x * NTHR) {
        const int d8 = (int)(id & 7), tok = (int)((id >> 3) & (PAST - 1)), g = (int)((id >> 17) & 1), b = (int)((id >> 18) & 31), kvi = (int)(id >> 23);
        const int page = p.page_table[b * 128 + (tok >> 7)];
        const float4* src = (const float4*)(p.cache_cmp + ((size_t)page * 128 + (tok & 127)) * 256 + kvi * 128 + g * 64 + d8 * 8);
        const float4 a = src[0], c = src[1];
        uint4 w; w.x = pk2(a.x, a.y); w.y = pk2(a.z, a.w); w.z = pk2(c.x, c.y); w.w = pk2(c.z, c.w);
        *(uint4*)(p.cs + id * 8) = w;
    }
}

__device__ __forceinline__ void ph_rwkv_prep(const P& p) {
    const int tid = threadIdx.x, lane = tid & 63, wid = tid >> 6;
    for (int it = blockIdx.x * 8 + wid; it < MR * 8; it += gridDim.x * 8) {
        const int row = it >> 3, h = it & 7, c = h * 64 + lane;
        const float* z = p.rz + (size_t)row * CR;
        const float* pv;
        bool zero_prev = false;
        if (row < NP) { if ((row & (SEQ - 1)) == 0) { zero_prev = true; pv = z; } else pv = z - CR; }
        else { const int rs = row - NP; if ((rs & 7) == 0) pv = p.state_shift + (size_t)(rs >> 3) * CR; else pv = z - CR; }
        auto lerp = [&](int col) { const float zz = z[col]; const float pr = zero_prev ? 0.f : pv[col]; return zz + (pr - zz) * p.mu[col]; };
        const float zr = lerp(c), zk = lerp(512 + c), zv = lerp(1024 + c), zwd = lerp(1536 + lane), zad = lerp(1600 + lane);
        const float th = tanhf(zwd);
        float accw = p.w0[c], acca = p.a0[c];
#pragma unroll 8
        for (int j = 0; j < 64; ++j) {
            const float tj = __shfl(th, j), aj = __shfl(zad, j);
            accw += tj * p.w_up[j * 512 + c]; acca += aj * p.a_up[j * 512 + c];
        }
        const float nx = -accw;
        const float sp = fmaxf(nx, 0.f) + log1pf(__expf(-fabsf(nx)));
        const float w = -sp - 0.5f;
        const float dec = __expf(-__expf(w));
        const float a = sigmoidf_(acca);
        const float kkr = zk * p.k_k[c];
        const float nrm = sqrtf(wave_sum(kkr * kkr));
        const float kk = kkr / fmaxf(nrm, 1e-12f);
        const float km = zk * (1.0f + (a - 1.0f) * p.k_a[c]);
        const float bon = wave_sum(zr * km * p.r_k[c]);
        float* o = p.rw6 + (size_t)it * 384 + lane;
        o[0] = zr; o[64] = dec; o[128] = km; o[192] = zv; o[256] = kk; o[320] = kk * a;
        if (lane == 0) p.bonus[it] = bon;
        if (h == 0) {
            float* so = nullptr;
            if (row < NP) { if ((row & (SEQ - 1)) == SEQ - 1) so = p.out + O_SH_P + (size_t)(row >> 12) * CR; }
            else { const int rs = row - NP; if ((rs & 7) == 7) so = p.out + O_SH_S + (size_t)(rs >> 3) * CR; }
            if (so) for (int i = lane; i < CR; i += 64) so[i] = z[i];
        }
    }
}

__device__ __forceinline__ void ph_rwkv_scan(const P& p, LAS float* lds) {
    const int tid = threadIdx.x, grp = tid >> 8, gt = tid & 255, vrow = gt >> 2, kq = gt & 3;
    LAS float* buf = lds + grp * (16 * 384);
    for (int bi = blockIdx.x; bi < 16 + 128; bi += gridDim.x) {
        int row0, T, b, h; const float* s0 = nullptr; float* sout;
        if (bi < 16) { const int item = bi * 2 + grp; b = item >> 3; h = item & 7; row0 = b * SEQ; T = SEQ; sout = p.out + O_WKV_P + (size_t)item * 4096; }
        else { const int item = (bi - 16) * 2 + grp; b = item >> 3; h = item & 7; row0 = NP + b * 8; T = 8; s0 = p.state_wkv + (size_t)item * 4096; sout = p.out + O_WKV_S + (size_t)item * 4096; }
        float S[16];
#pragma unroll
        for (int i = 0; i < 16; ++i) S[i] = s0 ? s0[vrow * 64 + kq * 16 + i] : 0.f;
        for (int t0 = 0; t0 < T; t0 += 16) {
            const int ns = (T - t0) < 16 ? (T - t0) : 16;
            __syncthreads();
#pragma unroll
            for (int i = 0; i < 6; ++i) {
                const int idx = i * 256 + gt, s = idx / 96, o = idx % 96;
                if (s < ns) *(LAS f32x4*)(buf + s * 384 + o * 4) = *(const f32x4*)(p.rw6 + ((size_t)(row0 + t0 + s) * 8 + h) * 384 + o * 4);
            }
            __syncthreads();
            for (int s = 0; s < ns; ++s) {
                LAS const float* bs = buf + s * 384;
                f32x4 r[4], d[4], km[4], kk[4], ka[4];
#pragma unroll
                for (int j = 0; j < 4; ++j) {
                    r[j] = *(LAS const f32x4*)(bs + 0 + kq * 16 + 4 * j);
                    d[j] = *(LAS const f32x4*)(bs + 64 + kq * 16 + 4 * j);
                    km[j] = *(LAS const f32x4*)(bs + 128 + kq * 16 + 4 * j);
                    kk[j] = *(LAS const f32x4*)(bs + 256 + kq * 16 + 4 * j);
                    ka[j] = *(LAS const f32x4*)(bs + 320 + kq * 16 + 4 * j);
                }
                const float vv = bs[192 + vrow];
                float sa = 0.f;
#pragma unroll
                for (int i = 0; i < 16; ++i) sa += S[i] * kk[i >> 2][i & 3];
                sa += __shfl_xor(sa, 1); sa += __shfl_xor(sa, 2);
                sa = -sa;
                float y = 0.f;
#pragma unroll
                for (int i = 0; i < 16; ++i) { S[i] = S[i] * d[i >> 2][i & 3] + sa * ka[i >> 2][i & 3] + vv * km[i >> 2][i & 3]; y += S[i] * r[i >> 2][i & 3]; }
                y += __shfl_xor(y, 1); y += __shfl_xor(y, 2);
                if (kq == 0) p.ybuf[(size_t)(row0 + t0 + s) * 512 + h * 64 + vrow] = y;
            }
        }
#pragma unroll
        for (int i = 0; i < 16; ++i) sout[vrow * 64 + kq * 16 + i] = S[i];
    }
}

__device__ __forceinline__ void ph_rwkv_post(const P& p) {
    const int tid = threadIdx.x, lane = tid & 63, wid = tid >> 6;
    for (int it = blockIdx.x * 8 + wid; it < MR * 8; it += gridDim.x * 8) {
        const int row = it >> 3, h = it & 7, c = h * 64 + lane;
        const float y = p.ybuf[(size_t)row * 512 + c];
        const float mean = wave_sum(y) * (1.0f / 64.0f);
        const float dv = y - mean;
        const float var = wave_sum(dv * dv) * (1.0f / 64.0f);
        float yn = dv * rsqrtf(var + 64e-5f) * p.gn_g[c] + p.gn_b[c];
        yn += p.bonus[it] * p.rw6[(size_t)it * 384 + 192 + lane];
        p.ob[(size_t)row * 512 + c] = f2bf(yn * bf2f(p.rg[(size_t)row * 512 + c]));
    }
}
#ifndef SMODE
#define SMODE 3
#endif
#ifndef ATTN_MODE
#define ATTN_MODE 3
#endif

typedef unsigned u32x2 __attribute__((ext_vector_type(2)));
__device__ __forceinline__ f32x16 mfma32(bf16x8 a, bf16x8 b, f32x16 c) { return __builtin_amdgcn_mfma_f32_32x32x16_bf16(a, b, c, 0, 0, 0); }
__device__ __forceinline__ bf16x8 pack8(float a0, float a1, float a2, float a3, float a4, float a5, float a6, float a7) {
    union { uint4 u; bf16x8 v; } x; x.u.x = pk2(a0, a1); x.u.y = pk2(a2, a3); x.u.z = pk2(a4, a5); x.u.w = pk2(a6, a7); return x.v;
}
__device__ __forceinline__ f32x16 zero16() { f32x16 z; for (int i = 0; i < 16; ++i) z[i] = 0.f; return z; }

struct KSrcBf { const bf16_t* base; __device__ __forceinline__ bf16x8 operator()(int tok0, int ks, int lane) const { return *(const bf16x8*)(base + (size_t)(tok0 + (lane & 31)) * 64 + 16 * ks + 8 * (lane >> 5)); } };
struct VSrcBfT { const bf16_t* base; int ld; __device__ __forceinline__ bf16x8 operator()(int tok0, int dt, int s2, int lane) const {
        const bf16_t* ptr = base + (size_t)(32 * dt + (lane & 31)) * ld + tok0 + 16 * s2 + 4 * (lane >> 5);
        union { uint4 u; bf16x8 v; } x; const uint2 a = *(const uint2*)ptr, b = *(const uint2*)(ptr + 8); x.u.x = a.x; x.u.y = a.y; x.u.z = b.x; x.u.w = b.y; return x.v; } };

template <class KS>
__device__ __forceinline__ f32x16 qk_tile(const bf16x8 (&qf)[4], const KS& ks, int tok0, int lane) {
    f32x16 s = zero16();
#pragma unroll
    for (int k = 0; k < 4; ++k) s = mfma32(ks(tok0, k, lane), qf[k], s);
    return s;
}
template <class OKF>
__device__ __forceinline__ void sm_stats(const f32x16& s, int hb, OKF ok, float& m, float& l) {
    float sv[16]; float tmax = -1e30f; unsigned okm = 0;
#pragma unroll
    for (int i = 0; i < 16; ++i) { const int kl = (i & 3) + 8 * (i >> 2) + 4 * hb; const bool k = ok(kl); okm |= (k ? 1u : 0u) << i; sv[i] = k ? s[i] : -1e30f; tmax = fmaxf(tmax, sv[i]); }
    tmax = fmaxf(tmax, __shfl_xor(tmax, 32));
    const float mn = fmaxf(m, tmax), alpha = __expf(m - mn); m = mn;
    float ps = 0.f;
#pragma unroll
    for (int i = 0; i < 16; ++i) ps += ((okm >> i) & 1u) ? __expf(sv[i] - mn) : 0.f;
    l = l * alpha + ps;
}
template <class OKF, class VF>
__device__ __forceinline__ void sm_pv(const f32x16& s, int hb, OKF ok, VF vf, float& m, float& l, f32x16 (&o)[2]) {
    float sv[16]; float tmax = -1e30f; unsigned okm = 0;
#pragma unroll
    for (int i = 0; i < 16; ++i) { const int kl = (i & 3) + 8 * (i >> 2) + 4 * hb; const bool k = ok(kl); okm |= (k ? 1u : 0u) << i; sv[i] = k ? s[i] : -1e30f; tmax = fmaxf(tmax, sv[i]); }
    tmax = fmaxf(tmax, __shfl_xor(tmax, 32));
    const float mn = fmaxf(m, tmax), alpha = __expf(m - mn); m = mn;
    float pr[16]; float ps = 0.f;
#pragma unroll
    for (int i = 0; i < 16; ++i) { pr[i] = ((okm >> i) & 1u) ? __expf(sv[i] - mn) : 0.f; ps += pr[i]; }
    l = l * alpha + ps;
    o[0] *= alpha; o[1] *= alpha;
#pragma unroll
    for (int s2 = 0; s2 < 2; ++s2) {
        const bf16x8 pb = pack8(pr[8 * s2 + 0], pr[8 * s2 + 1], pr[8 * s2 + 2], pr[8 * s2 + 3], pr[8 * s2 + 4], pr[8 * s2 + 5], pr[8 * s2 + 6], pr[8 * s2 + 7]);
#pragma unroll
        for (int dt = 0; dt < 2; ++dt) o[dt] = mfma32(vf(dt, s2), pb, o[dt]);
    }
}
template <class OKF, class VF>
__device__ __forceinline__ void cmp_pass2(const f32x16& s, int hb, OKF ok, VF vf, float m, float inv, f32x16 (&o)[2], LAS float* prow, bool writer) {
    float pr[16];
#pragma unroll
    for (int i = 0; i < 16; ++i) {
        const int kl = (i & 3) + 8 * (i >> 2) + 4 * hb;
        pr[i] = ok(kl) ? __expf(s[i] - m) * inv : 0.f;
        float q = pr[i] + __shfl_xor(pr[i], 1); q += __shfl_xor(q, 2);
        if (writer) prow[kl] = q;
    }
#pragma unroll
    for (int s2 = 0; s2 < 2; ++s2) {
        const bf16x8 pb = pack8(pr[8 * s2 + 0], pr[8 * s2 + 1], pr[8 * s2 + 2], pr[8 * s2 + 3], pr[8 * s2 + 4], pr[8 * s2 + 5], pr[8 * s2 + 6], pr[8 * s2 + 7]);
#pragma unroll
        for (int dt = 0; dt < 2; ++dt) o[dt] = mfma32(vf(dt, s2), pb, o[dt]);
    }
}

__device__ __forceinline__ void attn_store(const P& p, const f32x16 (&of)[2], int qrow, int head, int hb, bool doit) {
    if (!doit) return;
#pragma unroll
    for (int dt = 0; dt < 2; ++dt)
#pragma unroll
        for (int i4 = 0; i4 < 4; ++i4) {
            const int d = 32 * dt + 8 * i4 + 4 * hb;
            const size_t off = (size_t)qrow * 512 + head * 64 + d;
            const uint2 gw = *(const uint2*)(p.ag + off);
            f32x4 v;
            v[0] = of[dt][4 * i4 + 0] * __uint_as_float(gw.x << 16); v[1] = of[dt][4 * i4 + 1] * __uint_as_float(gw.x & 0xffff0000u);
            v[2] = of[dt][4 * i4 + 2] * __uint_as_float(gw.y << 16); v[3] = of[dt][4 * i4 + 3] * __uint_as_float(gw.y & 0xffff0000u);
            st_bf4(p.oa + off, v);
        }
}

__device__ __forceinline__ void attn_prompt_item(const P& p, int item, LAS unsigned char* wl, int lane) {
    const int bg = item & 7, tg = item >> 3, b = bg >> 1, g = bg & 1;
    const int col = lane & 31, hb = lane >> 5, tl = col >> 2, hh = col & 3;
    const int t0 = tg * 8, qpos = t0 + tl, qrow = b * SEQ + qpos, head = g * 4 + hh;
    bf16x8 qf[4];
#pragma unroll
    for (int ks = 0; ks < 4; ++ks) qf[ks] = *(const bf16x8*)(p.qb + (size_t)qrow * 512 + head * 64 + 16 * ks + 8 * hb);
    LAS float* psum = (LAS float*)wl;
    LAS unsigned long long* msk = (LAS unsigned long long*)(wl + 8192);
    const float g0 = p.gates[(size_t)qrow * 32 + head * 3 + 0], g1 = p.gates[(size_t)qrow * 32 + head * 3 + 1], g2 = p.gates[(size_t)qrow * 32 + head * 3 + 2];
    f32x16 of[2]; of[0] = zero16(); of[1] = zero16();
    {
        const int cm = t0 + 7 - 31;
        const int ntile = cm >= 0 ? ((cm >> 4) >> 5) + 1 : 0;
        const KSrcBf ksrc{p.kc_p + (size_t)bg * 256 * 64};
        const VSrcBfT vsrc{p.vcT_p + (size_t)bg * 64 * 256, 256};
        float m = -1e30f, l = 0.f;
#pragma unroll 1
        for (int kt = 0; kt < ntile; ++kt) {
            const f32x16 s = qk_tile(qf, ksrc, 32 * kt, lane);
            sm_stats(s, hb, [&](int kl) { return 16 * (32 * kt + kl) + 31 <= qpos; }, m, l);
        }
        l += __shfl_xor(l, 32);
        const float inv = l > 0.f ? 1.0f / l : 0.f;
#pragma unroll
        for (int i = 0; i < 32; ++i) psum[i * 64 + lane] = 0.f;
        WAVE_SYNC();
        f32x16 oc[2]; oc[0] = zero16(); oc[1] = zero16();
#pragma unroll 1
        for (int kt = 0; kt < ntile; ++kt) {
            const f32x16 s = qk_tile(qf, ksrc, 32 * kt, lane);
            cmp_pass2(s, hb, [&](int kl) { return 16 * (32 * kt + kl) + 31 <= qpos; }, [&](int dt, int s2) { return vsrc(32 * kt, dt, s2, lane); }, m, inv, oc,
                      psum + tl * 256 + 32 * kt, hh == 0);
        }
        of[0] = oc[0] * g0; of[1] = oc[1] * g0;
    }
    WAVE_SYNC();
    for (int t2 = 0; t2 < 8; ++t2) {
        const int t = t0 + t2, cur = t >> 6, n = lane;
        float imp = 0.f;
#pragma unroll
        for (int c = -1; c < 4; ++c) { const int cc = 4 * n + c; if (cc >= 0) imp += psum[t2 * 256 + cc]; }
        if (n == 0 || n == cur || n == cur - 1) imp = 1e4f;
        if (n * 64 > t) imp = -1.0f;
        int rank = 0;
#pragma unroll
        for (int j = 0; j < 64; ++j) {
            const float vj = __uint_as_float(__builtin_amdgcn_readlane(__float_as_uint(imp), j));
            rank += (vj > imp || (vj == imp && j < n)) ? 1 : 0;
        }
        const unsigned long long mk = __ballot(rank < 16);
        if (lane == 0) msk[t2] = mk;
    }
    WAVE_SYNC();
    const unsigned long long mymask = msk[tl];
    unsigned long long um = 0;
#pragma unroll
    for (int i = 0; i < 8; ++i) um |= msk[i];
    const int cur0 = t0 >> 6;
    {
        const KSrcBf ksrc{p.kb + (size_t)((1 * NB + b) * 2 + g) * SEQ * 64};
        const VSrcBfT vsrc{p.vT + (size_t)((0 * NB + b) * 2 + g) * 64 * SEQ, SEQ};
        float m = -1e30f, l = 0.f; f32x16 o[2]; o[0] = zero16(); o[1] = zero16();
#pragma unroll 1
        for (int tt = 0; tt <= 2 * cur0 + 1; ++tt) {
            const int n = tt >> 1;
            if (!((um >> n) & 1ull)) continue;
            const bool bsel = (mymask >> n) & 1ull;
            const int tok0 = 32 * tt;
            const f32x16 s = qk_tile(qf, ksrc, tok0, lane);
            sm_pv(s, hb, [&](int kl) { return bsel && (tok0 + kl <= qpos); }, [&](int dt, int s2) { return vsrc(tok0, dt, s2, lane); }, m, l, o);
        }
        l += __shfl_xor(l, 32);
        const float sc = l > 0.f ? g1 / l : 0.f;
        of[0] += o[0] * sc; of[1] += o[1] * sc;
    }
    {
        const KSrcBf ksrc{p.kb + (size_t)((2 * NB + b) * 2 + g) * SEQ * 64};
        const VSrcBfT vsrc{p.vT + (size_t)((1 * NB + b) * 2 + g) * 64 * SEQ, SEQ};
        float m = -1e30f, l = 0.f; f32x16 o[2]; o[0] = zero16(); o[1] = zero16();
        const int lo = t0 - 511;
        const int nlo = lo > 0 ? (lo >> 6) : 0;
#pragma unroll 1
        for (int tt = 2 * nlo; tt <= 2 * cur0 + 1; ++tt) {
            const int tok0 = 32 * tt;
            const f32x16 s = qk_tile(qf, ksrc, tok0, lane);
            sm_pv(s, hb, [&](int kl) { const int key = tok0 + kl; return key <= qpos && key + 511 >= qpos; }, [&](int dt, int s2) { return vsrc(tok0, dt, s2, lane); }, m, l, o);
        }
        l += __shfl_xor(l, 32);
        const float sc = l > 0.f ? g2 / l : 0.f;
        of[0] += o[0] * sc; of[1] += o[1] * sc;
    }
    attn_store(p, of, qrow, head, hb, true);
}

template <class RP, class OKF>
__device__ __forceinline__ void f32_tile(const bf16x8 (&qf)[4], RP rp, OKF ok, LAS bf16_t* vt, int lane, float& m, float& l, f32x16 (&o)[2]) {
    const int col = lane & 31, hb = lane >> 5;
    const float* kr = rp(col);
    f32x16 s = zero16();
#pragma unroll
    for (int ks = 0; ks < 4; ++ks) {
        const float4 a = *(const float4*)(kr + 16 * ks + 8 * hb), c = *(const float4*)(kr + 16 * ks + 8 * hb + 4);
        s = mfma32(pack8(a.x, a.y, a.z, a.w, c.x, c.y, c.z, c.w), qf[ks], s);
    }
    const float* vr = kr + 128 + 32 * hb;
#pragma unroll
    for (int j4 = 0; j4 < 8; ++j4) {
        const float4 a = *(const float4*)(vr + 4 * j4);
        vt[(32 * hb + 4 * j4 + 0) * 40 + col] = f2bf(a.x); vt[(32 * hb + 4 * j4 + 1) * 40 + col] = f2bf(a.y);
        vt[(32 * hb + 4 * j4 + 2) * 40 + col] = f2bf(a.z); vt[(32 * hb + 4 * j4 + 3) * 40 + col] = f2bf(a.w);
    }
    WAVE_SYNC();
    sm_pv(s, hb, ok, [&](int dt, int s2) {
        LAS const bf16_t* ptr = vt + (32 * dt + col) * 40 + 16 * s2 + 4 * hb;
        union { uint4 u; bf16x8 v; } x; const u32x2 a = *(LAS const u32x2*)ptr, c = *(LAS const u32x2*)(ptr + 8); x.u.x = a[0]; x.u.y = a[1]; x.u.z = c[0]; x.u.w = c[1]; return x.v; }, m, l, o);
    WAVE_SYNC();
}

__device__ __forceinline__ void attn_sample_item(const P& p, int item, LAS unsigned char* wl, int lane) {
    const int t = item & 7, g = (item >> 3) & 1, b = item >> 4, bg = b * 2 + g;
    const int col = lane & 31, hb = lane >> 5, hh = col & 3;
    const int qpos = PAST + t, qrow = NP + b * 8 + t, head = g * 4 + hh;
    bf16x8 qf[4];
#pragma unroll
    for (int ks = 0; ks < 4; ++ks) qf[ks] = *(const bf16x8*)(p.qb + (size_t)qrow * 512 + head * 64 + 16 * ks + 8 * hb);
    LAS float* psum = (LAS float*)wl;
    LAS int* list = (LAS int*)(wl + 8256);
    LAS float* impl = (LAS float*)(wl + 8448);
    LAS bf16_t* vt = (LAS bf16_t*)(wl + 9728);
    const float g0 = p.gates[(size_t)qrow * 32 + head * 3 + 0], g1 = p.gates[(size_t)qrow * 32 + head * 3 + 1], g2 = p.gates[(size_t)qrow * 32 + head * 3 + 2];
    f32x16 of[2];
    {
        const KSrcBf ksrc{p.kc_s + (size_t)bg * 1024 * 64};
        const VSrcBfT vsrc{p.vcT_s + (size_t)bg * 64 * 1024, 1024};
        float m = -1e30f, l = 0.f;
#pragma unroll 1
        for (int kt = 0; kt < 32; ++kt) {
            const f32x16 s = qk_tile(qf, ksrc, 32 * kt, lane);
            sm_stats(s, hb, [&](int kl) { return 32 * kt + kl <= 1022; }, m, l);
        }
        l += __shfl_xor(l, 32);
        const float inv = l > 0.f ? 1.0f / l : 0.f;
        f32x16 oc[2]; oc[0] = zero16(); oc[1] = zero16();
#pragma unroll 1
        for (int kt = 0; kt < 32; ++kt) {
            const f32x16 s = qk_tile(qf, ksrc, 32 * kt, lane);
            cmp_pass2(s, hb, [&](int kl) { return 32 * kt + kl <= 1022; }, [&](int dt, int s2) { return vsrc(32 * kt, dt, s2, lane); }, m, inv, oc, psum + 32 * kt, col == 0);
        }
        of[0] = oc[0] * g0; of[1] = oc[1] * g0;
    }
    WAVE_SYNC();
#pragma unroll
    for (int j = 0; j < 5; ++j) {
        const int n = lane + 64 * j;
        if (n <= 256) {
            float imp = 0.f;
            for (int c = -1; c < 4; ++c) { const int cc = 4 * n + c; if (cc >= 0 && cc <= 1022) imp += psum[cc]; }
            impl[n] = imp;
        }
    }
    WAVE_SYNC();
    {
        int base = 0;
#pragma unroll
        for (int j = 0; j < 4; ++j) {
            const int n = lane + 64 * j;
            const bool cand = n >= 1 && n <= 254;
            const float v = impl[n];
            int rank = 0;
            for (int q = 1; q <= 254; ++q) { const float vq = impl[q]; rank += (vq > v || (vq == v && q < n)) ? 1 : 0; }
            const bool sel = cand && rank < 13;
            const unsigned long long mk = __ballot(sel);
            if (sel) list[base + __popcll(mk & ((1ull << lane) - 1ull))] = n;
            base += __popcll(mk);
        }
        if (lane == 0) { list[13] = 0; list[14] = 255; list[15] = 256; }
    }
    WAVE_SYNC();
#if SMODE & 1
    {
        float m = -1e30f, l = 0.f; f32x16 o[2]; o[0] = zero16(); o[1] = zero16();
#pragma unroll 1
        for (int li = 0; li < 16; ++li) {
#if SMODE & 4
            const int n = li < 13 ? 17 * li + 5 : (li == 13 ? 0 : 242 + li);
#else
            const int n = __builtin_amdgcn_readfirstlane(list[li]);
#endif
            if (n < 256) {
                const int page = p.page_table[b * 128 + (n >> 1)];
                const float* base = p.cache_sel + ((size_t)page * 128 + (n & 1) * 64) * 256 + g * 64;
#pragma unroll 1
                for (int k2 = 0; k2 < 2; ++k2)
                    f32_tile(qf, [&](int kl) { return base + (size_t)(32 * k2 + kl) * 256; }, [&](int kl) { return true; }, vt, lane, m, l, o);
            } else {
                const float* base = p.out + O_SEL_S + (size_t)(b * 8) * 256 + g * 64;
                f32_tile(qf, [&](int kl) { return base + (size_t)(kl < 8 ? kl : 7) * 256; }, [&](int kl) { return kl <= t; }, vt, lane, m, l, o);
            }
        }
        l += __shfl_xor(l, 32);
        const float sc = l > 0.f ? g1 / l : 0.f;
        of[0] += o[0] * sc; of[1] += o[1] * sc;
    }
#endif
#if SMODE & 2
    {
        float m = -1e30f, l = 0.f; f32x16 o[2]; o[0] = zero16(); o[1] = zero16();
        const float* cw = p.cache_win + (size_t)b * 512 * 256 + g * 64;
        const float* nw = p.out + O_WIN_S + ((size_t)b * 512 + 504) * 256 + g * 64;
#pragma unroll 1
        for (int kt = 0; kt < 17; ++kt) {
            f32_tile(qf, [&](int kl) { const int j = 32 * kt + kl; return j < 512 ? cw + (size_t)j * 256 : nw + (size_t)(j - 512 < 8 ? j - 512 : 7) * 256; },
                     [&](int kl) { const int j = 32 * kt + kl; return j >= t + 1 && j <= 512 + t; }, vt, lane, m, l, o);
        }
        l += __shfl_xor(l, 32);
        const float sc = l > 0.f ? g2 / l : 0.f;
        of[0] += o[0] * sc; of[1] += o[1] * sc;
    }
#endif
    attn_store(p, of, qrow, head, hb, col < 4);
}

__device__ __forceinline__ void ph_attn(const P& p, LAS unsigned char* lds) {
    const int tid = threadIdx.x, lane = tid & 63, wid = tid >> 6;
    LAS unsigned char* wl = lds + wid * 16384;
    const int gw = blockIdx.x * 8 + wid, nw = gridDim.x * 8;
#if ATTN_MODE & 2
    for (int it = gw; it < 512; it += nw) attn_sample_item(p, it, wl, lane);
#endif
#if ATTN_MODE & 1
    for (int it = gw; it < 2048; it += nw) { attn_prompt_item(p, it, wl, lane); attn_prompt_item(p, 4095 - it, wl, lane); }
#endif
}
#ifndef STOP_AFTER
#define STOP_AFTER 3
#endif

constexpr int LDS_BYTES = pg8::STAGE_BYTES;

template <class Epi> __global__ __launch_bounds__(512, 2) void k_gemm(pg8::Gemm g, Epi E) {
    extern __shared__ __attribute__((aligned(16))) unsigned char shm[];
    pg8::StaticOrder S; S.init(g.M, g.N, (int)gridDim.x, (int)blockIdx.x);
    pg8::gemm_phase<Epi, pg8::StaticOrder, false>((PG8_LAS unsigned char*)shm, g, S, E, nullptr);
}
template <int PH> __global__ __launch_bounds__(512, 2) void k_phase(P p) {
    extern __shared__ __attribute__((aligned(16))) unsigned char shm[];
    LAS unsigned char* lds = (LAS unsigned char*)shm;
    if constexpr (PH == 0) ph_prep(p);
    if constexpr (PH == 1) ph_compress2(p, p.LHp, 8, 256, 255, p.kc_p, p.vcT_p, (LAS float*)lds);
    if constexpr (PH == 2) ph_cvt_cache(p);
    if constexpr (PH == 3) ph_compress2(p, p.LHs, 64, 1024, 1023, p.kc_s, p.vcT_s, (LAS float*)lds);
    if constexpr (PH == 4) ph_rwkv_prep(p);
    if constexpr (PH == 5) ph_rwkv_scan(p, (LAS float*)lds);
    if constexpr (PH == 6) ph_rwkv_post(p);
    if constexpr (PH == 7) ph_attn(p, lds);
    if constexpr (PH == 8) ph_final(p);
}

template <class Epi> static void launch_gemm(hipStream_t st, const bf16_t* A, const bf16_t* Bt, int M, int N, int K, const Epi& E) {
    static bool attr = false;
    if (!attr) { (void)hipFuncSetAttribute((const void*)k_gemm<Epi>, hipFuncAttributeMaxDynamicSharedMemorySize, LDS_BYTES); attr = true; }
    pg8::Gemm g{}; g.A = A; g.Bt = Bt; g.M = M; g.N = N; g.K = K;
    hipLaunchKernelGGL((k_gemm<Epi>), dim3(256), dim3(512), LDS_BYTES, st, g, E);
}
template <int PH> static void launch_phase(hipStream_t st, const P& p) {
    static bool attr = false;
    if (!attr) { (void)hipFuncSetAttribute((const void*)k_phase<PH>, hipFuncAttributeMaxDynamicSharedMemorySize, LDS_BYTES); attr = true; }
    hipLaunchKernelGGL((k_phase<PH>), dim3(256), dim3(512), LDS_BYTES, st, p);
}

extern "C" void kernel_launch(void* const* d_in, const int* in_sizes, int n_in, void* d_out, int out_size, void* d_ws, size_t ws_size, hipStream_t stream) {
    (void)in_sizes; (void)n_in; (void)out_size; (void)ws_size;
    P p{};
    p.x_prompt = (const float*)d_in[0]; p.x_sample = (const float*)d_in[1]; p.p_prompt = (const float*)d_in[2]; p.p_sample = (const float*)d_in[3];
    p.cache_cmp = (const float*)d_in[4]; p.cache_sel = (const float*)d_in[5]; p.cache_win = (const float*)d_in[6]; p.state_wkv = (const float*)d_in[7];
    p.state_shift = (const float*)d_in[8]; p.page_table = (const int*)d_in[9]; p.norm_g = (const float*)d_in[10]; p.w_in = (const float*)d_in[11];
    p.cmp_pe = (const float*)d_in[12]; p.cmp_w1 = (const float*)d_in[13]; p.cmp_b1 = (const float*)d_in[14]; p.cmp_w2 = (const float*)d_in[15]; p.cmp_b2 = (const float*)d_in[16];
    p.w_pa = (const float*)d_in[17]; p.mu = (const float*)d_in[18]; p.w0 = (const float*)d_in[19]; p.w_up = (const float*)d_in[20]; p.a0 = (const float*)d_in[21];
    p.a_up = (const float*)d_in[22]; p.k_k = (const float*)d_in[23]; p.k_a = (const float*)d_in[24]; p.r_k = (const float*)d_in[25]; p.gn_g = (const float*)d_in[26];
    p.gn_b = (const float*)d_in[27]; p.w_pb = (const float*)d_in[28]; p.w_out = (const float*)d_in[29]; p.ple_g = (const float*)d_in[30]; p.w_gate = (const float*)d_in[31];
    p.w_proj = (const float*)d_in[32]; p.final_g = (const float*)d_in[33];
    p.out = (float*)d_out;
    size_t off = 0;
    auto take = [&](size_t bytes) { void* r = (char*)d_ws + off; off += (bytes + 255) & ~(size_t)255; return r; };
    p.bar = (unsigned*)take(16384);
    p.hb = (bf16_t*)take((size_t)MR * DM * 2);
    p.WinT = (bf16_t*)take((size_t)NPAD * DM * 2);
    p.WpaT = (bf16_t*)take((size_t)DM * 512 * 2); p.WpbT = (bf16_t*)take((size_t)DM * 512 * 2);
    p.WoutT = (bf16_t*)take((size_t)DM * DM * 2); p.WgateT = (bf16_t*)take((size_t)DM * DM * 2); p.WprojT = (bf16_t*)take((size_t)DM * 256 * 2);
    p.W1T = (bf16_t*)take((size_t)512 * 1024 * 2);
    p.pb = (bf16_t*)take((size_t)MR * 256 * 2);
    p.tabc = (float*)take((size_t)4104 * 32 * 4); p.tabs = (float*)take((size_t)4104 * 32 * 4); p.pt = (float*)take(256 * 4);
    p.qb = (bf16_t*)take((size_t)MR * 512 * 2);
    p.kb = (bf16_t*)take((size_t)3 * NB * 2 * SEQ * 64 * 2);
    p.vcr = (bf16_t*)take((size_t)NB * 2 * SEQ * 64 * 2);
    p.vT = (bf16_t*)take((size_t)2 * NB * 2 * 64 * SEQ * 2);
    p.ag = (bf16_t*)take((size_t)MR * 512 * 2); p.rg = (bf16_t*)take((size_t)MR * 512 * 2); p.mg = (bf16_t*)take((size_t)MR * 2048 * 2);
    p.gates = (float*)take((size_t)MR * 32 * 4);
    p.rz = (float*)take((size_t)MR * CR * 4);
    p.LHp = (float*)take((size_t)2 * 2048 * 256 * 4);
    p.LHs = (float*)take((size_t)2 * 65536 * 256 * 4);
    p.cs = (bf16_t*)take((size_t)2 * 65536 * 1024 * 2);
    p.kc_p = (bf16_t*)take((size_t)8 * 256 * 64 * 2); p.vcT_p = (bf16_t*)take((size_t)8 * 64 * 256 * 2);
    p.kc_s = (bf16_t*)take((size_t)64 * 1024 * 64 * 2); p.vcT_s = (bf16_t*)take((size_t)64 * 64 * 1024 * 2);
    p.rw6 = (float*)take((size_t)MR * 8 * 384 * 4);
    p.bonus = (float*)take((size_t)MR * 8 * 4);
    p.ybuf = (float*)take((size_t)MR * 512 * 4);
    p.oa = (bf16_t*)take((size_t)MR * 512 * 2); p.ob = (bf16_t*)take((size_t)MR * 512 * 2);
    p.mb = (bf16_t*)take((size_t)MR * DM * 2); p.xg = (bf16_t*)take((size_t)MR * DM * 2);
    p.tmp = (float*)take((size_t)MR * DM * 4); p.x1 = (float*)take((size_t)MR * DM * 4);
    p.ss1 = (float*)take((size_t)MR * 16 * 4);
    p.pp = (float*)take((size_t)MR * DM * 4);

    launch_phase<0>(stream, p);
    { EpiIn e{}; e.p = p; launch_gemm(stream, p.hb, p.WinT, MR, NPAD, DM, e); }
#if STOP_AFTER >= 3
    { EpiPlain e{}; e.C = p.LHp; e.ldc = 256; launch_gemm(stream, p.kb, p.W1T, 2048, 256, 1024, e); }
    { EpiPlain e{}; e.C = p.LHp + (size_t)2048 * 256; e.ldc = 256; launch_gemm(stream, p.vcr, p.W1T + (size_t)256 * 1024, 2048, 256, 1024, e); }
    launch_phase<1>(stream, p);
    launch_phase<2>(stream, p);
    { EpiPlain e{}; e.C = p.LHs; e.ldc = 256; launch_gemm(stream, p.cs, p.W1T, 65536, 256, 1024, e); }
    { EpiPlain e{}; e.C = p.LHs + (size_t)65536 * 256; e.ldc = 256; launch_gemm(stream, p.cs + (size_t)65536 * 1024, p.W1T + (size_t)256 * 1024, 65536, 256, 1024, e); }
    launch_phase<3>(stream, p);
#endif
#if STOP_AFTER >= 2
    launch_phase<4>(stream, p);
    launch_phase<5>(stream, p);
    launch_phase<6>(stream, p);
#endif
    hipMemsetAsync(p.oa, 0, (size_t)MR * 512 * 2, stream);
#if STOP_AFTER >= 3
    launch_phase<7>(stream, p);
#endif
    { EpiYa e{}; e.p = p; launch_gemm(stream, p.oa, p.WpaT, MR, DM, 512, e); }
    { EpiYb e{}; e.p = p; launch_gemm(stream, p.ob, p.WpbT, MR, DM, 512, e); }
    { EpiOut e{}; e.p = p; launch_gemm(stream, p.mb, p.WoutT, MR, DM, DM, e); }
    { EpiPlain e{}; e.C = p.pp; e.ldc = DM; launch_gemm(stream, p.pb, p.WprojT, MR, DM, 256, e); }
    { EpiGate e{}; e.p = p; launch_gemm(stream, p.xg, p.WgateT, MR, DM, DM, e); }
    launch_phase<8>(stream, p);
}
```

```cpp
#include <hip/hip_runtime.h>
#include <stdint.h>
#include <stdio.h>
namespace pg8 {
#define PG8_LAS __attribute__((address_space(3)))
typedef unsigned short bf16_t;
typedef short bf16x8 __attribute__((ext_vector_type(8)));
typedef float f32x4 __attribute__((ext_vector_type(4)));
typedef unsigned u32x4 __attribute__((ext_vector_type(4)));
constexpr int BM = 256, BK = 64, HALF = 128, HTB = HALF * BK * 2  , STAGE_BYTES = 8 * HTB, NXCD = 8, WGM = 8;

__host__ __device__ __forceinline__ int lds_byte(int r, int c) { const int st = (r >> 4) * 2 + (c >> 5), rr = r & 15, cc = c & 31, ob = rr * 64 + cc * 2; return st * 1024 + (ob ^ (((ob >> 9) & 1) << 5)); }
__host__ __device__ __forceinline__ void stage_rc(int b, int& R, int& C) { const int st = b / 1024, sb = b % 1024, swz = sb ^ (((sb >> 9) & 1) << 5); R = (st >> 1) * 16 + swz / 64; C = (st & 1) * 32 + (swz % 64) / 2; }
__host__ __device__ __forceinline__ int perm32(int rho) { const int n = rho >> 4, i = rho & 15; return 8 * (i >> 2) + 4 * n + (i & 3); }

struct Unit { int pm, pn; };
struct Gemm { const bf16_t* A; const bf16_t* Bt; int M, N, K, pad_; };

struct StaticOrder {
    int nM, nN, nwg, G, c;
    __host__ __device__ void init(int M, int N, int G_, int c_) { nM = M / BM; nN = N / BM; nwg = nM * nN; G = G_; c = c_; }
    __host__ __device__ bool next(int i, Unit& u) const {
        const long L = (long)i * G + c; if (L >= nwg) return false;
        int wgid = (int)L; { const int q = nwg / NXCD, r = nwg % NXCD, xcd = wgid % NXCD, off = wgid / NXCD; wgid = (xcd < r ? xcd * (q + 1) : r * (q + 1) + (xcd - r) * q) + off; }
        const int nig = WGM * nN, gid = wgid / nig, fm = gid * WGM, gsz = (nM - fm) < WGM ? (nM - fm) : WGM;
        u.pm = fm + ((wgid % nig) % gsz); u.pn = (wgid % nig) / gsz; return true;
    }
    __device__ __forceinline__ void a_ready(const Unit&) const {}
    __device__ __forceinline__ void done(const Unit&) const {}
};
__device__ __forceinline__ unsigned cvt_pk_bf16(float lo, float hi) { unsigned r; asm volatile("v_cvt_pk_bf16_f32 %0, %1, %2" : "=v"(r) : "v"(lo), "v"(hi)); return r; }
typedef float f32x2 __attribute__((ext_vector_type(2)));
template <class Epi, class Sched, bool STAMP = false>
__device__ __forceinline__ void gemm_phase(PG8_LAS unsigned char* lds, const Gemm g, const Sched& S, const Epi& E, unsigned long long* stamps) {
    int tid_l = threadIdx.x; asm volatile("" : "+v"(tid_l));
    const int tid = tid_l, wid = __builtin_amdgcn_readfirstlane(tid >> 6), lane = tid & 63, wr = wid >> 2, wc = wid & 3, fr = lane & 15, fq = lane >> 4;
    const int K = g.K, nt = K / BK;
    int ts_lo = 0, ts_hi = 0, nts = 0; const unsigned long long rt_entry = STAMP ? (unsigned long long)wall_clock64() : 0ull;
#define PG8_STAMP() do { if (STAMP && wid == 0 && nts < 64) { const unsigned long long _c = (unsigned long long)clock64(); \
        ts_lo = (lane == nts) ? (int)(unsigned)_c : ts_lo; ts_hi = (lane == nts) ? (int)(unsigned)(_c >> 32) : ts_hi; ++nts; } } while (0)
    PG8_STAMP();
    unsigned voffA[2], voffB[2];
#pragma unroll
    for (int i = 0; i < 2; ++i) { int R, C; stage_rc(tid * 16 + i * 8192, R, C); const int Rb = Epi::PERM ? ((R & ~31) + perm32(R & 31)) : R;
        voffA[i] = (unsigned)(R * K + C) * 2u; voffB[i] = (unsigned)(Rb * K + C) * 2u; }
    const size_t kstep = (size_t)(BK * 2);
    const size_t hstep = (size_t)HALF * K * 2;
    const size_t tstep = 2 * hstep;
    const unsigned ldsw = (unsigned)wid * 1024u;
    const int aoff = lds_byte(wr * 64 + fr, fq * 8), boff = lds_byte(wc * 32 + fr, fq * 8);
#define PG8_SA(b, h) (((b) * 2 + (h)) * HTB)
#define PG8_SB(b, h) ((4 + (b) * 2 + (h)) * HTB)
#define PG8_STAGE(bufoff, gbase, voff) do { _Pragma("unroll") for (int _i = 0; _i < 2; ++_i) \
        __builtin_amdgcn_global_load_lds((const unsigned*)((const char*)(gbase) + (voff)[_i]), (PG8_LAS unsigned*)(lds + (bufoff) + ldsw + _i * 8192), 16, 0, 0); } while (0)
#define PG8_LDA(dst, b, h) do { _Pragma("unroll") for (int m = 0; m < 4; ++m) _Pragma("unroll") for (int k = 0; k < 2; ++k) dst[m][k] = *(const PG8_LAS bf16x8*)(lds + PG8_SA(b, h) + aoff + m * 2048 + k * 1024); } while (0)
#define PG8_LDB(dst, b, h) do { _Pragma("unroll") for (int n = 0; n < 2; ++n) _Pragma("unroll") for (int k = 0; k < 2; ++k) dst[n][k] = *(const PG8_LAS bf16x8*)(lds + PG8_SB(b, h) + boff + n * 2048 + k * 1024); } while (0)
#define PG8_MMA(ai, bj, At, Bt) do { __builtin_amdgcn_s_setprio(1); _Pragma("unroll") for (int m = 0; m < 4; ++m) _Pragma("unroll") for (int n = 0; n < 2; ++n) _Pragma("unroll") for (int k = 0; k < 2; ++k) \
        acc[ai][bj][m][n] = __builtin_amdgcn_mfma_f32_16x16x32_bf16(Bt[n][k], At[m][k], acc[ai][bj][m][n], 0, 0, 0); __builtin_amdgcn_s_setprio(0); } while (0)
#define PG8_WAIT_V(n) asm volatile("s_waitcnt vmcnt(" #n ")" ::: "memory")
#define PG8_WAIT_L(n) asm volatile("s_waitcnt lgkmcnt(" #n ")" ::: "memory")
#define PG8_BAR __builtin_amdgcn_s_barrier()
#define PG8_SCHED __builtin_amdgcn_sched_barrier(0)
    Unit cur, nxt; int ui = 0;
    if (!S.next(0, cur)) return;
    f32x4 acc[2][2][4][2];
#pragma unroll
    for (int a = 0; a < 2; ++a)
#pragma unroll
        for (int b = 0; b < 2; ++b)
#pragma unroll
            for (int m = 0; m < 4; ++m)
#pragma unroll
                for (int n = 0; n < 2; ++n) acc[a][b][m][n] = (f32x4){0.f, 0.f, 0.f, 0.f};
    bf16x8 At[4][2], B0[2][2], B1[2][2];
    const char* cA = (const char*)g.A + (size_t)cur.pm * tstep; const char* cB = (const char*)g.Bt + (size_t)cur.pn * tstep;
    S.a_ready(cur);
    PG8_STAGE(PG8_SB(0, 0), cB, voffB); PG8_STAGE(PG8_SA(0, 0), cA, voffA); PG8_STAGE(PG8_SB(0, 1), cB + hstep, voffB); PG8_STAGE(PG8_SA(0, 1), cA + hstep, voffA);
    if (wr == 1) PG8_BAR;
    PG8_WAIT_V(4); PG8_BAR;
    PG8_STAGE(PG8_SB(1, 0), cB + kstep, voffB); PG8_STAGE(PG8_SA(1, 0), cA + kstep, voffA); PG8_STAGE(PG8_SB(1, 1), cB + hstep + kstep, voffB);
    PG8_WAIT_V(6); PG8_BAR;
    PG8_STAMP();
    for (;;) {
        const bool has_next = S.next(ui + 1, nxt);
        const char* nA = has_next ? (const char*)g.A + (size_t)nxt.pm * tstep : cA; const char* nB = has_next ? (const char*)g.Bt + (size_t)nxt.pn * tstep : cB;
        for (int t = 0; t < nt; t += 2) {
            const bool last = (t == nt - 2);
            const char* a1 = cA + (size_t)(t + 1) * kstep;
            const char* a2 = last ? nA : cA + (size_t)(t + 2) * kstep; const char* b2 = last ? nB : cB + (size_t)(t + 2) * kstep;
            const char* a3 = a2 + kstep; const char* b3 = b2 + kstep;
            if (last && has_next) S.a_ready(nxt);
            PG8_LDB(B0, 0, 0); PG8_SCHED; PG8_LDA(At, 0, 0); PG8_STAGE(PG8_SA(1, 1), a1 + hstep, voffA);
            PG8_WAIT_L(8); PG8_BAR; PG8_WAIT_L(0); PG8_MMA(0, 0, At, B0); PG8_BAR; PG8_SCHED;
            PG8_LDB(B1, 0, 1); PG8_STAGE(PG8_SB(0, 0), b2, voffB);
            PG8_BAR; PG8_WAIT_L(0); PG8_MMA(0, 1, At, B1); PG8_BAR;
            PG8_LDA(At, 0, 1); PG8_STAGE(PG8_SA(0, 0), a2, voffA);
            PG8_BAR; PG8_WAIT_L(0); PG8_MMA(1, 0, At, B0); PG8_BAR; PG8_SCHED;
            PG8_STAGE(PG8_SB(0, 1), b2 + hstep, voffB);
            PG8_WAIT_V(6); PG8_BAR; PG8_MMA(1, 1, At, B1); PG8_BAR;
            PG8_LDB(B0, 1, 0); PG8_SCHED; PG8_LDA(At, 1, 0); PG8_STAGE(PG8_SA(0, 1), a2 + hstep, voffA);
            PG8_WAIT_L(8); PG8_BAR; PG8_WAIT_L(0); PG8_MMA(0, 0, At, B0); PG8_BAR; PG8_SCHED;
            PG8_LDB(B1, 1, 1); PG8_STAGE(PG8_SB(1, 0), b3, voffB);
            PG8_BAR; PG8_WAIT_L(0); PG8_MMA(0, 1, At, B1); PG8_BAR;
            PG8_LDA(At, 1, 1); PG8_STAGE(PG8_SA(1, 0), a3, voffA);
            PG8_BAR; PG8_WAIT_L(0); PG8_MMA(1, 0, At, B0); PG8_BAR; PG8_SCHED;
            PG8_STAGE(PG8_SB(1, 1), b3 + hstep, voffB);
            PG8_WAIT_V(6); PG8_BAR; PG8_MMA(1, 1, At, B1); PG8_BAR;
        }
        PG8_STAMP();
        if constexpr (!Epi::AFTER_DRAIN) { E(acc, cur, wr, wc, fr, fq); S.done(cur); }
        PG8_STAMP();
        if (!has_next) break;
#pragma unroll
        for (int a = 0; a < 2; ++a)
#pragma unroll
            for (int b = 0; b < 2; ++b)
#pragma unroll
                for (int m = 0; m < 4; ++m)
#pragma unroll
                    for (int n = 0; n < 2; ++n) acc[a][b][m][n] = (f32x4){0.f, 0.f, 0.f, 0.f};
        cur = nxt; cA = nA; cB = nB; ++ui;
    }
    PG8_WAIT_V(0);
    if (wr == 0) PG8_BAR;
    PG8_BAR;
    if constexpr (Epi::AFTER_DRAIN) { E.fused(acc, cur, wr, wc, fr, fq, lds, wid, lane); S.done(cur); }
    PG8_STAMP();
    if (STAMP && wid == 0) { stamps[lane] = lane < nts ? (((unsigned long long)(unsigned)ts_hi << 32) | (unsigned)ts_lo) : 0ull;
        if (lane == 62) stamps[62] = rt_entry; if (lane == 63) stamps[63] = (unsigned long long)wall_clock64(); }
#undef PG8_STAMP
#undef PG8_SA
#undef PG8_SB
#undef PG8_STAGE
#undef PG8_LDA
#undef PG8_LDB
#undef PG8_MMA
#undef PG8_WAIT_V
#undef PG8_WAIT_L
#undef PG8_BAR
#undef PG8_SCHED
}
}

typedef unsigned short bf16_t;
typedef short bf16x8 __attribute__((ext_vector_type(8)));
typedef float f32x4 __attribute__((ext_vector_type(4)));
typedef float f32x16 __attribute__((ext_vector_type(16)));
#define LAS __attribute__((address_space(3)))
#define WAVE_SYNC() do { asm volatile("s_waitcnt lgkmcnt(0)" ::: "memory"); __builtin_amdgcn_wave_barrier(); } while (0)

constexpr int DM = 1024, NP = 16384, NSMP = 256, MR = 16640, SEQ = 4096, NB = 4, DB = 32, DS = 8, PAST = 16384;
constexpr int CIN = 6040, NPAD = 6144, CR = 1664;
constexpr int NTHR = 512;
constexpr size_t O_Y_P = 0, O_Y_S = 16777216, O_CMP_P = 17039360, O_CMP_S = 21233664, O_SEL_P = 21299200, O_SEL_S = 25493504,
                 O_WIN_P = 25559040, O_WIN_S = 26083328, O_WKV_P = 30277632, O_WKV_S = 30408704, O_SH_P = 31457280, O_SH_S = 31463936;

constexpr size_t ws_al(size_t x) { return (x + 255) & ~(size_t)255; }
constexpr size_t WS_bar = 0;
constexpr size_t WS_hb = WS_bar + ws_al(16384);
constexpr size_t WS_WinT = WS_hb + ws_al((size_t)MR * DM * 2);
constexpr size_t WS_WpaT = WS_WinT + ws_al((size_t)NPAD * DM * 2);
constexpr size_t WS_WpbT = WS_WpaT + ws_al((size_t)DM * 512 * 2);
constexpr size_t WS_WoutT = WS_WpbT + ws_al((size_t)DM * 512 * 2);
constexpr size_t WS_WgateT = WS_WoutT + ws_al((size_t)DM * DM * 2);
constexpr size_t WS_WprojT = WS_WgateT + ws_al((size_t)DM * DM * 2);
constexpr size_t WS_W1T = WS_WprojT + ws_al((size_t)DM * 256 * 2);
constexpr size_t WS_pb = WS_W1T + ws_al((size_t)512 * 1024 * 2);
constexpr size_t WS_tabc = WS_pb + ws_al((size_t)MR * 256 * 2);
constexpr size_t WS_tabs = WS_tabc + ws_al((size_t)4104 * 32 * 4);
constexpr size_t WS_pt = WS_tabs + ws_al((size_t)4104 * 32 * 4);
constexpr size_t WS_qb = WS_pt + ws_al(256 * 4);
constexpr size_t WS_kb = WS_qb + ws_al((size_t)MR * 512 * 2);
constexpr size_t WS_vcr = WS_kb + ws_al((size_t)3 * NB * 2 * SEQ * 64 * 2);
constexpr size_t WS_vT = WS_vcr + ws_al((size_t)NB * 2 * SEQ * 64 * 2);
constexpr size_t WS_ag = WS_vT + ws_al((size_t)2 * NB * 2 * 64 * SEQ * 2);
constexpr size_t WS_rg = WS_ag + ws_al((size_t)MR * 512 * 2);
constexpr size_t WS_mg = WS_rg + ws_al((size_t)MR * 512 * 2);
constexpr size_t WS_gates = WS_mg + ws_al((size_t)MR * 2048 * 2);
constexpr size_t WS_rz = WS_gates + ws_al((size_t)MR * 32 * 4);
constexpr size_t WS_LHp = WS_rz + ws_al((size_t)MR * CR * 4);
constexpr size_t WS_LHs = WS_LHp + ws_al((size_t)2 * 2048 * 256 * 4);
constexpr size_t WS_cs = WS_LHs + ws_al((size_t)2 * 65536 * 256 * 4);
constexpr size_t WS_kc_p = WS_cs + ws_al((size_t)2 * 65536 * 1024 * 2);
constexpr size_t WS_vcT_p = WS_kc_p + ws_al((size_t)8 * 256 * 64 * 2);
constexpr size_t WS_kc_s = WS_vcT_p + ws_al((size_t)8 * 64 * 256 * 2);
constexpr size_t WS_vcT_s = WS_kc_s + ws_al((size_t)64 * 1024 * 64 * 2);
constexpr size_t WS_rw6 = WS_vcT_s + ws_al((size_t)64 * 64 * 1024 * 2);
constexpr size_t WS_bonus = WS_rw6 + ws_al((size_t)MR * 8 * 384 * 4);
constexpr size_t WS_ybuf = WS_bonus + ws_al((size_t)MR * 8 * 4);
constexpr size_t WS_oa = WS_ybuf + ws_al((size_t)MR * 512 * 4);
constexpr size_t WS_ob = WS_oa + ws_al((size_t)MR * 512 * 2);
constexpr size_t WS_mb = WS_ob + ws_al((size_t)MR * 512 * 2);
constexpr size_t WS_xg = WS_mb + ws_al((size_t)MR * DM * 2);
constexpr size_t WS_tmp = WS_xg + ws_al((size_t)MR * DM * 2);
constexpr size_t WS_x1 = WS_tmp + ws_al((size_t)MR * DM * 4);
constexpr size_t WS_ss1 = WS_x1 + ws_al((size_t)MR * DM * 4);
constexpr size_t WS_pp = WS_ss1 + ws_al((size_t)MR * 16 * 4);
constexpr size_t WS_TOTAL = WS_pp + ws_al((size_t)MR * DM * 4);

struct P {
    const float *x_prompt, *x_sample, *p_prompt, *p_sample, *cache_cmp, *cache_sel, *cache_win, *state_wkv, *state_shift;
    const int* page_table;
    const float *norm_g, *w_in, *cmp_pe, *cmp_w1, *cmp_b1, *cmp_w2, *cmp_b2, *w_pa, *mu, *w0, *w_up, *a0, *a_up, *k_k, *k_a, *r_k, *gn_g, *gn_b,
        *w_pb, *w_out, *ple_g, *w_gate, *w_proj, *final_g;
    float* out;
    unsigned char* ws;
    __host__ __device__ __forceinline__ unsigned* bar() const { return (unsigned*)(ws + WS_bar); }
    __host__ __device__ __forceinline__ bf16_t* hb() const { return (bf16_t*)(ws + WS_hb); }
    __host__ __device__ __forceinline__ bf16_t* WinT() const { return (bf16_t*)(ws + WS_WinT); }
    __host__ __device__ __forceinline__ bf16_t* WpaT() const { return (bf16_t*)(ws + WS_WpaT); }
    __host__ __device__ __forceinline__ bf16_t* WpbT() const { return (bf16_t*)(ws + WS_WpbT); }
    __host__ __device__ __forceinline__ bf16_t* WoutT() const { return (bf16_t*)(ws + WS_WoutT); }
    __host__ __device__ __forceinline__ bf16_t* WgateT() const { return (bf16_t*)(ws + WS_WgateT); }
    __host__ __device__ __forceinline__ bf16_t* WprojT() const { return (bf16_t*)(ws + WS_WprojT); }
    __host__ __device__ __forceinline__ bf16_t* W1T() const { return (bf16_t*)(ws + WS_W1T); }
    __host__ __device__ __forceinline__ bf16_t* pb() const { return (bf16_t*)(ws + WS_pb); }
    __host__ __device__ __forceinline__ float* tabc() const { return (float*)(ws + WS_tabc); }
    __host__ __device__ __forceinline__ float* tabs() const { return (float*)(ws + WS_tabs); }
    __host__ __device__ __forceinline__ float* pt() const { return (float*)(ws + WS_pt); }
    __host__ __device__ __forceinline__ bf16_t* qb() const { return (bf16_t*)(ws + WS_qb); }
    __host__ __device__ __forceinline__ bf16_t* kb() const { return (bf16_t*)(ws + WS_kb); }
    __host__ __device__ __forceinline__ bf16_t* vcr() const { return (bf16_t*)(ws + WS_vcr); }
    __host__ __device__ __forceinline__ bf16_t* vT() const { return (bf16_t*)(ws + WS_vT); }
    __host__ __device__ __forceinline__ bf16_t* ag() const { return (bf16_t*)(ws + WS_ag); }
    __host__ __device__ __forceinline__ bf16_t* rg() const { return (bf16_t*)(ws + WS_rg); }
    __host__ __device__ __forceinline__ bf16_t* mg() const { return (bf16_t*)(ws + WS_mg); }
    __host__ __device__ __forceinline__ float* gates() const { return (float*)(ws + WS_gates); }
    __host__ __device__ __forceinline__ float* rz() const { return (float*)(ws + WS_rz); }
    __host__ __device__ __forceinline__ float* LHp() const { return (float*)(ws + WS_LHp); }
    __host__ __device__ __forceinline__ float* LHs() const { return (float*)(ws + WS_LHs); }
    __host__ __device__ __forceinline__ bf16_t* cs() const { return (bf16_t*)(ws + WS_cs); }
    __host__ __device__ __forceinline__ bf16_t* kc_p() const { return (bf16_t*)(ws + WS_kc_p); }
    __host__ __device__ __forceinline__ bf16_t* vcT_p() const { return (bf16_t*)(ws + WS_vcT_p); }
    __host__ __device__ __forceinline__ bf16_t* kc_s() const { return (bf16_t*)(ws + WS_kc_s); }
    __host__ __device__ __forceinline__ bf16_t* vcT_s() const { return (bf16_t*)(ws + WS_vcT_s); }
    __host__ __device__ __forceinline__ float* rw6() const { return (float*)(ws + WS_rw6); }
    __host__ __device__ __forceinline__ float* bonus() const { return (float*)(ws + WS_bonus); }
    __host__ __device__ __forceinline__ float* ybuf() const { return (float*)(ws + WS_ybuf); }
    __host__ __device__ __forceinline__ bf16_t* oa() const { return (bf16_t*)(ws + WS_oa); }
    __host__ __device__ __forceinline__ bf16_t* ob() const { return (bf16_t*)(ws + WS_ob); }
    __host__ __device__ __forceinline__ bf16_t* mb() const { return (bf16_t*)(ws + WS_mb); }
    __host__ __device__ __forceinline__ bf16_t* xg() const { return (bf16_t*)(ws + WS_xg); }
    __host__ __device__ __forceinline__ float* tmp() const { return (float*)(ws + WS_tmp); }
    __host__ __device__ __forceinline__ float* x1() const { return (float*)(ws + WS_x1); }
    __host__ __device__ __forceinline__ float* ss1() const { return (float*)(ws + WS_ss1); }
    __host__ __device__ __forceinline__ float* pp() const { return (float*)(ws + WS_pp); }
};

__device__ __forceinline__ bf16_t f2bf(float f) { unsigned u = __float_as_uint(f); u += 0x7FFFu + ((u >> 16) & 1u); return (bf16_t)(u >> 16); }
__device__ __forceinline__ float bf2f(bf16_t b) { return __uint_as_float(((unsigned)b) << 16); }
typedef __bf16 bf16v2_t __attribute__((ext_vector_type(2)));
typedef float f32x2_t __attribute__((ext_vector_type(2)));
__device__ __forceinline__ unsigned pk2(float lo, float hi) { const f32x2_t v = {lo, hi}; return __builtin_bit_cast(unsigned, __builtin_convertvector(v, bf16v2_t)); }
__device__ __forceinline__ float wave_sum(float v) {
#pragma unroll
    for (int o = 32; o >= 1; o >>= 1) v += __shfl_xor(v, o);
    return v;
}
__device__ __forceinline__ float sigmoidf_(float x) { return 1.0f / (1.0f + __expf(-x)); }
__device__ __forceinline__ float siluf_(float x) { return x / (1.0f + __expf(-x)); }

__device__ __forceinline__ int win_src_col(int np) {
    const int pn = np >> 8, p = np & 255;
    if (pn < 5) {
        const int bj = p >> 7, wc = (p >> 5) & 3, n = (p >> 4) & 1, fq = (p >> 2) & 3, e = p & 3;
        const int d = 32 * n + 16 * (wc & 1) + 4 * fq + e;
        if (pn < 2) { const int head = pn * 4 + bj * 2 + (wc >> 1); return head * 64 + d; }
        const int br = pn - 2, g = wc >> 1;
        return 512 + br * 256 + bj * 128 + g * 64 + d;
    }
    if (pn < 7) return 1304 + (pn - 5) * 256 + p;
    if (pn < 13) return 1816 + (pn - 7) * 256 + p;
    if (pn == 13) { if (p < 128) return 1816 + 1536 + p; if (p < 152) return 1280 + (p - 128); return -1; }
    if (pn < 16) return 3480 + (pn - 14) * 256 + p;
    return 3992 + (pn - 16) * 256 + p;
}

template <class F>
__device__ __forceinline__ void transpose_cvt(bf16_t* dst, int Nd, int K, F f) {
    const int total = Nd * (K >> 3);
    for (int id = blockIdx.x * NTHR + threadIdx.x; id < total; id += gridDim.x * NTHR) {
        const int n = id % Nd, kc = id / Nd;
        float v[8];
#pragma unroll
        for (int j = 0; j < 8; ++j) v[j] = f(n, kc * 8 + j);
        uint4 w; w.x = pk2(v[0], v[1]); w.y = pk2(v[2], v[3]); w.z = pk2(v[4], v[5]); w.w = pk2(v[6], v[7]);
        *(uint4*)(dst + (size_t)n * K + kc * 8) = w;
    }
}

__device__ __forceinline__ void sincos_small(double r, float& s, float& c) {
    const double r2 = r * r;
    double sa = 1.0, ca = 1.0;
    double ts = 1.0, tc = 1.0; sa = 0.0; ca = 0.0;
#pragma unroll
    for (int k = 0; k < 16; ++k) {
        sa += ts; ca += tc;
        ts = -ts * r2 / (double)((2 * k + 2) * (2 * k + 3));
        tc = -tc * r2 / (double)((2 * k + 1) * (2 * k + 2));
    }
    s = (float)(sa * r); c = (float)ca;
}

__device__ __forceinline__ void ph_prep(const P& p) {
    const int tid = threadIdx.x, lane = tid & 63, wid = tid >> 6;
    const int gw = blockIdx.x * 8 + wid, nw = gridDim.x * 8;
    const int gt = blockIdx.x * NTHR + tid, nt = gridDim.x * NTHR;
    for (int row = gw; row < MR; row += nw) {
        const float4* src = (const float4*)(row < NP ? p.x_prompt + (size_t)row * DM : p.x_sample + (size_t)(row - NP) * DM);
        float4 v[4]; float ss = 0.f;
#pragma unroll
        for (int i = 0; i < 4; ++i) { v[i] = src[lane + 64 * i]; ss += v[i].x * v[i].x + v[i].y * v[i].y + v[i].z * v[i].z + v[i].w * v[i].w; }
        ss = wave_sum(ss);
        const float rstd = rsqrtf(ss * (1.0f / DM) + 1e-6f);
#pragma unroll
        for (int i = 0; i < 4; ++i) {
            const float4 g = ((const float4*)p.norm_g)[lane + 64 * i];
            uint2 w; w.x = pk2(v[i].x * rstd * g.x, v[i].y * rstd * g.y); w.y = pk2(v[i].z * rstd * g.z, v[i].w * rstd * g.w);
            *(uint2*)(p.hb() + (size_t)row * DM + 4 * (lane + 64 * i)) = w;
        }
    }
    { const float* w = p.w_in; transpose_cvt(p.WinT(), NPAD, DM, [=](int n, int k) { const int c = win_src_col(n); return c < 0 ? 0.f : w[(size_t)k * CIN + c]; }); }
    { const float* w = p.w_pa; transpose_cvt(p.WpaT(), DM, 512, [=](int n, int k) { return w[(size_t)k * DM + n]; }); }
    { const float* w = p.w_pb; transpose_cvt(p.WpbT(), DM, 512, [=](int n, int k) { return w[(size_t)k * DM + n]; }); }
    { const float* w = p.w_out; transpose_cvt(p.WoutT(), DM, DM, [=](int n, int k) { return w[(size_t)k * DM + n]; }); }
    { const float* w = p.w_gate; transpose_cvt(p.WgateT(), DM, DM, [=](int n, int k) { return w[(size_t)k * DM + n]; }); }
    { const float* w = p.w_proj; transpose_cvt(p.WprojT(), DM, 256, [=](int n, int k) { return w[(size_t)k * DM + n]; }); }
    { const float* w = p.cmp_w1; transpose_cvt(p.W1T(), 512, 1024, [=](int n, int k) { const int kvi = n >> 8, nn = n & 255; return w[(size_t)kvi * 262144 + (size_t)((nn >> 7) * 1024 + k) * 128 + (nn & 127)]; }); }
    for (int id = gt; id < MR * 64; id += nt) {
        const int row = id >> 6, c4 = id & 63;
        const float4 v = ((const float4*)(row < NP ? p.p_prompt + (size_t)row * 256 : p.p_sample + (size_t)(row - NP) * 256))[c4];
        uint2 w; w.x = pk2(v.x, v.y); w.y = pk2(v.z, v.w);
        *(uint2*)(p.pb() + (size_t)row * 256 + c4 * 4) = w;
    }
    for (int id = gt; id < 4104 * 32; id += nt) {
        const int pi = id >> 5, i = id & 31;
        const int pos = pi < 4096 ? pi : PAST + pi - 4096;
        const float inv = (float)exp(-(double)i * (9.210340371976184 / 32.0));
        const float ang = (float)pos * inv;
        const double x = (double)ang;
        const double k = rint(x * 0.15915494309189535);
        const double r = x - k * 6.283185307179586;
        float s, c; sincos_small(r, s, c);
        p.tabc()[id] = c; p.tabs()[id] = s;
    }
    for (int o = gw; o < 256; o += nw) {
        const int kvi = o >> 7, f = o & 127;
        float acc = 0.f;
        for (int jd = lane; jd < 2048; jd += 64) acc += p.cmp_pe[kvi * 2048 + jd] * p.cmp_w1[(size_t)kvi * 262144 + (size_t)jd * 128 + f];
        acc = wave_sum(acc);
        if (lane == 0) p.pt()[o] = acc + p.cmp_b1[o];
    }
    for (int id = gt; id < DB * 504 * 64; id += nt) {
        const int c4 = id & 63, j = (id >> 6) % 504, b = (id >> 6) / 504;
        ((float4*)(p.out + O_WIN_S))[((size_t)b * 512 + j) * 64 + c4] = ((const float4*)p.cache_win)[((size_t)b * 512 + j + 8) * 64 + c4];
    }
}
#define XB_TMO      128
#define XB_XCNT(j)  (256  + 64 * (j))
#define XB_XSUB(j)  (1280 + 64 * (j))
#define XB_XGEN(j)  (2304 + 64 * (j))
#define XB_TOP      3328
#define XB_TOPGEN   3392
#define XCD_BAR_WORDS 3456
#define XB_SPIN_CAP (1u << 18)

__device__ __forceinline__ unsigned xb_ld(unsigned* p)              { return __hip_atomic_load(p, __ATOMIC_RELAXED, __HIP_MEMORY_SCOPE_AGENT); }
__device__ __forceinline__ unsigned xb_add(unsigned* p, unsigned v) { return __hip_atomic_fetch_add(p, v, __ATOMIC_RELAXED, __HIP_MEMORY_SCOPE_AGENT); }
__device__ __forceinline__ unsigned xb_xcc_id() { return (unsigned)__builtin_amdgcn_s_getreg((3 << 11) | 20) & 0xFu; }
#define XB_SPIN(cond, bar) do { unsigned _sp = 0; while (cond) { __builtin_amdgcn_s_sleep(1); \
    if ((++_sp & 255u) == 0u) { if (xb_ld(&(bar)[XB_TMO])) break; if (_sp > XB_SPIN_CAP) { atomicAdd(&(bar)[XB_TMO], 1u); break; } } } } while (0)

struct XcdBarrier {
    unsigned* bar; unsigned x;
    volatile LAS unsigned* st;
};

__device__ __forceinline__ XcdBarrier xcd_barrier_post(unsigned* bar, volatile LAS unsigned* st) {
    XcdBarrier b; b.bar = bar; b.x = xb_xcc_id(); b.st = st;
    if (threadIdx.x == 0) (void)xb_add(&bar[XB_XCNT(b.x)], 1u);
    return b;
}
__device__ __forceinline__ void xcd_barrier_complete(unsigned* bar, unsigned x, unsigned& nloc, unsigned& nx) {
    const unsigned G = gridDim.x * gridDim.y * gridDim.z;
    unsigned sum, cnt, mine, sp = 0u;
    for (;;) {
        sum = 0u; cnt = 0u; mine = 0u;
#pragma unroll
        for (unsigned j = 0; j < 16; ++j) { const unsigned c = xb_ld(&bar[XB_XCNT(j)]); sum += c; cnt += (c > 0u) ? 1u : 0u; mine = (j == x) ? c : mine; }
        if (sum == G) break;
        __builtin_amdgcn_s_sleep(1);
        if ((++sp & 255u) == 0u) { if (xb_ld(&bar[XB_TMO])) break; if (sp > XB_SPIN_CAP) { atomicAdd(&bar[XB_TMO], 1u); break; } }
    }
    nloc = mine > 0u ? mine : 1u; nx = cnt > 0u ? cnt : 1u;
}

__device__ __forceinline__ void xcd_barrier(const XcdBarrier& b) {
    asm volatile("s_waitcnt vmcnt(0)" ::: "memory");
    __syncthreads();
    if (threadIdx.x == 0) {
        unsigned* bar = b.bar;
        __builtin_amdgcn_s_waitcnt(0);
        unsigned nloc = b.st[0], nx = b.st[1];
        if (nloc == 0u) { xcd_barrier_complete(bar, b.x, nloc, nx); b.st[0] = nloc; b.st[1] = nx; }
        const unsigned old = xb_add(&bar[XB_XSUB(b.x)], 1u);
        const unsigned gen = old / nloc;
        if (old + 1u == (gen + 1u) * nloc) {
            __builtin_amdgcn_fence(__ATOMIC_RELEASE, "agent");
            asm volatile("s_waitcnt vmcnt(0)" ::: "memory");
            const unsigned og = xb_add(&bar[XB_TOP], 1u);
            const unsigned tg = og / nx;
            if (og + 1u == (tg + 1u) * nx) xb_add(&bar[XB_TOPGEN], 1u);
            else XB_SPIN(xb_ld(&bar[XB_TOPGEN]) == tg, bar);
            __builtin_amdgcn_fence(__ATOMIC_ACQUIRE, "agent");
            xb_add(&bar[XB_XGEN(b.x)], 1u);
            asm volatile("s_waitcnt vmcnt(0)" ::: "memory");
        } else {
            XB_SPIN(xb_ld(&bar[XB_XGEN(b.x)]) == gen, bar);
            __builtin_amdgcn_fence(__ATOMIC_ACQUIRE, "agent");
            asm volatile("s_waitcnt vmcnt(0)" ::: "memory");
        }
    }
    __syncthreads();
}

using pg8::Unit;

__device__ __forceinline__ void st_bf4(bf16_t* dst, f32x4 v) { uint2 w; w.x = pk2(v[0], v[1]); w.y = pk2(v[2], v[3]); *(uint2*)dst = w; }

struct EpiIn {
    static constexpr bool PERM = false, AFTER_DRAIN = false;
    P p;
    __device__ __forceinline__ void operator()(const f32x4 (&acc)[2][2][4][2], const Unit& u, int wr, int wc, int fr, int fq) const {
        const int pn = u.pn;
#pragma unroll
        for (int ai = 0; ai < 2; ++ai)
#pragma unroll
            for (int m = 0; m < 4; ++m) {
                const int row = u.pm * 256 + ai * 128 + wr * 64 + m * 16 + fr;
                if (pn < 5) {
                    const int pi = row < NP ? (row & (SEQ - 1)) : 4096 + ((row - NP) & 7);
                    const int d0 = 16 * (wc & 1) + 4 * fq;
                    const f32x4 cs = *(const f32x4*)(p.tabc() + pi * 32 + d0), sn = *(const f32x4*)(p.tabs() + pi * 32 + d0);
#pragma unroll
                    for (int bj = 0; bj < 2; ++bj) {
                        const f32x4 x1 = acc[ai][bj][m][0], x2 = acc[ai][bj][m][1];
                        if (pn < 2) {
                            const int head = pn * 4 + bj * 2 + (wc >> 1);
                            const f32x4 o1 = (x1 * cs - x2 * sn) * 0.125f, o2 = (x2 * cs + x1 * sn) * 0.125f;
                            bf16_t* q = p.qb() + (size_t)row * 512 + head * 64 + d0;
                            st_bf4(q, o1); st_bf4(q + 32, o2);
                        } else {
                            const int br = pn - 2, g = wc >> 1;
                            f32x4 o1, o2;
                            if (bj == 0) { o1 = x1 * cs - x2 * sn; o2 = x2 * cs + x1 * sn; } else { o1 = x1; o2 = x2; }
                            float* dst = nullptr;
                            if (row < NP) {
                                if (br == 0) dst = p.out + O_CMP_P + (size_t)row * 256;
                                else if (br == 1) dst = p.out + O_SEL_P + (size_t)row * 256;
                                else { const int s = row & (SEQ - 1); if (s >= SEQ - 512) dst = p.out + O_WIN_P + ((size_t)(row >> 12) * 512 + (s - (SEQ - 512))) * 256; }
                            } else {
                                const int rs = row - NP;
                                if (br == 0) dst = p.out + O_CMP_S + (size_t)rs * 256;
                                else if (br == 1) dst = p.out + O_SEL_S + (size_t)rs * 256;
                                else dst = p.out + O_WIN_S + ((size_t)(rs >> 3) * 512 + 504 + (rs & 7)) * 256;
                            }
                            if (dst) { dst += bj * 128 + g * 64 + d0; *(f32x4*)dst = o1; *(f32x4*)(dst + 32) = o2; }
                            if (row < NP) {
                                const int b = row >> 12, s = row & (SEQ - 1);
                                if (bj == 0) {
                                    bf16_t* k = p.kb() + ((size_t)((br * NB + b) * 2 + g) * SEQ + s) * 64 + d0;
                                    st_bf4(k, o1); st_bf4(k + 32, o2);
                                } else if (br == 0) {
                                    bf16_t* v = p.vcr() + ((size_t)(b * 2 + g) * SEQ + s) * 64 + d0;
                                    st_bf4(v, o1); st_bf4(v + 32, o2);
                                } else {
                                    bf16_t* v = p.vT() + ((size_t)(((br - 1) * NB + b) * 2 + g) * 64 + d0) * SEQ + s;
#pragma unroll
                                    for (int e = 0; e < 4; ++e) { v[(size_t)e * SEQ] = f2bf(o1[e]); v[(size_t)(32 + e) * SEQ] = f2bf(o2[e]); }
                                }
                            }
                        }
                    }
                } else {
#pragma unroll
                    for (int bj = 0; bj < 2; ++bj)
#pragma unroll
                        for (int n = 0; n < 2; ++n) {
                            const int c = bj * 128 + wc * 32 + n * 16 + fq * 4;
                            const f32x4 v = acc[ai][bj][m][n];
                            if (pn < 7) {
                                f32x4 o; for (int e = 0; e < 4; ++e) o[e] = siluf_(v[e]);
                                st_bf4(p.ag() + (size_t)row * 512 + (pn - 5) * 256 + c, o);
                            } else if (pn < 13) {
                                *(f32x4*)(p.rz() + (size_t)row * CR + (pn - 7) * 256 + c) = v;
                            } else if (pn == 13) {
                                if (c < 128) *(f32x4*)(p.rz() + (size_t)row * CR + 1536 + c) = v;
                                else if (c < 152) { f32x4 o; for (int e = 0; e < 4; ++e) o[e] = sigmoidf_(v[e]); *(f32x4*)(p.gates() + (size_t)row * 32 + (c - 128)) = o; }
                            } else if (pn < 16) {
                                f32x4 o; for (int e = 0; e < 4; ++e) o[e] = siluf_(v[e]);
                                st_bf4(p.rg() + (size_t)row * 512 + (pn - 14) * 256 + c, o);
                            } else {
                                f32x4 o; for (int e = 0; e < 4; ++e) o[e] = sigmoidf_(v[e]);
                                st_bf4(p.mg() + (size_t)row * 2048 + (pn - 16) * 256 + c, o);
                            }
                        }
                }
            }
    }
};

struct EpiPlain {
    static constexpr bool PERM = false, AFTER_DRAIN = false;
    float* C; int ldc; int pad_;
    __device__ __forceinline__ void operator()(const f32x4 (&acc)[2][2][4][2], const Unit& u, int wr, int wc, int fr, int fq) const {
#pragma unroll
        for (int ai = 0; ai < 2; ++ai)
#pragma unroll
            for (int m = 0; m < 4; ++m) {
                float* rowp = C + (size_t)(u.pm * 256 + ai * 128 + wr * 64 + m * 16 + fr) * ldc + u.pn * 256 + wc * 32 + 4 * fq;
#pragma unroll
                for (int bj = 0; bj < 2; ++bj)
#pragma unroll
                    for (int n = 0; n < 2; ++n) *(f32x4*)(rowp + bj * 128 + n * 16) = acc[ai][bj][m][n];
            }
    }
};

struct EpiYa {
    static constexpr bool PERM = false, AFTER_DRAIN = false;
    P p;
    __device__ __forceinline__ void operator()(const f32x4 (&acc)[2][2][4][2], const Unit& u, int wr, int wc, int fr, int fq) const {
#pragma unroll
        for (int ai = 0; ai < 2; ++ai)
#pragma unroll
            for (int m = 0; m < 4; ++m) {
                const int row = u.pm * 256 + ai * 128 + wr * 64 + m * 16 + fr;
#pragma unroll
                for (int bj = 0; bj < 2; ++bj)
#pragma unroll
                    for (int n = 0; n < 2; ++n) {
                        const int c = u.pn * 256 + bj * 128 + wc * 32 + n * 16 + fq * 4;
                        const uint2 gw = *(const uint2*)(p.mg() + (size_t)row * 2048 + c);
                        f32x4 g; g[0] = __uint_as_float(gw.x << 16); g[1] = __uint_as_float(gw.x & 0xffff0000u); g[2] = __uint_as_float(gw.y << 16); g[3] = __uint_as_float(gw.y & 0xffff0000u);
                        *(f32x4*)(p.tmp() + (size_t)row * DM + c) = g * acc[ai][bj][m][n];
                    }
            }
    }
};
struct EpiYb {
    static constexpr bool PERM = false, AFTER_DRAIN = false;
    P p;
    __device__ __forceinline__ void operator()(const f32x4 (&acc)[2][2][4][2], const Unit& u, int wr, int wc, int fr, int fq) const {
#pragma unroll
        for (int ai = 0; ai < 2; ++ai)
#pragma unroll
            for (int m = 0; m < 4; ++m) {
                const int row = u.pm * 256 + ai * 128 + wr * 64 + m * 16 + fr;
#pragma unroll
                for (int bj = 0; bj < 2; ++bj)
#pragma unroll
                    for (int n = 0; n < 2; ++n) {
                        const int c = u.pn * 256 + bj * 128 + wc * 32 + n * 16 + fq * 4;
                        const uint2 gw = *(const uint2*)(p.mg() + (size_t)row * 2048 + 1024 + c);
                        f32x4 g; g[0] = __uint_as_float(gw.x << 16); g[1] = __uint_as_float(gw.x & 0xffff0000u); g[2] = __uint_as_float(gw.y << 16); g[3] = __uint_as_float(gw.y & 0xffff0000u);
                        const f32x4 t = *(const f32x4*)(p.tmp() + (size_t)row * DM + c);
                        st_bf4(p.mb() + (size_t)row * DM + c, t + g * acc[ai][bj][m][n]);
                    }
            }
    }
};
struct EpiOut {
    static constexpr bool PERM = false, AFTER_DRAIN = false;
    P p;
    __device__ __forceinline__ void operator()(const f32x4 (&acc)[2][2][4][2], const Unit& u, int wr, int wc, int fr, int fq) const {
#pragma unroll
        for (int ai = 0; ai < 2; ++ai)
#pragma unroll
            for (int m = 0; m < 4; ++m) {
                const int row = u.pm * 256 + ai * 128 + wr * 64 + m * 16 + fr;
                const float* xr = row < NP ? p.x_prompt + (size_t)row * DM : p.x_sample + (size_t)(row - NP) * DM;
                float ss = 0.f;
#pragma unroll
                for (int bj = 0; bj < 2; ++bj)
#pragma unroll
                    for (int n = 0; n < 2; ++n) {
                        const int c = u.pn * 256 + bj * 128 + wc * 32 + n * 16 + fq * 4;
                        const f32x4 v = *(const f32x4*)(xr + c) + acc[ai][bj][m][n];
                        *(f32x4*)(p.x1() + (size_t)row * DM + c) = v;
                        ss += v[0] * v[0] + v[1] * v[1] + v[2] * v[2] + v[3] * v[3];
                        st_bf4(p.xg() + (size_t)row * DM + c, v * *(const f32x4*)(p.ple_g + c));
                    }
                ss += __shfl_xor(ss, 16); ss += __shfl_xor(ss, 32);
                if (fq == 0) p.ss1()[(size_t)row * 16 + u.pn * 4 + wc] = ss;
            }
    }
};
struct EpiGate {
    static constexpr bool PERM = false, AFTER_DRAIN = false;
    P p;
    __device__ __forceinline__ void operator()(const f32x4 (&acc)[2][2][4][2], const Unit& u, int wr, int wc, int fr, int fq) const {
#pragma unroll
        for (int ai = 0; ai < 2; ++ai)
#pragma unroll
            for (int m = 0; m < 4; ++m) {
                const int row = u.pm * 256 + ai * 128 + wr * 64 + m * 16 + fr;
                float ss = 0.f;
#pragma unroll
                for (int i = 0; i < 4; ++i) { const f32x4 t = *(const f32x4*)(p.ss1() + (size_t)row * 16 + i * 4); ss += (t[0] + t[1]) + (t[2] + t[3]); }
                const float rstd = rsqrtf(ss * (1.0f / DM) + 1e-6f);
#pragma unroll
                for (int bj = 0; bj < 2; ++bj)
#pragma unroll
                    for (int n = 0; n < 2; ++n) {
                        const int c = u.pn * 256 + bj * 128 + wc * 32 + n * 16 + fq * 4;
                        const f32x4 a = acc[ai][bj][m][n] * rstd;
                        f32x4 g; for (int e = 0; e < 4; ++e) g[e] = sigmoidf_(a[e]);
                        float* ppp = p.pp() + (size_t)row * DM + c;
                        *(f32x4*)ppp = *(const f32x4*)(p.x1() + (size_t)row * DM + c) + g * *(const f32x4*)ppp;
                    }
            }
    }
};

__device__ __forceinline__ void ph_final(const P& p) {
    const int tid = threadIdx.x, lane = tid & 63, wid = tid >> 6;
    for (int row = blockIdx.x * 8 + wid; row < MR; row += gridDim.x * 8) {
        const float4* src = (const float4*)(p.pp() + (size_t)row * DM);
        float4 v[4]; float ss = 0.f;
#pragma unroll
        for (int i = 0; i < 4; ++i) { v[i] = src[lane + 64 * i]; ss += v[i].x * v[i].x + v[i].y * v[i].y + v[i].z * v[i].z + v[i].w * v[i].w; }
        ss = wave_sum(ss);
        const float rstd = rsqrtf(ss * (1.0f / DM) + 1e-6f);
        float4* dst = (float4*)(p.out + (row < NP ? O_Y_P + (size_t)row * DM : O_Y_S + (size_t)(row - NP) * DM));
#pragma unroll
        for (int i = 0; i < 4; ++i) {
            const float4 g = ((const float4*)p.final_g)[lane + 64 * i];
            float4 o; o.x = v[i].x * rstd * g.x; o.y = v[i].y * rstd * g.y; o.z = v[i].z * rstd * g.z; o.w = v[i].w * rstd * g.w;
            dst[lane + 64 * i] = o;
        }
    }
}

__device__ __forceinline__ void ph_compress2(const P& p, const float* LH, int nbg, int nrows, int nblk, bf16_t* kc, bf16_t* vcT, LAS float* lds) {
    const int tid = threadIdx.x, lane = tid & 63, wid = tid >> 6;
    LAS float* sbuf = lds + wid * 128;
    const int total = 2 * nbg * nrows;
    for (int it = blockIdx.x * 8 + wid; it < total; it += gridDim.x * 8) {
        const int i = it % nrows, bg = (it / nrows) % nbg, kvi = it / (nrows * nbg);
        float o = 0.f;
        if (i < nblk) {
            const float* l0 = LH + ((size_t)kvi * nbg * nrows + (size_t)bg * nrows + i) * 256;
            const float* l1 = l0 + 256;
#pragma unroll
            for (int h = 0; h < 2; ++h) {
                const int f = lane + 64 * h;
                const float hid = l0[f] + l1[128 + f] + p.pt()[kvi * 128 + f];
                sbuf[f] = siluf_(hid);
            }
            WAVE_SYNC();
            o = p.cmp_b2[kvi * 64 + lane];
            const float* w2 = p.cmp_w2 + kvi * 8192 + lane;
#pragma unroll 8
            for (int f = 0; f < 128; ++f) o += sbuf[f] * w2[f * 64];
            WAVE_SYNC();
        }
        if (kvi == 0) kc[((size_t)bg * nrows + i) * 64 + lane] = f2bf(o);
        else vcT[((size_t)bg * 64 + lane) * nrows + i] = f2bf(o);
    }
}

__device__ __forceinline__ void ph_cvt_cache(const P& p) {
    const size_t total = (size_t)2 * DB * 2 * PAST * 8;
    for (size_t id = (size_t)blockIdx.x * NTHR + threadIdx.x; id < total; id += (size_t)gridDim.x * NTHR) {
        const int d8 = (int)(id & 7), tok = (int)((id >> 3) & (PAST - 1)), g = (int)((id >> 17) & 1), b = (int)((id >> 18) & 31), kvi = (int)(id >> 23);
        const int page = p.page_table[b * 128 + (tok >> 7)];
        const float4* src = (const float4*)(p.cache_cmp + ((size_t)page * 128 + (tok & 127)) * 256 + kvi * 128 + g * 64 + d8 * 8);
        const float4 a = src[0], c = src[1];
        uint4 w; w.x = pk2(a.x, a.y); w.y = pk2(a.z, a.w); w.z = pk2(c.x, c.y); w.w = pk2(c.z, c.w);
        *(uint4*)(p.cs() + id * 8) = w;
    }
}

__device__ __forceinline__ void ph_rwkv_prep(const P& p) {
    const int tid = threadIdx.x, lane = tid & 63, wid = tid >> 6;
    for (int it = blockIdx.x * 8 + wid; it < MR * 8; it += gridDim.x * 8) {
        const int row = it >> 3, h = it & 7, c = h * 64 + lane;
        const float* z = p.rz() + (size_t)row * CR;
        const float* pv;
        bool zero_prev = false;
        if (row < NP) { if ((row & (SEQ - 1)) == 0) { zero_prev = true; pv = z; } else pv = z - CR; }
        else { const int rs = row - NP; if ((rs & 7) == 0) pv = p.state_shift + (size_t)(rs >> 3) * CR; else pv = z - CR; }
        auto lerp = [&](int col) { const float zz = z[col]; const float pr = zero_prev ? 0.f : pv[col]; return zz + (pr - zz) * p.mu[col]; };
        const float zr = lerp(c), zk = lerp(512 + c), zv = lerp(1024 + c), zwd = lerp(1536 + lane), zad = lerp(1600 + lane);
        const float th = tanhf(zwd);
        float accw = p.w0[c], acca = p.a0[c];
#pragma unroll 8
        for (int j = 0; j < 64; ++j) {
            const float tj = __shfl(th, j), aj = __shfl(zad, j);
            accw += tj * p.w_up[j * 512 + c]; acca += aj * p.a_up[j * 512 + c];
        }
        const float nx = -accw;
        const float sp = fmaxf(nx, 0.f) + log1pf(__expf(-fabsf(nx)));
        const float w = -sp - 0.5f;
        const float dec = __expf(-__expf(w));
        const float a = sigmoidf_(acca);
        const float kkr = zk * p.k_k[c];
        const float nrm = sqrtf(wave_sum(kkr * kkr));
        const float kk = kkr / fmaxf(nrm, 1e-12f);
        const float km = zk * (1.0f + (a - 1.0f) * p.k_a[c]);
        const float bon = wave_sum(zr * km * p.r_k[c]);
        float* o = p.rw6() + (size_t)it * 384 + lane;
        o[0] = zr; o[64] = dec; o[128] = km; o[192] = zv; o[256] = kk; o[320] = kk * a;
        if (lane == 0) p.bonus()[it] = bon;
        if (h == 0) {
            float* so = nullptr;
            if (row < NP) { if ((row & (SEQ - 1)) == SEQ - 1) so = p.out + O_SH_P + (size_t)(row >> 12) * CR; }
            else { const int rs = row - NP; if ((rs & 7) == 7) so = p.out + O_SH_S + (size_t)(rs >> 3) * CR; }
            if (so) for (int i = lane; i < CR; i += 64) so[i] = z[i];
        }
    }
}

__device__ __forceinline__ void ph_rwkv_scan(const P& p, LAS float* lds) {
    const int tid = threadIdx.x, grp = tid >> 8, gt = tid & 255, vrow = gt >> 2, kq = gt & 3;
    LAS float* buf = lds + grp * (16 * 384);
    for (int bi = blockIdx.x; bi < 16 + 128; bi += gridDim.x) {
        int row0, T, b, h; const float* s0 = nullptr; float* sout;
        if (bi < 16) { const int item = bi * 2 + grp; b = item >> 3; h = item & 7; row0 = b * SEQ; T = SEQ; sout = p.out + O_WKV_P + (size_t)item * 4096; }
        else { const int item = (bi - 16) * 2 + grp; b = item >> 3; h = item & 7; row0 = NP + b * 8; T = 8; s0 = p.state_wkv + (size_t)item * 4096; sout = p.out + O_WKV_S + (size_t)item * 4096; }
        float S[16];
#pragma unroll
        for (int i = 0; i < 16; ++i) S[i] = s0 ? s0[vrow * 64 + kq * 16 + i] : 0.f;
        for (int t0 = 0; t0 < T; t0 += 16) {
            const int ns = (T - t0) < 16 ? (T - t0) : 16;
            __syncthreads();
#pragma unroll
            for (int i = 0; i < 6; ++i) {
                const int idx = i * 256 + gt, s = idx / 96, o = idx % 96;
                if (s < ns) *(LAS f32x4*)(buf + s * 384 + o * 4) = *(const f32x4*)(p.rw6() + ((size_t)(row0 + t0 + s) * 8 + h) * 384 + o * 4);
            }
            __syncthreads();
            for (int s = 0; s < ns; ++s) {
                LAS const float* bs = buf + s * 384;
                f32x4 r[4], d[4], km[4], kk[4], ka[4];
#pragma unroll
                for (int j = 0; j < 4; ++j) {
                    r[j] = *(LAS const f32x4*)(bs + 0 + kq * 16 + 4 * j);
                    d[j] = *(LAS const f32x4*)(bs + 64 + kq * 16 + 4 * j);
                    km[j] = *(LAS const f32x4*)(bs + 128 + kq * 16 + 4 * j);
                    kk[j] = *(LAS const f32x4*)(bs + 256 + kq * 16 + 4 * j);
                    ka[j] = *(LAS const f32x4*)(bs + 320 + kq * 16 + 4 * j);
                }
                const float vv = bs[192 + vrow];
                float sa = 0.f;
#pragma unroll
                for (int i = 0; i < 16; ++i) sa += S[i] * kk[i >> 2][i & 3];
                sa += __shfl_xor(sa, 1); sa += __shfl_xor(sa, 2);
                sa = -sa;
                float y = 0.f;
#pragma unroll
                for (int i = 0; i < 16; ++i) { S[i] = S[i] * d[i >> 2][i & 3] + sa * ka[i >> 2][i & 3] + vv * km[i >> 2][i & 3]; y += S[i] * r[i >> 2][i & 3]; }
                y += __shfl_xor(y, 1); y += __shfl_xor(y, 2);
                if (kq == 0) p.ybuf()[(size_t)(row0 + t0 + s) * 512 + h * 64 + vrow] = y;
            }
        }
#pragma unroll
        for (int i = 0; i < 16; ++i) sout[vrow * 64 + kq * 16 + i] = S[i];
    }
}

__device__ __forceinline__ void ph_rwkv_post(const P& p) {
    const int tid = threadIdx.x, lane = tid & 63, wid = tid >> 6;
    for (int it = blockIdx.x * 8 + wid; it < MR * 8; it += gridDim.x * 8) {
        const int row = it >> 3, h = it & 7, c = h * 64 + lane;
        const float y = p.ybuf()[(size_t)row * 512 + c];
        const float mean = wave_sum(y) * (1.0f / 64.0f);
        const float dv = y - mean;
        const float var = wave_sum(dv * dv) * (1.0f / 64.0f);
        float yn = dv * rsqrtf(var + 64e-5f) * p.gn_g[c] + p.gn_b[c];
        yn += p.bonus()[it] * p.rw6()[(size_t)it * 384 + 192 + lane];
        p.ob()[(size_t)row * 512 + c] = f2bf(yn * bf2f(p.rg()[(size_t)row * 512 + c]));
    }
}
#ifndef SMODE
#define SMODE 3
#endif
#ifndef ATTN_MODE
#define ATTN_MODE 3
#endif

typedef unsigned u32x2 __attribute__((ext_vector_type(2)));
__device__ __forceinline__ f32x16 mfma32(bf16x8 a, bf16x8 b, f32x16 c) { return __builtin_amdgcn_mfma_f32_32x32x16_bf16(a, b, c, 0, 0, 0); }
__device__ __forceinline__ bf16x8 pack8(float a0, float a1, float a2, float a3, float a4, float a5, float a6, float a7) {
    union { uint4 u; bf16x8 v; } x; x.u.x = pk2(a0, a1); x.u.y = pk2(a2, a3); x.u.z = pk2(a4, a5); x.u.w = pk2(a6, a7); return x.v;
}
__device__ __forceinline__ f32x16 zero16() { f32x16 z; for (int i = 0; i < 16; ++i) z[i] = 0.f; return z; }

struct KSrcBf { const bf16_t* base; __device__ __forceinline__ bf16x8 operator()(int tok0, int ks, int lane) const { return *(const bf16x8*)(base + (size_t)(tok0 + (lane & 31)) * 64 + 16 * ks + 8 * (lane >> 5)); } };
struct VSrcBfT { const bf16_t* base; int ld; __device__ __forceinline__ bf16x8 operator()(int tok0, int dt, int s2, int lane) const {
        const bf16_t* ptr = base + (size_t)(32 * dt + (lane & 31)) * ld + tok0 + 16 * s2 + 4 * (lane >> 5);
        union { uint4 u; bf16x8 v; } x; const uint2 a = *(const uint2*)ptr, b = *(const uint2*)(ptr + 8); x.u.x = a.x; x.u.y = a.y; x.u.z = b.x; x.u.w = b.y; return x.v; } };

template <class KS>
__device__ __forceinline__ f32x16 qk_tile(const bf16x8 (&qf)[4], const KS& ks, int tok0, int lane) {
    f32x16 s = zero16();
#pragma unroll
    for (int k = 0; k < 4; ++k) s = mfma32(ks(tok0, k, lane), qf[k], s);
    return s;
}
template <class OKF>
__device__ __forceinline__ void sm_stats(const f32x16& s, int hb, OKF ok, float& m, float& l) {
    float sv[16]; float tmax = -1e30f; unsigned okm = 0;
#pragma unroll
    for (int i = 0; i < 16; ++i) { const int kl = (i & 3) + 8 * (i >> 2) + 4 * hb; const bool k = ok(kl); okm |= (k ? 1u : 0u) << i; sv[i] = k ? s[i] : -1e30f; tmax = fmaxf(tmax, sv[i]); }
    tmax = fmaxf(tmax, __shfl_xor(tmax, 32));
    const float mn = fmaxf(m, tmax), alpha = __expf(m - mn); m = mn;
    float ps = 0.f;
#pragma unroll
    for (int i = 0; i < 16; ++i) ps += ((okm >> i) & 1u) ? __expf(sv[i] - mn) : 0.f;
    l = l * alpha + ps;
}
template <class OKF, class VF>
__device__ __forceinline__ void sm_pv(const f32x16& s, int hb, OKF ok, VF vf, float& m, float& l, f32x16 (&o)[2]) {
    float sv[16]; float tmax = -1e30f; unsigned okm = 0;
#pragma unroll
    for (int i = 0; i < 16; ++i) { const int kl = (i & 3) + 8 * (i >> 2) + 4 * hb; const bool k = ok(kl); okm |= (k ? 1u : 0u) << i; sv[i] = k ? s[i] : -1e30f; tmax = fmaxf(tmax, sv[i]); }
    tmax = fmaxf(tmax, __shfl_xor(tmax, 32));
    const float mn = fmaxf(m, tmax), alpha = __expf(m - mn); m = mn;
    float pr[16]; float ps = 0.f;
#pragma unroll
    for (int i = 0; i < 16; ++i) { pr[i] = ((okm >> i) & 1u) ? __expf(sv[i] - mn) : 0.f; ps += pr[i]; }
    l = l * alpha + ps;
    o[0] *= alpha; o[1] *= alpha;
#pragma unroll
    for (int s2 = 0; s2 < 2; ++s2) {
        const bf16x8 pb = pack8(pr[8 * s2 + 0], pr[8 * s2 + 1], pr[8 * s2 + 2], pr[8 * s2 + 3], pr[8 * s2 + 4], pr[8 * s2 + 5], pr[8 * s2 + 6], pr[8 * s2 + 7]);
#pragma unroll
        for (int dt = 0; dt < 2; ++dt) o[dt] = mfma32(vf(dt, s2), pb, o[dt]);
    }
}
template <class OKF, class VF>
__device__ __forceinline__ void cmp_pass2(const f32x16& s, int hb, OKF ok, VF vf, float m, float inv, f32x16 (&o)[2], LAS float* prow, bool writer) {
    float pr[16];
#pragma unroll
    for (int i = 0; i < 16; ++i) {
        const int kl = (i & 3) + 8 * (i >> 2) + 4 * hb;
        pr[i] = ok(kl) ? __expf(s[i] - m) * inv : 0.f;
        float q = pr[i] + __shfl_xor(pr[i], 1); q += __shfl_xor(q, 2);
        if (writer) prow[kl] = q;
    }
#pragma unroll
    for (int s2 = 0; s2 < 2; ++s2) {
        const bf16x8 pb = pack8(pr[8 * s2 + 0], pr[8 * s2 + 1], pr[8 * s2 + 2], pr[8 * s2 + 3], pr[8 * s2 + 4], pr[8 * s2 + 5], pr[8 * s2 + 6], pr[8 * s2 + 7]);
#pragma unroll
        for (int dt = 0; dt < 2; ++dt) o[dt] = mfma32(vf(dt, s2), pb, o[dt]);
    }
}

__device__ __forceinline__ void attn_store(const P& p, const f32x16 (&of)[2], int qrow, int head, int hb, bool doit) {
    if (!doit) return;
#pragma unroll
    for (int dt = 0; dt < 2; ++dt)
#pragma unroll
        for (int i4 = 0; i4 < 4; ++i4) {
            const int d = 32 * dt + 8 * i4 + 4 * hb;
            const size_t off = (size_t)qrow * 512 + head * 64 + d;
            const uint2 gw = *(const uint2*)(p.ag() + off);
            f32x4 v;
            v[0] = of[dt][4 * i4 + 0] * __uint_as_float(gw.x << 16); v[1] = of[dt][4 * i4 + 1] * __uint_as_float(gw.x & 0xffff0000u);
            v[2] = of[dt][4 * i4 + 2] * __uint_as_float(gw.y << 16); v[3] = of[dt][4 * i4 + 3] * __uint_as_float(gw.y & 0xffff0000u);
            st_bf4(p.oa() + off, v);
        }
}


__device__ __forceinline__ void of_put(LAS float* st, int lane, const f32x16 (&o)[2], float sc) {
#pragma unroll
    for (int dt = 0; dt < 2; ++dt)
#pragma unroll
        for (int i = 0; i < 16; ++i) st[(dt * 16 + i) * 64 + lane] = o[dt][i] * sc;
}
__device__ __forceinline__ void of_add(LAS float* st, int lane, const f32x16 (&o)[2], float sc) {
#pragma unroll
    for (int dt = 0; dt < 2; ++dt)
#pragma unroll
        for (int i = 0; i < 16; ++i) st[(dt * 16 + i) * 64 + lane] += o[dt][i] * sc;
}
__device__ __forceinline__ void of_get_add(LAS float* st, int lane, const f32x16 (&o)[2], float sc, f32x16 (&of)[2]) {
#pragma unroll
    for (int dt = 0; dt < 2; ++dt)
#pragma unroll
        for (int i = 0; i < 16; ++i) of[dt][i] = st[(dt * 16 + i) * 64 + lane] + o[dt][i] * sc;
}

__device__ __forceinline__ void attn_prompt_item(const P& p, int item, LAS unsigned char* wl, int lane) {
    const int bg = item & 7, tg = item >> 3, b = bg >> 1, g = bg & 1;
    const int col = lane & 31, hb = lane >> 5, tl = col >> 2, hh = col & 3;
    const int t0 = tg * 8, qpos = t0 + tl, qrow = b * SEQ + qpos, head = g * 4 + hh;
    bf16x8 qf[4];
#pragma unroll
    for (int ks = 0; ks < 4; ++ks) qf[ks] = *(const bf16x8*)(p.qb() + (size_t)qrow * 512 + head * 64 + 16 * ks + 8 * hb);
    LAS float* psum = (LAS float*)wl;
    LAS unsigned long long* msk = (LAS unsigned long long*)(wl + 8192);
    const float g0 = p.gates()[(size_t)qrow * 32 + head * 3 + 0], g1 = p.gates()[(size_t)qrow * 32 + head * 3 + 1], g2 = p.gates()[(size_t)qrow * 32 + head * 3 + 2];
    f32x16 oc[2]; oc[0] = zero16(); oc[1] = zero16();
    {
        const int cm = t0 + 7 - 31;
        const int ntile = cm >= 0 ? ((cm >> 4) >> 5) + 1 : 0;
        const KSrcBf ksrc{p.kc_p() + (size_t)bg * 256 * 64};
        const VSrcBfT vsrc{p.vcT_p() + (size_t)bg * 64 * 256, 256};
        float m = -1e30f, l = 0.f;
#pragma unroll 1
        for (int kt = 0; kt < ntile; ++kt) {
            const f32x16 s = qk_tile(qf, ksrc, 32 * kt, lane);
            sm_stats(s, hb, [&](int kl) { return 16 * (32 * kt + kl) + 31 <= qpos; }, m, l);
        }
        l += __shfl_xor(l, 32);
        const float inv = l > 0.f ? 1.0f / l : 0.f;
#pragma unroll
        for (int i = 0; i < 32; ++i) psum[i * 64 + lane] = 0.f;
        WAVE_SYNC();
#pragma unroll 1
        for (int kt = 0; kt < ntile; ++kt) {
            const f32x16 s = qk_tile(qf, ksrc, 32 * kt, lane);
            cmp_pass2(s, hb, [&](int kl) { return 16 * (32 * kt + kl) + 31 <= qpos; }, [&](int dt, int s2) { return vsrc(32 * kt, dt, s2, lane); }, m, inv, oc,
                      psum + tl * 256 + 32 * kt, hh == 0);
        }
    }
    WAVE_SYNC();
    for (int t2 = 0; t2 < 8; ++t2) {
        const int t = t0 + t2, cur = t >> 6, n = lane;
        float imp = 0.f;
#pragma unroll
        for (int c = -1; c < 4; ++c) { const int cc = 4 * n + c; if (cc >= 0) imp += psum[t2 * 256 + cc]; }
        if (n == 0 || n == cur || n == cur - 1) imp = 1e4f;
        if (n * 64 > t) imp = -1.0f;
        int rank = 0;
#pragma unroll
        for (int j = 0; j < 64; ++j) {
            const float vj = __uint_as_float(__builtin_amdgcn_readlane(__float_as_uint(imp), j));
            rank += (vj > imp || (vj == imp && j < n)) ? 1 : 0;
        }
        const unsigned long long mk = __ballot(rank < 16);
        if (lane == 0) msk[t2] = mk;
    }
    WAVE_SYNC();
    const unsigned long long mymask = msk[tl];
    unsigned long long um = 0;
#pragma unroll
    for (int i = 0; i < 8; ++i) um |= msk[i];
    const int cur0 = t0 >> 6;
    WAVE_SYNC();
    LAS float* ost = (LAS float*)wl;
    of_put(ost, lane, oc, g0);
    {
        const KSrcBf ksrc{p.kb() + (size_t)((1 * NB + b) * 2 + g) * SEQ * 64};
        const VSrcBfT vsrc{p.vT() + (size_t)((0 * NB + b) * 2 + g) * 64 * SEQ, SEQ};
        float m = -1e30f, l = 0.f; f32x16 o[2]; o[0] = zero16(); o[1] = zero16();
#pragma unroll 1
        for (int tt = 0; tt <= 2 * cur0 + 1; ++tt) {
            const int n = tt >> 1;
            if (!((um >> n) & 1ull)) continue;
            const bool bsel = (mymask >> n) & 1ull;
            const int tok0 = 32 * tt;
            const f32x16 s = qk_tile(qf, ksrc, tok0, lane);
            sm_pv(s, hb, [&](int kl) { return bsel && (tok0 + kl <= qpos); }, [&](int dt, int s2) { return vsrc(tok0, dt, s2, lane); }, m, l, o);
        }
        l += __shfl_xor(l, 32);
        const float sc = l > 0.f ? g1 / l : 0.f;
        of_add(ost, lane, o, sc);
    }
    {
        const KSrcBf ksrc{p.kb() + (size_t)((2 * NB + b) * 2 + g) * SEQ * 64};
        const VSrcBfT vsrc{p.vT() + (size_t)((1 * NB + b) * 2 + g) * 64 * SEQ, SEQ};
        float m = -1e30f, l = 0.f; f32x16 o[2]; o[0] = zero16(); o[1] = zero16();
        const int lo = t0 - 511;
        const int nlo = lo > 0 ? (lo >> 6) : 0;
#pragma unroll 1
        for (int tt = 2 * nlo; tt <= 2 * cur0 + 1; ++tt) {
            const int tok0 = 32 * tt;
            const f32x16 s = qk_tile(qf, ksrc, tok0, lane);
            sm_pv(s, hb, [&](int kl) { const int key = tok0 + kl; return key <= qpos && key + 511 >= qpos; }, [&](int dt, int s2) { return vsrc(tok0, dt, s2, lane); }, m, l, o);
        }
        l += __shfl_xor(l, 32);
        const float sc = l > 0.f ? g2 / l : 0.f;
        f32x16 of[2];
        of_get_add(ost, lane, o, sc, of);
        attn_store(p, of, qrow, head, hb, true);
    }
    WAVE_SYNC();
}

template <class RP, class OKF>
__device__ __forceinline__ void f32_tile(const bf16x8 (&qf)[4], RP rp, OKF ok, LAS bf16_t* vt, int lane, float& m, float& l, f32x16 (&o)[2]) {
    const int col = lane & 31, hb = lane >> 5;
    const float* kr = rp(col);
    f32x16 s = zero16();
#pragma unroll
    for (int ks = 0; ks < 4; ++ks) {
        const float4 a = *(const float4*)(kr + 16 * ks + 8 * hb), c = *(const float4*)(kr + 16 * ks + 8 * hb + 4);
        s = mfma32(pack8(a.x, a.y, a.z, a.w, c.x, c.y, c.z, c.w), qf[ks], s);
    }
    const float* vr = kr + 128 + 32 * hb;
#pragma unroll
    for (int j4 = 0; j4 < 8; ++j4) {
        const float4 a = *(const float4*)(vr + 4 * j4);
        vt[(32 * hb + 4 * j4 + 0) * 40 + col] = f2bf(a.x); vt[(32 * hb + 4 * j4 + 1) * 40 + col] = f2bf(a.y);
        vt[(32 * hb + 4 * j4 + 2) * 40 + col] = f2bf(a.z); vt[(32 * hb + 4 * j4 + 3) * 40 + col] = f2bf(a.w);
    }
    WAVE_SYNC();
    sm_pv(s, hb, ok, [&](int dt, int s2) {
        LAS const bf16_t* ptr = vt + (32 * dt + col) * 40 + 16 * s2 + 4 * hb;
        union { uint4 u; bf16x8 v; } x; const u32x2 a = *(LAS const u32x2*)ptr, c = *(LAS const u32x2*)(ptr + 8); x.u.x = a[0]; x.u.y = a[1]; x.u.z = c[0]; x.u.w = c[1]; return x.v; }, m, l, o);
    WAVE_SYNC();
}

__device__ __forceinline__ void attn_sample_item(const P& p, int item, LAS unsigned char* wl, int lane) {
    const int t = item & 7, g = (item >> 3) & 1, b = item >> 4, bg = b * 2 + g;
    const int col = lane & 31, hb = lane >> 5, hh = col & 3;
    const int qpos = PAST + t, qrow = NP + b * 8 + t, head = g * 4 + hh;
    bf16x8 qf[4];
#pragma unroll
    for (int ks = 0; ks < 4; ++ks) qf[ks] = *(const bf16x8*)(p.qb() + (size_t)qrow * 512 + head * 64 + 16 * ks + 8 * hb);
    LAS float* psum = (LAS float*)wl;
    LAS int* list = (LAS int*)(wl + 8256);
    LAS float* impl = (LAS float*)(wl + 8448);
    LAS bf16_t* vt = (LAS bf16_t*)(wl + 9728);
    const float g0 = p.gates()[(size_t)qrow * 32 + head * 3 + 0], g1 = p.gates()[(size_t)qrow * 32 + head * 3 + 1], g2 = p.gates()[(size_t)qrow * 32 + head * 3 + 2];
    f32x16 oc[2]; oc[0] = zero16(); oc[1] = zero16();
    {
        const KSrcBf ksrc{p.kc_s() + (size_t)bg * 1024 * 64};
        const VSrcBfT vsrc{p.vcT_s() + (size_t)bg * 64 * 1024, 1024};
        float m = -1e30f, l = 0.f;
#pragma unroll 1
        for (int kt = 0; kt < 32; ++kt) {
            const f32x16 s = qk_tile(qf, ksrc, 32 * kt, lane);
            sm_stats(s, hb, [&](int kl) { return 32 * kt + kl <= 1022; }, m, l);
        }
        l += __shfl_xor(l, 32);
        const float inv = l > 0.f ? 1.0f / l : 0.f;
#pragma unroll 1
        for (int kt = 0; kt < 32; ++kt) {
            const f32x16 s = qk_tile(qf, ksrc, 32 * kt, lane);
            cmp_pass2(s, hb, [&](int kl) { return 32 * kt + kl <= 1022; }, [&](int dt, int s2) { return vsrc(32 * kt, dt, s2, lane); }, m, inv, oc, psum + 32 * kt, col == 0);
        }
    }
    WAVE_SYNC();
#pragma unroll
    for (int j = 0; j < 5; ++j) {
        const int n = lane + 64 * j;
        if (n <= 256) {
            float imp = 0.f;
            for (int c = -1; c < 4; ++c) { const int cc = 4 * n + c; if (cc >= 0 && cc <= 1022) imp += psum[cc]; }
            impl[n] = imp;
        }
    }
    WAVE_SYNC();
    {
        int base = 0;
#pragma unroll
        for (int j = 0; j < 4; ++j) {
            const int n = lane + 64 * j;
            const bool cand = n >= 1 && n <= 254;
            const float v = impl[n];
            int rank = 0;
            for (int q = 1; q <= 254; ++q) { const float vq = impl[q]; rank += (vq > v || (vq == v && q < n)) ? 1 : 0; }
            const bool sel = cand && rank < 13;
            const unsigned long long mk = __ballot(sel);
            if (sel) list[base + __popcll(mk & ((1ull << lane) - 1ull))] = n;
            base += __popcll(mk);
        }
        if (lane == 0) { list[13] = 0; list[14] = 255; list[15] = 256; }
    }
    WAVE_SYNC();
#if SMODE & 1
    LAS float* ost = (LAS float*)wl;
    of_put(ost, lane, oc, g0);
    {
        float m = -1e30f, l = 0.f; f32x16 o[2]; o[0] = zero16(); o[1] = zero16();
#pragma unroll 1
        for (int li = 0; li < 16; ++li) {
#if SMODE & 4
            const int n = li < 13 ? 17 * li + 5 : (li == 13 ? 0 : 242 + li);
#else
            const int n = __builtin_amdgcn_readfirstlane(list[li]);
#endif
            if (n < 256) {
                const int page = p.page_table[b * 128 + (n >> 1)];
                const float* base = p.cache_sel + ((size_t)page * 128 + (n & 1) * 64) * 256 + g * 64;
#pragma unroll 1
                for (int k2 = 0; k2 < 2; ++k2)
                    f32_tile(qf, [&](int kl) { return base + (size_t)(32 * k2 + kl) * 256; }, [&](int kl) { return true; }, vt, lane, m, l, o);
            } else {
                const float* base = p.out + O_SEL_S + (size_t)(b * 8) * 256 + g * 64;
                f32_tile(qf, [&](int kl) { return base + (size_t)(kl < 8 ? kl : 7) * 256; }, [&](int kl) { return kl <= t; }, vt, lane, m, l, o);
            }
        }
        l += __shfl_xor(l, 32);
        const float sc = l > 0.f ? g1 / l : 0.f;
        of_add(ost, lane, o, sc);
    }
#endif
#if SMODE & 2
    {
        float m = -1e30f, l = 0.f; f32x16 o[2]; o[0] = zero16(); o[1] = zero16();
        const float* cw = p.cache_win + (size_t)b * 512 * 256 + g * 64;
        const float* nw = p.out + O_WIN_S + ((size_t)b * 512 + 504) * 256 + g * 64;
#pragma unroll 1
        for (int kt = 0; kt < 17; ++kt) {
            f32_tile(qf, [&](int kl) { const int j = 32 * kt + kl; return j < 512 ? cw + (size_t)j * 256 : nw + (size_t)(j - 512 < 8 ? j - 512 : 7) * 256; },
                     [&](int kl) { const int j = 32 * kt + kl; return j >= t + 1 && j <= 512 + t; }, vt, lane, m, l, o);
        }
        l += __shfl_xor(l, 32);
        const float sc = l > 0.f ? g2 / l : 0.f;
        f32x16 of[2];
        of_get_add(ost, lane, o, sc, of);
        attn_store(p, of, qrow, head, hb, col < 4);
    }
    WAVE_SYNC();
#endif
}

__device__ __forceinline__ void ph_attn(const P& p, LAS unsigned char* lds) {
    const int tid = threadIdx.x, lane = tid & 63, wid = tid >> 6;
    LAS unsigned char* wl = lds + wid * 16384;
    const int gw = blockIdx.x * 8 + wid, nw = gridDim.x * 8;
#if ATTN_MODE & 2
    for (int it = gw; it < 512; it += nw) attn_sample_item(p, it, wl, lane);
#endif
#if ATTN_MODE & 1
    for (int it = gw; it < 2048; it += nw) { attn_prompt_item(p, it, wl, lane); attn_prompt_item(p, 4095 - it, wl, lane); }
#endif
}
#ifndef STOP_AFTER
#define STOP_AFTER 3
#endif

constexpr int LDS_BYTES = pg8::STAGE_BYTES;

template <class Epi> __global__ __launch_bounds__(512, 2) void k_gemm(pg8::Gemm g, Epi E) {
    extern __shared__ __attribute__((aligned(16))) unsigned char shm[];
    pg8::StaticOrder S; S.init(g.M, g.N, (int)gridDim.x, (int)blockIdx.x);
    pg8::gemm_phase<Epi, pg8::StaticOrder, false>((PG8_LAS unsigned char*)shm, g, S, E, nullptr);
}
template <int PH> __global__ __launch_bounds__(512, 2) void k_phase(P p) {
    extern __shared__ __attribute__((aligned(16))) unsigned char shm[];
    LAS unsigned char* lds = (LAS unsigned char*)shm;
    if constexpr (PH == 0) ph_prep(p);
    if constexpr (PH == 1) ph_compress2(p, p.LHp(), 8, 256, 255, p.kc_p(), p.vcT_p(), (LAS float*)lds);
    if constexpr (PH == 2) ph_cvt_cache(p);
    if constexpr (PH == 3) ph_compress2(p, p.LHs(), 64, 1024, 1023, p.kc_s(), p.vcT_s(), (LAS float*)lds);
    if constexpr (PH == 4) ph_rwkv_prep(p);
    if constexpr (PH == 5) ph_rwkv_scan(p, (LAS float*)lds);
    if constexpr (PH == 6) ph_rwkv_post(p);
    if constexpr (PH == 7) ph_attn(p, lds);
    if constexpr (PH == 8) ph_final(p);
}

template <class Epi> static void launch_gemm(hipStream_t st, const bf16_t* A, const bf16_t* Bt, int M, int N, int K, const Epi& E) {
    static bool attr = false;
    if (!attr) { (void)hipFuncSetAttribute((const void*)k_gemm<Epi>, hipFuncAttributeMaxDynamicSharedMemorySize, LDS_BYTES); attr = true; }
    pg8::Gemm g{}; g.A = A; g.Bt = Bt; g.M = M; g.N = N; g.K = K;
    hipLaunchKernelGGL((k_gemm<Epi>), dim3(256), dim3(512), LDS_BYTES, st, g, E);
}
template <int PH> static void launch_phase(hipStream_t st, const P& p) {
    static bool attr = false;
    if (!attr) { (void)hipFuncSetAttribute((const void*)k_phase<PH>, hipFuncAttributeMaxDynamicSharedMemorySize, LDS_BYTES); attr = true; }
    hipLaunchKernelGGL((k_phase<PH>), dim3(256), dim3(512), LDS_BYTES, st, p);
}


constexpr int FUSED_LDS = LDS_BYTES + 256;

template <class Epi> __device__ __forceinline__ void run_gemm(LAS unsigned char* lds, const bf16_t* A, const bf16_t* Bt, int M, int N, int K, const Epi& E) {
    pg8::Gemm g; g.A = A; g.Bt = Bt; g.M = M; g.N = N; g.K = K; g.pad_ = 0;
    pg8::StaticOrder S; S.init(M, N, (int)gridDim.x, (int)blockIdx.x);
    pg8::gemm_phase<Epi, pg8::StaticOrder, false>((PG8_LAS unsigned char*)lds, g, S, E, nullptr);
}

__global__ __launch_bounds__(512, 2) void k_fused(P p) {
    extern __shared__ __attribute__((aligned(16))) unsigned char shm[];
    LAS unsigned char* lds = (LAS unsigned char*)shm;
    LAS unsigned* xb = (LAS unsigned*)(lds + LDS_BYTES);
    if (threadIdx.x == 0) { xb[0] = 0u; xb[1] = 0u; xb[2] = 0u; xb[3] = 0u; }
    __syncthreads();
    XcdBarrier bar = xcd_barrier_post(p.bar(), (volatile LAS unsigned*)xb);
    ph_prep(p);
    xcd_barrier(bar);
    { EpiIn e; e.p = p; run_gemm(lds, p.hb(), p.WinT(), MR, NPAD, DM, e); }
    xcd_barrier(bar);
    { EpiPlain e; e.C = p.LHp(); e.ldc = 256; e.pad_ = 0; run_gemm(lds, p.kb(), p.W1T(), 2048, 256, 1024, e); }
    { EpiPlain e; e.C = p.LHp() + (size_t)2048 * 256; e.ldc = 256; e.pad_ = 0; run_gemm(lds, p.vcr(), p.W1T() + (size_t)256 * 1024, 2048, 256, 1024, e); }
    ph_cvt_cache(p);
    ph_rwkv_prep(p);
    xcd_barrier(bar);
    ph_compress2(p, p.LHp(), 8, 256, 255, p.kc_p(), p.vcT_p(), (LAS float*)lds);
    __syncthreads();
    { EpiPlain e; e.C = p.LHs(); e.ldc = 256; e.pad_ = 0; run_gemm(lds, p.cs(), p.W1T(), 65536, 256, 1024, e); }
    { EpiPlain e; e.C = p.LHs() + (size_t)65536 * 256; e.ldc = 256; e.pad_ = 0; run_gemm(lds, p.cs() + (size_t)65536 * 1024, p.W1T() + (size_t)256 * 1024, 65536, 256, 1024, e); }
    __syncthreads();
    ph_rwkv_scan(p, (LAS float*)lds);
    xcd_barrier(bar);
    ph_compress2(p, p.LHs(), 64, 1024, 1023, p.kc_s(), p.vcT_s(), (LAS float*)lds);
    ph_rwkv_post(p);
    xcd_barrier(bar);
    ph_attn(p, lds);
    xcd_barrier(bar);
    { EpiYa e; e.p = p; run_gemm(lds, p.oa(), p.WpaT(), MR, DM, 512, e); }
    { EpiYb e; e.p = p; run_gemm(lds, p.ob(), p.WpbT(), MR, DM, 512, e); }
    xcd_barrier(bar);
    { EpiOut e; e.p = p; run_gemm(lds, p.mb(), p.WoutT(), MR, DM, DM, e); }
    { EpiPlain e; e.C = p.pp(); e.ldc = DM; e.pad_ = 0; run_gemm(lds, p.pb(), p.WprojT(), MR, DM, 256, e); }
    xcd_barrier(bar);
    { EpiGate e; e.p = p; run_gemm(lds, p.xg(), p.WgateT(), MR, DM, DM, e); }
    xcd_barrier(bar);
    ph_final(p);
}
extern "C" void kernel_launch(void* const* d_in, const int* in_sizes, int n_in, void* d_out, int out_size, void* d_ws, size_t ws_size, hipStream_t stream) {
    (void)in_sizes; (void)n_in; (void)out_size; (void)ws_size;
    P p{};
    p.x_prompt = (const float*)d_in[0]; p.x_sample = (const float*)d_in[1]; p.p_prompt = (const float*)d_in[2]; p.p_sample = (const float*)d_in[3];
    p.cache_cmp = (const float*)d_in[4]; p.cache_sel = (const float*)d_in[5]; p.cache_win = (const float*)d_in[6]; p.state_wkv = (const float*)d_in[7];
    p.state_shift = (const float*)d_in[8]; p.page_table = (const int*)d_in[9]; p.norm_g = (const float*)d_in[10]; p.w_in = (const float*)d_in[11];
    p.cmp_pe = (const float*)d_in[12]; p.cmp_w1 = (const float*)d_in[13]; p.cmp_b1 = (const float*)d_in[14]; p.cmp_w2 = (const float*)d_in[15]; p.cmp_b2 = (const float*)d_in[16];
    p.w_pa = (const float*)d_in[17]; p.mu = (const float*)d_in[18]; p.w0 = (const float*)d_in[19]; p.w_up = (const float*)d_in[20]; p.a0 = (const float*)d_in[21];
    p.a_up = (const float*)d_in[22]; p.k_k = (const float*)d_in[23]; p.k_a = (const float*)d_in[24]; p.r_k = (const float*)d_in[25]; p.gn_g = (const float*)d_in[26];
    p.gn_b = (const float*)d_in[27]; p.w_pb = (const float*)d_in[28]; p.w_out = (const float*)d_in[29]; p.ple_g = (const float*)d_in[30]; p.w_gate = (const float*)d_in[31];
    p.w_proj = (const float*)d_in[32]; p.final_g = (const float*)d_in[33];
    p.out = (float*)d_out;
    p.ws = (unsigned char*)d_ws;

#if defined(MULTI_LAUNCH)
    launch_phase<0>(stream, p);
    { EpiIn e{}; e.p = p; launch_gemm(stream, p.hb(), p.WinT(), MR, NPAD, DM, e); }
#if STOP_AFTER >= 3
    { EpiPlain e{}; e.C = p.LHp(); e.ldc = 256; launch_gemm(stream, p.kb(), p.W1T(), 2048, 256, 1024, e); }
    { EpiPlain e{}; e.C = p.LHp() + (size_t)2048 * 256; e.ldc = 256; launch_gemm(stream, p.vcr(), p.W1T() + (size_t)256 * 1024, 2048, 256, 1024, e); }
    launch_phase<1>(stream, p);
    launch_phase<2>(stream, p);
    { EpiPlain e{}; e.C = p.LHs(); e.ldc = 256; launch_gemm(stream, p.cs(), p.W1T(), 65536, 256, 1024, e); }
    { EpiPlain e{}; e.C = p.LHs() + (size_t)65536 * 256; e.ldc = 256; launch_gemm(stream, p.cs() + (size_t)65536 * 1024, p.W1T() + (size_t)256 * 1024, 65536, 256, 1024, e); }
    launch_phase<3>(stream, p);
#endif
#if STOP_AFTER >= 2
    launch_phase<4>(stream, p);
    launch_phase<5>(stream, p);
    launch_phase<6>(stream, p);
#endif
    hipMemsetAsync(p.oa(), 0, (size_t)MR * 512 * 2, stream);
#if STOP_AFTER >= 3
    launch_phase<7>(stream, p);
#endif
    { EpiYa e{}; e.p = p; launch_gemm(stream, p.oa(), p.WpaT(), MR, DM, 512, e); }
    { EpiYb e{}; e.p = p; launch_gemm(stream, p.ob(), p.WpbT(), MR, DM, 512, e); }
    { EpiOut e{}; e.p = p; launch_gemm(stream, p.mb(), p.WoutT(), MR, DM, DM, e); }
    { EpiPlain e{}; e.C = p.pp(); e.ldc = DM; launch_gemm(stream, p.pb(), p.WprojT(), MR, DM, 256, e); }
    { EpiGate e{}; e.p = p; launch_gemm(stream, p.xg(), p.WgateT(), MR, DM, DM, e); }
    launch_phase<8>(stream, p);
#else
    static int grid = 0;
    if (!grid) {
        int dev = 0, cus = 0, per_cu = 0;
        (void)hipGetDevice(&dev);
        (void)hipDeviceGetAttribute(&cus, hipDeviceAttributeMultiprocessorCount, dev);
        (void)hipFuncSetAttribute((const void*)k_fused, hipFuncAttributeMaxDynamicSharedMemorySize, FUSED_LDS);
        (void)hipOccupancyMaxActiveBlocksPerMultiprocessor(&per_cu, k_fused, 512, FUSED_LDS);
        grid = per_cu >= 1 ? cus : 0;
        if (grid > 256) grid = 256;
    }
    (void)hipMemsetAsync(p.bar(), 0, XCD_BAR_WORDS * sizeof(unsigned), stream);
    if (grid > 0) hipLaunchKernelGGL(k_fused, dim3(grid), dim3(512), FUSED_LDS, stream, p);
#endif
}
```

```cpp
#include <hip/hip_runtime.h>
#include <stdint.h>
#include <stdio.h>
namespace pg8 {
#define PG8_LAS __attribute__((address_space(3)))
typedef unsigned short bf16_t;
typedef short bf16x8 __attribute__((ext_vector_type(8)));
typedef float f32x4 __attribute__((ext_vector_type(4)));
typedef unsigned u32x4 __attribute__((ext_vector_type(4)));
constexpr int BM = 256, BK = 64, HALF = 128, HTB = HALF * BK * 2  , STAGE_BYTES = 8 * HTB, NXCD = 8, WGM = 8;

__host__ __device__ __forceinline__ int lds_byte(int r, int c) { const int st = (r >> 4) * 2 + (c >> 5), rr = r & 15, cc = c & 31, ob = rr * 64 + cc * 2; return st * 1024 + (ob ^ (((ob >> 9) & 1) << 5)); }
__host__ __device__ __forceinline__ void stage_rc(int b, int& R, int& C) { const int st = b / 1024, sb = b % 1024, swz = sb ^ (((sb >> 9) & 1) << 5); R = (st >> 1) * 16 + swz / 64; C = (st & 1) * 32 + (swz % 64) / 2; }
__host__ __device__ __forceinline__ int perm32(int rho) { const int n = rho >> 4, i = rho & 15; return 8 * (i >> 2) + 4 * n + (i & 3); }

struct Unit { int pm, pn; };
struct Gemm { const bf16_t* A; const bf16_t* Bt; int M, N, K, pad_; };

struct StaticOrder {
    int nM, nN, nwg, G, c;
    __host__ __device__ void init(int M, int N, int G_, int c_) { nM = M / BM; nN = N / BM; nwg = nM * nN; G = G_; c = c_; }
    __host__ __device__ bool next(int i, Unit& u) const {
        const long L = (long)i * G + c; if (L >= nwg) return false;
        int wgid = (int)L; { const int q = nwg / NXCD, r = nwg % NXCD, xcd = wgid % NXCD, off = wgid / NXCD; wgid = (xcd < r ? xcd * (q + 1) : r * (q + 1) + (xcd - r) * q) + off; }
        const int nig = WGM * nN, gid = wgid / nig, fm = gid * WGM, gsz = (nM - fm) < WGM ? (nM - fm) : WGM;
        u.pm = fm + ((wgid % nig) % gsz); u.pn = (wgid % nig) / gsz; return true;
    }
    __device__ __forceinline__ void a_ready(const Unit&) const {}
    __device__ __forceinline__ void done(const Unit&) const {}
};
__device__ __forceinline__ unsigned cvt_pk_bf16(float lo, float hi) { unsigned r; asm volatile("v_cvt_pk_bf16_f32 %0, %1, %2" : "=v"(r) : "v"(lo), "v"(hi)); return r; }
typedef float f32x2 __attribute__((ext_vector_type(2)));
template <class Epi, class Sched, bool STAMP = false>
__device__ __forceinline__ void gemm_phase(PG8_LAS unsigned char* lds, const Gemm g, const Sched& S, const Epi& E, unsigned long long* stamps) {
    int tid_l = threadIdx.x; asm volatile("" : "+v"(tid_l));
    const int tid = tid_l, wid = __builtin_amdgcn_readfirstlane(tid >> 6), lane = tid & 63, wr = wid >> 2, wc = wid & 3, fr = lane & 15, fq = lane >> 4;
    const int K = g.K, nt = K / BK;
    int ts_lo = 0, ts_hi = 0, nts = 0; const unsigned long long rt_entry = STAMP ? (unsigned long long)wall_clock64() : 0ull;
#define PG8_STAMP() do { if (STAMP && wid == 0 && nts < 64) { const unsigned long long _c = (unsigned long long)clock64(); \
        ts_lo = (lane == nts) ? (int)(unsigned)_c : ts_lo; ts_hi = (lane == nts) ? (int)(unsigned)(_c >> 32) : ts_hi; ++nts; } } while (0)
    PG8_STAMP();
    unsigned voffA[2], voffB[2];
#pragma unroll
    for (int i = 0; i < 2; ++i) { int R, C; stage_rc(tid * 16 + i * 8192, R, C); const int Rb = Epi::PERM ? ((R & ~31) + perm32(R & 31)) : R;
        voffA[i] = (unsigned)(R * K + C) * 2u; voffB[i] = (unsigned)(Rb * K + C) * 2u; }
    const size_t kstep = (size_t)(BK * 2);
    const size_t hstep = (size_t)HALF * K * 2;
    const size_t tstep = 2 * hstep;
    const unsigned ldsw = (unsigned)wid * 1024u;
    const int aoff = lds_byte(wr * 64 + fr, fq * 8), boff = lds_byte(wc * 32 + fr, fq * 8);
#define PG8_SA(b, h) (((b) * 2 + (h)) * HTB)
#define PG8_SB(b, h) ((4 + (b) * 2 + (h)) * HTB)
#define PG8_STAGE(bufoff, gbase, voff) do { _Pragma("unroll") for (int _i = 0; _i < 2; ++_i) \
        __builtin_amdgcn_global_load_lds((const unsigned*)((const char*)(gbase) + (voff)[_i]), (PG8_LAS unsigned*)(lds + (bufoff) + ldsw + _i * 8192), 16, 0, 0); } while (0)
#define PG8_LDA(dst, b, h) do { _Pragma("unroll") for (int m = 0; m < 4; ++m) _Pragma("unroll") for (int k = 0; k < 2; ++k) dst[m][k] = *(const PG8_LAS bf16x8*)(lds + PG8_SA(b, h) + aoff + m * 2048 + k * 1024); } while (0)
#define PG8_LDB(dst, b, h) do { _Pragma("unroll") for (int n = 0; n < 2; ++n) _Pragma("unroll") for (int k = 0; k < 2; ++k) dst[n][k] = *(const PG8_LAS bf16x8*)(lds + PG8_SB(b, h) + boff + n * 2048 + k * 1024); } while (0)
#define PG8_MMA(ai, bj, At, Bt) do { __builtin_amdgcn_s_setprio(1); _Pragma("unroll") for (int m = 0; m < 4; ++m) _Pragma("unroll") for (int n = 0; n < 2; ++n) _Pragma("unroll") for (int k = 0; k < 2; ++k) \
        acc[ai][bj][m][n] = __builtin_amdgcn_mfma_f32_16x16x32_bf16(Bt[n][k], At[m][k], acc[ai][bj][m][n], 0, 0, 0); __builtin_amdgcn_s_setprio(0); } while (0)
#define PG8_WAIT_V(n) asm volatile("s_waitcnt vmcnt(" #n ")" ::: "memory")
#define PG8_WAIT_L(n) asm volatile("s_waitcnt lgkmcnt(" #n ")" ::: "memory")
#define PG8_BAR __builtin_amdgcn_s_barrier()
#define PG8_SCHED __builtin_amdgcn_sched_barrier(0)
    Unit cur, nxt; int ui = 0;
    if (!S.next(0, cur)) return;
    f32x4 acc[2][2][4][2];
#pragma unroll
    for (int a = 0; a < 2; ++a)
#pragma unroll
        for (int b = 0; b < 2; ++b)
#pragma unroll
            for (int m = 0; m < 4; ++m)
#pragma unroll
                for (int n = 0; n < 2; ++n) acc[a][b][m][n] = (f32x4){0.f, 0.f, 0.f, 0.f};
    bf16x8 At[4][2], B0[2][2], B1[2][2];
    const char* cA = (const char*)g.A + (size_t)cur.pm * tstep; const char* cB = (const char*)g.Bt + (size_t)cur.pn * tstep;
    S.a_ready(cur);
    PG8_STAGE(PG8_SB(0, 0), cB, voffB); PG8_STAGE(PG8_SA(0, 0), cA, voffA); PG8_STAGE(PG8_SB(0, 1), cB + hstep, voffB); PG8_STAGE(PG8_SA(0, 1), cA + hstep, voffA);
    if (wr == 1) PG8_BAR;
    PG8_WAIT_V(4); PG8_BAR;
    PG8_STAGE(PG8_SB(1, 0), cB + kstep, voffB); PG8_STAGE(PG8_SA(1, 0), cA + kstep, voffA); PG8_STAGE(PG8_SB(1, 1), cB + hstep + kstep, voffB);
    PG8_WAIT_V(6); PG8_BAR;
    PG8_STAMP();
    for (;;) {
        const bool has_next = S.next(ui + 1, nxt);
        const char* nA = has_next ? (const char*)g.A + (size_t)nxt.pm * tstep : cA; const char* nB = has_next ? (const char*)g.Bt + (size_t)nxt.pn * tstep : cB;
        for (int t = 0; t < nt; t += 2) {
            const bool last = (t == nt - 2);
            const char* a1 = cA + (size_t)(t + 1) * kstep;
            const char* a2 = last ? nA : cA + (size_t)(t + 2) * kstep; const char* b2 = last ? nB : cB + (size_t)(t + 2) * kstep;
            const char* a3 = a2 + kstep; const char* b3 = b2 + kstep;
            if (last && has_next) S.a_ready(nxt);
            PG8_LDB(B0, 0, 0); PG8_SCHED; PG8_LDA(At, 0, 0); PG8_STAGE(PG8_SA(1, 1), a1 + hstep, voffA);
            PG8_WAIT_L(8); PG8_BAR; PG8_WAIT_L(0); PG8_MMA(0, 0, At, B0); PG8_BAR; PG8_SCHED;
            PG8_LDB(B1, 0, 1); PG8_STAGE(PG8_SB(0, 0), b2, voffB);
            PG8_BAR; PG8_WAIT_L(0); PG8_MMA(0, 1, At, B1); PG8_BAR;
            PG8_LDA(At, 0, 1); PG8_STAGE(PG8_SA(0, 0), a2, voffA);
            PG8_BAR; PG8_WAIT_L(0); PG8_MMA(1, 0, At, B0); PG8_BAR; PG8_SCHED;
            PG8_STAGE(PG8_SB(0, 1), b2 + hstep, voffB);
            PG8_WAIT_V(6); PG8_BAR; PG8_MMA(1, 1, At, B1); PG8_BAR;
            PG8_LDB(B0, 1, 0); PG8_SCHED; PG8_LDA(At, 1, 0); PG8_STAGE(PG8_SA(0, 1), a2 + hstep, voffA);
            PG8_WAIT_L(8); PG8_BAR; PG8_WAIT_L(0); PG8_MMA(0, 0, At, B0); PG8_BAR; PG8_SCHED;
            PG8_LDB(B1, 1, 1); PG8_STAGE(PG8_SB(1, 0), b3, voffB);
            PG8_BAR; PG8_WAIT_L(0); PG8_MMA(0, 1, At, B1); PG8_BAR;
            PG8_LDA(At, 1, 1); PG8_STAGE(PG8_SA(1, 0), a3, voffA);
            PG8_BAR; PG8_WAIT_L(0); PG8_MMA(1, 0, At, B0); PG8_BAR; PG8_SCHED;
            PG8_STAGE(PG8_SB(1, 1), b3 + hstep, voffB);
            PG8_WAIT_V(6); PG8_BAR; PG8_MMA(1, 1, At, B1); PG8_BAR;
        }
        PG8_STAMP();
        if constexpr (!Epi::AFTER_DRAIN) { E(acc, cur, wr, wc, fr, fq); S.done(cur); }
        PG8_STAMP();
        if (!has_next) break;
#pragma unroll
        for (int a = 0; a < 2; ++a)
#pragma unroll
            for (int b = 0; b < 2; ++b)
#pragma unroll
                for (int m = 0; m < 4; ++m)
#pragma unroll
                    for (int n = 0; n < 2; ++n) acc[a][b][m][n] = (f32x4){0.f, 0.f, 0.f, 0.f};
        cur = nxt; cA = nA; cB = nB; ++ui;
    }
    PG8_WAIT_V(0);
    if (wr == 0) PG8_BAR;
    PG8_BAR;
    if constexpr (Epi::AFTER_DRAIN) { E.fused(acc, cur, wr, wc, fr, fq, lds, wid, lane); S.done(cur); }
    PG8_STAMP();
    if (STAMP && wid == 0) { stamps[lane] = lane < nts ? (((unsigned long long)(unsigned)ts_hi << 32) | (unsigned)ts_lo) : 0ull;
        if (lane == 62) stamps[62] = rt_entry; if (lane == 63) stamps[63] = (unsigned long long)wall_clock64(); }
#undef PG8_STAMP
#undef PG8_SA
#undef PG8_SB
#undef PG8_STAGE
#undef PG8_LDA
#undef PG8_LDB
#undef PG8_MMA
#undef PG8_WAIT_V
#undef PG8_WAIT_L
#undef PG8_BAR
#undef PG8_SCHED
}
}

typedef unsigned short bf16_t;
typedef short bf16x8 __attribute__((ext_vector_type(8)));
typedef float f32x4 __attribute__((ext_vector_type(4)));
typedef float f32x16 __attribute__((ext_vector_type(16)));
#define LAS __attribute__((address_space(3)))
#define WAVE_SYNC() do { asm volatile("s_waitcnt lgkmcnt(0)" ::: "memory"); __builtin_amdgcn_wave_barrier(); } while (0)

constexpr int DM = 1024, NP = 16384, NSMP = 256, MR = 16640, SEQ = 4096, NB = 4, DB = 32, DS = 8, PAST = 16384;
constexpr int CIN = 6040, NPAD = 6144, CR = 1664;
constexpr int NTHR = 512;
constexpr size_t O_Y_P = 0, O_Y_S = 16777216, O_CMP_P = 17039360, O_CMP_S = 21233664, O_SEL_P = 21299200, O_SEL_S = 25493504,
                 O_WIN_P = 25559040, O_WIN_S = 26083328, O_WKV_P = 30277632, O_WKV_S = 30408704, O_SH_P = 31457280, O_SH_S = 31463936;

constexpr size_t ws_al(size_t x) { return (x + 255) & ~(size_t)255; }
constexpr size_t WS_bar = 0;
constexpr size_t WS_hb = WS_bar + ws_al(16384);
constexpr size_t WS_WinT = WS_hb + ws_al((size_t)MR * DM * 2);
constexpr size_t WS_WpaT = WS_WinT + ws_al((size_t)NPAD * DM * 2);
constexpr size_t WS_WpbT = WS_WpaT + ws_al((size_t)DM * 512 * 2);
constexpr size_t WS_WoutT = WS_WpbT + ws_al((size_t)DM * 512 * 2);
constexpr size_t WS_WgateT = WS_WoutT + ws_al((size_t)DM * DM * 2);
constexpr size_t WS_WprojT = WS_WgateT + ws_al((size_t)DM * DM * 2);
constexpr size_t WS_W1T = WS_WprojT + ws_al((size_t)DM * 256 * 2);
constexpr size_t WS_pb = WS_W1T + ws_al((size_t)512 * 1024 * 2);
constexpr size_t WS_tabc = WS_pb + ws_al((size_t)MR * 256 * 2);
constexpr size_t WS_tabs = WS_tabc + ws_al((size_t)4104 * 32 * 4);
constexpr size_t WS_pt = WS_tabs + ws_al((size_t)4104 * 32 * 4);
constexpr size_t WS_qb = WS_pt + ws_al(256 * 4);
constexpr size_t WS_kb = WS_qb + ws_al((size_t)MR * 512 * 2);
constexpr size_t WS_vcr = WS_kb + ws_al((size_t)3 * NB * 2 * SEQ * 64 * 2);
constexpr size_t WS_vT = WS_vcr + ws_al((size_t)NB * 2 * SEQ * 64 * 2);
constexpr size_t WS_ag = WS_vT + ws_al((size_t)2 * NB * 2 * 64 * SEQ * 2);
constexpr size_t WS_rg = WS_ag + ws_al((size_t)MR * 512 * 2);
constexpr size_t WS_mg = WS_rg + ws_al((size_t)MR * 512 * 2);
constexpr size_t WS_gates = WS_mg + ws_al((size_t)MR * 2048 * 2);
constexpr size_t WS_rz = WS_gates + ws_al((size_t)MR * 32 * 4);
constexpr size_t WS_LHp = WS_rz + ws_al((size_t)MR * CR * 4);
constexpr size_t WS_LHs = WS_LHp + ws_al((size_t)2 * 2048 * 256 * 4);
constexpr size_t WS_cs = WS_LHs + ws_al((size_t)2 * 65536 * 256 * 4);
constexpr size_t WS_kc_p = WS_cs + ws_al((size_t)2 * 65536 * 1024 * 2);
constexpr size_t WS_vcT_p = WS_kc_p + ws_al((size_t)8 * 256 * 64 * 2);
constexpr size_t WS_kc_s = WS_vcT_p + ws_al((size_t)8 * 64 * 256 * 2);
constexpr size_t WS_vcT_s = WS_kc_s + ws_al((size_t)64 * 1024 * 64 * 2);
constexpr size_t WS_rw6 = WS_vcT_s + ws_al((size_t)64 * 64 * 1024 * 2);
constexpr size_t WS_bonus = WS_rw6 + ws_al((size_t)MR * 8 * 384 * 4);
constexpr size_t WS_ybuf = WS_bonus + ws_al((size_t)MR * 8 * 4);
constexpr size_t WS_oa = WS_ybuf + ws_al((size_t)MR * 512 * 4);
constexpr size_t WS_ob = WS_oa + ws_al((size_t)MR * 512 * 2);
constexpr size_t WS_mb = WS_ob + ws_al((size_t)MR * 512 * 2);
constexpr size_t WS_xg = WS_mb + ws_al((size_t)MR * DM * 2);
constexpr size_t WS_tmp = WS_xg + ws_al((size_t)MR * DM * 2);
constexpr size_t WS_x1 = WS_tmp + ws_al((size_t)MR * DM * 4);
constexpr size_t WS_ss1 = WS_x1 + ws_al((size_t)MR * DM * 4);
constexpr size_t WS_pp = WS_ss1 + ws_al((size_t)MR * 16 * 4);
constexpr size_t WS_TOTAL = WS_pp + ws_al((size_t)MR * DM * 4);

struct P {
    const float *x_prompt, *x_sample, *p_prompt, *p_sample, *cache_cmp, *cache_sel, *cache_win, *state_wkv, *state_shift;
    const int* page_table;
    const float *norm_g, *w_in, *cmp_pe, *cmp_w1, *cmp_b1, *cmp_w2, *cmp_b2, *w_pa, *mu, *w0, *w_up, *a0, *a_up, *k_k, *k_a, *r_k, *gn_g, *gn_b,
        *w_pb, *w_out, *ple_g, *w_gate, *w_proj, *final_g;
    float* out;
    unsigned char* ws;
    __host__ __device__ __forceinline__ unsigned* bar() const { return (unsigned*)(ws + WS_bar); }
    __host__ __device__ __forceinline__ bf16_t* hb() const { return (bf16_t*)(ws + WS_hb); }
    __host__ __device__ __forceinline__ bf16_t* WinT() const { return (bf16_t*)(ws + WS_WinT); }
    __host__ __device__ __forceinline__ bf16_t* WpaT() const { return (bf16_t*)(ws + WS_WpaT); }
    __host__ __device__ __forceinline__ bf16_t* WpbT() const { return (bf16_t*)(ws + WS_WpbT); }
    __host__ __device__ __forceinline__ bf16_t* WoutT() const { return (bf16_t*)(ws + WS_WoutT); }
    __host__ __device__ __forceinline__ bf16_t* WgateT() const { return (bf16_t*)(ws + WS_WgateT); }
    __host__ __device__ __forceinline__ bf16_t* WprojT() const { return (bf16_t*)(ws + WS_WprojT); }
    __host__ __device__ __forceinline__ bf16_t* W1T() const { return (bf16_t*)(ws + WS_W1T); }
    __host__ __device__ __forceinline__ bf16_t* pb() const { return (bf16_t*)(ws + WS_pb); }
    __host__ __device__ __forceinline__ float* tabc() const { return (float*)(ws + WS_tabc); }
    __host__ __device__ __forceinline__ float* tabs() const { return (float*)(ws + WS_tabs); }
    __host__ __device__ __forceinline__ float* pt() const { return (float*)(ws + WS_pt); }
    __host__ __device__ __forceinline__ bf16_t* qb() const { return (bf16_t*)(ws + WS_qb); }
    __host__ __device__ __forceinline__ bf16_t* kb() const { return (bf16_t*)(ws + WS_kb); }
    __host__ __device__ __forceinline__ bf16_t* vcr() const { return (bf16_t*)(ws + WS_vcr); }
    __host__ __device__ __forceinline__ bf16_t* vT() const { return (bf16_t*)(ws + WS_vT); }
    __host__ __device__ __forceinline__ bf16_t* ag() const { return (bf16_t*)(ws + WS_ag); }
    __host__ __device__ __forceinline__ bf16_t* rg() const { return (bf16_t*)(ws + WS_rg); }
    __host__ __device__ __forceinline__ bf16_t* mg() const { return (bf16_t*)(ws + WS_mg); }
    __host__ __device__ __forceinline__ float* gates() const { return (float*)(ws + WS_gates); }
    __host__ __device__ __forceinline__ float* rz() const { return (float*)(ws + WS_rz); }
    __host__ __device__ __forceinline__ float* LHp() const { return (float*)(ws + WS_LHp); }
    __host__ __device__ __forceinline__ float* LHs() const { return (float*)(ws + WS_LHs); }
    __host__ __device__ __forceinline__ bf16_t* cs() const { return (bf16_t*)(ws + WS_cs); }
    __host__ __device__ __forceinline__ bf16_t* kc_p() const { return (bf16_t*)(ws + WS_kc_p); }
    __host__ __device__ __forceinline__ bf16_t* vcT_p() const { return (bf16_t*)(ws + WS_vcT_p); }
    __host__ __device__ __forceinline__ bf16_t* kc_s() const { return (bf16_t*)(ws + WS_kc_s); }
    __host__ __device__ __forceinline__ bf16_t* vcT_s() const { return (bf16_t*)(ws + WS_vcT_s); }
    __host__ __device__ __forceinline__ float* rw6() const { return (float*)(ws + WS_rw6); }
    __host__ __device__ __forceinline__ float* bonus() const { return (float*)(ws + WS_bonus); }
    __host__ __device__ __forceinline__ float* ybuf() const { return (float*)(ws + WS_ybuf); }
    __host__ __device__ __forceinline__ bf16_t* oa() const { return (bf16_t*)(ws + WS_oa); }
    __host__ __device__ __forceinline__ bf16_t* ob() const { return (bf16_t*)(ws + WS_ob); }
    __host__ __device__ __forceinline__ bf16_t* mb() const { return (bf16_t*)(ws + WS_mb); }
    __host__ __device__ __forceinline__ bf16_t* xg() const { return (bf16_t*)(ws + WS_xg); }
    __host__ __device__ __forceinline__ float* tmp() const { return (float*)(ws + WS_tmp); }
    __host__ __device__ __forceinline__ float* x1() const { return (float*)(ws + WS_x1); }
    __host__ __device__ __forceinline__ float* ss1() const { return (float*)(ws + WS_ss1); }
    __host__ __device__ __forceinline__ float* pp() const { return (float*)(ws + WS_pp); }
};

__device__ __forceinline__ bf16_t f2bf(float f) { unsigned u = __float_as_uint(f); u += 0x7FFFu + ((u >> 16) & 1u); return (bf16_t)(u >> 16); }
__device__ __forceinline__ float bf2f(bf16_t b) { return __uint_as_float(((unsigned)b) << 16); }
typedef __bf16 bf16v2_t __attribute__((ext_vector_type(2)));
typedef float f32x2_t __attribute__((ext_vector_type(2)));
__device__ __forceinline__ unsigned pk2(float lo, float hi) { const f32x2_t v = {lo, hi}; return __builtin_bit_cast(unsigned, __builtin_convertvector(v, bf16v2_t)); }
__device__ __forceinline__ float wave_sum(float v) {
#pragma unroll
    for (int o = 32; o >= 1; o >>= 1) v += __shfl_xor(v, o);
    return v;
}
__device__ __forceinline__ float sigmoidf_(float x) { return 1.0f / (1.0f + __expf(-x)); }
__device__ __forceinline__ float siluf_(float x) { return x / (1.0f + __expf(-x)); }

__device__ __forceinline__ int win_src_col(int np) {
    const int pn = np >> 8, p = np & 255;
    if (pn < 5) {
        const int bj = p >> 7, wc = (p >> 5) & 3, n = (p >> 4) & 1, fq = (p >> 2) & 3, e = p & 3;
        const int d = 32 * n + 16 * (wc & 1) + 4 * fq + e;
        if (pn < 2) { const int head = pn * 4 + bj * 2 + (wc >> 1); return head * 64 + d; }
        const int br = pn - 2, g = wc >> 1;
        return 512 + br * 256 + bj * 128 + g * 64 + d;
    }
    if (pn < 7) return 1304 + (pn - 5) * 256 + p;
    if (pn < 13) return 1816 + (pn - 7) * 256 + p;
    if (pn == 13) { if (p < 128) return 1816 + 1536 + p; if (p < 152) return 1280 + (p - 128); return -1; }
    if (pn < 16) return 3480 + (pn - 14) * 256 + p;
    return 3992 + (pn - 16) * 256 + p;
}

template <class F>
__device__ __forceinline__ void transpose_cvt(bf16_t* dst, int Nd, int K, F f) {
    const int total = Nd * (K >> 3);
    for (int id = blockIdx.x * NTHR + threadIdx.x; id < total; id += gridDim.x * NTHR) {
        const int n = id % Nd, kc = id / Nd;
        float v[8];
#pragma unroll
        for (int j = 0; j < 8; ++j) v[j] = f(n, kc * 8 + j);
        uint4 w; w.x = pk2(v[0], v[1]); w.y = pk2(v[2], v[3]); w.z = pk2(v[4], v[5]); w.w = pk2(v[6], v[7]);
        *(uint4*)(dst + (size_t)n * K + kc * 8) = w;
    }
}

__device__ __forceinline__ void sincos_small(double r, float& s, float& c) {
    const double r2 = r * r;
    double sa = 1.0, ca = 1.0;
    double ts = 1.0, tc = 1.0; sa = 0.0; ca = 0.0;
#pragma unroll
    for (int k = 0; k < 16; ++k) {
        sa += ts; ca += tc;
        ts = -ts * r2 / (double)((2 * k + 2) * (2 * k + 3));
        tc = -tc * r2 / (double)((2 * k + 1) * (2 * k + 2));
    }
    s = (float)(sa * r); c = (float)ca;
}

__device__ __forceinline__ void ph_prep(const P& p) {
    const int tid = threadIdx.x, lane = tid & 63, wid = tid >> 6;
    const int gw = blockIdx.x * 8 + wid, nw = gridDim.x * 8;
    const int gt = blockIdx.x * NTHR + tid, nt = gridDim.x * NTHR;
    for (int row = gw; row < MR; row += nw) {
        const float4* src = (const float4*)(row < NP ? p.x_prompt + (size_t)row * DM : p.x_sample + (size_t)(row - NP) * DM);
        float4 v[4]; float ss = 0.f;
#pragma unroll
        for (int i = 0; i < 4; ++i) { v[i] = src[lane + 64 * i]; ss += v[i].x * v[i].x + v[i].y * v[i].y + v[i].z * v[i].z + v[i].w * v[i].w; }
        ss = wave_sum(ss);
        const float rstd = rsqrtf(ss * (1.0f / DM) + 1e-6f);
#pragma unroll
        for (int i = 0; i < 4; ++i) {
            const float4 g = ((const float4*)p.norm_g)[lane + 64 * i];
            uint2 w; w.x = pk2(v[i].x * rstd * g.x, v[i].y * rstd * g.y); w.y = pk2(v[i].z * rstd * g.z, v[i].w * rstd * g.w);
            *(uint2*)(p.hb() + (size_t)row * DM + 4 * (lane + 64 * i)) = w;
        }
    }
    { const float* w = p.w_in; transpose_cvt(p.WinT(), NPAD, DM, [=](int n, int k) { const int c = win_src_col(n); return c < 0 ? 0.f : w[(size_t)k * CIN + c]; }); }
    { const float* w = p.w_pa; transpose_cvt(p.WpaT(), DM, 512, [=](int n, int k) { return w[(size_t)k * DM + n]; }); }
    { const float* w = p.w_pb; transpose_cvt(p.WpbT(), DM, 512, [=](int n, int k) { return w[(size_t)k * DM + n]; }); }
    { const float* w = p.w_out; transpose_cvt(p.WoutT(), DM, DM, [=](int n, int k) { return w[(size_t)k * DM + n]; }); }
    { const float* w = p.w_gate; transpose_cvt(p.WgateT(), DM, DM, [=](int n, int k) { return w[(size_t)k * DM + n]; }); }
    { const float* w = p.w_proj; transpose_cvt(p.WprojT(), DM, 256, [=](int n, int k) { return w[(size_t)k * DM + n]; }); }
    { const float* w = p.cmp_w1; transpose_cvt(p.W1T(), 512, 1024, [=](int n, int k) { const int kvi = n >> 8, nn = n & 255; return w[(size_t)kvi * 262144 + (size_t)((nn >> 7) * 1024 + k) * 128 + (nn & 127)]; }); }
    for (int id = gt; id < MR * 64; id += nt) {
        const int row = id >> 6, c4 = id & 63;
        const float4 v = ((const float4*)(row < NP ? p.p_prompt + (size_t)row * 256 : p.p_sample + (size_t)(row - NP) * 256))[c4];
        uint2 w; w.x = pk2(v.x, v.y); w.y = pk2(v.z, v.w);
        *(uint2*)(p.pb() + (size_t)row * 256 + c4 * 4) = w;
    }
    for (int id = gt; id < 4104 * 32; id += nt) {
        const int pi = id >> 5, i = id & 31;
        const int pos = pi < 4096 ? pi : PAST + pi - 4096;
        const float inv = (float)exp(-(double)i * (9.210340371976184 / 32.0));
        const float ang = (float)pos * inv;
        const double x = (double)ang;
        const double k = rint(x * 0.15915494309189535);
        const double r = x - k * 6.283185307179586;
        float s, c; sincos_small(r, s, c);
        p.tabc()[id] = c; p.tabs()[id] = s;
    }
    for (int o = gw; o < 256; o += nw) {
        const int kvi = o >> 7, f = o & 127;
        float acc = 0.f;
        for (int jd = lane; jd < 2048; jd += 64) acc += p.cmp_pe[kvi * 2048 + jd] * p.cmp_w1[(size_t)kvi * 262144 + (size_t)jd * 128 + f];
        acc = wave_sum(acc);
        if (lane == 0) p.pt()[o] = acc + p.cmp_b1[o];
    }
    for (int id = gt; id < DB * 504 * 64; id += nt) {
        const int c4 = id & 63, j = (id >> 6) % 504, b = (id >> 6) / 504;
        ((float4*)(p.out + O_WIN_S))[((size_t)b * 512 + j) * 64 + c4] = ((const float4*)p.cache_win)[((size_t)b * 512 + j + 8) * 64 + c4];
    }
}
#define XB_TMO      128
#define XB_XCNT(j)  (256  + 64 * (j))
#define XB_XSUB(j)  (1280 + 64 * (j))
#define XB_XGEN(j)  (2304 + 64 * (j))
#define XB_TOP      3328
#define XB_TOPGEN   3392
#define XCD_BAR_WORDS 3456
#define XB_SPIN_CAP (1u << 18)

__device__ __forceinline__ unsigned xb_ld(unsigned* p)              { return __hip_atomic_load(p, __ATOMIC_RELAXED, __HIP_MEMORY_SCOPE_AGENT); }
__device__ __forceinline__ unsigned xb_add(unsigned* p, unsigned v) { return __hip_atomic_fetch_add(p, v, __ATOMIC_RELAXED, __HIP_MEMORY_SCOPE_AGENT); }
__device__ __forceinline__ unsigned xb_xcc_id() { return (unsigned)__builtin_amdgcn_s_getreg((3 << 11) | 20) & 0xFu; }
#define XB_SPIN(cond, bar) do { unsigned _sp = 0; while (cond) { __builtin_amdgcn_s_sleep(1); \
    if ((++_sp & 255u) == 0u) { if (xb_ld(&(bar)[XB_TMO])) break; if (_sp > XB_SPIN_CAP) { atomicAdd(&(bar)[XB_TMO], 1u); break; } } } } while (0)

struct XcdBarrier {
    unsigned* bar; unsigned x;
    volatile LAS unsigned* st;
};

__device__ __forceinline__ XcdBarrier xcd_barrier_post(unsigned* bar, volatile LAS unsigned* st) {
    XcdBarrier b; b.bar = bar; b.x = xb_xcc_id(); b.st = st;
    if (threadIdx.x == 0) (void)xb_add(&bar[XB_XCNT(b.x)], 1u);
    return b;
}
__device__ __forceinline__ void xcd_barrier_complete(unsigned* bar, unsigned x, unsigned& nloc, unsigned& nx) {
    const unsigned G = gridDim.x * gridDim.y * gridDim.z;
    unsigned sum, cnt, mine, sp = 0u;
    for (;;) {
        sum = 0u; cnt = 0u; mine = 0u;
#pragma unroll
        for (unsigned j = 0; j < 16; ++j) { const unsigned c = xb_ld(&bar[XB_XCNT(j)]); sum += c; cnt += (c > 0u) ? 1u : 0u; mine = (j == x) ? c : mine; }
        if (sum == G) break;
        __builtin_amdgcn_s_sleep(1);
        if ((++sp & 255u) == 0u) { if (xb_ld(&bar[XB_TMO])) break; if (sp > XB_SPIN_CAP) { atomicAdd(&bar[XB_TMO], 1u); break; } }
    }
    nloc = mine > 0u ? mine : 1u; nx = cnt > 0u ? cnt : 1u;
}

__device__ __forceinline__ void xcd_barrier(const XcdBarrier& b) {
    asm volatile("s_waitcnt vmcnt(0)" ::: "memory");
    __syncthreads();
    if (threadIdx.x == 0) {
        unsigned* bar = b.bar;
        __builtin_amdgcn_s_waitcnt(0);
        unsigned nloc = b.st[0], nx = b.st[1];
        if (nloc == 0u) { xcd_barrier_complete(bar, b.x, nloc, nx); b.st[0] = nloc; b.st[1] = nx; }
        const unsigned old = xb_add(&bar[XB_XSUB(b.x)], 1u);
        const unsigned gen = old / nloc;
        if (old + 1u == (gen + 1u) * nloc) {
            __builtin_amdgcn_fence(__ATOMIC_RELEASE, "agent");
            asm volatile("s_waitcnt vmcnt(0)" ::: "memory");
            const unsigned og = xb_add(&bar[XB_TOP], 1u);
            const unsigned tg = og / nx;
            if (og + 1u == (tg + 1u) * nx) xb_add(&bar[XB_TOPGEN], 1u);
            else XB_SPIN(xb_ld(&bar[XB_TOPGEN]) == tg, bar);
            __builtin_amdgcn_fence(__ATOMIC_ACQUIRE, "agent");
            xb_add(&bar[XB_XGEN(b.x)], 1u);
            asm volatile("s_waitcnt vmcnt(0)" ::: "memory");
        } else {
            XB_SPIN(xb_ld(&bar[XB_XGEN(b.x)]) == gen, bar);
            __builtin_amdgcn_fence(__ATOMIC_ACQUIRE, "agent");
            asm volatile("s_waitcnt vmcnt(0)" ::: "memory");
        }
    }
    __syncthreads();
}

using pg8::Unit;

__device__ __forceinline__ void st_bf4(bf16_t* dst, f32x4 v) { uint2 w; w.x = pk2(v[0], v[1]); w.y = pk2(v[2], v[3]); *(uint2*)dst = w; }

struct EpiIn {
    static constexpr bool PERM = false, AFTER_DRAIN = false;
    P p;
    __device__ __forceinline__ void operator()(const f32x4 (&acc)[2][2][4][2], const Unit& u, int wr, int wc, int fr, int fq) const {
        const int pn = u.pn;
#pragma unroll
        for (int ai = 0; ai < 2; ++ai)
#pragma unroll
            for (int m = 0; m < 4; ++m) {
                const int row = u.pm * 256 + ai * 128 + wr * 64 + m * 16 + fr;
                if (pn < 5) {
                    const int pi = row < NP ? (row & (SEQ - 1)) : 4096 + ((row - NP) & 7);
                    const int d0 = 16 * (wc & 1) + 4 * fq;
                    const f32x4 cs = *(const f32x4*)(p.tabc() + pi * 32 + d0), sn = *(const f32x4*)(p.tabs() + pi * 32 + d0);
#pragma unroll
                    for (int bj = 0; bj < 2; ++bj) {
                        const f32x4 x1 = acc[ai][bj][m][0], x2 = acc[ai][bj][m][1];
                        if (pn < 2) {
                            const int head = pn * 4 + bj * 2 + (wc >> 1);
                            const f32x4 o1 = (x1 * cs - x2 * sn) * 0.125f, o2 = (x2 * cs + x1 * sn) * 0.125f;
                            bf16_t* q = p.qb() + (size_t)row * 512 + head * 64 + d0;
                            st_bf4(q, o1); st_bf4(q + 32, o2);
                        } else {
                            const int br = pn - 2, g = wc >> 1;
                            f32x4 o1, o2;
                            if (bj == 0) { o1 = x1 * cs - x2 * sn; o2 = x2 * cs + x1 * sn; } else { o1 = x1; o2 = x2; }
                            float* dst = nullptr;
                            if (row < NP) {
                                if (br == 0) dst = p.out + O_CMP_P + (size_t)row * 256;
                                else if (br == 1) dst = p.out + O_SEL_P + (size_t)row * 256;
                                else { const int s = row & (SEQ - 1); if (s >= SEQ - 512) dst = p.out + O_WIN_P + ((size_t)(row >> 12) * 512 + (s - (SEQ - 512))) * 256; }
                            } else {
                                const int rs = row - NP;
                                if (br == 0) dst = p.out + O_CMP_S + (size_t)rs * 256;
                                else if (br == 1) dst = p.out + O_SEL_S + (size_t)rs * 256;
                                else dst = p.out + O_WIN_S + ((size_t)(rs >> 3) * 512 + 504 + (rs & 7)) * 256;
                            }
                            if (dst) { dst += bj * 128 + g * 64 + d0; *(f32x4*)dst = o1; *(f32x4*)(dst + 32) = o2; }
                            if (row < NP) {
                                const int b = row >> 12, s = row & (SEQ - 1);
                                if (bj == 0) {
                                    bf16_t* k = p.kb() + ((size_t)((br * NB + b) * 2 + g) * SEQ + s) * 64 + d0;
                                    st_bf4(k, o1); st_bf4(k + 32, o2);
                                } else if (br == 0) {
                                    bf16_t* v = p.vcr() + ((size_t)(b * 2 + g) * SEQ + s) * 64 + d0;
                                    st_bf4(v, o1); st_bf4(v + 32, o2);
                                } else {
                                    bf16_t* v = p.vT() + ((size_t)(((br - 1) * NB + b) * 2 + g) * 64 + d0) * SEQ + s;
#pragma unroll
                                    for (int e = 0; e < 4; ++e) { v[(size_t)e * SEQ] = f2bf(o1[e]); v[(size_t)(32 + e) * SEQ] = f2bf(o2[e]); }
                                }
                            }
                        }
                    }
                } else {
#pragma unroll
                    for (int bj = 0; bj < 2; ++bj)
#pragma unroll
                        for (int n = 0; n < 2; ++n) {
                            const int c = bj * 128 + wc * 32 + n * 16 + fq * 4;
                            const f32x4 v = acc[ai][bj][m][n];
                            if (pn < 7) {
                                f32x4 o; for (int e = 0; e < 4; ++e) o[e] = siluf_(v[e]);
                                st_bf4(p.ag() + (size_t)row * 512 + (pn - 5) * 256 + c, o);
                            } else if (pn < 13) {
                                *(f32x4*)(p.rz() + (size_t)row * CR + (pn - 7) * 256 + c) = v;
                            } else if (pn == 13) {
                                if (c < 128) *(f32x4*)(p.rz() + (size_t)row * CR + 1536 + c) = v;
                                else if (c < 152) { f32x4 o; for (int e = 0; e < 4; ++e) o[e] = sigmoidf_(v[e]); *(f32x4*)(p.gates() + (size_t)row * 32 + (c - 128)) = o; }
                            } else if (pn < 16) {
                                f32x4 o; for (int e = 0; e < 4; ++e) o[e] = siluf_(v[e]);
                                st_bf4(p.rg() + (size_t)row * 512 + (pn - 14) * 256 + c, o);
                            } else {
                                f32x4 o; for (int e = 0; e < 4; ++e) o[e] = sigmoidf_(v[e]);
                                st_bf4(p.mg() + (size_t)row * 2048 + (pn - 16) * 256 + c, o);
                            }
                        }
                }
            }
    }
};

struct EpiPlain {
    static constexpr bool PERM = false, AFTER_DRAIN = false;
    float* C; int ldc; int pad_;
    __device__ __forceinline__ void operator()(const f32x4 (&acc)[2][2][4][2], const Unit& u, int wr, int wc, int fr, int fq) const {
#pragma unroll
        for (int ai = 0; ai < 2; ++ai)
#pragma unroll
            for (int m = 0; m < 4; ++m) {
                float* rowp = C + (size_t)(u.pm * 256 + ai * 128 + wr * 64 + m * 16 + fr) * ldc + u.pn * 256 + wc * 32 + 4 * fq;
#pragma unroll
                for (int bj = 0; bj < 2; ++bj)
#pragma unroll
                    for (int n = 0; n < 2; ++n) *(f32x4*)(rowp + bj * 128 + n * 16) = acc[ai][bj][m][n];
            }
    }
};

struct EpiYa {
    static constexpr bool PERM = false, AFTER_DRAIN = false;
    P p;
    __device__ __forceinline__ void operator()(const f32x4 (&acc)[2][2][4][2], const Unit& u, int wr, int wc, int fr, int fq) const {
#pragma unroll
        for (int ai = 0; ai < 2; ++ai)
#pragma unroll
            for (int m = 0; m < 4; ++m) {
                const int row = u.pm * 256 + ai * 128 + wr * 64 + m * 16 + fr;
#pragma unroll
                for (int bj = 0; bj < 2; ++bj)
#pragma unroll
                    for (int n = 0; n < 2; ++n) {
                        const int c = u.pn * 256 + bj * 128 + wc * 32 + n * 16 + fq * 4;
                        const uint2 gw = *(const uint2*)(p.mg() + (size_t)row * 2048 + c);
                        f32x4 g; g[0] = __uint_as_float(gw.x << 16); g[1] = __uint_as_float(gw.x & 0xffff0000u); g[2] = __uint_as_float(gw.y << 16); g[3] = __uint_as_float(gw.y & 0xffff0000u);
                        *(f32x4*)(p.tmp() + (size_t)row * DM + c) = g * acc[ai][bj][m][n];
                    }
            }
    }
};
struct EpiYb {
    static constexpr bool PERM = false, AFTER_DRAIN = false;
    P p;
    __device__ __forceinline__ void operator()(const f32x4 (&acc)[2][2][4][2], const Unit& u, int wr, int wc, int fr, int fq) const {
#pragma unroll
        for (int ai = 0; ai < 2; ++ai)
#pragma unroll
            for (int m = 0; m < 4; ++m) {
                const int row = u.pm * 256 + ai * 128 + wr * 64 + m * 16 + fr;
#pragma unroll
                for (int bj = 0; bj < 2; ++bj)
#pragma unroll
                    for (int n = 0; n < 2; ++n) {
                        const int c = u.pn * 256 + bj * 128 + wc * 32 + n * 16 + fq * 4;
                        const uint2 gw = *(const uint2*)(p.mg() + (size_t)row * 2048 + 1024 + c);
                        f32x4 g; g[0] = __uint_as_float(gw.x << 16); g[1] = __uint_as_float(gw.x & 0xffff0000u); g[2] = __uint_as_float(gw.y << 16); g[3] = __uint_as_float(gw.y & 0xffff0000u);
                        const f32x4 t = *(const f32x4*)(p.tmp() + (size_t)row * DM + c);
                        st_bf4(p.mb() + (size_t)row * DM + c, t + g * acc[ai][bj][m][n]);
                    }
            }
    }
};
struct EpiOut {
    static constexpr bool PERM = false, AFTER_DRAIN = false;
    P p;
    __device__ __forceinline__ void operator()(const f32x4 (&acc)[2][2][4][2], const Unit& u, int wr, int wc, int fr, int fq) const {
#pragma unroll
        for (int ai = 0; ai < 2; ++ai)
#pragma unroll
            for (int m = 0; m < 4; ++m) {
                const int row = u.pm * 256 + ai * 128 + wr * 64 + m * 16 + fr;
                const float* xr = row < NP ? p.x_prompt + (size_t)row * DM : p.x_sample + (size_t)(row - NP) * DM;
                float ss = 0.f;
#pragma unroll
                for (int bj = 0; bj < 2; ++bj)
#pragma unroll
                    for (int n = 0; n < 2; ++n) {
                        const int c = u.pn * 256 + bj * 128 + wc * 32 + n * 16 + fq * 4;
                        const f32x4 v = *(const f32x4*)(xr + c) + acc[ai][bj][m][n];
                        *(f32x4*)(p.x1() + (size_t)row * DM + c) = v;
                        ss += v[0] * v[0] + v[1] * v[1] + v[2] * v[2] + v[3] * v[3];
                        st_bf4(p.xg() + (size_t)row * DM + c, v * *(const f32x4*)(p.ple_g + c));
                    }
                ss += __shfl_xor(ss, 16); ss += __shfl_xor(ss, 32);
                if (fq == 0) p.ss1()[(size_t)row * 16 + u.pn * 4 + wc] = ss;
            }
    }
};
struct EpiGate {
    static constexpr bool PERM = false, AFTER_DRAIN = false;
    P p;
    __device__ __forceinline__ void operator()(const f32x4 (&acc)[2][2][4][2], const Unit& u, int wr, int wc, int fr, int fq) const {
#pragma unroll
        for (int ai = 0; ai < 2; ++ai)
#pragma unroll
            for (int m = 0; m < 4; ++m) {
                const int row = u.pm * 256 + ai * 128 + wr * 64 + m * 16 + fr;
                float ss = 0.f;
#pragma unroll
                for (int i = 0; i < 4; ++i) { const f32x4 t = *(const f32x4*)(p.ss1() + (size_t)row * 16 + i * 4); ss += (t[0] + t[1]) + (t[2] + t[3]); }
                const float rstd = rsqrtf(ss * (1.0f / DM) + 1e-6f);
#pragma unroll
                for (int bj = 0; bj < 2; ++bj)
#pragma unroll
                    for (int n = 0; n < 2; ++n) {
                        const int c = u.pn * 256 + bj * 128 + wc * 32 + n * 16 + fq * 4;
                        const f32x4 a = acc[ai][bj][m][n] * rstd;
                        f32x4 g; for (int e = 0; e < 4; ++e) g[e] = sigmoidf_(a[e]);
                        float* ppp = p.pp() + (size_t)row * DM + c;
                        *(f32x4*)ppp = *(const f32x4*)(p.x1() + (size_t)row * DM + c) + g * *(const f32x4*)ppp;
                    }
            }
    }
};

__device__ __forceinline__ void ph_final(const P& p) {
    const int tid = threadIdx.x, lane = tid & 63, wid = tid >> 6;
    for (int row = blockIdx.x * 8 + wid; row < MR; row += gridDim.x * 8) {
        const float4* src = (const float4*)(p.pp() + (size_t)row * DM);
        float4 v[4]; float ss = 0.f;
#pragma unroll
        for (int i = 0; i < 4; ++i) { v[i] = src[lane + 64 * i]; ss += v[i].x * v[i].x + v[i].y * v[i].y + v[i].z * v[i].z + v[i].w * v[i].w; }
        ss = wave_sum(ss);
        const float rstd = rsqrtf(ss * (1.0f / DM) + 1e-6f);
        float4* dst = (float4*)(p.out + (row < NP ? O_Y_P + (size_t)row * DM : O_Y_S + (size_t)(row - NP) * DM));
#pragma unroll
        for (int i = 0; i < 4; ++i) {
            const float4 g = ((const float4*)p.final_g)[lane + 64 * i];
            float4 o; o.x = v[i].x * rstd * g.x; o.y = v[i].y * rstd * g.y; o.z = v[i].z * rstd * g.z; o.w = v[i].w * rstd * g.w;
            dst[lane + 64 * i] = o;
        }
    }
}

__device__ __forceinline__ void ph_compress2(const P& p, const float* LH, int nbg, int nrows, int nblk, bf16_t* kc, bf16_t* vcT, LAS float* lds) {
    const int tid = threadIdx.x, lane = tid & 63, wid = tid >> 6;
    LAS float* sbuf = lds + wid * 128;
    const int total = 2 * nbg * nrows;
    for (int it = blockIdx.x * 8 + wid; it < total; it += gridDim.x * 8) {
        const int i = it % nrows, bg = (it / nrows) % nbg, kvi = it / (nrows * nbg);
        float o = 0.f;
        if (i < nblk) {
            const float* l0 = LH + ((size_t)kvi * nbg * nrows + (size_t)bg * nrows + i) * 256;
            const float* l1 = l0 + 256;
#pragma unroll
            for (int h = 0; h < 2; ++h) {
                const int f = lane + 64 * h;
                const float hid = l0[f] + l1[128 + f] + p.pt()[kvi * 128 + f];
                sbuf[f] = siluf_(hid);
            }
            WAVE_SYNC();
            o = p.cmp_b2[kvi * 64 + lane];
            const float* w2 = p.cmp_w2 + kvi * 8192 + lane;
#pragma unroll 8
            for (int f = 0; f < 128; ++f) o += sbuf[f] * w2[f * 64];
            WAVE_SYNC();
        }
        if (kvi == 0) kc[((size_t)bg * nrows + i) * 64 + lane] = f2bf(o);
        else vcT[((size_t)bg * 64 + lane) * nrows + i] = f2bf(o);
    }
}

__device__ __forceinline__ void ph_cvt_cache(const P& p) {
    const size_t total = (size_t)2 * DB * 2 * PAST * 8;
    for (size_t id = (size_t)blockIdx.x * NTHR + threadIdx.x; id < total; id += (size_t)gridDim.x * NTHR) {
        const int d8 = (int)(id & 7), tok = (int)((id >> 3) & (PAST - 1)), g = (int)((id >> 17) & 1), b = (int)((id >> 18) & 31), kvi = (int)(id >> 23);
        const int page = p.page_table[b * 128 + (tok >> 7)];
        const float4* src = (const float4*)(p.cache_cmp + ((size_t)page * 128 + (tok & 127)) * 256 + kvi * 128 + g * 64 + d8 * 8);
        const float4 a = src[0], c = src[1];
        uint4 w; w.x = pk2(a.x, a.y); w.y = pk2(a.z, a.w); w.z = pk2(c.x, c.y); w.w = pk2(c.z, c.w);
        *(uint4*)(p.cs() + id * 8) = w;
    }
}

__device__ __forceinline__ void ph_rwkv_prep(const P& p) {
    const int tid = threadIdx.x, lane = tid & 63, wid = tid >> 6;
    for (int it = blockIdx.x * 8 + wid; it < MR * 8; it += gridDim.x * 8) {
        const int row = it >> 3, h = it & 7, c = h * 64 + lane;
        const float* z = p.rz() + (size_t)row * CR;
        const float* pv;
        bool zero_prev = false;
        if (row < NP) { if ((row & (SEQ - 1)) == 0) { zero_prev = true; pv = z; } else pv = z - CR; }
        else { const int rs = row - NP; if ((rs & 7) == 0) pv = p.state_shift + (size_t)(rs >> 3) * CR; else pv = z - CR; }
        auto lerp = [&](int col) { const float zz = z[col]; const float pr = zero_prev ? 0.f : pv[col]; return zz + (pr - zz) * p.mu[col]; };
        const float zr = lerp(c), zk = lerp(512 + c), zv = lerp(1024 + c), zwd = lerp(1536 + lane), zad = lerp(1600 + lane);
        const float th = tanhf(zwd);
        float accw = p.w0[c], acca = p.a0[c];
#pragma unroll 8
        for (int j = 0; j < 64; ++j) {
            const float tj = __shfl(th, j), aj = __shfl(zad, j);
            accw += tj * p.w_up[j * 512 + c]; acca += aj * p.a_up[j * 512 + c];
        }
        const float nx = -accw;
        const float sp = fmaxf(nx, 0.f) + log1pf(__expf(-fabsf(nx)));
        const float w = -sp - 0.5f;
        const float dec = __expf(-__expf(w));
        const float a = sigmoidf_(acca);
        const float kkr = zk * p.k_k[c];
        const float nrm = sqrtf(wave_sum(kkr * kkr));
        const float kk = kkr / fmaxf(nrm, 1e-12f);
        const float km = zk * (1.0f + (a - 1.0f) * p.k_a[c]);
        const float bon = wave_sum(zr * km * p.r_k[c]);
        float* o = p.rw6() + (size_t)it * 384 + lane;
        o[0] = zr; o[64] = dec; o[128] = km; o[192] = zv; o[256] = kk; o[320] = kk * a;
        if (lane == 0) p.bonus()[it] = bon;
        if (h == 0) {
            float* so = nullptr;
            if (row < NP) { if ((row & (SEQ - 1)) == SEQ - 1) so = p.out + O_SH_P + (size_t)(row >> 12) * CR; }
            else { const int rs = row - NP; if ((rs & 7) == 7) so = p.out + O_SH_S + (size_t)(rs >> 3) * CR; }
            if (so) for (int i = lane; i < CR; i += 64) so[i] = z[i];
        }
    }
}

typedef float f32x2 __attribute__((ext_vector_type(2)));
__device__ __forceinline__ float dpp_row_sum(float v) {
    v += __builtin_bit_cast(float, __builtin_amdgcn_mov_dpp(__builtin_bit_cast(int, v), 0xB1, 0xF, 0xF, true));
    v += __builtin_bit_cast(float, __builtin_amdgcn_mov_dpp(__builtin_bit_cast(int, v), 0x4E, 0xF, 0xF, true));
    v += __builtin_bit_cast(float, __builtin_amdgcn_mov_dpp(__builtin_bit_cast(int, v), 0x141, 0xF, 0xF, true));
    v += __builtin_bit_cast(float, __builtin_amdgcn_mov_dpp(__builtin_bit_cast(int, v), 0x140, 0xF, 0xF, true));
    return v;
}
constexpr int SCAN_TC = 32;
__device__ __forceinline__ void scan_item(const P& p, LAS float* lds, int row0, int T, int h, int half, const float* s0, float* sout) {
    const int tid = threadIdx.x, w = tid >> 6, lane = tid & 63, rl = lane >> 4, kq = lane & 15;
    const int vrow = half * 32 + w * 4 + rl;
    f32x4 S;
    if (s0) S = *(const f32x4*)(s0 + vrow * 64 + kq * 4); else { S[0] = 0.f; S[1] = 0.f; S[2] = 0.f; S[3] = 0.f; }
    const float* src = p.rw6() + ((size_t)row0 * 8 + h) * 384;
    const int nchunk = (T + SCAN_TC - 1) / SCAN_TC;
    f32x4 stg[6];
    int so[6], ss[6];
#pragma unroll
    for (int i = 0; i < 6; ++i) { const int idx = i * 512 + tid; ss[i] = idx / 96; so[i] = (idx % 96) * 4; }
    {
        const int ns = T < SCAN_TC ? T : SCAN_TC;
#pragma unroll
        for (int i = 0; i < 6; ++i) if (ss[i] < ns) *(LAS f32x4*)(lds + ss[i] * 384 + so[i]) = *(const f32x4*)(src + (size_t)ss[i] * 3072 + so[i]);
    }
    __syncthreads();
    for (int c = 0; c < nchunk; ++c) {
        const int t0 = c * SCAN_TC;
        const int ns = (T - t0) < SCAN_TC ? (T - t0) : SCAN_TC;
        const bool more = (c + 1) < nchunk;
        const int nns = more ? ((T - t0 - SCAN_TC) < SCAN_TC ? (T - t0 - SCAN_TC) : SCAN_TC) : 0;
        if (more) {
#pragma unroll
            for (int i = 0; i < 6; ++i) if (ss[i] < nns) stg[i] = *(const f32x4*)(src + (size_t)(t0 + SCAN_TC + ss[i]) * 3072 + so[i]);
        }
        LAS const float* buf = lds + (c & 1) * (SCAN_TC * 384);
        float* yo = p.ybuf() + (size_t)(row0 + t0) * 512 + h * 64 + vrow;
#pragma unroll 4
        for (int s = 0; s < ns; ++s) {
            LAS const float* bs = buf + s * 384 + kq * 4;
            const f32x4 r = *(LAS const f32x4*)(bs), d = *(LAS const f32x4*)(bs + 64), km = *(LAS const f32x4*)(bs + 128),
                        kk = *(LAS const f32x4*)(bs + 256), ka = *(LAS const f32x4*)(bs + 320);
            const float vv = buf[s * 384 + 192 + vrow];
            const f32x4 t1 = S * kk;
            float sa = dpp_row_sum((t1[0] + t1[1]) + (t1[2] + t1[3]));
            sa = -sa;
            S = S * d + ka * sa + km * vv;
            const f32x4 t2 = S * r;
            const float y = dpp_row_sum((t2[0] + t2[1]) + (t2[2] + t2[3]));
            if (kq == 0) yo[(size_t)s * 512] = y;
        }
        if (more) {
            LAS float* nb = lds + ((c + 1) & 1) * (SCAN_TC * 384);
#pragma unroll
            for (int i = 0; i < 6; ++i) if (ss[i] < nns) *(LAS f32x4*)(nb + ss[i] * 384 + so[i]) = stg[i];
        }
        __syncthreads();
    }
    *(f32x4*)(sout + vrow * 64 + kq * 4) = S;
}
__device__ __forceinline__ void ph_rwkv_scan(const P& p, LAS float* lds) {
    constexpr int NSCAN = 64;
    if ((int)blockIdx.x < NSCAN) {
        const int item = blockIdx.x >> 1, half = blockIdx.x & 1;
        scan_item(p, lds, (item >> 3) * SEQ, SEQ, item & 7, half, nullptr, p.out + O_WKV_P + (size_t)item * 4096);
    } else {
        const int nb = (int)gridDim.x - NSCAN;
        for (int hi = (int)blockIdx.x - NSCAN; hi < 512; hi += nb) {
            const int item = hi >> 1, half = hi & 1;
            scan_item(p, lds, NP + (item >> 3) * 8, 8, item & 7, half, p.state_wkv + (size_t)item * 4096, p.out + O_WKV_S + (size_t)item * 4096);
        }
    }
}

__device__ __forceinline__ void ph_rwkv_post(const P& p) {
    const int tid = threadIdx.x, lane = tid & 63, wid = tid >> 6;
    for (int it = blockIdx.x * 8 + wid; it < MR * 8; it += gridDim.x * 8) {
        const int row = it >> 3, h = it & 7, c = h * 64 + lane;
        const float y = p.ybuf()[(size_t)row * 512 + c];
        const float mean = wave_sum(y) * (1.0f / 64.0f);
        const float dv = y - mean;
        const float var = wave_sum(dv * dv) * (1.0f / 64.0f);
        float yn = dv * rsqrtf(var + 64e-5f) * p.gn_g[c] + p.gn_b[c];
        yn += p.bonus()[it] * p.rw6()[(size_t)it * 384 + 192 + lane];
        p.ob()[(size_t)row * 512 + c] = f2bf(yn * bf2f(p.rg()[(size_t)row * 512 + c]));
    }
}
#ifndef SMODE
#define SMODE 3
#endif
#ifndef ATTN_MODE
#define ATTN_MODE 3
#endif

typedef unsigned u32x2 __attribute__((ext_vector_type(2)));
__device__ __forceinline__ f32x16 mfma32(bf16x8 a, bf16x8 b, f32x16 c) { return __builtin_amdgcn_mfma_f32_32x32x16_bf16(a, b, c, 0, 0, 0); }
__device__ __forceinline__ bf16x8 pack8(float a0, float a1, float a2, float a3, float a4, float a5, float a6, float a7) {
    union { uint4 u; bf16x8 v; } x; x.u.x = pk2(a0, a1); x.u.y = pk2(a2, a3); x.u.z = pk2(a4, a5); x.u.w = pk2(a6, a7); return x.v;
}
__device__ __forceinline__ f32x16 zero16() { f32x16 z; for (int i = 0; i < 16; ++i) z[i] = 0.f; return z; }

struct KSrcBf { const bf16_t* base; __device__ __forceinline__ bf16x8 operator()(int tok0, int ks, int lane) const { return *(const bf16x8*)(base + (size_t)(tok0 + (lane & 31)) * 64 + 16 * ks + 8 * (lane >> 5)); } };
struct VSrcBfT { const bf16_t* base; int ld; __device__ __forceinline__ bf16x8 operator()(int tok0, int dt, int s2, int lane) const {
        const bf16_t* ptr = base + (size_t)(32 * dt + (lane & 31)) * ld + tok0 + 16 * s2 + 4 * (lane >> 5);
        union { uint4 u; bf16x8 v; } x; const uint2 a = *(const uint2*)ptr, b = *(const uint2*)(ptr + 8); x.u.x = a.x; x.u.y = a.y; x.u.z = b.x; x.u.w = b.y; return x.v; } };

template <class KS>
__device__ __forceinline__ f32x16 qk_tile(const bf16x8 (&qf)[4], const KS& ks, int tok0, int lane) {
    f32x16 s = zero16();
#pragma unroll
    for (int k = 0; k < 4; ++k) s = mfma32(ks(tok0, k, lane), qf[k], s);
    return s;
}
template <class OKF>
__device__ __forceinline__ void sm_stats(const f32x16& s, int hb, OKF ok, float& m, float& l) {
    float sv[16]; float tmax = -1e30f; unsigned okm = 0;
#pragma unroll
    for (int i = 0; i < 16; ++i) { const int kl = (i & 3) + 8 * (i >> 2) + 4 * hb; const bool k = ok(kl); okm |= (k ? 1u : 0u) << i; sv[i] = k ? s[i] : -1e30f; tmax = fmaxf(tmax, sv[i]); }
    tmax = fmaxf(tmax, __shfl_xor(tmax, 32));
    const float mn = fmaxf(m, tmax), alpha = __expf(m - mn); m = mn;
    float ps = 0.f;
#pragma unroll
    for (int i = 0; i < 16; ++i) ps += ((okm >> i) & 1u) ? __expf(sv[i] - mn) : 0.f;
    l = l * alpha + ps;
}
template <class OKF, class VF>
__device__ __forceinline__ void sm_pv(const f32x16& s, int hb, OKF ok, VF vf, float& m, float& l, f32x16 (&o)[2]) {
    float sv[16]; float tmax = -1e30f; unsigned okm = 0;
#pragma unroll
    for (int i = 0; i < 16; ++i) { const int kl = (i & 3) + 8 * (i >> 2) + 4 * hb; const bool k = ok(kl); okm |= (k ? 1u : 0u) << i; sv[i] = k ? s[i] : -1e30f; tmax = fmaxf(tmax, sv[i]); }
    tmax = fmaxf(tmax, __shfl_xor(tmax, 32));
    const float mn = fmaxf(m, tmax), alpha = __expf(m - mn); m = mn;
    float pr[16]; float ps = 0.f;
#pragma unroll
    for (int i = 0; i < 16; ++i) { pr[i] = ((okm >> i) & 1u) ? __expf(sv[i] - mn) : 0.f; ps += pr[i]; }
    l = l * alpha + ps;
    o[0] *= alpha; o[1] *= alpha;
#pragma unroll
    for (int s2 = 0; s2 < 2; ++s2) {
        const bf16x8 pb = pack8(pr[8 * s2 + 0], pr[8 * s2 + 1], pr[8 * s2 + 2], pr[8 * s2 + 3], pr[8 * s2 + 4], pr[8 * s2 + 5], pr[8 * s2 + 6], pr[8 * s2 + 7]);
#pragma unroll
        for (int dt = 0; dt < 2; ++dt) o[dt] = mfma32(vf(dt, s2), pb, o[dt]);
    }
}
template <class OKF, class VF>
__device__ __forceinline__ void cmp_pass2(const f32x16& s, int hb, OKF ok, VF vf, float m, float inv, f32x16 (&o)[2], LAS float* prow, bool writer) {
    float pr[16];
#pragma unroll
    for (int i = 0; i < 16; ++i) {
        const int kl = (i & 3) + 8 * (i >> 2) + 4 * hb;
        pr[i] = ok(kl) ? __expf(s[i] - m) * inv : 0.f;
        float q = pr[i] + __shfl_xor(pr[i], 1); q += __shfl_xor(q, 2);
        if (writer) prow[kl] = q;
    }
#pragma unroll
    for (int s2 = 0; s2 < 2; ++s2) {
        const bf16x8 pb = pack8(pr[8 * s2 + 0], pr[8 * s2 + 1], pr[8 * s2 + 2], pr[8 * s2 + 3], pr[8 * s2 + 4], pr[8 * s2 + 5], pr[8 * s2 + 6], pr[8 * s2 + 7]);
#pragma unroll
        for (int dt = 0; dt < 2; ++dt) o[dt] = mfma32(vf(dt, s2), pb, o[dt]);
    }
}

__device__ __forceinline__ void attn_store(const P& p, const f32x16 (&of)[2], int qrow, int head, int hb, bool doit) {
    if (!doit) return;
#pragma unroll
    for (int dt = 0; dt < 2; ++dt)
#pragma unroll
        for (int i4 = 0; i4 < 4; ++i4) {
            const int d = 32 * dt + 8 * i4 + 4 * hb;
            const size_t off = (size_t)qrow * 512 + head * 64 + d;
            const uint2 gw = *(const uint2*)(p.ag() + off);
            f32x4 v;
            v[0] = of[dt][4 * i4 + 0] * __uint_as_float(gw.x << 16); v[1] = of[dt][4 * i4 + 1] * __uint_as_float(gw.x & 0xffff0000u);
            v[2] = of[dt][4 * i4 + 2] * __uint_as_float(gw.y << 16); v[3] = of[dt][4 * i4 + 3] * __uint_as_float(gw.y & 0xffff0000u);
            st_bf4(p.oa() + off, v);
        }
}


__device__ __forceinline__ void of_put(LAS float* st, int lane, const f32x16 (&o)[2], float sc) {
#pragma unroll
    for (int dt = 0; dt < 2; ++dt)
#pragma unroll
        for (int i = 0; i < 16; ++i) st[(dt * 16 + i) * 64 + lane] = o[dt][i] * sc;
}
__device__ __forceinline__ void of_add(LAS float* st, int lane, const f32x16 (&o)[2], float sc) {
#pragma unroll
    for (int dt = 0; dt < 2; ++dt)
#pragma unroll
        for (int i = 0; i < 16; ++i) st[(dt * 16 + i) * 64 + lane] += o[dt][i] * sc;
}
__device__ __forceinline__ void of_get_add(LAS float* st, int lane, const f32x16 (&o)[2], float sc, f32x16 (&of)[2]) {
#pragma unroll
    for (int dt = 0; dt < 2; ++dt)
#pragma unroll
        for (int i = 0; i < 16; ++i) of[dt][i] = st[(dt * 16 + i) * 64 + lane] + o[dt][i] * sc;
}

__device__ __forceinline__ void attn_prompt_item(const P& p, int item, LAS unsigned char* wl, int lane) {
    const int bg = item & 7, tg = item >> 3, b = bg >> 1, g = bg & 1;
    const int col = lane & 31, hb = lane >> 5, tl = col >> 2, hh = col & 3;
    const int t0 = tg * 8, qpos = t0 + tl, qrow = b * SEQ + qpos, head = g * 4 + hh;
    bf16x8 qf[4];
#pragma unroll
    for (int ks = 0; ks < 4; ++ks) qf[ks] = *(const bf16x8*)(p.qb() + (size_t)qrow * 512 + head * 64 + 16 * ks + 8 * hb);
    LAS float* psum = (LAS float*)wl;
    LAS unsigned long long* msk = (LAS unsigned long long*)(wl + 8192);
    const float g0 = p.gates()[(size_t)qrow * 32 + head * 3 + 0], g1 = p.gates()[(size_t)qrow * 32 + head * 3 + 1], g2 = p.gates()[(size_t)qrow * 32 + head * 3 + 2];
    f32x16 oc[2]; oc[0] = zero16(); oc[1] = zero16();
    {
        const int cm = t0 + 7 - 31;
        const int ntile = cm >= 0 ? ((cm >> 4) >> 5) + 1 : 0;
        const KSrcBf ksrc{p.kc_p() + (size_t)bg * 256 * 64};
        const VSrcBfT vsrc{p.vcT_p() + (size_t)bg * 64 * 256, 256};
        float m = -1e30f, l = 0.f;
#pragma unroll 1
        for (int kt = 0; kt < ntile; ++kt) {
            const f32x16 s = qk_tile(qf, ksrc, 32 * kt, lane);
            sm_stats(s, hb, [&](int kl) { return 16 * (32 * kt + kl) + 31 <= qpos; }, m, l);
        }
        l += __shfl_xor(l, 32);
        const float inv = l > 0.f ? 1.0f / l : 0.f;
#pragma unroll
        for (int i = 0; i < 32; ++i) psum[i * 64 + lane] = 0.f;
        WAVE_SYNC();
#pragma unroll 1
        for (int kt = 0; kt < ntile; ++kt) {
            const f32x16 s = qk_tile(qf, ksrc, 32 * kt, lane);
            cmp_pass2(s, hb, [&](int kl) { return 16 * (32 * kt + kl) + 31 <= qpos; }, [&](int dt, int s2) { return vsrc(32 * kt, dt, s2, lane); }, m, inv, oc,
                      psum + tl * 256 + 32 * kt, hh == 0);
        }
    }
    WAVE_SYNC();
    for (int t2 = 0; t2 < 8; ++t2) {
        const int t = t0 + t2, cur = t >> 6, n = lane;
        float imp = 0.f;
#pragma unroll
        for (int c = -1; c < 4; ++c) { const int cc = 4 * n + c; if (cc >= 0) imp += psum[t2 * 256 + cc]; }
        if (n == 0 || n == cur || n == cur - 1) imp = 1e4f;
        if (n * 64 > t) imp = -1.0f;
        int rank = 0;
#pragma unroll
        for (int j = 0; j < 64; ++j) {
            const float vj = __uint_as_float(__builtin_amdgcn_readlane(__float_as_uint(imp), j));
            rank += (vj > imp || (vj == imp && j < n)) ? 1 : 0;
        }
        const unsigned long long mk = __ballot(rank < 16);
        if (lane == 0) msk[t2] = mk;
    }
    WAVE_SYNC();
    const unsigned long long mymask = msk[tl];
    unsigned long long um = 0;
#pragma unroll
    for (int i = 0; i < 8; ++i) um |= msk[i];
    const int cur0 = t0 >> 6;
    WAVE_SYNC();
    LAS float* ost = (LAS float*)wl;
    of_put(ost, lane, oc, g0);
    {
        const KSrcBf ksrc{p.kb() + (size_t)((1 * NB + b) * 2 + g) * SEQ * 64};
        const VSrcBfT vsrc{p.vT() + (size_t)((0 * NB + b) * 2 + g) * 64 * SEQ, SEQ};
        float m = -1e30f, l = 0.f; f32x16 o[2]; o[0] = zero16(); o[1] = zero16();
#pragma unroll 1
        for (int tt = 0; tt <= 2 * cur0 + 1; ++tt) {
            const int n = tt >> 1;
            if (!((um >> n) & 1ull)) continue;
            const bool bsel = (mymask >> n) & 1ull;
            const int tok0 = 32 * tt;
            const f32x16 s = qk_tile(qf, ksrc, tok0, lane);
            sm_pv(s, hb, [&](int kl) { return bsel && (tok0 + kl <= qpos); }, [&](int dt, int s2) { return vsrc(tok0, dt, s2, lane); }, m, l, o);
        }
        l += __shfl_xor(l, 32);
        const float sc = l > 0.f ? g1 / l : 0.f;
        of_add(ost, lane, o, sc);
    }
    {
        const KSrcBf ksrc{p.kb() + (size_t)((2 * NB + b) * 2 + g) * SEQ * 64};
        const VSrcBfT vsrc{p.vT() + (size_t)((1 * NB + b) * 2 + g) * 64 * SEQ, SEQ};
        float m = -1e30f, l = 0.f; f32x16 o[2]; o[0] = zero16(); o[1] = zero16();
        const int lo = t0 - 511;
        const int nlo = lo > 0 ? (lo >> 6) : 0;
#pragma unroll 1
        for (int tt = 2 * nlo; tt <= 2 * cur0 + 1; ++tt) {
            const int tok0 = 32 * tt;
            const f32x16 s = qk_tile(qf, ksrc, tok0, lane);
            sm_pv(s, hb, [&](int kl) { const int key = tok0 + kl; return key <= qpos && key + 511 >= qpos; }, [&](int dt, int s2) { return vsrc(tok0, dt, s2, lane); }, m, l, o);
        }
        l += __shfl_xor(l, 32);
        const float sc = l > 0.f ? g2 / l : 0.f;
        f32x16 of[2];
        of_get_add(ost, lane, o, sc, of);
        attn_store(p, of, qrow, head, hb, true);
    }
    WAVE_SYNC();
}

template <class RP, class OKF>
__device__ __forceinline__ void f32_tile(const bf16x8 (&qf)[4], RP rp, OKF ok, LAS bf16_t* vt, int lane, float& m, float& l, f32x16 (&o)[2]) {
    const int col = lane & 31, hb = lane >> 5;
    const float* kr = rp(col);
    f32x16 s = zero16();
#pragma unroll
    for (int ks = 0; ks < 4; ++ks) {
        const float4 a = *(const float4*)(kr + 16 * ks + 8 * hb), c = *(const float4*)(kr + 16 * ks + 8 * hb + 4);
        s = mfma32(pack8(a.x, a.y, a.z, a.w, c.x, c.y, c.z, c.w), qf[ks], s);
    }
    const float* vr = kr + 128 + 32 * hb;
#pragma unroll
    for (int j4 = 0; j4 < 8; ++j4) {
        const float4 a = *(const float4*)(vr + 4 * j4);
        vt[(32 * hb + 4 * j4 + 0) * 40 + col] = f2bf(a.x); vt[(32 * hb + 4 * j4 + 1) * 40 + col] = f2bf(a.y);
        vt[(32 * hb + 4 * j4 + 2) * 40 + col] = f2bf(a.z); vt[(32 * hb + 4 * j4 + 3) * 40 + col] = f2bf(a.w);
    }
    WAVE_SYNC();
    sm_pv(s, hb, ok, [&](int dt, int s2) {
        LAS const bf16_t* ptr = vt + (32 * dt + col) * 40 + 16 * s2 + 4 * hb;
        union { uint4 u; bf16x8 v; } x; const u32x2 a = *(LAS const u32x2*)ptr, c = *(LAS const u32x2*)(ptr + 8); x.u.x = a[0]; x.u.y = a[1]; x.u.z = c[0]; x.u.w = c[1]; return x.v; }, m, l, o);
    WAVE_SYNC();
}

__device__ __forceinline__ void attn_sample_item(const P& p, int item, LAS unsigned char* wl, int lane) {
    const int t = item & 7, g = (item >> 3) & 1, b = item >> 4, bg = b * 2 + g;
    const int col = lane & 31, hb = lane >> 5, hh = col & 3;
    const int qpos = PAST + t, qrow = NP + b * 8 + t, head = g * 4 + hh;
    bf16x8 qf[4];
#pragma unroll
    for (int ks = 0; ks < 4; ++ks) qf[ks] = *(const bf16x8*)(p.qb() + (size_t)qrow * 512 + head * 64 + 16 * ks + 8 * hb);
    LAS float* psum = (LAS float*)wl;
    LAS int* list = (LAS int*)(wl + 8256);
    LAS float* impl = (LAS float*)(wl + 8448);
    LAS bf16_t* vt = (LAS bf16_t*)(wl + 9728);
    const float g0 = p.gates()[(size_t)qrow * 32 + head * 3 + 0], g1 = p.gates()[(size_t)qrow * 32 + head * 3 + 1], g2 = p.gates()[(size_t)qrow * 32 + head * 3 + 2];
    f32x16 oc[2]; oc[0] = zero16(); oc[1] = zero16();
    {
        const KSrcBf ksrc{p.kc_s() + (size_t)bg * 1024 * 64};
        const VSrcBfT vsrc{p.vcT_s() + (size_t)bg * 64 * 1024, 1024};
        float m = -1e30f, l = 0.f;
#pragma unroll 1
        for (int kt = 0; kt < 32; ++kt) {
            const f32x16 s = qk_tile(qf, ksrc, 32 * kt, lane);
            sm_stats(s, hb, [&](int kl) { return 32 * kt + kl <= 1022; }, m, l);
        }
        l += __shfl_xor(l, 32);
        const float inv = l > 0.f ? 1.0f / l : 0.f;
#pragma unroll 1
        for (int kt = 0; kt < 32; ++kt) {
            const f32x16 s = qk_tile(qf, ksrc, 32 * kt, lane);
            cmp_pass2(s, hb, [&](int kl) { return 32 * kt + kl <= 1022; }, [&](int dt, int s2) { return vsrc(32 * kt, dt, s2, lane); }, m, inv, oc, psum + 32 * kt, col == 0);
        }
    }
    WAVE_SYNC();
#pragma unroll
    for (int j = 0; j < 5; ++j) {
        const int n = lane + 64 * j;
        if (n <= 256) {
            float imp = 0.f;
            for (int c = -1; c < 4; ++c) { const int cc = 4 * n + c; if (cc >= 0 && cc <= 1022) imp += psum[cc]; }
            impl[n] = imp;
        }
    }
    WAVE_SYNC();
    {
        int base = 0;
#pragma unroll
        for (int j = 0; j < 4; ++j) {
            const int n = lane + 64 * j;
            const bool cand = n >= 1 && n <= 254;
            const float v = impl[n];
            int rank = 0;
            for (int q = 1; q <= 254; ++q) { const float vq = impl[q]; rank += (vq > v || (vq == v && q < n)) ? 1 : 0; }
            const bool sel = cand && rank < 13;
            const unsigned long long mk = __ballot(sel);
            if (sel) list[base + __popcll(mk & ((1ull << lane) - 1ull))] = n;
            base += __popcll(mk);
        }
        if (lane == 0) { list[13] = 0; list[14] = 255; list[15] = 256; }
    }
    WAVE_SYNC();
#if SMODE & 1
    LAS float* ost = (LAS float*)wl;
    of_put(ost, lane, oc, g0);
    {
        float m = -1e30f, l = 0.f; f32x16 o[2]; o[0] = zero16(); o[1] = zero16();
#pragma unroll 1
        for (int li = 0; li < 16; ++li) {
#if SMODE & 4
            const int n = li < 13 ? 17 * li + 5 : (li == 13 ? 0 : 242 + li);
#else
            const int n = __builtin_amdgcn_readfirstlane(list[li]);
#endif
            if (n < 256) {
                const int page = p.page_table[b * 128 + (n >> 1)];
                const float* base = p.cache_sel + ((size_t)page * 128 + (n & 1) * 64) * 256 + g * 64;
#pragma unroll 1
                for (int k2 = 0; k2 < 2; ++k2)
                    f32_tile(qf, [&](int kl) { return base + (size_t)(32 * k2 + kl) * 256; }, [&](int kl) { return true; }, vt, lane, m, l, o);
            } else {
                const float* base = p.out + O_SEL_S + (size_t)(b * 8) * 256 + g * 64;
                f32_tile(qf, [&](int kl) { return base + (size_t)(kl < 8 ? kl : 7) * 256; }, [&](int kl) { return kl <= t; }, vt, lane, m, l, o);
            }
        }
        l += __shfl_xor(l, 32);
        const float sc = l > 0.f ? g1 / l : 0.f;
        of_add(ost, lane, o, sc);
    }
#endif
#if SMODE & 2
    {
        float m = -1e30f, l = 0.f; f32x16 o[2]; o[0] = zero16(); o[1] = zero16();
        const float* cw = p.cache_win + (size_t)b * 512 * 256 + g * 64;
        const float* nw = p.out + O_WIN_S + ((size_t)b * 512 + 504) * 256 + g * 64;
#pragma unroll 1
        for (int kt = 0; kt < 17; ++kt) {
            f32_tile(qf, [&](int kl) { const int j = 32 * kt + kl; return j < 512 ? cw + (size_t)j * 256 : nw + (size_t)(j - 512 < 8 ? j - 512 : 7) * 256; },
                     [&](int kl) { const int j = 32 * kt + kl; return j >= t + 1 && j <= 512 + t; }, vt, lane, m, l, o);
        }
        l += __shfl_xor(l, 32);
        const float sc = l > 0.f ? g2 / l : 0.f;
        f32x16 of[2];
        of_get_add(ost, lane, o, sc, of);
        attn_store(p, of, qrow, head, hb, col < 4);
    }
    WAVE_SYNC();
#endif
}

__device__ __forceinline__ void ph_attn(const P& p, LAS unsigned char* lds) {
    const int tid = threadIdx.x, lane = tid & 63, wid = tid >> 6;
    LAS unsigned char* wl = lds + wid * 16384;
    const int gw = blockIdx.x * 8 + wid, nw = gridDim.x * 8;
#if ATTN_MODE & 2
    for (int it = gw; it < 512; it += nw) attn_sample_item(p, it, wl, lane);
#endif
#if ATTN_MODE & 1
    for (int it = gw; it < 2048; it += nw) { attn_prompt_item(p, it, wl, lane); attn_prompt_item(p, 4095 - it, wl, lane); }
#endif
}
#ifndef STOP_AFTER
#define STOP_AFTER 3
#endif

constexpr int LDS_BYTES = pg8::STAGE_BYTES;

template <class Epi> __global__ __launch_bounds__(512, 2) void k_gemm(pg8::Gemm g, Epi E) {
    extern __shared__ __attribute__((aligned(16))) unsigned char shm[];
    pg8::StaticOrder S; S.init(g.M, g.N, (int)gridDim.x, (int)blockIdx.x);
    pg8::gemm_phase<Epi, pg8::StaticOrder, false>((PG8_LAS unsigned char*)shm, g, S, E, nullptr);
}
template <int PH> __global__ __launch_bounds__(512, 2) void k_phase(P p) {
    extern __shared__ __attribute__((aligned(16))) unsigned char shm[];
    LAS unsigned char* lds = (LAS unsigned char*)shm;
    if constexpr (PH == 0) ph_prep(p);
    if constexpr (PH == 1) ph_compress2(p, p.LHp(), 8, 256, 255, p.kc_p(), p.vcT_p(), (LAS float*)lds);
    if constexpr (PH == 2) ph_cvt_cache(p);
    if constexpr (PH == 3) ph_compress2(p, p.LHs(), 64, 1024, 1023, p.kc_s(), p.vcT_s(), (LAS float*)lds);
    if constexpr (PH == 4) ph_rwkv_prep(p);
    if constexpr (PH == 5) ph_rwkv_scan(p, (LAS float*)lds);
    if constexpr (PH == 6) ph_rwkv_post(p);
    if constexpr (PH == 7) ph_attn(p, lds);
    if constexpr (PH == 8) ph_final(p);
}

template <class Epi> static void launch_gemm(hipStream_t st, const bf16_t* A, const bf16_t* Bt, int M, int N, int K, const Epi& E) {
    static bool attr = false;
    if (!attr) { (void)hipFuncSetAttribute((const void*)k_gemm<Epi>, hipFuncAttributeMaxDynamicSharedMemorySize, LDS_BYTES); attr = true; }
    pg8::Gemm g{}; g.A = A; g.Bt = Bt; g.M = M; g.N = N; g.K = K;
    hipLaunchKernelGGL((k_gemm<Epi>), dim3(256), dim3(512), LDS_BYTES, st, g, E);
}
template <int PH> static void launch_phase(hipStream_t st, const P& p) {
    static bool attr = false;
    if (!attr) { (void)hipFuncSetAttribute((const void*)k_phase<PH>, hipFuncAttributeMaxDynamicSharedMemorySize, LDS_BYTES); attr = true; }
    hipLaunchKernelGGL((k_phase<PH>), dim3(256), dim3(512), LDS_BYTES, st, p);
}


constexpr int FUSED_LDS = LDS_BYTES + 256;

template <class Epi> __device__ __forceinline__ void run_gemm(LAS unsigned char* lds, const bf16_t* A, const bf16_t* Bt, int M, int N, int K, const Epi& E) {
    pg8::Gemm g; g.A = A; g.Bt = Bt; g.M = M; g.N = N; g.K = K; g.pad_ = 0;
    pg8::StaticOrder S; S.init(M, N, (int)gridDim.x, (int)blockIdx.x);
    pg8::gemm_phase<Epi, pg8::StaticOrder, false>((PG8_LAS unsigned char*)lds, g, S, E, nullptr);
}

__global__ __launch_bounds__(512, 2) void k_fused(P p) {
    extern __shared__ __attribute__((aligned(16))) unsigned char shm[];
    LAS unsigned char* lds = (LAS unsigned char*)shm;
    LAS unsigned* xb = (LAS unsigned*)(lds + LDS_BYTES);
    if (threadIdx.x == 0) { xb[0] = 0u; xb[1] = 0u; xb[2] = 0u; xb[3] = 0u; }
    __syncthreads();
    XcdBarrier bar = xcd_barrier_post(p.bar(), (volatile LAS unsigned*)xb);
    ph_prep(p);
    xcd_barrier(bar);
    { EpiIn e; e.p = p; run_gemm(lds, p.hb(), p.WinT(), MR, NPAD, DM, e); }
    xcd_barrier(bar);
    { EpiPlain e; e.C = p.LHp(); e.ldc = 256; e.pad_ = 0; run_gemm(lds, p.kb(), p.W1T(), 2048, 256, 1024, e); }
    { EpiPlain e; e.C = p.LHp() + (size_t)2048 * 256; e.ldc = 256; e.pad_ = 0; run_gemm(lds, p.vcr(), p.W1T() + (size_t)256 * 1024, 2048, 256, 1024, e); }
    ph_cvt_cache(p);
    ph_rwkv_prep(p);
    xcd_barrier(bar);
    ph_compress2(p, p.LHp(), 8, 256, 255, p.kc_p(), p.vcT_p(), (LAS float*)lds);
    __syncthreads();
    { EpiPlain e; e.C = p.LHs(); e.ldc = 256; e.pad_ = 0; run_gemm(lds, p.cs(), p.W1T(), 65536, 256, 1024, e); }
    { EpiPlain e; e.C = p.LHs() + (size_t)65536 * 256; e.ldc = 256; e.pad_ = 0; run_gemm(lds, p.cs() + (size_t)65536 * 1024, p.W1T() + (size_t)256 * 1024, 65536, 256, 1024, e); }
    __syncthreads();
    ph_rwkv_scan(p, (LAS float*)lds);
#ifdef PROBE_SCAN2
    __syncthreads(); ph_rwkv_scan(p, (LAS float*)lds);
#endif
    xcd_barrier(bar);
    ph_compress2(p, p.LHs(), 64, 1024, 1023, p.kc_s(), p.vcT_s(), (LAS float*)lds);
    ph_rwkv_post(p);
    xcd_barrier(bar);
    ph_attn(p, lds);
#ifdef PROBE_ATTN2
    __syncthreads(); ph_attn(p, lds);
#endif
    xcd_barrier(bar);
    { EpiYa e; e.p = p; run_gemm(lds, p.oa(), p.WpaT(), MR, DM, 512, e); }
    { EpiYb e; e.p = p; run_gemm(lds, p.ob(), p.WpbT(), MR, DM, 512, e); }
    xcd_barrier(bar);
    { EpiOut e; e.p = p; run_gemm(lds, p.mb(), p.WoutT(), MR, DM, DM, e); }
    { EpiPlain e; e.C = p.pp(); e.ldc = DM; e.pad_ = 0; run_gemm(lds, p.pb(), p.WprojT(), MR, DM, 256, e); }
    xcd_barrier(bar);
    { EpiGate e; e.p = p; run_gemm(lds, p.xg(), p.WgateT(), MR, DM, DM, e); }
    xcd_barrier(bar);
    ph_final(p);
}
extern "C" void kernel_launch(void* const* d_in, const int* in_sizes, int n_in, void* d_out, int out_size, void* d_ws, size_t ws_size, hipStream_t stream) {
    (void)in_sizes; (void)n_in; (void)out_size; (void)ws_size;
    P p{};
    p.x_prompt = (const float*)d_in[0]; p.x_sample = (const float*)d_in[1]; p.p_prompt = (const float*)d_in[2]; p.p_sample = (const float*)d_in[3];
    p.cache_cmp = (const float*)d_in[4]; p.cache_sel = (const float*)d_in[5]; p.cache_win = (const float*)d_in[6]; p.state_wkv = (const float*)d_in[7];
    p.state_shift = (const float*)d_in[8]; p.page_table = (const int*)d_in[9]; p.norm_g = (const float*)d_in[10]; p.w_in = (const float*)d_in[11];
    p.cmp_pe = (const float*)d_in[12]; p.cmp_w1 = (const float*)d_in[13]; p.cmp_b1 = (const float*)d_in[14]; p.cmp_w2 = (const float*)d_in[15]; p.cmp_b2 = (const float*)d_in[16];
    p.w_pa = (const float*)d_in[17]; p.mu = (const float*)d_in[18]; p.w0 = (const float*)d_in[19]; p.w_up = (const float*)d_in[20]; p.a0 = (const float*)d_in[21];
    p.a_up = (const float*)d_in[22]; p.k_k = (const float*)d_in[23]; p.k_a = (const float*)d_in[24]; p.r_k = (const float*)d_in[25]; p.gn_g = (const float*)d_in[26];
    p.gn_b = (const float*)d_in[27]; p.w_pb = (const float*)d_in[28]; p.w_out = (const float*)d_in[29]; p.ple_g = (const float*)d_in[30]; p.w_gate = (const float*)d_in[31];
    p.w_proj = (const float*)d_in[32]; p.final_g = (const float*)d_in[33];
    p.out = (float*)d_out;
    p.ws = (unsigned char*)d_ws;

#if defined(MULTI_LAUNCH)
    launch_phase<0>(stream, p);
    { EpiIn e{}; e.p = p; launch_gemm(stream, p.hb(), p.WinT(), MR, NPAD, DM, e); }
#if STOP_AFTER >= 3
    { EpiPlain e{}; e.C = p.LHp(); e.ldc = 256; launch_gemm(stream, p.kb(), p.W1T(), 2048, 256, 1024, e); }
    { EpiPlain e{}; e.C = p.LHp() + (size_t)2048 * 256; e.ldc = 256; launch_gemm(stream, p.vcr(), p.W1T() + (size_t)256 * 1024, 2048, 256, 1024, e); }
    launch_phase<1>(stream, p);
    launch_phase<2>(stream, p);
    { EpiPlain e{}; e.C = p.LHs(); e.ldc = 256; launch_gemm(stream, p.cs(), p.W1T(), 65536, 256, 1024, e); }
    { EpiPlain e{}; e.C = p.LHs() + (size_t)65536 * 256; e.ldc = 256; launch_gemm(stream, p.cs() + (size_t)65536 * 1024, p.W1T() + (size_t)256 * 1024, 65536, 256, 1024, e); }
    launch_phase<3>(stream, p);
#endif
#if STOP_AFTER >= 2
    launch_phase<4>(stream, p);
    launch_phase<5>(stream, p);
    launch_phase<6>(stream, p);
#endif
    hipMemsetAsync(p.oa(), 0, (size_t)MR * 512 * 2, stream);
#if STOP_AFTER >= 3
    launch_phase<7>(stream, p);
#endif
    { EpiYa e{}; e.p = p; launch_gemm(stream, p.oa(), p.WpaT(), MR, DM, 512, e); }
    { EpiYb e{}; e.p = p; launch_gemm(stream, p.ob(), p.WpbT(), MR, DM, 512, e); }
    { EpiOut e{}; e.p = p; launch_gemm(stream, p.mb(), p.WoutT(), MR, DM, DM, e); }
    { EpiPlain e{}; e.C = p.pp(); e.ldc = DM; launch_gemm(stream, p.pb(), p.WprojT(), MR, DM, 256, e); }
    { EpiGate e{}; e.p = p; launch_gemm(stream, p.xg(), p.WgateT(), MR, DM, DM, e); }
    launch_phase<8>(stream, p);
#else
    static int grid = 0;
    if (!grid) {
        int dev = 0, cus = 0, per_cu = 0;
        (void)hipGetDevice(&dev);
        (void)hipDeviceGetAttribute(&cus, hipDeviceAttributeMultiprocessorCount, dev);
        (void)hipFuncSetAttribute((const void*)k_fused, hipFuncAttributeMaxDynamicSharedMemorySize, FUSED_LDS);
        (void)hipOccupancyMaxActiveBlocksPerMultiprocessor(&per_cu, k_fused, 512, FUSED_LDS);
        grid = per_cu >= 1 ? cus : 0;
        if (grid > 256) grid = 256;
    }
    (void)hipMemsetAsync(p.bar(), 0, XCD_BAR_WORDS * sizeof(unsigned), stream);
    if (grid > 0) hipLaunchKernelGGL(k_fused, dim3(grid), dim3(512), FUSED_LDS, stream, p);
#endif
}
```

```cpp
#include <hip/hip_runtime.h>
#include <stdint.h>
#include <stdio.h>
namespace pg8 {
#define PG8_LAS __attribute__((address_space(3)))
typedef unsigned short bf16_t;
typedef short bf16x8 __attribute__((ext_vector_type(8)));
typedef float f32x4 __attribute__((ext_vector_type(4)));
typedef unsigned u32x4 __attribute__((ext_vector_type(4)));
constexpr int BM = 256, BK = 64, HALF = 128, HTB = HALF * BK * 2  , STAGE_BYTES = 8 * HTB, NXCD = 8, WGM = 8;

__host__ __device__ __forceinline__ int lds_byte(int r, int c) { const int st = (r >> 4) * 2 + (c >> 5), rr = r & 15, cc = c & 31, ob = rr * 64 + cc * 2; return st * 1024 + (ob ^ (((ob >> 9) & 1) << 5)); }
__host__ __device__ __forceinline__ void stage_rc(int b, int& R, int& C) { const int st = b / 1024, sb = b % 1024, swz = sb ^ (((sb >> 9) & 1) << 5); R = (st >> 1) * 16 + swz / 64; C = (st & 1) * 32 + (swz % 64) / 2; }
__host__ __device__ __forceinline__ int perm32(int rho) { const int n = rho >> 4, i = rho & 15; return 8 * (i >> 2) + 4 * n + (i & 3); }

struct Unit { int pm, pn; };
struct Gemm { const bf16_t* A; const bf16_t* Bt; int M, N, K, pad_; };

struct StaticOrder {
    int nM, nN, nwg, G, c;
    __host__ __device__ void init(int M, int N, int G_, int c_) { nM = M / BM; nN = N / BM; nwg = nM * nN; G = G_; c = c_; }
    __host__ __device__ bool next(int i, Unit& u) const {
        const long L = (long)i * G + c; if (L >= nwg) return false;
        int wgid = (int)L; { const int q = nwg / NXCD, r = nwg % NXCD, xcd = wgid % NXCD, off = wgid / NXCD; wgid = (xcd < r ? xcd * (q + 1) : r * (q + 1) + (xcd - r) * q) + off; }
        const int nig = WGM * nN, gid = wgid / nig, fm = gid * WGM, gsz = (nM - fm) < WGM ? (nM - fm) : WGM;
        u.pm = fm + ((wgid % nig) % gsz); u.pn = (wgid % nig) / gsz; return true;
    }
    __device__ __forceinline__ void a_ready(const Unit&) const {}
    __device__ __forceinline__ void done(const Unit&) const {}
};
__device__ __forceinline__ unsigned cvt_pk_bf16(float lo, float hi) { unsigned r; asm volatile("v_cvt_pk_bf16_f32 %0, %1, %2" : "=v"(r) : "v"(lo), "v"(hi)); return r; }
typedef float f32x2 __attribute__((ext_vector_type(2)));
template <class Epi, class Sched, bool STAMP = false>
__device__ __forceinline__ void gemm_phase(PG8_LAS unsigned char* lds, const Gemm g, const Sched& S, const Epi& E, unsigned long long* stamps) {
    int tid_l = threadIdx.x; asm volatile("" : "+v"(tid_l));
    const int tid = tid_l, wid = __builtin_amdgcn_readfirstlane(tid >> 6), lane = tid & 63, wr = wid >> 2, wc = wid & 3, fr = lane & 15, fq = lane >> 4;
    const int K = g.K, nt = K / BK;
    int ts_lo = 0, ts_hi = 0, nts = 0; const unsigned long long rt_entry = STAMP ? (unsigned long long)wall_clock64() : 0ull;
#define PG8_STAMP() do { if (STAMP && wid == 0 && nts < 64) { const unsigned long long _c = (unsigned long long)clock64(); \
        ts_lo = (lane == nts) ? (int)(unsigned)_c : ts_lo; ts_hi = (lane == nts) ? (int)(unsigned)(_c >> 32) : ts_hi; ++nts; } } while (0)
    PG8_STAMP();
    unsigned voffA[2], voffB[2];
#pragma unroll
    for (int i = 0; i < 2; ++i) { int R, C; stage_rc(tid * 16 + i * 8192, R, C); const int Rb = Epi::PERM ? ((R & ~31) + perm32(R & 31)) : R;
        voffA[i] = (unsigned)(R * K + C) * 2u; voffB[i] = (unsigned)(Rb * K + C) * 2u; }
    const size_t kstep = (size_t)(BK * 2);
    const size_t hstep = (size_t)HALF * K * 2;
    const size_t tstep = 2 * hstep;
    const unsigned ldsw = (unsigned)wid * 1024u;
    const int aoff = lds_byte(wr * 64 + fr, fq * 8), boff = lds_byte(wc * 32 + fr, fq * 8);
#define PG8_SA(b, h) (((b) * 2 + (h)) * HTB)
#define PG8_SB(b, h) ((4 + (b) * 2 + (h)) * HTB)
#define PG8_STAGE(bufoff, gbase, voff) do { _Pragma("unroll") for (int _i = 0; _i < 2; ++_i) \
        __builtin_amdgcn_global_load_lds((const unsigned*)((const char*)(gbase) + (voff)[_i]), (PG8_LAS unsigned*)(lds + (bufoff) + ldsw + _i * 8192), 16, 0, 0); } while (0)
#define PG8_LDA(dst, b, h) do { _Pragma("unroll") for (int m = 0; m < 4; ++m) _Pragma("unroll") for (int k = 0; k < 2; ++k) dst[m][k] = *(const PG8_LAS bf16x8*)(lds + PG8_SA(b, h) + aoff + m * 2048 + k * 1024); } while (0)
#define PG8_LDB(dst, b, h) do { _Pragma("unroll") for (int n = 0; n < 2; ++n) _Pragma("unroll") for (int k = 0; k < 2; ++k) dst[n][k] = *(const PG8_LAS bf16x8*)(lds + PG8_SB(b, h) + boff + n * 2048 + k * 1024); } while (0)
#define PG8_MMA(ai, bj, At, Bt) do { __builtin_amdgcn_s_setprio(1); _Pragma("unroll") for (int m = 0; m < 4; ++m) _Pragma("unroll") for (int n = 0; n < 2; ++n) _Pragma("unroll") for (int k = 0; k < 2; ++k) \
        acc[ai][bj][m][n] = __builtin_amdgcn_mfma_f32_16x16x32_bf16(Bt[n][k], At[m][k], acc[ai][bj][m][n], 0, 0, 0); __builtin_amdgcn_s_setprio(0); } while (0)
#define PG8_WAIT_V(n) asm volatile("s_waitcnt vmcnt(" #n ")" ::: "memory")
#define PG8_WAIT_L(n) asm volatile("s_waitcnt lgkmcnt(" #n ")" ::: "memory")
#define PG8_BAR __builtin_amdgcn_s_barrier()
#define PG8_SCHED __builtin_amdgcn_sched_barrier(0)
    Unit cur, nxt; int ui = 0;
    if (!S.next(0, cur)) return;
    f32x4 acc[2][2][4][2];
#pragma unroll
    for (int a = 0; a < 2; ++a)
#pragma unroll
        for (int b = 0; b < 2; ++b)
#pragma unroll
            for (int m = 0; m < 4; ++m)
#pragma unroll
                for (int n = 0; n < 2; ++n) acc[a][b][m][n] = (f32x4){0.f, 0.f, 0.f, 0.f};
    bf16x8 At[4][2], B0[2][2], B1[2][2];
    const char* cA = (const char*)g.A + (size_t)cur.pm * tstep; const char* cB = (const char*)g.Bt + (size_t)cur.pn * tstep;
    S.a_ready(cur);
    PG8_STAGE(PG8_SB(0, 0), cB, voffB); PG8_STAGE(PG8_SA(0, 0), cA, voffA); PG8_STAGE(PG8_SB(0, 1), cB + hstep, voffB); PG8_STAGE(PG8_SA(0, 1), cA + hstep, voffA);
    if (wr == 1) PG8_BAR;
    PG8_WAIT_V(4); PG8_BAR;
    PG8_STAGE(PG8_SB(1, 0), cB + kstep, voffB); PG8_STAGE(PG8_SA(1, 0), cA + kstep, voffA); PG8_STAGE(PG8_SB(1, 1), cB + hstep + kstep, voffB);
    PG8_WAIT_V(6); PG8_BAR;
    PG8_STAMP();
    for (;;) {
        const bool has_next = S.next(ui + 1, nxt);
        const char* nA = has_next ? (const char*)g.A + (size_t)nxt.pm * tstep : cA; const char* nB = has_next ? (const char*)g.Bt + (size_t)nxt.pn * tstep : cB;
        for (int t = 0; t < nt; t += 2) {
            const bool last = (t == nt - 2);
            const char* a1 = cA + (size_t)(t + 1) * kstep;
            const char* a2 = last ? nA : cA + (size_t)(t + 2) * kstep; const char* b2 = last ? nB : cB + (size_t)(t + 2) * kstep;
            const char* a3 = a2 + kstep; const char* b3 = b2 + kstep;
            if (last && has_next) S.a_ready(nxt);
            PG8_LDB(B0, 0, 0); PG8_SCHED; PG8_LDA(At, 0, 0); PG8_STAGE(PG8_SA(1, 1), a1 + hstep, voffA);
            PG8_WAIT_L(8); PG8_BAR; PG8_WAIT_L(0); PG8_MMA(0, 0, At, B0); PG8_BAR; PG8_SCHED;
            PG8_LDB(B1, 0, 1); PG8_STAGE(PG8_SB(0, 0), b2, voffB);
            PG8_BAR; PG8_WAIT_L(0); PG8_MMA(0, 1, At, B1); PG8_BAR;
            PG8_LDA(At, 0, 1); PG8_STAGE(PG8_SA(0, 0), a2, voffA);
            PG8_BAR; PG8_WAIT_L(0); PG8_MMA(1, 0, At, B0); PG8_BAR; PG8_SCHED;
            PG8_STAGE(PG8_SB(0, 1), b2 + hstep, voffB);
            PG8_WAIT_V(6); PG8_BAR; PG8_MMA(1, 1, At, B1); PG8_BAR;
            PG8_LDB(B0, 1, 0); PG8_SCHED; PG8_LDA(At, 1, 0); PG8_STAGE(PG8_SA(0, 1), a2 + hstep, voffA);
            PG8_WAIT_L(8); PG8_BAR; PG8_WAIT_L(0); PG8_MMA(0, 0, At, B0); PG8_BAR; PG8_SCHED;
            PG8_LDB(B1, 1, 1); PG8_STAGE(PG8_SB(1, 0), b3, voffB);
            PG8_BAR; PG8_WAIT_L(0); PG8_MMA(0, 1, At, B1); PG8_BAR;
            PG8_LDA(At, 1, 1); PG8_STAGE(PG8_SA(1, 0), a3, voffA);
            PG8_BAR; PG8_WAIT_L(0); PG8_MMA(1, 0, At, B0); PG8_BAR; PG8_SCHED;
            PG8_STAGE(PG8_SB(1, 1), b3 + hstep, voffB);
            PG8_WAIT_V(6); PG8_BAR; PG8_MMA(1, 1, At, B1); PG8_BAR;
        }
        PG8_STAMP();
        if constexpr (!Epi::AFTER_DRAIN) { E(acc, cur, wr, wc, fr, fq); S.done(cur); }
        PG8_STAMP();
        if (!has_next) break;
#pragma unroll
        for (int a = 0; a < 2; ++a)
#pragma unroll
            for (int b = 0; b < 2; ++b)
#pragma unroll
                for (int m = 0; m < 4; ++m)
#pragma unroll
                    for (int n = 0; n < 2; ++n) acc[a][b][m][n] = (f32x4){0.f, 0.f, 0.f, 0.f};
        cur = nxt; cA = nA; cB = nB; ++ui;
    }
    PG8_WAIT_V(0);
    if (wr == 0) PG8_BAR;
    PG8_BAR;
    if constexpr (Epi::AFTER_DRAIN) { E.fused(acc, cur, wr, wc, fr, fq, lds, wid, lane); S.done(cur); }
    PG8_STAMP();
    if (STAMP && wid == 0) { stamps[lane] = lane < nts ? (((unsigned long long)(unsigned)ts_hi << 32) | (unsigned)ts_lo) : 0ull;
        if (lane == 62) stamps[62] = rt_entry; if (lane == 63) stamps[63] = (unsigned long long)wall_clock64(); }
#undef PG8_STAMP
#undef PG8_SA
#undef PG8_SB
#undef PG8_STAGE
#undef PG8_LDA
#undef PG8_LDB
#undef PG8_MMA
#undef PG8_WAIT_V
#undef PG8_WAIT_L
#undef PG8_BAR
#undef PG8_SCHED
}
}

typedef unsigned short bf16_t;
typedef short bf16x8 __attribute__((ext_vector_type(8)));
typedef float f32x4 __attribute__((ext_vector_type(4)));
typedef float f32x16 __attribute__((ext_vector_type(16)));
#define LAS __attribute__((address_space(3)))
#define WAVE_SYNC() do { asm volatile("s_waitcnt lgkmcnt(0)" ::: "memory"); __builtin_amdgcn_wave_barrier(); } while (0)

constexpr int DM = 1024, NP = 16384, NSMP = 256, MR = 16640, SEQ = 4096, NB = 4, DB = 32, DS = 8, PAST = 16384;
constexpr int CIN = 6040, NPAD = 6144, CR = 1664;
constexpr int NTHR = 512;
constexpr size_t O_Y_P = 0, O_Y_S = 16777216, O_CMP_P = 17039360, O_CMP_S = 21233664, O_SEL_P = 21299200, O_SEL_S = 25493504,
                 O_WIN_P = 25559040, O_WIN_S = 26083328, O_WKV_P = 30277632, O_WKV_S = 30408704, O_SH_P = 31457280, O_SH_S = 31463936;

constexpr size_t ws_al(size_t x) { return (x + 255) & ~(size_t)255; }
constexpr size_t WS_bar = 0;
constexpr size_t WS_hb = WS_bar + ws_al(16384);
constexpr size_t WS_WinT = WS_hb + ws_al((size_t)MR * DM * 2);
constexpr size_t WS_WpaT = WS_WinT + ws_al((size_t)NPAD * DM * 2);
constexpr size_t WS_WpbT = WS_WpaT + ws_al((size_t)DM * 512 * 2);
constexpr size_t WS_WoutT = WS_WpbT + ws_al((size_t)DM * 512 * 2);
constexpr size_t WS_WgateT = WS_WoutT + ws_al((size_t)DM * DM * 2);
constexpr size_t WS_WprojT = WS_WgateT + ws_al((size_t)DM * DM * 2);
constexpr size_t WS_W1T = WS_WprojT + ws_al((size_t)DM * 256 * 2);
constexpr size_t WS_W2T = WS_W1T + ws_al((size_t)512 * 1024 * 2);
constexpr size_t WS_WupT = WS_W2T + ws_al((size_t)128 * 128 * 2);
constexpr size_t WS_AupT = WS_WupT + ws_al((size_t)512 * 64 * 2);
constexpr size_t WS_pb = WS_AupT + ws_al((size_t)512 * 64 * 2);
constexpr size_t WS_tabc = WS_pb + ws_al((size_t)MR * 256 * 2);
constexpr size_t WS_tabs = WS_tabc + ws_al((size_t)4104 * 32 * 4);
constexpr size_t WS_pt = WS_tabs + ws_al((size_t)4104 * 32 * 4);
constexpr size_t WS_qb = WS_pt + ws_al(256 * 4);
constexpr size_t WS_kb = WS_qb + ws_al((size_t)MR * 512 * 2);
constexpr size_t WS_vcr = WS_kb + ws_al((size_t)3 * NB * 2 * SEQ * 64 * 2);
constexpr size_t WS_vT = WS_vcr + ws_al((size_t)NB * 2 * SEQ * 64 * 2);
constexpr size_t WS_ag = WS_vT + ws_al((size_t)2 * NB * 2 * 64 * SEQ * 2);
constexpr size_t WS_rg = WS_ag + ws_al((size_t)MR * 512 * 2);
constexpr size_t WS_mg = WS_rg + ws_al((size_t)MR * 512 * 2);
constexpr size_t WS_gates = WS_mg + ws_al((size_t)MR * 2048 * 2);
constexpr size_t WS_rz = WS_gates + ws_al((size_t)MR * 32 * 4);
constexpr size_t WS_LHp = WS_rz + ws_al((size_t)MR * CR * 4);
constexpr size_t WS_LHs = WS_LHp + ws_al((size_t)2 * 2048 * 256 * 4);
constexpr size_t WS_cs = WS_LHs + ws_al((size_t)2 * 65536 * 256 * 4);
constexpr size_t WS_kc_p = WS_cs + ws_al((size_t)2 * 65536 * 1024 * 2);
constexpr size_t WS_vcT_p = WS_kc_p + ws_al((size_t)8 * 256 * 64 * 2);
constexpr size_t WS_kc_s = WS_vcT_p + ws_al((size_t)8 * 64 * 256 * 2);
constexpr size_t WS_vcT_s = WS_kc_s + ws_al((size_t)64 * 1024 * 64 * 2);
constexpr size_t WS_rw6 = WS_vcT_s + ws_al((size_t)64 * 64 * 1024 * 2);
constexpr size_t WS_bonus = WS_rw6 + ws_al((size_t)MR * 8 * 384 * 4);
constexpr size_t WS_ybuf = WS_bonus + ws_al((size_t)MR * 8 * 4);
constexpr size_t WS_oa = WS_ybuf + ws_al((size_t)MR * 512 * 4);
constexpr size_t WS_ob = WS_oa + ws_al((size_t)MR * 512 * 2);
constexpr size_t WS_mb = WS_ob + ws_al((size_t)MR * 512 * 2);
constexpr size_t WS_xg = WS_mb + ws_al((size_t)MR * DM * 2);
constexpr size_t WS_tmp = WS_xg + ws_al((size_t)MR * DM * 2);
constexpr size_t WS_x1 = WS_tmp + ws_al((size_t)MR * DM * 4);
constexpr size_t WS_ss1 = WS_x1 + ws_al((size_t)MR * DM * 4);
constexpr size_t WS_pp = WS_ss1 + ws_al((size_t)MR * 16 * 4);
constexpr size_t WS_TOTAL = WS_pp + ws_al((size_t)MR * DM * 4);

struct P {
    const float *x_prompt, *x_sample, *p_prompt, *p_sample, *cache_cmp, *cache_sel, *cache_win, *state_wkv, *state_shift;
    const int* page_table;
    const float *norm_g, *w_in, *cmp_pe, *cmp_w1, *cmp_b1, *cmp_w2, *cmp_b2, *w_pa, *mu, *w0, *w_up, *a0, *a_up, *k_k, *k_a, *r_k, *gn_g, *gn_b,
        *w_pb, *w_out, *ple_g, *w_gate, *w_proj, *final_g;
    float* out;
    unsigned char* ws;
    __host__ __device__ __forceinline__ unsigned* bar() const { return (unsigned*)(ws + WS_bar); }
    __host__ __device__ __forceinline__ bf16_t* hb() const { return (bf16_t*)(ws + WS_hb); }
    __host__ __device__ __forceinline__ bf16_t* WinT() const { return (bf16_t*)(ws + WS_WinT); }
    __host__ __device__ __forceinline__ bf16_t* WpaT() const { return (bf16_t*)(ws + WS_WpaT); }
    __host__ __device__ __forceinline__ bf16_t* WpbT() const { return (bf16_t*)(ws + WS_WpbT); }
    __host__ __device__ __forceinline__ bf16_t* WoutT() const { return (bf16_t*)(ws + WS_WoutT); }
    __host__ __device__ __forceinline__ bf16_t* WgateT() const { return (bf16_t*)(ws + WS_WgateT); }
    __host__ __device__ __forceinline__ bf16_t* WprojT() const { return (bf16_t*)(ws + WS_WprojT); }
    __host__ __device__ __forceinline__ bf16_t* W1T() const { return (bf16_t*)(ws + WS_W1T); }
    __host__ __device__ __forceinline__ bf16_t* W2T() const { return (bf16_t*)(ws + WS_W2T); }
    __host__ __device__ __forceinline__ bf16_t* WupT() const { return (bf16_t*)(ws + WS_WupT); }
    __host__ __device__ __forceinline__ bf16_t* AupT() const { return (bf16_t*)(ws + WS_AupT); }
    __host__ __device__ __forceinline__ bf16_t* pb() const { return (bf16_t*)(ws + WS_pb); }
    __host__ __device__ __forceinline__ float* tabc() const { return (float*)(ws + WS_tabc); }
    __host__ __device__ __forceinline__ float* tabs() const { return (float*)(ws + WS_tabs); }
    __host__ __device__ __forceinline__ float* pt() const { return (float*)(ws + WS_pt); }
    __host__ __device__ __forceinline__ bf16_t* qb() const { return (bf16_t*)(ws + WS_qb); }
    __host__ __device__ __forceinline__ bf16_t* kb() const { return (bf16_t*)(ws + WS_kb); }
    __host__ __device__ __forceinline__ bf16_t* vcr() const { return (bf16_t*)(ws + WS_vcr); }
    __host__ __device__ __forceinline__ bf16_t* vT() const { return (bf16_t*)(ws + WS_vT); }
    __host__ __device__ __forceinline__ bf16_t* ag() const { return (bf16_t*)(ws + WS_ag); }
    __host__ __device__ __forceinline__ bf16_t* rg() const { return (bf16_t*)(ws + WS_rg); }
    __host__ __device__ __forceinline__ bf16_t* mg() const { return (bf16_t*)(ws + WS_mg); }
    __host__ __device__ __forceinline__ float* gates() const { return (float*)(ws + WS_gates); }
    __host__ __device__ __forceinline__ float* rz() const { return (float*)(ws + WS_rz); }
    __host__ __device__ __forceinline__ float* LHp() const { return (float*)(ws + WS_LHp); }
    __host__ __device__ __forceinline__ float* LHs() const { return (float*)(ws + WS_LHs); }
    __host__ __device__ __forceinline__ bf16_t* cs() const { return (bf16_t*)(ws + WS_cs); }
    __host__ __device__ __forceinline__ bf16_t* kc_p() const { return (bf16_t*)(ws + WS_kc_p); }
    __host__ __device__ __forceinline__ bf16_t* vcT_p() const { return (bf16_t*)(ws + WS_vcT_p); }
    __host__ __device__ __forceinline__ bf16_t* kc_s() const { return (bf16_t*)(ws + WS_kc_s); }
    __host__ __device__ __forceinline__ bf16_t* vcT_s() const { return (bf16_t*)(ws + WS_vcT_s); }
    __host__ __device__ __forceinline__ float* rw6() const { return (float*)(ws + WS_rw6); }
    __host__ __device__ __forceinline__ float* bonus() const { return (float*)(ws + WS_bonus); }
    __host__ __device__ __forceinline__ float* ybuf() const { return (float*)(ws + WS_ybuf); }
    __host__ __device__ __forceinline__ bf16_t* oa() const { return (bf16_t*)(ws + WS_oa); }
    __host__ __device__ __forceinline__ bf16_t* ob() const { return (bf16_t*)(ws + WS_ob); }
    __host__ __device__ __forceinline__ bf16_t* mb() const { return (bf16_t*)(ws + WS_mb); }
    __host__ __device__ __forceinline__ bf16_t* xg() const { return (bf16_t*)(ws + WS_xg); }
    __host__ __device__ __forceinline__ float* tmp() const { return (float*)(ws + WS_tmp); }
    __host__ __device__ __forceinline__ float* x1() const { return (float*)(ws + WS_x1); }
    __host__ __device__ __forceinline__ float* ss1() const { return (float*)(ws + WS_ss1); }
    __host__ __device__ __forceinline__ float* pp() const { return (float*)(ws + WS_pp); }
};

__device__ __forceinline__ bf16_t f2bf(float f) { unsigned u = __float_as_uint(f); u += 0x7FFFu + ((u >> 16) & 1u); return (bf16_t)(u >> 16); }
__device__ __forceinline__ float bf2f(bf16_t b) { return __uint_as_float(((unsigned)b) << 16); }
typedef __bf16 bf16v2_t __attribute__((ext_vector_type(2)));
typedef float f32x2_t __attribute__((ext_vector_type(2)));
__device__ __forceinline__ unsigned pk2(float lo, float hi) { const f32x2_t v = {lo, hi}; return __builtin_bit_cast(unsigned, __builtin_convertvector(v, bf16v2_t)); }
__device__ __forceinline__ float wave_sum(float v) {
#pragma unroll
    for (int o = 32; o >= 1; o >>= 1) v += __shfl_xor(v, o);
    return v;
}
__device__ __forceinline__ float sigmoidf_(float x) { return 1.0f / (1.0f + __expf(-x)); }
__device__ __forceinline__ float siluf_(float x) { return x / (1.0f + __expf(-x)); }

__device__ __forceinline__ int win_src_col(int np) {
    const int pn = np >> 8, p = np & 255;
    if (pn < 5) {
        const int bj = p >> 7, wc = (p >> 5) & 3, n = (p >> 4) & 1, fq = (p >> 2) & 3, e = p & 3;
        const int d = 32 * n + 16 * (wc & 1) + 4 * fq + e;
        if (pn < 2) { const int head = pn * 4 + bj * 2 + (wc >> 1); return head * 64 + d; }
        const int br = pn - 2, g = wc >> 1;
        return 512 + br * 256 + bj * 128 + g * 64 + d;
    }
    if (pn < 7) return 1304 + (pn - 5) * 256 + p;
    if (pn < 13) return 1816 + (pn - 7) * 256 + p;
    if (pn == 13) { if (p < 128) return 1816 + 1536 + p; if (p < 152) return 1280 + (p - 128); return -1; }
    if (pn < 16) return 3480 + (pn - 14) * 256 + p;
    return 3992 + (pn - 16) * 256 + p;
}

template <class F>
__device__ __forceinline__ void transpose_cvt(bf16_t* dst, int Nd, int K, F f) {
    const int total = Nd * (K >> 3);
    for (int id = blockIdx.x * NTHR + threadIdx.x; id < total; id += gridDim.x * NTHR) {
        const int n = id % Nd, kc = id / Nd;
        float v[8];
#pragma unroll
        for (int j = 0; j < 8; ++j) v[j] = f(n, kc * 8 + j);
        uint4 w; w.x = pk2(v[0], v[1]); w.y = pk2(v[2], v[3]); w.z = pk2(v[4], v[5]); w.w = pk2(v[6], v[7]);
        *(uint4*)(dst + (size_t)n * K + kc * 8) = w;
    }
}

__device__ __forceinline__ void sincos_small(double r, float& s, float& c) {
    const double r2 = r * r;
    double sa = 1.0, ca = 1.0;
    double ts = 1.0, tc = 1.0; sa = 0.0; ca = 0.0;
#pragma unroll
    for (int k = 0; k < 16; ++k) {
        sa += ts; ca += tc;
        ts = -ts * r2 / (double)((2 * k + 2) * (2 * k + 3));
        tc = -tc * r2 / (double)((2 * k + 1) * (2 * k + 2));
    }
    s = (float)(sa * r); c = (float)ca;
}

__device__ __forceinline__ void ph_prep(const P& p) {
    const int tid = threadIdx.x, lane = tid & 63, wid = tid >> 6;
    const int gw = blockIdx.x * 8 + wid, nw = gridDim.x * 8;
    const int gt = blockIdx.x * NTHR + tid, nt = gridDim.x * NTHR;
    for (int row = gw; row < MR; row += nw) {
        const float4* src = (const float4*)(row < NP ? p.x_prompt + (size_t)row * DM : p.x_sample + (size_t)(row - NP) * DM);
        float4 v[4]; float ss = 0.f;
#pragma unroll
        for (int i = 0; i < 4; ++i) { v[i] = src[lane + 64 * i]; ss += v[i].x * v[i].x + v[i].y * v[i].y + v[i].z * v[i].z + v[i].w * v[i].w; }
        ss = wave_sum(ss);
        const float rstd = rsqrtf(ss * (1.0f / DM) + 1e-6f);
#pragma unroll
        for (int i = 0; i < 4; ++i) {
            const float4 g = ((const float4*)p.norm_g)[lane + 64 * i];
            uint2 w; w.x = pk2(v[i].x * rstd * g.x, v[i].y * rstd * g.y); w.y = pk2(v[i].z * rstd * g.z, v[i].w * rstd * g.w);
            *(uint2*)(p.hb() + (size_t)row * DM + 4 * (lane + 64 * i)) = w;
        }
    }
    { const float* w = p.w_in; transpose_cvt(p.WinT(), NPAD, DM, [=](int n, int k) { const int c = win_src_col(n); return c < 0 ? 0.f : w[(size_t)k * CIN + c]; }); }
    { const float* w = p.w_pa; transpose_cvt(p.WpaT(), DM, 512, [=](int n, int k) { return w[(size_t)k * DM + n]; }); }
    { const float* w = p.w_pb; transpose_cvt(p.WpbT(), DM, 512, [=](int n, int k) { return w[(size_t)k * DM + n]; }); }
    { const float* w = p.w_out; transpose_cvt(p.WoutT(), DM, DM, [=](int n, int k) { return w[(size_t)k * DM + n]; }); }
    { const float* w = p.w_gate; transpose_cvt(p.WgateT(), DM, DM, [=](int n, int k) { return w[(size_t)k * DM + n]; }); }
    { const float* w = p.w_proj; transpose_cvt(p.WprojT(), DM, 256, [=](int n, int k) { return w[(size_t)k * DM + n]; }); }
    { const float* w = p.cmp_w1; transpose_cvt(p.W1T(), 512, 1024, [=](int n, int k) { const int kvi = n >> 8, nn = n & 255; return w[(size_t)kvi * 262144 + (size_t)((nn >> 7) * 1024 + k) * 128 + (nn & 127)]; }); }
    { const float* w = p.cmp_w2; transpose_cvt(p.W2T(), 128, 128, [=](int n, int k) { return w[(size_t)(n >> 6) * 8192 + (size_t)k * 64 + (n & 63)]; }); }
    { const float* w = p.w_up; transpose_cvt(p.WupT(), 512, 64, [=](int n, int k) { return w[(size_t)k * 512 + n]; }); }
    { const float* w = p.a_up; transpose_cvt(p.AupT(), 512, 64, [=](int n, int k) { return w[(size_t)k * 512 + n]; }); }
    for (int id = gt; id < MR * 64; id += nt) {
        const int row = id >> 6, c4 = id & 63;
        const float4 v = ((const float4*)(row < NP ? p.p_prompt + (size_t)row * 256 : p.p_sample + (size_t)(row - NP) * 256))[c4];
        uint2 w; w.x = pk2(v.x, v.y); w.y = pk2(v.z, v.w);
        *(uint2*)(p.pb() + (size_t)row * 256 + c4 * 4) = w;
    }
    for (int id = gt; id < 4104 * 32; id += nt) {
        const int pi = id >> 5, i = id & 31;
        const int pos = pi < 4096 ? pi : PAST + pi - 4096;
        const float inv = (float)exp(-(double)i * (9.210340371976184 / 32.0));
        const float ang = (float)pos * inv;
        const double x = (double)ang;
        const double k = rint(x * 0.15915494309189535);
        const double r = x - k * 6.283185307179586;
        float s, c; sincos_small(r, s, c);
        p.tabc()[id] = c; p.tabs()[id] = s;
    }
    for (int o = gw; o < 256; o += nw) {
        const int kvi = o >> 7, f = o & 127;
        float acc = 0.f;
        for (int jd = lane; jd < 2048; jd += 64) acc += p.cmp_pe[kvi * 2048 + jd] * p.cmp_w1[(size_t)kvi * 262144 + (size_t)jd * 128 + f];
        acc = wave_sum(acc);
        if (lane == 0) p.pt()[o] = acc + p.cmp_b1[o];
    }
    for (int id = gt; id < DB * 504 * 64; id += nt) {
        const int c4 = id & 63, j = (id >> 6) % 504, b = (id >> 6) / 504;
        ((float4*)(p.out + O_WIN_S))[((size_t)b * 512 + j) * 64 + c4] = ((const float4*)p.cache_win)[((size_t)b * 512 + j + 8) * 64 + c4];
    }
}
#define XB_TMO      128
#define XB_XCNT(j)  (256  + 64 * (j))
#define XB_XSUB(j)  (1280 + 64 * (j))
#define XB_XGEN(j)  (2304 + 64 * (j))
#define XB_TOP      3328
#define XB_TOPGEN   3392
#define XCD_BAR_WORDS 3456
#define XB_SPIN_CAP (1u << 18)

__device__ __forceinline__ unsigned xb_ld(unsigned* p)              { return __hip_atomic_load(p, __ATOMIC_RELAXED, __HIP_MEMORY_SCOPE_AGENT); }
__device__ __forceinline__ unsigned xb_add(unsigned* p, unsigned v) { return __hip_atomic_fetch_add(p, v, __ATOMIC_RELAXED, __HIP_MEMORY_SCOPE_AGENT); }
__device__ __forceinline__ unsigned xb_xcc_id() { return (unsigned)__builtin_amdgcn_s_getreg((3 << 11) | 20) & 0xFu; }
#define XB_SPIN(cond, bar) do { unsigned _sp = 0; while (cond) { __builtin_amdgcn_s_sleep(1); \
    if ((++_sp & 255u) == 0u) { if (xb_ld(&(bar)[XB_TMO])) break; if (_sp > XB_SPIN_CAP) { atomicAdd(&(bar)[XB_TMO], 1u); break; } } } } while (0)

struct XcdBarrier {
    unsigned* bar; unsigned x;
    volatile LAS unsigned* st;
};

__device__ __forceinline__ XcdBarrier xcd_barrier_post(unsigned* bar, volatile LAS unsigned* st) {
    XcdBarrier b; b.bar = bar; b.x = xb_xcc_id(); b.st = st;
    if (threadIdx.x == 0) (void)xb_add(&bar[XB_XCNT(b.x)], 1u);
    return b;
}
__device__ __forceinline__ void xcd_barrier_complete(unsigned* bar, unsigned x, unsigned& nloc, unsigned& nx) {
    const unsigned G = gridDim.x * gridDim.y * gridDim.z;
    unsigned sum, cnt, mine, sp = 0u;
    for (;;) {
        sum = 0u; cnt = 0u; mine = 0u;
#pragma unroll
        for (unsigned j = 0; j < 16; ++j) { const unsigned c = xb_ld(&bar[XB_XCNT(j)]); sum += c; cnt += (c > 0u) ? 1u : 0u; mine = (j == x) ? c : mine; }
        if (sum == G) break;
        __builtin_amdgcn_s_sleep(1);
        if ((++sp & 255u) == 0u) { if (xb_ld(&bar[XB_TMO])) break; if (sp > XB_SPIN_CAP) { atomicAdd(&bar[XB_TMO], 1u); break; } }
    }
    nloc = mine > 0u ? mine : 1u; nx = cnt > 0u ? cnt : 1u;
}

__device__ __forceinline__ void xcd_barrier(const XcdBarrier& b) {
    asm volatile("s_waitcnt vmcnt(0)" ::: "memory");
    __syncthreads();
    if (threadIdx.x == 0) {
        unsigned* bar = b.bar;
        __builtin_amdgcn_s_waitcnt(0);
        unsigned nloc = b.st[0], nx = b.st[1];
        if (nloc == 0u) { xcd_barrier_complete(bar, b.x, nloc, nx); b.st[0] = nloc; b.st[1] = nx; }
        const unsigned old = xb_add(&bar[XB_XSUB(b.x)], 1u);
        const unsigned gen = old / nloc;
        if (old + 1u == (gen + 1u) * nloc) {
            __builtin_amdgcn_fence(__ATOMIC_RELEASE, "agent");
            asm volatile("s_waitcnt vmcnt(0)" ::: "memory");
            const unsigned og = xb_add(&bar[XB_TOP], 1u);
            const unsigned tg = og / nx;
            if (og + 1u == (tg + 1u) * nx) xb_add(&bar[XB_TOPGEN], 1u);
            else XB_SPIN(xb_ld(&bar[XB_TOPGEN]) == tg, bar);
            __builtin_amdgcn_fence(__ATOMIC_ACQUIRE, "agent");
            xb_add(&bar[XB_XGEN(b.x)], 1u);
            asm volatile("s_waitcnt vmcnt(0)" ::: "memory");
        } else {
            XB_SPIN(xb_ld(&bar[XB_XGEN(b.x)]) == gen, bar);
            __builtin_amdgcn_fence(__ATOMIC_ACQUIRE, "agent");
            asm volatile("s_waitcnt vmcnt(0)" ::: "memory");
        }
    }
    __syncthreads();
}

using pg8::Unit;
typedef unsigned u32x2 __attribute__((ext_vector_type(2)));
__device__ __forceinline__ f32x16 mfma32(bf16x8 a, bf16x8 b, f32x16 c) { return __builtin_amdgcn_mfma_f32_32x32x16_bf16(a, b, c, 0, 0, 0); }
__device__ __forceinline__ bf16x8 pack8(float a0, float a1, float a2, float a3, float a4, float a5, float a6, float a7) {
    union { uint4 u; bf16x8 v; } x; x.u.x = pk2(a0, a1); x.u.y = pk2(a2, a3); x.u.z = pk2(a4, a5); x.u.w = pk2(a6, a7); return x.v;
}
__device__ __forceinline__ f32x16 zero16() { f32x16 z; for (int i = 0; i < 16; ++i) z[i] = 0.f; return z; }


__device__ __forceinline__ void st_bf4(bf16_t* dst, f32x4 v) { uint2 w; w.x = pk2(v[0], v[1]); w.y = pk2(v[2], v[3]); *(uint2*)dst = w; }

struct EpiIn {
    static constexpr bool PERM = false, AFTER_DRAIN = false;
    P p;
    __device__ __forceinline__ void operator()(const f32x4 (&acc)[2][2][4][2], const Unit& u, int wr, int wc, int fr, int fq) const {
        const int pn = u.pn;
#pragma unroll
        for (int ai = 0; ai < 2; ++ai)
#pragma unroll
            for (int m = 0; m < 4; ++m) {
                const int row = u.pm * 256 + ai * 128 + wr * 64 + m * 16 + fr;
                if (pn < 5) {
                    const int pi = row < NP ? (row & (SEQ - 1)) : 4096 + ((row - NP) & 7);
                    const int d0 = 16 * (wc & 1) + 4 * fq;
                    const f32x4 cs = *(const f32x4*)(p.tabc() + pi * 32 + d0), sn = *(const f32x4*)(p.tabs() + pi * 32 + d0);
#pragma unroll
                    for (int bj = 0; bj < 2; ++bj) {
                        const f32x4 x1 = acc[ai][bj][m][0], x2 = acc[ai][bj][m][1];
                        if (pn < 2) {
                            const int head = pn * 4 + bj * 2 + (wc >> 1);
                            const f32x4 o1 = (x1 * cs - x2 * sn) * 0.125f, o2 = (x2 * cs + x1 * sn) * 0.125f;
                            bf16_t* q = p.qb() + (size_t)row * 512 + head * 64 + d0;
                            st_bf4(q, o1); st_bf4(q + 32, o2);
                        } else {
                            const int br = pn - 2, g = wc >> 1;
                            f32x4 o1, o2;
                            if (bj == 0) { o1 = x1 * cs - x2 * sn; o2 = x2 * cs + x1 * sn; } else { o1 = x1; o2 = x2; }
                            float* dst = nullptr;
                            if (row < NP) {
                                if (br == 0) dst = p.out + O_CMP_P + (size_t)row * 256;
                                else if (br == 1) dst = p.out + O_SEL_P + (size_t)row * 256;
                                else { const int s = row & (SEQ - 1); if (s >= SEQ - 512) dst = p.out + O_WIN_P + ((size_t)(row >> 12) * 512 + (s - (SEQ - 512))) * 256; }
                            } else {
                                const int rs = row - NP;
                                if (br == 0) dst = p.out + O_CMP_S + (size_t)rs * 256;
                                else if (br == 1) dst = p.out + O_SEL_S + (size_t)rs * 256;
                                else dst = p.out + O_WIN_S + ((size_t)(rs >> 3) * 512 + 504 + (rs & 7)) * 256;
                            }
                            if (dst) { dst += bj * 128 + g * 64 + d0; *(f32x4*)dst = o1; *(f32x4*)(dst + 32) = o2; }
                            if (row < NP) {
                                const int b = row >> 12, s = row & (SEQ - 1);
                                if (bj == 0) {
                                    bf16_t* k = p.kb() + ((size_t)((br * NB + b) * 2 + g) * SEQ + s) * 64 + d0;
                                    st_bf4(k, o1); st_bf4(k + 32, o2);
                                } else if (br == 0) {
                                    bf16_t* v = p.vcr() + ((size_t)(b * 2 + g) * SEQ + s) * 64 + d0;
                                    st_bf4(v, o1); st_bf4(v + 32, o2);
                                } else {
                                    bf16_t* v = p.vT() + ((size_t)(((br - 1) * NB + b) * 2 + g) * 64 + d0) * SEQ + s;
#pragma unroll
                                    for (int e = 0; e < 4; ++e) { v[(size_t)e * SEQ] = f2bf(o1[e]); v[(size_t)(32 + e) * SEQ] = f2bf(o2[e]); }
                                }
                            }
                        }
                    }
                } else {
#pragma unroll
                    for (int bj = 0; bj < 2; ++bj)
#pragma unroll
                        for (int n = 0; n < 2; ++n) {
                            const int c = bj * 128 + wc * 32 + n * 16 + fq * 4;
                            const f32x4 v = acc[ai][bj][m][n];
                            if (pn < 7) {
                                f32x4 o; for (int e = 0; e < 4; ++e) o[e] = siluf_(v[e]);
                                st_bf4(p.ag() + (size_t)row * 512 + (pn - 5) * 256 + c, o);
                            } else if (pn < 13) {
                                *(f32x4*)(p.rz() + (size_t)row * CR + (pn - 7) * 256 + c) = v;
                            } else if (pn == 13) {
                                if (c < 128) *(f32x4*)(p.rz() + (size_t)row * CR + 1536 + c) = v;
                                else if (c < 152) { f32x4 o; for (int e = 0; e < 4; ++e) o[e] = sigmoidf_(v[e]); *(f32x4*)(p.gates() + (size_t)row * 32 + (c - 128)) = o; }
                            } else if (pn < 16) {
                                f32x4 o; for (int e = 0; e < 4; ++e) o[e] = siluf_(v[e]);
                                st_bf4(p.rg() + (size_t)row * 512 + (pn - 14) * 256 + c, o);
                            } else {
                                f32x4 o; for (int e = 0; e < 4; ++e) o[e] = sigmoidf_(v[e]);
                                st_bf4(p.mg() + (size_t)row * 2048 + (pn - 16) * 256 + c, o);
                            }
                        }
                }
            }
    }
};

struct EpiPlain {
    static constexpr bool PERM = false, AFTER_DRAIN = false;
    float* C; int ldc; int pad_;
    __device__ __forceinline__ void operator()(const f32x4 (&acc)[2][2][4][2], const Unit& u, int wr, int wc, int fr, int fq) const {
#pragma unroll
        for (int ai = 0; ai < 2; ++ai)
#pragma unroll
            for (int m = 0; m < 4; ++m) {
                float* rowp = C + (size_t)(u.pm * 256 + ai * 128 + wr * 64 + m * 16 + fr) * ldc + u.pn * 256 + wc * 32 + 4 * fq;
#pragma unroll
                for (int bj = 0; bj < 2; ++bj)
#pragma unroll
                    for (int n = 0; n < 2; ++n) *(f32x4*)(rowp + bj * 128 + n * 16) = acc[ai][bj][m][n];
            }
    }
};

struct EpiYa {
    static constexpr bool PERM = false, AFTER_DRAIN = false;
    P p;
    __device__ __forceinline__ void operator()(const f32x4 (&acc)[2][2][4][2], const Unit& u, int wr, int wc, int fr, int fq) const {
#pragma unroll
        for (int ai = 0; ai < 2; ++ai)
#pragma unroll
            for (int m = 0; m < 4; ++m) {
                const int row = u.pm * 256 + ai * 128 + wr * 64 + m * 16 + fr;
#pragma unroll
                for (int bj = 0; bj < 2; ++bj)
#pragma unroll
                    for (int n = 0; n < 2; ++n) {
                        const int c = u.pn * 256 + bj * 128 + wc * 32 + n * 16 + fq * 4;
                        const uint2 gw = *(const uint2*)(p.mg() + (size_t)row * 2048 + c);
                        f32x4 g; g[0] = __uint_as_float(gw.x << 16); g[1] = __uint_as_float(gw.x & 0xffff0000u); g[2] = __uint_as_float(gw.y << 16); g[3] = __uint_as_float(gw.y & 0xffff0000u);
                        *(f32x4*)(p.tmp() + (size_t)row * DM + c) = g * acc[ai][bj][m][n];
                    }
            }
    }
};
struct EpiYb {
    static constexpr bool PERM = false, AFTER_DRAIN = false;
    P p;
    __device__ __forceinline__ void operator()(const f32x4 (&acc)[2][2][4][2], const Unit& u, int wr, int wc, int fr, int fq) const {
#pragma unroll
        for (int ai = 0; ai < 2; ++ai)
#pragma unroll
            for (int m = 0; m < 4; ++m) {
                const int row = u.pm * 256 + ai * 128 + wr * 64 + m * 16 + fr;
#pragma unroll
                for (int bj = 0; bj < 2; ++bj)
#pragma unroll
                    for (int n = 0; n < 2; ++n) {
                        const int c = u.pn * 256 + bj * 128 + wc * 32 + n * 16 + fq * 4;
                        const uint2 gw = *(const uint2*)(p.mg() + (size_t)row * 2048 + 1024 + c);
                        f32x4 g; g[0] = __uint_as_float(gw.x << 16); g[1] = __uint_as_float(gw.x & 0xffff0000u); g[2] = __uint_as_float(gw.y << 16); g[3] = __uint_as_float(gw.y & 0xffff0000u);
                        const f32x4 t = *(const f32x4*)(p.tmp() + (size_t)row * DM + c);
                        st_bf4(p.mb() + (size_t)row * DM + c, t + g * acc[ai][bj][m][n]);
                    }
            }
    }
};
struct EpiOut {
    static constexpr bool PERM = false, AFTER_DRAIN = false;
    P p;
    __device__ __forceinline__ void operator()(const f32x4 (&acc)[2][2][4][2], const Unit& u, int wr, int wc, int fr, int fq) const {
#pragma unroll
        for (int ai = 0; ai < 2; ++ai)
#pragma unroll
            for (int m = 0; m < 4; ++m) {
                const int row = u.pm * 256 + ai * 128 + wr * 64 + m * 16 + fr;
                const float* xr = row < NP ? p.x_prompt + (size_t)row * DM : p.x_sample + (size_t)(row - NP) * DM;
                float ss = 0.f;
#pragma unroll
                for (int bj = 0; bj < 2; ++bj)
#pragma unroll
                    for (int n = 0; n < 2; ++n) {
                        const int c = u.pn * 256 + bj * 128 + wc * 32 + n * 16 + fq * 4;
                        const f32x4 v = *(const f32x4*)(xr + c) + acc[ai][bj][m][n];
                        *(f32x4*)(p.x1() + (size_t)row * DM + c) = v;
                        ss += v[0] * v[0] + v[1] * v[1] + v[2] * v[2] + v[3] * v[3];
                        st_bf4(p.xg() + (size_t)row * DM + c, v * *(const f32x4*)(p.ple_g + c));
                    }
                ss += __shfl_xor(ss, 16); ss += __shfl_xor(ss, 32);
                if (fq == 0) p.ss1()[(size_t)row * 16 + u.pn * 4 + wc] = ss;
            }
    }
};
struct EpiGate {
    static constexpr bool PERM = false, AFTER_DRAIN = false;
    P p;
    __device__ __forceinline__ void operator()(const f32x4 (&acc)[2][2][4][2], const Unit& u, int wr, int wc, int fr, int fq) const {
#pragma unroll
        for (int ai = 0; ai < 2; ++ai)
#pragma unroll
            for (int m = 0; m < 4; ++m) {
                const int row = u.pm * 256 + ai * 128 + wr * 64 + m * 16 + fr;
                float ss = 0.f;
#pragma unroll
                for (int i = 0; i < 4; ++i) { const f32x4 t = *(const f32x4*)(p.ss1() + (size_t)row * 16 + i * 4); ss += (t[0] + t[1]) + (t[2] + t[3]); }
                const float rstd = rsqrtf(ss * (1.0f / DM) + 1e-6f);
#pragma unroll
                for (int bj = 0; bj < 2; ++bj)
#pragma unroll
                    for (int n = 0; n < 2; ++n) {
                        const int c = u.pn * 256 + bj * 128 + wc * 32 + n * 16 + fq * 4;
                        const f32x4 a = acc[ai][bj][m][n] * rstd;
                        f32x4 g; for (int e = 0; e < 4; ++e) g[e] = sigmoidf_(a[e]);
                        float* ppp = p.pp() + (size_t)row * DM + c;
                        *(f32x4*)ppp = *(const f32x4*)(p.x1() + (size_t)row * DM + c) + g * *(const f32x4*)ppp;
                    }
            }
    }
};

__device__ __forceinline__ void ph_final(const P& p) {
    const int tid = threadIdx.x, lane = tid & 63, wid = tid >> 6;
    for (int row = blockIdx.x * 8 + wid; row < MR; row += gridDim.x * 8) {
        const float4* src = (const float4*)(p.pp() + (size_t)row * DM);
        float4 v[4]; float ss = 0.f;
#pragma unroll
        for (int i = 0; i < 4; ++i) { v[i] = src[lane + 64 * i]; ss += v[i].x * v[i].x + v[i].y * v[i].y + v[i].z * v[i].z + v[i].w * v[i].w; }
        ss = wave_sum(ss);
        const float rstd = rsqrtf(ss * (1.0f / DM) + 1e-6f);
        float4* dst = (float4*)(p.out + (row < NP ? O_Y_P + (size_t)row * DM : O_Y_S + (size_t)(row - NP) * DM));
#pragma unroll
        for (int i = 0; i < 4; ++i) {
            const float4 g = ((const float4*)p.final_g)[lane + 64 * i];
            float4 o; o.x = v[i].x * rstd * g.x; o.y = v[i].y * rstd * g.y; o.z = v[i].z * rstd * g.z; o.w = v[i].w * rstd * g.w;
            dst[lane + 64 * i] = o;
        }
    }
}

__device__ __forceinline__ void ph_compress2(const P& p, const float* LH, int nbg, int nrows, int nblk, bf16_t* kc, bf16_t* vcT) {
    const int tid = threadIdx.x, lane = tid & 63, wid = tid >> 6, col = lane & 31, hb = lane >> 5;
    const int ntile = nrows >> 5, total = 2 * nbg * ntile;
    for (int it = blockIdx.x * 8 + wid; it < total; it += gridDim.x * 8) {
        const int tile = it % ntile, bg = (it / ntile) % nbg, kvi = it / (ntile * nbg);
        const int i = tile * 32 + col;
        const bool live = i < nblk;
        const float* l0 = LH + ((size_t)kvi * nbg * nrows + (size_t)bg * nrows + (live ? i : 0)) * 256;
        const float* ptp = p.pt() + kvi * 128;
        const bf16_t* w2t = p.W2T() + (size_t)kvi * 64 * 128;
        f32x16 acc[2]; acc[0] = zero16(); acc[1] = zero16();
#pragma unroll
        for (int ks = 0; ks < 8; ++ks) {
            const int f = 16 * ks + 8 * hb;
            float hv[8];
#pragma unroll
            for (int q = 0; q < 2; ++q) {
                const f32x4 lo = *(const f32x4*)(l0 + f + 4 * q), hi = *(const f32x4*)(l0 + 256 + 128 + f + 4 * q), pv = *(const f32x4*)(ptp + f + 4 * q);
#pragma unroll
                for (int e = 0; e < 4; ++e) hv[4 * q + e] = siluf_(lo[e] + hi[e] + pv[e]);
            }
            const bf16x8 hf = pack8(hv[0], hv[1], hv[2], hv[3], hv[4], hv[5], hv[6], hv[7]);
#pragma unroll
            for (int dt = 0; dt < 2; ++dt) {
                const bf16x8 wf = *(const bf16x8*)(w2t + (size_t)(32 * dt + col) * 128 + f);
                acc[dt] = (kvi == 0) ? mfma32(wf, hf, acc[dt]) : mfma32(hf, wf, acc[dt]);
            }
        }
        if (kvi == 0) {
            bf16_t* dst = kc + ((size_t)bg * nrows + i) * 64;
#pragma unroll
            for (int dt = 0; dt < 2; ++dt)
#pragma unroll
                for (int i4 = 0; i4 < 4; ++i4) {
                    const int d = 32 * dt + 8 * i4 + 4 * hb;
                    const f32x4 b2 = *(const f32x4*)(p.cmp_b2 + d);
                    f32x4 v; for (int e = 0; e < 4; ++e) v[e] = live ? acc[dt][4 * i4 + e] + b2[e] : 0.f;
                    st_bf4(dst + d, v);
                }
        } else {
#pragma unroll
            for (int dt = 0; dt < 2; ++dt) {
                const int d = 32 * dt + col;
                const float b2 = p.cmp_b2[64 + d];
                bf16_t* dst = vcT + ((size_t)bg * 64 + d) * nrows + tile * 32;
#pragma unroll
                for (int i4 = 0; i4 < 4; ++i4) {
                    const int r = 8 * i4 + 4 * hb;
                    f32x4 v; for (int e = 0; e < 4; ++e) v[e] = (tile * 32 + r + e) < nblk ? acc[dt][4 * i4 + e] + b2 : 0.f;
                    st_bf4(dst + r, v);
                }
            }
        }
    }
}

__device__ __forceinline__ void ph_cvt_cache(const P& p) {
    const size_t total = (size_t)2 * DB * 2 * PAST * 8;
    for (size_t id = (size_t)blockIdx.x * NTHR + threadIdx.x; id < total; id += (size_t)gridDim.x * NTHR) {
        const int d8 = (int)(id & 7), tok = (int)((id >> 3) & (PAST - 1)), g = (int)((id >> 17) & 1), b = (int)((id >> 18) & 31), kvi = (int)(id >> 23);
        const int page = p.page_table[b * 128 + (tok >> 7)];
        const float4* src = (const float4*)(p.cache_cmp + ((size_t)page * 128 + (tok & 127)) * 256 + kvi * 128 + g * 64 + d8 * 8);
        const float4 a = src[0], c = src[1];
        uint4 w; w.x = pk2(a.x, a.y); w.y = pk2(a.z, a.w); w.z = pk2(c.x, c.y); w.w = pk2(c.z, c.w);
        *(uint4*)(p.cs() + id * 8) = w;
    }
}

#if defined(OLD_RWKV_PREP)
__device__ __forceinline__ void ph_rwkv_prep(const P& p) {
    const int tid = threadIdx.x, lane = tid & 63, wid = tid >> 6;
    for (int it = blockIdx.x * 8 + wid; it < MR * 8; it += gridDim.x * 8) {
        const int row = it >> 3, h = it & 7, c = h * 64 + lane;
        const float* z = p.rz() + (size_t)row * CR;
        const float* pv;
        bool zero_prev = false;
        if (row < NP) { if ((row & (SEQ - 1)) == 0) { zero_prev = true; pv = z; } else pv = z - CR; }
        else { const int rs = row - NP; if ((rs & 7) == 0) pv = p.state_shift + (size_t)(rs >> 3) * CR; else pv = z - CR; }
        auto lerp = [&](int col) { const float zz = z[col]; const float pr = zero_prev ? 0.f : pv[col]; return zz + (pr - zz) * p.mu[col]; };
        const float zr = lerp(c), zk = lerp(512 + c), zv = lerp(1024 + c), zwd = lerp(1536 + lane), zad = lerp(1600 + lane);
        const float th = tanhf(zwd);
        float accw = p.w0[c], acca = p.a0[c];
#pragma unroll 8
        for (int j = 0; j < 64; ++j) {
            const float tj = __shfl(th, j), aj = __shfl(zad, j);
            accw += tj * p.w_up[j * 512 + c]; acca += aj * p.a_up[j * 512 + c];
        }
        const float nx = -accw;
        const float sp = fmaxf(nx, 0.f) + log1pf(__expf(-fabsf(nx)));
        const float w = -sp - 0.5f;
        const float dec = __expf(-__expf(w));
        const float a = sigmoidf_(acca);
        const float kkr = zk * p.k_k[c];
        const float nrm = sqrtf(wave_sum(kkr * kkr));
        const float kk = kkr / fmaxf(nrm, 1e-12f);
        const float km = zk * (1.0f + (a - 1.0f) * p.k_a[c]);
        const float bon = wave_sum(zr * km * p.r_k[c]);
        float* o = p.rw6() + (size_t)it * 384 + lane;
        o[0] = zr; o[64] = dec; o[128] = km; o[192] = zv; o[256] = kk; o[320] = kk * a;
        if (lane == 0) p.bonus()[it] = bon;
        if (h == 0) {
            float* so = nullptr;
            if (row < NP) { if ((row & (SEQ - 1)) == SEQ - 1) so = p.out + O_SH_P + (size_t)(row >> 12) * CR; }
            else { const int rs = row - NP; if ((rs & 7) == 7) so = p.out + O_SH_S + (size_t)(rs >> 3) * CR; }
            if (so) for (int i = lane; i < CR; i += 64) so[i] = z[i];
        }
    }
}

#else
__device__ __forceinline__ float dpp_row_sum16(float v) {
    v += __builtin_bit_cast(float, __builtin_amdgcn_mov_dpp(__builtin_bit_cast(int, v), 0xB1, 0xF, 0xF, true));
    v += __builtin_bit_cast(float, __builtin_amdgcn_mov_dpp(__builtin_bit_cast(int, v), 0x4E, 0xF, 0xF, true));
    v += __builtin_bit_cast(float, __builtin_amdgcn_mov_dpp(__builtin_bit_cast(int, v), 0x141, 0xF, 0xF, true));
    v += __builtin_bit_cast(float, __builtin_amdgcn_mov_dpp(__builtin_bit_cast(int, v), 0x140, 0xF, 0xF, true));
    return v;
}
__device__ __forceinline__ float half_sum32(float v) { v = dpp_row_sum16(v); return v + __shfl_xor(v, 16); }
__device__ __forceinline__ const float* rwkv_prev_row(const P& p, int row) {
    if (row < NP) return (row & (SEQ - 1)) == 0 ? nullptr : p.rz() + (size_t)(row - 1) * CR;
    const int rs = row - NP;
    return (rs & 7) == 0 ? p.state_shift + (size_t)(rs >> 3) * CR : p.rz() + (size_t)(row - 1) * CR;
}
__device__ __forceinline__ void ph_rwkv_prep(const P& p) {
    const int tid = threadIdx.x, lane = tid & 63, wid = tid >> 6, col = lane & 31, hb = lane >> 5;
    const int gw = blockIdx.x * 8 + wid, nw = gridDim.x * 8;
    for (int it = gw; it < NB + DB; it += nw) {
        const int row = it < NB ? it * SEQ + SEQ - 1 : NP + (it - NB) * 8 + 7;
        float* so = it < NB ? p.out + O_SH_P + (size_t)it * CR : p.out + O_SH_S + (size_t)(it - NB) * CR;
        const float* z = p.rz() + (size_t)row * CR;
        for (int i = lane; i < CR; i += 64) so[i] = z[i];
    }
    for (int it = gw; it < (MR / 32) * 8; it += nw) {
        const int h = it & 7, r0 = (it >> 3) * 32;
        bf16x8 Aw[4], Aa[4];
        {
            const int row = r0 + col;
            const float* z = p.rz() + (size_t)row * CR;
            const float* pv = rwkv_prev_row(p, row);
#pragma unroll
            for (int ks = 0; ks < 4; ++ks) {
                const int j0 = 16 * ks + 8 * hb;
                float tw[8], ta[8];
#pragma unroll
                for (int q = 0; q < 2; ++q) {
                    const f32x4 zw = *(const f32x4*)(z + 1536 + j0 + 4 * q), za = *(const f32x4*)(z + 1600 + j0 + 4 * q);
                    f32x4 pw, pa;
                    if (pv) { pw = *(const f32x4*)(pv + 1536 + j0 + 4 * q); pa = *(const f32x4*)(pv + 1600 + j0 + 4 * q); } else { pw = (f32x4){0.f, 0.f, 0.f, 0.f}; pa = pw; }
                    const f32x4 mw = *(const f32x4*)(p.mu + 1536 + j0 + 4 * q), ma = *(const f32x4*)(p.mu + 1600 + j0 + 4 * q);
#pragma unroll
                    for (int e = 0; e < 4; ++e) { tw[4 * q + e] = tanhf(zw[e] + (pw[e] - zw[e]) * mw[e]); ta[4 * q + e] = za[e] + (pa[e] - za[e]) * ma[e]; }
                }
                Aw[ks] = pack8(tw[0], tw[1], tw[2], tw[3], tw[4], tw[5], tw[6], tw[7]);
                Aa[ks] = pack8(ta[0], ta[1], ta[2], ta[3], ta[4], ta[5], ta[6], ta[7]);
            }
        }
        f32x16 accw[2], acca[2];
#pragma unroll
        for (int ct = 0; ct < 2; ++ct) {
            accw[ct] = zero16(); acca[ct] = zero16();
            const size_t wo = (size_t)(h * 64 + 32 * ct + col) * 64 + 8 * hb;
#pragma unroll
            for (int ks = 0; ks < 4; ++ks) {
                accw[ct] = mfma32(Aw[ks], *(const bf16x8*)(p.WupT() + wo + 16 * ks), accw[ct]);
                acca[ct] = mfma32(Aa[ks], *(const bf16x8*)(p.AupT() + wo + 16 * ks), acca[ct]);
            }
        }
        float w0v[2], a0v[2], kkv[2], kav[2], rkv[2], mur[2], muk[2], muv[2];
#pragma unroll
        for (int ct = 0; ct < 2; ++ct) {
            const int c = h * 64 + 32 * ct + col;
            w0v[ct] = p.w0[c]; a0v[ct] = p.a0[c]; kkv[ct] = p.k_k[c]; kav[ct] = p.k_a[c]; rkv[ct] = p.r_k[c];
            mur[ct] = p.mu[c]; muk[ct] = p.mu[512 + c]; muv[ct] = p.mu[1024 + c];
        }
#pragma unroll 2
        for (int i = 0; i < 16; ++i) {
            const int row = r0 + (i & 3) + 8 * (i >> 2) + 4 * hb;
            const float* z = p.rz() + (size_t)row * CR;
            const float* pv = rwkv_prev_row(p, row);
            float zr[2], zk[2], zv[2], dec[2], av[2], kkr[2], km[2];
            float n2 = 0.f, bon = 0.f;
#pragma unroll
            for (int ct = 0; ct < 2; ++ct) {
                const int c = h * 64 + 32 * ct + col;
                const float z0 = z[c], z1 = z[512 + c], z2 = z[1024 + c];
                const float p0 = pv ? pv[c] : 0.f, p1 = pv ? pv[512 + c] : 0.f, p2 = pv ? pv[1024 + c] : 0.f;
                zr[ct] = z0 + (p0 - z0) * mur[ct]; zk[ct] = z1 + (p1 - z1) * muk[ct]; zv[ct] = z2 + (p2 - z2) * muv[ct];
                const float nx = -(w0v[ct] + accw[ct][i]);
                const float sp = fmaxf(nx, 0.f) + log1pf(__expf(-fabsf(nx)));
                dec[ct] = __expf(-__expf(-sp - 0.5f));
                av[ct] = sigmoidf_(a0v[ct] + acca[ct][i]);
                kkr[ct] = zk[ct] * kkv[ct];
                km[ct] = zk[ct] * (1.0f + (av[ct] - 1.0f) * kav[ct]);
                n2 += kkr[ct] * kkr[ct];
                bon += zr[ct] * km[ct] * rkv[ct];
            }
            n2 = half_sum32(n2); bon = half_sum32(bon);
            const float rn = 1.0f / fmaxf(sqrtf(n2), 1e-12f);
            float* o = p.rw6() + ((size_t)row * 8 + h) * 384 + col;
#pragma unroll
            for (int ct = 0; ct < 2; ++ct) {
                const float kk = kkr[ct] * rn;
                float* oc = o + 32 * ct;
                oc[0] = zr[ct]; oc[64] = dec[ct]; oc[128] = km[ct]; oc[192] = zv[ct]; oc[256] = kk; oc[320] = kk * av[ct];
            }
            if (col == 0) p.bonus()[(size_t)row * 8 + h] = bon;
        }
    }
}

#endif
typedef float f32x2 __attribute__((ext_vector_type(2)));
__device__ __forceinline__ float dpp_row_sum(float v) {
    v += __builtin_bit_cast(float, __builtin_amdgcn_mov_dpp(__builtin_bit_cast(int, v), 0xB1, 0xF, 0xF, true));
    v += __builtin_bit_cast(float, __builtin_amdgcn_mov_dpp(__builtin_bit_cast(int, v), 0x4E, 0xF, 0xF, true));
    v += __builtin_bit_cast(float, __builtin_amdgcn_mov_dpp(__builtin_bit_cast(int, v), 0x141, 0xF, 0xF, true));
    v += __builtin_bit_cast(float, __builtin_amdgcn_mov_dpp(__builtin_bit_cast(int, v), 0x140, 0xF, 0xF, true));
    return v;
}
constexpr int SCAN_TC = 32;
__device__ __forceinline__ void scan_item(const P& p, LAS float* lds, int row0, int T, int h, int half, const float* s0, float* sout) {
    const int tid = threadIdx.x, w = tid >> 6, lane = tid & 63, rl = lane >> 4, kq = lane & 15;
    const int vrow = half * 32 + w * 4 + rl;
    f32x4 S;
    if (s0) S = *(const f32x4*)(s0 + vrow * 64 + kq * 4); else { S[0] = 0.f; S[1] = 0.f; S[2] = 0.f; S[3] = 0.f; }
    const float* src = p.rw6() + ((size_t)row0 * 8 + h) * 384;
    const int nchunk = (T + SCAN_TC - 1) / SCAN_TC;
    f32x4 stg[6];
    int so[6], ss[6];
#pragma unroll
    for (int i = 0; i < 6; ++i) { const int idx = i * 512 + tid; ss[i] = idx / 96; so[i] = (idx % 96) * 4; }
    {
        const int ns = T < SCAN_TC ? T : SCAN_TC;
#pragma unroll
        for (int i = 0; i < 6; ++i) if (ss[i] < ns) *(LAS f32x4*)(lds + ss[i] * 384 + so[i]) = *(const f32x4*)(src + (size_t)ss[i] * 3072 + so[i]);
    }
    __syncthreads();
    for (int c = 0; c < nchunk; ++c) {
        const int t0 = c * SCAN_TC;
        const int ns = (T - t0) < SCAN_TC ? (T - t0) : SCAN_TC;
        const bool more = (c + 1) < nchunk;
        const int nns = more ? ((T - t0 - SCAN_TC) < SCAN_TC ? (T - t0 - SCAN_TC) : SCAN_TC) : 0;
        if (more) {
#pragma unroll
            for (int i = 0; i < 6; ++i) if (ss[i] < nns) stg[i] = *(const f32x4*)(src + (size_t)(t0 + SCAN_TC + ss[i]) * 3072 + so[i]);
        }
        LAS const float* buf = lds + (c & 1) * (SCAN_TC * 384);
        float* yo = p.ybuf() + (size_t)(row0 + t0) * 512 + h * 64 + vrow;
#pragma unroll 4
        for (int s = 0; s < ns; ++s) {
            LAS const float* bs = buf + s * 384 + kq * 4;
            const f32x4 r = *(LAS const f32x4*)(bs), d = *(LAS const f32x4*)(bs + 64), km = *(LAS const f32x4*)(bs + 128),
                        kk = *(LAS const f32x4*)(bs + 256), ka = *(LAS const f32x4*)(bs + 320);
            const float vv = buf[s * 384 + 192 + vrow];
            const f32x4 t1 = S * kk;
            float sa = dpp_row_sum((t1[0] + t1[1]) + (t1[2] + t1[3]));
            sa = -sa;
            S = S * d + ka * sa + km * vv;
            const f32x4 t2 = S * r;
            const float y = dpp_row_sum((t2[0] + t2[1]) + (t2[2] + t2[3]));
            if (kq == 0) yo[(size_t)s * 512] = y;
        }
        if (more) {
            LAS float* nb = lds + ((c + 1) & 1) * (SCAN_TC * 384);
#pragma unroll
            for (int i = 0; i < 6; ++i) if (ss[i] < nns) *(LAS f32x4*)(nb + ss[i] * 384 + so[i]) = stg[i];
        }
        __syncthreads();
    }
    *(f32x4*)(sout + vrow * 64 + kq * 4) = S;
}
__device__ __forceinline__ void ph_rwkv_scan(const P& p, LAS float* lds) {
    constexpr int NSCAN = 64;
    if ((int)blockIdx.x < NSCAN) {
        const int item = blockIdx.x >> 1, half = blockIdx.x & 1;
        scan_item(p, lds, (item >> 3) * SEQ, SEQ, item & 7, half, nullptr, p.out + O_WKV_P + (size_t)item * 4096);
    } else {
        const int nb = (int)gridDim.x - NSCAN;
        for (int hi = (int)blockIdx.x - NSCAN; hi < 512; hi += nb) {
            const int item = hi >> 1, half = hi & 1;
            scan_item(p, lds, NP + (item >> 3) * 8, 8, item & 7, half, p.state_wkv + (size_t)item * 4096, p.out + O_WKV_S + (size_t)item * 4096);
        }
    }
}

__device__ __forceinline__ void ph_rwkv_post(const P& p) {
    const int tid = threadIdx.x, lane = tid & 63, wid = tid >> 6;
    for (int it = blockIdx.x * 8 + wid; it < MR * 8; it += gridDim.x * 8) {
        const int row = it >> 3, h = it & 7, c = h * 64 + lane;
        const float y = p.ybuf()[(size_t)row * 512 + c];
        const float mean = wave_sum(y) * (1.0f / 64.0f);
        const float dv = y - mean;
        const float var = wave_sum(dv * dv) * (1.0f / 64.0f);
        float yn = dv * rsqrtf(var + 64e-5f) * p.gn_g[c] + p.gn_b[c];
        yn += p.bonus()[it] * p.rw6()[(size_t)it * 384 + 192 + lane];
        p.ob()[(size_t)row * 512 + c] = f2bf(yn * bf2f(p.rg()[(size_t)row * 512 + c]));
    }
}
#ifndef SMODE
#define SMODE 3
#endif
#ifndef ATTN_MODE
#define ATTN_MODE 3
#endif

struct KSrcBf { const bf16_t* base; __device__ __forceinline__ bf16x8 operator()(int tok0, int ks, int lane) const { return *(const bf16x8*)(base + (size_t)(tok0 + (lane & 31)) * 64 + 16 * ks + 8 * (lane >> 5)); } };
struct VSrcBfT { const bf16_t* base; int ld; __device__ __forceinline__ bf16x8 operator()(int tok0, int dt, int s2, int lane) const {
        const bf16_t* ptr = base + (size_t)(32 * dt + (lane & 31)) * ld + tok0 + 16 * s2 + 4 * (lane >> 5);
        union { uint4 u; bf16x8 v; } x; const uint2 a = *(const uint2*)ptr, b = *(const uint2*)(ptr + 8); x.u.x = a.x; x.u.y = a.y; x.u.z = b.x; x.u.w = b.y; return x.v; } };

template <class KS>
__device__ __forceinline__ f32x16 qk_tile(const bf16x8 (&qf)[4], const KS& ks, int tok0, int lane) {
    f32x16 s = zero16();
#pragma unroll
    for (int k = 0; k < 4; ++k) s = mfma32(ks(tok0, k, lane), qf[k], s);
    return s;
}
template <class OKF>
__device__ __forceinline__ void sm_stats(const f32x16& s, int hb, OKF ok, float& m, float& l) {
    float sv[16]; float tmax = -1e30f; unsigned okm = 0;
#pragma unroll
    for (int i = 0; i < 16; ++i) { const int kl = (i & 3) + 8 * (i >> 2) + 4 * hb; const bool k = ok(kl); okm |= (k ? 1u : 0u) << i; sv[i] = k ? s[i] : -1e30f; tmax = fmaxf(tmax, sv[i]); }
    tmax = fmaxf(tmax, __shfl_xor(tmax, 32));
    const float mn = fmaxf(m, tmax), alpha = __expf(m - mn); m = mn;
    float ps = 0.f;
#pragma unroll
    for (int i = 0; i < 16; ++i) ps += ((okm >> i) & 1u) ? __expf(sv[i] - mn) : 0.f;
    l = l * alpha + ps;
}
template <class OKF, class VF>
__device__ __forceinline__ void sm_pv(const f32x16& s, int hb, OKF ok, VF vf, float& m, float& l, f32x16 (&o)[2]) {
    float sv[16]; float tmax = -1e30f; unsigned okm = 0;
#pragma unroll
    for (int i = 0; i < 16; ++i) { const int kl = (i & 3) + 8 * (i >> 2) + 4 * hb; const bool k = ok(kl); okm |= (k ? 1u : 0u) << i; sv[i] = k ? s[i] : -1e30f; tmax = fmaxf(tmax, sv[i]); }
    tmax = fmaxf(tmax, __shfl_xor(tmax, 32));
    const float mn = fmaxf(m, tmax), alpha = __expf(m - mn); m = mn;
    float pr[16]; float ps = 0.f;
#pragma unroll
    for (int i = 0; i < 16; ++i) { pr[i] = ((okm >> i) & 1u) ? __expf(sv[i] - mn) : 0.f; ps += pr[i]; }
    l = l * alpha + ps;
    o[0] *= alpha; o[1] *= alpha;
#pragma unroll
    for (int s2 = 0; s2 < 2; ++s2) {
        const bf16x8 pb = pack8(pr[8 * s2 + 0], pr[8 * s2 + 1], pr[8 * s2 + 2], pr[8 * s2 + 3], pr[8 * s2 + 4], pr[8 * s2 + 5], pr[8 * s2 + 6], pr[8 * s2 + 7]);
#pragma unroll
        for (int dt = 0; dt < 2; ++dt) o[dt] = mfma32(vf(dt, s2), pb, o[dt]);
    }
}
template <class OKF, class VF>
__device__ __forceinline__ void cmp_pass2(const f32x16& s, int hb, OKF ok, VF vf, float m, float inv, f32x16 (&o)[2], LAS float* prow, bool writer) {
    float pr[16];
#pragma unroll
    for (int i = 0; i < 16; ++i) {
        const int kl = (i & 3) + 8 * (i >> 2) + 4 * hb;
        pr[i] = ok(kl) ? __expf(s[i] - m) * inv : 0.f;
        float q = pr[i] + __shfl_xor(pr[i], 1); q += __shfl_xor(q, 2);
        if (writer) prow[kl] = q;
    }
#pragma unroll
    for (int s2 = 0; s2 < 2; ++s2) {
        const bf16x8 pb = pack8(pr[8 * s2 + 0], pr[8 * s2 + 1], pr[8 * s2 + 2], pr[8 * s2 + 3], pr[8 * s2 + 4], pr[8 * s2 + 5], pr[8 * s2 + 6], pr[8 * s2 + 7]);
#pragma unroll
        for (int dt = 0; dt < 2; ++dt) o[dt] = mfma32(vf(dt, s2), pb, o[dt]);
    }
}

__device__ __forceinline__ void attn_store(const P& p, const f32x16 (&of)[2], int qrow, int head, int hb, bool doit) {
    if (!doit) return;
#pragma unroll
    for (int dt = 0; dt < 2; ++dt)
#pragma unroll
        for (int i4 = 0; i4 < 4; ++i4) {
            const int d = 32 * dt + 8 * i4 + 4 * hb;
            const size_t off = (size_t)qrow * 512 + head * 64 + d;
            const uint2 gw = *(const uint2*)(p.ag() + off);
            f32x4 v;
            v[0] = of[dt][4 * i4 + 0] * __uint_as_float(gw.x << 16); v[1] = of[dt][4 * i4 + 1] * __uint_as_float(gw.x & 0xffff0000u);
            v[2] = of[dt][4 * i4 + 2] * __uint_as_float(gw.y << 16); v[3] = of[dt][4 * i4 + 3] * __uint_as_float(gw.y & 0xffff0000u);
            st_bf4(p.oa() + off, v);
        }
}


__device__ __forceinline__ void of_put(LAS float* st, int lane, const f32x16 (&o)[2], float sc) {
#pragma unroll
    for (int dt = 0; dt < 2; ++dt)
#pragma unroll
        for (int i = 0; i < 16; ++i) st[(dt * 16 + i) * 64 + lane] = o[dt][i] * sc;
}
__device__ __forceinline__ void of_add(LAS float* st, int lane, const f32x16 (&o)[2], float sc) {
#pragma unroll
    for (int dt = 0; dt < 2; ++dt)
#pragma unroll
        for (int i = 0; i < 16; ++i) st[(dt * 16 + i) * 64 + lane] += o[dt][i] * sc;
}
__device__ __forceinline__ void of_get_add(LAS float* st, int lane, const f32x16 (&o)[2], float sc, f32x16 (&of)[2]) {
#pragma unroll
    for (int dt = 0; dt < 2; ++dt)
#pragma unroll
        for (int i = 0; i < 16; ++i) of[dt][i] = st[(dt * 16 + i) * 64 + lane] + o[dt][i] * sc;
}


template <class NEXT, class OKF>
__device__ __forceinline__ void tile_loop(const bf16x8 (&qf)[4], const KSrcBf& ksrc, const VSrcBfT& vsrc, int tt, NEXT next, OKF ok, int lane, float& m, float& l, f32x16 (&o)[2]) {
    if (tt < 0) return;
    const int hb = lane >> 5;
    bf16x8 kf[4];
#pragma unroll
    for (int ks = 0; ks < 4; ++ks) kf[ks] = ksrc(32 * tt, ks, lane);
#pragma unroll 1
    for (;;) {
        const int tok0 = 32 * tt;
        const int nt = next(tt);
        bf16x8 vf[2][2];
#pragma unroll
        for (int dt = 0; dt < 2; ++dt)
#pragma unroll
            for (int s2 = 0; s2 < 2; ++s2) vf[dt][s2] = vsrc(tok0, dt, s2, lane);
        bf16x8 kn[4];
        const int ntc = nt >= 0 ? nt : tt;
#pragma unroll
        for (int ks = 0; ks < 4; ++ks) kn[ks] = ksrc(32 * ntc, ks, lane);
        f32x16 s = zero16();
#pragma unroll
        for (int ks = 0; ks < 4; ++ks) s = mfma32(kf[ks], qf[ks], s);
        sm_pv(s, hb, [&](int kl) { return ok(tok0, kl); }, [&](int dt, int s2) { return vf[dt][s2]; }, m, l, o);
        if (nt < 0) break;
#pragma unroll
        for (int ks = 0; ks < 4; ++ks) kf[ks] = kn[ks];
        tt = nt;
    }
}

__device__ __forceinline__ void attn_prompt_item(const P& p, int item, LAS unsigned char* wl, int lane) {
    const int bg = item & 7, tg = item >> 3, b = bg >> 1, g = bg & 1;
    const int col = lane & 31, hb = lane >> 5, tl = col >> 2, hh = col & 3;
    const int t0 = tg * 8, qpos = t0 + tl, qrow = b * SEQ + qpos, head = g * 4 + hh;
    bf16x8 qf[4];
#pragma unroll
    for (int ks = 0; ks < 4; ++ks) qf[ks] = *(const bf16x8*)(p.qb() + (size_t)qrow * 512 + head * 64 + 16 * ks + 8 * hb);
    LAS float* psum = (LAS float*)wl;
    LAS unsigned long long* msk = (LAS unsigned long long*)(wl + 8192);
    const float g0 = p.gates()[(size_t)qrow * 32 + head * 3 + 0], g1 = p.gates()[(size_t)qrow * 32 + head * 3 + 1], g2 = p.gates()[(size_t)qrow * 32 + head * 3 + 2];
    f32x16 oc[2]; oc[0] = zero16(); oc[1] = zero16();
    {
        const int cm = t0 + 7 - 31;
        const int ntile = cm >= 0 ? ((cm >> 4) >> 5) + 1 : 0;
        const KSrcBf ksrc{p.kc_p() + (size_t)bg * 256 * 64};
        const VSrcBfT vsrc{p.vcT_p() + (size_t)bg * 64 * 256, 256};
        float m = -1e30f, l = 0.f;
#pragma unroll 1
        for (int kt = 0; kt < ntile; ++kt) {
            const f32x16 s = qk_tile(qf, ksrc, 32 * kt, lane);
            sm_stats(s, hb, [&](int kl) { return 16 * (32 * kt + kl) + 31 <= qpos; }, m, l);
        }
        l += __shfl_xor(l, 32);
        const float inv = l > 0.f ? 1.0f / l : 0.f;
#pragma unroll
        for (int i = 0; i < 32; ++i) psum[i * 64 + lane] = 0.f;
        WAVE_SYNC();
#pragma unroll 1
        for (int kt = 0; kt < ntile; ++kt) {
            const f32x16 s = qk_tile(qf, ksrc, 32 * kt, lane);
            cmp_pass2(s, hb, [&](int kl) { return 16 * (32 * kt + kl) + 31 <= qpos; }, [&](int dt, int s2) { return vsrc(32 * kt, dt, s2, lane); }, m, inv, oc,
                      psum + tl * 256 + 32 * kt, hh == 0);
        }
    }
    WAVE_SYNC();
    for (int t2 = 0; t2 < 8; ++t2) {
        const int t = t0 + t2, cur = t >> 6, n = lane;
        float imp = 0.f;
#pragma unroll
        for (int c = -1; c < 4; ++c) { const int cc = 4 * n + c; if (cc >= 0) imp += psum[t2 * 256 + cc]; }
        if (n == 0 || n == cur || n == cur - 1) imp = 1e4f;
        if (n * 64 > t) imp = -1.0f;
        int rank = 0;
#pragma unroll
        for (int j = 0; j < 64; ++j) {
            const float vj = __uint_as_float(__builtin_amdgcn_readlane(__float_as_uint(imp), j));
            rank += (vj > imp || (vj == imp && j < n)) ? 1 : 0;
        }
        const unsigned long long mk = __ballot(rank < 16);
        if (lane == 0) msk[t2] = mk;
    }
    WAVE_SYNC();
    const unsigned long long mymask = msk[tl];
    unsigned long long um = 0;
#pragma unroll
    for (int i = 0; i < 8; ++i) um |= msk[i];
    const int cur0 = t0 >> 6;
    WAVE_SYNC();
    LAS float* ost = (LAS float*)wl;
    of_put(ost, lane, oc, g0);
    {
        const KSrcBf ksrc{p.kb() + (size_t)((1 * NB + b) * 2 + g) * SEQ * 64};
        const VSrcBfT vsrc{p.vT() + (size_t)((0 * NB + b) * 2 + g) * 64 * SEQ, SEQ};
        float m = -1e30f, l = 0.f; f32x16 o[2]; o[0] = zero16(); o[1] = zero16();
        {
            const unsigned um_lo = __builtin_amdgcn_readfirstlane((unsigned)um), um_hi = __builtin_amdgcn_readfirstlane((unsigned)(um >> 32));
            unsigned long long umu = ((unsigned long long)um_hi << 32) | um_lo;
            if (cur0 < 63) umu &= (2ull << cur0) - 1ull;
            const int first = umu ? 2 * (int)__builtin_ctzll(umu) : -1;
            tile_loop(qf, ksrc, vsrc, first,
                      [&](int tt) { if (!(tt & 1)) return tt + 1; const int n = tt >> 1; if (n >= 63) return -1; const unsigned long long rem = umu >> (n + 1); return rem ? 2 * (n + 1 + (int)__builtin_ctzll(rem)) : -1; },
                      [&](int tok0, int kl) { return (bool)((mymask >> (tok0 >> 6)) & 1ull) && (tok0 + kl <= qpos); }, lane, m, l, o);
        }
        l += __shfl_xor(l, 32);
        const float sc = l > 0.f ? g1 / l : 0.f;
        of_add(ost, lane, o, sc);
    }
    {
        const KSrcBf ksrc{p.kb() + (size_t)((2 * NB + b) * 2 + g) * SEQ * 64};
        const VSrcBfT vsrc{p.vT() + (size_t)((1 * NB + b) * 2 + g) * 64 * SEQ, SEQ};
        float m = -1e30f, l = 0.f; f32x16 o[2]; o[0] = zero16(); o[1] = zero16();
        const int lo = t0 - 511;
        const int nlo = lo > 0 ? (lo >> 6) : 0;
        {
            const int last = 2 * cur0 + 1;
            tile_loop(qf, ksrc, vsrc, 2 * nlo, [&](int tt) { return tt < last ? tt + 1 : -1; },
                      [&](int tok0, int kl) { const int key = tok0 + kl; return key <= qpos && key + 511 >= qpos; }, lane, m, l, o);
        }
        l += __shfl_xor(l, 32);
        const float sc = l > 0.f ? g2 / l : 0.f;
        f32x16 of[2];
        of_get_add(ost, lane, o, sc, of);
        attn_store(p, of, qrow, head, hb, true);
    }
    WAVE_SYNC();
}

template <class RP, class OKF>
__device__ __forceinline__ void f32_tile(const bf16x8 (&qf)[4], RP rp, OKF ok, LAS bf16_t* vt, int lane, float& m, float& l, f32x16 (&o)[2]) {
    const int col = lane & 31, hb = lane >> 5;
    const float* kr = rp(col);
    f32x16 s = zero16();
#pragma unroll
    for (int ks = 0; ks < 4; ++ks) {
        const float4 a = *(const float4*)(kr + 16 * ks + 8 * hb), c = *(const float4*)(kr + 16 * ks + 8 * hb + 4);
        s = mfma32(pack8(a.x, a.y, a.z, a.w, c.x, c.y, c.z, c.w), qf[ks], s);
    }
    const float* vr = kr + 128 + 32 * hb;
#pragma unroll
    for (int j4 = 0; j4 < 8; ++j4) {
        const float4 a = *(const float4*)(vr + 4 * j4);
        vt[(32 * hb + 4 * j4 + 0) * 40 + col] = f2bf(a.x); vt[(32 * hb + 4 * j4 + 1) * 40 + col] = f2bf(a.y);
        vt[(32 * hb + 4 * j4 + 2) * 40 + col] = f2bf(a.z); vt[(32 * hb + 4 * j4 + 3) * 40 + col] = f2bf(a.w);
    }
    WAVE_SYNC();
    sm_pv(s, hb, ok, [&](int dt, int s2) {
        LAS const bf16_t* ptr = vt + (32 * dt + col) * 40 + 16 * s2 + 4 * hb;
        union { uint4 u; bf16x8 v; } x; const u32x2 a = *(LAS const u32x2*)ptr, c = *(LAS const u32x2*)(ptr + 8); x.u.x = a[0]; x.u.y = a[1]; x.u.z = c[0]; x.u.w = c[1]; return x.v; }, m, l, o);
    WAVE_SYNC();
}

__device__ __forceinline__ void attn_sample_item(const P& p, int item, LAS unsigned char* wl, int lane) {
    const int t = item & 7, g = (item >> 3) & 1, b = item >> 4, bg = b * 2 + g;
    const int col = lane & 31, hb = lane >> 5, hh = col & 3;
    const int qpos = PAST + t, qrow = NP + b * 8 + t, head = g * 4 + hh;
    bf16x8 qf[4];
#pragma unroll
    for (int ks = 0; ks < 4; ++ks) qf[ks] = *(const bf16x8*)(p.qb() + (size_t)qrow * 512 + head * 64 + 16 * ks + 8 * hb);
    LAS float* psum = (LAS float*)wl;
    LAS int* list = (LAS int*)(wl + 8256);
    LAS float* impl = (LAS float*)(wl + 8448);
    LAS bf16_t* vt = (LAS bf16_t*)(wl + 9728);
    const float g0 = p.gates()[(size_t)qrow * 32 + head * 3 + 0], g1 = p.gates()[(size_t)qrow * 32 + head * 3 + 1], g2 = p.gates()[(size_t)qrow * 32 + head * 3 + 2];
    f32x16 oc[2]; oc[0] = zero16(); oc[1] = zero16();
    {
        const KSrcBf ksrc{p.kc_s() + (size_t)bg * 1024 * 64};
        const VSrcBfT vsrc{p.vcT_s() + (size_t)bg * 64 * 1024, 1024};
        float m = -1e30f, l = 0.f;
#pragma unroll 1
        for (int kt = 0; kt < 32; ++kt) {
            const f32x16 s = qk_tile(qf, ksrc, 32 * kt, lane);
            sm_stats(s, hb, [&](int kl) { return 32 * kt + kl <= 1022; }, m, l);
        }
        l += __shfl_xor(l, 32);
        const float inv = l > 0.f ? 1.0f / l : 0.f;
#pragma unroll 1
        for (int kt = 0; kt < 32; ++kt) {
            const f32x16 s = qk_tile(qf, ksrc, 32 * kt, lane);
            cmp_pass2(s, hb, [&](int kl) { return 32 * kt + kl <= 1022; }, [&](int dt, int s2) { return vsrc(32 * kt, dt, s2, lane); }, m, inv, oc, psum + 32 * kt, col == 0);
        }
    }
    WAVE_SYNC();
#pragma unroll
    for (int j = 0; j < 5; ++j) {
        const int n = lane + 64 * j;
        if (n <= 256) {
            float imp = 0.f;
            for (int c = -1; c < 4; ++c) { const int cc = 4 * n + c; if (cc >= 0 && cc <= 1022) imp += psum[cc]; }
            impl[n] = imp;
        }
    }
    WAVE_SYNC();
    {
        int base = 0;
#pragma unroll
        for (int j = 0; j < 4; ++j) {
            const int n = lane + 64 * j;
            const bool cand = n >= 1 && n <= 254;
            const float v = impl[n];
            int rank = 0;
            for (int q = 1; q <= 254; ++q) { const float vq = impl[q]; rank += (vq > v || (vq == v && q < n)) ? 1 : 0; }
            const bool sel = cand && rank < 13;
            const unsigned long long mk = __ballot(sel);
            if (sel) list[base + __popcll(mk & ((1ull << lane) - 1ull))] = n;
            base += __popcll(mk);
        }
        if (lane == 0) { list[13] = 0; list[14] = 255; list[15] = 256; }
    }
    WAVE_SYNC();
#if SMODE & 1
    LAS float* ost = (LAS float*)wl;
    of_put(ost, lane, oc, g0);
    {
        float m = -1e30f, l = 0.f; f32x16 o[2]; o[0] = zero16(); o[1] = zero16();
#pragma unroll 1
        for (int li = 0; li < 16; ++li) {
#if SMODE & 4
            const int n = li < 13 ? 17 * li + 5 : (li == 13 ? 0 : 242 + li);
#else
            const int n = __builtin_amdgcn_readfirstlane(list[li]);
#endif
            if (n < 256) {
                const int page = p.page_table[b * 128 + (n >> 1)];
                const float* base = p.cache_sel + ((size_t)page * 128 + (n & 1) * 64) * 256 + g * 64;
#pragma unroll 1
                for (int k2 = 0; k2 < 2; ++k2)
                    f32_tile(qf, [&](int kl) { return base + (size_t)(32 * k2 + kl) * 256; }, [&](int kl) { return true; }, vt, lane, m, l, o);
            } else {
                const float* base = p.out + O_SEL_S + (size_t)(b * 8) * 256 + g * 64;
                f32_tile(qf, [&](int kl) { return base + (size_t)(kl < 8 ? kl : 7) * 256; }, [&](int kl) { return kl <= t; }, vt, lane, m, l, o);
            }
        }
        l += __shfl_xor(l, 32);
        const float sc = l > 0.f ? g1 / l : 0.f;
        of_add(ost, lane, o, sc);
    }
#endif
#if SMODE & 2
    {
        float m = -1e30f, l = 0.f; f32x16 o[2]; o[0] = zero16(); o[1] = zero16();
        const float* cw = p.cache_win + (size_t)b * 512 * 256 + g * 64;
        const float* nw = p.out + O_WIN_S + ((size_t)b * 512 + 504) * 256 + g * 64;
#pragma unroll 1
        for (int kt = 0; kt < 17; ++kt) {
            f32_tile(qf, [&](int kl) { const int j = 32 * kt + kl; return j < 512 ? cw + (size_t)j * 256 : nw + (size_t)(j - 512 < 8 ? j - 512 : 7) * 256; },
                     [&](int kl) { const int j = 32 * kt + kl; return j >= t + 1 && j <= 512 + t; }, vt, lane, m, l, o);
        }
        l += __shfl_xor(l, 32);
        const float sc = l > 0.f ? g2 / l : 0.f;
        f32x16 of[2];
        of_get_add(ost, lane, o, sc, of);
        attn_store(p, of, qrow, head, hb, col < 4);
    }
    WAVE_SYNC();
#endif
}

__device__ __forceinline__ void ph_attn(const P& p, LAS unsigned char* lds) {
    const int tid = threadIdx.x, lane = tid & 63, wid = tid >> 6;
    LAS unsigned char* wl = lds + wid * 16384;
    unsigned* ctr = p.bar() + 3584;
    for (;;) {
        unsigned q = 0;
        if (lane == 0) q = __hip_atomic_fetch_add(ctr, 1u, __ATOMIC_RELAXED, __HIP_MEMORY_SCOPE_AGENT);
        q = __builtin_amdgcn_readfirstlane(q);
        if (q >= 512u + 4096u) break;
        if (q < 512u) attn_sample_item(p, (int)q, wl, lane);
        else attn_prompt_item(p, 4095 - (int)(q - 512u), wl, lane);
    }
}
#ifndef STOP_AFTER
#define STOP_AFTER 3
#endif

constexpr int LDS_BYTES = pg8::STAGE_BYTES;

template <class Epi> __global__ __launch_bounds__(512, 2) void k_gemm(pg8::Gemm g, Epi E) {
    extern __shared__ __attribute__((aligned(16))) unsigned char shm[];
    pg8::StaticOrder S; S.init(g.M, g.N, (int)gridDim.x, (int)blockIdx.x);
    pg8::gemm_phase<Epi, pg8::StaticOrder, false>((PG8_LAS unsigned char*)shm, g, S, E, nullptr);
}
template <int PH> __global__ __launch_bounds__(512, 2) void k_phase(P p) {
    extern __shared__ __attribute__((aligned(16))) unsigned char shm[];
    LAS unsigned char* lds = (LAS unsigned char*)shm;
    if constexpr (PH == 0) ph_prep(p);
    if constexpr (PH == 1) ph_compress2(p, p.LHp(), 8, 256, 255, p.kc_p(), p.vcT_p());
    if constexpr (PH == 2) ph_cvt_cache(p);
    if constexpr (PH == 3) ph_compress2(p, p.LHs(), 64, 1024, 1023, p.kc_s(), p.vcT_s());
    if constexpr (PH == 4) ph_rwkv_prep(p);
    if constexpr (PH == 5) ph_rwkv_scan(p, (LAS float*)lds);
    if constexpr (PH == 6) ph_rwkv_post(p);
    if constexpr (PH == 7) ph_attn(p, lds);
    if constexpr (PH == 8) ph_final(p);
}

template <class Epi> static void launch_gemm(hipStream_t st, const bf16_t* A, const bf16_t* Bt, int M, int N, int K, const Epi& E) {
    static bool attr = false;
    if (!attr) { (void)hipFuncSetAttribute((const void*)k_gemm<Epi>, hipFuncAttributeMaxDynamicSharedMemorySize, LDS_BYTES); attr = true; }
    pg8::Gemm g{}; g.A = A; g.Bt = Bt; g.M = M; g.N = N; g.K = K;
    hipLaunchKernelGGL((k_gemm<Epi>), dim3(256), dim3(512), LDS_BYTES, st, g, E);
}
template <int PH> static void launch_phase(hipStream_t st, const P& p) {
    static bool attr = false;
    if (!attr) { (void)hipFuncSetAttribute((const void*)k_phase<PH>, hipFuncAttributeMaxDynamicSharedMemorySize, LDS_BYTES); attr = true; }
    hipLaunchKernelGGL((k_phase<PH>), dim3(256), dim3(512), LDS_BYTES, st, p);
}


constexpr int FUSED_LDS = LDS_BYTES + 256;

template <class Epi> __device__ __forceinline__ void run_gemm(LAS unsigned char* lds, const bf16_t* A, const bf16_t* Bt, int M, int N, int K, const Epi& E) {
    pg8::Gemm g; g.A = A; g.Bt = Bt; g.M = M; g.N = N; g.K = K; g.pad_ = 0;
    pg8::StaticOrder S; S.init(M, N, (int)gridDim.x, (int)blockIdx.x);
    pg8::gemm_phase<Epi, pg8::StaticOrder, false>((PG8_LAS unsigned char*)lds, g, S, E, nullptr);
}

__global__ __launch_bounds__(512, 2) void k_fused(P p) {
    extern __shared__ __attribute__((aligned(16))) unsigned char shm[];
    LAS unsigned char* lds = (LAS unsigned char*)shm;
    LAS unsigned* xb = (LAS unsigned*)(lds + LDS_BYTES);
    if (threadIdx.x == 0) { xb[0] = 0u; xb[1] = 0u; xb[2] = 0u; xb[3] = 0u; }
    __syncthreads();
    XcdBarrier bar = xcd_barrier_post(p.bar(), (volatile LAS unsigned*)xb);
    ph_prep(p);
    ph_cvt_cache(p);
    xcd_barrier(bar);
    { EpiIn e; e.p = p; run_gemm(lds, p.hb(), p.WinT(), MR, NPAD, DM, e); }
    { EpiPlain e; e.C = p.LHs(); e.ldc = 256; e.pad_ = 0; run_gemm(lds, p.cs(), p.W1T(), 65536, 256, 1024, e); }
    { EpiPlain e; e.C = p.LHs() + (size_t)65536 * 256; e.ldc = 256; e.pad_ = 0; run_gemm(lds, p.cs() + (size_t)65536 * 1024, p.W1T() + (size_t)256 * 1024, 65536, 256, 1024, e); }
    xcd_barrier(bar);
    { EpiPlain e; e.C = p.LHp(); e.ldc = 256; e.pad_ = 0; run_gemm(lds, p.kb(), p.W1T(), 2048, 256, 1024, e); }
    { EpiPlain e; e.C = p.LHp() + (size_t)2048 * 256; e.ldc = 256; e.pad_ = 0; run_gemm(lds, p.vcr(), p.W1T() + (size_t)256 * 1024, 2048, 256, 1024, e); }
    ph_rwkv_prep(p);
    ph_compress2(p, p.LHs(), 64, 1024, 1023, p.kc_s(), p.vcT_s());
    xcd_barrier(bar);
    ph_compress2(p, p.LHp(), 8, 256, 255, p.kc_p(), p.vcT_p());
    xcd_barrier(bar);
    ph_rwkv_scan(p, (LAS float*)lds);
    __syncthreads();
    ph_attn(p, lds);
    xcd_barrier(bar);
    ph_rwkv_post(p);
    { EpiYa e; e.p = p; run_gemm(lds, p.oa(), p.WpaT(), MR, DM, 512, e); }
    xcd_barrier(bar);
    { EpiYb e; e.p = p; run_gemm(lds, p.ob(), p.WpbT(), MR, DM, 512, e); }
    xcd_barrier(bar);
    { EpiOut e; e.p = p; run_gemm(lds, p.mb(), p.WoutT(), MR, DM, DM, e); }
    { EpiPlain e; e.C = p.pp(); e.ldc = DM; e.pad_ = 0; run_gemm(lds, p.pb(), p.WprojT(), MR, DM, 256, e); }
    xcd_barrier(bar);
    { EpiGate e; e.p = p; run_gemm(lds, p.xg(), p.WgateT(), MR, DM, DM, e); }
    xcd_barrier(bar);
    ph_final(p);
}
extern "C" void kernel_launch(void* const* d_in, const int* in_sizes, int n_in, void* d_out, int out_size, void* d_ws, size_t ws_size, hipStream_t stream) {
    (void)in_sizes; (void)n_in; (void)out_size; (void)ws_size;
    P p{};
    p.x_prompt = (const float*)d_in[0]; p.x_sample = (const float*)d_in[1]; p.p_prompt = (const float*)d_in[2]; p.p_sample = (const float*)d_in[3];
    p.cache_cmp = (const float*)d_in[4]; p.cache_sel = (const float*)d_in[5]; p.cache_win = (const float*)d_in[6]; p.state_wkv = (const float*)d_in[7];
    p.state_shift = (const float*)d_in[8]; p.page_table = (const int*)d_in[9]; p.norm_g = (const float*)d_in[10]; p.w_in = (const float*)d_in[11];
    p.cmp_pe = (const float*)d_in[12]; p.cmp_w1 = (const float*)d_in[13]; p.cmp_b1 = (const float*)d_in[14]; p.cmp_w2 = (const float*)d_in[15]; p.cmp_b2 = (const float*)d_in[16];
    p.w_pa = (const float*)d_in[17]; p.mu = (const float*)d_in[18]; p.w0 = (const float*)d_in[19]; p.w_up = (const float*)d_in[20]; p.a0 = (const float*)d_in[21];
    p.a_up = (const float*)d_in[22]; p.k_k = (const float*)d_in[23]; p.k_a = (const float*)d_in[24]; p.r_k = (const float*)d_in[25]; p.gn_g = (const float*)d_in[26];
    p.gn_b = (const float*)d_in[27]; p.w_pb = (const float*)d_in[28]; p.w_out = (const float*)d_in[29]; p.ple_g = (const float*)d_in[30]; p.w_gate = (const float*)d_in[31];
    p.w_proj = (const float*)d_in[32]; p.final_g = (const float*)d_in[33];
    p.out = (float*)d_out;
    p.ws = (unsigned char*)d_ws;

#if defined(MULTI_LAUNCH)
    launch_phase<0>(stream, p);
    { EpiIn e{}; e.p = p; launch_gemm(stream, p.hb(), p.WinT(), MR, NPAD, DM, e); }
#if STOP_AFTER >= 3
    { EpiPlain e{}; e.C = p.LHp(); e.ldc = 256; launch_gemm(stream, p.kb(), p.W1T(), 2048, 256, 1024, e); }
    { EpiPlain e{}; e.C = p.LHp() + (size_t)2048 * 256; e.ldc = 256; launch_gemm(stream, p.vcr(), p.W1T() + (size_t)256 * 1024, 2048, 256, 1024, e); }
    launch_phase<1>(stream, p);
    launch_phase<2>(stream, p);
    { EpiPlain e{}; e.C = p.LHs(); e.ldc = 256; launch_gemm(stream, p.cs(), p.W1T(), 65536, 256, 1024, e); }
    { EpiPlain e{}; e.C = p.LHs() + (size_t)65536 * 256; e.ldc = 256; launch_gemm(stream, p.cs() + (size_t)65536 * 1024, p.W1T() + (size_t)256 * 1024, 65536, 256, 1024, e); }
    launch_phase<3>(stream, p);
#endif
#if STOP_AFTER >= 2
    launch_phase<4>(stream, p);
    launch_phase<5>(stream, p);
    launch_phase<6>(stream, p);
#endif
    hipMemsetAsync(p.oa(), 0, (size_t)MR * 512 * 2, stream);
#if STOP_AFTER >= 3
    launch_phase<7>(stream, p);
#endif
    { EpiYa e{}; e.p = p; launch_gemm(stream, p.oa(), p.WpaT(), MR, DM, 512, e); }
    { EpiYb e{}; e.p = p; launch_gemm(stream, p.ob(), p.WpbT(), MR, DM, 512, e); }
    { EpiOut e{}; e.p = p; launch_gemm(stream, p.mb(), p.WoutT(), MR, DM, DM, e); }
    { EpiPlain e{}; e.C = p.pp(); e.ldc = DM; launch_gemm(stream, p.pb(), p.WprojT(), MR, DM, 256, e); }
    { EpiGate e{}; e.p = p; launch_gemm(stream, p.xg(), p.WgateT(), MR, DM, DM, e); }
    launch_phase<8>(stream, p);
#else
    static int grid = 0;
    if (!grid) {
        int dev = 0, cus = 0, per_cu = 0;
        (void)hipGetDevice(&dev);
        (void)hipDeviceGetAttribute(&cus, hipDeviceAttributeMultiprocessorCount, dev);
        (void)hipFuncSetAttribute((const void*)k_fused, hipFuncAttributeMaxDynamicSharedMemorySize, FUSED_LDS);
        (void)hipOccupancyMaxActiveBlocksPerMultiprocessor(&per_cu, k_fused, 512, FUSED_LDS);
        grid = per_cu >= 1 ? cus : 0;
        if (grid > 256) grid = 256;
    }
    (void)hipMemsetAsync(p.bar(), 0, 16384, stream);
    if (grid > 0) hipLaunchKernelGGL(k_fused, dim3(grid), dim3(512), FUSED_LDS, stream, p);
#endif
}
```

```cpp
#include <hip/hip_runtime.h>
#include <stdint.h>
#include <stdio.h>
namespace pg8 {
#define PG8_LAS __attribute__((address_space(3)))
typedef unsigned short bf16_t;
typedef short bf16x8 __attribute__((ext_vector_type(8)));
typedef float f32x4 __attribute__((ext_vector_type(4)));
typedef unsigned u32x4 __attribute__((ext_vector_type(4)));
constexpr int BM = 256, BK = 64, HALF = 128, HTB = HALF * BK * 2  , STAGE_BYTES = 8 * HTB, NXCD = 8, WGM = 8;

__host__ __device__ __forceinline__ int lds_byte(int r, int c) { const int st = (r >> 4) * 2 + (c >> 5), rr = r & 15, cc = c & 31, ob = rr * 64 + cc * 2; return st * 1024 + (ob ^ (((ob >> 9) & 1) << 5)); }
__host__ __device__ __forceinline__ void stage_rc(int b, int& R, int& C) { const int st = b / 1024, sb = b % 1024, swz = sb ^ (((sb >> 9) & 1) << 5); R = (st >> 1) * 16 + swz / 64; C = (st & 1) * 32 + (swz % 64) / 2; }
__host__ __device__ __forceinline__ int perm32(int rho) { const int n = rho >> 4, i = rho & 15; return 8 * (i >> 2) + 4 * n + (i & 3); }

struct Unit { int pm, pn; };
struct Gemm { const bf16_t* A; const bf16_t* Bt; int M, N, K, pad_; };

struct StaticOrder {
    int nM, nN, nwg, G, c;
    __host__ __device__ void init(int M, int N, int G_, int c_) { nM = M / BM; nN = N / BM; nwg = nM * nN; G = G_; c = c_; }
    __host__ __device__ bool next(int i, Unit& u) const {
        const long L = (long)i * G + c; if (L >= nwg) return false;
        int wgid = (int)L; { const int q = nwg / NXCD, r = nwg % NXCD, xcd = wgid % NXCD, off = wgid / NXCD; wgid = (xcd < r ? xcd * (q + 1) : r * (q + 1) + (xcd - r) * q) + off; }
        const int nig = WGM * nN, gid = wgid / nig, fm = gid * WGM, gsz = (nM - fm) < WGM ? (nM - fm) : WGM;
        u.pm = fm + ((wgid % nig) % gsz); u.pn = (wgid % nig) / gsz; return true;
    }
    __device__ __forceinline__ void a_ready(const Unit&) const {}
    __device__ __forceinline__ void done(const Unit&) const {}
};
__device__ __forceinline__ unsigned cvt_pk_bf16(float lo, float hi) { unsigned r; asm volatile("v_cvt_pk_bf16_f32 %0, %1, %2" : "=v"(r) : "v"(lo), "v"(hi)); return r; }
typedef float f32x2 __attribute__((ext_vector_type(2)));
template <class Epi, class Sched, bool STAMP = false>
__device__ __forceinline__ void gemm_phase(PG8_LAS unsigned char* lds, const Gemm g, const Sched& S, const Epi& E, unsigned long long* stamps) {
    int tid_l = threadIdx.x; asm volatile("" : "+v"(tid_l));
    const int tid = tid_l, wid = __builtin_amdgcn_readfirstlane(tid >> 6), lane = tid & 63, wr = wid >> 2, wc = wid & 3, fr = lane & 15, fq = lane >> 4;
    const int K = g.K, nt = K / BK;
    int ts_lo = 0, ts_hi = 0, nts = 0; const unsigned long long rt_entry = STAMP ? (unsigned long long)wall_clock64() : 0ull;
#define PG8_STAMP() do { if (STAMP && wid == 0 && nts < 64) { const unsigned long long _c = (unsigned long long)clock64(); \
        ts_lo = (lane == nts) ? (int)(unsigned)_c : ts_lo; ts_hi = (lane == nts) ? (int)(unsigned)(_c >> 32) : ts_hi; ++nts; } } while (0)
    PG8_STAMP();
    unsigned voffA[2], voffB[2];
#pragma unroll
    for (int i = 0; i < 2; ++i) { int R, C; stage_rc(tid * 16 + i * 8192, R, C); const int Rb = Epi::PERM ? ((R & ~31) + perm32(R & 31)) : R;
        voffA[i] = (unsigned)(R * K + C) * 2u; voffB[i] = (unsigned)(Rb * K + C) * 2u; }
    const size_t kstep = (size_t)(BK * 2);
    const size_t hstep = (size_t)HALF * K * 2;
    const size_t tstep = 2 * hstep;
    const unsigned ldsw = (unsigned)wid * 1024u;
    const int aoff = lds_byte(wr * 64 + fr, fq * 8), boff = lds_byte(wc * 32 + fr, fq * 8);
#define PG8_SA(b, h) (((b) * 2 + (h)) * HTB)
#define PG8_SB(b, h) ((4 + (b) * 2 + (h)) * HTB)
#define PG8_STAGE(bufoff, gbase, voff) do { _Pragma("unroll") for (int _i = 0; _i < 2; ++_i) \
        __builtin_amdgcn_global_load_lds((const unsigned*)((const char*)(gbase) + (voff)[_i]), (PG8_LAS unsigned*)(lds + (bufoff) + ldsw + _i * 8192), 16, 0, 0); } while (0)
#define PG8_LDA(dst, b, h) do { _Pragma("unroll") for (int m = 0; m < 4; ++m) _Pragma("unroll") for (int k = 0; k < 2; ++k) dst[m][k] = *(const PG8_LAS bf16x8*)(lds + PG8_SA(b, h) + aoff + m * 2048 + k * 1024); } while (0)
#define PG8_LDB(dst, b, h) do { _Pragma("unroll") for (int n = 0; n < 2; ++n) _Pragma("unroll") for (int k = 0; k < 2; ++k) dst[n][k] = *(const PG8_LAS bf16x8*)(lds + PG8_SB(b, h) + boff + n * 2048 + k * 1024); } while (0)
#define PG8_MMA(ai, bj, At, Bt) do { __builtin_amdgcn_s_setprio(1); _Pragma("unroll") for (int m = 0; m < 4; ++m) _Pragma("unroll") for (int n = 0; n < 2; ++n) _Pragma("unroll") for (int k = 0; k < 2; ++k) \
        acc[ai][bj][m][n] = __builtin_amdgcn_mfma_f32_16x16x32_bf16(Bt[n][k], At[m][k], acc[ai][bj][m][n], 0, 0, 0); __builtin_amdgcn_s_setprio(0); } while (0)
#define PG8_WAIT_V(n) asm volatile("s_waitcnt vmcnt(" #n ")" ::: "memory")
#define PG8_WAIT_L(n) asm volatile("s_waitcnt lgkmcnt(" #n ")" ::: "memory")
#define PG8_BAR __builtin_amdgcn_s_barrier()
#define PG8_SCHED __builtin_amdgcn_sched_barrier(0)
    Unit cur, nxt; int ui = 0;
    if (!S.next(0, cur)) return;
    f32x4 acc[2][2][4][2];
#pragma unroll
    for (int a = 0; a < 2; ++a)
#pragma unroll
        for (int b = 0; b < 2; ++b)
#pragma unroll
            for (int m = 0; m < 4; ++m)
#pragma unroll
                for (int n = 0; n < 2; ++n) acc[a][b][m][n] = (f32x4){0.f, 0.f, 0.f, 0.f};
    bf16x8 At[4][2], B0[2][2], B1[2][2];
    const char* cA = (const char*)g.A + (size_t)cur.pm * tstep; const char* cB = (const char*)g.Bt + (size_t)cur.pn * tstep;
    S.a_ready(cur);
    PG8_STAGE(PG8_SB(0, 0), cB, voffB); PG8_STAGE(PG8_SA(0, 0), cA, voffA); PG8_STAGE(PG8_SB(0, 1), cB + hstep, voffB); PG8_STAGE(PG8_SA(0, 1), cA + hstep, voffA);
    if (wr == 1) PG8_BAR;
    PG8_WAIT_V(4); PG8_BAR;
    PG8_STAGE(PG8_SB(1, 0), cB + kstep, voffB); PG8_STAGE(PG8_SA(1, 0), cA + kstep, voffA); PG8_STAGE(PG8_SB(1, 1), cB + hstep + kstep, voffB);
    PG8_WAIT_V(6); PG8_BAR;
    PG8_STAMP();
    for (;;) {
        const bool has_next = S.next(ui + 1, nxt);
        const char* nA = has_next ? (const char*)g.A + (size_t)nxt.pm * tstep : cA; const char* nB = has_next ? (const char*)g.Bt + (size_t)nxt.pn * tstep : cB;
        for (int t = 0; t < nt; t += 2) {
            const bool last = (t == nt - 2);
            const char* a1 = cA + (size_t)(t + 1) * kstep;
            const char* a2 = last ? nA : cA + (size_t)(t + 2) * kstep; const char* b2 = last ? nB : cB + (size_t)(t + 2) * kstep;
            const char* a3 = a2 + kstep; const char* b3 = b2 + kstep;
            if (last && has_next) S.a_ready(nxt);
            PG8_LDB(B0, 0, 0); PG8_SCHED; PG8_LDA(At, 0, 0); PG8_STAGE(PG8_SA(1, 1), a1 + hstep, voffA);
            PG8_WAIT_L(8); PG8_BAR; PG8_WAIT_L(0); PG8_MMA(0, 0, At, B0); PG8_BAR; PG8_SCHED;
            PG8_LDB(B1, 0, 1); PG8_STAGE(PG8_SB(0, 0), b2, voffB);
            PG8_BAR; PG8_WAIT_L(0); PG8_MMA(0, 1, At, B1); PG8_BAR;
            PG8_LDA(At, 0, 1); PG8_STAGE(PG8_SA(0, 0), a2, voffA);
            PG8_BAR; PG8_WAIT_L(0); PG8_MMA(1, 0, At, B0); PG8_BAR; PG8_SCHED;
            PG8_STAGE(PG8_SB(0, 1), b2 + hstep, voffB);
            PG8_WAIT_V(6); PG8_BAR; PG8_MMA(1, 1, At, B1); PG8_BAR;
            PG8_LDB(B0, 1, 0); PG8_SCHED; PG8_LDA(At, 1, 0); PG8_STAGE(PG8_SA(0, 1), a2 + hstep, voffA);
            PG8_WAIT_L(8); PG8_BAR; PG8_WAIT_L(0); PG8_MMA(0, 0, At, B0); PG8_BAR; PG8_SCHED;
            PG8_LDB(B1, 1, 1); PG8_STAGE(PG8_SB(1, 0), b3, voffB);
            PG8_BAR; PG8_WAIT_L(0); PG8_MMA(0, 1, At, B1); PG8_BAR;
            PG8_LDA(At, 1, 1); PG8_STAGE(PG8_SA(1, 0), a3, voffA);
            PG8_BAR; PG8_WAIT_L(0); PG8_MMA(1, 0, At, B0); PG8_BAR; PG8_SCHED;
            PG8_STAGE(PG8_SB(1, 1), b3 + hstep, voffB);
            PG8_WAIT_V(6); PG8_BAR; PG8_MMA(1, 1, At, B1); PG8_BAR;
        }
        PG8_STAMP();
        if constexpr (!Epi::AFTER_DRAIN) { E(acc, cur, wr, wc, fr, fq); S.done(cur); }
        PG8_STAMP();
        if (!has_next) break;
#pragma unroll
        for (int a = 0; a < 2; ++a)
#pragma unroll
            for (int b = 0; b < 2; ++b)
#pragma unroll
                for (int m = 0; m < 4; ++m)
#pragma unroll
                    for (int n = 0; n < 2; ++n) acc[a][b][m][n] = (f32x4){0.f, 0.f, 0.f, 0.f};
        cur = nxt; cA = nA; cB = nB; ++ui;
    }
    PG8_WAIT_V(0);
    if (wr == 0) PG8_BAR;
    PG8_BAR;
    if constexpr (Epi::AFTER_DRAIN) { E.fused(acc, cur, wr, wc, fr, fq, lds, wid, lane); S.done(cur); }
    PG8_STAMP();
    if (STAMP && wid == 0) { stamps[lane] = lane < nts ? (((unsigned long long)(unsigned)ts_hi << 32) | (unsigned)ts_lo) : 0ull;
        if (lane == 62) stamps[62] = rt_entry; if (lane == 63) stamps[63] = (unsigned long long)wall_clock64(); }
#undef PG8_STAMP
#undef PG8_SA
#undef PG8_SB
#undef PG8_STAGE
#undef PG8_LDA
#undef PG8_LDB
#undef PG8_MMA
#undef PG8_WAIT_V
#undef PG8_WAIT_L
#undef PG8_BAR
#undef PG8_SCHED
}
}

typedef unsigned short bf16_t;
typedef short bf16x8 __attribute__((ext_vector_type(8)));
typedef float f32x4 __attribute__((ext_vector_type(4)));
typedef float f32x16 __attribute__((ext_vector_type(16)));
#define LAS __attribute__((address_space(3)))
#define WAVE_SYNC() do { asm volatile("s_waitcnt lgkmcnt(0)" ::: "memory"); __builtin_amdgcn_wave_barrier(); } while (0)

constexpr int DM = 1024, NP = 16384, NSMP = 256, MR = 16640, SEQ = 4096, NB = 4, DB = 32, DS = 8, PAST = 16384;
constexpr int CIN = 6040, NPAD = 6144, CR = 1664;
constexpr int NTHR = 512;
constexpr size_t O_Y_P = 0, O_Y_S = 16777216, O_CMP_P = 17039360, O_CMP_S = 21233664, O_SEL_P = 21299200, O_SEL_S = 25493504,
                 O_WIN_P = 25559040, O_WIN_S = 26083328, O_WKV_P = 30277632, O_WKV_S = 30408704, O_SH_P = 31457280, O_SH_S = 31463936;

constexpr size_t ws_al(size_t x) { return (x + 255) & ~(size_t)255; }
constexpr size_t WS_bar = 0;
constexpr size_t WS_hb = WS_bar + ws_al(32768);
constexpr size_t WS_WinT = WS_hb + ws_al((size_t)MR * DM * 2);
constexpr size_t WS_WpaT = WS_WinT + ws_al((size_t)NPAD * DM * 2);
constexpr size_t WS_WpbT = WS_WpaT + ws_al((size_t)DM * 512 * 2);
constexpr size_t WS_WoutT = WS_WpbT + ws_al((size_t)DM * 512 * 2);
constexpr size_t WS_WgateT = WS_WoutT + ws_al((size_t)DM * DM * 2);
constexpr size_t WS_WprojT = WS_WgateT + ws_al((size_t)DM * DM * 2);
constexpr size_t WS_W1T = WS_WprojT + ws_al((size_t)DM * 256 * 2);
constexpr size_t WS_W2T = WS_W1T + ws_al((size_t)512 * 1024 * 2);
constexpr size_t WS_WupT = WS_W2T + ws_al((size_t)128 * 128 * 2);
constexpr size_t WS_AupT = WS_WupT + ws_al((size_t)512 * 64 * 2);
constexpr size_t WS_pb = WS_AupT + ws_al((size_t)512 * 64 * 2);
constexpr size_t WS_tabc = WS_pb + ws_al((size_t)MR * 256 * 2);
constexpr size_t WS_tabs = WS_tabc + ws_al((size_t)4104 * 32 * 4);
constexpr size_t WS_pt = WS_tabs + ws_al((size_t)4104 * 32 * 4);
constexpr size_t WS_qb = WS_pt + ws_al(256 * 4);
constexpr size_t WS_kb = WS_qb + ws_al((size_t)MR * 512 * 2);
constexpr size_t WS_vcr = WS_kb + ws_al((size_t)3 * NB * 2 * SEQ * 64 * 2);
constexpr size_t WS_vT = WS_vcr + ws_al((size_t)NB * 2 * SEQ * 64 * 2);
constexpr size_t WS_ag = WS_vT + ws_al((size_t)2 * NB * 2 * 64 * SEQ * 2);
constexpr size_t WS_rg = WS_ag + ws_al((size_t)MR * 512 * 2);
constexpr size_t WS_mg = WS_rg + ws_al((size_t)MR * 512 * 2);
constexpr size_t WS_gates = WS_mg + ws_al((size_t)MR * 2048 * 2);
constexpr size_t WS_rz = WS_gates + ws_al((size_t)MR * 32 * 4);
constexpr size_t WS_LHp = WS_rz + ws_al((size_t)MR * CR * 4);
constexpr size_t WS_LHs = WS_LHp + ws_al((size_t)2 * 2048 * 256 * 4);
constexpr size_t WS_cs = WS_LHs + ws_al((size_t)2 * 65536 * 256 * 4);
constexpr size_t WS_kc_p = WS_cs + ws_al((size_t)2 * 65536 * 1024 * 2);
constexpr size_t WS_vcT_p = WS_kc_p + ws_al((size_t)8 * 256 * 64 * 2);
constexpr size_t WS_kc_s = WS_vcT_p + ws_al((size_t)8 * 64 * 256 * 2);
constexpr size_t WS_vcT_s = WS_kc_s + ws_al((size_t)64 * 1024 * 64 * 2);
constexpr size_t WS_rw6 = WS_vcT_s + ws_al((size_t)64 * 64 * 1024 * 2);
constexpr size_t WS_bonus = WS_rw6 + ws_al((size_t)MR * 8 * 384 * 4);
constexpr size_t WS_ybuf = WS_bonus + ws_al((size_t)MR * 8 * 4);
constexpr size_t WS_oa = WS_ybuf + ws_al((size_t)MR * 512 * 4);
constexpr size_t WS_ob = WS_oa + ws_al((size_t)MR * 512 * 2);
constexpr size_t WS_mb = WS_ob + ws_al((size_t)MR * 512 * 2);
constexpr size_t WS_xg = WS_mb + ws_al((size_t)MR * DM * 2);
constexpr size_t WS_tmp = WS_xg + ws_al((size_t)MR * DM * 2);
constexpr size_t WS_x1 = WS_tmp + ws_al((size_t)MR * DM * 4);
constexpr size_t WS_ss1 = WS_x1 + ws_al((size_t)MR * DM * 4);
constexpr size_t WS_pp = WS_ss1 + ws_al((size_t)MR * 16 * 4);
constexpr size_t WS_TOTAL = WS_pp + ws_al((size_t)MR * DM * 4);

struct P {
    const float *x_prompt, *x_sample, *p_prompt, *p_sample, *cache_cmp, *cache_sel, *cache_win, *state_wkv, *state_shift;
    const int* page_table;
    const float *norm_g, *w_in, *cmp_pe, *cmp_w1, *cmp_b1, *cmp_w2, *cmp_b2, *w_pa, *mu, *w0, *w_up, *a0, *a_up, *k_k, *k_a, *r_k, *gn_g, *gn_b,
        *w_pb, *w_out, *ple_g, *w_gate, *w_proj, *final_g;
    float* out;
    unsigned char* ws;
    __host__ __device__ __forceinline__ unsigned* bar() const { return (unsigned*)(ws + WS_bar); }
    __host__ __device__ __forceinline__ float* ss_s() const { return (float*)(ws + WS_bar + 16384); }
    __host__ __device__ __forceinline__ bf16_t* hb() const { return (bf16_t*)(ws + WS_hb); }
    __host__ __device__ __forceinline__ bf16_t* WinT() const { return (bf16_t*)(ws + WS_WinT); }
    __host__ __device__ __forceinline__ bf16_t* WpaT() const { return (bf16_t*)(ws + WS_WpaT); }
    __host__ __device__ __forceinline__ bf16_t* WpbT() const { return (bf16_t*)(ws + WS_WpbT); }
    __host__ __device__ __forceinline__ bf16_t* WoutT() const { return (bf16_t*)(ws + WS_WoutT); }
    __host__ __device__ __forceinline__ bf16_t* WgateT() const { return (bf16_t*)(ws + WS_WgateT); }
    __host__ __device__ __forceinline__ bf16_t* WprojT() const { return (bf16_t*)(ws + WS_WprojT); }
    __host__ __device__ __forceinline__ bf16_t* W1T() const { return (bf16_t*)(ws + WS_W1T); }
    __host__ __device__ __forceinline__ bf16_t* W2T() const { return (bf16_t*)(ws + WS_W2T); }
    __host__ __device__ __forceinline__ bf16_t* WupT() const { return (bf16_t*)(ws + WS_WupT); }
    __host__ __device__ __forceinline__ bf16_t* AupT() const { return (bf16_t*)(ws + WS_AupT); }
    __host__ __device__ __forceinline__ bf16_t* pb() const { return (bf16_t*)(ws + WS_pb); }
    __host__ __device__ __forceinline__ float* tabc() const { return (float*)(ws + WS_tabc); }
    __host__ __device__ __forceinline__ float* tabs() const { return (float*)(ws + WS_tabs); }
    __host__ __device__ __forceinline__ float* pt() const { return (float*)(ws + WS_pt); }
    __host__ __device__ __forceinline__ bf16_t* qb() const { return (bf16_t*)(ws + WS_qb); }
    __host__ __device__ __forceinline__ bf16_t* kb() const { return (bf16_t*)(ws + WS_kb); }
    __host__ __device__ __forceinline__ bf16_t* vcr() const { return (bf16_t*)(ws + WS_vcr); }
    __host__ __device__ __forceinline__ bf16_t* vT() const { return (bf16_t*)(ws + WS_vT); }
    __host__ __device__ __forceinline__ bf16_t* ag() const { return (bf16_t*)(ws + WS_ag); }
    __host__ __device__ __forceinline__ bf16_t* rg() const { return (bf16_t*)(ws + WS_rg); }
    __host__ __device__ __forceinline__ bf16_t* mg() const { return (bf16_t*)(ws + WS_mg); }
    __host__ __device__ __forceinline__ float* gates() const { return (float*)(ws + WS_gates); }
    __host__ __device__ __forceinline__ float* rz() const { return (float*)(ws + WS_rz); }
    __host__ __device__ __forceinline__ float* LHp() const { return (float*)(ws + WS_LHp); }
    __host__ __device__ __forceinline__ float* LHs() const { return (float*)(ws + WS_LHs); }
    __host__ __device__ __forceinline__ bf16_t* cs() const { return (bf16_t*)(ws + WS_cs); }
    __host__ __device__ __forceinline__ bf16_t* kc_p() const { return (bf16_t*)(ws + WS_kc_p); }
    __host__ __device__ __forceinline__ bf16_t* vcT_p() const { return (bf16_t*)(ws + WS_vcT_p); }
    __host__ __device__ __forceinline__ bf16_t* kc_s() const { return (bf16_t*)(ws + WS_kc_s); }
    __host__ __device__ __forceinline__ bf16_t* vcT_s() const { return (bf16_t*)(ws + WS_vcT_s); }
    __host__ __device__ __forceinline__ float* rw6() const { return (float*)(ws + WS_rw6); }
    __host__ __device__ __forceinline__ float* bonus() const { return (float*)(ws + WS_bonus); }
    __host__ __device__ __forceinline__ float* ybuf() const { return (float*)(ws + WS_ybuf); }
    __host__ __device__ __forceinline__ bf16_t* oa() const { return (bf16_t*)(ws + WS_oa); }
    __host__ __device__ __forceinline__ bf16_t* ob() const { return (bf16_t*)(ws + WS_ob); }
    __host__ __device__ __forceinline__ bf16_t* mb() const { return (bf16_t*)(ws + WS_mb); }
    __host__ __device__ __forceinline__ bf16_t* xg() const { return (bf16_t*)(ws + WS_xg); }
    __host__ __device__ __forceinline__ float* tmp() const { return (float*)(ws + WS_tmp); }
    __host__ __device__ __forceinline__ float* x1() const { return (float*)(ws + WS_x1); }
    __host__ __device__ __forceinline__ float* ss1() const { return (float*)(ws + WS_ss1); }
    __host__ __device__ __forceinline__ float* pp() const { return (float*)(ws + WS_pp); }
};

__device__ __forceinline__ bf16_t f2bf(float f) { unsigned u = __float_as_uint(f); u += 0x7FFFu + ((u >> 16) & 1u); return (bf16_t)(u >> 16); }
__device__ __forceinline__ float bf2f(bf16_t b) { return __uint_as_float(((unsigned)b) << 16); }
typedef __bf16 bf16v2_t __attribute__((ext_vector_type(2)));
typedef float f32x2_t __attribute__((ext_vector_type(2)));
__device__ __forceinline__ unsigned pk2(float lo, float hi) { const f32x2_t v = {lo, hi}; return __builtin_bit_cast(unsigned, __builtin_convertvector(v, bf16v2_t)); }
__device__ __forceinline__ float wave_sum(float v) {
#pragma unroll
    for (int o = 32; o >= 1; o >>= 1) v += __shfl_xor(v, o);
    return v;
}
__device__ __forceinline__ float sigmoidf_(float x) { return 1.0f / (1.0f + __expf(-x)); }
__device__ __forceinline__ float siluf_(float x) { return x / (1.0f + __expf(-x)); }

__device__ __forceinline__ int win_src_col(int np) {
    const int pn = np >> 8, p = np & 255;
    if (pn < 5) {
        const int bj = p >> 7, wc = (p >> 5) & 3, n = (p >> 4) & 1, fq = (p >> 2) & 3, e = p & 3;
        const int d = 32 * n + 16 * (wc & 1) + 4 * fq + e;
        if (pn < 2) { const int head = pn * 4 + bj * 2 + (wc >> 1); return head * 64 + d; }
        const int br = pn - 2, g = wc >> 1;
        return 512 + br * 256 + bj * 128 + g * 64 + d;
    }
    if (pn < 7) return 1304 + (pn - 5) * 256 + p;
    if (pn < 13) return 1816 + (pn - 7) * 256 + p;
    if (pn == 13) { if (p < 128) return 1816 + 1536 + p; if (p < 152) return 1280 + (p - 128); return -1; }
    if (pn < 16) return 3480 + (pn - 14) * 256 + p;
    return 3992 + (pn - 16) * 256 + p;
}

template <class F>
__device__ __forceinline__ void transpose_cvt(bf16_t* dst, int Nd, int K, F f) {
    const int total = Nd * (K >> 3);
    for (int id = blockIdx.x * NTHR + threadIdx.x; id < total; id += gridDim.x * NTHR) {
        const int n = id % Nd, kc = id / Nd;
        float v[8];
#pragma unroll
        for (int j = 0; j < 8; ++j) v[j] = f(n, kc * 8 + j);
        uint4 w; w.x = pk2(v[0], v[1]); w.y = pk2(v[2], v[3]); w.z = pk2(v[4], v[5]); w.w = pk2(v[6], v[7]);
        *(uint4*)(dst + (size_t)n * K + kc * 8) = w;
    }
}

__device__ __forceinline__ void sincos_small(double r, float& s, float& c) {
    const double r2 = r * r;
    double sa = 1.0, ca = 1.0;
    double ts = 1.0, tc = 1.0; sa = 0.0; ca = 0.0;
#pragma unroll
    for (int k = 0; k < 16; ++k) {
        sa += ts; ca += tc;
        ts = -ts * r2 / (double)((2 * k + 2) * (2 * k + 3));
        tc = -tc * r2 / (double)((2 * k + 1) * (2 * k + 2));
    }
    s = (float)(sa * r); c = (float)ca;
}

__device__ __forceinline__ void ph_prep(const P& p) {
    const int tid = threadIdx.x, lane = tid & 63, wid = tid >> 6;
    const int gw = blockIdx.x * 8 + wid, nw = gridDim.x * 8;
    const int gt = blockIdx.x * NTHR + tid, nt = gridDim.x * NTHR;
    for (int row = gw; row < MR; row += nw) {
        const float4* src = (const float4*)(row < NP ? p.x_prompt + (size_t)row * DM : p.x_sample + (size_t)(row - NP) * DM);
        float4 v[4]; float ss = 0.f;
#pragma unroll
        for (int i = 0; i < 4; ++i) { v[i] = src[lane + 64 * i]; ss += v[i].x * v[i].x + v[i].y * v[i].y + v[i].z * v[i].z + v[i].w * v[i].w; }
        ss = wave_sum(ss);
        const float rstd = rsqrtf(ss * (1.0f / DM) + 1e-6f);
#pragma unroll
        for (int i = 0; i < 4; ++i) {
            const float4 g = ((const float4*)p.norm_g)[lane + 64 * i];
            uint2 w; w.x = pk2(v[i].x * rstd * g.x, v[i].y * rstd * g.y); w.y = pk2(v[i].z * rstd * g.z, v[i].w * rstd * g.w);
            *(uint2*)(p.hb() + (size_t)row * DM + 4 * (lane + 64 * i)) = w;
        }
    }
    { const float* w = p.w_in; transpose_cvt(p.WinT(), NPAD, DM, [=](int n, int k) { const int c = win_src_col(n); return c < 0 ? 0.f : w[(size_t)k * CIN + c]; }); }
    { const float* w = p.w_pa; transpose_cvt(p.WpaT(), DM, 512, [=](int n, int k) { return w[(size_t)k * DM + n]; }); }
    { const float* w = p.w_pb; transpose_cvt(p.WpbT(), DM, 512, [=](int n, int k) { return w[(size_t)k * DM + n]; }); }
    { const float* w = p.w_out; transpose_cvt(p.WoutT(), DM, DM, [=](int n, int k) { return w[(size_t)k * DM + n]; }); }
    { const float* w = p.w_gate; transpose_cvt(p.WgateT(), DM, DM, [=](int n, int k) { return w[(size_t)k * DM + n]; }); }
    { const float* w = p.w_proj; transpose_cvt(p.WprojT(), DM, 256, [=](int n, int k) { return w[(size_t)k * DM + n]; }); }
    { const float* w = p.cmp_w1; transpose_cvt(p.W1T(), 512, 1024, [=](int n, int k) { const int kvi = n >> 8, nn = n & 255; return w[(size_t)kvi * 262144 + (size_t)((nn >> 7) * 1024 + k) * 128 + (nn & 127)]; }); }
    { const float* w = p.cmp_w2; transpose_cvt(p.W2T(), 128, 128, [=](int n, int k) { return w[(size_t)(n >> 6) * 8192 + (size_t)k * 64 + (n & 63)]; }); }
    { const float* w = p.w_up; transpose_cvt(p.WupT(), 512, 64, [=](int n, int k) { return w[(size_t)k * 512 + n]; }); }
    { const float* w = p.a_up; transpose_cvt(p.AupT(), 512, 64, [=](int n, int k) { return w[(size_t)k * 512 + n]; }); }
    for (int id = gt; id < MR * 64; id += nt) {
        const int row = id >> 6, c4 = id & 63;
        const float4 v = ((const float4*)(row < NP ? p.p_prompt + (size_t)row * 256 : p.p_sample + (size_t)(row - NP) * 256))[c4];
        uint2 w; w.x = pk2(v.x, v.y); w.y = pk2(v.z, v.w);
        *(uint2*)(p.pb() + (size_t)row * 256 + c4 * 4) = w;
    }
    for (int id = gt; id < 4104 * 32; id += nt) {
        const int pi = id >> 5, i = id & 31;
        const int pos = pi < 4096 ? pi : PAST + pi - 4096;
        const float inv = (float)exp(-(double)i * (9.210340371976184 / 32.0));
        const float ang = (float)pos * inv;
        const double x = (double)ang;
        const double k = rint(x * 0.15915494309189535);
        const double r = x - k * 6.283185307179586;
        float s, c; sincos_small(r, s, c);
        p.tabc()[id] = c; p.tabs()[id] = s;
    }
    for (int o = gw; o < 256; o += nw) {
        const int kvi = o >> 7, f = o & 127;
        float acc = 0.f;
        for (int jd = lane; jd < 2048; jd += 64) acc += p.cmp_pe[kvi * 2048 + jd] * p.cmp_w1[(size_t)kvi * 262144 + (size_t)jd * 128 + f];
        acc = wave_sum(acc);
        if (lane == 0) p.pt()[o] = acc + p.cmp_b1[o];
    }
    for (int id = gt; id < DB * 504 * 64; id += nt) {
        const int c4 = id & 63, j = (id >> 6) % 504, b = (id >> 6) / 504;
        ((float4*)(p.out + O_WIN_S))[((size_t)b * 512 + j) * 64 + c4] = ((const float4*)p.cache_win)[((size_t)b * 512 + j + 8) * 64 + c4];
    }
}
#define XB_TMO      128
#define XB_XCNT(j)  (256  + 64 * (j))
#define XB_XSUB(j)  (1280 + 64 * (j))
#define XB_XGEN(j)  (2304 + 64 * (j))
#define XB_TOP      3328
#define XB_TOPGEN   3392
#define XCD_BAR_WORDS 3456
#define XB_SPIN_CAP (1u << 18)

__device__ __forceinline__ unsigned xb_ld(unsigned* p)              { return __hip_atomic_load(p, __ATOMIC_RELAXED, __HIP_MEMORY_SCOPE_AGENT); }
__device__ __forceinline__ unsigned xb_add(unsigned* p, unsigned v) { return __hip_atomic_fetch_add(p, v, __ATOMIC_RELAXED, __HIP_MEMORY_SCOPE_AGENT); }
__device__ __forceinline__ unsigned xb_xcc_id() { return (unsigned)__builtin_amdgcn_s_getreg((3 << 11) | 20) & 0xFu; }
#define XB_SPIN(cond, bar) do { unsigned _sp = 0; while (cond) { __builtin_amdgcn_s_sleep(1); \
    if ((++_sp & 255u) == 0u) { if (xb_ld(&(bar)[XB_TMO])) break; if (_sp > XB_SPIN_CAP) { atomicAdd(&(bar)[XB_TMO], 1u); break; } } } } while (0)

struct XcdBarrier {
    unsigned* bar; unsigned x;
    volatile LAS unsigned* st;
};

__device__ __forceinline__ XcdBarrier xcd_barrier_post(unsigned* bar, volatile LAS unsigned* st) {
    XcdBarrier b; b.bar = bar; b.x = xb_xcc_id(); b.st = st;
    if (threadIdx.x == 0) (void)xb_add(&bar[XB_XCNT(b.x)], 1u);
    return b;
}
__device__ __forceinline__ void xcd_barrier_complete(unsigned* bar, unsigned x, unsigned& nloc, unsigned& nx) {
    const unsigned G = gridDim.x * gridDim.y * gridDim.z;
    unsigned sum, cnt, mine, sp = 0u;
    for (;;) {
        sum = 0u; cnt = 0u; mine = 0u;
#pragma unroll
        for (unsigned j = 0; j < 16; ++j) { const unsigned c = xb_ld(&bar[XB_XCNT(j)]); sum += c; cnt += (c > 0u) ? 1u : 0u; mine = (j == x) ? c : mine; }
        if (sum == G) break;
        __builtin_amdgcn_s_sleep(1);
        if ((++sp & 255u) == 0u) { if (xb_ld(&bar[XB_TMO])) break; if (sp > XB_SPIN_CAP) { atomicAdd(&bar[XB_TMO], 1u); break; } }
    }
    nloc = mine > 0u ? mine : 1u; nx = cnt > 0u ? cnt : 1u;
}

__device__ __forceinline__ void xcd_barrier(const XcdBarrier& b) {
    asm volatile("s_waitcnt vmcnt(0)" ::: "memory");
    __syncthreads();
    if (threadIdx.x == 0) {
        unsigned* bar = b.bar;
        __builtin_amdgcn_s_waitcnt(0);
        unsigned nloc = b.st[0], nx = b.st[1];
        if (nloc == 0u) { xcd_barrier_complete(bar, b.x, nloc, nx); b.st[0] = nloc; b.st[1] = nx; }
        const unsigned old = xb_add(&bar[XB_XSUB(b.x)], 1u);
        const unsigned gen = old / nloc;
        if (old + 1u == (gen + 1u) * nloc) {
            __builtin_amdgcn_fence(__ATOMIC_RELEASE, "agent");
            asm volatile("s_waitcnt vmcnt(0)" ::: "memory");
            const unsigned og = xb_add(&bar[XB_TOP], 1u);
            const unsigned tg = og / nx;
            if (og + 1u == (tg + 1u) * nx) xb_add(&bar[XB_TOPGEN], 1u);
            else XB_SPIN(xb_ld(&bar[XB_TOPGEN]) == tg, bar);
            __builtin_amdgcn_fence(__ATOMIC_ACQUIRE, "agent");
            xb_add(&bar[XB_XGEN(b.x)], 1u);
            asm volatile("s_waitcnt vmcnt(0)" ::: "memory");
        } else {
            XB_SPIN(xb_ld(&bar[XB_XGEN(b.x)]) == gen, bar);
            __builtin_amdgcn_fence(__ATOMIC_ACQUIRE, "agent");
            asm volatile("s_waitcnt vmcnt(0)" ::: "memory");
        }
    }
    __syncthreads();
}

using pg8::Unit;
typedef unsigned u32x2 __attribute__((ext_vector_type(2)));
__device__ __forceinline__ f32x16 mfma32(bf16x8 a, bf16x8 b, f32x16 c) { return __builtin_amdgcn_mfma_f32_32x32x16_bf16(a, b, c, 0, 0, 0); }
__device__ __forceinline__ bf16x8 pack8(float a0, float a1, float a2, float a3, float a4, float a5, float a6, float a7) {
    union { uint4 u; bf16x8 v; } x; x.u.x = pk2(a0, a1); x.u.y = pk2(a2, a3); x.u.z = pk2(a4, a5); x.u.w = pk2(a6, a7); return x.v;
}
__device__ __forceinline__ f32x16 zero16() { f32x16 z; for (int i = 0; i < 16; ++i) z[i] = 0.f; return z; }


__device__ __forceinline__ void st_bf4(bf16_t* dst, f32x4 v) { uint2 w; w.x = pk2(v[0], v[1]); w.y = pk2(v[2], v[3]); *(uint2*)dst = w; }

struct EpiIn {
    static constexpr bool PERM = false, AFTER_DRAIN = false;
    P p;
    __device__ __forceinline__ void operator()(const f32x4 (&acc)[2][2][4][2], const Unit& u, int wr, int wc, int fr, int fq) const {
        const int pn = u.pn;
#pragma unroll
        for (int ai = 0; ai < 2; ++ai)
#pragma unroll
            for (int m = 0; m < 4; ++m) {
                const int row = u.pm * 256 + ai * 128 + wr * 64 + m * 16 + fr;
                if (pn < 5) {
                    const int pi = row < NP ? (row & (SEQ - 1)) : 4096 + ((row - NP) & 7);
                    const int d0 = 16 * (wc & 1) + 4 * fq;
                    const f32x4 cs = *(const f32x4*)(p.tabc() + pi * 32 + d0), sn = *(const f32x4*)(p.tabs() + pi * 32 + d0);
#pragma unroll
                    for (int bj = 0; bj < 2; ++bj) {
                        const f32x4 x1 = acc[ai][bj][m][0], x2 = acc[ai][bj][m][1];
                        if (pn < 2) {
                            const int head = pn * 4 + bj * 2 + (wc >> 1);
                            const f32x4 o1 = (x1 * cs - x2 * sn) * 0.125f, o2 = (x2 * cs + x1 * sn) * 0.125f;
                            bf16_t* q = p.qb() + (size_t)row * 512 + head * 64 + d0;
                            st_bf4(q, o1); st_bf4(q + 32, o2);
                        } else {
                            const int br = pn - 2, g = wc >> 1;
                            f32x4 o1, o2;
                            if (bj == 0) { o1 = x1 * cs - x2 * sn; o2 = x2 * cs + x1 * sn; } else { o1 = x1; o2 = x2; }
                            float* dst = nullptr;
                            if (row < NP) {
                                if (br == 0) dst = p.out + O_CMP_P + (size_t)row * 256;
                                else if (br == 1) dst = p.out + O_SEL_P + (size_t)row * 256;
                                else { const int s = row & (SEQ - 1); if (s >= SEQ - 512) dst = p.out + O_WIN_P + ((size_t)(row >> 12) * 512 + (s - (SEQ - 512))) * 256; }
                            } else {
                                const int rs = row - NP;
                                if (br == 0) dst = p.out + O_CMP_S + (size_t)rs * 256;
                                else if (br == 1) dst = p.out + O_SEL_S + (size_t)rs * 256;
                                else dst = p.out + O_WIN_S + ((size_t)(rs >> 3) * 512 + 504 + (rs & 7)) * 256;
                            }
                            if (dst) { dst += bj * 128 + g * 64 + d0; *(f32x4*)dst = o1; *(f32x4*)(dst + 32) = o2; }
                            if (row < NP) {
                                const int b = row >> 12, s = row & (SEQ - 1);
                                if (bj == 0) {
                                    bf16_t* k = p.kb() + ((size_t)((br * NB + b) * 2 + g) * SEQ + s) * 64 + d0;
                                    st_bf4(k, o1); st_bf4(k + 32, o2);
                                } else if (br == 0) {
                                    bf16_t* v = p.vcr() + ((size_t)(b * 2 + g) * SEQ + s) * 64 + d0;
                                    st_bf4(v, o1); st_bf4(v + 32, o2);
                                } else {
                                    bf16_t* v = p.vT() + ((size_t)(((br - 1) * NB + b) * 2 + g) * 64 + d0) * SEQ + s;
#pragma unroll
                                    for (int e = 0; e < 4; ++e) { v[(size_t)e * SEQ] = f2bf(o1[e]); v[(size_t)(32 + e) * SEQ] = f2bf(o2[e]); }
                                }
                            }
                        }
                    }
                } else {
#pragma unroll
                    for (int bj = 0; bj < 2; ++bj)
#pragma unroll
                        for (int n = 0; n < 2; ++n) {
                            const int c = bj * 128 + wc * 32 + n * 16 + fq * 4;
                            const f32x4 v = acc[ai][bj][m][n];
                            if (pn < 7) {
                                f32x4 o; for (int e = 0; e < 4; ++e) o[e] = siluf_(v[e]);
                                st_bf4(p.ag() + (size_t)row * 512 + (pn - 5) * 256 + c, o);
                            } else if (pn < 13) {
                                *(f32x4*)(p.rz() + (size_t)row * CR + (pn - 7) * 256 + c) = v;
                            } else if (pn == 13) {
                                if (c < 128) *(f32x4*)(p.rz() + (size_t)row * CR + 1536 + c) = v;
                                else if (c < 152) { f32x4 o; for (int e = 0; e < 4; ++e) o[e] = sigmoidf_(v[e]); *(f32x4*)(p.gates() + (size_t)row * 32 + (c - 128)) = o; }
                            } else if (pn < 16) {
                                f32x4 o; for (int e = 0; e < 4; ++e) o[e] = siluf_(v[e]);
                                st_bf4(p.rg() + (size_t)row * 512 + (pn - 14) * 256 + c, o);
                            } else {
                                f32x4 o; for (int e = 0; e < 4; ++e) o[e] = sigmoidf_(v[e]);
                                st_bf4(p.mg() + (size_t)row * 2048 + (pn - 16) * 256 + c, o);
                            }
                        }
                }
            }
    }
};

struct EpiPlain {
    static constexpr bool PERM = false, AFTER_DRAIN = false;
    float* C; int ldc; int pad_;
    __device__ __forceinline__ void quad(int row, int c, f32x4 v) const { *(f32x4*)(C + (size_t)row * ldc + c) = v; }
    __device__ __forceinline__ void operator()(const f32x4 (&acc)[2][2][4][2], const Unit& u, int wr, int wc, int fr, int fq) const {
#pragma unroll
        for (int ai = 0; ai < 2; ++ai)
#pragma unroll
            for (int m = 0; m < 4; ++m) {
                float* rowp = C + (size_t)(u.pm * 256 + ai * 128 + wr * 64 + m * 16 + fr) * ldc + u.pn * 256 + wc * 32 + 4 * fq;
#pragma unroll
                for (int bj = 0; bj < 2; ++bj)
#pragma unroll
                    for (int n = 0; n < 2; ++n) *(f32x4*)(rowp + bj * 128 + n * 16) = acc[ai][bj][m][n];
            }
    }
};

struct EpiYa {
    static constexpr bool PERM = false, AFTER_DRAIN = false;
    P p;
    __device__ __forceinline__ void quad(int row, int c, f32x4 v) const {
        const uint2 gw = *(const uint2*)(p.mg() + (size_t)row * 2048 + c);
        f32x4 g; g[0] = __uint_as_float(gw.x << 16); g[1] = __uint_as_float(gw.x & 0xffff0000u); g[2] = __uint_as_float(gw.y << 16); g[3] = __uint_as_float(gw.y & 0xffff0000u);
        *(f32x4*)(p.tmp() + (size_t)row * DM + c) = g * v;
    }
    __device__ __forceinline__ void operator()(const f32x4 (&acc)[2][2][4][2], const Unit& u, int wr, int wc, int fr, int fq) const {
#pragma unroll
        for (int ai = 0; ai < 2; ++ai)
#pragma unroll
            for (int m = 0; m < 4; ++m) {
                const int row = u.pm * 256 + ai * 128 + wr * 64 + m * 16 + fr;
#pragma unroll
                for (int bj = 0; bj < 2; ++bj)
#pragma unroll
                    for (int n = 0; n < 2; ++n) {
                        const int c = u.pn * 256 + bj * 128 + wc * 32 + n * 16 + fq * 4;
                        const uint2 gw = *(const uint2*)(p.mg() + (size_t)row * 2048 + c);
                        f32x4 g; g[0] = __uint_as_float(gw.x << 16); g[1] = __uint_as_float(gw.x & 0xffff0000u); g[2] = __uint_as_float(gw.y << 16); g[3] = __uint_as_float(gw.y & 0xffff0000u);
                        *(f32x4*)(p.tmp() + (size_t)row * DM + c) = g * acc[ai][bj][m][n];
                    }
            }
    }
};
struct EpiYb {
    static constexpr bool PERM = false, AFTER_DRAIN = false;
    P p;
    __device__ __forceinline__ void quad(int row, int c, f32x4 v) const {
        const uint2 gw = *(const uint2*)(p.mg() + (size_t)row * 2048 + 1024 + c);
        f32x4 g; g[0] = __uint_as_float(gw.x << 16); g[1] = __uint_as_float(gw.x & 0xffff0000u); g[2] = __uint_as_float(gw.y << 16); g[3] = __uint_as_float(gw.y & 0xffff0000u);
        st_bf4(p.mb() + (size_t)row * DM + c, *(const f32x4*)(p.tmp() + (size_t)row * DM + c) + g * v);
    }
    __device__ __forceinline__ void operator()(const f32x4 (&acc)[2][2][4][2], const Unit& u, int wr, int wc, int fr, int fq) const {
#pragma unroll
        for (int ai = 0; ai < 2; ++ai)
#pragma unroll
            for (int m = 0; m < 4; ++m) {
                const int row = u.pm * 256 + ai * 128 + wr * 64 + m * 16 + fr;
#pragma unroll
                for (int bj = 0; bj < 2; ++bj)
#pragma unroll
                    for (int n = 0; n < 2; ++n) {
                        const int c = u.pn * 256 + bj * 128 + wc * 32 + n * 16 + fq * 4;
                        const uint2 gw = *(const uint2*)(p.mg() + (size_t)row * 2048 + 1024 + c);
                        f32x4 g; g[0] = __uint_as_float(gw.x << 16); g[1] = __uint_as_float(gw.x & 0xffff0000u); g[2] = __uint_as_float(gw.y << 16); g[3] = __uint_as_float(gw.y & 0xffff0000u);
                        const f32x4 t = *(const f32x4*)(p.tmp() + (size_t)row * DM + c);
                        st_bf4(p.mb() + (size_t)row * DM + c, t + g * acc[ai][bj][m][n]);
                    }
            }
    }
};
struct EpiOut {
    static constexpr bool PERM = false, AFTER_DRAIN = false;
    P p;
    __device__ __forceinline__ void quad(int row, int c, f32x4 a) const {
        const float* xr = p.x_sample + (size_t)(row - NP) * DM;
        const f32x4 v = *(const f32x4*)(xr + c) + a;
        *(f32x4*)(p.x1() + (size_t)row * DM + c) = v;
        st_bf4(p.xg() + (size_t)row * DM + c, v * *(const f32x4*)(p.ple_g + c));
        atomicAdd(p.ss_s() + (row - NP), v[0] * v[0] + v[1] * v[1] + v[2] * v[2] + v[3] * v[3]);
    }
    __device__ __forceinline__ void operator()(const f32x4 (&acc)[2][2][4][2], const Unit& u, int wr, int wc, int fr, int fq) const {
#pragma unroll
        for (int ai = 0; ai < 2; ++ai)
#pragma unroll
            for (int m = 0; m < 4; ++m) {
                const int row = u.pm * 256 + ai * 128 + wr * 64 + m * 16 + fr;
                const float* xr = row < NP ? p.x_prompt + (size_t)row * DM : p.x_sample + (size_t)(row - NP) * DM;
                float ss = 0.f;
#pragma unroll
                for (int bj = 0; bj < 2; ++bj)
#pragma unroll
                    for (int n = 0; n < 2; ++n) {
                        const int c = u.pn * 256 + bj * 128 + wc * 32 + n * 16 + fq * 4;
                        const f32x4 v = *(const f32x4*)(xr + c) + acc[ai][bj][m][n];
                        *(f32x4*)(p.x1() + (size_t)row * DM + c) = v;
                        ss += v[0] * v[0] + v[1] * v[1] + v[2] * v[2] + v[3] * v[3];
                        st_bf4(p.xg() + (size_t)row * DM + c, v * *(const f32x4*)(p.ple_g + c));
                    }
                ss += __shfl_xor(ss, 16); ss += __shfl_xor(ss, 32);
                if (fq == 0) p.ss1()[(size_t)row * 16 + u.pn * 4 + wc] = ss;
            }
    }
};
struct EpiGate {
    static constexpr bool PERM = false, AFTER_DRAIN = false;
    P p;
    __device__ __forceinline__ void quad(int row, int c, f32x4 acc) const {
        const float rstd = rsqrtf(p.ss_s()[row - NP] * (1.0f / DM) + 1e-6f);
        const f32x4 a = acc * rstd;
        f32x4 g; for (int e = 0; e < 4; ++e) g[e] = sigmoidf_(a[e]);
        float* ppp = p.pp() + (size_t)row * DM + c;
        *(f32x4*)ppp = *(const f32x4*)(p.x1() + (size_t)row * DM + c) + g * *(const f32x4*)ppp;
    }
    __device__ __forceinline__ void operator()(const f32x4 (&acc)[2][2][4][2], const Unit& u, int wr, int wc, int fr, int fq) const {
#pragma unroll
        for (int ai = 0; ai < 2; ++ai)
#pragma unroll
            for (int m = 0; m < 4; ++m) {
                const int row = u.pm * 256 + ai * 128 + wr * 64 + m * 16 + fr;
                float ss = 0.f;
#pragma unroll
                for (int i = 0; i < 4; ++i) { const f32x4 t = *(const f32x4*)(p.ss1() + (size_t)row * 16 + i * 4); ss += (t[0] + t[1]) + (t[2] + t[3]); }
                const float rstd = rsqrtf(ss * (1.0f / DM) + 1e-6f);
#pragma unroll
                for (int bj = 0; bj < 2; ++bj)
#pragma unroll
                    for (int n = 0; n < 2; ++n) {
                        const int c = u.pn * 256 + bj * 128 + wc * 32 + n * 16 + fq * 4;
                        const f32x4 a = acc[ai][bj][m][n] * rstd;
                        f32x4 g; for (int e = 0; e < 4; ++e) g[e] = sigmoidf_(a[e]);
                        float* ppp = p.pp() + (size_t)row * DM + c;
                        *(f32x4*)ppp = *(const f32x4*)(p.x1() + (size_t)row * DM + c) + g * *(const f32x4*)ppp;
                    }
            }
    }
};

__device__ __forceinline__ void ph_final(const P& p) {
    const int tid = threadIdx.x, lane = tid & 63, wid = tid >> 6;
    for (int row = blockIdx.x * 8 + wid; row < MR; row += gridDim.x * 8) {
        const float4* src = (const float4*)(p.pp() + (size_t)row * DM);
        float4 v[4]; float ss = 0.f;
#pragma unroll
        for (int i = 0; i < 4; ++i) { v[i] = src[lane + 64 * i]; ss += v[i].x * v[i].x + v[i].y * v[i].y + v[i].z * v[i].z + v[i].w * v[i].w; }
        ss = wave_sum(ss);
        const float rstd = rsqrtf(ss * (1.0f / DM) + 1e-6f);
        float4* dst = (float4*)(p.out + (row < NP ? O_Y_P + (size_t)row * DM : O_Y_S + (size_t)(row - NP) * DM));
#if defined(DBG_CMPALL)
        float dbgs = 1.0f; if (row >= NP) dbgs = 1.0f + (float)p.bar()[3840] * (1.0f / DBG_DIV);
#define DBGS * dbgs
#else
#define DBGS
#endif
#pragma unroll
        for (int i = 0; i < 4; ++i) {
            const float4 g = ((const float4*)p.final_g)[lane + 64 * i];
            float4 o; o.x = v[i].x * rstd * g.x DBGS; o.y = v[i].y * rstd * g.y DBGS; o.z = v[i].z * rstd * g.z DBGS; o.w = v[i].w * rstd * g.w DBGS;
            dst[lane + 64 * i] = o;
        }
    }
}

typedef float f32x4v __attribute__((ext_vector_type(4)));
template <class Epi> __device__ __forceinline__ void small_gemm(const bf16_t* A, const bf16_t* Bt, int K, const Epi& E) {
    const int tid = threadIdx.x, lane = tid & 63, wid = tid >> 6, r16 = lane & 15, q4 = lane >> 4;
    for (int tile = blockIdx.x * 8 + wid; tile < 16 * 64; tile += gridDim.x * 8) {
        const int rt = tile & 15, ct = tile >> 4;
        const bf16_t* ap = A + (size_t)(NP + rt * 16 + r16) * K + 8 * q4;
        const bf16_t* bp = Bt + (size_t)(ct * 16 + r16) * K + 8 * q4;
        f32x4 acc = {0.f, 0.f, 0.f, 0.f};
#pragma unroll 1
        for (int k0 = 0; k0 < K; k0 += 256) {
            bf16x8 af[8], bf[8];
#pragma unroll
            for (int i = 0; i < 8; ++i) { af[i] = *(const bf16x8*)(ap + k0 + 32 * i); bf[i] = *(const bf16x8*)(bp + k0 + 32 * i); }
#pragma unroll
            for (int i = 0; i < 8; ++i) acc = __builtin_amdgcn_mfma_f32_16x16x32_bf16(bf[i], af[i], acc, 0, 0, 0);
        }
        E.quad(NP + rt * 16 + r16, ct * 16 + 4 * q4, acc);
    }
}

__device__ __forceinline__ void ph_compress2(const P& p, const float* LH, int nbg, int nrows, int nblk, bf16_t* kc, bf16_t* vcT) {
    const int tid = threadIdx.x, lane = tid & 63, wid = tid >> 6, col = lane & 31, hb = lane >> 5;
    const int ntile = nrows >> 5, total = 2 * nbg * ntile;
    for (int it = blockIdx.x * 8 + wid; it < total; it += gridDim.x * 8) {
        const int tile = it % ntile, bg = (it / ntile) % nbg, kvi = it / (ntile * nbg);
        const int i = tile * 32 + col;
        const bool live = i < nblk;
        const float* l0 = LH + ((size_t)kvi * nbg * nrows + (size_t)bg * nrows + (live ? i : 0)) * 256;
        const float* ptp = p.pt() + kvi * 128;
        const bf16_t* w2t = p.W2T() + (size_t)kvi * 64 * 128;
        f32x16 acc[2]; acc[0] = zero16(); acc[1] = zero16();
#pragma unroll
        for (int ks = 0; ks < 8; ++ks) {
            const int f = 16 * ks + 8 * hb;
            float hv[8];
#pragma unroll
            for (int q = 0; q < 2; ++q) {
                const f32x4 lo = *(const f32x4*)(l0 + f + 4 * q), hi = *(const f32x4*)(l0 + 256 + 128 + f + 4 * q), pv = *(const f32x4*)(ptp + f + 4 * q);
#pragma unroll
                for (int e = 0; e < 4; ++e) hv[4 * q + e] = siluf_(lo[e] + hi[e] + pv[e]);
            }
            const bf16x8 hf = pack8(hv[0], hv[1], hv[2], hv[3], hv[4], hv[5], hv[6], hv[7]);
#pragma unroll
            for (int dt = 0; dt < 2; ++dt) {
                const bf16x8 wf = *(const bf16x8*)(w2t + (size_t)(32 * dt + col) * 128 + f);
                acc[dt] = (kvi == 0) ? mfma32(wf, hf, acc[dt]) : mfma32(hf, wf, acc[dt]);
            }
        }
        if (kvi == 0) {
            bf16_t* dst = kc + ((size_t)bg * nrows + i) * 64;
#pragma unroll
            for (int dt = 0; dt < 2; ++dt)
#pragma unroll
                for (int i4 = 0; i4 < 4; ++i4) {
                    const int d = 32 * dt + 8 * i4 + 4 * hb;
                    const f32x4 b2 = *(const f32x4*)(p.cmp_b2 + d);
                    f32x4 v; for (int e = 0; e < 4; ++e) v[e] = live ? acc[dt][4 * i4 + e] + b2[e] : 0.f;
                    st_bf4(dst + d, v);
                }
        } else {
#pragma unroll
            for (int dt = 0; dt < 2; ++dt) {
                const int d = 32 * dt + col;
                const float b2 = p.cmp_b2[64 + d];
                bf16_t* dst = vcT + ((size_t)bg * 64 + d) * nrows + tile * 32;
#pragma unroll
                for (int i4 = 0; i4 < 4; ++i4) {
                    const int r = 8 * i4 + 4 * hb;
                    f32x4 v; for (int e = 0; e < 4; ++e) v[e] = (tile * 32 + r + e) < nblk ? acc[dt][4 * i4 + e] + b2 : 0.f;
                    st_bf4(dst + r, v);
                }
            }
        }
    }
}

__device__ __forceinline__ void ph_cvt_cache(const P& p) {
    const size_t total = (size_t)2 * DB * 2 * PAST * 8;
    for (size_t id = (size_t)blockIdx.x * NTHR + threadIdx.x; id < total; id += (size_t)gridDim.x * NTHR) {
        const int d8 = (int)(id & 7), tok = (int)((id >> 3) & (PAST - 1)), g = (int)((id >> 17) & 1), b = (int)((id >> 18) & 31), kvi = (int)(id >> 23);
        const int page = p.page_table[b * 128 + (tok >> 7)];
        const float4* src = (const float4*)(p.cache_cmp + ((size_t)page * 128 + (tok & 127)) * 256 + kvi * 128 + g * 64 + d8 * 8);
        const float4 a = src[0], c = src[1];
        uint4 w; w.x = pk2(a.x, a.y); w.y = pk2(a.z, a.w); w.z = pk2(c.x, c.y); w.w = pk2(c.z, c.w);
        *(uint4*)(p.cs() + id * 8) = w;
    }
}

#if defined(OLD_RWKV_PREP)
__device__ __forceinline__ void ph_rwkv_prep(const P& p) {
    const int tid = threadIdx.x, lane = tid & 63, wid = tid >> 6;
    for (int it = blockIdx.x * 8 + wid; it < MR * 8; it += gridDim.x * 8) {
        const int row = it >> 3, h = it & 7, c = h * 64 + lane;
        const float* z = p.rz() + (size_t)row * CR;
        const float* pv;
        bool zero_prev = false;
        if (row < NP) { if ((row & (SEQ - 1)) == 0) { zero_prev = true; pv = z; } else pv = z - CR; }
        else { const int rs = row - NP; if ((rs & 7) == 0) pv = p.state_shift + (size_t)(rs >> 3) * CR; else pv = z - CR; }
        auto lerp = [&](int col) { const float zz = z[col]; const float pr = zero_prev ? 0.f : pv[col]; return zz + (pr - zz) * p.mu[col]; };
        const float zr = lerp(c), zk = lerp(512 + c), zv = lerp(1024 + c), zwd = lerp(1536 + lane), zad = lerp(1600 + lane);
        const float th = tanhf(zwd);
        float accw = p.w0[c], acca = p.a0[c];
#pragma unroll 8
        for (int j = 0; j < 64; ++j) {
            const float tj = __shfl(th, j), aj = __shfl(zad, j);
            accw += tj * p.w_up[j * 512 + c]; acca += aj * p.a_up[j * 512 + c];
        }
        const float nx = -accw;
        const float sp = fmaxf(nx, 0.f) + log1pf(__expf(-fabsf(nx)));
        const float w = -sp - 0.5f;
        const float dec = __expf(-__expf(w));
        const float a = sigmoidf_(acca);
        const float kkr = zk * p.k_k[c];
        const float nrm = sqrtf(wave_sum(kkr * kkr));
        const float kk = kkr / fmaxf(nrm, 1e-12f);
        const float km = zk * (1.0f + (a - 1.0f) * p.k_a[c]);
        const float bon = wave_sum(zr * km * p.r_k[c]);
        float* o = p.rw6() + (size_t)it * 384 + lane;
        o[0] = zr; o[64] = dec; o[128] = km; o[192] = zv; o[256] = kk; o[320] = kk * a;
        if (lane == 0) p.bonus()[it] = bon;
        if (h == 0) {
            float* so = nullptr;
            if (row < NP) { if ((row & (SEQ - 1)) == SEQ - 1) so = p.out + O_SH_P + (size_t)(row >> 12) * CR; }
            else { const int rs = row - NP; if ((rs & 7) == 7) so = p.out + O_SH_S + (size_t)(rs >> 3) * CR; }
            if (so) for (int i = lane; i < CR; i += 64) so[i] = z[i];
        }
    }
}

#else
__device__ __forceinline__ float dpp_row_sum16(float v) {
    v += __builtin_bit_cast(float, __builtin_amdgcn_mov_dpp(__builtin_bit_cast(int, v), 0xB1, 0xF, 0xF, true));
    v += __builtin_bit_cast(float, __builtin_amdgcn_mov_dpp(__builtin_bit_cast(int, v), 0x4E, 0xF, 0xF, true));
    v += __builtin_bit_cast(float, __builtin_amdgcn_mov_dpp(__builtin_bit_cast(int, v), 0x141, 0xF, 0xF, true));
    v += __builtin_bit_cast(float, __builtin_amdgcn_mov_dpp(__builtin_bit_cast(int, v), 0x140, 0xF, 0xF, true));
    return v;
}
__device__ __forceinline__ float half_sum32(float v) { v = dpp_row_sum16(v); return v + __shfl_xor(v, 16); }
__device__ __forceinline__ const float* rwkv_prev_row(const P& p, int row) {
    if (row < NP) return (row & (SEQ - 1)) == 0 ? nullptr : p.rz() + (size_t)(row - 1) * CR;
    const int rs = row - NP;
    return (rs & 7) == 0 ? p.state_shift + (size_t)(rs >> 3) * CR : p.rz() + (size_t)(row - 1) * CR;
}
__device__ __forceinline__ void ph_rwkv_prep(const P& p) {
    const int tid = threadIdx.x, lane = tid & 63, wid = tid >> 6, col = lane & 31, hb = lane >> 5;
    const int gw = blockIdx.x * 8 + wid, nw = gridDim.x * 8;
    for (int it = gw; it < NB + DB; it += nw) {
        const int row = it < NB ? it * SEQ + SEQ - 1 : NP + (it - NB) * 8 + 7;
        float* so = it < NB ? p.out + O_SH_P + (size_t)it * CR : p.out + O_SH_S + (size_t)(it - NB) * CR;
        const float* z = p.rz() + (size_t)row * CR;
        for (int i = lane; i < CR; i += 64) so[i] = z[i];
    }
    for (int it = gw; it < (MR / 32) * 8; it += nw) {
        const int h = it & 7, r0 = (it >> 3) * 32;
        bf16x8 Aw[4], Aa[4];
        {
            const int row = r0 + col;
            const float* z = p.rz() + (size_t)row * CR;
            const float* pv = rwkv_prev_row(p, row);
#pragma unroll
            for (int ks = 0; ks < 4; ++ks) {
                const int j0 = 16 * ks + 8 * hb;
                float tw[8], ta[8];
#pragma unroll
                for (int q = 0; q < 2; ++q) {
                    const f32x4 zw = *(const f32x4*)(z + 1536 + j0 + 4 * q), za = *(const f32x4*)(z + 1600 + j0 + 4 * q);
                    f32x4 pw, pa;
                    if (pv) { pw = *(const f32x4*)(pv + 1536 + j0 + 4 * q); pa = *(const f32x4*)(pv + 1600 + j0 + 4 * q); } else { pw = (f32x4){0.f, 0.f, 0.f, 0.f}; pa = pw; }
                    const f32x4 mw = *(const f32x4*)(p.mu + 1536 + j0 + 4 * q), ma = *(const f32x4*)(p.mu + 1600 + j0 + 4 * q);
#pragma unroll
                    for (int e = 0; e < 4; ++e) { tw[4 * q + e] = tanhf(zw[e] + (pw[e] - zw[e]) * mw[e]); ta[4 * q + e] = za[e] + (pa[e] - za[e]) * ma[e]; }
                }
                Aw[ks] = pack8(tw[0], tw[1], tw[2], tw[3], tw[4], tw[5], tw[6], tw[7]);
                Aa[ks] = pack8(ta[0], ta[1], ta[2], ta[3], ta[4], ta[5], ta[6], ta[7]);
            }
        }
        f32x16 accw[2], acca[2];
#pragma unroll
        for (int ct = 0; ct < 2; ++ct) {
            accw[ct] = zero16(); acca[ct] = zero16();
            const size_t wo = (size_t)(h * 64 + 32 * ct + col) * 64 + 8 * hb;
#pragma unroll
            for (int ks = 0; ks < 4; ++ks) {
                accw[ct] = mfma32(Aw[ks], *(const bf16x8*)(p.WupT() + wo + 16 * ks), accw[ct]);
                acca[ct] = mfma32(Aa[ks], *(const bf16x8*)(p.AupT() + wo + 16 * ks), acca[ct]);
            }
        }
        float w0v[2], a0v[2], kkv[2], kav[2], rkv[2], mur[2], muk[2], muv[2];
#pragma unroll
        for (int ct = 0; ct < 2; ++ct) {
            const int c = h * 64 + 32 * ct + col;
            w0v[ct] = p.w0[c]; a0v[ct] = p.a0[c]; kkv[ct] = p.k_k[c]; kav[ct] = p.k_a[c]; rkv[ct] = p.r_k[c];
            mur[ct] = p.mu[c]; muk[ct] = p.mu[512 + c]; muv[ct] = p.mu[1024 + c];
        }
#pragma unroll 2
        for (int i = 0; i < 16; ++i) {
            const int row = r0 + (i & 3) + 8 * (i >> 2) + 4 * hb;
            const float* z = p.rz() + (size_t)row * CR;
            const float* pv = rwkv_prev_row(p, row);
            float zr[2], zk[2], zv[2], dec[2], av[2], kkr[2], km[2];
            float n2 = 0.f, bon = 0.f;
#pragma unroll
            for (int ct = 0; ct < 2; ++ct) {
                const int c = h * 64 + 32 * ct + col;
                const float z0 = z[c], z1 = z[512 + c], z2 = z[1024 + c];
                const float p0 = pv ? pv[c] : 0.f, p1 = pv ? pv[512 + c] : 0.f, p2 = pv ? pv[1024 + c] : 0.f;
                zr[ct] = z0 + (p0 - z0) * mur[ct]; zk[ct] = z1 + (p1 - z1) * muk[ct]; zv[ct] = z2 + (p2 - z2) * muv[ct];
                const float nx = -(w0v[ct] + accw[ct][i]);
                const float sp = fmaxf(nx, 0.f) + log1pf(__expf(-fabsf(nx)));
                dec[ct] = __expf(-__expf(-sp - 0.5f));
                av[ct] = sigmoidf_(a0v[ct] + acca[ct][i]);
                kkr[ct] = zk[ct] * kkv[ct];
                km[ct] = zk[ct] * (1.0f + (av[ct] - 1.0f) * kav[ct]);
                n2 += kkr[ct] * kkr[ct];
                bon += zr[ct] * km[ct] * rkv[ct];
            }
            n2 = half_sum32(n2); bon = half_sum32(bon);
            const float rn = 1.0f / fmaxf(sqrtf(n2), 1e-12f);
            float* o = p.rw6() + ((size_t)row * 8 + h) * 384 + col;
#pragma unroll
            for (int ct = 0; ct < 2; ++ct) {
                const float kk = kkr[ct] * rn;
                float* oc = o + 32 * ct;
                oc[0] = zr[ct]; oc[64] = dec[ct]; oc[128] = km[ct]; oc[192] = zv[ct]; oc[256] = kk; oc[320] = kk * av[ct];
            }
            if (col == 0) p.bonus()[(size_t)row * 8 + h] = bon;
        }
    }
}

#endif
typedef float f32x2 __attribute__((ext_vector_type(2)));
__device__ __forceinline__ float dpp_row_sum(float v) {
    v += __builtin_bit_cast(float, __builtin_amdgcn_mov_dpp(__builtin_bit_cast(int, v), 0xB1, 0xF, 0xF, true));
    v += __builtin_bit_cast(float, __builtin_amdgcn_mov_dpp(__builtin_bit_cast(int, v), 0x4E, 0xF, 0xF, true));
    v += __builtin_bit_cast(float, __builtin_amdgcn_mov_dpp(__builtin_bit_cast(int, v), 0x141, 0xF, 0xF, true));
    v += __builtin_bit_cast(float, __builtin_amdgcn_mov_dpp(__builtin_bit_cast(int, v), 0x140, 0xF, 0xF, true));
    return v;
}
constexpr int SCAN_TC = 32;
__device__ __forceinline__ void scan_item(const P& p, LAS float* lds, int row0, int T, int h, int half, const float* s0, float* sout) {
    const int tid = threadIdx.x, w = tid >> 6, lane = tid & 63, rl = lane >> 4, kq = lane & 15;
    const int vrow = half * 32 + w * 4 + rl;
    f32x4 S;
    if (s0) S = *(const f32x4*)(s0 + vrow * 64 + kq * 4); else { S[0] = 0.f; S[1] = 0.f; S[2] = 0.f; S[3] = 0.f; }
    const float* src = p.rw6() + ((size_t)row0 * 8 + h) * 384;
    const int nchunk = (T + SCAN_TC - 1) / SCAN_TC;
    f32x4 stg[6];
    int so[6], ss[6];
#pragma unroll
    for (int i = 0; i < 6; ++i) { const int idx = i * 512 + tid; ss[i] = idx / 96; so[i] = (idx % 96) * 4; }
    {
        const int ns = T < SCAN_TC ? T : SCAN_TC;
#pragma unroll
        for (int i = 0; i < 6; ++i) if (ss[i] < ns) *(LAS f32x4*)(lds + ss[i] * 384 + so[i]) = *(const f32x4*)(src + (size_t)ss[i] * 3072 + so[i]);
    }
    __syncthreads();
    for (int c = 0; c < nchunk; ++c) {
        const int t0 = c * SCAN_TC;
        const int ns = (T - t0) < SCAN_TC ? (T - t0) : SCAN_TC;
        const bool more = (c + 1) < nchunk;
        const int nns = more ? ((T - t0 - SCAN_TC) < SCAN_TC ? (T - t0 - SCAN_TC) : SCAN_TC) : 0;
        if (more) {
#pragma unroll
            for (int i = 0; i < 6; ++i) if (ss[i] < nns) stg[i] = *(const f32x4*)(src + (size_t)(t0 + SCAN_TC + ss[i]) * 3072 + so[i]);
        }
        LAS const float* buf = lds + (c & 1) * (SCAN_TC * 384);
        float* yo = p.ybuf() + (size_t)(row0 + t0) * 512 + h * 64 + vrow;
#pragma unroll 4
        for (int s = 0; s < ns; ++s) {
            LAS const float* bs = buf + s * 384 + kq * 4;
            const f32x4 r = *(LAS const f32x4*)(bs), d = *(LAS const f32x4*)(bs + 64), km = *(LAS const f32x4*)(bs + 128),
                        kk = *(LAS const f32x4*)(bs + 256), ka = *(LAS const f32x4*)(bs + 320);
            const float vv = buf[s * 384 + 192 + vrow];
            const f32x4 t1 = S * kk;
            float sa = dpp_row_sum((t1[0] + t1[1]) + (t1[2] + t1[3]));
            sa = -sa;
            S = S * d + ka * sa + km * vv;
            const f32x4 t2 = S * r;
            const float y = dpp_row_sum((t2[0] + t2[1]) + (t2[2] + t2[3]));
            if (kq == 0) yo[(size_t)s * 512] = y;
        }
        if (more) {
            LAS float* nb = lds + ((c + 1) & 1) * (SCAN_TC * 384);
#pragma unroll
            for (int i = 0; i < 6; ++i) if (ss[i] < nns) *(LAS f32x4*)(nb + ss[i] * 384 + so[i]) = stg[i];
        }
        __syncthreads();
    }
    *(f32x4*)(sout + vrow * 64 + kq * 4) = S;
}
__device__ __forceinline__ void ph_rwkv_scan(const P& p, LAS float* lds) {
    constexpr int NSCAN = 64;
    if ((int)blockIdx.x < NSCAN) {
        const int item = blockIdx.x >> 1, half = blockIdx.x & 1;
        scan_item(p, lds, (item >> 3) * SEQ, SEQ, item & 7, half, nullptr, p.out + O_WKV_P + (size_t)item * 4096);
    } else {
        const int nb = (int)gridDim.x - NSCAN;
        for (int hi = (int)blockIdx.x - NSCAN; hi < 512; hi += nb) {
            const int item = hi >> 1, half = hi & 1;
            scan_item(p, lds, NP + (item >> 3) * 8, 8, item & 7, half, p.state_wkv + (size_t)item * 4096, p.out + O_WKV_S + (size_t)item * 4096);
        }
    }
}

__device__ __forceinline__ void ph_rwkv_post(const P& p) {
    const int tid = threadIdx.x, lane = tid & 63, wid = tid >> 6;
    for (int it = blockIdx.x * 8 + wid; it < MR * 8; it += gridDim.x * 8) {
        const int row = it >> 3, h = it & 7, c = h * 64 + lane;
        const float y = p.ybuf()[(size_t)row * 512 + c];
        const float mean = wave_sum(y) * (1.0f / 64.0f);
        const float dv = y - mean;
        const float var = wave_sum(dv * dv) * (1.0f / 64.0f);
        float yn = dv * rsqrtf(var + 64e-5f) * p.gn_g[c] + p.gn_b[c];
        yn += p.bonus()[it] * p.rw6()[(size_t)it * 384 + 192 + lane];
        p.ob()[(size_t)row * 512 + c] = f2bf(yn * bf2f(p.rg()[(size_t)row * 512 + c]));
    }
}
#define KEEP_OLD_PATH 1
#ifndef SMODE
#define SMODE 3
#endif
#ifndef ATTN_MODE
#define ATTN_MODE 3
#endif

struct KSrcBf { const bf16_t* base; __device__ __forceinline__ bf16x8 operator()(int tok0, int ks, int lane) const { return *(const bf16x8*)(base + (size_t)(tok0 + (lane & 31)) * 64 + 16 * ks + 8 * (lane >> 5)); } };
struct VSrcBfT { const bf16_t* base; int ld; __device__ __forceinline__ bf16x8 operator()(int tok0, int dt, int s2, int lane) const {
        const bf16_t* ptr = base + (size_t)(32 * dt + (lane & 31)) * ld + tok0 + 16 * s2 + 4 * (lane >> 5);
        union { uint4 u; bf16x8 v; } x; const uint2 a = *(const uint2*)ptr, b = *(const uint2*)(ptr + 8); x.u.x = a.x; x.u.y = a.y; x.u.z = b.x; x.u.w = b.y; return x.v; } };

template <class KS>
__device__ __forceinline__ f32x16 qk_tile(const bf16x8 (&qf)[4], const KS& ks, int tok0, int lane) {
    f32x16 s = zero16();
#pragma unroll
    for (int k = 0; k < 4; ++k) s = mfma32(ks(tok0, k, lane), qf[k], s);
    return s;
}
template <class OKF>
__device__ __forceinline__ void sm_stats(const f32x16& s, int hb, OKF ok, float& m, float& l) {
    float sv[16]; float tmax = -1e30f; unsigned okm = 0;
#pragma unroll
    for (int i = 0; i < 16; ++i) { const int kl = (i & 3) + 8 * (i >> 2) + 4 * hb; const bool k = ok(kl); okm |= (k ? 1u : 0u) << i; sv[i] = k ? s[i] : -1e30f; tmax = fmaxf(tmax, sv[i]); }
    tmax = fmaxf(tmax, __shfl_xor(tmax, 32));
    const float mn = fmaxf(m, tmax), alpha = __expf(m - mn); m = mn;
    float ps = 0.f;
#pragma unroll
    for (int i = 0; i < 16; ++i) ps += ((okm >> i) & 1u) ? __expf(sv[i] - mn) : 0.f;
    l = l * alpha + ps;
}
template <class OKF, class VF>
__device__ __forceinline__ void sm_pv(const f32x16& s, int hb, OKF ok, VF vf, float& m, float& l, f32x16 (&o)[2]) {
    float sv[16]; float tmax = -1e30f; unsigned okm = 0;
#pragma unroll
    for (int i = 0; i < 16; ++i) { const int kl = (i & 3) + 8 * (i >> 2) + 4 * hb; const bool k = ok(kl); okm |= (k ? 1u : 0u) << i; sv[i] = k ? s[i] : -1e30f; tmax = fmaxf(tmax, sv[i]); }
    tmax = fmaxf(tmax, __shfl_xor(tmax, 32));
    const float mn = fmaxf(m, tmax), alpha = __expf(m - mn); m = mn;
    float pr[16]; float ps = 0.f;
#pragma unroll
    for (int i = 0; i < 16; ++i) { pr[i] = ((okm >> i) & 1u) ? __expf(sv[i] - mn) : 0.f; ps += pr[i]; }
    l = l * alpha + ps;
    o[0] *= alpha; o[1] *= alpha;
#pragma unroll
    for (int s2 = 0; s2 < 2; ++s2) {
        const bf16x8 pb = pack8(pr[8 * s2 + 0], pr[8 * s2 + 1], pr[8 * s2 + 2], pr[8 * s2 + 3], pr[8 * s2 + 4], pr[8 * s2 + 5], pr[8 * s2 + 6], pr[8 * s2 + 7]);
#pragma unroll
        for (int dt = 0; dt < 2; ++dt) o[dt] = mfma32(vf(dt, s2), pb, o[dt]);
    }
}
template <class OKF, class VF>
__device__ __forceinline__ void cmp_pass2(const f32x16& s, int hb, OKF ok, VF vf, float m, float inv, f32x16 (&o)[2], LAS float* prow, bool writer) {
    float pr[16];
#pragma unroll
    for (int i = 0; i < 16; ++i) {
        const int kl = (i & 3) + 8 * (i >> 2) + 4 * hb;
        pr[i] = ok(kl) ? __expf(s[i] - m) * inv : 0.f;
        float q = pr[i] + __shfl_xor(pr[i], 1); q += __shfl_xor(q, 2);
        if (writer) prow[kl] = q;
    }
#pragma unroll
    for (int s2 = 0; s2 < 2; ++s2) {
        const bf16x8 pb = pack8(pr[8 * s2 + 0], pr[8 * s2 + 1], pr[8 * s2 + 2], pr[8 * s2 + 3], pr[8 * s2 + 4], pr[8 * s2 + 5], pr[8 * s2 + 6], pr[8 * s2 + 7]);
#pragma unroll
        for (int dt = 0; dt < 2; ++dt) o[dt] = mfma32(vf(dt, s2), pb, o[dt]);
    }
}

__device__ __forceinline__ void attn_store(const P& p, const f32x16 (&of)[2], int qrow, int head, int hb, bool doit, bf16_t* oadst = nullptr) {
    if (!oadst) oadst = p.oa();
    if (!doit) return;
#pragma unroll
    for (int dt = 0; dt < 2; ++dt)
#pragma unroll
        for (int i4 = 0; i4 < 4; ++i4) {
            const int d = 32 * dt + 8 * i4 + 4 * hb;
            const size_t off = (size_t)qrow * 512 + head * 64 + d;
            const uint2 gw = *(const uint2*)(p.ag() + off);
            f32x4 v;
            v[0] = of[dt][4 * i4 + 0] * __uint_as_float(gw.x << 16); v[1] = of[dt][4 * i4 + 1] * __uint_as_float(gw.x & 0xffff0000u);
            v[2] = of[dt][4 * i4 + 2] * __uint_as_float(gw.y << 16); v[3] = of[dt][4 * i4 + 3] * __uint_as_float(gw.y & 0xffff0000u);
            st_bf4(oadst + off, v);
        }
}


__device__ __forceinline__ void of_put(LAS float* st, int lane, const f32x16 (&o)[2], float sc) {
#pragma unroll
    for (int dt = 0; dt < 2; ++dt)
#pragma unroll
        for (int i = 0; i < 16; ++i) st[(dt * 16 + i) * 64 + lane] = o[dt][i] * sc;
}
__device__ __forceinline__ void of_add(LAS float* st, int lane, const f32x16 (&o)[2], float sc) {
#pragma unroll
    for (int dt = 0; dt < 2; ++dt)
#pragma unroll
        for (int i = 0; i < 16; ++i) st[(dt * 16 + i) * 64 + lane] += o[dt][i] * sc;
}
__device__ __forceinline__ void of_get_add(LAS float* st, int lane, const f32x16 (&o)[2], float sc, f32x16 (&of)[2]) {
#pragma unroll
    for (int dt = 0; dt < 2; ++dt)
#pragma unroll
        for (int i = 0; i < 16; ++i) of[dt][i] = st[(dt * 16 + i) * 64 + lane] + o[dt][i] * sc;
}


template <class NEXT, class OKF>
__device__ __forceinline__ void tile_loop(const bf16x8 (&qf)[4], const KSrcBf& ksrc, const VSrcBfT& vsrc, int tt, NEXT next, OKF ok, int lane, float& m, float& l, f32x16 (&o)[2]) {
    if (tt < 0) return;
    const int hb = lane >> 5;
    bf16x8 kf[4];
#pragma unroll
    for (int ks = 0; ks < 4; ++ks) kf[ks] = ksrc(32 * tt, ks, lane);
#pragma unroll 1
    for (;;) {
        const int tok0 = 32 * tt;
        const int nt = next(tt);
        bf16x8 vf[2][2];
#pragma unroll
        for (int dt = 0; dt < 2; ++dt)
#pragma unroll
            for (int s2 = 0; s2 < 2; ++s2) vf[dt][s2] = vsrc(tok0, dt, s2, lane);
        bf16x8 kn[4];
        const int ntc = nt >= 0 ? nt : tt;
#pragma unroll
        for (int ks = 0; ks < 4; ++ks) kn[ks] = ksrc(32 * ntc, ks, lane);
        f32x16 s = zero16();
#pragma unroll
        for (int ks = 0; ks < 4; ++ks) s = mfma32(kf[ks], qf[ks], s);
        sm_pv(s, hb, [&](int kl) { return ok(tok0, kl); }, [&](int dt, int s2) { return vf[dt][s2]; }, m, l, o);
        if (nt < 0) break;
#pragma unroll
        for (int ks = 0; ks < 4; ++ks) kf[ks] = kn[ks];
        tt = nt;
    }
}

__device__ __forceinline__ void attn_prompt_item(const P& p, int item, LAS unsigned char* wl, int lane, bf16_t* oadst = nullptr) {
    const int bg = item & 7, tg = item >> 3, b = bg >> 1, g = bg & 1;
    const int col = lane & 31, hb = lane >> 5, tl = col >> 2, hh = col & 3;
    const int t0 = tg * 8, qpos = t0 + tl, qrow = b * SEQ + qpos, head = g * 4 + hh;
    bf16x8 qf[4];
#pragma unroll
    for (int ks = 0; ks < 4; ++ks) qf[ks] = *(const bf16x8*)(p.qb() + (size_t)qrow * 512 + head * 64 + 16 * ks + 8 * hb);
    LAS float* psum = (LAS float*)wl;
    LAS unsigned long long* msk = (LAS unsigned long long*)(wl + 8192);
    const float g0 = p.gates()[(size_t)qrow * 32 + head * 3 + 0], g1 = p.gates()[(size_t)qrow * 32 + head * 3 + 1], g2 = p.gates()[(size_t)qrow * 32 + head * 3 + 2];
    f32x16 oc[2]; oc[0] = zero16(); oc[1] = zero16();
    {
        const int cm = t0 + 7 - 31;
        const int ntile = cm >= 0 ? ((cm >> 4) >> 5) + 1 : 0;
        const KSrcBf ksrc{p.kc_p() + (size_t)bg * 256 * 64};
        const VSrcBfT vsrc{p.vcT_p() + (size_t)bg * 64 * 256, 256};
        float m = -1e30f, l = 0.f;
#pragma unroll 1
        for (int kt = 0; kt < ntile; ++kt) {
            const f32x16 s = qk_tile(qf, ksrc, 32 * kt, lane);
            sm_stats(s, hb, [&](int kl) { return 16 * (32 * kt + kl) + 31 <= qpos; }, m, l);
        }
        l += __shfl_xor(l, 32);
        const float inv = l > 0.f ? 1.0f / l : 0.f;
#pragma unroll
        for (int i = 0; i < 32; ++i) psum[i * 64 + lane] = 0.f;
        WAVE_SYNC();
#pragma unroll 1
        for (int kt = 0; kt < ntile; ++kt) {
            const f32x16 s = qk_tile(qf, ksrc, 32 * kt, lane);
            cmp_pass2(s, hb, [&](int kl) { return 16 * (32 * kt + kl) + 31 <= qpos; }, [&](int dt, int s2) { return vsrc(32 * kt, dt, s2, lane); }, m, inv, oc,
                      psum + tl * 256 + 32 * kt, hh == 0);
        }
    }
    WAVE_SYNC();
    for (int t2 = 0; t2 < 8; ++t2) {
        const int t = t0 + t2, cur = t >> 6, n = lane;
        float imp = 0.f;
#pragma unroll
        for (int c = -1; c < 4; ++c) { const int cc = 4 * n + c; if (cc >= 0) imp += psum[t2 * 256 + cc]; }
        if (n == 0 || n == cur || n == cur - 1) imp = 1e4f;
        if (n * 64 > t) imp = -1.0f;
        int rank = 0;
#pragma unroll
        for (int j = 0; j < 64; ++j) {
            const float vj = __uint_as_float(__builtin_amdgcn_readlane(__float_as_uint(imp), j));
            rank += (vj > imp || (vj == imp && j < n)) ? 1 : 0;
        }
        const unsigned long long mk = __ballot(rank < 16);
        if (lane == 0) msk[t2] = mk;
    }
    WAVE_SYNC();
    const unsigned long long mymask = msk[tl];
    unsigned long long um = 0;
#pragma unroll
    for (int i = 0; i < 8; ++i) um |= msk[i];
    const int cur0 = t0 >> 6;
    WAVE_SYNC();
    LAS float* ost = (LAS float*)wl;
    of_put(ost, lane, oc, g0);
    {
        const KSrcBf ksrc{p.kb() + (size_t)((1 * NB + b) * 2 + g) * SEQ * 64};
        const VSrcBfT vsrc{p.vT() + (size_t)((0 * NB + b) * 2 + g) * 64 * SEQ, SEQ};
        float m = -1e30f, l = 0.f; f32x16 o[2]; o[0] = zero16(); o[1] = zero16();
        {
            const unsigned um_lo = __builtin_amdgcn_readfirstlane((unsigned)um), um_hi = __builtin_amdgcn_readfirstlane((unsigned)(um >> 32));
            unsigned long long umu = ((unsigned long long)um_hi << 32) | um_lo;
            if (cur0 < 63) umu &= (2ull << cur0) - 1ull;
            const int first = umu ? 2 * (int)__builtin_ctzll(umu) : -1;
            tile_loop(qf, ksrc, vsrc, first,
                      [&](int tt) { if (!(tt & 1)) return tt + 1; const int n = tt >> 1; if (n >= 63) return -1; const unsigned long long rem = umu >> (n + 1); return rem ? 2 * (n + 1 + (int)__builtin_ctzll(rem)) : -1; },
                      [&](int tok0, int kl) { return (bool)((mymask >> (tok0 >> 6)) & 1ull) && (tok0 + kl <= qpos); }, lane, m, l, o);
        }
        l += __shfl_xor(l, 32);
        const float sc = l > 0.f ? g1 / l : 0.f;
        of_add(ost, lane, o, sc);
    }
    {
        const KSrcBf ksrc{p.kb() + (size_t)((2 * NB + b) * 2 + g) * SEQ * 64};
        const VSrcBfT vsrc{p.vT() + (size_t)((1 * NB + b) * 2 + g) * 64 * SEQ, SEQ};
        float m = -1e30f, l = 0.f; f32x16 o[2]; o[0] = zero16(); o[1] = zero16();
        const int lo = t0 - 511;
        const int nlo = lo > 0 ? (lo >> 6) : 0;
        {
            const int last = 2 * cur0 + 1;
            tile_loop(qf, ksrc, vsrc, 2 * nlo, [&](int tt) { return tt < last ? tt + 1 : -1; },
                      [&](int tok0, int kl) { const int key = tok0 + kl; return key <= qpos && key + 511 >= qpos; }, lane, m, l, o);
        }
        l += __shfl_xor(l, 32);
        const float sc = l > 0.f ? g2 / l : 0.f;
        f32x16 of[2];
        of_get_add(ost, lane, o, sc, of);
        attn_store(p, of, qrow, head, hb, true, oadst);
    }
    WAVE_SYNC();
}

template <class RP, class OKF>
__device__ __forceinline__ void f32_tile(const bf16x8 (&qf)[4], RP rp, OKF ok, LAS bf16_t* vt, int lane, float& m, float& l, f32x16 (&o)[2]) {
    const int col = lane & 31, hb = lane >> 5;
    const float* kr = rp(col);
    f32x16 s = zero16();
#pragma unroll
    for (int ks = 0; ks < 4; ++ks) {
        const float4 a = *(const float4*)(kr + 16 * ks + 8 * hb), c = *(const float4*)(kr + 16 * ks + 8 * hb + 4);
        s = mfma32(pack8(a.x, a.y, a.z, a.w, c.x, c.y, c.z, c.w), qf[ks], s);
    }
    const float* vr = kr + 128 + 32 * hb;
#pragma unroll
    for (int j4 = 0; j4 < 8; ++j4) {
        const float4 a = *(const float4*)(vr + 4 * j4);
        vt[(32 * hb + 4 * j4 + 0) * 40 + col] = f2bf(a.x); vt[(32 * hb + 4 * j4 + 1) * 40 + col] = f2bf(a.y);
        vt[(32 * hb + 4 * j4 + 2) * 40 + col] = f2bf(a.z); vt[(32 * hb + 4 * j4 + 3) * 40 + col] = f2bf(a.w);
    }
    WAVE_SYNC();
    sm_pv(s, hb, ok, [&](int dt, int s2) {
        LAS const bf16_t* ptr = vt + (32 * dt + col) * 40 + 16 * s2 + 4 * hb;
        union { uint4 u; bf16x8 v; } x; const u32x2 a = *(LAS const u32x2*)ptr, c = *(LAS const u32x2*)(ptr + 8); x.u.x = a[0]; x.u.y = a[1]; x.u.z = c[0]; x.u.w = c[1]; return x.v; }, m, l, o);
    WAVE_SYNC();
}

__device__ __forceinline__ void attn_sample_item(const P& p, int item, LAS unsigned char* wl, int lane) {
    const int t = item & 7, g = (item >> 3) & 1, b = item >> 4, bg = b * 2 + g;
    const int col = lane & 31, hb = lane >> 5, hh = col & 3;
    const int qpos = PAST + t, qrow = NP + b * 8 + t, head = g * 4 + hh;
    bf16x8 qf[4];
#pragma unroll
    for (int ks = 0; ks < 4; ++ks) qf[ks] = *(const bf16x8*)(p.qb() + (size_t)qrow * 512 + head * 64 + 16 * ks + 8 * hb);
    LAS float* psum = (LAS float*)wl;
    LAS int* list = (LAS int*)(wl + 8256);
    LAS float* impl = (LAS float*)(wl + 8448);
    LAS bf16_t* vt = (LAS bf16_t*)(wl + 9728);
    const float g0 = p.gates()[(size_t)qrow * 32 + head * 3 + 0], g1 = p.gates()[(size_t)qrow * 32 + head * 3 + 1], g2 = p.gates()[(size_t)qrow * 32 + head * 3 + 2];
    f32x16 oc[2]; oc[0] = zero16(); oc[1] = zero16();
    {
        const KSrcBf ksrc{p.kc_s() + (size_t)bg * 1024 * 64};
        const VSrcBfT vsrc{p.vcT_s() + (size_t)bg * 64 * 1024, 1024};
        float m = -1e30f, l = 0.f;
#pragma unroll 1
        for (int kt = 0; kt < 32; ++kt) {
            const f32x16 s = qk_tile(qf, ksrc, 32 * kt, lane);
            sm_stats(s, hb, [&](int kl) { return 32 * kt + kl <= 1022; }, m, l);
        }
        l += __shfl_xor(l, 32);
        const float inv = l > 0.f ? 1.0f / l : 0.f;
#pragma unroll 1
        for (int kt = 0; kt < 32; ++kt) {
            const f32x16 s = qk_tile(qf, ksrc, 32 * kt, lane);
            cmp_pass2(s, hb, [&](int kl) { return 32 * kt + kl <= 1022; }, [&](int dt, int s2) { return vsrc(32 * kt, dt, s2, lane); }, m, inv, oc, psum + 32 * kt, col == 0);
        }
    }
    WAVE_SYNC();
#pragma unroll
    for (int j = 0; j < 5; ++j) {
        const int n = lane + 64 * j;
        if (n <= 256) {
            float imp = 0.f;
            for (int c = -1; c < 4; ++c) { const int cc = 4 * n + c; if (cc >= 0 && cc <= 1022) imp += psum[cc]; }
            impl[n] = imp;
        }
    }
    WAVE_SYNC();
    {
        int base = 0;
#pragma unroll
        for (int j = 0; j < 4; ++j) {
            const int n = lane + 64 * j;
            const bool cand = n >= 1 && n <= 254;
            const float v = impl[n];
            int rank = 0;
            for (int q = 1; q <= 254; ++q) { const float vq = impl[q]; rank += (vq > v || (vq == v && q < n)) ? 1 : 0; }
            const bool sel = cand && rank < 13;
            const unsigned long long mk = __ballot(sel);
            if (sel) list[base + __popcll(mk & ((1ull << lane) - 1ull))] = n;
            base += __popcll(mk);
        }
        if (lane == 0) { list[13] = 0; list[14] = 255; list[15] = 256; }
    }
    WAVE_SYNC();
#if SMODE & 1
    LAS float* ost = (LAS float*)wl;
    of_put(ost, lane, oc, g0);
    {
        float m = -1e30f, l = 0.f; f32x16 o[2]; o[0] = zero16(); o[1] = zero16();
#pragma unroll 1
        for (int li = 0; li < 16; ++li) {
#if SMODE & 4
            const int n = li < 13 ? 17 * li + 5 : (li == 13 ? 0 : 242 + li);
#else
            const int n = __builtin_amdgcn_readfirstlane(list[li]);
#endif
            if (n < 256) {
                const int page = p.page_table[b * 128 + (n >> 1)];
                const float* base = p.cache_sel + ((size_t)page * 128 + (n & 1) * 64) * 256 + g * 64;
#pragma unroll 1
                for (int k2 = 0; k2 < 2; ++k2)
                    f32_tile(qf, [&](int kl) { return base + (size_t)(32 * k2 + kl) * 256; }, [&](int kl) { return true; }, vt, lane, m, l, o);
            } else {
                const float* base = p.out + O_SEL_S + (size_t)(b * 8) * 256 + g * 64;
                f32_tile(qf, [&](int kl) { return base + (size_t)(kl < 8 ? kl : 7) * 256; }, [&](int kl) { return kl <= t; }, vt, lane, m, l, o);
            }
        }
        l += __shfl_xor(l, 32);
        const float sc = l > 0.f ? g1 / l : 0.f;
        of_add(ost, lane, o, sc);
    }
#endif
#if SMODE & 2
    {
        float m = -1e30f, l = 0.f; f32x16 o[2]; o[0] = zero16(); o[1] = zero16();
        const float* cw = p.cache_win + (size_t)b * 512 * 256 + g * 64;
        const float* nw = p.out + O_WIN_S + ((size_t)b * 512 + 504) * 256 + g * 64;
#pragma unroll 1
        for (int kt = 0; kt < 17; ++kt) {
            f32_tile(qf, [&](int kl) { const int j = 32 * kt + kl; return j < 512 ? cw + (size_t)j * 256 : nw + (size_t)(j - 512 < 8 ? j - 512 : 7) * 256; },
                     [&](int kl) { const int j = 32 * kt + kl; return j >= t + 1 && j <= 512 + t; }, vt, lane, m, l, o);
        }
        l += __shfl_xor(l, 32);
        const float sc = l > 0.f ? g2 / l : 0.f;
        f32x16 of[2];
        of_get_add(ost, lane, o, sc, of);
        attn_store(p, of, qrow, head, hb, col < 4);
    }
    WAVE_SYNC();
#endif
}

typedef unsigned u32x4_t __attribute__((ext_vector_type(4)));
constexpr int WL_STRIDE = 15360, KV_OFF = 8 * WL_STRIDE, KV_BUF = 17920, XB_OFF = KV_OFF + 2 * KV_BUF;

template <bool WITH_V, class NEXT, class ACTIVE, class BODY>
__device__ __forceinline__ void block_loop(const bf16_t* kbase, const bf16_t* vbase, int ld, LAS unsigned char* kv, int first, NEXT next, ACTIVE active, BODY body) {
    if (first < 0) return;
    const int tid = threadIdx.x, srow = tid >> 3, sch = tid & 7;
    int n = first, cur = 0;
    u32x4_t kr, vr;
    kr = *(const u32x4_t*)(kbase + (size_t)(64 * n + srow) * 64 + sch * 8);
    if (WITH_V) vr = *(const u32x4_t*)(vbase + (size_t)srow * ld + 64 * n + sch * 8);
    *(LAS u32x4_t*)(kv + srow * 144 + sch * 16) = kr;
    if (WITH_V) { LAS u32x2* vp = (LAS u32x2*)(kv + 9216 + srow * 136 + sch * 16); vp[0] = (u32x2){vr[0], vr[1]}; vp[1] = (u32x2){vr[2], vr[3]}; }
    __syncthreads();
#pragma unroll 1
    for (;;) {
        const int nn = next(n);
        if (nn >= 0) {
            kr = *(const u32x4_t*)(kbase + (size_t)(64 * nn + srow) * 64 + sch * 8);
            if (WITH_V) vr = *(const u32x4_t*)(vbase + (size_t)srow * ld + 64 * nn + sch * 8);
        }
        if (active(n)) body(n, (LAS const bf16_t*)(kv + cur * KV_BUF), (LAS const bf16_t*)(kv + cur * KV_BUF + 9216));
        if (nn >= 0) {
            LAS unsigned char* nb = kv + (cur ^ 1) * KV_BUF;
            *(LAS u32x4_t*)(nb + srow * 144 + sch * 16) = kr;
            if (WITH_V) { LAS u32x2* vp = (LAS u32x2*)(nb + 9216 + srow * 136 + sch * 16); vp[0] = (u32x2){vr[0], vr[1]}; vp[1] = (u32x2){vr[2], vr[3]}; }
        }
        __syncthreads();
        if (nn < 0) break;
        cur ^= 1; n = nn;
    }
}
__device__ __forceinline__ bf16x8 lds_kfrag(LAS const bf16_t* kb, int kt, int ks, int col, int hb) { return *(LAS const bf16x8*)(kb + (32 * kt + col) * 72 + 16 * ks + 8 * hb); }
__device__ __forceinline__ bf16x8 lds_vfrag(LAS const bf16_t* vb, int kt, int dt, int s2, int col, int hb) {
    LAS const bf16_t* ptr = vb + (32 * dt + col) * 68 + 32 * kt + 16 * s2 + 4 * hb;
    union { u32x4_t u; bf16x8 v; } x; const u32x2 a = *(LAS const u32x2*)ptr, c = *(LAS const u32x2*)(ptr + 8); x.u[0] = a[0]; x.u[1] = a[1]; x.u[2] = c[0]; x.u[3] = c[1]; return x.v;
}
__device__ __forceinline__ f32x16 lds_qk(const bf16x8 (&qf)[4], LAS const bf16_t* kb, int kt, int col, int hb) {
    f32x16 s = zero16();
#pragma unroll
    for (int ks = 0; ks < 4; ++ks) s = mfma32(lds_kfrag(kb, kt, ks, col, hb), qf[ks], s);
    return s;
}

__device__ __forceinline__ void attn_prompt_block(const P& p, int bg, int j, LAS unsigned char* lds) {
    const int tid = threadIdx.x, lane = tid & 63, wid = tid >> 6;
    const int b = bg >> 1, g = bg & 1;
    const int col = lane & 31, hb = lane >> 5, tl = col >> 2, hh = col & 3;
    const int t0 = 64 * j + 8 * wid, qpos = t0 + tl, qrow = b * SEQ + qpos, head = g * 4 + hh;
    LAS unsigned char* wl = lds + wid * WL_STRIDE;
    LAS unsigned char* kv = lds + KV_OFF;
    LAS float* psum = (LAS float*)wl;
    LAS unsigned long long* msk = (LAS unsigned long long*)(wl + 8192);
    bf16x8 qf[4];
#pragma unroll
    for (int ks = 0; ks < 4; ++ks) qf[ks] = *(const bf16x8*)(p.qb() + (size_t)qrow * 512 + head * 64 + 16 * ks + 8 * hb);
    const float g0 = p.gates()[(size_t)qrow * 32 + head * 3 + 0], g1 = p.gates()[(size_t)qrow * 32 + head * 3 + 1], g2 = p.gates()[(size_t)qrow * 32 + head * 3 + 2];
    f32x16 oc[2]; oc[0] = zero16(); oc[1] = zero16();
    {
        const int cmb = 64 * j + 63 - 31;
        const int nbc = ((cmb >> 4) >> 6) + 1;
        const int cmw = t0 + 7 - 31;
        const int cmaxw = cmw >= 0 ? (cmw >> 4) : -1;
        const bf16_t* kc = p.kc_p() + (size_t)bg * 256 * 64;
        const bf16_t* vc = p.vcT_p() + (size_t)bg * 64 * 256;
        float m = -1e30f, l = 0.f;
        block_loop<false>(kc, vc, 256, kv, 0, [&](int n) { return n + 1 < nbc ? n + 1 : -1; }, [&](int n) { return cmaxw >= 64 * n; },
            [&](int n, LAS const bf16_t* kb, LAS const bf16_t* vb) {
#pragma unroll 1
                for (int kt = 0; kt < 2; ++kt) {
#if defined(BLK_GLOBAL_FRAGS)
                    const f32x16 s = qk_tile(qf, KSrcBf{kc}, 64 * n + 32 * kt, lane);
#else
                    const f32x16 s = lds_qk(qf, kb, kt, col, hb);
#endif
                    sm_stats(s, hb, [&](int kl) { return 16 * (64 * n + 32 * kt + kl) + 31 <= qpos; }, m, l);
                }
            });
        l += __shfl_xor(l, 32);
        const float inv = l > 0.f ? 1.0f / l : 0.f;
#pragma unroll
        for (int i = 0; i < 32; ++i) psum[i * 64 + lane] = 0.f;
        WAVE_SYNC();
        block_loop<true>(kc, vc, 256, kv, 0, [&](int n) { return n + 1 < nbc ? n + 1 : -1; }, [&](int n) { return cmaxw >= 64 * n; },
            [&](int n, LAS const bf16_t* kb, LAS const bf16_t* vb) {
#pragma unroll 1
                for (int kt = 0; kt < 2; ++kt) {
#if defined(BLK_GLOBAL_FRAGS)
                    const f32x16 s = qk_tile(qf, KSrcBf{kc}, 64 * n + 32 * kt, lane);
                    const VSrcBfT vsg{vc, 256};
                    cmp_pass2(s, hb, [&](int kl) { return 16 * (64 * n + 32 * kt + kl) + 31 <= qpos; }, [&](int dt, int s2) { return vsg(64 * n + 32 * kt, dt, s2, lane); }, m, inv, oc,
#else
                    const f32x16 s = lds_qk(qf, kb, kt, col, hb);
                    cmp_pass2(s, hb, [&](int kl) { return 16 * (64 * n + 32 * kt + kl) + 31 <= qpos; }, [&](int dt, int s2) { return lds_vfrag(vb, kt, dt, s2, col, hb); }, m, inv, oc,
#endif
                              psum + tl * 256 + 64 * n + 32 * kt, hh == 0);
                }
            });
    }
    WAVE_SYNC();
    unsigned long long umw = 0;
    for (int t2 = 0; t2 < 8; ++t2) {
        const int t = t0 + t2, cur = t >> 6, n = lane;
        float imp = 0.f;
#pragma unroll
        for (int c = -1; c < 4; ++c) { const int cc = 4 * n + c; if (cc >= 0) imp += psum[t2 * 256 + cc]; }
        if (n == 0 || n == cur || n == cur - 1) imp = 1e4f;
        if (n * 64 > t) imp = -1.0f;
        int rank = 0;
#pragma unroll
        for (int jj = 0; jj < 64; ++jj) {
            const float vj = __uint_as_float(__builtin_amdgcn_readlane(__float_as_uint(imp), jj));
            rank += (vj > imp || (vj == imp && jj < n)) ? 1 : 0;
        }
        const unsigned long long mk = __ballot(rank < 16);
        if (lane == 0) msk[t2] = mk;
        umw |= mk;
    }
    if (lane == 0) msk[8] = umw;
    __syncthreads();
    const unsigned long long mymask = msk[tl];
    unsigned long long umb = 0;
#pragma unroll
    for (int w2 = 0; w2 < 8; ++w2) umb |= *(LAS const unsigned long long*)(lds + w2 * WL_STRIDE + 8192 + 64);
    {
        const unsigned lo = __builtin_amdgcn_readfirstlane((unsigned)umb), hi = __builtin_amdgcn_readfirstlane((unsigned)(umb >> 32));
        umb = ((unsigned long long)hi << 32) | lo;
        if (j < 63) umb &= (2ull << j) - 1ull;
    }
    LAS float* ost = (LAS float*)wl;
#if defined(DBG_UMB)
    { const unsigned long long lim = j < 63 ? ((2ull << j) - 1ull) : ~0ull; if ((umw & lim & ~umb) != 0ull) oc[0][0] = __builtin_nanf(""); }
#endif
    of_put(ost, lane, oc, g0);
#if defined(DBG_SCHED)
    __builtin_amdgcn_sched_barrier(0);
#endif
#if defined(BLK_OLD_SEL)
    {
        const KSrcBf ksrc{p.kb() + (size_t)((1 * NB + b) * 2 + g) * SEQ * 64};
        const VSrcBfT vsrc{p.vT() + (size_t)((0 * NB + b) * 2 + g) * 64 * SEQ, SEQ};
        float m = -1e30f, l = 0.f; f32x16 o[2]; o[0] = zero16(); o[1] = zero16();
        unsigned long long umu = umw; const int cur0 = j;
        { const unsigned lo = __builtin_amdgcn_readfirstlane((unsigned)umu), hi = __builtin_amdgcn_readfirstlane((unsigned)(umu >> 32)); umu = ((unsigned long long)hi << 32) | lo; }
        if (cur0 < 63) umu &= (2ull << cur0) - 1ull;
        const int first = umu ? 2 * (int)__builtin_ctzll(umu) : -1;
        tile_loop(qf, ksrc, vsrc, first,
                  [&](int tt) { if (!(tt & 1)) return tt + 1; const int n = tt >> 1; if (n >= 63) return -1; const unsigned long long rem = umu >> (n + 1); return rem ? 2 * (n + 1 + (int)__builtin_ctzll(rem)) : -1; },
                  [&](int tok0, int kl) { return (bool)((mymask >> (tok0 >> 6)) & 1ull) && (tok0 + kl <= qpos); }, lane, m, l, o);
        l += __shfl_xor(l, 32);
        const float sc = l > 0.f ? g1 / l : 0.f;
        of_add(ost, lane, o, sc);
    }
#else
    {
        const bf16_t* kbs = p.kb() + (size_t)((1 * NB + b) * 2 + g) * SEQ * 64;
        const bf16_t* vbs = p.vT() + (size_t)((0 * NB + b) * 2 + g) * 64 * SEQ;
        float m = -1e30f, l = 0.f; f32x16 o[2]; o[0] = zero16(); o[1] = zero16();
        block_loop<true>(kbs, vbs, SEQ, kv, umb ? (int)__builtin_ctzll(umb) : -1,
            [&](int n) { if (n >= 63) return -1; const unsigned long long rem = umb >> (n + 1); return rem ? n + 1 + (int)__builtin_ctzll(rem) : -1; },
#if defined(SEL_ALWAYS_ACTIVE)
            [&](int n) { return true; },
#else
            [&](int n) { return (bool)((umw >> n) & 1ull); },
#endif
            [&](int n, LAS const bf16_t* kb, LAS const bf16_t* vb) {
                const bool bsel = (mymask >> n) & 1ull;
#pragma unroll
                for (int kt = 0; kt < 2; ++kt) {
                    const int tok0 = 64 * n + 32 * kt;
#if defined(BLK_GLOBAL_FRAGS)
                    const f32x16 s = qk_tile(qf, KSrcBf{kbs}, tok0, lane);
                    const VSrcBfT vsg{vbs, SEQ};
                    sm_pv(s, hb, [&](int kl) { return bsel && (tok0 + kl <= qpos); }, [&](int dt, int s2) { return vsg(tok0, dt, s2, lane); }, m, l, o);
#else
                    const f32x16 s = lds_qk(qf, kb, kt, col, hb);
                    sm_pv(s, hb, [&](int kl) { return (bool)((mymask >> (tok0 >> 6)) & 1ull) && (tok0 + kl <= qpos); }, [&](int dt, int s2) { return lds_vfrag(vb, kt, dt, s2, col, hb); }, m, l, o);
#endif
                }
            });
        l += __shfl_xor(l, 32);
        const float sc = l > 0.f ? g1 / l : 0.f;
        of_add(ost, lane, o, sc);
#if defined(DBG_SELCMP)
        {
            const float i1 = l > 0.f ? 1.0f / l : 0.f;
            float c1 = 0.f;
            for (int dt = 0; dt < 2; ++dt) for (int i = 0; i < 16; ++i) c1 += o[dt][i] * i1 * (1.0f + 0.37f * (float)(dt * 16 + i));
            const KSrcBf ksrc{kbs}; const VSrcBfT vsrc{vbs, SEQ};
            float m2 = -1e30f, l2 = 0.f; f32x16 o2[2]; o2[0] = zero16(); o2[1] = zero16();
            unsigned long long umu = umw;
            { const unsigned lo = __builtin_amdgcn_readfirstlane((unsigned)umu), hi = __builtin_amdgcn_readfirstlane((unsigned)(umu >> 32)); umu = ((unsigned long long)hi << 32) | lo; }
            if (j < 63) umu &= (2ull << j) - 1ull;
            const int first = umu ? 2 * (int)__builtin_ctzll(umu) : -1;
            tile_loop(qf, ksrc, vsrc, first,
                      [&](int tt) { if (!(tt & 1)) return tt + 1; const int n = tt >> 1; if (n >= 63) return -1; const unsigned long long rem = umu >> (n + 1); return rem ? 2 * (n + 1 + (int)__builtin_ctzll(rem)) : -1; },
                      [&](int tok0, int kl) { return (bool)((mymask >> (tok0 >> 6)) & 1ull) && (tok0 + kl <= qpos); }, lane, m2, l2, o2);
            l2 += __shfl_xor(l2, 32);
            const float i2 = l2 > 0.f ? 1.0f / l2 : 0.f;
            float c2 = 0.f;
            for (int dt = 0; dt < 2; ++dt) for (int i = 0; i < 16; ++i) c2 += o2[dt][i] * i2 * (1.0f + 0.37f * (float)(dt * 16 + i));
            if (!(fabsf(c1 - c2) < DBG_TOL) DBG_COND) ost[lane] = __builtin_nanf("");
        }
#endif
    }
#endif
#if defined(BLK_OLD_WIN)
    {
        const KSrcBf ksrc{p.kb() + (size_t)((2 * NB + b) * 2 + g) * SEQ * 64};
        const VSrcBfT vsrc{p.vT() + (size_t)((1 * NB + b) * 2 + g) * 64 * SEQ, SEQ};
        float m = -1e30f, l = 0.f; f32x16 o[2]; o[0] = zero16(); o[1] = zero16();
        const int lo = t0 - 511; const int nlo = lo > 0 ? (lo >> 6) : 0; const int last = 2 * j + 1;
        tile_loop(qf, ksrc, vsrc, 2 * nlo, [&](int tt) { return tt < last ? tt + 1 : -1; },
                  [&](int tok0, int kl) { const int key = tok0 + kl; return key <= qpos && key + 511 >= qpos; }, lane, m, l, o);
        l += __shfl_xor(l, 32);
        const float sc = l > 0.f ? g2 / l : 0.f;
        f32x16 of[2];
        of_get_add(ost, lane, o, sc, of);
        attn_store(p, of, qrow, head, hb, true);
    }
#else
#if defined(DBG_SCHED)
    __builtin_amdgcn_sched_barrier(0);
#endif
#if defined(DBG_EXTRA_SYNC)
    __syncthreads();
#endif
#if defined(DBG_SLEEP)
    for (int r = 0; r < (wid ^ (j & 7)) * 6; ++r) __builtin_amdgcn_s_sleep(100);
#endif
    {
        const bf16_t* kbw = p.kb() + (size_t)((2 * NB + b) * 2 + g) * SEQ * 64;
        const bf16_t* vbw = p.vT() + (size_t)((1 * NB + b) * 2 + g) * 64 * SEQ;
        float m = -1e30f, l = 0.f; f32x16 o[2]; o[0] = zero16(); o[1] = zero16();
        block_loop<true>(kbw, vbw, SEQ, kv, j > 8 ? j - 8 : 0, [&](int n) { return n < j ? n + 1 : -1; }, [&](int n) { return true; },
            [&](int n, LAS const bf16_t* kb, LAS const bf16_t* vb) {
#pragma unroll 1
                for (int kt = 0; kt < 2; ++kt) {
                    const int tok0 = 64 * n + 32 * kt;
#if defined(BLK_GLOBAL_FRAGS)
                    const f32x16 s = qk_tile(qf, KSrcBf{kbw}, tok0, lane);
                    const VSrcBfT vsg{vbw, SEQ};
                    sm_pv(s, hb, [&](int kl) { const int key = tok0 + kl; return key <= qpos && key + 511 >= qpos; }, [&](int dt, int s2) { return vsg(tok0, dt, s2, lane); }, m, l, o);
#else
                    const f32x16 s = lds_qk(qf, kb, kt, col, hb);
                    sm_pv(s, hb, [&](int kl) { const int key = tok0 + kl; return key <= qpos && key + 511 >= qpos; }, [&](int dt, int s2) { return lds_vfrag(vb, kt, dt, s2, col, hb); }, m, l, o);
#endif
                }
            });
        l += __shfl_xor(l, 32);
        const float sc = l > 0.f ? g2 / l : 0.f;
        f32x16 of[2];
        of_get_add(ost, lane, o, sc, of);
        attn_store(p, of, qrow, head, hb, true);
    }
#endif
    __syncthreads();
}

__device__ __forceinline__ void ph_attn(const P& p, LAS unsigned char* lds, int qsel = 0) {
    const int tid = threadIdx.x, lane = tid & 63, wid = tid >> 6;
    unsigned* ctr = p.bar() + 3584 + 64 * qsel;
    LAS unsigned* qslot = (LAS unsigned*)(lds + XB_OFF + 64);
    for (;;) {
        if (tid == 0) *qslot = __hip_atomic_fetch_add(ctr, 1u, __ATOMIC_RELAXED, __HIP_MEMORY_SCOPE_AGENT);
        __syncthreads();
        const unsigned q = __builtin_amdgcn_readfirstlane(*qslot);
        __syncthreads();
        if (q >= 64u + 512u) break;
        if (q < 64u) { attn_sample_item(p, (int)q * 8 + wid, lds + wid * WL_STRIDE, lane); __syncthreads(); }
#if defined(OLD_PROMPT_ATTN)
        else { const int idx = (int)q - 64; attn_prompt_item(p, 4095 - (idx * 8 + wid), lds + wid * WL_STRIDE, lane); __syncthreads(); }
#else
        else { const int idx = (int)q - 64; attn_prompt_block(p, idx & 7, 63 - (idx >> 3), lds);
#if defined(DBG_REDO_OLD)
            attn_prompt_item(p, (8 * (63 - (idx >> 3)) + wid) * 8 + (idx & 7), lds + wid * WL_STRIDE, lane); __syncthreads();
#endif
        }
#endif
    }
}

#if defined(DBG_CMPALL)
__device__ __forceinline__ void dbg_old_attn(const P& p, LAS unsigned char* lds) {
    const int tid = threadIdx.x, lane = tid & 63, wid = tid >> 6;
    for (int it = blockIdx.x * 8 + wid; it < 4096; it += gridDim.x * 8) attn_prompt_item(p, it, lds + wid * WL_STRIDE, lane, (bf16_t*)p.tmp());
}
__device__ __forceinline__ void dbg_compare(const P& p) {
    const int tid = threadIdx.x, lane = tid & 63, wid = tid >> 6;
    const bf16_t* a = p.oa(); const bf16_t* b = (const bf16_t*)p.tmp();
    unsigned cnt = 0;
    for (int it = blockIdx.x * 8 + wid; it < NP * 8; it += gridDim.x * 8) {
        const int row = it >> 3, head = it & 7;
        const float x = bf2f(a[(size_t)row * 512 + head * 64 + lane]), y = bf2f(b[(size_t)row * 512 + head * 64 + lane]);
        const bool bad = __any(!(fabsf(x - y) <= DBG_TOL));
        const int s = row & (SEQ - 1), j = s >> 6, w = (s >> 3) & 7, g = head >> 2, bb = row >> 12;
        if (bad && (DBG_SEL)) ++cnt;
    }
    if (lane == 0 && cnt) atomicAdd(p.bar() + 3840, cnt);
}
#endif

#if defined(KEEP_OLD_PATH)
__device__ __forceinline__ void keep_old_attn(const P& p, LAS unsigned char* lds) {
    const int tid = threadIdx.x, lane = tid & 63, wid = tid >> 6;
    const int ndbg = (int)__builtin_amdgcn_readfirstlane(__hip_atomic_load(p.bar() + 3900, __ATOMIC_RELAXED, __HIP_MEMORY_SCOPE_AGENT));
    for (int it = blockIdx.x * 8 + wid; it < ndbg; it += gridDim.x * 8) attn_prompt_item(p, it, lds + wid * WL_STRIDE, lane, (bf16_t*)p.tmp());
}
#endif
#ifndef PROBE_PHASE
#define PROBE_PHASE 0
#endif
#ifndef STOP_AFTER
#define STOP_AFTER 3
#endif

constexpr int LDS_BYTES = pg8::STAGE_BYTES;

template <class Epi> __global__ __launch_bounds__(512, 2) void k_gemm(pg8::Gemm g, Epi E) {
    extern __shared__ __attribute__((aligned(16))) unsigned char shm[];
    pg8::StaticOrder S; S.init(g.M, g.N, (int)gridDim.x, (int)blockIdx.x);
    pg8::gemm_phase<Epi, pg8::StaticOrder, false>((PG8_LAS unsigned char*)shm, g, S, E, nullptr);
}
template <int PH> __global__ __launch_bounds__(512, 2) void k_phase(P p) {
    extern __shared__ __attribute__((aligned(16))) unsigned char shm[];
    LAS unsigned char* lds = (LAS unsigned char*)shm;
    if constexpr (PH == 0) ph_prep(p);
    if constexpr (PH == 1) ph_compress2(p, p.LHp(), 8, 256, 255, p.kc_p(), p.vcT_p());
    if constexpr (PH == 2) ph_cvt_cache(p);
    if constexpr (PH == 3) ph_compress2(p, p.LHs(), 64, 1024, 1023, p.kc_s(), p.vcT_s());
    if constexpr (PH == 4) ph_rwkv_prep(p);
    if constexpr (PH == 5) ph_rwkv_scan(p, (LAS float*)lds);
    if constexpr (PH == 6) ph_rwkv_post(p);
    if constexpr (PH == 7) ph_attn(p, lds);
    if constexpr (PH == 8) ph_final(p);
}

template <class Epi> static void launch_gemm(hipStream_t st, const bf16_t* A, const bf16_t* Bt, int M, int N, int K, const Epi& E) {
    static bool attr = false;
    if (!attr) { (void)hipFuncSetAttribute((const void*)k_gemm<Epi>, hipFuncAttributeMaxDynamicSharedMemorySize, LDS_BYTES); attr = true; }
    pg8::Gemm g{}; g.A = A; g.Bt = Bt; g.M = M; g.N = N; g.K = K;
    hipLaunchKernelGGL((k_gemm<Epi>), dim3(256), dim3(512), LDS_BYTES, st, g, E);
}
template <int PH> static void launch_phase(hipStream_t st, const P& p) {
    static bool attr = false;
    if (!attr) { (void)hipFuncSetAttribute((const void*)k_phase<PH>, hipFuncAttributeMaxDynamicSharedMemorySize, LDS_BYTES); attr = true; }
    hipLaunchKernelGGL((k_phase<PH>), dim3(256), dim3(512), LDS_BYTES, st, p);
}


constexpr int FUSED_LDS = XB_OFF + 256;

template <class Epi> __device__ __forceinline__ void run_gemm(LAS unsigned char* lds, const bf16_t* A, const bf16_t* Bt, int M, int N, int K, const Epi& E) {
    pg8::Gemm g; g.A = A; g.Bt = Bt; g.M = M; g.N = N; g.K = K; g.pad_ = 0;
    pg8::StaticOrder S; S.init(M, N, (int)gridDim.x, (int)blockIdx.x);
    pg8::gemm_phase<Epi, pg8::StaticOrder, false>((PG8_LAS unsigned char*)lds, g, S, E, nullptr);
}

__global__ __launch_bounds__(512, 2) void k_fused(P p) {
    extern __shared__ __attribute__((aligned(16))) unsigned char shm[];
    LAS unsigned char* lds = (LAS unsigned char*)shm;
    LAS unsigned* xb = (LAS unsigned*)(lds + XB_OFF);
    if (threadIdx.x == 0) { xb[0] = 0u; xb[1] = 0u; xb[2] = 0u; xb[3] = 0u; }
    __syncthreads();
    XcdBarrier bar = xcd_barrier_post(p.bar(), (volatile LAS unsigned*)xb);
    ph_prep(p);
    ph_cvt_cache(p);
#if PROBE_PHASE == 1
    xcd_barrier(bar);
    ph_prep(p);
    ph_cvt_cache(p);
#endif
    xcd_barrier(bar);
    { EpiIn e; e.p = p; run_gemm(lds, p.hb(), p.WinT(), MR, NPAD, DM, e); }
    { EpiPlain e; e.C = p.LHs(); e.ldc = 256; e.pad_ = 0; run_gemm(lds, p.cs(), p.W1T(), 65536, 256, 1024, e); }
    { EpiPlain e; e.C = p.LHs() + (size_t)65536 * 256; e.ldc = 256; e.pad_ = 0; run_gemm(lds, p.cs() + (size_t)65536 * 1024, p.W1T() + (size_t)256 * 1024, 65536, 256, 1024, e); }
#if PROBE_PHASE == 2
    xcd_barrier(bar);
    { EpiIn e; e.p = p; run_gemm(lds, p.hb(), p.WinT(), MR, NPAD, DM, e); }
    { EpiPlain e; e.C = p.LHs(); e.ldc = 256; e.pad_ = 0; run_gemm(lds, p.cs(), p.W1T(), 65536, 256, 1024, e); }
    { EpiPlain e; e.C = p.LHs() + (size_t)65536 * 256; e.ldc = 256; e.pad_ = 0; run_gemm(lds, p.cs() + (size_t)65536 * 1024, p.W1T() + (size_t)256 * 1024, 65536, 256, 1024, e); }
#endif
    xcd_barrier(bar);
    { EpiPlain e; e.C = p.LHp(); e.ldc = 256; e.pad_ = 0; run_gemm(lds, p.kb(), p.W1T(), 2048, 256, 1024, e); }
    { EpiPlain e; e.C = p.LHp() + (size_t)2048 * 256; e.ldc = 256; e.pad_ = 0; run_gemm(lds, p.vcr(), p.W1T() + (size_t)256 * 1024, 2048, 256, 1024, e); }
    ph_rwkv_prep(p);
    ph_compress2(p, p.LHs(), 64, 1024, 1023, p.kc_s(), p.vcT_s());
#if PROBE_PHASE == 3
    xcd_barrier(bar);
    { EpiPlain e; e.C = p.LHp(); e.ldc = 256; e.pad_ = 0; run_gemm(lds, p.kb(), p.W1T(), 2048, 256, 1024, e); }
    { EpiPlain e; e.C = p.LHp() + (size_t)2048 * 256; e.ldc = 256; e.pad_ = 0; run_gemm(lds, p.vcr(), p.W1T() + (size_t)256 * 1024, 2048, 256, 1024, e); }
    ph_rwkv_prep(p);
    ph_compress2(p, p.LHs(), 64, 1024, 1023, p.kc_s(), p.vcT_s());
#endif
    xcd_barrier(bar);
    ph_compress2(p, p.LHp(), 8, 256, 255, p.kc_p(), p.vcT_p());
    xcd_barrier(bar);
    ph_rwkv_scan(p, (LAS float*)lds);
#if defined(SCAN_SEPARATE)
    xcd_barrier(bar);
#endif
    __syncthreads();
    ph_attn(p, lds);
#if PROBE_PHASE == 5
    xcd_barrier(bar);
    ph_attn(p, lds, 1);
#endif
    xcd_barrier(bar);
#if defined(KEEP_OLD_PATH)
    keep_old_attn(p, lds);
#endif
#if defined(DBG_XBAR)
    xcd_barrier(bar);
    xcd_barrier(bar);
#endif
#if defined(DBG_CMPALL)
    dbg_old_attn(p, lds);
    xcd_barrier(bar);
    dbg_compare(p);
    xcd_barrier(bar);
#endif
    ph_rwkv_post(p);
    { EpiYa e; e.p = p; small_gemm(p.oa(), p.WpaT(), 512, e); run_gemm(lds, p.oa(), p.WpaT(), NP, DM, 512, e); }
#if PROBE_PHASE == 6
    xcd_barrier(bar);
    ph_rwkv_post(p);
    { EpiYa e; e.p = p; small_gemm(p.oa(), p.WpaT(), 512, e); run_gemm(lds, p.oa(), p.WpaT(), NP, DM, 512, e); }
#endif
    xcd_barrier(bar);
    { EpiYb e; e.p = p; small_gemm(p.ob(), p.WpbT(), 512, e); run_gemm(lds, p.ob(), p.WpbT(), NP, DM, 512, e); }
#if PROBE_PHASE == 7
    xcd_barrier(bar);
    { EpiYb e; e.p = p; small_gemm(p.ob(), p.WpbT(), 512, e); run_gemm(lds, p.ob(), p.WpbT(), NP, DM, 512, e); }
#endif
    xcd_barrier(bar);
    { EpiOut e; e.p = p; small_gemm(p.mb(), p.WoutT(), DM, e); run_gemm(lds, p.mb(), p.WoutT(), NP, DM, DM, e); }
    { EpiPlain e; e.C = p.pp(); e.ldc = DM; e.pad_ = 0; small_gemm(p.pb(), p.WprojT(), 256, e); run_gemm(lds, p.pb(), p.WprojT(), NP, DM, 256, e); }
#if PROBE_PHASE == 8
    xcd_barrier(bar);
    { EpiOut e; e.p = p; small_gemm(p.mb(), p.WoutT(), DM, e); run_gemm(lds, p.mb(), p.WoutT(), NP, DM, DM, e); }
    { EpiPlain e; e.C = p.pp(); e.ldc = DM; e.pad_ = 0; small_gemm(p.pb(), p.WprojT(), 256, e); run_gemm(lds, p.pb(), p.WprojT(), NP, DM, 256, e); }
#endif
    xcd_barrier(bar);
    { EpiGate e; e.p = p; small_gemm(p.xg(), p.WgateT(), DM, e); run_gemm(lds, p.xg(), p.WgateT(), NP, DM, DM, e); }
#if PROBE_PHASE == 9
    xcd_barrier(bar);
    { EpiGate e; e.p = p; small_gemm(p.xg(), p.WgateT(), DM, e); run_gemm(lds, p.xg(), p.WgateT(), NP, DM, DM, e); }
#endif
    xcd_barrier(bar);
    ph_final(p);
}
extern "C" void kernel_launch(void* const* d_in, const int* in_sizes, int n_in, void* d_out, int out_size, void* d_ws, size_t ws_size, hipStream_t stream) {
    (void)in_sizes; (void)n_in; (void)out_size; (void)ws_size;
    P p{};
    p.x_prompt = (const float*)d_in[0]; p.x_sample = (const float*)d_in[1]; p.p_prompt = (const float*)d_in[2]; p.p_sample = (const float*)d_in[3];
    p.cache_cmp = (const float*)d_in[4]; p.cache_sel = (const float*)d_in[5]; p.cache_win = (const float*)d_in[6]; p.state_wkv = (const float*)d_in[7];
    p.state_shift = (const float*)d_in[8]; p.page_table = (const int*)d_in[9]; p.norm_g = (const float*)d_in[10]; p.w_in = (const float*)d_in[11];
    p.cmp_pe = (const float*)d_in[12]; p.cmp_w1 = (const float*)d_in[13]; p.cmp_b1 = (const float*)d_in[14]; p.cmp_w2 = (const float*)d_in[15]; p.cmp_b2 = (const float*)d_in[16];
    p.w_pa = (const float*)d_in[17]; p.mu = (const float*)d_in[18]; p.w0 = (const float*)d_in[19]; p.w_up = (const float*)d_in[20]; p.a0 = (const float*)d_in[21];
    p.a_up = (const float*)d_in[22]; p.k_k = (const float*)d_in[23]; p.k_a = (const float*)d_in[24]; p.r_k = (const float*)d_in[25]; p.gn_g = (const float*)d_in[26];
    p.gn_b = (const float*)d_in[27]; p.w_pb = (const float*)d_in[28]; p.w_out = (const float*)d_in[29]; p.ple_g = (const float*)d_in[30]; p.w_gate = (const float*)d_in[31];
    p.w_proj = (const float*)d_in[32]; p.final_g = (const float*)d_in[33];
    p.out = (float*)d_out;
    p.ws = (unsigned char*)d_ws;

#if defined(MULTI_LAUNCH)
    launch_phase<0>(stream, p);
    { EpiIn e{}; e.p = p; launch_gemm(stream, p.hb(), p.WinT(), MR, NPAD, DM, e); }
#if STOP_AFTER >= 3
    { EpiPlain e{}; e.C = p.LHp(); e.ldc = 256; launch_gemm(stream, p.kb(), p.W1T(), 2048, 256, 1024, e); }
    { EpiPlain e{}; e.C = p.LHp() + (size_t)2048 * 256; e.ldc = 256; launch_gemm(stream, p.vcr(), p.W1T() + (size_t)256 * 1024, 2048, 256, 1024, e); }
    launch_phase<1>(stream, p);
    launch_phase<2>(stream, p);
    { EpiPlain e{}; e.C = p.LHs(); e.ldc = 256; launch_gemm(stream, p.cs(), p.W1T(), 65536, 256, 1024, e); }
    { EpiPlain e{}; e.C = p.LHs() + (size_t)65536 * 256; e.ldc = 256; launch_gemm(stream, p.cs() + (size_t)65536 * 1024, p.W1T() + (size_t)256 * 1024, 65536, 256, 1024, e); }
    launch_phase<3>(stream, p);
#endif
#if STOP_AFTER >= 2
    launch_phase<4>(stream, p);
    launch_phase<5>(stream, p);
    launch_phase<6>(stream, p);
#endif
    hipMemsetAsync(p.oa(), 0, (size_t)MR * 512 * 2, stream);
#if STOP_AFTER >= 3
    launch_phase<7>(stream, p);
#endif
    { EpiYa e{}; e.p = p; launch_gemm(stream, p.oa(), p.WpaT(), MR, DM, 512, e); }
    { EpiYb e{}; e.p = p; launch_gemm(stream, p.ob(), p.WpbT(), MR, DM, 512, e); }
    { EpiOut e{}; e.p = p; launch_gemm(stream, p.mb(), p.WoutT(), MR, DM, DM, e); }
    { EpiPlain e{}; e.C = p.pp(); e.ldc = DM; launch_gemm(stream, p.pb(), p.WprojT(), MR, DM, 256, e); }
    { EpiGate e{}; e.p = p; launch_gemm(stream, p.xg(), p.WgateT(), MR, DM, DM, e); }
    launch_phase<8>(stream, p);
#else
    static int grid = 0;
    if (!grid) {
        int dev = 0, cus = 0, per_cu = 0;
        (void)hipGetDevice(&dev);
        (void)hipDeviceGetAttribute(&cus, hipDeviceAttributeMultiprocessorCount, dev);
        (void)hipFuncSetAttribute((const void*)k_fused, hipFuncAttributeMaxDynamicSharedMemorySize, FUSED_LDS);
        (void)hipOccupancyMaxActiveBlocksPerMultiprocessor(&per_cu, k_fused, 512, FUSED_LDS);
        grid = per_cu >= 1 ? cus : 0;
        if (grid > 256) grid = 256;
    }
    (void)hipMemsetAsync(p.bar(), 0, 32768, stream);
    if (grid > 0) hipLaunchKernelGGL(k_fused, dim3(grid), dim3(512), FUSED_LDS, stream, p);
#endif
}
```

```cpp
#include <hip/hip_runtime.h>
#include <stdint.h>
#include <stdio.h>
namespace pg8 {
#define PG8_LAS __attribute__((address_space(3)))
typedef unsigned short bf16_t;
typedef short bf16x8 __attribute__((ext_vector_type(8)));
typedef float f32x4 __attribute__((ext_vector_type(4)));
typedef unsigned u32x4 __attribute__((ext_vector_type(4)));
constexpr int BM = 256, BK = 64, HALF = 128, HTB = HALF * BK * 2  , STAGE_BYTES = 8 * HTB, NXCD = 8, WGM = 8;

__host__ __device__ __forceinline__ int lds_byte(int r, int c) { const int st = (r >> 4) * 2 + (c >> 5), rr = r & 15, cc = c & 31, ob = rr * 64 + cc * 2; return st * 1024 + (ob ^ (((ob >> 9) & 1) << 5)); }
__host__ __device__ __forceinline__ void stage_rc(int b, int& R, int& C) { const int st = b / 1024, sb = b % 1024, swz = sb ^ (((sb >> 9) & 1) << 5); R = (st >> 1) * 16 + swz / 64; C = (st & 1) * 32 + (swz % 64) / 2; }
__host__ __device__ __forceinline__ int perm32(int rho) { const int n = rho >> 4, i = rho & 15; return 8 * (i >> 2) + 4 * n + (i & 3); }

struct Unit { int pm, pn; };
struct Gemm { const bf16_t* A; const bf16_t* Bt; int M, N, K, pad_; };

struct StaticOrder {
    int nM, nN, nwg, G, c;
    __host__ __device__ void init(int M, int N, int G_, int c_) { nM = M / BM; nN = N / BM; nwg = nM * nN; G = G_; c = c_; }
    __host__ __device__ bool next(int i, Unit& u) const {
        const long L = (long)i * G + c; if (L >= nwg) return false;
        int wgid = (int)L; { const int q = nwg / NXCD, r = nwg % NXCD, xcd = wgid % NXCD, off = wgid / NXCD; wgid = (xcd < r ? xcd * (q + 1) : r * (q + 1) + (xcd - r) * q) + off; }
        const int nig = WGM * nN, gid = wgid / nig, fm = gid * WGM, gsz = (nM - fm) < WGM ? (nM - fm) : WGM;
        u.pm = fm + ((wgid % nig) % gsz); u.pn = (wgid % nig) / gsz; return true;
    }
    __device__ __forceinline__ void a_ready(const Unit&) const {}
    __device__ __forceinline__ void done(const Unit&) const {}
};
__device__ __forceinline__ unsigned cvt_pk_bf16(float lo, float hi) { unsigned r; asm volatile("v_cvt_pk_bf16_f32 %0, %1, %2" : "=v"(r) : "v"(lo), "v"(hi)); return r; }
typedef float f32x2 __attribute__((ext_vector_type(2)));
template <class Epi, class Sched, bool STAMP = false>
__device__ __forceinline__ void gemm_phase(PG8_LAS unsigned char* lds, const Gemm g, const Sched& S, const Epi& E, unsigned long long* stamps) {
    int tid_l = threadIdx.x; asm volatile("" : "+v"(tid_l));
    const int tid = tid_l, wid = __builtin_amdgcn_readfirstlane(tid >> 6), lane = tid & 63, wr = wid >> 2, wc = wid & 3, fr = lane & 15, fq = lane >> 4;
    const int K = g.K, nt = K / BK;
    int ts_lo = 0, ts_hi = 0, nts = 0; const unsigned long long rt_entry = STAMP ? (unsigned long long)wall_clock64() : 0ull;
#define PG8_STAMP() do { if (STAMP && wid == 0 && nts < 64) { const unsigned long long _c = (unsigned long long)clock64(); \
        ts_lo = (lane == nts) ? (int)(unsigned)_c : ts_lo; ts_hi = (lane == nts) ? (int)(unsigned)(_c >> 32) : ts_hi; ++nts; } } while (0)
    PG8_STAMP();
    unsigned voffA[2], voffB[2];
#pragma unroll
    for (int i = 0; i < 2; ++i) { int R, C; stage_rc(tid * 16 + i * 8192, R, C); const int Rb = Epi::PERM ? ((R & ~31) + perm32(R & 31)) : R;
        voffA[i] = (unsigned)(R * K + C) * 2u; voffB[i] = (unsigned)(Rb * K + C) * 2u; }
    const size_t kstep = (size_t)(BK * 2);
    const size_t hstep = (size_t)HALF * K * 2;
    const size_t tstep = 2 * hstep;
    const unsigned ldsw = (unsigned)wid * 1024u;
    const int aoff = lds_byte(wr * 64 + fr, fq * 8), boff = lds_byte(wc * 32 + fr, fq * 8);
#define PG8_SA(b, h) (((b) * 2 + (h)) * HTB)
#define PG8_SB(b, h) ((4 + (b) * 2 + (h)) * HTB)
#define PG8_STAGE(bufoff, gbase, voff) do { _Pragma("unroll") for (int _i = 0; _i < 2; ++_i) \
        __builtin_amdgcn_global_load_lds((const unsigned*)((const char*)(gbase) + (voff)[_i]), (PG8_LAS unsigned*)(lds + (bufoff) + ldsw + _i * 8192), 16, 0, 0); } while (0)
#define PG8_LDA(dst, b, h) do { _Pragma("unroll") for (int m = 0; m < 4; ++m) _Pragma("unroll") for (int k = 0; k < 2; ++k) dst[m][k] = *(const PG8_LAS bf16x8*)(lds + PG8_SA(b, h) + aoff + m * 2048 + k * 1024); } while (0)
#define PG8_LDB(dst, b, h) do { _Pragma("unroll") for (int n = 0; n < 2; ++n) _Pragma("unroll") for (int k = 0; k < 2; ++k) dst[n][k] = *(const PG8_LAS bf16x8*)(lds + PG8_SB(b, h) + boff + n * 2048 + k * 1024); } while (0)
#define PG8_MMA(ai, bj, At, Bt) do { __builtin_amdgcn_s_setprio(1); _Pragma("unroll") for (int m = 0; m < 4; ++m) _Pragma("unroll") for (int n = 0; n < 2; ++n) _Pragma("unroll") for (int k = 0; k < 2; ++k) \
        acc[ai][bj][m][n] = __builtin_amdgcn_mfma_f32_16x16x32_bf16(Bt[n][k], At[m][k], acc[ai][bj][m][n], 0, 0, 0); __builtin_amdgcn_s_setprio(0); } while (0)
#define PG8_WAIT_V(n) asm volatile("s_waitcnt vmcnt(" #n ")" ::: "memory")
#define PG8_WAIT_L(n) asm volatile("s_waitcnt lgkmcnt(" #n ")" ::: "memory")
#define PG8_BAR __builtin_amdgcn_s_barrier()
#define PG8_SCHED __builtin_amdgcn_sched_barrier(0)
    Unit cur, nxt; int ui = 0;
    if (!S.next(0, cur)) return;
    f32x4 acc[2][2][4][2];
#pragma unroll
    for (int a = 0; a < 2; ++a)
#pragma unroll
        for (int b = 0; b < 2; ++b)
#pragma unroll
            for (int m = 0; m < 4; ++m)
#pragma unroll
                for (int n = 0; n < 2; ++n) acc[a][b][m][n] = (f32x4){0.f, 0.f, 0.f, 0.f};
    bf16x8 At[4][2], B0[2][2], B1[2][2];
    const char* cA = (const char*)g.A + (size_t)cur.pm * tstep; const char* cB = (const char*)g.Bt + (size_t)cur.pn * tstep;
    S.a_ready(cur);
    PG8_STAGE(PG8_SB(0, 0), cB, voffB); PG8_STAGE(PG8_SA(0, 0), cA, voffA); PG8_STAGE(PG8_SB(0, 1), cB + hstep, voffB); PG8_STAGE(PG8_SA(0, 1), cA + hstep, voffA);
    if (wr == 1) PG8_BAR;
    PG8_WAIT_V(4); PG8_BAR;
    PG8_STAGE(PG8_SB(1, 0), cB + kstep, voffB); PG8_STAGE(PG8_SA(1, 0), cA + kstep, voffA); PG8_STAGE(PG8_SB(1, 1), cB + hstep + kstep, voffB);
    PG8_WAIT_V(6); PG8_BAR;
    PG8_STAMP();
    for (;;) {
        const bool has_next = S.next(ui + 1, nxt);
        const char* nA = has_next ? (const char*)g.A + (size_t)nxt.pm * tstep : cA; const char* nB = has_next ? (const char*)g.Bt + (size_t)nxt.pn * tstep : cB;
        for (int t = 0; t < nt; t += 2) {
            const bool last = (t == nt - 2);
            const char* a1 = cA + (size_t)(t + 1) * kstep;
            const char* a2 = last ? nA : cA + (size_t)(t + 2) * kstep; const char* b2 = last ? nB : cB + (size_t)(t + 2) * kstep;
            const char* a3 = a2 + kstep; const char* b3 = b2 + kstep;
            if (last && has_next) S.a_ready(nxt);
            PG8_LDB(B0, 0, 0); PG8_SCHED; PG8_LDA(At, 0, 0); PG8_STAGE(PG8_SA(1, 1), a1 + hstep, voffA);
            PG8_WAIT_L(8); PG8_BAR; PG8_WAIT_L(0); PG8_MMA(0, 0, At, B0); PG8_BAR; PG8_SCHED;
            PG8_LDB(B1, 0, 1); PG8_STAGE(PG8_SB(0, 0), b2, voffB);
            PG8_BAR; PG8_WAIT_L(0); PG8_MMA(0, 1, At, B1); PG8_BAR;
            PG8_LDA(At, 0, 1); PG8_STAGE(PG8_SA(0, 0), a2, voffA);
            PG8_BAR; PG8_WAIT_L(0); PG8_MMA(1, 0, At, B0); PG8_BAR; PG8_SCHED;
            PG8_STAGE(PG8_SB(0, 1), b2 + hstep, voffB);
            PG8_WAIT_V(6); PG8_BAR; PG8_MMA(1, 1, At, B1); PG8_BAR;
            PG8_LDB(B0, 1, 0); PG8_SCHED; PG8_LDA(At, 1, 0); PG8_STAGE(PG8_SA(0, 1), a2 + hstep, voffA);
            PG8_WAIT_L(8); PG8_BAR; PG8_WAIT_L(0); PG8_MMA(0, 0, At, B0); PG8_BAR; PG8_SCHED;
            PG8_LDB(B1, 1, 1); PG8_STAGE(PG8_SB(1, 0), b3, voffB);
            PG8_BAR; PG8_WAIT_L(0); PG8_MMA(0, 1, At, B1); PG8_BAR;
            PG8_LDA(At, 1, 1); PG8_STAGE(PG8_SA(1, 0), a3, voffA);
            PG8_BAR; PG8_WAIT_L(0); PG8_MMA(1, 0, At, B0); PG8_BAR; PG8_SCHED;
            PG8_STAGE(PG8_SB(1, 1), b3 + hstep, voffB);
            PG8_WAIT_V(6); PG8_BAR; PG8_MMA(1, 1, At, B1); PG8_BAR;
        }
        PG8_STAMP();
        if constexpr (!Epi::AFTER_DRAIN) { E(acc, cur, wr, wc, fr, fq); S.done(cur); }
        PG8_STAMP();
        if (!has_next) break;
#pragma unroll
        for (int a = 0; a < 2; ++a)
#pragma unroll
            for (int b = 0; b < 2; ++b)
#pragma unroll
                for (int m = 0; m < 4; ++m)
#pragma unroll
                    for (int n = 0; n < 2; ++n) acc[a][b][m][n] = (f32x4){0.f, 0.f, 0.f, 0.f};
        cur = nxt; cA = nA; cB = nB; ++ui;
    }
    PG8_WAIT_V(0);
    if (wr == 0) PG8_BAR;
    PG8_BAR;
    if constexpr (Epi::AFTER_DRAIN) { E.fused(acc, cur, wr, wc, fr, fq, lds, wid, lane); S.done(cur); }
    PG8_STAMP();
    if (STAMP && wid == 0) { stamps[lane] = lane < nts ? (((unsigned long long)(unsigned)ts_hi << 32) | (unsigned)ts_lo) : 0ull;
        if (lane == 62) stamps[62] = rt_entry; if (lane == 63) stamps[63] = (unsigned long long)wall_clock64(); }
#undef PG8_STAMP
#undef PG8_SA
#undef PG8_SB
#undef PG8_STAGE
#undef PG8_LDA
#undef PG8_LDB
#undef PG8_MMA
#undef PG8_WAIT_V
#undef PG8_WAIT_L
#undef PG8_BAR
#undef PG8_SCHED
}
}

typedef unsigned short bf16_t;
typedef short bf16x8 __attribute__((ext_vector_type(8)));
typedef float f32x4 __attribute__((ext_vector_type(4)));
typedef float f32x16 __attribute__((ext_vector_type(16)));
#define LAS __attribute__((address_space(3)))
#define WAVE_SYNC() do { asm volatile("s_waitcnt lgkmcnt(0)" ::: "memory"); __builtin_amdgcn_wave_barrier(); } while (0)

constexpr int DM = 1024, NP = 16384, NSMP = 256, MR = 16640, SEQ = 4096, NB = 4, DB = 32, DS = 8, PAST = 16384;
constexpr int CIN = 6040, NPAD = 6144, CR = 1664;
constexpr int NTHR = 512;
constexpr size_t O_Y_P = 0, O_Y_S = 16777216, O_CMP_P = 17039360, O_CMP_S = 21233664, O_SEL_P = 21299200, O_SEL_S = 25493504,
                 O_WIN_P = 25559040, O_WIN_S = 26083328, O_WKV_P = 30277632, O_WKV_S = 30408704, O_SH_P = 31457280, O_SH_S = 31463936;

constexpr size_t ws_al(size_t x) { return (x + 255) & ~(size_t)255; }
constexpr size_t WS_bar = 0;
constexpr size_t WS_hb = WS_bar + ws_al(32768);
constexpr size_t WS_WinT = WS_hb + ws_al((size_t)MR * DM * 2);
constexpr size_t WS_WpaT = WS_WinT + ws_al((size_t)NPAD * DM * 2);
constexpr size_t WS_WpbT = WS_WpaT + ws_al((size_t)DM * 512 * 2);
constexpr size_t WS_WoutT = WS_WpbT + ws_al((size_t)DM * 512 * 2);
constexpr size_t WS_WgateT = WS_WoutT + ws_al((size_t)DM * DM * 2);
constexpr size_t WS_WprojT = WS_WgateT + ws_al((size_t)DM * DM * 2);
constexpr size_t WS_W1T = WS_WprojT + ws_al((size_t)DM * 256 * 2);
constexpr size_t WS_W2T = WS_W1T + ws_al((size_t)512 * 1024 * 2);
constexpr size_t WS_WupT = WS_W2T + ws_al((size_t)128 * 128 * 2);
constexpr size_t WS_AupT = WS_WupT + ws_al((size_t)512 * 64 * 2);
constexpr size_t WS_pb = WS_AupT + ws_al((size_t)512 * 64 * 2);
constexpr size_t WS_tabc = WS_pb + ws_al((size_t)MR * 256 * 2);
constexpr size_t WS_tabs = WS_tabc + ws_al((size_t)4104 * 32 * 4);
constexpr size_t WS_pt = WS_tabs + ws_al((size_t)4104 * 32 * 4);
constexpr size_t WS_qb = WS_pt + ws_al(256 * 4);
constexpr size_t WS_kb = WS_qb + ws_al((size_t)MR * 512 * 2);
constexpr size_t WS_vcr = WS_kb + ws_al((size_t)3 * NB * 2 * SEQ * 64 * 2);
constexpr size_t WS_vT = WS_vcr + ws_al((size_t)NB * 2 * SEQ * 64 * 2);
constexpr size_t WS_ag = WS_vT + ws_al((size_t)2 * NB * 2 * 64 * SEQ * 2);
constexpr size_t WS_rg = WS_ag + ws_al((size_t)MR * 512 * 2);
constexpr size_t WS_mg = WS_rg + ws_al((size_t)MR * 512 * 2);
constexpr size_t WS_gates = WS_mg + ws_al((size_t)MR * 2048 * 2);
constexpr size_t WS_rz = WS_gates + ws_al((size_t)MR * 32 * 4);
constexpr size_t WS_LHp = WS_rz + ws_al((size_t)MR * CR * 4);
constexpr size_t WS_LHs = WS_LHp + ws_al((size_t)2 * 2048 * 256 * 4);
constexpr size_t WS_cs = WS_LHs + ws_al((size_t)2 * 65536 * 256 * 4);
constexpr size_t WS_kc_p = WS_cs + ws_al((size_t)2 * 65536 * 1024 * 2);
constexpr size_t WS_vcT_p = WS_kc_p + ws_al((size_t)8 * 256 * 64 * 2);
constexpr size_t WS_kc_s = WS_vcT_p + ws_al((size_t)8 * 64 * 256 * 2);
constexpr size_t WS_vcT_s = WS_kc_s + ws_al((size_t)64 * 1024 * 64 * 2);
constexpr size_t WS_rw6 = WS_vcT_s + ws_al((size_t)64 * 64 * 1024 * 2);
constexpr size_t WS_bonus = WS_rw6 + ws_al((size_t)MR * 8 * 384 * 4);
constexpr size_t WS_ybuf = WS_bonus + ws_al((size_t)MR * 8 * 4);
constexpr size_t WS_oa = WS_ybuf + ws_al((size_t)MR * 512 * 4);
constexpr size_t WS_ob = WS_oa + ws_al((size_t)MR * 512 * 2);
constexpr size_t WS_mb = WS_ob + ws_al((size_t)MR * 512 * 2);
constexpr size_t WS_xg = WS_mb + ws_al((size_t)MR * DM * 2);
constexpr size_t WS_tmp = WS_xg + ws_al((size_t)MR * DM * 2);
constexpr size_t WS_x1 = WS_tmp + ws_al((size_t)MR * DM * 4);
constexpr size_t WS_ss1 = WS_x1 + ws_al((size_t)MR * DM * 4);
constexpr size_t WS_pp = WS_ss1 + ws_al((size_t)MR * 16 * 4);
constexpr size_t WS_TOTAL = WS_pp + ws_al((size_t)MR * DM * 4);

struct P {
    const float *x_prompt, *x_sample, *p_prompt, *p_sample, *cache_cmp, *cache_sel, *cache_win, *state_wkv, *state_shift;
    const int* page_table;
    const float *norm_g, *w_in, *cmp_pe, *cmp_w1, *cmp_b1, *cmp_w2, *cmp_b2, *w_pa, *mu, *w0, *w_up, *a0, *a_up, *k_k, *k_a, *r_k, *gn_g, *gn_b,
        *w_pb, *w_out, *ple_g, *w_gate, *w_proj, *final_g;
    float* out;
    unsigned char* ws;
    __host__ __device__ __forceinline__ unsigned* bar() const { return (unsigned*)(ws + WS_bar); }
    __host__ __device__ __forceinline__ float* ss_s() const { return (float*)(ws + WS_bar + 16384); }
    __host__ __device__ __forceinline__ bf16_t* hb() const { return (bf16_t*)(ws + WS_hb); }
    __host__ __device__ __forceinline__ bf16_t* WinT() const { return (bf16_t*)(ws + WS_WinT); }
    __host__ __device__ __forceinline__ bf16_t* WpaT() const { return (bf16_t*)(ws + WS_WpaT); }
    __host__ __device__ __forceinline__ bf16_t* WpbT() const { return (bf16_t*)(ws + WS_WpbT); }
    __host__ __device__ __forceinline__ bf16_t* WoutT() const { return (bf16_t*)(ws + WS_WoutT); }
    __host__ __device__ __forceinline__ bf16_t* WgateT() const { return (bf16_t*)(ws + WS_WgateT); }
    __host__ __device__ __forceinline__ bf16_t* WprojT() const { return (bf16_t*)(ws + WS_WprojT); }
    __host__ __device__ __forceinline__ bf16_t* W1T() const { return (bf16_t*)(ws + WS_W1T); }
    __host__ __device__ __forceinline__ bf16_t* W2T() const { return (bf16_t*)(ws + WS_W2T); }
    __host__ __device__ __forceinline__ bf16_t* WupT() const { return (bf16_t*)(ws + WS_WupT); }
    __host__ __device__ __forceinline__ bf16_t* AupT() const { return (bf16_t*)(ws + WS_AupT); }
    __host__ __device__ __forceinline__ bf16_t* pb() const { return (bf16_t*)(ws + WS_pb); }
    __host__ __device__ __forceinline__ float* tabc() const { return (float*)(ws + WS_tabc); }
    __host__ __device__ __forceinline__ float* tabs() const { return (float*)(ws + WS_tabs); }
    __host__ __device__ __forceinline__ float* pt() const { return (float*)(ws + WS_pt); }
    __host__ __device__ __forceinline__ bf16_t* qb() const { return (bf16_t*)(ws + WS_qb); }
    __host__ __device__ __forceinline__ bf16_t* kb() const { return (bf16_t*)(ws + WS_kb); }
    __host__ __device__ __forceinline__ bf16_t* vcr() const { return (bf16_t*)(ws + WS_vcr); }
    __host__ __device__ __forceinline__ bf16_t* vT() const { return (bf16_t*)(ws + WS_vT); }
    __host__ __device__ __forceinline__ bf16_t* ag() const { return (bf16_t*)(ws + WS_ag); }
    __host__ __device__ __forceinline__ bf16_t* rg() const { return (bf16_t*)(ws + WS_rg); }
    __host__ __device__ __forceinline__ bf16_t* mg() const { return (bf16_t*)(ws + WS_mg); }
    __host__ __device__ __forceinline__ float* gates() const { return (float*)(ws + WS_gates); }
    __host__ __device__ __forceinline__ float* rz() const { return (float*)(ws + WS_rz); }
    __host__ __device__ __forceinline__ float* LHp() const { return (float*)(ws + WS_LHp); }
    __host__ __device__ __forceinline__ float* LHs() const { return (float*)(ws + WS_LHs); }
    __host__ __device__ __forceinline__ bf16_t* cs() const { return (bf16_t*)(ws + WS_cs); }
    __host__ __device__ __forceinline__ bf16_t* kc_p() const { return (bf16_t*)(ws + WS_kc_p); }
    __host__ __device__ __forceinline__ bf16_t* vcT_p() const { return (bf16_t*)(ws + WS_vcT_p); }
    __host__ __device__ __forceinline__ bf16_t* kc_s() const { return (bf16_t*)(ws + WS_kc_s); }
    __host__ __device__ __forceinline__ bf16_t* vcT_s() const { return (bf16_t*)(ws + WS_vcT_s); }
    __host__ __device__ __forceinline__ float* rw6() const { return (float*)(ws + WS_rw6); }
    __host__ __device__ __forceinline__ float* bonus() const { return (float*)(ws + WS_bonus); }
    __host__ __device__ __forceinline__ float* ybuf() const { return (float*)(ws + WS_ybuf); }
    __host__ __device__ __forceinline__ bf16_t* oa() const { return (bf16_t*)(ws + WS_oa); }
    __host__ __device__ __forceinline__ bf16_t* ob() const { return (bf16_t*)(ws + WS_ob); }
    __host__ __device__ __forceinline__ bf16_t* mb() const { return (bf16_t*)(ws + WS_mb); }
    __host__ __device__ __forceinline__ bf16_t* xg() const { return (bf16_t*)(ws + WS_xg); }
    __host__ __device__ __forceinline__ float* tmp() const { return (float*)(ws + WS_tmp); }
    __host__ __device__ __forceinline__ float* x1() const { return (float*)(ws + WS_x1); }
    __host__ __device__ __forceinline__ float* ss1() const { return (float*)(ws + WS_ss1); }
    __host__ __device__ __forceinline__ float* pp() const { return (float*)(ws + WS_pp); }
};

__device__ __forceinline__ bf16_t f2bf(float f) { unsigned u = __float_as_uint(f); u += 0x7FFFu + ((u >> 16) & 1u); return (bf16_t)(u >> 16); }
__device__ __forceinline__ float bf2f(bf16_t b) { return __uint_as_float(((unsigned)b) << 16); }
typedef __bf16 bf16v2_t __attribute__((ext_vector_type(2)));
typedef float f32x2_t __attribute__((ext_vector_type(2)));
__device__ __forceinline__ unsigned pk2(float lo, float hi) { const f32x2_t v = {lo, hi}; return __builtin_bit_cast(unsigned, __builtin_convertvector(v, bf16v2_t)); }
__device__ __forceinline__ float wave_sum(float v) {
#pragma unroll
    for (int o = 32; o >= 1; o >>= 1) v += __shfl_xor(v, o);
    return v;
}
__device__ __forceinline__ float sigmoidf_(float x) { return 1.0f / (1.0f + __expf(-x)); }
__device__ __forceinline__ float siluf_(float x) { return x / (1.0f + __expf(-x)); }

__device__ __forceinline__ int win_src_col(int np) {
    const int pn = np >> 8, p = np & 255;
    if (pn < 5) {
        const int bj = p >> 7, wc = (p >> 5) & 3, n = (p >> 4) & 1, fq = (p >> 2) & 3, e = p & 3;
        const int d = 32 * n + 16 * (wc & 1) + 4 * fq + e;
        if (pn < 2) { const int head = pn * 4 + bj * 2 + (wc >> 1); return head * 64 + d; }
        const int br = pn - 2, g = wc >> 1;
        return 512 + br * 256 + bj * 128 + g * 64 + d;
    }
    if (pn < 7) return 1304 + (pn - 5) * 256 + p;
    if (pn < 13) return 1816 + (pn - 7) * 256 + p;
    if (pn == 13) { if (p < 128) return 1816 + 1536 + p; if (p < 152) return 1280 + (p - 128); return -1; }
    if (pn < 16) return 3480 + (pn - 14) * 256 + p;
    return 3992 + (pn - 16) * 256 + p;
}

template <class F>
__device__ __forceinline__ void transpose_cvt(bf16_t* dst, int Nd, int K, F f) {
    const int total = Nd * (K >> 3);
    for (int id = blockIdx.x * NTHR + threadIdx.x; id < total; id += gridDim.x * NTHR) {
        const int n = id % Nd, kc = id / Nd;
        float v[8];
#pragma unroll
        for (int j = 0; j < 8; ++j) v[j] = f(n, kc * 8 + j);
        uint4 w; w.x = pk2(v[0], v[1]); w.y = pk2(v[2], v[3]); w.z = pk2(v[4], v[5]); w.w = pk2(v[6], v[7]);
        *(uint4*)(dst + (size_t)n * K + kc * 8) = w;
    }
}

__device__ __forceinline__ void sincos_small(double r, float& s, float& c) {
    const double r2 = r * r;
    double sa = 1.0, ca = 1.0;
    double ts = 1.0, tc = 1.0; sa = 0.0; ca = 0.0;
#pragma unroll
    for (int k = 0; k < 16; ++k) {
        sa += ts; ca += tc;
        ts = -ts * r2 / (double)((2 * k + 2) * (2 * k + 3));
        tc = -tc * r2 / (double)((2 * k + 1) * (2 * k + 2));
    }
    s = (float)(sa * r); c = (float)ca;
}

__device__ __forceinline__ void ph_prep(const P& p) {
    const int tid = threadIdx.x, lane = tid & 63, wid = tid >> 6;
    const int gw = blockIdx.x * 8 + wid, nw = gridDim.x * 8;
    const int gt = blockIdx.x * NTHR + tid, nt = gridDim.x * NTHR;
    for (int row = gw; row < MR; row += nw) {
        const float4* src = (const float4*)(row < NP ? p.x_prompt + (size_t)row * DM : p.x_sample + (size_t)(row - NP) * DM);
        float4 v[4]; float ss = 0.f;
#pragma unroll
        for (int i = 0; i < 4; ++i) { v[i] = src[lane + 64 * i]; ss += v[i].x * v[i].x + v[i].y * v[i].y + v[i].z * v[i].z + v[i].w * v[i].w; }
        ss = wave_sum(ss);
        const float rstd = rsqrtf(ss * (1.0f / DM) + 1e-6f);
#pragma unroll
        for (int i = 0; i < 4; ++i) {
            const float4 g = ((const float4*)p.norm_g)[lane + 64 * i];
            uint2 w; w.x = pk2(v[i].x * rstd * g.x, v[i].y * rstd * g.y); w.y = pk2(v[i].z * rstd * g.z, v[i].w * rstd * g.w);
            *(uint2*)(p.hb() + (size_t)row * DM + 4 * (lane + 64 * i)) = w;
        }
    }
    { const float* w = p.w_in; transpose_cvt(p.WinT(), NPAD, DM, [=](int n, int k) { const int c = win_src_col(n); return c < 0 ? 0.f : w[(size_t)k * CIN + c]; }); }
    { const float* w = p.w_pa; transpose_cvt(p.WpaT(), DM, 512, [=](int n, int k) { return w[(size_t)k * DM + n]; }); }
    { const float* w = p.w_pb; transpose_cvt(p.WpbT(), DM, 512, [=](int n, int k) { return w[(size_t)k * DM + n]; }); }
    { const float* w = p.w_out; transpose_cvt(p.WoutT(), DM, DM, [=](int n, int k) { return w[(size_t)k * DM + n]; }); }
    { const float* w = p.w_gate; transpose_cvt(p.WgateT(), DM, DM, [=](int n, int k) { return w[(size_t)k * DM + n]; }); }
    { const float* w = p.w_proj; transpose_cvt(p.WprojT(), DM, 256, [=](int n, int k) { return w[(size_t)k * DM + n]; }); }
    { const float* w = p.cmp_w1; transpose_cvt(p.W1T(), 512, 1024, [=](int n, int k) { const int kvi = n >> 8, nn = n & 255; return w[(size_t)kvi * 262144 + (size_t)((nn >> 7) * 1024 + k) * 128 + (nn & 127)]; }); }
    { const float* w = p.cmp_w2; transpose_cvt(p.W2T(), 128, 128, [=](int n, int k) { return w[(size_t)(n >> 6) * 8192 + (size_t)k * 64 + (n & 63)]; }); }
    { const float* w = p.w_up; transpose_cvt(p.WupT(), 512, 64, [=](int n, int k) { return w[(size_t)k * 512 + n]; }); }
    { const float* w = p.a_up; transpose_cvt(p.AupT(), 512, 64, [=](int n, int k) { return w[(size_t)k * 512 + n]; }); }
    for (int id = gt; id < MR * 64; id += nt) {
        const int row = id >> 6, c4 = id & 63;
        const float4 v = ((const float4*)(row < NP ? p.p_prompt + (size_t)row * 256 : p.p_sample + (size_t)(row - NP) * 256))[c4];
        uint2 w; w.x = pk2(v.x, v.y); w.y = pk2(v.z, v.w);
        *(uint2*)(p.pb() + (size_t)row * 256 + c4 * 4) = w;
    }
    for (int id = gt; id < 4104 * 32; id += nt) {
        const int pi = id >> 5, i = id & 31;
        const int pos = pi < 4096 ? pi : PAST + pi - 4096;
        const float inv = (float)exp(-(double)i * (9.210340371976184 / 32.0));
        const float ang = (float)pos * inv;
        const double x = (double)ang;
        const double k = rint(x * 0.15915494309189535);
        const double r = x - k * 6.283185307179586;
        float s, c; sincos_small(r, s, c);
        p.tabc()[id] = c; p.tabs()[id] = s;
    }
    for (int o = gw; o < 256; o += nw) {
        const int kvi = o >> 7, f = o & 127;
        float acc = 0.f;
        for (int jd = lane; jd < 2048; jd += 64) acc += p.cmp_pe[kvi * 2048 + jd] * p.cmp_w1[(size_t)kvi * 262144 + (size_t)jd * 128 + f];
        acc = wave_sum(acc);
        if (lane == 0) p.pt()[o] = acc + p.cmp_b1[o];
    }
    for (int id = gt; id < DB * 504 * 64; id += nt) {
        const int c4 = id & 63, j = (id >> 6) % 504, b = (id >> 6) / 504;
        ((float4*)(p.out + O_WIN_S))[((size_t)b * 512 + j) * 64 + c4] = ((const float4*)p.cache_win)[((size_t)b * 512 + j + 8) * 64 + c4];
    }
}
#define XB_TMO      128
#define XB_XCNT(j)  (256  + 64 * (j))
#define XB_XSUB(j)  (1280 + 64 * (j))
#define XB_XGEN(j)  (2304 + 64 * (j))
#define XB_TOP      3328
#define XB_TOPGEN   3392
#define XCD_BAR_WORDS 3456
#define XB_SPIN_CAP (1u << 18)

__device__ __forceinline__ unsigned xb_ld(unsigned* p)              { return __hip_atomic_load(p, __ATOMIC_RELAXED, __HIP_MEMORY_SCOPE_AGENT); }
__device__ __forceinline__ unsigned xb_add(unsigned* p, unsigned v) { return __hip_atomic_fetch_add(p, v, __ATOMIC_RELAXED, __HIP_MEMORY_SCOPE_AGENT); }
__device__ __forceinline__ unsigned xb_xcc_id() { return (unsigned)__builtin_amdgcn_s_getreg((3 << 11) | 20) & 0xFu; }
#define XB_SPIN(cond, bar) do { unsigned _sp = 0; while (cond) { __builtin_amdgcn_s_sleep(1); \
    if ((++_sp & 255u) == 0u) { if (xb_ld(&(bar)[XB_TMO])) break; if (_sp > XB_SPIN_CAP) { atomicAdd(&(bar)[XB_TMO], 1u); break; } } } } while (0)

struct XcdBarrier {
    unsigned* bar; unsigned x;
    volatile LAS unsigned* st;
};

__device__ __forceinline__ XcdBarrier xcd_barrier_post(unsigned* bar, volatile LAS unsigned* st) {
    XcdBarrier b; b.bar = bar; b.x = xb_xcc_id(); b.st = st;
    if (threadIdx.x == 0) (void)xb_add(&bar[XB_XCNT(b.x)], 1u);
    return b;
}
__device__ __forceinline__ void xcd_barrier_complete(unsigned* bar, unsigned x, unsigned& nloc, unsigned& nx) {
    const unsigned G = gridDim.x * gridDim.y * gridDim.z;
    unsigned sum, cnt, mine, sp = 0u;
    for (;;) {
        sum = 0u; cnt = 0u; mine = 0u;
#pragma unroll
        for (unsigned j = 0; j < 16; ++j) { const unsigned c = xb_ld(&bar[XB_XCNT(j)]); sum += c; cnt += (c > 0u) ? 1u : 0u; mine = (j == x) ? c : mine; }
        if (sum == G) break;
        __builtin_amdgcn_s_sleep(1);
        if ((++sp & 255u) == 0u) { if (xb_ld(&bar[XB_TMO])) break; if (sp > XB_SPIN_CAP) { atomicAdd(&bar[XB_TMO], 1u); break; } }
    }
    nloc = mine > 0u ? mine : 1u; nx = cnt > 0u ? cnt : 1u;
}

__device__ __forceinline__ void xcd_barrier(const XcdBarrier& b) {
    asm volatile("s_waitcnt vmcnt(0)" ::: "memory");
    __syncthreads();
    if (threadIdx.x == 0) {
        unsigned* bar = b.bar;
        __builtin_amdgcn_s_waitcnt(0);
        unsigned nloc = b.st[0], nx = b.st[1];
        if (nloc == 0u) { xcd_barrier_complete(bar, b.x, nloc, nx); b.st[0] = nloc; b.st[1] = nx; }
        const unsigned old = xb_add(&bar[XB_XSUB(b.x)], 1u);
        const unsigned gen = old / nloc;
        if (old + 1u == (gen + 1u) * nloc) {
            __builtin_amdgcn_fence(__ATOMIC_RELEASE, "agent");
            asm volatile("s_waitcnt vmcnt(0)" ::: "memory");
            const unsigned og = xb_add(&bar[XB_TOP], 1u);
            const unsigned tg = og / nx;
            if (og + 1u == (tg + 1u) * nx) xb_add(&bar[XB_TOPGEN], 1u);
            else XB_SPIN(xb_ld(&bar[XB_TOPGEN]) == tg, bar);
            __builtin_amdgcn_fence(__ATOMIC_ACQUIRE, "agent");
            xb_add(&bar[XB_XGEN(b.x)], 1u);
            asm volatile("s_waitcnt vmcnt(0)" ::: "memory");
        } else {
            XB_SPIN(xb_ld(&bar[XB_XGEN(b.x)]) == gen, bar);
            __builtin_amdgcn_fence(__ATOMIC_ACQUIRE, "agent");
            asm volatile("s_waitcnt vmcnt(0)" ::: "memory");
        }
    }
    __syncthreads();
}

using pg8::Unit;
typedef unsigned u32x2 __attribute__((ext_vector_type(2)));
typedef unsigned u32x4_t __attribute__((ext_vector_type(4)));
__device__ __forceinline__ f32x16 mfma32(bf16x8 a, bf16x8 b, f32x16 c) { return __builtin_amdgcn_mfma_f32_32x32x16_bf16(a, b, c, 0, 0, 0); }
__device__ __forceinline__ bf16x8 pack8(float a0, float a1, float a2, float a3, float a4, float a5, float a6, float a7) {
    union { uint4 u; bf16x8 v; } x; x.u.x = pk2(a0, a1); x.u.y = pk2(a2, a3); x.u.z = pk2(a4, a5); x.u.w = pk2(a6, a7); return x.v;
}
__device__ __forceinline__ f32x16 zero16() { f32x16 z; for (int i = 0; i < 16; ++i) z[i] = 0.f; return z; }


__device__ __forceinline__ void st_bf4(bf16_t* dst, f32x4 v) { uint2 w; w.x = pk2(v[0], v[1]); w.y = pk2(v[2], v[3]); *(uint2*)dst = w; }

struct EpiIn {
    static constexpr bool PERM = false, AFTER_DRAIN = false;
    P p;
    __device__ __forceinline__ void operator()(const f32x4 (&acc)[2][2][4][2], const Unit& u, int wr, int wc, int fr, int fq) const {
        const int pn = u.pn;
#pragma unroll
        for (int ai = 0; ai < 2; ++ai)
#pragma unroll
            for (int m = 0; m < 4; ++m) {
                const int row = u.pm * 256 + ai * 128 + wr * 64 + m * 16 + fr;
                if (pn < 5) {
                    const int pi = row < NP ? (row & (SEQ - 1)) : 4096 + ((row - NP) & 7);
                    const int d0 = 16 * (wc & 1) + 4 * fq;
                    const f32x4 cs = *(const f32x4*)(p.tabc() + pi * 32 + d0), sn = *(const f32x4*)(p.tabs() + pi * 32 + d0);
#pragma unroll
                    for (int bj = 0; bj < 2; ++bj) {
                        const f32x4 x1 = acc[ai][bj][m][0], x2 = acc[ai][bj][m][1];
                        if (pn < 2) {
                            const int head = pn * 4 + bj * 2 + (wc >> 1);
                            const f32x4 o1 = (x1 * cs - x2 * sn) * 0.125f, o2 = (x2 * cs + x1 * sn) * 0.125f;
                            bf16_t* q = p.qb() + (size_t)row * 512 + head * 64 + d0;
                            st_bf4(q, o1); st_bf4(q + 32, o2);
                        } else {
                            const int br = pn - 2, g = wc >> 1;
                            f32x4 o1, o2;
                            if (bj == 0) { o1 = x1 * cs - x2 * sn; o2 = x2 * cs + x1 * sn; } else { o1 = x1; o2 = x2; }
                            float* dst = nullptr;
                            if (row < NP) {
                                if (br == 0) dst = p.out + O_CMP_P + (size_t)row * 256;
                                else if (br == 1) dst = p.out + O_SEL_P + (size_t)row * 256;
                                else { const int s = row & (SEQ - 1); if (s >= SEQ - 512) dst = p.out + O_WIN_P + ((size_t)(row >> 12) * 512 + (s - (SEQ - 512))) * 256; }
                            } else {
                                const int rs = row - NP;
                                if (br == 0) dst = p.out + O_CMP_S + (size_t)rs * 256;
                                else if (br == 1) dst = p.out + O_SEL_S + (size_t)rs * 256;
                                else dst = p.out + O_WIN_S + ((size_t)(rs >> 3) * 512 + 504 + (rs & 7)) * 256;
                            }
                            if (dst) { dst += bj * 128 + g * 64 + d0; *(f32x4*)dst = o1; *(f32x4*)(dst + 32) = o2; }
                            if (row < NP) {
                                const int b = row >> 12, s = row & (SEQ - 1);
                                if (bj == 0) {
                                    bf16_t* k = p.kb() + ((size_t)((br * NB + b) * 2 + g) * SEQ + s) * 64 + d0;
                                    st_bf4(k, o1); st_bf4(k + 32, o2);
                                } else if (br == 0) {
                                    bf16_t* v = p.vcr() + ((size_t)(b * 2 + g) * SEQ + s) * 64 + d0;
                                    st_bf4(v, o1); st_bf4(v + 32, o2);
                                } else {
                                    bf16_t* v = p.vT() + ((size_t)(((br - 1) * NB + b) * 2 + g) * 64 + d0) * SEQ + s;
#pragma unroll
                                    for (int e = 0; e < 4; ++e) { v[(size_t)e * SEQ] = f2bf(o1[e]); v[(size_t)(32 + e) * SEQ] = f2bf(o2[e]); }
                                }
                            }
                        }
                    }
                } else {
#pragma unroll
                    for (int bj = 0; bj < 2; ++bj)
#pragma unroll
                        for (int n = 0; n < 2; ++n) {
                            const int c = bj * 128 + wc * 32 + n * 16 + fq * 4;
                            const f32x4 v = acc[ai][bj][m][n];
                            if (pn < 7) {
                                f32x4 o; for (int e = 0; e < 4; ++e) o[e] = siluf_(v[e]);
                                st_bf4(p.ag() + (size_t)row * 512 + (pn - 5) * 256 + c, o);
                            } else if (pn < 13) {
                                *(f32x4*)(p.rz() + (size_t)row * CR + (pn - 7) * 256 + c) = v;
                            } else if (pn == 13) {
                                if (c < 128) *(f32x4*)(p.rz() + (size_t)row * CR + 1536 + c) = v;
                                else if (c < 152) { f32x4 o; for (int e = 0; e < 4; ++e) o[e] = sigmoidf_(v[e]); *(f32x4*)(p.gates() + (size_t)row * 32 + (c - 128)) = o; }
                            } else if (pn < 16) {
                                f32x4 o; for (int e = 0; e < 4; ++e) o[e] = siluf_(v[e]);
                                st_bf4(p.rg() + (size_t)row * 512 + (pn - 14) * 256 + c, o);
                            } else {
                                f32x4 o; for (int e = 0; e < 4; ++e) o[e] = sigmoidf_(v[e]);
                                st_bf4(p.mg() + (size_t)row * 2048 + (pn - 16) * 256 + c, o);
                            }
                        }
                }
            }
    }
};

struct EpiPlain {
    static constexpr bool PERM = false, AFTER_DRAIN = false;
    float* C; int ldc; int pad_;
    __device__ __forceinline__ void quad(int row, int c, f32x4 v) const { *(f32x4*)(C + (size_t)row * ldc + c) = v; }
    __device__ __forceinline__ void operator()(const f32x4 (&acc)[2][2][4][2], const Unit& u, int wr, int wc, int fr, int fq) const {
#pragma unroll
        for (int ai = 0; ai < 2; ++ai)
#pragma unroll
            for (int m = 0; m < 4; ++m) {
                float* rowp = C + (size_t)(u.pm * 256 + ai * 128 + wr * 64 + m * 16 + fr) * ldc + u.pn * 256 + wc * 32 + 4 * fq;
#pragma unroll
                for (int bj = 0; bj < 2; ++bj)
#pragma unroll
                    for (int n = 0; n < 2; ++n) *(f32x4*)(rowp + bj * 128 + n * 16) = acc[ai][bj][m][n];
            }
    }
};

struct EpiYa {
    static constexpr bool PERM = false, AFTER_DRAIN = false;
    P p;
    __device__ __forceinline__ void quad(int row, int c, f32x4 v) const {
        const uint2 gw = *(const uint2*)(p.mg() + (size_t)row * 2048 + c);
        f32x4 g; g[0] = __uint_as_float(gw.x << 16); g[1] = __uint_as_float(gw.x & 0xffff0000u); g[2] = __uint_as_float(gw.y << 16); g[3] = __uint_as_float(gw.y & 0xffff0000u);
        *(f32x4*)(p.tmp() + (size_t)row * DM + c) = g * v;
    }
    __device__ __forceinline__ void operator()(const f32x4 (&acc)[2][2][4][2], const Unit& u, int wr, int wc, int fr, int fq) const {
#pragma unroll
        for (int ai = 0; ai < 2; ++ai)
#pragma unroll
            for (int m = 0; m < 4; ++m) {
                const int row = u.pm * 256 + ai * 128 + wr * 64 + m * 16 + fr;
#pragma unroll
                for (int bj = 0; bj < 2; ++bj)
#pragma unroll
                    for (int n = 0; n < 2; ++n) {
                        const int c = u.pn * 256 + bj * 128 + wc * 32 + n * 16 + fq * 4;
                        const uint2 gw = *(const uint2*)(p.mg() + (size_t)row * 2048 + c);
                        f32x4 g; g[0] = __uint_as_float(gw.x << 16); g[1] = __uint_as_float(gw.x & 0xffff0000u); g[2] = __uint_as_float(gw.y << 16); g[3] = __uint_as_float(gw.y & 0xffff0000u);
                        *(f32x4*)(p.tmp() + (size_t)row * DM + c) = g * acc[ai][bj][m][n];
                    }
            }
    }
};
struct EpiYb {
    static constexpr bool PERM = false, AFTER_DRAIN = false;
    P p;
    __device__ __forceinline__ void quad(int row, int c, f32x4 v) const {
        const uint2 gw = *(const uint2*)(p.mg() + (size_t)row * 2048 + 1024 + c);
        f32x4 g; g[0] = __uint_as_float(gw.x << 16); g[1] = __uint_as_float(gw.x & 0xffff0000u); g[2] = __uint_as_float(gw.y << 16); g[3] = __uint_as_float(gw.y & 0xffff0000u);
        st_bf4(p.mb() + (size_t)row * DM + c, *(const f32x4*)(p.tmp() + (size_t)row * DM + c) + g * v);
    }
    __device__ __forceinline__ void operator()(const f32x4 (&acc)[2][2][4][2], const Unit& u, int wr, int wc, int fr, int fq) const {
#pragma unroll
        for (int ai = 0; ai < 2; ++ai)
#pragma unroll
            for (int m = 0; m < 4; ++m) {
                const int row = u.pm * 256 + ai * 128 + wr * 64 + m * 16 + fr;
#pragma unroll
                for (int bj = 0; bj < 2; ++bj)
#pragma unroll
                    for (int n = 0; n < 2; ++n) {
                        const int c = u.pn * 256 + bj * 128 + wc * 32 + n * 16 + fq * 4;
                        const uint2 gw = *(const uint2*)(p.mg() + (size_t)row * 2048 + 1024 + c);
                        f32x4 g; g[0] = __uint_as_float(gw.x << 16); g[1] = __uint_as_float(gw.x & 0xffff0000u); g[2] = __uint_as_float(gw.y << 16); g[3] = __uint_as_float(gw.y & 0xffff0000u);
                        const f32x4 t = *(const f32x4*)(p.tmp() + (size_t)row * DM + c);
                        st_bf4(p.mb() + (size_t)row * DM + c, t + g * acc[ai][bj][m][n]);
                    }
            }
    }
};
struct EpiOut {
    static constexpr bool PERM = false, AFTER_DRAIN = false;
    P p;
    __device__ __forceinline__ void quad(int row, int c, f32x4 a) const {
        const float* xr = p.x_sample + (size_t)(row - NP) * DM;
        const f32x4 v = *(const f32x4*)(xr + c) + a;
        *(f32x4*)(p.x1() + (size_t)row * DM + c) = v;
        st_bf4(p.xg() + (size_t)row * DM + c, v * *(const f32x4*)(p.ple_g + c));
        atomicAdd(p.ss_s() + (row - NP), v[0] * v[0] + v[1] * v[1] + v[2] * v[2] + v[3] * v[3]);
    }
    __device__ __forceinline__ void operator()(const f32x4 (&acc)[2][2][4][2], const Unit& u, int wr, int wc, int fr, int fq) const {
#pragma unroll
        for (int ai = 0; ai < 2; ++ai)
#pragma unroll
            for (int m = 0; m < 4; ++m) {
                const int row = u.pm * 256 + ai * 128 + wr * 64 + m * 16 + fr;
                const float* xr = row < NP ? p.x_prompt + (size_t)row * DM : p.x_sample + (size_t)(row - NP) * DM;
                float ss = 0.f;
#pragma unroll
                for (int bj = 0; bj < 2; ++bj)
#pragma unroll
                    for (int n = 0; n < 2; ++n) {
                        const int c = u.pn * 256 + bj * 128 + wc * 32 + n * 16 + fq * 4;
                        const f32x4 v = *(const f32x4*)(xr + c) + acc[ai][bj][m][n];
                        *(f32x4*)(p.x1() + (size_t)row * DM + c) = v;
                        ss += v[0] * v[0] + v[1] * v[1] + v[2] * v[2] + v[3] * v[3];
                        st_bf4(p.xg() + (size_t)row * DM + c, v * *(const f32x4*)(p.ple_g + c));
                    }
                ss += __shfl_xor(ss, 16); ss += __shfl_xor(ss, 32);
                if (fq == 0) p.ss1()[(size_t)row * 16 + u.pn * 4 + wc] = ss;
            }
    }
};
struct EpiGate {
    static constexpr bool PERM = false, AFTER_DRAIN = false;
    P p;
    __device__ __forceinline__ void quad(int row, int c, f32x4 acc) const {
        const float rstd = rsqrtf(p.ss_s()[row - NP] * (1.0f / DM) + 1e-6f);
        const f32x4 a = acc * rstd;
        f32x4 g; for (int e = 0; e < 4; ++e) g[e] = sigmoidf_(a[e]);
        float* ppp = p.pp() + (size_t)row * DM + c;
        *(f32x4*)ppp = *(const f32x4*)(p.x1() + (size_t)row * DM + c) + g * *(const f32x4*)ppp;
    }
    __device__ __forceinline__ void operator()(const f32x4 (&acc)[2][2][4][2], const Unit& u, int wr, int wc, int fr, int fq) const {
#pragma unroll
        for (int ai = 0; ai < 2; ++ai)
#pragma unroll
            for (int m = 0; m < 4; ++m) {
                const int row = u.pm * 256 + ai * 128 + wr * 64 + m * 16 + fr;
                float ss = 0.f;
#pragma unroll
                for (int i = 0; i < 4; ++i) { const f32x4 t = *(const f32x4*)(p.ss1() + (size_t)row * 16 + i * 4); ss += (t[0] + t[1]) + (t[2] + t[3]); }
                const float rstd = rsqrtf(ss * (1.0f / DM) + 1e-6f);
#pragma unroll
                for (int bj = 0; bj < 2; ++bj)
#pragma unroll
                    for (int n = 0; n < 2; ++n) {
                        const int c = u.pn * 256 + bj * 128 + wc * 32 + n * 16 + fq * 4;
                        const f32x4 a = acc[ai][bj][m][n] * rstd;
                        f32x4 g; for (int e = 0; e < 4; ++e) g[e] = sigmoidf_(a[e]);
                        float* ppp = p.pp() + (size_t)row * DM + c;
                        *(f32x4*)ppp = *(const f32x4*)(p.x1() + (size_t)row * DM + c) + g * *(const f32x4*)ppp;
                    }
            }
    }
};

__device__ __forceinline__ void ph_final(const P& p) {
    const int tid = threadIdx.x, lane = tid & 63, wid = tid >> 6;
    for (int row = blockIdx.x * 8 + wid; row < MR; row += gridDim.x * 8) {
        const float4* src = (const float4*)(p.pp() + (size_t)row * DM);
        float4 v[4]; float ss = 0.f;
#pragma unroll
        for (int i = 0; i < 4; ++i) { v[i] = src[lane + 64 * i]; ss += v[i].x * v[i].x + v[i].y * v[i].y + v[i].z * v[i].z + v[i].w * v[i].w; }
        ss = wave_sum(ss);
        const float rstd = rsqrtf(ss * (1.0f / DM) + 1e-6f);
        float4* dst = (float4*)(p.out + (row < NP ? O_Y_P + (size_t)row * DM : O_Y_S + (size_t)(row - NP) * DM));
#if defined(DBG_CMPALL)
        float dbgs = 1.0f; if (row >= NP) dbgs = 1.0f + (float)p.bar()[3840] * (1.0f / DBG_DIV);
#define DBGS * dbgs
#else
#define DBGS
#endif
#pragma unroll
        for (int i = 0; i < 4; ++i) {
            const float4 g = ((const float4*)p.final_g)[lane + 64 * i];
            float4 o; o.x = v[i].x * rstd * g.x DBGS; o.y = v[i].y * rstd * g.y DBGS; o.z = v[i].z * rstd * g.z DBGS; o.w = v[i].w * rstd * g.w DBGS;
            dst[lane + 64 * i] = o;
        }
    }
}

typedef float f32x4v __attribute__((ext_vector_type(4)));
template <class Epi> __device__ __forceinline__ void small_gemm(const bf16_t* A, const bf16_t* Bt, int K, const Epi& E) {
    const int tid = threadIdx.x, lane = tid & 63, wid = tid >> 6, r16 = lane & 15, q4 = lane >> 4;
    for (int tile = blockIdx.x * 8 + wid; tile < 16 * 64; tile += gridDim.x * 8) {
        const int rt = tile & 15, ct = tile >> 4;
        const bf16_t* ap = A + (size_t)(NP + rt * 16 + r16) * K + 8 * q4;
        const bf16_t* bp = Bt + (size_t)(ct * 16 + r16) * K + 8 * q4;
        f32x4 acc = {0.f, 0.f, 0.f, 0.f};
#pragma unroll 1
        for (int k0 = 0; k0 < K; k0 += 256) {
            bf16x8 af[8], bf[8];
#pragma unroll
            for (int i = 0; i < 8; ++i) { af[i] = *(const bf16x8*)(ap + k0 + 32 * i); bf[i] = *(const bf16x8*)(bp + k0 + 32 * i); }
#pragma unroll
            for (int i = 0; i < 8; ++i) acc = __builtin_amdgcn_mfma_f32_16x16x32_bf16(bf[i], af[i], acc, 0, 0, 0);
        }
        E.quad(NP + rt * 16 + r16, ct * 16 + 4 * q4, acc);
    }
}

__device__ __forceinline__ void ph_compress2(const P& p, const float* LH, int nbg, int nrows, int nblk, bf16_t* kc, bf16_t* vcT) {
    const int tid = threadIdx.x, lane = tid & 63, wid = tid >> 6, col = lane & 31, hb = lane >> 5;
    const int ntile = nrows >> 5, total = 2 * nbg * ntile;
    for (int it = blockIdx.x * 8 + wid; it < total; it += gridDim.x * 8) {
        const int tile = it % ntile, bg = (it / ntile) % nbg, kvi = it / (ntile * nbg);
        const int i = tile * 32 + col;
        const bool live = i < nblk;
        const float* l0 = LH + ((size_t)kvi * nbg * nrows + (size_t)bg * nrows + (live ? i : 0)) * 256;
        const float* ptp = p.pt() + kvi * 128;
        const bf16_t* w2t = p.W2T() + (size_t)kvi * 64 * 128;
        f32x16 acc[2]; acc[0] = zero16(); acc[1] = zero16();
#pragma unroll
        for (int ks = 0; ks < 8; ++ks) {
            const int f = 16 * ks + 8 * hb;
            float hv[8];
#pragma unroll
            for (int q = 0; q < 2; ++q) {
                const f32x4 lo = *(const f32x4*)(l0 + f + 4 * q), hi = *(const f32x4*)(l0 + 256 + 128 + f + 4 * q), pv = *(const f32x4*)(ptp + f + 4 * q);
#pragma unroll
                for (int e = 0; e < 4; ++e) hv[4 * q + e] = siluf_(lo[e] + hi[e] + pv[e]);
            }
            const bf16x8 hf = pack8(hv[0], hv[1], hv[2], hv[3], hv[4], hv[5], hv[6], hv[7]);
#pragma unroll
            for (int dt = 0; dt < 2; ++dt) {
                const bf16x8 wf = *(const bf16x8*)(w2t + (size_t)(32 * dt + col) * 128 + f);
                acc[dt] = (kvi == 0) ? mfma32(wf, hf, acc[dt]) : mfma32(hf, wf, acc[dt]);
            }
        }
        if (kvi == 0) {
            bf16_t* dst = kc + ((size_t)bg * nrows + i) * 64;
#pragma unroll
            for (int dt = 0; dt < 2; ++dt)
#pragma unroll
                for (int i4 = 0; i4 < 4; ++i4) {
                    const int d = 32 * dt + 8 * i4 + 4 * hb;
                    const f32x4 b2 = *(const f32x4*)(p.cmp_b2 + d);
                    f32x4 v; for (int e = 0; e < 4; ++e) v[e] = live ? acc[dt][4 * i4 + e] + b2[e] : 0.f;
                    st_bf4(dst + d, v);
                }
        } else {
#pragma unroll
            for (int dt = 0; dt < 2; ++dt) {
                const int d = 32 * dt + col;
                const float b2 = p.cmp_b2[64 + d];
                bf16_t* dst = vcT + ((size_t)bg * 64 + d) * nrows + tile * 32;
#pragma unroll
                for (int i4 = 0; i4 < 4; ++i4) {
                    const int r = 8 * i4 + 4 * hb;
                    f32x4 v; for (int e = 0; e < 4; ++e) v[e] = (tile * 32 + r + e) < nblk ? acc[dt][4 * i4 + e] + b2 : 0.f;
                    st_bf4(dst + r, v);
                }
            }
        }
    }
}

__device__ __forceinline__ void ph_cvt_cache(const P& p) {
    const size_t total = (size_t)2 * DB * 2 * PAST * 8;
    for (size_t id = (size_t)blockIdx.x * NTHR + threadIdx.x; id < total; id += (size_t)gridDim.x * NTHR) {
        const int d8 = (int)(id & 7), tok = (int)((id >> 3) & (PAST - 1)), g = (int)((id >> 17) & 1), b = (int)((id >> 18) & 31), kvi = (int)(id >> 23);
        const int page = p.page_table[b * 128 + (tok >> 7)];
        const float4* src = (const float4*)(p.cache_cmp + ((size_t)page * 128 + (tok & 127)) * 256 + kvi * 128 + g * 64 + d8 * 8);
        const float4 a = src[0], c = src[1];
        uint4 w; w.x = pk2(a.x, a.y); w.y = pk2(a.z, a.w); w.z = pk2(c.x, c.y); w.w = pk2(c.z, c.w);
        *(uint4*)(p.cs() + id * 8) = w;
    }
}

#if defined(OLD_RWKV_PREP)
__device__ __forceinline__ void ph_rwkv_prep(const P& p) {
    const int tid = threadIdx.x, lane = tid & 63, wid = tid >> 6;
    for (int it = blockIdx.x * 8 + wid; it < MR * 8; it += gridDim.x * 8) {
        const int row = it >> 3, h = it & 7, c = h * 64 + lane;
        const float* z = p.rz() + (size_t)row * CR;
        const float* pv;
        bool zero_prev = false;
        if (row < NP) { if ((row & (SEQ - 1)) == 0) { zero_prev = true; pv = z; } else pv = z - CR; }
        else { const int rs = row - NP; if ((rs & 7) == 0) pv = p.state_shift + (size_t)(rs >> 3) * CR; else pv = z - CR; }
        auto lerp = [&](int col) { const float zz = z[col]; const float pr = zero_prev ? 0.f : pv[col]; return zz + (pr - zz) * p.mu[col]; };
        const float zr = lerp(c), zk = lerp(512 + c), zv = lerp(1024 + c), zwd = lerp(1536 + lane), zad = lerp(1600 + lane);
        const float th = tanhf(zwd);
        float accw = p.w0[c], acca = p.a0[c];
#pragma unroll 8
        for (int j = 0; j < 64; ++j) {
            const float tj = __shfl(th, j), aj = __shfl(zad, j);
            accw += tj * p.w_up[j * 512 + c]; acca += aj * p.a_up[j * 512 + c];
        }
        const float nx = -accw;
        const float sp = fmaxf(nx, 0.f) + log1pf(__expf(-fabsf(nx)));
        const float w = -sp - 0.5f;
        const float dec = __expf(-__expf(w));
        const float a = sigmoidf_(acca);
        const float kkr = zk * p.k_k[c];
        const float nrm = sqrtf(wave_sum(kkr * kkr));
        const float kk = kkr / fmaxf(nrm, 1e-12f);
        const float km = zk * (1.0f + (a - 1.0f) * p.k_a[c]);
        const float bon = wave_sum(zr * km * p.r_k[c]);
        float* o = p.rw6() + (size_t)it * 384 + lane;
        o[0] = zr; o[64] = dec; o[128] = km; o[192] = zv; o[256] = kk; o[320] = kk * a;
        if (lane == 0) p.bonus()[it] = bon;
        if (h == 0) {
            float* so = nullptr;
            if (row < NP) { if ((row & (SEQ - 1)) == SEQ - 1) so = p.out + O_SH_P + (size_t)(row >> 12) * CR; }
            else { const int rs = row - NP; if ((rs & 7) == 7) so = p.out + O_SH_S + (size_t)(rs >> 3) * CR; }
            if (so) for (int i = lane; i < CR; i += 64) so[i] = z[i];
        }
    }
}

#else
__device__ __forceinline__ float dpp_row_sum16(float v) {
    v += __builtin_bit_cast(float, __builtin_amdgcn_mov_dpp(__builtin_bit_cast(int, v), 0xB1, 0xF, 0xF, true));
    v += __builtin_bit_cast(float, __builtin_amdgcn_mov_dpp(__builtin_bit_cast(int, v), 0x4E, 0xF, 0xF, true));
    v += __builtin_bit_cast(float, __builtin_amdgcn_mov_dpp(__builtin_bit_cast(int, v), 0x141, 0xF, 0xF, true));
    v += __builtin_bit_cast(float, __builtin_amdgcn_mov_dpp(__builtin_bit_cast(int, v), 0x140, 0xF, 0xF, true));
    return v;
}
__device__ __forceinline__ float half_sum32(float v) { v = dpp_row_sum16(v); return v + __shfl_xor(v, 16); }
__device__ __forceinline__ const float* rwkv_prev_row(const P& p, int row) {
    if (row < NP) return (row & (SEQ - 1)) == 0 ? nullptr : p.rz() + (size_t)(row - 1) * CR;
    const int rs = row - NP;
    return (rs & 7) == 0 ? p.state_shift + (size_t)(rs >> 3) * CR : p.rz() + (size_t)(row - 1) * CR;
}
__device__ __forceinline__ void ph_rwkv_prep(const P& p) {
    const int tid = threadIdx.x, lane = tid & 63, wid = tid >> 6, col = lane & 31, hb = lane >> 5;
    const int gw = blockIdx.x * 8 + wid, nw = gridDim.x * 8;
    for (int it = gw; it < NB + DB; it += nw) {
        const int row = it < NB ? it * SEQ + SEQ - 1 : NP + (it - NB) * 8 + 7;
        float* so = it < NB ? p.out + O_SH_P + (size_t)it * CR : p.out + O_SH_S + (size_t)(it - NB) * CR;
        const float* z = p.rz() + (size_t)row * CR;
        for (int i = lane; i < CR; i += 64) so[i] = z[i];
    }
    for (int it = gw; it < (MR / 32) * 8; it += nw) {
        const int h = it & 7, r0 = (it >> 3) * 32;
        bf16x8 Aw[4], Aa[4];
        {
            const int row = r0 + col;
            const float* z = p.rz() + (size_t)row * CR;
            const float* pv = rwkv_prev_row(p, row);
#pragma unroll
            for (int ks = 0; ks < 4; ++ks) {
                const int j0 = 16 * ks + 8 * hb;
                float tw[8], ta[8];
#pragma unroll
                for (int q = 0; q < 2; ++q) {
                    const f32x4 zw = *(const f32x4*)(z + 1536 + j0 + 4 * q), za = *(const f32x4*)(z + 1600 + j0 + 4 * q);
                    f32x4 pw, pa;
                    if (pv) { pw = *(const f32x4*)(pv + 1536 + j0 + 4 * q); pa = *(const f32x4*)(pv + 1600 + j0 + 4 * q); } else { pw = (f32x4){0.f, 0.f, 0.f, 0.f}; pa = pw; }
                    const f32x4 mw = *(const f32x4*)(p.mu + 1536 + j0 + 4 * q), ma = *(const f32x4*)(p.mu + 1600 + j0 + 4 * q);
#pragma unroll
                    for (int e = 0; e < 4; ++e) { tw[4 * q + e] = tanhf(zw[e] + (pw[e] - zw[e]) * mw[e]); ta[4 * q + e] = za[e] + (pa[e] - za[e]) * ma[e]; }
                }
                Aw[ks] = pack8(tw[0], tw[1], tw[2], tw[3], tw[4], tw[5], tw[6], tw[7]);
                Aa[ks] = pack8(ta[0], ta[1], ta[2], ta[3], ta[4], ta[5], ta[6], ta[7]);
            }
        }
        f32x16 accw[2], acca[2];
#pragma unroll
        for (int ct = 0; ct < 2; ++ct) {
            accw[ct] = zero16(); acca[ct] = zero16();
            const size_t wo = (size_t)(h * 64 + 32 * ct + col) * 64 + 8 * hb;
#pragma unroll
            for (int ks = 0; ks < 4; ++ks) {
                accw[ct] = mfma32(Aw[ks], *(const bf16x8*)(p.WupT() + wo + 16 * ks), accw[ct]);
                acca[ct] = mfma32(Aa[ks], *(const bf16x8*)(p.AupT() + wo + 16 * ks), acca[ct]);
            }
        }
        float w0v[2], a0v[2], kkv[2], kav[2], rkv[2], mur[2], muk[2], muv[2];
#pragma unroll
        for (int ct = 0; ct < 2; ++ct) {
            const int c = h * 64 + 32 * ct + col;
            w0v[ct] = p.w0[c]; a0v[ct] = p.a0[c]; kkv[ct] = p.k_k[c]; kav[ct] = p.k_a[c]; rkv[ct] = p.r_k[c];
            mur[ct] = p.mu[c]; muk[ct] = p.mu[512 + c]; muv[ct] = p.mu[1024 + c];
        }
#pragma unroll 2
        for (int i = 0; i < 16; ++i) {
            const int row = r0 + (i & 3) + 8 * (i >> 2) + 4 * hb;
            const float* z = p.rz() + (size_t)row * CR;
            const float* pv = rwkv_prev_row(p, row);
            float zr[2], zk[2], zv[2], dec[2], av[2], kkr[2], km[2];
            float n2 = 0.f, bon = 0.f;
#pragma unroll
            for (int ct = 0; ct < 2; ++ct) {
                const int c = h * 64 + 32 * ct + col;
                const float z0 = z[c], z1 = z[512 + c], z2 = z[1024 + c];
                const float p0 = pv ? pv[c] : 0.f, p1 = pv ? pv[512 + c] : 0.f, p2 = pv ? pv[1024 + c] : 0.f;
                zr[ct] = z0 + (p0 - z0) * mur[ct]; zk[ct] = z1 + (p1 - z1) * muk[ct]; zv[ct] = z2 + (p2 - z2) * muv[ct];
                const float nx = -(w0v[ct] + accw[ct][i]);
                const float sp = fmaxf(nx, 0.f) + log1pf(__expf(-fabsf(nx)));
                dec[ct] = __expf(-__expf(-sp - 0.5f));
                av[ct] = sigmoidf_(a0v[ct] + acca[ct][i]);
                kkr[ct] = zk[ct] * kkv[ct];
                km[ct] = zk[ct] * (1.0f + (av[ct] - 1.0f) * kav[ct]);
                n2 += kkr[ct] * kkr[ct];
                bon += zr[ct] * km[ct] * rkv[ct];
            }
            n2 = half_sum32(n2); bon = half_sum32(bon);
            const float rn = 1.0f / fmaxf(sqrtf(n2), 1e-12f);
            float* o = p.rw6() + ((size_t)row * 8 + h) * 384 + col;
#pragma unroll
            for (int ct = 0; ct < 2; ++ct) {
                const float kk = kkr[ct] * rn;
                float* oc = o + 32 * ct;
                oc[0] = zr[ct]; oc[64] = dec[ct]; oc[128] = km[ct]; oc[192] = zv[ct]; oc[256] = kk; oc[320] = kk * av[ct];
            }
            if (col == 0) p.bonus()[(size_t)row * 8 + h] = bon;
        }
    }
}

#endif
typedef float f32x2 __attribute__((ext_vector_type(2)));
__device__ __forceinline__ float dpp_row_sum(float v) {
    v += __builtin_bit_cast(float, __builtin_amdgcn_mov_dpp(__builtin_bit_cast(int, v), 0xB1, 0xF, 0xF, true));
    v += __builtin_bit_cast(float, __builtin_amdgcn_mov_dpp(__builtin_bit_cast(int, v), 0x4E, 0xF, 0xF, true));
    v += __builtin_bit_cast(float, __builtin_amdgcn_mov_dpp(__builtin_bit_cast(int, v), 0x141, 0xF, 0xF, true));
    v += __builtin_bit_cast(float, __builtin_amdgcn_mov_dpp(__builtin_bit_cast(int, v), 0x140, 0xF, 0xF, true));
    return v;
}
constexpr int SCAN_TC = 32;
template <int NROWS>
__device__ __forceinline__ void scan_item(const P& p, LAS float* lds, int row0, int T, int h, int half, const float* s0, float* sout) {
    const int tid = threadIdx.x, w = tid >> 6, lane = tid & 63, rl = lane >> 4, kq = lane & 15;
    const bool act = w * 4 < NROWS;
    const int vrow = half * NROWS + (act ? w * 4 : 0) + rl;
    f32x4 S;
    if (s0) S = *(const f32x4*)(s0 + vrow * 64 + kq * 4); else { S[0] = 0.f; S[1] = 0.f; S[2] = 0.f; S[3] = 0.f; }
    const float* src = p.rw6() + ((size_t)row0 * 8 + h) * 384;
    const int nchunk = (T + SCAN_TC - 1) / SCAN_TC;
    f32x4 stg[6];
    int so[6], ss[6];
#pragma unroll
    for (int i = 0; i < 6; ++i) { const int idx = i * 512 + tid; ss[i] = idx / 96; so[i] = (idx % 96) * 4; }
    {
        const int ns = T < SCAN_TC ? T : SCAN_TC;
#pragma unroll
        for (int i = 0; i < 6; ++i) if (ss[i] < ns) *(LAS f32x4*)(lds + ss[i] * 384 + so[i]) = *(const f32x4*)(src + (size_t)ss[i] * 3072 + so[i]);
    }
    __syncthreads();
    for (int c = 0; c < nchunk; ++c) {
        const int t0 = c * SCAN_TC;
        const int ns = (T - t0) < SCAN_TC ? (T - t0) : SCAN_TC;
        const bool more = (c + 1) < nchunk;
        const int nns = more ? ((T - t0 - SCAN_TC) < SCAN_TC ? (T - t0 - SCAN_TC) : SCAN_TC) : 0;
        if (more) {
#pragma unroll
            for (int i = 0; i < 6; ++i) if (ss[i] < nns) stg[i] = *(const f32x4*)(src + (size_t)(t0 + SCAN_TC + ss[i]) * 3072 + so[i]);
        }
        LAS const float* buf = lds + (c & 1) * (SCAN_TC * 384);
        float* yo = p.ybuf() + (size_t)(row0 + t0) * 512 + h * 64 + vrow;
        if (act)
#pragma unroll 4
        for (int s = 0; s < ns; ++s) {
            LAS const float* bs = buf + s * 384 + kq * 4;
            const f32x4 r = *(LAS const f32x4*)(bs), d = *(LAS const f32x4*)(bs + 64), km = *(LAS const f32x4*)(bs + 128),
                        kk = *(LAS const f32x4*)(bs + 256), ka = *(LAS const f32x4*)(bs + 320);
            const float vv = buf[s * 384 + 192 + vrow];
            const f32x4 t1 = S * kk;
            float sa = dpp_row_sum((t1[0] + t1[1]) + (t1[2] + t1[3]));
            sa = -sa;
            S = S * d + ka * sa + km * vv;
            const f32x4 t2 = S * r;
            const float y = dpp_row_sum((t2[0] + t2[1]) + (t2[2] + t2[3]));
            if (kq == 0) yo[(size_t)s * 512] = y;
        }
        if (more) {
            LAS float* nb = lds + ((c + 1) & 1) * (SCAN_TC * 384);
#pragma unroll
            for (int i = 0; i < 6; ++i) if (ss[i] < nns) *(LAS f32x4*)(nb + ss[i] * 384 + so[i]) = stg[i];
        }
        __syncthreads();
    }
    if (act) *(f32x4*)(sout + vrow * 64 + kq * 4) = S;
}
constexpr int NSCAN = 128;
__device__ __forceinline__ void ph_rwkv_scan(const P& p, LAS float* lds) {
    if ((int)blockIdx.x < NSCAN) {
        const int item = blockIdx.x >> 2, part = blockIdx.x & 3;
        scan_item<16>(p, lds, (item >> 3) * SEQ, SEQ, item & 7, part, nullptr, p.out + O_WKV_P + (size_t)item * 4096);
    } else {
        const int nb = (int)gridDim.x - NSCAN;
        for (int hi = (int)blockIdx.x - NSCAN; hi < 512; hi += nb) {
            const int item = hi >> 1, half = hi & 1;
            scan_item<32>(p, lds, NP + (item >> 3) * 8, 8, item & 7, half, p.state_wkv + (size_t)item * 4096, p.out + O_WKV_S + (size_t)item * 4096);
        }
    }
}

__device__ __forceinline__ void ph_rwkv_post(const P& p) {
    const int tid = threadIdx.x, lane = tid & 63, wid = tid >> 6;
    for (int it = blockIdx.x * 8 + wid; it < MR * 8; it += gridDim.x * 8) {
        const int row = it >> 3, h = it & 7, c = h * 64 + lane;
        const float y = p.ybuf()[(size_t)row * 512 + c];
        const float mean = wave_sum(y) * (1.0f / 64.0f);
        const float dv = y - mean;
        const float var = wave_sum(dv * dv) * (1.0f / 64.0f);
        float yn = dv * rsqrtf(var + 64e-5f) * p.gn_g[c] + p.gn_b[c];
        yn += p.bonus()[it] * p.rw6()[(size_t)it * 384 + 192 + lane];
        p.ob()[(size_t)row * 512 + c] = f2bf(yn * bf2f(p.rg()[(size_t)row * 512 + c]));
    }
}

__device__ __forceinline__ void ph_cmp_gemm_f32(const P& p, LAS unsigned char* lds) {
    using pg8::lds_byte;
    const int tid = threadIdx.x, wid = __builtin_amdgcn_readfirstlane(tid >> 6), lane = tid & 63, wr = wid >> 2, wc = wid & 3, fr = lane & 15, fq = lane >> 4;
    constexpr int HTB = 16384;
    const int srow = tid >> 1, shalf = tid & 1;
    const int swbase = (srow >> 7) * HTB + lds_byte(srow & 127, shalf * 32);
    const int swx = lds_byte(srow & 127, shalf * 32 + 16) - lds_byte(srow & 127, shalf * 32);
    unsigned voffB[2];
#pragma unroll
    for (int i = 0; i < 2; ++i) { int R, C; pg8::stage_rc(tid * 16 + i * 8192, R, C); voffB[i] = (unsigned)(R * 1024 + C) * 2u; }
    const unsigned ldsw = (unsigned)wid * 1024u;
    const int aoff = lds_byte(wr * 64 + fr, fq * 8), boff = lds_byte(wc * 32 + fr, fq * 8);
    for (int unit = blockIdx.x; unit < 512; unit += gridDim.x) {
        const int kvi = unit >> 8, bg = (unit >> 2) & 63, c0 = (unit & 3) * 256, b = bg >> 1, g = bg & 1;
        const int chunk = c0 + srow;
        const int page = p.page_table[b * 128 + (chunk >> 3)];
        const float* arow = p.cache_cmp + ((size_t)page * 128 + (chunk & 7) * 16) * 256 + kvi * 128 + g * 64 + shalf * 32;
        const char* bbase = (const char*)(p.W1T() + (size_t)kvi * 256 * 1024);
        f32x4 acc[2][2][4][2];
#pragma unroll
        for (int a = 0; a < 2; ++a)
#pragma unroll
            for (int bb = 0; bb < 2; ++bb)
#pragma unroll
                for (int m = 0; m < 4; ++m)
#pragma unroll
                    for (int n = 0; n < 2; ++n) acc[a][bb][m][n] = (f32x4){0.f, 0.f, 0.f, 0.f};
        f32x4 ar[8];
        auto stage_b = [&](int st, int t) {
#pragma unroll
            for (int h = 0; h < 2; ++h)
#pragma unroll
                for (int i = 0; i < 2; ++i)
                    __builtin_amdgcn_global_load_lds((const unsigned*)(bbase + (size_t)h * 128 * 2048 + (size_t)t * 128 + voffB[i]),
                                                     (PG8_LAS unsigned*)(lds + st * 65536 + 32768 + h * HTB + ldsw + i * 8192), 16, 0, 0);
        };
        auto write_a = [&](int st) {
            LAS unsigned char* na = lds + st * 65536;
#pragma unroll
            for (int q = 0; q < 4; ++q) {
                u32x4_t w; w[0] = pk2(ar[2 * q][0], ar[2 * q][1]); w[1] = pk2(ar[2 * q][2], ar[2 * q][3]); w[2] = pk2(ar[2 * q + 1][0], ar[2 * q + 1][1]); w[3] = pk2(ar[2 * q + 1][2], ar[2 * q + 1][3]);
                *(LAS u32x4_t*)(na + swbase + (q >> 1) * swx + (q & 1) * 16) = w;
            }
        };
        __syncthreads();
#pragma unroll
        for (int q = 0; q < 8; ++q) ar[q] = *(const f32x4*)(arow + 4 * q);
        stage_b(0, 0);
        write_a(0);
        __syncthreads();
#pragma unroll 1
        for (int t = 0; t < 16; ++t) {
            const int cur = t & 1;
            if (t + 1 < 16) {
#pragma unroll
                for (int q = 0; q < 8; ++q) ar[q] = *(const f32x4*)(arow + (size_t)(t + 1) * 256 + 4 * q);
                stage_b(cur ^ 1, t + 1);
            }
            LAS const unsigned char* sa = lds + cur * 65536;
            LAS const unsigned char* sb = sa + 32768;
#pragma unroll
            for (int ai = 0; ai < 2; ++ai)
#pragma unroll
                for (int bj = 0; bj < 2; ++bj) {
                    bf16x8 Bt[2][2];
#pragma unroll
                    for (int n = 0; n < 2; ++n)
#pragma unroll
                        for (int k = 0; k < 2; ++k) Bt[n][k] = *(LAS const bf16x8*)(sb + bj * HTB + boff + n * 2048 + k * 1024);
#pragma unroll
                    for (int m = 0; m < 4; ++m) {
                        const bf16x8 a0 = *(LAS const bf16x8*)(sa + ai * HTB + aoff + m * 2048), a1 = *(LAS const bf16x8*)(sa + ai * HTB + aoff + m * 2048 + 1024);
#pragma unroll
                        for (int n = 0; n < 2; ++n) {
                            acc[ai][bj][m][n] = __builtin_amdgcn_mfma_f32_16x16x32_bf16(Bt[n][0], a0, acc[ai][bj][m][n], 0, 0, 0);
                            acc[ai][bj][m][n] = __builtin_amdgcn_mfma_f32_16x16x32_bf16(Bt[n][1], a1, acc[ai][bj][m][n], 0, 0, 0);
                        }
                    }
                    __builtin_amdgcn_sched_barrier(0);
                }
            if (t + 1 < 16) write_a(cur ^ 1);
            __syncthreads();
        }
        EpiPlain e; e.C = p.LHs() + ((size_t)kvi * 65536 + (size_t)bg * 1024 + c0) * 256; e.ldc = 256; e.pad_ = 0;
        pg8::Unit u; u.pm = 0; u.pn = 0;
        e(acc, u, wr, wc, fr, fq);
    }
}
#ifndef NO_KEEP_OLD
#define KEEP_OLD_PATH 1
#endif
#ifndef SMODE
#define SMODE 3
#endif
#ifndef ATTN_MODE
#define ATTN_MODE 3
#endif

struct KSrcBf { const bf16_t* base; __device__ __forceinline__ bf16x8 operator()(int tok0, int ks, int lane) const { return *(const bf16x8*)(base + (size_t)(tok0 + (lane & 31)) * 64 + 16 * ks + 8 * (lane >> 5)); } };
struct VSrcBfT { const bf16_t* base; int ld; __device__ __forceinline__ bf16x8 operator()(int tok0, int dt, int s2, int lane) const {
        const bf16_t* ptr = base + (size_t)(32 * dt + (lane & 31)) * ld + tok0 + 16 * s2 + 4 * (lane >> 5);
        union { uint4 u; bf16x8 v; } x; const uint2 a = *(const uint2*)ptr, b = *(const uint2*)(ptr + 8); x.u.x = a.x; x.u.y = a.y; x.u.z = b.x; x.u.w = b.y; return x.v; } };

template <class KS>
__device__ __forceinline__ f32x16 qk_tile(const bf16x8 (&qf)[4], const KS& ks, int tok0, int lane) {
    f32x16 s = zero16();
#pragma unroll
    for (int k = 0; k < 4; ++k) s = mfma32(ks(tok0, k, lane), qf[k], s);
    return s;
}
template <class OKF>
__device__ __forceinline__ void sm_stats(const f32x16& s, int hb, OKF ok, float& m, float& l) {
    float sv[16]; float tmax = -1e30f; unsigned okm = 0;
#pragma unroll
    for (int i = 0; i < 16; ++i) { const int kl = (i & 3) + 8 * (i >> 2) + 4 * hb; const bool k = ok(kl); okm |= (k ? 1u : 0u) << i; sv[i] = k ? s[i] : -1e30f; tmax = fmaxf(tmax, sv[i]); }
    tmax = fmaxf(tmax, __shfl_xor(tmax, 32));
    const float mn = fmaxf(m, tmax), alpha = __expf(m - mn); m = mn;
    float ps = 0.f;
#pragma unroll
    for (int i = 0; i < 16; ++i) ps += ((okm >> i) & 1u) ? __expf(sv[i] - mn) : 0.f;
    l = l * alpha + ps;
}
template <class OKF, class VF>
__device__ __forceinline__ void sm_pv(const f32x16& s, int hb, OKF ok, VF vf, float& m, float& l, f32x16 (&o)[2]) {
    float sv[16]; float tmax = -1e30f; unsigned okm = 0;
#pragma unroll
    for (int i = 0; i < 16; ++i) { const int kl = (i & 3) + 8 * (i >> 2) + 4 * hb; const bool k = ok(kl); okm |= (k ? 1u : 0u) << i; sv[i] = k ? s[i] : -1e30f; tmax = fmaxf(tmax, sv[i]); }
    tmax = fmaxf(tmax, __shfl_xor(tmax, 32));
    const float mn = fmaxf(m, tmax), alpha = __expf(m - mn); m = mn;
    float pr[16]; float ps = 0.f;
#pragma unroll
    for (int i = 0; i < 16; ++i) { pr[i] = ((okm >> i) & 1u) ? __expf(sv[i] - mn) : 0.f; ps += pr[i]; }
    l = l * alpha + ps;
    o[0] *= alpha; o[1] *= alpha;
#pragma unroll
    for (int s2 = 0; s2 < 2; ++s2) {
        const bf16x8 pb = pack8(pr[8 * s2 + 0], pr[8 * s2 + 1], pr[8 * s2 + 2], pr[8 * s2 + 3], pr[8 * s2 + 4], pr[8 * s2 + 5], pr[8 * s2 + 6], pr[8 * s2 + 7]);
#pragma unroll
        for (int dt = 0; dt < 2; ++dt) o[dt] = mfma32(vf(dt, s2), pb, o[dt]);
    }
}
template <class OKF, class VF>
__device__ __forceinline__ void cmp_pass2(const f32x16& s, int hb, OKF ok, VF vf, float m, float inv, f32x16 (&o)[2], LAS float* prow, bool writer) {
    float pr[16];
#pragma unroll
    for (int i = 0; i < 16; ++i) {
        const int kl = (i & 3) + 8 * (i >> 2) + 4 * hb;
        pr[i] = ok(kl) ? __expf(s[i] - m) * inv : 0.f;
        float q = pr[i] + __shfl_xor(pr[i], 1); q += __shfl_xor(q, 2);
        if (writer) prow[kl] = q;
    }
#pragma unroll
    for (int s2 = 0; s2 < 2; ++s2) {
        const bf16x8 pb = pack8(pr[8 * s2 + 0], pr[8 * s2 + 1], pr[8 * s2 + 2], pr[8 * s2 + 3], pr[8 * s2 + 4], pr[8 * s2 + 5], pr[8 * s2 + 6], pr[8 * s2 + 7]);
#pragma unroll
        for (int dt = 0; dt < 2; ++dt) o[dt] = mfma32(vf(dt, s2), pb, o[dt]);
    }
}

__device__ __forceinline__ void attn_store(const P& p, const f32x16 (&of)[2], int qrow, int head, int hb, bool doit, bf16_t* oadst = nullptr) {
    if (!oadst) oadst = p.oa();
    if (!doit) return;
#pragma unroll
    for (int dt = 0; dt < 2; ++dt)
#pragma unroll
        for (int i4 = 0; i4 < 4; ++i4) {
            const int d = 32 * dt + 8 * i4 + 4 * hb;
            const size_t off = (size_t)qrow * 512 + head * 64 + d;
            const uint2 gw = *(const uint2*)(p.ag() + off);
            f32x4 v;
            v[0] = of[dt][4 * i4 + 0] * __uint_as_float(gw.x << 16); v[1] = of[dt][4 * i4 + 1] * __uint_as_float(gw.x & 0xffff0000u);
            v[2] = of[dt][4 * i4 + 2] * __uint_as_float(gw.y << 16); v[3] = of[dt][4 * i4 + 3] * __uint_as_float(gw.y & 0xffff0000u);
            st_bf4(oadst + off, v);
        }
}


__device__ __forceinline__ void of_put(LAS float* st, int lane, const f32x16 (&o)[2], float sc) {
#pragma unroll
    for (int dt = 0; dt < 2; ++dt)
#pragma unroll
        for (int i = 0; i < 16; ++i) st[(dt * 16 + i) * 64 + lane] = o[dt][i] * sc;
}
__device__ __forceinline__ void of_add(LAS float* st, int lane, const f32x16 (&o)[2], float sc) {
#pragma unroll
    for (int dt = 0; dt < 2; ++dt)
#pragma unroll
        for (int i = 0; i < 16; ++i) st[(dt * 16 + i) * 64 + lane] += o[dt][i] * sc;
}
__device__ __forceinline__ void of_get_add(LAS float* st, int lane, const f32x16 (&o)[2], float sc, f32x16 (&of)[2]) {
#pragma unroll
    for (int dt = 0; dt < 2; ++dt)
#pragma unroll
        for (int i = 0; i < 16; ++i) of[dt][i] = st[(dt * 16 + i) * 64 + lane] + o[dt][i] * sc;
}


template <class NEXT, class OKF>
__device__ __forceinline__ void tile_loop(const bf16x8 (&qf)[4], const KSrcBf& ksrc, const VSrcBfT& vsrc, int tt, NEXT next, OKF ok, int lane, float& m, float& l, f32x16 (&o)[2]) {
    if (tt < 0) return;
    const int hb = lane >> 5;
    bf16x8 kf[4];
#pragma unroll
    for (int ks = 0; ks < 4; ++ks) kf[ks] = ksrc(32 * tt, ks, lane);
#pragma unroll 1
    for (;;) {
        const int tok0 = 32 * tt;
        const int nt = next(tt);
        bf16x8 vf[2][2];
#pragma unroll
        for (int dt = 0; dt < 2; ++dt)
#pragma unroll
            for (int s2 = 0; s2 < 2; ++s2) vf[dt][s2] = vsrc(tok0, dt, s2, lane);
        bf16x8 kn[4];
        const int ntc = nt >= 0 ? nt : tt;
#pragma unroll
        for (int ks = 0; ks < 4; ++ks) kn[ks] = ksrc(32 * ntc, ks, lane);
        f32x16 s = zero16();
#pragma unroll
        for (int ks = 0; ks < 4; ++ks) s = mfma32(kf[ks], qf[ks], s);
        sm_pv(s, hb, [&](int kl) { return ok(tok0, kl); }, [&](int dt, int s2) { return vf[dt][s2]; }, m, l, o);
        if (nt < 0) break;
#pragma unroll
        for (int ks = 0; ks < 4; ++ks) kf[ks] = kn[ks];
        tt = nt;
    }
}

__device__ __forceinline__ void attn_prompt_item(const P& p, int item, LAS unsigned char* wl, int lane, bf16_t* oadst = nullptr) {
    const int bg = item & 7, tg = item >> 3, b = bg >> 1, g = bg & 1;
    const int col = lane & 31, hb = lane >> 5, tl = col >> 2, hh = col & 3;
    const int t0 = tg * 8, qpos = t0 + tl, qrow = b * SEQ + qpos, head = g * 4 + hh;
    bf16x8 qf[4];
#pragma unroll
    for (int ks = 0; ks < 4; ++ks) qf[ks] = *(const bf16x8*)(p.qb() + (size_t)qrow * 512 + head * 64 + 16 * ks + 8 * hb);
    LAS float* psum = (LAS float*)wl;
    LAS unsigned long long* msk = (LAS unsigned long long*)(wl + 8192);
    const float g0 = p.gates()[(size_t)qrow * 32 + head * 3 + 0], g1 = p.gates()[(size_t)qrow * 32 + head * 3 + 1], g2 = p.gates()[(size_t)qrow * 32 + head * 3 + 2];
    f32x16 oc[2]; oc[0] = zero16(); oc[1] = zero16();
    {
        const int cm = t0 + 7 - 31;
        const int ntile = cm >= 0 ? ((cm >> 4) >> 5) + 1 : 0;
        const KSrcBf ksrc{p.kc_p() + (size_t)bg * 256 * 64};
        const VSrcBfT vsrc{p.vcT_p() + (size_t)bg * 64 * 256, 256};
        float m = -1e30f, l = 0.f;
#pragma unroll 1
        for (int kt = 0; kt < ntile; ++kt) {
            const f32x16 s = qk_tile(qf, ksrc, 32 * kt, lane);
            sm_stats(s, hb, [&](int kl) { return 16 * (32 * kt + kl) + 31 <= qpos; }, m, l);
        }
        l += __shfl_xor(l, 32);
        const float inv = l > 0.f ? 1.0f / l : 0.f;
#pragma unroll
        for (int i = 0; i < 32; ++i) psum[i * 64 + lane] = 0.f;
        WAVE_SYNC();
#pragma unroll 1
        for (int kt = 0; kt < ntile; ++kt) {
            const f32x16 s = qk_tile(qf, ksrc, 32 * kt, lane);
            cmp_pass2(s, hb, [&](int kl) { return 16 * (32 * kt + kl) + 31 <= qpos; }, [&](int dt, int s2) { return vsrc(32 * kt, dt, s2, lane); }, m, inv, oc,
                      psum + tl * 256 + 32 * kt, hh == 0);
        }
    }
    WAVE_SYNC();
    for (int t2 = 0; t2 < 8; ++t2) {
        const int t = t0 + t2, cur = t >> 6, n = lane;
        float imp = 0.f;
#pragma unroll
        for (int c = -1; c < 4; ++c) { const int cc = 4 * n + c; if (cc >= 0) imp += psum[t2 * 256 + cc]; }
        if (n == 0 || n == cur || n == cur - 1) imp = 1e4f;
        if (n * 64 > t) imp = -1.0f;
        int rank = 0;
#pragma unroll
        for (int j = 0; j < 64; ++j) {
            const float vj = __uint_as_float(__builtin_amdgcn_readlane(__float_as_uint(imp), j));
            rank += (vj > imp || (vj == imp && j < n)) ? 1 : 0;
        }
        const unsigned long long mk = __ballot(rank < 16);
        if (lane == 0) msk[t2] = mk;
    }
    WAVE_SYNC();
    const unsigned long long mymask = msk[tl];
    unsigned long long um = 0;
#pragma unroll
    for (int i = 0; i < 8; ++i) um |= msk[i];
    const int cur0 = t0 >> 6;
    WAVE_SYNC();
    LAS float* ost = (LAS float*)wl;
    of_put(ost, lane, oc, g0);
    {
        const KSrcBf ksrc{p.kb() + (size_t)((1 * NB + b) * 2 + g) * SEQ * 64};
        const VSrcBfT vsrc{p.vT() + (size_t)((0 * NB + b) * 2 + g) * 64 * SEQ, SEQ};
        float m = -1e30f, l = 0.f; f32x16 o[2]; o[0] = zero16(); o[1] = zero16();
        {
            const unsigned um_lo = __builtin_amdgcn_readfirstlane((unsigned)um), um_hi = __builtin_amdgcn_readfirstlane((unsigned)(um >> 32));
            unsigned long long umu = ((unsigned long long)um_hi << 32) | um_lo;
            if (cur0 < 63) umu &= (2ull << cur0) - 1ull;
            const int first = umu ? 2 * (int)__builtin_ctzll(umu) : -1;
            tile_loop(qf, ksrc, vsrc, first,
                      [&](int tt) { if (!(tt & 1)) return tt + 1; const int n = tt >> 1; if (n >= 63) return -1; const unsigned long long rem = umu >> (n + 1); return rem ? 2 * (n + 1 + (int)__builtin_ctzll(rem)) : -1; },
                      [&](int tok0, int kl) { return (bool)((mymask >> (tok0 >> 6)) & 1ull) && (tok0 + kl <= qpos); }, lane, m, l, o);
        }
        l += __shfl_xor(l, 32);
        const float sc = l > 0.f ? g1 / l : 0.f;
        of_add(ost, lane, o, sc);
    }
    {
        const KSrcBf ksrc{p.kb() + (size_t)((2 * NB + b) * 2 + g) * SEQ * 64};
        const VSrcBfT vsrc{p.vT() + (size_t)((1 * NB + b) * 2 + g) * 64 * SEQ, SEQ};
        float m = -1e30f, l = 0.f; f32x16 o[2]; o[0] = zero16(); o[1] = zero16();
        const int lo = t0 - 511;
        const int nlo = lo > 0 ? (lo >> 6) : 0;
        {
            const int last = 2 * cur0 + 1;
            tile_loop(qf, ksrc, vsrc, 2 * nlo, [&](int tt) { return tt < last ? tt + 1 : -1; },
                      [&](int tok0, int kl) { const int key = tok0 + kl; return key <= qpos && key + 511 >= qpos; }, lane, m, l, o);
        }
        l += __shfl_xor(l, 32);
        const float sc = l > 0.f ? g2 / l : 0.f;
        f32x16 of[2];
        of_get_add(ost, lane, o, sc, of);
        attn_store(p, of, qrow, head, hb, true, oadst);
    }
    WAVE_SYNC();
}

template <class RP, class OKF>
__device__ __forceinline__ void f32_tile(const bf16x8 (&qf)[4], RP rp, OKF ok, LAS bf16_t* vt, int lane, float& m, float& l, f32x16 (&o)[2]) {
    const int col = lane & 31, hb = lane >> 5;
    const float* kr = rp(col);
    f32x16 s = zero16();
#pragma unroll
    for (int ks = 0; ks < 4; ++ks) {
        const float4 a = *(const float4*)(kr + 16 * ks + 8 * hb), c = *(const float4*)(kr + 16 * ks + 8 * hb + 4);
        s = mfma32(pack8(a.x, a.y, a.z, a.w, c.x, c.y, c.z, c.w), qf[ks], s);
    }
    const float* vr = kr + 128 + 32 * hb;
#pragma unroll
    for (int j4 = 0; j4 < 8; ++j4) {
        const float4 a = *(const float4*)(vr + 4 * j4);
        vt[(32 * hb + 4 * j4 + 0) * 40 + col] = f2bf(a.x); vt[(32 * hb + 4 * j4 + 1) * 40 + col] = f2bf(a.y);
        vt[(32 * hb + 4 * j4 + 2) * 40 + col] = f2bf(a.z); vt[(32 * hb + 4 * j4 + 3) * 40 + col] = f2bf(a.w);
    }
    WAVE_SYNC();
    sm_pv(s, hb, ok, [&](int dt, int s2) {
        LAS const bf16_t* ptr = vt + (32 * dt + col) * 40 + 16 * s2 + 4 * hb;
        union { uint4 u; bf16x8 v; } x; const u32x2 a = *(LAS const u32x2*)ptr, c = *(LAS const u32x2*)(ptr + 8); x.u.x = a[0]; x.u.y = a[1]; x.u.z = c[0]; x.u.w = c[1]; return x.v; }, m, l, o);
    WAVE_SYNC();
}

__device__ __forceinline__ void attn_sample_item(const P& p, int item, LAS unsigned char* wl, int lane) {
    const int t = item & 7, g = (item >> 3) & 1, b = item >> 4, bg = b * 2 + g;
    const int col = lane & 31, hb = lane >> 5, hh = col & 3;
    const int qpos = PAST + t, qrow = NP + b * 8 + t, head = g * 4 + hh;
    bf16x8 qf[4];
#pragma unroll
    for (int ks = 0; ks < 4; ++ks) qf[ks] = *(const bf16x8*)(p.qb() + (size_t)qrow * 512 + head * 64 + 16 * ks + 8 * hb);
    LAS float* psum = (LAS float*)wl;
    LAS int* list = (LAS int*)(wl + 8256);
    LAS float* impl = (LAS float*)(wl + 8448);
    LAS bf16_t* vt = (LAS bf16_t*)(wl + 9728);
    const float g0 = p.gates()[(size_t)qrow * 32 + head * 3 + 0], g1 = p.gates()[(size_t)qrow * 32 + head * 3 + 1], g2 = p.gates()[(size_t)qrow * 32 + head * 3 + 2];
    f32x16 oc[2]; oc[0] = zero16(); oc[1] = zero16();
    {
        const KSrcBf ksrc{p.kc_s() + (size_t)bg * 1024 * 64};
        const VSrcBfT vsrc{p.vcT_s() + (size_t)bg * 64 * 1024, 1024};
        float m = -1e30f, l = 0.f;
#pragma unroll 1
        for (int kt = 0; kt < 32; ++kt) {
            const f32x16 s = qk_tile(qf, ksrc, 32 * kt, lane);
            sm_stats(s, hb, [&](int kl) { return 32 * kt + kl <= 1022; }, m, l);
        }
        l += __shfl_xor(l, 32);
        const float inv = l > 0.f ? 1.0f / l : 0.f;
#pragma unroll 1
        for (int kt = 0; kt < 32; ++kt) {
            const f32x16 s = qk_tile(qf, ksrc, 32 * kt, lane);
            cmp_pass2(s, hb, [&](int kl) { return 32 * kt + kl <= 1022; }, [&](int dt, int s2) { return vsrc(32 * kt, dt, s2, lane); }, m, inv, oc, psum + 32 * kt, col == 0);
        }
    }
    WAVE_SYNC();
#pragma unroll
    for (int j = 0; j < 5; ++j) {
        const int n = lane + 64 * j;
        if (n <= 256) {
            float imp = 0.f;
            for (int c = -1; c < 4; ++c) { const int cc = 4 * n + c; if (cc >= 0 && cc <= 1022) imp += psum[cc]; }
            impl[n] = imp;
        }
    }
    WAVE_SYNC();
    {
        int base = 0;
#pragma unroll
        for (int j = 0; j < 4; ++j) {
            const int n = lane + 64 * j;
            const bool cand = n >= 1 && n <= 254;
            const float v = impl[n];
            int rank = 0;
            for (int q = 1; q <= 254; ++q) { const float vq = impl[q]; rank += (vq > v || (vq == v && q < n)) ? 1 : 0; }
            const bool sel = cand && rank < 13;
            const unsigned long long mk = __ballot(sel);
            if (sel) list[base + __popcll(mk & ((1ull << lane) - 1ull))] = n;
            base += __popcll(mk);
        }
        if (lane == 0) { list[13] = 0; list[14] = 255; list[15] = 256; }
    }
    WAVE_SYNC();
#if SMODE & 1
    LAS float* ost = (LAS float*)wl;
    of_put(ost, lane, oc, g0);
    {
        float m = -1e30f, l = 0.f; f32x16 o[2]; o[0] = zero16(); o[1] = zero16();
#pragma unroll 1
        for (int li = 0; li < 16; ++li) {
#if SMODE & 4
            const int n = li < 13 ? 17 * li + 5 : (li == 13 ? 0 : 242 + li);
#else
            const int n = __builtin_amdgcn_readfirstlane(list[li]);
#endif
            if (n < 256) {
                const int page = p.page_table[b * 128 + (n >> 1)];
                const float* base = p.cache_sel + ((size_t)page * 128 + (n & 1) * 64) * 256 + g * 64;
#pragma unroll 1
                for (int k2 = 0; k2 < 2; ++k2)
                    f32_tile(qf, [&](int kl) { return base + (size_t)(32 * k2 + kl) * 256; }, [&](int kl) { return true; }, vt, lane, m, l, o);
            } else {
                const float* base = p.out + O_SEL_S + (size_t)(b * 8) * 256 + g * 64;
                f32_tile(qf, [&](int kl) { return base + (size_t)(kl < 8 ? kl : 7) * 256; }, [&](int kl) { return kl <= t; }, vt, lane, m, l, o);
            }
        }
        l += __shfl_xor(l, 32);
        const float sc = l > 0.f ? g1 / l : 0.f;
        of_add(ost, lane, o, sc);
    }
#endif
#if SMODE & 2
    {
        float m = -1e30f, l = 0.f; f32x16 o[2]; o[0] = zero16(); o[1] = zero16();
        const float* cw = p.cache_win + (size_t)b * 512 * 256 + g * 64;
        const float* nw = p.out + O_WIN_S + ((size_t)b * 512 + 504) * 256 + g * 64;
#pragma unroll 1
        for (int kt = 0; kt < 17; ++kt) {
            f32_tile(qf, [&](int kl) { const int j = 32 * kt + kl; return j < 512 ? cw + (size_t)j * 256 : nw + (size_t)(j - 512 < 8 ? j - 512 : 7) * 256; },
                     [&](int kl) { const int j = 32 * kt + kl; return j >= t + 1 && j <= 512 + t; }, vt, lane, m, l, o);
        }
        l += __shfl_xor(l, 32);
        const float sc = l > 0.f ? g2 / l : 0.f;
        f32x16 of[2];
        of_get_add(ost, lane, o, sc, of);
        attn_store(p, of, qrow, head, hb, col < 4);
    }
    WAVE_SYNC();
#endif
}

constexpr int WL_STRIDE = 15360, KV_OFF = 8 * WL_STRIDE, KV_BUF = 17920, XB_OFF = KV_OFF + 2 * KV_BUF;

struct LoadBf16 {
    const bf16_t* kbase; const bf16_t* vbase; int ld; bool with_v; u32x4_t kr, vr;
    __device__ __forceinline__ void load(int n) {
        const int tid = threadIdx.x, srow = tid >> 3, sch = tid & 7;
        kr = *(const u32x4_t*)(kbase + (size_t)(64 * n + srow) * 64 + sch * 8);
        if (with_v) vr = *(const u32x4_t*)(vbase + (size_t)srow * ld + 64 * n + sch * 8);
    }
    __device__ __forceinline__ void store(LAS unsigned char* buf) const {
        const int tid = threadIdx.x, srow = tid >> 3, sch = tid & 7;
        *(LAS u32x4_t*)(buf + srow * 144 + sch * 16) = kr;
        if (with_v) { LAS u32x2* vp = (LAS u32x2*)(buf + 9216 + srow * 136 + sch * 16); vp[0] = (u32x2){vr[0], vr[1]}; vp[1] = (u32x2){vr[2], vr[3]}; }
    }
};
struct LoadWinF32 {
    const float* cw; const float* nw; f32x4 k0, k1, v0, v1;
    __device__ __forceinline__ void load(int n) {
        const int tid = threadIdx.x, srow = tid >> 3, sch = tid & 7;
        const int j = 64 * n + srow;
        const float* r = j < 512 ? cw + (size_t)j * 256 : nw + (size_t)(j - 512 < 8 ? j - 512 : 7) * 256;
        k0 = *(const f32x4*)(r + sch * 8); k1 = *(const f32x4*)(r + sch * 8 + 4);
        v0 = *(const f32x4*)(r + 128 + sch * 8); v1 = *(const f32x4*)(r + 128 + sch * 8 + 4);
    }
    __device__ __forceinline__ void store(LAS unsigned char* buf) const {
        const int tid = threadIdx.x, srow = tid >> 3, sch = tid & 7;
        u32x4_t kw; kw[0] = pk2(k0[0], k0[1]); kw[1] = pk2(k0[2], k0[3]); kw[2] = pk2(k1[0], k1[1]); kw[3] = pk2(k1[2], k1[3]);
        *(LAS u32x4_t*)(buf + srow * 144 + sch * 16) = kw;
        LAS bf16_t* vb = (LAS bf16_t*)(buf + 9216) + (sch * 8) * 68 + srow;
#pragma unroll
        for (int e = 0; e < 4; ++e) { vb[e * 68] = f2bf(v0[e]); vb[(4 + e) * 68] = f2bf(v1[e]); }
    }
};

template <class LOADER, class NEXT, class ACTIVE, class BODY>
__device__ __forceinline__ void block_loop_g(LOADER ld, LAS unsigned char* kv, int first, NEXT next, ACTIVE active, BODY body) {
    if (first < 0) return;
    int n = first, cur = 0;
    ld.load(n);
    ld.store(kv);
    __syncthreads();
#pragma unroll 1
    for (;;) {
        const int nn = next(n);
        if (nn >= 0) ld.load(nn);
        if (active(n)) body(n, (LAS const bf16_t*)(kv + cur * KV_BUF), (LAS const bf16_t*)(kv + cur * KV_BUF + 9216));
        if (nn >= 0) ld.store(kv + (cur ^ 1) * KV_BUF);
        __syncthreads();
        if (nn < 0) break;
        cur ^= 1; n = nn;
    }
}
template <bool WITH_V, class NEXT, class ACTIVE, class BODY>
__device__ __forceinline__ void block_loop(const bf16_t* kbase, const bf16_t* vbase, int ld, LAS unsigned char* kv, int first, NEXT next, ACTIVE active, BODY body) {
    LoadBf16 L; L.kbase = kbase; L.vbase = vbase; L.ld = ld; L.with_v = WITH_V;
    block_loop_g(L, kv, first, next, active, body);
}
__device__ __forceinline__ bf16x8 lds_kfrag(LAS const bf16_t* kb, int kt, int ks, int col, int hb) { return *(LAS const bf16x8*)(kb + (32 * kt + col) * 72 + 16 * ks + 8 * hb); }
__device__ __forceinline__ bf16x8 lds_vfrag(LAS const bf16_t* vb, int kt, int dt, int s2, int col, int hb) {
    LAS const bf16_t* ptr = vb + (32 * dt + col) * 68 + 32 * kt + 16 * s2 + 4 * hb;
    union { u32x4_t u; bf16x8 v; } x; const u32x2 a = *(LAS const u32x2*)ptr, c = *(LAS const u32x2*)(ptr + 8); x.u[0] = a[0]; x.u[1] = a[1]; x.u[2] = c[0]; x.u[3] = c[1]; return x.v;
}
__device__ __forceinline__ f32x16 lds_qk(const bf16x8 (&qf)[4], LAS const bf16_t* kb, int kt, int col, int hb) {
    f32x16 s = zero16();
#pragma unroll
    for (int ks = 0; ks < 4; ++ks) s = mfma32(lds_kfrag(kb, kt, ks, col, hb), qf[ks], s);
    return s;
}

__device__ __forceinline__ void attn_prompt_block(const P& p, int bg, int j, LAS unsigned char* lds) {
    const int tid = threadIdx.x, lane = tid & 63, wid = tid >> 6;
    const int b = bg >> 1, g = bg & 1;
    const int col = lane & 31, hb = lane >> 5, tl = col >> 2, hh = col & 3;
    const int t0 = 64 * j + 8 * wid, qpos = t0 + tl, qrow = b * SEQ + qpos, head = g * 4 + hh;
    LAS unsigned char* wl = lds + wid * WL_STRIDE;
    LAS unsigned char* kv = lds + KV_OFF;
    LAS float* psum = (LAS float*)wl;
    LAS unsigned long long* msk = (LAS unsigned long long*)(wl + 8192);
    bf16x8 qf[4];
#pragma unroll
    for (int ks = 0; ks < 4; ++ks) qf[ks] = *(const bf16x8*)(p.qb() + (size_t)qrow * 512 + head * 64 + 16 * ks + 8 * hb);
    const float g0 = p.gates()[(size_t)qrow * 32 + head * 3 + 0], g1 = p.gates()[(size_t)qrow * 32 + head * 3 + 1], g2 = p.gates()[(size_t)qrow * 32 + head * 3 + 2];
    f32x16 oc[2]; oc[0] = zero16(); oc[1] = zero16();
    {
        const int cmb = 64 * j + 63 - 31;
        const int nbc = ((cmb >> 4) >> 6) + 1;
        const int cmw = t0 + 7 - 31;
        const int cmaxw = cmw >= 0 ? (cmw >> 4) : -1;
        const bf16_t* kc = p.kc_p() + (size_t)bg * 256 * 64;
        const bf16_t* vc = p.vcT_p() + (size_t)bg * 64 * 256;
        float m = -1e30f, l = 0.f;
        block_loop<false>(kc, vc, 256, kv, 0, [&](int n) { return n + 1 < nbc ? n + 1 : -1; }, [&](int n) { return cmaxw >= 64 * n; },
            [&](int n, LAS const bf16_t* kb, LAS const bf16_t* vb) {
#pragma unroll 1
                for (int kt = 0; kt < 2; ++kt) {
#if defined(BLK_GLOBAL_FRAGS)
                    const f32x16 s = qk_tile(qf, KSrcBf{kc}, 64 * n + 32 * kt, lane);
#else
                    const f32x16 s = lds_qk(qf, kb, kt, col, hb);
#endif
                    sm_stats(s, hb, [&](int kl) { return 16 * (64 * n + 32 * kt + kl) + 31 <= qpos; }, m, l);
                }
            });
        l += __shfl_xor(l, 32);
        const float inv = l > 0.f ? 1.0f / l : 0.f;
#pragma unroll
        for (int i = 0; i < 32; ++i) psum[i * 64 + lane] = 0.f;
        WAVE_SYNC();
        block_loop<true>(kc, vc, 256, kv, 0, [&](int n) { return n + 1 < nbc ? n + 1 : -1; }, [&](int n) { return cmaxw >= 64 * n; },
            [&](int n, LAS const bf16_t* kb, LAS const bf16_t* vb) {
#pragma unroll 1
                for (int kt = 0; kt < 2; ++kt) {
#if defined(BLK_GLOBAL_FRAGS)
                    const f32x16 s = qk_tile(qf, KSrcBf{kc}, 64 * n + 32 * kt, lane);
                    const VSrcBfT vsg{vc, 256};
                    cmp_pass2(s, hb, [&](int kl) { return 16 * (64 * n + 32 * kt + kl) + 31 <= qpos; }, [&](int dt, int s2) { return vsg(64 * n + 32 * kt, dt, s2, lane); }, m, inv, oc,
#else
                    const f32x16 s = lds_qk(qf, kb, kt, col, hb);
                    cmp_pass2(s, hb, [&](int kl) { return 16 * (64 * n + 32 * kt + kl) + 31 <= qpos; }, [&](int dt, int s2) { return lds_vfrag(vb, kt, dt, s2, col, hb); }, m, inv, oc,
#endif
                              psum + tl * 256 + 64 * n + 32 * kt, hh == 0);
                }
            });
    }
    WAVE_SYNC();
    unsigned long long umw = 0;
    for (int t2 = 0; t2 < 8; ++t2) {
        const int t = t0 + t2, cur = t >> 6, n = lane;
        float imp = 0.f;
#pragma unroll
        for (int c = -1; c < 4; ++c) { const int cc = 4 * n + c; if (cc >= 0) imp += psum[t2 * 256 + cc]; }
        if (n == 0 || n == cur || n == cur - 1) imp = 1e4f;
        if (n * 64 > t) imp = -1.0f;
        int rank = 0;
#pragma unroll
        for (int jj = 0; jj < 64; ++jj) {
            const float vj = __uint_as_float(__builtin_amdgcn_readlane(__float_as_uint(imp), jj));
            rank += (vj > imp || (vj == imp && jj < n)) ? 1 : 0;
        }
        const unsigned long long mk = __ballot(rank < 16);
        if (lane == 0) msk[t2] = mk;
        umw |= mk;
    }
    if (lane == 0) msk[8] = umw;
    __syncthreads();
    const unsigned long long mymask = msk[tl];
    unsigned long long umb = 0;
#pragma unroll
    for (int w2 = 0; w2 < 8; ++w2) umb |= *(LAS const unsigned long long*)(lds + w2 * WL_STRIDE + 8192 + 64);
    {
        const unsigned lo = __builtin_amdgcn_readfirstlane((unsigned)umb), hi = __builtin_amdgcn_readfirstlane((unsigned)(umb >> 32));
        umb = ((unsigned long long)hi << 32) | lo;
        if (j < 63) umb &= (2ull << j) - 1ull;
    }
    LAS float* ost = (LAS float*)wl;
#if defined(DBG_UMB)
    { const unsigned long long lim = j < 63 ? ((2ull << j) - 1ull) : ~0ull; if ((umw & lim & ~umb) != 0ull) oc[0][0] = __builtin_nanf(""); }
#endif
    of_put(ost, lane, oc, g0);
#if defined(DBG_SCHED)
    __builtin_amdgcn_sched_barrier(0);
#endif
#if defined(BLK_OLD_SEL)
    {
        const KSrcBf ksrc{p.kb() + (size_t)((1 * NB + b) * 2 + g) * SEQ * 64};
        const VSrcBfT vsrc{p.vT() + (size_t)((0 * NB + b) * 2 + g) * 64 * SEQ, SEQ};
        float m = -1e30f, l = 0.f; f32x16 o[2]; o[0] = zero16(); o[1] = zero16();
        unsigned long long umu = umw; const int cur0 = j;
        { const unsigned lo = __builtin_amdgcn_readfirstlane((unsigned)umu), hi = __builtin_amdgcn_readfirstlane((unsigned)(umu >> 32)); umu = ((unsigned long long)hi << 32) | lo; }
        if (cur0 < 63) umu &= (2ull << cur0) - 1ull;
        const int first = umu ? 2 * (int)__builtin_ctzll(umu) : -1;
        tile_loop(qf, ksrc, vsrc, first,
                  [&](int tt) { if (!(tt & 1)) return tt + 1; const int n = tt >> 1; if (n >= 63) return -1; const unsigned long long rem = umu >> (n + 1); return rem ? 2 * (n + 1 + (int)__builtin_ctzll(rem)) : -1; },
                  [&](int tok0, int kl) { return (bool)((mymask >> (tok0 >> 6)) & 1ull) && (tok0 + kl <= qpos); }, lane, m, l, o);
        l += __shfl_xor(l, 32);
        const float sc = l > 0.f ? g1 / l : 0.f;
        of_add(ost, lane, o, sc);
    }
#else
    {
        const bf16_t* kbs = p.kb() + (size_t)((1 * NB + b) * 2 + g) * SEQ * 64;
        const bf16_t* vbs = p.vT() + (size_t)((0 * NB + b) * 2 + g) * 64 * SEQ;
        float m = -1e30f, l = 0.f; f32x16 o[2]; o[0] = zero16(); o[1] = zero16();
        block_loop<true>(kbs, vbs, SEQ, kv, umb ? (int)__builtin_ctzll(umb) : -1,
            [&](int n) { if (n >= 63) return -1; const unsigned long long rem = umb >> (n + 1); return rem ? n + 1 + (int)__builtin_ctzll(rem) : -1; },
#if defined(SEL_ALWAYS_ACTIVE)
            [&](int n) { return true; },
#else
            [&](int n) { return (bool)((umw >> n) & 1ull); },
#endif
            [&](int n, LAS const bf16_t* kb, LAS const bf16_t* vb) {
                const bool bsel = (mymask >> n) & 1ull;
#pragma unroll
                for (int kt = 0; kt < 2; ++kt) {
                    const int tok0 = 64 * n + 32 * kt;
#if defined(BLK_GLOBAL_FRAGS)
                    const f32x16 s = qk_tile(qf, KSrcBf{kbs}, tok0, lane);
                    const VSrcBfT vsg{vbs, SEQ};
                    sm_pv(s, hb, [&](int kl) { return bsel && (tok0 + kl <= qpos); }, [&](int dt, int s2) { return vsg(tok0, dt, s2, lane); }, m, l, o);
#else
                    const f32x16 s = lds_qk(qf, kb, kt, col, hb);
                    sm_pv(s, hb, [&](int kl) { return (bool)((mymask >> (tok0 >> 6)) & 1ull) && (tok0 + kl <= qpos); }, [&](int dt, int s2) { return lds_vfrag(vb, kt, dt, s2, col, hb); }, m, l, o);
#endif
                }
            });
        l += __shfl_xor(l, 32);
        const float sc = l > 0.f ? g1 / l : 0.f;
        of_add(ost, lane, o, sc);
#if defined(DBG_SELCMP)
        {
            const float i1 = l > 0.f ? 1.0f / l : 0.f;
            float c1 = 0.f;
            for (int dt = 0; dt < 2; ++dt) for (int i = 0; i < 16; ++i) c1 += o[dt][i] * i1 * (1.0f + 0.37f * (float)(dt * 16 + i));
            const KSrcBf ksrc{kbs}; const VSrcBfT vsrc{vbs, SEQ};
            float m2 = -1e30f, l2 = 0.f; f32x16 o2[2]; o2[0] = zero16(); o2[1] = zero16();
            unsigned long long umu = umw;
            { const unsigned lo = __builtin_amdgcn_readfirstlane((unsigned)umu), hi = __builtin_amdgcn_readfirstlane((unsigned)(umu >> 32)); umu = ((unsigned long long)hi << 32) | lo; }
            if (j < 63) umu &= (2ull << j) - 1ull;
            const int first = umu ? 2 * (int)__builtin_ctzll(umu) : -1;
            tile_loop(qf, ksrc, vsrc, first,
                      [&](int tt) { if (!(tt & 1)) return tt + 1; const int n = tt >> 1; if (n >= 63) return -1; const unsigned long long rem = umu >> (n + 1); return rem ? 2 * (n + 1 + (int)__builtin_ctzll(rem)) : -1; },
                      [&](int tok0, int kl) { return (bool)((mymask >> (tok0 >> 6)) & 1ull) && (tok0 + kl <= qpos); }, lane, m2, l2, o2);
            l2 += __shfl_xor(l2, 32);
            const float i2 = l2 > 0.f ? 1.0f / l2 : 0.f;
            float c2 = 0.f;
            for (int dt = 0; dt < 2; ++dt) for (int i = 0; i < 16; ++i) c2 += o2[dt][i] * i2 * (1.0f + 0.37f * (float)(dt * 16 + i));
            if (!(fabsf(c1 - c2) < DBG_TOL) DBG_COND) ost[lane] = __builtin_nanf("");
        }
#endif
    }
#endif
#if defined(BLK_OLD_WIN)
    {
        const KSrcBf ksrc{p.kb() + (size_t)((2 * NB + b) * 2 + g) * SEQ * 64};
        const VSrcBfT vsrc{p.vT() + (size_t)((1 * NB + b) * 2 + g) * 64 * SEQ, SEQ};
        float m = -1e30f, l = 0.f; f32x16 o[2]; o[0] = zero16(); o[1] = zero16();
        const int lo = t0 - 511; const int nlo = lo > 0 ? (lo >> 6) : 0; const int last = 2 * j + 1;
        tile_loop(qf, ksrc, vsrc, 2 * nlo, [&](int tt) { return tt < last ? tt + 1 : -1; },
                  [&](int tok0, int kl) { const int key = tok0 + kl; return key <= qpos && key + 511 >= qpos; }, lane, m, l, o);
        l += __shfl_xor(l, 32);
        const float sc = l > 0.f ? g2 / l : 0.f;
        f32x16 of[2];
        of_get_add(ost, lane, o, sc, of);
        attn_store(p, of, qrow, head, hb, true);
    }
#else
#if defined(DBG_SCHED)
    __builtin_amdgcn_sched_barrier(0);
#endif
#if defined(DBG_EXTRA_SYNC)
    __syncthreads();
#endif
#if defined(DBG_SLEEP)
    for (int r = 0; r < (wid ^ (j & 7)) * 6; ++r) __builtin_amdgcn_s_sleep(100);
#endif
    {
        const bf16_t* kbw = p.kb() + (size_t)((2 * NB + b) * 2 + g) * SEQ * 64;
        const bf16_t* vbw = p.vT() + (size_t)((1 * NB + b) * 2 + g) * 64 * SEQ;
        float m = -1e30f, l = 0.f; f32x16 o[2]; o[0] = zero16(); o[1] = zero16();
        block_loop<true>(kbw, vbw, SEQ, kv, j > 8 ? j - 8 : 0, [&](int n) { return n < j ? n + 1 : -1; }, [&](int n) { return true; },
            [&](int n, LAS const bf16_t* kb, LAS const bf16_t* vb) {
#pragma unroll 1
                for (int kt = 0; kt < 2; ++kt) {
                    const int tok0 = 64 * n + 32 * kt;
#if defined(BLK_GLOBAL_FRAGS)
                    const f32x16 s = qk_tile(qf, KSrcBf{kbw}, tok0, lane);
                    const VSrcBfT vsg{vbw, SEQ};
                    sm_pv(s, hb, [&](int kl) { const int key = tok0 + kl; return key <= qpos && key + 511 >= qpos; }, [&](int dt, int s2) { return vsg(tok0, dt, s2, lane); }, m, l, o);
#else
                    const f32x16 s = lds_qk(qf, kb, kt, col, hb);
                    sm_pv(s, hb, [&](int kl) { const int key = tok0 + kl; return key <= qpos && key + 511 >= qpos; }, [&](int dt, int s2) { return lds_vfrag(vb, kt, dt, s2, col, hb); }, m, l, o);
#endif
                }
            });
        l += __shfl_xor(l, 32);
        const float sc = l > 0.f ? g2 / l : 0.f;
        f32x16 of[2];
        of_get_add(ost, lane, o, sc, of);
        attn_store(p, of, qrow, head, hb, true);
    }
#endif
    __syncthreads();
}

__device__ __forceinline__ void attn_sample_block(const P& p, int bg, LAS unsigned char* lds) {
    const int tid = threadIdx.x, lane = tid & 63, wid = tid >> 6;
    const int b = bg >> 1, g = bg & 1, t = wid;
    const int col = lane & 31, hb = lane >> 5, hh = col & 3;
    const int qrow = NP + b * 8 + t, head = g * 4 + hh;
    LAS unsigned char* wl = lds + wid * WL_STRIDE;
    LAS unsigned char* kv = lds + KV_OFF;
    bf16x8 qf[4];
#pragma unroll
    for (int ks = 0; ks < 4; ++ks) qf[ks] = *(const bf16x8*)(p.qb() + (size_t)qrow * 512 + head * 64 + 16 * ks + 8 * hb);
    LAS float* psum = (LAS float*)wl;
    LAS int* list = (LAS int*)(wl + 8256);
    LAS float* impl = (LAS float*)(wl + 8448);
    LAS bf16_t* vt = (LAS bf16_t*)(wl + 9728);
    const float g0 = p.gates()[(size_t)qrow * 32 + head * 3 + 0], g1 = p.gates()[(size_t)qrow * 32 + head * 3 + 1], g2 = p.gates()[(size_t)qrow * 32 + head * 3 + 2];
    f32x16 oc[2]; oc[0] = zero16(); oc[1] = zero16();
    {
        const bf16_t* kc = p.kc_s() + (size_t)bg * 1024 * 64;
        const bf16_t* vc = p.vcT_s() + (size_t)bg * 64 * 1024;
        float m = -1e30f, l = 0.f;
        block_loop<false>(kc, vc, 1024, kv, 0, [&](int n) { return n < 15 ? n + 1 : -1; }, [&](int n) { return true; },
            [&](int n, LAS const bf16_t* kb, LAS const bf16_t* vb) {
#pragma unroll 1
                for (int kt = 0; kt < 2; ++kt) {
                    const f32x16 s = lds_qk(qf, kb, kt, col, hb);
                    sm_stats(s, hb, [&](int kl) { return 64 * n + 32 * kt + kl <= 1022; }, m, l);
                }
            });
        l += __shfl_xor(l, 32);
        const float inv = l > 0.f ? 1.0f / l : 0.f;
        block_loop<true>(kc, vc, 1024, kv, 0, [&](int n) { return n < 15 ? n + 1 : -1; }, [&](int n) { return true; },
            [&](int n, LAS const bf16_t* kb, LAS const bf16_t* vb) {
#pragma unroll 1
                for (int kt = 0; kt < 2; ++kt) {
                    const f32x16 s = lds_qk(qf, kb, kt, col, hb);
                    cmp_pass2(s, hb, [&](int kl) { return 64 * n + 32 * kt + kl <= 1022; }, [&](int dt, int s2) { return lds_vfrag(vb, kt, dt, s2, col, hb); }, m, inv, oc,
                              psum + 64 * n + 32 * kt, col == 0);
                }
            });
    }
    WAVE_SYNC();
#pragma unroll
    for (int j = 0; j < 5; ++j) {
        const int n = lane + 64 * j;
        if (n <= 256) {
            float imp = 0.f;
            for (int c = -1; c < 4; ++c) { const int cc = 4 * n + c; if (cc >= 0 && cc <= 1022) imp += psum[cc]; }
            impl[n] = imp;
        }
    }
    WAVE_SYNC();
    {
        int base = 0;
#pragma unroll
        for (int j = 0; j < 4; ++j) {
            const int n = lane + 64 * j;
            const bool cand = n >= 1 && n <= 254;
            const float v = impl[n];
            int rank = 0;
            for (int q = 1; q <= 254; ++q) { const float vq = impl[q]; rank += (vq > v || (vq == v && q < n)) ? 1 : 0; }
            const bool sel = cand && rank < 13;
            const unsigned long long mk = __ballot(sel);
            if (sel) list[base + __popcll(mk & ((1ull << lane) - 1ull))] = n;
            base += __popcll(mk);
        }
        if (lane == 0) { list[13] = 0; list[14] = 255; list[15] = 256; }
    }
    WAVE_SYNC();
    if (lane < 16) {
        const int n = list[lane];
        list[16 + lane] = n < 256 ? p.page_table[b * 128 + (n >> 1)] * 128 + (n & 1) * 64 : -1;
    }
    WAVE_SYNC();
    LAS float* ost = (LAS float*)wl;
    of_put(ost, lane, oc, g0);
    {
        float m = -1e30f, l = 0.f; f32x16 o[2]; o[0] = zero16(); o[1] = zero16();
        const float* newrows = p.out + O_SEL_S + (size_t)(b * 8) * 256 + g * 64;
        auto rowptr = [&](int u) -> const float* {
            const int rb = __builtin_amdgcn_readfirstlane(list[16 + (u >> 1)]);
            return rb >= 0 ? p.cache_sel + ((size_t)rb + 32 * (u & 1) + col) * 256 + g * 64 : newrows + (size_t)(col < 8 ? col : 7) * 256;
        };
        f32x4 kA[4], kB[4];
        { const float* kr = rowptr(0) + 8 * hb;
#pragma unroll
          for (int ks = 0; ks < 4; ++ks) { kA[ks] = *(const f32x4*)(kr + 16 * ks); kB[ks] = *(const f32x4*)(kr + 16 * ks + 4); } }
#pragma unroll 1
        for (int u = 0; u < 31; ++u) {
            const bool isnew = __builtin_amdgcn_readfirstlane(list[16 + (u >> 1)]) < 0;
            const float* vr = rowptr(u) + 128 + 32 * hb;
            f32x4 vv[8];
#pragma unroll
            for (int j4 = 0; j4 < 8; ++j4) vv[j4] = *(const f32x4*)(vr + 4 * j4);
            f32x16 s = zero16();
#pragma unroll
            for (int ks = 0; ks < 4; ++ks) s = mfma32(pack8(kA[ks][0], kA[ks][1], kA[ks][2], kA[ks][3], kB[ks][0], kB[ks][1], kB[ks][2], kB[ks][3]), qf[ks], s);
            if (u + 1 < 31) { const float* kr = rowptr(u + 1) + 8 * hb;
#pragma unroll
                for (int ks = 0; ks < 4; ++ks) { kA[ks] = *(const f32x4*)(kr + 16 * ks); kB[ks] = *(const f32x4*)(kr + 16 * ks + 4); } }
#pragma unroll
            for (int j4 = 0; j4 < 8; ++j4)
#pragma unroll
                for (int e = 0; e < 4; ++e) vt[(32 * hb + 4 * j4 + e) * 40 + col] = f2bf(vv[j4][e]);
            WAVE_SYNC();
            sm_pv(s, hb, [&](int kl) { return !isnew || kl <= t; }, [&](int dt, int s2) {
                LAS const bf16_t* ptr = vt + (32 * dt + col) * 40 + 16 * s2 + 4 * hb;
                union { u32x4_t u4; bf16x8 v; } x; const u32x2 a = *(LAS const u32x2*)ptr, c = *(LAS const u32x2*)(ptr + 8); x.u4[0] = a[0]; x.u4[1] = a[1]; x.u4[2] = c[0]; x.u4[3] = c[1]; return x.v; }, m, l, o);
            WAVE_SYNC();
        }
        l += __shfl_xor(l, 32);
        const float sc = l > 0.f ? g1 / l : 0.f;
        of_add(ost, lane, o, sc);
    }
    {
        float m = -1e30f, l = 0.f; f32x16 o[2]; o[0] = zero16(); o[1] = zero16();
        LoadWinF32 L; L.cw = p.cache_win + (size_t)b * 512 * 256 + g * 64; L.nw = p.out + O_WIN_S + ((size_t)b * 512 + 504) * 256 + g * 64;
        block_loop_g(L, kv, 0, [&](int n) { return n < 8 ? n + 1 : -1; }, [&](int n) { return true; },
            [&](int n, LAS const bf16_t* kb, LAS const bf16_t* vb) {
#pragma unroll 1
                for (int kt = 0; kt < 2; ++kt) {
                    const int j0 = 64 * n + 32 * kt;
                    if (j0 >= 520) break;
                    const f32x16 s = lds_qk(qf, kb, kt, col, hb);
                    sm_pv(s, hb, [&](int kl) { const int j = j0 + kl; return j >= t + 1 && j <= 512 + t; }, [&](int dt, int s2) { return lds_vfrag(vb, kt, dt, s2, col, hb); }, m, l, o);
                }
            });
        l += __shfl_xor(l, 32);
        const float sc = l > 0.f ? g2 / l : 0.f;
        f32x16 of[2];
        of_get_add(ost, lane, o, sc, of);
        attn_store(p, of, qrow, head, hb, col < 4);
    }
    __syncthreads();
}

__device__ __forceinline__ void ph_attn(const P& p, LAS unsigned char* lds, int qsel = 0) {
    const int tid = threadIdx.x, lane = tid & 63, wid = tid >> 6;
    unsigned* ctr = p.bar() + 3584 + 64 * qsel;
    LAS unsigned* qslot = (LAS unsigned*)(lds + XB_OFF + 64);
    for (;;) {
        if (tid == 0) *qslot = __hip_atomic_fetch_add(ctr, 1u, __ATOMIC_RELAXED, __HIP_MEMORY_SCOPE_AGENT);
        __syncthreads();
        const unsigned q = __builtin_amdgcn_readfirstlane(*qslot);
        __syncthreads();
        if (q >= 64u + 512u) break;
#if defined(OLD_SAMPLE_ATTN)
        if (q < 64u) { attn_sample_item(p, (int)q * 8 + wid, lds + wid * WL_STRIDE, lane); __syncthreads(); }
#else
        if (q < 64u) attn_sample_block(p, (int)q, lds);
#endif
#if defined(OLD_PROMPT_ATTN)
        else { const int idx = (int)q - 64; attn_prompt_item(p, 4095 - (idx * 8 + wid), lds + wid * WL_STRIDE, lane); __syncthreads(); }
#else
        else { const int idx = (int)q - 64; attn_prompt_block(p, idx & 7, 63 - (idx >> 3), lds);
#if defined(DBG_REDO_OLD)
            attn_prompt_item(p, (8 * (63 - (idx >> 3)) + wid) * 8 + (idx & 7), lds + wid * WL_STRIDE, lane); __syncthreads();
#endif
        }
#endif
    }
}

#if defined(DBG_CMPALL)
__device__ __forceinline__ void dbg_old_attn(const P& p, LAS unsigned char* lds) {
    const int tid = threadIdx.x, lane = tid & 63, wid = tid >> 6;
    for (int it = blockIdx.x * 8 + wid; it < 4096; it += gridDim.x * 8) attn_prompt_item(p, it, lds + wid * WL_STRIDE, lane, (bf16_t*)p.tmp());
}
__device__ __forceinline__ void dbg_compare(const P& p) {
    const int tid = threadIdx.x, lane = tid & 63, wid = tid >> 6;
    const bf16_t* a = p.oa(); const bf16_t* b = (const bf16_t*)p.tmp();
    unsigned cnt = 0;
    for (int it = blockIdx.x * 8 + wid; it < NP * 8; it += gridDim.x * 8) {
        const int row = it >> 3, head = it & 7;
        const float x = bf2f(a[(size_t)row * 512 + head * 64 + lane]), y = bf2f(b[(size_t)row * 512 + head * 64 + lane]);
        const bool bad = __any(!(fabsf(x - y) <= DBG_TOL));
        const int s = row & (SEQ - 1), j = s >> 6, w = (s >> 3) & 7, g = head >> 2, bb = row >> 12;
        if (bad && (DBG_SEL)) ++cnt;
    }
    if (lane == 0 && cnt) atomicAdd(p.bar() + 3840, cnt);
}
#endif

#if defined(KEEP_OLD_PATH)
__device__ __forceinline__ void keep_old_attn(const P& p, LAS unsigned char* lds) {
    const int tid = threadIdx.x, lane = tid & 63, wid = tid >> 6;
    const int ndbg = (int)__builtin_amdgcn_readfirstlane(__hip_atomic_load(p.bar() + 3900, __ATOMIC_RELAXED, __HIP_MEMORY_SCOPE_AGENT));
    for (int it = blockIdx.x * 8 + wid; it < ndbg; it += gridDim.x * 8) attn_prompt_item(p, it, lds + wid * WL_STRIDE, lane, (bf16_t*)p.tmp());
}
#endif
#ifndef PROBE_PHASE
#define PROBE_PHASE 0
#endif
#ifndef STOP_AFTER
#define STOP_AFTER 3
#endif

constexpr int LDS_BYTES = pg8::STAGE_BYTES;

template <class Epi> __global__ __launch_bounds__(512, 2) void k_gemm(pg8::Gemm g, Epi E) {
    extern __shared__ __attribute__((aligned(16))) unsigned char shm[];
    pg8::StaticOrder S; S.init(g.M, g.N, (int)gridDim.x, (int)blockIdx.x);
    pg8::gemm_phase<Epi, pg8::StaticOrder, false>((PG8_LAS unsigned char*)shm, g, S, E, nullptr);
}
template <int PH> __global__ __launch_bounds__(512, 2) void k_phase(P p) {
    extern __shared__ __attribute__((aligned(16))) unsigned char shm[];
    LAS unsigned char* lds = (LAS unsigned char*)shm;
    if constexpr (PH == 0) ph_prep(p);
    if constexpr (PH == 1) ph_compress2(p, p.LHp(), 8, 256, 255, p.kc_p(), p.vcT_p());
    if constexpr (PH == 2) ph_cvt_cache(p);
    if constexpr (PH == 3) ph_compress2(p, p.LHs(), 64, 1024, 1023, p.kc_s(), p.vcT_s());
    if constexpr (PH == 4) ph_rwkv_prep(p);
    if constexpr (PH == 5) ph_rwkv_scan(p, (LAS float*)lds);
    if constexpr (PH == 6) ph_rwkv_post(p);
    if constexpr (PH == 7) ph_attn(p, lds);
    if constexpr (PH == 8) ph_final(p);
}

template <class Epi> static void launch_gemm(hipStream_t st, const bf16_t* A, const bf16_t* Bt, int M, int N, int K, const Epi& E) {
    static bool attr = false;
    if (!attr) { (void)hipFuncSetAttribute((const void*)k_gemm<Epi>, hipFuncAttributeMaxDynamicSharedMemorySize, LDS_BYTES); attr = true; }
    pg8::Gemm g{}; g.A = A; g.Bt = Bt; g.M = M; g.N = N; g.K = K;
    hipLaunchKernelGGL((k_gemm<Epi>), dim3(256), dim3(512), LDS_BYTES, st, g, E);
}
template <int PH> static void launch_phase(hipStream_t st, const P& p) {
    static bool attr = false;
    if (!attr) { (void)hipFuncSetAttribute((const void*)k_phase<PH>, hipFuncAttributeMaxDynamicSharedMemorySize, LDS_BYTES); attr = true; }
    hipLaunchKernelGGL((k_phase<PH>), dim3(256), dim3(512), LDS_BYTES, st, p);
}


constexpr int FUSED_LDS = XB_OFF + 256;

template <class Epi> __device__ __forceinline__ void run_gemm(LAS unsigned char* lds, const bf16_t* A, const bf16_t* Bt, int M, int N, int K, const Epi& E) {
    pg8::Gemm g; g.A = A; g.Bt = Bt; g.M = M; g.N = N; g.K = K; g.pad_ = 0;
    pg8::StaticOrder S; S.init(M, N, (int)gridDim.x, (int)blockIdx.x);
    pg8::gemm_phase<Epi, pg8::StaticOrder, false>((PG8_LAS unsigned char*)lds, g, S, E, nullptr);
}

__global__ __launch_bounds__(512, 2) void k_fused(P p) {
    extern __shared__ __attribute__((aligned(16))) unsigned char shm[];
    LAS unsigned char* lds = (LAS unsigned char*)shm;
    LAS unsigned* xb = (LAS unsigned*)(lds + XB_OFF);
    if (threadIdx.x == 0) { xb[0] = 0u; xb[1] = 0u; xb[2] = 0u; xb[3] = 0u; }
    __syncthreads();
    XcdBarrier bar = xcd_barrier_post(p.bar(), (volatile LAS unsigned*)xb);
    ph_prep(p);
#if PROBE_PHASE == 1
    xcd_barrier(bar);
    ph_prep(p);
#endif
    xcd_barrier(bar);
    { EpiIn e; e.p = p; run_gemm(lds, p.hb(), p.WinT(), MR, NPAD, DM, e); }
    ph_cmp_gemm_f32(p, lds);
#if PROBE_PHASE == 2
    xcd_barrier(bar);
    { EpiIn e; e.p = p; run_gemm(lds, p.hb(), p.WinT(), MR, NPAD, DM, e); }
    ph_cmp_gemm_f32(p, lds);
#endif
    xcd_barrier(bar);
    { EpiPlain e; e.C = p.LHp(); e.ldc = 256; e.pad_ = 0; run_gemm(lds, p.kb(), p.W1T(), 2048, 256, 1024, e); }
    { EpiPlain e; e.C = p.LHp() + (size_t)2048 * 256; e.ldc = 256; e.pad_ = 0; run_gemm(lds, p.vcr(), p.W1T() + (size_t)256 * 1024, 2048, 256, 1024, e); }
    ph_rwkv_prep(p);
    ph_compress2(p, p.LHs(), 64, 1024, 1023, p.kc_s(), p.vcT_s());
#if PROBE_PHASE == 3
    xcd_barrier(bar);
    { EpiPlain e; e.C = p.LHp(); e.ldc = 256; e.pad_ = 0; run_gemm(lds, p.kb(), p.W1T(), 2048, 256, 1024, e); }
    { EpiPlain e; e.C = p.LHp() + (size_t)2048 * 256; e.ldc = 256; e.pad_ = 0; run_gemm(lds, p.vcr(), p.W1T() + (size_t)256 * 1024, 2048, 256, 1024, e); }
    ph_rwkv_prep(p);
    ph_compress2(p, p.LHs(), 64, 1024, 1023, p.kc_s(), p.vcT_s());
#endif
    xcd_barrier(bar);
    ph_compress2(p, p.LHp(), 8, 256, 255, p.kc_p(), p.vcT_p());
    xcd_barrier(bar);
    ph_rwkv_scan(p, (LAS float*)lds);
#if defined(SCAN_SEPARATE)
    xcd_barrier(bar);
#endif
    __syncthreads();
    ph_attn(p, lds);
#if PROBE_PHASE == 5
    xcd_barrier(bar);
    ph_attn(p, lds, 1);
#endif
    xcd_barrier(bar);
#if defined(KEEP_OLD_PATH)
    keep_old_attn(p, lds);
#endif
#if defined(DBG_XBAR)
    xcd_barrier(bar);
    xcd_barrier(bar);
#endif
#if defined(DBG_CMPALL)
    dbg_old_attn(p, lds);
    xcd_barrier(bar);
    dbg_compare(p);
    xcd_barrier(bar);
#endif
    ph_rwkv_post(p);
    { EpiYa e; e.p = p; small_gemm(p.oa(), p.WpaT(), 512, e); run_gemm(lds, p.oa(), p.WpaT(), NP, DM, 512, e); }
#if PROBE_PHASE == 6
    xcd_barrier(bar);
    ph_rwkv_post(p);
    { EpiYa e; e.p = p; small_gemm(p.oa(), p.WpaT(), 512, e); run_gemm(lds, p.oa(), p.WpaT(), NP, DM, 512, e); }
#endif
    xcd_barrier(bar);
    { EpiYb e; e.p = p; small_gemm(p.ob(), p.WpbT(), 512, e); run_gemm(lds, p.ob(), p.WpbT(), NP, DM, 512, e); }
#if PROBE_PHASE == 7
    xcd_barrier(bar);
    { EpiYb e; e.p = p; small_gemm(p.ob(), p.WpbT(), 512, e); run_gemm(lds, p.ob(), p.WpbT(), NP, DM, 512, e); }
#endif
    xcd_barrier(bar);
    { EpiOut e; e.p = p; small_gemm(p.mb(), p.WoutT(), DM, e); run_gemm(lds, p.mb(), p.WoutT(), NP, DM, DM, e); }
    { EpiPlain e; e.C = p.pp(); e.ldc = DM; e.pad_ = 0; small_gemm(p.pb(), p.WprojT(), 256, e); run_gemm(lds, p.pb(), p.WprojT(), NP, DM, 256, e); }
#if PROBE_PHASE == 8
    xcd_barrier(bar);
    { EpiOut e; e.p = p; small_gemm(p.mb(), p.WoutT(), DM, e); run_gemm(lds, p.mb(), p.WoutT(), NP, DM, DM, e); }
    { EpiPlain e; e.C = p.pp(); e.ldc = DM; e.pad_ = 0; small_gemm(p.pb(), p.WprojT(), 256, e); run_gemm(lds, p.pb(), p.WprojT(), NP, DM, 256, e); }
#endif
    xcd_barrier(bar);
    { EpiGate e; e.p = p; small_gemm(p.xg(), p.WgateT(), DM, e); run_gemm(lds, p.xg(), p.WgateT(), NP, DM, DM, e); }
#if PROBE_PHASE == 9
    xcd_barrier(bar);
    { EpiGate e; e.p = p; small_gemm(p.xg(), p.WgateT(), DM, e); run_gemm(lds, p.xg(), p.WgateT(), NP, DM, DM, e); }
#endif
    xcd_barrier(bar);
    ph_final(p);
}
extern "C" void kernel_launch(void* const* d_in, const int* in_sizes, int n_in, void* d_out, int out_size, void* d_ws, size_t ws_size, hipStream_t stream) {
    (void)in_sizes; (void)n_in; (void)out_size; (void)ws_size;
    P p{};
    p.x_prompt = (const float*)d_in[0]; p.x_sample = (const float*)d_in[1]; p.p_prompt = (const float*)d_in[2]; p.p_sample = (const float*)d_in[3];
    p.cache_cmp = (const float*)d_in[4]; p.cache_sel = (const float*)d_in[5]; p.cache_win = (const float*)d_in[6]; p.state_wkv = (const float*)d_in[7];
    p.state_shift = (const float*)d_in[8]; p.page_table = (const int*)d_in[9]; p.norm_g = (const float*)d_in[10]; p.w_in = (const float*)d_in[11];
    p.cmp_pe = (const float*)d_in[12]; p.cmp_w1 = (const float*)d_in[13]; p.cmp_b1 = (const float*)d_in[14]; p.cmp_w2 = (const float*)d_in[15]; p.cmp_b2 = (const float*)d_in[16];
    p.w_pa = (const float*)d_in[17]; p.mu = (const float*)d_in[18]; p.w0 = (const float*)d_in[19]; p.w_up = (const float*)d_in[20]; p.a0 = (const float*)d_in[21];
    p.a_up = (const float*)d_in[22]; p.k_k = (const float*)d_in[23]; p.k_a = (const float*)d_in[24]; p.r_k = (const float*)d_in[25]; p.gn_g = (const float*)d_in[26];
    p.gn_b = (const float*)d_in[27]; p.w_pb = (const float*)d_in[28]; p.w_out = (const float*)d_in[29]; p.ple_g = (const float*)d_in[30]; p.w_gate = (const float*)d_in[31];
    p.w_proj = (const float*)d_in[32]; p.final_g = (const float*)d_in[33];
    p.out = (float*)d_out;
    p.ws = (unsigned char*)d_ws;

#if defined(MULTI_LAUNCH)
    launch_phase<0>(stream, p);
    { EpiIn e{}; e.p = p; launch_gemm(stream, p.hb(), p.WinT(), MR, NPAD, DM, e); }
#if STOP_AFTER >= 3
    { EpiPlain e{}; e.C = p.LHp(); e.ldc = 256; launch_gemm(stream, p.kb(), p.W1T(), 2048, 256, 1024, e); }
    { EpiPlain e{}; e.C = p.LHp() + (size_t)2048 * 256; e.ldc = 256; launch_gemm(stream, p.vcr(), p.W1T() + (size_t)256 * 1024, 2048, 256, 1024, e); }
    launch_phase<1>(stream, p);
    launch_phase<2>(stream, p);
    { EpiPlain e{}; e.C = p.LHs(); e.ldc = 256; launch_gemm(stream, p.cs(), p.W1T(), 65536, 256, 1024, e); }
    { EpiPlain e{}; e.C = p.LHs() + (size_t)65536 * 256; e.ldc = 256; launch_gemm(stream, p.cs() + (size_t)65536 * 1024, p.W1T() + (size_t)256 * 1024, 65536, 256, 1024, e); }
    launch_phase<3>(stream, p);
#endif
#if STOP_AFTER >= 2
    launch_phase<4>(stream, p);
    launch_phase<5>(stream, p);
    launch_phase<6>(stream, p);
#endif
    hipMemsetAsync(p.oa(), 0, (size_t)MR * 512 * 2, stream);
#if STOP_AFTER >= 3
    launch_phase<7>(stream, p);
#endif
    { EpiYa e{}; e.p = p; launch_gemm(stream, p.oa(), p.WpaT(), MR, DM, 512, e); }
    { EpiYb e{}; e.p = p; launch_gemm(stream, p.ob(), p.WpbT(), MR, DM, 512, e); }
    { EpiOut e{}; e.p = p; launch_gemm(stream, p.mb(), p.WoutT(), MR, DM, DM, e); }
    { EpiPlain e{}; e.C = p.pp(); e.ldc = DM; launch_gemm(stream, p.pb(), p.WprojT(), MR, DM, 256, e); }
    { EpiGate e{}; e.p = p; launch_gemm(stream, p.xg(), p.WgateT(), MR, DM, DM, e); }
    launch_phase<8>(stream, p);
#else
    static int grid = 0;
    if (!grid) {
        int dev = 0, cus = 0, per_cu = 0;
        (void)hipGetDevice(&dev);
        (void)hipDeviceGetAttribute(&cus, hipDeviceAttributeMultiprocessorCount, dev);
        (void)hipFuncSetAttribute((const void*)k_fused, hipFuncAttributeMaxDynamicSharedMemorySize, FUSED_LDS);
        (void)hipOccupancyMaxActiveBlocksPerMultiprocessor(&per_cu, k_fused, 512, FUSED_LDS);
        grid = per_cu >= 1 ? cus : 0;
        if (grid > 256) grid = 256;
    }
    (void)hipMemsetAsync(p.bar(), 0, 32768, stream);
    if (grid > 0) hipLaunchKernelGGL(k_fused, dim3(grid), dim3(512), FUSED_LDS, stream, p);
#endif
}
```

```cpp
#include <hip/hip_runtime.h>
#include <stdint.h>
#include <stdio.h>
namespace pg8 {
#define PG8_LAS __attribute__((address_space(3)))
typedef unsigned short bf16_t;
typedef short bf16x8 __attribute__((ext_vector_type(8)));
typedef float f32x4 __attribute__((ext_vector_type(4)));
typedef unsigned u32x4 __attribute__((ext_vector_type(4)));
constexpr int BM = 256, BK = 64, HALF = 128, HTB = HALF * BK * 2  , STAGE_BYTES = 8 * HTB, NXCD = 8, WGM = 8;

__host__ __device__ __forceinline__ int lds_byte(int r, int c) { const int st = (r >> 4) * 2 + (c >> 5), rr = r & 15, cc = c & 31, ob = rr * 64 + cc * 2; return st * 1024 + (ob ^ (((ob >> 9) & 1) << 5)); }
__host__ __device__ __forceinline__ void stage_rc(int b, int& R, int& C) { const int st = b / 1024, sb = b % 1024, swz = sb ^ (((sb >> 9) & 1) << 5); R = (st >> 1) * 16 + swz / 64; C = (st & 1) * 32 + (swz % 64) / 2; }
__host__ __device__ __forceinline__ int perm32(int rho) { const int n = rho >> 4, i = rho & 15; return 8 * (i >> 2) + 4 * n + (i & 3); }

struct Unit { int pm, pn; };
struct Gemm { const bf16_t* A; const bf16_t* Bt; int M, N, K, pad_; };

struct StaticOrder {
    int nM, nN, nwg, G, c;
    __host__ __device__ void init(int M, int N, int G_, int c_) { nM = M / BM; nN = N / BM; nwg = nM * nN; G = G_; c = c_; }
    __host__ __device__ bool next(int i, Unit& u) const {
        const long L = (long)i * G + c; if (L >= nwg) return false;
        int wgid = (int)L; { const int q = nwg / NXCD, r = nwg % NXCD, xcd = wgid % NXCD, off = wgid / NXCD; wgid = (xcd < r ? xcd * (q + 1) : r * (q + 1) + (xcd - r) * q) + off; }
        const int nig = WGM * nN, gid = wgid / nig, fm = gid * WGM, gsz = (nM - fm) < WGM ? (nM - fm) : WGM;
        u.pm = fm + ((wgid % nig) % gsz); u.pn = (wgid % nig) / gsz; return true;
    }
    __device__ __forceinline__ void a_ready(const Unit&) const {}
    __device__ __forceinline__ void done(const Unit&) const {}
};
__device__ __forceinline__ unsigned cvt_pk_bf16(float lo, float hi) { unsigned r; asm volatile("v_cvt_pk_bf16_f32 %0, %1, %2" : "=v"(r) : "v"(lo), "v"(hi)); return r; }
typedef float f32x2 __attribute__((ext_vector_type(2)));
template <class Epi, class Sched, bool STAMP = false>
__device__ __forceinline__ void gemm_phase(PG8_LAS unsigned char* lds, const Gemm g, const Sched& S, const Epi& E, unsigned long long* stamps) {
    int tid_l = threadIdx.x; asm volatile("" : "+v"(tid_l));
    const int tid = tid_l, wid = __builtin_amdgcn_readfirstlane(tid >> 6), lane = tid & 63, wr = wid >> 2, wc = wid & 3, fr = lane & 15, fq = lane >> 4;
    const int K = g.K, nt = K / BK;
    int ts_lo = 0, ts_hi = 0, nts = 0; const unsigned long long rt_entry = STAMP ? (unsigned long long)wall_clock64() : 0ull;
#define PG8_STAMP() do { if (STAMP && wid == 0 && nts < 64) { const unsigned long long _c = (unsigned long long)clock64(); \
        ts_lo = (lane == nts) ? (int)(unsigned)_c : ts_lo; ts_hi = (lane == nts) ? (int)(unsigned)(_c >> 32) : ts_hi; ++nts; } } while (0)
    PG8_STAMP();
    unsigned voffA[2], voffB[2];
#pragma unroll
    for (int i = 0; i < 2; ++i) { int R, C; stage_rc(tid * 16 + i * 8192, R, C); const int Rb = Epi::PERM ? ((R & ~31) + perm32(R & 31)) : R;
        voffA[i] = (unsigned)(R * K + C) * 2u; voffB[i] = (unsigned)(Rb * K + C) * 2u; }
    const size_t kstep = (size_t)(BK * 2);
    const size_t hstep = (size_t)HALF * K * 2;
    const size_t tstep = 2 * hstep;
    const unsigned ldsw = (unsigned)wid * 1024u;
    const int aoff = lds_byte(wr * 64 + fr, fq * 8), boff = lds_byte(wc * 32 + fr, fq * 8);
#define PG8_SA(b, h) (((b) * 2 + (h)) * HTB)
#define PG8_SB(b, h) ((4 + (b) * 2 + (h)) * HTB)
#define PG8_STAGE(bufoff, gbase, voff) do { _Pragma("unroll") for (int _i = 0; _i < 2; ++_i) \
        __builtin_amdgcn_global_load_lds((const unsigned*)((const char*)(gbase) + (voff)[_i]), (PG8_LAS unsigned*)(lds + (bufoff) + ldsw + _i * 8192), 16, 0, 0); } while (0)
#define PG8_LDA(dst, b, h) do { _Pragma("unroll") for (int m = 0; m < 4; ++m) _Pragma("unroll") for (int k = 0; k < 2; ++k) dst[m][k] = *(const PG8_LAS bf16x8*)(lds + PG8_SA(b, h) + aoff + m * 2048 + k * 1024); } while (0)
#define PG8_LDB(dst, b, h) do { _Pragma("unroll") for (int n = 0; n < 2; ++n) _Pragma("unroll") for (int k = 0; k < 2; ++k) dst[n][k] = *(const PG8_LAS bf16x8*)(lds + PG8_SB(b, h) + boff + n * 2048 + k * 1024); } while (0)
#define PG8_MMA(ai, bj, At, Bt) do { __builtin_amdgcn_s_setprio(1); _Pragma("unroll") for (int m = 0; m < 4; ++m) _Pragma("unroll") for (int n = 0; n < 2; ++n) _Pragma("unroll") for (int k = 0; k < 2; ++k) \
        acc[ai][bj][m][n] = __builtin_amdgcn_mfma_f32_16x16x32_bf16(Bt[n][k], At[m][k], acc[ai][bj][m][n], 0, 0, 0); __builtin_amdgcn_s_setprio(0); } while (0)
#define PG8_WAIT_V(n) asm volatile("s_waitcnt vmcnt(" #n ")" ::: "memory")
#define PG8_WAIT_L(n) asm volatile("s_waitcnt lgkmcnt(" #n ")" ::: "memory")
#define PG8_BAR __builtin_amdgcn_s_barrier()
#define PG8_SCHED __builtin_amdgcn_sched_barrier(0)
    Unit cur, nxt; int ui = 0;
    if (!S.next(0, cur)) return;
    f32x4 acc[2][2][4][2];
#pragma unroll
    for (int a = 0; a < 2; ++a)
#pragma unroll
        for (int b = 0; b < 2; ++b)
#pragma unroll
            for (int m = 0; m < 4; ++m)
#pragma unroll
                for (int n = 0; n < 2; ++n) acc[a][b][m][n] = (f32x4){0.f, 0.f, 0.f, 0.f};
    bf16x8 At[4][2], B0[2][2], B1[2][2];
    const char* cA = (const char*)g.A + (size_t)cur.pm * tstep; const char* cB = (const char*)g.Bt + (size_t)cur.pn * tstep;
    S.a_ready(cur);
    PG8_STAGE(PG8_SB(0, 0), cB, voffB); PG8_STAGE(PG8_SA(0, 0), cA, voffA); PG8_STAGE(PG8_SB(0, 1), cB + hstep, voffB); PG8_STAGE(PG8_SA(0, 1), cA + hstep, voffA);
    if (wr == 1) PG8_BAR;
    PG8_WAIT_V(4); PG8_BAR;
    PG8_STAGE(PG8_SB(1, 0), cB + kstep, voffB); PG8_STAGE(PG8_SA(1, 0), cA + kstep, voffA); PG8_STAGE(PG8_SB(1, 1), cB + hstep + kstep, voffB);
    PG8_WAIT_V(6); PG8_BAR;
    PG8_STAMP();
    for (;;) {
        const bool has_next = S.next(ui + 1, nxt);
        const char* nA = has_next ? (const char*)g.A + (size_t)nxt.pm * tstep : cA; const char* nB = has_next ? (const char*)g.Bt + (size_t)nxt.pn * tstep : cB;
        for (int t = 0; t < nt; t += 2) {
            const bool last = (t == nt - 2);
            const char* a1 = cA + (size_t)(t + 1) * kstep;
            const char* a2 = last ? nA : cA + (size_t)(t + 2) * kstep; const char* b2 = last ? nB : cB + (size_t)(t + 2) * kstep;
            const char* a3 = a2 + kstep; const char* b3 = b2 + kstep;
            if (last && has_next) S.a_ready(nxt);
            PG8_LDB(B0, 0, 0); PG8_SCHED; PG8_LDA(At, 0, 0); PG8_STAGE(PG8_SA(1, 1), a1 + hstep, voffA);
            PG8_WAIT_L(8); PG8_BAR; PG8_WAIT_L(0); PG8_MMA(0, 0, At, B0); PG8_BAR; PG8_SCHED;
            PG8_LDB(B1, 0, 1); PG8_STAGE(PG8_SB(0, 0), b2, voffB);
            PG8_BAR; PG8_WAIT_L(0); PG8_MMA(0, 1, At, B1); PG8_BAR;
            PG8_LDA(At, 0, 1); PG8_STAGE(PG8_SA(0, 0), a2, voffA);
            PG8_BAR; PG8_WAIT_L(0); PG8_MMA(1, 0, At, B0); PG8_BAR; PG8_SCHED;
            PG8_STAGE(PG8_SB(0, 1), b2 + hstep, voffB);
            PG8_WAIT_V(6); PG8_BAR; PG8_MMA(1, 1, At, B1); PG8_BAR;
            PG8_LDB(B0, 1, 0); PG8_SCHED; PG8_LDA(At, 1, 0); PG8_STAGE(PG8_SA(0, 1), a2 + hstep, voffA);
            PG8_WAIT_L(8); PG8_BAR; PG8_WAIT_L(0); PG8_MMA(0, 0, At, B0); PG8_BAR; PG8_SCHED;
            PG8_LDB(B1, 1, 1); PG8_STAGE(PG8_SB(1, 0), b3, voffB);
            PG8_BAR; PG8_WAIT_L(0); PG8_MMA(0, 1, At, B1); PG8_BAR;
            PG8_LDA(At, 1, 1); PG8_STAGE(PG8_SA(1, 0), a3, voffA);
            PG8_BAR; PG8_WAIT_L(0); PG8_MMA(1, 0, At, B0); PG8_BAR; PG8_SCHED;
            PG8_STAGE(PG8_SB(1, 1), b3 + hstep, voffB);
            PG8_WAIT_V(6); PG8_BAR; PG8_MMA(1, 1, At, B1); PG8_BAR;
        }
        PG8_STAMP();
        if constexpr (!Epi::AFTER_DRAIN) { E(acc, cur, wr, wc, fr, fq); S.done(cur); }
        PG8_STAMP();
        if (!has_next) break;
#pragma unroll
        for (int a = 0; a < 2; ++a)
#pragma unroll
            for (int b = 0; b < 2; ++b)
#pragma unroll
                for (int m = 0; m < 4; ++m)
#pragma unroll
                    for (int n = 0; n < 2; ++n) acc[a][b][m][n] = (f32x4){0.f, 0.f, 0.f, 0.f};
        cur = nxt; cA = nA; cB = nB; ++ui;
    }
    PG8_WAIT_V(0);
    if (wr == 0) PG8_BAR;
    PG8_BAR;
    if constexpr (Epi::AFTER_DRAIN) { E.fused(acc, cur, wr, wc, fr, fq, lds, wid, lane); S.done(cur); }
    PG8_STAMP();
    if (STAMP && wid == 0) { stamps[lane] = lane < nts ? (((unsigned long long)(unsigned)ts_hi << 32) | (unsigned)ts_lo) : 0ull;
        if (lane == 62) stamps[62] = rt_entry; if (lane == 63) stamps[63] = (unsigned long long)wall_clock64(); }
#undef PG8_STAMP
#undef PG8_SA
#undef PG8_SB
#undef PG8_STAGE
#undef PG8_LDA
#undef PG8_LDB
#undef PG8_MMA
#undef PG8_WAIT_V
#undef PG8_WAIT_L
#undef PG8_BAR
#undef PG8_SCHED
}
}

typedef unsigned short bf16_t;
typedef short bf16x8 __attribute__((ext_vector_type(8)));
typedef float f32x4 __attribute__((ext_vector_type(4)));
typedef float f32x16 __attribute__((ext_vector_type(16)));
#define LAS __attribute__((address_space(3)))
#define WAVE_SYNC() do { asm volatile("s_waitcnt lgkmcnt(0)" ::: "memory"); __builtin_amdgcn_wave_barrier(); } while (0)

constexpr int DM = 1024, NP = 16384, NSMP = 256, MR = 16640, SEQ = 4096, NB = 4, DB = 32, DS = 8, PAST = 16384;
constexpr int CIN = 6040, NPAD = 6144, CR = 1664;
constexpr int NTHR = 512;
constexpr size_t O_Y_P = 0, O_Y_S = 16777216, O_CMP_P = 17039360, O_CMP_S = 21233664, O_SEL_P = 21299200, O_SEL_S = 25493504,
                 O_WIN_P = 25559040, O_WIN_S = 26083328, O_WKV_P = 30277632, O_WKV_S = 30408704, O_SH_P = 31457280, O_SH_S = 31463936;

constexpr size_t ws_al(size_t x) { return (x + 255) & ~(size_t)255; }
constexpr size_t WS_bar = 0;
constexpr size_t WS_hb = WS_bar + ws_al(32768);
constexpr size_t WS_WinT = WS_hb + ws_al((size_t)MR * DM * 2);
constexpr size_t WS_WpaT = WS_WinT + ws_al((size_t)NPAD * DM * 2);
constexpr size_t WS_WpbT = WS_WpaT + ws_al((size_t)DM * 512 * 2);
constexpr size_t WS_WoutT = WS_WpbT + ws_al((size_t)DM * 512 * 2);
constexpr size_t WS_WgateT = WS_WoutT + ws_al((size_t)DM * DM * 2);
constexpr size_t WS_WprojT = WS_WgateT + ws_al((size_t)DM * DM * 2);
constexpr size_t WS_W1T = WS_WprojT + ws_al((size_t)DM * 256 * 2);
constexpr size_t WS_W2T = WS_W1T + ws_al((size_t)512 * 1024 * 2);
constexpr size_t WS_WupT = WS_W2T + ws_al((size_t)128 * 128 * 2);
constexpr size_t WS_AupT = WS_WupT + ws_al((size_t)512 * 64 * 2);
constexpr size_t WS_pb = WS_AupT + ws_al((size_t)512 * 64 * 2);
constexpr size_t WS_tabc = WS_pb + ws_al((size_t)MR * 256 * 2);
constexpr size_t WS_tabs = WS_tabc + ws_al((size_t)4104 * 32 * 4);
constexpr size_t WS_pt = WS_tabs + ws_al((size_t)4104 * 32 * 4);
constexpr size_t WS_qb = WS_pt + ws_al(256 * 4);
constexpr size_t WS_kb = WS_qb + ws_al((size_t)MR * 512 * 2);
constexpr size_t WS_vcr = WS_kb + ws_al((size_t)3 * NB * 2 * SEQ * 64 * 2);
constexpr size_t WS_vT = WS_vcr + ws_al((size_t)NB * 2 * SEQ * 64 * 2);
constexpr size_t WS_ag = WS_vT + ws_al((size_t)2 * NB * 2 * 64 * SEQ * 2);
constexpr size_t WS_rg = WS_ag + ws_al((size_t)MR * 512 * 2);
constexpr size_t WS_mg = WS_rg + ws_al((size_t)MR * 512 * 2);
constexpr size_t WS_gates = WS_mg + ws_al((size_t)MR * 2048 * 2);
constexpr size_t WS_rz = WS_gates + ws_al((size_t)MR * 32 * 4);
constexpr size_t WS_zs0 = WS_rz + ws_al((size_t)MR * CR * 2);
constexpr size_t WS_LHp = WS_zs0 + ws_al((size_t)33 * CR * 2);
constexpr size_t WS_LHs = WS_LHp + ws_al((size_t)2 * 2048 * 256 * 4);
constexpr size_t WS_cs = WS_LHs + ws_al((size_t)2 * 65536 * 256 * 4);
constexpr size_t WS_kc_p = WS_cs + ws_al((size_t)2 * 65536 * 1024 * 2);
constexpr size_t WS_vcT_p = WS_kc_p + ws_al((size_t)8 * 256 * 64 * 2);
constexpr size_t WS_kc_s = WS_vcT_p + ws_al((size_t)8 * 64 * 256 * 2);
constexpr size_t WS_vcT_s = WS_kc_s + ws_al((size_t)64 * 1024 * 64 * 2);
constexpr size_t WS_rw6 = WS_vcT_s + ws_al((size_t)64 * 64 * 1024 * 2);
constexpr int RW6_STRIDE = 896;
constexpr size_t WS_bonus = WS_rw6 + ws_al((size_t)MR * 8 * RW6_STRIDE);
constexpr size_t WS_ybuf = WS_bonus + ws_al((size_t)MR * 8 * 4);
constexpr size_t WS_oa = WS_ybuf + ws_al((size_t)MR * 512 * 4);
constexpr size_t WS_ob = WS_oa + ws_al((size_t)MR * 512 * 2);
constexpr size_t WS_mb = WS_ob + ws_al((size_t)MR * 512 * 2);
constexpr size_t WS_xg = WS_mb + ws_al((size_t)MR * DM * 2);
constexpr size_t WS_tmp = WS_xg + ws_al((size_t)MR * DM * 2);
constexpr size_t WS_x1 = WS_tmp + ws_al((size_t)MR * DM * 4);
constexpr size_t WS_ss1 = WS_x1 + ws_al((size_t)MR * DM * 4);
constexpr size_t WS_pp = WS_ss1 + ws_al((size_t)MR * 16 * 4);
constexpr size_t WS_TOTAL = WS_pp + ws_al((size_t)MR * DM * 4);

struct P {
    const float *x_prompt, *x_sample, *p_prompt, *p_sample, *cache_cmp, *cache_sel, *cache_win, *state_wkv, *state_shift;
    const int* page_table;
    const float *norm_g, *w_in, *cmp_pe, *cmp_w1, *cmp_b1, *cmp_w2, *cmp_b2, *w_pa, *mu, *w0, *w_up, *a0, *a_up, *k_k, *k_a, *r_k, *gn_g, *gn_b,
        *w_pb, *w_out, *ple_g, *w_gate, *w_proj, *final_g;
    float* out;
    unsigned char* ws;
    __host__ __device__ __forceinline__ unsigned* bar() const { return (unsigned*)(ws + WS_bar); }
    __host__ __device__ __forceinline__ float* ss_s() const { return (float*)(ws + WS_bar + 16384); }
    __host__ __device__ __forceinline__ bf16_t* hb() const { return (bf16_t*)(ws + WS_hb); }
    __host__ __device__ __forceinline__ bf16_t* WinT() const { return (bf16_t*)(ws + WS_WinT); }
    __host__ __device__ __forceinline__ bf16_t* WpaT() const { return (bf16_t*)(ws + WS_WpaT); }
    __host__ __device__ __forceinline__ bf16_t* WpbT() const { return (bf16_t*)(ws + WS_WpbT); }
    __host__ __device__ __forceinline__ bf16_t* WoutT() const { return (bf16_t*)(ws + WS_WoutT); }
    __host__ __device__ __forceinline__ bf16_t* WgateT() const { return (bf16_t*)(ws + WS_WgateT); }
    __host__ __device__ __forceinline__ bf16_t* WprojT() const { return (bf16_t*)(ws + WS_WprojT); }
    __host__ __device__ __forceinline__ bf16_t* W1T() const { return (bf16_t*)(ws + WS_W1T); }
    __host__ __device__ __forceinline__ bf16_t* W2T() const { return (bf16_t*)(ws + WS_W2T); }
    __host__ __device__ __forceinline__ bf16_t* WupT() const { return (bf16_t*)(ws + WS_WupT); }
    __host__ __device__ __forceinline__ bf16_t* AupT() const { return (bf16_t*)(ws + WS_AupT); }
    __host__ __device__ __forceinline__ bf16_t* pb() const { return (bf16_t*)(ws + WS_pb); }
    __host__ __device__ __forceinline__ float* tabc() const { return (float*)(ws + WS_tabc); }
    __host__ __device__ __forceinline__ float* tabs() const { return (float*)(ws + WS_tabs); }
    __host__ __device__ __forceinline__ float* pt() const { return (float*)(ws + WS_pt); }
    __host__ __device__ __forceinline__ bf16_t* qb() const { return (bf16_t*)(ws + WS_qb); }
    __host__ __device__ __forceinline__ bf16_t* kb() const { return (bf16_t*)(ws + WS_kb); }
    __host__ __device__ __forceinline__ bf16_t* vcr() const { return (bf16_t*)(ws + WS_vcr); }
    __host__ __device__ __forceinline__ bf16_t* vT() const { return (bf16_t*)(ws + WS_vT); }
    __host__ __device__ __forceinline__ bf16_t* ag() const { return (bf16_t*)(ws + WS_ag); }
    __host__ __device__ __forceinline__ bf16_t* rg() const { return (bf16_t*)(ws + WS_rg); }
    __host__ __device__ __forceinline__ bf16_t* mg() const { return (bf16_t*)(ws + WS_mg); }
    __host__ __device__ __forceinline__ float* gates() const { return (float*)(ws + WS_gates); }
    __host__ __device__ __forceinline__ bf16_t* rz() const { return (bf16_t*)(ws + WS_rz); }
    __host__ __device__ __forceinline__ bf16_t* zs0() const { return (bf16_t*)(ws + WS_zs0); }
    __host__ __device__ __forceinline__ bf16_t* LHp() const { return (bf16_t*)(ws + WS_LHp); }
    __host__ __device__ __forceinline__ bf16_t* LHs() const { return (bf16_t*)(ws + WS_LHs); }
    __host__ __device__ __forceinline__ bf16_t* cs() const { return (bf16_t*)(ws + WS_cs); }
    __host__ __device__ __forceinline__ bf16_t* kc_p() const { return (bf16_t*)(ws + WS_kc_p); }
    __host__ __device__ __forceinline__ bf16_t* vcT_p() const { return (bf16_t*)(ws + WS_vcT_p); }
    __host__ __device__ __forceinline__ bf16_t* kc_s() const { return (bf16_t*)(ws + WS_kc_s); }
    __host__ __device__ __forceinline__ bf16_t* vcT_s() const { return (bf16_t*)(ws + WS_vcT_s); }
    __host__ __device__ __forceinline__ unsigned char* rw6() const { return ws + WS_rw6; }
    __host__ __device__ __forceinline__ float* bonus() const { return (float*)(ws + WS_bonus); }
    __host__ __device__ __forceinline__ float* ybuf() const { return (float*)(ws + WS_ybuf); }
    __host__ __device__ __forceinline__ bf16_t* oa() const { return (bf16_t*)(ws + WS_oa); }
    __host__ __device__ __forceinline__ bf16_t* ob() const { return (bf16_t*)(ws + WS_ob); }
    __host__ __device__ __forceinline__ bf16_t* mb() const { return (bf16_t*)(ws + WS_mb); }
    __host__ __device__ __forceinline__ bf16_t* xg() const { return (bf16_t*)(ws + WS_xg); }
    __host__ __device__ __forceinline__ float* tmp() const { return (float*)(ws + WS_tmp); }
    __host__ __device__ __forceinline__ float* x1() const { return (float*)(ws + WS_x1); }
    __host__ __device__ __forceinline__ float* ss1() const { return (float*)(ws + WS_ss1); }
    __host__ __device__ __forceinline__ float* pp() const { return (float*)(ws + WS_pp); }
};

__device__ __forceinline__ bf16_t f2bf(float f) { unsigned u = __float_as_uint(f); u += 0x7FFFu + ((u >> 16) & 1u); return (bf16_t)(u >> 16); }
__device__ __forceinline__ float bf2f(bf16_t b) { return __uint_as_float(((unsigned)b) << 16); }
typedef __bf16 bf16v2_t __attribute__((ext_vector_type(2)));
typedef float f32x2_t __attribute__((ext_vector_type(2)));
__device__ __forceinline__ unsigned pk2(float lo, float hi) { const f32x2_t v = {lo, hi}; return __builtin_bit_cast(unsigned, __builtin_convertvector(v, bf16v2_t)); }
__device__ __forceinline__ float wave_sum(float v) {
#pragma unroll
    for (int o = 32; o >= 1; o >>= 1) v += __shfl_xor(v, o);
    return v;
}
#ifndef FAST_RCP_SITES
#define FAST_RCP_SITES 1
#endif
__device__ __forceinline__ float sigmoidf_(float x) { return 1.0f / (1.0f + __expf(-x)); }
__device__ __forceinline__ float siluf_(float x) { return x / (1.0f + __expf(-x)); }
__device__ __forceinline__ float sigmoid_fast(float x) { return __builtin_amdgcn_rcpf(1.0f + __expf(-x)); }
#if defined(SILU_DIVMUL)
__device__ __forceinline__ float silu_fast(float x) { return x * (1.0f / (1.0f + __expf(-x))); }
#elif defined(SILU_NOP)
__device__ __forceinline__ float silu_fast(float x) { float r = __builtin_amdgcn_rcpf(1.0f + __expf(-x)); asm(SILU_NOP_STR : "+v"(r)); return x * r; }
#else
__device__ __forceinline__ float silu_fast(float x) { return x * __builtin_amdgcn_rcpf(1.0f + __expf(-x)); }
#endif
#define SIG(site, x) (((FAST_RCP_SITES) & (site)) ? sigmoid_fast(x) : sigmoidf_(x))
#define SILU(site, x) (((FAST_RCP_SITES) & (site)) ? silu_fast(x) : siluf_(x))

__device__ __forceinline__ int win_src_col(int np) {
    const int pn = np >> 8, p = np & 255;
    if (pn < 5) {
        const int bj = p >> 7, wc = (p >> 5) & 3, n = (p >> 4) & 1, fq = (p >> 2) & 3, e = p & 3;
        const int d = 32 * n + 16 * (wc & 1) + 4 * fq + e;
        if (pn < 2) { const int head = pn * 4 + bj * 2 + (wc >> 1); return head * 64 + d; }
        const int br = pn - 2, g = wc >> 1;
        return 512 + br * 256 + bj * 128 + g * 64 + d;
    }
    if (pn < 7) return 1304 + (pn - 5) * 256 + p;
    if (pn < 13) return 1816 + (pn - 7) * 256 + p;
    if (pn == 13) { if (p < 128) return 1816 + 1536 + p; if (p < 152) return 1280 + (p - 128); return -1; }
    if (pn < 16) return 3480 + (pn - 14) * 256 + p;
    return 3992 + (pn - 16) * 256 + p;
}

template <class F>
__device__ __forceinline__ void transpose_cvt(bf16_t* dst, int Nd, int K, F f) {
    const int total = Nd * (K >> 3);
    for (int id = blockIdx.x * NTHR + threadIdx.x; id < total; id += gridDim.x * NTHR) {
        const int n = id % Nd, kc = id / Nd;
        float v[8];
#pragma unroll
        for (int j = 0; j < 8; ++j) v[j] = f(n, kc * 8 + j);
        uint4 w; w.x = pk2(v[0], v[1]); w.y = pk2(v[2], v[3]); w.z = pk2(v[4], v[5]); w.w = pk2(v[6], v[7]);
        *(uint4*)(dst + (size_t)n * K + kc * 8) = w;
    }
}

__device__ __forceinline__ void sincos_small(double r, float& s, float& c) {
    const double r2 = r * r;
    double sa = 1.0, ca = 1.0;
    double ts = 1.0, tc = 1.0; sa = 0.0; ca = 0.0;
#pragma unroll
    for (int k = 0; k < 16; ++k) {
        sa += ts; ca += tc;
        ts = -ts * r2 / (double)((2 * k + 2) * (2 * k + 3));
        tc = -tc * r2 / (double)((2 * k + 1) * (2 * k + 2));
    }
    s = (float)(sa * r); c = (float)ca;
}

__device__ __forceinline__ void ph_prep(const P& p) {
    const int tid = threadIdx.x, lane = tid & 63, wid = tid >> 6;
    const int gw = blockIdx.x * 8 + wid, nw = gridDim.x * 8;
    const int gt = blockIdx.x * NTHR + tid, nt = gridDim.x * NTHR;
    for (int row = gw; row < MR; row += nw) {
        const float4* src = (const float4*)(row < NP ? p.x_prompt + (size_t)row * DM : p.x_sample + (size_t)(row - NP) * DM);
        float4 v[4]; float ss = 0.f;
#pragma unroll
        for (int i = 0; i < 4; ++i) { v[i] = src[lane + 64 * i]; ss += v[i].x * v[i].x + v[i].y * v[i].y + v[i].z * v[i].z + v[i].w * v[i].w; }
        ss = wave_sum(ss);
        const float rstd = rsqrtf(ss * (1.0f / DM) + 1e-6f);
#pragma unroll
        for (int i = 0; i < 4; ++i) {
            const float4 g = ((const float4*)p.norm_g)[lane + 64 * i];
            uint2 w; w.x = pk2(v[i].x * rstd * g.x, v[i].y * rstd * g.y); w.y = pk2(v[i].z * rstd * g.z, v[i].w * rstd * g.w);
            *(uint2*)(p.hb() + (size_t)row * DM + 4 * (lane + 64 * i)) = w;
        }
    }
    { const float* w = p.w_in; transpose_cvt(p.WinT(), NPAD, DM, [=](int n, int k) { const int c = win_src_col(n); return c < 0 ? 0.f : w[(size_t)k * CIN + c]; }); }
    { const float* w = p.w_pa; transpose_cvt(p.WpaT(), DM, 512, [=](int n, int k) { return w[(size_t)k * DM + n]; }); }
    { const float* w = p.w_pb; transpose_cvt(p.WpbT(), DM, 512, [=](int n, int k) { return w[(size_t)k * DM + n]; }); }
    { const float* w = p.w_out; transpose_cvt(p.WoutT(), DM, DM, [=](int n, int k) { return w[(size_t)k * DM + n]; }); }
    { const float* w = p.w_gate; transpose_cvt(p.WgateT(), DM, DM, [=](int n, int k) { return w[(size_t)k * DM + n]; }); }
    { const float* w = p.w_proj; transpose_cvt(p.WprojT(), DM, 256, [=](int n, int k) { return w[(size_t)k * DM + n]; }); }
    { const float* w = p.cmp_w1; transpose_cvt(p.W1T(), 512, 1024, [=](int n, int k) { const int kvi = n >> 8, nn = n & 255; return w[(size_t)kvi * 262144 + (size_t)((nn >> 7) * 1024 + k) * 128 + (nn & 127)]; }); }
    { const float* w = p.cmp_w2; transpose_cvt(p.W2T(), 128, 128, [=](int n, int k) { return w[(size_t)(n >> 6) * 8192 + (size_t)k * 64 + (n & 63)]; }); }
    { const float* w = p.w_up; transpose_cvt(p.WupT(), 512, 64, [=](int n, int k) { return w[(size_t)k * 512 + n]; }); }
    { const float* w = p.a_up; transpose_cvt(p.AupT(), 512, 64, [=](int n, int k) { return w[(size_t)k * 512 + n]; }); }
    for (int id = gt; id < 33 * CR; id += nt) p.zs0()[id] = id < CR ? (bf16_t)0 : f2bf(p.state_shift[id - CR]);
    for (int id = gt; id < MR * 64; id += nt) {
        const int row = id >> 6, c4 = id & 63;
        const float4 v = ((const float4*)(row < NP ? p.p_prompt + (size_t)row * 256 : p.p_sample + (size_t)(row - NP) * 256))[c4];
        uint2 w; w.x = pk2(v.x, v.y); w.y = pk2(v.z, v.w);
        *(uint2*)(p.pb() + (size_t)row * 256 + c4 * 4) = w;
    }
    for (int id = gt; id < 4104 * 32; id += nt) {
        const int pi = id >> 5, i = id & 31;
        const int pos = pi < 4096 ? pi : PAST + pi - 4096;
        const float inv = (float)exp(-(double)i * (9.210340371976184 / 32.0));
        const float ang = (float)pos * inv;
        const double x = (double)ang;
        const double k = rint(x * 0.15915494309189535);
        const double r = x - k * 6.283185307179586;
        float s, c; sincos_small(r, s, c);
        p.tabc()[id] = c; p.tabs()[id] = s;
    }
    for (int o = gw; o < 256; o += nw) {
        const int kvi = o >> 7, f = o & 127;
        float acc = 0.f;
        for (int jd = lane; jd < 2048; jd += 64) acc += p.cmp_pe[kvi * 2048 + jd] * p.cmp_w1[(size_t)kvi * 262144 + (size_t)jd * 128 + f];
        acc = wave_sum(acc);
        if (lane == 0) p.pt()[o] = acc + p.cmp_b1[o];
    }
    for (int id = gt; id < DB * 504 * 64; id += nt) {
        const int c4 = id & 63, j = (id >> 6) % 504, b = (id >> 6) / 504;
        ((float4*)(p.out + O_WIN_S))[((size_t)b * 512 + j) * 64 + c4] = ((const float4*)p.cache_win)[((size_t)b * 512 + j + 8) * 64 + c4];
    }
}
#define XB_TMO      128
#define XB_XCNT(j)  (256  + 64 * (j))
#define XB_XSUB(j)  (1280 + 64 * (j))
#define XB_XGEN(j)  (2304 + 64 * (j))
#define XB_TOP      3328
#define XB_TOPGEN   3392
#define XCD_BAR_WORDS 3456
#define XB_SPIN_CAP (1u << 18)

__device__ __forceinline__ unsigned xb_ld(unsigned* p)              { return __hip_atomic_load(p, __ATOMIC_RELAXED, __HIP_MEMORY_SCOPE_AGENT); }
__device__ __forceinline__ unsigned xb_add(unsigned* p, unsigned v) { return __hip_atomic_fetch_add(p, v, __ATOMIC_RELAXED, __HIP_MEMORY_SCOPE_AGENT); }
__device__ __forceinline__ unsigned xb_xcc_id() { return (unsigned)__builtin_amdgcn_s_getreg((3 << 11) | 20) & 0xFu; }
#define XB_SPIN(cond, bar) do { unsigned _sp = 0; while (cond) { __builtin_amdgcn_s_sleep(1); \
    if ((++_sp & 255u) == 0u) { if (xb_ld(&(bar)[XB_TMO])) break; if (_sp > XB_SPIN_CAP) { atomicAdd(&(bar)[XB_TMO], 1u); break; } } } } while (0)

struct XcdBarrier {
    unsigned* bar; unsigned x;
    volatile LAS unsigned* st;
};

__device__ __forceinline__ XcdBarrier xcd_barrier_post(unsigned* bar, volatile LAS unsigned* st) {
    XcdBarrier b; b.bar = bar; b.x = xb_xcc_id(); b.st = st;
    if (threadIdx.x == 0) (void)xb_add(&bar[XB_XCNT(b.x)], 1u);
    return b;
}
__device__ __forceinline__ void xcd_barrier_complete(unsigned* bar, unsigned x, unsigned& nloc, unsigned& nx) {
    const unsigned G = gridDim.x * gridDim.y * gridDim.z;
    unsigned sum, cnt, mine, sp = 0u;
    for (;;) {
        sum = 0u; cnt = 0u; mine = 0u;
#pragma unroll
        for (unsigned j = 0; j < 16; ++j) { const unsigned c = xb_ld(&bar[XB_XCNT(j)]); sum += c; cnt += (c > 0u) ? 1u : 0u; mine = (j == x) ? c : mine; }
        if (sum == G) break;
        __builtin_amdgcn_s_sleep(1);
        if ((++sp & 255u) == 0u) { if (xb_ld(&bar[XB_TMO])) break; if (sp > XB_SPIN_CAP) { atomicAdd(&bar[XB_TMO], 1u); break; } }
    }
    nloc = mine > 0u ? mine : 1u; nx = cnt > 0u ? cnt : 1u;
}

__device__ __forceinline__ void xcd_barrier(const XcdBarrier& b) {
    asm volatile("s_waitcnt vmcnt(0)" ::: "memory");
    __syncthreads();
    if (threadIdx.x == 0) {
        unsigned* bar = b.bar;
        __builtin_amdgcn_s_waitcnt(0);
        unsigned nloc = b.st[0], nx = b.st[1];
        if (nloc == 0u) { xcd_barrier_complete(bar, b.x, nloc, nx); b.st[0] = nloc; b.st[1] = nx; }
        const unsigned old = xb_add(&bar[XB_XSUB(b.x)], 1u);
        const unsigned gen = old / nloc;
        if (old + 1u == (gen + 1u) * nloc) {
            __builtin_amdgcn_fence(__ATOMIC_RELEASE, "agent");
            asm volatile("s_waitcnt vmcnt(0)" ::: "memory");
            const unsigned og = xb_add(&bar[XB_TOP], 1u);
            const unsigned tg = og / nx;
            if (og + 1u == (tg + 1u) * nx) xb_add(&bar[XB_TOPGEN], 1u);
            else XB_SPIN(xb_ld(&bar[XB_TOPGEN]) == tg, bar);
            __builtin_amdgcn_fence(__ATOMIC_ACQUIRE, "agent");
            xb_add(&bar[XB_XGEN(b.x)], 1u);
            asm volatile("s_waitcnt vmcnt(0)" ::: "memory");
        } else {
            XB_SPIN(xb_ld(&bar[XB_XGEN(b.x)]) == gen, bar);
            __builtin_amdgcn_fence(__ATOMIC_ACQUIRE, "agent");
            asm volatile("s_waitcnt vmcnt(0)" ::: "memory");
        }
    }
    __syncthreads();
}

using pg8::Unit;
typedef unsigned u32x2 __attribute__((ext_vector_type(2)));
typedef unsigned u32x4_t __attribute__((ext_vector_type(4)));
__device__ __forceinline__ f32x16 mfma32(bf16x8 a, bf16x8 b, f32x16 c) { return __builtin_amdgcn_mfma_f32_32x32x16_bf16(a, b, c, 0, 0, 0); }
__device__ __forceinline__ bf16x8 pack8(float a0, float a1, float a2, float a3, float a4, float a5, float a6, float a7) {
    union { uint4 u; bf16x8 v; } x; x.u.x = pk2(a0, a1); x.u.y = pk2(a2, a3); x.u.z = pk2(a4, a5); x.u.w = pk2(a6, a7); return x.v;
}
__device__ __forceinline__ f32x16 zero16() { f32x16 z; for (int i = 0; i < 16; ++i) z[i] = 0.f; return z; }


__device__ __forceinline__ void st_bf4(bf16_t* dst, f32x4 v) { uint2 w; w.x = pk2(v[0], v[1]); w.y = pk2(v[2], v[3]); *(uint2*)dst = w; }

struct EpiIn {
    static constexpr bool PERM = false, AFTER_DRAIN = false;
    P p; int row0; int pad_;
    __device__ __forceinline__ void operator()(const f32x4 (&acc)[2][2][4][2], const Unit& u, int wr, int wc, int fr, int fq) const {
        const int pn = u.pn;
#pragma unroll
        for (int ai = 0; ai < 2; ++ai)
#pragma unroll
            for (int m = 0; m < 4; ++m) {
                const int row = row0 + u.pm * 256 + ai * 128 + wr * 64 + m * 16 + fr;
                if (pn < 5) {
                    const int pi = row < NP ? (row & (SEQ - 1)) : 4096 + ((row - NP) & 7);
                    const int d0 = 16 * (wc & 1) + 4 * fq;
                    const f32x4 cs = *(const f32x4*)(p.tabc() + pi * 32 + d0), sn = *(const f32x4*)(p.tabs() + pi * 32 + d0);
#pragma unroll
                    for (int bj = 0; bj < 2; ++bj) {
                        const f32x4 x1 = acc[ai][bj][m][0], x2 = acc[ai][bj][m][1];
                        if (pn < 2) {
                            const int head = pn * 4 + bj * 2 + (wc >> 1);
                            const f32x4 o1 = (x1 * cs - x2 * sn) * 0.125f, o2 = (x2 * cs + x1 * sn) * 0.125f;
                            bf16_t* q = p.qb() + (size_t)row * 512 + head * 64 + d0;
                            st_bf4(q, o1); st_bf4(q + 32, o2);
                        } else {
                            const int br = pn - 2, g = wc >> 1;
                            f32x4 o1, o2;
                            if (bj == 0) { o1 = x1 * cs - x2 * sn; o2 = x2 * cs + x1 * sn; } else { o1 = x1; o2 = x2; }
                            float* dst = nullptr;
                            if (row < NP) {
                                if (br == 0) dst = p.out + O_CMP_P + (size_t)row * 256;
                                else if (br == 1) dst = p.out + O_SEL_P + (size_t)row * 256;
                                else { const int s = row & (SEQ - 1); if (s >= SEQ - 512) dst = p.out + O_WIN_P + ((size_t)(row >> 12) * 512 + (s - (SEQ - 512))) * 256; }
                            } else {
                                const int rs = row - NP;
                                if (br == 0) dst = p.out + O_CMP_S + (size_t)rs * 256;
                                else if (br == 1) dst = p.out + O_SEL_S + (size_t)rs * 256;
                                else dst = p.out + O_WIN_S + ((size_t)(rs >> 3) * 512 + 504 + (rs & 7)) * 256;
                            }
                            if (dst) { dst += bj * 128 + g * 64 + d0; *(f32x4*)dst = o1; *(f32x4*)(dst + 32) = o2; }
                            if (row < NP) {
                                const int b = row >> 12, s = row & (SEQ - 1);
                                if (bj == 0) {
                                    bf16_t* k = p.kb() + ((size_t)((br * NB + b) * 2 + g) * SEQ + s) * 64 + d0;
                                    st_bf4(k, o1); st_bf4(k + 32, o2);
                                } else if (br == 0) {
                                    bf16_t* v = p.vcr() + ((size_t)(b * 2 + g) * SEQ + s) * 64 + d0;
                                    st_bf4(v, o1); st_bf4(v + 32, o2);
                                } else {
                                    bf16_t* v = p.vT() + ((size_t)(((br - 1) * NB + b) * 2 + g) * 64 + d0) * SEQ + s;
#pragma unroll
                                    for (int e = 0; e < 4; ++e) { v[(size_t)e * SEQ] = f2bf(o1[e]); v[(size_t)(32 + e) * SEQ] = f2bf(o2[e]); }
                                }
                            }
                        }
                    }
                } else {
#pragma unroll
                    for (int bj = 0; bj < 2; ++bj)
#pragma unroll
                        for (int n = 0; n < 2; ++n) {
                            const int c = bj * 128 + wc * 32 + n * 16 + fq * 4;
                            const f32x4 v = acc[ai][bj][m][n];
                            if (pn < 7) {
                                f32x4 o; for (int e = 0; e < 4; ++e) o[e] = SILU(1, v[e]);
                                st_bf4(p.ag() + (size_t)row * 512 + (pn - 5) * 256 + c, o);
                            } else if (pn < 13) {
                                st_bf4(p.rz() + (size_t)row * CR + (pn - 7) * 256 + c, v);
                            } else if (pn == 13) {
                                if (c < 128) st_bf4(p.rz() + (size_t)row * CR + 1536 + c, v);
                                else if (c < 152) { f32x4 o; for (int e = 0; e < 4; ++e) o[e] = SIG(1, v[e]); *(f32x4*)(p.gates() + (size_t)row * 32 + (c - 128)) = o; }
                            } else if (pn < 16) {
                                f32x4 o; for (int e = 0; e < 4; ++e) o[e] = SILU(1, v[e]);
                                st_bf4(p.rg() + (size_t)row * 512 + (pn - 14) * 256 + c, o);
                            } else {
                                f32x4 o; for (int e = 0; e < 4; ++e) o[e] = SIG(1, v[e]);
                                st_bf4(p.mg() + (size_t)row * 2048 + (pn - 16) * 256 + c, o);
                            }
                        }
                }
            }
    }
};

struct EpiPlain {
    static constexpr bool PERM = false, AFTER_DRAIN = false;
    float* C; int ldc; int pad_;
    __device__ __forceinline__ void quad(int row, int c, f32x4 v) const { *(f32x4*)(C + (size_t)row * ldc + c) = v; }
    __device__ __forceinline__ void operator()(const f32x4 (&acc)[2][2][4][2], const Unit& u, int wr, int wc, int fr, int fq) const {
#pragma unroll
        for (int ai = 0; ai < 2; ++ai)
#pragma unroll
            for (int m = 0; m < 4; ++m) {
                float* rowp = C + (size_t)(u.pm * 256 + ai * 128 + wr * 64 + m * 16 + fr) * ldc + u.pn * 256 + wc * 32 + 4 * fq;
#pragma unroll
                for (int bj = 0; bj < 2; ++bj)
#pragma unroll
                    for (int n = 0; n < 2; ++n) *(f32x4*)(rowp + bj * 128 + n * 16) = acc[ai][bj][m][n];
            }
    }
};


struct EpiPlainBf {
    static constexpr bool PERM = false, AFTER_DRAIN = false;
    bf16_t* C; int ldc; int pad_;
    __device__ __forceinline__ void operator()(const f32x4 (&acc)[2][2][4][2], const Unit& u, int wr, int wc, int fr, int fq) const {
#pragma unroll
        for (int ai = 0; ai < 2; ++ai)
#pragma unroll
            for (int m = 0; m < 4; ++m) {
                bf16_t* rowp = C + (size_t)(u.pm * 256 + ai * 128 + wr * 64 + m * 16 + fr) * ldc + u.pn * 256 + wc * 32 + 4 * fq;
#pragma unroll
                for (int bj = 0; bj < 2; ++bj)
#pragma unroll
                    for (int n = 0; n < 2; ++n) st_bf4(rowp + bj * 128 + n * 16, acc[ai][bj][m][n]);
            }
    }
};

struct EpiYa {
    static constexpr bool PERM = false, AFTER_DRAIN = false;
    P p;
    __device__ __forceinline__ void quad(int row, int c, f32x4 v) const {
        const uint2 gw = *(const uint2*)(p.mg() + (size_t)row * 2048 + c);
        f32x4 g; g[0] = __uint_as_float(gw.x << 16); g[1] = __uint_as_float(gw.x & 0xffff0000u); g[2] = __uint_as_float(gw.y << 16); g[3] = __uint_as_float(gw.y & 0xffff0000u);
        *(f32x4*)(p.tmp() + (size_t)row * DM + c) = g * v;
    }
    __device__ __forceinline__ void operator()(const f32x4 (&acc)[2][2][4][2], const Unit& u, int wr, int wc, int fr, int fq) const {
#pragma unroll
        for (int ai = 0; ai < 2; ++ai)
#pragma unroll
            for (int m = 0; m < 4; ++m) {
                const int row = u.pm * 256 + ai * 128 + wr * 64 + m * 16 + fr;
#pragma unroll
                for (int bj = 0; bj < 2; ++bj)
#pragma unroll
                    for (int n = 0; n < 2; ++n) {
                        const int c = u.pn * 256 + bj * 128 + wc * 32 + n * 16 + fq * 4;
                        const uint2 gw = *(const uint2*)(p.mg() + (size_t)row * 2048 + c);
                        f32x4 g; g[0] = __uint_as_float(gw.x << 16); g[1] = __uint_as_float(gw.x & 0xffff0000u); g[2] = __uint_as_float(gw.y << 16); g[3] = __uint_as_float(gw.y & 0xffff0000u);
                        *(f32x4*)(p.tmp() + (size_t)row * DM + c) = g * acc[ai][bj][m][n];
                    }
            }
    }
};
struct EpiYb {
    static constexpr bool PERM = false, AFTER_DRAIN = false;
    P p;
    __device__ __forceinline__ void quad(int row, int c, f32x4 v) const {
        const uint2 gw = *(const uint2*)(p.mg() + (size_t)row * 2048 + 1024 + c);
        f32x4 g; g[0] = __uint_as_float(gw.x << 16); g[1] = __uint_as_float(gw.x & 0xffff0000u); g[2] = __uint_as_float(gw.y << 16); g[3] = __uint_as_float(gw.y & 0xffff0000u);
        st_bf4(p.mb() + (size_t)row * DM + c, *(const f32x4*)(p.tmp() + (size_t)row * DM + c) + g * v);
    }
    __device__ __forceinline__ void operator()(const f32x4 (&acc)[2][2][4][2], const Unit& u, int wr, int wc, int fr, int fq) const {
#pragma unroll
        for (int ai = 0; ai < 2; ++ai)
#pragma unroll
            for (int m = 0; m < 4; ++m) {
                const int row = u.pm * 256 + ai * 128 + wr * 64 + m * 16 + fr;
#pragma unroll
                for (int bj = 0; bj < 2; ++bj)
#pragma unroll
                    for (int n = 0; n < 2; ++n) {
                        const int c = u.pn * 256 + bj * 128 + wc * 32 + n * 16 + fq * 4;
                        const uint2 gw = *(const uint2*)(p.mg() + (size_t)row * 2048 + 1024 + c);
                        f32x4 g; g[0] = __uint_as_float(gw.x << 16); g[1] = __uint_as_float(gw.x & 0xffff0000u); g[2] = __uint_as_float(gw.y << 16); g[3] = __uint_as_float(gw.y & 0xffff0000u);
                        const f32x4 t = *(const f32x4*)(p.tmp() + (size_t)row * DM + c);
                        st_bf4(p.mb() + (size_t)row * DM + c, t + g * acc[ai][bj][m][n]);
                    }
            }
    }
};
struct EpiOut {
    static constexpr bool PERM = false, AFTER_DRAIN = false;
    P p;
    __device__ __forceinline__ void quad(int row, int c, f32x4 a) const {
        const float* xr = p.x_sample + (size_t)(row - NP) * DM;
        const f32x4 v = *(const f32x4*)(xr + c) + a;
        *(f32x4*)(p.x1() + (size_t)row * DM + c) = v;
        st_bf4(p.xg() + (size_t)row * DM + c, v * *(const f32x4*)(p.ple_g + c));
        atomicAdd(p.ss_s() + (row - NP), v[0] * v[0] + v[1] * v[1] + v[2] * v[2] + v[3] * v[3]);
    }
    __device__ __forceinline__ void operator()(const f32x4 (&acc)[2][2][4][2], const Unit& u, int wr, int wc, int fr, int fq) const {
#pragma unroll
        for (int ai = 0; ai < 2; ++ai)
#pragma unroll
            for (int m = 0; m < 4; ++m) {
                const int row = u.pm * 256 + ai * 128 + wr * 64 + m * 16 + fr;
                const float* xr = row < NP ? p.x_prompt + (size_t)row * DM : p.x_sample + (size_t)(row - NP) * DM;
                float ss = 0.f;
#pragma unroll
                for (int bj = 0; bj < 2; ++bj)
#pragma unroll
                    for (int n = 0; n < 2; ++n) {
                        const int c = u.pn * 256 + bj * 128 + wc * 32 + n * 16 + fq * 4;
                        const f32x4 v = *(const f32x4*)(xr + c) + acc[ai][bj][m][n];
                        *(f32x4*)(p.x1() + (size_t)row * DM + c) = v;
                        ss += v[0] * v[0] + v[1] * v[1] + v[2] * v[2] + v[3] * v[3];
                        st_bf4(p.xg() + (size_t)row * DM + c, v * *(const f32x4*)(p.ple_g + c));
                    }
                ss += __shfl_xor(ss, 16); ss += __shfl_xor(ss, 32);
                if (fq == 0) p.ss1()[(size_t)row * 16 + u.pn * 4 + wc] = ss;
            }
    }
};
struct EpiGate {
    static constexpr bool PERM = false, AFTER_DRAIN = false;
    P p;
    __device__ __forceinline__ void quad(int row, int c, f32x4 acc) const {
        const float rstd = rsqrtf(p.ss_s()[row - NP] * (1.0f / DM) + 1e-6f);
        const f32x4 a = acc * rstd;
        f32x4 g; for (int e = 0; e < 4; ++e) g[e] = SIG(8, a[e]);
        float* ppp = p.pp() + (size_t)row * DM + c;
        *(f32x4*)ppp = *(const f32x4*)(p.x1() + (size_t)row * DM + c) + g * *(const f32x4*)ppp;
    }
    __device__ __forceinline__ void operator()(const f32x4 (&acc)[2][2][4][2], const Unit& u, int wr, int wc, int fr, int fq) const {
#pragma unroll
        for (int ai = 0; ai < 2; ++ai)
#pragma unroll
            for (int m = 0; m < 4; ++m) {
                const int row = u.pm * 256 + ai * 128 + wr * 64 + m * 16 + fr;
                float ss = 0.f;
#pragma unroll
                for (int i = 0; i < 4; ++i) { const f32x4 t = *(const f32x4*)(p.ss1() + (size_t)row * 16 + i * 4); ss += (t[0] + t[1]) + (t[2] + t[3]); }
                const float rstd = rsqrtf(ss * (1.0f / DM) + 1e-6f);
#pragma unroll
                for (int bj = 0; bj < 2; ++bj)
#pragma unroll
                    for (int n = 0; n < 2; ++n) {
                        const int c = u.pn * 256 + bj * 128 + wc * 32 + n * 16 + fq * 4;
                        const f32x4 a = acc[ai][bj][m][n] * rstd;
                        f32x4 g; for (int e = 0; e < 4; ++e) g[e] = SIG(8, a[e]);
                        float* ppp = p.pp() + (size_t)row * DM + c;
                        *(f32x4*)ppp = *(const f32x4*)(p.x1() + (size_t)row * DM + c) + g * *(const f32x4*)ppp;
                    }
            }
    }
};

__device__ __forceinline__ void ph_final(const P& p) {
    const int tid = threadIdx.x, lane = tid & 63, wid = tid >> 6;
    for (int row = blockIdx.x * 8 + wid; row < MR; row += gridDim.x * 8) {
        const float4* src = (const float4*)(p.pp() + (size_t)row * DM);
        float4 v[4]; float ss = 0.f;
#pragma unroll
        for (int i = 0; i < 4; ++i) { v[i] = src[lane + 64 * i]; ss += v[i].x * v[i].x + v[i].y * v[i].y + v[i].z * v[i].z + v[i].w * v[i].w; }
        ss = wave_sum(ss);
        const float rstd = rsqrtf(ss * (1.0f / DM) + 1e-6f);
        float4* dst = (float4*)(p.out + (row < NP ? O_Y_P + (size_t)row * DM : O_Y_S + (size_t)(row - NP) * DM));
#if defined(DBG_CMPALL)
        float dbgs = 1.0f; if (row >= NP) dbgs = 1.0f + (float)p.bar()[3840] * (1.0f / DBG_DIV);
#define DBGS * dbgs
#else
#define DBGS
#endif
#pragma unroll
        for (int i = 0; i < 4; ++i) {
            const float4 g = ((const float4*)p.final_g)[lane + 64 * i];
            float4 o; o.x = v[i].x * rstd * g.x DBGS; o.y = v[i].y * rstd * g.y DBGS; o.z = v[i].z * rstd * g.z DBGS; o.w = v[i].w * rstd * g.w DBGS;
            dst[lane + 64 * i] = o;
        }
    }
}

typedef float f32x4v __attribute__((ext_vector_type(4)));
template <class Epi> __device__ __forceinline__ void small_gemm(const bf16_t* A, const bf16_t* Bt, int K, const Epi& E) {
    const int tid = threadIdx.x, lane = tid & 63, wid = tid >> 6, r16 = lane & 15, q4 = lane >> 4;
    for (int tile = blockIdx.x * 8 + wid; tile < 16 * 64; tile += gridDim.x * 8) {
        const int rt = tile & 15, ct = tile >> 4;
        const bf16_t* ap = A + (size_t)(NP + rt * 16 + r16) * K + 8 * q4;
        const bf16_t* bp = Bt + (size_t)(ct * 16 + r16) * K + 8 * q4;
        f32x4 acc = {0.f, 0.f, 0.f, 0.f};
#pragma unroll 1
        for (int k0 = 0; k0 < K; k0 += 256) {
            bf16x8 af[8], bf[8];
#pragma unroll
            for (int i = 0; i < 8; ++i) { af[i] = *(const bf16x8*)(ap + k0 + 32 * i); bf[i] = *(const bf16x8*)(bp + k0 + 32 * i); }
#pragma unroll
            for (int i = 0; i < 8; ++i) acc = __builtin_amdgcn_mfma_f32_16x16x32_bf16(bf[i], af[i], acc, 0, 0, 0);
        }
        E.quad(NP + rt * 16 + r16, ct * 16 + 4 * q4, acc);
    }
}
#ifndef DBG_PERTURB
#define DBG_PERTURB
#endif

__device__ __forceinline__ f32x4 ld_bf4c(const bf16_t* q) { const uint2 w = *(const uint2*)q; f32x4 v; v[0] = __uint_as_float(w.x << 16); v[1] = __uint_as_float(w.x & 0xffff0000u); v[2] = __uint_as_float(w.y << 16); v[3] = __uint_as_float(w.y & 0xffff0000u); return v; }
__device__ __forceinline__ void ph_compress2(const P& p, const bf16_t* LH, int nbg, int nrows, int nblk, bf16_t* kc, bf16_t* vcT) {
    const int tid = threadIdx.x, lane = tid & 63, wid = tid >> 6, col = lane & 31, hb = lane >> 5;
    const int ntile = nrows >> 5, total = 2 * nbg * ntile;
    for (int it = blockIdx.x * 8 + wid; it < total; it += gridDim.x * 8) {
        const int tile = it % ntile, bg = (it / ntile) % nbg, kvi = it / (ntile * nbg);
        const int i = tile * 32 + col;
        const bool live = i < nblk;
        const bf16_t* l0 = LH + ((size_t)kvi * nbg * nrows + (size_t)bg * nrows + (live ? i : 0)) * 256;
        const float* ptp = p.pt() + kvi * 128;
        const bf16_t* w2t = p.W2T() + (size_t)kvi * 64 * 128;
        f32x16 acc[2]; acc[0] = zero16(); acc[1] = zero16();
#pragma unroll
        for (int ks = 0; ks < 8; ++ks) {
            const int f = 16 * ks + 8 * hb;
            float hv[8];
#pragma unroll
            for (int q = 0; q < 2; ++q) {
                const f32x4 lo = ld_bf4c(l0 + f + 4 * q), hi = ld_bf4c(l0 + 256 + 128 + f + 4 * q), pv = *(const f32x4*)(ptp + f + 4 * q);
#pragma unroll
                for (int e = 0; e < 4; ++e) hv[4 * q + e] = SILU(2, lo[e] + hi[e] + pv[e]) DBG_PERTURB;
            }
            const bf16x8 hf = pack8(hv[0], hv[1], hv[2], hv[3], hv[4], hv[5], hv[6], hv[7]);
#pragma unroll
            for (int dt = 0; dt < 2; ++dt) {
                const bf16x8 wf = *(const bf16x8*)(w2t + (size_t)(32 * dt + col) * 128 + f);
                acc[dt] = (kvi == 0) ? mfma32(wf, hf, acc[dt]) : mfma32(hf, wf, acc[dt]);
            }
        }
        if (kvi == 0) {
            bf16_t* dst = kc + ((size_t)bg * nrows + i) * 64;
#pragma unroll
            for (int dt = 0; dt < 2; ++dt)
#pragma unroll
                for (int i4 = 0; i4 < 4; ++i4) {
                    const int d = 32 * dt + 8 * i4 + 4 * hb;
                    const f32x4 b2 = *(const f32x4*)(p.cmp_b2 + d);
                    f32x4 v; for (int e = 0; e < 4; ++e) v[e] = live ? acc[dt][4 * i4 + e] + b2[e] : 0.f;
                    st_bf4(dst + d, v);
                }
        } else {
#pragma unroll
            for (int dt = 0; dt < 2; ++dt) {
                const int d = 32 * dt + col;
                const float b2 = p.cmp_b2[64 + d];
                bf16_t* dst = vcT + ((size_t)bg * 64 + d) * nrows + tile * 32;
#pragma unroll
                for (int i4 = 0; i4 < 4; ++i4) {
                    const int r = 8 * i4 + 4 * hb;
                    f32x4 v; for (int e = 0; e < 4; ++e) v[e] = (tile * 32 + r + e) < nblk ? acc[dt][4 * i4 + e] + b2 : 0.f;
                    st_bf4(dst + r, v);
                }
            }
        }
    }
}

__device__ __forceinline__ void ph_cvt_cache(const P& p) {
    const size_t total = (size_t)2 * DB * 2 * PAST * 8;
    for (size_t id = (size_t)blockIdx.x * NTHR + threadIdx.x; id < total; id += (size_t)gridDim.x * NTHR) {
        const int d8 = (int)(id & 7), tok = (int)((id >> 3) & (PAST - 1)), g = (int)((id >> 17) & 1), b = (int)((id >> 18) & 31), kvi = (int)(id >> 23);
        const int page = p.page_table[b * 128 + (tok >> 7)];
        const float4* src = (const float4*)(p.cache_cmp + ((size_t)page * 128 + (tok & 127)) * 256 + kvi * 128 + g * 64 + d8 * 8);
        const float4 a = src[0], c = src[1];
        uint4 w; w.x = pk2(a.x, a.y); w.y = pk2(a.z, a.w); w.z = pk2(c.x, c.y); w.w = pk2(c.z, c.w);
        *(uint4*)(p.cs() + id * 8) = w;
    }
}

#if defined(OLD_RWKV_PREP)
__device__ __forceinline__ void ph_rwkv_prep(const P& p) {
    const int tid = threadIdx.x, lane = tid & 63, wid = tid >> 6;
    for (int it = blockIdx.x * 8 + wid; it < MR * 8; it += gridDim.x * 8) {
        const int row = it >> 3, h = it & 7, c = h * 64 + lane;
        const float* z = p.rz() + (size_t)row * CR;
        const float* pv;
        bool zero_prev = false;
        if (row < NP) { if ((row & (SEQ - 1)) == 0) { zero_prev = true; pv = z; } else pv = z - CR; }
        else { const int rs = row - NP; if ((rs & 7) == 0) pv = p.state_shift + (size_t)(rs >> 3) * CR; else pv = z - CR; }
        auto lerp = [&](int col) { const float zz = z[col]; const float pr = zero_prev ? 0.f : pv[col]; return zz + (pr - zz) * p.mu[col]; };
        const float zr = lerp(c), zk = lerp(512 + c), zv = lerp(1024 + c), zwd = lerp(1536 + lane), zad = lerp(1600 + lane);
        const float th = tanhf(zwd);
        float accw = p.w0[c], acca = p.a0[c];
#pragma unroll 8
        for (int j = 0; j < 64; ++j) {
            const float tj = __shfl(th, j), aj = __shfl(zad, j);
            accw += tj * p.w_up[j * 512 + c]; acca += aj * p.a_up[j * 512 + c];
        }
        const float nx = -accw;
        const float sp = fmaxf(nx, 0.f) + log1pf(__expf(-fabsf(nx)));
        const float w = -sp - 0.5f;
        const float dec = __expf(-__expf(w));
        const float a = sigmoidf_(acca);
        const float kkr = zk * p.k_k[c];
        const float nrm = sqrtf(wave_sum(kkr * kkr));
        const float kk = kkr / fmaxf(nrm, 1e-12f);
        const float km = zk * (1.0f + (a - 1.0f) * p.k_a[c]);
        const float bon = wave_sum(zr * km * p.r_k[c]);
        float* o = p.rw6() + (size_t)it * 384 + lane;
        o[0] = zr; o[64] = dec; o[128] = km; o[192] = zv; o[256] = kk; o[320] = kk * a;
        if (lane == 0) p.bonus()[it] = bon;
        if (h == 0) {
            float* so = nullptr;
            if (row < NP) { if ((row & (SEQ - 1)) == SEQ - 1) so = p.out + O_SH_P + (size_t)(row >> 12) * CR; }
            else { const int rs = row - NP; if ((rs & 7) == 7) so = p.out + O_SH_S + (size_t)(rs >> 3) * CR; }
            if (so) for (int i = lane; i < CR; i += 64) so[i] = z[i];
        }
    }
}

#else
__device__ __forceinline__ float dpp_row_sum16(float v) {
    v += __builtin_bit_cast(float, __builtin_amdgcn_mov_dpp(__builtin_bit_cast(int, v), 0xB1, 0xF, 0xF, true));
    v += __builtin_bit_cast(float, __builtin_amdgcn_mov_dpp(__builtin_bit_cast(int, v), 0x4E, 0xF, 0xF, true));
    v += __builtin_bit_cast(float, __builtin_amdgcn_mov_dpp(__builtin_bit_cast(int, v), 0x141, 0xF, 0xF, true));
    v += __builtin_bit_cast(float, __builtin_amdgcn_mov_dpp(__builtin_bit_cast(int, v), 0x140, 0xF, 0xF, true));
    return v;
}
__device__ __forceinline__ float half_sum32(float v) { v = dpp_row_sum16(v); return v + __shfl_xor(v, 16); }
__device__ __forceinline__ const bf16_t* rwkv_prev_row(const P& p, int row) {
    if (row < NP) return (row & (SEQ - 1)) == 0 ? p.zs0() : p.rz() + (size_t)(row - 1) * CR;
    const int rs = row - NP;
    return (rs & 7) == 0 ? p.zs0() + (size_t)(1 + (rs >> 3)) * CR : p.rz() + (size_t)(row - 1) * CR;
}
__device__ __forceinline__ f32x4 ld_bf4(const bf16_t* q) { const uint2 w = *(const uint2*)q; f32x4 v; v[0] = __uint_as_float(w.x << 16); v[1] = __uint_as_float(w.x & 0xffff0000u); v[2] = __uint_as_float(w.y << 16); v[3] = __uint_as_float(w.y & 0xffff0000u); return v; }
__device__ __forceinline__ void ph_rwkv_prep(const P& p) {
    const int tid = threadIdx.x, lane = tid & 63, wid = tid >> 6, col = lane & 31, hb = lane >> 5;
    const int gw = blockIdx.x * 8 + wid, nw = gridDim.x * 8;
    for (int it = gw; it < NB + DB; it += nw) {
        const int row = it < NB ? it * SEQ + SEQ - 1 : NP + (it - NB) * 8 + 7;
        float* so = it < NB ? p.out + O_SH_P + (size_t)it * CR : p.out + O_SH_S + (size_t)(it - NB) * CR;
        const bf16_t* z = p.rz() + (size_t)row * CR;
        for (int i = lane; i < CR; i += 64) so[i] = bf2f(z[i]);
    }
    for (int it = gw; it < (MR / 32) * 8; it += nw) {
        const int h = it & 7, r0 = (it >> 3) * 32;
        bf16x8 Aw[4], Aa[4];
        {
            const int row = r0 + col;
            const bf16_t* z = p.rz() + (size_t)row * CR;
            const bf16_t* pv = rwkv_prev_row(p, row);
#pragma unroll
            for (int ks = 0; ks < 4; ++ks) {
                const int j0 = 16 * ks + 8 * hb;
                float tw[8], ta[8];
#pragma unroll
                for (int q = 0; q < 2; ++q) {
                    const f32x4 zw = ld_bf4(z + 1536 + j0 + 4 * q), za = ld_bf4(z + 1600 + j0 + 4 * q);
                    const f32x4 pw = ld_bf4(pv + 1536 + j0 + 4 * q), pa = ld_bf4(pv + 1600 + j0 + 4 * q);
                    const f32x4 mw = *(const f32x4*)(p.mu + 1536 + j0 + 4 * q), ma = *(const f32x4*)(p.mu + 1600 + j0 + 4 * q);
#pragma unroll
                    for (int e = 0; e < 4; ++e) { tw[4 * q + e] = tanhf(zw[e] + (pw[e] - zw[e]) * mw[e]); ta[4 * q + e] = za[e] + (pa[e] - za[e]) * ma[e]; }
                }
                Aw[ks] = pack8(tw[0], tw[1], tw[2], tw[3], tw[4], tw[5], tw[6], tw[7]);
                Aa[ks] = pack8(ta[0], ta[1], ta[2], ta[3], ta[4], ta[5], ta[6], ta[7]);
            }
        }
        f32x16 accw[2], acca[2];
#pragma unroll
        for (int ct = 0; ct < 2; ++ct) {
            accw[ct] = zero16(); acca[ct] = zero16();
            const size_t wo = (size_t)(h * 64 + 32 * ct + col) * 64 + 8 * hb;
#pragma unroll
            for (int ks = 0; ks < 4; ++ks) {
                accw[ct] = mfma32(Aw[ks], *(const bf16x8*)(p.WupT() + wo + 16 * ks), accw[ct]);
                acca[ct] = mfma32(Aa[ks], *(const bf16x8*)(p.AupT() + wo + 16 * ks), acca[ct]);
            }
        }
        float w0v[2], a0v[2], kkv[2], kav[2], rkv[2], mur[2], muk[2], muv[2];
#pragma unroll
        for (int ct = 0; ct < 2; ++ct) {
            const int c = h * 64 + 32 * ct + col;
            w0v[ct] = p.w0[c]; a0v[ct] = p.a0[c]; kkv[ct] = p.k_k[c]; kav[ct] = p.k_a[c]; rkv[ct] = p.r_k[c];
            mur[ct] = p.mu[c]; muk[ct] = p.mu[512 + c]; muv[ct] = p.mu[1024 + c];
        }
#pragma unroll
        for (int i = 0; i < 16; ++i) {
            const int row = r0 + (i & 3) + 8 * (i >> 2) + 4 * hb;
            const bf16_t* z = p.rz() + (size_t)row * CR;
            const bf16_t* pv = rwkv_prev_row(p, row);
            float zr[2], zk[2], zv[2], dec[2], av[2], kkr[2], km[2];
            float n2 = 0.f, bon = 0.f;
#pragma unroll
            for (int ct = 0; ct < 2; ++ct) {
                const int c = h * 64 + 32 * ct + col;
                const float z0 = bf2f(z[c]), z1 = bf2f(z[512 + c]), z2 = bf2f(z[1024 + c]);
                const float p0 = bf2f(pv[c]), p1 = bf2f(pv[512 + c]), p2 = bf2f(pv[1024 + c]);
                zr[ct] = z0 + (p0 - z0) * mur[ct]; zk[ct] = z1 + (p1 - z1) * muk[ct]; zv[ct] = z2 + (p2 - z2) * muv[ct];
                const float nx = -(w0v[ct] + accw[ct][i]);
                const float sp = fmaxf(nx, 0.f) + log1pf(__expf(-fabsf(nx)));
                dec[ct] = __expf(-__expf(-sp - 0.5f));
                av[ct] = SIG(4, a0v[ct] + acca[ct][i]);
                kkr[ct] = zk[ct] * kkv[ct];
                km[ct] = zk[ct] * (1.0f + (av[ct] - 1.0f) * kav[ct]);
                n2 += kkr[ct] * kkr[ct];
                bon += zr[ct] * km[ct] * rkv[ct];
            }
            n2 = half_sum32(n2); bon = half_sum32(bon);
            const float rn = 1.0f / fmaxf(sqrtf(n2), 1e-12f);
            unsigned char* o = p.rw6() + ((size_t)row * 8 + h) * RW6_STRIDE;
#pragma unroll
            for (int ct = 0; ct < 2; ++ct) {
                const float kk = kkr[ct] * rn;
                const int cl = 32 * ct + col;
                ((float*)o)[cl] = dec[ct];
                bf16_t* ob = (bf16_t*)(o + 256) + cl;
                ob[0] = f2bf(zr[ct]); ob[64] = f2bf(km[ct]); ob[128] = f2bf(zv[ct]); ob[192] = f2bf(kk); ob[256] = f2bf(kk * av[ct]);
            }
            if (col == 0) p.bonus()[(size_t)row * 8 + h] = bon;
        }
    }
}

#endif
typedef float f32x2 __attribute__((ext_vector_type(2)));
__device__ __forceinline__ float dpp_row_sum(float v) {
    v += __builtin_bit_cast(float, __builtin_amdgcn_mov_dpp(__builtin_bit_cast(int, v), 0xB1, 0xF, 0xF, true));
    v += __builtin_bit_cast(float, __builtin_amdgcn_mov_dpp(__builtin_bit_cast(int, v), 0x4E, 0xF, 0xF, true));
    v += __builtin_bit_cast(float, __builtin_amdgcn_mov_dpp(__builtin_bit_cast(int, v), 0x141, 0xF, 0xF, true));
    v += __builtin_bit_cast(float, __builtin_amdgcn_mov_dpp(__builtin_bit_cast(int, v), 0x140, 0xF, 0xF, true));
    return v;
}
constexpr int SCAN_TC = 32;
template <int NROWS>
__device__ __forceinline__ void scan_item(const P& p, LAS float* lds, int row0, int T, int h, int half, const float* s0, float* sout) {
    const int tid = threadIdx.x, w = tid >> 6, lane = tid & 63, rl = lane >> 4, kq = lane & 15;
    const bool act = w * 4 < NROWS;
    const int vrow = half * NROWS + (act ? w * 4 : 0) + rl;
    f32x4 S;
    if (s0) S = *(const f32x4*)(s0 + vrow * 64 + kq * 4); else { S[0] = 0.f; S[1] = 0.f; S[2] = 0.f; S[3] = 0.f; }
    const unsigned char* src = p.rw6() + ((size_t)row0 * 8 + h) * RW6_STRIDE;
    const int nchunk = (T + SCAN_TC - 1) / SCAN_TC;
    u32x4_t stg[4];
    int ss[4], sc[4], sl[4];
#pragma unroll
    for (int i = 0; i < 4; ++i) {
        const int idx = i * 512 + tid; ss[i] = idx / 56; sc[i] = idx % 56;
        const int cb = sc[i] - 16, q = cb >> 3;
        sl[i] = sc[i] < 16 ? 64 + 4 * sc[i] : (q == 0 ? 0 : 64 + 64 * q) + 8 * (cb & 7);
    }
    auto put = [&](LAS float* b, int i) {
        LAS float* d = b + ss[i] * 384 + sl[i];
        if (sc[i] < 16) *(LAS u32x4_t*)d = stg[i];
        else {
            f32x4 lo, hi;
            lo[0] = __uint_as_float(stg[i][0] << 16); lo[1] = __uint_as_float(stg[i][0] & 0xffff0000u); lo[2] = __uint_as_float(stg[i][1] << 16); lo[3] = __uint_as_float(stg[i][1] & 0xffff0000u);
            hi[0] = __uint_as_float(stg[i][2] << 16); hi[1] = __uint_as_float(stg[i][2] & 0xffff0000u); hi[2] = __uint_as_float(stg[i][3] << 16); hi[3] = __uint_as_float(stg[i][3] & 0xffff0000u);
            *(LAS f32x4*)d = lo; *(LAS f32x4*)(d + 4) = hi;
        }
    };
    {
        const int ns = T < SCAN_TC ? T : SCAN_TC;
#pragma unroll
        for (int i = 0; i < 4; ++i) if (ss[i] < ns) { stg[i] = *(const u32x4_t*)(src + (size_t)ss[i] * (8 * RW6_STRIDE) + sc[i] * 16); put(lds, i); }
    }
    __syncthreads();
    for (int c = 0; c < nchunk; ++c) {
        const int t0 = c * SCAN_TC;
        const int ns = (T - t0) < SCAN_TC ? (T - t0) : SCAN_TC;
        const bool more = (c + 1) < nchunk;
        const int nns = more ? ((T - t0 - SCAN_TC) < SCAN_TC ? (T - t0 - SCAN_TC) : SCAN_TC) : 0;
        if (more) {
#pragma unroll
            for (int i = 0; i < 4; ++i) if (ss[i] < nns) stg[i] = *(const u32x4_t*)(src + (size_t)(t0 + SCAN_TC + ss[i]) * (8 * RW6_STRIDE) + sc[i] * 16);
        }
        LAS const float* buf = lds + (c & 1) * (SCAN_TC * 384);
        float* yo = p.ybuf() + (size_t)(row0 + t0) * 512 + h * 64 + vrow;
        if (act)
#pragma unroll 4
        for (int s = 0; s < ns; ++s) {
            LAS const float* bs = buf + s * 384 + kq * 4;
            const f32x4 r = *(LAS const f32x4*)(bs), d = *(LAS const f32x4*)(bs + 64), km = *(LAS const f32x4*)(bs + 128),
                        kk = *(LAS const f32x4*)(bs + 256), ka = *(LAS const f32x4*)(bs + 320);
            const float vv = buf[s * 384 + 192 + vrow];
            const f32x4 t1 = S * kk;
            float sa = dpp_row_sum((t1[0] + t1[1]) + (t1[2] + t1[3]));
            sa = -sa;
            S = S * d + ka * sa + km * vv;
            const f32x4 t2 = S * r;
            const float y = dpp_row_sum((t2[0] + t2[1]) + (t2[2] + t2[3]));
            if (kq == 0) yo[(size_t)s * 512] = y;
        }
        if (more) {
            LAS float* nb = lds + ((c + 1) & 1) * (SCAN_TC * 384);
#pragma unroll
            for (int i = 0; i < 4; ++i) if (ss[i] < nns) put(nb, i);
        }
        __syncthreads();
    }
    if (act) *(f32x4*)(sout + vrow * 64 + kq * 4) = S;
}
constexpr int NSCAN = 128;
__device__ __forceinline__ void ph_rwkv_scan(const P& p, LAS float* lds) {
    if ((int)blockIdx.x < NSCAN) {
        const int item = blockIdx.x >> 2, part = blockIdx.x & 3;
        scan_item<16>(p, lds, (item >> 3) * SEQ, SEQ, item & 7, part, nullptr, p.out + O_WKV_P + (size_t)item * 4096);
    } else {
        const int nb = (int)gridDim.x - NSCAN;
        for (int hi = (int)blockIdx.x - NSCAN; hi < 512; hi += nb) {
            const int item = hi >> 1, half = hi & 1;
            scan_item<32>(p, lds, NP + (item >> 3) * 8, 8, item & 7, half, p.state_wkv + (size_t)item * 4096, p.out + O_WKV_S + (size_t)item * 4096);
        }
    }
}

__device__ __forceinline__ void ph_rwkv_post(const P& p) {
    const int tid = threadIdx.x, lane = tid & 63, wid = tid >> 6;
    for (int it = blockIdx.x * 8 + wid; it < MR * 8; it += gridDim.x * 8) {
        const int row = it >> 3, h = it & 7, c = h * 64 + lane;
        const float y = p.ybuf()[(size_t)row * 512 + c];
        const float mean = wave_sum(y) * (1.0f / 64.0f);
        const float dv = y - mean;
        const float var = wave_sum(dv * dv) * (1.0f / 64.0f);
        float yn = dv * rsqrtf(var + 64e-5f) * p.gn_g[c] + p.gn_b[c];
        yn += p.bonus()[it] * bf2f(((const bf16_t*)(p.rw6() + (size_t)it * RW6_STRIDE + 256))[128 + lane]);
        p.ob()[(size_t)row * 512 + c] = f2bf(yn * bf2f(p.rg()[(size_t)row * 512 + c]));
    }
}

__device__ __forceinline__ void ph_cmp_gemm_f32(const P& p, LAS unsigned char* lds) {
    using pg8::lds_byte;
    const int tid = threadIdx.x, wid = __builtin_amdgcn_readfirstlane(tid >> 6), lane = tid & 63, wr = wid >> 2, wc = wid & 3, fr = lane & 15, fq = lane >> 4;
    constexpr int HTB = 16384;
    const int arow_l = 4 * wid + (lane >> 4), acol = 4 * (lane & 15);
    const int swbase = lds_byte(arow_l, acol);
    LAS unsigned long long* rowoff = (LAS unsigned long long*)(lds + 131072);
    unsigned voffB[2];
#pragma unroll
    for (int i = 0; i < 2; ++i) { int R, C; pg8::stage_rc(tid * 16 + i * 8192, R, C); voffB[i] = (unsigned)(R * 1024 + C) * 2u; }
    const unsigned ldsw = (unsigned)wid * 1024u;
    const int aoff = lds_byte(wr * 64 + fr, fq * 8), boff = lds_byte(wc * 32 + fr, fq * 8);
    for (int unit = blockIdx.x; unit < 512; unit += gridDim.x) {
        const int kvi = unit >> 8, bg = (unit >> 2) & 63, c0 = (unit & 3) * 256, b = bg >> 1, g = bg & 1;
        __syncthreads();
        if (tid < 256) {
            const int chunk = c0 + tid;
            const int page = p.page_table[b * 128 + (chunk >> 3)];
            rowoff[tid] = ((unsigned long long)page * 128 + (chunk & 7) * 16) * 256 + kvi * 128 + g * 64;
        }
        const char* bbase = (const char*)(p.W1T() + (size_t)kvi * 256 * 1024);
        f32x4 acc[2][2][4][2];
#pragma unroll
        for (int a = 0; a < 2; ++a)
#pragma unroll
            for (int bb = 0; bb < 2; ++bb)
#pragma unroll
                for (int m = 0; m < 4; ++m)
#pragma unroll
                    for (int n = 0; n < 2; ++n) acc[a][bb][m][n] = (f32x4){0.f, 0.f, 0.f, 0.f};
        f32x4 ar[8];
        auto stage_b = [&](int st, int t) {
#pragma unroll
            for (int h = 0; h < 2; ++h)
#pragma unroll
                for (int i = 0; i < 2; ++i)
                    __builtin_amdgcn_global_load_lds((const unsigned*)(bbase + (size_t)h * 128 * 2048 + (size_t)t * 128 + voffB[i]),
                                                     (PG8_LAS unsigned*)(lds + st * 65536 + 32768 + h * HTB + ldsw + i * 8192), 16, 0, 0);
        };
        auto load_a = [&](int t) {
#pragma unroll
            for (int q = 0; q < 8; ++q) ar[q] = *(const f32x4*)(p.cache_cmp + rowoff[32 * q + arow_l] + (size_t)t * 256 + acol);
        };
        auto write_a = [&](int st) {
            LAS unsigned char* na = lds + st * 65536;
#pragma unroll
            for (int q = 0; q < 8; ++q) *(LAS u32x2*)(na + swbase + (q >> 2) * HTB + (q & 3) * 4096) = (u32x2){pk2(ar[q][0], ar[q][1]), pk2(ar[q][2], ar[q][3])};
        };
        __syncthreads();
        load_a(0);
        stage_b(0, 0);
        write_a(0);
        __syncthreads();
#pragma unroll 1
        for (int t = 0; t < 16; ++t) {
            const int cur = t & 1;
            if (t + 1 < 16) { load_a(t + 1); stage_b(cur ^ 1, t + 1); }
            LAS const unsigned char* sa = lds + cur * 65536;
            LAS const unsigned char* sb = sa + 32768;
#pragma unroll
            for (int ai = 0; ai < 2; ++ai)
#pragma unroll
                for (int bj = 0; bj < 2; ++bj) {
                    bf16x8 Bt[2][2];
#pragma unroll
                    for (int n = 0; n < 2; ++n)
#pragma unroll
                        for (int k = 0; k < 2; ++k) Bt[n][k] = *(LAS const bf16x8*)(sb + bj * HTB + boff + n * 2048 + k * 1024);
#pragma unroll
                    for (int m = 0; m < 4; ++m) {
                        const bf16x8 a0 = *(LAS const bf16x8*)(sa + ai * HTB + aoff + m * 2048), a1 = *(LAS const bf16x8*)(sa + ai * HTB + aoff + m * 2048 + 1024);
#pragma unroll
                        for (int n = 0; n < 2; ++n) {
                            acc[ai][bj][m][n] = __builtin_amdgcn_mfma_f32_16x16x32_bf16(Bt[n][0], a0, acc[ai][bj][m][n], 0, 0, 0);
                            acc[ai][bj][m][n] = __builtin_amdgcn_mfma_f32_16x16x32_bf16(Bt[n][1], a1, acc[ai][bj][m][n], 0, 0, 0);
                        }
                    }
                    __builtin_amdgcn_sched_barrier(0);
                }
            if (t + 1 < 16) write_a(cur ^ 1);
            __syncthreads();
        }
        EpiPlainBf e; e.C = p.LHs() + ((size_t)kvi * 65536 + (size_t)bg * 1024 + c0) * 256; e.ldc = 256; e.pad_ = 0;
        pg8::Unit u; u.pm = 0; u.pn = 0;
        e(acc, u, wr, wc, fr, fq);
    }
}
#ifndef NO_KEEP_OLD
#define KEEP_OLD_PATH 1
#endif
#ifndef SMODE
#define SMODE 3
#endif
#ifndef ATTN_MODE
#define ATTN_MODE 3
#endif

struct KSrcBf { const bf16_t* base; __device__ __forceinline__ bf16x8 operator()(int tok0, int ks, int lane) const { return *(const bf16x8*)(base + (size_t)(tok0 + (lane & 31)) * 64 + 16 * ks + 8 * (lane >> 5)); } };
struct VSrcBfT { const bf16_t* base; int ld; __device__ __forceinline__ bf16x8 operator()(int tok0, int dt, int s2, int lane) const {
        const bf16_t* ptr = base + (size_t)(32 * dt + (lane & 31)) * ld + tok0 + 16 * s2 + 4 * (lane >> 5);
        union { uint4 u; bf16x8 v; } x; const uint2 a = *(const uint2*)ptr, b = *(const uint2*)(ptr + 8); x.u.x = a.x; x.u.y = a.y; x.u.z = b.x; x.u.w = b.y; return x.v; } };

template <class KS>
__device__ __forceinline__ f32x16 qk_tile(const bf16x8 (&qf)[4], const KS& ks, int tok0, int lane) {
    f32x16 s = zero16();
#pragma unroll
    for (int k = 0; k < 4; ++k) s = mfma32(ks(tok0, k, lane), qf[k], s);
    return s;
}
template <class OKF>
__device__ __forceinline__ void sm_stats(const f32x16& s, int hb, OKF ok, float& m, float& l) {
    float sv[16]; float tmax = -1e30f; unsigned okm = 0;
#pragma unroll
    for (int i = 0; i < 16; ++i) { const int kl = (i & 3) + 8 * (i >> 2) + 4 * hb; const bool k = ok(kl); okm |= (k ? 1u : 0u) << i; sv[i] = k ? s[i] : -1e30f; tmax = fmaxf(tmax, sv[i]); }
    tmax = fmaxf(tmax, __shfl_xor(tmax, 32));
    const float mn = fmaxf(m, tmax), alpha = __expf(m - mn); m = mn;
    float ps = 0.f;
#pragma unroll
    for (int i = 0; i < 16; ++i) ps += ((okm >> i) & 1u) ? __expf(sv[i] - mn) : 0.f;
    l = l * alpha + ps;
}
template <class OKF, class VF>
__device__ __forceinline__ void sm_pv(const f32x16& s, int hb, OKF ok, VF vf, float& m, float& l, f32x16 (&o)[2]) {
    float sv[16]; float tmax = -1e30f; unsigned okm = 0;
#pragma unroll
    for (int i = 0; i < 16; ++i) { const int kl = (i & 3) + 8 * (i >> 2) + 4 * hb; const bool k = ok(kl); okm |= (k ? 1u : 0u) << i; sv[i] = k ? s[i] : -1e30f; tmax = fmaxf(tmax, sv[i]); }
    tmax = fmaxf(tmax, __shfl_xor(tmax, 32));
    const float mn = fmaxf(m, tmax), alpha = __expf(m - mn); m = mn;
    float pr[16]; float ps = 0.f;
#pragma unroll
    for (int i = 0; i < 16; ++i) { pr[i] = ((okm >> i) & 1u) ? __expf(sv[i] - mn) : 0.f; ps += pr[i]; }
    l = l * alpha + ps;
    o[0] *= alpha; o[1] *= alpha;
#pragma unroll
    for (int s2 = 0; s2 < 2; ++s2) {
        const bf16x8 pb = pack8(pr[8 * s2 + 0], pr[8 * s2 + 1], pr[8 * s2 + 2], pr[8 * s2 + 3], pr[8 * s2 + 4], pr[8 * s2 + 5], pr[8 * s2 + 6], pr[8 * s2 + 7]);
#pragma unroll
        for (int dt = 0; dt < 2; ++dt) o[dt] = mfma32(vf(dt, s2), pb, o[dt]);
    }
}
template <class OKF, class VF>
__device__ __forceinline__ void cmp_pass2(const f32x16& s, int hb, OKF ok, VF vf, float m, float inv, f32x16 (&o)[2], LAS float* prow, bool writer) {
    float pr[16];
#pragma unroll
    for (int i = 0; i < 16; ++i) {
        const int kl = (i & 3) + 8 * (i >> 2) + 4 * hb;
        pr[i] = ok(kl) ? __expf(s[i] - m) * inv : 0.f;
        float q = pr[i] + __shfl_xor(pr[i], 1); q += __shfl_xor(q, 2);
        if (writer) prow[kl] = q;
    }
#pragma unroll
    for (int s2 = 0; s2 < 2; ++s2) {
        const bf16x8 pb = pack8(pr[8 * s2 + 0], pr[8 * s2 + 1], pr[8 * s2 + 2], pr[8 * s2 + 3], pr[8 * s2 + 4], pr[8 * s2 + 5], pr[8 * s2 + 6], pr[8 * s2 + 7]);
#pragma unroll
        for (int dt = 0; dt < 2; ++dt) o[dt] = mfma32(vf(dt, s2), pb, o[dt]);
    }
}

__device__ __forceinline__ void attn_store(const P& p, const f32x16 (&of)[2], int qrow, int head, int hb, bool doit, bf16_t* oadst = nullptr) {
    if (!oadst) oadst = p.oa();
    if (!doit) return;
#pragma unroll
    for (int dt = 0; dt < 2; ++dt)
#pragma unroll
        for (int i4 = 0; i4 < 4; ++i4) {
            const int d = 32 * dt + 8 * i4 + 4 * hb;
            const size_t off = (size_t)qrow * 512 + head * 64 + d;
            const uint2 gw = *(const uint2*)(p.ag() + off);
            f32x4 v;
            v[0] = of[dt][4 * i4 + 0] * __uint_as_float(gw.x << 16); v[1] = of[dt][4 * i4 + 1] * __uint_as_float(gw.x & 0xffff0000u);
            v[2] = of[dt][4 * i4 + 2] * __uint_as_float(gw.y << 16); v[3] = of[dt][4 * i4 + 3] * __uint_as_float(gw.y & 0xffff0000u);
            st_bf4(oadst + off, v);
        }
}


__device__ __forceinline__ void of_put(LAS float* st, int lane, const f32x16 (&o)[2], float sc) {
#pragma unroll
    for (int dt = 0; dt < 2; ++dt)
#pragma unroll
        for (int i = 0; i < 16; ++i) st[(dt * 16 + i) * 64 + lane] = o[dt][i] * sc;
}
__device__ __forceinline__ void of_add(LAS float* st, int lane, const f32x16 (&o)[2], float sc) {
#pragma unroll
    for (int dt = 0; dt < 2; ++dt)
#pragma unroll
        for (int i = 0; i < 16; ++i) st[(dt * 16 + i) * 64 + lane] += o[dt][i] * sc;
}
__device__ __forceinline__ void of_get_add(LAS float* st, int lane, const f32x16 (&o)[2], float sc, f32x16 (&of)[2]) {
#pragma unroll
    for (int dt = 0; dt < 2; ++dt)
#pragma unroll
        for (int i = 0; i < 16; ++i) of[dt][i] = st[(dt * 16 + i) * 64 + lane] + o[dt][i] * sc;
}


template <class NEXT, class OKF>
__device__ __forceinline__ void tile_loop(const bf16x8 (&qf)[4], const KSrcBf& ksrc, const VSrcBfT& vsrc, int tt, NEXT next, OKF ok, int lane, float& m, float& l, f32x16 (&o)[2]) {
    if (tt < 0) return;
    const int hb = lane >> 5;
    bf16x8 kf[4];
#pragma unroll
    for (int ks = 0; ks < 4; ++ks) kf[ks] = ksrc(32 * tt, ks, lane);
#pragma unroll 1
    for (;;) {
        const int tok0 = 32 * tt;
        const int nt = next(tt);
        bf16x8 vf[2][2];
#pragma unroll
        for (int dt = 0; dt < 2; ++dt)
#pragma unroll
            for (int s2 = 0; s2 < 2; ++s2) vf[dt][s2] = vsrc(tok0, dt, s2, lane);
        bf16x8 kn[4];
        const int ntc = nt >= 0 ? nt : tt;
#pragma unroll
        for (int ks = 0; ks < 4; ++ks) kn[ks] = ksrc(32 * ntc, ks, lane);
        f32x16 s = zero16();
#pragma unroll
        for (int ks = 0; ks < 4; ++ks) s = mfma32(kf[ks], qf[ks], s);
        sm_pv(s, hb, [&](int kl) { return ok(tok0, kl); }, [&](int dt, int s2) { return vf[dt][s2]; }, m, l, o);
        if (nt < 0) break;
#pragma unroll
        for (int ks = 0; ks < 4; ++ks) kf[ks] = kn[ks];
        tt = nt;
    }
}

__device__ __forceinline__ void attn_prompt_item(const P& p, int item, LAS unsigned char* wl, int lane, bf16_t* oadst = nullptr) {
    const int bg = item & 7, tg = item >> 3, b = bg >> 1, g = bg & 1;
    const int col = lane & 31, hb = lane >> 5, tl = col >> 2, hh = col & 3;
    const int t0 = tg * 8, qpos = t0 + tl, qrow = b * SEQ + qpos, head = g * 4 + hh;
    bf16x8 qf[4];
#pragma unroll
    for (int ks = 0; ks < 4; ++ks) qf[ks] = *(const bf16x8*)(p.qb() + (size_t)qrow * 512 + head * 64 + 16 * ks + 8 * hb);
    LAS float* psum = (LAS float*)wl;
    LAS unsigned long long* msk = (LAS unsigned long long*)(wl + 8192);
    const float g0 = p.gates()[(size_t)qrow * 32 + head * 3 + 0], g1 = p.gates()[(size_t)qrow * 32 + head * 3 + 1], g2 = p.gates()[(size_t)qrow * 32 + head * 3 + 2];
    f32x16 oc[2]; oc[0] = zero16(); oc[1] = zero16();
    {
        const int cm = t0 + 7 - 31;
        const int ntile = cm >= 0 ? ((cm >> 4) >> 5) + 1 : 0;
        const KSrcBf ksrc{p.kc_p() + (size_t)bg * 256 * 64};
        const VSrcBfT vsrc{p.vcT_p() + (size_t)bg * 64 * 256, 256};
        float m = -1e30f, l = 0.f;
#pragma unroll 1
        for (int kt = 0; kt < ntile; ++kt) {
            const f32x16 s = qk_tile(qf, ksrc, 32 * kt, lane);
            sm_stats(s, hb, [&](int kl) { return 16 * (32 * kt + kl) + 31 <= qpos; }, m, l);
        }
        l += __shfl_xor(l, 32);
        const float inv = l > 0.f ? 1.0f / l : 0.f;
#pragma unroll
        for (int i = 0; i < 32; ++i) psum[i * 64 + lane] = 0.f;
        WAVE_SYNC();
#pragma unroll 1
        for (int kt = 0; kt < ntile; ++kt) {
            const f32x16 s = qk_tile(qf, ksrc, 32 * kt, lane);
            cmp_pass2(s, hb, [&](int kl) { return 16 * (32 * kt + kl) + 31 <= qpos; }, [&](int dt, int s2) { return vsrc(32 * kt, dt, s2, lane); }, m, inv, oc,
                      psum + tl * 256 + 32 * kt, hh == 0);
        }
    }
    WAVE_SYNC();
    for (int t2 = 0; t2 < 8; ++t2) {
        const int t = t0 + t2, cur = t >> 6, n = lane;
        float imp = 0.f;
#pragma unroll
        for (int c = -1; c < 4; ++c) { const int cc = 4 * n + c; if (cc >= 0) imp += psum[t2 * 256 + cc]; }
        if (n == 0 || n == cur || n == cur - 1) imp = 1e4f;
        if (n * 64 > t) imp = -1.0f;
        int rank = 0;
#pragma unroll
        for (int j = 0; j < 64; ++j) {
            const float vj = __uint_as_float(__builtin_amdgcn_readlane(__float_as_uint(imp), j));
            rank += (vj > imp || (vj == imp && j < n)) ? 1 : 0;
        }
        const unsigned long long mk = __ballot(rank < 16);
        if (lane == 0) msk[t2] = mk;
    }
    WAVE_SYNC();
    const unsigned long long mymask = msk[tl];
    unsigned long long um = 0;
#pragma unroll
    for (int i = 0; i < 8; ++i) um |= msk[i];
    const int cur0 = t0 >> 6;
    WAVE_SYNC();
    LAS float* ost = (LAS float*)wl;
    of_put(ost, lane, oc, g0);
    {
        const KSrcBf ksrc{p.kb() + (size_t)((1 * NB + b) * 2 + g) * SEQ * 64};
        const VSrcBfT vsrc{p.vT() + (size_t)((0 * NB + b) * 2 + g) * 64 * SEQ, SEQ};
        float m = -1e30f, l = 0.f; f32x16 o[2]; o[0] = zero16(); o[1] = zero16();
        {
            const unsigned um_lo = __builtin_amdgcn_readfirstlane((unsigned)um), um_hi = __builtin_amdgcn_readfirstlane((unsigned)(um >> 32));
            unsigned long long umu = ((unsigned long long)um_hi << 32) | um_lo;
            if (cur0 < 63) umu &= (2ull << cur0) - 1ull;
            const int first = umu ? 2 * (int)__builtin_ctzll(umu) : -1;
            tile_loop(qf, ksrc, vsrc, first,
                      [&](int tt) { if (!(tt & 1)) return tt + 1; const int n = tt >> 1; if (n >= 63) return -1; const unsigned long long rem = umu >> (n + 1); return rem ? 2 * (n + 1 + (int)__builtin_ctzll(rem)) : -1; },
                      [&](int tok0, int kl) { return (bool)((mymask >> (tok0 >> 6)) & 1ull) && (tok0 + kl <= qpos); }, lane, m, l, o);
        }
        l += __shfl_xor(l, 32);
        const float sc = l > 0.f ? g1 / l : 0.f;
        of_add(ost, lane, o, sc);
    }
    {
        const KSrcBf ksrc{p.kb() + (size_t)((2 * NB + b) * 2 + g) * SEQ * 64};
        const VSrcBfT vsrc{p.vT() + (size_t)((1 * NB + b) * 2 + g) * 64 * SEQ, SEQ};
        float m = -1e30f, l = 0.f; f32x16 o[2]; o[0] = zero16(); o[1] = zero16();
        const int lo = t0 - 511;
        const int nlo = lo > 0 ? (lo >> 6) : 0;
        {
            const int last = 2 * cur0 + 1;
            tile_loop(qf, ksrc, vsrc, 2 * nlo, [&](int tt) { return tt < last ? tt + 1 : -1; },
                      [&](int tok0, int kl) { const int key = tok0 + kl; return key <= qpos && key + 511 >= qpos; }, lane, m, l, o);
        }
        l += __shfl_xor(l, 32);
        const float sc = l > 0.f ? g2 / l : 0.f;
        f32x16 of[2];
        of_get_add(ost, lane, o, sc, of);
        attn_store(p, of, qrow, head, hb, true, oadst);
    }
    WAVE_SYNC();
}

template <class RP, class OKF>
__device__ __forceinline__ void f32_tile(const bf16x8 (&qf)[4], RP rp, OKF ok, LAS bf16_t* vt, int lane, float& m, float& l, f32x16 (&o)[2]) {
    const int col = lane & 31, hb = lane >> 5;
    const float* kr = rp(col);
    f32x16 s = zero16();
#pragma unroll
    for (int ks = 0; ks < 4; ++ks) {
        const float4 a = *(const float4*)(kr + 16 * ks + 8 * hb), c = *(const float4*)(kr + 16 * ks + 8 * hb + 4);
        s = mfma32(pack8(a.x, a.y, a.z, a.w, c.x, c.y, c.z, c.w), qf[ks], s);
    }
    const float* vr = kr + 128 + 32 * hb;
#pragma unroll
    for (int j4 = 0; j4 < 8; ++j4) {
        const float4 a = *(const float4*)(vr + 4 * j4);
        vt[(32 * hb + 4 * j4 + 0) * 40 + col] = f2bf(a.x); vt[(32 * hb + 4 * j4 + 1) * 40 + col] = f2bf(a.y);
        vt[(32 * hb + 4 * j4 + 2) * 40 + col] = f2bf(a.z); vt[(32 * hb + 4 * j4 + 3) * 40 + col] = f2bf(a.w);
    }
    WAVE_SYNC();
    sm_pv(s, hb, ok, [&](int dt, int s2) {
        LAS const bf16_t* ptr = vt + (32 * dt + col) * 40 + 16 * s2 + 4 * hb;
        union { uint4 u; bf16x8 v; } x; const u32x2 a = *(LAS const u32x2*)ptr, c = *(LAS const u32x2*)(ptr + 8); x.u.x = a[0]; x.u.y = a[1]; x.u.z = c[0]; x.u.w = c[1]; return x.v; }, m, l, o);
    WAVE_SYNC();
}

__device__ __forceinline__ void attn_sample_item(const P& p, int item, LAS unsigned char* wl, int lane) {
    const int t = item & 7, g = (item >> 3) & 1, b = item >> 4, bg = b * 2 + g;
    const int col = lane & 31, hb = lane >> 5, hh = col & 3;
    const int qpos = PAST + t, qrow = NP + b * 8 + t, head = g * 4 + hh;
    bf16x8 qf[4];
#pragma unroll
    for (int ks = 0; ks < 4; ++ks) qf[ks] = *(const bf16x8*)(p.qb() + (size_t)qrow * 512 + head * 64 + 16 * ks + 8 * hb);
    LAS float* psum = (LAS float*)wl;
    LAS int* list = (LAS int*)(wl + 8256);
    LAS float* impl = (LAS float*)(wl + 8448);
    LAS bf16_t* vt = (LAS bf16_t*)(wl + 9728);
    const float g0 = p.gates()[(size_t)qrow * 32 + head * 3 + 0], g1 = p.gates()[(size_t)qrow * 32 + head * 3 + 1], g2 = p.gates()[(size_t)qrow * 32 + head * 3 + 2];
    f32x16 oc[2]; oc[0] = zero16(); oc[1] = zero16();
    {
        const KSrcBf ksrc{p.kc_s() + (size_t)bg * 1024 * 64};
        const VSrcBfT vsrc{p.vcT_s() + (size_t)bg * 64 * 1024, 1024};
        float m = -1e30f, l = 0.f;
#pragma unroll 1
        for (int kt = 0; kt < 32; ++kt) {
            const f32x16 s = qk_tile(qf, ksrc, 32 * kt, lane);
            sm_stats(s, hb, [&](int kl) { return 32 * kt + kl <= 1022; }, m, l);
        }
        l += __shfl_xor(l, 32);
        const float inv = l > 0.f ? 1.0f / l : 0.f;
#pragma unroll 1
        for (int kt = 0; kt < 32; ++kt) {
            const f32x16 s = qk_tile(qf, ksrc, 32 * kt, lane);
            cmp_pass2(s, hb, [&](int kl) { return 32 * kt + kl <= 1022; }, [&](int dt, int s2) { return vsrc(32 * kt, dt, s2, lane); }, m, inv, oc, psum + 32 * kt, col == 0);
        }
    }
    WAVE_SYNC();
#pragma unroll
    for (int j = 0; j < 5; ++j) {
        const int n = lane + 64 * j;
        if (n <= 256) {
            float imp = 0.f;
            for (int c = -1; c < 4; ++c) { const int cc = 4 * n + c; if (cc >= 0 && cc <= 1022) imp += psum[cc]; }
            impl[n] = imp;
        }
    }
    WAVE_SYNC();
    {
        int base = 0;
#pragma unroll
        for (int j = 0; j < 4; ++j) {
            const int n = lane + 64 * j;
            const bool cand = n >= 1 && n <= 254;
            const float v = impl[n];
            int rank = 0;
            for (int q = 1; q <= 254; ++q) { const float vq = impl[q]; rank += (vq > v || (vq == v && q < n)) ? 1 : 0; }
            const bool sel = cand && rank < 13;
            const unsigned long long mk = __ballot(sel);
            if (sel) list[base + __popcll(mk & ((1ull << lane) - 1ull))] = n;
            base += __popcll(mk);
        }
        if (lane == 0) { list[13] = 0; list[14] = 255; list[15] = 256; }
    }
    WAVE_SYNC();
#if SMODE & 1
    LAS float* ost = (LAS float*)wl;
    of_put(ost, lane, oc, g0);
    {
        float m = -1e30f, l = 0.f; f32x16 o[2]; o[0] = zero16(); o[1] = zero16();
#pragma unroll 1
        for (int li = 0; li < 16; ++li) {
#if SMODE & 4
            const int n = li < 13 ? 17 * li + 5 : (li == 13 ? 0 : 242 + li);
#else
            const int n = __builtin_amdgcn_readfirstlane(list[li]);
#endif
            if (n < 256) {
                const int page = p.page_table[b * 128 + (n >> 1)];
                const float* base = p.cache_sel + ((size_t)page * 128 + (n & 1) * 64) * 256 + g * 64;
#pragma unroll 1
                for (int k2 = 0; k2 < 2; ++k2)
                    f32_tile(qf, [&](int kl) { return base + (size_t)(32 * k2 + kl) * 256; }, [&](int kl) { return true; }, vt, lane, m, l, o);
            } else {
                const float* base = p.out + O_SEL_S + (size_t)(b * 8) * 256 + g * 64;
                f32_tile(qf, [&](int kl) { return base + (size_t)(kl < 8 ? kl : 7) * 256; }, [&](int kl) { return kl <= t; }, vt, lane, m, l, o);
            }
        }
        l += __shfl_xor(l, 32);
        const float sc = l > 0.f ? g1 / l : 0.f;
        of_add(ost, lane, o, sc);
    }
#endif
#if SMODE & 2
    {
        float m = -1e30f, l = 0.f; f32x16 o[2]; o[0] = zero16(); o[1] = zero16();
        const float* cw = p.cache_win + (size_t)b * 512 * 256 + g * 64;
        const float* nw = p.out + O_WIN_S + ((size_t)b * 512 + 504) * 256 + g * 64;
#pragma unroll 1
        for (int kt = 0; kt < 17; ++kt) {
            f32_tile(qf, [&](int kl) { const int j = 32 * kt + kl; return j < 512 ? cw + (size_t)j * 256 : nw + (size_t)(j - 512 < 8 ? j - 512 : 7) * 256; },
                     [&](int kl) { const int j = 32 * kt + kl; return j >= t + 1 && j <= 512 + t; }, vt, lane, m, l, o);
        }
        l += __shfl_xor(l, 32);
        const float sc = l > 0.f ? g2 / l : 0.f;
        f32x16 of[2];
        of_get_add(ost, lane, o, sc, of);
        attn_store(p, of, qrow, head, hb, col < 4);
    }
    WAVE_SYNC();
#endif
}

constexpr int WL_STRIDE = 15360, KV_OFF = 8 * WL_STRIDE, KV_BUF = 17920, XB_OFF = KV_OFF + 2 * KV_BUF;

struct LoadBf16 {
    const bf16_t* kbase; const bf16_t* vbase; int ld; bool with_v; u32x4_t kr, vr;
    __device__ __forceinline__ void load(int n) {
        const int tid = threadIdx.x, srow = tid >> 3, sch = tid & 7;
        kr = *(const u32x4_t*)(kbase + (size_t)(64 * n + srow) * 64 + sch * 8);
        if (with_v) vr = *(const u32x4_t*)(vbase + (size_t)srow * ld + 64 * n + sch * 8);
    }
    __device__ __forceinline__ void store(LAS unsigned char* buf) const {
        const int tid = threadIdx.x, srow = tid >> 3, sch = tid & 7;
        *(LAS u32x4_t*)(buf + srow * 144 + sch * 16) = kr;
        if (with_v) { LAS u32x2* vp = (LAS u32x2*)(buf + 9216 + srow * 136 + sch * 16); vp[0] = (u32x2){vr[0], vr[1]}; vp[1] = (u32x2){vr[2], vr[3]}; }
    }
};
struct LoadWinF32 {
    const float* cw; const float* nw; f32x4 k0, k1, v0, v1;
    __device__ __forceinline__ void load(int n) {
        const int tid = threadIdx.x, srow = tid >> 3, sch = tid & 7;
        const int j = 64 * n + srow;
        const float* r = j < 512 ? cw + (size_t)j * 256 : nw + (size_t)(j - 512 < 8 ? j - 512 : 7) * 256;
        k0 = *(const f32x4*)(r + sch * 8); k1 = *(const f32x4*)(r + sch * 8 + 4);
        v0 = *(const f32x4*)(r + 128 + sch * 8); v1 = *(const f32x4*)(r + 128 + sch * 8 + 4);
    }
    __device__ __forceinline__ void store(LAS unsigned char* buf) const {
        const int tid = threadIdx.x, srow = tid >> 3, sch = tid & 7;
        u32x4_t kw; kw[0] = pk2(k0[0], k0[1]); kw[1] = pk2(k0[2], k0[3]); kw[2] = pk2(k1[0], k1[1]); kw[3] = pk2(k1[2], k1[3]);
        *(LAS u32x4_t*)(buf + srow * 144 + sch * 16) = kw;
        LAS bf16_t* vb = (LAS bf16_t*)(buf + 9216) + (sch * 8) * 68 + srow;
#pragma unroll
        for (int e = 0; e < 4; ++e) { vb[e * 68] = f2bf(v0[e]); vb[(4 + e) * 68] = f2bf(v1[e]); }
    }
};

template <class LOADER, class NEXT, class ACTIVE, class BODY>
__device__ __forceinline__ void block_loop_g(LOADER ld, LAS unsigned char* kv, int first, NEXT next, ACTIVE active, BODY body) {
    if (first < 0) return;
    int n = first, cur = 0;
    ld.load(n);
    ld.store(kv);
    __syncthreads();
#pragma unroll 1
    for (;;) {
        const int nn = next(n);
        if (nn >= 0) ld.load(nn);
        if (active(n)) body(n, (LAS const bf16_t*)(kv + cur * KV_BUF), (LAS const bf16_t*)(kv + cur * KV_BUF + 9216));
        if (nn >= 0) ld.store(kv + (cur ^ 1) * KV_BUF);
        __syncthreads();
        if (nn < 0) break;
        cur ^= 1; n = nn;
    }
}
template <bool WITH_V, class NEXT, class ACTIVE, class BODY>
__device__ __forceinline__ void block_loop(const bf16_t* kbase, const bf16_t* vbase, int ld, LAS unsigned char* kv, int first, NEXT next, ACTIVE active, BODY body) {
    LoadBf16 L; L.kbase = kbase; L.vbase = vbase; L.ld = ld; L.with_v = WITH_V;
    block_loop_g(L, kv, first, next, active, body);
}
__device__ __forceinline__ bf16x8 lds_kfrag(LAS const bf16_t* kb, int kt, int ks, int col, int hb) { return *(LAS const bf16x8*)(kb + (32 * kt + col) * 72 + 16 * ks + 8 * hb); }
__device__ __forceinline__ bf16x8 lds_vfrag(LAS const bf16_t* vb, int kt, int dt, int s2, int col, int hb) {
    LAS const bf16_t* ptr = vb + (32 * dt + col) * 68 + 32 * kt + 16 * s2 + 4 * hb;
    union { u32x4_t u; bf16x8 v; } x; const u32x2 a = *(LAS const u32x2*)ptr, c = *(LAS const u32x2*)(ptr + 8); x.u[0] = a[0]; x.u[1] = a[1]; x.u[2] = c[0]; x.u[3] = c[1]; return x.v;
}
__device__ __forceinline__ f32x16 lds_qk(const bf16x8 (&qf)[4], LAS const bf16_t* kb, int kt, int col, int hb) {
    f32x16 s = zero16();
#pragma unroll
    for (int ks = 0; ks < 4; ++ks) s = mfma32(lds_kfrag(kb, kt, ks, col, hb), qf[ks], s);
    return s;
}

__device__ __forceinline__ void attn_prompt_block(const P& p, int bg, int j, LAS unsigned char* lds) {
    const int tid = threadIdx.x, lane = tid & 63, wid = tid >> 6;
    const int b = bg >> 1, g = bg & 1;
    const int col = lane & 31, hb = lane >> 5, tl = col >> 2, hh = col & 3;
    const int t0 = 64 * j + 8 * wid, qpos = t0 + tl, qrow = b * SEQ + qpos, head = g * 4 + hh;
    LAS unsigned char* wl = lds + wid * WL_STRIDE;
    LAS unsigned char* kv = lds + KV_OFF;
    LAS float* psum = (LAS float*)wl;
    LAS unsigned long long* msk = (LAS unsigned long long*)(wl + 8192);
    bf16x8 qf[4];
#pragma unroll
    for (int ks = 0; ks < 4; ++ks) qf[ks] = *(const bf16x8*)(p.qb() + (size_t)qrow * 512 + head * 64 + 16 * ks + 8 * hb);
    const float g0 = p.gates()[(size_t)qrow * 32 + head * 3 + 0], g1 = p.gates()[(size_t)qrow * 32 + head * 3 + 1], g2 = p.gates()[(size_t)qrow * 32 + head * 3 + 2];
    f32x16 oc[2]; oc[0] = zero16(); oc[1] = zero16();
    {
        const int cmb = 64 * j + 63 - 31;
        const int nbc = ((cmb >> 4) >> 6) + 1;
        const int cmw = t0 + 7 - 31;
        const int cmaxw = cmw >= 0 ? (cmw >> 4) : -1;
        const bf16_t* kc = p.kc_p() + (size_t)bg * 256 * 64;
        const bf16_t* vc = p.vcT_p() + (size_t)bg * 64 * 256;
        float m = -1e30f, l = 0.f;
        block_loop<false>(kc, vc, 256, kv, 0, [&](int n) { return n + 1 < nbc ? n + 1 : -1; }, [&](int n) { return cmaxw >= 64 * n; },
            [&](int n, LAS const bf16_t* kb, LAS const bf16_t* vb) {
#pragma unroll 1
                for (int kt = 0; kt < 2; ++kt) {
#if defined(BLK_GLOBAL_FRAGS)
                    const f32x16 s = qk_tile(qf, KSrcBf{kc}, 64 * n + 32 * kt, lane);
#else
                    const f32x16 s = lds_qk(qf, kb, kt, col, hb);
#endif
                    sm_stats(s, hb, [&](int kl) { return 16 * (64 * n + 32 * kt + kl) + 31 <= qpos; }, m, l);
                }
            });
        l += __shfl_xor(l, 32);
        const float inv = l > 0.f ? 1.0f / l : 0.f;
#pragma unroll
        for (int i = 0; i < 32; ++i) psum[i * 64 + lane] = 0.f;
        WAVE_SYNC();
        block_loop<true>(kc, vc, 256, kv, 0, [&](int n) { return n + 1 < nbc ? n + 1 : -1; }, [&](int n) { return cmaxw >= 64 * n; },
            [&](int n, LAS const bf16_t* kb, LAS const bf16_t* vb) {
#pragma unroll 1
                for (int kt = 0; kt < 2; ++kt) {
#if defined(BLK_GLOBAL_FRAGS)
                    const f32x16 s = qk_tile(qf, KSrcBf{kc}, 64 * n + 32 * kt, lane);
                    const VSrcBfT vsg{vc, 256};
                    cmp_pass2(s, hb, [&](int kl) { return 16 * (64 * n + 32 * kt + kl) + 31 <= qpos; }, [&](int dt, int s2) { return vsg(64 * n + 32 * kt, dt, s2, lane); }, m, inv, oc,
#else
                    const f32x16 s = lds_qk(qf, kb, kt, col, hb);
                    cmp_pass2(s, hb, [&](int kl) { return 16 * (64 * n + 32 * kt + kl) + 31 <= qpos; }, [&](int dt, int s2) { return lds_vfrag(vb, kt, dt, s2, col, hb); }, m, inv, oc,
#endif
                              psum + tl * 256 + 64 * n + 32 * kt, hh == 0);
                }
            });
    }
    WAVE_SYNC();
    unsigned long long umw = 0;
    for (int t2 = 0; t2 < 8; ++t2) {
        const int t = t0 + t2, cur = t >> 6, n = lane;
        float imp = 0.f;
#pragma unroll
        for (int c = -1; c < 4; ++c) { const int cc = 4 * n + c; if (cc >= 0) imp += psum[t2 * 256 + cc]; }
        if (n == 0 || n == cur || n == cur - 1) imp = 1e4f;
        if (n * 64 > t) imp = -1.0f;
        int rank = 0;
#pragma unroll
        for (int jj = 0; jj < 64; ++jj) {
            const float vj = __uint_as_float(__builtin_amdgcn_readlane(__float_as_uint(imp), jj));
            rank += (vj > imp || (vj == imp && jj < n)) ? 1 : 0;
        }
        const unsigned long long mk = __ballot(rank < 16);
        if (lane == 0) msk[t2] = mk;
        umw |= mk;
    }
    if (lane == 0) msk[8] = umw;
    __syncthreads();
    const unsigned long long mymask = msk[tl];
    unsigned long long umb = 0;
#pragma unroll
    for (int w2 = 0; w2 < 8; ++w2) umb |= *(LAS const unsigned long long*)(lds + w2 * WL_STRIDE + 8192 + 64);
    {
        const unsigned lo = __builtin_amdgcn_readfirstlane((unsigned)umb), hi = __builtin_amdgcn_readfirstlane((unsigned)(umb >> 32));
        umb = ((unsigned long long)hi << 32) | lo;
        if (j < 63) umb &= (2ull << j) - 1ull;
    }
    LAS float* ost = (LAS float*)wl;
#if defined(DBG_UMB)
    { const unsigned long long lim = j < 63 ? ((2ull << j) - 1ull) : ~0ull; if ((umw & lim & ~umb) != 0ull) oc[0][0] = __builtin_nanf(""); }
#endif
    of_put(ost, lane, oc, g0);
#if defined(DBG_SCHED)
    __builtin_amdgcn_sched_barrier(0);
#endif
#if defined(BLK_OLD_SEL)
    {
        const KSrcBf ksrc{p.kb() + (size_t)((1 * NB + b) * 2 + g) * SEQ * 64};
        const VSrcBfT vsrc{p.vT() + (size_t)((0 * NB + b) * 2 + g) * 64 * SEQ, SEQ};
        float m = -1e30f, l = 0.f; f32x16 o[2]; o[0] = zero16(); o[1] = zero16();
        unsigned long long umu = umw; const int cur0 = j;
        { const unsigned lo = __builtin_amdgcn_readfirstlane((unsigned)umu), hi = __builtin_amdgcn_readfirstlane((unsigned)(umu >> 32)); umu = ((unsigned long long)hi << 32) | lo; }
        if (cur0 < 63) umu &= (2ull << cur0) - 1ull;
        const int first = umu ? 2 * (int)__builtin_ctzll(umu) : -1;
        tile_loop(qf, ksrc, vsrc, first,
                  [&](int tt) { if (!(tt & 1)) return tt + 1; const int n = tt >> 1; if (n >= 63) return -1; const unsigned long long rem = umu >> (n + 1); return rem ? 2 * (n + 1 + (int)__builtin_ctzll(rem)) : -1; },
                  [&](int tok0, int kl) { return (bool)((mymask >> (tok0 >> 6)) & 1ull) && (tok0 + kl <= qpos); }, lane, m, l, o);
        l += __shfl_xor(l, 32);
        const float sc = l > 0.f ? g1 / l : 0.f;
        of_add(ost, lane, o, sc);
    }
#else
    {
        const bf16_t* kbs = p.kb() + (size_t)((1 * NB + b) * 2 + g) * SEQ * 64;
        const bf16_t* vbs = p.vT() + (size_t)((0 * NB + b) * 2 + g) * 64 * SEQ;
        float m = -1e30f, l = 0.f; f32x16 o[2]; o[0] = zero16(); o[1] = zero16();
        block_loop<true>(kbs, vbs, SEQ, kv, umb ? (int)__builtin_ctzll(umb) : -1,
            [&](int n) { if (n >= 63) return -1; const unsigned long long rem = umb >> (n + 1); return rem ? n + 1 + (int)__builtin_ctzll(rem) : -1; },
#if defined(SEL_ALWAYS_ACTIVE)
            [&](int n) { return true; },
#else
            [&](int n) { return (bool)((umw >> n) & 1ull); },
#endif
            [&](int n, LAS const bf16_t* kb, LAS const bf16_t* vb) {
                const bool bsel = (mymask >> n) & 1ull;
#pragma unroll
                for (int kt = 0; kt < 2; ++kt) {
                    const int tok0 = 64 * n + 32 * kt;
#if defined(BLK_GLOBAL_FRAGS)
                    const f32x16 s = qk_tile(qf, KSrcBf{kbs}, tok0, lane);
                    const VSrcBfT vsg{vbs, SEQ};
                    sm_pv(s, hb, [&](int kl) { return bsel && (tok0 + kl <= qpos); }, [&](int dt, int s2) { return vsg(tok0, dt, s2, lane); }, m, l, o);
#else
                    const f32x16 s = lds_qk(qf, kb, kt, col, hb);
                    sm_pv(s, hb, [&](int kl) { return (bool)((mymask >> (tok0 >> 6)) & 1ull) && (tok0 + kl <= qpos); }, [&](int dt, int s2) { return lds_vfrag(vb, kt, dt, s2, col, hb); }, m, l, o);
#endif
                }
            });
        l += __shfl_xor(l, 32);
        const float sc = l > 0.f ? g1 / l : 0.f;
        of_add(ost, lane, o, sc);
#if defined(DBG_SELCMP)
        {
            const float i1 = l > 0.f ? 1.0f / l : 0.f;
            float c1 = 0.f;
            for (int dt = 0; dt < 2; ++dt) for (int i = 0; i < 16; ++i) c1 += o[dt][i] * i1 * (1.0f + 0.37f * (float)(dt * 16 + i));
            const KSrcBf ksrc{kbs}; const VSrcBfT vsrc{vbs, SEQ};
            float m2 = -1e30f, l2 = 0.f; f32x16 o2[2]; o2[0] = zero16(); o2[1] = zero16();
            unsigned long long umu = umw;
            { const unsigned lo = __builtin_amdgcn_readfirstlane((unsigned)umu), hi = __builtin_amdgcn_readfirstlane((unsigned)(umu >> 32)); umu = ((unsigned long long)hi << 32) | lo; }
            if (j < 63) umu &= (2ull << j) - 1ull;
            const int first = umu ? 2 * (int)__builtin_ctzll(umu) : -1;
            tile_loop(qf, ksrc, vsrc, first,
                      [&](int tt) { if (!(tt & 1)) return tt + 1; const int n = tt >> 1; if (n >= 63) return -1; const unsigned long long rem = umu >> (n + 1); return rem ? 2 * (n + 1 + (int)__builtin_ctzll(rem)) : -1; },
                      [&](int tok0, int kl) { return (bool)((mymask >> (tok0 >> 6)) & 1ull) && (tok0 + kl <= qpos); }, lane, m2, l2, o2);
            l2 += __shfl_xor(l2, 32);
            const float i2 = l2 > 0.f ? 1.0f / l2 : 0.f;
            float c2 = 0.f;
            for (int dt = 0; dt < 2; ++dt) for (int i = 0; i < 16; ++i) c2 += o2[dt][i] * i2 * (1.0f + 0.37f * (float)(dt * 16 + i));
            if (!(fabsf(c1 - c2) < DBG_TOL) DBG_COND) ost[lane] = __builtin_nanf("");
        }
#endif
    }
#endif
#if defined(BLK_OLD_WIN)
    {
        const KSrcBf ksrc{p.kb() + (size_t)((2 * NB + b) * 2 + g) * SEQ * 64};
        const VSrcBfT vsrc{p.vT() + (size_t)((1 * NB + b) * 2 + g) * 64 * SEQ, SEQ};
        float m = -1e30f, l = 0.f; f32x16 o[2]; o[0] = zero16(); o[1] = zero16();
        const int lo = t0 - 511; const int nlo = lo > 0 ? (lo >> 6) : 0; const int last = 2 * j + 1;
        tile_loop(qf, ksrc, vsrc, 2 * nlo, [&](int tt) { return tt < last ? tt + 1 : -1; },
                  [&](int tok0, int kl) { const int key = tok0 + kl; return key <= qpos && key + 511 >= qpos; }, lane, m, l, o);
        l += __shfl_xor(l, 32);
        const float sc = l > 0.f ? g2 / l : 0.f;
        f32x16 of[2];
        of_get_add(ost, lane, o, sc, of);
        attn_store(p, of, qrow, head, hb, true);
    }
#else
#if defined(DBG_SCHED)
    __builtin_amdgcn_sched_barrier(0);
#endif
#if defined(DBG_EXTRA_SYNC)
    __syncthreads();
#endif
#if defined(DBG_SLEEP)
    for (int r = 0; r < (wid ^ (j & 7)) * 6; ++r) __builtin_amdgcn_s_sleep(100);
#endif
    {
        const bf16_t* kbw = p.kb() + (size_t)((2 * NB + b) * 2 + g) * SEQ * 64;
        const bf16_t* vbw = p.vT() + (size_t)((1 * NB + b) * 2 + g) * 64 * SEQ;
        float m = -1e30f, l = 0.f; f32x16 o[2]; o[0] = zero16(); o[1] = zero16();
        block_loop<true>(kbw, vbw, SEQ, kv, j > 8 ? j - 8 : 0, [&](int n) { return n < j ? n + 1 : -1; }, [&](int n) { return true; },
            [&](int n, LAS const bf16_t* kb, LAS const bf16_t* vb) {
#pragma unroll 1
                for (int kt = 0; kt < 2; ++kt) {
                    const int tok0 = 64 * n + 32 * kt;
#if defined(BLK_GLOBAL_FRAGS)
                    const f32x16 s = qk_tile(qf, KSrcBf{kbw}, tok0, lane);
                    const VSrcBfT vsg{vbw, SEQ};
                    sm_pv(s, hb, [&](int kl) { const int key = tok0 + kl; return key <= qpos && key + 511 >= qpos; }, [&](int dt, int s2) { return vsg(tok0, dt, s2, lane); }, m, l, o);
#else
                    const f32x16 s = lds_qk(qf, kb, kt, col, hb);
                    sm_pv(s, hb, [&](int kl) { const int key = tok0 + kl; return key <= qpos && key + 511 >= qpos; }, [&](int dt, int s2) { return lds_vfrag(vb, kt, dt, s2, col, hb); }, m, l, o);
#endif
                }
            });
        l += __shfl_xor(l, 32);
        const float sc = l > 0.f ? g2 / l : 0.f;
        f32x16 of[2];
        of_get_add(ost, lane, o, sc, of);
        attn_store(p, of, qrow, head, hb, true);
    }
#endif
    __syncthreads();
}

__device__ __forceinline__ void attn_sample_block(const P& p, int bg, LAS unsigned char* lds) {
    const int tid = threadIdx.x, lane = tid & 63, wid = tid >> 6;
    const int b = bg >> 1, g = bg & 1, t = wid;
    const int col = lane & 31, hb = lane >> 5, hh = col & 3;
    const int qrow = NP + b * 8 + t, head = g * 4 + hh;
    LAS unsigned char* wl = lds + wid * WL_STRIDE;
    LAS unsigned char* kv = lds + KV_OFF;
    bf16x8 qf[4];
#pragma unroll
    for (int ks = 0; ks < 4; ++ks) qf[ks] = *(const bf16x8*)(p.qb() + (size_t)qrow * 512 + head * 64 + 16 * ks + 8 * hb);
    LAS float* psum = (LAS float*)wl;
    LAS int* list = (LAS int*)(wl + 8256);
    LAS float* impl = (LAS float*)(wl + 8448);
    LAS bf16_t* vt = (LAS bf16_t*)(wl + 9728);
    const float g0 = p.gates()[(size_t)qrow * 32 + head * 3 + 0], g1 = p.gates()[(size_t)qrow * 32 + head * 3 + 1], g2 = p.gates()[(size_t)qrow * 32 + head * 3 + 2];
    f32x16 oc[2]; oc[0] = zero16(); oc[1] = zero16();
    {
        const bf16_t* kc = p.kc_s() + (size_t)bg * 1024 * 64;
        const bf16_t* vc = p.vcT_s() + (size_t)bg * 64 * 1024;
        float m = -1e30f, l = 0.f;
        block_loop<false>(kc, vc, 1024, kv, 0, [&](int n) { return n < 15 ? n + 1 : -1; }, [&](int n) { return true; },
            [&](int n, LAS const bf16_t* kb, LAS const bf16_t* vb) {
#pragma unroll 1
                for (int kt = 0; kt < 2; ++kt) {
                    const f32x16 s = lds_qk(qf, kb, kt, col, hb);
                    sm_stats(s, hb, [&](int kl) { return 64 * n + 32 * kt + kl <= 1022; }, m, l);
                }
            });
        l += __shfl_xor(l, 32);
        const float inv = l > 0.f ? 1.0f / l : 0.f;
        block_loop<true>(kc, vc, 1024, kv, 0, [&](int n) { return n < 15 ? n + 1 : -1; }, [&](int n) { return true; },
            [&](int n, LAS const bf16_t* kb, LAS const bf16_t* vb) {
#pragma unroll 1
                for (int kt = 0; kt < 2; ++kt) {
                    const f32x16 s = lds_qk(qf, kb, kt, col, hb);
                    cmp_pass2(s, hb, [&](int kl) { return 64 * n + 32 * kt + kl <= 1022; }, [&](int dt, int s2) { return lds_vfrag(vb, kt, dt, s2, col, hb); }, m, inv, oc,
                              psum + 64 * n + 32 * kt, col == 0);
                }
            });
    }
    WAVE_SYNC();
#pragma unroll
    for (int j = 0; j < 5; ++j) {
        const int n = lane + 64 * j;
        if (n <= 256) {
            float imp = 0.f;
            for (int c = -1; c < 4; ++c) { const int cc = 4 * n + c; if (cc >= 0 && cc <= 1022) imp += psum[cc]; }
            impl[n] = imp;
        }
    }
    WAVE_SYNC();
    {
        int base = 0;
#pragma unroll
        for (int j = 0; j < 4; ++j) {
            const int n = lane + 64 * j;
            const bool cand = n >= 1 && n <= 254;
            const float v = impl[n];
            int rank = 0;
            for (int q = 1; q <= 254; ++q) { const float vq = impl[q]; rank += (vq > v || (vq == v && q < n)) ? 1 : 0; }
            const bool sel = cand && rank < 13;
            const unsigned long long mk = __ballot(sel);
            if (sel) list[base + __popcll(mk & ((1ull << lane) - 1ull))] = n;
            base += __popcll(mk);
        }
        if (lane == 0) { list[13] = 0; list[14] = 255; list[15] = 256; }
    }
    WAVE_SYNC();
    if (lane < 16) {
        const int n = list[lane];
        list[16 + lane] = n < 256 ? p.page_table[b * 128 + (n >> 1)] * 128 + (n & 1) * 64 : -1;
    }
    WAVE_SYNC();
    LAS float* ost = (LAS float*)wl;
    of_put(ost, lane, oc, g0);
    {
        float m = -1e30f, l = 0.f; f32x16 o[2]; o[0] = zero16(); o[1] = zero16();
        const float* newrows = p.out + O_SEL_S + (size_t)(b * 8) * 256 + g * 64;
        auto rowptr = [&](int u) -> const float* {
            const int rb = __builtin_amdgcn_readfirstlane(list[16 + (u >> 1)]);
            return rb >= 0 ? p.cache_sel + ((size_t)rb + 32 * (u & 1) + col) * 256 + g * 64 : newrows + (size_t)(col < 8 ? col : 7) * 256;
        };
        f32x4 kA[4], kB[4];
        { const float* kr = rowptr(0) + 8 * hb;
#pragma unroll
          for (int ks = 0; ks < 4; ++ks) { kA[ks] = *(const f32x4*)(kr + 16 * ks); kB[ks] = *(const f32x4*)(kr + 16 * ks + 4); } }
#pragma unroll 1
        for (int u = 0; u < 31; ++u) {
            const bool isnew = __builtin_amdgcn_readfirstlane(list[16 + (u >> 1)]) < 0;
            const float* vr = rowptr(u) + 128 + 32 * hb;
            f32x4 vv[8];
#pragma unroll
            for (int j4 = 0; j4 < 8; ++j4) vv[j4] = *(const f32x4*)(vr + 4 * j4);
            f32x16 s = zero16();
#pragma unroll
            for (int ks = 0; ks < 4; ++ks) s = mfma32(pack8(kA[ks][0], kA[ks][1], kA[ks][2], kA[ks][3], kB[ks][0], kB[ks][1], kB[ks][2], kB[ks][3]), qf[ks], s);
            if (u + 1 < 31) { const float* kr = rowptr(u + 1) + 8 * hb;
#pragma unroll
                for (int ks = 0; ks < 4; ++ks) { kA[ks] = *(const f32x4*)(kr + 16 * ks); kB[ks] = *(const f32x4*)(kr + 16 * ks + 4); } }
#pragma unroll
            for (int j4 = 0; j4 < 8; ++j4)
#pragma unroll
                for (int e = 0; e < 4; ++e) vt[(32 * hb + 4 * j4 + e) * 40 + col] = f2bf(vv[j4][e]);
            WAVE_SYNC();
            sm_pv(s, hb, [&](int kl) { return !isnew || kl <= t; }, [&](int dt, int s2) {
                LAS const bf16_t* ptr = vt + (32 * dt + col) * 40 + 16 * s2 + 4 * hb;
                union { u32x4_t u4; bf16x8 v; } x; const u32x2 a = *(LAS const u32x2*)ptr, c = *(LAS const u32x2*)(ptr + 8); x.u4[0] = a[0]; x.u4[1] = a[1]; x.u4[2] = c[0]; x.u4[3] = c[1]; return x.v; }, m, l, o);
            WAVE_SYNC();
        }
        l += __shfl_xor(l, 32);
        const float sc = l > 0.f ? g1 / l : 0.f;
        of_add(ost, lane, o, sc);
    }
    {
        float m = -1e30f, l = 0.f; f32x16 o[2]; o[0] = zero16(); o[1] = zero16();
        LoadWinF32 L; L.cw = p.cache_win + (size_t)b * 512 * 256 + g * 64; L.nw = p.out + O_WIN_S + ((size_t)b * 512 + 504) * 256 + g * 64;
        block_loop_g(L, kv, 0, [&](int n) { return n < 8 ? n + 1 : -1; }, [&](int n) { return true; },
            [&](int n, LAS const bf16_t* kb, LAS const bf16_t* vb) {
#pragma unroll 1
                for (int kt = 0; kt < 2; ++kt) {
                    const int j0 = 64 * n + 32 * kt;
                    if (j0 >= 520) break;
                    const f32x16 s = lds_qk(qf, kb, kt, col, hb);
                    sm_pv(s, hb, [&](int kl) { const int j = j0 + kl; return j >= t + 1 && j <= 512 + t; }, [&](int dt, int s2) { return lds_vfrag(vb, kt, dt, s2, col, hb); }, m, l, o);
                }
            });
        l += __shfl_xor(l, 32);
        const float sc = l > 0.f ? g2 / l : 0.f;
        f32x16 of[2];
        of_get_add(ost, lane, o, sc, of);
        attn_store(p, of, qrow, head, hb, col < 4);
    }
    __syncthreads();
}

__device__ __forceinline__ void ph_attn(const P& p, LAS unsigned char* lds, int qsel = 0) {
    const int tid = threadIdx.x, lane = tid & 63, wid = tid >> 6;
    unsigned* ctr = p.bar() + 3584 + 64 * qsel;
    LAS unsigned* qslot = (LAS unsigned*)(lds + XB_OFF + 64);
    for (;;) {
        if (tid == 0) *qslot = __hip_atomic_fetch_add(ctr, 1u, __ATOMIC_RELAXED, __HIP_MEMORY_SCOPE_AGENT);
        __syncthreads();
        const unsigned q = __builtin_amdgcn_readfirstlane(*qslot);
        __syncthreads();
        if (q >= 64u + 512u) break;
#if defined(OLD_SAMPLE_ATTN)
        if (q < 64u) { attn_sample_item(p, (int)q * 8 + wid, lds + wid * WL_STRIDE, lane); __syncthreads(); }
#else
        if (q < 64u) attn_sample_block(p, (int)q, lds);
#endif
#if defined(OLD_PROMPT_ATTN)
        else { const int idx = (int)q - 64; attn_prompt_item(p, 4095 - (idx * 8 + wid), lds + wid * WL_STRIDE, lane); __syncthreads(); }
#else
        else { const int idx = (int)q - 64; attn_prompt_block(p, idx & 7, 63 - (idx >> 3), lds);
#if defined(DBG_REDO_OLD)
            attn_prompt_item(p, (8 * (63 - (idx >> 3)) + wid) * 8 + (idx & 7), lds + wid * WL_STRIDE, lane); __syncthreads();
#endif
        }
#endif
    }
}

#if defined(DBG_CMPALL)
__device__ __forceinline__ void dbg_old_attn(const P& p, LAS unsigned char* lds) {
    const int tid = threadIdx.x, lane = tid & 63, wid = tid >> 6;
    for (int it = blockIdx.x * 8 + wid; it < 4096; it += gridDim.x * 8) attn_prompt_item(p, it, lds + wid * WL_STRIDE, lane, (bf16_t*)p.tmp());
}
__device__ __forceinline__ void dbg_compare(const P& p) {
    const int tid = threadIdx.x, lane = tid & 63, wid = tid >> 6;
    const bf16_t* a = p.oa(); const bf16_t* b = (const bf16_t*)p.tmp();
    unsigned cnt = 0;
    for (int it = blockIdx.x * 8 + wid; it < NP * 8; it += gridDim.x * 8) {
        const int row = it >> 3, head = it & 7;
        const float x = bf2f(a[(size_t)row * 512 + head * 64 + lane]), y = bf2f(b[(size_t)row * 512 + head * 64 + lane]);
        const bool bad = __any(!(fabsf(x - y) <= DBG_TOL));
        const int s = row & (SEQ - 1), j = s >> 6, w = (s >> 3) & 7, g = head >> 2, bb = row >> 12;
        if (bad && (DBG_SEL)) ++cnt;
    }
    if (lane == 0 && cnt) atomicAdd(p.bar() + 3840, cnt);
}
#endif

#if defined(KEEP_OLD_PATH)
__device__ __forceinline__ void keep_old_attn(const P& p, LAS unsigned char* lds) {
    const int tid = threadIdx.x, lane = tid & 63, wid = tid >> 6;
    const int ndbg = (int)__builtin_amdgcn_readfirstlane(__hip_atomic_load(p.bar() + 3900, __ATOMIC_RELAXED, __HIP_MEMORY_SCOPE_AGENT));
    for (int it = blockIdx.x * 8 + wid; it < ndbg; it += gridDim.x * 8) attn_prompt_item(p, it, lds + wid * WL_STRIDE, lane, (bf16_t*)p.tmp());
}
#endif
#ifndef PROBE_PHASE
#define PROBE_PHASE 0
#endif
#ifndef STOP_AFTER
#define STOP_AFTER 3
#endif

constexpr int LDS_BYTES = pg8::STAGE_BYTES;

template <class Epi> __global__ __launch_bounds__(512, 2) void k_gemm(pg8::Gemm g, Epi E) {
    extern __shared__ __attribute__((aligned(16))) unsigned char shm[];
    pg8::StaticOrder S; S.init(g.M, g.N, (int)gridDim.x, (int)blockIdx.x);
    pg8::gemm_phase<Epi, pg8::StaticOrder, false>((PG8_LAS unsigned char*)shm, g, S, E, nullptr);
}
template <int PH> __global__ __launch_bounds__(512, 2) void k_phase(P p) {
    extern __shared__ __attribute__((aligned(16))) unsigned char shm[];
    LAS unsigned char* lds = (LAS unsigned char*)shm;
    if constexpr (PH == 0) ph_prep(p);
    if constexpr (PH == 1) ph_compress2(p, p.LHp(), 8, 256, 255, p.kc_p(), p.vcT_p());
    if constexpr (PH == 2) ph_cvt_cache(p);
    if constexpr (PH == 3) ph_compress2(p, p.LHs(), 64, 1024, 1023, p.kc_s(), p.vcT_s());
    if constexpr (PH == 4) ph_rwkv_prep(p);
    if constexpr (PH == 5) ph_rwkv_scan(p, (LAS float*)lds);
    if constexpr (PH == 6) ph_rwkv_post(p);
    if constexpr (PH == 7) ph_attn(p, lds);
    if constexpr (PH == 8) ph_final(p);
}

template <class Epi> static void launch_gemm(hipStream_t st, const bf16_t* A, const bf16_t* Bt, int M, int N, int K, const Epi& E) {
    static bool attr = false;
    if (!attr) { (void)hipFuncSetAttribute((const void*)k_gemm<Epi>, hipFuncAttributeMaxDynamicSharedMemorySize, LDS_BYTES); attr = true; }
    pg8::Gemm g{}; g.A = A; g.Bt = Bt; g.M = M; g.N = N; g.K = K;
    hipLaunchKernelGGL((k_gemm<Epi>), dim3(256), dim3(512), LDS_BYTES, st, g, E);
}
template <int PH> static void launch_phase(hipStream_t st, const P& p) {
    static bool attr = false;
    if (!attr) { (void)hipFuncSetAttribute((const void*)k_phase<PH>, hipFuncAttributeMaxDynamicSharedMemorySize, LDS_BYTES); attr = true; }
    hipLaunchKernelGGL((k_phase<PH>), dim3(256), dim3(512), LDS_BYTES, st, p);
}


constexpr int FUSED_LDS = XB_OFF + 256;

template <class Epi> __device__ __forceinline__ void run_gemm(LAS unsigned char* lds, const bf16_t* A, const bf16_t* Bt, int M, int N, int K, const Epi& E) {
    pg8::Gemm g; g.A = A; g.Bt = Bt; g.M = M; g.N = N; g.K = K; g.pad_ = 0;
    pg8::StaticOrder S; S.init(M, N, (int)gridDim.x, (int)blockIdx.x);
    pg8::gemm_phase<Epi, pg8::StaticOrder, false>((PG8_LAS unsigned char*)lds, g, S, E, nullptr);
}

#if defined(DBG_LDSCLEAR)
#define XBAR() do { xcd_barrier(bar); for (int _i = threadIdx.x * 16; _i < XB_OFF; _i += 512 * 16) *(LAS u32x4_t*)(lds + _i) = (u32x4_t){DBG_FILL, DBG_FILL, DBG_FILL, DBG_FILL}; __syncthreads(); } while (0)
#elif defined(DBG_DOUBLEBAR)
#define XBAR() do { xcd_barrier(bar); xcd_barrier(bar); } while (0)
#else
#define XBAR() xcd_barrier(bar)
#endif
__global__ __launch_bounds__(512, 2) void k_fused(P p) {
    extern __shared__ __attribute__((aligned(16))) unsigned char shm[];
    LAS unsigned char* lds = (LAS unsigned char*)shm;
    LAS unsigned* xb = (LAS unsigned*)(lds + XB_OFF);
    if (threadIdx.x == 0) { xb[0] = 0u; xb[1] = 0u; xb[2] = 0u; xb[3] = 0u; }
    __syncthreads();
    XcdBarrier bar = xcd_barrier_post(p.bar(), (volatile LAS unsigned*)xb);
    ph_prep(p);
#if PROBE_PHASE == 1
    XBAR();
    ph_prep(p);
#endif
    XBAR();
    { EpiIn e; e.p = p; e.row0 = 0; e.pad_ = 0; run_gemm(lds, p.hb(), p.WinT(), MR, NPAD, DM, e); }
    ph_cmp_gemm_f32(p, lds);
#if PROBE_PHASE == 21
    XBAR();
    { EpiIn e; e.p = p; e.row0 = 0; e.pad_ = 0; run_gemm(lds, p.hb(), p.WinT(), MR, NPAD, DM, e); }
#endif
#if PROBE_PHASE == 22
    XBAR();
    ph_cmp_gemm_f32(p, lds);
#endif
#if PROBE_PHASE == 2
    XBAR();
    { EpiIn e; e.p = p; e.row0 = 0; e.pad_ = 0; run_gemm(lds, p.hb(), p.WinT(), MR, NPAD, DM, e); }
    ph_cmp_gemm_f32(p, lds);
#endif
    XBAR();
    { EpiPlainBf e; e.C = p.LHp(); e.ldc = 256; e.pad_ = 0; run_gemm(lds, p.kb(), p.W1T(), 2048, 256, 1024, e); }
    { EpiPlainBf e; e.C = p.LHp() + (size_t)2048 * 256; e.ldc = 256; e.pad_ = 0; run_gemm(lds, p.vcr(), p.W1T() + (size_t)256 * 1024, 2048, 256, 1024, e); }
    ph_rwkv_prep(p);
    ph_compress2(p, p.LHs(), 64, 1024, 1023, p.kc_s(), p.vcT_s());
#if PROBE_PHASE == 3
    XBAR();
    { EpiPlainBf e; e.C = p.LHp(); e.ldc = 256; e.pad_ = 0; run_gemm(lds, p.kb(), p.W1T(), 2048, 256, 1024, e); }
    { EpiPlainBf e; e.C = p.LHp() + (size_t)2048 * 256; e.ldc = 256; e.pad_ = 0; run_gemm(lds, p.vcr(), p.W1T() + (size_t)256 * 1024, 2048, 256, 1024, e); }
    ph_rwkv_prep(p);
    ph_compress2(p, p.LHs(), 64, 1024, 1023, p.kc_s(), p.vcT_s());
#endif
    XBAR();
    ph_compress2(p, p.LHp(), 8, 256, 255, p.kc_p(), p.vcT_p());
    XBAR();
    ph_rwkv_scan(p, (LAS float*)lds);
#if defined(SCAN_SEPARATE)
    XBAR();
#endif
    __syncthreads();
    ph_attn(p, lds);
#if PROBE_PHASE == 5
    XBAR();
    ph_attn(p, lds, 1);
#endif
    XBAR();
#if defined(KEEP_OLD_PATH)
    keep_old_attn(p, lds);
#endif
#if defined(DBG_XBAR)
    XBAR();
    XBAR();
#endif
#if defined(DBG_CMPALL)
    dbg_old_attn(p, lds);
    XBAR();
    dbg_compare(p);
    XBAR();
#endif
    ph_rwkv_post(p);
    { EpiYa e; e.p = p; small_gemm(p.oa(), p.WpaT(), 512, e); run_gemm(lds, p.oa(), p.WpaT(), NP, DM, 512, e); }
#if PROBE_PHASE == 6
    XBAR();
    ph_rwkv_post(p);
    { EpiYa e; e.p = p; small_gemm(p.oa(), p.WpaT(), 512, e); run_gemm(lds, p.oa(), p.WpaT(), NP, DM, 512, e); }
#endif
    XBAR();
    { EpiYb e; e.p = p; small_gemm(p.ob(), p.WpbT(), 512, e); run_gemm(lds, p.ob(), p.WpbT(), NP, DM, 512, e); }
#if PROBE_PHASE == 7
    XBAR();
    { EpiYb e; e.p = p; small_gemm(p.ob(), p.WpbT(), 512, e); run_gemm(lds, p.ob(), p.WpbT(), NP, DM, 512, e); }
#endif
    XBAR();
    { EpiOut e; e.p = p; small_gemm(p.mb(), p.WoutT(), DM, e); run_gemm(lds, p.mb(), p.WoutT(), NP, DM, DM, e); }
    { EpiPlain e; e.C = p.pp(); e.ldc = DM; e.pad_ = 0; small_gemm(p.pb(), p.WprojT(), 256, e); run_gemm(lds, p.pb(), p.WprojT(), NP, DM, 256, e); }
#if PROBE_PHASE == 8
    XBAR();
    { EpiOut e; e.p = p; small_gemm(p.mb(), p.WoutT(), DM, e); run_gemm(lds, p.mb(), p.WoutT(), NP, DM, DM, e); }
    { EpiPlain e; e.C = p.pp(); e.ldc = DM; e.pad_ = 0; small_gemm(p.pb(), p.WprojT(), 256, e); run_gemm(lds, p.pb(), p.WprojT(), NP, DM, 256, e); }
#endif
    XBAR();
    { EpiGate e; e.p = p; small_gemm(p.xg(), p.WgateT(), DM, e); run_gemm(lds, p.xg(), p.WgateT(), NP, DM, DM, e); }
#if PROBE_PHASE == 9
    XBAR();
    { EpiGate e; e.p = p; small_gemm(p.xg(), p.WgateT(), DM, e); run_gemm(lds, p.xg(), p.WgateT(), NP, DM, DM, e); }
#endif
    XBAR();
    ph_final(p);
}
extern "C" void kernel_launch(void* const* d_in, const int* in_sizes, int n_in, void* d_out, int out_size, void* d_ws, size_t ws_size, hipStream_t stream) {
    (void)in_sizes; (void)n_in; (void)out_size; (void)ws_size;
    P p{};
    p.x_prompt = (const float*)d_in[0]; p.x_sample = (const float*)d_in[1]; p.p_prompt = (const float*)d_in[2]; p.p_sample = (const float*)d_in[3];
    p.cache_cmp = (const float*)d_in[4]; p.cache_sel = (const float*)d_in[5]; p.cache_win = (const float*)d_in[6]; p.state_wkv = (const float*)d_in[7];
    p.state_shift = (const float*)d_in[8]; p.page_table = (const int*)d_in[9]; p.norm_g = (const float*)d_in[10]; p.w_in = (const float*)d_in[11];
    p.cmp_pe = (const float*)d_in[12]; p.cmp_w1 = (const float*)d_in[13]; p.cmp_b1 = (const float*)d_in[14]; p.cmp_w2 = (const float*)d_in[15]; p.cmp_b2 = (const float*)d_in[16];
    p.w_pa = (const float*)d_in[17]; p.mu = (const float*)d_in[18]; p.w0 = (const float*)d_in[19]; p.w_up = (const float*)d_in[20]; p.a0 = (const float*)d_in[21];
    p.a_up = (const float*)d_in[22]; p.k_k = (const float*)d_in[23]; p.k_a = (const float*)d_in[24]; p.r_k = (const float*)d_in[25]; p.gn_g = (const float*)d_in[26];
    p.gn_b = (const float*)d_in[27]; p.w_pb = (const float*)d_in[28]; p.w_out = (const float*)d_in[29]; p.ple_g = (const float*)d_in[30]; p.w_gate = (const float*)d_in[31];
    p.w_proj = (const float*)d_in[32]; p.final_g = (const float*)d_in[33];
    p.out = (float*)d_out;
    p.ws = (unsigned char*)d_ws;

#if defined(MULTI_LAUNCH)
    launch_phase<0>(stream, p);
    { EpiIn e{}; e.p = p; e.row0 = 0; launch_gemm(stream, p.hb(), p.WinT(), MR, NPAD, DM, e); }
#if STOP_AFTER >= 3
    { EpiPlain e{}; e.C = p.LHp(); e.ldc = 256; launch_gemm(stream, p.kb(), p.W1T(), 2048, 256, 1024, e); }
    { EpiPlain e{}; e.C = p.LHp() + (size_t)2048 * 256; e.ldc = 256; launch_gemm(stream, p.vcr(), p.W1T() + (size_t)256 * 1024, 2048, 256, 1024, e); }
    launch_phase<1>(stream, p);
    launch_phase<2>(stream, p);
    { EpiPlain e{}; e.C = p.LHs(); e.ldc = 256; launch_gemm(stream, p.cs(), p.W1T(), 65536, 256, 1024, e); }
    { EpiPlain e{}; e.C = p.LHs() + (size_t)65536 * 256; e.ldc = 256; launch_gemm(stream, p.cs() + (size_t)65536 * 1024, p.W1T() + (size_t)256 * 1024, 65536, 256, 1024, e); }
    launch_phase<3>(stream, p);
#endif
#if STOP_AFTER >= 2
    launch_phase<4>(stream, p);
    launch_phase<5>(stream, p);
    launch_phase<6>(stream, p);
#endif
    hipMemsetAsync(p.oa(), 0, (size_t)MR * 512 * 2, stream);
#if STOP_AFTER >= 3
    launch_phase<7>(stream, p);
#endif
    { EpiYa e{}; e.p = p; launch_gemm(stream, p.oa(), p.WpaT(), MR, DM, 512, e); }
    { EpiYb e{}; e.p = p; launch_gemm(stream, p.ob(), p.WpbT(), MR, DM, 512, e); }
    { EpiOut e{}; e.p = p; launch_gemm(stream, p.mb(), p.WoutT(), MR, DM, DM, e); }
    { EpiPlain e{}; e.C = p.pp(); e.ldc = DM; launch_gemm(stream, p.pb(), p.WprojT(), MR, DM, 256, e); }
    { EpiGate e{}; e.p = p; launch_gemm(stream, p.xg(), p.WgateT(), MR, DM, DM, e); }
    launch_phase<8>(stream, p);
#else
    static int grid = 0;
    if (!grid) {
        int dev = 0, cus = 0, per_cu = 0;
        (void)hipGetDevice(&dev);
        (void)hipDeviceGetAttribute(&cus, hipDeviceAttributeMultiprocessorCount, dev);
        (void)hipFuncSetAttribute((const void*)k_fused, hipFuncAttributeMaxDynamicSharedMemorySize, FUSED_LDS);
        (void)hipOccupancyMaxActiveBlocksPerMultiprocessor(&per_cu, k_fused, 512, FUSED_LDS);
        grid = per_cu >= 1 ? cus : 0;
        if (grid > 256) grid = 256;
    }
    (void)hipMemsetAsync(p.bar(), 0, 32768, stream);
    if (grid > 0) hipLaunchKernelGGL(k_fused, dim3(grid), dim3(512), FUSED_LDS, stream, p);
#endif
}
```

```cpp
#include <hip/hip_runtime.h>
#include <stdint.h>
#include <stdio.h>
namespace pg8 {
#define PG8_LAS __attribute__((address_space(3)))
typedef unsigned short bf16_t;
typedef short bf16x8 __attribute__((ext_vector_type(8)));
typedef float f32x4 __attribute__((ext_vector_type(4)));
typedef unsigned u32x4 __attribute__((ext_vector_type(4)));
constexpr int BM = 256, BK = 64, HALF = 128, HTB = HALF * BK * 2  , STAGE_BYTES = 8 * HTB, NXCD = 8, WGM = 8;

__host__ __device__ __forceinline__ int lds_byte(int r, int c) { const int st = (r >> 4) * 2 + (c >> 5), rr = r & 15, cc = c & 31, ob = rr * 64 + cc * 2; return st * 1024 + (ob ^ (((ob >> 9) & 1) << 5)); }
__host__ __device__ __forceinline__ void stage_rc(int b, int& R, int& C) { const int st = b / 1024, sb = b % 1024, swz = sb ^ (((sb >> 9) & 1) << 5); R = (st >> 1) * 16 + swz / 64; C = (st & 1) * 32 + (swz % 64) / 2; }
__host__ __device__ __forceinline__ int perm32(int rho) { const int n = rho >> 4, i = rho & 15; return 8 * (i >> 2) + 4 * n + (i & 3); }

struct Unit { int pm, pn; };
struct Gemm { const bf16_t* A; const bf16_t* Bt; int M, N, K, pad_; };

struct StaticOrder {
    int nM, nN, nwg, G, c;
    __host__ __device__ void init(int M, int N, int G_, int c_) { nM = M / BM; nN = N / BM; nwg = nM * nN; G = G_; c = c_; }
    __host__ __device__ bool next(int i, Unit& u) const {
        const long L = (long)i * G + c; if (L >= nwg) return false;
        int wgid = (int)L; { const int q = nwg / NXCD, r = nwg % NXCD, xcd = wgid % NXCD, off = wgid / NXCD; wgid = (xcd < r ? xcd * (q + 1) : r * (q + 1) + (xcd - r) * q) + off; }
        const int nig = WGM * nN, gid = wgid / nig, fm = gid * WGM, gsz = (nM - fm) < WGM ? (nM - fm) : WGM;
        u.pm = fm + ((wgid % nig) % gsz); u.pn = (wgid % nig) / gsz; return true;
    }
    __device__ __forceinline__ void a_ready(const Unit&) const {}
    __device__ __forceinline__ void done(const Unit&) const {}
};
__device__ __forceinline__ unsigned cvt_pk_bf16(float lo, float hi) { unsigned r; asm volatile("v_cvt_pk_bf16_f32 %0, %1, %2" : "=v"(r) : "v"(lo), "v"(hi)); return r; }
typedef float f32x2 __attribute__((ext_vector_type(2)));
template <class Epi, class Sched, bool STAMP = false>
__device__ __forceinline__ void gemm_phase(PG8_LAS unsigned char* lds, const Gemm g, const Sched& S, const Epi& E, unsigned long long* stamps) {
    int tid_l = threadIdx.x; asm volatile("" : "+v"(tid_l));
    const int tid = tid_l, wid = __builtin_amdgcn_readfirstlane(tid >> 6), lane = tid & 63, wr = wid >> 2, wc = wid & 3, fr = lane & 15, fq = lane >> 4;
    const int K = g.K, nt = K / BK;
    int ts_lo = 0, ts_hi = 0, nts = 0; const unsigned long long rt_entry = STAMP ? (unsigned long long)wall_clock64() : 0ull;
#define PG8_STAMP() do { if (STAMP && wid == 0 && nts < 64) { const unsigned long long _c = (unsigned long long)clock64(); \
        ts_lo = (lane == nts) ? (int)(unsigned)_c : ts_lo; ts_hi = (lane == nts) ? (int)(unsigned)(_c >> 32) : ts_hi; ++nts; } } while (0)
    PG8_STAMP();
    unsigned voffA[2], voffB[2];
#pragma unroll
    for (int i = 0; i < 2; ++i) { int R, C; stage_rc(tid * 16 + i * 8192, R, C); const int Rb = Epi::PERM ? ((R & ~31) + perm32(R & 31)) : R;
        voffA[i] = (unsigned)(R * K + C) * 2u; voffB[i] = (unsigned)(Rb * K + C) * 2u; }
    const size_t kstep = (size_t)(BK * 2);
    const size_t hstep = (size_t)HALF * K * 2;
    const size_t tstep = 2 * hstep;
    const unsigned ldsw = (unsigned)wid * 1024u;
    const int aoff = lds_byte(wr * 64 + fr, fq * 8), boff = lds_byte(wc * 32 + fr, fq * 8);
#define PG8_SA(b, h) (((b) * 2 + (h)) * HTB)
#define PG8_SB(b, h) ((4 + (b) * 2 + (h)) * HTB)
#define PG8_STAGE(bufoff, gbase, voff) do { _Pragma("unroll") for (int _i = 0; _i < 2; ++_i) \
        __builtin_amdgcn_global_load_lds((const unsigned*)((const char*)(gbase) + (voff)[_i]), (PG8_LAS unsigned*)(lds + (bufoff) + ldsw + _i * 8192), 16, 0, 0); } while (0)
#define PG8_LDA(dst, b, h) do { _Pragma("unroll") for (int m = 0; m < 4; ++m) _Pragma("unroll") for (int k = 0; k < 2; ++k) dst[m][k] = *(const PG8_LAS bf16x8*)(lds + PG8_SA(b, h) + aoff + m * 2048 + k * 1024); } while (0)
#define PG8_LDB(dst, b, h) do { _Pragma("unroll") for (int n = 0; n < 2; ++n) _Pragma("unroll") for (int k = 0; k < 2; ++k) dst[n][k] = *(const PG8_LAS bf16x8*)(lds + PG8_SB(b, h) + boff + n * 2048 + k * 1024); } while (0)
#define PG8_MMA(ai, bj, At, Bt) do { __builtin_amdgcn_s_setprio(1); _Pragma("unroll") for (int m = 0; m < 4; ++m) _Pragma("unroll") for (int n = 0; n < 2; ++n) _Pragma("unroll") for (int k = 0; k < 2; ++k) \
        acc[ai][bj][m][n] = __builtin_amdgcn_mfma_f32_16x16x32_bf16(Bt[n][k], At[m][k], acc[ai][bj][m][n], 0, 0, 0); __builtin_amdgcn_s_setprio(0); } while (0)
#define PG8_WAIT_V(n) asm volatile("s_waitcnt vmcnt(" #n ")" ::: "memory")
#define PG8_WAIT_L(n) asm volatile("s_waitcnt lgkmcnt(" #n ")" ::: "memory")
#define PG8_BAR __builtin_amdgcn_s_barrier()
#define PG8_SCHED __builtin_amdgcn_sched_barrier(0)
    Unit cur, nxt; int ui = 0;
    if (!S.next(0, cur)) return;
    f32x4 acc[2][2][4][2];
#pragma unroll
    for (int a = 0; a < 2; ++a)
#pragma unroll
        for (int b = 0; b < 2; ++b)
#pragma unroll
            for (int m = 0; m < 4; ++m)
#pragma unroll
                for (int n = 0; n < 2; ++n) acc[a][b][m][n] = (f32x4){0.f, 0.f, 0.f, 0.f};
    bf16x8 At[4][2], B0[2][2], B1[2][2];
    const char* cA = (const char*)g.A + (size_t)cur.pm * tstep; const char* cB = (const char*)g.Bt + (size_t)cur.pn * tstep;
    S.a_ready(cur);
    PG8_STAGE(PG8_SB(0, 0), cB, voffB); PG8_STAGE(PG8_SA(0, 0), cA, voffA); PG8_STAGE(PG8_SB(0, 1), cB + hstep, voffB); PG8_STAGE(PG8_SA(0, 1), cA + hstep, voffA);
    if (wr == 1) PG8_BAR;
    PG8_WAIT_V(4); PG8_BAR;
    PG8_STAGE(PG8_SB(1, 0), cB + kstep, voffB); PG8_STAGE(PG8_SA(1, 0), cA + kstep, voffA); PG8_STAGE(PG8_SB(1, 1), cB + hstep + kstep, voffB);
    PG8_WAIT_V(6); PG8_BAR;
    PG8_STAMP();
    for (;;) {
        const bool has_next = S.next(ui + 1, nxt);
        const char* nA = has_next ? (const char*)g.A + (size_t)nxt.pm * tstep : cA; const char* nB = has_next ? (const char*)g.Bt + (size_t)nxt.pn * tstep : cB;
        for (int t = 0; t < nt; t += 2) {
            const bool last = (t == nt - 2);
            const char* a1 = cA + (size_t)(t + 1) * kstep;
            const char* a2 = last ? nA : cA + (size_t)(t + 2) * kstep; const char* b2 = last ? nB : cB + (size_t)(t + 2) * kstep;
            const char* a3 = a2 + kstep; const char* b3 = b2 + kstep;
            if (last && has_next) S.a_ready(nxt);
            PG8_LDB(B0, 0, 0); PG8_SCHED; PG8_LDA(At, 0, 0); PG8_STAGE(PG8_SA(1, 1), a1 + hstep, voffA);
            PG8_WAIT_L(8); PG8_BAR; PG8_WAIT_L(0); PG8_MMA(0, 0, At, B0); PG8_BAR; PG8_SCHED;
            PG8_LDB(B1, 0, 1); PG8_STAGE(PG8_SB(0, 0), b2, voffB);
            PG8_BAR; PG8_WAIT_L(0); PG8_MMA(0, 1, At, B1); PG8_BAR;
            PG8_LDA(At, 0, 1); PG8_STAGE(PG8_SA(0, 0), a2, voffA);
            PG8_BAR; PG8_WAIT_L(0); PG8_MMA(1, 0, At, B0); PG8_BAR; PG8_SCHED;
            PG8_STAGE(PG8_SB(0, 1), b2 + hstep, voffB);
            PG8_WAIT_V(6); PG8_BAR; PG8_MMA(1, 1, At, B1); PG8_BAR;
            PG8_LDB(B0, 1, 0); PG8_SCHED; PG8_LDA(At, 1, 0); PG8_STAGE(PG8_SA(0, 1), a2 + hstep, voffA);
            PG8_WAIT_L(8); PG8_BAR; PG8_WAIT_L(0); PG8_MMA(0, 0, At, B0); PG8_BAR; PG8_SCHED;
            PG8_LDB(B1, 1, 1); PG8_STAGE(PG8_SB(1, 0), b3, voffB);
            PG8_BAR; PG8_WAIT_L(0); PG8_MMA(0, 1, At, B1); PG8_BAR;
            PG8_LDA(At, 1, 1); PG8_STAGE(PG8_SA(1, 0), a3, voffA);
            PG8_BAR; PG8_WAIT_L(0); PG8_MMA(1, 0, At, B0); PG8_BAR; PG8_SCHED;
            PG8_STAGE(PG8_SB(1, 1), b3 + hstep, voffB);
            PG8_WAIT_V(6); PG8_BAR; PG8_MMA(1, 1, At, B1); PG8_BAR;
        }
        PG8_STAMP();
        if constexpr (!Epi::AFTER_DRAIN) { E(acc, cur, wr, wc, fr, fq); S.done(cur); }
        PG8_STAMP();
        if (!has_next) break;
#pragma unroll
        for (int a = 0; a < 2; ++a)
#pragma unroll
            for (int b = 0; b < 2; ++b)
#pragma unroll
                for (int m = 0; m < 4; ++m)
#pragma unroll
                    for (int n = 0; n < 2; ++n) acc[a][b][m][n] = (f32x4){0.f, 0.f, 0.f, 0.f};
        cur = nxt; cA = nA; cB = nB; ++ui;
    }
    PG8_WAIT_V(0);
    if (wr == 0) PG8_BAR;
    PG8_BAR;
    if constexpr (Epi::AFTER_DRAIN) { E.fused(acc, cur, wr, wc, fr, fq, lds, wid, lane); S.done(cur); }
    PG8_STAMP();
    if (STAMP && wid == 0) { stamps[lane] = lane < nts ? (((unsigned long long)(unsigned)ts_hi << 32) | (unsigned)ts_lo) : 0ull;
        if (lane == 62) stamps[62] = rt_entry; if (lane == 63) stamps[63] = (unsigned long long)wall_clock64(); }
#undef PG8_STAMP
#undef PG8_SA
#undef PG8_SB
#undef PG8_STAGE
#undef PG8_LDA
#undef PG8_LDB
#undef PG8_MMA
#undef PG8_WAIT_V
#undef PG8_WAIT_L
#undef PG8_BAR
#undef PG8_SCHED
}
}

typedef unsigned short bf16_t;
typedef short bf16x8 __attribute__((ext_vector_type(8)));
typedef float f32x4 __attribute__((ext_vector_type(4)));
typedef float f32x16 __attribute__((ext_vector_type(16)));
#define LAS __attribute__((address_space(3)))
#define WAVE_SYNC() do { asm volatile("s_waitcnt lgkmcnt(0)" ::: "memory"); __builtin_amdgcn_wave_barrier(); } while (0)

constexpr int DM = 1024, NP = 16384, NSMP = 256, MR = 16640, SEQ = 4096, NB = 4, DB = 32, DS = 8, PAST = 16384;
constexpr int CIN = 6040, NPAD = 6144, CR = 1664;
constexpr int NTHR = 512;
constexpr size_t O_Y_P = 0, O_Y_S = 16777216, O_CMP_P = 17039360, O_CMP_S = 21233664, O_SEL_P = 21299200, O_SEL_S = 25493504,
                 O_WIN_P = 25559040, O_WIN_S = 26083328, O_WKV_P = 30277632, O_WKV_S = 30408704, O_SH_P = 31457280, O_SH_S = 31463936;

constexpr size_t ws_al(size_t x) { return (x + 255) & ~(size_t)255; }
constexpr size_t WS_bar = 0;
constexpr size_t WS_hb = WS_bar + ws_al(32768);
constexpr size_t WS_WinT = WS_hb + ws_al((size_t)MR * DM * 2);
constexpr size_t WS_WpaT = WS_WinT + ws_al((size_t)NPAD * DM * 2);
constexpr size_t WS_WpbT = WS_WpaT + ws_al((size_t)DM * 512 * 2);
constexpr size_t WS_WoutT = WS_WpbT + ws_al((size_t)DM * 512 * 2);
constexpr size_t WS_WgateT = WS_WoutT + ws_al((size_t)DM * DM * 2);
constexpr size_t WS_WprojT = WS_WgateT + ws_al((size_t)DM * DM * 2);
constexpr size_t WS_W1T = WS_WprojT + ws_al((size_t)DM * 256 * 2);
constexpr size_t WS_W2T = WS_W1T + ws_al((size_t)512 * 1024 * 2);
constexpr size_t WS_WupT = WS_W2T + ws_al((size_t)128 * 128 * 2);
constexpr size_t WS_AupT = WS_WupT + ws_al((size_t)512 * 64 * 2);
constexpr size_t WS_pb = WS_AupT + ws_al((size_t)512 * 64 * 2);
constexpr size_t WS_tabc = WS_pb + ws_al((size_t)MR * 256 * 2);
constexpr size_t WS_tabs = WS_tabc + ws_al((size_t)4104 * 32 * 4);
constexpr size_t WS_pt = WS_tabs + ws_al((size_t)4104 * 32 * 4);
constexpr size_t WS_qb = WS_pt + ws_al(256 * 4);
constexpr size_t WS_kb = WS_qb + ws_al((size_t)MR * 512 * 2);
constexpr size_t WS_vcr = WS_kb + ws_al((size_t)3 * NB * 2 * SEQ * 64 * 2);
constexpr size_t WS_vT = WS_vcr + ws_al((size_t)NB * 2 * SEQ * 64 * 2);
constexpr size_t WS_ag = WS_vT + ws_al((size_t)2 * NB * 2 * 64 * SEQ * 2);
constexpr size_t WS_rg = WS_ag + ws_al((size_t)MR * 512 * 2);
constexpr size_t WS_mg = WS_rg + ws_al((size_t)MR * 512 * 2);
constexpr size_t WS_gates = WS_mg + ws_al((size_t)MR * 2048 * 2);
constexpr size_t WS_rz = WS_gates + ws_al((size_t)MR * 32 * 4);
constexpr size_t WS_zs0 = WS_rz + ws_al((size_t)MR * CR * 2);
constexpr size_t WS_LHp = WS_zs0 + ws_al((size_t)33 * CR * 2);
constexpr size_t WS_LHs = WS_LHp + ws_al((size_t)2 * 2048 * 256 * 4);
constexpr size_t WS_cs = WS_LHs + ws_al((size_t)2 * 65536 * 256 * 4);
constexpr size_t WS_kc_p = WS_cs + ws_al((size_t)2 * 65536 * 1024 * 2);
constexpr size_t WS_vcT_p = WS_kc_p + ws_al((size_t)8 * 256 * 64 * 2);
constexpr size_t WS_kc_s = WS_vcT_p + ws_al((size_t)8 * 64 * 256 * 2);
constexpr size_t WS_vcT_s = WS_kc_s + ws_al((size_t)64 * 1024 * 64 * 2);
constexpr size_t WS_rw6 = WS_vcT_s + ws_al((size_t)64 * 64 * 1024 * 2);
constexpr int RW6_STRIDE = 896;
constexpr size_t WS_bonus = WS_rw6 + ws_al((size_t)MR * 8 * RW6_STRIDE);
constexpr size_t WS_ybuf = WS_bonus + ws_al((size_t)MR * 8 * 4);
constexpr size_t WS_oa = WS_ybuf + ws_al((size_t)MR * 512 * 4);
constexpr size_t WS_ob = WS_oa + ws_al((size_t)MR * 512 * 2);
constexpr size_t WS_mb = WS_ob + ws_al((size_t)MR * 512 * 2);
constexpr size_t WS_xg = WS_mb + ws_al((size_t)MR * DM * 2);
constexpr size_t WS_tmp = WS_xg + ws_al((size_t)MR * DM * 2);
constexpr size_t WS_x1 = WS_tmp + ws_al((size_t)MR * DM * 4);
constexpr size_t WS_ss1 = WS_x1 + ws_al((size_t)MR * DM * 4);
constexpr size_t WS_pp = WS_ss1 + ws_al((size_t)MR * 16 * 4);
constexpr size_t WS_TOTAL = WS_pp + ws_al((size_t)MR * DM * 4);

struct P {
    const float *x_prompt, *x_sample, *p_prompt, *p_sample, *cache_cmp, *cache_sel, *cache_win, *state_wkv, *state_shift;
    const int* page_table;
    const float *norm_g, *w_in, *cmp_pe, *cmp_w1, *cmp_b1, *cmp_w2, *cmp_b2, *w_pa, *mu, *w0, *w_up, *a0, *a_up, *k_k, *k_a, *r_k, *gn_g, *gn_b,
        *w_pb, *w_out, *ple_g, *w_gate, *w_proj, *final_g;
    float* out;
    unsigned char* ws;
    __host__ __device__ __forceinline__ unsigned* bar() const { return (unsigned*)(ws + WS_bar); }
    __host__ __device__ __forceinline__ float* ss_s() const { return (float*)(ws + WS_bar + 16384); }
    __host__ __device__ __forceinline__ bf16_t* hb() const { return (bf16_t*)(ws + WS_hb); }
    __host__ __device__ __forceinline__ bf16_t* WinT() const { return (bf16_t*)(ws + WS_WinT); }
    __host__ __device__ __forceinline__ bf16_t* WpaT() const { return (bf16_t*)(ws + WS_WpaT); }
    __host__ __device__ __forceinline__ bf16_t* WpbT() const { return (bf16_t*)(ws + WS_WpbT); }
    __host__ __device__ __forceinline__ bf16_t* WoutT() const { return (bf16_t*)(ws + WS_WoutT); }
    __host__ __device__ __forceinline__ bf16_t* WgateT() const { return (bf16_t*)(ws + WS_WgateT); }
    __host__ __device__ __forceinline__ bf16_t* WprojT() const { return (bf16_t*)(ws + WS_WprojT); }
    __host__ __device__ __forceinline__ bf16_t* W1T() const { return (bf16_t*)(ws + WS_W1T); }
    __host__ __device__ __forceinline__ bf16_t* W2T() const { return (bf16_t*)(ws + WS_W2T); }
    __host__ __device__ __forceinline__ bf16_t* WupT() const { return (bf16_t*)(ws + WS_WupT); }
    __host__ __device__ __forceinline__ bf16_t* AupT() const { return (bf16_t*)(ws + WS_AupT); }
    __host__ __device__ __forceinline__ bf16_t* pb() const { return (bf16_t*)(ws + WS_pb); }
    __host__ __device__ __forceinline__ float* tabc() const { return (float*)(ws + WS_tabc); }
    __host__ __device__ __forceinline__ float* tabs() const { return (float*)(ws + WS_tabs); }
    __host__ __device__ __forceinline__ float* pt() const { return (float*)(ws + WS_pt); }
    __host__ __device__ __forceinline__ bf16_t* qb() const { return (bf16_t*)(ws + WS_qb); }
    __host__ __device__ __forceinline__ bf16_t* kb() const { return (bf16_t*)(ws + WS_kb); }
    __host__ __device__ __forceinline__ bf16_t* vcr() const { return (bf16_t*)(ws + WS_vcr); }
    __host__ __device__ __forceinline__ bf16_t* vT() const { return (bf16_t*)(ws + WS_vT); }
    __host__ __device__ __forceinline__ bf16_t* ag() const { return (bf16_t*)(ws + WS_ag); }
    __host__ __device__ __forceinline__ bf16_t* rg() const { return (bf16_t*)(ws + WS_rg); }
    __host__ __device__ __forceinline__ bf16_t* mg() const { return (bf16_t*)(ws + WS_mg); }
    __host__ __device__ __forceinline__ float* gates() const { return (float*)(ws + WS_gates); }
    __host__ __device__ __forceinline__ bf16_t* rz() const { return (bf16_t*)(ws + WS_rz); }
    __host__ __device__ __forceinline__ bf16_t* zs0() const { return (bf16_t*)(ws + WS_zs0); }
    __host__ __device__ __forceinline__ bf16_t* LHp() const { return (bf16_t*)(ws + WS_LHp); }
    __host__ __device__ __forceinline__ bf16_t* LHs() const { return (bf16_t*)(ws + WS_LHs); }
    __host__ __device__ __forceinline__ bf16_t* cs() const { return (bf16_t*)(ws + WS_cs); }
    __host__ __device__ __forceinline__ bf16_t* kc_p() const { return (bf16_t*)(ws + WS_kc_p); }
    __host__ __device__ __forceinline__ bf16_t* vcT_p() const { return (bf16_t*)(ws + WS_vcT_p); }
    __host__ __device__ __forceinline__ bf16_t* kc_s() const { return (bf16_t*)(ws + WS_kc_s); }
    __host__ __device__ __forceinline__ bf16_t* vcT_s() const { return (bf16_t*)(ws + WS_vcT_s); }
    __host__ __device__ __forceinline__ unsigned char* rw6() const { return ws + WS_rw6; }
    __host__ __device__ __forceinline__ float* bonus() const { return (float*)(ws + WS_bonus); }
    __host__ __device__ __forceinline__ float* ybuf() const { return (float*)(ws + WS_ybuf); }
    __host__ __device__ __forceinline__ bf16_t* oa() const { return (bf16_t*)(ws + WS_oa); }
    __host__ __device__ __forceinline__ bf16_t* ob() const { return (bf16_t*)(ws + WS_ob); }
    __host__ __device__ __forceinline__ bf16_t* mb() const { return (bf16_t*)(ws + WS_mb); }
    __host__ __device__ __forceinline__ bf16_t* xg() const { return (bf16_t*)(ws + WS_xg); }
    __host__ __device__ __forceinline__ float* tmp() const { return (float*)(ws + WS_tmp); }
    __host__ __device__ __forceinline__ float* x1() const { return (float*)(ws + WS_x1); }
    __host__ __device__ __forceinline__ float* ss1() const { return (float*)(ws + WS_ss1); }
    __host__ __device__ __forceinline__ float* pp() const { return (float*)(ws + WS_pp); }
};

__device__ __forceinline__ bf16_t f2bf(float f) { unsigned u = __float_as_uint(f); u += 0x7FFFu + ((u >> 16) & 1u); return (bf16_t)(u >> 16); }
__device__ __forceinline__ float bf2f(bf16_t b) { return __uint_as_float(((unsigned)b) << 16); }
typedef __bf16 bf16v2_t __attribute__((ext_vector_type(2)));
typedef float f32x2_t __attribute__((ext_vector_type(2)));
__device__ __forceinline__ unsigned pk2(float lo, float hi) { const f32x2_t v = {lo, hi}; return __builtin_bit_cast(unsigned, __builtin_convertvector(v, bf16v2_t)); }
__device__ __forceinline__ float wave_sum(float v) {
#pragma unroll
    for (int o = 32; o >= 1; o >>= 1) v += __shfl_xor(v, o);
    return v;
}
#ifndef FAST_RCP_SITES
#define FAST_RCP_SITES 1
#endif
__device__ __forceinline__ float sigmoidf_(float x) { return 1.0f / (1.0f + __expf(-x)); }
__device__ __forceinline__ float siluf_(float x) { return x / (1.0f + __expf(-x)); }
__device__ __forceinline__ float sigmoid_fast(float x) { return __builtin_amdgcn_rcpf(1.0f + __expf(-x)); }
#if defined(SILU_DIVMUL)
__device__ __forceinline__ float silu_fast(float x) { return x * (1.0f / (1.0f + __expf(-x))); }
#elif defined(SILU_NOP)
__device__ __forceinline__ float silu_fast(float x) { float r = __builtin_amdgcn_rcpf(1.0f + __expf(-x)); asm(SILU_NOP_STR : "+v"(r)); return x * r; }
#else
__device__ __forceinline__ float silu_fast(float x) { return x * __builtin_amdgcn_rcpf(1.0f + __expf(-x)); }
#endif
#define SIG(site, x) (((FAST_RCP_SITES) & (site)) ? sigmoid_fast(x) : sigmoidf_(x))
#define SILU(site, x) (((FAST_RCP_SITES) & (site)) ? silu_fast(x) : siluf_(x))

__device__ __forceinline__ int win_src_col(int np) {
    const int pn = np >> 8, p = np & 255;
    if (pn < 5) {
        const int bj = p >> 7, wc = (p >> 5) & 3, n = (p >> 4) & 1, fq = (p >> 2) & 3, e = p & 3;
        const int d = 32 * n + 16 * (wc & 1) + 4 * fq + e;
        if (pn < 2) { const int head = pn * 4 + bj * 2 + (wc >> 1); return head * 64 + d; }
        const int br = pn - 2, g = wc >> 1;
        return 512 + br * 256 + bj * 128 + g * 64 + d;
    }
    const int s = (p & 0xe0) + 8 * ((p >> 2) & 3) + 4 * ((p >> 4) & 1) + (p & 3);
    if (pn < 7) return 1304 + (pn - 5) * 256 + s;
    if (pn < 13) return 1816 + (pn - 7) * 256 + s;
    if (pn == 13) { if (s < 128) return 1816 + 1536 + s; if (s < 152) return 1280 + (s - 128); return -1; }
    if (pn < 16) return 3480 + (pn - 14) * 256 + s;
    return 3992 + (pn - 16) * 256 + s;
}

__device__ __forceinline__ int perm8(int np) { return (np & ~31) + 8 * ((np >> 2) & 3) + 4 * ((np >> 4) & 1) + (np & 3); }
template <class F>
__device__ __forceinline__ void transpose_cvt(bf16_t* dst, int Nd, int K, F f) {
    const int total = Nd * (K >> 3);
    for (int id = blockIdx.x * NTHR + threadIdx.x; id < total; id += gridDim.x * NTHR) {
        const int n = id % Nd, kc = id / Nd;
        float v[8];
#pragma unroll
        for (int j = 0; j < 8; ++j) v[j] = f(n, kc * 8 + j);
        uint4 w; w.x = pk2(v[0], v[1]); w.y = pk2(v[2], v[3]); w.z = pk2(v[4], v[5]); w.w = pk2(v[6], v[7]);
        *(uint4*)(dst + (size_t)n * K + kc * 8) = w;
    }
}

__device__ __forceinline__ void sincos_small(double r, float& s, float& c) {
    const double r2 = r * r;
    double sa = 1.0, ca = 1.0;
    double ts = 1.0, tc = 1.0; sa = 0.0; ca = 0.0;
#pragma unroll
    for (int k = 0; k < 16; ++k) {
        sa += ts; ca += tc;
        ts = -ts * r2 / (double)((2 * k + 2) * (2 * k + 3));
        tc = -tc * r2 / (double)((2 * k + 1) * (2 * k + 2));
    }
    s = (float)(sa * r); c = (float)ca;
}

__device__ __forceinline__ void ph_prep(const P& p) {
    const int tid = threadIdx.x, lane = tid & 63, wid = tid >> 6;
    const int gw = blockIdx.x * 8 + wid, nw = gridDim.x * 8;
    const int gt = blockIdx.x * NTHR + tid, nt = gridDim.x * NTHR;
    for (int row = gw; row < MR; row += nw) {
        const float4* src = (const float4*)(row < NP ? p.x_prompt + (size_t)row * DM : p.x_sample + (size_t)(row - NP) * DM);
        float4 v[4]; float ss = 0.f;
#pragma unroll
        for (int i = 0; i < 4; ++i) { v[i] = src[lane + 64 * i]; ss += v[i].x * v[i].x + v[i].y * v[i].y + v[i].z * v[i].z + v[i].w * v[i].w; }
        ss = wave_sum(ss);
        const float rstd = rsqrtf(ss * (1.0f / DM) + 1e-6f);
#pragma unroll
        for (int i = 0; i < 4; ++i) {
            const float4 g = ((const float4*)p.norm_g)[lane + 64 * i];
            uint2 w; w.x = pk2(v[i].x * rstd * g.x, v[i].y * rstd * g.y); w.y = pk2(v[i].z * rstd * g.z, v[i].w * rstd * g.w);
            *(uint2*)(p.hb() + (size_t)row * DM + 4 * (lane + 64 * i)) = w;
        }
    }
    { const float* w = p.w_in; transpose_cvt(p.WinT(), NPAD, DM, [=](int n, int k) { const int c = win_src_col(n); return c < 0 ? 0.f : w[(size_t)k * CIN + c]; }); }
    { const float* w = p.w_pa; transpose_cvt(p.WpaT(), DM, 512, [=](int n, int k) { return w[(size_t)k * DM + perm8(n)]; }); }
    { const float* w = p.w_pb; transpose_cvt(p.WpbT(), DM, 512, [=](int n, int k) { return w[(size_t)k * DM + perm8(n)]; }); }
    { const float* w = p.w_out; transpose_cvt(p.WoutT(), DM, DM, [=](int n, int k) { return w[(size_t)k * DM + perm8(n)]; }); }
    { const float* w = p.w_gate; transpose_cvt(p.WgateT(), DM, DM, [=](int n, int k) { return w[(size_t)k * DM + perm8(n)]; }); }
    { const float* w = p.w_proj; transpose_cvt(p.WprojT(), DM, 256, [=](int n, int k) { return w[(size_t)k * DM + perm8(n)]; }); }
    { const float* w = p.cmp_w1; transpose_cvt(p.W1T(), 512, 1024, [=](int n, int k) { const int kvi = n >> 8, nn = n & 255; return w[(size_t)kvi * 262144 + (size_t)((nn >> 7) * 1024 + k) * 128 + (nn & 127)]; }); }
    { const float* w = p.cmp_w2; transpose_cvt(p.W2T(), 128, 128, [=](int n, int k) { return w[(size_t)(n >> 6) * 8192 + (size_t)k * 64 + (n & 63)]; }); }
    { const float* w = p.w_up; transpose_cvt(p.WupT(), 512, 64, [=](int n, int k) { return w[(size_t)k * 512 + n]; }); }
    { const float* w = p.a_up; transpose_cvt(p.AupT(), 512, 64, [=](int n, int k) { return w[(size_t)k * 512 + n]; }); }
    for (int id = gt; id < 33 * CR; id += nt) p.zs0()[id] = id < CR ? (bf16_t)0 : f2bf(p.state_shift[id - CR]);
    for (int id = gt; id < MR * 64; id += nt) {
        const int row = id >> 6, c4 = id & 63;
        const float4 v = ((const float4*)(row < NP ? p.p_prompt + (size_t)row * 256 : p.p_sample + (size_t)(row - NP) * 256))[c4];
        uint2 w; w.x = pk2(v.x, v.y); w.y = pk2(v.z, v.w);
        *(uint2*)(p.pb() + (size_t)row * 256 + c4 * 4) = w;
    }
    for (int id = gt; id < 4104 * 32; id += nt) {
        const int pi = id >> 5, i = id & 31;
        const int pos = pi < 4096 ? pi : PAST + pi - 4096;
        const float inv = (float)exp(-(double)i * (9.210340371976184 / 32.0));
        const float ang = (float)pos * inv;
        const double x = (double)ang;
        const double k = rint(x * 0.15915494309189535);
        const double r = x - k * 6.283185307179586;
        float s, c; sincos_small(r, s, c);
        p.tabc()[id] = c; p.tabs()[id] = s;
    }
    for (int o = gw; o < 256; o += nw) {
        const int kvi = o >> 7, f = o & 127;
        float acc = 0.f;
        for (int jd = lane; jd < 2048; jd += 64) acc += p.cmp_pe[kvi * 2048 + jd] * p.cmp_w1[(size_t)kvi * 262144 + (size_t)jd * 128 + f];
        acc = wave_sum(acc);
        if (lane == 0) p.pt()[o] = acc + p.cmp_b1[o];
    }
    for (int id = gt; id < DB * 504 * 64; id += nt) {
        const int c4 = id & 63, j = (id >> 6) % 504, b = (id >> 6) / 504;
        ((float4*)(p.out + O_WIN_S))[((size_t)b * 512 + j) * 64 + c4] = ((const float4*)p.cache_win)[((size_t)b * 512 + j + 8) * 64 + c4];
    }
}
#define XB_TMO      128
#define XB_XCNT(j)  (256  + 64 * (j))
#define XB_XSUB(j)  (1280 + 64 * (j))
#define XB_XGEN(j)  (2304 + 64 * (j))
#define XB_TOP      3328
#define XB_TOPGEN   3392
#define XCD_BAR_WORDS 3456
#define XB_SPIN_CAP (1u << 18)

__device__ __forceinline__ unsigned xb_ld(unsigned* p)              { return __hip_atomic_load(p, __ATOMIC_RELAXED, __HIP_MEMORY_SCOPE_AGENT); }
__device__ __forceinline__ unsigned xb_add(unsigned* p, unsigned v) { return __hip_atomic_fetch_add(p, v, __ATOMIC_RELAXED, __HIP_MEMORY_SCOPE_AGENT); }
__device__ __forceinline__ unsigned xb_xcc_id() { return (unsigned)__builtin_amdgcn_s_getreg((3 << 11) | 20) & 0xFu; }
#define XB_SPIN(cond, bar) do { unsigned _sp = 0; while (cond) { __builtin_amdgcn_s_sleep(1); \
    if ((++_sp & 255u) == 0u) { if (xb_ld(&(bar)[XB_TMO])) break; if (_sp > XB_SPIN_CAP) { atomicAdd(&(bar)[XB_TMO], 1u); break; } } } } while (0)

struct XcdBarrier {
    unsigned* bar; unsigned x;
    volatile LAS unsigned* st;
};

__device__ __forceinline__ XcdBarrier xcd_barrier_post(unsigned* bar, volatile LAS unsigned* st) {
    XcdBarrier b; b.bar = bar; b.x = xb_xcc_id(); b.st = st;
    if (threadIdx.x == 0) (void)xb_add(&bar[XB_XCNT(b.x)], 1u);
    return b;
}
__device__ __forceinline__ void xcd_barrier_complete(unsigned* bar, unsigned x, unsigned& nloc, unsigned& nx) {
    const unsigned G = gridDim.x * gridDim.y * gridDim.z;
    unsigned sum, cnt, mine, sp = 0u;
    for (;;) {
        sum = 0u; cnt = 0u; mine = 0u;
#pragma unroll
        for (unsigned j = 0; j < 16; ++j) { const unsigned c = xb_ld(&bar[XB_XCNT(j)]); sum += c; cnt += (c > 0u) ? 1u : 0u; mine = (j == x) ? c : mine; }
        if (sum == G) break;
        __builtin_amdgcn_s_sleep(1);
        if ((++sp & 255u) == 0u) { if (xb_ld(&bar[XB_TMO])) break; if (sp > XB_SPIN_CAP) { atomicAdd(&bar[XB_TMO], 1u); break; } }
    }
    nloc = mine > 0u ? mine : 1u; nx = cnt > 0u ? cnt : 1u;
}

__device__ __forceinline__ void xcd_barrier(const XcdBarrier& b) {
    asm volatile("s_waitcnt vmcnt(0)" ::: "memory");
    __syncthreads();
    if (threadIdx.x == 0) {
        unsigned* bar = b.bar;
        __builtin_amdgcn_s_waitcnt(0);
        unsigned nloc = b.st[0], nx = b.st[1];
        if (nloc == 0u) { xcd_barrier_complete(bar, b.x, nloc, nx); b.st[0] = nloc; b.st[1] = nx; }
        const unsigned old = xb_add(&bar[XB_XSUB(b.x)], 1u);
        const unsigned gen = old / nloc;
        if (old + 1u == (gen + 1u) * nloc) {
            __builtin_amdgcn_fence(__ATOMIC_RELEASE, "agent");
            asm volatile("s_waitcnt vmcnt(0)" ::: "memory");
            const unsigned og = xb_add(&bar[XB_TOP], 1u);
            const unsigned tg = og / nx;
            if (og + 1u == (tg + 1u) * nx) xb_add(&bar[XB_TOPGEN], 1u);
            else XB_SPIN(xb_ld(&bar[XB_TOPGEN]) == tg, bar);
            __builtin_amdgcn_fence(__ATOMIC_ACQUIRE, "agent");
            xb_add(&bar[XB_XGEN(b.x)], 1u);
            asm volatile("s_waitcnt vmcnt(0)" ::: "memory");
        } else {
            XB_SPIN(xb_ld(&bar[XB_XGEN(b.x)]) == gen, bar);
            __builtin_amdgcn_fence(__ATOMIC_ACQUIRE, "agent");
            asm volatile("s_waitcnt vmcnt(0)" ::: "memory");
        }
    }
    __syncthreads();
}

using pg8::Unit;
typedef unsigned u32x2 __attribute__((ext_vector_type(2)));
typedef unsigned u32x4_t __attribute__((ext_vector_type(4)));
__device__ __forceinline__ f32x16 mfma32(bf16x8 a, bf16x8 b, f32x16 c) { return __builtin_amdgcn_mfma_f32_32x32x16_bf16(a, b, c, 0, 0, 0); }
__device__ __forceinline__ bf16x8 pack8(float a0, float a1, float a2, float a3, float a4, float a5, float a6, float a7) {
    union { uint4 u; bf16x8 v; } x; x.u.x = pk2(a0, a1); x.u.y = pk2(a2, a3); x.u.z = pk2(a4, a5); x.u.w = pk2(a6, a7); return x.v;
}
__device__ __forceinline__ f32x16 zero16() { f32x16 z; for (int i = 0; i < 16; ++i) z[i] = 0.f; return z; }


__device__ __forceinline__ void st_bf4(bf16_t* dst, f32x4 v) { uint2 w; w.x = pk2(v[0], v[1]); w.y = pk2(v[2], v[3]); *(uint2*)dst = w; }

constexpr float QSCALE = 0.125f * 1.4426950408889634f;
struct EpiIn {
    static constexpr bool PERM = false, AFTER_DRAIN = false;
    P p; int row0; int pad_;
    __device__ __forceinline__ void operator()(const f32x4 (&acc)[2][2][4][2], const Unit& u, int wr, int wc, int fr, int fq) const {
        const int pn = u.pn;
#pragma unroll
        for (int ai = 0; ai < 2; ++ai)
#pragma unroll
            for (int m = 0; m < 4; ++m) {
                const int row = row0 + u.pm * 256 + ai * 128 + wr * 64 + m * 16 + fr;
                if (pn < 5) {
                    const int pi = row < NP ? (row & (SEQ - 1)) : 4096 + ((row - NP) & 7);
                    const int d0 = 16 * (wc & 1) + 4 * fq;
                    const f32x4 cs = *(const f32x4*)(p.tabc() + pi * 32 + d0), sn = *(const f32x4*)(p.tabs() + pi * 32 + d0);
#pragma unroll
                    for (int bj = 0; bj < 2; ++bj) {
                        const f32x4 x1 = acc[ai][bj][m][0], x2 = acc[ai][bj][m][1];
                        if (pn < 2) {
                            const int head = pn * 4 + bj * 2 + (wc >> 1);
                            const f32x4 o1 = (x1 * cs - x2 * sn) * QSCALE, o2 = (x2 * cs + x1 * sn) * QSCALE;
                            bf16_t* q = p.qb() + (size_t)row * 512 + head * 64 + d0;
                            st_bf4(q, o1); st_bf4(q + 32, o2);
                        } else {
                            const int br = pn - 2, g = wc >> 1;
                            f32x4 o1, o2;
                            if (bj == 0) { o1 = x1 * cs - x2 * sn; o2 = x2 * cs + x1 * sn; } else { o1 = x1; o2 = x2; }
                            float* dst = nullptr;
                            if (row < NP) {
                                if (br == 0) dst = p.out + O_CMP_P + (size_t)row * 256;
                                else if (br == 1) dst = p.out + O_SEL_P + (size_t)row * 256;
                                else { const int s = row & (SEQ - 1); if (s >= SEQ - 512) dst = p.out + O_WIN_P + ((size_t)(row >> 12) * 512 + (s - (SEQ - 512))) * 256; }
                            } else {
                                const int rs = row - NP;
                                if (br == 0) dst = p.out + O_CMP_S + (size_t)rs * 256;
                                else if (br == 1) dst = p.out + O_SEL_S + (size_t)rs * 256;
                                else dst = p.out + O_WIN_S + ((size_t)(rs >> 3) * 512 + 504 + (rs & 7)) * 256;
                            }
                            if (dst) { dst += bj * 128 + g * 64 + d0; *(f32x4*)dst = o1; *(f32x4*)(dst + 32) = o2; }
                            if (row < NP) {
                                const int b = row >> 12, s = row & (SEQ - 1);
                                if (bj == 0) {
                                    bf16_t* k = p.kb() + ((size_t)((br * NB + b) * 2 + g) * SEQ + s) * 64 + d0;
                                    st_bf4(k, o1); st_bf4(k + 32, o2);
                                } else if (br == 0) {
                                    bf16_t* v = p.vcr() + ((size_t)(b * 2 + g) * SEQ + s) * 64 + d0;
                                    st_bf4(v, o1); st_bf4(v + 32, o2);
                                } else {
                                    bf16_t* v = p.vT() + ((size_t)(((br - 1) * NB + b) * 2 + g) * 64 + d0) * SEQ + s;
#pragma unroll
                                    for (int e = 0; e < 4; ++e) { v[(size_t)e * SEQ] = f2bf(o1[e]); v[(size_t)(32 + e) * SEQ] = f2bf(o2[e]); }
                                }
                            }
                        }
                    }
                } else {
#pragma unroll
                    for (int bj = 0; bj < 2; ++bj) {
                        const int c = bj * 128 + wc * 32 + fq * 8;
                        const f32x4 v0 = acc[ai][bj][m][0], v1 = acc[ai][bj][m][1];
                        auto st8 = [&](bf16_t* dst, const f32x4& a, const f32x4& b) { uint4 w; w.x = pk2(a[0], a[1]); w.y = pk2(a[2], a[3]); w.z = pk2(b[0], b[1]); w.w = pk2(b[2], b[3]); *(uint4*)dst = w; };
                        if (pn < 7 || (pn >= 14 && pn < 16)) {
                            f32x4 o0, o1; for (int e = 0; e < 4; ++e) { o0[e] = SILU(1, v0[e]); o1[e] = SILU(1, v1[e]); }
                            st8((pn < 7 ? p.ag() + (size_t)row * 512 + (pn - 5) * 256 : p.rg() + (size_t)row * 512 + (pn - 14) * 256) + c, o0, o1);
                        } else if (pn < 13) {
                            st8(p.rz() + (size_t)row * CR + (pn - 7) * 256 + c, v0, v1);
                        } else if (pn == 13) {
                            if (c < 128) st8(p.rz() + (size_t)row * CR + 1536 + c, v0, v1);
                            else if (c < 152) { f32x4 o0, o1; for (int e = 0; e < 4; ++e) { o0[e] = SIG(1, v0[e]); o1[e] = SIG(1, v1[e]); }
                                *(f32x4*)(p.gates() + (size_t)row * 32 + (c - 128)) = o0; *(f32x4*)(p.gates() + (size_t)row * 32 + (c - 128) + 4) = o1; }
                        } else {
                            f32x4 o0, o1; for (int e = 0; e < 4; ++e) { o0[e] = SIG(1, v0[e]); o1[e] = SIG(1, v1[e]); }
                            st8(p.mg() + (size_t)row * 2048 + (pn - 16) * 256 + c, o0, o1);
                        }
                    }
                }
            }
    }
};

struct EpiPlain {
    static constexpr bool PERM = false, AFTER_DRAIN = false;
    float* C; int ldc; int pad_;
    __device__ __forceinline__ void quad(int row, int c, f32x4 v) const { *(f32x4*)(C + (size_t)row * ldc + c) = v; }
    __device__ __forceinline__ void operator()(const f32x4 (&acc)[2][2][4][2], const Unit& u, int wr, int wc, int fr, int fq) const {
#pragma unroll
        for (int ai = 0; ai < 2; ++ai)
#pragma unroll
            for (int m = 0; m < 4; ++m) {
                float* rowp = C + (size_t)(u.pm * 256 + ai * 128 + wr * 64 + m * 16 + fr) * ldc + u.pn * 256 + wc * 32 + 8 * fq;
#pragma unroll
                for (int bj = 0; bj < 2; ++bj)
#pragma unroll
                    for (int n = 0; n < 2; ++n) *(f32x4*)(rowp + bj * 128 + n * 4) = acc[ai][bj][m][n];
            }
    }
};


struct EpiPlainBf {
    static constexpr bool PERM = false, AFTER_DRAIN = false;
    bf16_t* C; int ldc; int pad_;
    __device__ __forceinline__ void operator()(const f32x4 (&acc)[2][2][4][2], const Unit& u, int wr, int wc, int fr, int fq) const {
#pragma unroll
        for (int ai = 0; ai < 2; ++ai)
#pragma unroll
            for (int m = 0; m < 4; ++m) {
                bf16_t* rowp = C + (size_t)(u.pm * 256 + ai * 128 + wr * 64 + m * 16 + fr) * ldc + u.pn * 256 + wc * 32 + 4 * fq;
#pragma unroll
                for (int bj = 0; bj < 2; ++bj)
#pragma unroll
                    for (int n = 0; n < 2; ++n) st_bf4(rowp + bj * 128 + n * 16, acc[ai][bj][m][n]);
            }
    }
};

struct EpiYa {
    static constexpr bool PERM = false, AFTER_DRAIN = false;
    P p;
    __device__ __forceinline__ void quad(int row, int c, f32x4 v) const {
        const uint2 gw = *(const uint2*)(p.mg() + (size_t)row * 2048 + c);
        f32x4 g; g[0] = __uint_as_float(gw.x << 16); g[1] = __uint_as_float(gw.x & 0xffff0000u); g[2] = __uint_as_float(gw.y << 16); g[3] = __uint_as_float(gw.y & 0xffff0000u);
        *(f32x4*)(p.tmp() + (size_t)row * DM + c) = g * v;
    }
    __device__ __forceinline__ void operator()(const f32x4 (&acc)[2][2][4][2], const Unit& u, int wr, int wc, int fr, int fq) const {
#pragma unroll
        for (int ai = 0; ai < 2; ++ai)
#pragma unroll
            for (int m = 0; m < 4; ++m) {
                const int row = u.pm * 256 + ai * 128 + wr * 64 + m * 16 + fr;
#pragma unroll
                for (int bj = 0; bj < 2; ++bj)
#pragma unroll
                    for (int n = 0; n < 2; ++n) {
                        const int c = u.pn * 256 + bj * 128 + wc * 32 + fq * 8 + n * 4;
                        const uint2 gw = *(const uint2*)(p.mg() + (size_t)row * 2048 + c);
                        f32x4 g; g[0] = __uint_as_float(gw.x << 16); g[1] = __uint_as_float(gw.x & 0xffff0000u); g[2] = __uint_as_float(gw.y << 16); g[3] = __uint_as_float(gw.y & 0xffff0000u);
                        *(f32x4*)(p.tmp() + (size_t)row * DM + c) = g * acc[ai][bj][m][n];
                    }
            }
    }
};
struct EpiYb {
    static constexpr bool PERM = false, AFTER_DRAIN = false;
    P p;
    __device__ __forceinline__ void quad(int row, int c, f32x4 v) const {
        const uint2 gw = *(const uint2*)(p.mg() + (size_t)row * 2048 + 1024 + c);
        f32x4 g; g[0] = __uint_as_float(gw.x << 16); g[1] = __uint_as_float(gw.x & 0xffff0000u); g[2] = __uint_as_float(gw.y << 16); g[3] = __uint_as_float(gw.y & 0xffff0000u);
        st_bf4(p.mb() + (size_t)row * DM + c, *(const f32x4*)(p.tmp() + (size_t)row * DM + c) + g * v);
    }
    __device__ __forceinline__ void operator()(const f32x4 (&acc)[2][2][4][2], const Unit& u, int wr, int wc, int fr, int fq) const {
#pragma unroll
        for (int ai = 0; ai < 2; ++ai)
#pragma unroll
            for (int m = 0; m < 4; ++m) {
                const int row = u.pm * 256 + ai * 128 + wr * 64 + m * 16 + fr;
#pragma unroll
                for (int bj = 0; bj < 2; ++bj)
#pragma unroll
                    for (int n = 0; n < 2; ++n) {
                        const int c = u.pn * 256 + bj * 128 + wc * 32 + fq * 8 + n * 4;
                        const uint2 gw = *(const uint2*)(p.mg() + (size_t)row * 2048 + 1024 + c);
                        f32x4 g; g[0] = __uint_as_float(gw.x << 16); g[1] = __uint_as_float(gw.x & 0xffff0000u); g[2] = __uint_as_float(gw.y << 16); g[3] = __uint_as_float(gw.y & 0xffff0000u);
                        const f32x4 t = *(const f32x4*)(p.tmp() + (size_t)row * DM + c);
                        st_bf4(p.mb() + (size_t)row * DM + c, t + g * acc[ai][bj][m][n]);
                    }
            }
    }
};
struct EpiOut {
    static constexpr bool PERM = false, AFTER_DRAIN = false;
    P p;
    __device__ __forceinline__ void quad(int row, int c, f32x4 a) const {
        const float* xr = p.x_sample + (size_t)(row - NP) * DM;
        const f32x4 v = *(const f32x4*)(xr + c) + a;
        *(f32x4*)(p.x1() + (size_t)row * DM + c) = v;
        st_bf4(p.xg() + (size_t)row * DM + c, v * *(const f32x4*)(p.ple_g + c));
        atomicAdd(p.ss_s() + (row - NP), v[0] * v[0] + v[1] * v[1] + v[2] * v[2] + v[3] * v[3]);
    }
    __device__ __forceinline__ void operator()(const f32x4 (&acc)[2][2][4][2], const Unit& u, int wr, int wc, int fr, int fq) const {
#pragma unroll
        for (int ai = 0; ai < 2; ++ai)
#pragma unroll
            for (int m = 0; m < 4; ++m) {
                const int row = u.pm * 256 + ai * 128 + wr * 64 + m * 16 + fr;
                const float* xr = row < NP ? p.x_prompt + (size_t)row * DM : p.x_sample + (size_t)(row - NP) * DM;
                float ss = 0.f;
#pragma unroll
                for (int bj = 0; bj < 2; ++bj)
#pragma unroll
                    for (int n = 0; n < 2; ++n) {
                        const int c = u.pn * 256 + bj * 128 + wc * 32 + fq * 8 + n * 4;
                        const f32x4 v = *(const f32x4*)(xr + c) + acc[ai][bj][m][n];
                        *(f32x4*)(p.x1() + (size_t)row * DM + c) = v;
                        ss += v[0] * v[0] + v[1] * v[1] + v[2] * v[2] + v[3] * v[3];
                        st_bf4(p.xg() + (size_t)row * DM + c, v * *(const f32x4*)(p.ple_g + c));
                    }
                ss += __shfl_xor(ss, 16); ss += __shfl_xor(ss, 32);
                if (fq == 0) p.ss1()[(size_t)row * 16 + u.pn * 4 + wc] = ss;
            }
    }
};
struct EpiGate {
    static constexpr bool PERM = false, AFTER_DRAIN = false;
    P p;
    __device__ __forceinline__ void quad(int row, int c, f32x4 acc) const {
        const float rstd = rsqrtf(p.ss_s()[row - NP] * (1.0f / DM) + 1e-6f);
        const f32x4 a = acc * rstd;
        f32x4 g; for (int e = 0; e < 4; ++e) g[e] = SIG(8, a[e]);
        float* ppp = p.pp() + (size_t)row * DM + c;
        *(f32x4*)ppp = *(const f32x4*)(p.x1() + (size_t)row * DM + c) + g * *(const f32x4*)ppp;
    }
    __device__ __forceinline__ void operator()(const f32x4 (&acc)[2][2][4][2], const Unit& u, int wr, int wc, int fr, int fq) const {
#pragma unroll
        for (int ai = 0; ai < 2; ++ai)
#pragma unroll
            for (int m = 0; m < 4; ++m) {
                const int row = u.pm * 256 + ai * 128 + wr * 64 + m * 16 + fr;
                float ss = 0.f;
#pragma unroll
                for (int i = 0; i < 4; ++i) { const f32x4 t = *(const f32x4*)(p.ss1() + (size_t)row * 16 + i * 4); ss += (t[0] + t[1]) + (t[2] + t[3]); }
                const float rstd = rsqrtf(ss * (1.0f / DM) + 1e-6f);
#pragma unroll
                for (int bj = 0; bj < 2; ++bj)
#pragma unroll
                    for (int n = 0; n < 2; ++n) {
                        const int c = u.pn * 256 + bj * 128 + wc * 32 + fq * 8 + n * 4;
                        const f32x4 a = acc[ai][bj][m][n] * rstd;
                        f32x4 g; for (int e = 0; e < 4; ++e) g[e] = SIG(8, a[e]);
                        float* ppp = p.pp() + (size_t)row * DM + c;
                        *(f32x4*)ppp = *(const f32x4*)(p.x1() + (size_t)row * DM + c) + g * *(const f32x4*)ppp;
                    }
            }
    }
};

__device__ __forceinline__ void ph_final(const P& p) {
    const int tid = threadIdx.x, lane = tid & 63, wid = tid >> 6;
    for (int row = blockIdx.x * 8 + wid; row < MR; row += gridDim.x * 8) {
        const float4* src = (const float4*)(p.pp() + (size_t)row * DM);
        float4 v[4]; float ss = 0.f;
#pragma unroll
        for (int i = 0; i < 4; ++i) { v[i] = src[lane + 64 * i]; ss += v[i].x * v[i].x + v[i].y * v[i].y + v[i].z * v[i].z + v[i].w * v[i].w; }
        ss = wave_sum(ss);
        const float rstd = rsqrtf(ss * (1.0f / DM) + 1e-6f);
        float4* dst = (float4*)(p.out + (row < NP ? O_Y_P + (size_t)row * DM : O_Y_S + (size_t)(row - NP) * DM));
#if defined(DBG_CMPALL)
        float dbgs = 1.0f; if (row >= NP) dbgs = 1.0f + (float)p.bar()[3840] * (1.0f / DBG_DIV);
#define DBGS * dbgs
#else
#define DBGS
#endif
#pragma unroll
        for (int i = 0; i < 4; ++i) {
            const float4 g = ((const float4*)p.final_g)[lane + 64 * i];
            float4 o; o.x = v[i].x * rstd * g.x DBGS; o.y = v[i].y * rstd * g.y DBGS; o.z = v[i].z * rstd * g.z DBGS; o.w = v[i].w * rstd * g.w DBGS;
            dst[lane + 64 * i] = o;
        }
    }
}

typedef float f32x4v __attribute__((ext_vector_type(4)));
template <class Epi> __device__ __forceinline__ void small_gemm(const bf16_t* A, const bf16_t* Bt, int K, const Epi& E) {
    const int tid = threadIdx.x, lane = tid & 63, wid = tid >> 6, r16 = lane & 15, q4 = lane >> 4;
    for (int tile = blockIdx.x * 8 + wid; tile < 16 * 64; tile += gridDim.x * 8) {
        const int rt = tile & 15, ct = tile >> 4;
        const bf16_t* ap = A + (size_t)(NP + rt * 16 + r16) * K + 8 * q4;
        const bf16_t* bp = Bt + (size_t)(ct * 16 + r16) * K + 8 * q4;
        f32x4 acc = {0.f, 0.f, 0.f, 0.f};
#pragma unroll 1
        for (int k0 = 0; k0 < K; k0 += 256) {
            bf16x8 af[8], bf[8];
#pragma unroll
            for (int i = 0; i < 8; ++i) { af[i] = *(const bf16x8*)(ap + k0 + 32 * i); bf[i] = *(const bf16x8*)(bp + k0 + 32 * i); }
#pragma unroll
            for (int i = 0; i < 8; ++i) acc = __builtin_amdgcn_mfma_f32_16x16x32_bf16(bf[i], af[i], acc, 0, 0, 0);
        }
        E.quad(NP + rt * 16 + r16, (ct >> 1) * 32 + 8 * q4 + 4 * (ct & 1), acc);
    }
}
#ifndef DBG_PERTURB
#define DBG_PERTURB
#endif

__device__ __forceinline__ f32x4 ld_bf4c(const bf16_t* q) { const uint2 w = *(const uint2*)q; f32x4 v; v[0] = __uint_as_float(w.x << 16); v[1] = __uint_as_float(w.x & 0xffff0000u); v[2] = __uint_as_float(w.y << 16); v[3] = __uint_as_float(w.y & 0xffff0000u); return v; }
__device__ __forceinline__ void ph_compress2(const P& p, const bf16_t* LH, int nbg, int nrows, int nblk, bf16_t* kc, bf16_t* vcT) {
    const int tid = threadIdx.x, lane = tid & 63, wid = tid >> 6, col = lane & 31, hb = lane >> 5;
    const int ntile = nrows >> 5, total = 2 * nbg * ntile;
    for (int it = blockIdx.x * 8 + wid; it < total; it += gridDim.x * 8) {
        const int tile = it % ntile, bg = (it / ntile) % nbg, kvi = it / (ntile * nbg);
        const int i = tile * 32 + col;
        const bool live = i < nblk;
        const bf16_t* l0 = LH + ((size_t)kvi * nbg * nrows + (size_t)bg * nrows + (live ? i : 0)) * 256;
        const float* ptp = p.pt() + kvi * 128;
        const bf16_t* w2t = p.W2T() + (size_t)kvi * 64 * 128;
        f32x16 acc[2]; acc[0] = zero16(); acc[1] = zero16();
#pragma unroll
        for (int ks = 0; ks < 8; ++ks) {
            const int f = 16 * ks + 8 * hb;
            float hv[8];
#pragma unroll
            for (int q = 0; q < 2; ++q) {
                const f32x4 lo = ld_bf4c(l0 + f + 4 * q), hi = ld_bf4c(l0 + 256 + 128 + f + 4 * q), pv = *(const f32x4*)(ptp + f + 4 * q);
#pragma unroll
                for (int e = 0; e < 4; ++e) hv[4 * q + e] = SILU(2, lo[e] + hi[e] + pv[e]) DBG_PERTURB;
            }
            const bf16x8 hf = pack8(hv[0], hv[1], hv[2], hv[3], hv[4], hv[5], hv[6], hv[7]);
#pragma unroll
            for (int dt = 0; dt < 2; ++dt) {
                const bf16x8 wf = *(const bf16x8*)(w2t + (size_t)(32 * dt + col) * 128 + f);
                acc[dt] = (kvi == 0) ? mfma32(wf, hf, acc[dt]) : mfma32(hf, wf, acc[dt]);
            }
        }
        if (kvi == 0) {
            bf16_t* dst = kc + ((size_t)bg * nrows + i) * 64;
#pragma unroll
            for (int dt = 0; dt < 2; ++dt)
#pragma unroll
                for (int i4 = 0; i4 < 4; ++i4) {
                    const int d = 32 * dt + 8 * i4 + 4 * hb;
                    const f32x4 b2 = *(const f32x4*)(p.cmp_b2 + d);
                    f32x4 v; for (int e = 0; e < 4; ++e) v[e] = live ? acc[dt][4 * i4 + e] + b2[e] : 0.f;
                    st_bf4(dst + d, v);
                }
        } else {
#pragma unroll
            for (int dt = 0; dt < 2; ++dt) {
                const int d = 32 * dt + col;
                const float b2 = p.cmp_b2[64 + d];
                bf16_t* dst = vcT + ((size_t)bg * 64 + d) * nrows + tile * 32;
#pragma unroll
                for (int i4 = 0; i4 < 4; ++i4) {
                    const int r = 8 * i4 + 4 * hb;
                    f32x4 v; for (int e = 0; e < 4; ++e) v[e] = (tile * 32 + r + e) < nblk ? acc[dt][4 * i4 + e] + b2 : 0.f;
                    st_bf4(dst + r, v);
                }
            }
        }
    }
}

__device__ __forceinline__ void ph_cvt_cache(const P& p) {
    const size_t total = (size_t)2 * DB * 2 * PAST * 8;
    for (size_t id = (size_t)blockIdx.x * NTHR + threadIdx.x; id < total; id += (size_t)gridDim.x * NTHR) {
        const int d8 = (int)(id & 7), tok = (int)((id >> 3) & (PAST - 1)), g = (int)((id >> 17) & 1), b = (int)((id >> 18) & 31), kvi = (int)(id >> 23);
        const int page = p.page_table[b * 128 + (tok >> 7)];
        const float4* src = (const float4*)(p.cache_cmp + ((size_t)page * 128 + (tok & 127)) * 256 + kvi * 128 + g * 64 + d8 * 8);
        const float4 a = src[0], c = src[1];
        uint4 w; w.x = pk2(a.x, a.y); w.y = pk2(a.z, a.w); w.z = pk2(c.x, c.y); w.w = pk2(c.z, c.w);
        *(uint4*)(p.cs() + id * 8) = w;
    }
}

#if defined(OLD_RWKV_PREP)
__device__ __forceinline__ void ph_rwkv_prep(const P& p) {
    const int tid = threadIdx.x, lane = tid & 63, wid = tid >> 6;
    for (int it = blockIdx.x * 8 + wid; it < MR * 8; it += gridDim.x * 8) {
        const int row = it >> 3, h = it & 7, c = h * 64 + lane;
        const float* z = p.rz() + (size_t)row * CR;
        const float* pv;
        bool zero_prev = false;
        if (row < NP) { if ((row & (SEQ - 1)) == 0) { zero_prev = true; pv = z; } else pv = z - CR; }
        else { const int rs = row - NP; if ((rs & 7) == 0) pv = p.state_shift + (size_t)(rs >> 3) * CR; else pv = z - CR; }
        auto lerp = [&](int col) { const float zz = z[col]; const float pr = zero_prev ? 0.f : pv[col]; return zz + (pr - zz) * p.mu[col]; };
        const float zr = lerp(c), zk = lerp(512 + c), zv = lerp(1024 + c), zwd = lerp(1536 + lane), zad = lerp(1600 + lane);
        const float th = tanhf(zwd);
        float accw = p.w0[c], acca = p.a0[c];
#pragma unroll 8
        for (int j = 0; j < 64; ++j) {
            const float tj = __shfl(th, j), aj = __shfl(zad, j);
            accw += tj * p.w_up[j * 512 + c]; acca += aj * p.a_up[j * 512 + c];
        }
        const float nx = -accw;
        const float sp = fmaxf(nx, 0.f) + log1pf(__expf(-fabsf(nx)));
        const float w = -sp - 0.5f;
        const float dec = __expf(-__expf(w));
        const float a = sigmoidf_(acca);
        const float kkr = zk * p.k_k[c];
        const float nrm = sqrtf(wave_sum(kkr * kkr));
        const float kk = kkr / fmaxf(nrm, 1e-12f);
        const float km = zk * (1.0f + (a - 1.0f) * p.k_a[c]);
        const float bon = wave_sum(zr * km * p.r_k[c]);
        float* o = p.rw6() + (size_t)it * 384 + lane;
        o[0] = zr; o[64] = dec; o[128] = km; o[192] = zv; o[256] = kk; o[320] = kk * a;
        if (lane == 0) p.bonus()[it] = bon;
        if (h == 0) {
            float* so = nullptr;
            if (row < NP) { if ((row & (SEQ - 1)) == SEQ - 1) so = p.out + O_SH_P + (size_t)(row >> 12) * CR; }
            else { const int rs = row - NP; if ((rs & 7) == 7) so = p.out + O_SH_S + (size_t)(rs >> 3) * CR; }
            if (so) for (int i = lane; i < CR; i += 64) so[i] = z[i];
        }
    }
}

#else
__device__ __forceinline__ float dpp_row_sum16(float v) {
    v += __builtin_bit_cast(float, __builtin_amdgcn_mov_dpp(__builtin_bit_cast(int, v), 0xB1, 0xF, 0xF, true));
    v += __builtin_bit_cast(float, __builtin_amdgcn_mov_dpp(__builtin_bit_cast(int, v), 0x4E, 0xF, 0xF, true));
    v += __builtin_bit_cast(float, __builtin_amdgcn_mov_dpp(__builtin_bit_cast(int, v), 0x141, 0xF, 0xF, true));
    v += __builtin_bit_cast(float, __builtin_amdgcn_mov_dpp(__builtin_bit_cast(int, v), 0x140, 0xF, 0xF, true));
    return v;
}
__device__ __forceinline__ float half_sum32(float v) { v = dpp_row_sum16(v); return v + __shfl_xor(v, 16); }
__device__ __forceinline__ const bf16_t* rwkv_prev_row(const P& p, int row) {
    if (row < NP) return (row & (SEQ - 1)) == 0 ? p.zs0() : p.rz() + (size_t)(row - 1) * CR;
    const int rs = row - NP;
    return (rs & 7) == 0 ? p.zs0() + (size_t)(1 + (rs >> 3)) * CR : p.rz() + (size_t)(row - 1) * CR;
}
__device__ __forceinline__ f32x4 ld_bf4(const bf16_t* q) { const uint2 w = *(const uint2*)q; f32x4 v; v[0] = __uint_as_float(w.x << 16); v[1] = __uint_as_float(w.x & 0xffff0000u); v[2] = __uint_as_float(w.y << 16); v[3] = __uint_as_float(w.y & 0xffff0000u); return v; }
__device__ __forceinline__ void ph_rwkv_prep(const P& p) {
    const int tid = threadIdx.x, lane = tid & 63, wid = tid >> 6, col = lane & 31, hb = lane >> 5;
    const int gw = blockIdx.x * 8 + wid, nw = gridDim.x * 8;
    for (int it = gw; it < NB + DB; it += nw) {
        const int row = it < NB ? it * SEQ + SEQ - 1 : NP + (it - NB) * 8 + 7;
        float* so = it < NB ? p.out + O_SH_P + (size_t)it * CR : p.out + O_SH_S + (size_t)(it - NB) * CR;
        const bf16_t* z = p.rz() + (size_t)row * CR;
        for (int i = lane; i < CR; i += 64) so[i] = bf2f(z[i]);
    }
    for (int it = gw; it < (MR / 32) * 8; it += nw) {
        const int h = it & 7, r0 = (it >> 3) * 32;
        bf16x8 Aw[4], Aa[4];
        {
            const int row = r0 + col;
            const bf16_t* z = p.rz() + (size_t)row * CR;
            const bf16_t* pv = rwkv_prev_row(p, row);
#pragma unroll
            for (int ks = 0; ks < 4; ++ks) {
                const int j0 = 16 * ks + 8 * hb;
                float tw[8], ta[8];
#pragma unroll
                for (int q = 0; q < 2; ++q) {
                    const f32x4 zw = ld_bf4(z + 1536 + j0 + 4 * q), za = ld_bf4(z + 1600 + j0 + 4 * q);
                    const f32x4 pw = ld_bf4(pv + 1536 + j0 + 4 * q), pa = ld_bf4(pv + 1600 + j0 + 4 * q);
                    const f32x4 mw = *(const f32x4*)(p.mu + 1536 + j0 + 4 * q), ma = *(const f32x4*)(p.mu + 1600 + j0 + 4 * q);
#pragma unroll
                    for (int e = 0; e < 4; ++e) { tw[4 * q + e] = tanhf(zw[e] + (pw[e] - zw[e]) * mw[e]); ta[4 * q + e] = za[e] + (pa[e] - za[e]) * ma[e]; }
                }
                Aw[ks] = pack8(tw[0], tw[1], tw[2], tw[3], tw[4], tw[5], tw[6], tw[7]);
                Aa[ks] = pack8(ta[0], ta[1], ta[2], ta[3], ta[4], ta[5], ta[6], ta[7]);
            }
        }
        f32x16 accw[2], acca[2];
#pragma unroll
        for (int ct = 0; ct < 2; ++ct) {
            accw[ct] = zero16(); acca[ct] = zero16();
            const size_t wo = (size_t)(h * 64 + 32 * ct + col) * 64 + 8 * hb;
#pragma unroll
            for (int ks = 0; ks < 4; ++ks) {
                accw[ct] = mfma32(Aw[ks], *(const bf16x8*)(p.WupT() + wo + 16 * ks), accw[ct]);
                acca[ct] = mfma32(Aa[ks], *(const bf16x8*)(p.AupT() + wo + 16 * ks), acca[ct]);
            }
        }
        float w0v[2], a0v[2], kkv[2], kav[2], rkv[2], mur[2], muk[2], muv[2];
#pragma unroll
        for (int ct = 0; ct < 2; ++ct) {
            const int c = h * 64 + 32 * ct + col;
            w0v[ct] = p.w0[c]; a0v[ct] = p.a0[c]; kkv[ct] = p.k_k[c]; kav[ct] = p.k_a[c]; rkv[ct] = p.r_k[c];
            mur[ct] = p.mu[c]; muk[ct] = p.mu[512 + c]; muv[ct] = p.mu[1024 + c];
        }
#pragma unroll
        for (int i = 0; i < 16; ++i) {
            const int row = r0 + (i & 3) + 8 * (i >> 2) + 4 * hb;
            const bf16_t* z = p.rz() + (size_t)row * CR;
            const bf16_t* pv = rwkv_prev_row(p, row);
            float zr[2], zk[2], zv[2], dec[2], av[2], kkr[2], km[2];
            float n2 = 0.f, bon = 0.f;
#pragma unroll
            for (int ct = 0; ct < 2; ++ct) {
                const int c = h * 64 + 32 * ct + col;
                const float z0 = bf2f(z[c]), z1 = bf2f(z[512 + c]), z2 = bf2f(z[1024 + c]);
                const float p0 = bf2f(pv[c]), p1 = bf2f(pv[512 + c]), p2 = bf2f(pv[1024 + c]);
                zr[ct] = z0 + (p0 - z0) * mur[ct]; zk[ct] = z1 + (p1 - z1) * muk[ct]; zv[ct] = z2 + (p2 - z2) * muv[ct];
                const float nx = -(w0v[ct] + accw[ct][i]);
                const float sp = fmaxf(nx, 0.f) + log1pf(__expf(-fabsf(nx)));
                dec[ct] = __expf(-__expf(-sp - 0.5f));
                av[ct] = SIG(4, a0v[ct] + acca[ct][i]);
                kkr[ct] = zk[ct] * kkv[ct];
                km[ct] = zk[ct] * (1.0f + (av[ct] - 1.0f) * kav[ct]);
                n2 += kkr[ct] * kkr[ct];
                bon += zr[ct] * km[ct] * rkv[ct];
            }
            n2 = half_sum32(n2); bon = half_sum32(bon);
            const float rn = 1.0f / fmaxf(sqrtf(n2), 1e-12f);
            unsigned char* o = p.rw6() + ((size_t)row * 8 + h) * RW6_STRIDE;
#pragma unroll
            for (int ct = 0; ct < 2; ++ct) {
                const float kk = kkr[ct] * rn;
                const int cl = 32 * ct + col;
                ((float*)o)[cl] = dec[ct];
                bf16_t* ob = (bf16_t*)(o + 256) + cl;
                ob[0] = f2bf(zr[ct]); ob[64] = f2bf(km[ct]); ob[128] = f2bf(zv[ct]); ob[192] = f2bf(kk); ob[256] = f2bf(kk * av[ct]);
            }
            if (col == 0) p.bonus()[(size_t)row * 8 + h] = bon;
        }
    }
}

#endif
typedef float f32x2 __attribute__((ext_vector_type(2)));
__device__ __forceinline__ float dpp_row_sum(float v) {
    v += __builtin_bit_cast(float, __builtin_amdgcn_mov_dpp(__builtin_bit_cast(int, v), 0xB1, 0xF, 0xF, true));
    v += __builtin_bit_cast(float, __builtin_amdgcn_mov_dpp(__builtin_bit_cast(int, v), 0x4E, 0xF, 0xF, true));
    v += __builtin_bit_cast(float, __builtin_amdgcn_mov_dpp(__builtin_bit_cast(int, v), 0x141, 0xF, 0xF, true));
    v += __builtin_bit_cast(float, __builtin_amdgcn_mov_dpp(__builtin_bit_cast(int, v), 0x140, 0xF, 0xF, true));
    return v;
}
constexpr int SCAN_TC = 32;
template <int NROWS>
__device__ __forceinline__ void scan_item(const P& p, LAS float* lds, int row0, int T, int h, int half, const float* s0, float* sout) {
    const int tid = threadIdx.x, w = tid >> 6, lane = tid & 63, rl = lane >> 4, kq = lane & 15;
    const bool act = w * 4 < NROWS;
    const int vrow = half * NROWS + (act ? w * 4 : 0) + rl;
    f32x4 S;
    if (s0) S = *(const f32x4*)(s0 + vrow * 64 + kq * 4); else { S[0] = 0.f; S[1] = 0.f; S[2] = 0.f; S[3] = 0.f; }
    const unsigned char* src = p.rw6() + ((size_t)row0 * 8 + h) * RW6_STRIDE;
    const int nchunk = (T + SCAN_TC - 1) / SCAN_TC;
    u32x4_t stg[4];
    int ss[4], sc[4], sl[4];
#pragma unroll
    for (int i = 0; i < 4; ++i) {
        const int idx = i * 512 + tid; ss[i] = idx / 56; sc[i] = idx % 56;
        const int cb = sc[i] - 16, q = cb >> 3;
        sl[i] = sc[i] < 16 ? 64 + 4 * sc[i] : (q == 0 ? 0 : 64 + 64 * q) + 8 * (cb & 7);
    }
    auto put = [&](LAS float* b, int i) {
        LAS float* d = b + ss[i] * 384 + sl[i];
        if (sc[i] < 16) *(LAS u32x4_t*)d = stg[i];
        else {
            f32x4 lo, hi;
            lo[0] = __uint_as_float(stg[i][0] << 16); lo[1] = __uint_as_float(stg[i][0] & 0xffff0000u); lo[2] = __uint_as_float(stg[i][1] << 16); lo[3] = __uint_as_float(stg[i][1] & 0xffff0000u);
            hi[0] = __uint_as_float(stg[i][2] << 16); hi[1] = __uint_as_float(stg[i][2] & 0xffff0000u); hi[2] = __uint_as_float(stg[i][3] << 16); hi[3] = __uint_as_float(stg[i][3] & 0xffff0000u);
            *(LAS f32x4*)d = lo; *(LAS f32x4*)(d + 4) = hi;
        }
    };
    {
        const int ns = T < SCAN_TC ? T : SCAN_TC;
#pragma unroll
        for (int i = 0; i < 4; ++i) if (ss[i] < ns) { stg[i] = *(const u32x4_t*)(src + (size_t)ss[i] * (8 * RW6_STRIDE) + sc[i] * 16); put(lds, i); }
    }
    __syncthreads();
    for (int c = 0; c < nchunk; ++c) {
        const int t0 = c * SCAN_TC;
        const int ns = (T - t0) < SCAN_TC ? (T - t0) : SCAN_TC;
        const bool more = (c + 1) < nchunk;
        const int nns = more ? ((T - t0 - SCAN_TC) < SCAN_TC ? (T - t0 - SCAN_TC) : SCAN_TC) : 0;
        if (more) {
#pragma unroll
            for (int i = 0; i < 4; ++i) if (ss[i] < nns) stg[i] = *(const u32x4_t*)(src + (size_t)(t0 + SCAN_TC + ss[i]) * (8 * RW6_STRIDE) + sc[i] * 16);
        }
        LAS const float* buf = lds + (c & 1) * (SCAN_TC * 384);
        float* yo = p.ybuf() + (size_t)(row0 + t0) * 512 + h * 64 + vrow;
        if (act)
#pragma unroll 4
        for (int s = 0; s < ns; ++s) {
            LAS const float* bs = buf + s * 384 + kq * 4;
            const f32x4 r = *(LAS const f32x4*)(bs), d = *(LAS const f32x4*)(bs + 64), km = *(LAS const f32x4*)(bs + 128),
                        kk = *(LAS const f32x4*)(bs + 256), ka = *(LAS const f32x4*)(bs + 320);
            const float vv = buf[s * 384 + 192 + vrow];
            const f32x4 t1 = S * kk;
            float sa = dpp_row_sum((t1[0] + t1[1]) + (t1[2] + t1[3]));
            sa = -sa;
            S = S * d + ka * sa + km * vv;
            const f32x4 t2 = S * r;
            const float y = dpp_row_sum((t2[0] + t2[1]) + (t2[2] + t2[3]));
            if (kq == 0) yo[(size_t)s * 512] = y;
        }
        if (more) {
            LAS float* nb = lds + ((c + 1) & 1) * (SCAN_TC * 384);
#pragma unroll
            for (int i = 0; i < 4; ++i) if (ss[i] < nns) put(nb, i);
        }
        __syncthreads();
    }
    if (act) *(f32x4*)(sout + vrow * 64 + kq * 4) = S;
}
constexpr int NSCAN = 128;
__device__ __forceinline__ void ph_rwkv_scan(const P& p, LAS float* lds) {
    if ((int)blockIdx.x < NSCAN) {
        const int item = blockIdx.x >> 2, part = blockIdx.x & 3;
        scan_item<16>(p, lds, (item >> 3) * SEQ, SEQ, item & 7, part, nullptr, p.out + O_WKV_P + (size_t)item * 4096);
    } else {
        const int nb = (int)gridDim.x - NSCAN;
        for (int hi = (int)blockIdx.x - NSCAN; hi < 512; hi += nb) {
            const int item = hi >> 1, half = hi & 1;
            scan_item<32>(p, lds, NP + (item >> 3) * 8, 8, item & 7, half, p.state_wkv + (size_t)item * 4096, p.out + O_WKV_S + (size_t)item * 4096);
        }
    }
}

__device__ __forceinline__ void ph_rwkv_post(const P& p) {
    const int tid = threadIdx.x, lane = tid & 63, wid = tid >> 6;
    for (int it = blockIdx.x * 8 + wid; it < MR * 8; it += gridDim.x * 8) {
        const int row = it >> 3, h = it & 7, c = h * 64 + lane;
        const float y = p.ybuf()[(size_t)row * 512 + c];
        const float mean = wave_sum(y) * (1.0f / 64.0f);
        const float dv = y - mean;
        const float var = wave_sum(dv * dv) * (1.0f / 64.0f);
        float yn = dv * rsqrtf(var + 64e-5f) * p.gn_g[c] + p.gn_b[c];
        yn += p.bonus()[it] * bf2f(((const bf16_t*)(p.rw6() + (size_t)it * RW6_STRIDE + 256))[128 + lane]);
        p.ob()[(size_t)row * 512 + c] = f2bf(yn * bf2f(p.rg()[(size_t)row * 512 + c]));
    }
}

__device__ __forceinline__ void ph_cmp_gemm_f32(const P& p, LAS unsigned char* lds) {
    using pg8::lds_byte;
    const int tid = threadIdx.x, wid = __builtin_amdgcn_readfirstlane(tid >> 6), lane = tid & 63, wr = wid >> 2, wc = wid & 3, fr = lane & 15, fq = lane >> 4;
    constexpr int HTB = 16384;
    const int arow_l = 4 * wid + (lane >> 4), acol = 4 * (lane & 15);
    const int swbase = lds_byte(arow_l, acol);
    LAS unsigned long long* rowoff = (LAS unsigned long long*)(lds + 131072);
    unsigned voffB[2];
#pragma unroll
    for (int i = 0; i < 2; ++i) { int R, C; pg8::stage_rc(tid * 16 + i * 8192, R, C); voffB[i] = (unsigned)(R * 1024 + C) * 2u; }
    const unsigned ldsw = (unsigned)wid * 1024u;
    const int aoff = lds_byte(wr * 64 + fr, fq * 8), boff = lds_byte(wc * 32 + fr, fq * 8);
    for (int unit = blockIdx.x; unit < 512; unit += gridDim.x) {
        const int kvi = unit >> 8, bg = (unit >> 2) & 63, c0 = (unit & 3) * 256, b = bg >> 1, g = bg & 1;
        __syncthreads();
        if (tid < 256) {
            const int chunk = c0 + tid;
            const int page = p.page_table[b * 128 + (chunk >> 3)];
            rowoff[tid] = ((unsigned long long)page * 128 + (chunk & 7) * 16) * 256 + kvi * 128 + g * 64;
        }
        const char* bbase = (const char*)(p.W1T() + (size_t)kvi * 256 * 1024);
        f32x4 acc[2][2][4][2];
#pragma unroll
        for (int a = 0; a < 2; ++a)
#pragma unroll
            for (int bb = 0; bb < 2; ++bb)
#pragma unroll
                for (int m = 0; m < 4; ++m)
#pragma unroll
                    for (int n = 0; n < 2; ++n) acc[a][bb][m][n] = (f32x4){0.f, 0.f, 0.f, 0.f};
        f32x4 ar[8];
        auto stage_b = [&](int st, int t) {
#pragma unroll
            for (int h = 0; h < 2; ++h)
#pragma unroll
                for (int i = 0; i < 2; ++i)
                    __builtin_amdgcn_global_load_lds((const unsigned*)(bbase + (size_t)h * 128 * 2048 + (size_t)t * 128 + voffB[i]),
                                                     (PG8_LAS unsigned*)(lds + st * 65536 + 32768 + h * HTB + ldsw + i * 8192), 16, 0, 0);
        };
        auto load_a = [&](int t) {
#pragma unroll
            for (int q = 0; q < 8; ++q) ar[q] = *(const f32x4*)(p.cache_cmp + rowoff[32 * q + arow_l] + (size_t)t * 256 + acol);
        };
        auto write_a = [&](int st) {
            LAS unsigned char* na = lds + st * 65536;
#pragma unroll
            for (int q = 0; q < 8; ++q) *(LAS u32x2*)(na + swbase + (q >> 2) * HTB + (q & 3) * 4096) = (u32x2){pk2(ar[q][0], ar[q][1]), pk2(ar[q][2], ar[q][3])};
        };
        __syncthreads();
        load_a(0);
        stage_b(0, 0);
        write_a(0);
        __syncthreads();
#pragma unroll 1
        for (int t = 0; t < 16; ++t) {
            const int cur = t & 1;
            if (t + 1 < 16) { load_a(t + 1); stage_b(cur ^ 1, t + 1); }
            LAS const unsigned char* sa = lds + cur * 65536;
            LAS const unsigned char* sb = sa + 32768;
#pragma unroll
            for (int ai = 0; ai < 2; ++ai)
#pragma unroll
                for (int bj = 0; bj < 2; ++bj) {
                    bf16x8 Bt[2][2];
#pragma unroll
                    for (int n = 0; n < 2; ++n)
#pragma unroll
                        for (int k = 0; k < 2; ++k) Bt[n][k] = *(LAS const bf16x8*)(sb + bj * HTB + boff + n * 2048 + k * 1024);
#pragma unroll
                    for (int m = 0; m < 4; ++m) {
                        const bf16x8 a0 = *(LAS const bf16x8*)(sa + ai * HTB + aoff + m * 2048), a1 = *(LAS const bf16x8*)(sa + ai * HTB + aoff + m * 2048 + 1024);
#pragma unroll
                        for (int n = 0; n < 2; ++n) {
                            acc[ai][bj][m][n] = __builtin_amdgcn_mfma_f32_16x16x32_bf16(Bt[n][0], a0, acc[ai][bj][m][n], 0, 0, 0);
                            acc[ai][bj][m][n] = __builtin_amdgcn_mfma_f32_16x16x32_bf16(Bt[n][1], a1, acc[ai][bj][m][n], 0, 0, 0);
                        }
                    }
                    __builtin_amdgcn_sched_barrier(0);
                }
            if (t + 1 < 16) write_a(cur ^ 1);
            __syncthreads();
        }
        EpiPlainBf e; e.C = p.LHs() + ((size_t)kvi * 65536 + (size_t)bg * 1024 + c0) * 256; e.ldc = 256; e.pad_ = 0;
        pg8::Unit u; u.pm = 0; u.pn = 0;
        e(acc, u, wr, wc, fr, fq);
    }
}
#if 0
#define KEEP_OLD_PATH 1
#endif
#ifndef SMODE
#define SMODE 3
#endif
#ifndef ATTN_MODE
#define ATTN_MODE 3
#endif

struct KSrcBf { const bf16_t* base; __device__ __forceinline__ bf16x8 operator()(int tok0, int ks, int lane) const { return *(const bf16x8*)(base + (size_t)(tok0 + (lane & 31)) * 64 + 16 * ks + 8 * (lane >> 5)); } };
struct VSrcBfT { const bf16_t* base; int ld; __device__ __forceinline__ bf16x8 operator()(int tok0, int dt, int s2, int lane) const {
        const bf16_t* ptr = base + (size_t)(32 * dt + (lane & 31)) * ld + tok0 + 16 * s2 + 4 * (lane >> 5);
        union { uint4 u; bf16x8 v; } x; const uint2 a = *(const uint2*)ptr, b = *(const uint2*)(ptr + 8); x.u.x = a.x; x.u.y = a.y; x.u.z = b.x; x.u.w = b.y; return x.v; } };

template <class KS>
__device__ __forceinline__ f32x16 qk_tile(const bf16x8 (&qf)[4], const KS& ks, int tok0, int lane) {
    f32x16 s = zero16();
#pragma unroll
    for (int k = 0; k < 4; ++k) s = mfma32(ks(tok0, k, lane), qf[k], s);
    return s;
}
__device__ __forceinline__ float exp2_(float x) { return __builtin_amdgcn_exp2f(x); }
template <class OKF>
__device__ __forceinline__ void sm_stats(const f32x16& s, int hb, OKF ok, float& m, float& l) {
    float sv[16]; float tmax = -1e30f; unsigned okm = 0;
#pragma unroll
    for (int i = 0; i < 16; ++i) { const int kl = (i & 3) + 8 * (i >> 2) + 4 * hb; const bool k = ok(kl); okm |= (k ? 1u : 0u) << i; sv[i] = k ? s[i] : -1e30f; tmax = fmaxf(tmax, sv[i]); }
    tmax = fmaxf(tmax, __shfl_xor(tmax, 32));
    const float mn = fmaxf(m, tmax), alpha = exp2_(m - mn); m = mn;
    float ps = 0.f;
#pragma unroll
    for (int i = 0; i < 16; ++i) ps += ((okm >> i) & 1u) ? exp2_(sv[i] - mn) : 0.f;
    l = l * alpha + ps;
}
template <class OKF, class VF>
__device__ __forceinline__ void sm_pv(const f32x16& s, int hb, OKF ok, VF vf, float& m, float& l, f32x16 (&o)[2]) {
    float sv[16]; float tmax = -1e30f; unsigned okm = 0;
#pragma unroll
    for (int i = 0; i < 16; ++i) { const int kl = (i & 3) + 8 * (i >> 2) + 4 * hb; const bool k = ok(kl); okm |= (k ? 1u : 0u) << i; sv[i] = k ? s[i] : -1e30f; tmax = fmaxf(tmax, sv[i]); }
    tmax = fmaxf(tmax, __shfl_xor(tmax, 32));
    const float mn = fmaxf(m, tmax), alpha = exp2_(m - mn); m = mn;
    float pr[16]; float ps = 0.f;
#pragma unroll
    for (int i = 0; i < 16; ++i) { pr[i] = ((okm >> i) & 1u) ? exp2_(sv[i] - mn) : 0.f; ps += pr[i]; }
    l = l * alpha + ps;
    o[0] *= alpha; o[1] *= alpha;
#pragma unroll
    for (int s2 = 0; s2 < 2; ++s2) {
        const bf16x8 pb = pack8(pr[8 * s2 + 0], pr[8 * s2 + 1], pr[8 * s2 + 2], pr[8 * s2 + 3], pr[8 * s2 + 4], pr[8 * s2 + 5], pr[8 * s2 + 6], pr[8 * s2 + 7]);
#pragma unroll
        for (int dt = 0; dt < 2; ++dt) o[dt] = mfma32(vf(dt, s2), pb, o[dt]);
    }
}
template <class VF>
__device__ __forceinline__ void sm_pv_nomask(const f32x16& s, bool csel, VF vf, float& m, float& l, f32x16 (&o)[2]) {
    float tmax = fmaxf(fmaxf(s[0], s[1]), s[2]);
#pragma unroll
    for (int i = 3; i < 16; ++i) tmax = fmaxf(tmax, s[i]);
    tmax = csel ? tmax : -1e30f;
    tmax = fmaxf(tmax, __shfl_xor(tmax, 32));
    const float mn = fmaxf(m, tmax), alpha = exp2_(m - mn); m = mn;
    float pr[16]; float ps = 0.f;
#pragma unroll
    for (int i = 0; i < 16; ++i) { pr[i] = csel ? exp2_(s[i] - mn) : 0.f; ps += pr[i]; }
    l = l * alpha + ps;
    o[0] *= alpha; o[1] *= alpha;
#pragma unroll
    for (int s2 = 0; s2 < 2; ++s2) {
        const bf16x8 pb = pack8(pr[8 * s2 + 0], pr[8 * s2 + 1], pr[8 * s2 + 2], pr[8 * s2 + 3], pr[8 * s2 + 4], pr[8 * s2 + 5], pr[8 * s2 + 6], pr[8 * s2 + 7]);
#pragma unroll
        for (int dt = 0; dt < 2; ++dt) o[dt] = mfma32(vf(dt, s2), pb, o[dt]);
    }
}
template <class OKF, class VF>
__device__ __forceinline__ void cmp_pass2(const f32x16& s, int hb, OKF ok, VF vf, float m, float inv, f32x16 (&o)[2], LAS float* prow, bool writer) {
    float pr[16];
#pragma unroll
    for (int i = 0; i < 16; ++i) {
        const int kl = (i & 3) + 8 * (i >> 2) + 4 * hb;
        pr[i] = ok(kl) ? exp2_(s[i] - m) * inv : 0.f;
        float q = pr[i] + __shfl_xor(pr[i], 1); q += __shfl_xor(q, 2);
        if (writer) prow[kl] = q;
    }
#pragma unroll
    for (int s2 = 0; s2 < 2; ++s2) {
        const bf16x8 pb = pack8(pr[8 * s2 + 0], pr[8 * s2 + 1], pr[8 * s2 + 2], pr[8 * s2 + 3], pr[8 * s2 + 4], pr[8 * s2 + 5], pr[8 * s2 + 6], pr[8 * s2 + 7]);
#pragma unroll
        for (int dt = 0; dt < 2; ++dt) o[dt] = mfma32(vf(dt, s2), pb, o[dt]);
    }
}

__device__ __forceinline__ void attn_store(const P& p, const f32x16 (&of)[2], int qrow, int head, int hb, bool doit, bf16_t* oadst = nullptr) {
    if (!oadst) oadst = p.oa();
    if (!doit) return;
#pragma unroll
    for (int dt = 0; dt < 2; ++dt)
#pragma unroll
        for (int i4 = 0; i4 < 4; ++i4) {
            const int d = 32 * dt + 8 * i4 + 4 * hb;
            const size_t off = (size_t)qrow * 512 + head * 64 + d;
            const uint2 gw = *(const uint2*)(p.ag() + off);
            f32x4 v;
            v[0] = of[dt][4 * i4 + 0] * __uint_as_float(gw.x << 16); v[1] = of[dt][4 * i4 + 1] * __uint_as_float(gw.x & 0xffff0000u);
            v[2] = of[dt][4 * i4 + 2] * __uint_as_float(gw.y << 16); v[3] = of[dt][4 * i4 + 3] * __uint_as_float(gw.y & 0xffff0000u);
            st_bf4(oadst + off, v);
        }
}


__device__ __forceinline__ void of_put(LAS float* st, int lane, const f32x16 (&o)[2], float sc) {
#pragma unroll
    for (int dt = 0; dt < 2; ++dt)
#pragma unroll
        for (int i = 0; i < 16; ++i) st[(dt * 16 + i) * 64 + lane] = o[dt][i] * sc;
}
__device__ __forceinline__ void of_add(LAS float* st, int lane, const f32x16 (&o)[2], float sc) {
#pragma unroll
    for (int dt = 0; dt < 2; ++dt)
#pragma unroll
        for (int i = 0; i < 16; ++i) st[(dt * 16 + i) * 64 + lane] += o[dt][i] * sc;
}
__device__ __forceinline__ void of_get_add(LAS float* st, int lane, const f32x16 (&o)[2], float sc, f32x16 (&of)[2]) {
#pragma unroll
    for (int dt = 0; dt < 2; ++dt)
#pragma unroll
        for (int i = 0; i < 16; ++i) of[dt][i] = st[(dt * 16 + i) * 64 + lane] + o[dt][i] * sc;
}


template <class NEXT, class OKF>
__device__ __forceinline__ void tile_loop(const bf16x8 (&qf)[4], const KSrcBf& ksrc, const VSrcBfT& vsrc, int tt, NEXT next, OKF ok, int lane, float& m, float& l, f32x16 (&o)[2]) {
    if (tt < 0) return;
    const int hb = lane >> 5;
    bf16x8 kf[4];
#pragma unroll
    for (int ks = 0; ks < 4; ++ks) kf[ks] = ksrc(32 * tt, ks, lane);
#pragma unroll 1
    for (;;) {
        const int tok0 = 32 * tt;
        const int nt = next(tt);
        bf16x8 vf[2][2];
#pragma unroll
        for (int dt = 0; dt < 2; ++dt)
#pragma unroll
            for (int s2 = 0; s2 < 2; ++s2) vf[dt][s2] = vsrc(tok0, dt, s2, lane);
        bf16x8 kn[4];
        const int ntc = nt >= 0 ? nt : tt;
#pragma unroll
        for (int ks = 0; ks < 4; ++ks) kn[ks] = ksrc(32 * ntc, ks, lane);
        f32x16 s = zero16();
#pragma unroll
        for (int ks = 0; ks < 4; ++ks) s = mfma32(kf[ks], qf[ks], s);
        sm_pv(s, hb, [&](int kl) { return ok(tok0, kl); }, [&](int dt, int s2) { return vf[dt][s2]; }, m, l, o);
        if (nt < 0) break;
#pragma unroll
        for (int ks = 0; ks < 4; ++ks) kf[ks] = kn[ks];
        tt = nt;
    }
}

__device__ __forceinline__ void attn_prompt_item(const P& p, int item, LAS unsigned char* wl, int lane, bf16_t* oadst = nullptr) {
    const int bg = item & 7, tg = item >> 3, b = bg >> 1, g = bg & 1;
    const int col = lane & 31, hb = lane >> 5, tl = col >> 2, hh = col & 3;
    const int t0 = tg * 8, qpos = t0 + tl, qrow = b * SEQ + qpos, head = g * 4 + hh;
    bf16x8 qf[4];
#pragma unroll
    for (int ks = 0; ks < 4; ++ks) qf[ks] = *(const bf16x8*)(p.qb() + (size_t)qrow * 512 + head * 64 + 16 * ks + 8 * hb);
    LAS float* psum = (LAS float*)wl;
    LAS unsigned long long* msk = (LAS unsigned long long*)(wl + 8192);
    const float g0 = p.gates()[(size_t)qrow * 32 + head * 3 + 0], g1 = p.gates()[(size_t)qrow * 32 + head * 3 + 1], g2 = p.gates()[(size_t)qrow * 32 + head * 3 + 2];
    f32x16 oc[2]; oc[0] = zero16(); oc[1] = zero16();
    {
        const int cm = t0 + 7 - 31;
        const int ntile = cm >= 0 ? ((cm >> 4) >> 5) + 1 : 0;
        const KSrcBf ksrc{p.kc_p() + (size_t)bg * 256 * 64};
        const VSrcBfT vsrc{p.vcT_p() + (size_t)bg * 64 * 256, 256};
        float m = -1e30f, l = 0.f;
#pragma unroll 1
        for (int kt = 0; kt < ntile; ++kt) {
            const f32x16 s = qk_tile(qf, ksrc, 32 * kt, lane);
            sm_stats(s, hb, [&](int kl) { return 16 * (32 * kt + kl) + 31 <= qpos; }, m, l);
        }
        l += __shfl_xor(l, 32);
        const float inv = l > 0.f ? 1.0f / l : 0.f;
#pragma unroll
        for (int i = 0; i < 32; ++i) psum[i * 64 + lane] = 0.f;
        WAVE_SYNC();
#pragma unroll 1
        for (int kt = 0; kt < ntile; ++kt) {
            const f32x16 s = qk_tile(qf, ksrc, 32 * kt, lane);
            cmp_pass2(s, hb, [&](int kl) { return 16 * (32 * kt + kl) + 31 <= qpos; }, [&](int dt, int s2) { return vsrc(32 * kt, dt, s2, lane); }, m, inv, oc,
                      psum + tl * 256 + 32 * kt, hh == 0);
        }
    }
    WAVE_SYNC();
    for (int t2 = 0; t2 < 8; ++t2) {
        const int t = t0 + t2, cur = t >> 6, n = lane;
        float imp = 0.f;
#pragma unroll
        for (int c = -1; c < 4; ++c) { const int cc = 4 * n + c; if (cc >= 0) imp += psum[t2 * 256 + cc]; }
        if (n == 0 || n == cur || n == cur - 1) imp = 1e4f;
        if (n * 64 > t) imp = -1.0f;
        int rank = 0;
#pragma unroll
        for (int j = 0; j < 64; ++j) {
            const float vj = __uint_as_float(__builtin_amdgcn_readlane(__float_as_uint(imp), j));
            rank += (vj > imp || (vj == imp && j < n)) ? 1 : 0;
        }
        const unsigned long long mk = __ballot(rank < 16);
        if (lane == 0) msk[t2] = mk;
    }
    WAVE_SYNC();
    const unsigned long long mymask = msk[tl];
    unsigned long long um = 0;
#pragma unroll
    for (int i = 0; i < 8; ++i) um |= msk[i];
    const int cur0 = t0 >> 6;
    WAVE_SYNC();
    LAS float* ost = (LAS float*)wl;
    of_put(ost, lane, oc, g0);
    {
        const KSrcBf ksrc{p.kb() + (size_t)((1 * NB + b) * 2 + g) * SEQ * 64};
        const VSrcBfT vsrc{p.vT() + (size_t)((0 * NB + b) * 2 + g) * 64 * SEQ, SEQ};
        float m = -1e30f, l = 0.f; f32x16 o[2]; o[0] = zero16(); o[1] = zero16();
        {
            const unsigned um_lo = __builtin_amdgcn_readfirstlane((unsigned)um), um_hi = __builtin_amdgcn_readfirstlane((unsigned)(um >> 32));
            unsigned long long umu = ((unsigned long long)um_hi << 32) | um_lo;
            if (cur0 < 63) umu &= (2ull << cur0) - 1ull;
            const int first = umu ? 2 * (int)__builtin_ctzll(umu) : -1;
            tile_loop(qf, ksrc, vsrc, first,
                      [&](int tt) { if (!(tt & 1)) return tt + 1; const int n = tt >> 1; if (n >= 63) return -1; const unsigned long long rem = umu >> (n + 1); return rem ? 2 * (n + 1 + (int)__builtin_ctzll(rem)) : -1; },
                      [&](int tok0, int kl) { return (bool)((mymask >> (tok0 >> 6)) & 1ull) && (tok0 + kl <= qpos); }, lane, m, l, o);
        }
        l += __shfl_xor(l, 32);
        const float sc = l > 0.f ? g1 / l : 0.f;
        of_add(ost, lane, o, sc);
    }
    {
        const KSrcBf ksrc{p.kb() + (size_t)((2 * NB + b) * 2 + g) * SEQ * 64};
        const VSrcBfT vsrc{p.vT() + (size_t)((1 * NB + b) * 2 + g) * 64 * SEQ, SEQ};
        float m = -1e30f, l = 0.f; f32x16 o[2]; o[0] = zero16(); o[1] = zero16();
        const int lo = t0 - 511;
        const int nlo = lo > 0 ? (lo >> 6) : 0;
        {
            const int last = 2 * cur0 + 1;
            tile_loop(qf, ksrc, vsrc, 2 * nlo, [&](int tt) { return tt < last ? tt + 1 : -1; },
                      [&](int tok0, int kl) { const int key = tok0 + kl; return key <= qpos && key + 511 >= qpos; }, lane, m, l, o);
        }
        l += __shfl_xor(l, 32);
        const float sc = l > 0.f ? g2 / l : 0.f;
        f32x16 of[2];
        of_get_add(ost, lane, o, sc, of);
        attn_store(p, of, qrow, head, hb, true, oadst);
    }
    WAVE_SYNC();
}

template <class RP, class OKF>
__device__ __forceinline__ void f32_tile(const bf16x8 (&qf)[4], RP rp, OKF ok, LAS bf16_t* vt, int lane, float& m, float& l, f32x16 (&o)[2]) {
    const int col = lane & 31, hb = lane >> 5;
    const float* kr = rp(col);
    f32x16 s = zero16();
#pragma unroll
    for (int ks = 0; ks < 4; ++ks) {
        const float4 a = *(const float4*)(kr + 16 * ks + 8 * hb), c = *(const float4*)(kr + 16 * ks + 8 * hb + 4);
        s = mfma32(pack8(a.x, a.y, a.z, a.w, c.x, c.y, c.z, c.w), qf[ks], s);
    }
    const float* vr = kr + 128 + 32 * hb;
#pragma unroll
    for (int j4 = 0; j4 < 8; ++j4) {
        const float4 a = *(const float4*)(vr + 4 * j4);
        vt[(32 * hb + 4 * j4 + 0) * 40 + col] = f2bf(a.x); vt[(32 * hb + 4 * j4 + 1) * 40 + col] = f2bf(a.y);
        vt[(32 * hb + 4 * j4 + 2) * 40 + col] = f2bf(a.z); vt[(32 * hb + 4 * j4 + 3) * 40 + col] = f2bf(a.w);
    }
    WAVE_SYNC();
    sm_pv(s, hb, ok, [&](int dt, int s2) {
        LAS const bf16_t* ptr = vt + (32 * dt + col) * 40 + 16 * s2 + 4 * hb;
        union { uint4 u; bf16x8 v; } x; const u32x2 a = *(LAS const u32x2*)ptr, c = *(LAS const u32x2*)(ptr + 8); x.u.x = a[0]; x.u.y = a[1]; x.u.z = c[0]; x.u.w = c[1]; return x.v; }, m, l, o);
    WAVE_SYNC();
}

__device__ __forceinline__ void attn_sample_item(const P& p, int item, LAS unsigned char* wl, int lane) {
    const int t = item & 7, g = (item >> 3) & 1, b = item >> 4, bg = b * 2 + g;
    const int col = lane & 31, hb = lane >> 5, hh = col & 3;
    const int qpos = PAST + t, qrow = NP + b * 8 + t, head = g * 4 + hh;
    bf16x8 qf[4];
#pragma unroll
    for (int ks = 0; ks < 4; ++ks) qf[ks] = *(const bf16x8*)(p.qb() + (size_t)qrow * 512 + head * 64 + 16 * ks + 8 * hb);
    LAS float* psum = (LAS float*)wl;
    LAS int* list = (LAS int*)(wl + 8256);
    LAS float* impl = (LAS float*)(wl + 8448);
    LAS bf16_t* vt = (LAS bf16_t*)(wl + 9728);
    const float g0 = p.gates()[(size_t)qrow * 32 + head * 3 + 0], g1 = p.gates()[(size_t)qrow * 32 + head * 3 + 1], g2 = p.gates()[(size_t)qrow * 32 + head * 3 + 2];
    f32x16 oc[2]; oc[0] = zero16(); oc[1] = zero16();
    {
        const KSrcBf ksrc{p.kc_s() + (size_t)bg * 1024 * 64};
        const VSrcBfT vsrc{p.vcT_s() + (size_t)bg * 64 * 1024, 1024};
        float m = -1e30f, l = 0.f;
#pragma unroll 1
        for (int kt = 0; kt < 32; ++kt) {
            const f32x16 s = qk_tile(qf, ksrc, 32 * kt, lane);
            sm_stats(s, hb, [&](int kl) { return 32 * kt + kl <= 1022; }, m, l);
        }
        l += __shfl_xor(l, 32);
        const float inv = l > 0.f ? 1.0f / l : 0.f;
#pragma unroll 1
        for (int kt = 0; kt < 32; ++kt) {
            const f32x16 s = qk_tile(qf, ksrc, 32 * kt, lane);
            cmp_pass2(s, hb, [&](int kl) { return 32 * kt + kl <= 1022; }, [&](int dt, int s2) { return vsrc(32 * kt, dt, s2, lane); }, m, inv, oc, psum + 32 * kt, col == 0);
        }
    }
    WAVE_SYNC();
#pragma unroll
    for (int j = 0; j < 5; ++j) {
        const int n = lane + 64 * j;
        if (n <= 256) {
            float imp = 0.f;
            for (int c = -1; c < 4; ++c) { const int cc = 4 * n + c; if (cc >= 0 && cc <= 1022) imp += psum[cc]; }
            impl[n] = imp;
        }
    }
    WAVE_SYNC();
    {
        int base = 0;
#pragma unroll
        for (int j = 0; j < 4; ++j) {
            const int n = lane + 64 * j;
            const bool cand = n >= 1 && n <= 254;
            const float v = impl[n];
            int rank = 0;
            for (int q = 1; q <= 254; ++q) { const float vq = impl[q]; rank += (vq > v || (vq == v && q < n)) ? 1 : 0; }
            const bool sel = cand && rank < 13;
            const unsigned long long mk = __ballot(sel);
            if (sel) list[base + __popcll(mk & ((1ull << lane) - 1ull))] = n;
            base += __popcll(mk);
        }
        if (lane == 0) { list[13] = 0; list[14] = 255; list[15] = 256; }
    }
    WAVE_SYNC();
#if SMODE & 1
    LAS float* ost = (LAS float*)wl;
    of_put(ost, lane, oc, g0);
    {
        float m = -1e30f, l = 0.f; f32x16 o[2]; o[0] = zero16(); o[1] = zero16();
#pragma unroll 1
        for (int li = 0; li < 16; ++li) {
#if SMODE & 4
            const int n = li < 13 ? 17 * li + 5 : (li == 13 ? 0 : 242 + li);
#else
            const int n = __builtin_amdgcn_readfirstlane(list[li]);
#endif
            if (n < 256) {
                const int page = p.page_table[b * 128 + (n >> 1)];
                const float* base = p.cache_sel + ((size_t)page * 128 + (n & 1) * 64) * 256 + g * 64;
#pragma unroll 1
                for (int k2 = 0; k2 < 2; ++k2)
                    f32_tile(qf, [&](int kl) { return base + (size_t)(32 * k2 + kl) * 256; }, [&](int kl) { return true; }, vt, lane, m, l, o);
            } else {
                const float* base = p.out + O_SEL_S + (size_t)(b * 8) * 256 + g * 64;
                f32_tile(qf, [&](int kl) { return base + (size_t)(kl < 8 ? kl : 7) * 256; }, [&](int kl) { return kl <= t; }, vt, lane, m, l, o);
            }
        }
        l += __shfl_xor(l, 32);
        const float sc = l > 0.f ? g1 / l : 0.f;
        of_add(ost, lane, o, sc);
    }
#endif
#if SMODE & 2
    {
        float m = -1e30f, l = 0.f; f32x16 o[2]; o[0] = zero16(); o[1] = zero16();
        const float* cw = p.cache_win + (size_t)b * 512 * 256 + g * 64;
        const float* nw = p.out + O_WIN_S + ((size_t)b * 512 + 504) * 256 + g * 64;
#pragma unroll 1
        for (int kt = 0; kt < 17; ++kt) {
            f32_tile(qf, [&](int kl) { const int j = 32 * kt + kl; return j < 512 ? cw + (size_t)j * 256 : nw + (size_t)(j - 512 < 8 ? j - 512 : 7) * 256; },
                     [&](int kl) { const int j = 32 * kt + kl; return j >= t + 1 && j <= 512 + t; }, vt, lane, m, l, o);
        }
        l += __shfl_xor(l, 32);
        const float sc = l > 0.f ? g2 / l : 0.f;
        f32x16 of[2];
        of_get_add(ost, lane, o, sc, of);
        attn_store(p, of, qrow, head, hb, col < 4);
    }
    WAVE_SYNC();
#endif
}

constexpr int WL_STRIDE = 15360, KV_OFF = 8 * WL_STRIDE, KV_BUF = 17920, XB_OFF = KV_OFF + 2 * KV_BUF;

struct LoadBf16 {
    const bf16_t* kbase; const bf16_t* vbase; int ld; bool with_v; u32x4_t kr, vr;
    __device__ __forceinline__ void load(int n) {
        const int tid = threadIdx.x, srow = tid >> 3, sch = tid & 7;
        kr = *(const u32x4_t*)(kbase + (size_t)(64 * n + srow) * 64 + sch * 8);
        if (with_v) vr = *(const u32x4_t*)(vbase + (size_t)srow * ld + 64 * n + sch * 8);
    }
    __device__ __forceinline__ void store(LAS unsigned char* buf) const {
        const int tid = threadIdx.x, srow = tid >> 3, sch = tid & 7;
        *(LAS u32x4_t*)(buf + srow * 144 + sch * 16) = kr;
        if (with_v) { LAS u32x2* vp = (LAS u32x2*)(buf + 9216 + srow * 136 + sch * 16); vp[0] = (u32x2){vr[0], vr[1]}; vp[1] = (u32x2){vr[2], vr[3]}; }
    }
};
struct LoadWinF32 {
    const float* cw; const float* nw; f32x4 k0, k1, v0, v1;
    __device__ __forceinline__ void load(int n) {
        const int tid = threadIdx.x, srow = tid >> 3, sch = tid & 7;
        const int j = 64 * n + srow;
        const float* r = j < 512 ? cw + (size_t)j * 256 : nw + (size_t)(j - 512 < 8 ? j - 512 : 7) * 256;
        k0 = *(const f32x4*)(r + sch * 8); k1 = *(const f32x4*)(r + sch * 8 + 4);
        v0 = *(const f32x4*)(r + 128 + sch * 8); v1 = *(const f32x4*)(r + 128 + sch * 8 + 4);
    }
    __device__ __forceinline__ void store(LAS unsigned char* buf) const {
        const int tid = threadIdx.x, srow = tid >> 3, sch = tid & 7;
        u32x4_t kw; kw[0] = pk2(k0[0], k0[1]); kw[1] = pk2(k0[2], k0[3]); kw[2] = pk2(k1[0], k1[1]); kw[3] = pk2(k1[2], k1[3]);
        *(LAS u32x4_t*)(buf + srow * 144 + sch * 16) = kw;
        LAS bf16_t* vb = (LAS bf16_t*)(buf + 9216) + (sch * 8) * 68 + srow;
#pragma unroll
        for (int e = 0; e < 4; ++e) { vb[e * 68] = f2bf(v0[e]); vb[(4 + e) * 68] = f2bf(v1[e]); }
    }
};

template <class LOADER, class NEXT, class ACTIVE, class BODY>
__device__ __forceinline__ void block_loop_g(LOADER ld, LAS unsigned char* kv, int first, NEXT next, ACTIVE active, BODY body) {
    if (first < 0) return;
    int n = first, cur = 0;
    ld.load(n);
    ld.store(kv);
    __syncthreads();
#pragma unroll 1
    for (;;) {
        const int nn = next(n);
        if (nn >= 0) ld.load(nn);
        if (active(n)) body(n, (LAS const bf16_t*)(kv + cur * KV_BUF), (LAS const bf16_t*)(kv + cur * KV_BUF + 9216));
        if (nn >= 0) ld.store(kv + (cur ^ 1) * KV_BUF);
        __syncthreads();
        if (nn < 0) break;
        cur ^= 1; n = nn;
    }
}
template <bool WITH_V, class NEXT, class ACTIVE, class BODY>
__device__ __forceinline__ void block_loop(const bf16_t* kbase, const bf16_t* vbase, int ld, LAS unsigned char* kv, int first, NEXT next, ACTIVE active, BODY body) {
    LoadBf16 L; L.kbase = kbase; L.vbase = vbase; L.ld = ld; L.with_v = WITH_V;
    block_loop_g(L, kv, first, next, active, body);
}
__device__ __forceinline__ bf16x8 lds_kfrag(LAS const bf16_t* kb, int kt, int ks, int col, int hb) { return *(LAS const bf16x8*)(kb + (32 * kt + col) * 72 + 16 * ks + 8 * hb); }
__device__ __forceinline__ bf16x8 lds_vfrag(LAS const bf16_t* vb, int kt, int dt, int s2, int col, int hb) {
    LAS const bf16_t* ptr = vb + (32 * dt + col) * 68 + 32 * kt + 16 * s2 + 4 * hb;
    union { u32x4_t u; bf16x8 v; } x; const u32x2 a = *(LAS const u32x2*)ptr, c = *(LAS const u32x2*)(ptr + 8); x.u[0] = a[0]; x.u[1] = a[1]; x.u[2] = c[0]; x.u[3] = c[1]; return x.v;
}
__device__ __forceinline__ f32x16 lds_qk(const bf16x8 (&qf)[4], LAS const bf16_t* kb, int kt, int col, int hb) {
    f32x16 s = zero16();
#pragma unroll
    for (int ks = 0; ks < 4; ++ks) s = mfma32(lds_kfrag(kb, kt, ks, col, hb), qf[ks], s);
    return s;
}

__device__ __forceinline__ void attn_prompt_block(const P& p, int bg, int j, LAS unsigned char* lds) {
    int tid_l = threadIdx.x; asm volatile("" : "+v"(tid_l));
    const int tid = tid_l, lane = tid & 63, wid = __builtin_amdgcn_readfirstlane(tid >> 6);
    const int b = bg >> 1, g = bg & 1;
    const int col = lane & 31, hb = lane >> 5, tl = col >> 2, hh = col & 3;
    const int t0 = 64 * j + 8 * wid, qpos = t0 + tl, qrow = b * SEQ + qpos, head = g * 4 + hh;
    LAS unsigned char* wl = lds + wid * WL_STRIDE;
    LAS unsigned char* kv = lds + KV_OFF;
    LAS float* psum = (LAS float*)wl;
    LAS unsigned long long* msk = (LAS unsigned long long*)(wl + 8192);
    bf16x8 qf[4];
#pragma unroll
    for (int ks = 0; ks < 4; ++ks) qf[ks] = *(const bf16x8*)(p.qb() + (size_t)qrow * 512 + head * 64 + 16 * ks + 8 * hb);
    const float g0 = p.gates()[(size_t)qrow * 32 + head * 3 + 0], g1 = p.gates()[(size_t)qrow * 32 + head * 3 + 1], g2 = p.gates()[(size_t)qrow * 32 + head * 3 + 2];
    f32x16 oc[2]; oc[0] = zero16(); oc[1] = zero16();
    {
        const int cmb = 64 * j + 63 - 31;
        const int nbc = ((cmb >> 4) >> 6) + 1;
        const int cmw = t0 + 7 - 31;
        const int cmaxw = cmw >= 0 ? (cmw >> 4) : -1;
        const bf16_t* kc = p.kc_p() + (size_t)bg * 256 * 64;
        const bf16_t* vc = p.vcT_p() + (size_t)bg * 64 * 256;
        float m = -1e30f, l = 0.f;
        block_loop<false>(kc, vc, 256, kv, 0, [&](int n) { return n + 1 < nbc ? n + 1 : -1; }, [&](int n) { return cmaxw >= 64 * n; },
            [&](int n, LAS const bf16_t* kb, LAS const bf16_t* vb) {
#pragma unroll 1
                for (int kt = 0; kt < 2; ++kt) {
#if defined(BLK_GLOBAL_FRAGS)
                    const f32x16 s = qk_tile(qf, KSrcBf{kc}, 64 * n + 32 * kt, lane);
#else
                    const f32x16 s = lds_qk(qf, kb, kt, col, hb);
#endif
                    sm_stats(s, hb, [&](int kl) { return 16 * (64 * n + 32 * kt + kl) + 31 <= qpos; }, m, l);
                }
            });
        l += __shfl_xor(l, 32);
        const float inv = l > 0.f ? 1.0f / l : 0.f;
#pragma unroll
        for (int i = 0; i < 32; ++i) psum[i * 64 + lane] = 0.f;
        WAVE_SYNC();
        block_loop<true>(kc, vc, 256, kv, 0, [&](int n) { return n + 1 < nbc ? n + 1 : -1; }, [&](int n) { return cmaxw >= 64 * n; },
            [&](int n, LAS const bf16_t* kb, LAS const bf16_t* vb) {
#pragma unroll 1
                for (int kt = 0; kt < 2; ++kt) {
#if defined(BLK_GLOBAL_FRAGS)
                    const f32x16 s = qk_tile(qf, KSrcBf{kc}, 64 * n + 32 * kt, lane);
                    const VSrcBfT vsg{vc, 256};
                    cmp_pass2(s, hb, [&](int kl) { return 16 * (64 * n + 32 * kt + kl) + 31 <= qpos; }, [&](int dt, int s2) { return vsg(64 * n + 32 * kt, dt, s2, lane); }, m, inv, oc,
#else
                    const f32x16 s = lds_qk(qf, kb, kt, col, hb);
                    cmp_pass2(s, hb, [&](int kl) { return 16 * (64 * n + 32 * kt + kl) + 31 <= qpos; }, [&](int dt, int s2) { return lds_vfrag(vb, kt, dt, s2, col, hb); }, m, inv, oc,
#endif
                              psum + tl * 256 + 64 * n + 32 * kt, hh == 0);
                }
            });
    }
    WAVE_SYNC();
    unsigned long long umw = 0;
    for (int t2 = 0; t2 < 8; ++t2) {
        const int t = t0 + t2, cur = t >> 6, n = lane;
        float imp = 0.f;
#pragma unroll
        for (int c = -1; c < 4; ++c) { const int cc = 4 * n + c; if (cc >= 0) imp += psum[t2 * 256 + cc]; }
        if (n == 0 || n == cur || n == cur - 1) imp = 1e4f;
        if (n * 64 > t) imp = -1.0f;
        int rank = 0;
#pragma unroll
        for (int jj = 0; jj < 64; ++jj) {
            const float vj = __uint_as_float(__builtin_amdgcn_readlane(__float_as_uint(imp), jj));
            rank += (vj > imp || (vj == imp && jj < n)) ? 1 : 0;
        }
        const unsigned long long mk = __ballot(rank < 16);
        if (lane == 0) msk[t2] = mk;
        umw |= mk;
    }
    if (lane == 0) msk[8] = umw;
    __syncthreads();
    const unsigned long long mymask = msk[tl];
    unsigned long long umb = 0;
#pragma unroll
    for (int w2 = 0; w2 < 8; ++w2) umb |= *(LAS const unsigned long long*)(lds + w2 * WL_STRIDE + 8192 + 64);
    {
        const unsigned lo = __builtin_amdgcn_readfirstlane((unsigned)umb), hi = __builtin_amdgcn_readfirstlane((unsigned)(umb >> 32));
        umb = ((unsigned long long)hi << 32) | lo;
        if (j < 63) umb &= (2ull << j) - 1ull;
    }
    LAS float* ost = (LAS float*)wl;
#if defined(DBG_UMB)
    { const unsigned long long lim = j < 63 ? ((2ull << j) - 1ull) : ~0ull; if ((umw & lim & ~umb) != 0ull) oc[0][0] = __builtin_nanf(""); }
#endif
    of_put(ost, lane, oc, g0);
#if defined(DBG_SCHED)
    __builtin_amdgcn_sched_barrier(0);
#endif
#if defined(BLK_OLD_SEL)
    {
        const KSrcBf ksrc{p.kb() + (size_t)((1 * NB + b) * 2 + g) * SEQ * 64};
        const VSrcBfT vsrc{p.vT() + (size_t)((0 * NB + b) * 2 + g) * 64 * SEQ, SEQ};
        float m = -1e30f, l = 0.f; f32x16 o[2]; o[0] = zero16(); o[1] = zero16();
        unsigned long long umu = umw; const int cur0 = j;
        { const unsigned lo = __builtin_amdgcn_readfirstlane((unsigned)umu), hi = __builtin_amdgcn_readfirstlane((unsigned)(umu >> 32)); umu = ((unsigned long long)hi << 32) | lo; }
        if (cur0 < 63) umu &= (2ull << cur0) - 1ull;
        const int first = umu ? 2 * (int)__builtin_ctzll(umu) : -1;
        tile_loop(qf, ksrc, vsrc, first,
                  [&](int tt) { if (!(tt & 1)) return tt + 1; const int n = tt >> 1; if (n >= 63) return -1; const unsigned long long rem = umu >> (n + 1); return rem ? 2 * (n + 1 + (int)__builtin_ctzll(rem)) : -1; },
                  [&](int tok0, int kl) { return (bool)((mymask >> (tok0 >> 6)) & 1ull) && (tok0 + kl <= qpos); }, lane, m, l, o);
        l += __shfl_xor(l, 32);
        const float sc = l > 0.f ? g1 / l : 0.f;
        of_add(ost, lane, o, sc);
    }
#else
    {
        const bf16_t* kbs = p.kb() + (size_t)((1 * NB + b) * 2 + g) * SEQ * 64;
        const bf16_t* vbs = p.vT() + (size_t)((0 * NB + b) * 2 + g) * 64 * SEQ;
        float m = -1e30f, l = 0.f; f32x16 o[2]; o[0] = zero16(); o[1] = zero16();
        block_loop<true>(kbs, vbs, SEQ, kv, umb ? (int)__builtin_ctzll(umb) : -1,
            [&](int n) { if (n >= 63) return -1; const unsigned long long rem = umb >> (n + 1); return rem ? n + 1 + (int)__builtin_ctzll(rem) : -1; },
#if defined(SEL_ALWAYS_ACTIVE)
            [&](int n) { return true; },
#else
            [&](int n) { return (bool)((umw >> n) & 1ull); },
#endif
            [&](int n, LAS const bf16_t* kb, LAS const bf16_t* vb) {
                const bool bsel = (mymask >> n) & 1ull;
#pragma unroll
                for (int kt = 0; kt < 2; ++kt) {
                    const int tok0 = 64 * n + 32 * kt;
#if defined(BLK_GLOBAL_FRAGS)
                    const f32x16 s = qk_tile(qf, KSrcBf{kbs}, tok0, lane);
                    const VSrcBfT vsg{vbs, SEQ};
                    sm_pv(s, hb, [&](int kl) { return bsel && (tok0 + kl <= qpos); }, [&](int dt, int s2) { return vsg(tok0, dt, s2, lane); }, m, l, o);
#else
                    const f32x16 s = lds_qk(qf, kb, kt, col, hb);
                    if (n < j) sm_pv_nomask(s, bsel, [&](int dt, int s2) { return lds_vfrag(vb, kt, dt, s2, col, hb); }, m, l, o);
                    else sm_pv(s, hb, [&](int kl) { return bsel && (tok0 + kl <= qpos); }, [&](int dt, int s2) { return lds_vfrag(vb, kt, dt, s2, col, hb); }, m, l, o);
#endif
                }
            });
        l += __shfl_xor(l, 32);
        const float sc = l > 0.f ? g1 / l : 0.f;
        of_add(ost, lane, o, sc);
#if defined(DBG_SELCMP)
        {
            const float i1 = l > 0.f ? 1.0f / l : 0.f;
            float c1 = 0.f;
            for (int dt = 0; dt < 2; ++dt) for (int i = 0; i < 16; ++i) c1 += o[dt][i] * i1 * (1.0f + 0.37f * (float)(dt * 16 + i));
            const KSrcBf ksrc{kbs}; const VSrcBfT vsrc{vbs, SEQ};
            float m2 = -1e30f, l2 = 0.f; f32x16 o2[2]; o2[0] = zero16(); o2[1] = zero16();
            unsigned long long umu = umw;
            { const unsigned lo = __builtin_amdgcn_readfirstlane((unsigned)umu), hi = __builtin_amdgcn_readfirstlane((unsigned)(umu >> 32)); umu = ((unsigned long long)hi << 32) | lo; }
            if (j < 63) umu &= (2ull << j) - 1ull;
            const int first = umu ? 2 * (int)__builtin_ctzll(umu) : -1;
            tile_loop(qf, ksrc, vsrc, first,
                      [&](int tt) { if (!(tt & 1)) return tt + 1; const int n = tt >> 1; if (n >= 63) return -1; const unsigned long long rem = umu >> (n + 1); return rem ? 2 * (n + 1 + (int)__builtin_ctzll(rem)) : -1; },
                      [&](int tok0, int kl) { return (bool)((mymask >> (tok0 >> 6)) & 1ull) && (tok0 + kl <= qpos); }, lane, m2, l2, o2);
            l2 += __shfl_xor(l2, 32);
            const float i2 = l2 > 0.f ? 1.0f / l2 : 0.f;
            float c2 = 0.f;
            for (int dt = 0; dt < 2; ++dt) for (int i = 0; i < 16; ++i) c2 += o2[dt][i] * i2 * (1.0f + 0.37f * (float)(dt * 16 + i));
            if (!(fabsf(c1 - c2) < DBG_TOL) DBG_COND) ost[lane] = __builtin_nanf("");
        }
#endif
    }
#endif
#if defined(BLK_OLD_WIN)
    {
        const KSrcBf ksrc{p.kb() + (size_t)((2 * NB + b) * 2 + g) * SEQ * 64};
        const VSrcBfT vsrc{p.vT() + (size_t)((1 * NB + b) * 2 + g) * 64 * SEQ, SEQ};
        float m = -1e30f, l = 0.f; f32x16 o[2]; o[0] = zero16(); o[1] = zero16();
        const int lo = t0 - 511; const int nlo = lo > 0 ? (lo >> 6) : 0; const int last = 2 * j + 1;
        tile_loop(qf, ksrc, vsrc, 2 * nlo, [&](int tt) { return tt < last ? tt + 1 : -1; },
                  [&](int tok0, int kl) { const int key = tok0 + kl; return key <= qpos && key + 511 >= qpos; }, lane, m, l, o);
        l += __shfl_xor(l, 32);
        const float sc = l > 0.f ? g2 / l : 0.f;
        f32x16 of[2];
        of_get_add(ost, lane, o, sc, of);
        attn_store(p, of, qrow, head, hb, true);
    }
#else
#if defined(DBG_SCHED)
    __builtin_amdgcn_sched_barrier(0);
#endif
#if defined(DBG_EXTRA_SYNC)
    __syncthreads();
#endif
#if defined(DBG_SLEEP)
    for (int r = 0; r < (wid ^ (j & 7)) * 6; ++r) __builtin_amdgcn_s_sleep(100);
#endif
    {
        const bf16_t* kbw = p.kb() + (size_t)((2 * NB + b) * 2 + g) * SEQ * 64;
        const bf16_t* vbw = p.vT() + (size_t)((1 * NB + b) * 2 + g) * 64 * SEQ;
        float m = -1e30f, l = 0.f; f32x16 o[2]; o[0] = zero16(); o[1] = zero16();
        block_loop<true>(kbw, vbw, SEQ, kv, j > 8 ? j - 8 : 0, [&](int n) { return n < j ? n + 1 : -1; }, [&](int n) { return true; },
            [&](int n, LAS const bf16_t* kb, LAS const bf16_t* vb) {
#pragma unroll 1
                for (int kt = 0; kt < 2; ++kt) {
                    const int tok0 = 64 * n + 32 * kt;
#if defined(BLK_GLOBAL_FRAGS)
                    const f32x16 s = qk_tile(qf, KSrcBf{kbw}, tok0, lane);
                    const VSrcBfT vsg{vbw, SEQ};
                    sm_pv(s, hb, [&](int kl) { const int key = tok0 + kl; return key <= qpos && key + 511 >= qpos; }, [&](int dt, int s2) { return vsg(tok0, dt, s2, lane); }, m, l, o);
#else
                    const f32x16 s = lds_qk(qf, kb, kt, col, hb);
                    if (n < j && n > j - 8) sm_pv_nomask(s, true, [&](int dt, int s2) { return lds_vfrag(vb, kt, dt, s2, col, hb); }, m, l, o);
                    else sm_pv(s, hb, [&](int kl) { const int key = tok0 + kl; return key <= qpos && key + 511 >= qpos; }, [&](int dt, int s2) { return lds_vfrag(vb, kt, dt, s2, col, hb); }, m, l, o);
#endif
                }
            });
        l += __shfl_xor(l, 32);
        const float sc = l > 0.f ? g2 / l : 0.f;
        f32x16 of[2];
        of_get_add(ost, lane, o, sc, of);
        attn_store(p, of, qrow, head, hb, true);
    }
#endif
    __syncthreads();
}

__device__ __forceinline__ void attn_sample_block(const P& p, int bg, LAS unsigned char* lds) {
    int tid_l = threadIdx.x; asm volatile("" : "+v"(tid_l));
    const int tid = tid_l, lane = tid & 63, wid = __builtin_amdgcn_readfirstlane(tid >> 6);
    const int b = bg >> 1, g = bg & 1, t = wid;
    const int col = lane & 31, hb = lane >> 5, hh = col & 3;
    const int qrow = NP + b * 8 + t, head = g * 4 + hh;
    LAS unsigned char* wl = lds + wid * WL_STRIDE;
    LAS unsigned char* kv = lds + KV_OFF;
    bf16x8 qf[4];
#pragma unroll
    for (int ks = 0; ks < 4; ++ks) qf[ks] = *(const bf16x8*)(p.qb() + (size_t)qrow * 512 + head * 64 + 16 * ks + 8 * hb);
    LAS float* psum = (LAS float*)wl;
    LAS int* list = (LAS int*)(wl + 8256);
    LAS float* impl = (LAS float*)(wl + 8448);
    LAS bf16_t* vt = (LAS bf16_t*)(wl + 9728);
    const float g0 = p.gates()[(size_t)qrow * 32 + head * 3 + 0], g1 = p.gates()[(size_t)qrow * 32 + head * 3 + 1], g2 = p.gates()[(size_t)qrow * 32 + head * 3 + 2];
    f32x16 oc[2]; oc[0] = zero16(); oc[1] = zero16();
    {
        const bf16_t* kc = p.kc_s() + (size_t)bg * 1024 * 64;
        const bf16_t* vc = p.vcT_s() + (size_t)bg * 64 * 1024;
        float m = -1e30f, l = 0.f;
        block_loop<false>(kc, vc, 1024, kv, 0, [&](int n) { return n < 15 ? n + 1 : -1; }, [&](int n) { return true; },
            [&](int n, LAS const bf16_t* kb, LAS const bf16_t* vb) {
#pragma unroll 1
                for (int kt = 0; kt < 2; ++kt) {
                    const f32x16 s = lds_qk(qf, kb, kt, col, hb);
                    sm_stats(s, hb, [&](int kl) { return 64 * n + 32 * kt + kl <= 1022; }, m, l);
                }
            });
        l += __shfl_xor(l, 32);
        const float inv = l > 0.f ? 1.0f / l : 0.f;
        block_loop<true>(kc, vc, 1024, kv, 0, [&](int n) { return n < 15 ? n + 1 : -1; }, [&](int n) { return true; },
            [&](int n, LAS const bf16_t* kb, LAS const bf16_t* vb) {
#pragma unroll 1
                for (int kt = 0; kt < 2; ++kt) {
                    const f32x16 s = lds_qk(qf, kb, kt, col, hb);
                    cmp_pass2(s, hb, [&](int kl) { return 64 * n + 32 * kt + kl <= 1022; }, [&](int dt, int s2) { return lds_vfrag(vb, kt, dt, s2, col, hb); }, m, inv, oc,
                              psum + 64 * n + 32 * kt, col == 0);
                }
            });
    }
    WAVE_SYNC();
#pragma unroll
    for (int j = 0; j < 5; ++j) {
        const int n = lane + 64 * j;
        if (n <= 256) {
            float imp = 0.f;
            for (int c = -1; c < 4; ++c) { const int cc = 4 * n + c; if (cc >= 0 && cc <= 1022) imp += psum[cc]; }
            impl[n] = imp;
        }
    }
    WAVE_SYNC();
    {
        int base = 0;
#pragma unroll
        for (int j = 0; j < 4; ++j) {
            const int n = lane + 64 * j;
            const bool cand = n >= 1 && n <= 254;
            const float v = impl[n];
            int rank = 0;
            for (int q = 1; q <= 254; ++q) { const float vq = impl[q]; rank += (vq > v || (vq == v && q < n)) ? 1 : 0; }
            const bool sel = cand && rank < 13;
            const unsigned long long mk = __ballot(sel);
            if (sel) list[base + __popcll(mk & ((1ull << lane) - 1ull))] = n;
            base += __popcll(mk);
        }
        if (lane == 0) { list[13] = 0; list[14] = 255; list[15] = 256; }
    }
    WAVE_SYNC();
    if (lane < 16) {
        const int n = list[lane];
        list[16 + lane] = n < 256 ? p.page_table[b * 128 + (n >> 1)] * 128 + (n & 1) * 64 : -1;
    }
    WAVE_SYNC();
    LAS float* ost = (LAS float*)wl;
    of_put(ost, lane, oc, g0);
    {
        float m = -1e30f, l = 0.f; f32x16 o[2]; o[0] = zero16(); o[1] = zero16();
        const float* newrows = p.out + O_SEL_S + (size_t)(b * 8) * 256 + g * 64;
        auto rowptr = [&](int u) -> const float* {
            const int rb = __builtin_amdgcn_readfirstlane(list[16 + (u >> 1)]);
            return rb >= 0 ? p.cache_sel + ((size_t)rb + 32 * (u & 1) + col) * 256 + g * 64 : newrows + (size_t)(col < 8 ? col : 7) * 256;
        };
        f32x4 kA[4], kB[4];
        { const float* kr = rowptr(0) + 8 * hb;
#pragma unroll
          for (int ks = 0; ks < 4; ++ks) { kA[ks] = *(const f32x4*)(kr + 16 * ks); kB[ks] = *(const f32x4*)(kr + 16 * ks + 4); } }
#pragma unroll 1
        for (int u = 0; u < 31; ++u) {
            const bool isnew = __builtin_amdgcn_readfirstlane(list[16 + (u >> 1)]) < 0;
            const float* vr = rowptr(u) + 128 + 32 * hb;
            f32x4 vv[8];
#pragma unroll
            for (int j4 = 0; j4 < 8; ++j4) vv[j4] = *(const f32x4*)(vr + 4 * j4);
            f32x16 s = zero16();
#pragma unroll
            for (int ks = 0; ks < 4; ++ks) s = mfma32(pack8(kA[ks][0], kA[ks][1], kA[ks][2], kA[ks][3], kB[ks][0], kB[ks][1], kB[ks][2], kB[ks][3]), qf[ks], s);
            if (u + 1 < 31) { const float* kr = rowptr(u + 1) + 8 * hb;
#pragma unroll
                for (int ks = 0; ks < 4; ++ks) { kA[ks] = *(const f32x4*)(kr + 16 * ks); kB[ks] = *(const f32x4*)(kr + 16 * ks + 4); } }
#pragma unroll
            for (int j4 = 0; j4 < 8; ++j4)
#pragma unroll
                for (int e = 0; e < 4; ++e) vt[(32 * hb + 4 * j4 + e) * 40 + col] = f2bf(vv[j4][e]);
            WAVE_SYNC();
            sm_pv(s, hb, [&](int kl) { return !isnew || kl <= t; }, [&](int dt, int s2) {
                LAS const bf16_t* ptr = vt + (32 * dt + col) * 40 + 16 * s2 + 4 * hb;
                union { u32x4_t u4; bf16x8 v; } x; const u32x2 a = *(LAS const u32x2*)ptr, c = *(LAS const u32x2*)(ptr + 8); x.u4[0] = a[0]; x.u4[1] = a[1]; x.u4[2] = c[0]; x.u4[3] = c[1]; return x.v; }, m, l, o);
            WAVE_SYNC();
        }
        l += __shfl_xor(l, 32);
        const float sc = l > 0.f ? g1 / l : 0.f;
        of_add(ost, lane, o, sc);
    }
    {
        float m = -1e30f, l = 0.f; f32x16 o[2]; o[0] = zero16(); o[1] = zero16();
        LoadWinF32 L; L.cw = p.cache_win + (size_t)b * 512 * 256 + g * 64; L.nw = p.out + O_WIN_S + ((size_t)b * 512 + 504) * 256 + g * 64;
        block_loop_g(L, kv, 0, [&](int n) { return n < 8 ? n + 1 : -1; }, [&](int n) { return true; },
            [&](int n, LAS const bf16_t* kb, LAS const bf16_t* vb) {
#pragma unroll 1
                for (int kt = 0; kt < 2; ++kt) {
                    const int j0 = 64 * n + 32 * kt;
                    if (j0 >= 520) break;
                    const f32x16 s = lds_qk(qf, kb, kt, col, hb);
                    sm_pv(s, hb, [&](int kl) { const int j = j0 + kl; return j >= t + 1 && j <= 512 + t; }, [&](int dt, int s2) { return lds_vfrag(vb, kt, dt, s2, col, hb); }, m, l, o);
                }
            });
        l += __shfl_xor(l, 32);
        const float sc = l > 0.f ? g2 / l : 0.f;
        f32x16 of[2];
        of_get_add(ost, lane, o, sc, of);
        attn_store(p, of, qrow, head, hb, col < 4);
    }
    __syncthreads();
}

__device__ __forceinline__ void ph_attn(const P& p, LAS unsigned char* lds, int qsel = 0) {
    const int tid = threadIdx.x, lane = tid & 63, wid = tid >> 6;
    unsigned* ctr = p.bar() + 3584 + 64 * qsel;
    LAS unsigned* qslot = (LAS unsigned*)(lds + XB_OFF + 64);
    for (;;) {
        if (tid == 0) *qslot = __hip_atomic_fetch_add(ctr, 1u, __ATOMIC_RELAXED, __HIP_MEMORY_SCOPE_AGENT);
        __syncthreads();
        const unsigned q = __builtin_amdgcn_readfirstlane(*qslot);
        __syncthreads();
        if (q >= 64u + 512u) break;
#if defined(OLD_SAMPLE_ATTN)
        if (q < 64u) { attn_sample_item(p, (int)q * 8 + wid, lds + wid * WL_STRIDE, lane); __syncthreads(); }
#else
        if (q < 64u) attn_sample_block(p, (int)q, lds);
#endif
#if defined(OLD_PROMPT_ATTN)
        else { const int idx = (int)q - 64; attn_prompt_item(p, 4095 - (idx * 8 + wid), lds + wid * WL_STRIDE, lane); __syncthreads(); }
#else
        else { const int idx = (int)q - 64; attn_prompt_block(p, idx & 7, 63 - (idx >> 3), lds);
#if defined(DBG_REDO_OLD)
            attn_prompt_item(p, (8 * (63 - (idx >> 3)) + wid) * 8 + (idx & 7), lds + wid * WL_STRIDE, lane); __syncthreads();
#endif
        }
#endif
    }
}

#if defined(DBG_CMPALL)
__device__ __forceinline__ void dbg_old_attn(const P& p, LAS unsigned char* lds) {
    const int tid = threadIdx.x, lane = tid & 63, wid = tid >> 6;
    for (int it = blockIdx.x * 8 + wid; it < 4096; it += gridDim.x * 8) attn_prompt_item(p, it, lds + wid * WL_STRIDE, lane, (bf16_t*)p.tmp());
}
__device__ __forceinline__ void dbg_compare(const P& p) {
    const int tid = threadIdx.x, lane = tid & 63, wid = tid >> 6;
    const bf16_t* a = p.oa(); const bf16_t* b = (const bf16_t*)p.tmp();
    unsigned cnt = 0;
    for (int it = blockIdx.x * 8 + wid; it < NP * 8; it += gridDim.x * 8) {
        const int row = it >> 3, head = it & 7;
        const float x = bf2f(a[(size_t)row * 512 + head * 64 + lane]), y = bf2f(b[(size_t)row * 512 + head * 64 + lane]);
        const bool bad = __any(!(fabsf(x - y) <= DBG_TOL));
        const int s = row & (SEQ - 1), j = s >> 6, w = (s >> 3) & 7, g = head >> 2, bb = row >> 12;
        if (bad && (DBG_SEL)) ++cnt;
    }
    if (lane == 0 && cnt) atomicAdd(p.bar() + 3840, cnt);
}
#endif

#if defined(KEEP_OLD_PATH)
__device__ __forceinline__ void keep_old_attn(const P& p, LAS unsigned char* lds) {
    const int tid = threadIdx.x, lane = tid & 63, wid = tid >> 6;
    const int ndbg = (int)__builtin_amdgcn_readfirstlane(__hip_atomic_load(p.bar() + 3900, __ATOMIC_RELAXED, __HIP_MEMORY_SCOPE_AGENT));
    for (int it = blockIdx.x * 8 + wid; it < ndbg; it += gridDim.x * 8) attn_prompt_item(p, it, lds + wid * WL_STRIDE, lane, (bf16_t*)p.tmp());
}
#endif
#ifndef PROBE_PHASE
#define PROBE_PHASE 0
#endif
#ifndef STOP_AFTER
#define STOP_AFTER 3
#endif

constexpr int LDS_BYTES = pg8::STAGE_BYTES;

template <class Epi> __global__ __launch_bounds__(512, 2) void k_gemm(pg8::Gemm g, Epi E) {
    extern __shared__ __attribute__((aligned(16))) unsigned char shm[];
    pg8::StaticOrder S; S.init(g.M, g.N, (int)gridDim.x, (int)blockIdx.x);
    pg8::gemm_phase<Epi, pg8::StaticOrder, false>((PG8_LAS unsigned char*)shm, g, S, E, nullptr);
}
template <int PH> __global__ __launch_bounds__(512, 2) void k_phase(P p) {
    extern __shared__ __attribute__((aligned(16))) unsigned char shm[];
    LAS unsigned char* lds = (LAS unsigned char*)shm;
    if constexpr (PH == 0) ph_prep(p);
    if constexpr (PH == 1) ph_compress2(p, p.LHp(), 8, 256, 255, p.kc_p(), p.vcT_p());
    if constexpr (PH == 2) ph_cvt_cache(p);
    if constexpr (PH == 3) ph_compress2(p, p.LHs(), 64, 1024, 1023, p.kc_s(), p.vcT_s());
    if constexpr (PH == 4) ph_rwkv_prep(p);
    if constexpr (PH == 5) ph_rwkv_scan(p, (LAS float*)lds);
    if constexpr (PH == 6) ph_rwkv_post(p);
    if constexpr (PH == 7) ph_attn(p, lds);
    if constexpr (PH == 8) ph_final(p);
}

template <class Epi> static void launch_gemm(hipStream_t st, const bf16_t* A, const bf16_t* Bt, int M, int N, int K, const Epi& E) {
    static bool attr = false;
    if (!attr) { (void)hipFuncSetAttribute((const void*)k_gemm<Epi>, hipFuncAttributeMaxDynamicSharedMemorySize, LDS_BYTES); attr = true; }
    pg8::Gemm g{}; g.A = A; g.Bt = Bt; g.M = M; g.N = N; g.K = K;
    hipLaunchKernelGGL((k_gemm<Epi>), dim3(256), dim3(512), LDS_BYTES, st, g, E);
}
template <int PH> static void launch_phase(hipStream_t st, const P& p) {
    static bool attr = false;
    if (!attr) { (void)hipFuncSetAttribute((const void*)k_phase<PH>, hipFuncAttributeMaxDynamicSharedMemorySize, LDS_BYTES); attr = true; }
    hipLaunchKernelGGL((k_phase<PH>), dim3(256), dim3(512), LDS_BYTES, st, p);
}


constexpr int FUSED_LDS = XB_OFF + 256;

template <class Epi> __device__ __forceinline__ void run_gemm(LAS unsigned char* lds, const bf16_t* A, const bf16_t* Bt, int M, int N, int K, const Epi& E) {
    pg8::Gemm g; g.A = A; g.Bt = Bt; g.M = M; g.N = N; g.K = K; g.pad_ = 0;
    pg8::StaticOrder S; S.init(M, N, (int)gridDim.x, (int)blockIdx.x);
    pg8::gemm_phase<Epi, pg8::StaticOrder, false>((PG8_LAS unsigned char*)lds, g, S, E, nullptr);
}

#if defined(DBG_LDSCLEAR)
#define XBAR() do { xcd_barrier(bar); for (int _i = threadIdx.x * 16; _i < XB_OFF; _i += 512 * 16) *(LAS u32x4_t*)(lds + _i) = (u32x4_t){DBG_FILL, DBG_FILL, DBG_FILL, DBG_FILL}; __syncthreads(); } while (0)
#elif defined(DBG_DOUBLEBAR)
#define XBAR() do { xcd_barrier(bar); xcd_barrier(bar); } while (0)
#else
#define XBAR() xcd_barrier(bar)
#endif
__global__ __launch_bounds__(512, 2) void k_fused(P p) {
    extern __shared__ __attribute__((aligned(16))) unsigned char shm[];
    LAS unsigned char* lds = (LAS unsigned char*)shm;
    LAS unsigned* xb = (LAS unsigned*)(lds + XB_OFF);
    if (threadIdx.x == 0) { xb[0] = 0u; xb[1] = 0u; xb[2] = 0u; xb[3] = 0u; }
    __syncthreads();
    XcdBarrier bar = xcd_barrier_post(p.bar(), (volatile LAS unsigned*)xb);
    ph_prep(p);
#if PROBE_PHASE == 1
    XBAR();
    ph_prep(p);
#endif
    XBAR();
    { EpiIn e; e.p = p; e.row0 = 0; e.pad_ = 0; run_gemm(lds, p.hb(), p.WinT(), MR, NPAD, DM, e); }
    ph_cmp_gemm_f32(p, lds);
#if PROBE_PHASE == 21
    XBAR();
    { EpiIn e; e.p = p; e.row0 = 0; e.pad_ = 0; run_gemm(lds, p.hb(), p.WinT(), MR, NPAD, DM, e); }
#endif
#if PROBE_PHASE == 22
    XBAR();
    ph_cmp_gemm_f32(p, lds);
#endif
#if PROBE_PHASE == 2
    XBAR();
    { EpiIn e; e.p = p; e.row0 = 0; e.pad_ = 0; run_gemm(lds, p.hb(), p.WinT(), MR, NPAD, DM, e); }
    ph_cmp_gemm_f32(p, lds);
#endif
    XBAR();
    { EpiPlainBf e; e.C = p.LHp(); e.ldc = 256; e.pad_ = 0; run_gemm(lds, p.kb(), p.W1T(), 2048, 256, 1024, e); }
    { EpiPlainBf e; e.C = p.LHp() + (size_t)2048 * 256; e.ldc = 256; e.pad_ = 0; run_gemm(lds, p.vcr(), p.W1T() + (size_t)256 * 1024, 2048, 256, 1024, e); }
    ph_rwkv_prep(p);
    ph_compress2(p, p.LHs(), 64, 1024, 1023, p.kc_s(), p.vcT_s());
#if PROBE_PHASE == 3
    XBAR();
    { EpiPlainBf e; e.C = p.LHp(); e.ldc = 256; e.pad_ = 0; run_gemm(lds, p.kb(), p.W1T(), 2048, 256, 1024, e); }
    { EpiPlainBf e; e.C = p.LHp() + (size_t)2048 * 256; e.ldc = 256; e.pad_ = 0; run_gemm(lds, p.vcr(), p.W1T() + (size_t)256 * 1024, 2048, 256, 1024, e); }
    ph_rwkv_prep(p);
    ph_compress2(p, p.LHs(), 64, 1024, 1023, p.kc_s(), p.vcT_s());
#endif
    XBAR();
    ph_compress2(p, p.LHp(), 8, 256, 255, p.kc_p(), p.vcT_p());
    XBAR();
    ph_rwkv_scan(p, (LAS float*)lds);
#if defined(SCAN_SEPARATE)
    XBAR();
#endif
    __syncthreads();
    ph_attn(p, lds);
#if PROBE_PHASE == 5
    XBAR();
    ph_attn(p, lds, 1);
#endif
    XBAR();
#if defined(KEEP_OLD_PATH)
    keep_old_attn(p, lds);
#endif
#if defined(DBG_XBAR)
    XBAR();
    XBAR();
#endif
#if defined(DBG_CMPALL)
    dbg_old_attn(p, lds);
    XBAR();
    dbg_compare(p);
    XBAR();
#endif
    ph_rwkv_post(p);
    { EpiYa e; e.p = p; small_gemm(p.oa(), p.WpaT(), 512, e); run_gemm(lds, p.oa(), p.WpaT(), NP, DM, 512, e); }
#if PROBE_PHASE == 6
    XBAR();
    ph_rwkv_post(p);
    { EpiYa e; e.p = p; small_gemm(p.oa(), p.WpaT(), 512, e); run_gemm(lds, p.oa(), p.WpaT(), NP, DM, 512, e); }
#endif
    XBAR();
    { EpiYb e; e.p = p; small_gemm(p.ob(), p.WpbT(), 512, e); run_gemm(lds, p.ob(), p.WpbT(), NP, DM, 512, e); }
#if PROBE_PHASE == 7
    XBAR();
    { EpiYb e; e.p = p; small_gemm(p.ob(), p.WpbT(), 512, e); run_gemm(lds, p.ob(), p.WpbT(), NP, DM, 512, e); }
#endif
    XBAR();
    { EpiOut e; e.p = p; small_gemm(p.mb(), p.WoutT(), DM, e); run_gemm(lds, p.mb(), p.WoutT(), NP, DM, DM, e); }
    { EpiPlain e; e.C = p.pp(); e.ldc = DM; e.pad_ = 0; small_gemm(p.pb(), p.WprojT(), 256, e); run_gemm(lds, p.pb(), p.WprojT(), NP, DM, 256, e); }
#if PROBE_PHASE == 8
    XBAR();
    { EpiOut e; e.p = p; small_gemm(p.mb(), p.WoutT(), DM, e); run_gemm(lds, p.mb(), p.WoutT(), NP, DM, DM, e); }
    { EpiPlain e; e.C = p.pp(); e.ldc = DM; e.pad_ = 0; small_gemm(p.pb(), p.WprojT(), 256, e); run_gemm(lds, p.pb(), p.WprojT(), NP, DM, 256, e); }
#endif
    XBAR();
    { EpiGate e; e.p = p; small_gemm(p.xg(), p.WgateT(), DM, e); run_gemm(lds, p.xg(), p.WgateT(), NP, DM, DM, e); }
#if PROBE_PHASE == 9
    XBAR();
    { EpiGate e; e.p = p; small_gemm(p.xg(), p.WgateT(), DM, e); run_gemm(lds, p.xg(), p.WgateT(), NP, DM, DM, e); }
#endif
    XBAR();
    ph_final(p);
}
extern "C" void kernel_launch(void* const* d_in, const int* in_sizes, int n_in, void* d_out, int out_size, void* d_ws, size_t ws_size, hipStream_t stream) {
    (void)in_sizes; (void)n_in; (void)out_size; (void)ws_size;
    P p{};
    p.x_prompt = (const float*)d_in[0]; p.x_sample = (const float*)d_in[1]; p.p_prompt = (const float*)d_in[2]; p.p_sample = (const float*)d_in[3];
    p.cache_cmp = (const float*)d_in[4]; p.cache_sel = (const float*)d_in[5]; p.cache_win = (const float*)d_in[6]; p.state_wkv = (const float*)d_in[7];
    p.state_shift = (const float*)d_in[8]; p.page_table = (const int*)d_in[9]; p.norm_g = (const float*)d_in[10]; p.w_in = (const float*)d_in[11];
    p.cmp_pe = (const float*)d_in[12]; p.cmp_w1 = (const float*)d_in[13]; p.cmp_b1 = (const float*)d_in[14]; p.cmp_w2 = (const float*)d_in[15]; p.cmp_b2 = (const float*)d_in[16];
    p.w_pa = (const float*)d_in[17]; p.mu = (const float*)d_in[18]; p.w0 = (const float*)d_in[19]; p.w_up = (const float*)d_in[20]; p.a0 = (const float*)d_in[21];
    p.a_up = (const float*)d_in[22]; p.k_k = (const float*)d_in[23]; p.k_a = (const float*)d_in[24]; p.r_k = (const float*)d_in[25]; p.gn_g = (const float*)d_in[26];
    p.gn_b = (const float*)d_in[27]; p.w_pb = (const float*)d_in[28]; p.w_out = (const float*)d_in[29]; p.ple_g = (const float*)d_in[30]; p.w_gate = (const float*)d_in[31];
    p.w_proj = (const float*)d_in[32]; p.final_g = (const float*)d_in[33];
    p.out = (float*)d_out;
    p.ws = (unsigned char*)d_ws;

#if defined(MULTI_LAUNCH)
    launch_phase<0>(stream, p);
    { EpiIn e{}; e.p = p; e.row0 = 0; launch_gemm(stream, p.hb(), p.WinT(), MR, NPAD, DM, e); }
#if STOP_AFTER >= 3
    { EpiPlain e{}; e.C = p.LHp(); e.ldc = 256; launch_gemm(stream, p.kb(), p.W1T(), 2048, 256, 1024, e); }
    { EpiPlain e{}; e.C = p.LHp() + (size_t)2048 * 256; e.ldc = 256; launch_gemm(stream, p.vcr(), p.W1T() + (size_t)256 * 1024, 2048, 256, 1024, e); }
    launch_phase<1>(stream, p);
    launch_phase<2>(stream, p);
    { EpiPlain e{}; e.C = p.LHs(); e.ldc = 256; launch_gemm(stream, p.cs(), p.W1T(), 65536, 256, 1024, e); }
    { EpiPlain e{}; e.C = p.LHs() + (size_t)65536 * 256; e.ldc = 256; launch_gemm(stream, p.cs() + (size_t)65536 * 1024, p.W1T() + (size_t)256 * 1024, 65536, 256, 1024, e); }
    launch_phase<3>(stream, p);
#endif
#if STOP_AFTER >= 2
    launch_phase<4>(stream, p);
    launch_phase<5>(stream, p);
    launch_phase<6>(stream, p);
#endif
    hipMemsetAsync(p.oa(), 0, (size_t)MR * 512 * 2, stream);
#if STOP_AFTER >= 3
    launch_phase<7>(stream, p);
#endif
    { EpiYa e{}; e.p = p; launch_gemm(stream, p.oa(), p.WpaT(), MR, DM, 512, e); }
    { EpiYb e{}; e.p = p; launch_gemm(stream, p.ob(), p.WpbT(), MR, DM, 512, e); }
    { EpiOut e{}; e.p = p; launch_gemm(stream, p.mb(), p.WoutT(), MR, DM, DM, e); }
    { EpiPlain e{}; e.C = p.pp(); e.ldc = DM; launch_gemm(stream, p.pb(), p.WprojT(), MR, DM, 256, e); }
    { EpiGate e{}; e.p = p; launch_gemm(stream, p.xg(), p.WgateT(), MR, DM, DM, e); }
    launch_phase<8>(stream, p);
#else
    static int grid = 0;
    if (!grid) {
        int dev = 0, cus = 0, per_cu = 0;
        (void)hipGetDevice(&dev);
        (void)hipDeviceGetAttribute(&cus, hipDeviceAttributeMultiprocessorCount, dev);
        (void)hipFuncSetAttribute((const void*)k_fused, hipFuncAttributeMaxDynamicSharedMemorySize, FUSED_LDS);
        (void)hipOccupancyMaxActiveBlocksPerMultiprocessor(&per_cu, k_fused, 512, FUSED_LDS);
        grid = per_cu >= 1 ? cus : 0;
        if (grid > 256) grid = 256;
    }
    (void)hipMemsetAsync(p.bar(), 0, 32768, stream);
    if (grid > 0) hipLaunchKernelGGL(k_fused, dim3(grid), dim3(512), FUSED_LDS, stream, p);
#endif
}
```

```cpp
#include <hip/hip_runtime.h>
#include <stdint.h>
#include <stdio.h>
namespace pg8 {
#define PG8_LAS __attribute__((address_space(3)))
typedef unsigned short bf16_t;
typedef short bf16x8 __attribute__((ext_vector_type(8)));
typedef float f32x4 __attribute__((ext_vector_type(4)));
typedef unsigned u32x4 __attribute__((ext_vector_type(4)));
constexpr int BM = 256, BK = 64, HALF = 128, HTB = HALF * BK * 2  , STAGE_BYTES = 8 * HTB, NXCD = 8, WGM = 8;

__host__ __device__ __forceinline__ int lds_byte(int r, int c) { const int st = (r >> 4) * 2 + (c >> 5), rr = r & 15, cc = c & 31, ob = rr * 64 + cc * 2; return st * 1024 + (ob ^ (((ob >> 9) & 1) << 5)); }
__host__ __device__ __forceinline__ void stage_rc(int b, int& R, int& C) { const int st = b / 1024, sb = b % 1024, swz = sb ^ (((sb >> 9) & 1) << 5); R = (st >> 1) * 16 + swz / 64; C = (st & 1) * 32 + (swz % 64) / 2; }
__host__ __device__ __forceinline__ int perm32(int rho) { const int n = rho >> 4, i = rho & 15; return 8 * (i >> 2) + 4 * n + (i & 3); }

struct Unit { int pm, pn; };
struct Gemm { const bf16_t* A; const bf16_t* Bt; int M, N, K, pad_; };

struct StaticOrder {
    int nM, nN, nwg, G, c;
    __host__ __device__ void init(int M, int N, int G_, int c_) { nM = M / BM; nN = N / BM; nwg = nM * nN; G = G_; c = c_; }
    __host__ __device__ bool next(int i, Unit& u) const {
        const long L = (long)i * G + c; if (L >= nwg) return false;
        int wgid = (int)L; { const int q = nwg / NXCD, r = nwg % NXCD, xcd = wgid % NXCD, off = wgid / NXCD; wgid = (xcd < r ? xcd * (q + 1) : r * (q + 1) + (xcd - r) * q) + off; }
        const int nig = WGM * nN, gid = wgid / nig, fm = gid * WGM, gsz = (nM - fm) < WGM ? (nM - fm) : WGM;
        u.pm = fm + ((wgid % nig) % gsz); u.pn = (wgid % nig) / gsz; return true;
    }
    __device__ __forceinline__ void a_ready(const Unit&) const {}
    __device__ __forceinline__ void done(const Unit&) const {}
};
__device__ __forceinline__ unsigned cvt_pk_bf16(float lo, float hi) { unsigned r; asm volatile("v_cvt_pk_bf16_f32 %0, %1, %2" : "=v"(r) : "v"(lo), "v"(hi)); return r; }
typedef float f32x2 __attribute__((ext_vector_type(2)));
template <class Epi, class Sched, bool STAMP = false>
__device__ __forceinline__ void gemm_phase(PG8_LAS unsigned char* lds, const Gemm g, const Sched& S, const Epi& E, unsigned long long* stamps) {
    int tid_l = threadIdx.x; asm volatile("" : "+v"(tid_l));
    const int tid = tid_l, wid = __builtin_amdgcn_readfirstlane(tid >> 6), lane = tid & 63, wr = wid >> 2, wc = wid & 3, fr = lane & 15, fq = lane >> 4;
    const int K = g.K, nt = K / BK;
    int ts_lo = 0, ts_hi = 0, nts = 0; const unsigned long long rt_entry = STAMP ? (unsigned long long)wall_clock64() : 0ull;
#define PG8_STAMP() do { if (STAMP && wid == 0 && nts < 64) { const unsigned long long _c = (unsigned long long)clock64(); \
        ts_lo = (lane == nts) ? (int)(unsigned)_c : ts_lo; ts_hi = (lane == nts) ? (int)(unsigned)(_c >> 32) : ts_hi; ++nts; } } while (0)
    PG8_STAMP();
    unsigned voffA[2], voffB[2];
#pragma unroll
    for (int i = 0; i < 2; ++i) { int R, C; stage_rc(tid * 16 + i * 8192, R, C); const int Rb = Epi::PERM ? ((R & ~31) + perm32(R & 31)) : R;
        voffA[i] = (unsigned)(R * K + C) * 2u; voffB[i] = (unsigned)(Rb * K + C) * 2u; }
    const size_t kstep = (size_t)(BK * 2);
    const size_t hstep = (size_t)HALF * K * 2;
    const size_t tstep = 2 * hstep;
    const unsigned ldsw = (unsigned)wid * 1024u;
    const int aoff = lds_byte(wr * 64 + fr, fq * 8), boff = lds_byte(wc * 32 + fr, fq * 8);
#define PG8_SA(b, h) (((b) * 2 + (h)) * HTB)
#define PG8_SB(b, h) ((4 + (b) * 2 + (h)) * HTB)
#define PG8_STAGE(bufoff, gbase, voff) do { _Pragma("unroll") for (int _i = 0; _i < 2; ++_i) \
        __builtin_amdgcn_global_load_lds((const unsigned*)((const char*)(gbase) + (voff)[_i]), (PG8_LAS unsigned*)(lds + (bufoff) + ldsw + _i * 8192), 16, 0, 0); } while (0)
#define PG8_LDA(dst, b, h) do { _Pragma("unroll") for (int m = 0; m < 4; ++m) _Pragma("unroll") for (int k = 0; k < 2; ++k) dst[m][k] = *(const PG8_LAS bf16x8*)(lds + PG8_SA(b, h) + aoff + m * 2048 + k * 1024); } while (0)
#define PG8_LDB(dst, b, h) do { _Pragma("unroll") for (int n = 0; n < 2; ++n) _Pragma("unroll") for (int k = 0; k < 2; ++k) dst[n][k] = *(const PG8_LAS bf16x8*)(lds + PG8_SB(b, h) + boff + n * 2048 + k * 1024); } while (0)
#define PG8_MMA(ai, bj, At, Bt) do { __builtin_amdgcn_s_setprio(1); _Pragma("unroll") for (int m = 0; m < 4; ++m) _Pragma("unroll") for (int n = 0; n < 2; ++n) _Pragma("unroll") for (int k = 0; k < 2; ++k) \
        acc[ai][bj][m][n] = __builtin_amdgcn_mfma_f32_16x16x32_bf16(Bt[n][k], At[m][k], acc[ai][bj][m][n], 0, 0, 0); __builtin_amdgcn_s_setprio(0); } while (0)
#define PG8_WAIT_V(n) asm volatile("s_waitcnt vmcnt(" #n ")" ::: "memory")
#define PG8_WAIT_L(n) asm volatile("s_waitcnt lgkmcnt(" #n ")" ::: "memory")
#define PG8_BAR __builtin_amdgcn_s_barrier()
#define PG8_SCHED __builtin_amdgcn_sched_barrier(0)
    Unit cur, nxt; int ui = 0;
    if (!S.next(0, cur)) return;
    f32x4 acc[2][2][4][2];
#pragma unroll
    for (int a = 0; a < 2; ++a)
#pragma unroll
        for (int b = 0; b < 2; ++b)
#pragma unroll
            for (int m = 0; m < 4; ++m)
#pragma unroll
                for (int n = 0; n < 2; ++n) acc[a][b][m][n] = (f32x4){0.f, 0.f, 0.f, 0.f};
    bf16x8 At[4][2], B0[2][2], B1[2][2];
    const char* cA = (const char*)g.A + (size_t)cur.pm * tstep; const char* cB = (const char*)g.Bt + (size_t)cur.pn * tstep;
    S.a_ready(cur);
    PG8_STAGE(PG8_SB(0, 0), cB, voffB); PG8_STAGE(PG8_SA(0, 0), cA, voffA); PG8_STAGE(PG8_SB(0, 1), cB + hstep, voffB); PG8_STAGE(PG8_SA(0, 1), cA + hstep, voffA);
    if (wr == 1) PG8_BAR;
    PG8_WAIT_V(4); PG8_BAR;
    PG8_STAGE(PG8_SB(1, 0), cB + kstep, voffB); PG8_STAGE(PG8_SA(1, 0), cA + kstep, voffA); PG8_STAGE(PG8_SB(1, 1), cB + hstep + kstep, voffB);
    PG8_WAIT_V(6); PG8_BAR;
    PG8_STAMP();
    for (;;) {
        const bool has_next = S.next(ui + 1, nxt);
        const char* nA = has_next ? (const char*)g.A + (size_t)nxt.pm * tstep : cA; const char* nB = has_next ? (const char*)g.Bt + (size_t)nxt.pn * tstep : cB;
        for (int t = 0; t < nt; t += 2) {
            const bool last = (t == nt - 2);
            const char* a1 = cA + (size_t)(t + 1) * kstep;
            const char* a2 = last ? nA : cA + (size_t)(t + 2) * kstep; const char* b2 = last ? nB : cB + (size_t)(t + 2) * kstep;
            const char* a3 = a2 + kstep; const char* b3 = b2 + kstep;
            if (last && has_next) S.a_ready(nxt);
            PG8_LDB(B0, 0, 0); PG8_SCHED; PG8_LDA(At, 0, 0); PG8_STAGE(PG8_SA(1, 1), a1 + hstep, voffA);
            PG8_WAIT_L(8); PG8_BAR; PG8_WAIT_L(0); PG8_MMA(0, 0, At, B0); PG8_BAR; PG8_SCHED;
            PG8_LDB(B1, 0, 1); PG8_STAGE(PG8_SB(0, 0), b2, voffB);
            PG8_BAR; PG8_WAIT_L(0); PG8_MMA(0, 1, At, B1); PG8_BAR;
            PG8_LDA(At, 0, 1); PG8_STAGE(PG8_SA(0, 0), a2, voffA);
            PG8_BAR; PG8_WAIT_L(0); PG8_MMA(1, 0, At, B0); PG8_BAR; PG8_SCHED;
            PG8_STAGE(PG8_SB(0, 1), b2 + hstep, voffB);
            PG8_WAIT_V(6); PG8_BAR; PG8_MMA(1, 1, At, B1); PG8_BAR;
            PG8_LDB(B0, 1, 0); PG8_SCHED; PG8_LDA(At, 1, 0); PG8_STAGE(PG8_SA(0, 1), a2 + hstep, voffA);
            PG8_WAIT_L(8); PG8_BAR; PG8_WAIT_L(0); PG8_MMA(0, 0, At, B0); PG8_BAR; PG8_SCHED;
            PG8_LDB(B1, 1, 1); PG8_STAGE(PG8_SB(1, 0), b3, voffB);
            PG8_BAR; PG8_WAIT_L(0); PG8_MMA(0, 1, At, B1); PG8_BAR;
            PG8_LDA(At, 1, 1); PG8_STAGE(PG8_SA(1, 0), a3, voffA);
            PG8_BAR; PG8_WAIT_L(0); PG8_MMA(1, 0, At, B0); PG8_BAR; PG8_SCHED;
            PG8_STAGE(PG8_SB(1, 1), b3 + hstep, voffB);
            PG8_WAIT_V(6); PG8_BAR; PG8_MMA(1, 1, At, B1); PG8_BAR;
        }
        PG8_STAMP();
        if constexpr (!Epi::AFTER_DRAIN) { E(acc, cur, wr, wc, fr, fq); S.done(cur); }
        PG8_STAMP();
        if (!has_next) break;
#pragma unroll
        for (int a = 0; a < 2; ++a)
#pragma unroll
            for (int b = 0; b < 2; ++b)
#pragma unroll
                for (int m = 0; m < 4; ++m)
#pragma unroll
                    for (int n = 0; n < 2; ++n) acc[a][b][m][n] = (f32x4){0.f, 0.f, 0.f, 0.f};
        cur = nxt; cA = nA; cB = nB; ++ui;
    }
    PG8_WAIT_V(0);
    if (wr == 0) PG8_BAR;
    PG8_BAR;
    if constexpr (Epi::AFTER_DRAIN) { E.fused(acc, cur, wr, wc, fr, fq, lds, wid, lane); S.done(cur); }
    PG8_STAMP();
    if (STAMP && wid == 0) { stamps[lane] = lane < nts ? (((unsigned long long)(unsigned)ts_hi << 32) | (unsigned)ts_lo) : 0ull;
        if (lane == 62) stamps[62] = rt_entry; if (lane == 63) stamps[63] = (unsigned long long)wall_clock64(); }
#undef PG8_STAMP
#undef PG8_SA
#undef PG8_SB
#undef PG8_STAGE
#undef PG8_LDA
#undef PG8_LDB
#undef PG8_MMA
#undef PG8_WAIT_V
#undef PG8_WAIT_L
#undef PG8_BAR
#undef PG8_SCHED
}
}

typedef unsigned short bf16_t;
typedef short bf16x8 __attribute__((ext_vector_type(8)));
typedef float f32x4 __attribute__((ext_vector_type(4)));
typedef float f32x16 __attribute__((ext_vector_type(16)));
#define LAS __attribute__((address_space(3)))
#define WAVE_SYNC() do { asm volatile("s_waitcnt lgkmcnt(0)" ::: "memory"); __builtin_amdgcn_wave_barrier(); } while (0)

constexpr int DM = 1024, NP = 16384, NSMP = 256, MR = 16640, SEQ = 4096, NB = 4, DB = 32, DS = 8, PAST = 16384;
constexpr int CIN = 6040, NPAD = 6144, CR = 1664;
constexpr int NTHR = 512;
constexpr size_t O_Y_P = 0, O_Y_S = 16777216, O_CMP_P = 17039360, O_CMP_S = 21233664, O_SEL_P = 21299200, O_SEL_S = 25493504,
                 O_WIN_P = 25559040, O_WIN_S = 26083328, O_WKV_P = 30277632, O_WKV_S = 30408704, O_SH_P = 31457280, O_SH_S = 31463936;

constexpr size_t ws_al(size_t x) { return (x + 255) & ~(size_t)255; }
constexpr size_t WS_bar = 0;
constexpr size_t WS_hb = WS_bar + ws_al(32768);
constexpr size_t WS_WinT = WS_hb + ws_al((size_t)MR * DM * 2);
constexpr size_t WS_WpaT = WS_WinT + ws_al((size_t)NPAD * DM * 2);
constexpr size_t WS_WpbT = WS_WpaT + ws_al((size_t)DM * 512 * 2);
constexpr size_t WS_WoutT = WS_WpbT + ws_al((size_t)DM * 512 * 2);
constexpr size_t WS_WgateT = WS_WoutT + ws_al((size_t)DM * DM * 2);
constexpr size_t WS_WprojT = WS_WgateT + ws_al((size_t)DM * DM * 2);
constexpr size_t WS_W1T = WS_WprojT + ws_al((size_t)DM * 256 * 2);
constexpr size_t WS_W2T = WS_W1T + ws_al((size_t)512 * 1024 * 2);
constexpr size_t WS_WupT = WS_W2T + ws_al((size_t)128 * 128 * 2);
constexpr size_t WS_AupT = WS_WupT + ws_al((size_t)512 * 64 * 2);
constexpr size_t WS_pb = WS_AupT + ws_al((size_t)512 * 64 * 2);
constexpr size_t WS_tabc = WS_pb + ws_al((size_t)MR * 256 * 2);
constexpr size_t WS_tabs = WS_tabc + ws_al((size_t)4104 * 32 * 4);
constexpr size_t WS_pt = WS_tabs + ws_al((size_t)4104 * 32 * 4);
constexpr size_t WS_qb = WS_pt + ws_al(256 * 4);
constexpr size_t WS_kb = WS_qb + ws_al((size_t)MR * 512 * 2);
constexpr size_t WS_vcr = WS_kb + ws_al((size_t)3 * NB * 2 * SEQ * 64 * 2);
constexpr size_t WS_vT = WS_vcr + ws_al((size_t)NB * 2 * SEQ * 64 * 2);
constexpr size_t WS_ag = WS_vT + ws_al((size_t)2 * NB * 2 * 64 * SEQ * 2);
constexpr size_t WS_rg = WS_ag + ws_al((size_t)MR * 512 * 2);
constexpr size_t WS_mg = WS_rg + ws_al((size_t)MR * 512 * 2);
constexpr size_t WS_gates = WS_mg + ws_al((size_t)MR * 2048 * 2);
constexpr size_t WS_rz = WS_gates + ws_al((size_t)MR * 32 * 4);
constexpr size_t WS_zs0 = WS_rz + ws_al((size_t)MR * CR * 2);
constexpr size_t WS_LHp = WS_zs0 + ws_al((size_t)33 * CR * 2);
constexpr size_t WS_LHs = WS_LHp + ws_al((size_t)2 * 2048 * 256 * 4);
constexpr size_t WS_cs = WS_LHs + ws_al((size_t)2 * 65536 * 256 * 4);
constexpr size_t WS_kc_p = WS_cs + ws_al((size_t)2 * 65536 * 1024 * 2);
constexpr size_t WS_vcT_p = WS_kc_p + ws_al((size_t)8 * 256 * 64 * 2);
constexpr size_t WS_kc_s = WS_vcT_p + ws_al((size_t)8 * 64 * 256 * 2);
constexpr size_t WS_vcT_s = WS_kc_s + ws_al((size_t)64 * 1024 * 64 * 2);
constexpr size_t WS_rw6 = WS_vcT_s + ws_al((size_t)64 * 64 * 1024 * 2);
constexpr int RW6_STRIDE = 896;
constexpr size_t WS_bonus = WS_rw6 + ws_al((size_t)MR * 8 * RW6_STRIDE);
constexpr size_t WS_ybuf = WS_bonus + ws_al((size_t)MR * 8 * 4);
constexpr size_t WS_oa = WS_ybuf + ws_al((size_t)MR * 512 * 4);
constexpr size_t WS_ob = WS_oa + ws_al((size_t)MR * 512 * 2);
constexpr size_t WS_mb = WS_ob + ws_al((size_t)MR * 512 * 2);
constexpr size_t WS_xg = WS_mb + ws_al((size_t)MR * DM * 2);
constexpr size_t WS_tmp = WS_xg + ws_al((size_t)MR * DM * 2);
constexpr size_t WS_x1 = WS_tmp + ws_al((size_t)MR * DM * 4);
constexpr size_t WS_ss1 = WS_x1 + ws_al((size_t)MR * DM * 4);
constexpr size_t WS_pp = WS_ss1 + ws_al((size_t)MR * 16 * 4);
constexpr size_t WS_TOTAL = WS_pp + ws_al((size_t)MR * DM * 4);

struct P {
    const float *x_prompt, *x_sample, *p_prompt, *p_sample, *cache_cmp, *cache_sel, *cache_win, *state_wkv, *state_shift;
    const int* page_table;
    const float *norm_g, *w_in, *cmp_pe, *cmp_w1, *cmp_b1, *cmp_w2, *cmp_b2, *w_pa, *mu, *w0, *w_up, *a0, *a_up, *k_k, *k_a, *r_k, *gn_g, *gn_b,
        *w_pb, *w_out, *ple_g, *w_gate, *w_proj, *final_g;
    float* out;
    unsigned char* ws;
    __host__ __device__ __forceinline__ unsigned* bar() const { return (unsigned*)(ws + WS_bar); }
    __host__ __device__ __forceinline__ float* ss_s() const { return (float*)(ws + WS_bar + 16384); }
    __host__ __device__ __forceinline__ bf16_t* hb() const { return (bf16_t*)(ws + WS_hb); }
    __host__ __device__ __forceinline__ bf16_t* WinT() const { return (bf16_t*)(ws + WS_WinT); }
    __host__ __device__ __forceinline__ bf16_t* WpaT() const { return (bf16_t*)(ws + WS_WpaT); }
    __host__ __device__ __forceinline__ bf16_t* WpbT() const { return (bf16_t*)(ws + WS_WpbT); }
    __host__ __device__ __forceinline__ bf16_t* WoutT() const { return (bf16_t*)(ws + WS_WoutT); }
    __host__ __device__ __forceinline__ bf16_t* WgateT() const { return (bf16_t*)(ws + WS_WgateT); }
    __host__ __device__ __forceinline__ bf16_t* WprojT() const { return (bf16_t*)(ws + WS_WprojT); }
    __host__ __device__ __forceinline__ bf16_t* W1T() const { return (bf16_t*)(ws + WS_W1T); }
    __host__ __device__ __forceinline__ bf16_t* W2T() const { return (bf16_t*)(ws + WS_W2T); }
    __host__ __device__ __forceinline__ bf16_t* WupT() const { return (bf16_t*)(ws + WS_WupT); }
    __host__ __device__ __forceinline__ bf16_t* AupT() const { return (bf16_t*)(ws + WS_AupT); }
    __host__ __device__ __forceinline__ bf16_t* pb() const { return (bf16_t*)(ws + WS_pb); }
    __host__ __device__ __forceinline__ float* tabc() const { return (float*)(ws + WS_tabc); }
    __host__ __device__ __forceinline__ float* tabs() const { return (float*)(ws + WS_tabs); }
    __host__ __device__ __forceinline__ float* pt() const { return (float*)(ws + WS_pt); }
    __host__ __device__ __forceinline__ bf16_t* qb() const { return (bf16_t*)(ws + WS_qb); }
    __host__ __device__ __forceinline__ bf16_t* kb() const { return (bf16_t*)(ws + WS_kb); }
    __host__ __device__ __forceinline__ bf16_t* vcr() const { return (bf16_t*)(ws + WS_vcr); }
    __host__ __device__ __forceinline__ bf16_t* vT() const { return (bf16_t*)(ws + WS_vT); }
    __host__ __device__ __forceinline__ bf16_t* ag() const { return (bf16_t*)(ws + WS_ag); }
    __host__ __device__ __forceinline__ bf16_t* rg() const { return (bf16_t*)(ws + WS_rg); }
    __host__ __device__ __forceinline__ bf16_t* mg() const { return (bf16_t*)(ws + WS_mg); }
    __host__ __device__ __forceinline__ float* gates() const { return (float*)(ws + WS_gates); }
    __host__ __device__ __forceinline__ bf16_t* rz() const { return (bf16_t*)(ws + WS_rz); }
    __host__ __device__ __forceinline__ bf16_t* zs0() const { return (bf16_t*)(ws + WS_zs0); }
    __host__ __device__ __forceinline__ bf16_t* LHp() const { return (bf16_t*)(ws + WS_LHp); }
    __host__ __device__ __forceinline__ bf16_t* LHs() const { return (bf16_t*)(ws + WS_LHs); }
    __host__ __device__ __forceinline__ bf16_t* cs() const { return (bf16_t*)(ws + WS_cs); }
    __host__ __device__ __forceinline__ bf16_t* kc_p() const { return (bf16_t*)(ws + WS_kc_p); }
    __host__ __device__ __forceinline__ bf16_t* vcT_p() const { return (bf16_t*)(ws + WS_vcT_p); }
    __host__ __device__ __forceinline__ bf16_t* kc_s() const { return (bf16_t*)(ws + WS_kc_s); }
    __host__ __device__ __forceinline__ bf16_t* vcT_s() const { return (bf16_t*)(ws + WS_vcT_s); }
    __host__ __device__ __forceinline__ unsigned char* rw6() const { return ws + WS_rw6; }
    __host__ __device__ __forceinline__ float* bonus() const { return (float*)(ws + WS_bonus); }
    __host__ __device__ __forceinline__ float* ybuf() const { return (float*)(ws + WS_ybuf); }
    __host__ __device__ __forceinline__ bf16_t* oa() const { return (bf16_t*)(ws + WS_oa); }
    __host__ __device__ __forceinline__ bf16_t* ob() const { return (bf16_t*)(ws + WS_ob); }
    __host__ __device__ __forceinline__ bf16_t* mb() const { return (bf16_t*)(ws + WS_mb); }
    __host__ __device__ __forceinline__ bf16_t* xg() const { return (bf16_t*)(ws + WS_xg); }
    __host__ __device__ __forceinline__ float* tmp() const { return (float*)(ws + WS_tmp); }
    __host__ __device__ __forceinline__ float* x1() const { return (float*)(ws + WS_x1); }
    __host__ __device__ __forceinline__ float* ss1() const { return (float*)(ws + WS_ss1); }
    __host__ __device__ __forceinline__ float* pp() const { return (float*)(ws + WS_pp); }
};


__device__ __forceinline__ float bf2f(bf16_t b) { return __uint_as_float(((unsigned)b) << 16); }
typedef __bf16 bf16v2_t __attribute__((ext_vector_type(2)));
typedef float f32x2_t __attribute__((ext_vector_type(2)));
__device__ __forceinline__ unsigned pk2(float lo, float hi) { const f32x2_t v = {lo, hi}; return __builtin_bit_cast(unsigned, __builtin_convertvector(v, bf16v2_t)); }
__device__ __forceinline__ bf16_t f2bf(float f) { return (bf16_t)(pk2(f, f) & 0xffffu); }
__device__ __forceinline__ float wave_sum(float v) {
#pragma unroll
    for (int o = 32; o >= 1; o >>= 1) v += __shfl_xor(v, o);
    return v;
}
#ifndef FAST_RCP_SITES
#define FAST_RCP_SITES 1
#endif
__device__ __forceinline__ float sigmoidf_(float x) { return 1.0f / (1.0f + __expf(-x)); }
__device__ __forceinline__ float siluf_(float x) { return x / (1.0f + __expf(-x)); }
__device__ __forceinline__ float sigmoid_fast(float x) { return __builtin_amdgcn_rcpf(1.0f + __expf(-x)); }
#if defined(SILU_DIVMUL)
__device__ __forceinline__ float silu_fast(float x) { return x * (1.0f / (1.0f + __expf(-x))); }
#elif defined(SILU_NOP)
__device__ __forceinline__ float silu_fast(float x) { float r = __builtin_amdgcn_rcpf(1.0f + __expf(-x)); asm(SILU_NOP_STR : "+v"(r)); return x * r; }
#else
__device__ __forceinline__ float silu_fast(float x) { return x * __builtin_amdgcn_rcpf(1.0f + __expf(-x)); }
#endif
#define SIG(site, x) (((FAST_RCP_SITES) & (site)) ? sigmoid_fast(x) : sigmoidf_(x))
#define SILU(site, x) (((FAST_RCP_SITES) & (site)) ? silu_fast(x) : siluf_(x))

__device__ __forceinline__ int win_src_col(int np) {
    const int pn = np >> 8, p = np & 255;
    if (pn < 5) {
        const int bj = p >> 7, wc = (p >> 5) & 3, n = (p >> 4) & 1, fq = (p >> 2) & 3, e = p & 3;
        const int d = 32 * n + 16 * (wc & 1) + 4 * fq + e;
        if (pn < 2) { const int head = pn * 4 + bj * 2 + (wc >> 1); return head * 64 + d; }
        const int br = pn - 2, g = wc >> 1;
        return 512 + br * 256 + bj * 128 + g * 64 + d;
    }
    const int s = (p & 0xe0) + 8 * ((p >> 2) & 3) + 4 * ((p >> 4) & 1) + (p & 3);
    if (pn < 7) return 1304 + (pn - 5) * 256 + s;
    if (pn < 13) return 1816 + (pn - 7) * 256 + s;
    if (pn == 13) { if (s < 128) return 1816 + 1536 + s; if (s < 152) return 1280 + (s - 128); return -1; }
    if (pn < 16) return 3480 + (pn - 14) * 256 + s;
    return 3992 + (pn - 16) * 256 + s;
}

__device__ __forceinline__ int perm8(int np) { return (np & ~31) + 8 * ((np >> 2) & 3) + 4 * ((np >> 4) & 1) + (np & 3); }
template <class F>
__device__ __forceinline__ void transpose_cvt(bf16_t* dst, int Nd, int K, F f) {
    const int total = Nd * (K >> 3);
    for (int id = blockIdx.x * NTHR + threadIdx.x; id < total; id += gridDim.x * NTHR) {
        const int n = id % Nd, kc = id / Nd;
        float v[8];
#pragma unroll
        for (int j = 0; j < 8; ++j) v[j] = f(n, kc * 8 + j);
        uint4 w; w.x = pk2(v[0], v[1]); w.y = pk2(v[2], v[3]); w.z = pk2(v[4], v[5]); w.w = pk2(v[6], v[7]);
        *(uint4*)(dst + (size_t)n * K + kc * 8) = w;
    }
}

__device__ __forceinline__ void sincos_small(double r, float& s, float& c) {
    const double r2 = r * r;
    double sa = 1.0, ca = 1.0;
    double ts = 1.0, tc = 1.0; sa = 0.0; ca = 0.0;
#pragma unroll
    for (int k = 0; k < 16; ++k) {
        sa += ts; ca += tc;
        ts = -ts * r2 / (double)((2 * k + 2) * (2 * k + 3));
        tc = -tc * r2 / (double)((2 * k + 1) * (2 * k + 2));
    }
    s = (float)(sa * r); c = (float)ca;
}

__device__ __forceinline__ void ph_prep(const P& p) {
    const int tid = threadIdx.x, lane = tid & 63, wid = tid >> 6;
    const int gw = blockIdx.x * 8 + wid, nw = gridDim.x * 8;
    const int gt = blockIdx.x * NTHR + tid, nt = gridDim.x * NTHR;
    for (int row = gw; row < MR; row += nw) {
        const float4* src = (const float4*)(row < NP ? p.x_prompt + (size_t)row * DM : p.x_sample + (size_t)(row - NP) * DM);
        float4 v[4]; float ss = 0.f;
#pragma unroll
        for (int i = 0; i < 4; ++i) { v[i] = src[lane + 64 * i]; ss += v[i].x * v[i].x + v[i].y * v[i].y + v[i].z * v[i].z + v[i].w * v[i].w; }
        ss = wave_sum(ss);
        const float rstd = rsqrtf(ss * (1.0f / DM) + 1e-6f);
#pragma unroll
        for (int i = 0; i < 4; ++i) {
            const float4 g = ((const float4*)p.norm_g)[lane + 64 * i];
            uint2 w; w.x = pk2(v[i].x * rstd * g.x, v[i].y * rstd * g.y); w.y = pk2(v[i].z * rstd * g.z, v[i].w * rstd * g.w);
            *(uint2*)(p.hb() + (size_t)row * DM + 4 * (lane + 64 * i)) = w;
        }
    }
    { const float* w = p.w_in; transpose_cvt(p.WinT(), NPAD, DM, [=](int n, int k) { const int c = win_src_col(n); return c < 0 ? 0.f : w[(size_t)k * CIN + c]; }); }
    { const float* w = p.w_pa; transpose_cvt(p.WpaT(), DM, 512, [=](int n, int k) { return w[(size_t)k * DM + perm8(n)]; }); }
    { const float* w = p.w_pb; transpose_cvt(p.WpbT(), DM, 512, [=](int n, int k) { return w[(size_t)k * DM + perm8(n)]; }); }
    { const float* w = p.w_out; transpose_cvt(p.WoutT(), DM, DM, [=](int n, int k) { return w[(size_t)k * DM + perm8(n)]; }); }
    { const float* w = p.w_gate; transpose_cvt(p.WgateT(), DM, DM, [=](int n, int k) { return w[(size_t)k * DM + perm8(n)]; }); }
    { const float* w = p.w_proj; transpose_cvt(p.WprojT(), DM, 256, [=](int n, int k) { return w[(size_t)k * DM + perm8(n)]; }); }
    { const float* w = p.cmp_w1; transpose_cvt(p.W1T(), 512, 1024, [=](int n, int k) { const int kvi = n >> 8, nn = n & 255; return w[(size_t)kvi * 262144 + (size_t)((nn >> 7) * 1024 + k) * 128 + (nn & 127)]; }); }
    { const float* w = p.cmp_w2; transpose_cvt(p.W2T(), 128, 128, [=](int n, int k) { return w[(size_t)(n >> 6) * 8192 + (size_t)k * 64 + (n & 63)]; }); }
    { const float* w = p.w_up; transpose_cvt(p.WupT(), 512, 64, [=](int n, int k) { return w[(size_t)k * 512 + n]; }); }
    { const float* w = p.a_up; transpose_cvt(p.AupT(), 512, 64, [=](int n, int k) { return w[(size_t)k * 512 + n]; }); }
    for (int id = gt; id < 33 * CR; id += nt) p.zs0()[id] = id < CR ? (bf16_t)0 : f2bf(p.state_shift[id - CR]);
    for (int id = gt; id < MR * 64; id += nt) {
        const int row = id >> 6, c4 = id & 63;
        const float4 v = ((const float4*)(row < NP ? p.p_prompt + (size_t)row * 256 : p.p_sample + (size_t)(row - NP) * 256))[c4];
        uint2 w; w.x = pk2(v.x, v.y); w.y = pk2(v.z, v.w);
        *(uint2*)(p.pb() + (size_t)row * 256 + c4 * 4) = w;
    }
    for (int id = gt; id < 4104 * 32; id += nt) {
        const int pi = id >> 5, i = id & 31;
        const int pos = pi < 4096 ? pi : PAST + pi - 4096;
        const float inv = (float)exp(-(double)i * (9.210340371976184 / 32.0));
        const float ang = (float)pos * inv;
        const double x = (double)ang;
        const double k = rint(x * 0.15915494309189535);
        const double r = x - k * 6.283185307179586;
        float s, c; sincos_small(r, s, c);
        p.tabc()[id] = c; p.tabs()[id] = s;
    }
    for (int o = gw; o < 256; o += nw) {
        const int kvi = o >> 7, f = o & 127;
        float acc = 0.f;
        for (int jd = lane; jd < 2048; jd += 64) acc += p.cmp_pe[kvi * 2048 + jd] * p.cmp_w1[(size_t)kvi * 262144 + (size_t)jd * 128 + f];
        acc = wave_sum(acc);
        if (lane == 0) p.pt()[o] = acc + p.cmp_b1[o];
    }
    for (int id = gt; id < DB * 504 * 64; id += nt) {
        const int c4 = id & 63, j = (id >> 6) % 504, b = (id >> 6) / 504;
        ((float4*)(p.out + O_WIN_S))[((size_t)b * 512 + j) * 64 + c4] = ((const float4*)p.cache_win)[((size_t)b * 512 + j + 8) * 64 + c4];
    }
}
#define XB_TMO      128
#define XB_XCNT(j)  (256  + 64 * (j))
#define XB_XSUB(j)  (1280 + 64 * (j))
#define XB_XGEN(j)  (2304 + 64 * (j))
#define XB_TOP      3328
#define XB_TOPGEN   3392
#define XCD_BAR_WORDS 3456
#define XB_SPIN_CAP (1u << 18)

__device__ __forceinline__ unsigned xb_ld(unsigned* p)              { return __hip_atomic_load(p, __ATOMIC_RELAXED, __HIP_MEMORY_SCOPE_AGENT); }
__device__ __forceinline__ unsigned xb_add(unsigned* p, unsigned v) { return __hip_atomic_fetch_add(p, v, __ATOMIC_RELAXED, __HIP_MEMORY_SCOPE_AGENT); }
__device__ __forceinline__ unsigned xb_xcc_id() { return (unsigned)__builtin_amdgcn_s_getreg((3 << 11) | 20) & 0xFu; }
#define XB_SPIN(cond, bar) do { unsigned _sp = 0; while (cond) { __builtin_amdgcn_s_sleep(1); \
    if ((++_sp & 255u) == 0u) { if (xb_ld(&(bar)[XB_TMO])) break; if (_sp > XB_SPIN_CAP) { atomicAdd(&(bar)[XB_TMO], 1u); break; } } } } while (0)

struct XcdBarrier {
    unsigned* bar; unsigned x;
    volatile LAS unsigned* st;
};

__device__ __forceinline__ XcdBarrier xcd_barrier_post(unsigned* bar, volatile LAS unsigned* st) {
    XcdBarrier b; b.bar = bar; b.x = xb_xcc_id(); b.st = st;
    if (threadIdx.x == 0) (void)xb_add(&bar[XB_XCNT(b.x)], 1u);
    return b;
}
__device__ __forceinline__ void xcd_barrier_complete(unsigned* bar, unsigned x, unsigned& nloc, unsigned& nx) {
    const unsigned G = gridDim.x * gridDim.y * gridDim.z;
    unsigned sum, cnt, mine, sp = 0u;
    for (;;) {
        sum = 0u; cnt = 0u; mine = 0u;
#pragma unroll
        for (unsigned j = 0; j < 16; ++j) { const unsigned c = xb_ld(&bar[XB_XCNT(j)]); sum += c; cnt += (c > 0u) ? 1u : 0u; mine = (j == x) ? c : mine; }
        if (sum == G) break;
        __builtin_amdgcn_s_sleep(1);
        if ((++sp & 255u) == 0u) { if (xb_ld(&bar[XB_TMO])) break; if (sp > XB_SPIN_CAP) { atomicAdd(&bar[XB_TMO], 1u); break; } }
    }
    nloc = mine > 0u ? mine : 1u; nx = cnt > 0u ? cnt : 1u;
}

__device__ __forceinline__ void xcd_barrier(const XcdBarrier& b) {
    asm volatile("s_waitcnt vmcnt(0)" ::: "memory");
    __syncthreads();
    if (threadIdx.x == 0) {
        unsigned* bar = b.bar;
        __builtin_amdgcn_s_waitcnt(0);
        unsigned nloc = b.st[0], nx = b.st[1];
        if (nloc == 0u) { xcd_barrier_complete(bar, b.x, nloc, nx); b.st[0] = nloc; b.st[1] = nx; }
        const unsigned old = xb_add(&bar[XB_XSUB(b.x)], 1u);
        const unsigned gen = old / nloc;
        if (old + 1u == (gen + 1u) * nloc) {
            __builtin_amdgcn_fence(__ATOMIC_RELEASE, "agent");
            asm volatile("s_waitcnt vmcnt(0)" ::: "memory");
            const unsigned og = xb_add(&bar[XB_TOP], 1u);
            const unsigned tg = og / nx;
            if (og + 1u == (tg + 1u) * nx) xb_add(&bar[XB_TOPGEN], 1u);
            else XB_SPIN(xb_ld(&bar[XB_TOPGEN]) == tg, bar);
            __builtin_amdgcn_fence(__ATOMIC_ACQUIRE, "agent");
            xb_add(&bar[XB_XGEN(b.x)], 1u);
            asm volatile("s_waitcnt vmcnt(0)" ::: "memory");
        } else {
            XB_SPIN(xb_ld(&bar[XB_XGEN(b.x)]) == gen, bar);
            __builtin_amdgcn_fence(__ATOMIC_ACQUIRE, "agent");
            asm volatile("s_waitcnt vmcnt(0)" ::: "memory");
        }
    }
    __syncthreads();
}

using pg8::Unit;
typedef unsigned u32x2 __attribute__((ext_vector_type(2)));
typedef unsigned u32x4_t __attribute__((ext_vector_type(4)));
__device__ __forceinline__ f32x16 mfma32(bf16x8 a, bf16x8 b, f32x16 c) { return __builtin_amdgcn_mfma_f32_32x32x16_bf16(a, b, c, 0, 0, 0); }
__device__ __forceinline__ bf16x8 pack8(float a0, float a1, float a2, float a3, float a4, float a5, float a6, float a7) {
    union { uint4 u; bf16x8 v; } x; x.u.x = pk2(a0, a1); x.u.y = pk2(a2, a3); x.u.z = pk2(a4, a5); x.u.w = pk2(a6, a7); return x.v;
}
__device__ __forceinline__ f32x16 zero16() { f32x16 z; for (int i = 0; i < 16; ++i) z[i] = 0.f; return z; }


__device__ __forceinline__ void st_bf4(bf16_t* dst, f32x4 v) { uint2 w; w.x = pk2(v[0], v[1]); w.y = pk2(v[2], v[3]); *(uint2*)dst = w; }

constexpr float QSCALE = 0.125f * 1.4426950408889634f;
struct EpiIn {
    static constexpr bool PERM = false, AFTER_DRAIN = false;
    P p; int row0; int pad_;
    __device__ __forceinline__ void operator()(const f32x4 (&acc)[2][2][4][2], const Unit& u, int wr, int wc, int fr, int fq) const {
        const int pn = u.pn;
#pragma unroll
        for (int ai = 0; ai < 2; ++ai)
#pragma unroll
            for (int m = 0; m < 4; ++m) {
                const int row = row0 + u.pm * 256 + ai * 128 + wr * 64 + m * 16 + fr;
                if (pn < 5) {
                    const int pi = row < NP ? (row & (SEQ - 1)) : 4096 + ((row - NP) & 7);
                    const int d0 = 16 * (wc & 1) + 4 * fq;
                    const f32x4 cs = *(const f32x4*)(p.tabc() + pi * 32 + d0), sn = *(const f32x4*)(p.tabs() + pi * 32 + d0);
#pragma unroll
                    for (int bj = 0; bj < 2; ++bj) {
                        const f32x4 x1 = acc[ai][bj][m][0], x2 = acc[ai][bj][m][1];
                        if (pn < 2) {
                            const int head = pn * 4 + bj * 2 + (wc >> 1);
                            const f32x4 o1 = (x1 * cs - x2 * sn) * QSCALE, o2 = (x2 * cs + x1 * sn) * QSCALE;
                            bf16_t* q = p.qb() + (size_t)row * 512 + head * 64 + d0;
                            st_bf4(q, o1); st_bf4(q + 32, o2);
                        } else {
                            const int br = pn - 2, g = wc >> 1;
                            f32x4 o1, o2;
                            if (bj == 0) { o1 = x1 * cs - x2 * sn; o2 = x2 * cs + x1 * sn; } else { o1 = x1; o2 = x2; }
                            float* dst = nullptr;
                            if (row < NP) {
                                if (br == 0) dst = p.out + O_CMP_P + (size_t)row * 256;
                                else if (br == 1) dst = p.out + O_SEL_P + (size_t)row * 256;
                                else { const int s = row & (SEQ - 1); if (s >= SEQ - 512) dst = p.out + O_WIN_P + ((size_t)(row >> 12) * 512 + (s - (SEQ - 512))) * 256; }
                            } else {
                                const int rs = row - NP;
                                if (br == 0) dst = p.out + O_CMP_S + (size_t)rs * 256;
                                else if (br == 1) dst = p.out + O_SEL_S + (size_t)rs * 256;
                                else dst = p.out + O_WIN_S + ((size_t)(rs >> 3) * 512 + 504 + (rs & 7)) * 256;
                            }
                            if (dst) { dst += bj * 128 + g * 64 + d0; *(f32x4*)dst = o1; *(f32x4*)(dst + 32) = o2; }
                            if (row < NP) {
                                const int b = row >> 12, s = row & (SEQ - 1);
                                if (bj == 0) {
                                    bf16_t* k = p.kb() + ((size_t)((br * NB + b) * 2 + g) * SEQ + s) * 64 + d0;
                                    st_bf4(k, o1); st_bf4(k + 32, o2);
                                } else if (br == 0) {
                                    bf16_t* v = p.vcr() + ((size_t)(b * 2 + g) * SEQ + s) * 64 + d0;
                                    st_bf4(v, o1); st_bf4(v + 32, o2);
                                } else {
                                    bf16_t* v = p.vT() + ((size_t)(((br - 1) * NB + b) * 2 + g) * 64 + d0) * SEQ + s;
#pragma unroll
                                    for (int e = 0; e < 4; ++e) { v[(size_t)e * SEQ] = f2bf(o1[e]); v[(size_t)(32 + e) * SEQ] = f2bf(o2[e]); }
                                }
                            }
                        }
                    }
                } else {
#pragma unroll
                    for (int bj = 0; bj < 2; ++bj) {
                        const int c = bj * 128 + wc * 32 + fq * 8;
                        const f32x4 v0 = acc[ai][bj][m][0], v1 = acc[ai][bj][m][1];
                        auto st8 = [&](bf16_t* dst, const f32x4& a, const f32x4& b) { uint4 w; w.x = pk2(a[0], a[1]); w.y = pk2(a[2], a[3]); w.z = pk2(b[0], b[1]); w.w = pk2(b[2], b[3]); *(uint4*)dst = w; };
                        if (pn < 7 || (pn >= 14 && pn < 16)) {
                            f32x4 o0, o1; for (int e = 0; e < 4; ++e) { o0[e] = SILU(1, v0[e]); o1[e] = SILU(1, v1[e]); }
                            st8((pn < 7 ? p.ag() + (size_t)row * 512 + (pn - 5) * 256 : p.rg() + (size_t)row * 512 + (pn - 14) * 256) + c, o0, o1);
                        } else if (pn < 13) {
                            st8(p.rz() + (size_t)row * CR + (pn - 7) * 256 + c, v0, v1);
                        } else if (pn == 13) {
                            if (c < 128) st8(p.rz() + (size_t)row * CR + 1536 + c, v0, v1);
                            else if (c < 152) { f32x4 o0, o1; for (int e = 0; e < 4; ++e) { o0[e] = SIG(1, v0[e]); o1[e] = SIG(1, v1[e]); }
                                *(f32x4*)(p.gates() + (size_t)row * 32 + (c - 128)) = o0; *(f32x4*)(p.gates() + (size_t)row * 32 + (c - 128) + 4) = o1; }
                        } else {
                            f32x4 o0, o1; for (int e = 0; e < 4; ++e) { o0[e] = SIG(1, v0[e]); o1[e] = SIG(1, v1[e]); }
                            st8(p.mg() + (size_t)row * 2048 + (pn - 16) * 256 + c, o0, o1);
                        }
                    }
                }
            }
    }
};

struct EpiPlain {
    static constexpr bool PERM = false, AFTER_DRAIN = false;
    float* C; int ldc; int pad_;
    __device__ __forceinline__ void quad(int row, int c, f32x4 v) const { *(f32x4*)(C + (size_t)row * ldc + c) = v; }
    __device__ __forceinline__ void operator()(const f32x4 (&acc)[2][2][4][2], const Unit& u, int wr, int wc, int fr, int fq) const {
#pragma unroll
        for (int ai = 0; ai < 2; ++ai)
#pragma unroll
            for (int m = 0; m < 4; ++m) {
                float* rowp = C + (size_t)(u.pm * 256 + ai * 128 + wr * 64 + m * 16 + fr) * ldc + u.pn * 256 + wc * 32 + 8 * fq;
#pragma unroll
                for (int bj = 0; bj < 2; ++bj)
#pragma unroll
                    for (int n = 0; n < 2; ++n) *(f32x4*)(rowp + bj * 128 + n * 4) = acc[ai][bj][m][n];
            }
    }
};


struct EpiPlainBf {
    static constexpr bool PERM = false, AFTER_DRAIN = false;
    bf16_t* C; int ldc; int pad_;
    __device__ __forceinline__ void operator()(const f32x4 (&acc)[2][2][4][2], const Unit& u, int wr, int wc, int fr, int fq) const {
#pragma unroll
        for (int ai = 0; ai < 2; ++ai)
#pragma unroll
            for (int m = 0; m < 4; ++m) {
                bf16_t* rowp = C + (size_t)(u.pm * 256 + ai * 128 + wr * 64 + m * 16 + fr) * ldc + u.pn * 256 + wc * 32 + 4 * fq;
#pragma unroll
                for (int bj = 0; bj < 2; ++bj)
#pragma unroll
                    for (int n = 0; n < 2; ++n) st_bf4(rowp + bj * 128 + n * 16, acc[ai][bj][m][n]);
            }
    }
};

struct EpiYa {
    static constexpr bool PERM = false, AFTER_DRAIN = false;
    P p;
    __device__ __forceinline__ void quad(int row, int c, f32x4 v) const {
        const uint2 gw = *(const uint2*)(p.mg() + (size_t)row * 2048 + c);
        f32x4 g; g[0] = __uint_as_float(gw.x << 16); g[1] = __uint_as_float(gw.x & 0xffff0000u); g[2] = __uint_as_float(gw.y << 16); g[3] = __uint_as_float(gw.y & 0xffff0000u);
        *(f32x4*)(p.tmp() + (size_t)row * DM + c) = g * v;
    }
    __device__ __forceinline__ void operator()(const f32x4 (&acc)[2][2][4][2], const Unit& u, int wr, int wc, int fr, int fq) const {
#pragma unroll
        for (int ai = 0; ai < 2; ++ai)
#pragma unroll
            for (int m = 0; m < 4; ++m) {
                const int row = u.pm * 256 + ai * 128 + wr * 64 + m * 16 + fr;
#pragma unroll
                for (int bj = 0; bj < 2; ++bj)
#pragma unroll
                    for (int n = 0; n < 2; ++n) {
                        const int c = u.pn * 256 + bj * 128 + wc * 32 + fq * 8 + n * 4;
                        const uint2 gw = *(const uint2*)(p.mg() + (size_t)row * 2048 + c);
                        f32x4 g; g[0] = __uint_as_float(gw.x << 16); g[1] = __uint_as_float(gw.x & 0xffff0000u); g[2] = __uint_as_float(gw.y << 16); g[3] = __uint_as_float(gw.y & 0xffff0000u);
                        *(f32x4*)(p.tmp() + (size_t)row * DM + c) = g * acc[ai][bj][m][n];
                    }
            }
    }
};
struct EpiYb {
    static constexpr bool PERM = false, AFTER_DRAIN = false;
    P p;
    __device__ __forceinline__ void quad(int row, int c, f32x4 v) const {
        const uint2 gw = *(const uint2*)(p.mg() + (size_t)row * 2048 + 1024 + c);
        f32x4 g; g[0] = __uint_as_float(gw.x << 16); g[1] = __uint_as_float(gw.x & 0xffff0000u); g[2] = __uint_as_float(gw.y << 16); g[3] = __uint_as_float(gw.y & 0xffff0000u);
        st_bf4(p.mb() + (size_t)row * DM + c, *(const f32x4*)(p.tmp() + (size_t)row * DM + c) + g * v);
    }
    __device__ __forceinline__ void operator()(const f32x4 (&acc)[2][2][4][2], const Unit& u, int wr, int wc, int fr, int fq) const {
#pragma unroll
        for (int ai = 0; ai < 2; ++ai)
#pragma unroll
            for (int m = 0; m < 4; ++m) {
                const int row = u.pm * 256 + ai * 128 + wr * 64 + m * 16 + fr;
#pragma unroll
                for (int bj = 0; bj < 2; ++bj)
#pragma unroll
                    for (int n = 0; n < 2; ++n) {
                        const int c = u.pn * 256 + bj * 128 + wc * 32 + fq * 8 + n * 4;
                        const uint2 gw = *(const uint2*)(p.mg() + (size_t)row * 2048 + 1024 + c);
                        f32x4 g; g[0] = __uint_as_float(gw.x << 16); g[1] = __uint_as_float(gw.x & 0xffff0000u); g[2] = __uint_as_float(gw.y << 16); g[3] = __uint_as_float(gw.y & 0xffff0000u);
                        const f32x4 t = *(const f32x4*)(p.tmp() + (size_t)row * DM + c);
                        st_bf4(p.mb() + (size_t)row * DM + c, t + g * acc[ai][bj][m][n]);
                    }
            }
    }
};
struct EpiOut {
    static constexpr bool PERM = false, AFTER_DRAIN = false;
    P p;
    __device__ __forceinline__ void quad(int row, int c, f32x4 a) const {
        const float* xr = p.x_sample + (size_t)(row - NP) * DM;
        const f32x4 v = *(const f32x4*)(xr + c) + a;
        *(f32x4*)(p.x1() + (size_t)row * DM + c) = v;
        st_bf4(p.xg() + (size_t)row * DM + c, v * *(const f32x4*)(p.ple_g + c));
        atomicAdd(p.ss_s() + (row - NP), v[0] * v[0] + v[1] * v[1] + v[2] * v[2] + v[3] * v[3]);
    }
    __device__ __forceinline__ void operator()(const f32x4 (&acc)[2][2][4][2], const Unit& u, int wr, int wc, int fr, int fq) const {
#pragma unroll
        for (int ai = 0; ai < 2; ++ai)
#pragma unroll
            for (int m = 0; m < 4; ++m) {
                const int row = u.pm * 256 + ai * 128 + wr * 64 + m * 16 + fr;
                const float* xr = row < NP ? p.x_prompt + (size_t)row * DM : p.x_sample + (size_t)(row - NP) * DM;
                float ss = 0.f;
#pragma unroll
                for (int bj = 0; bj < 2; ++bj)
#pragma unroll
                    for (int n = 0; n < 2; ++n) {
                        const int c = u.pn * 256 + bj * 128 + wc * 32 + fq * 8 + n * 4;
                        const f32x4 v = *(const f32x4*)(xr + c) + acc[ai][bj][m][n];
                        *(f32x4*)(p.x1() + (size_t)row * DM + c) = v;
                        ss += v[0] * v[0] + v[1] * v[1] + v[2] * v[2] + v[3] * v[3];
                        st_bf4(p.xg() + (size_t)row * DM + c, v * *(const f32x4*)(p.ple_g + c));
                    }
                ss += __shfl_xor(ss, 16); ss += __shfl_xor(ss, 32);
                if (fq == 0) p.ss1()[(size_t)row * 16 + u.pn * 4 + wc] = ss;
            }
    }
};
struct EpiGate {
    static constexpr bool PERM = false, AFTER_DRAIN = false;
    P p;
    __device__ __forceinline__ void quad(int row, int c, f32x4 acc) const {
        const float rstd = rsqrtf(p.ss_s()[row - NP] * (1.0f / DM) + 1e-6f);
        const f32x4 a = acc * rstd;
        f32x4 g; for (int e = 0; e < 4; ++e) g[e] = SIG(8, a[e]);
        float* ppp = p.pp() + (size_t)row * DM + c;
        *(f32x4*)ppp = *(const f32x4*)(p.x1() + (size_t)row * DM + c) + g * *(const f32x4*)ppp;
    }
    __device__ __forceinline__ void operator()(const f32x4 (&acc)[2][2][4][2], const Unit& u, int wr, int wc, int fr, int fq) const {
#pragma unroll
        for (int ai = 0; ai < 2; ++ai)
#pragma unroll
            for (int m = 0; m < 4; ++m) {
                const int row = u.pm * 256 + ai * 128 + wr * 64 + m * 16 + fr;
                float ss = 0.f;
#pragma unroll
                for (int i = 0; i < 4; ++i) { const f32x4 t = *(const f32x4*)(p.ss1() + (size_t)row * 16 + i * 4); ss += (t[0] + t[1]) + (t[2] + t[3]); }
                const float rstd = rsqrtf(ss * (1.0f / DM) + 1e-6f);
#pragma unroll
                for (int bj = 0; bj < 2; ++bj)
#pragma unroll
                    for (int n = 0; n < 2; ++n) {
                        const int c = u.pn * 256 + bj * 128 + wc * 32 + fq * 8 + n * 4;
                        const f32x4 a = acc[ai][bj][m][n] * rstd;
                        f32x4 g; for (int e = 0; e < 4; ++e) g[e] = SIG(8, a[e]);
                        float* ppp = p.pp() + (size_t)row * DM + c;
                        *(f32x4*)ppp = *(const f32x4*)(p.x1() + (size_t)row * DM + c) + g * *(const f32x4*)ppp;
                    }
            }
    }
};

__device__ __forceinline__ void ph_final(const P& p) {
    const int tid = threadIdx.x, lane = tid & 63, wid = tid >> 6;
    for (int row = blockIdx.x * 8 + wid; row < MR; row += gridDim.x * 8) {
        const float4* src = (const float4*)(p.pp() + (size_t)row * DM);
        float4 v[4]; float ss = 0.f;
#pragma unroll
        for (int i = 0; i < 4; ++i) { v[i] = src[lane + 64 * i]; ss += v[i].x * v[i].x + v[i].y * v[i].y + v[i].z * v[i].z + v[i].w * v[i].w; }
        ss = wave_sum(ss);
        const float rstd = rsqrtf(ss * (1.0f / DM) + 1e-6f);
        float4* dst = (float4*)(p.out + (row < NP ? O_Y_P + (size_t)row * DM : O_Y_S + (size_t)(row - NP) * DM));
#if defined(DBG_CMPALL)
        float dbgs = 1.0f; if (row >= NP) dbgs = 1.0f + (float)p.bar()[3840] * (1.0f / DBG_DIV);
#define DBGS * dbgs
#else
#define DBGS
#endif
#pragma unroll
        for (int i = 0; i < 4; ++i) {
            const float4 g = ((const float4*)p.final_g)[lane + 64 * i];
            float4 o; o.x = v[i].x * rstd * g.x DBGS; o.y = v[i].y * rstd * g.y DBGS; o.z = v[i].z * rstd * g.z DBGS; o.w = v[i].w * rstd * g.w DBGS;
            dst[lane + 64 * i] = o;
        }
    }
}

typedef float f32x4v __attribute__((ext_vector_type(4)));
template <class Epi> __device__ __forceinline__ void small_gemm(const bf16_t* A, const bf16_t* Bt, int K, const Epi& E) {
    const int tid = threadIdx.x, lane = tid & 63, wid = tid >> 6, r16 = lane & 15, q4 = lane >> 4;
    for (int tile = blockIdx.x * 8 + wid; tile < 16 * 64; tile += gridDim.x * 8) {
        const int rt = tile & 15, ct = tile >> 4;
        const bf16_t* ap = A + (size_t)(NP + rt * 16 + r16) * K + 8 * q4;
        const bf16_t* bp = Bt + (size_t)(ct * 16 + r16) * K + 8 * q4;
        f32x4 acc = {0.f, 0.f, 0.f, 0.f};
#pragma unroll 1
        for (int k0 = 0; k0 < K; k0 += 256) {
            bf16x8 af[8], bf[8];
#pragma unroll
            for (int i = 0; i < 8; ++i) { af[i] = *(const bf16x8*)(ap + k0 + 32 * i); bf[i] = *(const bf16x8*)(bp + k0 + 32 * i); }
#pragma unroll
            for (int i = 0; i < 8; ++i) acc = __builtin_amdgcn_mfma_f32_16x16x32_bf16(bf[i], af[i], acc, 0, 0, 0);
        }
        E.quad(NP + rt * 16 + r16, (ct >> 1) * 32 + 8 * q4 + 4 * (ct & 1), acc);
    }
}
#ifndef DBG_PERTURB
#define DBG_PERTURB
#endif

__device__ __forceinline__ f32x4 ld_bf4c(const bf16_t* q) { const uint2 w = *(const uint2*)q; f32x4 v; v[0] = __uint_as_float(w.x << 16); v[1] = __uint_as_float(w.x & 0xffff0000u); v[2] = __uint_as_float(w.y << 16); v[3] = __uint_as_float(w.y & 0xffff0000u); return v; }
__device__ __forceinline__ void compress2_tile(const P& p, const bf16_t* LH, int nbg, int nrows, int nblk, bf16_t* kc, bf16_t* vcT, int kvi, int bg, int tile, int lane, LAS unsigned char* wlds) {
    const int col = lane & 31, hb = lane >> 5;
    {
        const int i = tile * 32 + col;
        const bool live = i < nblk;
        const bf16_t* lbase = LH + ((size_t)kvi * nbg * nrows + (size_t)bg * nrows) * 256;
        const bf16_t* w2t = p.W2T() + (size_t)kvi * 64 * 128;
        LAS bf16_t* hs = (LAS bf16_t*)wlds;
        {
            const int rq = lane >> 4, c8 = lane & 15;
            const f32x4 pa = *(const f32x4*)(p.pt() + kvi * 128 + c8 * 8), pb = *(const f32x4*)(p.pt() + kvi * 128 + c8 * 8 + 4);
#pragma unroll
            for (int it = 0; it < 8; ++it) {
                const int rr = 4 * it + rq, gi = tile * 32 + rr;
                const bf16_t* rp = lbase + (size_t)(gi < nblk ? gi : 0) * 256 + c8 * 8;
                const uint4 lo = *(const uint4*)rp, hi = *(const uint4*)(rp + 256 + 128);
                float hv[8];
                const unsigned lw[4] = {lo.x, lo.y, lo.z, lo.w}, hw[4] = {hi.x, hi.y, hi.z, hi.w};
#pragma unroll
                for (int e = 0; e < 4; ++e) {
                    const float pe0 = e < 2 ? pa[2 * e] : pb[2 * e - 4], pe1 = e < 2 ? pa[2 * e + 1] : pb[2 * e - 3];
                    hv[2 * e] = SILU(2, __uint_as_float(lw[e] << 16) + __uint_as_float(hw[e] << 16) + pe0) DBG_PERTURB;
                    hv[2 * e + 1] = SILU(2, __uint_as_float(lw[e] & 0xffff0000u) + __uint_as_float(hw[e] & 0xffff0000u) + pe1) DBG_PERTURB;
                }
                *(LAS bf16x8*)(hs + rr * 136 + c8 * 8) = pack8(hv[0], hv[1], hv[2], hv[3], hv[4], hv[5], hv[6], hv[7]);
            }
        }
        WAVE_SYNC();
        f32x16 acc[2]; acc[0] = zero16(); acc[1] = zero16();
#pragma unroll
        for (int ks = 0; ks < 8; ++ks) {
            const int f = 16 * ks + 8 * hb;
            const bf16x8 hf = *(LAS const bf16x8*)(hs + col * 136 + f);
#pragma unroll
            for (int dt = 0; dt < 2; ++dt) {
                const bf16x8 wf = *(const bf16x8*)(w2t + (size_t)(32 * dt + col) * 128 + f);
                acc[dt] = (kvi == 0) ? mfma32(wf, hf, acc[dt]) : mfma32(hf, wf, acc[dt]);
            }
        }
        WAVE_SYNC();
        if (kvi == 0) {
            bf16_t* dst = kc + ((size_t)bg * nrows + i) * 64;
#pragma unroll
            for (int dt = 0; dt < 2; ++dt)
#pragma unroll
                for (int i4 = 0; i4 < 4; ++i4) {
                    const int d = 32 * dt + 8 * i4 + 4 * hb;
                    const f32x4 b2 = *(const f32x4*)(p.cmp_b2 + d);
                    f32x4 v; for (int e = 0; e < 4; ++e) v[e] = live ? acc[dt][4 * i4 + e] + b2[e] : 0.f;
                    st_bf4(dst + d, v);
                }
        } else {
#pragma unroll
            for (int dt = 0; dt < 2; ++dt) {
                const int d = 32 * dt + col;
                const float b2 = p.cmp_b2[64 + d];
                bf16_t* dst = vcT + ((size_t)bg * 64 + d) * nrows + tile * 32;
#pragma unroll
                for (int i4 = 0; i4 < 4; ++i4) {
                    const int r = 8 * i4 + 4 * hb;
                    f32x4 v; for (int e = 0; e < 4; ++e) v[e] = (tile * 32 + r + e) < nblk ? acc[dt][4 * i4 + e] + b2 : 0.f;
                    st_bf4(dst + r, v);
                }
            }
        }
    }
}

__device__ __forceinline__ void ph_compress2(const P& p, const bf16_t* LH, int nbg, int nrows, int nblk, bf16_t* kc, bf16_t* vcT, LAS unsigned char* lds) {
    const int tid = threadIdx.x, lane = tid & 63, wid = tid >> 6;
    const int ntile = nrows >> 5, total = 2 * nbg * ntile;
    for (int it = blockIdx.x * 8 + wid; it < total; it += gridDim.x * 8)
        compress2_tile(p, LH, nbg, nrows, nblk, kc, vcT, it / (ntile * nbg), (it / ntile) % nbg, it % ntile, lane, lds + wid * 8960);
}

__device__ __forceinline__ void ph_cvt_cache(const P& p) {
    const size_t total = (size_t)2 * DB * 2 * PAST * 8;
    for (size_t id = (size_t)blockIdx.x * NTHR + threadIdx.x; id < total; id += (size_t)gridDim.x * NTHR) {
        const int d8 = (int)(id & 7), tok = (int)((id >> 3) & (PAST - 1)), g = (int)((id >> 17) & 1), b = (int)((id >> 18) & 31), kvi = (int)(id >> 23);
        const int page = p.page_table[b * 128 + (tok >> 7)];
        const float4* src = (const float4*)(p.cache_cmp + ((size_t)page * 128 + (tok & 127)) * 256 + kvi * 128 + g * 64 + d8 * 8);
        const float4 a = src[0], c = src[1];
        uint4 w; w.x = pk2(a.x, a.y); w.y = pk2(a.z, a.w); w.z = pk2(c.x, c.y); w.w = pk2(c.z, c.w);
        *(uint4*)(p.cs() + id * 8) = w;
    }
}

#if defined(OLD_RWKV_PREP)
__device__ __forceinline__ void ph_rwkv_prep(const P& p) {
    const int tid = threadIdx.x, lane = tid & 63, wid = tid >> 6;
    for (int it = blockIdx.x * 8 + wid; it < MR * 8; it += gridDim.x * 8) {
        const int row = it >> 3, h = it & 7, c = h * 64 + lane;
        const float* z = p.rz() + (size_t)row * CR;
        const float* pv;
        bool zero_prev = false;
        if (row < NP) { if ((row & (SEQ - 1)) == 0) { zero_prev = true; pv = z; } else pv = z - CR; }
        else { const int rs = row - NP; if ((rs & 7) == 0) pv = p.state_shift + (size_t)(rs >> 3) * CR; else pv = z - CR; }
        auto lerp = [&](int col) { const float zz = z[col]; const float pr = zero_prev ? 0.f : pv[col]; return zz + (pr - zz) * p.mu[col]; };
        const float zr = lerp(c), zk = lerp(512 + c), zv = lerp(1024 + c), zwd = lerp(1536 + lane), zad = lerp(1600 + lane);
        const float th = tanhf(zwd);
        float accw = p.w0[c], acca = p.a0[c];
#pragma unroll 8
        for (int j = 0; j < 64; ++j) {
            const float tj = __shfl(th, j), aj = __shfl(zad, j);
            accw += tj * p.w_up[j * 512 + c]; acca += aj * p.a_up[j * 512 + c];
        }
        const float nx = -accw;
        const float sp = fmaxf(nx, 0.f) + log1pf(__expf(-fabsf(nx)));
        const float w = -sp - 0.5f;
        const float dec = __expf(-__expf(w));
        const float a = sigmoidf_(acca);
        const float kkr = zk * p.k_k[c];
        const float nrm = sqrtf(wave_sum(kkr * kkr));
        const float kk = kkr / fmaxf(nrm, 1e-12f);
        const float km = zk * (1.0f + (a - 1.0f) * p.k_a[c]);
        const float bon = wave_sum(zr * km * p.r_k[c]);
        float* o = p.rw6() + (size_t)it * 384 + lane;
        o[0] = zr; o[64] = dec; o[128] = km; o[192] = zv; o[256] = kk; o[320] = kk * a;
        if (lane == 0) p.bonus()[it] = bon;
        if (h == 0) {
            float* so = nullptr;
            if (row < NP) { if ((row & (SEQ - 1)) == SEQ - 1) so = p.out + O_SH_P + (size_t)(row >> 12) * CR; }
            else { const int rs = row - NP; if ((rs & 7) == 7) so = p.out + O_SH_S + (size_t)(rs >> 3) * CR; }
            if (so) for (int i = lane; i < CR; i += 64) so[i] = z[i];
        }
    }
}

#else
__device__ __forceinline__ float dpp_row_sum16(float v) {
    v += __builtin_bit_cast(float, __builtin_amdgcn_mov_dpp(__builtin_bit_cast(int, v), 0xB1, 0xF, 0xF, true));
    v += __builtin_bit_cast(float, __builtin_amdgcn_mov_dpp(__builtin_bit_cast(int, v), 0x4E, 0xF, 0xF, true));
    v += __builtin_bit_cast(float, __builtin_amdgcn_mov_dpp(__builtin_bit_cast(int, v), 0x141, 0xF, 0xF, true));
    v += __builtin_bit_cast(float, __builtin_amdgcn_mov_dpp(__builtin_bit_cast(int, v), 0x140, 0xF, 0xF, true));
    return v;
}
__device__ __forceinline__ float tanh_fast(float x) { const float e = __expf(2.0f * x); return 1.0f - 2.0f / (e + 1.0f); }
__device__ __forceinline__ float half_sum32(float v) { v = dpp_row_sum16(v); return v + __shfl_xor(v, 16); }
__device__ __forceinline__ const bf16_t* rwkv_prev_row(const P& p, int row) {
    if (row < NP) return (row & (SEQ - 1)) == 0 ? p.zs0() : p.rz() + (size_t)(row - 1) * CR;
    const int rs = row - NP;
    return (rs & 7) == 0 ? p.zs0() + (size_t)(1 + (rs >> 3)) * CR : p.rz() + (size_t)(row - 1) * CR;
}
__device__ __forceinline__ f32x4 ld_bf4(const bf16_t* q) { const uint2 w = *(const uint2*)q; f32x4 v; v[0] = __uint_as_float(w.x << 16); v[1] = __uint_as_float(w.x & 0xffff0000u); v[2] = __uint_as_float(w.y << 16); v[3] = __uint_as_float(w.y & 0xffff0000u); return v; }
__device__ __forceinline__ void ph_rwkv_prep(const P& p) {
    const int tid = threadIdx.x, lane = tid & 63, wid = tid >> 6, col = lane & 31, hb = lane >> 5;
    const int gw = blockIdx.x * 8 + wid, nw = gridDim.x * 8;
    for (int it = gw; it < NB + DB; it += nw) {
        const int row = it < NB ? it * SEQ + SEQ - 1 : NP + (it - NB) * 8 + 7;
        float* so = it < NB ? p.out + O_SH_P + (size_t)it * CR : p.out + O_SH_S + (size_t)(it - NB) * CR;
        const bf16_t* z = p.rz() + (size_t)row * CR;
        for (int i = lane; i < CR; i += 64) so[i] = bf2f(z[i]);
    }
    for (int rnd = 0; rnd < 3; ++rnd) {
        int it;
        if (rnd < 2) it = rnd * nw + gw; else { if (wid != 0 || (int)blockIdx.x >= 64) break; it = 2 * nw + (int)blockIdx.x; }
        if (it >= (MR / 32) * 8) break;
        const int h = it & 7, r0 = (it >> 3) * 32;
        bf16x8 Aw[4], Aa[4];
        {
            const int row = r0 + col;
            const bf16_t* z = p.rz() + (size_t)row * CR;
            const bf16_t* pv = rwkv_prev_row(p, row);
#pragma unroll
            for (int ks = 0; ks < 4; ++ks) {
                const int j0 = 16 * ks + 8 * hb;
                float tw[8], ta[8];
#pragma unroll
                for (int q = 0; q < 2; ++q) {
                    const f32x4 zw = ld_bf4(z + 1536 + j0 + 4 * q), za = ld_bf4(z + 1600 + j0 + 4 * q);
                    const f32x4 pw = ld_bf4(pv + 1536 + j0 + 4 * q), pa = ld_bf4(pv + 1600 + j0 + 4 * q);
                    const f32x4 mw = *(const f32x4*)(p.mu + 1536 + j0 + 4 * q), ma = *(const f32x4*)(p.mu + 1600 + j0 + 4 * q);
#pragma unroll
                    for (int e = 0; e < 4; ++e) { tw[4 * q + e] = tanh_fast(zw[e] + (pw[e] - zw[e]) * mw[e]); ta[4 * q + e] = za[e] + (pa[e] - za[e]) * ma[e]; }
                }
                Aw[ks] = pack8(tw[0], tw[1], tw[2], tw[3], tw[4], tw[5], tw[6], tw[7]);
                Aa[ks] = pack8(ta[0], ta[1], ta[2], ta[3], ta[4], ta[5], ta[6], ta[7]);
            }
        }
        f32x16 accw[2], acca[2];
#pragma unroll
        for (int ct = 0; ct < 2; ++ct) {
            accw[ct] = zero16(); acca[ct] = zero16();
            const size_t wo = (size_t)(h * 64 + 32 * ct + col) * 64 + 8 * hb;
#pragma unroll
            for (int ks = 0; ks < 4; ++ks) {
                accw[ct] = mfma32(Aw[ks], *(const bf16x8*)(p.WupT() + wo + 16 * ks), accw[ct]);
                acca[ct] = mfma32(Aa[ks], *(const bf16x8*)(p.AupT() + wo + 16 * ks), acca[ct]);
            }
        }
        float w0v[2], a0v[2], kkv[2], kav[2], rkv[2], mur[2], muk[2], muv[2];
#pragma unroll
        for (int ct = 0; ct < 2; ++ct) {
            const int c = h * 64 + 32 * ct + col;
            w0v[ct] = p.w0[c]; a0v[ct] = p.a0[c]; kkv[ct] = p.k_k[c]; kav[ct] = p.k_a[c]; rkv[ct] = p.r_k[c];
            mur[ct] = p.mu[c]; muk[ct] = p.mu[512 + c]; muv[ct] = p.mu[1024 + c];
        }
#pragma unroll
        for (int hf = 0; hf < 2; ++hf) {
        float zz[8][2][3], pz[2][2][3];
#pragma unroll
        for (int ii = 0; ii < 8; ++ii) {
            const int i = 8 * hf + ii;
            const bf16_t* z = p.rz() + (size_t)(r0 + (i & 3) + 8 * (i >> 2) + 4 * hb) * CR + h * 64 + col;
#pragma unroll
            for (int ct = 0; ct < 2; ++ct) { zz[ii][ct][0] = bf2f(z[32 * ct]); zz[ii][ct][1] = bf2f(z[512 + 32 * ct]); zz[ii][ct][2] = bf2f(z[1024 + 32 * ct]); }
        }
#pragma unroll
        for (int g2 = 0; g2 < 2; ++g2) {
            const bf16_t* pv = rwkv_prev_row(p, r0 + 8 * (2 * hf + g2) + 4 * hb) + h * 64 + col;
#pragma unroll
            for (int ct = 0; ct < 2; ++ct) { pz[g2][ct][0] = bf2f(pv[32 * ct]); pz[g2][ct][1] = bf2f(pv[512 + 32 * ct]); pz[g2][ct][2] = bf2f(pv[1024 + 32 * ct]); }
        }
#pragma unroll
        for (int ii = 0; ii < 8; ++ii) {
            const int i = 8 * hf + ii;
            const int row = r0 + (i & 3) + 8 * (i >> 2) + 4 * hb;
            float zr[2], zk[2], zv[2], dec[2], av[2], kkr[2], km[2];
            float n2 = 0.f, bon = 0.f;
#pragma unroll
            for (int ct = 0; ct < 2; ++ct) {
                const float z0 = zz[ii][ct][0], z1 = zz[ii][ct][1], z2 = zz[ii][ct][2];
                const int ip = ii > 0 ? ii - 1 : 0;
                const float p0 = (i & 3) ? zz[ip][ct][0] : pz[ii >> 2][ct][0], p1 = (i & 3) ? zz[ip][ct][1] : pz[ii >> 2][ct][1], p2 = (i & 3) ? zz[ip][ct][2] : pz[ii >> 2][ct][2];
                zr[ct] = z0 + (p0 - z0) * mur[ct]; zk[ct] = z1 + (p1 - z1) * muk[ct]; zv[ct] = z2 + (p2 - z2) * muv[ct];
                const float nx = -(w0v[ct] + accw[ct][i]);
                const float sp = fmaxf(nx, 0.f) + __logf(1.0f + __expf(-fabsf(nx)));
                dec[ct] = __expf(-__expf(-sp - 0.5f));
                av[ct] = SIG(4, a0v[ct] + acca[ct][i]);
                kkr[ct] = zk[ct] * kkv[ct];
                km[ct] = zk[ct] * (1.0f + (av[ct] - 1.0f) * kav[ct]);
                n2 += kkr[ct] * kkr[ct];
                bon += zr[ct] * km[ct] * rkv[ct];
            }
            n2 = half_sum32(n2); bon = half_sum32(bon);
            const float rn = 1.0f / fmaxf(sqrtf(n2), 1e-12f);
            unsigned char* o = p.rw6() + ((size_t)row * 8 + h) * RW6_STRIDE;
#pragma unroll
            for (int ct = 0; ct < 2; ++ct) {
                const float kk = kkr[ct] * rn;
                const int cl = 32 * ct + col;
                ((float*)o)[cl] = dec[ct];
                bf16_t* ob = (bf16_t*)(o + 256) + cl;
                ob[0] = f2bf(zr[ct]); ob[64] = f2bf(km[ct]); ob[128] = f2bf(zv[ct]); ob[192] = f2bf(kk); ob[256] = f2bf(kk * av[ct]);
            }
            if (col == 0) p.bonus()[(size_t)row * 8 + h] = bon;
        }
        }
    }
}

#endif
typedef float f32x2 __attribute__((ext_vector_type(2)));
__device__ __forceinline__ float dpp_row_sum(float v) {
    v += __builtin_bit_cast(float, __builtin_amdgcn_mov_dpp(__builtin_bit_cast(int, v), 0xB1, 0xF, 0xF, true));
    v += __builtin_bit_cast(float, __builtin_amdgcn_mov_dpp(__builtin_bit_cast(int, v), 0x4E, 0xF, 0xF, true));
    v += __builtin_bit_cast(float, __builtin_amdgcn_mov_dpp(__builtin_bit_cast(int, v), 0x141, 0xF, 0xF, true));
    v += __builtin_bit_cast(float, __builtin_amdgcn_mov_dpp(__builtin_bit_cast(int, v), 0x140, 0xF, 0xF, true));
    return v;
}
constexpr int SCAN_TC = 32;
template <int NROWS>
__device__ __forceinline__ void scan_item(const P& p, LAS float* lds, int row0, int T, int h, int half, const float* s0, float* sout) {
    const int tid = threadIdx.x, w = tid >> 6, lane = tid & 63, rl = lane >> 4, kq = lane & 15;
    const bool act = w * 4 < NROWS;
    const int vrow = half * NROWS + (act ? w * 4 : 0) + rl;
    f32x4 S;
    if (s0) S = *(const f32x4*)(s0 + vrow * 64 + kq * 4); else { S[0] = 0.f; S[1] = 0.f; S[2] = 0.f; S[3] = 0.f; }
    const unsigned char* src = p.rw6() + ((size_t)row0 * 8 + h) * RW6_STRIDE;
    const int nchunk = (T + SCAN_TC - 1) / SCAN_TC;
    u32x4_t stg[4];
    int ss[4], sc[4], sl[4];
#pragma unroll
    for (int i = 0; i < 4; ++i) {
        const int idx = i * 512 + tid; ss[i] = idx / 56; sc[i] = idx % 56;
        const int cb = sc[i] - 16, q = cb >> 3;
        sl[i] = sc[i] < 16 ? 64 + 4 * sc[i] : (q == 0 ? 0 : 64 + 64 * q) + 8 * (cb & 7);
    }
    auto put = [&](LAS float* b, int i) {
        LAS float* d = b + ss[i] * 384 + sl[i];
        if (sc[i] < 16) *(LAS u32x4_t*)d = stg[i];
        else {
            f32x4 lo, hi;
            lo[0] = __uint_as_float(stg[i][0] << 16); lo[1] = __uint_as_float(stg[i][0] & 0xffff0000u); lo[2] = __uint_as_float(stg[i][1] << 16); lo[3] = __uint_as_float(stg[i][1] & 0xffff0000u);
            hi[0] = __uint_as_float(stg[i][2] << 16); hi[1] = __uint_as_float(stg[i][2] & 0xffff0000u); hi[2] = __uint_as_float(stg[i][3] << 16); hi[3] = __uint_as_float(stg[i][3] & 0xffff0000u);
            *(LAS f32x4*)d = lo; *(LAS f32x4*)(d + 4) = hi;
        }
    };
    {
        const int ns = T < SCAN_TC ? T : SCAN_TC;
#pragma unroll
        for (int i = 0; i < 4; ++i) if (ss[i] < ns) { stg[i] = *(const u32x4_t*)(src + (size_t)ss[i] * (8 * RW6_STRIDE) + sc[i] * 16); put(lds, i); }
    }
    __syncthreads();
    for (int c = 0; c < nchunk; ++c) {
        const int t0 = c * SCAN_TC;
        const int ns = (T - t0) < SCAN_TC ? (T - t0) : SCAN_TC;
        const bool more = (c + 1) < nchunk;
        const int nns = more ? ((T - t0 - SCAN_TC) < SCAN_TC ? (T - t0 - SCAN_TC) : SCAN_TC) : 0;
        if (more) {
#pragma unroll
            for (int i = 0; i < 4; ++i) if (ss[i] < nns) stg[i] = *(const u32x4_t*)(src + (size_t)(t0 + SCAN_TC + ss[i]) * (8 * RW6_STRIDE) + sc[i] * 16);
        }
        LAS const float* buf = lds + (c & 1) * (SCAN_TC * 384);
        float* yo = p.ybuf() + (size_t)(row0 + t0) * 512 + h * 64 + vrow;
        if (act)
#pragma unroll 4
        for (int s = 0; s < ns; ++s) {
            LAS const float* bs = buf + s * 384 + kq * 4;
            const f32x4 r = *(LAS const f32x4*)(bs), d = *(LAS const f32x4*)(bs + 64), km = *(LAS const f32x4*)(bs + 128),
                        kk = *(LAS const f32x4*)(bs + 256), ka = *(LAS const f32x4*)(bs + 320);
            const float vv = buf[s * 384 + 192 + vrow];
            const f32x4 t1 = S * kk;
            float sa = dpp_row_sum((t1[0] + t1[1]) + (t1[2] + t1[3]));
            sa = -sa;
            S = S * d + ka * sa + km * vv;
            const f32x4 t2 = S * r;
            const float y = dpp_row_sum((t2[0] + t2[1]) + (t2[2] + t2[3]));
            if (kq == 0) yo[(size_t)s * 512] = y;
        }
        if (more) {
            LAS float* nb = lds + ((c + 1) & 1) * (SCAN_TC * 384);
#pragma unroll
            for (int i = 0; i < 4; ++i) if (ss[i] < nns) put(nb, i);
        }
        __syncthreads();
    }
    if (act) *(f32x4*)(sout + vrow * 64 + kq * 4) = S;
}
constexpr int NSCAN = 128;
__device__ __forceinline__ void ph_rwkv_scan(const P& p, LAS float* lds) {
    if ((int)blockIdx.x < NSCAN) {
        const int item = blockIdx.x >> 2, part = blockIdx.x & 3;
        scan_item<16>(p, lds, (item >> 3) * SEQ, SEQ, item & 7, part, nullptr, p.out + O_WKV_P + (size_t)item * 4096);
    } else {
        const int nb = (int)gridDim.x - NSCAN;
        for (int hi = (int)blockIdx.x - NSCAN; hi < 512; hi += nb) {
            const int item = hi >> 1, half = hi & 1;
            scan_item<32>(p, lds, NP + (item >> 3) * 8, 8, item & 7, half, p.state_wkv + (size_t)item * 4096, p.out + O_WKV_S + (size_t)item * 4096);
        }
    }
}

__device__ __forceinline__ void ph_rwkv_post(const P& p) {
    const int tid = threadIdx.x, lane = tid & 63, wid = tid >> 6;
    for (int it = blockIdx.x * 8 + wid; it < MR * 8; it += gridDim.x * 8) {
        const int row = it >> 3, h = it & 7, c = h * 64 + lane;
        const float y = p.ybuf()[(size_t)row * 512 + c];
        const float mean = wave_sum(y) * (1.0f / 64.0f);
        const float dv = y - mean;
        const float var = wave_sum(dv * dv) * (1.0f / 64.0f);
        float yn = dv * rsqrtf(var + 64e-5f) * p.gn_g[c] + p.gn_b[c];
        yn += p.bonus()[it] * bf2f(((const bf16_t*)(p.rw6() + (size_t)it * RW6_STRIDE + 256))[128 + lane]);
        p.ob()[(size_t)row * 512 + c] = f2bf(yn * bf2f(p.rg()[(size_t)row * 512 + c]));
    }
}

__device__ __forceinline__ void ph_cmp_gemm_f32(const P& p, LAS unsigned char* lds) {
    using pg8::lds_byte;
    const int tid = threadIdx.x, wid = __builtin_amdgcn_readfirstlane(tid >> 6), lane = tid & 63, wr = wid >> 2, wc = wid & 3, fr = lane & 15, fq = lane >> 4;
    constexpr int HTB = 16384;
    const int arow_l = 4 * wid + (lane >> 4), acol = 4 * (lane & 15);
    const int swbase = lds_byte(arow_l, acol);
    LAS unsigned long long* rowoff = (LAS unsigned long long*)(lds + 131072);
    unsigned voffB[2];
#pragma unroll
    for (int i = 0; i < 2; ++i) { int R, C; pg8::stage_rc(tid * 16 + i * 8192, R, C); voffB[i] = (unsigned)(R * 1024 + C) * 2u; }
    const unsigned ldsw = (unsigned)wid * 1024u;
    const int aoff = lds_byte(wr * 64 + fr, fq * 8), boff = lds_byte(wc * 32 + fr, fq * 8);
    for (int unit = blockIdx.x; unit < 512; unit += gridDim.x) {
        const int kvi = unit >> 8, bg = (unit >> 2) & 63, c0 = (unit & 3) * 256, b = bg >> 1, g = bg & 1;
        __syncthreads();
        if (tid < 256) {
            const int chunk = c0 + tid;
            const int page = p.page_table[b * 128 + (chunk >> 3)];
            rowoff[tid] = ((unsigned long long)page * 128 + (chunk & 7) * 16) * 256 + kvi * 128 + g * 64;
        }
        const char* bbase = (const char*)(p.W1T() + (size_t)kvi * 256 * 1024);
        f32x4 acc[2][2][4][2];
#pragma unroll
        for (int a = 0; a < 2; ++a)
#pragma unroll
            for (int bb = 0; bb < 2; ++bb)
#pragma unroll
                for (int m = 0; m < 4; ++m)
#pragma unroll
                    for (int n = 0; n < 2; ++n) acc[a][bb][m][n] = (f32x4){0.f, 0.f, 0.f, 0.f};
        f32x4 ar[8];
        auto stage_b = [&](int st, int t) {
#pragma unroll
            for (int h = 0; h < 2; ++h)
#pragma unroll
                for (int i = 0; i < 2; ++i)
                    __builtin_amdgcn_global_load_lds((const unsigned*)(bbase + (size_t)h * 128 * 2048 + (size_t)t * 128 + voffB[i]),
                                                     (PG8_LAS unsigned*)(lds + st * 65536 + 32768 + h * HTB + ldsw + i * 8192), 16, 0, 0);
        };
        auto load_a = [&](int t) {
#pragma unroll
            for (int q = 0; q < 8; ++q) ar[q] = *(const f32x4*)(p.cache_cmp + rowoff[32 * q + arow_l] + (size_t)t * 256 + acol);
        };
        auto write_a = [&](int st) {
            LAS unsigned char* na = lds + st * 65536;
#pragma unroll
            for (int q = 0; q < 8; ++q) *(LAS u32x2*)(na + swbase + (q >> 2) * HTB + (q & 3) * 4096) = (u32x2){pk2(ar[q][0], ar[q][1]), pk2(ar[q][2], ar[q][3])};
        };
        __syncthreads();
        load_a(0);
        stage_b(0, 0);
        write_a(0);
        __syncthreads();
#pragma unroll 1
        for (int t = 0; t < 16; ++t) {
            const int cur = t & 1;
            if (t + 1 < 16) { load_a(t + 1); stage_b(cur ^ 1, t + 1); }
            LAS const unsigned char* sa = lds + cur * 65536;
            LAS const unsigned char* sb = sa + 32768;
#pragma unroll
            for (int ai = 0; ai < 2; ++ai)
#pragma unroll
                for (int bj = 0; bj < 2; ++bj) {
                    bf16x8 Bt[2][2];
#pragma unroll
                    for (int n = 0; n < 2; ++n)
#pragma unroll
                        for (int k = 0; k < 2; ++k) Bt[n][k] = *(LAS const bf16x8*)(sb + bj * HTB + boff + n * 2048 + k * 1024);
#pragma unroll
                    for (int m = 0; m < 4; ++m) {
                        const bf16x8 a0 = *(LAS const bf16x8*)(sa + ai * HTB + aoff + m * 2048), a1 = *(LAS const bf16x8*)(sa + ai * HTB + aoff + m * 2048 + 1024);
#pragma unroll
                        for (int n = 0; n < 2; ++n) {
                            acc[ai][bj][m][n] = __builtin_amdgcn_mfma_f32_16x16x32_bf16(Bt[n][0], a0, acc[ai][bj][m][n], 0, 0, 0);
                            acc[ai][bj][m][n] = __builtin_amdgcn_mfma_f32_16x16x32_bf16(Bt[n][1], a1, acc[ai][bj][m][n], 0, 0, 0);
                        }
                    }
                    __builtin_amdgcn_sched_barrier(0);
                }
            if (t + 1 < 16) write_a(cur ^ 1);
            __syncthreads();
        }
        EpiPlainBf e; e.C = p.LHs() + ((size_t)kvi * 65536 + (size_t)bg * 1024 + c0) * 256; e.ldc = 256; e.pad_ = 0;
        pg8::Unit u; u.pm = 0; u.pn = 0;
        e(acc, u, wr, wc, fr, fq);
    }
}
#if 0
#define KEEP_OLD_PATH 1
#endif
#ifndef SMODE
#define SMODE 3
#endif
#ifndef ATTN_MODE
#define ATTN_MODE 3
#endif

struct KSrcBf { const bf16_t* base; __device__ __forceinline__ bf16x8 operator()(int tok0, int ks, int lane) const { return *(const bf16x8*)(base + (size_t)(tok0 + (lane & 31)) * 64 + 16 * ks + 8 * (lane >> 5)); } };
struct VSrcBfT { const bf16_t* base; int ld; __device__ __forceinline__ bf16x8 operator()(int tok0, int dt, int s2, int lane) const {
        const bf16_t* ptr = base + (size_t)(32 * dt + (lane & 31)) * ld + tok0 + 16 * s2 + 4 * (lane >> 5);
        union { uint4 u; bf16x8 v; } x; const uint2 a = *(const uint2*)ptr, b = *(const uint2*)(ptr + 8); x.u.x = a.x; x.u.y = a.y; x.u.z = b.x; x.u.w = b.y; return x.v; } };

template <class KS>
__device__ __forceinline__ f32x16 qk_tile(const bf16x8 (&qf)[4], const KS& ks, int tok0, int lane) {
    f32x16 s = zero16();
#pragma unroll
    for (int k = 0; k < 4; ++k) s = mfma32(ks(tok0, k, lane), qf[k], s);
    return s;
}
__device__ __forceinline__ float exp2_(float x) { return __builtin_amdgcn_exp2f(x); }
template <class OKF>
__device__ __forceinline__ void sm_stats(const f32x16& s, int hb, OKF ok, float& m, float& l) {
    float sv[16]; float tmax = -1e30f; unsigned okm = 0;
#pragma unroll
    for (int i = 0; i < 16; ++i) { const int kl = (i & 3) + 8 * (i >> 2) + 4 * hb; const bool k = ok(kl); okm |= (k ? 1u : 0u) << i; sv[i] = k ? s[i] : -1e30f; tmax = fmaxf(tmax, sv[i]); }
    tmax = fmaxf(tmax, __shfl_xor(tmax, 32));
    const float mn = fmaxf(m, tmax), alpha = exp2_(m - mn); m = mn;
    float ps = 0.f;
#pragma unroll
    for (int i = 0; i < 16; ++i) ps += ((okm >> i) & 1u) ? exp2_(sv[i] - mn) : 0.f;
    l = l * alpha + ps;
}
template <class OKF, class VF>
__device__ __forceinline__ void sm_pv(const f32x16& s, int hb, OKF ok, VF vf, float& m, float& l, f32x16 (&o)[2]) {
    float sv[16]; float tmax = -1e30f; unsigned okm = 0;
#pragma unroll
    for (int i = 0; i < 16; ++i) { const int kl = (i & 3) + 8 * (i >> 2) + 4 * hb; const bool k = ok(kl); okm |= (k ? 1u : 0u) << i; sv[i] = k ? s[i] : -1e30f; tmax = fmaxf(tmax, sv[i]); }
    tmax = fmaxf(tmax, __shfl_xor(tmax, 32));
    const float mn = fmaxf(m, tmax), alpha = exp2_(m - mn); m = mn;
    float pr[16]; float ps = 0.f;
#pragma unroll
    for (int i = 0; i < 16; ++i) { pr[i] = ((okm >> i) & 1u) ? exp2_(sv[i] - mn) : 0.f; ps += pr[i]; }
    l = l * alpha + ps;
    o[0] *= alpha; o[1] *= alpha;
#pragma unroll
    for (int s2 = 0; s2 < 2; ++s2) {
        const bf16x8 pb = pack8(pr[8 * s2 + 0], pr[8 * s2 + 1], pr[8 * s2 + 2], pr[8 * s2 + 3], pr[8 * s2 + 4], pr[8 * s2 + 5], pr[8 * s2 + 6], pr[8 * s2 + 7]);
#pragma unroll
        for (int dt = 0; dt < 2; ++dt) o[dt] = mfma32(vf(dt, s2), pb, o[dt]);
    }
}
template <class VF>
__device__ __forceinline__ void sm_pv_nomask(const f32x16& s, bool csel, VF vf, float& m, float& l, f32x16 (&o)[2]) {
    float tmax = fmaxf(fmaxf(s[0], s[1]), s[2]);
#pragma unroll
    for (int i = 3; i < 16; ++i) tmax = fmaxf(tmax, s[i]);
    tmax = csel ? tmax : -1e30f;
    tmax = fmaxf(tmax, __shfl_xor(tmax, 32));
    const float mn = fmaxf(m, tmax), alpha = exp2_(m - mn); m = mn;
    float pr[16]; float ps = 0.f;
#pragma unroll
    for (int i = 0; i < 16; ++i) { pr[i] = csel ? exp2_(s[i] - mn) : 0.f; ps += pr[i]; }
    l = l * alpha + ps;
    o[0] *= alpha; o[1] *= alpha;
#pragma unroll
    for (int s2 = 0; s2 < 2; ++s2) {
        const bf16x8 pb = pack8(pr[8 * s2 + 0], pr[8 * s2 + 1], pr[8 * s2 + 2], pr[8 * s2 + 3], pr[8 * s2 + 4], pr[8 * s2 + 5], pr[8 * s2 + 6], pr[8 * s2 + 7]);
#pragma unroll
        for (int dt = 0; dt < 2; ++dt) o[dt] = mfma32(vf(dt, s2), pb, o[dt]);
    }
}
template <class OKF, class VF>
__device__ __forceinline__ void cmp_pass2(const f32x16& s, int hb, OKF ok, VF vf, float m, float inv, f32x16 (&o)[2], LAS float* prow, bool writer) {
    float pr[16];
#pragma unroll
    for (int i = 0; i < 16; ++i) {
        const int kl = (i & 3) + 8 * (i >> 2) + 4 * hb;
        pr[i] = ok(kl) ? exp2_(s[i] - m) * inv : 0.f;
        float q = pr[i] + __shfl_xor(pr[i], 1); q += __shfl_xor(q, 2);
        if (writer) prow[kl] = q;
    }
#pragma unroll
    for (int s2 = 0; s2 < 2; ++s2) {
        const bf16x8 pb = pack8(pr[8 * s2 + 0], pr[8 * s2 + 1], pr[8 * s2 + 2], pr[8 * s2 + 3], pr[8 * s2 + 4], pr[8 * s2 + 5], pr[8 * s2 + 6], pr[8 * s2 + 7]);
#pragma unroll
        for (int dt = 0; dt < 2; ++dt) o[dt] = mfma32(vf(dt, s2), pb, o[dt]);
    }
}

__device__ __forceinline__ void attn_store(const P& p, const f32x16 (&of)[2], int qrow, int head, int hb, bool doit, bf16_t* oadst = nullptr) {
    if (!oadst) oadst = p.oa();
    if (!doit) return;
#pragma unroll
    for (int dt = 0; dt < 2; ++dt)
#pragma unroll
        for (int i4 = 0; i4 < 4; ++i4) {
            const int d = 32 * dt + 8 * i4 + 4 * hb;
            const size_t off = (size_t)qrow * 512 + head * 64 + d;
            const uint2 gw = *(const uint2*)(p.ag() + off);
            f32x4 v;
            v[0] = of[dt][4 * i4 + 0] * __uint_as_float(gw.x << 16); v[1] = of[dt][4 * i4 + 1] * __uint_as_float(gw.x & 0xffff0000u);
            v[2] = of[dt][4 * i4 + 2] * __uint_as_float(gw.y << 16); v[3] = of[dt][4 * i4 + 3] * __uint_as_float(gw.y & 0xffff0000u);
            st_bf4(oadst + off, v);
        }
}


__device__ __forceinline__ void of_put(LAS float* st, int lane, const f32x16 (&o)[2], float sc) {
#pragma unroll
    for (int dt = 0; dt < 2; ++dt)
#pragma unroll
        for (int i = 0; i < 16; ++i) st[(dt * 16 + i) * 64 + lane] = o[dt][i] * sc;
}
__device__ __forceinline__ void of_add(LAS float* st, int lane, const f32x16 (&o)[2], float sc) {
#pragma unroll
    for (int dt = 0; dt < 2; ++dt)
#pragma unroll
        for (int i = 0; i < 16; ++i) st[(dt * 16 + i) * 64 + lane] += o[dt][i] * sc;
}
__device__ __forceinline__ void of_get_add(LAS float* st, int lane, const f32x16 (&o)[2], float sc, f32x16 (&of)[2]) {
#pragma unroll
    for (int dt = 0; dt < 2; ++dt)
#pragma unroll
        for (int i = 0; i < 16; ++i) of[dt][i] = st[(dt * 16 + i) * 64 + lane] + o[dt][i] * sc;
}


template <class NEXT, class OKF>
__device__ __forceinline__ void tile_loop(const bf16x8 (&qf)[4], const KSrcBf& ksrc, const VSrcBfT& vsrc, int tt, NEXT next, OKF ok, int lane, float& m, float& l, f32x16 (&o)[2]) {
    if (tt < 0) return;
    const int hb = lane >> 5;
    bf16x8 kf[4];
#pragma unroll
    for (int ks = 0; ks < 4; ++ks) kf[ks] = ksrc(32 * tt, ks, lane);
#pragma unroll 1
    for (;;) {
        const int tok0 = 32 * tt;
        const int nt = next(tt);
        bf16x8 vf[2][2];
#pragma unroll
        for (int dt = 0; dt < 2; ++dt)
#pragma unroll
            for (int s2 = 0; s2 < 2; ++s2) vf[dt][s2] = vsrc(tok0, dt, s2, lane);
        bf16x8 kn[4];
        const int ntc = nt >= 0 ? nt : tt;
#pragma unroll
        for (int ks = 0; ks < 4; ++ks) kn[ks] = ksrc(32 * ntc, ks, lane);
        f32x16 s = zero16();
#pragma unroll
        for (int ks = 0; ks < 4; ++ks) s = mfma32(kf[ks], qf[ks], s);
        sm_pv(s, hb, [&](int kl) { return ok(tok0, kl); }, [&](int dt, int s2) { return vf[dt][s2]; }, m, l, o);
        if (nt < 0) break;
#pragma unroll
        for (int ks = 0; ks < 4; ++ks) kf[ks] = kn[ks];
        tt = nt;
    }
}

__device__ __forceinline__ void attn_prompt_item(const P& p, int item, LAS unsigned char* wl, int lane, bf16_t* oadst = nullptr) {
    const int bg = item & 7, tg = item >> 3, b = bg >> 1, g = bg & 1;
    const int col = lane & 31, hb = lane >> 5, tl = col >> 2, hh = col & 3;
    const int t0 = tg * 8, qpos = t0 + tl, qrow = b * SEQ + qpos, head = g * 4 + hh;
    bf16x8 qf[4];
#pragma unroll
    for (int ks = 0; ks < 4; ++ks) qf[ks] = *(const bf16x8*)(p.qb() + (size_t)qrow * 512 + head * 64 + 16 * ks + 8 * hb);
    LAS float* psum = (LAS float*)wl;
    LAS unsigned long long* msk = (LAS unsigned long long*)(wl + 8192);
    const float g0 = p.gates()[(size_t)qrow * 32 + head * 3 + 0], g1 = p.gates()[(size_t)qrow * 32 + head * 3 + 1], g2 = p.gates()[(size_t)qrow * 32 + head * 3 + 2];
    f32x16 oc[2]; oc[0] = zero16(); oc[1] = zero16();
    {
        const int cm = t0 + 7 - 31;
        const int ntile = cm >= 0 ? ((cm >> 4) >> 5) + 1 : 0;
        const KSrcBf ksrc{p.kc_p() + (size_t)bg * 256 * 64};
        const VSrcBfT vsrc{p.vcT_p() + (size_t)bg * 64 * 256, 256};
        float m = -1e30f, l = 0.f;
#pragma unroll 1
        for (int kt = 0; kt < ntile; ++kt) {
            const f32x16 s = qk_tile(qf, ksrc, 32 * kt, lane);
            sm_stats(s, hb, [&](int kl) { return 16 * (32 * kt + kl) + 31 <= qpos; }, m, l);
        }
        l += __shfl_xor(l, 32);
        const float inv = l > 0.f ? 1.0f / l : 0.f;
#pragma unroll
        for (int i = 0; i < 32; ++i) psum[i * 64 + lane] = 0.f;
        WAVE_SYNC();
#pragma unroll 1
        for (int kt = 0; kt < ntile; ++kt) {
            const f32x16 s = qk_tile(qf, ksrc, 32 * kt, lane);
            cmp_pass2(s, hb, [&](int kl) { return 16 * (32 * kt + kl) + 31 <= qpos; }, [&](int dt, int s2) { return vsrc(32 * kt, dt, s2, lane); }, m, inv, oc,
                      psum + tl * 256 + 32 * kt, hh == 0);
        }
    }
    WAVE_SYNC();
    for (int t2 = 0; t2 < 8; ++t2) {
        const int t = t0 + t2, cur = t >> 6, n = lane;
        float imp = 0.f;
#pragma unroll
        for (int c = -1; c < 4; ++c) { const int cc = 4 * n + c; if (cc >= 0) imp += psum[t2 * 256 + cc]; }
        if (n == 0 || n == cur || n == cur - 1) imp = 1e4f;
        if (n * 64 > t) imp = -1.0f;
        int rank = 0;
#pragma unroll
        for (int j = 0; j < 64; ++j) {
            const float vj = __uint_as_float(__builtin_amdgcn_readlane(__float_as_uint(imp), j));
            rank += (vj > imp || (vj == imp && j < n)) ? 1 : 0;
        }
        const unsigned long long mk = __ballot(rank < 16);
        if (lane == 0) msk[t2] = mk;
    }
    WAVE_SYNC();
    const unsigned long long mymask = msk[tl];
    unsigned long long um = 0;
#pragma unroll
    for (int i = 0; i < 8; ++i) um |= msk[i];
    const int cur0 = t0 >> 6;
    WAVE_SYNC();
    LAS float* ost = (LAS float*)wl;
    of_put(ost, lane, oc, g0);
    {
        const KSrcBf ksrc{p.kb() + (size_t)((1 * NB + b) * 2 + g) * SEQ * 64};
        const VSrcBfT vsrc{p.vT() + (size_t)((0 * NB + b) * 2 + g) * 64 * SEQ, SEQ};
        float m = -1e30f, l = 0.f; f32x16 o[2]; o[0] = zero16(); o[1] = zero16();
        {
            const unsigned um_lo = __builtin_amdgcn_readfirstlane((unsigned)um), um_hi = __builtin_amdgcn_readfirstlane((unsigned)(um >> 32));
            unsigned long long umu = ((unsigned long long)um_hi << 32) | um_lo;
            if (cur0 < 63) umu &= (2ull << cur0) - 1ull;
            const int first = umu ? 2 * (int)__builtin_ctzll(umu) : -1;
            tile_loop(qf, ksrc, vsrc, first,
                      [&](int tt) { if (!(tt & 1)) return tt + 1; const int n = tt >> 1; if (n >= 63) return -1; const unsigned long long rem = umu >> (n + 1); return rem ? 2 * (n + 1 + (int)__builtin_ctzll(rem)) : -1; },
                      [&](int tok0, int kl) { return (bool)((mymask >> (tok0 >> 6)) & 1ull) && (tok0 + kl <= qpos); }, lane, m, l, o);
        }
        l += __shfl_xor(l, 32);
        const float sc = l > 0.f ? g1 / l : 0.f;
        of_add(ost, lane, o, sc);
    }
    {
        const KSrcBf ksrc{p.kb() + (size_t)((2 * NB + b) * 2 + g) * SEQ * 64};
        const VSrcBfT vsrc{p.vT() + (size_t)((1 * NB + b) * 2 + g) * 64 * SEQ, SEQ};
        float m = -1e30f, l = 0.f; f32x16 o[2]; o[0] = zero16(); o[1] = zero16();
        const int lo = t0 - 511;
        const int nlo = lo > 0 ? (lo >> 6) : 0;
        {
            const int last = 2 * cur0 + 1;
            tile_loop(qf, ksrc, vsrc, 2 * nlo, [&](int tt) { return tt < last ? tt + 1 : -1; },
                      [&](int tok0, int kl) { const int key = tok0 + kl; return key <= qpos && key + 511 >= qpos; }, lane, m, l, o);
        }
        l += __shfl_xor(l, 32);
        const float sc = l > 0.f ? g2 / l : 0.f;
        f32x16 of[2];
        of_get_add(ost, lane, o, sc, of);
        attn_store(p, of, qrow, head, hb, true, oadst);
    }
    WAVE_SYNC();
}

template <class RP, class OKF>
__device__ __forceinline__ void f32_tile(const bf16x8 (&qf)[4], RP rp, OKF ok, LAS bf16_t* vt, int lane, float& m, float& l, f32x16 (&o)[2]) {
    const int col = lane & 31, hb = lane >> 5;
    const float* kr = rp(col);
    f32x16 s = zero16();
#pragma unroll
    for (int ks = 0; ks < 4; ++ks) {
        const float4 a = *(const float4*)(kr + 16 * ks + 8 * hb), c = *(const float4*)(kr + 16 * ks + 8 * hb + 4);
        s = mfma32(pack8(a.x, a.y, a.z, a.w, c.x, c.y, c.z, c.w), qf[ks], s);
    }
    const float* vr = kr + 128 + 32 * hb;
#pragma unroll
    for (int j4 = 0; j4 < 8; ++j4) {
        const float4 a = *(const float4*)(vr + 4 * j4);
        vt[(32 * hb + 4 * j4 + 0) * 40 + col] = f2bf(a.x); vt[(32 * hb + 4 * j4 + 1) * 40 + col] = f2bf(a.y);
        vt[(32 * hb + 4 * j4 + 2) * 40 + col] = f2bf(a.z); vt[(32 * hb + 4 * j4 + 3) * 40 + col] = f2bf(a.w);
    }
    WAVE_SYNC();
    sm_pv(s, hb, ok, [&](int dt, int s2) {
        LAS const bf16_t* ptr = vt + (32 * dt + col) * 40 + 16 * s2 + 4 * hb;
        union { uint4 u; bf16x8 v; } x; const u32x2 a = *(LAS const u32x2*)ptr, c = *(LAS const u32x2*)(ptr + 8); x.u.x = a[0]; x.u.y = a[1]; x.u.z = c[0]; x.u.w = c[1]; return x.v; }, m, l, o);
    WAVE_SYNC();
}

__device__ __forceinline__ void attn_sample_item(const P& p, int item, LAS unsigned char* wl, int lane) {
    const int t = item & 7, g = (item >> 3) & 1, b = item >> 4, bg = b * 2 + g;
    const int col = lane & 31, hb = lane >> 5, hh = col & 3;
    const int qpos = PAST + t, qrow = NP + b * 8 + t, head = g * 4 + hh;
    bf16x8 qf[4];
#pragma unroll
    for (int ks = 0; ks < 4; ++ks) qf[ks] = *(const bf16x8*)(p.qb() + (size_t)qrow * 512 + head * 64 + 16 * ks + 8 * hb);
    LAS float* psum = (LAS float*)wl;
    LAS int* list = (LAS int*)(wl + 8256);
    LAS float* impl = (LAS float*)(wl + 8448);
    LAS bf16_t* vt = (LAS bf16_t*)(wl + 9728);
    const float g0 = p.gates()[(size_t)qrow * 32 + head * 3 + 0], g1 = p.gates()[(size_t)qrow * 32 + head * 3 + 1], g2 = p.gates()[(size_t)qrow * 32 + head * 3 + 2];
    f32x16 oc[2]; oc[0] = zero16(); oc[1] = zero16();
    {
        const KSrcBf ksrc{p.kc_s() + (size_t)bg * 1024 * 64};
        const VSrcBfT vsrc{p.vcT_s() + (size_t)bg * 64 * 1024, 1024};
        float m = -1e30f, l = 0.f;
#pragma unroll 1
        for (int kt = 0; kt < 32; ++kt) {
            const f32x16 s = qk_tile(qf, ksrc, 32 * kt, lane);
            sm_stats(s, hb, [&](int kl) { return 32 * kt + kl <= 1022; }, m, l);
        }
        l += __shfl_xor(l, 32);
        const float inv = l > 0.f ? 1.0f / l : 0.f;
#pragma unroll 1
        for (int kt = 0; kt < 32; ++kt) {
            const f32x16 s = qk_tile(qf, ksrc, 32 * kt, lane);
            cmp_pass2(s, hb, [&](int kl) { return 32 * kt + kl <= 1022; }, [&](int dt, int s2) { return vsrc(32 * kt, dt, s2, lane); }, m, inv, oc, psum + 32 * kt, col == 0);
        }
    }
    WAVE_SYNC();
#pragma unroll
    for (int j = 0; j < 5; ++j) {
        const int n = lane + 64 * j;
        if (n <= 256) {
            float imp = 0.f;
            for (int c = -1; c < 4; ++c) { const int cc = 4 * n + c; if (cc >= 0 && cc <= 1022) imp += psum[cc]; }
            impl[n] = imp;
        }
    }
    WAVE_SYNC();
    {
        int base = 0;
#pragma unroll
        for (int j = 0; j < 4; ++j) {
            const int n = lane + 64 * j;
            const bool cand = n >= 1 && n <= 254;
            const float v = impl[n];
            int rank = 0;
            for (int q = 1; q <= 254; ++q) { const float vq = impl[q]; rank += (vq > v || (vq == v && q < n)) ? 1 : 0; }
            const bool sel = cand && rank < 13;
            const unsigned long long mk = __ballot(sel);
            if (sel) list[base + __popcll(mk & ((1ull << lane) - 1ull))] = n;
            base += __popcll(mk);
        }
        if (lane == 0) { list[13] = 0; list[14] = 255; list[15] = 256; }
    }
    WAVE_SYNC();
#if SMODE & 1
    LAS float* ost = (LAS float*)wl;
    of_put(ost, lane, oc, g0);
    {
        float m = -1e30f, l = 0.f; f32x16 o[2]; o[0] = zero16(); o[1] = zero16();
#pragma unroll 1
        for (int li = 0; li < 16; ++li) {
#if SMODE & 4
            const int n = li < 13 ? 17 * li + 5 : (li == 13 ? 0 : 242 + li);
#else
            const int n = __builtin_amdgcn_readfirstlane(list[li]);
#endif
            if (n < 256) {
                const int page = p.page_table[b * 128 + (n >> 1)];
                const float* base = p.cache_sel + ((size_t)page * 128 + (n & 1) * 64) * 256 + g * 64;
#pragma unroll 1
                for (int k2 = 0; k2 < 2; ++k2)
                    f32_tile(qf, [&](int kl) { return base + (size_t)(32 * k2 + kl) * 256; }, [&](int kl) { return true; }, vt, lane, m, l, o);
            } else {
                const float* base = p.out + O_SEL_S + (size_t)(b * 8) * 256 + g * 64;
                f32_tile(qf, [&](int kl) { return base + (size_t)(kl < 8 ? kl : 7) * 256; }, [&](int kl) { return kl <= t; }, vt, lane, m, l, o);
            }
        }
        l += __shfl_xor(l, 32);
        const float sc = l > 0.f ? g1 / l : 0.f;
        of_add(ost, lane, o, sc);
    }
#endif
#if SMODE & 2
    {
        float m = -1e30f, l = 0.f; f32x16 o[2]; o[0] = zero16(); o[1] = zero16();
        const float* cw = p.cache_win + (size_t)b * 512 * 256 + g * 64;
        const float* nw = p.out + O_WIN_S + ((size_t)b * 512 + 504) * 256 + g * 64;
#pragma unroll 1
        for (int kt = 0; kt < 17; ++kt) {
            f32_tile(qf, [&](int kl) { const int j = 32 * kt + kl; return j < 512 ? cw + (size_t)j * 256 : nw + (size_t)(j - 512 < 8 ? j - 512 : 7) * 256; },
                     [&](int kl) { const int j = 32 * kt + kl; return j >= t + 1 && j <= 512 + t; }, vt, lane, m, l, o);
        }
        l += __shfl_xor(l, 32);
        const float sc = l > 0.f ? g2 / l : 0.f;
        f32x16 of[2];
        of_get_add(ost, lane, o, sc, of);
        attn_store(p, of, qrow, head, hb, col < 4);
    }
    WAVE_SYNC();
#endif
}

constexpr int WL_STRIDE = 15360, KV_OFF = 8 * WL_STRIDE, KV_BUF = 17920, XB_OFF = KV_OFF + 2 * KV_BUF;

struct LoadBf16 {
    const bf16_t* kbase; const bf16_t* vbase; int ld; bool with_v; u32x4_t kr, vr;
    __device__ __forceinline__ void load(int n) {
        const int tid = threadIdx.x, srow = tid >> 3, sch = tid & 7;
        kr = *(const u32x4_t*)(kbase + (size_t)(64 * n + srow) * 64 + sch * 8);
        if (with_v) vr = *(const u32x4_t*)(vbase + (size_t)srow * ld + 64 * n + sch * 8);
    }
    __device__ __forceinline__ void store(LAS unsigned char* buf) const {
        const int tid = threadIdx.x, srow = tid >> 3, sch = tid & 7;
        *(LAS u32x4_t*)(buf + srow * 144 + sch * 16) = kr;
        if (with_v) { LAS u32x2* vp = (LAS u32x2*)(buf + 9216 + srow * 136 + sch * 16); vp[0] = (u32x2){vr[0], vr[1]}; vp[1] = (u32x2){vr[2], vr[3]}; }
    }
};
struct LoadWinF32 {
    const float* cw; const float* nw; f32x4 k0, k1, v0, v1;
    __device__ __forceinline__ void load(int n) {
        const int tid = threadIdx.x, srow = tid >> 3, sch = tid & 7;
        const int j = 64 * n + srow;
        const float* r = j < 512 ? cw + (size_t)j * 256 : nw + (size_t)(j - 512 < 8 ? j - 512 : 7) * 256;
        k0 = *(const f32x4*)(r + sch * 8); k1 = *(const f32x4*)(r + sch * 8 + 4);
        v0 = *(const f32x4*)(r + 128 + sch * 8); v1 = *(const f32x4*)(r + 128 + sch * 8 + 4);
    }
    __device__ __forceinline__ void store(LAS unsigned char* buf) const {
        const int tid = threadIdx.x, srow = tid >> 3, sch = tid & 7;
        u32x4_t kw; kw[0] = pk2(k0[0], k0[1]); kw[1] = pk2(k0[2], k0[3]); kw[2] = pk2(k1[0], k1[1]); kw[3] = pk2(k1[2], k1[3]);
        *(LAS u32x4_t*)(buf + srow * 144 + sch * 16) = kw;
        LAS bf16_t* vb = (LAS bf16_t*)(buf + 9216) + (sch * 8) * 68 + srow;
#pragma unroll
        for (int e = 0; e < 4; ++e) { vb[e * 68] = f2bf(v0[e]); vb[(4 + e) * 68] = f2bf(v1[e]); }
    }
};

template <class LOADER, class NEXT, class ACTIVE, class BODY>
__device__ __forceinline__ void block_loop_g(LOADER ld, LAS unsigned char* kv, int first, NEXT next, ACTIVE active, BODY body) {
    if (first < 0) return;
    int n = first, cur = 0;
    ld.load(n);
    ld.store(kv);
    __syncthreads();
#pragma unroll 1
    for (;;) {
        const int nn = next(n);
        if (nn >= 0) ld.load(nn);
        if (active(n)) body(n, (LAS const bf16_t*)(kv + cur * KV_BUF), (LAS const bf16_t*)(kv + cur * KV_BUF + 9216));
        if (nn >= 0) ld.store(kv + (cur ^ 1) * KV_BUF);
        __syncthreads();
        if (nn < 0) break;
        cur ^= 1; n = nn;
    }
}
template <bool WITH_V, class NEXT, class ACTIVE, class BODY>
__device__ __forceinline__ void block_loop(const bf16_t* kbase, const bf16_t* vbase, int ld, LAS unsigned char* kv, int first, NEXT next, ACTIVE active, BODY body) {
    LoadBf16 L; L.kbase = kbase; L.vbase = vbase; L.ld = ld; L.with_v = WITH_V;
    block_loop_g(L, kv, first, next, active, body);
}
__device__ __forceinline__ bf16x8 lds_kfrag(LAS const bf16_t* kb, int kt, int ks, int col, int hb) { return *(LAS const bf16x8*)(kb + (32 * kt + col) * 72 + 16 * ks + 8 * hb); }
__device__ __forceinline__ bf16x8 lds_vfrag(LAS const bf16_t* vb, int kt, int dt, int s2, int col, int hb) {
    LAS const bf16_t* ptr = vb + (32 * dt + col) * 68 + 32 * kt + 16 * s2 + 4 * hb;
    union { u32x4_t u; bf16x8 v; } x; const u32x2 a = *(LAS const u32x2*)ptr, c = *(LAS const u32x2*)(ptr + 8); x.u[0] = a[0]; x.u[1] = a[1]; x.u[2] = c[0]; x.u[3] = c[1]; return x.v;
}
__device__ __forceinline__ f32x16 lds_qk(const bf16x8 (&qf)[4], LAS const bf16_t* kb, int kt, int col, int hb) {
    f32x16 s = zero16();
#pragma unroll
    for (int ks = 0; ks < 4; ++ks) s = mfma32(lds_kfrag(kb, kt, ks, col, hb), qf[ks], s);
    return s;
}

__device__ __forceinline__ void attn_prompt_block(const P& p, int bg, int j, LAS unsigned char* lds) {
    int tid_l = threadIdx.x; asm volatile("" : "+v"(tid_l));
    const int tid = tid_l, lane = tid & 63, wid = __builtin_amdgcn_readfirstlane(tid >> 6);
    const int b = bg >> 1, g = bg & 1;
    const int col = lane & 31, hb = lane >> 5, tl = col >> 2, hh = col & 3;
    const int t0 = 64 * j + 8 * wid, qpos = t0 + tl, qrow = b * SEQ + qpos, head = g * 4 + hh;
    LAS unsigned char* wl = lds + wid * WL_STRIDE;
    LAS unsigned char* kv = lds + KV_OFF;
    LAS float* psum = (LAS float*)wl;
    LAS unsigned long long* msk = (LAS unsigned long long*)(wl + 8192);
    bf16x8 qf[4];
#pragma unroll
    for (int ks = 0; ks < 4; ++ks) qf[ks] = *(const bf16x8*)(p.qb() + (size_t)qrow * 512 + head * 64 + 16 * ks + 8 * hb);
    const float g0 = p.gates()[(size_t)qrow * 32 + head * 3 + 0], g1 = p.gates()[(size_t)qrow * 32 + head * 3 + 1], g2 = p.gates()[(size_t)qrow * 32 + head * 3 + 2];
    f32x16 oc[2]; oc[0] = zero16(); oc[1] = zero16();
    {
        const int cmb = 64 * j + 63 - 31;
        const int nbc = ((cmb >> 4) >> 6) + 1;
        const int cmw = t0 + 7 - 31;
        const int cmaxw = cmw >= 0 ? (cmw >> 4) : -1;
        const bf16_t* kc = p.kc_p() + (size_t)bg * 256 * 64;
        const bf16_t* vc = p.vcT_p() + (size_t)bg * 64 * 256;
        float m = -1e30f, l = 0.f;
        block_loop<false>(kc, vc, 256, kv, 0, [&](int n) { return n + 1 < nbc ? n + 1 : -1; }, [&](int n) { return cmaxw >= 64 * n; },
            [&](int n, LAS const bf16_t* kb, LAS const bf16_t* vb) {
#pragma unroll 1
                for (int kt = 0; kt < 2; ++kt) {
#if defined(BLK_GLOBAL_FRAGS)
                    const f32x16 s = qk_tile(qf, KSrcBf{kc}, 64 * n + 32 * kt, lane);
#else
                    const f32x16 s = lds_qk(qf, kb, kt, col, hb);
#endif
                    sm_stats(s, hb, [&](int kl) { return 16 * (64 * n + 32 * kt + kl) + 31 <= qpos; }, m, l);
                }
            });
        l += __shfl_xor(l, 32);
        const float inv = l > 0.f ? 1.0f / l : 0.f;
#pragma unroll
        for (int i = 0; i < 32; ++i) psum[i * 64 + lane] = 0.f;
        WAVE_SYNC();
        block_loop<true>(kc, vc, 256, kv, 0, [&](int n) { return n + 1 < nbc ? n + 1 : -1; }, [&](int n) { return cmaxw >= 64 * n; },
            [&](int n, LAS const bf16_t* kb, LAS const bf16_t* vb) {
#pragma unroll 1
                for (int kt = 0; kt < 2; ++kt) {
#if defined(BLK_GLOBAL_FRAGS)
                    const f32x16 s = qk_tile(qf, KSrcBf{kc}, 64 * n + 32 * kt, lane);
                    const VSrcBfT vsg{vc, 256};
                    cmp_pass2(s, hb, [&](int kl) { return 16 * (64 * n + 32 * kt + kl) + 31 <= qpos; }, [&](int dt, int s2) { return vsg(64 * n + 32 * kt, dt, s2, lane); }, m, inv, oc,
#else
                    const f32x16 s = lds_qk(qf, kb, kt, col, hb);
                    cmp_pass2(s, hb, [&](int kl) { return 16 * (64 * n + 32 * kt + kl) + 31 <= qpos; }, [&](int dt, int s2) { return lds_vfrag(vb, kt, dt, s2, col, hb); }, m, inv, oc,
#endif
                              psum + tl * 256 + 64 * n + 32 * kt, hh == 0);
                }
            });
    }
    WAVE_SYNC();
    unsigned long long umw = 0;
    for (int t2 = 0; t2 < 8; ++t2) {
        const int t = t0 + t2, cur = t >> 6, n = lane;
        float imp = 0.f;
#pragma unroll
        for (int c = -1; c < 4; ++c) { const int cc = 4 * n + c; if (cc >= 0) imp += psum[t2 * 256 + cc]; }
        if (n == 0 || n == cur || n == cur - 1) imp = 1e4f;
        if (n * 64 > t) imp = -1.0f;
        int rank = 0;
#pragma unroll
        for (int jj = 0; jj < 64; ++jj) {
            const float vj = __uint_as_float(__builtin_amdgcn_readlane(__float_as_uint(imp), jj));
            rank += (vj > imp || (vj == imp && jj < n)) ? 1 : 0;
        }
        const unsigned long long mk = __ballot(rank < 16);
        if (lane == 0) msk[t2] = mk;
        umw |= mk;
    }
    if (lane == 0) msk[8] = umw;
    __syncthreads();
    const unsigned long long mymask = msk[tl];
    unsigned long long umb = 0;
#pragma unroll
    for (int w2 = 0; w2 < 8; ++w2) umb |= *(LAS const unsigned long long*)(lds + w2 * WL_STRIDE + 8192 + 64);
    {
        const unsigned lo = __builtin_amdgcn_readfirstlane((unsigned)umb), hi = __builtin_amdgcn_readfirstlane((unsigned)(umb >> 32));
        umb = ((unsigned long long)hi << 32) | lo;
        if (j < 63) umb &= (2ull << j) - 1ull;
    }
    LAS float* ost = (LAS float*)wl;
#if defined(DBG_UMB)
    { const unsigned long long lim = j < 63 ? ((2ull << j) - 1ull) : ~0ull; if ((umw & lim & ~umb) != 0ull) oc[0][0] = __builtin_nanf(""); }
#endif
    of_put(ost, lane, oc, g0);
#if defined(DBG_SCHED)
    __builtin_amdgcn_sched_barrier(0);
#endif
#if defined(BLK_OLD_SEL)
    {
        const KSrcBf ksrc{p.kb() + (size_t)((1 * NB + b) * 2 + g) * SEQ * 64};
        const VSrcBfT vsrc{p.vT() + (size_t)((0 * NB + b) * 2 + g) * 64 * SEQ, SEQ};
        float m = -1e30f, l = 0.f; f32x16 o[2]; o[0] = zero16(); o[1] = zero16();
        unsigned long long umu = umw; const int cur0 = j;
        { const unsigned lo = __builtin_amdgcn_readfirstlane((unsigned)umu), hi = __builtin_amdgcn_readfirstlane((unsigned)(umu >> 32)); umu = ((unsigned long long)hi << 32) | lo; }
        if (cur0 < 63) umu &= (2ull << cur0) - 1ull;
        const int first = umu ? 2 * (int)__builtin_ctzll(umu) : -1;
        tile_loop(qf, ksrc, vsrc, first,
                  [&](int tt) { if (!(tt & 1)) return tt + 1; const int n = tt >> 1; if (n >= 63) return -1; const unsigned long long rem = umu >> (n + 1); return rem ? 2 * (n + 1 + (int)__builtin_ctzll(rem)) : -1; },
                  [&](int tok0, int kl) { return (bool)((mymask >> (tok0 >> 6)) & 1ull) && (tok0 + kl <= qpos); }, lane, m, l, o);
        l += __shfl_xor(l, 32);
        const float sc = l > 0.f ? g1 / l : 0.f;
        of_add(ost, lane, o, sc);
    }
#else
    {
        const bf16_t* kbs = p.kb() + (size_t)((1 * NB + b) * 2 + g) * SEQ * 64;
        const bf16_t* vbs = p.vT() + (size_t)((0 * NB + b) * 2 + g) * 64 * SEQ;
        float m = -1e30f, l = 0.f; f32x16 o[2]; o[0] = zero16(); o[1] = zero16();
        block_loop<true>(kbs, vbs, SEQ, kv, umb ? (int)__builtin_ctzll(umb) : -1,
            [&](int n) { if (n >= 63) return -1; const unsigned long long rem = umb >> (n + 1); return rem ? n + 1 + (int)__builtin_ctzll(rem) : -1; },
#if defined(SEL_ALWAYS_ACTIVE)
            [&](int n) { return true; },
#else
            [&](int n) { return (bool)((umw >> n) & 1ull); },
#endif
            [&](int n, LAS const bf16_t* kb, LAS const bf16_t* vb) {
                const bool bsel = (mymask >> n) & 1ull;
#pragma unroll
                for (int kt = 0; kt < 2; ++kt) {
                    const int tok0 = 64 * n + 32 * kt;
#if defined(BLK_GLOBAL_FRAGS)
                    const f32x16 s = qk_tile(qf, KSrcBf{kbs}, tok0, lane);
                    const VSrcBfT vsg{vbs, SEQ};
                    sm_pv(s, hb, [&](int kl) { return bsel && (tok0 + kl <= qpos); }, [&](int dt, int s2) { return vsg(tok0, dt, s2, lane); }, m, l, o);
#else
                    const f32x16 s = lds_qk(qf, kb, kt, col, hb);
                    if (n < j) sm_pv_nomask(s, bsel, [&](int dt, int s2) { return lds_vfrag(vb, kt, dt, s2, col, hb); }, m, l, o);
                    else sm_pv(s, hb, [&](int kl) { return bsel && (tok0 + kl <= qpos); }, [&](int dt, int s2) { return lds_vfrag(vb, kt, dt, s2, col, hb); }, m, l, o);
#endif
                }
            });
        l += __shfl_xor(l, 32);
        const float sc = l > 0.f ? g1 / l : 0.f;
        of_add(ost, lane, o, sc);
#if defined(DBG_SELCMP)
        {
            const float i1 = l > 0.f ? 1.0f / l : 0.f;
            float c1 = 0.f;
            for (int dt = 0; dt < 2; ++dt) for (int i = 0; i < 16; ++i) c1 += o[dt][i] * i1 * (1.0f + 0.37f * (float)(dt * 16 + i));
            const KSrcBf ksrc{kbs}; const VSrcBfT vsrc{vbs, SEQ};
            float m2 = -1e30f, l2 = 0.f; f32x16 o2[2]; o2[0] = zero16(); o2[1] = zero16();
            unsigned long long umu = umw;
            { const unsigned lo = __builtin_amdgcn_readfirstlane((unsigned)umu), hi = __builtin_amdgcn_readfirstlane((unsigned)(umu >> 32)); umu = ((unsigned long long)hi << 32) | lo; }
            if (j < 63) umu &= (2ull << j) - 1ull;
            const int first = umu ? 2 * (int)__builtin_ctzll(umu) : -1;
            tile_loop(qf, ksrc, vsrc, first,
                      [&](int tt) { if (!(tt & 1)) return tt + 1; const int n = tt >> 1; if (n >= 63) return -1; const unsigned long long rem = umu >> (n + 1); return rem ? 2 * (n + 1 + (int)__builtin_ctzll(rem)) : -1; },
                      [&](int tok0, int kl) { return (bool)((mymask >> (tok0 >> 6)) & 1ull) && (tok0 + kl <= qpos); }, lane, m2, l2, o2);
            l2 += __shfl_xor(l2, 32);
            const float i2 = l2 > 0.f ? 1.0f / l2 : 0.f;
            float c2 = 0.f;
            for (int dt = 0; dt < 2; ++dt) for (int i = 0; i < 16; ++i) c2 += o2[dt][i] * i2 * (1.0f + 0.37f * (float)(dt * 16 + i));
            if (!(fabsf(c1 - c2) < DBG_TOL) DBG_COND) ost[lane] = __builtin_nanf("");
        }
#endif
    }
#endif
#if defined(BLK_OLD_WIN)
    {
        const KSrcBf ksrc{p.kb() + (size_t)((2 * NB + b) * 2 + g) * SEQ * 64};
        const VSrcBfT vsrc{p.vT() + (size_t)((1 * NB + b) * 2 + g) * 64 * SEQ, SEQ};
        float m = -1e30f, l = 0.f; f32x16 o[2]; o[0] = zero16(); o[1] = zero16();
        const int lo = t0 - 511; const int nlo = lo > 0 ? (lo >> 6) : 0; const int last = 2 * j + 1;
        tile_loop(qf, ksrc, vsrc, 2 * nlo, [&](int tt) { return tt < last ? tt + 1 : -1; },
                  [&](int tok0, int kl) { const int key = tok0 + kl; return key <= qpos && key + 511 >= qpos; }, lane, m, l, o);
        l += __shfl_xor(l, 32);
        const float sc = l > 0.f ? g2 / l : 0.f;
        f32x16 of[2];
        of_get_add(ost, lane, o, sc, of);
        attn_store(p, of, qrow, head, hb, true);
    }
#else
#if defined(DBG_SCHED)
    __builtin_amdgcn_sched_barrier(0);
#endif
#if defined(DBG_EXTRA_SYNC)
    __syncthreads();
#endif
#if defined(DBG_SLEEP)
    for (int r = 0; r < (wid ^ (j & 7)) * 6; ++r) __builtin_amdgcn_s_sleep(100);
#endif
    {
        const bf16_t* kbw = p.kb() + (size_t)((2 * NB + b) * 2 + g) * SEQ * 64;
        const bf16_t* vbw = p.vT() + (size_t)((1 * NB + b) * 2 + g) * 64 * SEQ;
        float m = -1e30f, l = 0.f; f32x16 o[2]; o[0] = zero16(); o[1] = zero16();
        block_loop<true>(kbw, vbw, SEQ, kv, j > 8 ? j - 8 : 0, [&](int n) { return n < j ? n + 1 : -1; }, [&](int n) { return true; },
            [&](int n, LAS const bf16_t* kb, LAS const bf16_t* vb) {
#pragma unroll 1
                for (int kt = 0; kt < 2; ++kt) {
                    const int tok0 = 64 * n + 32 * kt;
#if defined(BLK_GLOBAL_FRAGS)
                    const f32x16 s = qk_tile(qf, KSrcBf{kbw}, tok0, lane);
                    const VSrcBfT vsg{vbw, SEQ};
                    sm_pv(s, hb, [&](int kl) { const int key = tok0 + kl; return key <= qpos && key + 511 >= qpos; }, [&](int dt, int s2) { return vsg(tok0, dt, s2, lane); }, m, l, o);
#else
                    const f32x16 s = lds_qk(qf, kb, kt, col, hb);
                    if (n < j && n > j - 8) sm_pv_nomask(s, true, [&](int dt, int s2) { return lds_vfrag(vb, kt, dt, s2, col, hb); }, m, l, o);
                    else sm_pv(s, hb, [&](int kl) { const int key = tok0 + kl; return key <= qpos && key + 511 >= qpos; }, [&](int dt, int s2) { return lds_vfrag(vb, kt, dt, s2, col, hb); }, m, l, o);
#endif
                }
            });
        l += __shfl_xor(l, 32);
        const float sc = l > 0.f ? g2 / l : 0.f;
        f32x16 of[2];
        of_get_add(ost, lane, o, sc, of);
        attn_store(p, of, qrow, head, hb, true);
    }
#endif
    __syncthreads();
}

__device__ __forceinline__ void attn_sample_block(const P& p, int bg, LAS unsigned char* lds) {
    int tid_l = threadIdx.x; asm volatile("" : "+v"(tid_l));
    const int tid = tid_l, lane = tid & 63, wid = __builtin_amdgcn_readfirstlane(tid >> 6);
    const int b = bg >> 1, g = bg & 1, t = wid;
    const int col = lane & 31, hb = lane >> 5, hh = col & 3;
    const int qrow = NP + b * 8 + t, head = g * 4 + hh;
    LAS unsigned char* wl = lds + wid * WL_STRIDE;
    LAS unsigned char* kv = lds + KV_OFF;
    bf16x8 qf[4];
#pragma unroll
    for (int ks = 0; ks < 4; ++ks) qf[ks] = *(const bf16x8*)(p.qb() + (size_t)qrow * 512 + head * 64 + 16 * ks + 8 * hb);
    LAS float* psum = (LAS float*)wl;
    LAS int* list = (LAS int*)(wl + 8256);
    LAS float* impl = (LAS float*)(wl + 8448);
    LAS bf16_t* vt = (LAS bf16_t*)(wl + 9728);
    const float g0 = p.gates()[(size_t)qrow * 32 + head * 3 + 0], g1 = p.gates()[(size_t)qrow * 32 + head * 3 + 1], g2 = p.gates()[(size_t)qrow * 32 + head * 3 + 2];
    f32x16 oc[2]; oc[0] = zero16(); oc[1] = zero16();
    {
        const bf16_t* kc = p.kc_s() + (size_t)bg * 1024 * 64;
        const bf16_t* vc = p.vcT_s() + (size_t)bg * 64 * 1024;
        float m = -1e30f, l = 0.f;
        block_loop<false>(kc, vc, 1024, kv, 0, [&](int n) { return n < 15 ? n + 1 : -1; }, [&](int n) { return true; },
            [&](int n, LAS const bf16_t* kb, LAS const bf16_t* vb) {
#pragma unroll 1
                for (int kt = 0; kt < 2; ++kt) {
                    const f32x16 s = lds_qk(qf, kb, kt, col, hb);
                    sm_stats(s, hb, [&](int kl) { return 64 * n + 32 * kt + kl <= 1022; }, m, l);
                }
            });
        l += __shfl_xor(l, 32);
        const float inv = l > 0.f ? 1.0f / l : 0.f;
        block_loop<true>(kc, vc, 1024, kv, 0, [&](int n) { return n < 15 ? n + 1 : -1; }, [&](int n) { return true; },
            [&](int n, LAS const bf16_t* kb, LAS const bf16_t* vb) {
#pragma unroll 1
                for (int kt = 0; kt < 2; ++kt) {
                    const f32x16 s = lds_qk(qf, kb, kt, col, hb);
                    cmp_pass2(s, hb, [&](int kl) { return 64 * n + 32 * kt + kl <= 1022; }, [&](int dt, int s2) { return lds_vfrag(vb, kt, dt, s2, col, hb); }, m, inv, oc,
                              psum + 64 * n + 32 * kt, col == 0);
                }
            });
    }
    WAVE_SYNC();
#pragma unroll
    for (int j = 0; j < 5; ++j) {
        const int n = lane + 64 * j;
        if (n <= 256) {
            float imp = 0.f;
            for (int c = -1; c < 4; ++c) { const int cc = 4 * n + c; if (cc >= 0 && cc <= 1022) imp += psum[cc]; }
            impl[n] = imp;
        }
    }
    WAVE_SYNC();
    {
        int base = 0;
#pragma unroll
        for (int j = 0; j < 4; ++j) {
            const int n = lane + 64 * j;
            const bool cand = n >= 1 && n <= 254;
            const float v = impl[n];
            int rank = 0;
            for (int q = 1; q <= 254; ++q) { const float vq = impl[q]; rank += (vq > v || (vq == v && q < n)) ? 1 : 0; }
            const bool sel = cand && rank < 13;
            const unsigned long long mk = __ballot(sel);
            if (sel) list[base + __popcll(mk & ((1ull << lane) - 1ull))] = n;
            base += __popcll(mk);
        }
        if (lane == 0) { list[13] = 0; list[14] = 255; list[15] = 256; }
    }
    WAVE_SYNC();
    if (lane < 16) {
        const int n = list[lane];
        list[16 + lane] = n < 256 ? p.page_table[b * 128 + (n >> 1)] * 128 + (n & 1) * 64 : -1;
    }
    WAVE_SYNC();
    LAS float* ost = (LAS float*)wl;
    of_put(ost, lane, oc, g0);
    {
        float m = -1e30f, l = 0.f; f32x16 o[2]; o[0] = zero16(); o[1] = zero16();
        const float* newrows = p.out + O_SEL_S + (size_t)(b * 8) * 256 + g * 64;
        auto rowptr = [&](int u) -> const float* {
            const int rb = __builtin_amdgcn_readfirstlane(list[16 + (u >> 1)]);
            return rb >= 0 ? p.cache_sel + ((size_t)rb + 32 * (u & 1) + col) * 256 + g * 64 : newrows + (size_t)(col < 8 ? col : 7) * 256;
        };
        f32x4 kA[4], kB[4];
        { const float* kr = rowptr(0) + 8 * hb;
#pragma unroll
          for (int ks = 0; ks < 4; ++ks) { kA[ks] = *(const f32x4*)(kr + 16 * ks); kB[ks] = *(const f32x4*)(kr + 16 * ks + 4); } }
#pragma unroll 1
        for (int u = 0; u < 31; ++u) {
            const bool isnew = __builtin_amdgcn_readfirstlane(list[16 + (u >> 1)]) < 0;
            const float* vr = rowptr(u) + 128 + 32 * hb;
            f32x4 vv[8];
#pragma unroll
            for (int j4 = 0; j4 < 8; ++j4) vv[j4] = *(const f32x4*)(vr + 4 * j4);
            f32x16 s = zero16();
#pragma unroll
            for (int ks = 0; ks < 4; ++ks) s = mfma32(pack8(kA[ks][0], kA[ks][1], kA[ks][2], kA[ks][3], kB[ks][0], kB[ks][1], kB[ks][2], kB[ks][3]), qf[ks], s);
            if (u + 1 < 31) { const float* kr = rowptr(u + 1) + 8 * hb;
#pragma unroll
                for (int ks = 0; ks < 4; ++ks) { kA[ks] = *(const f32x4*)(kr + 16 * ks); kB[ks] = *(const f32x4*)(kr + 16 * ks + 4); } }
#pragma unroll
            for (int j4 = 0; j4 < 8; ++j4)
#pragma unroll
                for (int e = 0; e < 4; ++e) vt[(32 * hb + 4 * j4 + e) * 40 + col] = f2bf(vv[j4][e]);
            WAVE_SYNC();
            sm_pv(s, hb, [&](int kl) { return !isnew || kl <= t; }, [&](int dt, int s2) {
                LAS const bf16_t* ptr = vt + (32 * dt + col) * 40 + 16 * s2 + 4 * hb;
                union { u32x4_t u4; bf16x8 v; } x; const u32x2 a = *(LAS const u32x2*)ptr, c = *(LAS const u32x2*)(ptr + 8); x.u4[0] = a[0]; x.u4[1] = a[1]; x.u4[2] = c[0]; x.u4[3] = c[1]; return x.v; }, m, l, o);
            WAVE_SYNC();
        }
        l += __shfl_xor(l, 32);
        const float sc = l > 0.f ? g1 / l : 0.f;
        of_add(ost, lane, o, sc);
    }
    {
        float m = -1e30f, l = 0.f; f32x16 o[2]; o[0] = zero16(); o[1] = zero16();
        LoadWinF32 L; L.cw = p.cache_win + (size_t)b * 512 * 256 + g * 64; L.nw = p.out + O_WIN_S + ((size_t)b * 512 + 504) * 256 + g * 64;
        block_loop_g(L, kv, 0, [&](int n) { return n < 8 ? n + 1 : -1; }, [&](int n) { return true; },
            [&](int n, LAS const bf16_t* kb, LAS const bf16_t* vb) {
#pragma unroll 1
                for (int kt = 0; kt < 2; ++kt) {
                    const int j0 = 64 * n + 32 * kt;
                    if (j0 >= 520) break;
                    const f32x16 s = lds_qk(qf, kb, kt, col, hb);
                    sm_pv(s, hb, [&](int kl) { const int j = j0 + kl; return j >= t + 1 && j <= 512 + t; }, [&](int dt, int s2) { return lds_vfrag(vb, kt, dt, s2, col, hb); }, m, l, o);
                }
            });
        l += __shfl_xor(l, 32);
        const float sc = l > 0.f ? g2 / l : 0.f;
        f32x16 of[2];
        of_get_add(ost, lane, o, sc, of);
        attn_store(p, of, qrow, head, hb, col < 4);
    }
    __syncthreads();
}

__device__ __forceinline__ void ph_attn(const P& p, LAS unsigned char* lds, int qsel = 0) {
    const int tid = threadIdx.x, lane = tid & 63, wid = tid >> 6;
    unsigned* ctr = p.bar() + 3584 + 64 * qsel;
    LAS unsigned* qslot = (LAS unsigned*)(lds + XB_OFF + 64);
    for (;;) {
        if (tid == 0) *qslot = __hip_atomic_fetch_add(ctr, 1u, __ATOMIC_RELAXED, __HIP_MEMORY_SCOPE_AGENT);
        __syncthreads();
        const unsigned q = __builtin_amdgcn_readfirstlane(*qslot);
        __syncthreads();
        if (q >= 64u + 512u) break;
#if defined(OLD_SAMPLE_ATTN)
        if (q < 64u) { attn_sample_item(p, (int)q * 8 + wid, lds + wid * WL_STRIDE, lane); __syncthreads(); }
#else
        if (q < 64u) attn_sample_block(p, (int)q, lds);
#endif
#if defined(OLD_PROMPT_ATTN)
        else { const int idx = (int)q - 64; attn_prompt_item(p, 4095 - (idx * 8 + wid), lds + wid * WL_STRIDE, lane); __syncthreads(); }
#else
        else { const int idx = (int)q - 64; attn_prompt_block(p, idx & 7, 63 - (idx >> 3), lds);
#if defined(DBG_REDO_OLD)
            attn_prompt_item(p, (8 * (63 - (idx >> 3)) + wid) * 8 + (idx & 7), lds + wid * WL_STRIDE, lane); __syncthreads();
#endif
        }
#endif
    }
}

#if defined(DBG_CMPALL)
__device__ __forceinline__ void dbg_old_attn(const P& p, LAS unsigned char* lds) {
    const int tid = threadIdx.x, lane = tid & 63, wid = tid >> 6;
    for (int it = blockIdx.x * 8 + wid; it < 4096; it += gridDim.x * 8) attn_prompt_item(p, it, lds + wid * WL_STRIDE, lane, (bf16_t*)p.tmp());
}
__device__ __forceinline__ void dbg_compare(const P& p) {
    const int tid = threadIdx.x, lane = tid & 63, wid = tid >> 6;
    const bf16_t* a = p.oa(); const bf16_t* b = (const bf16_t*)p.tmp();
    unsigned cnt = 0;
    for (int it = blockIdx.x * 8 + wid; it < NP * 8; it += gridDim.x * 8) {
        const int row = it >> 3, head = it & 7;
        const float x = bf2f(a[(size_t)row * 512 + head * 64 + lane]), y = bf2f(b[(size_t)row * 512 + head * 64 + lane]);
        const bool bad = __any(!(fabsf(x - y) <= DBG_TOL));
        const int s = row & (SEQ - 1), j = s >> 6, w = (s >> 3) & 7, g = head >> 2, bb = row >> 12;
        if (bad && (DBG_SEL)) ++cnt;
    }
    if (lane == 0 && cnt) atomicAdd(p.bar() + 3840, cnt);
}
#endif

#if defined(KEEP_OLD_PATH)
__device__ __forceinline__ void keep_old_attn(const P& p, LAS unsigned char* lds) {
    const int tid = threadIdx.x, lane = tid & 63, wid = tid >> 6;
    const int ndbg = (int)__builtin_amdgcn_readfirstlane(__hip_atomic_load(p.bar() + 3900, __ATOMIC_RELAXED, __HIP_MEMORY_SCOPE_AGENT));
    for (int it = blockIdx.x * 8 + wid; it < ndbg; it += gridDim.x * 8) attn_prompt_item(p, it, lds + wid * WL_STRIDE, lane, (bf16_t*)p.tmp());
}
#endif
#ifndef PROBE_PHASE
#define PROBE_PHASE 0
#endif
#ifndef STOP_AFTER
#define STOP_AFTER 3
#endif

constexpr int LDS_BYTES = pg8::STAGE_BYTES;

template <class Epi> __global__ __launch_bounds__(512, 2) void k_gemm(pg8::Gemm g, Epi E) {
    extern __shared__ __attribute__((aligned(16))) unsigned char shm[];
    pg8::StaticOrder S; S.init(g.M, g.N, (int)gridDim.x, (int)blockIdx.x);
    pg8::gemm_phase<Epi, pg8::StaticOrder, false>((PG8_LAS unsigned char*)shm, g, S, E, nullptr);
}
template <int PH> __global__ __launch_bounds__(512, 2) void k_phase(P p) {
    extern __shared__ __attribute__((aligned(16))) unsigned char shm[];
    LAS unsigned char* lds = (LAS unsigned char*)shm;
    if constexpr (PH == 0) ph_prep(p);
    if constexpr (PH == 1) ph_compress2(p, p.LHp(), 8, 256, 255, p.kc_p(), p.vcT_p(), lds);
    if constexpr (PH == 2) ph_cvt_cache(p);
    if constexpr (PH == 3) ph_compress2(p, p.LHs(), 64, 1024, 1023, p.kc_s(), p.vcT_s(), lds);
    if constexpr (PH == 4) ph_rwkv_prep(p);
    if constexpr (PH == 5) ph_rwkv_scan(p, (LAS float*)lds);
    if constexpr (PH == 6) ph_rwkv_post(p);
    if constexpr (PH == 7) ph_attn(p, lds);
    if constexpr (PH == 8) ph_final(p);
}

template <class Epi> static void launch_gemm(hipStream_t st, const bf16_t* A, const bf16_t* Bt, int M, int N, int K, const Epi& E) {
    static bool attr = false;
    if (!attr) { (void)hipFuncSetAttribute((const void*)k_gemm<Epi>, hipFuncAttributeMaxDynamicSharedMemorySize, LDS_BYTES); attr = true; }
    pg8::Gemm g{}; g.A = A; g.Bt = Bt; g.M = M; g.N = N; g.K = K;
    hipLaunchKernelGGL((k_gemm<Epi>), dim3(256), dim3(512), LDS_BYTES, st, g, E);
}
template <int PH> static void launch_phase(hipStream_t st, const P& p) {
    static bool attr = false;
    if (!attr) { (void)hipFuncSetAttribute((const void*)k_phase<PH>, hipFuncAttributeMaxDynamicSharedMemorySize, LDS_BYTES); attr = true; }
    hipLaunchKernelGGL((k_phase<PH>), dim3(256), dim3(512), LDS_BYTES, st, p);
}


constexpr int FUSED_LDS = XB_OFF + 256;

template <class Epi> __device__ __forceinline__ void run_gemm(LAS unsigned char* lds, const bf16_t* A, const bf16_t* Bt, int M, int N, int K, const Epi& E, int slot = -1) {
    pg8::Gemm g; g.A = A; g.Bt = Bt; g.M = M; g.N = N; g.K = K; g.pad_ = 0;
    pg8::StaticOrder S; S.init(M, N, (int)gridDim.x, slot >= 0 ? slot : (int)blockIdx.x);
    pg8::gemm_phase<Epi, pg8::StaticOrder, false>((PG8_LAS unsigned char*)lds, g, S, E, nullptr);
}

#if defined(DBG_LDSCLEAR)
#define XBAR() do { xcd_barrier(bar); for (int _i = threadIdx.x * 16; _i < XB_OFF; _i += 512 * 16) *(LAS u32x4_t*)(lds + _i) = (u32x4_t){DBG_FILL, DBG_FILL, DBG_FILL, DBG_FILL}; __syncthreads(); } while (0)
#elif defined(DBG_DOUBLEBAR)
#define XBAR() do { xcd_barrier(bar); xcd_barrier(bar); } while (0)
#else
#define XBAR() xcd_barrier(bar)
#endif
__global__ __launch_bounds__(512, 2) void k_fused(P p) {
    extern __shared__ __attribute__((aligned(16))) unsigned char shm[];
    LAS unsigned char* lds = (LAS unsigned char*)shm;
    LAS unsigned* xb = (LAS unsigned*)(lds + XB_OFF);
    if (threadIdx.x == 0) { xb[0] = 0u; xb[1] = 0u; xb[2] = 0u; xb[3] = 0u; }
    __syncthreads();
    XcdBarrier bar = xcd_barrier_post(p.bar(), (volatile LAS unsigned*)xb);
    ph_prep(p);
#if PROBE_PHASE == 1
    XBAR();
    ph_prep(p);
#endif
    XBAR();
    { EpiIn e; e.p = p; e.row0 = 0; e.pad_ = 0; run_gemm(lds, p.hb(), p.WinT(), MR, NPAD, DM, e); }
    ph_cmp_gemm_f32(p, lds);
#if PROBE_PHASE == 2
    XBAR();
    { EpiIn e; e.p = p; e.row0 = 0; e.pad_ = 0; run_gemm(lds, p.hb(), p.WinT(), MR, NPAD, DM, e); }
    ph_cmp_gemm_f32(p, lds);
#endif
    XBAR();
    if ((int)blockIdx.x < 16) {
        const int kvi = blockIdx.x >> 3, bg = blockIdx.x & 7;
        EpiPlainBf e; e.C = p.LHp() + ((size_t)kvi * 2048 + (size_t)bg * 256) * 256; e.ldc = 256; e.pad_ = 0;
        run_gemm(lds, (kvi ? p.vcr() : p.kb()) + (size_t)bg * 256 * 1024, p.W1T() + (size_t)kvi * 256 * 1024, 256, 256, 1024, e, 0);
        __builtin_amdgcn_fence(__ATOMIC_RELEASE, "agent");
        asm volatile("s_waitcnt vmcnt(0)" ::: "memory");
        __syncthreads();
        __builtin_amdgcn_fence(__ATOMIC_ACQUIRE, "agent");
        asm volatile("s_waitcnt vmcnt(0)" ::: "memory");
        compress2_tile(p, p.LHp(), 8, 256, 255, p.kc_p(), p.vcT_p(), kvi, bg, threadIdx.x >> 6, threadIdx.x & 63, lds + (threadIdx.x >> 6) * 8960);
    }
    ph_rwkv_prep(p);
    ph_compress2(p, p.LHs(), 64, 1024, 1023, p.kc_s(), p.vcT_s(), lds);
#if PROBE_PHASE == 31
    XBAR();
    ph_rwkv_prep(p);
#endif
#if PROBE_PHASE == 32
    XBAR();
    ph_compress2(p, p.LHs(), 64, 1024, 1023, p.kc_s(), p.vcT_s(), lds);
#endif
#if PROBE_PHASE == 3
    XBAR();
    if ((int)blockIdx.x < 16) {
        const int kvi = blockIdx.x >> 3, bg = blockIdx.x & 7;
        EpiPlainBf e; e.C = p.LHp() + ((size_t)kvi * 2048 + (size_t)bg * 256) * 256; e.ldc = 256; e.pad_ = 0;
        run_gemm(lds, (kvi ? p.vcr() : p.kb()) + (size_t)bg * 256 * 1024, p.W1T() + (size_t)kvi * 256 * 1024, 256, 256, 1024, e, 0);
        __builtin_amdgcn_fence(__ATOMIC_RELEASE, "agent");
        asm volatile("s_waitcnt vmcnt(0)" ::: "memory");
        __syncthreads();
        __builtin_amdgcn_fence(__ATOMIC_ACQUIRE, "agent");
        asm volatile("s_waitcnt vmcnt(0)" ::: "memory");
        compress2_tile(p, p.LHp(), 8, 256, 255, p.kc_p(), p.vcT_p(), kvi, bg, threadIdx.x >> 6, threadIdx.x & 63, lds + (threadIdx.x >> 6) * 8960);
    }
    ph_rwkv_prep(p);
    ph_compress2(p, p.LHs(), 64, 1024, 1023, p.kc_s(), p.vcT_s(), lds);
#endif
    XBAR();
    ph_rwkv_scan(p, (LAS float*)lds);
    __syncthreads();
    ph_attn(p, lds);
    XBAR();
    ph_rwkv_post(p);
    { EpiYa e; e.p = p; small_gemm(p.oa(), p.WpaT(), 512, e); run_gemm(lds, p.oa(), p.WpaT(), NP, DM, 512, e); }
#if PROBE_PHASE == 6
    XBAR();
    ph_rwkv_post(p);
    { EpiYa e; e.p = p; small_gemm(p.oa(), p.WpaT(), 512, e); run_gemm(lds, p.oa(), p.WpaT(), NP, DM, 512, e); }
#endif
    XBAR();
    { EpiYb e; e.p = p; small_gemm(p.ob(), p.WpbT(), 512, e); run_gemm(lds, p.ob(), p.WpbT(), NP, DM, 512, e); }
#if PROBE_PHASE == 7
    XBAR();
    { EpiYb e; e.p = p; small_gemm(p.ob(), p.WpbT(), 512, e); run_gemm(lds, p.ob(), p.WpbT(), NP, DM, 512, e); }
#endif
    XBAR();
    { EpiOut e; e.p = p; small_gemm(p.mb(), p.WoutT(), DM, e); run_gemm(lds, p.mb(), p.WoutT(), NP, DM, DM, e); }
    { EpiPlain e; e.C = p.pp(); e.ldc = DM; e.pad_ = 0; small_gemm(p.pb(), p.WprojT(), 256, e); run_gemm(lds, p.pb(), p.WprojT(), NP, DM, 256, e); }
#if PROBE_PHASE == 8
    XBAR();
    { EpiOut e; e.p = p; small_gemm(p.mb(), p.WoutT(), DM, e); run_gemm(lds, p.mb(), p.WoutT(), NP, DM, DM, e); }
    { EpiPlain e; e.C = p.pp(); e.ldc = DM; e.pad_ = 0; small_gemm(p.pb(), p.WprojT(), 256, e); run_gemm(lds, p.pb(), p.WprojT(), NP, DM, 256, e); }
#endif
    XBAR();
    { EpiGate e; e.p = p; small_gemm(p.xg(), p.WgateT(), DM, e); run_gemm(lds, p.xg(), p.WgateT(), NP, DM, DM, e); }
    XBAR();
    ph_final(p);
}
extern "C" void kernel_launch(void* const* d_in, const int* in_sizes, int n_in, void* d_out, int out_size, void* d_ws, size_t ws_size, hipStream_t stream) {
    (void)in_sizes; (void)n_in; (void)out_size; (void)ws_size;
    P p{};
    p.x_prompt = (const float*)d_in[0]; p.x_sample = (const float*)d_in[1]; p.p_prompt = (const float*)d_in[2]; p.p_sample = (const float*)d_in[3];
    p.cache_cmp = (const float*)d_in[4]; p.cache_sel = (const float*)d_in[5]; p.cache_win = (const float*)d_in[6]; p.state_wkv = (const float*)d_in[7];
    p.state_shift = (const float*)d_in[8]; p.page_table = (const int*)d_in[9]; p.norm_g = (const float*)d_in[10]; p.w_in = (const float*)d_in[11];
    p.cmp_pe = (const float*)d_in[12]; p.cmp_w1 = (const float*)d_in[13]; p.cmp_b1 = (const float*)d_in[14]; p.cmp_w2 = (const float*)d_in[15]; p.cmp_b2 = (const float*)d_in[16];
    p.w_pa = (const float*)d_in[17]; p.mu = (const float*)d_in[18]; p.w0 = (const float*)d_in[19]; p.w_up = (const float*)d_in[20]; p.a0 = (const float*)d_in[21];
    p.a_up = (const float*)d_in[22]; p.k_k = (const float*)d_in[23]; p.k_a = (const float*)d_in[24]; p.r_k = (const float*)d_in[25]; p.gn_g = (const float*)d_in[26];
    p.gn_b = (const float*)d_in[27]; p.w_pb = (const float*)d_in[28]; p.w_out = (const float*)d_in[29]; p.ple_g = (const float*)d_in[30]; p.w_gate = (const float*)d_in[31];
    p.w_proj = (const float*)d_in[32]; p.final_g = (const float*)d_in[33];
    p.out = (float*)d_out;
    p.ws = (unsigned char*)d_ws;

#if defined(MULTI_LAUNCH)
    launch_phase<0>(stream, p);
    { EpiIn e{}; e.p = p; e.row0 = 0; launch_gemm(stream, p.hb(), p.WinT(), MR, NPAD, DM, e); }
#if STOP_AFTER >= 3
    { EpiPlain e{}; e.C = p.LHp(); e.ldc = 256; launch_gemm(stream, p.kb(), p.W1T(), 2048, 256, 1024, e); }
    { EpiPlain e{}; e.C = p.LHp() + (size_t)2048 * 256; e.ldc = 256; launch_gemm(stream, p.vcr(), p.W1T() + (size_t)256 * 1024, 2048, 256, 1024, e); }
    launch_phase<1>(stream, p);
    launch_phase<2>(stream, p);
    { EpiPlain e{}; e.C = p.LHs(); e.ldc = 256; launch_gemm(stream, p.cs(), p.W1T(), 65536, 256, 1024, e); }
    { EpiPlain e{}; e.C = p.LHs() + (size_t)65536 * 256; e.ldc = 256; launch_gemm(stream, p.cs() + (size_t)65536 * 1024, p.W1T() + (size_t)256 * 1024, 65536, 256, 1024, e); }
    launch_phase<3>(stream, p);
#endif
#if STOP_AFTER >= 2
    launch_phase<4>(stream, p);
    launch_phase<5>(stream, p);
    launch_phase<6>(stream, p);
#endif
    hipMemsetAsync(p.oa(), 0, (size_t)MR * 512 * 2, stream);
#if STOP_AFTER >= 3
    launch_phase<7>(stream, p);
#endif
    { EpiYa e{}; e.p = p; launch_gemm(stream, p.oa(), p.WpaT(), MR, DM, 512, e); }
    { EpiYb e{}; e.p = p; launch_gemm(stream, p.ob(), p.WpbT(), MR, DM, 512, e); }
    { EpiOut e{}; e.p = p; launch_gemm(stream, p.mb(), p.WoutT(), MR, DM, DM, e); }
    { EpiPlain e{}; e.C = p.pp(); e.ldc = DM; launch_gemm(stream, p.pb(), p.WprojT(), MR, DM, 256, e); }
    { EpiGate e{}; e.p = p; launch_gemm(stream, p.xg(), p.WgateT(), MR, DM, DM, e); }
    launch_phase<8>(stream, p);
#else
    static int grid = 0;
    if (!grid) {
        int dev = 0, cus = 0, per_cu = 0;
        (void)hipGetDevice(&dev);
        (void)hipDeviceGetAttribute(&cus, hipDeviceAttributeMultiprocessorCount, dev);
        (void)hipFuncSetAttribute((const void*)k_fused, hipFuncAttributeMaxDynamicSharedMemorySize, FUSED_LDS);
        (void)hipOccupancyMaxActiveBlocksPerMultiprocessor(&per_cu, k_fused, 512, FUSED_LDS);
        grid = per_cu >= 1 ? cus : 0;
        if (grid > 256) grid = 256;
    }
    (void)hipMemsetAsync(p.bar(), 0, 32768, stream);
    if (grid > 0) hipLaunchKernelGGL(k_fused, dim3(grid), dim3(512), FUSED_LDS, stream, p);
#endif
}
```

```cpp
#include <hip/hip_runtime.h>
#include <stdint.h>
#include <stdio.h>
namespace pg8 {
#define PG8_LAS __attribute__((address_space(3)))
typedef unsigned short bf16_t;
typedef short bf16x8 __attribute__((ext_vector_type(8)));
typedef float f32x4 __attribute__((ext_vector_type(4)));
typedef unsigned u32x4 __attribute__((ext_vector_type(4)));
constexpr int BM = 256, BK = 64, HALF = 128, HTB = HALF * BK * 2  , STAGE_BYTES = 8 * HTB, NXCD = 8, WGM = 8;

__host__ __device__ __forceinline__ int lds_byte(int r, int c) { const int st = (r >> 4) * 2 + (c >> 5), rr = r & 15, cc = c & 31, ob = rr * 64 + cc * 2; return st * 1024 + (ob ^ (((ob >> 9) & 1) << 5)); }
__host__ __device__ __forceinline__ void stage_rc(int b, int& R, int& C) { const int st = b / 1024, sb = b % 1024, swz = sb ^ (((sb >> 9) & 1) << 5); R = (st >> 1) * 16 + swz / 64; C = (st & 1) * 32 + (swz % 64) / 2; }
__host__ __device__ __forceinline__ int perm32(int rho) { const int n = rho >> 4, i = rho & 15; return 8 * (i >> 2) + 4 * n + (i & 3); }

struct Unit { int pm, pn; };
struct Gemm { const bf16_t* A; const bf16_t* Bt; int M, N, K, pad_; };

struct StaticOrder {
    int nM, nN, nwg, G, c;
    __host__ __device__ void init(int M, int N, int G_, int c_) { nM = M / BM; nN = N / BM; nwg = nM * nN; G = G_; c = c_; }
    __host__ __device__ bool next(int i, Unit& u) const {
        const long L = (long)i * G + c; if (L >= nwg) return false;
        int wgid = (int)L; { const int q = nwg / NXCD, r = nwg % NXCD, xcd = wgid % NXCD, off = wgid / NXCD; wgid = (xcd < r ? xcd * (q + 1) : r * (q + 1) + (xcd - r) * q) + off; }
        const int nig = WGM * nN, gid = wgid / nig, fm = gid * WGM, gsz = (nM - fm) < WGM ? (nM - fm) : WGM;
        u.pm = fm + ((wgid % nig) % gsz); u.pn = (wgid % nig) / gsz; return true;
    }
    __device__ __forceinline__ void a_ready(const Unit&) const {}
    __device__ __forceinline__ void done(const Unit&) const {}
};
__device__ __forceinline__ unsigned cvt_pk_bf16(float lo, float hi) { unsigned r; asm volatile("v_cvt_pk_bf16_f32 %0, %1, %2" : "=v"(r) : "v"(lo), "v"(hi)); return r; }
typedef float f32x2 __attribute__((ext_vector_type(2)));
template <class Epi, class Sched, bool STAMP = false>
__device__ __forceinline__ void gemm_phase(PG8_LAS unsigned char* lds, const Gemm g, const Sched& S, const Epi& E, unsigned long long* stamps) {
    int tid_l = threadIdx.x; asm volatile("" : "+v"(tid_l));
    const int tid = tid_l, wid = __builtin_amdgcn_readfirstlane(tid >> 6), lane = tid & 63, wr = wid >> 2, wc = wid & 3, fr = lane & 15, fq = lane >> 4;
    const int K = g.K, nt = K / BK;
    int ts_lo = 0, ts_hi = 0, nts = 0; const unsigned long long rt_entry = STAMP ? (unsigned long long)wall_clock64() : 0ull;
#define PG8_STAMP() do { if (STAMP && wid == 0 && nts < 64) { const unsigned long long _c = (unsigned long long)clock64(); \
        ts_lo = (lane == nts) ? (int)(unsigned)_c : ts_lo; ts_hi = (lane == nts) ? (int)(unsigned)(_c >> 32) : ts_hi; ++nts; } } while (0)
    PG8_STAMP();
    unsigned voffA[2], voffB[2];
#pragma unroll
    for (int i = 0; i < 2; ++i) { int R, C; stage_rc(tid * 16 + i * 8192, R, C); const int Rb = Epi::PERM ? ((R & ~31) + perm32(R & 31)) : R;
        voffA[i] = (unsigned)(R * K + C) * 2u; voffB[i] = (unsigned)(Rb * K + C) * 2u; }
    const size_t kstep = (size_t)(BK * 2);
    const size_t hstep = (size_t)HALF * K * 2;
    const size_t tstep = 2 * hstep;
    const unsigned ldsw = (unsigned)wid * 1024u;
    const int aoff = lds_byte(wr * 64 + fr, fq * 8), boff = lds_byte(wc * 32 + fr, fq * 8);
#define PG8_SA(b, h) (((b) * 2 + (h)) * HTB)
#define PG8_SB(b, h) ((4 + (b) * 2 + (h)) * HTB)
#define PG8_STAGE(bufoff, gbase, voff) do { _Pragma("unroll") for (int _i = 0; _i < 2; ++_i) \
        __builtin_amdgcn_global_load_lds((const unsigned*)((const char*)(gbase) + (voff)[_i]), (PG8_LAS unsigned*)(lds + (bufoff) + ldsw + _i * 8192), 16, 0, 0); } while (0)
#define PG8_LDA(dst, b, h) do { _Pragma("unroll") for (int m = 0; m < 4; ++m) _Pragma("unroll") for (int k = 0; k < 2; ++k) dst[m][k] = *(const PG8_LAS bf16x8*)(lds + PG8_SA(b, h) + aoff + m * 2048 + k * 1024); } while (0)
#define PG8_LDB(dst, b, h) do { _Pragma("unroll") for (int n = 0; n < 2; ++n) _Pragma("unroll") for (int k = 0; k < 2; ++k) dst[n][k] = *(const PG8_LAS bf16x8*)(lds + PG8_SB(b, h) + boff + n * 2048 + k * 1024); } while (0)
#define PG8_MMA(ai, bj, At, Bt) do { __builtin_amdgcn_s_setprio(1); _Pragma("unroll") for (int m = 0; m < 4; ++m) _Pragma("unroll") for (int n = 0; n < 2; ++n) _Pragma("unroll") for (int k = 0; k < 2; ++k) \
        acc[ai][bj][m][n] = __builtin_amdgcn_mfma_f32_16x16x32_bf16(Bt[n][k], At[m][k], acc[ai][bj][m][n], 0, 0, 0); __builtin_amdgcn_s_setprio(0); } while (0)
#define PG8_WAIT_V(n) asm volatile("s_waitcnt vmcnt(" #n ")" ::: "memory")
#define PG8_WAIT_L(n) asm volatile("s_waitcnt lgkmcnt(" #n ")" ::: "memory")
#define PG8_BAR __builtin_amdgcn_s_barrier()
#define PG8_SCHED __builtin_amdgcn_sched_barrier(0)
    Unit cur, nxt; int ui = 0;
    if (!S.next(0, cur)) return;
    f32x4 acc[2][2][4][2];
#pragma unroll
    for (int a = 0; a < 2; ++a)
#pragma unroll
        for (int b = 0; b < 2; ++b)
#pragma unroll
            for (int m = 0; m < 4; ++m)
#pragma unroll
                for (int n = 0; n < 2; ++n) acc[a][b][m][n] = (f32x4){0.f, 0.f, 0.f, 0.f};
    bf16x8 At[4][2], B0[2][2], B1[2][2];
    const char* cA = (const char*)g.A + (size_t)cur.pm * tstep; const char* cB = (const char*)g.Bt + (size_t)cur.pn * tstep;
    S.a_ready(cur);
    PG8_STAGE(PG8_SB(0, 0), cB, voffB); PG8_STAGE(PG8_SA(0, 0), cA, voffA); PG8_STAGE(PG8_SB(0, 1), cB + hstep, voffB); PG8_STAGE(PG8_SA(0, 1), cA + hstep, voffA);
    if (wr == 1) PG8_BAR;
    PG8_WAIT_V(4); PG8_BAR;
    PG8_STAGE(PG8_SB(1, 0), cB + kstep, voffB); PG8_STAGE(PG8_SA(1, 0), cA + kstep, voffA); PG8_STAGE(PG8_SB(1, 1), cB + hstep + kstep, voffB);
    PG8_WAIT_V(6); PG8_BAR;
    PG8_STAMP();
    for (;;) {
        const bool has_next = S.next(ui + 1, nxt);
        const char* nA = has_next ? (const char*)g.A + (size_t)nxt.pm * tstep : cA; const char* nB = has_next ? (const char*)g.Bt + (size_t)nxt.pn * tstep : cB;
        for (int t = 0; t < nt; t += 2) {
            const bool last = (t == nt - 2);
            const char* a1 = cA + (size_t)(t + 1) * kstep;
            const char* a2 = last ? nA : cA + (size_t)(t + 2) * kstep; const char* b2 = last ? nB : cB + (size_t)(t + 2) * kstep;
            const char* a3 = a2 + kstep; const char* b3 = b2 + kstep;
            if (last && has_next) S.a_ready(nxt);
            PG8_LDB(B0, 0, 0); PG8_SCHED; PG8_LDA(At, 0, 0); PG8_STAGE(PG8_SA(1, 1), a1 + hstep, voffA);
            PG8_WAIT_L(8); PG8_BAR; PG8_WAIT_L(0); PG8_MMA(0, 0, At, B0); PG8_BAR; PG8_SCHED;
            PG8_LDB(B1, 0, 1); PG8_STAGE(PG8_SB(0, 0), b2, voffB);
            PG8_BAR; PG8_WAIT_L(0); PG8_MMA(0, 1, At, B1); PG8_BAR;
            PG8_LDA(At, 0, 1); PG8_STAGE(PG8_SA(0, 0), a2, voffA);
            PG8_BAR; PG8_WAIT_L(0); PG8_MMA(1, 0, At, B0); PG8_BAR; PG8_SCHED;
            PG8_STAGE(PG8_SB(0, 1), b2 + hstep, voffB);
            PG8_WAIT_V(6); PG8_BAR; PG8_MMA(1, 1, At, B1); PG8_BAR;
            PG8_LDB(B0, 1, 0); PG8_SCHED; PG8_LDA(At, 1, 0); PG8_STAGE(PG8_SA(0, 1), a2 + hstep, voffA);
            PG8_WAIT_L(8); PG8_BAR; PG8_WAIT_L(0); PG8_MMA(0, 0, At, B0); PG8_BAR; PG8_SCHED;
            PG8_LDB(B1, 1, 1); PG8_STAGE(PG8_SB(1, 0), b3, voffB);
            PG8_BAR; PG8_WAIT_L(0); PG8_MMA(0, 1, At, B1); PG8_BAR;
            PG8_LDA(At, 1, 1); PG8_STAGE(PG8_SA(1, 0), a3, voffA);
            PG8_BAR; PG8_WAIT_L(0); PG8_MMA(1, 0, At, B0); PG8_BAR; PG8_SCHED;
            PG8_STAGE(PG8_SB(1, 1), b3 + hstep, voffB);
            PG8_WAIT_V(6); PG8_BAR; PG8_MMA(1, 1, At, B1); PG8_BAR;
        }
        PG8_STAMP();
        if constexpr (!Epi::AFTER_DRAIN) { E(acc, cur, wr, wc, fr, fq); S.done(cur); }
        PG8_STAMP();
        if (!has_next) break;
#pragma unroll
        for (int a = 0; a < 2; ++a)
#pragma unroll
            for (int b = 0; b < 2; ++b)
#pragma unroll
                for (int m = 0; m < 4; ++m)
#pragma unroll
                    for (int n = 0; n < 2; ++n) acc[a][b][m][n] = (f32x4){0.f, 0.f, 0.f, 0.f};
        cur = nxt; cA = nA; cB = nB; ++ui;
    }
    PG8_WAIT_V(0);
    if (wr == 0) PG8_BAR;
    PG8_BAR;
    if constexpr (Epi::AFTER_DRAIN) { E.fused(acc, cur, wr, wc, fr, fq, lds, wid, lane); S.done(cur); }
    PG8_STAMP();
    if (STAMP && wid == 0) { stamps[lane] = lane < nts ? (((unsigned long long)(unsigned)ts_hi << 32) | (unsigned)ts_lo) : 0ull;
        if (lane == 62) stamps[62] = rt_entry; if (lane == 63) stamps[63] = (unsigned long long)wall_clock64(); }
#undef PG8_STAMP
#undef PG8_SA
#undef PG8_SB
#undef PG8_STAGE
#undef PG8_LDA
#undef PG8_LDB
#undef PG8_MMA
#undef PG8_WAIT_V
#undef PG8_WAIT_L
#undef PG8_BAR
#undef PG8_SCHED
}
}

typedef unsigned short bf16_t;
typedef short bf16x8 __attribute__((ext_vector_type(8)));
typedef float f32x4 __attribute__((ext_vector_type(4)));
typedef float f32x16 __attribute__((ext_vector_type(16)));
#define LAS __attribute__((address_space(3)))
#define WAVE_SYNC() do { asm volatile("s_waitcnt lgkmcnt(0)" ::: "memory"); __builtin_amdgcn_wave_barrier(); } while (0)

constexpr int DM = 1024, NP = 16384, NSMP = 256, MR = 16640, SEQ = 4096, NB = 4, DB = 32, DS = 8, PAST = 16384;
constexpr int CIN = 6040, NPAD = 6144, CR = 1664;
constexpr int NTHR = 512;
constexpr size_t O_Y_P = 0, O_Y_S = 16777216, O_CMP_P = 17039360, O_CMP_S = 21233664, O_SEL_P = 21299200, O_SEL_S = 25493504,
                 O_WIN_P = 25559040, O_WIN_S = 26083328, O_WKV_P = 30277632, O_WKV_S = 30408704, O_SH_P = 31457280, O_SH_S = 31463936;

constexpr size_t ws_al(size_t x) { return (x + 255) & ~(size_t)255; }
constexpr size_t WS_bar = 0;
constexpr size_t WS_hb = WS_bar + ws_al(32768);
constexpr size_t WS_WinT = WS_hb + ws_al((size_t)MR * DM * 2);
constexpr size_t WS_WpaT = WS_WinT + ws_al((size_t)NPAD * DM * 2);
constexpr size_t WS_WpbT = WS_WpaT + ws_al((size_t)DM * 512 * 2);
constexpr size_t WS_WoutT = WS_WpbT + ws_al((size_t)DM * 512 * 2);
constexpr size_t WS_WgateT = WS_WoutT + ws_al((size_t)DM * DM * 2);
constexpr size_t WS_WprojT = WS_WgateT + ws_al((size_t)DM * DM * 2);
constexpr size_t WS_W1T = WS_WprojT + ws_al((size_t)DM * 256 * 2);
constexpr size_t WS_W2T = WS_W1T + ws_al((size_t)512 * 1024 * 2);
constexpr size_t WS_WupT = WS_W2T + ws_al((size_t)128 * 128 * 2);
constexpr size_t WS_AupT = WS_WupT + ws_al((size_t)512 * 64 * 2);
constexpr size_t WS_pb = WS_AupT + ws_al((size_t)512 * 64 * 2);
constexpr size_t WS_tabc = WS_pb + ws_al((size_t)MR * 256 * 2);
constexpr size_t WS_tabs = WS_tabc + ws_al((size_t)4104 * 32 * 4);
constexpr size_t WS_pt = WS_tabs + ws_al((size_t)4104 * 32 * 4);
constexpr size_t WS_qb = WS_pt + ws_al(256 * 4);
constexpr size_t WS_kb = WS_qb + ws_al((size_t)MR * 512 * 2);
constexpr size_t WS_vcr = WS_kb + ws_al((size_t)3 * NB * 2 * SEQ * 64 * 2);
constexpr size_t WS_vT = WS_vcr + ws_al((size_t)NB * 2 * SEQ * 64 * 2);
constexpr size_t WS_ag = WS_vT + ws_al((size_t)2 * NB * 2 * 64 * SEQ * 2);
constexpr size_t WS_rg = WS_ag + ws_al((size_t)MR * 512 * 2);
constexpr size_t WS_mg = WS_rg + ws_al((size_t)MR * 512 * 2);
constexpr size_t WS_gates = WS_mg + ws_al((size_t)MR * 2048 * 2);
constexpr size_t WS_rz = WS_gates + ws_al((size_t)MR * 32 * 4);
constexpr size_t WS_zs0 = WS_rz + ws_al((size_t)MR * CR * 2);
constexpr size_t WS_LHp = WS_zs0 + ws_al((size_t)33 * CR * 2);
constexpr size_t WS_LHs = WS_LHp + ws_al((size_t)2 * 2048 * 256 * 4);
constexpr size_t WS_cs = WS_LHs + ws_al((size_t)2 * 65536 * 256 * 4);
constexpr size_t WS_kc_p = WS_cs + ws_al((size_t)2 * 65536 * 1024 * 2);
constexpr size_t WS_vcT_p = WS_kc_p + ws_al((size_t)8 * 256 * 64 * 2);
constexpr size_t WS_kc_s = WS_vcT_p + ws_al((size_t)8 * 64 * 256 * 2);
constexpr size_t WS_vcT_s = WS_kc_s + ws_al((size_t)64 * 1024 * 64 * 2);
constexpr size_t WS_rw6 = WS_vcT_s + ws_al((size_t)64 * 64 * 1024 * 2);
constexpr int RW6_STRIDE = 896;
constexpr size_t WS_bonus = WS_rw6 + ws_al((size_t)MR * 8 * RW6_STRIDE);
constexpr size_t WS_ybuf = WS_bonus + ws_al((size_t)MR * 8 * 4);
constexpr size_t WS_oa = WS_ybuf + ws_al((size_t)MR * 512 * 4);
constexpr size_t WS_ob = WS_oa + ws_al((size_t)MR * 512 * 2);
constexpr size_t WS_mb = WS_ob + ws_al((size_t)MR * 512 * 2);
constexpr size_t WS_xg = WS_mb + ws_al((size_t)MR * DM * 2);
constexpr size_t WS_tmp = WS_xg + ws_al((size_t)MR * DM * 2);
constexpr size_t WS_x1 = WS_tmp + ws_al((size_t)MR * DM * 4);
constexpr size_t WS_ss1 = WS_x1 + ws_al((size_t)MR * DM * 4);
constexpr size_t WS_pp = WS_ss1 + ws_al((size_t)MR * 16 * 4);
constexpr size_t WS_TOTAL = WS_pp + ws_al((size_t)MR * DM * 4);

struct P {
    const float *x_prompt, *x_sample, *p_prompt, *p_sample, *cache_cmp, *cache_sel, *cache_win, *state_wkv, *state_shift;
    const int* page_table;
    const float *norm_g, *w_in, *cmp_pe, *cmp_w1, *cmp_b1, *cmp_w2, *cmp_b2, *w_pa, *mu, *w0, *w_up, *a0, *a_up, *k_k, *k_a, *r_k, *gn_g, *gn_b,
        *w_pb, *w_out, *ple_g, *w_gate, *w_proj, *final_g;
    float* out;
    unsigned char* ws;
    __host__ __device__ __forceinline__ unsigned* bar() const { return (unsigned*)(ws + WS_bar); }
    __host__ __device__ __forceinline__ float* ss_s() const { return (float*)(ws + WS_bar + 16384); }
    __host__ __device__ __forceinline__ bf16_t* hb() const { return (bf16_t*)(ws + WS_hb); }
    __host__ __device__ __forceinline__ bf16_t* WinT() const { return (bf16_t*)(ws + WS_WinT); }
    __host__ __device__ __forceinline__ bf16_t* WpaT() const { return (bf16_t*)(ws + WS_WpaT); }
    __host__ __device__ __forceinline__ bf16_t* WpbT() const { return (bf16_t*)(ws + WS_WpbT); }
    __host__ __device__ __forceinline__ bf16_t* WoutT() const { return (bf16_t*)(ws + WS_WoutT); }
    __host__ __device__ __forceinline__ bf16_t* WgateT() const { return (bf16_t*)(ws + WS_WgateT); }
    __host__ __device__ __forceinline__ bf16_t* WprojT() const { return (bf16_t*)(ws + WS_WprojT); }
    __host__ __device__ __forceinline__ bf16_t* W1T() const { return (bf16_t*)(ws + WS_W1T); }
    __host__ __device__ __forceinline__ bf16_t* W2T() const { return (bf16_t*)(ws + WS_W2T); }
    __host__ __device__ __forceinline__ bf16_t* WupT() const { return (bf16_t*)(ws + WS_WupT); }
    __host__ __device__ __forceinline__ bf16_t* AupT() const { return (bf16_t*)(ws + WS_AupT); }
    __host__ __device__ __forceinline__ bf16_t* pb() const { return (bf16_t*)(ws + WS_pb); }
    __host__ __device__ __forceinline__ float* tabc() const { return (float*)(ws + WS_tabc); }
    __host__ __device__ __forceinline__ float* tabs() const { return (float*)(ws + WS_tabs); }
    __host__ __device__ __forceinline__ float* pt() const { return (float*)(ws + WS_pt); }
    __host__ __device__ __forceinline__ bf16_t* qb() const { return (bf16_t*)(ws + WS_qb); }
    __host__ __device__ __forceinline__ bf16_t* kb() const { return (bf16_t*)(ws + WS_kb); }
    __host__ __device__ __forceinline__ bf16_t* vcr() const { return (bf16_t*)(ws + WS_vcr); }
    __host__ __device__ __forceinline__ bf16_t* vT() const { return (bf16_t*)(ws + WS_vT); }
    __host__ __device__ __forceinline__ bf16_t* ag() const { return (bf16_t*)(ws + WS_ag); }
    __host__ __device__ __forceinline__ bf16_t* rg() const { return (bf16_t*)(ws + WS_rg); }
    __host__ __device__ __forceinline__ bf16_t* mg() const { return (bf16_t*)(ws + WS_mg); }
    __host__ __device__ __forceinline__ float* gates() const { return (float*)(ws + WS_gates); }
    __host__ __device__ __forceinline__ bf16_t* rz() const { return (bf16_t*)(ws + WS_rz); }
    __host__ __device__ __forceinline__ bf16_t* zs0() const { return (bf16_t*)(ws + WS_zs0); }
    __host__ __device__ __forceinline__ bf16_t* LHp() const { return (bf16_t*)(ws + WS_LHp); }
    __host__ __device__ __forceinline__ bf16_t* LHs() const { return (bf16_t*)(ws + WS_LHs); }
    __host__ __device__ __forceinline__ bf16_t* cs() const { return (bf16_t*)(ws + WS_cs); }
    __host__ __device__ __forceinline__ bf16_t* kc_p() const { return (bf16_t*)(ws + WS_kc_p); }
    __host__ __device__ __forceinline__ bf16_t* vcT_p() const { return (bf16_t*)(ws + WS_vcT_p); }
    __host__ __device__ __forceinline__ bf16_t* kc_s() const { return (bf16_t*)(ws + WS_kc_s); }
    __host__ __device__ __forceinline__ bf16_t* vcT_s() const { return (bf16_t*)(ws + WS_vcT_s); }
    __host__ __device__ __forceinline__ unsigned char* rw6() const { return ws + WS_rw6; }
    __host__ __device__ __forceinline__ float* bonus() const { return (float*)(ws + WS_bonus); }
    __host__ __device__ __forceinline__ float* ybuf() const { return (float*)(ws + WS_ybuf); }
    __host__ __device__ __forceinline__ bf16_t* oa() const { return (bf16_t*)(ws + WS_oa); }
    __host__ __device__ __forceinline__ bf16_t* ob() const { return (bf16_t*)(ws + WS_ob); }
    __host__ __device__ __forceinline__ bf16_t* mb() const { return (bf16_t*)(ws + WS_mb); }
    __host__ __device__ __forceinline__ bf16_t* xg() const { return (bf16_t*)(ws + WS_xg); }
    __host__ __device__ __forceinline__ float* tmp() const { return (float*)(ws + WS_tmp); }
    __host__ __device__ __forceinline__ float* x1() const { return (float*)(ws + WS_x1); }
    __host__ __device__ __forceinline__ float* ss1() const { return (float*)(ws + WS_ss1); }
    __host__ __device__ __forceinline__ float* pp() const { return (float*)(ws + WS_pp); }
};


__device__ __forceinline__ float bf2f(bf16_t b) { return __uint_as_float(((unsigned)b) << 16); }
typedef __bf16 bf16v2_t __attribute__((ext_vector_type(2)));
typedef float f32x2_t __attribute__((ext_vector_type(2)));
__device__ __forceinline__ unsigned pk2(float lo, float hi) { const f32x2_t v = {lo, hi}; return __builtin_bit_cast(unsigned, __builtin_convertvector(v, bf16v2_t)); }
__device__ __forceinline__ bf16_t f2bf(float f) { return (bf16_t)(pk2(f, f) & 0xffffu); }
__device__ __forceinline__ float xsum16(float v) { const auto r = __builtin_amdgcn_permlane16_swap(__float_as_uint(v), __float_as_uint(v), false, false); return __uint_as_float(r[0]) + __uint_as_float(r[1]); }
__device__ __forceinline__ float xsum32(float v) { const auto r = __builtin_amdgcn_permlane32_swap(__float_as_uint(v), __float_as_uint(v), false, false); return __uint_as_float(r[0]) + __uint_as_float(r[1]); }
__device__ __forceinline__ float xmax32(float v) { const auto r = __builtin_amdgcn_permlane32_swap(__float_as_uint(v), __float_as_uint(v), false, false); return fmaxf(__uint_as_float(r[0]), __uint_as_float(r[1])); }
__device__ __forceinline__ float quad_sum(float v) {
    v += __builtin_bit_cast(float, __builtin_amdgcn_mov_dpp(__builtin_bit_cast(int, v), 0xB1, 0xF, 0xF, true));
    v += __builtin_bit_cast(float, __builtin_amdgcn_mov_dpp(__builtin_bit_cast(int, v), 0x4E, 0xF, 0xF, true));
    return v;
}
__device__ __forceinline__ float wave_sum(float v) {
    v += __builtin_bit_cast(float, __builtin_amdgcn_mov_dpp(__builtin_bit_cast(int, v), 0xB1, 0xF, 0xF, true));
    v += __builtin_bit_cast(float, __builtin_amdgcn_mov_dpp(__builtin_bit_cast(int, v), 0x4E, 0xF, 0xF, true));
    v += __builtin_bit_cast(float, __builtin_amdgcn_mov_dpp(__builtin_bit_cast(int, v), 0x141, 0xF, 0xF, true));
    v += __builtin_bit_cast(float, __builtin_amdgcn_mov_dpp(__builtin_bit_cast(int, v), 0x140, 0xF, 0xF, true));
    return xsum32(xsum16(v));
}
__device__ __forceinline__ float sigmoidf_(float x) { return 1.0f / (1.0f + __expf(-x)); }
__device__ __forceinline__ float siluf_(float x) { return x / (1.0f + __expf(-x)); }
__device__ __forceinline__ float sigmoid_fast(float x) { return __builtin_amdgcn_rcpf(1.0f + __expf(-x)); }
__device__ __forceinline__ float silu_fast(float x) { return x * __builtin_amdgcn_rcpf(1.0f + __expf(-x)); }

__device__ __forceinline__ int win_src_col(int np) {
    const int pn = np >> 8, p = np & 255;
    if (pn < 5) {
        const int bj = p >> 7, wc = (p >> 5) & 3, n = (p >> 4) & 1, fq = (p >> 2) & 3, e = p & 3;
        const int d = 32 * n + 16 * (wc & 1) + 4 * fq + e;
        if (pn < 2) { const int head = pn * 4 + bj * 2 + (wc >> 1); return head * 64 + d; }
        const int br = pn - 2, g = wc >> 1;
        return 512 + br * 256 + bj * 128 + g * 64 + d;
    }
    const int s = (p & 0xe0) + 8 * ((p >> 2) & 3) + 4 * ((p >> 4) & 1) + (p & 3);
    if (pn < 7) return 1304 + (pn - 5) * 256 + s;
    if (pn < 13) return 1816 + (pn - 7) * 256 + s;
    if (pn == 13) { if (s < 128) return 1816 + 1536 + s; if (s < 152) return 1280 + (s - 128); return -1; }
    if (pn < 16) return 3480 + (pn - 14) * 256 + s;
    return 3992 + (pn - 16) * 256 + s;
}

__device__ __forceinline__ int perm8(int np) { return (np & ~31) + 8 * ((np >> 2) & 3) + 4 * ((np >> 4) & 1) + (np & 3); }
template <class F>
__device__ __forceinline__ void transpose_cvt(bf16_t* dst, int Nd, int K, F f) {
    const int total = Nd * (K >> 3);
    for (int id = blockIdx.x * NTHR + threadIdx.x; id < total; id += gridDim.x * NTHR) {
        const int n = id % Nd, kc = id / Nd;
        float v[8];
#pragma unroll
        for (int j = 0; j < 8; ++j) v[j] = f(n, kc * 8 + j);
        uint4 w; w.x = pk2(v[0], v[1]); w.y = pk2(v[2], v[3]); w.z = pk2(v[4], v[5]); w.w = pk2(v[6], v[7]);
        *(uint4*)(dst + (size_t)n * K + kc * 8) = w;
    }
}

__device__ __forceinline__ void sincos_small(double r, float& s, float& c) {
    const double r2 = r * r;
    double sa = 1.0, ca = 1.0;
    double ts = 1.0, tc = 1.0; sa = 0.0; ca = 0.0;
#pragma unroll
    for (int k = 0; k < 16; ++k) {
        sa += ts; ca += tc;
        ts = -ts * r2 / (double)((2 * k + 2) * (2 * k + 3));
        tc = -tc * r2 / (double)((2 * k + 1) * (2 * k + 2));
    }
    s = (float)(sa * r); c = (float)ca;
}

__device__ __forceinline__ void ph_prep(const P& p) {
    const int tid = threadIdx.x, lane = tid & 63, wid = tid >> 6;
    const int gw = blockIdx.x * 8 + wid, nw = gridDim.x * 8;
    const int gt = blockIdx.x * NTHR + tid, nt = gridDim.x * NTHR;
    for (int row = gw; row < MR; row += nw) {
        const float4* src = (const float4*)(row < NP ? p.x_prompt + (size_t)row * DM : p.x_sample + (size_t)(row - NP) * DM);
        float4 v[4]; float ss = 0.f;
#pragma unroll
        for (int i = 0; i < 4; ++i) { v[i] = src[lane + 64 * i]; ss += v[i].x * v[i].x + v[i].y * v[i].y + v[i].z * v[i].z + v[i].w * v[i].w; }
        ss = wave_sum(ss);
        const float rstd = rsqrtf(ss * (1.0f / DM) + 1e-6f);
#pragma unroll
        for (int i = 0; i < 4; ++i) {
            const float4 g = ((const float4*)p.norm_g)[lane + 64 * i];
            uint2 w; w.x = pk2(v[i].x * rstd * g.x, v[i].y * rstd * g.y); w.y = pk2(v[i].z * rstd * g.z, v[i].w * rstd * g.w);
            *(uint2*)(p.hb() + (size_t)row * DM + 4 * (lane + 64 * i)) = w;
        }
    }
    { const float* w = p.w_in; transpose_cvt(p.WinT(), NPAD, DM, [=](int n, int k) { const int c = win_src_col(n); return c < 0 ? 0.f : w[(size_t)k * CIN + c]; }); }
    { const float* w = p.w_pa; transpose_cvt(p.WpaT(), DM, 512, [=](int n, int k) { return w[(size_t)k * DM + perm8(n)]; }); }
    { const float* w = p.w_pb; transpose_cvt(p.WpbT(), DM, 512, [=](int n, int k) { return w[(size_t)k * DM + perm8(n)]; }); }
    { const float* w = p.w_out; transpose_cvt(p.WoutT(), DM, DM, [=](int n, int k) { return w[(size_t)k * DM + perm8(n)]; }); }
    { const float* w = p.w_gate; transpose_cvt(p.WgateT(), DM, DM, [=](int n, int k) { return w[(size_t)k * DM + perm8(n)]; }); }
    { const float* w = p.w_proj; transpose_cvt(p.WprojT(), DM, 256, [=](int n, int k) { return w[(size_t)k * DM + perm8(n)]; }); }
    { const float* w = p.cmp_w1; transpose_cvt(p.W1T(), 512, 1024, [=](int n, int k) { const int kvi = n >> 8, nn = n & 255; return w[(size_t)kvi * 262144 + (size_t)((nn >> 7) * 1024 + k) * 128 + (nn & 127)]; }); }
    { const float* w = p.cmp_w2; transpose_cvt(p.W2T(), 128, 128, [=](int n, int k) { return w[(size_t)(n >> 6) * 8192 + (size_t)k * 64 + (n & 63)]; }); }
    { const float* w = p.w_up; transpose_cvt(p.WupT(), 512, 64, [=](int n, int k) { return w[(size_t)k * 512 + n]; }); }
    { const float* w = p.a_up; transpose_cvt(p.AupT(), 512, 64, [=](int n, int k) { return w[(size_t)k * 512 + n]; }); }
    for (int id = gt; id < 33 * CR; id += nt) p.zs0()[id] = id < CR ? (bf16_t)0 : f2bf(p.state_shift[id - CR]);
    for (int id = gt; id < MR * 64; id += nt) {
        const int row = id >> 6, c4 = id & 63;
        const float4 v = ((const float4*)(row < NP ? p.p_prompt + (size_t)row * 256 : p.p_sample + (size_t)(row - NP) * 256))[c4];
        uint2 w; w.x = pk2(v.x, v.y); w.y = pk2(v.z, v.w);
        *(uint2*)(p.pb() + (size_t)row * 256 + c4 * 4) = w;
    }
    for (int id = gt; id < 4104 * 32; id += nt) {
        const int pi = id >> 5, i = id & 31;
        const int pos = pi < 4096 ? pi : PAST + pi - 4096;
        const float inv = (float)exp(-(double)i * (9.210340371976184 / 32.0));
        const float ang = (float)pos * inv;
        const double x = (double)ang;
        const double k = rint(x * 0.15915494309189535);
        const double r = x - k * 6.283185307179586;
        float s, c; sincos_small(r, s, c);
        p.tabc()[id] = c; p.tabs()[id] = s;
    }
    for (int o = gw; o < 256; o += nw) {
        const int kvi = o >> 7, f = o & 127;
        float acc = 0.f;
        for (int jd = lane; jd < 2048; jd += 64) acc += p.cmp_pe[kvi * 2048 + jd] * p.cmp_w1[(size_t)kvi * 262144 + (size_t)jd * 128 + f];
        acc = wave_sum(acc);
        if (lane == 0) p.pt()[o] = acc + p.cmp_b1[o];
    }
    for (int id = gt; id < DB * 504 * 64; id += nt) {
        const int c4 = id & 63, j = (id >> 6) % 504, b = (id >> 6) / 504;
        ((float4*)(p.out + O_WIN_S))[((size_t)b * 512 + j) * 64 + c4] = ((const float4*)p.cache_win)[((size_t)b * 512 + j + 8) * 64 + c4];
    }
}
#define XB_TMO      128
#define XB_XCNT(j)  (256  + 64 * (j))
#define XB_XSUB(j)  (1280 + 64 * (j))
#define XB_XGEN(j)  (2304 + 64 * (j))
#define XB_TOP      3328
#define XB_TOPGEN   3392
#define XCD_BAR_WORDS 3456
#define XB_SPIN_CAP (1u << 18)

__device__ __forceinline__ unsigned xb_ld(unsigned* p)              { return __hip_atomic_load(p, __ATOMIC_RELAXED, __HIP_MEMORY_SCOPE_AGENT); }
__device__ __forceinline__ unsigned xb_add(unsigned* p, unsigned v) { return __hip_atomic_fetch_add(p, v, __ATOMIC_RELAXED, __HIP_MEMORY_SCOPE_AGENT); }
__device__ __forceinline__ unsigned xb_xcc_id() { return (unsigned)__builtin_amdgcn_s_getreg((3 << 11) | 20) & 0xFu; }
#define XB_SPIN(cond, bar) do { unsigned _sp = 0; while (cond) { __builtin_amdgcn_s_sleep(1); \
    if ((++_sp & 255u) == 0u) { if (xb_ld(&(bar)[XB_TMO])) break; if (_sp > XB_SPIN_CAP) { atomicAdd(&(bar)[XB_TMO], 1u); break; } } } } while (0)

struct XcdBarrier {
    unsigned* bar; unsigned x;
    volatile LAS unsigned* st;
};

__device__ __forceinline__ XcdBarrier xcd_barrier_post(unsigned* bar, volatile LAS unsigned* st) {
    XcdBarrier b; b.bar = bar; b.x = xb_xcc_id(); b.st = st;
    if (threadIdx.x == 0) (void)xb_add(&bar[XB_XCNT(b.x)], 1u);
    return b;
}
__device__ __forceinline__ void xcd_barrier_complete(unsigned* bar, unsigned x, unsigned& nloc, unsigned& nx) {
    const unsigned G = gridDim.x * gridDim.y * gridDim.z;
    unsigned sum, cnt, mine, sp = 0u;
    for (;;) {
        sum = 0u; cnt = 0u; mine = 0u;
#pragma unroll
        for (unsigned j = 0; j < 16; ++j) { const unsigned c = xb_ld(&bar[XB_XCNT(j)]); sum += c; cnt += (c > 0u) ? 1u : 0u; mine = (j == x) ? c : mine; }
        if (sum == G) break;
        __builtin_amdgcn_s_sleep(1);
        if ((++sp & 255u) == 0u) { if (xb_ld(&bar[XB_TMO])) break; if (sp > XB_SPIN_CAP) { atomicAdd(&bar[XB_TMO], 1u); break; } }
    }
    nloc = mine > 0u ? mine : 1u; nx = cnt > 0u ? cnt : 1u;
}

__device__ __forceinline__ void xcd_barrier(const XcdBarrier& b) {
    asm volatile("s_waitcnt vmcnt(0)" ::: "memory");
    __syncthreads();
    if (threadIdx.x == 0) {
        unsigned* bar = b.bar;
        __builtin_amdgcn_s_waitcnt(0);
        unsigned nloc = b.st[0], nx = b.st[1];
        if (nloc == 0u) { xcd_barrier_complete(bar, b.x, nloc, nx); b.st[0] = nloc; b.st[1] = nx; }
        const unsigned old = xb_add(&bar[XB_XSUB(b.x)], 1u);
        const unsigned gen = old / nloc;
        if (old + 1u == (gen + 1u) * nloc) {
            __builtin_amdgcn_fence(__ATOMIC_RELEASE, "agent");
            asm volatile("s_waitcnt vmcnt(0)" ::: "memory");
            const unsigned og = xb_add(&bar[XB_TOP], 1u);
            const unsigned tg = og / nx;
            if (og + 1u == (tg + 1u) * nx) xb_add(&bar[XB_TOPGEN], 1u);
            else XB_SPIN(xb_ld(&bar[XB_TOPGEN]) == tg, bar);
            __builtin_amdgcn_fence(__ATOMIC_ACQUIRE, "agent");
            xb_add(&bar[XB_XGEN(b.x)], 1u);
            asm volatile("s_waitcnt vmcnt(0)" ::: "memory");
        } else {
            XB_SPIN(xb_ld(&bar[XB_XGEN(b.x)]) == gen, bar);
            __builtin_amdgcn_fence(__ATOMIC_ACQUIRE, "agent");
            asm volatile("s_waitcnt vmcnt(0)" ::: "memory");
        }
    }
    __syncthreads();
}

using pg8::Unit;
typedef unsigned u32x2 __attribute__((ext_vector_type(2)));
typedef unsigned u32x4_t __attribute__((ext_vector_type(4)));
__device__ __forceinline__ f32x16 mfma32(bf16x8 a, bf16x8 b, f32x16 c) { return __builtin_amdgcn_mfma_f32_32x32x16_bf16(a, b, c, 0, 0, 0); }
__device__ __forceinline__ bf16x8 pack8(float a0, float a1, float a2, float a3, float a4, float a5, float a6, float a7) {
    union { uint4 u; bf16x8 v; } x; x.u.x = pk2(a0, a1); x.u.y = pk2(a2, a3); x.u.z = pk2(a4, a5); x.u.w = pk2(a6, a7); return x.v;
}
__device__ __forceinline__ f32x16 zero16() { f32x16 z; for (int i = 0; i < 16; ++i) z[i] = 0.f; return z; }


__device__ __forceinline__ void st_bf4(bf16_t* dst, f32x4 v) { uint2 w; w.x = pk2(v[0], v[1]); w.y = pk2(v[2], v[3]); *(uint2*)dst = w; }

constexpr float QSCALE = 0.125f * 1.4426950408889634f;
struct EpiIn {
    static constexpr bool PERM = false, AFTER_DRAIN = false;
    P p; int row0; int pn0;
    __device__ __forceinline__ void operator()(const f32x4 (&acc)[2][2][4][2], const Unit& u, int wr, int wc, int fr, int fq) const {
        const int pn = pn0 + u.pn;
#pragma unroll
        for (int ai = 0; ai < 2; ++ai)
#pragma unroll
            for (int m = 0; m < 4; ++m) {
                const int row = row0 + u.pm * 256 + ai * 128 + wr * 64 + m * 16 + fr;
                if (pn < 5) {
                    const int pi = row < NP ? (row & (SEQ - 1)) : 4096 + ((row - NP) & 7);
                    const int d0 = 16 * (wc & 1) + 4 * fq;
                    const f32x4 cs = *(const f32x4*)(p.tabc() + pi * 32 + d0), sn = *(const f32x4*)(p.tabs() + pi * 32 + d0);
#pragma unroll
                    for (int bj = 0; bj < 2; ++bj) {
                        const f32x4 x1 = acc[ai][bj][m][0], x2 = acc[ai][bj][m][1];
                        if (pn < 2) {
                            const int head = pn * 4 + bj * 2 + (wc >> 1);
                            const f32x4 o1 = (x1 * cs - x2 * sn) * QSCALE, o2 = (x2 * cs + x1 * sn) * QSCALE;
                            bf16_t* q = p.qb() + (size_t)row * 512 + head * 64 + d0;
                            st_bf4(q, o1); st_bf4(q + 32, o2);
                        } else {
                            const int br = pn - 2, g = wc >> 1;
                            f32x4 o1, o2;
                            if (bj == 0) { o1 = x1 * cs - x2 * sn; o2 = x2 * cs + x1 * sn; } else { o1 = x1; o2 = x2; }
                            float* dst = nullptr;
                            if (row < NP) {
                                if (br == 0) dst = p.out + O_CMP_P + (size_t)row * 256;
                                else if (br == 1) dst = p.out + O_SEL_P + (size_t)row * 256;
                                else { const int s = row & (SEQ - 1); if (s >= SEQ - 512) dst = p.out + O_WIN_P + ((size_t)(row >> 12) * 512 + (s - (SEQ - 512))) * 256; }
                            } else {
                                const int rs = row - NP;
                                if (br == 0) dst = p.out + O_CMP_S + (size_t)rs * 256;
                                else if (br == 1) dst = p.out + O_SEL_S + (size_t)rs * 256;
                                else dst = p.out + O_WIN_S + ((size_t)(rs >> 3) * 512 + 504 + (rs & 7)) * 256;
                            }
                            if (dst) { dst += bj * 128 + g * 64 + d0; *(f32x4*)dst = o1; *(f32x4*)(dst + 32) = o2; }
                            if (row < NP) {
                                const int b = row >> 12, s = row & (SEQ - 1);
                                if (bj == 0) {
                                    bf16_t* k = p.kb() + ((size_t)((br * NB + b) * 2 + g) * SEQ + s) * 64 + d0;
                                    st_bf4(k, o1); st_bf4(k + 32, o2);
                                } else if (br == 0) {
                                    bf16_t* v = p.vcr() + ((size_t)(b * 2 + g) * SEQ + s) * 64 + d0;
                                    st_bf4(v, o1); st_bf4(v + 32, o2);
                                } else {
                                    bf16_t* v = p.vT() + ((size_t)(((br - 1) * NB + b) * 2 + g) * 64 + d0) * SEQ + s;
#pragma unroll
                                    for (int e = 0; e < 4; ++e) { v[(size_t)e * SEQ] = f2bf(o1[e]); v[(size_t)(32 + e) * SEQ] = f2bf(o2[e]); }
                                }
                            }
                        }
                    }
                } else {
#pragma unroll
                    for (int bj = 0; bj < 2; ++bj) {
                        const int c = bj * 128 + wc * 32 + fq * 8;
                        const f32x4 v0 = acc[ai][bj][m][0], v1 = acc[ai][bj][m][1];
                        auto st8 = [&](bf16_t* dst, const f32x4& a, const f32x4& b) { uint4 w; w.x = pk2(a[0], a[1]); w.y = pk2(a[2], a[3]); w.z = pk2(b[0], b[1]); w.w = pk2(b[2], b[3]); *(uint4*)dst = w; };
                        if (pn < 7 || (pn >= 14 && pn < 16)) {
                            f32x4 o0, o1; for (int e = 0; e < 4; ++e) { o0[e] = silu_fast(v0[e]); o1[e] = silu_fast(v1[e]); }
                            st8((pn < 7 ? p.ag() + (size_t)row * 512 + (pn - 5) * 256 : p.rg() + (size_t)row * 512 + (pn - 14) * 256) + c, o0, o1);
                        } else if (pn < 13) {
                            st8(p.rz() + (size_t)row * CR + (pn - 7) * 256 + c, v0, v1);
                        } else if (pn == 13) {
                            if (c < 128) st8(p.rz() + (size_t)row * CR + 1536 + c, v0, v1);
                            else if (c < 152) { f32x4 o0, o1; for (int e = 0; e < 4; ++e) { o0[e] = sigmoid_fast(v0[e]); o1[e] = sigmoid_fast(v1[e]); }
                                *(f32x4*)(p.gates() + (size_t)row * 32 + (c - 128)) = o0; *(f32x4*)(p.gates() + (size_t)row * 32 + (c - 128) + 4) = o1; }
                        } else {
                            f32x4 o0, o1; for (int e = 0; e < 4; ++e) { o0[e] = sigmoid_fast(v0[e]); o1[e] = sigmoid_fast(v1[e]); }
                            st8(p.mg() + (size_t)row * 2048 + (pn - 16) * 256 + c, o0, o1);
                        }
                    }
                }
            }
    }
};

struct EpiPlain {
    static constexpr bool PERM = false, AFTER_DRAIN = false;
    float* C; int ldc; int pad_;
    __device__ __forceinline__ void quad(int row, int c, f32x4 v) const { *(f32x4*)(C + (size_t)row * ldc + c) = v; }
    __device__ __forceinline__ void operator()(const f32x4 (&acc)[2][2][4][2], const Unit& u, int wr, int wc, int fr, int fq) const {
#pragma unroll
        for (int ai = 0; ai < 2; ++ai)
#pragma unroll
            for (int m = 0; m < 4; ++m) {
                float* rowp = C + (size_t)(u.pm * 256 + ai * 128 + wr * 64 + m * 16 + fr) * ldc + u.pn * 256 + wc * 32 + 8 * fq;
#pragma unroll
                for (int bj = 0; bj < 2; ++bj)
#pragma unroll
                    for (int n = 0; n < 2; ++n) *(f32x4*)(rowp + bj * 128 + n * 4) = acc[ai][bj][m][n];
            }
    }
};


struct EpiPlainBf {
    static constexpr bool PERM = false, AFTER_DRAIN = false;
    bf16_t* C; int ldc; int pad_;
    __device__ __forceinline__ void operator()(const f32x4 (&acc)[2][2][4][2], const Unit& u, int wr, int wc, int fr, int fq) const {
#pragma unroll
        for (int ai = 0; ai < 2; ++ai)
#pragma unroll
            for (int m = 0; m < 4; ++m) {
                bf16_t* rowp = C + (size_t)(u.pm * 256 + ai * 128 + wr * 64 + m * 16 + fr) * ldc + u.pn * 256 + wc * 32 + 4 * fq;
#pragma unroll
                for (int bj = 0; bj < 2; ++bj)
#pragma unroll
                    for (int n = 0; n < 2; ++n) st_bf4(rowp + bj * 128 + n * 16, acc[ai][bj][m][n]);
            }
    }
};

struct EpiYa {
    static constexpr bool PERM = false, AFTER_DRAIN = false;
    P p;
    __device__ __forceinline__ void quad(int row, int c, f32x4 v) const {
        const uint2 gw = *(const uint2*)(p.mg() + (size_t)row * 2048 + c);
        f32x4 g; g[0] = __uint_as_float(gw.x << 16); g[1] = __uint_as_float(gw.x & 0xffff0000u); g[2] = __uint_as_float(gw.y << 16); g[3] = __uint_as_float(gw.y & 0xffff0000u);
        *(f32x4*)(p.tmp() + (size_t)row * DM + c) = g * v;
    }
    __device__ __forceinline__ void operator()(const f32x4 (&acc)[2][2][4][2], const Unit& u, int wr, int wc, int fr, int fq) const {
#pragma unroll
        for (int ai = 0; ai < 2; ++ai)
#pragma unroll
            for (int m = 0; m < 4; ++m) {
                const int row = u.pm * 256 + ai * 128 + wr * 64 + m * 16 + fr;
#pragma unroll
                for (int bj = 0; bj < 2; ++bj)
#pragma unroll
                    for (int n = 0; n < 2; ++n) {
                        const int c = u.pn * 256 + bj * 128 + wc * 32 + fq * 8 + n * 4;
                        const uint2 gw = *(const uint2*)(p.mg() + (size_t)row * 2048 + c);
                        f32x4 g; g[0] = __uint_as_float(gw.x << 16); g[1] = __uint_as_float(gw.x & 0xffff0000u); g[2] = __uint_as_float(gw.y << 16); g[3] = __uint_as_float(gw.y & 0xffff0000u);
                        *(f32x4*)(p.tmp() + (size_t)row * DM + c) = g * acc[ai][bj][m][n];
                    }
            }
    }
};
struct EpiYb {
    static constexpr bool PERM = false, AFTER_DRAIN = false;
    P p;
    __device__ __forceinline__ void quad(int row, int c, f32x4 v) const {
        const uint2 gw = *(const uint2*)(p.mg() + (size_t)row * 2048 + 1024 + c);
        f32x4 g; g[0] = __uint_as_float(gw.x << 16); g[1] = __uint_as_float(gw.x & 0xffff0000u); g[2] = __uint_as_float(gw.y << 16); g[3] = __uint_as_float(gw.y & 0xffff0000u);
        st_bf4(p.mb() + (size_t)row * DM + c, *(const f32x4*)(p.tmp() + (size_t)row * DM + c) + g * v);
    }
    __device__ __forceinline__ void operator()(const f32x4 (&acc)[2][2][4][2], const Unit& u, int wr, int wc, int fr, int fq) const {
#pragma unroll
        for (int ai = 0; ai < 2; ++ai)
#pragma unroll
            for (int m = 0; m < 4; ++m) {
                const int row = u.pm * 256 + ai * 128 + wr * 64 + m * 16 + fr;
#pragma unroll
                for (int bj = 0; bj < 2; ++bj)
#pragma unroll
                    for (int n = 0; n < 2; ++n) {
                        const int c = u.pn * 256 + bj * 128 + wc * 32 + fq * 8 + n * 4;
                        const uint2 gw = *(const uint2*)(p.mg() + (size_t)row * 2048 + 1024 + c);
                        f32x4 g; g[0] = __uint_as_float(gw.x << 16); g[1] = __uint_as_float(gw.x & 0xffff0000u); g[2] = __uint_as_float(gw.y << 16); g[3] = __uint_as_float(gw.y & 0xffff0000u);
                        const f32x4 t = *(const f32x4*)(p.tmp() + (size_t)row * DM + c);
                        st_bf4(p.mb() + (size_t)row * DM + c, t + g * acc[ai][bj][m][n]);
                    }
            }
    }
};
struct EpiOut {
    static constexpr bool PERM = false, AFTER_DRAIN = false;
    P p;
    __device__ __forceinline__ void quad(int row, int c, f32x4 a) const {
        const float* xr = p.x_sample + (size_t)(row - NP) * DM;
        const f32x4 v = *(const f32x4*)(xr + c) + a;
        *(f32x4*)(p.x1() + (size_t)row * DM + c) = v;
        st_bf4(p.xg() + (size_t)row * DM + c, v * *(const f32x4*)(p.ple_g + c));
        atomicAdd(p.ss_s() + (row - NP), v[0] * v[0] + v[1] * v[1] + v[2] * v[2] + v[3] * v[3]);
    }
    __device__ __forceinline__ void operator()(const f32x4 (&acc)[2][2][4][2], const Unit& u, int wr, int wc, int fr, int fq) const {
#pragma unroll
        for (int ai = 0; ai < 2; ++ai)
#pragma unroll
            for (int m = 0; m < 4; ++m) {
                const int row = u.pm * 256 + ai * 128 + wr * 64 + m * 16 + fr;
                const float* xr = row < NP ? p.x_prompt + (size_t)row * DM : p.x_sample + (size_t)(row - NP) * DM;
                float ss = 0.f;
#pragma unroll
                for (int bj = 0; bj < 2; ++bj)
#pragma unroll
                    for (int n = 0; n < 2; ++n) {
                        const int c = u.pn * 256 + bj * 128 + wc * 32 + fq * 8 + n * 4;
                        const f32x4 v = *(const f32x4*)(xr + c) + acc[ai][bj][m][n];
                        *(f32x4*)(p.x1() + (size_t)row * DM + c) = v;
                        ss += v[0] * v[0] + v[1] * v[1] + v[2] * v[2] + v[3] * v[3];
                        st_bf4(p.xg() + (size_t)row * DM + c, v * *(const f32x4*)(p.ple_g + c));
                    }
                ss += __shfl_xor(ss, 16); ss += __shfl_xor(ss, 32);
                if (fq == 0) p.ss1()[(size_t)row * 16 + u.pn * 4 + wc] = ss;
            }
    }
};
struct EpiGate {
    static constexpr bool PERM = false, AFTER_DRAIN = false;
    P p;
    __device__ __forceinline__ void quad(int row, int c, f32x4 acc) const {
        const float rstd = rsqrtf(p.ss_s()[row - NP] * (1.0f / DM) + 1e-6f);
        const f32x4 a = acc * rstd;
        f32x4 g; for (int e = 0; e < 4; ++e) g[e] = sigmoidf_(a[e]);
        float* ppp = p.pp() + (size_t)row * DM + c;
        *(f32x4*)ppp = *(const f32x4*)(p.x1() + (size_t)row * DM + c) + g * *(const f32x4*)ppp;
    }
    __device__ __forceinline__ void operator()(const f32x4 (&acc)[2][2][4][2], const Unit& u, int wr, int wc, int fr, int fq) const {
#pragma unroll
        for (int ai = 0; ai < 2; ++ai)
#pragma unroll
            for (int m = 0; m < 4; ++m) {
                const int row = u.pm * 256 + ai * 128 + wr * 64 + m * 16 + fr;
                float ss = 0.f;
#pragma unroll
                for (int i = 0; i < 4; ++i) { const f32x4 t = *(const f32x4*)(p.ss1() + (size_t)row * 16 + i * 4); ss += (t[0] + t[1]) + (t[2] + t[3]); }
                const float rstd = rsqrtf(ss * (1.0f / DM) + 1e-6f);
#pragma unroll
                for (int bj = 0; bj < 2; ++bj)
#pragma unroll
                    for (int n = 0; n < 2; ++n) {
                        const int c = u.pn * 256 + bj * 128 + wc * 32 + fq * 8 + n * 4;
                        const f32x4 a = acc[ai][bj][m][n] * rstd;
                        f32x4 g; for (int e = 0; e < 4; ++e) g[e] = sigmoidf_(a[e]);
                        float* ppp = p.pp() + (size_t)row * DM + c;
                        *(f32x4*)ppp = *(const f32x4*)(p.x1() + (size_t)row * DM + c) + g * *(const f32x4*)ppp;
                    }
            }
    }
};

__device__ __forceinline__ void ph_final(const P& p) {
    const int tid = threadIdx.x, lane = tid & 63, wid = tid >> 6;
    for (int row = blockIdx.x * 8 + wid; row < MR; row += gridDim.x * 8) {
        const float4* src = (const float4*)(p.pp() + (size_t)row * DM);
        float4 v[4]; float ss = 0.f;
#pragma unroll
        for (int i = 0; i < 4; ++i) { v[i] = src[lane + 64 * i]; ss += v[i].x * v[i].x + v[i].y * v[i].y + v[i].z * v[i].z + v[i].w * v[i].w; }
        ss = wave_sum(ss);
        const float rstd = rsqrtf(ss * (1.0f / DM) + 1e-6f);
        float4* dst = (float4*)(p.out + (row < NP ? O_Y_P + (size_t)row * DM : O_Y_S + (size_t)(row - NP) * DM));
#pragma unroll
        for (int i = 0; i < 4; ++i) {
            const float4 g = ((const float4*)p.final_g)[lane + 64 * i];
            float4 o; o.x = v[i].x * rstd * g.x; o.y = v[i].y * rstd * g.y; o.z = v[i].z * rstd * g.z; o.w = v[i].w * rstd * g.w;
            dst[lane + 64 * i] = o;
        }
    }
}

typedef float f32x4v __attribute__((ext_vector_type(4)));
template <class Epi> __device__ __forceinline__ void small_gemm(const bf16_t* A, const bf16_t* Bt, int K, const Epi& E) {
    const int tid = threadIdx.x, lane = tid & 63, wid = tid >> 6, r16 = lane & 15, q4 = lane >> 4;
    for (int tile = blockIdx.x * 8 + wid; tile < 16 * 64; tile += gridDim.x * 8) {
        const int rt = tile & 15, ct = tile >> 4;
        const bf16_t* ap = A + (size_t)(NP + rt * 16 + r16) * K + 8 * q4;
        const bf16_t* bp = Bt + (size_t)(ct * 16 + r16) * K + 8 * q4;
        f32x4 acc = {0.f, 0.f, 0.f, 0.f};
#pragma unroll 1
        for (int k0 = 0; k0 < K; k0 += 256) {
            bf16x8 af[8], bf[8];
#pragma unroll
            for (int i = 0; i < 8; ++i) { af[i] = *(const bf16x8*)(ap + k0 + 32 * i); bf[i] = *(const bf16x8*)(bp + k0 + 32 * i); }
#pragma unroll
            for (int i = 0; i < 8; ++i) acc = __builtin_amdgcn_mfma_f32_16x16x32_bf16(bf[i], af[i], acc, 0, 0, 0);
        }
        E.quad(NP + rt * 16 + r16, (ct >> 1) * 32 + 8 * q4 + 4 * (ct & 1), acc);
    }
}

__device__ __forceinline__ f32x4 ld_bf4c(const bf16_t* q) { const uint2 w = *(const uint2*)q; f32x4 v; v[0] = __uint_as_float(w.x << 16); v[1] = __uint_as_float(w.x & 0xffff0000u); v[2] = __uint_as_float(w.y << 16); v[3] = __uint_as_float(w.y & 0xffff0000u); return v; }
__device__ __forceinline__ void compress2_tile(const P& p, const bf16_t* LH, int nbg, int nrows, int nblk, bf16_t* kc, bf16_t* vcT, int kvi, int bg, int tile, int lane, LAS unsigned char* wlds) {
    const int col = lane & 31, hb = lane >> 5;
    {
        const int i = tile * 32 + col;
        const bool live = i < nblk;
        const bf16_t* lbase = LH + ((size_t)kvi * nbg * nrows + (size_t)bg * nrows) * 256;
        const bf16_t* w2t = p.W2T() + (size_t)kvi * 64 * 128;
        LAS bf16_t* hs = (LAS bf16_t*)wlds;
        {
            const int rq = lane >> 4, c8 = lane & 15;
            const f32x4 pa = *(const f32x4*)(p.pt() + kvi * 128 + c8 * 8), pb = *(const f32x4*)(p.pt() + kvi * 128 + c8 * 8 + 4);
#pragma unroll
            for (int it = 0; it < 8; ++it) {
                const int rr = 4 * it + rq, gi = tile * 32 + rr;
                const bf16_t* rp = lbase + (size_t)(gi < nblk ? gi : 0) * 256 + c8 * 8;
                const uint4 lo = *(const uint4*)rp, hi = *(const uint4*)(rp + 256 + 128);
                float hv[8];
                const unsigned lw[4] = {lo.x, lo.y, lo.z, lo.w}, hw[4] = {hi.x, hi.y, hi.z, hi.w};
#pragma unroll
                for (int e = 0; e < 4; ++e) {
                    const float pe0 = e < 2 ? pa[2 * e] : pb[2 * e - 4], pe1 = e < 2 ? pa[2 * e + 1] : pb[2 * e - 3];
                    hv[2 * e] = siluf_(__uint_as_float(lw[e] << 16) + __uint_as_float(hw[e] << 16) + pe0);
                    hv[2 * e + 1] = siluf_(__uint_as_float(lw[e] & 0xffff0000u) + __uint_as_float(hw[e] & 0xffff0000u) + pe1);
                }
                *(LAS bf16x8*)(hs + rr * 136 + c8 * 8) = pack8(hv[0], hv[1], hv[2], hv[3], hv[4], hv[5], hv[6], hv[7]);
            }
        }
        WAVE_SYNC();
        f32x16 acc[2]; acc[0] = zero16(); acc[1] = zero16();
#pragma unroll
        for (int ks = 0; ks < 8; ++ks) {
            const int f = 16 * ks + 8 * hb;
            const bf16x8 hf = *(LAS const bf16x8*)(hs + col * 136 + f);
#pragma unroll
            for (int dt = 0; dt < 2; ++dt) {
                const bf16x8 wf = *(const bf16x8*)(w2t + (size_t)(32 * dt + col) * 128 + f);
                acc[dt] = (kvi == 0) ? mfma32(wf, hf, acc[dt]) : mfma32(hf, wf, acc[dt]);
            }
        }
        WAVE_SYNC();
        if (kvi == 0) {
            bf16_t* dst = kc + ((size_t)bg * nrows + i) * 64;
#pragma unroll
            for (int dt = 0; dt < 2; ++dt)
#pragma unroll
                for (int i4 = 0; i4 < 4; ++i4) {
                    const int d = 32 * dt + 8 * i4 + 4 * hb;
                    const f32x4 b2 = *(const f32x4*)(p.cmp_b2 + d);
                    f32x4 v; for (int e = 0; e < 4; ++e) v[e] = live ? acc[dt][4 * i4 + e] + b2[e] : 0.f;
                    st_bf4(dst + d, v);
                }
        } else {
#pragma unroll
            for (int dt = 0; dt < 2; ++dt) {
                const int d = 32 * dt + col;
                const float b2 = p.cmp_b2[64 + d];
                bf16_t* dst = vcT + ((size_t)bg * 64 + d) * nrows + tile * 32;
#pragma unroll
                for (int i4 = 0; i4 < 4; ++i4) {
                    const int r = 8 * i4 + 4 * hb;
                    f32x4 v; for (int e = 0; e < 4; ++e) v[e] = (tile * 32 + r + e) < nblk ? acc[dt][4 * i4 + e] + b2 : 0.f;
                    st_bf4(dst + r, v);
                }
            }
        }
    }
}

__device__ __forceinline__ void ph_compress2(const P& p, const bf16_t* LH, int nbg, int nrows, int nblk, bf16_t* kc, bf16_t* vcT, LAS unsigned char* lds) {
    const int tid = threadIdx.x, lane = tid & 63, wid = tid >> 6;
    const int ntile = nrows >> 5, total = 2 * nbg * ntile;
    for (int it = blockIdx.x * 8 + wid; it < total; it += gridDim.x * 8)
        compress2_tile(p, LH, nbg, nrows, nblk, kc, vcT, it / (ntile * nbg), (it / ntile) % nbg, it % ntile, lane, lds + wid * 8960);
}


__device__ __forceinline__ float dpp_row_sum16(float v) {
    v += __builtin_bit_cast(float, __builtin_amdgcn_mov_dpp(__builtin_bit_cast(int, v), 0xB1, 0xF, 0xF, true));
    v += __builtin_bit_cast(float, __builtin_amdgcn_mov_dpp(__builtin_bit_cast(int, v), 0x4E, 0xF, 0xF, true));
    v += __builtin_bit_cast(float, __builtin_amdgcn_mov_dpp(__builtin_bit_cast(int, v), 0x141, 0xF, 0xF, true));
    v += __builtin_bit_cast(float, __builtin_amdgcn_mov_dpp(__builtin_bit_cast(int, v), 0x140, 0xF, 0xF, true));
    return v;
}
__device__ __forceinline__ float tanh_fast(float x) { const float e = __expf(2.0f * x); return 1.0f - 2.0f / (e + 1.0f); }
__device__ __forceinline__ float half_sum32(float v) { return xsum16(dpp_row_sum16(v)); }
__device__ __forceinline__ const bf16_t* rwkv_prev_row(const P& p, int row) {
    if (row < NP) return (row & (SEQ - 1)) == 0 ? p.zs0() : p.rz() + (size_t)(row - 1) * CR;
    const int rs = row - NP;
    return (rs & 7) == 0 ? p.zs0() + (size_t)(1 + (rs >> 3)) * CR : p.rz() + (size_t)(row - 1) * CR;
}
__device__ __forceinline__ f32x4 ld_bf4(const bf16_t* q) { const uint2 w = *(const uint2*)q; f32x4 v; v[0] = __uint_as_float(w.x << 16); v[1] = __uint_as_float(w.x & 0xffff0000u); v[2] = __uint_as_float(w.y << 16); v[3] = __uint_as_float(w.y & 0xffff0000u); return v; }
__device__ __forceinline__ void ph_rwkv_prep(const P& p) {
    const int tid = threadIdx.x, lane = tid & 63, wid = tid >> 6, col = lane & 31, hb = lane >> 5;
    const int gw = blockIdx.x * 8 + wid, nw = gridDim.x * 8;
    for (int it = gw; it < NB + DB; it += nw) {
        const int row = it < NB ? it * SEQ + SEQ - 1 : NP + (it - NB) * 8 + 7;
        float* so = it < NB ? p.out + O_SH_P + (size_t)it * CR : p.out + O_SH_S + (size_t)(it - NB) * CR;
        const bf16_t* z = p.rz() + (size_t)row * CR;
        for (int i = lane; i < CR; i += 64) so[i] = bf2f(z[i]);
    }
    for (int rnd = 0; rnd < 3; ++rnd) {
        int it;
        if (rnd < 2) it = rnd * nw + gw; else { if (wid != 0 || (int)blockIdx.x >= 64) break; it = 2 * nw + (int)blockIdx.x; }
        if (it >= (MR / 32) * 8) break;
        const int h = it & 7, r0 = (it >> 3) * 32;
        bf16x8 Aw[4], Aa[4];
        {
            const int row = r0 + col;
            const bf16_t* z = p.rz() + (size_t)row * CR;
            const bf16_t* pv = rwkv_prev_row(p, row);
#pragma unroll
            for (int ks = 0; ks < 4; ++ks) {
                const int j0 = 16 * ks + 8 * hb;
                float tw[8], ta[8];
#pragma unroll
                for (int q = 0; q < 2; ++q) {
                    const f32x4 zw = ld_bf4(z + 1536 + j0 + 4 * q), za = ld_bf4(z + 1600 + j0 + 4 * q);
                    const f32x4 pw = ld_bf4(pv + 1536 + j0 + 4 * q), pa = ld_bf4(pv + 1600 + j0 + 4 * q);
                    const f32x4 mw = *(const f32x4*)(p.mu + 1536 + j0 + 4 * q), ma = *(const f32x4*)(p.mu + 1600 + j0 + 4 * q);
#pragma unroll
                    for (int e = 0; e < 4; ++e) { tw[4 * q + e] = tanh_fast(zw[e] + (pw[e] - zw[e]) * mw[e]); ta[4 * q + e] = za[e] + (pa[e] - za[e]) * ma[e]; }
                }
                Aw[ks] = pack8(tw[0], tw[1], tw[2], tw[3], tw[4], tw[5], tw[6], tw[7]);
                Aa[ks] = pack8(ta[0], ta[1], ta[2], ta[3], ta[4], ta[5], ta[6], ta[7]);
            }
        }
        f32x16 accw[2], acca[2];
#pragma unroll
        for (int ct = 0; ct < 2; ++ct) {
            accw[ct] = zero16(); acca[ct] = zero16();
            const size_t wo = (size_t)(h * 64 + 32 * ct + col) * 64 + 8 * hb;
#pragma unroll
            for (int ks = 0; ks < 4; ++ks) {
                accw[ct] = mfma32(Aw[ks], *(const bf16x8*)(p.WupT() + wo + 16 * ks), accw[ct]);
                acca[ct] = mfma32(Aa[ks], *(const bf16x8*)(p.AupT() + wo + 16 * ks), acca[ct]);
            }
        }
        float w0v[2], a0v[2], kkv[2], kav[2], rkv[2], mur[2], muk[2], muv[2];
#pragma unroll
        for (int ct = 0; ct < 2; ++ct) {
            const int c = h * 64 + 32 * ct + col;
            w0v[ct] = p.w0[c]; a0v[ct] = p.a0[c]; kkv[ct] = p.k_k[c]; kav[ct] = p.k_a[c]; rkv[ct] = p.r_k[c];
            mur[ct] = p.mu[c]; muk[ct] = p.mu[512 + c]; muv[ct] = p.mu[1024 + c];
        }
#pragma unroll
        for (int hf = 0; hf < 2; ++hf) {
        float zz[8][2][3], pz[2][2][3];
#pragma unroll
        for (int ii = 0; ii < 8; ++ii) {
            const int i = 8 * hf + ii;
            const bf16_t* z = p.rz() + (size_t)(r0 + (i & 3) + 8 * (i >> 2) + 4 * hb) * CR + h * 64 + col;
#pragma unroll
            for (int ct = 0; ct < 2; ++ct) { zz[ii][ct][0] = bf2f(z[32 * ct]); zz[ii][ct][1] = bf2f(z[512 + 32 * ct]); zz[ii][ct][2] = bf2f(z[1024 + 32 * ct]); }
        }
#pragma unroll
        for (int g2 = 0; g2 < 2; ++g2) {
            const bf16_t* pv = rwkv_prev_row(p, r0 + 8 * (2 * hf + g2) + 4 * hb) + h * 64 + col;
#pragma unroll
            for (int ct = 0; ct < 2; ++ct) { pz[g2][ct][0] = bf2f(pv[32 * ct]); pz[g2][ct][1] = bf2f(pv[512 + 32 * ct]); pz[g2][ct][2] = bf2f(pv[1024 + 32 * ct]); }
        }
#pragma unroll
        for (int ii = 0; ii < 8; ++ii) {
            const int i = 8 * hf + ii;
            const int row = r0 + (i & 3) + 8 * (i >> 2) + 4 * hb;
            float zr[2], zk[2], zv[2], dec[2], av[2], kkr[2], km[2];
            float n2 = 0.f, bon = 0.f;
#pragma unroll
            for (int ct = 0; ct < 2; ++ct) {
                const float z0 = zz[ii][ct][0], z1 = zz[ii][ct][1], z2 = zz[ii][ct][2];
                const int ip = ii > 0 ? ii - 1 : 0;
                const float p0 = (i & 3) ? zz[ip][ct][0] : pz[ii >> 2][ct][0], p1 = (i & 3) ? zz[ip][ct][1] : pz[ii >> 2][ct][1], p2 = (i & 3) ? zz[ip][ct][2] : pz[ii >> 2][ct][2];
                zr[ct] = z0 + (p0 - z0) * mur[ct]; zk[ct] = z1 + (p1 - z1) * muk[ct]; zv[ct] = z2 + (p2 - z2) * muv[ct];
                const float nx = -(w0v[ct] + accw[ct][i]);
                const float sp = fmaxf(nx, 0.f) + __logf(1.0f + __expf(-fabsf(nx)));
                dec[ct] = __expf(-__expf(-sp - 0.5f));
                av[ct] = sigmoidf_(a0v[ct] + acca[ct][i]);
                kkr[ct] = zk[ct] * kkv[ct];
                km[ct] = zk[ct] * (1.0f + (av[ct] - 1.0f) * kav[ct]);
                n2 += kkr[ct] * kkr[ct];
                bon += zr[ct] * km[ct] * rkv[ct];
            }
            n2 = half_sum32(n2); bon = half_sum32(bon);
            const float rn = 1.0f / fmaxf(sqrtf(n2), 1e-12f);
            unsigned char* o = p.rw6() + ((size_t)row * 8 + h) * RW6_STRIDE;
#pragma unroll
            for (int ct = 0; ct < 2; ++ct) {
                const float kk = kkr[ct] * rn;
                const int cl = 32 * ct + col;
                ((float*)o)[cl] = dec[ct];
                bf16_t* ob = (bf16_t*)(o + 256) + cl;
                ob[0] = f2bf(zr[ct]); ob[64] = f2bf(km[ct]); ob[128] = f2bf(zv[ct]); ob[192] = f2bf(kk); ob[256] = f2bf(kk * av[ct]);
            }
            if (col == 0) p.bonus()[(size_t)row * 8 + h] = bon;
        }
        }
    }
}

typedef float f32x2 __attribute__((ext_vector_type(2)));
__device__ __forceinline__ float dpp_row_sum(float v) {
    v += __builtin_bit_cast(float, __builtin_amdgcn_mov_dpp(__builtin_bit_cast(int, v), 0xB1, 0xF, 0xF, true));
    v += __builtin_bit_cast(float, __builtin_amdgcn_mov_dpp(__builtin_bit_cast(int, v), 0x4E, 0xF, 0xF, true));
    v += __builtin_bit_cast(float, __builtin_amdgcn_mov_dpp(__builtin_bit_cast(int, v), 0x141, 0xF, 0xF, true));
    v += __builtin_bit_cast(float, __builtin_amdgcn_mov_dpp(__builtin_bit_cast(int, v), 0x140, 0xF, 0xF, true));
    return v;
}
constexpr int SCAN_TC = 32;
template <int NROWS>
__device__ __forceinline__ void scan_item(const P& p, LAS float* lds, int row0, int T, int h, int half, const float* s0, float* sout) {
    const int tid = threadIdx.x, w = tid >> 6, lane = tid & 63, rl = lane >> 4, kq = lane & 15;
    const bool act = w * 4 < NROWS;
    const int vrow = half * NROWS + (act ? w * 4 : 0) + rl;
    f32x4 S;
    if (s0) S = *(const f32x4*)(s0 + vrow * 64 + kq * 4); else { S[0] = 0.f; S[1] = 0.f; S[2] = 0.f; S[3] = 0.f; }
    const unsigned char* src = p.rw6() + ((size_t)row0 * 8 + h) * RW6_STRIDE;
    const int nchunk = (T + SCAN_TC - 1) / SCAN_TC;
    u32x4_t stg[4];
    int ss[4], sc[4], sl[4];
#pragma unroll
    for (int i = 0; i < 4; ++i) {
        const int idx = i * 512 + tid; ss[i] = idx / 56; sc[i] = idx % 56;
        const int cb = sc[i] - 16, q = cb >> 3;
        sl[i] = sc[i] < 16 ? 64 + 4 * sc[i] : (q == 0 ? 0 : 64 + 64 * q) + 8 * (cb & 7);
    }
    auto put = [&](LAS float* b, int i) {
        LAS float* d = b + ss[i] * 384 + sl[i];
        if (sc[i] < 16) *(LAS u32x4_t*)d = stg[i];
        else {
            f32x4 lo, hi;
            lo[0] = __uint_as_float(stg[i][0] << 16); lo[1] = __uint_as_float(stg[i][0] & 0xffff0000u); lo[2] = __uint_as_float(stg[i][1] << 16); lo[3] = __uint_as_float(stg[i][1] & 0xffff0000u);
            hi[0] = __uint_as_float(stg[i][2] << 16); hi[1] = __uint_as_float(stg[i][2] & 0xffff0000u); hi[2] = __uint_as_float(stg[i][3] << 16); hi[3] = __uint_as_float(stg[i][3] & 0xffff0000u);
            *(LAS f32x4*)d = lo; *(LAS f32x4*)(d + 4) = hi;
        }
    };
    {
        const int ns = T < SCAN_TC ? T : SCAN_TC;
#pragma unroll
        for (int i = 0; i < 4; ++i) if (ss[i] < ns) { stg[i] = *(const u32x4_t*)(src + (size_t)ss[i] * (8 * RW6_STRIDE) + sc[i] * 16); put(lds, i); }
    }
    __syncthreads();
    for (int c = 0; c < nchunk; ++c) {
        const int t0 = c * SCAN_TC;
        const int ns = (T - t0) < SCAN_TC ? (T - t0) : SCAN_TC;
        const bool more = (c + 1) < nchunk;
        const int nns = more ? ((T - t0 - SCAN_TC) < SCAN_TC ? (T - t0 - SCAN_TC) : SCAN_TC) : 0;
        if (more) {
#pragma unroll
            for (int i = 0; i < 4; ++i) if (ss[i] < nns) stg[i] = *(const u32x4_t*)(src + (size_t)(t0 + SCAN_TC + ss[i]) * (8 * RW6_STRIDE) + sc[i] * 16);
        }
        LAS const float* buf = lds + (c & 1) * (SCAN_TC * 384);
        float* yo = p.ybuf() + (size_t)(row0 + t0) * 512 + h * 64 + vrow;
        if (act)
#pragma unroll 4
        for (int s = 0; s < ns; ++s) {
            LAS const float* bs = buf + s * 384 + kq * 4;
            const f32x4 r = *(LAS const f32x4*)(bs), d = *(LAS const f32x4*)(bs + 64), km = *(LAS const f32x4*)(bs + 128),
                        kk = *(LAS const f32x4*)(bs + 256), ka = *(LAS const f32x4*)(bs + 320);
            const float vv = buf[s * 384 + 192 + vrow];
            const f32x4 t1 = S * kk;
            float sa = dpp_row_sum((t1[0] + t1[1]) + (t1[2] + t1[3]));
            sa = -sa;
            S = S * d + ka * sa + km * vv;
            const f32x4 t2 = S * r;
            const float y = dpp_row_sum((t2[0] + t2[1]) + (t2[2] + t2[3]));
            if (kq == 0) yo[(size_t)s * 512] = y;
        }
        if (more) {
            LAS float* nb = lds + ((c + 1) & 1) * (SCAN_TC * 384);
#pragma unroll
            for (int i = 0; i < 4; ++i) if (ss[i] < nns) put(nb, i);
        }
        __syncthreads();
    }
    if (act) *(f32x4*)(sout + vrow * 64 + kq * 4) = S;
}
constexpr int NSCAN = 128;
__device__ __forceinline__ void ph_rwkv_scan(const P& p, LAS float* lds) {
    if ((int)blockIdx.x < NSCAN) {
        const int item = blockIdx.x >> 2, part = blockIdx.x & 3;
        scan_item<16>(p, lds, (item >> 3) * SEQ, SEQ, item & 7, part, nullptr, p.out + O_WKV_P + (size_t)item * 4096);
    } else {
        const int nb = (int)gridDim.x - NSCAN;
        for (int hi = (int)blockIdx.x - NSCAN; hi < 512; hi += nb) {
            const int item = hi >> 1, half = hi & 1;
            scan_item<32>(p, lds, NP + (item >> 3) * 8, 8, item & 7, half, p.state_wkv + (size_t)item * 4096, p.out + O_WKV_S + (size_t)item * 4096);
        }
    }
}

__device__ __forceinline__ void ph_rwkv_post(const P& p) {
    const int tid = threadIdx.x, lane = tid & 63, wid = tid >> 6;
    for (int it = blockIdx.x * 8 + wid; it < MR * 8; it += gridDim.x * 8) {
        const int row = it >> 3, h = it & 7, c = h * 64 + lane;
        const float y = p.ybuf()[(size_t)row * 512 + c];
        const float s1 = wave_sum(y), s2 = wave_sum(y * y);
        const float mean = s1 * (1.0f / 64.0f);
        const float var = fmaxf(s2 * (1.0f / 64.0f) - mean * mean, 0.f);
        const float dv = y - mean;
        float yn = dv * rsqrtf(var + 64e-5f) * p.gn_g[c] + p.gn_b[c];
        yn += p.bonus()[it] * bf2f(((const bf16_t*)(p.rw6() + (size_t)it * RW6_STRIDE + 256))[128 + lane]);
        p.ob()[(size_t)row * 512 + c] = f2bf(yn * bf2f(p.rg()[(size_t)row * 512 + c]));
    }
}

__device__ __forceinline__ void ph_cmp_gemm_f32(const P& p, LAS unsigned char* lds) {
    using pg8::lds_byte;
    const int tid = threadIdx.x, wid = __builtin_amdgcn_readfirstlane(tid >> 6), lane = tid & 63, wr = wid >> 2, wc = wid & 3, fr = lane & 15, fq = lane >> 4;
    constexpr int HTB = 16384;
    const int arow_l = 4 * wid + (lane >> 4), acol = 4 * (lane & 15);
    const int swbase = lds_byte(arow_l, acol);
    LAS unsigned long long* rowoff = (LAS unsigned long long*)(lds + 131072);
    unsigned voffB[2];
#pragma unroll
    for (int i = 0; i < 2; ++i) { int R, C; pg8::stage_rc(tid * 16 + i * 8192, R, C); voffB[i] = (unsigned)(R * 1024 + C) * 2u; }
    const unsigned ldsw = (unsigned)wid * 1024u;
    const int aoff = lds_byte(wr * 64 + fr, fq * 8), boff = lds_byte(wc * 32 + fr, fq * 8);
    for (int unit = blockIdx.x; unit < 512; unit += gridDim.x) {
        const int kvi = unit >> 8, bg = (unit >> 2) & 63, c0 = (unit & 3) * 256, b = bg >> 1, g = bg & 1;
        __syncthreads();
        if (tid < 256) {
            const int chunk = c0 + tid;
            const int page = p.page_table[b * 128 + (chunk >> 3)];
            rowoff[tid] = ((unsigned long long)page * 128 + (chunk & 7) * 16) * 256 + kvi * 128 + g * 64;
        }
        const char* bbase = (const char*)(p.W1T() + (size_t)kvi * 256 * 1024);
        f32x4 acc[2][2][4][2];
#pragma unroll
        for (int a = 0; a < 2; ++a)
#pragma unroll
            for (int bb = 0; bb < 2; ++bb)
#pragma unroll
                for (int m = 0; m < 4; ++m)
#pragma unroll
                    for (int n = 0; n < 2; ++n) acc[a][bb][m][n] = (f32x4){0.f, 0.f, 0.f, 0.f};
        f32x4 ar[8];
        auto stage_b = [&](int st, int t) {
#pragma unroll
            for (int h = 0; h < 2; ++h)
#pragma unroll
                for (int i = 0; i < 2; ++i)
                    __builtin_amdgcn_global_load_lds((const unsigned*)(bbase + (size_t)h * 128 * 2048 + (size_t)t * 128 + voffB[i]),
                                                     (PG8_LAS unsigned*)(lds + st * 65536 + 32768 + h * HTB + ldsw + i * 8192), 16, 0, 0);
        };
        auto load_a = [&](int t) {
#pragma unroll
            for (int q = 0; q < 8; ++q) ar[q] = *(const f32x4*)(p.cache_cmp + rowoff[32 * q + arow_l] + (size_t)t * 256 + acol);
        };
        auto write_a = [&](int st) {
            LAS unsigned char* na = lds + st * 65536;
#pragma unroll
            for (int q = 0; q < 8; ++q) *(LAS u32x2*)(na + swbase + (q >> 2) * HTB + (q & 3) * 4096) = (u32x2){pk2(ar[q][0], ar[q][1]), pk2(ar[q][2], ar[q][3])};
        };
        __syncthreads();
        load_a(0);
        stage_b(0, 0);
        write_a(0);
        __syncthreads();
#pragma unroll 1
        for (int t = 0; t < 16; ++t) {
            const int cur = t & 1;
            if (t + 1 < 16) { load_a(t + 1); stage_b(cur ^ 1, t + 1); }
            LAS const unsigned char* sa = lds + cur * 65536;
            LAS const unsigned char* sb = sa + 32768;
#pragma unroll
            for (int ai = 0; ai < 2; ++ai)
#pragma unroll
                for (int bj = 0; bj < 2; ++bj) {
                    bf16x8 Bt[2][2];
#pragma unroll
                    for (int n = 0; n < 2; ++n)
#pragma unroll
                        for (int k = 0; k < 2; ++k) Bt[n][k] = *(LAS const bf16x8*)(sb + bj * HTB + boff + n * 2048 + k * 1024);
#pragma unroll
                    for (int m = 0; m < 4; ++m) {
                        const bf16x8 a0 = *(LAS const bf16x8*)(sa + ai * HTB + aoff + m * 2048), a1 = *(LAS const bf16x8*)(sa + ai * HTB + aoff + m * 2048 + 1024);
#pragma unroll
                        for (int n = 0; n < 2; ++n) {
                            acc[ai][bj][m][n] = __builtin_amdgcn_mfma_f32_16x16x32_bf16(Bt[n][0], a0, acc[ai][bj][m][n], 0, 0, 0);
                            acc[ai][bj][m][n] = __builtin_amdgcn_mfma_f32_16x16x32_bf16(Bt[n][1], a1, acc[ai][bj][m][n], 0, 0, 0);
                        }
                    }
                    __builtin_amdgcn_sched_barrier(0);
                }
            if (t + 1 < 16) write_a(cur ^ 1);
            __syncthreads();
        }
        EpiPlainBf e; e.C = p.LHs() + ((size_t)kvi * 65536 + (size_t)bg * 1024 + c0) * 256; e.ldc = 256; e.pad_ = 0;
        pg8::Unit u; u.pm = 0; u.pn = 0;
        e(acc, u, wr, wc, fr, fq);
    }
}

__device__ __forceinline__ float exp2_(float x) { return __builtin_amdgcn_exp2f(x); }
template <class OKF>
__device__ __forceinline__ void sm_stats(const f32x16& s, int hb, OKF ok, float& m, float& l) {
    float sv[16]; float tmax = -1e30f; unsigned okm = 0;
#pragma unroll
    for (int i = 0; i < 16; ++i) { const int kl = (i & 3) + 8 * (i >> 2) + 4 * hb; const bool k = ok(kl); okm |= (k ? 1u : 0u) << i; sv[i] = k ? s[i] : -1e30f; tmax = fmaxf(tmax, sv[i]); }
    tmax = fmaxf(tmax, __shfl_xor(tmax, 32));
    const float mn = fmaxf(m, tmax), alpha = exp2_(m - mn); m = mn;
    float ps = 0.f;
#pragma unroll
    for (int i = 0; i < 16; ++i) ps += ((okm >> i) & 1u) ? exp2_(sv[i] - mn) : 0.f;
    l = l * alpha + ps;
}
template <class OKF, class VF>
__device__ __forceinline__ void sm_pv(const f32x16& s, int hb, OKF ok, VF vf, float& m, float& l, f32x16 (&o)[2]) {
    float sv[16]; float tmax = -1e30f; unsigned okm = 0;
#pragma unroll
    for (int i = 0; i < 16; ++i) { const int kl = (i & 3) + 8 * (i >> 2) + 4 * hb; const bool k = ok(kl); okm |= (k ? 1u : 0u) << i; sv[i] = k ? s[i] : -1e30f; tmax = fmaxf(tmax, sv[i]); }
    tmax = fmaxf(tmax, __shfl_xor(tmax, 32));
    const float mn = fmaxf(m, tmax), alpha = exp2_(m - mn); m = mn;
    float pr[16]; float ps = 0.f;
#pragma unroll
    for (int i = 0; i < 16; ++i) { pr[i] = ((okm >> i) & 1u) ? exp2_(sv[i] - mn) : 0.f; ps += pr[i]; }
    l = l * alpha + ps;
    o[0] *= alpha; o[1] *= alpha;
#pragma unroll
    for (int s2 = 0; s2 < 2; ++s2) {
        const bf16x8 pb = pack8(pr[8 * s2 + 0], pr[8 * s2 + 1], pr[8 * s2 + 2], pr[8 * s2 + 3], pr[8 * s2 + 4], pr[8 * s2 + 5], pr[8 * s2 + 6], pr[8 * s2 + 7]);
#pragma unroll
        for (int dt = 0; dt < 2; ++dt) o[dt] = mfma32(vf(dt, s2), pb, o[dt]);
    }
}
template <class VF>
__device__ __forceinline__ void sm_pv_nomask(const f32x16& s, bool csel, VF vf, float& m, float& l, f32x16 (&o)[2]) {
    float tmax = fmaxf(fmaxf(s[0], s[1]), s[2]);
#pragma unroll
    for (int i = 3; i < 16; ++i) tmax = fmaxf(tmax, s[i]);
    tmax = csel ? tmax : -1e30f;
    tmax = fmaxf(tmax, __shfl_xor(tmax, 32));
    const float mn = fmaxf(m, tmax), alpha = exp2_(m - mn); m = mn;
    float pr[16]; float ps = 0.f;
#pragma unroll
    for (int i = 0; i < 16; ++i) { pr[i] = csel ? exp2_(s[i] - mn) : 0.f; ps += pr[i]; }
    l = l * alpha + ps;
    o[0] *= alpha; o[1] *= alpha;
#pragma unroll
    for (int s2 = 0; s2 < 2; ++s2) {
        const bf16x8 pb = pack8(pr[8 * s2 + 0], pr[8 * s2 + 1], pr[8 * s2 + 2], pr[8 * s2 + 3], pr[8 * s2 + 4], pr[8 * s2 + 5], pr[8 * s2 + 6], pr[8 * s2 + 7]);
#pragma unroll
        for (int dt = 0; dt < 2; ++dt) o[dt] = mfma32(vf(dt, s2), pb, o[dt]);
    }
}
template <class OKF, class VF>
__device__ __forceinline__ void cmp_pass2(const f32x16& s, int hb, OKF ok, VF vf, float m, float inv, f32x16 (&o)[2], LAS float* prow, bool writer) {
    float pr[16];
#pragma unroll
    for (int i = 0; i < 16; ++i) {
        const int kl = (i & 3) + 8 * (i >> 2) + 4 * hb;
        pr[i] = ok(kl) ? exp2_(s[i] - m) * inv : 0.f;
        float q = pr[i] + __shfl_xor(pr[i], 1); q += __shfl_xor(q, 2);
        if (writer) prow[kl] = q;
    }
#pragma unroll
    for (int s2 = 0; s2 < 2; ++s2) {
        const bf16x8 pb = pack8(pr[8 * s2 + 0], pr[8 * s2 + 1], pr[8 * s2 + 2], pr[8 * s2 + 3], pr[8 * s2 + 4], pr[8 * s2 + 5], pr[8 * s2 + 6], pr[8 * s2 + 7]);
#pragma unroll
        for (int dt = 0; dt < 2; ++dt) o[dt] = mfma32(vf(dt, s2), pb, o[dt]);
    }
}

__device__ __forceinline__ void attn_store(const P& p, const f32x16 (&of)[2], int qrow, int head, int hb, bool doit, bf16_t* oadst = nullptr) {
    if (!oadst) oadst = p.oa();
    if (!doit) return;
#pragma unroll
    for (int dt = 0; dt < 2; ++dt)
#pragma unroll
        for (int i4 = 0; i4 < 4; ++i4) {
            const int d = 32 * dt + 8 * i4 + 4 * hb;
            const size_t off = (size_t)qrow * 512 + head * 64 + d;
            const uint2 gw = *(const uint2*)(p.ag() + off);
            f32x4 v;
            v[0] = of[dt][4 * i4 + 0] * __uint_as_float(gw.x << 16); v[1] = of[dt][4 * i4 + 1] * __uint_as_float(gw.x & 0xffff0000u);
            v[2] = of[dt][4 * i4 + 2] * __uint_as_float(gw.y << 16); v[3] = of[dt][4 * i4 + 3] * __uint_as_float(gw.y & 0xffff0000u);
            st_bf4(oadst + off, v);
        }
}


__device__ __forceinline__ void of_put(LAS float* st, int lane, const f32x16 (&o)[2], float sc) {
#pragma unroll
    for (int dt = 0; dt < 2; ++dt)
#pragma unroll
        for (int i = 0; i < 16; ++i) st[(dt * 16 + i) * 64 + lane] = o[dt][i] * sc;
}
__device__ __forceinline__ void of_add(LAS float* st, int lane, const f32x16 (&o)[2], float sc) {
#pragma unroll
    for (int dt = 0; dt < 2; ++dt)
#pragma unroll
        for (int i = 0; i < 16; ++i) st[(dt * 16 + i) * 64 + lane] += o[dt][i] * sc;
}
__device__ __forceinline__ void of_get_add(LAS float* st, int lane, const f32x16 (&o)[2], float sc, f32x16 (&of)[2]) {
#pragma unroll
    for (int dt = 0; dt < 2; ++dt)
#pragma unroll
        for (int i = 0; i < 16; ++i) of[dt][i] = st[(dt * 16 + i) * 64 + lane] + o[dt][i] * sc;
}


constexpr int WL_STRIDE = 15360, KV_OFF = 8 * WL_STRIDE, KV_BUF = 17920, XB_OFF = KV_OFF + 2 * KV_BUF;

struct LoadBf16 {
    const bf16_t* kbase; const bf16_t* vbase; int ld; bool with_v; u32x4_t kr, vr;
    __device__ __forceinline__ void load(int n) {
        const int tid = threadIdx.x, srow = tid >> 3, sch = tid & 7;
        kr = *(const u32x4_t*)(kbase + (size_t)(64 * n + srow) * 64 + sch * 8);
        if (with_v) vr = *(const u32x4_t*)(vbase + (size_t)srow * ld + 64 * n + sch * 8);
    }
    __device__ __forceinline__ void store(LAS unsigned char* buf) const {
        const int tid = threadIdx.x, srow = tid >> 3, sch = tid & 7;
        *(LAS u32x4_t*)(buf + srow * 144 + sch * 16) = kr;
        if (with_v) { LAS u32x2* vp = (LAS u32x2*)(buf + 9216 + srow * 136 + sch * 16); vp[0] = (u32x2){vr[0], vr[1]}; vp[1] = (u32x2){vr[2], vr[3]}; }
    }
};
struct LoadWinF32 {
    const float* cw; const float* nw; f32x4 k0, k1, v0, v1;
    __device__ __forceinline__ void load(int n) {
        const int tid = threadIdx.x, srow = tid >> 3, sch = tid & 7;
        const int j = 64 * n + srow;
        const float* r = j < 512 ? cw + (size_t)j * 256 : nw + (size_t)(j - 512 < 8 ? j - 512 : 7) * 256;
        k0 = *(const f32x4*)(r + sch * 8); k1 = *(const f32x4*)(r + sch * 8 + 4);
        v0 = *(const f32x4*)(r + 128 + sch * 8); v1 = *(const f32x4*)(r + 128 + sch * 8 + 4);
    }
    __device__ __forceinline__ void store(LAS unsigned char* buf) const {
        const int tid = threadIdx.x, srow = tid >> 3, sch = tid & 7;
        u32x4_t kw; kw[0] = pk2(k0[0], k0[1]); kw[1] = pk2(k0[2], k0[3]); kw[2] = pk2(k1[0], k1[1]); kw[3] = pk2(k1[2], k1[3]);
        *(LAS u32x4_t*)(buf + srow * 144 + sch * 16) = kw;
        LAS bf16_t* vb = (LAS bf16_t*)(buf + 9216) + (sch * 8) * 68 + srow;
#pragma unroll
        for (int e = 0; e < 4; ++e) { vb[e * 68] = f2bf(v0[e]); vb[(4 + e) * 68] = f2bf(v1[e]); }
    }
};

template <class LOADER, class NEXT, class ACTIVE, class BODY>
__device__ __forceinline__ void block_loop_g(LOADER ld, LAS unsigned char* kv, int first, NEXT next, ACTIVE active, BODY body) {
    if (first < 0) return;
    int n = first, cur = 0;
    ld.load(n);
    ld.store(kv);
    __syncthreads();
#pragma unroll 1
    for (;;) {
        const int nn = next(n);
        if (nn >= 0) ld.load(nn);
        if (active(n)) body(n, (LAS const bf16_t*)(kv + cur * KV_BUF), (LAS const bf16_t*)(kv + cur * KV_BUF + 9216));
        if (nn >= 0) ld.store(kv + (cur ^ 1) * KV_BUF);
        __syncthreads();
        if (nn < 0) break;
        cur ^= 1; n = nn;
    }
}
template <bool WITH_V, class NEXT, class ACTIVE, class BODY>
__device__ __forceinline__ void block_loop(const bf16_t* kbase, const bf16_t* vbase, int ld, LAS unsigned char* kv, int first, NEXT next, ACTIVE active, BODY body) {
    LoadBf16 L; L.kbase = kbase; L.vbase = vbase; L.ld = ld; L.with_v = WITH_V;
    block_loop_g(L, kv, first, next, active, body);
}
__device__ __forceinline__ bf16x8 lds_kfrag(LAS const bf16_t* kb, int kt, int ks, int col, int hb) { return *(LAS const bf16x8*)(kb + (32 * kt + col) * 72 + 16 * ks + 8 * hb); }
__device__ __forceinline__ bf16x8 lds_vfrag(LAS const bf16_t* vb, int kt, int dt, int s2, int col, int hb) {
    LAS const bf16_t* ptr = vb + (32 * dt + col) * 68 + 32 * kt + 16 * s2 + 4 * hb;
    union { u32x4_t u; bf16x8 v; } x; const u32x2 a = *(LAS const u32x2*)ptr, c = *(LAS const u32x2*)(ptr + 8); x.u[0] = a[0]; x.u[1] = a[1]; x.u[2] = c[0]; x.u[3] = c[1]; return x.v;
}
__device__ __forceinline__ f32x16 lds_qk(const bf16x8 (&qf)[4], LAS const bf16_t* kb, int kt, int col, int hb) {
    f32x16 s = zero16();
#pragma unroll
    for (int ks = 0; ks < 4; ++ks) s = mfma32(lds_kfrag(kb, kt, ks, col, hb), qf[ks], s);
    return s;
}

__device__ __forceinline__ void attn_prompt_block(const P& p, int bg, int j, LAS unsigned char* lds) {
    int tid_l = threadIdx.x; asm volatile("" : "+v"(tid_l));
    const int tid = tid_l, lane = tid & 63, wid = __builtin_amdgcn_readfirstlane(tid >> 6);
    const int b = bg >> 1, g = bg & 1;
    const int col = lane & 31, hb = lane >> 5, tl = col >> 2, hh = col & 3;
    const int t0 = 64 * j + 8 * wid, qpos = t0 + tl, qrow = b * SEQ + qpos, head = g * 4 + hh;
    LAS unsigned char* wl = lds + wid * WL_STRIDE;
    LAS unsigned char* kv = lds + KV_OFF;
    LAS float* psum = (LAS float*)wl;
    LAS unsigned long long* msk = (LAS unsigned long long*)(wl + 8192);
    bf16x8 qf[4];
#pragma unroll
    for (int ks = 0; ks < 4; ++ks) qf[ks] = *(const bf16x8*)(p.qb() + (size_t)qrow * 512 + head * 64 + 16 * ks + 8 * hb);
    const float g0 = p.gates()[(size_t)qrow * 32 + head * 3 + 0], g1 = p.gates()[(size_t)qrow * 32 + head * 3 + 1], g2 = p.gates()[(size_t)qrow * 32 + head * 3 + 2];
    f32x16 oc[2]; oc[0] = zero16(); oc[1] = zero16();
    {
        const int cmb = 64 * j + 63 - 31;
        const int nbc = ((cmb >> 4) >> 6) + 1;
        const int cmw = t0 + 7 - 31;
        const int cmaxw = cmw >= 0 ? (cmw >> 4) : -1;
        const bf16_t* kc = p.kc_p() + (size_t)bg * 256 * 64;
        const bf16_t* vc = p.vcT_p() + (size_t)bg * 64 * 256;
        float m = -1e30f, l = 0.f;
        block_loop<false>(kc, vc, 256, kv, 0, [&](int n) { return n + 1 < nbc ? n + 1 : -1; }, [&](int n) { return cmaxw >= 64 * n; },
            [&](int n, LAS const bf16_t* kb, LAS const bf16_t* vb) {
#pragma unroll 1
                for (int kt = 0; kt < 2; ++kt) {
                    const f32x16 s = lds_qk(qf, kb, kt, col, hb);
                    sm_stats(s, hb, [&](int kl) { return 16 * (64 * n + 32 * kt + kl) + 31 <= qpos; }, m, l);
                }
            });
        l += __shfl_xor(l, 32);
        const float inv = l > 0.f ? 1.0f / l : 0.f;
#pragma unroll
        for (int i = 0; i < 32; ++i) psum[i * 64 + lane] = 0.f;
        WAVE_SYNC();
        block_loop<true>(kc, vc, 256, kv, 0, [&](int n) { return n + 1 < nbc ? n + 1 : -1; }, [&](int n) { return cmaxw >= 64 * n; },
            [&](int n, LAS const bf16_t* kb, LAS const bf16_t* vb) {
#pragma unroll 1
                for (int kt = 0; kt < 2; ++kt) {
                    const f32x16 s = lds_qk(qf, kb, kt, col, hb);
                    cmp_pass2(s, hb, [&](int kl) { return 16 * (64 * n + 32 * kt + kl) + 31 <= qpos; }, [&](int dt, int s2) { return lds_vfrag(vb, kt, dt, s2, col, hb); }, m, inv, oc,
                              psum + tl * 256 + 64 * n + 32 * kt, hh == 0);
                }
            });
    }
    WAVE_SYNC();
    unsigned long long umw = 0;
    for (int t2 = 0; t2 < 8; ++t2) {
        const int t = t0 + t2, cur = t >> 6, n = lane;
        float imp = 0.f;
#pragma unroll
        for (int c = -1; c < 4; ++c) { const int cc = 4 * n + c; if (cc >= 0) imp += psum[t2 * 256 + cc]; }
        if (n == 0 || n == cur || n == cur - 1) imp = 1e4f;
        if (n * 64 > t) imp = -1.0f;
        int rank = 0;
#pragma unroll
        for (int jj = 0; jj < 64; ++jj) {
            const float vj = __uint_as_float(__builtin_amdgcn_readlane(__float_as_uint(imp), jj));
            rank += (vj > imp || (vj == imp && jj < n)) ? 1 : 0;
        }
        const unsigned long long mk = __ballot(rank < 16);
        if (lane == 0) msk[t2] = mk;
        umw |= mk;
    }
    if (lane == 0) msk[8] = umw;
    __syncthreads();
    const unsigned long long mymask = msk[tl];
    unsigned long long umb = 0;
#pragma unroll
    for (int w2 = 0; w2 < 8; ++w2) umb |= *(LAS const unsigned long long*)(lds + w2 * WL_STRIDE + 8192 + 64);
    {
        const unsigned lo = __builtin_amdgcn_readfirstlane((unsigned)umb), hi = __builtin_amdgcn_readfirstlane((unsigned)(umb >> 32));
        umb = ((unsigned long long)hi << 32) | lo;
        if (j < 63) umb &= (2ull << j) - 1ull;
    }
    LAS float* ost = (LAS float*)wl;
    of_put(ost, lane, oc, g0);
    {
        const bf16_t* kbs = p.kb() + (size_t)((1 * NB + b) * 2 + g) * SEQ * 64;
        const bf16_t* vbs = p.vT() + (size_t)((0 * NB + b) * 2 + g) * 64 * SEQ;
        float m = -1e30f, l = 0.f; f32x16 o[2]; o[0] = zero16(); o[1] = zero16();
        block_loop<true>(kbs, vbs, SEQ, kv, umb ? (int)__builtin_ctzll(umb) : -1,
            [&](int n) { if (n >= 63) return -1; const unsigned long long rem = umb >> (n + 1); return rem ? n + 1 + (int)__builtin_ctzll(rem) : -1; },
            [&](int n) { return (bool)((umw >> n) & 1ull); },
            [&](int n, LAS const bf16_t* kb, LAS const bf16_t* vb) {
                const bool bsel = (mymask >> n) & 1ull;
#pragma unroll
                for (int kt = 0; kt < 2; ++kt) {
                    const int tok0 = 64 * n + 32 * kt;
                    const f32x16 s = lds_qk(qf, kb, kt, col, hb);
                    if (n < j) sm_pv_nomask(s, bsel, [&](int dt, int s2) { return lds_vfrag(vb, kt, dt, s2, col, hb); }, m, l, o);
                    else sm_pv(s, hb, [&](int kl) { return bsel && (tok0 + kl <= qpos); }, [&](int dt, int s2) { return lds_vfrag(vb, kt, dt, s2, col, hb); }, m, l, o);
                }
            });
        l += __shfl_xor(l, 32);
        const float sc = l > 0.f ? g1 / l : 0.f;
        of_add(ost, lane, o, sc);
    }
    {
        const bf16_t* kbw = p.kb() + (size_t)((2 * NB + b) * 2 + g) * SEQ * 64;
        const bf16_t* vbw = p.vT() + (size_t)((1 * NB + b) * 2 + g) * 64 * SEQ;
        float m = -1e30f, l = 0.f; f32x16 o[2]; o[0] = zero16(); o[1] = zero16();
        block_loop<true>(kbw, vbw, SEQ, kv, j > 8 ? j - 8 : 0, [&](int n) { return n < j ? n + 1 : -1; }, [&](int n) { return true; },
            [&](int n, LAS const bf16_t* kb, LAS const bf16_t* vb) {
#pragma unroll 1
                for (int kt = 0; kt < 2; ++kt) {
                    const int tok0 = 64 * n + 32 * kt;
                    const f32x16 s = lds_qk(qf, kb, kt, col, hb);
                    if (n < j && n > j - 8) sm_pv_nomask(s, true, [&](int dt, int s2) { return lds_vfrag(vb, kt, dt, s2, col, hb); }, m, l, o);
                    else sm_pv(s, hb, [&](int kl) { const int key = tok0 + kl; return key <= qpos && key + 511 >= qpos; }, [&](int dt, int s2) { return lds_vfrag(vb, kt, dt, s2, col, hb); }, m, l, o);
                }
            });
        l += __shfl_xor(l, 32);
        const float sc = l > 0.f ? g2 / l : 0.f;
        f32x16 of[2];
        of_get_add(ost, lane, o, sc, of);
        attn_store(p, of, qrow, head, hb, true);
    }
    __syncthreads();
}

__device__ __forceinline__ void attn_sample_block(const P& p, int bg, LAS unsigned char* lds) {
    int tid_l = threadIdx.x; asm volatile("" : "+v"(tid_l));
    const int tid = tid_l, lane = tid & 63, wid = __builtin_amdgcn_readfirstlane(tid >> 6);
    const int b = bg >> 1, g = bg & 1, t = wid;
    const int col = lane & 31, hb = lane >> 5, hh = col & 3;
    const int qrow = NP + b * 8 + t, head = g * 4 + hh;
    LAS unsigned char* wl = lds + wid * WL_STRIDE;
    LAS unsigned char* kv = lds + KV_OFF;
    bf16x8 qf[4];
#pragma unroll
    for (int ks = 0; ks < 4; ++ks) qf[ks] = *(const bf16x8*)(p.qb() + (size_t)qrow * 512 + head * 64 + 16 * ks + 8 * hb);
    LAS float* psum = (LAS float*)wl;
    LAS int* list = (LAS int*)(wl + 8256);
    LAS float* impl = (LAS float*)(wl + 8448);
    LAS bf16_t* vt = (LAS bf16_t*)(wl + 9728);
    const float g0 = p.gates()[(size_t)qrow * 32 + head * 3 + 0], g1 = p.gates()[(size_t)qrow * 32 + head * 3 + 1], g2 = p.gates()[(size_t)qrow * 32 + head * 3 + 2];
    f32x16 oc[2]; oc[0] = zero16(); oc[1] = zero16();
    {
        const bf16_t* kc = p.kc_s() + (size_t)bg * 1024 * 64;
        const bf16_t* vc = p.vcT_s() + (size_t)bg * 64 * 1024;
        float m = -1e30f, l = 0.f;
        block_loop<false>(kc, vc, 1024, kv, 0, [&](int n) { return n < 15 ? n + 1 : -1; }, [&](int n) { return true; },
            [&](int n, LAS const bf16_t* kb, LAS const bf16_t* vb) {
#pragma unroll 1
                for (int kt = 0; kt < 2; ++kt) {
                    const f32x16 s = lds_qk(qf, kb, kt, col, hb);
                    sm_stats(s, hb, [&](int kl) { return 64 * n + 32 * kt + kl <= 1022; }, m, l);
                }
            });
        l += __shfl_xor(l, 32);
        const float inv = l > 0.f ? 1.0f / l : 0.f;
        block_loop<true>(kc, vc, 1024, kv, 0, [&](int n) { return n < 15 ? n + 1 : -1; }, [&](int n) { return true; },
            [&](int n, LAS const bf16_t* kb, LAS const bf16_t* vb) {
#pragma unroll 1
                for (int kt = 0; kt < 2; ++kt) {
                    const f32x16 s = lds_qk(qf, kb, kt, col, hb);
                    cmp_pass2(s, hb, [&](int kl) { return 64 * n + 32 * kt + kl <= 1022; }, [&](int dt, int s2) { return lds_vfrag(vb, kt, dt, s2, col, hb); }, m, inv, oc,
                              psum + 64 * n + 32 * kt, col == 0);
                }
            });
    }
    WAVE_SYNC();
#pragma unroll
    for (int j = 0; j < 5; ++j) {
        const int n = lane + 64 * j;
        if (n <= 256) {
            float imp = 0.f;
            for (int c = -1; c < 4; ++c) { const int cc = 4 * n + c; if (cc >= 0 && cc <= 1022) imp += psum[cc]; }
            impl[n] = imp;
        }
    }
    WAVE_SYNC();
    {
        int base = 0;
#pragma unroll
        for (int j = 0; j < 4; ++j) {
            const int n = lane + 64 * j;
            const bool cand = n >= 1 && n <= 254;
            const float v = impl[n];
            int rank = 0;
            for (int q = 1; q <= 254; ++q) { const float vq = impl[q]; rank += (vq > v || (vq == v && q < n)) ? 1 : 0; }
            const bool sel = cand && rank < 13;
            const unsigned long long mk = __ballot(sel);
            if (sel) list[base + __popcll(mk & ((1ull << lane) - 1ull))] = n;
            base += __popcll(mk);
        }
        if (lane == 0) { list[13] = 0; list[14] = 255; list[15] = 256; }
    }
    WAVE_SYNC();
    if (lane < 16) {
        const int n = list[lane];
        list[16 + lane] = n < 256 ? p.page_table[b * 128 + (n >> 1)] * 128 + (n & 1) * 64 : -1;
    }
    WAVE_SYNC();
    LAS float* ost = (LAS float*)wl;
    of_put(ost, lane, oc, g0);
    {
        float m = -1e30f, l = 0.f; f32x16 o[2]; o[0] = zero16(); o[1] = zero16();
        const float* newrows = p.out + O_SEL_S + (size_t)(b * 8) * 256 + g * 64;
        auto rowptr = [&](int u) -> const float* {
            const int rb = __builtin_amdgcn_readfirstlane(list[16 + (u >> 1)]);
            return rb >= 0 ? p.cache_sel + ((size_t)rb + 32 * (u & 1) + col) * 256 + g * 64 : newrows + (size_t)(col < 8 ? col : 7) * 256;
        };
        f32x4 kA[4], kB[4];
        { const float* kr = rowptr(0) + 8 * hb;
#pragma unroll
          for (int ks = 0; ks < 4; ++ks) { kA[ks] = *(const f32x4*)(kr + 16 * ks); kB[ks] = *(const f32x4*)(kr + 16 * ks + 4); } }
#pragma unroll 1
        for (int u = 0; u < 31; ++u) {
            const bool isnew = __builtin_amdgcn_readfirstlane(list[16 + (u >> 1)]) < 0;
            const float* vr = rowptr(u) + 128 + 32 * hb;
            f32x4 vv[8];
#pragma unroll
            for (int j4 = 0; j4 < 8; ++j4) vv[j4] = *(const f32x4*)(vr + 4 * j4);
            f32x16 s = zero16();
#pragma unroll
            for (int ks = 0; ks < 4; ++ks) s = mfma32(pack8(kA[ks][0], kA[ks][1], kA[ks][2], kA[ks][3], kB[ks][0], kB[ks][1], kB[ks][2], kB[ks][3]), qf[ks], s);
            if (u + 1 < 31) { const float* kr = rowptr(u + 1) + 8 * hb;
#pragma unroll
                for (int ks = 0; ks < 4; ++ks) { kA[ks] = *(const f32x4*)(kr + 16 * ks); kB[ks] = *(const f32x4*)(kr + 16 * ks + 4); } }
#pragma unroll
            for (int j4 = 0; j4 < 8; ++j4)
#pragma unroll
                for (int e = 0; e < 4; ++e) vt[(32 * hb + 4 * j4 + e) * 40 + col] = f2bf(vv[j4][e]);
            WAVE_SYNC();
            sm_pv(s, hb, [&](int kl) { return !isnew || kl <= t; }, [&](int dt, int s2) {
                LAS const bf16_t* ptr = vt + (32 * dt + col) * 40 + 16 * s2 + 4 * hb;
                union { u32x4_t u4; bf16x8 v; } x; const u32x2 a = *(LAS const u32x2*)ptr, c = *(LAS const u32x2*)(ptr + 8); x.u4[0] = a[0]; x.u4[1] = a[1]; x.u4[2] = c[0]; x.u4[3] = c[1]; return x.v; }, m, l, o);
            WAVE_SYNC();
        }
        l += __shfl_xor(l, 32);
        const float sc = l > 0.f ? g1 / l : 0.f;
        of_add(ost, lane, o, sc);
    }
    {
        float m = -1e30f, l = 0.f; f32x16 o[2]; o[0] = zero16(); o[1] = zero16();
        LoadWinF32 L; L.cw = p.cache_win + (size_t)b * 512 * 256 + g * 64; L.nw = p.out + O_WIN_S + ((size_t)b * 512 + 504) * 256 + g * 64;
        block_loop_g(L, kv, 0, [&](int n) { return n < 8 ? n + 1 : -1; }, [&](int n) { return true; },
            [&](int n, LAS const bf16_t* kb, LAS const bf16_t* vb) {
#pragma unroll 1
                for (int kt = 0; kt < 2; ++kt) {
                    const int j0 = 64 * n + 32 * kt;
                    if (j0 >= 520) break;
                    const f32x16 s = lds_qk(qf, kb, kt, col, hb);
                    sm_pv(s, hb, [&](int kl) { const int j = j0 + kl; return j >= t + 1 && j <= 512 + t; }, [&](int dt, int s2) { return lds_vfrag(vb, kt, dt, s2, col, hb); }, m, l, o);
                }
            });
        l += __shfl_xor(l, 32);
        const float sc = l > 0.f ? g2 / l : 0.f;
        f32x16 of[2];
        of_get_add(ost, lane, o, sc, of);
        attn_store(p, of, qrow, head, hb, col < 4);
    }
    __syncthreads();
}

__device__ __forceinline__ void ph_attn(const P& p, LAS unsigned char* lds, int qsel = 0) {
    const int tid = threadIdx.x, lane = tid & 63, wid = tid >> 6;
    unsigned* ctr = p.bar() + 3584 + 64 * qsel;
    LAS unsigned* qslot = (LAS unsigned*)(lds + XB_OFF + 64);
    for (;;) {
        if (tid == 0) *qslot = __hip_atomic_fetch_add(ctr, 1u, __ATOMIC_RELAXED, __HIP_MEMORY_SCOPE_AGENT);
        __syncthreads();
        const unsigned q = __builtin_amdgcn_readfirstlane(*qslot);
        __syncthreads();
        if (q >= 64u + 512u) break;
        if (q < 64u) attn_sample_block(p, (int)q, lds);
        else { const int idx = (int)q - 64; attn_prompt_block(p, idx & 7, 63 - (idx >> 3), lds);
        }
    }
}


constexpr int LDS_BYTES = pg8::STAGE_BYTES;

constexpr int FUSED_LDS = XB_OFF + 256;

template <class Epi> __device__ __forceinline__ void run_gemm(LAS unsigned char* lds, const bf16_t* A, const bf16_t* Bt, int M, int N, int K, const Epi& E, int slot = -1) {
    pg8::Gemm g; g.A = A; g.Bt = Bt; g.M = M; g.N = N; g.K = K; g.pad_ = 0;
    pg8::StaticOrder S; S.init(M, N, (int)gridDim.x, slot >= 0 ? slot : (int)blockIdx.x);
    pg8::gemm_phase<Epi, pg8::StaticOrder, false>((PG8_LAS unsigned char*)lds, g, S, E, nullptr);
}

#define XBAR() xcd_barrier(bar)
__global__ __launch_bounds__(512, 2) void k_fused(P p) {
    extern __shared__ __attribute__((aligned(16))) unsigned char shm[];
    LAS unsigned char* lds = (LAS unsigned char*)shm;
    LAS unsigned* xb = (LAS unsigned*)(lds + XB_OFF);
    if (threadIdx.x == 0) { xb[0] = 0u; xb[1] = 0u; xb[2] = 0u; xb[3] = 0u; }
    __syncthreads();
    XcdBarrier bar = xcd_barrier_post(p.bar(), (volatile LAS unsigned*)xb);
    ph_prep(p);
    XBAR();
    { EpiIn e; e.p = p; e.row0 = 0; e.pn0 = 0; run_gemm(lds, p.hb(), p.WinT(), MR, NPAD, DM, e); }
    ph_cmp_gemm_f32(p, lds);
    XBAR();
    if ((int)blockIdx.x < 16) {
        const int kvi = blockIdx.x >> 3, bg = blockIdx.x & 7;
        EpiPlainBf e; e.C = p.LHp() + ((size_t)kvi * 2048 + (size_t)bg * 256) * 256; e.ldc = 256; e.pad_ = 0;
        run_gemm(lds, (kvi ? p.vcr() : p.kb()) + (size_t)bg * 256 * 1024, p.W1T() + (size_t)kvi * 256 * 1024, 256, 256, 1024, e, 0);
        __builtin_amdgcn_fence(__ATOMIC_RELEASE, "agent");
        asm volatile("s_waitcnt vmcnt(0)" ::: "memory");
        __syncthreads();
        __builtin_amdgcn_fence(__ATOMIC_ACQUIRE, "agent");
        asm volatile("s_waitcnt vmcnt(0)" ::: "memory");
        compress2_tile(p, p.LHp(), 8, 256, 255, p.kc_p(), p.vcT_p(), kvi, bg, threadIdx.x >> 6, threadIdx.x & 63, lds + (threadIdx.x >> 6) * 8960);
    }
    ph_rwkv_prep(p);
    ph_compress2(p, p.LHs(), 64, 1024, 1023, p.kc_s(), p.vcT_s(), lds);
    XBAR();
    ph_rwkv_scan(p, (LAS float*)lds);
    __syncthreads();
    ph_attn(p, lds);
    XBAR();
    ph_rwkv_post(p);
    { EpiYa e; e.p = p; small_gemm(p.oa(), p.WpaT(), 512, e); run_gemm(lds, p.oa(), p.WpaT(), NP, DM, 512, e); }
    XBAR();
    { EpiYb e; e.p = p; small_gemm(p.ob(), p.WpbT(), 512, e); run_gemm(lds, p.ob(), p.WpbT(), NP, DM, 512, e); }
    XBAR();
    { EpiOut e; e.p = p; small_gemm(p.mb(), p.WoutT(), DM, e); run_gemm(lds, p.mb(), p.WoutT(), NP, DM, DM, e); }
    { EpiPlain e; e.C = p.pp(); e.ldc = DM; e.pad_ = 0; small_gemm(p.pb(), p.WprojT(), 256, e); run_gemm(lds, p.pb(), p.WprojT(), NP, DM, 256, e); }
    XBAR();
    { EpiGate e; e.p = p; small_gemm(p.xg(), p.WgateT(), DM, e); run_gemm(lds, p.xg(), p.WgateT(), NP, DM, DM, e); }
    XBAR();
    ph_final(p);
}
extern "C" void kernel_launch(void* const* d_in, const int* in_sizes, int n_in, void* d_out, int out_size, void* d_ws, size_t ws_size, hipStream_t stream) {
    (void)in_sizes; (void)n_in; (void)out_size; (void)ws_size;
    P p{};
    p.x_prompt = (const float*)d_in[0]; p.x_sample = (const float*)d_in[1]; p.p_prompt = (const float*)d_in[2]; p.p_sample = (const float*)d_in[3];
    p.cache_cmp = (const float*)d_in[4]; p.cache_sel = (const float*)d_in[5]; p.cache_win = (const float*)d_in[6]; p.state_wkv = (const float*)d_in[7];
    p.state_shift = (const float*)d_in[8]; p.page_table = (const int*)d_in[9]; p.norm_g = (const float*)d_in[10]; p.w_in = (const float*)d_in[11];
    p.cmp_pe = (const float*)d_in[12]; p.cmp_w1 = (const float*)d_in[13]; p.cmp_b1 = (const float*)d_in[14]; p.cmp_w2 = (const float*)d_in[15]; p.cmp_b2 = (const float*)d_in[16];
    p.w_pa = (const float*)d_in[17]; p.mu = (const float*)d_in[18]; p.w0 = (const float*)d_in[19]; p.w_up = (const float*)d_in[20]; p.a0 = (const float*)d_in[21];
    p.a_up = (const float*)d_in[22]; p.k_k = (const float*)d_in[23]; p.k_a = (const float*)d_in[24]; p.r_k = (const float*)d_in[25]; p.gn_g = (const float*)d_in[26];
    p.gn_b = (const float*)d_in[27]; p.w_pb = (const float*)d_in[28]; p.w_out = (const float*)d_in[29]; p.ple_g = (const float*)d_in[30]; p.w_gate = (const float*)d_in[31];
    p.w_proj = (const float*)d_in[32]; p.final_g = (const float*)d_in[33];
    p.out = (float*)d_out;
    p.ws = (unsigned char*)d_ws;

    static int grid = 0;
    if (!grid) {
        int dev = 0, cus = 0, per_cu = 0;
        (void)hipGetDevice(&dev);
        (void)hipDeviceGetAttribute(&cus, hipDeviceAttributeMultiprocessorCount, dev);
        (void)hipFuncSetAttribute((const void*)k_fused, hipFuncAttributeMaxDynamicSharedMemorySize, FUSED_LDS);
        (void)hipOccupancyMaxActiveBlocksPerMultiprocessor(&per_cu, k_fused, 512, FUSED_LDS);
        grid = per_cu >= 1 ? cus : 0;
        if (grid > 256) grid = 256;
    }
    (void)hipMemsetAsync(p.bar(), 0, 32768, stream);
    if (grid > 0) hipLaunchKernelGGL(k_fused, dim3(grid), dim3(512), FUSED_LDS, stream, p);
}
```

```cpp
#include <hip/hip_runtime.h>
#include <stdint.h>
#include <stdio.h>
namespace pg8 {
#define PG8_LAS __attribute__((address_space(3)))
typedef unsigned short bf16_t;
typedef short bf16x8 __attribute__((ext_vector_type(8)));
typedef float f32x4 __attribute__((ext_vector_type(4)));
typedef unsigned u32x4 __attribute__((ext_vector_type(4)));
constexpr int BM = 256, BK = 64, HALF = 128, HTB = HALF * BK * 2  , STAGE_BYTES = 8 * HTB, NXCD = 8, WGM = 8;

__host__ __device__ __forceinline__ int lds_byte(int r, int c) { const int st = (r >> 4) * 2 + (c >> 5), rr = r & 15, cc = c & 31, ob = rr * 64 + cc * 2; return st * 1024 + (ob ^ (((ob >> 9) & 1) << 5)); }
__host__ __device__ __forceinline__ void stage_rc(int b, int& R, int& C) { const int st = b / 1024, sb = b % 1024, swz = sb ^ (((sb >> 9) & 1) << 5); R = (st >> 1) * 16 + swz / 64; C = (st & 1) * 32 + (swz % 64) / 2; }
__host__ __device__ __forceinline__ int perm32(int rho) { const int n = rho >> 4, i = rho & 15; return 8 * (i >> 2) + 4 * n + (i & 3); }

struct Unit { int pm, pn; };
struct Gemm { const bf16_t* A; const bf16_t* Bt; int M, N, K, pad_; };

struct StaticOrder {
    int nM, nN, nwg, G, c;
    __host__ __device__ void init(int M, int N, int G_, int c_) { nM = M / BM; nN = N / BM; nwg = nM * nN; G = G_; c = c_; }
    __host__ __device__ bool next(int i, Unit& u) const {
        const long L = (long)i * G + c; if (L >= nwg) return false;
        int wgid = (int)L; { const int q = nwg / NXCD, r = nwg % NXCD, xcd = wgid % NXCD, off = wgid / NXCD; wgid = (xcd < r ? xcd * (q + 1) : r * (q + 1) + (xcd - r) * q) + off; }
        const int nig = WGM * nN, gid = wgid / nig, fm = gid * WGM, gsz = (nM - fm) < WGM ? (nM - fm) : WGM;
        u.pm = fm + ((wgid % nig) % gsz); u.pn = (wgid % nig) / gsz; return true;
    }
    __device__ __forceinline__ void a_ready(const Unit&) const {}
    __device__ __forceinline__ void done(const Unit&) const {}
};
__device__ __forceinline__ unsigned cvt_pk_bf16(float lo, float hi) { unsigned r; asm volatile("v_cvt_pk_bf16_f32 %0, %1, %2" : "=v"(r) : "v"(lo), "v"(hi)); return r; }
typedef float f32x2 __attribute__((ext_vector_type(2)));
template <class Epi, class Sched, bool STAMP = false>
__device__ __forceinline__ void gemm_phase(PG8_LAS unsigned char* lds, const Gemm g, const Sched& S, const Epi& E, unsigned long long* stamps) {
    int tid_l = threadIdx.x; asm volatile("" : "+v"(tid_l));
    const int tid = tid_l, wid = __builtin_amdgcn_readfirstlane(tid >> 6), lane = tid & 63, wr = wid >> 2, wc = wid & 3, fr = lane & 15, fq = lane >> 4;
    const int K = g.K, nt = K / BK;
    int ts_lo = 0, ts_hi = 0, nts = 0; const unsigned long long rt_entry = STAMP ? (unsigned long long)wall_clock64() : 0ull;
#define PG8_STAMP() do { if (STAMP && wid == 0 && nts < 64) { const unsigned long long _c = (unsigned long long)clock64(); \
        ts_lo = (lane == nts) ? (int)(unsigned)_c : ts_lo; ts_hi = (lane == nts) ? (int)(unsigned)(_c >> 32) : ts_hi; ++nts; } } while (0)
    PG8_STAMP();
    unsigned voffA[2], voffB[2];
#pragma unroll
    for (int i = 0; i < 2; ++i) { int R, C; stage_rc(tid * 16 + i * 8192, R, C); const int Rb = Epi::PERM ? ((R & ~31) + perm32(R & 31)) : R;
        voffA[i] = (unsigned)(R * K + C) * 2u; voffB[i] = (unsigned)(Rb * K + C) * 2u; }
    const size_t kstep = (size_t)(BK * 2);
    const size_t hstep = (size_t)HALF * K * 2;
    const size_t tstep = 2 * hstep;
    const unsigned ldsw = (unsigned)wid * 1024u;
    const int aoff = lds_byte(wr * 64 + fr, fq * 8), boff = lds_byte(wc * 32 + fr, fq * 8);
#define PG8_SA(b, h) (((b) * 2 + (h)) * HTB)
#define PG8_SB(b, h) ((4 + (b) * 2 + (h)) * HTB)
#define PG8_STAGE(bufoff, gbase, voff) do { _Pragma("unroll") for (int _i = 0; _i < 2; ++_i) \
        __builtin_amdgcn_global_load_lds((const unsigned*)((const char*)(gbase) + (voff)[_i]), (PG8_LAS unsigned*)(lds + (bufoff) + ldsw + _i * 8192), 16, 0, 0); } while (0)
#define PG8_LDA(dst, b, h) do { _Pragma("unroll") for (int m = 0; m < 4; ++m) _Pragma("unroll") for (int k = 0; k < 2; ++k) dst[m][k] = *(const PG8_LAS bf16x8*)(lds + PG8_SA(b, h) + aoff + m * 2048 + k * 1024); } while (0)
#define PG8_LDB(dst, b, h) do { _Pragma("unroll") for (int n = 0; n < 2; ++n) _Pragma("unroll") for (int k = 0; k < 2; ++k) dst[n][k] = *(const PG8_LAS bf16x8*)(lds + PG8_SB(b, h) + boff + n * 2048 + k * 1024); } while (0)
#define PG8_MMA(ai, bj, At, Bt) do { __builtin_amdgcn_s_setprio(1); _Pragma("unroll") for (int m = 0; m < 4; ++m) _Pragma("unroll") for (int n = 0; n < 2; ++n) _Pragma("unroll") for (int k = 0; k < 2; ++k) \
        acc[ai][bj][m][n] = __builtin_amdgcn_mfma_f32_16x16x32_bf16(Bt[n][k], At[m][k], acc[ai][bj][m][n], 0, 0, 0); __builtin_amdgcn_s_setprio(0); } while (0)
#define PG8_WAIT_V(n) asm volatile("s_waitcnt vmcnt(" #n ")" ::: "memory")
#define PG8_WAIT_L(n) asm volatile("s_waitcnt lgkmcnt(" #n ")" ::: "memory")
#define PG8_BAR __builtin_amdgcn_s_barrier()
#define PG8_SCHED __builtin_amdgcn_sched_barrier(0)
    Unit cur, nxt; int ui = 0;
    if (!S.next(0, cur)) return;
    f32x4 acc[2][2][4][2];
#pragma unroll
    for (int a = 0; a < 2; ++a)
#pragma unroll
        for (int b = 0; b < 2; ++b)
#pragma unroll
            for (int m = 0; m < 4; ++m)
#pragma unroll
                for (int n = 0; n < 2; ++n) acc[a][b][m][n] = (f32x4){0.f, 0.f, 0.f, 0.f};
    bf16x8 At[4][2], B0[2][2], B1[2][2];
    const char* cA = (const char*)g.A + (size_t)cur.pm * tstep; const char* cB = (const char*)g.Bt + (size_t)cur.pn * tstep;
    S.a_ready(cur);
    PG8_STAGE(PG8_SB(0, 0), cB, voffB); PG8_STAGE(PG8_SA(0, 0), cA, voffA); PG8_STAGE(PG8_SB(0, 1), cB + hstep, voffB); PG8_STAGE(PG8_SA(0, 1), cA + hstep, voffA);
    if (wr == 1) PG8_BAR;
    PG8_WAIT_V(4); PG8_BAR;
    PG8_STAGE(PG8_SB(1, 0), cB + kstep, voffB); PG8_STAGE(PG8_SA(1, 0), cA + kstep, voffA); PG8_STAGE(PG8_SB(1, 1), cB + hstep + kstep, voffB);
    PG8_WAIT_V(6); PG8_BAR;
    PG8_STAMP();
    for (;;) {
        const bool has_next = S.next(ui + 1, nxt);
        const char* nA = has_next ? (const char*)g.A + (size_t)nxt.pm * tstep : cA; const char* nB = has_next ? (const char*)g.Bt + (size_t)nxt.pn * tstep : cB;
        for (int t = 0; t < nt; t += 2) {
            const bool last = (t == nt - 2);
            const char* a1 = cA + (size_t)(t + 1) * kstep;
            const char* a2 = last ? nA : cA + (size_t)(t + 2) * kstep; const char* b2 = last ? nB : cB + (size_t)(t + 2) * kstep;
            const char* a3 = a2 + kstep; const char* b3 = b2 + kstep;
            if (last && has_next) S.a_ready(nxt);
            PG8_LDB(B0, 0, 0); PG8_SCHED; PG8_LDA(At, 0, 0); PG8_STAGE(PG8_SA(1, 1), a1 + hstep, voffA);
            PG8_WAIT_L(8); PG8_BAR; PG8_WAIT_L(0); PG8_MMA(0, 0, At, B0); PG8_BAR; PG8_SCHED;
            PG8_LDB(B1, 0, 1); PG8_STAGE(PG8_SB(0, 0), b2, voffB);
            PG8_BAR; PG8_WAIT_L(0); PG8_MMA(0, 1, At, B1); PG8_BAR;
            PG8_LDA(At, 0, 1); PG8_STAGE(PG8_SA(0, 0), a2, voffA);
            PG8_BAR; PG8_WAIT_L(0); PG8_MMA(1, 0, At, B0); PG8_BAR; PG8_SCHED;
            PG8_STAGE(PG8_SB(0, 1), b2 + hstep, voffB);
            PG8_WAIT_V(6); PG8_BAR; PG8_MMA(1, 1, At, B1); PG8_BAR;
            PG8_LDB(B0, 1, 0); PG8_SCHED; PG8_LDA(At, 1, 0); PG8_STAGE(PG8_SA(0, 1), a2 + hstep, voffA);
            PG8_WAIT_L(8); PG8_BAR; PG8_WAIT_L(0); PG8_MMA(0, 0, At, B0); PG8_BAR; PG8_SCHED;
            PG8_LDB(B1, 1, 1); PG8_STAGE(PG8_SB(1, 0), b3, voffB);
            PG8_BAR; PG8_WAIT_L(0); PG8_MMA(0, 1, At, B1); PG8_BAR;
            PG8_LDA(At, 1, 1); PG8_STAGE(PG8_SA(1, 0), a3, voffA);
            PG8_BAR; PG8_WAIT_L(0); PG8_MMA(1, 0, At, B0); PG8_BAR; PG8_SCHED;
            PG8_STAGE(PG8_SB(1, 1), b3 + hstep, voffB);
            PG8_WAIT_V(6); PG8_BAR; PG8_MMA(1, 1, At, B1); PG8_BAR;
        }
        PG8_STAMP();
        if constexpr (!Epi::AFTER_DRAIN) { E(acc, cur, wr, wc, fr, fq); S.done(cur); }
        PG8_STAMP();
        if (!has_next) break;
#pragma unroll
        for (int a = 0; a < 2; ++a)
#pragma unroll
            for (int b = 0; b < 2; ++b)
#pragma unroll
                for (int m = 0; m < 4; ++m)
#pragma unroll
                    for (int n = 0; n < 2; ++n) acc[a][b][m][n] = (f32x4){0.f, 0.f, 0.f, 0.f};
        cur = nxt; cA = nA; cB = nB; ++ui;
    }
    PG8_WAIT_V(0);
    if (wr == 0) PG8_BAR;
    PG8_BAR;
    if constexpr (Epi::AFTER_DRAIN) { E.fused(acc, cur, wr, wc, fr, fq, lds, wid, lane); S.done(cur); }
    PG8_STAMP();
    if (STAMP && wid == 0) { stamps[lane] = lane < nts ? (((unsigned long long)(unsigned)ts_hi << 32) | (unsigned)ts_lo) : 0ull;
        if (lane == 62) stamps[62] = rt_entry; if (lane == 63) stamps[63] = (unsigned long long)wall_clock64(); }
#undef PG8_STAMP
#undef PG8_SA
#undef PG8_SB
#undef PG8_STAGE
#undef PG8_LDA
#undef PG8_LDB
#undef PG8_MMA
#undef PG8_WAIT_V
#undef PG8_WAIT_L
#undef PG8_BAR
#undef PG8_SCHED
}
}

typedef unsigned short bf16_t;
typedef short bf16x8 __attribute__((ext_vector_type(8)));
typedef float f32x4 __attribute__((ext_vector_type(4)));
typedef float f32x16 __attribute__((ext_vector_type(16)));
#define LAS __attribute__((address_space(3)))
#define WAVE_SYNC() do { asm volatile("s_waitcnt lgkmcnt(0)" ::: "memory"); __builtin_amdgcn_wave_barrier(); } while (0)

constexpr int DM = 1024, NP = 16384, NSMP = 256, MR = 16640, SEQ = 4096, NB = 4, DB = 32, DS = 8, PAST = 16384;
constexpr int CIN = 6040, NPAD = 6144, CR = 1664;
constexpr int NTHR = 512;
constexpr size_t O_Y_P = 0, O_Y_S = 16777216, O_CMP_P = 17039360, O_CMP_S = 21233664, O_SEL_P = 21299200, O_SEL_S = 25493504,
                 O_WIN_P = 25559040, O_WIN_S = 26083328, O_WKV_P = 30277632, O_WKV_S = 30408704, O_SH_P = 31457280, O_SH_S = 31463936;

constexpr size_t ws_al(size_t x) { return (x + 255) & ~(size_t)255; }
constexpr size_t WS_bar = 0;
constexpr size_t WS_hb = WS_bar + ws_al(32768);
constexpr size_t WS_WinT = WS_hb + ws_al((size_t)MR * DM * 2);
constexpr size_t WS_WpaT = WS_WinT + ws_al((size_t)NPAD * DM * 2);
constexpr size_t WS_WpbT = WS_WpaT + ws_al((size_t)DM * 512 * 2);
constexpr size_t WS_WoutT = WS_WpbT + ws_al((size_t)DM * 512 * 2);
constexpr size_t WS_WgateT = WS_WoutT + ws_al((size_t)DM * DM * 2);
constexpr size_t WS_WprojT = WS_WgateT + ws_al((size_t)DM * DM * 2);
constexpr size_t WS_W1T = WS_WprojT + ws_al((size_t)DM * 256 * 2);
constexpr size_t WS_W2T = WS_W1T + ws_al((size_t)512 * 1024 * 2);
constexpr size_t WS_WupT = WS_W2T + ws_al((size_t)128 * 128 * 2);
constexpr size_t WS_AupT = WS_WupT + ws_al((size_t)512 * 64 * 2);
constexpr size_t WS_pb = WS_AupT + ws_al((size_t)512 * 64 * 2);
constexpr size_t WS_tabc = WS_pb + ws_al((size_t)MR * 256 * 2);
constexpr size_t WS_tabs = WS_tabc + ws_al((size_t)4104 * 32 * 4);
constexpr size_t WS_pt = WS_tabs + ws_al((size_t)4104 * 32 * 4);
constexpr size_t WS_qb = WS_pt + ws_al(256 * 4);
constexpr size_t WS_kb = WS_qb + ws_al((size_t)MR * 512 * 2);
constexpr size_t WS_vcr = WS_kb + ws_al((size_t)3 * NB * 2 * SEQ * 64 * 2);
constexpr size_t WS_vT = WS_vcr + ws_al((size_t)NB * 2 * SEQ * 64 * 2);
constexpr size_t WS_ag = WS_vT + ws_al((size_t)2 * NB * 2 * 64 * SEQ * 2);
constexpr size_t WS_rg = WS_ag + ws_al((size_t)MR * 512 * 2);
constexpr size_t WS_mg = WS_rg + ws_al((size_t)MR * 512 * 2);
constexpr size_t WS_gates = WS_mg + ws_al((size_t)MR * 2048 * 2);
constexpr size_t WS_rz = WS_gates + ws_al((size_t)MR * 32 * 4);
constexpr size_t WS_zs0 = WS_rz + ws_al((size_t)MR * CR * 2);
constexpr size_t WS_LHp = WS_zs0 + ws_al((size_t)33 * CR * 2);
constexpr size_t WS_LHs = WS_LHp + ws_al((size_t)2 * 2048 * 256 * 4);
constexpr size_t WS_cs = WS_LHs + ws_al((size_t)2 * 65536 * 256 * 4);
constexpr size_t WS_kc_p = WS_cs + ws_al((size_t)2 * 65536 * 1024 * 2);
constexpr size_t WS_vcT_p = WS_kc_p + ws_al((size_t)8 * 256 * 64 * 2);
constexpr size_t WS_kc_s = WS_vcT_p + ws_al((size_t)8 * 64 * 256 * 2);
constexpr size_t WS_vcT_s = WS_kc_s + ws_al((size_t)64 * 1024 * 64 * 2);
constexpr size_t WS_rw6 = WS_vcT_s + ws_al((size_t)64 * 64 * 1024 * 2);
constexpr int RW6_STRIDE = 896;
constexpr size_t WS_bonus = WS_rw6 + ws_al((size_t)MR * 8 * RW6_STRIDE);
constexpr size_t WS_ybuf = WS_bonus + ws_al((size_t)MR * 8 * 4);
constexpr size_t WS_oa = WS_ybuf + ws_al((size_t)MR * 512 * 4);
constexpr size_t WS_ob = WS_oa + ws_al((size_t)MR * 512 * 2);
constexpr size_t WS_mb = WS_ob + ws_al((size_t)MR * 512 * 2);
constexpr size_t WS_xg = WS_mb + ws_al((size_t)MR * DM * 2);
constexpr size_t WS_tmp = WS_xg + ws_al((size_t)MR * DM * 2);
constexpr size_t WS_x1 = WS_tmp + ws_al((size_t)MR * DM * 4);
constexpr size_t WS_ss1 = WS_x1 + ws_al((size_t)MR * DM * 4);
constexpr size_t WS_pp = WS_ss1 + ws_al((size_t)MR * 16 * 4);
constexpr size_t WS_TOTAL = WS_pp + ws_al((size_t)MR * DM * 4);

struct P {
    const float *x_prompt, *x_sample, *p_prompt, *p_sample, *cache_cmp, *cache_sel, *cache_win, *state_wkv, *state_shift;
    const int* page_table;
    const float *norm_g, *w_in, *cmp_pe, *cmp_w1, *cmp_b1, *cmp_w2, *cmp_b2, *w_pa, *mu, *w0, *w_up, *a0, *a_up, *k_k, *k_a, *r_k, *gn_g, *gn_b,
        *w_pb, *w_out, *ple_g, *w_gate, *w_proj, *final_g;
    float* out;
    unsigned char* ws;
    __host__ __device__ __forceinline__ unsigned* bar() const { return (unsigned*)(ws + WS_bar); }
    __host__ __device__ __forceinline__ float* ss_s() const { return (float*)(ws + WS_bar + 16384); }
    __host__ __device__ __forceinline__ bf16_t* hb() const { return (bf16_t*)(ws + WS_hb); }
    __host__ __device__ __forceinline__ bf16_t* WinT() const { return (bf16_t*)(ws + WS_WinT); }
    __host__ __device__ __forceinline__ bf16_t* WpaT() const { return (bf16_t*)(ws + WS_WpaT); }
    __host__ __device__ __forceinline__ bf16_t* WpbT() const { return (bf16_t*)(ws + WS_WpbT); }
    __host__ __device__ __forceinline__ bf16_t* WoutT() const { return (bf16_t*)(ws + WS_WoutT); }
    __host__ __device__ __forceinline__ bf16_t* WgateT() const { return (bf16_t*)(ws + WS_WgateT); }
    __host__ __device__ __forceinline__ bf16_t* WprojT() const { return (bf16_t*)(ws + WS_WprojT); }
    __host__ __device__ __forceinline__ bf16_t* W1T() const { return (bf16_t*)(ws + WS_W1T); }
    __host__ __device__ __forceinline__ bf16_t* W2T() const { return (bf16_t*)(ws + WS_W2T); }
    __host__ __device__ __forceinline__ bf16_t* WupT() const { return (bf16_t*)(ws + WS_WupT); }
    __host__ __device__ __forceinline__ bf16_t* AupT() const { return (bf16_t*)(ws + WS_AupT); }
    __host__ __device__ __forceinline__ bf16_t* pb() const { return (bf16_t*)(ws + WS_pb); }
    __host__ __device__ __forceinline__ float* tabc() const { return (float*)(ws + WS_tabc); }
    __host__ __device__ __forceinline__ float* tabs() const { return (float*)(ws + WS_tabs); }
    __host__ __device__ __forceinline__ float* pt() const { return (float*)(ws + WS_pt); }
    __host__ __device__ __forceinline__ bf16_t* qb() const { return (bf16_t*)(ws + WS_qb); }
    __host__ __device__ __forceinline__ bf16_t* kb() const { return (bf16_t*)(ws + WS_kb); }
    __host__ __device__ __forceinline__ bf16_t* vcr() const { return (bf16_t*)(ws + WS_vcr); }
    __host__ __device__ __forceinline__ bf16_t* vT() const { return (bf16_t*)(ws + WS_vT); }
    __host__ __device__ __forceinline__ bf16_t* ag() const { return (bf16_t*)(ws + WS_ag); }
    __host__ __device__ __forceinline__ bf16_t* rg() const { return (bf16_t*)(ws + WS_rg); }
    __host__ __device__ __forceinline__ bf16_t* mg() const { return (bf16_t*)(ws + WS_mg); }
    __host__ __device__ __forceinline__ float* gates() const { return (float*)(ws + WS_gates); }
    __host__ __device__ __forceinline__ bf16_t* rz() const { return (bf16_t*)(ws + WS_rz); }
    __host__ __device__ __forceinline__ bf16_t* zs0() const { return (bf16_t*)(ws + WS_zs0); }
    __host__ __device__ __forceinline__ bf16_t* LHp() const { return (bf16_t*)(ws + WS_LHp); }
    __host__ __device__ __forceinline__ bf16_t* LHs() const { return (bf16_t*)(ws + WS_LHs); }
    __host__ __device__ __forceinline__ bf16_t* cs() const { return (bf16_t*)(ws + WS_cs); }
    __host__ __device__ __forceinline__ bf16_t* kc_p() const { return (bf16_t*)(ws + WS_kc_p); }
    __host__ __device__ __forceinline__ bf16_t* vcT_p() const { return (bf16_t*)(ws + WS_vcT_p); }
    __host__ __device__ __forceinline__ bf16_t* kc_s() const { return (bf16_t*)(ws + WS_kc_s); }
    __host__ __device__ __forceinline__ bf16_t* vcT_s() const { return (bf16_t*)(ws + WS_vcT_s); }
    __host__ __device__ __forceinline__ unsigned char* rw6() const { return ws + WS_rw6; }
    __host__ __device__ __forceinline__ float* bonus() const { return (float*)(ws + WS_bonus); }
    __host__ __device__ __forceinline__ float* ybuf() const { return (float*)(ws + WS_ybuf); }
    __host__ __device__ __forceinline__ bf16_t* oa() const { return (bf16_t*)(ws + WS_oa); }
    __host__ __device__ __forceinline__ bf16_t* ob() const { return (bf16_t*)(ws + WS_ob); }
    __host__ __device__ __forceinline__ bf16_t* mb() const { return (bf16_t*)(ws + WS_mb); }
    __host__ __device__ __forceinline__ bf16_t* xg() const { return (bf16_t*)(ws + WS_xg); }
    __host__ __device__ __forceinline__ float* tmp() const { return (float*)(ws + WS_tmp); }
    __host__ __device__ __forceinline__ float* x1() const { return (float*)(ws + WS_x1); }
    __host__ __device__ __forceinline__ float* ss1() const { return (float*)(ws + WS_ss1); }
    __host__ __device__ __forceinline__ float* pp() const { return (float*)(ws + WS_pp); }
};


__device__ __forceinline__ float bf2f(bf16_t b) { return __uint_as_float(((unsigned)b) << 16); }
typedef __bf16 bf16v2_t __attribute__((ext_vector_type(2)));
typedef float f32x2_t __attribute__((ext_vector_type(2)));
__device__ __forceinline__ unsigned pk2(float lo, float hi) { const f32x2_t v = {lo, hi}; return __builtin_bit_cast(unsigned, __builtin_convertvector(v, bf16v2_t)); }
__device__ __forceinline__ bf16_t f2bf(float f) { return (bf16_t)(pk2(f, f) & 0xffffu); }
__device__ __forceinline__ float xsum16(float v) { const auto r = __builtin_amdgcn_permlane16_swap(__float_as_uint(v), __float_as_uint(v), false, false); return __uint_as_float(r[0]) + __uint_as_float(r[1]); }
__device__ __forceinline__ float xsum32(float v) { const auto r = __builtin_amdgcn_permlane32_swap(__float_as_uint(v), __float_as_uint(v), false, false); return __uint_as_float(r[0]) + __uint_as_float(r[1]); }
__device__ __forceinline__ float xmax32(float v) { const auto r = __builtin_amdgcn_permlane32_swap(__float_as_uint(v), __float_as_uint(v), false, false); return fmaxf(__uint_as_float(r[0]), __uint_as_float(r[1])); }
__device__ __forceinline__ float quad_sum(float v) {
    v += __builtin_bit_cast(float, __builtin_amdgcn_mov_dpp(__builtin_bit_cast(int, v), 0xB1, 0xF, 0xF, true));
    v += __builtin_bit_cast(float, __builtin_amdgcn_mov_dpp(__builtin_bit_cast(int, v), 0x4E, 0xF, 0xF, true));
    return v;
}
__device__ __forceinline__ float wave_sum(float v) {
    v += __builtin_bit_cast(float, __builtin_amdgcn_mov_dpp(__builtin_bit_cast(int, v), 0xB1, 0xF, 0xF, true));
    v += __builtin_bit_cast(float, __builtin_amdgcn_mov_dpp(__builtin_bit_cast(int, v), 0x4E, 0xF, 0xF, true));
    v += __builtin_bit_cast(float, __builtin_amdgcn_mov_dpp(__builtin_bit_cast(int, v), 0x141, 0xF, 0xF, true));
    v += __builtin_bit_cast(float, __builtin_amdgcn_mov_dpp(__builtin_bit_cast(int, v), 0x140, 0xF, 0xF, true));
    return xsum32(xsum16(v));
}
__device__ __forceinline__ float sigmoidf_(float x) { return 1.0f / (1.0f + __expf(-x)); }
__device__ __forceinline__ float siluf_(float x) { return x / (1.0f + __expf(-x)); }
__device__ __forceinline__ float sigmoid_fast(float x) { return __builtin_amdgcn_rcpf(1.0f + __expf(-x)); }
__device__ __forceinline__ float silu_fast(float x) { return x * __builtin_amdgcn_rcpf(1.0f + __expf(-x)); }

__device__ __forceinline__ int win_src_col(int np) {
    const int pn = np >> 8, p = np & 255;
    if (pn < 5) {
        const int bj = p >> 7, wc = (p >> 5) & 3, n = (p >> 4) & 1, fq = (p >> 2) & 3, e = p & 3;
        const int d = 32 * n + 16 * (wc & 1) + 4 * fq + e;
        if (pn < 2) { const int head = pn * 4 + bj * 2 + (wc >> 1); return head * 64 + d; }
        const int br = pn - 2, g = wc >> 1;
        return 512 + br * 256 + bj * 128 + g * 64 + d;
    }
    const int s = (p & 0xe0) + 8 * ((p >> 2) & 3) + 4 * ((p >> 4) & 1) + (p & 3);
    if (pn < 7) return 1304 + (pn - 5) * 256 + s;
    if (pn < 13) return 1816 + (pn - 7) * 256 + s;
    if (pn == 13) { if (s < 128) return 1816 + 1536 + s; if (s < 152) return 1280 + (s - 128); return -1; }
    if (pn < 16) return 3480 + (pn - 14) * 256 + s;
    return 3992 + (pn - 16) * 256 + s;
}

__device__ __forceinline__ int perm8(int np) { return (np & ~31) + 8 * ((np >> 2) & 3) + 4 * ((np >> 4) & 1) + (np & 3); }
template <class F>
__device__ __forceinline__ void transpose_cvt(bf16_t* dst, int Nd, int K, F f) {
    const int total = Nd * (K >> 3);
    for (int id = blockIdx.x * NTHR + threadIdx.x; id < total; id += gridDim.x * NTHR) {
        const int n = id % Nd, kc = id / Nd;
        float v[8];
#pragma unroll
        for (int j = 0; j < 8; ++j) v[j] = f(n, kc * 8 + j);
        uint4 w; w.x = pk2(v[0], v[1]); w.y = pk2(v[2], v[3]); w.z = pk2(v[4], v[5]); w.w = pk2(v[6], v[7]);
        *(uint4*)(dst + (size_t)n * K + kc * 8) = w;
    }
}

__device__ __forceinline__ void sincos_small(double r, float& s, float& c) {
    const double r2 = r * r;
    double sa = 1.0, ca = 1.0;
    double ts = 1.0, tc = 1.0; sa = 0.0; ca = 0.0;
#pragma unroll
    for (int k = 0; k < 16; ++k) {
        sa += ts; ca += tc;
        ts = -ts * r2 / (double)((2 * k + 2) * (2 * k + 3));
        tc = -tc * r2 / (double)((2 * k + 1) * (2 * k + 2));
    }
    s = (float)(sa * r); c = (float)ca;
}

__device__ __forceinline__ void ph_prep(const P& p) {
    const int tid = threadIdx.x, lane = tid & 63, wid = tid >> 6;
    const int gw = blockIdx.x * 8 + wid, nw = gridDim.x * 8;
    const int gt = blockIdx.x * NTHR + tid, nt = gridDim.x * NTHR;
    for (int row = gw; row < MR; row += nw) {
        const float4* src = (const float4*)(row < NP ? p.x_prompt + (size_t)row * DM : p.x_sample + (size_t)(row - NP) * DM);
        float4 v[4]; float ss = 0.f;
#pragma unroll
        for (int i = 0; i < 4; ++i) { v[i] = src[lane + 64 * i]; ss += v[i].x * v[i].x + v[i].y * v[i].y + v[i].z * v[i].z + v[i].w * v[i].w; }
        ss = wave_sum(ss);
        const float rstd = rsqrtf(ss * (1.0f / DM) + 1e-6f);
#pragma unroll
        for (int i = 0; i < 4; ++i) {
            const float4 g = ((const float4*)p.norm_g)[lane + 64 * i];
            uint2 w; w.x = pk2(v[i].x * rstd * g.x, v[i].y * rstd * g.y); w.y = pk2(v[i].z * rstd * g.z, v[i].w * rstd * g.w);
            *(uint2*)(p.hb() + (size_t)row * DM + 4 * (lane + 64 * i)) = w;
        }
    }
    { const float* w = p.w_in; transpose_cvt(p.WinT(), NPAD, DM, [=](int n, int k) { const int c = win_src_col(n); return c < 0 ? 0.f : w[(size_t)k * CIN + c]; }); }
    { const float* w = p.w_pa; transpose_cvt(p.WpaT(), DM, 512, [=](int n, int k) { return w[(size_t)k * DM + perm8(n)]; }); }
    { const float* w = p.w_pb; transpose_cvt(p.WpbT(), DM, 512, [=](int n, int k) { return w[(size_t)k * DM + perm8(n)]; }); }
    { const float* w = p.w_out; transpose_cvt(p.WoutT(), DM, DM, [=](int n, int k) { return w[(size_t)k * DM + perm8(n)]; }); }
    { const float* w = p.w_gate; transpose_cvt(p.WgateT(), DM, DM, [=](int n, int k) { return w[(size_t)k * DM + perm8(n)]; }); }
    { const float* w = p.w_proj; transpose_cvt(p.WprojT(), DM, 256, [=](int n, int k) { return w[(size_t)k * DM + perm8(n)]; }); }
    { const float* w = p.cmp_w1; transpose_cvt(p.W1T(), 512, 1024, [=](int n, int k) { const int kvi = n >> 8, nn = n & 255; return w[(size_t)kvi * 262144 + (size_t)((nn >> 7) * 1024 + k) * 128 + (nn & 127)]; }); }
    { const float* w = p.cmp_w2; transpose_cvt(p.W2T(), 128, 128, [=](int n, int k) { return w[(size_t)(n >> 6) * 8192 + (size_t)k * 64 + (n & 63)]; }); }
    { const float* w = p.w_up; transpose_cvt(p.WupT(), 512, 64, [=](int n, int k) { return w[(size_t)k * 512 + n]; }); }
    { const float* w = p.a_up; transpose_cvt(p.AupT(), 512, 64, [=](int n, int k) { return w[(size_t)k * 512 + n]; }); }
    for (int id = gt; id < 33 * CR; id += nt) p.zs0()[id] = id < CR ? (bf16_t)0 : f2bf(p.state_shift[id - CR]);
    for (int id = gt; id < MR * 64; id += nt) {
        const int row = id >> 6, c4 = id & 63;
        const float4 v = ((const float4*)(row < NP ? p.p_prompt + (size_t)row * 256 : p.p_sample + (size_t)(row - NP) * 256))[c4];
        uint2 w; w.x = pk2(v.x, v.y); w.y = pk2(v.z, v.w);
        *(uint2*)(p.pb() + (size_t)row * 256 + c4 * 4) = w;
    }
    for (int id = gt; id < 4104 * 32; id += nt) {
        const int pi = id >> 5, i = id & 31;
        const int pos = pi < 4096 ? pi : PAST + pi - 4096;
        const float inv = (float)exp(-(double)i * (9.210340371976184 / 32.0));
        const float ang = (float)pos * inv;
        const double x = (double)ang;
        const double k = rint(x * 0.15915494309189535);
        const double r = x - k * 6.283185307179586;
        float s, c; sincos_small(r, s, c);
        p.tabc()[id] = c; p.tabs()[id] = s;
    }
    for (int o = gw; o < 256; o += nw) {
        const int kvi = o >> 7, f = o & 127;
        float acc = 0.f;
        for (int jd = lane; jd < 2048; jd += 64) acc += p.cmp_pe[kvi * 2048 + jd] * p.cmp_w1[(size_t)kvi * 262144 + (size_t)jd * 128 + f];
        acc = wave_sum(acc);
        if (lane == 0) p.pt()[o] = acc + p.cmp_b1[o];
    }
    for (int id = gt; id < DB * 504 * 64; id += nt) {
        const int c4 = id & 63, j = (id >> 6) % 504, b = (id >> 6) / 504;
        ((float4*)(p.out + O_WIN_S))[((size_t)b * 512 + j) * 64 + c4] = ((const float4*)p.cache_win)[((size_t)b * 512 + j + 8) * 64 + c4];
    }
}
#define XB_TMO      128
#define XB_XCNT(j)  (256  + 64 * (j))
#define XB_XSUB(j)  (1280 + 64 * (j))
#define XB_XGEN(j)  (2304 + 64 * (j))
#define XB_TOP      3328
#define XB_TOPGEN   3392
#define XCD_BAR_WORDS 3456
#define XB_SPIN_CAP (1u << 18)

__device__ __forceinline__ unsigned xb_ld(unsigned* p)              { return __hip_atomic_load(p, __ATOMIC_RELAXED, __HIP_MEMORY_SCOPE_AGENT); }
__device__ __forceinline__ unsigned xb_add(unsigned* p, unsigned v) { return __hip_atomic_fetch_add(p, v, __ATOMIC_RELAXED, __HIP_MEMORY_SCOPE_AGENT); }
__device__ __forceinline__ unsigned xb_xcc_id() { return (unsigned)__builtin_amdgcn_s_getreg((3 << 11) | 20) & 0xFu; }
#define XB_SPIN(cond, bar) do { unsigned _sp = 0; while (cond) { __builtin_amdgcn_s_sleep(1); \
    if ((++_sp & 255u) == 0u) { if (xb_ld(&(bar)[XB_TMO])) break; if (_sp > XB_SPIN_CAP) { atomicAdd(&(bar)[XB_TMO], 1u); break; } } } } while (0)

struct XcdBarrier {
    unsigned* bar; unsigned x;
    volatile LAS unsigned* st;
};

__device__ __forceinline__ XcdBarrier xcd_barrier_post(unsigned* bar, volatile LAS unsigned* st) {
    XcdBarrier b; b.bar = bar; b.x = xb_xcc_id(); b.st = st;
    if (threadIdx.x == 0) (void)xb_add(&bar[XB_XCNT(b.x)], 1u);
    return b;
}
__device__ __forceinline__ void xcd_barrier_complete(unsigned* bar, unsigned x, unsigned& nloc, unsigned& nx) {
    const unsigned G = gridDim.x * gridDim.y * gridDim.z;
    unsigned sum, cnt, mine, sp = 0u;
    for (;;) {
        sum = 0u; cnt = 0u; mine = 0u;
#pragma unroll
        for (unsigned j = 0; j < 16; ++j) { const unsigned c = xb_ld(&bar[XB_XCNT(j)]); sum += c; cnt += (c > 0u) ? 1u : 0u; mine = (j == x) ? c : mine; }
        if (sum == G) break;
        __builtin_amdgcn_s_sleep(1);
        if ((++sp & 255u) == 0u) { if (xb_ld(&bar[XB_TMO])) break; if (sp > XB_SPIN_CAP) { atomicAdd(&bar[XB_TMO], 1u); break; } }
    }
    nloc = mine > 0u ? mine : 1u; nx = cnt > 0u ? cnt : 1u;
}

__device__ __forceinline__ void xcd_barrier(const XcdBarrier& b) {
    asm volatile("s_waitcnt vmcnt(0)" ::: "memory");
    __syncthreads();
    if (threadIdx.x == 0) {
        unsigned* bar = b.bar;
        __builtin_amdgcn_s_waitcnt(0);
        unsigned nloc = b.st[0], nx = b.st[1];
        if (nloc == 0u) { xcd_barrier_complete(bar, b.x, nloc, nx); b.st[0] = nloc; b.st[1] = nx; }
        const unsigned old = xb_add(&bar[XB_XSUB(b.x)], 1u);
        const unsigned gen = old / nloc;
        if (old + 1u == (gen + 1u) * nloc) {
            __builtin_amdgcn_fence(__ATOMIC_RELEASE, "agent");
            asm volatile("s_waitcnt vmcnt(0)" ::: "memory");
            const unsigned og = xb_add(&bar[XB_TOP], 1u);
            const unsigned tg = og / nx;
            if (og + 1u == (tg + 1u) * nx) xb_add(&bar[XB_TOPGEN], 1u);
            else XB_SPIN(xb_ld(&bar[XB_TOPGEN]) == tg, bar);
            __builtin_amdgcn_fence(__ATOMIC_ACQUIRE, "agent");
            xb_add(&bar[XB_XGEN(b.x)], 1u);
            asm volatile("s_waitcnt vmcnt(0)" ::: "memory");
        } else {
            XB_SPIN(xb_ld(&bar[XB_XGEN(b.x)]) == gen, bar);
            __builtin_amdgcn_fence(__ATOMIC_ACQUIRE, "agent");
            asm volatile("s_waitcnt vmcnt(0)" ::: "memory");
        }
    }
    __syncthreads();
}

using pg8::Unit;
typedef unsigned u32x2 __attribute__((ext_vector_type(2)));
typedef unsigned u32x4_t __attribute__((ext_vector_type(4)));
__device__ __forceinline__ f32x16 mfma32(bf16x8 a, bf16x8 b, f32x16 c) { return __builtin_amdgcn_mfma_f32_32x32x16_bf16(a, b, c, 0, 0, 0); }
__device__ __forceinline__ bf16x8 pack8(float a0, float a1, float a2, float a3, float a4, float a5, float a6, float a7) {
    union { uint4 u; bf16x8 v; } x; x.u.x = pk2(a0, a1); x.u.y = pk2(a2, a3); x.u.z = pk2(a4, a5); x.u.w = pk2(a6, a7); return x.v;
}
__device__ __forceinline__ f32x16 zero16() { f32x16 z; for (int i = 0; i < 16; ++i) z[i] = 0.f; return z; }


__device__ __forceinline__ void st_bf4(bf16_t* dst, f32x4 v) { uint2 w; w.x = pk2(v[0], v[1]); w.y = pk2(v[2], v[3]); *(uint2*)dst = w; }

constexpr float QSCALE = 0.125f * 1.4426950408889634f;
struct EpiIn {
    static constexpr bool PERM = false, AFTER_DRAIN = false;
    P p; int row0; int pn0;
    __device__ __forceinline__ void operator()(const f32x4 (&acc)[2][2][4][2], const Unit& u, int wr, int wc, int fr, int fq) const {
        const int pn = pn0 + u.pn;
#pragma unroll
        for (int ai = 0; ai < 2; ++ai)
#pragma unroll
            for (int m = 0; m < 4; ++m) {
                const int row = row0 + u.pm * 256 + ai * 128 + wr * 64 + m * 16 + fr;
                if (pn < 5) {
                    const int pi = row < NP ? (row & (SEQ - 1)) : 4096 + ((row - NP) & 7);
                    const int d0 = 16 * (wc & 1) + 4 * fq;
                    const f32x4 cs = *(const f32x4*)(p.tabc() + pi * 32 + d0), sn = *(const f32x4*)(p.tabs() + pi * 32 + d0);
#pragma unroll
                    for (int bj = 0; bj < 2; ++bj) {
                        const f32x4 x1 = acc[ai][bj][m][0], x2 = acc[ai][bj][m][1];
                        if (pn < 2) {
                            const int head = pn * 4 + bj * 2 + (wc >> 1);
                            const f32x4 o1 = (x1 * cs - x2 * sn) * QSCALE, o2 = (x2 * cs + x1 * sn) * QSCALE;
                            bf16_t* q = p.qb() + (size_t)row * 512 + head * 64 + d0;
                            st_bf4(q, o1); st_bf4(q + 32, o2);
                        } else {
                            const int br = pn - 2, g = wc >> 1;
                            f32x4 o1, o2;
                            if (bj == 0) { o1 = x1 * cs - x2 * sn; o2 = x2 * cs + x1 * sn; } else { o1 = x1; o2 = x2; }
                            float* dst = nullptr;
                            if (row < NP) {
                                if (br == 0) dst = p.out + O_CMP_P + (size_t)row * 256;
                                else if (br == 1) dst = p.out + O_SEL_P + (size_t)row * 256;
                                else { const int s = row & (SEQ - 1); if (s >= SEQ - 512) dst = p.out + O_WIN_P + ((size_t)(row >> 12) * 512 + (s - (SEQ - 512))) * 256; }
                            } else {
                                const int rs = row - NP;
                                if (br == 0) dst = p.out + O_CMP_S + (size_t)rs * 256;
                                else if (br == 1) dst = p.out + O_SEL_S + (size_t)rs * 256;
                                else dst = p.out + O_WIN_S + ((size_t)(rs >> 3) * 512 + 504 + (rs & 7)) * 256;
                            }
                            if (dst) { dst += bj * 128 + g * 64 + d0; *(f32x4*)dst = o1; *(f32x4*)(dst + 32) = o2; }
                            if (row < NP) {
                                const int b = row >> 12, s = row & (SEQ - 1);
                                if (bj == 0) {
                                    bf16_t* k = p.kb() + ((size_t)((br * NB + b) * 2 + g) * SEQ + s) * 64 + d0;
                                    st_bf4(k, o1); st_bf4(k + 32, o2);
                                } else if (br == 0) {
                                    bf16_t* v = p.vcr() + ((size_t)(b * 2 + g) * SEQ + s) * 64 + d0;
                                    st_bf4(v, o1); st_bf4(v + 32, o2);
                                } else {
                                    bf16_t* v = p.vT() + ((size_t)(((br - 1) * NB + b) * 2 + g) * 64 + d0) * SEQ + s;
#pragma unroll
                                    for (int e = 0; e < 4; ++e) { v[(size_t)e * SEQ] = f2bf(o1[e]); v[(size_t)(32 + e) * SEQ] = f2bf(o2[e]); }
                                }
                            }
                        }
                    }
                } else {
#pragma unroll
                    for (int bj = 0; bj < 2; ++bj) {
                        const int c = bj * 128 + wc * 32 + fq * 8;
                        const f32x4 v0 = acc[ai][bj][m][0], v1 = acc[ai][bj][m][1];
                        auto st8 = [&](bf16_t* dst, const f32x4& a, const f32x4& b) { uint4 w; w.x = pk2(a[0], a[1]); w.y = pk2(a[2], a[3]); w.z = pk2(b[0], b[1]); w.w = pk2(b[2], b[3]); *(uint4*)dst = w; };
                        if (pn < 7 || (pn >= 14 && pn < 16)) {
                            f32x4 o0, o1; for (int e = 0; e < 4; ++e) { o0[e] = silu_fast(v0[e]); o1[e] = silu_fast(v1[e]); }
                            st8((pn < 7 ? p.ag() + (size_t)row * 512 + (pn - 5) * 256 : p.rg() + (size_t)row * 512 + (pn - 14) * 256) + c, o0, o1);
                        } else if (pn < 13) {
                            st8(p.rz() + (size_t)row * CR + (pn - 7) * 256 + c, v0, v1);
                        } else if (pn == 13) {
                            if (c < 128) st8(p.rz() + (size_t)row * CR + 1536 + c, v0, v1);
                            else if (c < 152) { f32x4 o0, o1; for (int e = 0; e < 4; ++e) { o0[e] = sigmoid_fast(v0[e]); o1[e] = sigmoid_fast(v1[e]); }
                                *(f32x4*)(p.gates() + (size_t)row * 32 + (c - 128)) = o0; *(f32x4*)(p.gates() + (size_t)row * 32 + (c - 128) + 4) = o1; }
                        } else {
                            f32x4 o0, o1; for (int e = 0; e < 4; ++e) { o0[e] = sigmoid_fast(v0[e]); o1[e] = sigmoid_fast(v1[e]); }
                            st8(p.mg() + (size_t)row * 2048 + (pn - 16) * 256 + c, o0, o1);
                        }
                    }
                }
            }
    }
};

struct EpiPlain {
    static constexpr bool PERM = false, AFTER_DRAIN = false;
    float* C; int ldc; int pad_;
    __device__ __forceinline__ void quad(int row, int c, f32x4 v) const { *(f32x4*)(C + (size_t)row * ldc + c) = v; }
    __device__ __forceinline__ void operator()(const f32x4 (&acc)[2][2][4][2], const Unit& u, int wr, int wc, int fr, int fq) const {
#pragma unroll
        for (int ai = 0; ai < 2; ++ai)
#pragma unroll
            for (int m = 0; m < 4; ++m) {
                float* rowp = C + (size_t)(u.pm * 256 + ai * 128 + wr * 64 + m * 16 + fr) * ldc + u.pn * 256 + wc * 32 + 8 * fq;
#pragma unroll
                for (int bj = 0; bj < 2; ++bj)
#pragma unroll
                    for (int n = 0; n < 2; ++n) *(f32x4*)(rowp + bj * 128 + n * 4) = acc[ai][bj][m][n];
            }
    }
};


struct EpiPlainBf {
    static constexpr bool PERM = false, AFTER_DRAIN = false;
    bf16_t* C; int ldc; int pad_;
    __device__ __forceinline__ void operator()(const f32x4 (&acc)[2][2][4][2], const Unit& u, int wr, int wc, int fr, int fq) const {
#pragma unroll
        for (int ai = 0; ai < 2; ++ai)
#pragma unroll
            for (int m = 0; m < 4; ++m) {
                bf16_t* rowp = C + (size_t)(u.pm * 256 + ai * 128 + wr * 64 + m * 16 + fr) * ldc + u.pn * 256 + wc * 32 + 4 * fq;
#pragma unroll
                for (int bj = 0; bj < 2; ++bj)
#pragma unroll
                    for (int n = 0; n < 2; ++n) st_bf4(rowp + bj * 128 + n * 16, acc[ai][bj][m][n]);
            }
    }
};

struct EpiYa {
    static constexpr bool PERM = false, AFTER_DRAIN = false;
    P p;
    __device__ __forceinline__ void quad(int row, int c, f32x4 v) const {
        const uint2 gw = *(const uint2*)(p.mg() + (size_t)row * 2048 + c);
        f32x4 g; g[0] = __uint_as_float(gw.x << 16); g[1] = __uint_as_float(gw.x & 0xffff0000u); g[2] = __uint_as_float(gw.y << 16); g[3] = __uint_as_float(gw.y & 0xffff0000u);
        *(f32x4*)(p.tmp() + (size_t)row * DM + c) = g * v;
    }
    __device__ __forceinline__ void operator()(const f32x4 (&acc)[2][2][4][2], const Unit& u, int wr, int wc, int fr, int fq) const {
#pragma unroll
        for (int ai = 0; ai < 2; ++ai)
#pragma unroll
            for (int m = 0; m < 4; ++m) {
                const int row = u.pm * 256 + ai * 128 + wr * 64 + m * 16 + fr;
#pragma unroll
                for (int bj = 0; bj < 2; ++bj)
#pragma unroll
                    for (int n = 0; n < 2; ++n) {
                        const int c = u.pn * 256 + bj * 128 + wc * 32 + fq * 8 + n * 4;
                        const uint2 gw = *(const uint2*)(p.mg() + (size_t)row * 2048 + c);
                        f32x4 g; g[0] = __uint_as_float(gw.x << 16); g[1] = __uint_as_float(gw.x & 0xffff0000u); g[2] = __uint_as_float(gw.y << 16); g[3] = __uint_as_float(gw.y & 0xffff0000u);
                        *(f32x4*)(p.tmp() + (size_t)row * DM + c) = g * acc[ai][bj][m][n];
                    }
            }
    }
};
struct EpiYb {
    static constexpr bool PERM = false, AFTER_DRAIN = false;
    P p;
    __device__ __forceinline__ void quad(int row, int c, f32x4 v) const {
        const uint2 gw = *(const uint2*)(p.mg() + (size_t)row * 2048 + 1024 + c);
        f32x4 g; g[0] = __uint_as_float(gw.x << 16); g[1] = __uint_as_float(gw.x & 0xffff0000u); g[2] = __uint_as_float(gw.y << 16); g[3] = __uint_as_float(gw.y & 0xffff0000u);
        st_bf4(p.mb() + (size_t)row * DM + c, *(const f32x4*)(p.tmp() + (size_t)row * DM + c) + g * v);
    }
    __device__ __forceinline__ void operator()(const f32x4 (&acc)[2][2][4][2], const Unit& u, int wr, int wc, int fr, int fq) const {
#pragma unroll
        for (int ai = 0; ai < 2; ++ai)
#pragma unroll
            for (int m = 0; m < 4; ++m) {
                const int row = u.pm * 256 + ai * 128 + wr * 64 + m * 16 + fr;
#pragma unroll
                for (int bj = 0; bj < 2; ++bj)
#pragma unroll
                    for (int n = 0; n < 2; ++n) {
                        const int c = u.pn * 256 + bj * 128 + wc * 32 + fq * 8 + n * 4;
                        const uint2 gw = *(const uint2*)(p.mg() + (size_t)row * 2048 + 1024 + c);
                        f32x4 g; g[0] = __uint_as_float(gw.x << 16); g[1] = __uint_as_float(gw.x & 0xffff0000u); g[2] = __uint_as_float(gw.y << 16); g[3] = __uint_as_float(gw.y & 0xffff0000u);
                        const f32x4 t = *(const f32x4*)(p.tmp() + (size_t)row * DM + c);
                        st_bf4(p.mb() + (size_t)row * DM + c, t + g * acc[ai][bj][m][n]);
                    }
            }
    }
};
struct EpiOut {
    static constexpr bool PERM = false, AFTER_DRAIN = false;
    P p;
    __device__ __forceinline__ void quad(int row, int c, f32x4 a) const {
        const float* xr = p.x_sample + (size_t)(row - NP) * DM;
        const f32x4 v = *(const f32x4*)(xr + c) + a;
        *(f32x4*)(p.x1() + (size_t)row * DM + c) = v;
        st_bf4(p.xg() + (size_t)row * DM + c, v * *(const f32x4*)(p.ple_g + c));
        atomicAdd(p.ss_s() + (row - NP), v[0] * v[0] + v[1] * v[1] + v[2] * v[2] + v[3] * v[3]);
    }
    __device__ __forceinline__ void operator()(const f32x4 (&acc)[2][2][4][2], const Unit& u, int wr, int wc, int fr, int fq) const {
#pragma unroll
        for (int ai = 0; ai < 2; ++ai)
#pragma unroll
            for (int m = 0; m < 4; ++m) {
                const int row = u.pm * 256 + ai * 128 + wr * 64 + m * 16 + fr;
                const float* xr = row < NP ? p.x_prompt + (size_t)row * DM : p.x_sample + (size_t)(row - NP) * DM;
                float ss = 0.f;
#pragma unroll
                for (int bj = 0; bj < 2; ++bj)
#pragma unroll
                    for (int n = 0; n < 2; ++n) {
                        const int c = u.pn * 256 + bj * 128 + wc * 32 + fq * 8 + n * 4;
                        const f32x4 v = *(const f32x4*)(xr + c) + acc[ai][bj][m][n];
                        *(f32x4*)(p.x1() + (size_t)row * DM + c) = v;
                        ss += v[0] * v[0] + v[1] * v[1] + v[2] * v[2] + v[3] * v[3];
                        st_bf4(p.xg() + (size_t)row * DM + c, v * *(const f32x4*)(p.ple_g + c));
                    }
                ss += __shfl_xor(ss, 16); ss += __shfl_xor(ss, 32);
                if (fq == 0) p.ss1()[(size_t)row * 16 + u.pn * 4 + wc] = ss;
            }
    }
};
struct EpiGate {
    static constexpr bool PERM = false, AFTER_DRAIN = false;
    P p;
    __device__ __forceinline__ void quad(int row, int c, f32x4 acc) const {
        const float rstd = rsqrtf(p.ss_s()[row - NP] * (1.0f / DM) + 1e-6f);
        const f32x4 a = acc * rstd;
        f32x4 g; for (int e = 0; e < 4; ++e) g[e] = sigmoidf_(a[e]);
        float* ppp = p.pp() + (size_t)row * DM + c;
        *(f32x4*)ppp = *(const f32x4*)(p.x1() + (size_t)row * DM + c) + g * *(const f32x4*)ppp;
    }
    __device__ __forceinline__ void operator()(const f32x4 (&acc)[2][2][4][2], const Unit& u, int wr, int wc, int fr, int fq) const {
#pragma unroll
        for (int ai = 0; ai < 2; ++ai)
#pragma unroll
            for (int m = 0; m < 4; ++m) {
                const int row = u.pm * 256 + ai * 128 + wr * 64 + m * 16 + fr;
                float ss = 0.f;
#pragma unroll
                for (int i = 0; i < 4; ++i) { const f32x4 t = *(const f32x4*)(p.ss1() + (size_t)row * 16 + i * 4); ss += (t[0] + t[1]) + (t[2] + t[3]); }
                const float rstd = rsqrtf(ss * (1.0f / DM) + 1e-6f);
#pragma unroll
                for (int bj = 0; bj < 2; ++bj)
#pragma unroll
                    for (int n = 0; n < 2; ++n) {
                        const int c = u.pn * 256 + bj * 128 + wc * 32 + fq * 8 + n * 4;
                        const f32x4 a = acc[ai][bj][m][n] * rstd;
                        f32x4 g; for (int e = 0; e < 4; ++e) g[e] = sigmoidf_(a[e]);
                        float* ppp = p.pp() + (size_t)row * DM + c;
                        *(f32x4*)ppp = *(const f32x4*)(p.x1() + (size_t)row * DM + c) + g * *(const f32x4*)ppp;
                    }
            }
    }
};

__device__ __forceinline__ void ph_final(const P& p) {
    const int tid = threadIdx.x, lane = tid & 63, wid = tid >> 6;
    for (int row = blockIdx.x * 8 + wid; row < MR; row += gridDim.x * 8) {
        const float4* src = (const float4*)(p.pp() + (size_t)row * DM);
        float4 v[4]; float ss = 0.f;
#pragma unroll
        for (int i = 0; i < 4; ++i) { v[i] = src[lane + 64 * i]; ss += v[i].x * v[i].x + v[i].y * v[i].y + v[i].z * v[i].z + v[i].w * v[i].w; }
        ss = wave_sum(ss);
        const float rstd = rsqrtf(ss * (1.0f / DM) + 1e-6f);
        float4* dst = (float4*)(p.out + (row < NP ? O_Y_P + (size_t)row * DM : O_Y_S + (size_t)(row - NP) * DM));
#pragma unroll
        for (int i = 0; i < 4; ++i) {
            const float4 g = ((const float4*)p.final_g)[lane + 64 * i];
            float4 o; o.x = v[i].x * rstd * g.x; o.y = v[i].y * rstd * g.y; o.z = v[i].z * rstd * g.z; o.w = v[i].w * rstd * g.w;
            dst[lane + 64 * i] = o;
        }
    }
}

typedef float f32x4v __attribute__((ext_vector_type(4)));
template <class Epi> __device__ __forceinline__ void small_gemm(const bf16_t* A, const bf16_t* Bt, int K, const Epi& E) {
    const int tid = threadIdx.x, lane = tid & 63, wid = tid >> 6, r16 = lane & 15, q4 = lane >> 4;
    for (int tile = blockIdx.x * 8 + wid; tile < 16 * 64; tile += gridDim.x * 8) {
        const int rt = tile & 15, ct = tile >> 4;
        const bf16_t* ap = A + (size_t)(NP + rt * 16 + r16) * K + 8 * q4;
        const bf16_t* bp = Bt + (size_t)(ct * 16 + r16) * K + 8 * q4;
        f32x4 acc = {0.f, 0.f, 0.f, 0.f};
#pragma unroll 1
        for (int k0 = 0; k0 < K; k0 += 256) {
            bf16x8 af[8], bf[8];
#pragma unroll
            for (int i = 0; i < 8; ++i) { af[i] = *(const bf16x8*)(ap + k0 + 32 * i); bf[i] = *(const bf16x8*)(bp + k0 + 32 * i); }
#pragma unroll
            for (int i = 0; i < 8; ++i) acc = __builtin_amdgcn_mfma_f32_16x16x32_bf16(bf[i], af[i], acc, 0, 0, 0);
        }
        E.quad(NP + rt * 16 + r16, (ct >> 1) * 32 + 8 * q4 + 4 * (ct & 1), acc);
    }
}

__device__ __forceinline__ f32x4 ld_bf4c(const bf16_t* q) { const uint2 w = *(const uint2*)q; f32x4 v; v[0] = __uint_as_float(w.x << 16); v[1] = __uint_as_float(w.x & 0xffff0000u); v[2] = __uint_as_float(w.y << 16); v[3] = __uint_as_float(w.y & 0xffff0000u); return v; }
__device__ __forceinline__ void compress2_tile(const P& p, const bf16_t* LH, int nbg, int nrows, int nblk, bf16_t* kc, bf16_t* vcT, int kvi, int bg, int tile, int lane, LAS unsigned char* wlds) {
    const int col = lane & 31, hb = lane >> 5;
    {
        const int i = tile * 32 + col;
        const bool live = i < nblk;
        const bf16_t* lbase = LH + ((size_t)kvi * nbg * nrows + (size_t)bg * nrows) * 256;
        const bf16_t* w2t = p.W2T() + (size_t)kvi * 64 * 128;
        LAS bf16_t* hs = (LAS bf16_t*)wlds;
        {
            const int rq = lane >> 4, c8 = lane & 15;
            const f32x4 pa = *(const f32x4*)(p.pt() + kvi * 128 + c8 * 8), pb = *(const f32x4*)(p.pt() + kvi * 128 + c8 * 8 + 4);
#pragma unroll
            for (int it = 0; it < 8; ++it) {
                const int rr = 4 * it + rq, gi = tile * 32 + rr;
                const bf16_t* rp = lbase + (size_t)(gi < nblk ? gi : 0) * 256 + c8 * 8;
                const uint4 lo = *(const uint4*)rp, hi = *(const uint4*)(rp + 256 + 128);
                float hv[8];
                const unsigned lw[4] = {lo.x, lo.y, lo.z, lo.w}, hw[4] = {hi.x, hi.y, hi.z, hi.w};
#pragma unroll
                for (int e = 0; e < 4; ++e) {
                    const float pe0 = e < 2 ? pa[2 * e] : pb[2 * e - 4], pe1 = e < 2 ? pa[2 * e + 1] : pb[2 * e - 3];
                    hv[2 * e] = siluf_(__uint_as_float(lw[e] << 16) + __uint_as_float(hw[e] << 16) + pe0);
                    hv[2 * e + 1] = siluf_(__uint_as_float(lw[e] & 0xffff0000u) + __uint_as_float(hw[e] & 0xffff0000u) + pe1);
                }
                *(LAS bf16x8*)(hs + rr * 136 + c8 * 8) = pack8(hv[0], hv[1], hv[2], hv[3], hv[4], hv[5], hv[6], hv[7]);
            }
        }
        WAVE_SYNC();
        f32x16 acc[2]; acc[0] = zero16(); acc[1] = zero16();
#pragma unroll
        for (int ks = 0; ks < 8; ++ks) {
            const int f = 16 * ks + 8 * hb;
            const bf16x8 hf = *(LAS const bf16x8*)(hs + col * 136 + f);
#pragma unroll
            for (int dt = 0; dt < 2; ++dt) {
                const bf16x8 wf = *(const bf16x8*)(w2t + (size_t)(32 * dt + col) * 128 + f);
                acc[dt] = (kvi == 0) ? mfma32(wf, hf, acc[dt]) : mfma32(hf, wf, acc[dt]);
            }
        }
        WAVE_SYNC();
        if (kvi == 0) {
            bf16_t* dst = kc + ((size_t)bg * nrows + i) * 64;
#pragma unroll
            for (int dt = 0; dt < 2; ++dt)
#pragma unroll
                for (int i4 = 0; i4 < 4; ++i4) {
                    const int d = 32 * dt + 8 * i4 + 4 * hb;
                    const f32x4 b2 = *(const f32x4*)(p.cmp_b2 + d);
                    f32x4 v; for (int e = 0; e < 4; ++e) v[e] = live ? acc[dt][4 * i4 + e] + b2[e] : 0.f;
                    st_bf4(dst + d, v);
                }
        } else {
#pragma unroll
            for (int dt = 0; dt < 2; ++dt) {
                const int d = 32 * dt + col;
                const float b2 = p.cmp_b2[64 + d];
                bf16_t* dst = vcT + ((size_t)bg * 64 + d) * nrows + tile * 32;
#pragma unroll
                for (int i4 = 0; i4 < 4; ++i4) {
                    const int r = 8 * i4 + 4 * hb;
                    f32x4 v; for (int e = 0; e < 4; ++e) v[e] = (tile * 32 + r + e) < nblk ? acc[dt][4 * i4 + e] + b2 : 0.f;
                    st_bf4(dst + r, v);
                }
            }
        }
    }
}

__device__ __forceinline__ void ph_compress2(const P& p, const bf16_t* LH, int nbg, int nrows, int nblk, bf16_t* kc, bf16_t* vcT, LAS unsigned char* lds) {
    const int tid = threadIdx.x, lane = tid & 63, wid = tid >> 6;
    const int ntile = nrows >> 5, total = 2 * nbg * ntile;
    for (int it = blockIdx.x * 8 + wid; it < total; it += gridDim.x * 8)
        compress2_tile(p, LH, nbg, nrows, nblk, kc, vcT, it / (ntile * nbg), (it / ntile) % nbg, it % ntile, lane, lds + wid * 8960);
}


__device__ __forceinline__ float dpp_row_sum16(float v) {
    v += __builtin_bit_cast(float, __builtin_amdgcn_mov_dpp(__builtin_bit_cast(int, v), 0xB1, 0xF, 0xF, true));
    v += __builtin_bit_cast(float, __builtin_amdgcn_mov_dpp(__builtin_bit_cast(int, v), 0x4E, 0xF, 0xF, true));
    v += __builtin_bit_cast(float, __builtin_amdgcn_mov_dpp(__builtin_bit_cast(int, v), 0x141, 0xF, 0xF, true));
    v += __builtin_bit_cast(float, __builtin_amdgcn_mov_dpp(__builtin_bit_cast(int, v), 0x140, 0xF, 0xF, true));
    return v;
}
__device__ __forceinline__ float tanh_fast(float x) { const float e = __expf(2.0f * x); return 1.0f - 2.0f / (e + 1.0f); }
__device__ __forceinline__ float half_sum32(float v) { return xsum16(dpp_row_sum16(v)); }
__device__ __forceinline__ const bf16_t* rwkv_prev_row(const P& p, int row) {
    if (row < NP) return (row & (SEQ - 1)) == 0 ? p.zs0() : p.rz() + (size_t)(row - 1) * CR;
    const int rs = row - NP;
    return (rs & 7) == 0 ? p.zs0() + (size_t)(1 + (rs >> 3)) * CR : p.rz() + (size_t)(row - 1) * CR;
}
__device__ __forceinline__ f32x4 ld_bf4(const bf16_t* q) { const uint2 w = *(const uint2*)q; f32x4 v; v[0] = __uint_as_float(w.x << 16); v[1] = __uint_as_float(w.x & 0xffff0000u); v[2] = __uint_as_float(w.y << 16); v[3] = __uint_as_float(w.y & 0xffff0000u); return v; }
__device__ __forceinline__ void ph_rwkv_prep(const P& p) {
    const int tid = threadIdx.x, lane = tid & 63, wid = tid >> 6, col = lane & 31, hb = lane >> 5;
    const int gw = blockIdx.x * 8 + wid, nw = gridDim.x * 8;
    for (int it = gw; it < NB + DB; it += nw) {
        const int row = it < NB ? it * SEQ + SEQ - 1 : NP + (it - NB) * 8 + 7;
        float* so = it < NB ? p.out + O_SH_P + (size_t)it * CR : p.out + O_SH_S + (size_t)(it - NB) * CR;
        const bf16_t* z = p.rz() + (size_t)row * CR;
        for (int i = lane; i < CR; i += 64) so[i] = bf2f(z[i]);
    }
    for (int rnd = 0; rnd < 3; ++rnd) {
        int it;
        if (rnd < 2) it = rnd * nw + gw; else { if (wid != 0 || (int)blockIdx.x >= 64) break; it = 2 * nw + (int)blockIdx.x; }
        if (it >= (MR / 32) * 8) break;
        const int h = it & 7, r0 = (it >> 3) * 32;
        bf16x8 Aw[4], Aa[4];
        {
            const int row = r0 + col;
            const bf16_t* z = p.rz() + (size_t)row * CR;
            const bf16_t* pv = rwkv_prev_row(p, row);
#pragma unroll
            for (int ks = 0; ks < 4; ++ks) {
                const int j0 = 16 * ks + 8 * hb;
                float tw[8], ta[8];
#pragma unroll
                for (int q = 0; q < 2; ++q) {
                    const f32x4 zw = ld_bf4(z + 1536 + j0 + 4 * q), za = ld_bf4(z + 1600 + j0 + 4 * q);
                    const f32x4 pw = ld_bf4(pv + 1536 + j0 + 4 * q), pa = ld_bf4(pv + 1600 + j0 + 4 * q);
                    const f32x4 mw = *(const f32x4*)(p.mu + 1536 + j0 + 4 * q), ma = *(const f32x4*)(p.mu + 1600 + j0 + 4 * q);
#pragma unroll
                    for (int e = 0; e < 4; ++e) { tw[4 * q + e] = tanh_fast(zw[e] + (pw[e] - zw[e]) * mw[e]); ta[4 * q + e] = za[e] + (pa[e] - za[e]) * ma[e]; }
                }
                Aw[ks] = pack8(tw[0], tw[1], tw[2], tw[3], tw[4], tw[5], tw[6], tw[7]);
                Aa[ks] = pack8(ta[0], ta[1], ta[2], ta[3], ta[4], ta[5], ta[6], ta[7]);
            }
        }
        f32x16 accw[2], acca[2];
#pragma unroll
        for (int ct = 0; ct < 2; ++ct) {
            accw[ct] = zero16(); acca[ct] = zero16();
            const size_t wo = (size_t)(h * 64 + 32 * ct + col) * 64 + 8 * hb;
#pragma unroll
            for (int ks = 0; ks < 4; ++ks) {
                accw[ct] = mfma32(Aw[ks], *(const bf16x8*)(p.WupT() + wo + 16 * ks), accw[ct]);
                acca[ct] = mfma32(Aa[ks], *(const bf16x8*)(p.AupT() + wo + 16 * ks), acca[ct]);
            }
        }
        float w0v[2], a0v[2], kkv[2], kav[2], rkv[2], mur[2], muk[2], muv[2];
#pragma unroll
        for (int ct = 0; ct < 2; ++ct) {
            const int c = h * 64 + 32 * ct + col;
            w0v[ct] = p.w0[c]; a0v[ct] = p.a0[c]; kkv[ct] = p.k_k[c]; kav[ct] = p.k_a[c]; rkv[ct] = p.r_k[c];
            mur[ct] = p.mu[c]; muk[ct] = p.mu[512 + c]; muv[ct] = p.mu[1024 + c];
        }
#pragma unroll
        for (int hf = 0; hf < 2; ++hf) {
        float zz[8][2][3], pz[2][2][3];
#pragma unroll
        for (int ii = 0; ii < 8; ++ii) {
            const int i = 8 * hf + ii;
            const bf16_t* z = p.rz() + (size_t)(r0 + (i & 3) + 8 * (i >> 2) + 4 * hb) * CR + h * 64 + col;
#pragma unroll
            for (int ct = 0; ct < 2; ++ct) { zz[ii][ct][0] = bf2f(z[32 * ct]); zz[ii][ct][1] = bf2f(z[512 + 32 * ct]); zz[ii][ct][2] = bf2f(z[1024 + 32 * ct]); }
        }
#pragma unroll
        for (int g2 = 0; g2 < 2; ++g2) {
            const bf16_t* pv = rwkv_prev_row(p, r0 + 8 * (2 * hf + g2) + 4 * hb) + h * 64 + col;
#pragma unroll
            for (int ct = 0; ct < 2; ++ct) { pz[g2][ct][0] = bf2f(pv[32 * ct]); pz[g2][ct][1] = bf2f(pv[512 + 32 * ct]); pz[g2][ct][2] = bf2f(pv[1024 + 32 * ct]); }
        }
#pragma unroll
        for (int ii = 0; ii < 8; ++ii) {
            const int i = 8 * hf + ii;
            const int row = r0 + (i & 3) + 8 * (i >> 2) + 4 * hb;
            float zr[2], zk[2], zv[2], dec[2], av[2], kkr[2], km[2];
            float n2 = 0.f, bon = 0.f;
#pragma unroll
            for (int ct = 0; ct < 2; ++ct) {
                const float z0 = zz[ii][ct][0], z1 = zz[ii][ct][1], z2 = zz[ii][ct][2];
                const int ip = ii > 0 ? ii - 1 : 0;
                const float p0 = (i & 3) ? zz[ip][ct][0] : pz[ii >> 2][ct][0], p1 = (i & 3) ? zz[ip][ct][1] : pz[ii >> 2][ct][1], p2 = (i & 3) ? zz[ip][ct][2] : pz[ii >> 2][ct][2];
                zr[ct] = z0 + (p0 - z0) * mur[ct]; zk[ct] = z1 + (p1 - z1) * muk[ct]; zv[ct] = z2 + (p2 - z2) * muv[ct];
                const float nx = -(w0v[ct] + accw[ct][i]);
                const float sp = fmaxf(nx, 0.f) + __logf(1.0f + __expf(-fabsf(nx)));
                dec[ct] = __expf(-__expf(-sp - 0.5f));
                av[ct] = sigmoidf_(a0v[ct] + acca[ct][i]);
                kkr[ct] = zk[ct] * kkv[ct];
                km[ct] = zk[ct] * (1.0f + (av[ct] - 1.0f) * kav[ct]);
                n2 += kkr[ct] * kkr[ct];
                bon += zr[ct] * km[ct] * rkv[ct];
            }
            n2 = half_sum32(n2); bon = half_sum32(bon);
            const float rn = 1.0f / fmaxf(sqrtf(n2), 1e-12f);
            unsigned char* o = p.rw6() + ((size_t)row * 8 + h) * RW6_STRIDE;
#pragma unroll
            for (int ct = 0; ct < 2; ++ct) {
                const float kk = kkr[ct] * rn;
                const int cl = 32 * ct + col;
                ((float*)o)[cl] = dec[ct];
                bf16_t* ob = (bf16_t*)(o + 256) + cl;
                ob[0] = f2bf(zr[ct]); ob[64] = f2bf(km[ct]); ob[128] = f2bf(zv[ct]); ob[192] = f2bf(kk); ob[256] = f2bf(kk * av[ct]);
            }
            if (col == 0) p.bonus()[(size_t)row * 8 + h] = bon;
        }
        }
    }
}

typedef float f32x2 __attribute__((ext_vector_type(2)));
__device__ __forceinline__ float dpp_row_sum(float v) {
    v += __builtin_bit_cast(float, __builtin_amdgcn_mov_dpp(__builtin_bit_cast(int, v), 0xB1, 0xF, 0xF, true));
    v += __builtin_bit_cast(float, __builtin_amdgcn_mov_dpp(__builtin_bit_cast(int, v), 0x4E, 0xF, 0xF, true));
    v += __builtin_bit_cast(float, __builtin_amdgcn_mov_dpp(__builtin_bit_cast(int, v), 0x141, 0xF, 0xF, true));
    v += __builtin_bit_cast(float, __builtin_amdgcn_mov_dpp(__builtin_bit_cast(int, v), 0x140, 0xF, 0xF, true));
    return v;
}
constexpr int SCAN_TC = 32;
template <int NROWS>
__device__ __forceinline__ void scan_item(const P& p, LAS float* lds, int row0, int T, int h, int half, const float* s0, float* sout) {
    const int tid = threadIdx.x, w = tid >> 6, lane = tid & 63, rl = lane >> 4, kq = lane & 15;
    const bool act = w * 4 < NROWS;
    const int vrow = half * NROWS + (act ? w * 4 : 0) + rl;
    f32x4 S;
    if (s0) S = *(const f32x4*)(s0 + vrow * 64 + kq * 4); else { S[0] = 0.f; S[1] = 0.f; S[2] = 0.f; S[3] = 0.f; }
    const unsigned char* src = p.rw6() + ((size_t)row0 * 8 + h) * RW6_STRIDE;
    const int nchunk = (T + SCAN_TC - 1) / SCAN_TC;
    u32x4_t stg[4];
    int ss[4], sc[4], sl[4];
#pragma unroll
    for (int i = 0; i < 4; ++i) {
        const int idx = i * 512 + tid; ss[i] = idx / 56; sc[i] = idx % 56;
        const int cb = sc[i] - 16, q = cb >> 3;
        sl[i] = sc[i] < 16 ? 64 + 4 * sc[i] : (q == 0 ? 0 : 64 + 64 * q) + 8 * (cb & 7);
    }
    auto put = [&](LAS float* b, int i) {
        LAS float* d = b + ss[i] * 384 + sl[i];
        if (sc[i] < 16) *(LAS u32x4_t*)d = stg[i];
        else {
            f32x4 lo, hi;
            lo[0] = __uint_as_float(stg[i][0] << 16); lo[1] = __uint_as_float(stg[i][0] & 0xffff0000u); lo[2] = __uint_as_float(stg[i][1] << 16); lo[3] = __uint_as_float(stg[i][1] & 0xffff0000u);
            hi[0] = __uint_as_float(stg[i][2] << 16); hi[1] = __uint_as_float(stg[i][2] & 0xffff0000u); hi[2] = __uint_as_float(stg[i][3] << 16); hi[3] = __uint_as_float(stg[i][3] & 0xffff0000u);
            *(LAS f32x4*)d = lo; *(LAS f32x4*)(d + 4) = hi;
        }
    };
    {
        const int ns = T < SCAN_TC ? T : SCAN_TC;
#pragma unroll
        for (int i = 0; i < 4; ++i) if (ss[i] < ns) { stg[i] = *(const u32x4_t*)(src + (size_t)ss[i] * (8 * RW6_STRIDE) + sc[i] * 16); put(lds, i); }
    }
    __syncthreads();
    for (int c = 0; c < nchunk; ++c) {
        const int t0 = c * SCAN_TC;
        const int ns = (T - t0) < SCAN_TC ? (T - t0) : SCAN_TC;
        const bool more = (c + 1) < nchunk;
        const int nns = more ? ((T - t0 - SCAN_TC) < SCAN_TC ? (T - t0 - SCAN_TC) : SCAN_TC) : 0;
        if (more) {
#pragma unroll
            for (int i = 0; i < 4; ++i) if (ss[i] < nns) stg[i] = *(const u32x4_t*)(src + (size_t)(t0 + SCAN_TC + ss[i]) * (8 * RW6_STRIDE) + sc[i] * 16);
        }
        LAS const float* buf = lds + (c & 1) * (SCAN_TC * 384);
        float* yo = p.ybuf() + (size_t)(row0 + t0) * 512 + h * 64 + vrow;
        if (act)
#pragma unroll 4
        for (int s = 0; s < ns; ++s) {
            LAS const float* bs = buf + s * 384 + kq * 4;
            const f32x4 r = *(LAS const f32x4*)(bs), d = *(LAS const f32x4*)(bs + 64), km = *(LAS const f32x4*)(bs + 128),
                        kk = *(LAS const f32x4*)(bs + 256), ka = *(LAS const f32x4*)(bs + 320);
            const float vv = buf[s * 384 + 192 + vrow];
            const f32x4 t1 = S * kk;
            float sa = dpp_row_sum((t1[0] + t1[1]) + (t1[2] + t1[3]));
            sa = -sa;
            S = S * d + ka * sa + km * vv;
            const f32x4 t2 = S * r;
            const float y = dpp_row_sum((t2[0] + t2[1]) + (t2[2] + t2[3]));
            if (kq == 0) yo[(size_t)s * 512] = y;
        }
        if (more) {
            LAS float* nb = lds + ((c + 1) & 1) * (SCAN_TC * 384);
#pragma unroll
            for (int i = 0; i < 4; ++i) if (ss[i] < nns) put(nb, i);
        }
        __syncthreads();
    }
    if (act) *(f32x4*)(sout + vrow * 64 + kq * 4) = S;
}
constexpr int NSCAN = 128;
__device__ __forceinline__ void ph_rwkv_scan(const P& p, LAS float* lds) {
    if ((int)blockIdx.x < NSCAN) {
        const int item = blockIdx.x >> 2, part = blockIdx.x & 3;
        scan_item<16>(p, lds, (item >> 3) * SEQ, SEQ, item & 7, part, nullptr, p.out + O_WKV_P + (size_t)item * 4096);
    } else {
        const int nb = (int)gridDim.x - NSCAN;
        for (int hi = (int)blockIdx.x - NSCAN; hi < 512; hi += nb) {
            const int item = hi >> 1, half = hi & 1;
            scan_item<32>(p, lds, NP + (item >> 3) * 8, 8, item & 7, half, p.state_wkv + (size_t)item * 4096, p.out + O_WKV_S + (size_t)item * 4096);
        }
    }
}

__device__ __forceinline__ void ph_rwkv_post(const P& p) {
    const int tid = threadIdx.x, lane = tid & 63, wid = tid >> 6;
    for (int it = blockIdx.x * 8 + wid; it < MR * 8; it += gridDim.x * 8) {
        const int row = it >> 3, h = it & 7, c = h * 64 + lane;
        const float y = p.ybuf()[(size_t)row * 512 + c];
        const float s1 = wave_sum(y), s2 = wave_sum(y * y);
        const float mean = s1 * (1.0f / 64.0f);
        const float var = fmaxf(s2 * (1.0f / 64.0f) - mean * mean, 0.f);
        const float dv = y - mean;
        float yn = dv * rsqrtf(var + 64e-5f) * p.gn_g[c] + p.gn_b[c];
        yn += p.bonus()[it] * bf2f(((const bf16_t*)(p.rw6() + (size_t)it * RW6_STRIDE + 256))[128 + lane]);
        p.ob()[(size_t)row * 512 + c] = f2bf(yn * bf2f(p.rg()[(size_t)row * 512 + c]));
    }
}

__device__ __forceinline__ void ph_cmp_gemm_f32(const P& p, LAS unsigned char* lds) {
    using pg8::lds_byte;
    const int tid = threadIdx.x, wid = __builtin_amdgcn_readfirstlane(tid >> 6), lane = tid & 63, wr = wid >> 2, wc = wid & 3, fr = lane & 15, fq = lane >> 4;
    constexpr int HTB = 16384;
    const int arow_l = 4 * wid + (lane >> 4), acol = 4 * (lane & 15);
    const int swbase = lds_byte(arow_l, acol);
    LAS unsigned long long* rowoff = (LAS unsigned long long*)(lds + 131072);
    unsigned voffB[2];
#pragma unroll
    for (int i = 0; i < 2; ++i) { int R, C; pg8::stage_rc(tid * 16 + i * 8192, R, C); voffB[i] = (unsigned)(R * 1024 + C) * 2u; }
    const unsigned ldsw = (unsigned)wid * 1024u;
    const int aoff = lds_byte(wr * 64 + fr, fq * 8), boff = lds_byte(wc * 32 + fr, fq * 8);
    for (int unit = blockIdx.x; unit < 512; unit += gridDim.x) {
        const int kvi = unit >> 8, bg = (unit >> 2) & 63, c0 = (unit & 3) * 256, b = bg >> 1, g = bg & 1;
        __syncthreads();
        if (tid < 256) {
            const int chunk = c0 + tid;
            const int page = p.page_table[b * 128 + (chunk >> 3)];
            rowoff[tid] = ((unsigned long long)page * 128 + (chunk & 7) * 16) * 256 + kvi * 128 + g * 64;
        }
        const char* bbase = (const char*)(p.W1T() + (size_t)kvi * 256 * 1024);
        f32x4 acc[2][2][4][2];
#pragma unroll
        for (int a = 0; a < 2; ++a)
#pragma unroll
            for (int bb = 0; bb < 2; ++bb)
#pragma unroll
                for (int m = 0; m < 4; ++m)
#pragma unroll
                    for (int n = 0; n < 2; ++n) acc[a][bb][m][n] = (f32x4){0.f, 0.f, 0.f, 0.f};
        f32x4 ar[8];
        auto stage_b = [&](int st, int t) {
#pragma unroll
            for (int h = 0; h < 2; ++h)
#pragma unroll
                for (int i = 0; i < 2; ++i)
                    __builtin_amdgcn_global_load_lds((const unsigned*)(bbase + (size_t)h * 128 * 2048 + (size_t)t * 128 + voffB[i]),
                                                     (PG8_LAS unsigned*)(lds + st * 65536 + 32768 + h * HTB + ldsw + i * 8192), 16, 0, 0);
        };
        auto load_a = [&](int t) {
#pragma unroll
            for (int q = 0; q < 8; ++q) ar[q] = *(const f32x4*)(p.cache_cmp + rowoff[32 * q + arow_l] + (size_t)t * 256 + acol);
        };
        auto write_a = [&](int st) {
            LAS unsigned char* na = lds + st * 65536;
#pragma unroll
            for (int q = 0; q < 8; ++q) *(LAS u32x2*)(na + swbase + (q >> 2) * HTB + (q & 3) * 4096) = (u32x2){pk2(ar[q][0], ar[q][1]), pk2(ar[q][2], ar[q][3])};
        };
        __syncthreads();
        load_a(0);
        stage_b(0, 0);
        write_a(0);
        __syncthreads();
#pragma unroll 1
        for (int t = 0; t < 16; ++t) {
            const int cur = t & 1;
            if (t + 1 < 16) { load_a(t + 1); stage_b(cur ^ 1, t + 1); }
            LAS const unsigned char* sa = lds + cur * 65536;
            LAS const unsigned char* sb = sa + 32768;
#pragma unroll
            for (int ai = 0; ai < 2; ++ai)
#pragma unroll
                for (int bj = 0; bj < 2; ++bj) {
                    bf16x8 Bt[2][2];
#pragma unroll
                    for (int n = 0; n < 2; ++n)
#pragma unroll
                        for (int k = 0; k < 2; ++k) Bt[n][k] = *(LAS const bf16x8*)(sb + bj * HTB + boff + n * 2048 + k * 1024);
#pragma unroll
                    for (int m = 0; m < 4; ++m) {
                        const bf16x8 a0 = *(LAS const bf16x8*)(sa + ai * HTB + aoff + m * 2048), a1 = *(LAS const bf16x8*)(sa + ai * HTB + aoff + m * 2048 + 1024);
#pragma unroll
                        for (int n = 0; n < 2; ++n) {
                            acc[ai][bj][m][n] = __builtin_amdgcn_mfma_f32_16x16x32_bf16(Bt[n][0], a0, acc[ai][bj][m][n], 0, 0, 0);
                            acc[ai][bj][m][n] = __builtin_amdgcn_mfma_f32_16x16x32_bf16(Bt[n][1], a1, acc[ai][bj][m][n], 0, 0, 0);
                        }
                    }
                    __builtin_amdgcn_sched_barrier(0);
                }
            if (t + 1 < 16) write_a(cur ^ 1);
            __syncthreads();
        }
        EpiPlainBf e; e.C = p.LHs() + ((size_t)kvi * 65536 + (size_t)bg * 1024 + c0) * 256; e.ldc = 256; e.pad_ = 0;
        pg8::Unit u; u.pm = 0; u.pn = 0;
        e(acc, u, wr, wc, fr, fq);
    }
}

__device__ __forceinline__ float exp2_(float x) { return __builtin_amdgcn_exp2f(x); }
template <class OKF>
__device__ __forceinline__ void sm_stats(const f32x16& s, int hb, OKF ok, float& m, float& l) {
    float sv[16]; float tmax = -1e30f; unsigned okm = 0;
#pragma unroll
    for (int i = 0; i < 16; ++i) { const int kl = (i & 3) + 8 * (i >> 2) + 4 * hb; const bool k = ok(kl); okm |= (k ? 1u : 0u) << i; sv[i] = k ? s[i] : -1e30f; tmax = fmaxf(tmax, sv[i]); }
    tmax = fmaxf(tmax, __shfl_xor(tmax, 32));
    const float mn = fmaxf(m, tmax), alpha = exp2_(m - mn); m = mn;
    float ps = 0.f;
#pragma unroll
    for (int i = 0; i < 16; ++i) ps += ((okm >> i) & 1u) ? exp2_(sv[i] - mn) : 0.f;
    l = l * alpha + ps;
}
template <class OKF, class VF>
__device__ __forceinline__ void sm_pv(const f32x16& s, int hb, OKF ok, VF vf, float& m, float& l, f32x16 (&o)[2]) {
    float sv[16]; float tmax = -1e30f; unsigned okm = 0;
#pragma unroll
    for (int i = 0; i < 16; ++i) { const int kl = (i & 3) + 8 * (i >> 2) + 4 * hb; const bool k = ok(kl); okm |= (k ? 1u : 0u) << i; sv[i] = k ? s[i] : -1e30f; tmax = fmaxf(tmax, sv[i]); }
    tmax = fmaxf(tmax, __shfl_xor(tmax, 32));
    const float mn = fmaxf(m, tmax), alpha = exp2_(m - mn); m = mn;
    float pr[16]; float ps = 0.f;
#pragma unroll
    for (int i = 0; i < 16; ++i) { pr[i] = ((okm >> i) & 1u) ? exp2_(sv[i] - mn) : 0.f; ps += pr[i]; }
    l = l * alpha + ps;
    o[0] *= alpha; o[1] *= alpha;
#pragma unroll
    for (int s2 = 0; s2 < 2; ++s2) {
        const bf16x8 pb = pack8(pr[8 * s2 + 0], pr[8 * s2 + 1], pr[8 * s2 + 2], pr[8 * s2 + 3], pr[8 * s2 + 4], pr[8 * s2 + 5], pr[8 * s2 + 6], pr[8 * s2 + 7]);
#pragma unroll
        for (int dt = 0; dt < 2; ++dt) o[dt] = mfma32(vf(dt, s2), pb, o[dt]);
    }
}
template <class VF>
__device__ __forceinline__ void sm_pv_nomask(const f32x16& s, bool csel, VF vf, float& m, float& l, f32x16 (&o)[2]) {
    float tmax = fmaxf(fmaxf(s[0], s[1]), s[2]);
#pragma unroll
    for (int i = 3; i < 16; ++i) tmax = fmaxf(tmax, s[i]);
    tmax = csel ? tmax : -1e30f;
    tmax = fmaxf(tmax, __shfl_xor(tmax, 32));
    const float mn = fmaxf(m, tmax), alpha = exp2_(m - mn); m = mn;
    float pr[16]; float ps = 0.f;
#pragma unroll
    for (int i = 0; i < 16; ++i) { pr[i] = csel ? exp2_(s[i] - mn) : 0.f; ps += pr[i]; }
    l = l * alpha + ps;
    o[0] *= alpha; o[1] *= alpha;
#pragma unroll
    for (int s2 = 0; s2 < 2; ++s2) {
        const bf16x8 pb = pack8(pr[8 * s2 + 0], pr[8 * s2 + 1], pr[8 * s2 + 2], pr[8 * s2 + 3], pr[8 * s2 + 4], pr[8 * s2 + 5], pr[8 * s2 + 6], pr[8 * s2 + 7]);
#pragma unroll
        for (int dt = 0; dt < 2; ++dt) o[dt] = mfma32(vf(dt, s2), pb, o[dt]);
    }
}
template <class OKF, class VF>
__device__ __forceinline__ void cmp_pass2(const f32x16& s, int hb, OKF ok, VF vf, float m, float inv, f32x16 (&o)[2], LAS float* prow, bool writer) {
    float pr[16];
#pragma unroll
    for (int i = 0; i < 16; ++i) {
        const int kl = (i & 3) + 8 * (i >> 2) + 4 * hb;
        pr[i] = ok(kl) ? exp2_(s[i] - m) * inv : 0.f;
        float q = pr[i] + __shfl_xor(pr[i], 1); q += __shfl_xor(q, 2);
        if (writer) prow[kl] = q;
    }
#pragma unroll
    for (int s2 = 0; s2 < 2; ++s2) {
        const bf16x8 pb = pack8(pr[8 * s2 + 0], pr[8 * s2 + 1], pr[8 * s2 + 2], pr[8 * s2 + 3], pr[8 * s2 + 4], pr[8 * s2 + 5], pr[8 * s2 + 6], pr[8 * s2 + 7]);
#pragma unroll
        for (int dt = 0; dt < 2; ++dt) o[dt] = mfma32(vf(dt, s2), pb, o[dt]);
    }
}

__device__ __forceinline__ void attn_store(const P& p, const f32x16 (&of)[2], int qrow, int head, int hb, bool doit, bf16_t* oadst = nullptr) {
    if (!oadst) oadst = p.oa();
    if (!doit) return;
#pragma unroll
    for (int dt = 0; dt < 2; ++dt)
#pragma unroll
        for (int i4 = 0; i4 < 4; ++i4) {
            const int d = 32 * dt + 8 * i4 + 4 * hb;
            const size_t off = (size_t)qrow * 512 + head * 64 + d;
            const uint2 gw = *(const uint2*)(p.ag() + off);
            f32x4 v;
            v[0] = of[dt][4 * i4 + 0] * __uint_as_float(gw.x << 16); v[1] = of[dt][4 * i4 + 1] * __uint_as_float(gw.x & 0xffff0000u);
            v[2] = of[dt][4 * i4 + 2] * __uint_as_float(gw.y << 16); v[3] = of[dt][4 * i4 + 3] * __uint_as_float(gw.y & 0xffff0000u);
            st_bf4(oadst + off, v);
        }
}


__device__ __forceinline__ void of_put(LAS float* st, int lane, const f32x16 (&o)[2], float sc) {
#pragma unroll
    for (int dt = 0; dt < 2; ++dt)
#pragma unroll
        for (int i = 0; i < 16; ++i) st[(dt * 16 + i) * 64 + lane] = o[dt][i] * sc;
}
__device__ __forceinline__ void of_add(LAS float* st, int lane, const f32x16 (&o)[2], float sc) {
#pragma unroll
    for (int dt = 0; dt < 2; ++dt)
#pragma unroll
        for (int i = 0; i < 16; ++i) st[(dt * 16 + i) * 64 + lane] += o[dt][i] * sc;
}
__device__ __forceinline__ void of_get_add(LAS float* st, int lane, const f32x16 (&o)[2], float sc, f32x16 (&of)[2]) {
#pragma unroll
    for (int dt = 0; dt < 2; ++dt)
#pragma unroll
        for (int i = 0; i < 16; ++i) of[dt][i] = st[(dt * 16 + i) * 64 + lane] + o[dt][i] * sc;
}


constexpr int WL_STRIDE = 15360, KV_OFF = 8 * WL_STRIDE, KV_BUF = 17920, XB_OFF = KV_OFF + 2 * KV_BUF;

struct LoadBf16 {
    const bf16_t* kbase; const bf16_t* vbase; int ld; bool with_v; u32x4_t kr[2], vr[2];
    static constexpr int DEPTH = 2;
    __device__ __forceinline__ void load(int n, int slot) {
        const int tid = threadIdx.x, srow = tid >> 3, sch = tid & 7;
        const u32x4_t k = *(const u32x4_t*)(kbase + (size_t)(64 * n + srow) * 64 + sch * 8);
        u32x4_t v = k;
        if (with_v) v = *(const u32x4_t*)(vbase + (size_t)srow * ld + 64 * n + sch * 8);
        if (slot) { kr[1] = k; vr[1] = v; } else { kr[0] = k; vr[0] = v; }
    }
    __device__ __forceinline__ void store(LAS unsigned char* buf, int slot) const {
        const int tid = threadIdx.x, srow = tid >> 3, sch = tid & 7;
        const u32x4_t k = slot ? kr[1] : kr[0], v = slot ? vr[1] : vr[0];
        *(LAS u32x4_t*)(buf + srow * 144 + sch * 16) = k;
        if (with_v) { LAS u32x2* vp = (LAS u32x2*)(buf + 9216 + srow * 136 + sch * 16); vp[0] = (u32x2){v[0], v[1]}; vp[1] = (u32x2){v[2], v[3]}; }
    }
};
struct LoadWinF32 {
    const float* cw; const float* nw; f32x4 k0, k1, v0, v1;
    static constexpr int DEPTH = 1;
    __device__ __forceinline__ void load(int n, int) {
        const int tid = threadIdx.x, srow = tid >> 3, sch = tid & 7;
        const int j = 64 * n + srow;
        const float* r = j < 512 ? cw + (size_t)j * 256 : nw + (size_t)(j - 512 < 8 ? j - 512 : 7) * 256;
        k0 = *(const f32x4*)(r + sch * 8); k1 = *(const f32x4*)(r + sch * 8 + 4);
        v0 = *(const f32x4*)(r + 128 + sch * 8); v1 = *(const f32x4*)(r + 128 + sch * 8 + 4);
    }
    __device__ __forceinline__ void store(LAS unsigned char* buf, int) const {
        const int tid = threadIdx.x, srow = tid >> 3, sch = tid & 7;
        u32x4_t kw; kw[0] = pk2(k0[0], k0[1]); kw[1] = pk2(k0[2], k0[3]); kw[2] = pk2(k1[0], k1[1]); kw[3] = pk2(k1[2], k1[3]);
        *(LAS u32x4_t*)(buf + srow * 144 + sch * 16) = kw;
        LAS bf16_t* vb = (LAS bf16_t*)(buf + 9216) + (sch * 8) * 68 + srow;
#pragma unroll
        for (int e = 0; e < 4; ++e) { vb[e * 68] = f2bf(v0[e]); vb[(4 + e) * 68] = f2bf(v1[e]); }
    }
};

template <class LOADER, class NEXT, class ACTIVE, class BODY>
__device__ __forceinline__ void block_loop_g(LOADER ld, LAS unsigned char* kv, int first, NEXT next, ACTIVE active, BODY body) {
    if (first < 0) return;
    int n = first, cur = 0;
    if (LOADER::DEPTH == 2) {
        int nn = next(n), k = 0;
        ld.load(n, 0); ld.store(kv, 0);
        if (nn >= 0) ld.load(nn, 1);
        __syncthreads();
#pragma unroll 1
        for (;;) {
            const int nnn = nn >= 0 ? next(nn) : -1;
            if (nnn >= 0) ld.load(nnn, k & 1);
            if (active(n)) body(n, (LAS const bf16_t*)(kv + cur * KV_BUF), (LAS const bf16_t*)(kv + cur * KV_BUF + 9216));
            if (nn >= 0) ld.store(kv + (cur ^ 1) * KV_BUF, (k + 1) & 1);
            __syncthreads();
            if (nn < 0) break;
            cur ^= 1; n = nn; nn = nnn; ++k;
        }
    } else {
        ld.load(n, 0);
        ld.store(kv, 0);
        __syncthreads();
#pragma unroll 1
        for (;;) {
            const int nn = next(n);
            if (nn >= 0) ld.load(nn, 0);
            if (active(n)) body(n, (LAS const bf16_t*)(kv + cur * KV_BUF), (LAS const bf16_t*)(kv + cur * KV_BUF + 9216));
            if (nn >= 0) ld.store(kv + (cur ^ 1) * KV_BUF, 0);
            __syncthreads();
            if (nn < 0) break;
            cur ^= 1; n = nn;
        }
    }
}
template <bool WITH_V, class NEXT, class ACTIVE, class BODY>
__device__ __forceinline__ void block_loop(const bf16_t* kbase, const bf16_t* vbase, int ld, LAS unsigned char* kv, int first, NEXT next, ACTIVE active, BODY body) {
    LoadBf16 L; L.kbase = kbase; L.vbase = vbase; L.ld = ld; L.with_v = WITH_V;
    block_loop_g(L, kv, first, next, active, body);
}
__device__ __forceinline__ bf16x8 lds_kfrag(LAS const bf16_t* kb, int kt, int ks, int col, int hb) { return *(LAS const bf16x8*)(kb + (32 * kt + col) * 72 + 16 * ks + 8 * hb); }
__device__ __forceinline__ bf16x8 lds_vfrag(LAS const bf16_t* vb, int kt, int dt, int s2, int col, int hb) {
    LAS const bf16_t* ptr = vb + (32 * dt + col) * 68 + 32 * kt + 16 * s2 + 4 * hb;
    union { u32x4_t u; bf16x8 v; } x; const u32x2 a = *(LAS const u32x2*)ptr, c = *(LAS const u32x2*)(ptr + 8); x.u[0] = a[0]; x.u[1] = a[1]; x.u[2] = c[0]; x.u[3] = c[1]; return x.v;
}
__device__ __forceinline__ f32x16 lds_qk(const bf16x8 (&qf)[4], LAS const bf16_t* kb, int kt, int col, int hb) {
    f32x16 s = zero16();
#pragma unroll
    for (int ks = 0; ks < 4; ++ks) s = mfma32(lds_kfrag(kb, kt, ks, col, hb), qf[ks], s);
    return s;
}

__device__ __forceinline__ void attn_prompt_block(const P& p, int bg, int j, LAS unsigned char* lds) {
    int tid_l = threadIdx.x; asm volatile("" : "+v"(tid_l));
    const int tid = tid_l, lane = tid & 63, wid = __builtin_amdgcn_readfirstlane(tid >> 6);
    const int b = bg >> 1, g = bg & 1;
    const int col = lane & 31, hb = lane >> 5, tl = col >> 2, hh = col & 3;
    const int t0 = 64 * j + 8 * wid, qpos = t0 + tl, qrow = b * SEQ + qpos, head = g * 4 + hh;
    LAS unsigned char* wl = lds + wid * WL_STRIDE;
    LAS unsigned char* kv = lds + KV_OFF;
    LAS float* psum = (LAS float*)wl;
    LAS unsigned long long* msk = (LAS unsigned long long*)(wl + 8192);
    bf16x8 qf[4];
#pragma unroll
    for (int ks = 0; ks < 4; ++ks) qf[ks] = *(const bf16x8*)(p.qb() + (size_t)qrow * 512 + head * 64 + 16 * ks + 8 * hb);
    const float g0 = p.gates()[(size_t)qrow * 32 + head * 3 + 0], g1 = p.gates()[(size_t)qrow * 32 + head * 3 + 1], g2 = p.gates()[(size_t)qrow * 32 + head * 3 + 2];
    f32x16 oc[2]; oc[0] = zero16(); oc[1] = zero16();
    {
        const int cmb = 64 * j + 63 - 31;
        const int nbc = ((cmb >> 4) >> 6) + 1;
        const int cmw = t0 + 7 - 31;
        const int cmaxw = cmw >= 0 ? (cmw >> 4) : -1;
        const bf16_t* kc = p.kc_p() + (size_t)bg * 256 * 64;
        const bf16_t* vc = p.vcT_p() + (size_t)bg * 64 * 256;
        float m = -1e30f, l = 0.f;
        block_loop<false>(kc, vc, 256, kv, 0, [&](int n) { return n + 1 < nbc ? n + 1 : -1; }, [&](int n) { return cmaxw >= 64 * n; },
            [&](int n, LAS const bf16_t* kb, LAS const bf16_t* vb) {
#pragma unroll 1
                for (int kt = 0; kt < 2; ++kt) {
                    const f32x16 s = lds_qk(qf, kb, kt, col, hb);
                    sm_stats(s, hb, [&](int kl) { return 16 * (64 * n + 32 * kt + kl) + 31 <= qpos; }, m, l);
                }
            });
        l += __shfl_xor(l, 32);
        const float inv = l > 0.f ? 1.0f / l : 0.f;
#pragma unroll
        for (int i = 0; i < 32; ++i) psum[i * 64 + lane] = 0.f;
        WAVE_SYNC();
        block_loop<true>(kc, vc, 256, kv, 0, [&](int n) { return n + 1 < nbc ? n + 1 : -1; }, [&](int n) { return cmaxw >= 64 * n; },
            [&](int n, LAS const bf16_t* kb, LAS const bf16_t* vb) {
#pragma unroll 1
                for (int kt = 0; kt < 2; ++kt) {
                    const f32x16 s = lds_qk(qf, kb, kt, col, hb);
                    cmp_pass2(s, hb, [&](int kl) { return 16 * (64 * n + 32 * kt + kl) + 31 <= qpos; }, [&](int dt, int s2) { return lds_vfrag(vb, kt, dt, s2, col, hb); }, m, inv, oc,
                              psum + tl * 256 + 64 * n + 32 * kt, hh == 0);
                }
            });
    }
    WAVE_SYNC();
    unsigned long long umw = 0;
    for (int t2 = 0; t2 < 8; ++t2) {
        const int t = t0 + t2, cur = t >> 6, n = lane;
        float imp = 0.f;
#pragma unroll
        for (int c = -1; c < 4; ++c) { const int cc = 4 * n + c; if (cc >= 0) imp += psum[t2 * 256 + cc]; }
        if (n == 0 || n == cur || n == cur - 1) imp = 1e4f;
        if (n * 64 > t) imp = -1.0f;
        int rank = 0;
#pragma unroll
        for (int jj = 0; jj < 64; ++jj) {
            const float vj = __uint_as_float(__builtin_amdgcn_readlane(__float_as_uint(imp), jj));
            rank += (vj > imp || (vj == imp && jj < n)) ? 1 : 0;
        }
        const unsigned long long mk = __ballot(rank < 16);
        if (lane == 0) msk[t2] = mk;
        umw |= mk;
    }
    if (lane == 0) msk[8] = umw;
    __syncthreads();
    const unsigned long long mymask = msk[tl];
    unsigned long long umb = 0;
#pragma unroll
    for (int w2 = 0; w2 < 8; ++w2) umb |= *(LAS const unsigned long long*)(lds + w2 * WL_STRIDE + 8192 + 64);
    {
        const unsigned lo = __builtin_amdgcn_readfirstlane((unsigned)umb), hi = __builtin_amdgcn_readfirstlane((unsigned)(umb >> 32));
        umb = ((unsigned long long)hi << 32) | lo;
        if (j < 63) umb &= (2ull << j) - 1ull;
    }
    LAS float* ost = (LAS float*)wl;
    of_put(ost, lane, oc, g0);
    {
        const bf16_t* kbs = p.kb() + (size_t)((1 * NB + b) * 2 + g) * SEQ * 64;
        const bf16_t* vbs = p.vT() + (size_t)((0 * NB + b) * 2 + g) * 64 * SEQ;
        float m = -1e30f, l = 0.f; f32x16 o[2]; o[0] = zero16(); o[1] = zero16();
        block_loop<true>(kbs, vbs, SEQ, kv, umb ? (int)__builtin_ctzll(umb) : -1,
            [&](int n) { if (n >= 63) return -1; const unsigned long long rem = umb >> (n + 1); return rem ? n + 1 + (int)__builtin_ctzll(rem) : -1; },
            [&](int n) { return (bool)((umw >> n) & 1ull); },
            [&](int n, LAS const bf16_t* kb, LAS const bf16_t* vb) {
                const bool bsel = (mymask >> n) & 1ull;
#pragma unroll
                for (int kt = 0; kt < 2; ++kt) {
                    const int tok0 = 64 * n + 32 * kt;
                    const f32x16 s = lds_qk(qf, kb, kt, col, hb);
                    if (n < j) sm_pv_nomask(s, bsel, [&](int dt, int s2) { return lds_vfrag(vb, kt, dt, s2, col, hb); }, m, l, o);
                    else sm_pv(s, hb, [&](int kl) { return bsel && (tok0 + kl <= qpos); }, [&](int dt, int s2) { return lds_vfrag(vb, kt, dt, s2, col, hb); }, m, l, o);
                }
            });
        l += __shfl_xor(l, 32);
        const float sc = l > 0.f ? g1 / l : 0.f;
        of_add(ost, lane, o, sc);
    }
    {
        const bf16_t* kbw = p.kb() + (size_t)((2 * NB + b) * 2 + g) * SEQ * 64;
        const bf16_t* vbw = p.vT() + (size_t)((1 * NB + b) * 2 + g) * 64 * SEQ;
        float m = -1e30f, l = 0.f; f32x16 o[2]; o[0] = zero16(); o[1] = zero16();
        block_loop<true>(kbw, vbw, SEQ, kv, j > 8 ? j - 8 : 0, [&](int n) { return n < j ? n + 1 : -1; }, [&](int n) { return true; },
            [&](int n, LAS const bf16_t* kb, LAS const bf16_t* vb) {
#pragma unroll 1
                for (int kt = 0; kt < 2; ++kt) {
                    const int tok0 = 64 * n + 32 * kt;
                    const f32x16 s = lds_qk(qf, kb, kt, col, hb);
                    if (n < j && n > j - 8) sm_pv_nomask(s, true, [&](int dt, int s2) { return lds_vfrag(vb, kt, dt, s2, col, hb); }, m, l, o);
                    else sm_pv(s, hb, [&](int kl) { const int key = tok0 + kl; return key <= qpos && key + 511 >= qpos; }, [&](int dt, int s2) { return lds_vfrag(vb, kt, dt, s2, col, hb); }, m, l, o);
                }
            });
        l += __shfl_xor(l, 32);
        const float sc = l > 0.f ? g2 / l : 0.f;
        f32x16 of[2];
        of_get_add(ost, lane, o, sc, of);
        attn_store(p, of, qrow, head, hb, true);
    }
    __syncthreads();
}

__device__ __forceinline__ void attn_sample_block(const P& p, int bg, LAS unsigned char* lds) {
    int tid_l = threadIdx.x; asm volatile("" : "+v"(tid_l));
    const int tid = tid_l, lane = tid & 63, wid = __builtin_amdgcn_readfirstlane(tid >> 6);
    const int b = bg >> 1, g = bg & 1, t = wid;
    const int col = lane & 31, hb = lane >> 5, hh = col & 3;
    const int qrow = NP + b * 8 + t, head = g * 4 + hh;
    LAS unsigned char* wl = lds + wid * WL_STRIDE;
    LAS unsigned char* kv = lds + KV_OFF;
    bf16x8 qf[4];
#pragma unroll
    for (int ks = 0; ks < 4; ++ks) qf[ks] = *(const bf16x8*)(p.qb() + (size_t)qrow * 512 + head * 64 + 16 * ks + 8 * hb);
    LAS float* psum = (LAS float*)wl;
    LAS int* list = (LAS int*)(wl + 8256);
    LAS float* impl = (LAS float*)(wl + 8448);
    LAS bf16_t* vt = (LAS bf16_t*)(wl + 9728);
    const float g0 = p.gates()[(size_t)qrow * 32 + head * 3 + 0], g1 = p.gates()[(size_t)qrow * 32 + head * 3 + 1], g2 = p.gates()[(size_t)qrow * 32 + head * 3 + 2];
    f32x16 oc[2]; oc[0] = zero16(); oc[1] = zero16();
    {
        const bf16_t* kc = p.kc_s() + (size_t)bg * 1024 * 64;
        const bf16_t* vc = p.vcT_s() + (size_t)bg * 64 * 1024;
        float m = -1e30f, l = 0.f;
        block_loop<false>(kc, vc, 1024, kv, 0, [&](int n) { return n < 15 ? n + 1 : -1; }, [&](int n) { return true; },
            [&](int n, LAS const bf16_t* kb, LAS const bf16_t* vb) {
#pragma unroll 1
                for (int kt = 0; kt < 2; ++kt) {
                    const f32x16 s = lds_qk(qf, kb, kt, col, hb);
                    sm_stats(s, hb, [&](int kl) { return 64 * n + 32 * kt + kl <= 1022; }, m, l);
                }
            });
        l += __shfl_xor(l, 32);
        const float inv = l > 0.f ? 1.0f / l : 0.f;
        block_loop<true>(kc, vc, 1024, kv, 0, [&](int n) { return n < 15 ? n + 1 : -1; }, [&](int n) { return true; },
            [&](int n, LAS const bf16_t* kb, LAS const bf16_t* vb) {
#pragma unroll 1
                for (int kt = 0; kt < 2; ++kt) {
                    const f32x16 s = lds_qk(qf, kb, kt, col, hb);
                    cmp_pass2(s, hb, [&](int kl) { return 64 * n + 32 * kt + kl <= 1022; }, [&](int dt, int s2) { return lds_vfrag(vb, kt, dt, s2, col, hb); }, m, inv, oc,
                              psum + 64 * n + 32 * kt, col == 0);
                }
            });
    }
    WAVE_SYNC();
#pragma unroll
    for (int j = 0; j < 5; ++j) {
        const int n = lane + 64 * j;
        if (n <= 256) {
            float imp = 0.f;
            for (int c = -1; c < 4; ++c) { const int cc = 4 * n + c; if (cc >= 0 && cc <= 1022) imp += psum[cc]; }
            impl[n] = imp;
        }
    }
    WAVE_SYNC();
    {
        int base = 0;
#pragma unroll
        for (int j = 0; j < 4; ++j) {
            const int n = lane + 64 * j;
            const bool cand = n >= 1 && n <= 254;
            const float v = impl[n];
            int rank = 0;
            for (int q = 1; q <= 254; ++q) { const float vq = impl[q]; rank += (vq > v || (vq == v && q < n)) ? 1 : 0; }
            const bool sel = cand && rank < 13;
            const unsigned long long mk = __ballot(sel);
            if (sel) list[base + __popcll(mk & ((1ull << lane) - 1ull))] = n;
            base += __popcll(mk);
        }
        if (lane == 0) { list[13] = 0; list[14] = 255; list[15] = 256; }
    }
    WAVE_SYNC();
    if (lane < 16) {
        const int n = list[lane];
        list[16 + lane] = n < 256 ? p.page_table[b * 128 + (n >> 1)] * 128 + (n & 1) * 64 : -1;
    }
    WAVE_SYNC();
    LAS float* ost = (LAS float*)wl;
    of_put(ost, lane, oc, g0);
    {
        float m = -1e30f, l = 0.f; f32x16 o[2]; o[0] = zero16(); o[1] = zero16();
        const float* newrows = p.out + O_SEL_S + (size_t)(b * 8) * 256 + g * 64;
        auto rowptr = [&](int u) -> const float* {
            const int rb = __builtin_amdgcn_readfirstlane(list[16 + (u >> 1)]);
            return rb >= 0 ? p.cache_sel + ((size_t)rb + 32 * (u & 1) + col) * 256 + g * 64 : newrows + (size_t)(col < 8 ? col : 7) * 256;
        };
        f32x4 kA[4], kB[4];
        { const float* kr = rowptr(0) + 8 * hb;
#pragma unroll
          for (int ks = 0; ks < 4; ++ks) { kA[ks] = *(const f32x4*)(kr + 16 * ks); kB[ks] = *(const f32x4*)(kr + 16 * ks + 4); } }
#pragma unroll 1
        for (int u = 0; u < 31; ++u) {
            const bool isnew = __builtin_amdgcn_readfirstlane(list[16 + (u >> 1)]) < 0;
            const float* vr = rowptr(u) + 128 + 32 * hb;
            f32x4 vv[8];
#pragma unroll
            for (int j4 = 0; j4 < 8; ++j4) vv[j4] = *(const f32x4*)(vr + 4 * j4);
            f32x16 s = zero16();
#pragma unroll
            for (int ks = 0; ks < 4; ++ks) s = mfma32(pack8(kA[ks][0], kA[ks][1], kA[ks][2], kA[ks][3], kB[ks][0], kB[ks][1], kB[ks][2], kB[ks][3]), qf[ks], s);
            if (u + 1 < 31) { const float* kr = rowptr(u + 1) + 8 * hb;
#pragma unroll
                for (int ks = 0; ks < 4; ++ks) { kA[ks] = *(const f32x4*)(kr + 16 * ks); kB[ks] = *(const f32x4*)(kr + 16 * ks + 4); } }
#pragma unroll
            for (int j4 = 0; j4 < 8; ++j4)
#pragma unroll
                for (int e = 0; e < 4; ++e) vt[(32 * hb + 4 * j4 + e) * 40 + col] = f2bf(vv[j4][e]);
            WAVE_SYNC();
            sm_pv(s, hb, [&](int kl) { return !isnew || kl <= t; }, [&](int dt, int s2) {
                LAS const bf16_t* ptr = vt + (32 * dt + col) * 40 + 16 * s2 + 4 * hb;
                union { u32x4_t u4; bf16x8 v; } x; const u32x2 a = *(LAS const u32x2*)ptr, c = *(LAS const u32x2*)(ptr + 8); x.u4[0] = a[0]; x.u4[1] = a[1]; x.u4[2] = c[0]; x.u4[3] = c[1]; return x.v; }, m, l, o);
            WAVE_SYNC();
        }
        l += __shfl_xor(l, 32);
        const float sc = l > 0.f ? g1 / l : 0.f;
        of_add(ost, lane, o, sc);
    }
    {
        float m = -1e30f, l = 0.f; f32x16 o[2]; o[0] = zero16(); o[1] = zero16();
        LoadWinF32 L; L.cw = p.cache_win + (size_t)b * 512 * 256 + g * 64; L.nw = p.out + O_WIN_S + ((size_t)b * 512 + 504) * 256 + g * 64;
        block_loop_g(L, kv, 0, [&](int n) { return n < 8 ? n + 1 : -1; }, [&](int n) { return true; },
            [&](int n, LAS const bf16_t* kb, LAS const bf16_t* vb) {
#pragma unroll 1
                for (int kt = 0; kt < 2; ++kt) {
                    const int j0 = 64 * n + 32 * kt;
                    if (j0 >= 520) break;
                    const f32x16 s = lds_qk(qf, kb, kt, col, hb);
                    sm_pv(s, hb, [&](int kl) { const int j = j0 + kl; return j >= t + 1 && j <= 512 + t; }, [&](int dt, int s2) { return lds_vfrag(vb, kt, dt, s2, col, hb); }, m, l, o);
                }
            });
        l += __shfl_xor(l, 32);
        const float sc = l > 0.f ? g2 / l : 0.f;
        f32x16 of[2];
        of_get_add(ost, lane, o, sc, of);
        attn_store(p, of, qrow, head, hb, col < 4);
    }
    __syncthreads();
}

__device__ __forceinline__ void ph_attn(const P& p, LAS unsigned char* lds, int qsel = 0) {
    const int tid = threadIdx.x, lane = tid & 63, wid = tid >> 6;
    unsigned* ctr = p.bar() + 3584 + 64 * qsel;
    LAS unsigned* qslot = (LAS unsigned*)(lds + XB_OFF + 64);
    for (;;) {
        if (tid == 0) *qslot = __hip_atomic_fetch_add(ctr, 1u, __ATOMIC_RELAXED, __HIP_MEMORY_SCOPE_AGENT);
        __syncthreads();
        const unsigned q = __builtin_amdgcn_readfirstlane(*qslot);
        __syncthreads();
        if (q >= 64u + 512u) break;
        if (q < 64u) attn_sample_block(p, (int)q, lds);
        else { const int idx = (int)q - 64; attn_prompt_block(p, idx & 7, 63 - (idx >> 3), lds);
        }
    }
}


constexpr int LDS_BYTES = pg8::STAGE_BYTES;

constexpr int FUSED_LDS = XB_OFF + 256;

template <class Epi> __device__ __forceinline__ void run_gemm(LAS unsigned char* lds, const bf16_t* A, const bf16_t* Bt, int M, int N, int K, const Epi& E, int slot = -1) {
    pg8::Gemm g; g.A = A; g.Bt = Bt; g.M = M; g.N = N; g.K = K; g.pad_ = 0;
    pg8::StaticOrder S; S.init(M, N, (int)gridDim.x, slot >= 0 ? slot : (int)blockIdx.x);
    pg8::gemm_phase<Epi, pg8::StaticOrder, false>((PG8_LAS unsigned char*)lds, g, S, E, nullptr);
}

#define XBAR() xcd_barrier(bar)
__global__ __launch_bounds__(512, 2) void k_fused(P p) {
    extern __shared__ __attribute__((aligned(16))) unsigned char shm[];
    LAS unsigned char* lds = (LAS unsigned char*)shm;
    LAS unsigned* xb = (LAS unsigned*)(lds + XB_OFF);
    if (threadIdx.x == 0) { xb[0] = 0u; xb[1] = 0u; xb[2] = 0u; xb[3] = 0u; }
    __syncthreads();
    XcdBarrier bar = xcd_barrier_post(p.bar(), (volatile LAS unsigned*)xb);
    ph_prep(p);
    XBAR();
    { EpiIn e; e.p = p; e.row0 = 0; e.pn0 = 0; run_gemm(lds, p.hb(), p.WinT(), MR, NPAD, DM, e); }
    ph_cmp_gemm_f32(p, lds);
    XBAR();
    if ((int)blockIdx.x < 16) {
        const int kvi = blockIdx.x >> 3, bg = blockIdx.x & 7;
        EpiPlainBf e; e.C = p.LHp() + ((size_t)kvi * 2048 + (size_t)bg * 256) * 256; e.ldc = 256; e.pad_ = 0;
        run_gemm(lds, (kvi ? p.vcr() : p.kb()) + (size_t)bg * 256 * 1024, p.W1T() + (size_t)kvi * 256 * 1024, 256, 256, 1024, e, 0);
        __builtin_amdgcn_fence(__ATOMIC_RELEASE, "agent");
        asm volatile("s_waitcnt vmcnt(0)" ::: "memory");
        __syncthreads();
        __builtin_amdgcn_fence(__ATOMIC_ACQUIRE, "agent");
        asm volatile("s_waitcnt vmcnt(0)" ::: "memory");
        compress2_tile(p, p.LHp(), 8, 256, 255, p.kc_p(), p.vcT_p(), kvi, bg, threadIdx.x >> 6, threadIdx.x & 63, lds + (threadIdx.x >> 6) * 8960);
    }
    ph_rwkv_prep(p);
    ph_compress2(p, p.LHs(), 64, 1024, 1023, p.kc_s(), p.vcT_s(), lds);
    XBAR();
    ph_rwkv_scan(p, (LAS float*)lds);
    __syncthreads();
    ph_attn(p, lds);
    XBAR();
    ph_rwkv_post(p);
    { EpiYa e; e.p = p; small_gemm(p.oa(), p.WpaT(), 512, e); run_gemm(lds, p.oa(), p.WpaT(), NP, DM, 512, e); }
    XBAR();
    { EpiYb e; e.p = p; small_gemm(p.ob(), p.WpbT(), 512, e); run_gemm(lds, p.ob(), p.WpbT(), NP, DM, 512, e); }
    XBAR();
    { EpiOut e; e.p = p; small_gemm(p.mb(), p.WoutT(), DM, e); run_gemm(lds, p.mb(), p.WoutT(), NP, DM, DM, e); }
    { EpiPlain e; e.C = p.pp(); e.ldc = DM; e.pad_ = 0; small_gemm(p.pb(), p.WprojT(), 256, e); run_gemm(lds, p.pb(), p.WprojT(), NP, DM, 256, e); }
    XBAR();
    { EpiGate e; e.p = p; small_gemm(p.xg(), p.WgateT(), DM, e); run_gemm(lds, p.xg(), p.WgateT(), NP, DM, DM, e); }
    XBAR();
    ph_final(p);
}
extern "C" void kernel_launch(void* const* d_in, const int* in_sizes, int n_in, void* d_out, int out_size, void* d_ws, size_t ws_size, hipStream_t stream) {
    (void)in_sizes; (void)n_in; (void)out_size; (void)ws_size;
    P p{};
    p.x_prompt = (const float*)d_in[0]; p.x_sample = (const float*)d_in[1]; p.p_prompt = (const float*)d_in[2]; p.p_sample = (const float*)d_in[3];
    p.cache_cmp = (const float*)d_in[4]; p.cache_sel = (const float*)d_in[5]; p.cache_win = (const float*)d_in[6]; p.state_wkv = (const float*)d_in[7];
    p.state_shift = (const float*)d_in[8]; p.page_table = (const int*)d_in[9]; p.norm_g = (const float*)d_in[10]; p.w_in = (const float*)d_in[11];
    p.cmp_pe = (const float*)d_in[12]; p.cmp_w1 = (const float*)d_in[13]; p.cmp_b1 = (const float*)d_in[14]; p.cmp_w2 = (const float*)d_in[15]; p.cmp_b2 = (const float*)d_in[16];
    p.w_pa = (const float*)d_in[17]; p.mu = (const float*)d_in[18]; p.w0 = (const float*)d_in[19]; p.w_up = (const float*)d_in[20]; p.a0 = (const float*)d_in[21];
    p.a_up = (const float*)d_in[22]; p.k_k = (const float*)d_in[23]; p.k_a = (const float*)d_in[24]; p.r_k = (const float*)d_in[25]; p.gn_g = (const float*)d_in[26];
    p.gn_b = (const float*)d_in[27]; p.w_pb = (const float*)d_in[28]; p.w_out = (const float*)d_in[29]; p.ple_g = (const float*)d_in[30]; p.w_gate = (const float*)d_in[31];
    p.w_proj = (const float*)d_in[32]; p.final_g = (const float*)d_in[33];
    p.out = (float*)d_out;
    p.ws = (unsigned char*)d_ws;

    static int grid = 0;
    if (!grid) {
        int dev = 0, cus = 0, per_cu = 0;
        (void)hipGetDevice(&dev);
        (void)hipDeviceGetAttribute(&cus, hipDeviceAttributeMultiprocessorCount, dev);
        (void)hipFuncSetAttribute((const void*)k_fused, hipFuncAttributeMaxDynamicSharedMemorySize, FUSED_LDS);
        (void)hipOccupancyMaxActiveBlocksPerMultiprocessor(&per_cu, k_fused, 512, FUSED_LDS);
        grid = per_cu >= 1 ? cus : 0;
        if (grid > 256) grid = 256;
    }
    (void)hipMemsetAsync(p.bar(), 0, 32768, stream);
    if (grid > 0) hipLaunchKernelGGL(k_fused, dim3(grid), dim3(512), FUSED_LDS, stream, p);
}
```

```cpp
#include <hip/hip_runtime.h>
#include <stdint.h>
#include <stdio.h>
namespace pg8 {
#define PG8_LAS __attribute__((address_space(3)))
typedef unsigned short bf16_t;
typedef short bf16x8 __attribute__((ext_vector_type(8)));
typedef float f32x4 __attribute__((ext_vector_type(4)));
typedef unsigned u32x4 __attribute__((ext_vector_type(4)));
constexpr int BM = 256, BK = 64, HALF = 128, HTB = HALF * BK * 2  , STAGE_BYTES = 8 * HTB, NXCD = 8, WGM = 8;

__host__ __device__ __forceinline__ int lds_byte(int r, int c) { const int st = (r >> 4) * 2 + (c >> 5), rr = r & 15, cc = c & 31, ob = rr * 64 + cc * 2; return st * 1024 + (ob ^ (((ob >> 9) & 1) << 5)); }
__host__ __device__ __forceinline__ void stage_rc(int b, int& R, int& C) { const int st = b / 1024, sb = b % 1024, swz = sb ^ (((sb >> 9) & 1) << 5); R = (st >> 1) * 16 + swz / 64; C = (st & 1) * 32 + (swz % 64) / 2; }
__host__ __device__ __forceinline__ int perm32(int rho) { const int n = rho >> 4, i = rho & 15; return 8 * (i >> 2) + 4 * n + (i & 3); }

struct Unit { int pm, pn; };
struct Gemm { const bf16_t* A; const bf16_t* Bt; int M, N, K, pad_; };

struct StaticOrder {
    int nM, nN, nwg, G, c;
    __host__ __device__ void init(int M, int N, int G_, int c_) { nM = M / BM; nN = N / BM; nwg = nM * nN; G = G_; c = c_; }
    __host__ __device__ bool next(int i, Unit& u) const {
        const long L = (long)i * G + c; if (L >= nwg) return false;
        int wgid = (int)L; { const int q = nwg / NXCD, r = nwg % NXCD, xcd = wgid % NXCD, off = wgid / NXCD; wgid = (xcd < r ? xcd * (q + 1) : r * (q + 1) + (xcd - r) * q) + off; }
        const int nig = WGM * nN, gid = wgid / nig, fm = gid * WGM, gsz = (nM - fm) < WGM ? (nM - fm) : WGM;
        u.pm = fm + ((wgid % nig) % gsz); u.pn = (wgid % nig) / gsz; return true;
    }
    __device__ __forceinline__ void a_ready(const Unit&) const {}
    __device__ __forceinline__ void done(const Unit&) const {}
};
__device__ __forceinline__ unsigned cvt_pk_bf16(float lo, float hi) { unsigned r; asm volatile("v_cvt_pk_bf16_f32 %0, %1, %2" : "=v"(r) : "v"(lo), "v"(hi)); return r; }
typedef float f32x2 __attribute__((ext_vector_type(2)));
template <class Epi, class Sched, bool STAMP = false>
__device__ __forceinline__ void gemm_phase(PG8_LAS unsigned char* lds, const Gemm g, const Sched& S, const Epi& E, unsigned long long* stamps) {
    int tid_l = threadIdx.x; asm volatile("" : "+v"(tid_l));
    const int tid = tid_l, wid = __builtin_amdgcn_readfirstlane(tid >> 6), lane = tid & 63, wr = wid >> 2, wc = wid & 3, fr = lane & 15, fq = lane >> 4;
    const int K = g.K, nt = K / BK;
    int ts_lo = 0, ts_hi = 0, nts = 0; const unsigned long long rt_entry = STAMP ? (unsigned long long)wall_clock64() : 0ull;
#define PG8_STAMP() do { if (STAMP && wid == 0 && nts < 64) { const unsigned long long _c = (unsigned long long)clock64(); \
        ts_lo = (lane == nts) ? (int)(unsigned)_c : ts_lo; ts_hi = (lane == nts) ? (int)(unsigned)(_c >> 32) : ts_hi; ++nts; } } while (0)
    PG8_STAMP();
    unsigned voffA[2], voffB[2];
#pragma unroll
    for (int i = 0; i < 2; ++i) { int R, C; stage_rc(tid * 16 + i * 8192, R, C); const int Rb = Epi::PERM ? ((R & ~31) + perm32(R & 31)) : R;
        voffA[i] = (unsigned)(R * K + C) * 2u; voffB[i] = (unsigned)(Rb * K + C) * 2u; }
    const size_t kstep = (size_t)(BK * 2);
    const size_t hstep = (size_t)HALF * K * 2;
    const size_t tstep = 2 * hstep;
    const unsigned ldsw = (unsigned)wid * 1024u;
    const int aoff = lds_byte(wr * 64 + fr, fq * 8), boff = lds_byte(wc * 32 + fr, fq * 8);
#define PG8_SA(b, h) (((b) * 2 + (h)) * HTB)
#define PG8_SB(b, h) ((4 + (b) * 2 + (h)) * HTB)
#define PG8_STAGE(bufoff, gbase, voff) do { _Pragma("unroll") for (int _i = 0; _i < 2; ++_i) \
        __builtin_amdgcn_global_load_lds((const unsigned*)((const char*)(gbase) + (voff)[_i]), (PG8_LAS unsigned*)(lds + (bufoff) + ldsw + _i * 8192), 16, 0, 0); } while (0)
#define PG8_LDA(dst, b, h) do { _Pragma("unroll") for (int m = 0; m < 4; ++m) _Pragma("unroll") for (int k = 0; k < 2; ++k) dst[m][k] = *(const PG8_LAS bf16x8*)(lds + PG8_SA(b, h) + aoff + m * 2048 + k * 1024); } while (0)
#define PG8_LDB(dst, b, h) do { _Pragma("unroll") for (int n = 0; n < 2; ++n) _Pragma("unroll") for (int k = 0; k < 2; ++k) dst[n][k] = *(const PG8_LAS bf16x8*)(lds + PG8_SB(b, h) + boff + n * 2048 + k * 1024); } while (0)
#define PG8_MMA(ai, bj, At, Bt) do { __builtin_amdgcn_s_setprio(1); _Pragma("unroll") for (int m = 0; m < 4; ++m) _Pragma("unroll") for (int n = 0; n < 2; ++n) _Pragma("unroll") for (int k = 0; k < 2; ++k) \
        acc[ai][bj][m][n] = __builtin_amdgcn_mfma_f32_16x16x32_bf16(Bt[n][k], At[m][k], acc[ai][bj][m][n], 0, 0, 0); __builtin_amdgcn_s_setprio(0); } while (0)
#define PG8_WAIT_V(n) asm volatile("s_waitcnt vmcnt(" #n ")" ::: "memory")
#define PG8_WAIT_L(n) asm volatile("s_waitcnt lgkmcnt(" #n ")" ::: "memory")
#define PG8_BAR __builtin_amdgcn_s_barrier()
#define PG8_SCHED __builtin_amdgcn_sched_barrier(0)
    Unit cur, nxt; int ui = 0;
    if (!S.next(0, cur)) return;
    f32x4 acc[2][2][4][2];
#pragma unroll
    for (int a = 0; a < 2; ++a)
#pragma unroll
        for (int b = 0; b < 2; ++b)
#pragma unroll
            for (int m = 0; m < 4; ++m)
#pragma unroll
                for (int n = 0; n < 2; ++n) acc[a][b][m][n] = (f32x4){0.f, 0.f, 0.f, 0.f};
    bf16x8 At[4][2], B0[2][2], B1[2][2];
    const char* cA = (const char*)g.A + (size_t)cur.pm * tstep; const char* cB = (const char*)g.Bt + (size_t)cur.pn * tstep;
    S.a_ready(cur);
    PG8_STAGE(PG8_SB(0, 0), cB, voffB); PG8_STAGE(PG8_SA(0, 0), cA, voffA); PG8_STAGE(PG8_SB(0, 1), cB + hstep, voffB); PG8_STAGE(PG8_SA(0, 1), cA + hstep, voffA);
    if (wr == 1) PG8_BAR;
    PG8_WAIT_V(4); PG8_BAR;
    PG8_STAGE(PG8_SB(1, 0), cB + kstep, voffB); PG8_STAGE(PG8_SA(1, 0), cA + kstep, voffA); PG8_STAGE(PG8_SB(1, 1), cB + hstep + kstep, voffB);
    PG8_WAIT_V(6); PG8_BAR;
    PG8_STAMP();
    for (;;) {
        const bool has_next = S.next(ui + 1, nxt);
        const char* nA = has_next ? (const char*)g.A + (size_t)nxt.pm * tstep : cA; const char* nB = has_next ? (const char*)g.Bt + (size_t)nxt.pn * tstep : cB;
        for (int t = 0; t < nt; t += 2) {
            const bool last = (t == nt - 2);
            const char* a1 = cA + (size_t)(t + 1) * kstep;
            const char* a2 = last ? nA : cA + (size_t)(t + 2) * kstep; const char* b2 = last ? nB : cB + (size_t)(t + 2) * kstep;
            const char* a3 = a2 + kstep; const char* b3 = b2 + kstep;
            if (last && has_next) S.a_ready(nxt);
            PG8_LDB(B0, 0, 0); PG8_SCHED; PG8_LDA(At, 0, 0); PG8_STAGE(PG8_SA(1, 1), a1 + hstep, voffA);
            PG8_WAIT_L(8); PG8_BAR; PG8_WAIT_L(0); PG8_MMA(0, 0, At, B0); PG8_BAR; PG8_SCHED;
            PG8_LDB(B1, 0, 1); PG8_STAGE(PG8_SB(0, 0), b2, voffB);
            PG8_BAR; PG8_WAIT_L(0); PG8_MMA(0, 1, At, B1); PG8_BAR;
            PG8_LDA(At, 0, 1); PG8_STAGE(PG8_SA(0, 0), a2, voffA);
            PG8_BAR; PG8_WAIT_L(0); PG8_MMA(1, 0, At, B0); PG8_BAR; PG8_SCHED;
            PG8_STAGE(PG8_SB(0, 1), b2 + hstep, voffB);
            PG8_WAIT_V(6); PG8_BAR; PG8_MMA(1, 1, At, B1); PG8_BAR;
            PG8_LDB(B0, 1, 0); PG8_SCHED; PG8_LDA(At, 1, 0); PG8_STAGE(PG8_SA(0, 1), a2 + hstep, voffA);
            PG8_WAIT_L(8); PG8_BAR; PG8_WAIT_L(0); PG8_MMA(0, 0, At, B0); PG8_BAR; PG8_SCHED;
            PG8_LDB(B1, 1, 1); PG8_STAGE(PG8_SB(1, 0), b3, voffB);
            PG8_BAR; PG8_WAIT_L(0); PG8_MMA(0, 1, At, B1); PG8_BAR;
            PG8_LDA(At, 1, 1); PG8_STAGE(PG8_SA(1, 0), a3, voffA);
            PG8_BAR; PG8_WAIT_L(0); PG8_MMA(1, 0, At, B0); PG8_BAR; PG8_SCHED;
            PG8_STAGE(PG8_SB(1, 1), b3 + hstep, voffB);
            PG8_WAIT_V(6); PG8_BAR; PG8_MMA(1, 1, At, B1); PG8_BAR;
        }
        PG8_STAMP();
        if constexpr (!Epi::AFTER_DRAIN) { E(acc, cur, wr, wc, fr, fq); S.done(cur); }
        PG8_STAMP();
        if (!has_next) break;
#pragma unroll
        for (int a = 0; a < 2; ++a)
#pragma unroll
            for (int b = 0; b < 2; ++b)
#pragma unroll
                for (int m = 0; m < 4; ++m)
#pragma unroll
                    for (int n = 0; n < 2; ++n) acc[a][b][m][n] = (f32x4){0.f, 0.f, 0.f, 0.f};
        cur = nxt; cA = nA; cB = nB; ++ui;
    }
    PG8_WAIT_V(0);
    if (wr == 0) PG8_BAR;
    PG8_BAR;
    if constexpr (Epi::AFTER_DRAIN) { E.fused(acc, cur, wr, wc, fr, fq, lds, wid, lane); S.done(cur); }
    PG8_STAMP();
    if (STAMP && wid == 0) { stamps[lane] = lane < nts ? (((unsigned long long)(unsigned)ts_hi << 32) | (unsigned)ts_lo) : 0ull;
        if (lane == 62) stamps[62] = rt_entry; if (lane == 63) stamps[63] = (unsigned long long)wall_clock64(); }
#undef PG8_STAMP
#undef PG8_SA
#undef PG8_SB
#undef PG8_STAGE
#undef PG8_LDA
#undef PG8_LDB
#undef PG8_MMA
#undef PG8_WAIT_V
#undef PG8_WAIT_L
#undef PG8_BAR
#undef PG8_SCHED
}
}

typedef unsigned short bf16_t;
typedef short bf16x8 __attribute__((ext_vector_type(8)));
typedef float f32x4 __attribute__((ext_vector_type(4)));
typedef float f32x16 __attribute__((ext_vector_type(16)));
#define LAS __attribute__((address_space(3)))
#define WAVE_SYNC() do { asm volatile("s_waitcnt lgkmcnt(0)" ::: "memory"); __builtin_amdgcn_wave_barrier(); } while (0)

constexpr int DM = 1024, NP = 16384, NSMP = 256, MR = 16640, SEQ = 4096, NB = 4, DB = 32, DS = 8, PAST = 16384;
constexpr int CIN = 6040, NPAD = 6144, CR = 1664;
constexpr int NTHR = 512;
constexpr size_t O_Y_P = 0, O_Y_S = 16777216, O_CMP_P = 17039360, O_CMP_S = 21233664, O_SEL_P = 21299200, O_SEL_S = 25493504,
                 O_WIN_P = 25559040, O_WIN_S = 26083328, O_WKV_P = 30277632, O_WKV_S = 30408704, O_SH_P = 31457280, O_SH_S = 31463936;

constexpr size_t ws_al(size_t x) { return (x + 255) & ~(size_t)255; }
constexpr size_t WS_bar = 0;
constexpr size_t WS_hb = WS_bar + ws_al(32768);
constexpr size_t WS_WinT = WS_hb + ws_al((size_t)MR * DM * 2);
constexpr size_t WS_WpaT = WS_WinT + ws_al((size_t)NPAD * DM * 2);
constexpr size_t WS_WpbT = WS_WpaT + ws_al((size_t)DM * 512 * 2);
constexpr size_t WS_WoutT = WS_WpbT + ws_al((size_t)DM * 512 * 2);
constexpr size_t WS_WgateT = WS_WoutT + ws_al((size_t)DM * DM * 2);
constexpr size_t WS_WprojT = WS_WgateT + ws_al((size_t)DM * DM * 2);
constexpr size_t WS_W1T = WS_WprojT + ws_al((size_t)DM * 256 * 2);
constexpr size_t WS_W2T = WS_W1T + ws_al((size_t)512 * 1024 * 2);
constexpr size_t WS_WupT = WS_W2T + ws_al((size_t)128 * 128 * 2);
constexpr size_t WS_AupT = WS_WupT + ws_al((size_t)512 * 64 * 2);
constexpr size_t WS_pb = WS_AupT + ws_al((size_t)512 * 64 * 2);
constexpr size_t WS_tabc = WS_pb + ws_al((size_t)MR * 256 * 2);
constexpr size_t WS_tabs = WS_tabc + ws_al((size_t)4104 * 32 * 4);
constexpr size_t WS_pt = WS_tabs + ws_al((size_t)4104 * 32 * 4);
constexpr size_t WS_qb = WS_pt + ws_al(256 * 4);
constexpr size_t WS_kb = WS_qb + ws_al((size_t)MR * 512 * 2);
constexpr size_t WS_vcr = WS_kb + ws_al((size_t)3 * NB * 2 * SEQ * 64 * 2);
constexpr size_t WS_vT = WS_vcr + ws_al((size_t)NB * 2 * SEQ * 64 * 2);
constexpr size_t WS_ag = WS_vT + ws_al((size_t)2 * NB * 2 * 64 * SEQ * 2);
constexpr size_t WS_rg = WS_ag + ws_al((size_t)MR * 512 * 2);
constexpr size_t WS_mg = WS_rg + ws_al((size_t)MR * 512 * 2);
constexpr size_t WS_gates = WS_mg + ws_al((size_t)MR * 2048 * 2);
constexpr size_t WS_rz = WS_gates + ws_al((size_t)MR * 32 * 4);
constexpr size_t WS_zs0 = WS_rz + ws_al((size_t)MR * CR * 2);
constexpr size_t WS_LHp = WS_zs0 + ws_al((size_t)33 * CR * 2);
constexpr size_t WS_LHs = WS_LHp + ws_al((size_t)2 * 2048 * 256 * 4);
constexpr size_t WS_cs = WS_LHs + ws_al((size_t)2 * 65536 * 256 * 4);
constexpr size_t WS_kc_p = WS_cs + ws_al((size_t)2 * 65536 * 1024 * 2);
constexpr size_t WS_vcT_p = WS_kc_p + ws_al((size_t)8 * 256 * 64 * 2);
constexpr size_t WS_kc_s = WS_vcT_p + ws_al((size_t)8 * 64 * 256 * 2);
constexpr size_t WS_vcT_s = WS_kc_s + ws_al((size_t)64 * 1024 * 64 * 2);
constexpr size_t WS_rw6 = WS_vcT_s + ws_al((size_t)64 * 64 * 1024 * 2);
constexpr int RW6_STRIDE = 896;
constexpr size_t WS_bonus = WS_rw6 + ws_al((size_t)MR * 8 * RW6_STRIDE);
constexpr size_t WS_ybuf = WS_bonus + ws_al((size_t)MR * 8 * 4);
constexpr size_t WS_oa = WS_ybuf + ws_al((size_t)MR * 512 * 4);
constexpr size_t WS_ob = WS_oa + ws_al((size_t)MR * 512 * 2);
constexpr size_t WS_mb = WS_ob + ws_al((size_t)MR * 512 * 2);
constexpr size_t WS_xg = WS_mb + ws_al((size_t)MR * DM * 2);
constexpr size_t WS_tmp = WS_xg + ws_al((size_t)MR * DM * 2);
constexpr size_t WS_x1 = WS_tmp + ws_al((size_t)MR * DM * 4);
constexpr size_t WS_ss1 = WS_x1 + ws_al((size_t)MR * DM * 4);
constexpr size_t WS_pp = WS_ss1 + ws_al((size_t)MR * 16 * 4);
constexpr size_t WS_TOTAL = WS_pp + ws_al((size_t)MR * DM * 4);

struct P {
    const float *x_prompt, *x_sample, *p_prompt, *p_sample, *cache_cmp, *cache_sel, *cache_win, *state_wkv, *state_shift;
    const int* page_table;
    const float *norm_g, *w_in, *cmp_pe, *cmp_w1, *cmp_b1, *cmp_w2, *cmp_b2, *w_pa, *mu, *w0, *w_up, *a0, *a_up, *k_k, *k_a, *r_k, *gn_g, *gn_b,
        *w_pb, *w_out, *ple_g, *w_gate, *w_proj, *final_g;
    float* out;
    unsigned char* ws;
    __host__ __device__ __forceinline__ unsigned* bar() const { return (unsigned*)(ws + WS_bar); }
    __host__ __device__ __forceinline__ float* ss_s() const { return (float*)(ws + WS_bar + 16384); }
    __host__ __device__ __forceinline__ bf16_t* hb() const { return (bf16_t*)(ws + WS_hb); }
    __host__ __device__ __forceinline__ bf16_t* WinT() const { return (bf16_t*)(ws + WS_WinT); }
    __host__ __device__ __forceinline__ bf16_t* WpaT() const { return (bf16_t*)(ws + WS_WpaT); }
    __host__ __device__ __forceinline__ bf16_t* WpbT() const { return (bf16_t*)(ws + WS_WpbT); }
    __host__ __device__ __forceinline__ bf16_t* WoutT() const { return (bf16_t*)(ws + WS_WoutT); }
    __host__ __device__ __forceinline__ bf16_t* WgateT() const { return (bf16_t*)(ws + WS_WgateT); }
    __host__ __device__ __forceinline__ bf16_t* WprojT() const { return (bf16_t*)(ws + WS_WprojT); }
    __host__ __device__ __forceinline__ bf16_t* W1T() const { return (bf16_t*)(ws + WS_W1T); }
    __host__ __device__ __forceinline__ bf16_t* W2T() const { return (bf16_t*)(ws + WS_W2T); }
    __host__ __device__ __forceinline__ bf16_t* WupT() const { return (bf16_t*)(ws + WS_WupT); }
    __host__ __device__ __forceinline__ bf16_t* AupT() const { return (bf16_t*)(ws + WS_AupT); }
    __host__ __device__ __forceinline__ bf16_t* pb() const { return (bf16_t*)(ws + WS_pb); }
    __host__ __device__ __forceinline__ float* tabc() const { return (float*)(ws + WS_tabc); }
    __host__ __device__ __forceinline__ float* tabs() const { return (float*)(ws + WS_tabs); }
    __host__ __device__ __forceinline__ float* pt() const { return (float*)(ws + WS_pt); }
    __host__ __device__ __forceinline__ bf16_t* qb() const { return (bf16_t*)(ws + WS_qb); }
    __host__ __device__ __forceinline__ bf16_t* kb() const { return (bf16_t*)(ws + WS_kb); }
    __host__ __device__ __forceinline__ bf16_t* vcr() const { return (bf16_t*)(ws + WS_vcr); }
    __host__ __device__ __forceinline__ bf16_t* vT() const { return (bf16_t*)(ws + WS_vT); }
    __host__ __device__ __forceinline__ bf16_t* ag() const { return (bf16_t*)(ws + WS_ag); }
    __host__ __device__ __forceinline__ bf16_t* rg() const { return (bf16_t*)(ws + WS_rg); }
    __host__ __device__ __forceinline__ bf16_t* mg() const { return (bf16_t*)(ws + WS_mg); }
    __host__ __device__ __forceinline__ float* gates() const { return (float*)(ws + WS_gates); }
    __host__ __device__ __forceinline__ bf16_t* rz() const { return (bf16_t*)(ws + WS_rz); }
    __host__ __device__ __forceinline__ bf16_t* zs0() const { return (bf16_t*)(ws + WS_zs0); }
    __host__ __device__ __forceinline__ bf16_t* LHp() const { return (bf16_t*)(ws + WS_LHp); }
    __host__ __device__ __forceinline__ bf16_t* LHs() const { return (bf16_t*)(ws + WS_LHs); }
    __host__ __device__ __forceinline__ bf16_t* cs() const { return (bf16_t*)(ws + WS_cs); }
    __host__ __device__ __forceinline__ bf16_t* kc_p() const { return (bf16_t*)(ws + WS_kc_p); }
    __host__ __device__ __forceinline__ bf16_t* vcT_p() const { return (bf16_t*)(ws + WS_vcT_p); }
    __host__ __device__ __forceinline__ bf16_t* kc_s() const { return (bf16_t*)(ws + WS_kc_s); }
    __host__ __device__ __forceinline__ bf16_t* vcT_s() const { return (bf16_t*)(ws + WS_vcT_s); }
    __host__ __device__ __forceinline__ unsigned char* rw6() const { return ws + WS_rw6; }
    __host__ __device__ __forceinline__ float* bonus() const { return (float*)(ws + WS_bonus); }
    __host__ __device__ __forceinline__ float* ybuf() const { return (float*)(ws + WS_ybuf); }
    __host__ __device__ __forceinline__ bf16_t* oa() const { return (bf16_t*)(ws + WS_oa); }
    __host__ __device__ __forceinline__ bf16_t* ob() const { return (bf16_t*)(ws + WS_ob); }
    __host__ __device__ __forceinline__ bf16_t* mb() const { return (bf16_t*)(ws + WS_mb); }
    __host__ __device__ __forceinline__ bf16_t* xg() const { return (bf16_t*)(ws + WS_xg); }
    __host__ __device__ __forceinline__ float* tmp() const { return (float*)(ws + WS_tmp); }
    __host__ __device__ __forceinline__ float* x1() const { return (float*)(ws + WS_x1); }
    __host__ __device__ __forceinline__ float* ss1() const { return (float*)(ws + WS_ss1); }
    __host__ __device__ __forceinline__ float* pp() const { return (float*)(ws + WS_pp); }
};


__device__ __forceinline__ float bf2f(bf16_t b) { return __uint_as_float(((unsigned)b) << 16); }
typedef __bf16 bf16v2_t __attribute__((ext_vector_type(2)));
typedef float f32x2_t __attribute__((ext_vector_type(2)));
__device__ __forceinline__ unsigned pk2(float lo, float hi) { const f32x2_t v = {lo, hi}; return __builtin_bit_cast(unsigned, __builtin_convertvector(v, bf16v2_t)); }
__device__ __forceinline__ bf16_t f2bf(float f) { return (bf16_t)(pk2(f, f) & 0xffffu); }
__device__ __forceinline__ float xsum16(float v) { const auto r = __builtin_amdgcn_permlane16_swap(__float_as_uint(v), __float_as_uint(v), false, false); return __uint_as_float(r[0]) + __uint_as_float(r[1]); }
__device__ __forceinline__ float xsum32(float v) { const auto r = __builtin_amdgcn_permlane32_swap(__float_as_uint(v), __float_as_uint(v), false, false); return __uint_as_float(r[0]) + __uint_as_float(r[1]); }
__device__ __forceinline__ float xmax32(float v) { const auto r = __builtin_amdgcn_permlane32_swap(__float_as_uint(v), __float_as_uint(v), false, false); return fmaxf(__uint_as_float(r[0]), __uint_as_float(r[1])); }
__device__ __forceinline__ float quad_sum(float v) {
    v += __builtin_bit_cast(float, __builtin_amdgcn_mov_dpp(__builtin_bit_cast(int, v), 0xB1, 0xF, 0xF, true));
    v += __builtin_bit_cast(float, __builtin_amdgcn_mov_dpp(__builtin_bit_cast(int, v), 0x4E, 0xF, 0xF, true));
    return v;
}
__device__ __forceinline__ float wave_sum(float v) {
    v += __builtin_bit_cast(float, __builtin_amdgcn_mov_dpp(__builtin_bit_cast(int, v), 0xB1, 0xF, 0xF, true));
    v += __builtin_bit_cast(float, __builtin_amdgcn_mov_dpp(__builtin_bit_cast(int, v), 0x4E, 0xF, 0xF, true));
    v += __builtin_bit_cast(float, __builtin_amdgcn_mov_dpp(__builtin_bit_cast(int, v), 0x141, 0xF, 0xF, true));
    v += __builtin_bit_cast(float, __builtin_amdgcn_mov_dpp(__builtin_bit_cast(int, v), 0x140, 0xF, 0xF, true));
    return xsum32(xsum16(v));
}
__device__ __forceinline__ float sigmoidf_(float x) { return 1.0f / (1.0f + __expf(-x)); }
__device__ __forceinline__ float siluf_(float x) { return x / (1.0f + __expf(-x)); }
__device__ __forceinline__ float sigmoid_fast(float x) { return __builtin_amdgcn_rcpf(1.0f + __expf(-x)); }
__device__ __forceinline__ float silu_fast(float x) { return x * __builtin_amdgcn_rcpf(1.0f + __expf(-x)); }

__device__ __forceinline__ int win_src_col(int np) {
    const int pn = np >> 8, p = np & 255;
    if (pn < 5) {
        const int bj = p >> 7, wc = (p >> 5) & 3, n = (p >> 4) & 1, fq = (p >> 2) & 3, e = p & 3;
        const int d = 32 * n + 16 * (wc & 1) + 4 * fq + e;
        if (pn < 2) { const int head = pn * 4 + bj * 2 + (wc >> 1); return head * 64 + d; }
        const int br = pn - 2, g = wc >> 1;
        return 512 + br * 256 + bj * 128 + g * 64 + d;
    }
    const int s = (p & 0xe0) + 8 * ((p >> 2) & 3) + 4 * ((p >> 4) & 1) + (p & 3);
    if (pn < 7) return 1304 + (pn - 5) * 256 + s;
    if (pn < 13) return 1816 + (pn - 7) * 256 + s;
    if (pn == 13) { if (s < 128) return 1816 + 1536 + s; if (s < 152) return 1280 + (s - 128); return -1; }
    if (pn < 16) return 3480 + (pn - 14) * 256 + s;
    return 3992 + (pn - 16) * 256 + s;
}

__device__ __forceinline__ int perm8(int np) { return (np & ~31) + 8 * ((np >> 2) & 3) + 4 * ((np >> 4) & 1) + (np & 3); }
template <class F>
__device__ __forceinline__ void transpose_cvt(bf16_t* dst, int Nd, int K, F f) {
    const int total = Nd * (K >> 3);
    for (int id = blockIdx.x * NTHR + threadIdx.x; id < total; id += gridDim.x * NTHR) {
        const int n = id % Nd, kc = id / Nd;
        float v[8];
#pragma unroll
        for (int j = 0; j < 8; ++j) v[j] = f(n, kc * 8 + j);
        uint4 w; w.x = pk2(v[0], v[1]); w.y = pk2(v[2], v[3]); w.z = pk2(v[4], v[5]); w.w = pk2(v[6], v[7]);
        *(uint4*)(dst + (size_t)n * K + kc * 8) = w;
    }
}

__device__ __forceinline__ void sincos_small(double r, float& s, float& c) {
    const double r2 = r * r;
    double sa = 1.0, ca = 1.0;
    double ts = 1.0, tc = 1.0; sa = 0.0; ca = 0.0;
#pragma unroll
    for (int k = 0; k < 16; ++k) {
        sa += ts; ca += tc;
        ts = -ts * r2 / (double)((2 * k + 2) * (2 * k + 3));
        tc = -tc * r2 / (double)((2 * k + 1) * (2 * k + 2));
    }
    s = (float)(sa * r); c = (float)ca;
}

__device__ __forceinline__ void ph_prep(const P& p) {
    const int tid = threadIdx.x, lane = tid & 63, wid = tid >> 6;
    const int gw = blockIdx.x * 8 + wid, nw = gridDim.x * 8;
    const int gt = blockIdx.x * NTHR + tid, nt = gridDim.x * NTHR;
    for (int row = gw; row < MR; row += nw) {
        const float4* src = (const float4*)(row < NP ? p.x_prompt + (size_t)row * DM : p.x_sample + (size_t)(row - NP) * DM);
        float4 v[4]; float ss = 0.f;
#pragma unroll
        for (int i = 0; i < 4; ++i) { v[i] = src[lane + 64 * i]; ss += v[i].x * v[i].x + v[i].y * v[i].y + v[i].z * v[i].z + v[i].w * v[i].w; }
        ss = wave_sum(ss);
        const float rstd = rsqrtf(ss * (1.0f / DM) + 1e-6f);
#pragma unroll
        for (int i = 0; i < 4; ++i) {
            const float4 g = ((const float4*)p.norm_g)[lane + 64 * i];
            uint2 w; w.x = pk2(v[i].x * rstd * g.x, v[i].y * rstd * g.y); w.y = pk2(v[i].z * rstd * g.z, v[i].w * rstd * g.w);
            *(uint2*)(p.hb() + (size_t)row * DM + 4 * (lane + 64 * i)) = w;
        }
    }
    { const float* w = p.w_in; transpose_cvt(p.WinT(), NPAD, DM, [=](int n, int k) { const int c = win_src_col(n); return c < 0 ? 0.f : w[(size_t)k * CIN + c]; }); }
    { const float* w = p.w_pa; transpose_cvt(p.WpaT(), DM, 512, [=](int n, int k) { return w[(size_t)k * DM + perm8(n)]; }); }
    { const float* w = p.w_pb; transpose_cvt(p.WpbT(), DM, 512, [=](int n, int k) { return w[(size_t)k * DM + perm8(n)]; }); }
    { const float* w = p.w_out; transpose_cvt(p.WoutT(), DM, DM, [=](int n, int k) { return w[(size_t)k * DM + perm8(n)]; }); }
    { const float* w = p.w_gate; transpose_cvt(p.WgateT(), DM, DM, [=](int n, int k) { return w[(size_t)k * DM + perm8(n)]; }); }
    { const float* w = p.w_proj; transpose_cvt(p.WprojT(), DM, 256, [=](int n, int k) { return w[(size_t)k * DM + perm8(n)]; }); }
    { const float* w = p.cmp_w1; transpose_cvt(p.W1T(), 512, 1024, [=](int n, int k) { const int kvi = n >> 8, nn = n & 255; return w[(size_t)kvi * 262144 + (size_t)((nn >> 7) * 1024 + k) * 128 + (nn & 127)]; }); }
    { const float* w = p.cmp_w2; transpose_cvt(p.W2T(), 128, 128, [=](int n, int k) { return w[(size_t)(n >> 6) * 8192 + (size_t)k * 64 + (n & 63)]; }); }
    { const float* w = p.w_up; transpose_cvt(p.WupT(), 512, 64, [=](int n, int k) { return w[(size_t)k * 512 + n]; }); }
    { const float* w = p.a_up; transpose_cvt(p.AupT(), 512, 64, [=](int n, int k) { return w[(size_t)k * 512 + n]; }); }
    for (int id = gt; id < 33 * CR; id += nt) p.zs0()[id] = id < CR ? (bf16_t)0 : f2bf(p.state_shift[id - CR]);
    for (int id = gt; id < MR * 64; id += nt) {
        const int row = id >> 6, c4 = id & 63;
        const float4 v = ((const float4*)(row < NP ? p.p_prompt + (size_t)row * 256 : p.p_sample + (size_t)(row - NP) * 256))[c4];
        uint2 w; w.x = pk2(v.x, v.y); w.y = pk2(v.z, v.w);
        *(uint2*)(p.pb() + (size_t)row * 256 + c4 * 4) = w;
    }
    for (int id = gt; id < 4104 * 32; id += nt) {
        const int pi = id >> 5, i = id & 31;
        const int pos = pi < 4096 ? pi : PAST + pi - 4096;
        const float inv = (float)exp(-(double)i * (9.210340371976184 / 32.0));
        const float ang = (float)pos * inv;
        const double x = (double)ang;
        const double k = rint(x * 0.15915494309189535);
        const double r = x - k * 6.283185307179586;
        float s, c; sincos_small(r, s, c);
        p.tabc()[id] = c; p.tabs()[id] = s;
    }
    for (int o = gw; o < 256; o += nw) {
        const int kvi = o >> 7, f = o & 127;
        float acc = 0.f;
        for (int jd = lane; jd < 2048; jd += 64) acc += p.cmp_pe[kvi * 2048 + jd] * p.cmp_w1[(size_t)kvi * 262144 + (size_t)jd * 128 + f];
        acc = wave_sum(acc);
        if (lane == 0) p.pt()[o] = acc + p.cmp_b1[o];
    }
    for (int id = gt; id < DB * 504 * 64; id += nt) {
        const int c4 = id & 63, j = (id >> 6) % 504, b = (id >> 6) / 504;
        ((float4*)(p.out + O_WIN_S))[((size_t)b * 512 + j) * 64 + c4] = ((const float4*)p.cache_win)[((size_t)b * 512 + j + 8) * 64 + c4];
    }
}
#define XB_TMO      128
#define XB_XCNT(j)  (256  + 64 * (j))
#define XB_XSUB(j)  (1280 + 64 * (j))
#define XB_XGEN(j)  (2304 + 64 * (j))
#define XB_TOP      3328
#define XB_TOPGEN   3392
#define XCD_BAR_WORDS 3456
#define XB_SPIN_CAP (1u << 18)

__device__ __forceinline__ unsigned xb_ld(unsigned* p)              { return __hip_atomic_load(p, __ATOMIC_RELAXED, __HIP_MEMORY_SCOPE_AGENT); }
__device__ __forceinline__ unsigned xb_add(unsigned* p, unsigned v) { return __hip_atomic_fetch_add(p, v, __ATOMIC_RELAXED, __HIP_MEMORY_SCOPE_AGENT); }
__device__ __forceinline__ unsigned xb_xcc_id() { return (unsigned)__builtin_amdgcn_s_getreg((3 << 11) | 20) & 0xFu; }
#define XB_SPIN(cond, bar) do { unsigned _sp = 0; while (cond) { __builtin_amdgcn_s_sleep(1); \
    if ((++_sp & 255u) == 0u) { if (xb_ld(&(bar)[XB_TMO])) break; if (_sp > XB_SPIN_CAP) { atomicAdd(&(bar)[XB_TMO], 1u); break; } } } } while (0)

struct XcdBarrier {
    unsigned* bar; unsigned x;
    volatile LAS unsigned* st;
};

__device__ __forceinline__ XcdBarrier xcd_barrier_post(unsigned* bar, volatile LAS unsigned* st) {
    XcdBarrier b; b.bar = bar; b.x = xb_xcc_id(); b.st = st;
    if (threadIdx.x == 0) (void)xb_add(&bar[XB_XCNT(b.x)], 1u);
    return b;
}
__device__ __forceinline__ void xcd_barrier_complete(unsigned* bar, unsigned x, unsigned& nloc, unsigned& nx) {
    const unsigned G = gridDim.x * gridDim.y * gridDim.z;
    unsigned sum, cnt, mine, sp = 0u;
    for (;;) {
        sum = 0u; cnt = 0u; mine = 0u;
#pragma unroll
        for (unsigned j = 0; j < 16; ++j) { const unsigned c = xb_ld(&bar[XB_XCNT(j)]); sum += c; cnt += (c > 0u) ? 1u : 0u; mine = (j == x) ? c : mine; }
        if (sum == G) break;
        __builtin_amdgcn_s_sleep(1);
        if ((++sp & 255u) == 0u) { if (xb_ld(&bar[XB_TMO])) break; if (sp > XB_SPIN_CAP) { atomicAdd(&bar[XB_TMO], 1u); break; } }
    }
    nloc = mine > 0u ? mine : 1u; nx = cnt > 0u ? cnt : 1u;
}

__device__ __forceinline__ void xcd_barrier(const XcdBarrier& b) {
    asm volatile("s_waitcnt vmcnt(0)" ::: "memory");
    __syncthreads();
    if (threadIdx.x == 0) {
        unsigned* bar = b.bar;
        __builtin_amdgcn_s_waitcnt(0);
        unsigned nloc = b.st[0], nx = b.st[1];
        if (nloc == 0u) { xcd_barrier_complete(bar, b.x, nloc, nx); b.st[0] = nloc; b.st[1] = nx; }
        const unsigned old = xb_add(&bar[XB_XSUB(b.x)], 1u);
        const unsigned gen = old / nloc;
        if (old + 1u == (gen + 1u) * nloc) {
            __builtin_amdgcn_fence(__ATOMIC_RELEASE, "agent");
            asm volatile("s_waitcnt vmcnt(0)" ::: "memory");
            const unsigned og = xb_add(&bar[XB_TOP], 1u);
            const unsigned tg = og / nx;
            if (og + 1u == (tg + 1u) * nx) xb_add(&bar[XB_TOPGEN], 1u);
            else XB_SPIN(xb_ld(&bar[XB_TOPGEN]) == tg, bar);
            __builtin_amdgcn_fence(__ATOMIC_ACQUIRE, "agent");
            xb_add(&bar[XB_XGEN(b.x)], 1u);
            asm volatile("s_waitcnt vmcnt(0)" ::: "memory");
        } else {
            XB_SPIN(xb_ld(&bar[XB_XGEN(b.x)]) == gen, bar);
            __builtin_amdgcn_fence(__ATOMIC_ACQUIRE, "agent");
            asm volatile("s_waitcnt vmcnt(0)" ::: "memory");
        }
    }
    __syncthreads();
}

using pg8::Unit;
typedef unsigned u32x2 __attribute__((ext_vector_type(2)));
typedef unsigned u32x4_t __attribute__((ext_vector_type(4)));
__device__ __forceinline__ f32x16 mfma32(bf16x8 a, bf16x8 b, f32x16 c) { return __builtin_amdgcn_mfma_f32_32x32x16_bf16(a, b, c, 0, 0, 0); }
__device__ __forceinline__ bf16x8 pack8(float a0, float a1, float a2, float a3, float a4, float a5, float a6, float a7) {
    union { uint4 u; bf16x8 v; } x; x.u.x = pk2(a0, a1); x.u.y = pk2(a2, a3); x.u.z = pk2(a4, a5); x.u.w = pk2(a6, a7); return x.v;
}
__device__ __forceinline__ f32x16 zero16() { f32x16 z; for (int i = 0; i < 16; ++i) z[i] = 0.f; return z; }


__device__ __forceinline__ void st_bf4(bf16_t* dst, f32x4 v) { uint2 w; w.x = pk2(v[0], v[1]); w.y = pk2(v[2], v[3]); *(uint2*)dst = w; }

constexpr float QSCALE = 0.125f * 1.4426950408889634f;
struct EpiIn {
    static constexpr bool PERM = false, AFTER_DRAIN = false;
    P p; int row0; int pn0;
    __device__ __forceinline__ void operator()(const f32x4 (&acc)[2][2][4][2], const Unit& u, int wr, int wc, int fr, int fq) const {
        const int pn = pn0 + u.pn;
#pragma unroll
        for (int ai = 0; ai < 2; ++ai)
#pragma unroll
            for (int m = 0; m < 4; ++m) {
                const int row = row0 + u.pm * 256 + ai * 128 + wr * 64 + m * 16 + fr;
                if (pn < 5) {
                    const int pi = row < NP ? (row & (SEQ - 1)) : 4096 + ((row - NP) & 7);
                    const int d0 = 16 * (wc & 1) + 4 * fq;
                    const f32x4 cs = *(const f32x4*)(p.tabc() + pi * 32 + d0), sn = *(const f32x4*)(p.tabs() + pi * 32 + d0);
#pragma unroll
                    for (int bj = 0; bj < 2; ++bj) {
                        const f32x4 x1 = acc[ai][bj][m][0], x2 = acc[ai][bj][m][1];
                        if (pn < 2) {
                            const int head = pn * 4 + bj * 2 + (wc >> 1);
                            const f32x4 o1 = (x1 * cs - x2 * sn) * QSCALE, o2 = (x2 * cs + x1 * sn) * QSCALE;
                            bf16_t* q = p.qb() + (size_t)row * 512 + head * 64 + d0;
                            st_bf4(q, o1); st_bf4(q + 32, o2);
                        } else {
                            const int br = pn - 2, g = wc >> 1;
                            f32x4 o1, o2;
                            if (bj == 0) { o1 = x1 * cs - x2 * sn; o2 = x2 * cs + x1 * sn; } else { o1 = x1; o2 = x2; }
                            float* dst = nullptr;
                            if (row < NP) {
                                if (br == 0) dst = p.out + O_CMP_P + (size_t)row * 256;
                                else if (br == 1) dst = p.out + O_SEL_P + (size_t)row * 256;
                                else { const int s = row & (SEQ - 1); if (s >= SEQ - 512) dst = p.out + O_WIN_P + ((size_t)(row >> 12) * 512 + (s - (SEQ - 512))) * 256; }
                            } else {
                                const int rs = row - NP;
                                if (br == 0) dst = p.out + O_CMP_S + (size_t)rs * 256;
                                else if (br == 1) dst = p.out + O_SEL_S + (size_t)rs * 256;
                                else dst = p.out + O_WIN_S + ((size_t)(rs >> 3) * 512 + 504 + (rs & 7)) * 256;
                            }
                            if (dst) { dst += bj * 128 + g * 64 + d0; *(f32x4*)dst = o1; *(f32x4*)(dst + 32) = o2; }
                            if (row < NP) {
                                const int b = row >> 12, s = row & (SEQ - 1);
                                if (bj == 0) {
                                    bf16_t* k = p.kb() + ((size_t)((br * NB + b) * 2 + g) * SEQ + s) * 64 + d0;
                                    st_bf4(k, o1); st_bf4(k + 32, o2);
                                } else if (br == 0) {
                                    bf16_t* v = p.vcr() + ((size_t)(b * 2 + g) * SEQ + s) * 64 + d0;
                                    st_bf4(v, o1); st_bf4(v + 32, o2);
                                } else {
                                    bf16_t* v = p.vT() + ((size_t)(((br - 1) * NB + b) * 2 + g) * 64 + d0) * SEQ + s;
#pragma unroll
                                    for (int e = 0; e < 4; ++e) { v[(size_t)e * SEQ] = f2bf(o1[e]); v[(size_t)(32 + e) * SEQ] = f2bf(o2[e]); }
                                }
                            }
                        }
                    }
                } else {
#pragma unroll
                    for (int bj = 0; bj < 2; ++bj) {
                        const int c = bj * 128 + wc * 32 + fq * 8;
                        const f32x4 v0 = acc[ai][bj][m][0], v1 = acc[ai][bj][m][1];
                        auto st8 = [&](bf16_t* dst, const f32x4& a, const f32x4& b) { uint4 w; w.x = pk2(a[0], a[1]); w.y = pk2(a[2], a[3]); w.z = pk2(b[0], b[1]); w.w = pk2(b[2], b[3]); *(uint4*)dst = w; };
                        if (pn < 7 || (pn >= 14 && pn < 16)) {
                            f32x4 o0, o1; for (int e = 0; e < 4; ++e) { o0[e] = silu_fast(v0[e]); o1[e] = silu_fast(v1[e]); }
                            st8((pn < 7 ? p.ag() + (size_t)row * 512 + (pn - 5) * 256 : p.rg() + (size_t)row * 512 + (pn - 14) * 256) + c, o0, o1);
                        } else if (pn < 13) {
                            st8(p.rz() + (size_t)row * CR + (pn - 7) * 256 + c, v0, v1);
                        } else if (pn == 13) {
                            if (c < 128) st8(p.rz() + (size_t)row * CR + 1536 + c, v0, v1);
                            else if (c < 152) { f32x4 o0, o1; for (int e = 0; e < 4; ++e) { o0[e] = sigmoid_fast(v0[e]); o1[e] = sigmoid_fast(v1[e]); }
                                *(f32x4*)(p.gates() + (size_t)row * 32 + (c - 128)) = o0; *(f32x4*)(p.gates() + (size_t)row * 32 + (c - 128) + 4) = o1; }
                        } else {
                            f32x4 o0, o1; for (int e = 0; e < 4; ++e) { o0[e] = sigmoid_fast(v0[e]); o1[e] = sigmoid_fast(v1[e]); }
                            st8(p.mg() + (size_t)row * 2048 + (pn - 16) * 256 + c, o0, o1);
                        }
                    }
                }
            }
    }
};

struct EpiPlain {
    static constexpr bool PERM = false, AFTER_DRAIN = false;
    float* C; int ldc; int pad_;
    __device__ __forceinline__ void quad(int row, int c, f32x4 v) const { *(f32x4*)(C + (size_t)row * ldc + c) = v; }
    __device__ __forceinline__ void operator()(const f32x4 (&acc)[2][2][4][2], const Unit& u, int wr, int wc, int fr, int fq) const {
#pragma unroll
        for (int ai = 0; ai < 2; ++ai)
#pragma unroll
            for (int m = 0; m < 4; ++m) {
                float* rowp = C + (size_t)(u.pm * 256 + ai * 128 + wr * 64 + m * 16 + fr) * ldc + u.pn * 256 + wc * 32 + 8 * fq;
#pragma unroll
                for (int bj = 0; bj < 2; ++bj)
#pragma unroll
                    for (int n = 0; n < 2; ++n) *(f32x4*)(rowp + bj * 128 + n * 4) = acc[ai][bj][m][n];
            }
    }
};


struct EpiPlainBf {
    static constexpr bool PERM = false, AFTER_DRAIN = false;
    bf16_t* C; int ldc; int pad_;
    __device__ __forceinline__ void operator()(const f32x4 (&acc)[2][2][4][2], const Unit& u, int wr, int wc, int fr, int fq) const {
#pragma unroll
        for (int ai = 0; ai < 2; ++ai)
#pragma unroll
            for (int m = 0; m < 4; ++m) {
                bf16_t* rowp = C + (size_t)(u.pm * 256 + ai * 128 + wr * 64 + m * 16 + fr) * ldc + u.pn * 256 + wc * 32 + 4 * fq;
#pragma unroll
                for (int bj = 0; bj < 2; ++bj)
#pragma unroll
                    for (int n = 0; n < 2; ++n) st_bf4(rowp + bj * 128 + n * 16, acc[ai][bj][m][n]);
            }
    }
};

struct EpiYa {
    static constexpr bool PERM = false, AFTER_DRAIN = false;
    P p;
    __device__ __forceinline__ void quad(int row, int c, f32x4 v) const {
        const uint2 gw = *(const uint2*)(p.mg() + (size_t)row * 2048 + c);
        f32x4 g; g[0] = __uint_as_float(gw.x << 16); g[1] = __uint_as_float(gw.x & 0xffff0000u); g[2] = __uint_as_float(gw.y << 16); g[3] = __uint_as_float(gw.y & 0xffff0000u);
        *(f32x4*)(p.tmp() + (size_t)row * DM + c) = g * v;
    }
    __device__ __forceinline__ void operator()(const f32x4 (&acc)[2][2][4][2], const Unit& u, int wr, int wc, int fr, int fq) const {
#pragma unroll
        for (int ai = 0; ai < 2; ++ai)
#pragma unroll
            for (int m = 0; m < 4; ++m) {
                const int row = u.pm * 256 + ai * 128 + wr * 64 + m * 16 + fr;
#pragma unroll
                for (int bj = 0; bj < 2; ++bj)
#pragma unroll
                    for (int n = 0; n < 2; ++n) {
                        const int c = u.pn * 256 + bj * 128 + wc * 32 + fq * 8 + n * 4;
                        const uint2 gw = *(const uint2*)(p.mg() + (size_t)row * 2048 + c);
                        f32x4 g; g[0] = __uint_as_float(gw.x << 16); g[1] = __uint_as_float(gw.x & 0xffff0000u); g[2] = __uint_as_float(gw.y << 16); g[3] = __uint_as_float(gw.y & 0xffff0000u);
                        *(f32x4*)(p.tmp() + (size_t)row * DM + c) = g * acc[ai][bj][m][n];
                    }
            }
    }
};
struct EpiYb {
    static constexpr bool PERM = false, AFTER_DRAIN = false;
    P p;
    __device__ __forceinline__ void quad(int row, int c, f32x4 v) const {
        const uint2 gw = *(const uint2*)(p.mg() + (size_t)row * 2048 + 1024 + c);
        f32x4 g; g[0] = __uint_as_float(gw.x << 16); g[1] = __uint_as_float(gw.x & 0xffff0000u); g[2] = __uint_as_float(gw.y << 16); g[3] = __uint_as_float(gw.y & 0xffff0000u);
        st_bf4(p.mb() + (size_t)row * DM + c, *(const f32x4*)(p.tmp() + (size_t)row * DM + c) + g * v);
    }
    __device__ __forceinline__ void operator()(const f32x4 (&acc)[2][2][4][2], const Unit& u, int wr, int wc, int fr, int fq) const {
#pragma unroll
        for (int ai = 0; ai < 2; ++ai)
#pragma unroll
            for (int m = 0; m < 4; ++m) {
                const int row = u.pm * 256 + ai * 128 + wr * 64 + m * 16 + fr;
#pragma unroll
                for (int bj = 0; bj < 2; ++bj)
#pragma unroll
                    for (int n = 0; n < 2; ++n) {
                        const int c = u.pn * 256 + bj * 128 + wc * 32 + fq * 8 + n * 4;
                        const uint2 gw = *(const uint2*)(p.mg() + (size_t)row * 2048 + 1024 + c);
                        f32x4 g; g[0] = __uint_as_float(gw.x << 16); g[1] = __uint_as_float(gw.x & 0xffff0000u); g[2] = __uint_as_float(gw.y << 16); g[3] = __uint_as_float(gw.y & 0xffff0000u);
                        const f32x4 t = *(const f32x4*)(p.tmp() + (size_t)row * DM + c);
                        st_bf4(p.mb() + (size_t)row * DM + c, t + g * acc[ai][bj][m][n]);
                    }
            }
    }
};
struct EpiOut {
    static constexpr bool PERM = false, AFTER_DRAIN = false;
    P p;
    __device__ __forceinline__ void quad(int row, int c, f32x4 a) const {
        const float* xr = p.x_sample + (size_t)(row - NP) * DM;
        const f32x4 v = *(const f32x4*)(xr + c) + a;
        *(f32x4*)(p.x1() + (size_t)row * DM + c) = v;
        st_bf4(p.xg() + (size_t)row * DM + c, v * *(const f32x4*)(p.ple_g + c));
        atomicAdd(p.ss_s() + (row - NP), v[0] * v[0] + v[1] * v[1] + v[2] * v[2] + v[3] * v[3]);
    }
    __device__ __forceinline__ void operator()(const f32x4 (&acc)[2][2][4][2], const Unit& u, int wr, int wc, int fr, int fq) const {
#pragma unroll
        for (int ai = 0; ai < 2; ++ai)
#pragma unroll
            for (int m = 0; m < 4; ++m) {
                const int row = u.pm * 256 + ai * 128 + wr * 64 + m * 16 + fr;
                const float* xr = row < NP ? p.x_prompt + (size_t)row * DM : p.x_sample + (size_t)(row - NP) * DM;
                float ss = 0.f;
#pragma unroll
                for (int bj = 0; bj < 2; ++bj)
#pragma unroll
                    for (int n = 0; n < 2; ++n) {
                        const int c = u.pn * 256 + bj * 128 + wc * 32 + fq * 8 + n * 4;
                        const f32x4 v = *(const f32x4*)(xr + c) + acc[ai][bj][m][n];
                        *(f32x4*)(p.x1() + (size_t)row * DM + c) = v;
                        ss += v[0] * v[0] + v[1] * v[1] + v[2] * v[2] + v[3] * v[3];
                        st_bf4(p.xg() + (size_t)row * DM + c, v * *(const f32x4*)(p.ple_g + c));
                    }
                ss += __shfl_xor(ss, 16); ss += __shfl_xor(ss, 32);
                if (fq == 0) p.ss1()[(size_t)row * 16 + u.pn * 4 + wc] = ss;
            }
    }
};
struct EpiGate {
    static constexpr bool PERM = false, AFTER_DRAIN = false;
    P p;
    __device__ __forceinline__ void quad(int row, int c, f32x4 acc) const {
        const float rstd = rsqrtf(p.ss_s()[row - NP] * (1.0f / DM) + 1e-6f);
        const f32x4 a = acc * rstd;
        f32x4 g; for (int e = 0; e < 4; ++e) g[e] = sigmoidf_(a[e]);
        float* ppp = p.pp() + (size_t)row * DM + c;
        *(f32x4*)ppp = *(const f32x4*)(p.x1() + (size_t)row * DM + c) + g * *(const f32x4*)ppp;
    }
    __device__ __forceinline__ void operator()(const f32x4 (&acc)[2][2][4][2], const Unit& u, int wr, int wc, int fr, int fq) const {
#pragma unroll
        for (int ai = 0; ai < 2; ++ai)
#pragma unroll
            for (int m = 0; m < 4; ++m) {
                const int row = u.pm * 256 + ai * 128 + wr * 64 + m * 16 + fr;
                float ss = 0.f;
#pragma unroll
                for (int i = 0; i < 4; ++i) { const f32x4 t = *(const f32x4*)(p.ss1() + (size_t)row * 16 + i * 4); ss += (t[0] + t[1]) + (t[2] + t[3]); }
                const float rstd = rsqrtf(ss * (1.0f / DM) + 1e-6f);
#pragma unroll
                for (int bj = 0; bj < 2; ++bj)
#pragma unroll
                    for (int n = 0; n < 2; ++n) {
                        const int c = u.pn * 256 + bj * 128 + wc * 32 + fq * 8 + n * 4;
                        const f32x4 a = acc[ai][bj][m][n] * rstd;
                        f32x4 g; for (int e = 0; e < 4; ++e) g[e] = sigmoidf_(a[e]);
                        float* ppp = p.pp() + (size_t)row * DM + c;
                        *(f32x4*)ppp = *(const f32x4*)(p.x1() + (size_t)row * DM + c) + g * *(const f32x4*)ppp;
                    }
            }
    }
};

__device__ __forceinline__ void ph_final(const P& p) {
    const int tid = threadIdx.x, lane = tid & 63, wid = tid >> 6;
    for (int row = blockIdx.x * 8 + wid; row < MR; row += gridDim.x * 8) {
        const float4* src = (const float4*)(p.pp() + (size_t)row * DM);
        float4 v[4]; float ss = 0.f;
#pragma unroll
        for (int i = 0; i < 4; ++i) { v[i] = src[lane + 64 * i]; ss += v[i].x * v[i].x + v[i].y * v[i].y + v[i].z * v[i].z + v[i].w * v[i].w; }
        ss = wave_sum(ss);
        const float rstd = rsqrtf(ss * (1.0f / DM) + 1e-6f);
        float4* dst = (float4*)(p.out + (row < NP ? O_Y_P + (size_t)row * DM : O_Y_S + (size_t)(row - NP) * DM));
#pragma unroll
        for (int i = 0; i < 4; ++i) {
            const float4 g = ((const float4*)p.final_g)[lane + 64 * i];
            float4 o; o.x = v[i].x * rstd * g.x; o.y = v[i].y * rstd * g.y; o.z = v[i].z * rstd * g.z; o.w = v[i].w * rstd * g.w;
            dst[lane + 64 * i] = o;
        }
    }
}

typedef float f32x4v __attribute__((ext_vector_type(4)));
template <class Epi> __device__ __forceinline__ void small_gemm(const bf16_t* A, const bf16_t* Bt, int K, const Epi& E) {
    const int tid = threadIdx.x, lane = tid & 63, wid = tid >> 6, r16 = lane & 15, q4 = lane >> 4;
    for (int tile = blockIdx.x * 8 + wid; tile < 16 * 64; tile += gridDim.x * 8) {
        const int rt = tile & 15, ct = tile >> 4;
        const bf16_t* ap = A + (size_t)(NP + rt * 16 + r16) * K + 8 * q4;
        const bf16_t* bp = Bt + (size_t)(ct * 16 + r16) * K + 8 * q4;
        f32x4 acc = {0.f, 0.f, 0.f, 0.f};
#pragma unroll 1
        for (int k0 = 0; k0 < K; k0 += 256) {
            bf16x8 af[8], bf[8];
#pragma unroll
            for (int i = 0; i < 8; ++i) { af[i] = *(const bf16x8*)(ap + k0 + 32 * i); bf[i] = *(const bf16x8*)(bp + k0 + 32 * i); }
#pragma unroll
            for (int i = 0; i < 8; ++i) acc = __builtin_amdgcn_mfma_f32_16x16x32_bf16(bf[i], af[i], acc, 0, 0, 0);
        }
        E.quad(NP + rt * 16 + r16, (ct >> 1) * 32 + 8 * q4 + 4 * (ct & 1), acc);
    }
}

__device__ __forceinline__ f32x4 ld_bf4c(const bf16_t* q) { const uint2 w = *(const uint2*)q; f32x4 v; v[0] = __uint_as_float(w.x << 16); v[1] = __uint_as_float(w.x & 0xffff0000u); v[2] = __uint_as_float(w.y << 16); v[3] = __uint_as_float(w.y & 0xffff0000u); return v; }
__device__ __forceinline__ void compress2_tile(const P& p, const bf16_t* LH, int nbg, int nrows, int nblk, bf16_t* kc, bf16_t* vcT, int kvi, int bg, int tile, int lane, LAS unsigned char* wlds) {
    const int col = lane & 31, hb = lane >> 5;
    {
        const int i = tile * 32 + col;
        const bool live = i < nblk;
        const bf16_t* lbase = LH + ((size_t)kvi * nbg * nrows + (size_t)bg * nrows) * 256;
        const bf16_t* w2t = p.W2T() + (size_t)kvi * 64 * 128;
        LAS bf16_t* hs = (LAS bf16_t*)wlds;
        {
            const int rq = lane >> 4, c8 = lane & 15;
            const f32x4 pa = *(const f32x4*)(p.pt() + kvi * 128 + c8 * 8), pb = *(const f32x4*)(p.pt() + kvi * 128 + c8 * 8 + 4);
#pragma unroll
            for (int it = 0; it < 8; ++it) {
                const int rr = 4 * it + rq, gi = tile * 32 + rr;
                const bf16_t* rp = lbase + (size_t)(gi < nblk ? gi : 0) * 256 + c8 * 8;
                const uint4 lo = *(const uint4*)rp, hi = *(const uint4*)(rp + 256 + 128);
                float hv[8];
                const unsigned lw[4] = {lo.x, lo.y, lo.z, lo.w}, hw[4] = {hi.x, hi.y, hi.z, hi.w};
#pragma unroll
                for (int e = 0; e < 4; ++e) {
                    const float pe0 = e < 2 ? pa[2 * e] : pb[2 * e - 4], pe1 = e < 2 ? pa[2 * e + 1] : pb[2 * e - 3];
                    hv[2 * e] = siluf_(__uint_as_float(lw[e] << 16) + __uint_as_float(hw[e] << 16) + pe0);
                    hv[2 * e + 1] = siluf_(__uint_as_float(lw[e] & 0xffff0000u) + __uint_as_float(hw[e] & 0xffff0000u) + pe1);
                }
                *(LAS bf16x8*)(hs + rr * 136 + c8 * 8) = pack8(hv[0], hv[1], hv[2], hv[3], hv[4], hv[5], hv[6], hv[7]);
            }
        }
        WAVE_SYNC();
        f32x16 acc[2]; acc[0] = zero16(); acc[1] = zero16();
#pragma unroll
        for (int ks = 0; ks < 8; ++ks) {
            const int f = 16 * ks + 8 * hb;
            const bf16x8 hf = *(LAS const bf16x8*)(hs + col * 136 + f);
#pragma unroll
            for (int dt = 0; dt < 2; ++dt) {
                const bf16x8 wf = *(const bf16x8*)(w2t + (size_t)(32 * dt + col) * 128 + f);
                acc[dt] = (kvi == 0) ? mfma32(wf, hf, acc[dt]) : mfma32(hf, wf, acc[dt]);
            }
        }
        WAVE_SYNC();
        if (kvi == 0) {
            bf16_t* dst = kc + ((size_t)bg * nrows + i) * 64;
#pragma unroll
            for (int dt = 0; dt < 2; ++dt)
#pragma unroll
                for (int i4 = 0; i4 < 4; ++i4) {
                    const int d = 32 * dt + 8 * i4 + 4 * hb;
                    const f32x4 b2 = *(const f32x4*)(p.cmp_b2 + d);
                    f32x4 v; for (int e = 0; e < 4; ++e) v[e] = live ? acc[dt][4 * i4 + e] + b2[e] : 0.f;
                    st_bf4(dst + d, v);
                }
        } else {
#pragma unroll
            for (int dt = 0; dt < 2; ++dt) {
                const int d = 32 * dt + col;
                const float b2 = p.cmp_b2[64 + d];
                bf16_t* dst = vcT + ((size_t)bg * 64 + d) * nrows + tile * 32;
#pragma unroll
                for (int i4 = 0; i4 < 4; ++i4) {
                    const int r = 8 * i4 + 4 * hb;
                    f32x4 v; for (int e = 0; e < 4; ++e) v[e] = (tile * 32 + r + e) < nblk ? acc[dt][4 * i4 + e] + b2 : 0.f;
                    st_bf4(dst + r, v);
                }
            }
        }
    }
}

__device__ __forceinline__ void ph_compress2(const P& p, const bf16_t* LH, int nbg, int nrows, int nblk, bf16_t* kc, bf16_t* vcT, LAS unsigned char* lds) {
    const int tid = threadIdx.x, lane = tid & 63, wid = tid >> 6;
    const int ntile = nrows >> 5, total = 2 * nbg * ntile;
    for (int it = blockIdx.x * 8 + wid; it < total; it += gridDim.x * 8)
        compress2_tile(p, LH, nbg, nrows, nblk, kc, vcT, it / (ntile * nbg), (it / ntile) % nbg, it % ntile, lane, lds + wid * 8960);
}


__device__ __forceinline__ float dpp_row_sum16(float v) {
    v += __builtin_bit_cast(float, __builtin_amdgcn_mov_dpp(__builtin_bit_cast(int, v), 0xB1, 0xF, 0xF, true));
    v += __builtin_bit_cast(float, __builtin_amdgcn_mov_dpp(__builtin_bit_cast(int, v), 0x4E, 0xF, 0xF, true));
    v += __builtin_bit_cast(float, __builtin_amdgcn_mov_dpp(__builtin_bit_cast(int, v), 0x141, 0xF, 0xF, true));
    v += __builtin_bit_cast(float, __builtin_amdgcn_mov_dpp(__builtin_bit_cast(int, v), 0x140, 0xF, 0xF, true));
    return v;
}
__device__ __forceinline__ float tanh_fast(float x) { const float e = __expf(2.0f * x); return 1.0f - 2.0f / (e + 1.0f); }
__device__ __forceinline__ float half_sum32(float v) { return xsum16(dpp_row_sum16(v)); }
__device__ __forceinline__ const bf16_t* rwkv_prev_row(const P& p, int row) {
    if (row < NP) return (row & (SEQ - 1)) == 0 ? p.zs0() : p.rz() + (size_t)(row - 1) * CR;
    const int rs = row - NP;
    return (rs & 7) == 0 ? p.zs0() + (size_t)(1 + (rs >> 3)) * CR : p.rz() + (size_t)(row - 1) * CR;
}
__device__ __forceinline__ f32x4 ld_bf4(const bf16_t* q) { const uint2 w = *(const uint2*)q; f32x4 v; v[0] = __uint_as_float(w.x << 16); v[1] = __uint_as_float(w.x & 0xffff0000u); v[2] = __uint_as_float(w.y << 16); v[3] = __uint_as_float(w.y & 0xffff0000u); return v; }
__device__ __forceinline__ void ph_rwkv_prep(const P& p) {
    const int tid = threadIdx.x, lane = tid & 63, wid = tid >> 6, col = lane & 31, hb = lane >> 5;
    const int gw = blockIdx.x * 8 + wid, nw = gridDim.x * 8;
    for (int it = gw; it < NB + DB; it += nw) {
        const int row = it < NB ? it * SEQ + SEQ - 1 : NP + (it - NB) * 8 + 7;
        float* so = it < NB ? p.out + O_SH_P + (size_t)it * CR : p.out + O_SH_S + (size_t)(it - NB) * CR;
        const bf16_t* z = p.rz() + (size_t)row * CR;
        for (int i = lane; i < CR; i += 64) so[i] = bf2f(z[i]);
    }
    for (int rnd = 0; rnd < 3; ++rnd) {
        int it;
        if (rnd < 2) it = rnd * nw + gw; else { if (wid != 0 || (int)blockIdx.x >= 64) break; it = 2 * nw + (int)blockIdx.x; }
        if (it >= (MR / 32) * 8) break;
        const int h = it & 7, r0 = (it >> 3) * 32;
        bf16x8 Aw[4], Aa[4];
        {
            const int row = r0 + col;
            const bf16_t* z = p.rz() + (size_t)row * CR;
            const bf16_t* pv = rwkv_prev_row(p, row);
#pragma unroll
            for (int ks = 0; ks < 4; ++ks) {
                const int j0 = 16 * ks + 8 * hb;
                float tw[8], ta[8];
#pragma unroll
                for (int q = 0; q < 2; ++q) {
                    const f32x4 zw = ld_bf4(z + 1536 + j0 + 4 * q), za = ld_bf4(z + 1600 + j0 + 4 * q);
                    const f32x4 pw = ld_bf4(pv + 1536 + j0 + 4 * q), pa = ld_bf4(pv + 1600 + j0 + 4 * q);
                    const f32x4 mw = *(const f32x4*)(p.mu + 1536 + j0 + 4 * q), ma = *(const f32x4*)(p.mu + 1600 + j0 + 4 * q);
#pragma unroll
                    for (int e = 0; e < 4; ++e) { tw[4 * q + e] = tanh_fast(zw[e] + (pw[e] - zw[e]) * mw[e]); ta[4 * q + e] = za[e] + (pa[e] - za[e]) * ma[e]; }
                }
                Aw[ks] = pack8(tw[0], tw[1], tw[2], tw[3], tw[4], tw[5], tw[6], tw[7]);
                Aa[ks] = pack8(ta[0], ta[1], ta[2], ta[3], ta[4], ta[5], ta[6], ta[7]);
            }
        }
        f32x16 accw[2], acca[2];
#pragma unroll
        for (int ct = 0; ct < 2; ++ct) {
            accw[ct] = zero16(); acca[ct] = zero16();
            const size_t wo = (size_t)(h * 64 + 32 * ct + col) * 64 + 8 * hb;
#pragma unroll
            for (int ks = 0; ks < 4; ++ks) {
                accw[ct] = mfma32(Aw[ks], *(const bf16x8*)(p.WupT() + wo + 16 * ks), accw[ct]);
                acca[ct] = mfma32(Aa[ks], *(const bf16x8*)(p.AupT() + wo + 16 * ks), acca[ct]);
            }
        }
        float w0v[2], a0v[2], kkv[2], kav[2], rkv[2], mur[2], muk[2], muv[2];
#pragma unroll
        for (int ct = 0; ct < 2; ++ct) {
            const int c = h * 64 + 32 * ct + col;
            w0v[ct] = p.w0[c]; a0v[ct] = p.a0[c]; kkv[ct] = p.k_k[c]; kav[ct] = p.k_a[c]; rkv[ct] = p.r_k[c];
            mur[ct] = p.mu[c]; muk[ct] = p.mu[512 + c]; muv[ct] = p.mu[1024 + c];
        }
#pragma unroll
        for (int hf = 0; hf < 2; ++hf) {
        float zz[8][2][3], pz[2][2][3];
#pragma unroll
        for (int ii = 0; ii < 8; ++ii) {
            const int i = 8 * hf + ii;
            const bf16_t* z = p.rz() + (size_t)(r0 + (i & 3) + 8 * (i >> 2) + 4 * hb) * CR + h * 64 + col;
#pragma unroll
            for (int ct = 0; ct < 2; ++ct) { zz[ii][ct][0] = bf2f(z[32 * ct]); zz[ii][ct][1] = bf2f(z[512 + 32 * ct]); zz[ii][ct][2] = bf2f(z[1024 + 32 * ct]); }
        }
#pragma unroll
        for (int g2 = 0; g2 < 2; ++g2) {
            const bf16_t* pv = rwkv_prev_row(p, r0 + 8 * (2 * hf + g2) + 4 * hb) + h * 64 + col;
#pragma unroll
            for (int ct = 0; ct < 2; ++ct) { pz[g2][ct][0] = bf2f(pv[32 * ct]); pz[g2][ct][1] = bf2f(pv[512 + 32 * ct]); pz[g2][ct][2] = bf2f(pv[1024 + 32 * ct]); }
        }
#pragma unroll
        for (int ii = 0; ii < 8; ++ii) {
            const int i = 8 * hf + ii;
            const int row = r0 + (i & 3) + 8 * (i >> 2) + 4 * hb;
            float zr[2], zk[2], zv[2], dec[2], av[2], kkr[2], km[2];
            float n2 = 0.f, bon = 0.f;
#pragma unroll
            for (int ct = 0; ct < 2; ++ct) {
                const float z0 = zz[ii][ct][0], z1 = zz[ii][ct][1], z2 = zz[ii][ct][2];
                const int ip = ii > 0 ? ii - 1 : 0;
                const float p0 = (i & 3) ? zz[ip][ct][0] : pz[ii >> 2][ct][0], p1 = (i & 3) ? zz[ip][ct][1] : pz[ii >> 2][ct][1], p2 = (i & 3) ? zz[ip][ct][2] : pz[ii >> 2][ct][2];
                zr[ct] = z0 + (p0 - z0) * mur[ct]; zk[ct] = z1 + (p1 - z1) * muk[ct]; zv[ct] = z2 + (p2 - z2) * muv[ct];
                const float nx = -(w0v[ct] + accw[ct][i]);
                const float sp = fmaxf(nx, 0.f) + __logf(1.0f + __expf(-fabsf(nx)));
                dec[ct] = __expf(-__expf(-sp - 0.5f));
                av[ct] = sigmoidf_(a0v[ct] + acca[ct][i]);
                kkr[ct] = zk[ct] * kkv[ct];
                km[ct] = zk[ct] * (1.0f + (av[ct] - 1.0f) * kav[ct]);
                n2 += kkr[ct] * kkr[ct];
                bon += zr[ct] * km[ct] * rkv[ct];
            }
            n2 = half_sum32(n2); bon = half_sum32(bon);
            const float rn = 1.0f / fmaxf(sqrtf(n2), 1e-12f);
            unsigned char* o = p.rw6() + ((size_t)row * 8 + h) * RW6_STRIDE;
#pragma unroll
            for (int ct = 0; ct < 2; ++ct) {
                const float kk = kkr[ct] * rn;
                const int cl = 32 * ct + col;
                ((float*)o)[cl] = dec[ct];
                bf16_t* ob = (bf16_t*)(o + 256) + cl;
                ob[0] = f2bf(zr[ct]); ob[64] = f2bf(km[ct]); ob[128] = f2bf(zv[ct]); ob[192] = f2bf(kk); ob[256] = f2bf(kk * av[ct]);
            }
            if (col == 0) p.bonus()[(size_t)row * 8 + h] = bon;
        }
        }
    }
}

typedef float f32x2 __attribute__((ext_vector_type(2)));
__device__ __forceinline__ float dpp_row_sum(float v) {
    v += __builtin_bit_cast(float, __builtin_amdgcn_mov_dpp(__builtin_bit_cast(int, v), 0xB1, 0xF, 0xF, true));
    v += __builtin_bit_cast(float, __builtin_amdgcn_mov_dpp(__builtin_bit_cast(int, v), 0x4E, 0xF, 0xF, true));
    v += __builtin_bit_cast(float, __builtin_amdgcn_mov_dpp(__builtin_bit_cast(int, v), 0x141, 0xF, 0xF, true));
    v += __builtin_bit_cast(float, __builtin_amdgcn_mov_dpp(__builtin_bit_cast(int, v), 0x140, 0xF, 0xF, true));
    return v;
}
constexpr int SCAN_TC = 32;
template <int NROWS>
__device__ __forceinline__ void scan_item(const P& p, LAS float* lds, int row0, int T, int h, int half, const float* s0, float* sout) {
    const int tid = threadIdx.x, w = tid >> 6, lane = tid & 63, rl = lane >> 4, kq = lane & 15;
    const bool act = w * 4 < NROWS;
    const int vrow = half * NROWS + (act ? w * 4 : 0) + rl;
    f32x4 S;
    if (s0) S = *(const f32x4*)(s0 + vrow * 64 + kq * 4); else { S[0] = 0.f; S[1] = 0.f; S[2] = 0.f; S[3] = 0.f; }
    const unsigned char* src = p.rw6() + ((size_t)row0 * 8 + h) * RW6_STRIDE;
    const int nchunk = (T + SCAN_TC - 1) / SCAN_TC;
    u32x4_t stg[4];
    int ss[4], sc[4], sl[4];
#pragma unroll
    for (int i = 0; i < 4; ++i) {
        const int idx = i * 512 + tid; ss[i] = idx / 56; sc[i] = idx % 56;
        const int cb = sc[i] - 16, q = cb >> 3;
        sl[i] = sc[i] < 16 ? 64 + 4 * sc[i] : (q == 0 ? 0 : 64 + 64 * q) + 8 * (cb & 7);
    }
    auto put = [&](LAS float* b, int i) {
        LAS float* d = b + ss[i] * 384 + sl[i];
        if (sc[i] < 16) *(LAS u32x4_t*)d = stg[i];
        else {
            f32x4 lo, hi;
            lo[0] = __uint_as_float(stg[i][0] << 16); lo[1] = __uint_as_float(stg[i][0] & 0xffff0000u); lo[2] = __uint_as_float(stg[i][1] << 16); lo[3] = __uint_as_float(stg[i][1] & 0xffff0000u);
            hi[0] = __uint_as_float(stg[i][2] << 16); hi[1] = __uint_as_float(stg[i][2] & 0xffff0000u); hi[2] = __uint_as_float(stg[i][3] << 16); hi[3] = __uint_as_float(stg[i][3] & 0xffff0000u);
            *(LAS f32x4*)d = lo; *(LAS f32x4*)(d + 4) = hi;
        }
    };
    {
        const int ns = T < SCAN_TC ? T : SCAN_TC;
#pragma unroll
        for (int i = 0; i < 4; ++i) if (ss[i] < ns) { stg[i] = *(const u32x4_t*)(src + (size_t)ss[i] * (8 * RW6_STRIDE) + sc[i] * 16); put(lds, i); }
    }
    __syncthreads();
    for (int c = 0; c < nchunk; ++c) {
        const int t0 = c * SCAN_TC;
        const int ns = (T - t0) < SCAN_TC ? (T - t0) : SCAN_TC;
        const bool more = (c + 1) < nchunk;
        const int nns = more ? ((T - t0 - SCAN_TC) < SCAN_TC ? (T - t0 - SCAN_TC) : SCAN_TC) : 0;
        if (more) {
#pragma unroll
            for (int i = 0; i < 4; ++i) if (ss[i] < nns) stg[i] = *(const u32x4_t*)(src + (size_t)(t0 + SCAN_TC + ss[i]) * (8 * RW6_STRIDE) + sc[i] * 16);
        }
        LAS const float* buf = lds + (c & 1) * (SCAN_TC * 384);
        float* yo = p.ybuf() + (size_t)(row0 + t0) * 512 + h * 64 + vrow;
        if (act)
#pragma unroll 4
        for (int s = 0; s < ns; ++s) {
            LAS const float* bs = buf + s * 384 + kq * 4;
            const f32x4 r = *(LAS const f32x4*)(bs), d = *(LAS const f32x4*)(bs + 64), km = *(LAS const f32x4*)(bs + 128),
                        kk = *(LAS const f32x4*)(bs + 256), ka = *(LAS const f32x4*)(bs + 320);
            const float vv = buf[s * 384 + 192 + vrow];
            const f32x4 t1 = S * kk;
            float sa = dpp_row_sum((t1[0] + t1[1]) + (t1[2] + t1[3]));
            sa = -sa;
            S = S * d + ka * sa + km * vv;
            const f32x4 t2 = S * r;
            const float y = dpp_row_sum((t2[0] + t2[1]) + (t2[2] + t2[3]));
            if (kq == 0) yo[(size_t)s * 512] = y;
        }
        if (more) {
            LAS float* nb = lds + ((c + 1) & 1) * (SCAN_TC * 384);
#pragma unroll
            for (int i = 0; i < 4; ++i) if (ss[i] < nns) put(nb, i);
        }
        __syncthreads();
    }
    if (act) *(f32x4*)(sout + vrow * 64 + kq * 4) = S;
}
struct ScanVec { f32x4 r, d, km, kk, ka; float vv; };
__device__ __forceinline__ void scan_ld(ScanVec& v, LAS const float* bs, LAS const float* bv) {
    v.kk = *(LAS const f32x4*)(bs + 256); v.d = *(LAS const f32x4*)(bs + 64); v.ka = *(LAS const f32x4*)(bs + 320);
    v.km = *(LAS const f32x4*)(bs + 128); v.vv = *bv; v.r = *(LAS const f32x4*)(bs);
}
__device__ __forceinline__ float scan_step(f32x4& S, const ScanVec& v) {
    const f32x4 t1 = S * v.kk;
    const float sa = -dpp_row_sum((t1[0] + t1[2]) + (t1[1] + t1[3]));
    S = S * v.d + v.ka * sa + v.km * v.vv;
    const f32x4 t2 = S * v.r;
    return dpp_row_sum((t2[0] + t2[2]) + (t2[1] + t2[3]));
}
__device__ __forceinline__ void scan_prompt(const P& p, LAS float* lds, int row0, int h, int part, float* sout) {
    const int tid = threadIdx.x, w = tid >> 6, lane = tid & 63, rl = lane >> 4, kq = lane & 15;
    const bool act = w < 4;
    const int vrow = part * 16 + (act ? w * 4 : 0) + rl;
    f32x4 S;
    S[0] = 0.f; S[1] = 0.f; S[2] = 0.f; S[3] = 0.f;
    const unsigned char* src = p.rw6() + ((size_t)row0 * 8 + h) * RW6_STRIDE;
    constexpr int nchunk = SEQ / SCAN_TC;
    u32x4_t stg[4];
    int ss[4], sc[4], sl[4];
#pragma unroll
    for (int i = 0; i < 4; ++i) {
        const int idx = i * 512 + tid; ss[i] = idx / 56; sc[i] = idx % 56;
        const int cb = sc[i] - 16, q = cb >> 3;
        sl[i] = sc[i] < 16 ? 64 + 4 * sc[i] : (q == 0 ? 0 : 64 + 64 * q) + 8 * (cb & 7);
    }
    auto put = [&](LAS float* b, int i) {
        LAS float* d = b + ss[i] * 384 + sl[i];
        if (sc[i] < 16) *(LAS u32x4_t*)d = stg[i];
        else {
            f32x4 lo, hi;
            lo[0] = __uint_as_float(stg[i][0] << 16); lo[1] = __uint_as_float(stg[i][0] & 0xffff0000u); lo[2] = __uint_as_float(stg[i][1] << 16); lo[3] = __uint_as_float(stg[i][1] & 0xffff0000u);
            hi[0] = __uint_as_float(stg[i][2] << 16); hi[1] = __uint_as_float(stg[i][2] & 0xffff0000u); hi[2] = __uint_as_float(stg[i][3] << 16); hi[3] = __uint_as_float(stg[i][3] & 0xffff0000u);
            *(LAS f32x4*)d = lo; *(LAS f32x4*)(d + 4) = hi;
        }
    };
#pragma unroll
    for (int i = 0; i < 4; ++i) if (ss[i] < SCAN_TC) { stg[i] = *(const u32x4_t*)(src + (size_t)ss[i] * (8 * RW6_STRIDE) + sc[i] * 16); put(lds, i); }
    __syncthreads();
#pragma unroll 1
    for (int c = 0; c < nchunk; ++c) {
        const int t0 = c * SCAN_TC;
        const bool more = (c + 1) < nchunk;
        if (more) {
#pragma unroll
            for (int i = 0; i < 4; ++i) if (ss[i] < SCAN_TC) stg[i] = *(const u32x4_t*)(src + (size_t)(t0 + SCAN_TC + ss[i]) * (8 * RW6_STRIDE) + sc[i] * 16);
        }
        LAS const float* buf = lds + (c & 1) * (SCAN_TC * 384);
        if (act) {
            LAS const float* bk = buf + kq * 4;
            LAS const float* bv = buf + 192 + vrow;
            float* yo = p.ybuf() + (size_t)(row0 + t0 + kq) * 512 + h * 64 + vrow;
            ScanVec A, B;
            scan_ld(A, bk, bv);
            float ysel = 0.f;
#pragma unroll
            for (int s = 0; s < SCAN_TC; s += 2) {
                scan_ld(B, bk + (s + 1) * 384, bv + (s + 1) * 384);
                __builtin_amdgcn_sched_barrier(0);
                { const float y = scan_step(S, A); ysel = (kq == (s & 15)) ? y : ysel; }
                if (s + 2 < SCAN_TC) scan_ld(A, bk + (s + 2) * 384, bv + (s + 2) * 384);
                __builtin_amdgcn_sched_barrier(0);
                { const float y = scan_step(S, B); ysel = (kq == ((s + 1) & 15)) ? y : ysel; }
                if (((s + 1) & 15) == 15) yo[(size_t)(s >> 4) * 16 * 512] = ysel;
            }
        }
        if (more) {
            LAS float* nb = lds + ((c + 1) & 1) * (SCAN_TC * 384);
#pragma unroll
            for (int i = 0; i < 4; ++i) if (ss[i] < SCAN_TC) put(nb, i);
        }
        __syncthreads();
    }
    if (act) *(f32x4*)(sout + vrow * 64 + kq * 4) = S;
}
constexpr int NSCAN = 128;
__device__ __forceinline__ void ph_rwkv_scan(const P& p, LAS float* lds) {
    if ((int)blockIdx.x < NSCAN) {
        const int item = blockIdx.x >> 2, part = blockIdx.x & 3;
        scan_prompt(p, lds, (item >> 3) * SEQ, item & 7, part, p.out + O_WKV_P + (size_t)item * 4096);
    } else {
        const int nb = (int)gridDim.x - NSCAN;
        for (int hi = (int)blockIdx.x - NSCAN; hi < 512; hi += nb) {
            const int item = hi >> 1, half = hi & 1;
            scan_item<32>(p, lds, NP + (item >> 3) * 8, 8, item & 7, half, p.state_wkv + (size_t)item * 4096, p.out + O_WKV_S + (size_t)item * 4096);
        }
    }
}

__device__ __forceinline__ void ph_rwkv_post(const P& p) {
    const int tid = threadIdx.x, lane = tid & 63, wid = tid >> 6;
    for (int it = blockIdx.x * 8 + wid; it < MR * 8; it += gridDim.x * 8) {
        const int row = it >> 3, h = it & 7, c = h * 64 + lane;
        const float y = p.ybuf()[(size_t)row * 512 + c];
        const float s1 = wave_sum(y), s2 = wave_sum(y * y);
        const float mean = s1 * (1.0f / 64.0f);
        const float var = fmaxf(s2 * (1.0f / 64.0f) - mean * mean, 0.f);
        const float dv = y - mean;
        float yn = dv * rsqrtf(var + 64e-5f) * p.gn_g[c] + p.gn_b[c];
        yn += p.bonus()[it] * bf2f(((const bf16_t*)(p.rw6() + (size_t)it * RW6_STRIDE + 256))[128 + lane]);
        p.ob()[(size_t)row * 512 + c] = f2bf(yn * bf2f(p.rg()[(size_t)row * 512 + c]));
    }
}

__device__ __forceinline__ void ph_cmp_gemm_f32(const P& p, LAS unsigned char* lds) {
    using pg8::lds_byte;
    const int tid = threadIdx.x, wid = __builtin_amdgcn_readfirstlane(tid >> 6), lane = tid & 63, wr = wid >> 2, wc = wid & 3, fr = lane & 15, fq = lane >> 4;
    constexpr int HTB = 16384;
    const int arow_l = 4 * wid + (lane >> 4), acol = 4 * (lane & 15);
    const int swbase = lds_byte(arow_l, acol);
    LAS unsigned long long* rowoff = (LAS unsigned long long*)(lds + 131072);
    unsigned voffB[2];
#pragma unroll
    for (int i = 0; i < 2; ++i) { int R, C; pg8::stage_rc(tid * 16 + i * 8192, R, C); voffB[i] = (unsigned)(R * 1024 + C) * 2u; }
    const unsigned ldsw = (unsigned)wid * 1024u;
    const int aoff = lds_byte(wr * 64 + fr, fq * 8), boff = lds_byte(wc * 32 + fr, fq * 8);
    for (int unit = blockIdx.x; unit < 512; unit += gridDim.x) {
        const int kvi = unit >> 8, bg = (unit >> 2) & 63, c0 = (unit & 3) * 256, b = bg >> 1, g = bg & 1;
        __syncthreads();
        if (tid < 256) {
            const int chunk = c0 + tid;
            const int page = p.page_table[b * 128 + (chunk >> 3)];
            rowoff[tid] = ((unsigned long long)page * 128 + (chunk & 7) * 16) * 256 + kvi * 128 + g * 64;
        }
        const char* bbase = (const char*)(p.W1T() + (size_t)kvi * 256 * 1024);
        f32x4 acc[2][2][4][2];
#pragma unroll
        for (int a = 0; a < 2; ++a)
#pragma unroll
            for (int bb = 0; bb < 2; ++bb)
#pragma unroll
                for (int m = 0; m < 4; ++m)
#pragma unroll
                    for (int n = 0; n < 2; ++n) acc[a][bb][m][n] = (f32x4){0.f, 0.f, 0.f, 0.f};
        f32x4 ar[8];
        auto stage_b = [&](int st, int t) {
#pragma unroll
            for (int h = 0; h < 2; ++h)
#pragma unroll
                for (int i = 0; i < 2; ++i)
                    __builtin_amdgcn_global_load_lds((const unsigned*)(bbase + (size_t)h * 128 * 2048 + (size_t)t * 128 + voffB[i]),
                                                     (PG8_LAS unsigned*)(lds + st * 65536 + 32768 + h * HTB + ldsw + i * 8192), 16, 0, 0);
        };
        auto load_a = [&](int t) {
#pragma unroll
            for (int q = 0; q < 8; ++q) ar[q] = *(const f32x4*)(p.cache_cmp + rowoff[32 * q + arow_l] + (size_t)t * 256 + acol);
        };
        auto write_a = [&](int st) {
            LAS unsigned char* na = lds + st * 65536;
#pragma unroll
            for (int q = 0; q < 8; ++q) *(LAS u32x2*)(na + swbase + (q >> 2) * HTB + (q & 3) * 4096) = (u32x2){pk2(ar[q][0], ar[q][1]), pk2(ar[q][2], ar[q][3])};
        };
        __syncthreads();
        load_a(0);
        stage_b(0, 0);
        write_a(0);
        __syncthreads();
#pragma unroll 1
        for (int t = 0; t < 16; ++t) {
            const int cur = t & 1;
            if (t + 1 < 16) { load_a(t + 1); stage_b(cur ^ 1, t + 1); }
            LAS const unsigned char* sa = lds + cur * 65536;
            LAS const unsigned char* sb = sa + 32768;
#pragma unroll
            for (int ai = 0; ai < 2; ++ai)
#pragma unroll
                for (int bj = 0; bj < 2; ++bj) {
                    bf16x8 Bt[2][2];
#pragma unroll
                    for (int n = 0; n < 2; ++n)
#pragma unroll
                        for (int k = 0; k < 2; ++k) Bt[n][k] = *(LAS const bf16x8*)(sb + bj * HTB + boff + n * 2048 + k * 1024);
#pragma unroll
                    for (int m = 0; m < 4; ++m) {
                        const bf16x8 a0 = *(LAS const bf16x8*)(sa + ai * HTB + aoff + m * 2048), a1 = *(LAS const bf16x8*)(sa + ai * HTB + aoff + m * 2048 + 1024);
#pragma unroll
                        for (int n = 0; n < 2; ++n) {
                            acc[ai][bj][m][n] = __builtin_amdgcn_mfma_f32_16x16x32_bf16(Bt[n][0], a0, acc[ai][bj][m][n], 0, 0, 0);
                            acc[ai][bj][m][n] = __builtin_amdgcn_mfma_f32_16x16x32_bf16(Bt[n][1], a1, acc[ai][bj][m][n], 0, 0, 0);
                        }
                    }
                    __builtin_amdgcn_sched_barrier(0);
                }
            if (t + 1 < 16) write_a(cur ^ 1);
            __syncthreads();
        }
        EpiPlainBf e; e.C = p.LHs() + ((size_t)kvi * 65536 + (size_t)bg * 1024 + c0) * 256; e.ldc = 256; e.pad_ = 0;
        pg8::Unit u; u.pm = 0; u.pn = 0;
        e(acc, u, wr, wc, fr, fq);
    }
}

__device__ __forceinline__ float exp2_(float x) { return __builtin_amdgcn_exp2f(x); }
template <class OKF>
__device__ __forceinline__ void sm_stats(const f32x16& s, int hb, OKF ok, float& m, float& l) {
    float sv[16]; float tmax = -1e30f; unsigned okm = 0;
#pragma unroll
    for (int i = 0; i < 16; ++i) { const int kl = (i & 3) + 8 * (i >> 2) + 4 * hb; const bool k = ok(kl); okm |= (k ? 1u : 0u) << i; sv[i] = k ? s[i] : -1e30f; tmax = fmaxf(tmax, sv[i]); }
    tmax = fmaxf(tmax, __shfl_xor(tmax, 32));
    const float mn = fmaxf(m, tmax), alpha = exp2_(m - mn); m = mn;
    float ps = 0.f;
#pragma unroll
    for (int i = 0; i < 16; ++i) ps += ((okm >> i) & 1u) ? exp2_(sv[i] - mn) : 0.f;
    l = l * alpha + ps;
}
template <class OKF, class VF>
__device__ __forceinline__ void sm_pv(const f32x16& s, int hb, OKF ok, VF vf, float& m, float& l, f32x16 (&o)[2]) {
    float sv[16]; float tmax = -1e30f; unsigned okm = 0;
#pragma unroll
    for (int i = 0; i < 16; ++i) { const int kl = (i & 3) + 8 * (i >> 2) + 4 * hb; const bool k = ok(kl); okm |= (k ? 1u : 0u) << i; sv[i] = k ? s[i] : -1e30f; tmax = fmaxf(tmax, sv[i]); }
    tmax = fmaxf(tmax, __shfl_xor(tmax, 32));
    const float mn = fmaxf(m, tmax), alpha = exp2_(m - mn); m = mn;
    float pr[16]; float ps = 0.f;
#pragma unroll
    for (int i = 0; i < 16; ++i) { pr[i] = ((okm >> i) & 1u) ? exp2_(sv[i] - mn) : 0.f; ps += pr[i]; }
    l = l * alpha + ps;
    o[0] *= alpha; o[1] *= alpha;
#pragma unroll
    for (int s2 = 0; s2 < 2; ++s2) {
        const bf16x8 pb = pack8(pr[8 * s2 + 0], pr[8 * s2 + 1], pr[8 * s2 + 2], pr[8 * s2 + 3], pr[8 * s2 + 4], pr[8 * s2 + 5], pr[8 * s2 + 6], pr[8 * s2 + 7]);
#pragma unroll
        for (int dt = 0; dt < 2; ++dt) o[dt] = mfma32(vf(dt, s2), pb, o[dt]);
    }
}
template <class VF>
__device__ __forceinline__ void sm_pv_nomask(const f32x16& s, bool csel, VF vf, float& m, float& l, f32x16 (&o)[2]) {
    float tmax = fmaxf(fmaxf(s[0], s[1]), s[2]);
#pragma unroll
    for (int i = 3; i < 16; ++i) tmax = fmaxf(tmax, s[i]);
    tmax = csel ? tmax : -1e30f;
    tmax = fmaxf(tmax, __shfl_xor(tmax, 32));
    const float mn = fmaxf(m, tmax), alpha = exp2_(m - mn); m = mn;
    float pr[16]; float ps = 0.f;
#pragma unroll
    for (int i = 0; i < 16; ++i) { pr[i] = csel ? exp2_(s[i] - mn) : 0.f; ps += pr[i]; }
    l = l * alpha + ps;
    o[0] *= alpha; o[1] *= alpha;
#pragma unroll
    for (int s2 = 0; s2 < 2; ++s2) {
        const bf16x8 pb = pack8(pr[8 * s2 + 0], pr[8 * s2 + 1], pr[8 * s2 + 2], pr[8 * s2 + 3], pr[8 * s2 + 4], pr[8 * s2 + 5], pr[8 * s2 + 6], pr[8 * s2 + 7]);
#pragma unroll
        for (int dt = 0; dt < 2; ++dt) o[dt] = mfma32(vf(dt, s2), pb, o[dt]);
    }
}
template <class OKF, class VF>
__device__ __forceinline__ void cmp_pass2(const f32x16& s, int hb, OKF ok, VF vf, float m, float inv, f32x16 (&o)[2], LAS float* prow, bool writer) {
    float pr[16];
#pragma unroll
    for (int i = 0; i < 16; ++i) {
        const int kl = (i & 3) + 8 * (i >> 2) + 4 * hb;
        pr[i] = ok(kl) ? exp2_(s[i] - m) * inv : 0.f;
        float q = pr[i] + __shfl_xor(pr[i], 1); q += __shfl_xor(q, 2);
        if (writer) prow[kl] = q;
    }
#pragma unroll
    for (int s2 = 0; s2 < 2; ++s2) {
        const bf16x8 pb = pack8(pr[8 * s2 + 0], pr[8 * s2 + 1], pr[8 * s2 + 2], pr[8 * s2 + 3], pr[8 * s2 + 4], pr[8 * s2 + 5], pr[8 * s2 + 6], pr[8 * s2 + 7]);
#pragma unroll
        for (int dt = 0; dt < 2; ++dt) o[dt] = mfma32(vf(dt, s2), pb, o[dt]);
    }
}

__device__ __forceinline__ void attn_store(const P& p, const f32x16 (&of)[2], int qrow, int head, int hb, bool doit, bf16_t* oadst = nullptr) {
    if (!oadst) oadst = p.oa();
    if (!doit) return;
#pragma unroll
    for (int dt = 0; dt < 2; ++dt)
#pragma unroll
        for (int i4 = 0; i4 < 4; ++i4) {
            const int d = 32 * dt + 8 * i4 + 4 * hb;
            const size_t off = (size_t)qrow * 512 + head * 64 + d;
            const uint2 gw = *(const uint2*)(p.ag() + off);
            f32x4 v;
            v[0] = of[dt][4 * i4 + 0] * __uint_as_float(gw.x << 16); v[1] = of[dt][4 * i4 + 1] * __uint_as_float(gw.x & 0xffff0000u);
            v[2] = of[dt][4 * i4 + 2] * __uint_as_float(gw.y << 16); v[3] = of[dt][4 * i4 + 3] * __uint_as_float(gw.y & 0xffff0000u);
            st_bf4(oadst + off, v);
        }
}


__device__ __forceinline__ void of_put(LAS float* st, int lane, const f32x16 (&o)[2], float sc) {
#pragma unroll
    for (int dt = 0; dt < 2; ++dt)
#pragma unroll
        for (int i = 0; i < 16; ++i) st[(dt * 16 + i) * 64 + lane] = o[dt][i] * sc;
}
__device__ __forceinline__ void of_add(LAS float* st, int lane, const f32x16 (&o)[2], float sc) {
#pragma unroll
    for (int dt = 0; dt < 2; ++dt)
#pragma unroll
        for (int i = 0; i < 16; ++i) st[(dt * 16 + i) * 64 + lane] += o[dt][i] * sc;
}
__device__ __forceinline__ void of_get_add(LAS float* st, int lane, const f32x16 (&o)[2], float sc, f32x16 (&of)[2]) {
#pragma unroll
    for (int dt = 0; dt < 2; ++dt)
#pragma unroll
        for (int i = 0; i < 16; ++i) of[dt][i] = st[(dt * 16 + i) * 64 + lane] + o[dt][i] * sc;
}


constexpr int WL_STRIDE = 15360, KV_OFF = 8 * WL_STRIDE, KV_BUF = 17920, XB_OFF = KV_OFF + 2 * KV_BUF;

struct LoadBf16 {
    const bf16_t* kbase; const bf16_t* vbase; int ld; bool with_v; u32x4_t kr[2], vr[2];
    static constexpr int DEPTH = 2;
    __device__ __forceinline__ void load(int n, int slot) {
        const int tid = threadIdx.x, srow = tid >> 3, sch = tid & 7;
        const u32x4_t k = *(const u32x4_t*)(kbase + (size_t)(64 * n + srow) * 64 + sch * 8);
        u32x4_t v = k;
        if (with_v) v = *(const u32x4_t*)(vbase + (size_t)srow * ld + 64 * n + sch * 8);
        if (slot) { kr[1] = k; vr[1] = v; } else { kr[0] = k; vr[0] = v; }
    }
    __device__ __forceinline__ void store(LAS unsigned char* buf, int slot) const {
        const int tid = threadIdx.x, srow = tid >> 3, sch = tid & 7;
        const u32x4_t k = slot ? kr[1] : kr[0], v = slot ? vr[1] : vr[0];
        *(LAS u32x4_t*)(buf + srow * 144 + sch * 16) = k;
        if (with_v) { LAS u32x2* vp = (LAS u32x2*)(buf + 9216 + srow * 136 + sch * 16); vp[0] = (u32x2){v[0], v[1]}; vp[1] = (u32x2){v[2], v[3]}; }
    }
};
struct LoadWinF32 {
    const float* cw; const float* nw; f32x4 k0, k1, v0, v1;
    static constexpr int DEPTH = 1;
    __device__ __forceinline__ void load(int n, int) {
        const int tid = threadIdx.x, srow = tid >> 3, sch = tid & 7;
        const int j = 64 * n + srow;
        const float* r = j < 512 ? cw + (size_t)j * 256 : nw + (size_t)(j - 512 < 8 ? j - 512 : 7) * 256;
        k0 = *(const f32x4*)(r + sch * 8); k1 = *(const f32x4*)(r + sch * 8 + 4);
        v0 = *(const f32x4*)(r + 128 + sch * 8); v1 = *(const f32x4*)(r + 128 + sch * 8 + 4);
    }
    __device__ __forceinline__ void store(LAS unsigned char* buf, int) const {
        const int tid = threadIdx.x, srow = tid >> 3, sch = tid & 7;
        u32x4_t kw; kw[0] = pk2(k0[0], k0[1]); kw[1] = pk2(k0[2], k0[3]); kw[2] = pk2(k1[0], k1[1]); kw[3] = pk2(k1[2], k1[3]);
        *(LAS u32x4_t*)(buf + srow * 144 + sch * 16) = kw;
        LAS bf16_t* vb = (LAS bf16_t*)(buf + 9216) + (sch * 8) * 68 + srow;
#pragma unroll
        for (int e = 0; e < 4; ++e) { vb[e * 68] = f2bf(v0[e]); vb[(4 + e) * 68] = f2bf(v1[e]); }
    }
};

template <class LOADER, class NEXT, class ACTIVE, class BODY>
__device__ __forceinline__ void block_loop_g(LOADER ld, LAS unsigned char* kv, int first, NEXT next, ACTIVE active, BODY body) {
    if (first < 0) return;
    int n = first, cur = 0;
    if (LOADER::DEPTH == 2) {
        int nn = next(n), k = 0;
        ld.load(n, 0); ld.store(kv, 0);
        if (nn >= 0) ld.load(nn, 1);
        __syncthreads();
#pragma unroll 1
        for (;;) {
            const int nnn = nn >= 0 ? next(nn) : -1;
            if (nnn >= 0) ld.load(nnn, k & 1);
            if (active(n)) body(n, (LAS const bf16_t*)(kv + cur * KV_BUF), (LAS const bf16_t*)(kv + cur * KV_BUF + 9216));
            if (nn >= 0) ld.store(kv + (cur ^ 1) * KV_BUF, (k + 1) & 1);
            __syncthreads();
            if (nn < 0) break;
            cur ^= 1; n = nn; nn = nnn; ++k;
        }
    } else {
        ld.load(n, 0);
        ld.store(kv, 0);
        __syncthreads();
#pragma unroll 1
        for (;;) {
            const int nn = next(n);
            if (nn >= 0) ld.load(nn, 0);
            if (active(n)) body(n, (LAS const bf16_t*)(kv + cur * KV_BUF), (LAS const bf16_t*)(kv + cur * KV_BUF + 9216));
            if (nn >= 0) ld.store(kv + (cur ^ 1) * KV_BUF, 0);
            __syncthreads();
            if (nn < 0) break;
            cur ^= 1; n = nn;
        }
    }
}
template <bool WITH_V, class NEXT, class ACTIVE, class BODY>
__device__ __forceinline__ void block_loop(const bf16_t* kbase, const bf16_t* vbase, int ld, LAS unsigned char* kv, int first, NEXT next, ACTIVE active, BODY body) {
    LoadBf16 L; L.kbase = kbase; L.vbase = vbase; L.ld = ld; L.with_v = WITH_V;
    block_loop_g(L, kv, first, next, active, body);
}
__device__ __forceinline__ bf16x8 lds_kfrag(LAS const bf16_t* kb, int kt, int ks, int col, int hb) { return *(LAS const bf16x8*)(kb + (32 * kt + col) * 72 + 16 * ks + 8 * hb); }
__device__ __forceinline__ bf16x8 lds_vfrag(LAS const bf16_t* vb, int kt, int dt, int s2, int col, int hb) {
    LAS const bf16_t* ptr = vb + (32 * dt + col) * 68 + 32 * kt + 16 * s2 + 4 * hb;
    union { u32x4_t u; bf16x8 v; } x; const u32x2 a = *(LAS const u32x2*)ptr, c = *(LAS const u32x2*)(ptr + 8); x.u[0] = a[0]; x.u[1] = a[1]; x.u[2] = c[0]; x.u[3] = c[1]; return x.v;
}
__device__ __forceinline__ f32x16 lds_qk(const bf16x8 (&qf)[4], LAS const bf16_t* kb, int kt, int col, int hb) {
    f32x16 s = zero16();
#pragma unroll
    for (int ks = 0; ks < 4; ++ks) s = mfma32(lds_kfrag(kb, kt, ks, col, hb), qf[ks], s);
    return s;
}

__device__ __forceinline__ void attn_prompt_block(const P& p, int bg, int j, LAS unsigned char* lds) {
    int tid_l = threadIdx.x; asm volatile("" : "+v"(tid_l));
    const int tid = tid_l, lane = tid & 63, wid = __builtin_amdgcn_readfirstlane(tid >> 6);
    const int b = bg >> 1, g = bg & 1;
    const int col = lane & 31, hb = lane >> 5, tl = col >> 2, hh = col & 3;
    const int t0 = 64 * j + 8 * wid, qpos = t0 + tl, qrow = b * SEQ + qpos, head = g * 4 + hh;
    LAS unsigned char* wl = lds + wid * WL_STRIDE;
    LAS unsigned char* kv = lds + KV_OFF;
    LAS float* psum = (LAS float*)wl;
    LAS unsigned long long* msk = (LAS unsigned long long*)(wl + 8192);
    bf16x8 qf[4];
#pragma unroll
    for (int ks = 0; ks < 4; ++ks) qf[ks] = *(const bf16x8*)(p.qb() + (size_t)qrow * 512 + head * 64 + 16 * ks + 8 * hb);
    const float g0 = p.gates()[(size_t)qrow * 32 + head * 3 + 0], g1 = p.gates()[(size_t)qrow * 32 + head * 3 + 1], g2 = p.gates()[(size_t)qrow * 32 + head * 3 + 2];
    f32x16 oc[2]; oc[0] = zero16(); oc[1] = zero16();
    {
        const int cmb = 64 * j + 63 - 31;
        const int nbc = ((cmb >> 4) >> 6) + 1;
        const int cmw = t0 + 7 - 31;
        const int cmaxw = cmw >= 0 ? (cmw >> 4) : -1;
        const bf16_t* kc = p.kc_p() + (size_t)bg * 256 * 64;
        const bf16_t* vc = p.vcT_p() + (size_t)bg * 64 * 256;
        float m = -1e30f, l = 0.f;
        block_loop<false>(kc, vc, 256, kv, 0, [&](int n) { return n + 1 < nbc ? n + 1 : -1; }, [&](int n) { return cmaxw >= 64 * n; },
            [&](int n, LAS const bf16_t* kb, LAS const bf16_t* vb) {
#pragma unroll 1
                for (int kt = 0; kt < 2; ++kt) {
                    const f32x16 s = lds_qk(qf, kb, kt, col, hb);
                    sm_stats(s, hb, [&](int kl) { return 16 * (64 * n + 32 * kt + kl) + 31 <= qpos; }, m, l);
                }
            });
        l += __shfl_xor(l, 32);
        const float inv = l > 0.f ? 1.0f / l : 0.f;
#pragma unroll
        for (int i = 0; i < 32; ++i) psum[i * 64 + lane] = 0.f;
        WAVE_SYNC();
        block_loop<true>(kc, vc, 256, kv, 0, [&](int n) { return n + 1 < nbc ? n + 1 : -1; }, [&](int n) { return cmaxw >= 64 * n; },
            [&](int n, LAS const bf16_t* kb, LAS const bf16_t* vb) {
#pragma unroll 1
                for (int kt = 0; kt < 2; ++kt) {
                    const f32x16 s = lds_qk(qf, kb, kt, col, hb);
                    cmp_pass2(s, hb, [&](int kl) { return 16 * (64 * n + 32 * kt + kl) + 31 <= qpos; }, [&](int dt, int s2) { return lds_vfrag(vb, kt, dt, s2, col, hb); }, m, inv, oc,
                              psum + tl * 256 + 64 * n + 32 * kt, hh == 0);
                }
            });
    }
    WAVE_SYNC();
    unsigned long long umw = 0;
    for (int t2 = 0; t2 < 8; ++t2) {
        const int t = t0 + t2, cur = t >> 6, n = lane;
        float imp = 0.f;
#pragma unroll
        for (int c = -1; c < 4; ++c) { const int cc = 4 * n + c; if (cc >= 0) imp += psum[t2 * 256 + cc]; }
        if (n == 0 || n == cur || n == cur - 1) imp = 1e4f;
        if (n * 64 > t) imp = -1.0f;
        int rank = 0;
#pragma unroll
        for (int jj = 0; jj < 64; ++jj) {
            const float vj = __uint_as_float(__builtin_amdgcn_readlane(__float_as_uint(imp), jj));
            rank += (vj > imp || (vj == imp && jj < n)) ? 1 : 0;
        }
        const unsigned long long mk = __ballot(rank < 16);
        if (lane == 0) msk[t2] = mk;
        umw |= mk;
    }
    if (lane == 0) msk[8] = umw;
    __syncthreads();
    const unsigned long long mymask = msk[tl];
    unsigned long long umb = 0;
#pragma unroll
    for (int w2 = 0; w2 < 8; ++w2) umb |= *(LAS const unsigned long long*)(lds + w2 * WL_STRIDE + 8192 + 64);
    {
        const unsigned lo = __builtin_amdgcn_readfirstlane((unsigned)umb), hi = __builtin_amdgcn_readfirstlane((unsigned)(umb >> 32));
        umb = ((unsigned long long)hi << 32) | lo;
        if (j < 63) umb &= (2ull << j) - 1ull;
    }
    LAS float* ost = (LAS float*)wl;
    of_put(ost, lane, oc, g0);
    {
        const bf16_t* kbs = p.kb() + (size_t)((1 * NB + b) * 2 + g) * SEQ * 64;
        const bf16_t* vbs = p.vT() + (size_t)((0 * NB + b) * 2 + g) * 64 * SEQ;
        float m = -1e30f, l = 0.f; f32x16 o[2]; o[0] = zero16(); o[1] = zero16();
        block_loop<true>(kbs, vbs, SEQ, kv, umb ? (int)__builtin_ctzll(umb) : -1,
            [&](int n) { if (n >= 63) return -1; const unsigned long long rem = umb >> (n + 1); return rem ? n + 1 + (int)__builtin_ctzll(rem) : -1; },
            [&](int n) { return (bool)((umw >> n) & 1ull); },
            [&](int n, LAS const bf16_t* kb, LAS const bf16_t* vb) {
                const bool bsel = (mymask >> n) & 1ull;
#pragma unroll
                for (int kt = 0; kt < 2; ++kt) {
                    const int tok0 = 64 * n + 32 * kt;
                    const f32x16 s = lds_qk(qf, kb, kt, col, hb);
                    if (n < j) sm_pv_nomask(s, bsel, [&](int dt, int s2) { return lds_vfrag(vb, kt, dt, s2, col, hb); }, m, l, o);
                    else sm_pv(s, hb, [&](int kl) { return bsel && (tok0 + kl <= qpos); }, [&](int dt, int s2) { return lds_vfrag(vb, kt, dt, s2, col, hb); }, m, l, o);
                }
            });
        l += __shfl_xor(l, 32);
        const float sc = l > 0.f ? g1 / l : 0.f;
        of_add(ost, lane, o, sc);
    }
    {
        const bf16_t* kbw = p.kb() + (size_t)((2 * NB + b) * 2 + g) * SEQ * 64;
        const bf16_t* vbw = p.vT() + (size_t)((1 * NB + b) * 2 + g) * 64 * SEQ;
        float m = -1e30f, l = 0.f; f32x16 o[2]; o[0] = zero16(); o[1] = zero16();
        block_loop<true>(kbw, vbw, SEQ, kv, j > 8 ? j - 8 : 0, [&](int n) { return n < j ? n + 1 : -1; }, [&](int n) { return true; },
            [&](int n, LAS const bf16_t* kb, LAS const bf16_t* vb) {
#pragma unroll 1
                for (int kt = 0; kt < 2; ++kt) {
                    const int tok0 = 64 * n + 32 * kt;
                    const f32x16 s = lds_qk(qf, kb, kt, col, hb);
                    if (n < j && n > j - 8) sm_pv_nomask(s, true, [&](int dt, int s2) { return lds_vfrag(vb, kt, dt, s2, col, hb); }, m, l, o);
                    else sm_pv(s, hb, [&](int kl) { const int key = tok0 + kl; return key <= qpos && key + 511 >= qpos; }, [&](int dt, int s2) { return lds_vfrag(vb, kt, dt, s2, col, hb); }, m, l, o);
                }
            });
        l += __shfl_xor(l, 32);
        const float sc = l > 0.f ? g2 / l : 0.f;
        f32x16 of[2];
        of_get_add(ost, lane, o, sc, of);
        attn_store(p, of, qrow, head, hb, true);
    }
    __syncthreads();
}

__device__ __forceinline__ void attn_sample_block(const P& p, int bg, LAS unsigned char* lds) {
    int tid_l = threadIdx.x; asm volatile("" : "+v"(tid_l));
    const int tid = tid_l, lane = tid & 63, wid = __builtin_amdgcn_readfirstlane(tid >> 6);
    const int b = bg >> 1, g = bg & 1, t = wid;
    const int col = lane & 31, hb = lane >> 5, hh = col & 3;
    const int qrow = NP + b * 8 + t, head = g * 4 + hh;
    LAS unsigned char* wl = lds + wid * WL_STRIDE;
    LAS unsigned char* kv = lds + KV_OFF;
    bf16x8 qf[4];
#pragma unroll
    for (int ks = 0; ks < 4; ++ks) qf[ks] = *(const bf16x8*)(p.qb() + (size_t)qrow * 512 + head * 64 + 16 * ks + 8 * hb);
    LAS float* psum = (LAS float*)wl;
    LAS int* list = (LAS int*)(wl + 8256);
    LAS float* impl = (LAS float*)(wl + 8448);
    LAS bf16_t* vt = (LAS bf16_t*)(wl + 9728);
    const float g0 = p.gates()[(size_t)qrow * 32 + head * 3 + 0], g1 = p.gates()[(size_t)qrow * 32 + head * 3 + 1], g2 = p.gates()[(size_t)qrow * 32 + head * 3 + 2];
    f32x16 oc[2]; oc[0] = zero16(); oc[1] = zero16();
    {
        const bf16_t* kc = p.kc_s() + (size_t)bg * 1024 * 64;
        const bf16_t* vc = p.vcT_s() + (size_t)bg * 64 * 1024;
        float m = -1e30f, l = 0.f;
        block_loop<false>(kc, vc, 1024, kv, 0, [&](int n) { return n < 15 ? n + 1 : -1; }, [&](int n) { return true; },
            [&](int n, LAS const bf16_t* kb, LAS const bf16_t* vb) {
#pragma unroll 1
                for (int kt = 0; kt < 2; ++kt) {
                    const f32x16 s = lds_qk(qf, kb, kt, col, hb);
                    sm_stats(s, hb, [&](int kl) { return 64 * n + 32 * kt + kl <= 1022; }, m, l);
                }
            });
        l += __shfl_xor(l, 32);
        const float inv = l > 0.f ? 1.0f / l : 0.f;
        block_loop<true>(kc, vc, 1024, kv, 0, [&](int n) { return n < 15 ? n + 1 : -1; }, [&](int n) { return true; },
            [&](int n, LAS const bf16_t* kb, LAS const bf16_t* vb) {
#pragma unroll 1
                for (int kt = 0; kt < 2; ++kt) {
                    const f32x16 s = lds_qk(qf, kb, kt, col, hb);
                    cmp_pass2(s, hb, [&](int kl) { return 64 * n + 32 * kt + kl <= 1022; }, [&](int dt, int s2) { return lds_vfrag(vb, kt, dt, s2, col, hb); }, m, inv, oc,
                              psum + 64 * n + 32 * kt, col == 0);
                }
            });
    }
    WAVE_SYNC();
#pragma unroll
    for (int j = 0; j < 5; ++j) {
        const int n = lane + 64 * j;
        if (n <= 256) {
            float imp = 0.f;
            for (int c = -1; c < 4; ++c) { const int cc = 4 * n + c; if (cc >= 0 && cc <= 1022) imp += psum[cc]; }
            impl[n] = imp;
        }
    }
    WAVE_SYNC();
    {
        int base = 0;
#pragma unroll
        for (int j = 0; j < 4; ++j) {
            const int n = lane + 64 * j;
            const bool cand = n >= 1 && n <= 254;
            const float v = impl[n];
            int rank = 0;
            for (int q = 1; q <= 254; ++q) { const float vq = impl[q]; rank += (vq > v || (vq == v && q < n)) ? 1 : 0; }
            const bool sel = cand && rank < 13;
            const unsigned long long mk = __ballot(sel);
            if (sel) list[base + __popcll(mk & ((1ull << lane) - 1ull))] = n;
            base += __popcll(mk);
        }
        if (lane == 0) { list[13] = 0; list[14] = 255; list[15] = 256; }
    }
    WAVE_SYNC();
    if (lane < 16) {
        const int n = list[lane];
        list[16 + lane] = n < 256 ? p.page_table[b * 128 + (n >> 1)] * 128 + (n & 1) * 64 : -1;
    }
    WAVE_SYNC();
    LAS float* ost = (LAS float*)wl;
    of_put(ost, lane, oc, g0);
    {
        float m = -1e30f, l = 0.f; f32x16 o[2]; o[0] = zero16(); o[1] = zero16();
        const float* newrows = p.out + O_SEL_S + (size_t)(b * 8) * 256 + g * 64;
        auto rowptr = [&](int u) -> const float* {
            const int rb = __builtin_amdgcn_readfirstlane(list[16 + (u >> 1)]);
            return rb >= 0 ? p.cache_sel + ((size_t)rb + 32 * (u & 1) + col) * 256 + g * 64 : newrows + (size_t)(col < 8 ? col : 7) * 256;
        };
        f32x4 kA[4], kB[4];
        { const float* kr = rowptr(0) + 8 * hb;
#pragma unroll
          for (int ks = 0; ks < 4; ++ks) { kA[ks] = *(const f32x4*)(kr + 16 * ks); kB[ks] = *(const f32x4*)(kr + 16 * ks + 4); } }
#pragma unroll 1
        for (int u = 0; u < 31; ++u) {
            const bool isnew = __builtin_amdgcn_readfirstlane(list[16 + (u >> 1)]) < 0;
            const float* vr = rowptr(u) + 128 + 32 * hb;
            f32x4 vv[8];
#pragma unroll
            for (int j4 = 0; j4 < 8; ++j4) vv[j4] = *(const f32x4*)(vr + 4 * j4);
            f32x16 s = zero16();
#pragma unroll
            for (int ks = 0; ks < 4; ++ks) s = mfma32(pack8(kA[ks][0], kA[ks][1], kA[ks][2], kA[ks][3], kB[ks][0], kB[ks][1], kB[ks][2], kB[ks][3]), qf[ks], s);
            if (u + 1 < 31) { const float* kr = rowptr(u + 1) + 8 * hb;
#pragma unroll
                for (int ks = 0; ks < 4; ++ks) { kA[ks] = *(const f32x4*)(kr + 16 * ks); kB[ks] = *(const f32x4*)(kr + 16 * ks + 4); } }
#pragma unroll
            for (int j4 = 0; j4 < 8; ++j4)
#pragma unroll
                for (int e = 0; e < 4; ++e) vt[(32 * hb + 4 * j4 + e) * 40 + col] = f2bf(vv[j4][e]);
            WAVE_SYNC();
            sm_pv(s, hb, [&](int kl) { return !isnew || kl <= t; }, [&](int dt, int s2) {
                LAS const bf16_t* ptr = vt + (32 * dt + col) * 40 + 16 * s2 + 4 * hb;
                union { u32x4_t u4; bf16x8 v; } x; const u32x2 a = *(LAS const u32x2*)ptr, c = *(LAS const u32x2*)(ptr + 8); x.u4[0] = a[0]; x.u4[1] = a[1]; x.u4[2] = c[0]; x.u4[3] = c[1]; return x.v; }, m, l, o);
            WAVE_SYNC();
        }
        l += __shfl_xor(l, 32);
        const float sc = l > 0.f ? g1 / l : 0.f;
        of_add(ost, lane, o, sc);
    }
    {
        float m = -1e30f, l = 0.f; f32x16 o[2]; o[0] = zero16(); o[1] = zero16();
        LoadWinF32 L; L.cw = p.cache_win + (size_t)b * 512 * 256 + g * 64; L.nw = p.out + O_WIN_S + ((size_t)b * 512 + 504) * 256 + g * 64;
        block_loop_g(L, kv, 0, [&](int n) { return n < 8 ? n + 1 : -1; }, [&](int n) { return true; },
            [&](int n, LAS const bf16_t* kb, LAS const bf16_t* vb) {
#pragma unroll 1
                for (int kt = 0; kt < 2; ++kt) {
                    const int j0 = 64 * n + 32 * kt;
                    if (j0 >= 520) break;
                    const f32x16 s = lds_qk(qf, kb, kt, col, hb);
                    sm_pv(s, hb, [&](int kl) { const int j = j0 + kl; return j >= t + 1 && j <= 512 + t; }, [&](int dt, int s2) { return lds_vfrag(vb, kt, dt, s2, col, hb); }, m, l, o);
                }
            });
        l += __shfl_xor(l, 32);
        const float sc = l > 0.f ? g2 / l : 0.f;
        f32x16 of[2];
        of_get_add(ost, lane, o, sc, of);
        attn_store(p, of, qrow, head, hb, col < 4);
    }
    __syncthreads();
}

__device__ __forceinline__ void ph_attn(const P& p, LAS unsigned char* lds, int qsel = 0) {
    const int tid = threadIdx.x, lane = tid & 63, wid = tid >> 6;
    unsigned* ctr = p.bar() + 3584 + 64 * qsel;
    LAS unsigned* qslot = (LAS unsigned*)(lds + XB_OFF + 64);
    for (;;) {
        if (tid == 0) *qslot = __hip_atomic_fetch_add(ctr, 1u, __ATOMIC_RELAXED, __HIP_MEMORY_SCOPE_AGENT);
        __syncthreads();
        const unsigned q = __builtin_amdgcn_readfirstlane(*qslot);
        __syncthreads();
        if (q >= 64u + 512u) break;
        if (q < 64u) attn_sample_block(p, (int)q, lds);
        else { const int idx = (int)q - 64; attn_prompt_block(p, idx & 7, 63 - (idx >> 3), lds);
        }
    }
}


constexpr int LDS_BYTES = pg8::STAGE_BYTES;

constexpr int FUSED_LDS = XB_OFF + 256;

template <class Epi> __device__ __forceinline__ void run_gemm(LAS unsigned char* lds, const bf16_t* A, const bf16_t* Bt, int M, int N, int K, const Epi& E, int slot = -1) {
    pg8::Gemm g; g.A = A; g.Bt = Bt; g.M = M; g.N = N; g.K = K; g.pad_ = 0;
    pg8::StaticOrder S; S.init(M, N, (int)gridDim.x, slot >= 0 ? slot : (int)blockIdx.x);
    pg8::gemm_phase<Epi, pg8::StaticOrder, false>((PG8_LAS unsigned char*)lds, g, S, E, nullptr);
}

#define XBAR() xcd_barrier(bar)
__global__ __launch_bounds__(512, 2) void k_fused(P p) {
    extern __shared__ __attribute__((aligned(16))) unsigned char shm[];
    LAS unsigned char* lds = (LAS unsigned char*)shm;
    LAS unsigned* xb = (LAS unsigned*)(lds + XB_OFF);
    if (threadIdx.x == 0) { xb[0] = 0u; xb[1] = 0u; xb[2] = 0u; xb[3] = 0u; }
    __syncthreads();
    XcdBarrier bar = xcd_barrier_post(p.bar(), (volatile LAS unsigned*)xb);
    ph_prep(p);
    XBAR();
    { EpiIn e; e.p = p; e.row0 = 0; e.pn0 = 0; run_gemm(lds, p.hb(), p.WinT(), MR, NPAD, DM, e); }
    ph_cmp_gemm_f32(p, lds);
    XBAR();
    if ((int)blockIdx.x < 16) {
        const int kvi = blockIdx.x >> 3, bg = blockIdx.x & 7;
        EpiPlainBf e; e.C = p.LHp() + ((size_t)kvi * 2048 + (size_t)bg * 256) * 256; e.ldc = 256; e.pad_ = 0;
        run_gemm(lds, (kvi ? p.vcr() : p.kb()) + (size_t)bg * 256 * 1024, p.W1T() + (size_t)kvi * 256 * 1024, 256, 256, 1024, e, 0);
        __builtin_amdgcn_fence(__ATOMIC_RELEASE, "agent");
        asm volatile("s_waitcnt vmcnt(0)" ::: "memory");
        __syncthreads();
        __builtin_amdgcn_fence(__ATOMIC_ACQUIRE, "agent");
        asm volatile("s_waitcnt vmcnt(0)" ::: "memory");
        compress2_tile(p, p.LHp(), 8, 256, 255, p.kc_p(), p.vcT_p(), kvi, bg, threadIdx.x >> 6, threadIdx.x & 63, lds + (threadIdx.x >> 6) * 8960);
    }
    ph_rwkv_prep(p);
    ph_compress2(p, p.LHs(), 64, 1024, 1023, p.kc_s(), p.vcT_s(), lds);
    XBAR();
    ph_rwkv_scan(p, (LAS float*)lds);
    __syncthreads();
    ph_attn(p, lds);
    XBAR();
    ph_rwkv_post(p);
    { EpiYa e; e.p = p; small_gemm(p.oa(), p.WpaT(), 512, e); run_gemm(lds, p.oa(), p.WpaT(), NP, DM, 512, e); }
    XBAR();
    { EpiYb e; e.p = p; small_gemm(p.ob(), p.WpbT(), 512, e); run_gemm(lds, p.ob(), p.WpbT(), NP, DM, 512, e); }
    XBAR();
    { EpiOut e; e.p = p; small_gemm(p.mb(), p.WoutT(), DM, e); run_gemm(lds, p.mb(), p.WoutT(), NP, DM, DM, e); }
    { EpiPlain e; e.C = p.pp(); e.ldc = DM; e.pad_ = 0; small_gemm(p.pb(), p.WprojT(), 256, e); run_gemm(lds, p.pb(), p.WprojT(), NP, DM, 256, e); }
    XBAR();
    { EpiGate e; e.p = p; small_gemm(p.xg(), p.WgateT(), DM, e); run_gemm(lds, p.xg(), p.WgateT(), NP, DM, DM, e); }
    XBAR();
    ph_final(p);
}
extern "C" void kernel_launch(void* const* d_in, const int* in_sizes, int n_in, void* d_out, int out_size, void* d_ws, size_t ws_size, hipStream_t stream) {
    (void)in_sizes; (void)n_in; (void)out_size; (void)ws_size;
    P p{};
    p.x_prompt = (const float*)d_in[0]; p.x_sample = (const float*)d_in[1]; p.p_prompt = (const float*)d_in[2]; p.p_sample = (const float*)d_in[3];
    p.cache_cmp = (const float*)d_in[4]; p.cache_sel = (const float*)d_in[5]; p.cache_win = (const float*)d_in[6]; p.state_wkv = (const float*)d_in[7];
    p.state_shift = (const float*)d_in[8]; p.page_table = (const int*)d_in[9]; p.norm_g = (const float*)d_in[10]; p.w_in = (const float*)d_in[11];
    p.cmp_pe = (const float*)d_in[12]; p.cmp_w1 = (const float*)d_in[13]; p.cmp_b1 = (const float*)d_in[14]; p.cmp_w2 = (const float*)d_in[15]; p.cmp_b2 = (const float*)d_in[16];
    p.w_pa = (const float*)d_in[17]; p.mu = (const float*)d_in[18]; p.w0 = (const float*)d_in[19]; p.w_up = (const float*)d_in[20]; p.a0 = (const float*)d_in[21];
    p.a_up = (const float*)d_in[22]; p.k_k = (const float*)d_in[23]; p.k_a = (const float*)d_in[24]; p.r_k = (const float*)d_in[25]; p.gn_g = (const float*)d_in[26];
    p.gn_b = (const float*)d_in[27]; p.w_pb = (const float*)d_in[28]; p.w_out = (const float*)d_in[29]; p.ple_g = (const float*)d_in[30]; p.w_gate = (const float*)d_in[31];
    p.w_proj = (const float*)d_in[32]; p.final_g = (const float*)d_in[33];
    p.out = (float*)d_out;
    p.ws = (unsigned char*)d_ws;

    static int grid = 0;
    if (!grid) {
        int dev = 0, cus = 0, per_cu = 0;
        (void)hipGetDevice(&dev);
        (void)hipDeviceGetAttribute(&cus, hipDeviceAttributeMultiprocessorCount, dev);
        (void)hipFuncSetAttribute((const void*)k_fused, hipFuncAttributeMaxDynamicSharedMemorySize, FUSED_LDS);
        (void)hipOccupancyMaxActiveBlocksPerMultiprocessor(&per_cu, k_fused, 512, FUSED_LDS);
        grid = per_cu >= 1 ? cus : 0;
        if (grid > 256) grid = 256;
    }
    (void)hipMemsetAsync(p.bar(), 0, 32768, stream);
    if (grid > 0) hipLaunchKernelGGL(k_fused, dim3(grid), dim3(512), FUSED_LDS, stream, p);
}
```

```cpp
#include <hip/hip_runtime.h>
#include <stdint.h>
#include <stdio.h>
namespace pg8 {
#define PG8_LAS __attribute__((address_space(3)))
typedef unsigned short bf16_t;
typedef short bf16x8 __attribute__((ext_vector_type(8)));
typedef float f32x4 __attribute__((ext_vector_type(4)));
typedef unsigned u32x4 __attribute__((ext_vector_type(4)));
constexpr int BM = 256, BK = 64, HALF = 128, HTB = HALF * BK * 2  , STAGE_BYTES = 8 * HTB, NXCD = 8, WGM = 8;

__host__ __device__ __forceinline__ int lds_byte(int r, int c) { const int st = (r >> 4) * 2 + (c >> 5), rr = r & 15, cc = c & 31, ob = rr * 64 + cc * 2; return st * 1024 + (ob ^ (((ob >> 9) & 1) << 5)); }
__host__ __device__ __forceinline__ void stage_rc(int b, int& R, int& C) { const int st = b / 1024, sb = b % 1024, swz = sb ^ (((sb >> 9) & 1) << 5); R = (st >> 1) * 16 + swz / 64; C = (st & 1) * 32 + (swz % 64) / 2; }
__host__ __device__ __forceinline__ int perm32(int rho) { const int n = rho >> 4, i = rho & 15; return 8 * (i >> 2) + 4 * n + (i & 3); }

struct Unit { int pm, pn; };
struct Gemm { const bf16_t* A; const bf16_t* Bt; int M, N, K, pad_; };

struct StaticOrder {
    int nM, nN, nwg, G, c;
    __host__ __device__ void init(int M, int N, int G_, int c_) { nM = M / BM; nN = N / BM; nwg = nM * nN; G = G_; c = c_; }
    __host__ __device__ bool next(int i, Unit& u) const {
        const long L = (long)i * G + c; if (L >= nwg) return false;
        int wgid = (int)L; { const int q = nwg / NXCD, r = nwg % NXCD, xcd = wgid % NXCD, off = wgid / NXCD; wgid = (xcd < r ? xcd * (q + 1) : r * (q + 1) + (xcd - r) * q) + off; }
        const int nig = WGM * nN, gid = wgid / nig, fm = gid * WGM, gsz = (nM - fm) < WGM ? (nM - fm) : WGM;
        u.pm = fm + ((wgid % nig) % gsz); u.pn = (wgid % nig) / gsz; return true;
    }
    __device__ __forceinline__ void a_ready(const Unit&) const {}
    __device__ __forceinline__ void done(const Unit&) const {}
};
__device__ __forceinline__ unsigned cvt_pk_bf16(float lo, float hi) { unsigned r; asm volatile("v_cvt_pk_bf16_f32 %0, %1, %2" : "=v"(r) : "v"(lo), "v"(hi)); return r; }
typedef float f32x2 __attribute__((ext_vector_type(2)));
template <class Epi, class Sched, bool STAMP = false>
__device__ __forceinline__ void gemm_phase(PG8_LAS unsigned char* lds, const Gemm g, const Sched& S, const Epi& E, unsigned long long* stamps) {
    int tid_l = threadIdx.x; asm volatile("" : "+v"(tid_l));
    const int tid = tid_l, wid = __builtin_amdgcn_readfirstlane(tid >> 6), lane = tid & 63, wr = wid >> 2, wc = wid & 3, fr = lane & 15, fq = lane >> 4;
    const int K = g.K, nt = K / BK;
    int ts_lo = 0, ts_hi = 0, nts = 0; const unsigned long long rt_entry = STAMP ? (unsigned long long)wall_clock64() : 0ull;
#define PG8_STAMP() do { if (STAMP && wid == 0 && nts < 64) { const unsigned long long _c = (unsigned long long)clock64(); \
        ts_lo = (lane == nts) ? (int)(unsigned)_c : ts_lo; ts_hi = (lane == nts) ? (int)(unsigned)(_c >> 32) : ts_hi; ++nts; } } while (0)
    PG8_STAMP();
    unsigned voffA[2], voffB[2];
#pragma unroll
    for (int i = 0; i < 2; ++i) { int R, C; stage_rc(tid * 16 + i * 8192, R, C); const int Rb = Epi::PERM ? ((R & ~31) + perm32(R & 31)) : R;
        voffA[i] = (unsigned)(R * K + C) * 2u; voffB[i] = (unsigned)(Rb * K + C) * 2u; }
    const size_t kstep = (size_t)(BK * 2);
    const size_t hstep = (size_t)HALF * K * 2;
    const size_t tstep = 2 * hstep;
    const unsigned ldsw = (unsigned)wid * 1024u;
    const int aoff = lds_byte(wr * 64 + fr, fq * 8), boff = lds_byte(wc * 32 + fr, fq * 8);
#define PG8_SA(b, h) (((b) * 2 + (h)) * HTB)
#define PG8_SB(b, h) ((4 + (b) * 2 + (h)) * HTB)
#define PG8_STAGE(bufoff, gbase, voff) do { _Pragma("unroll") for (int _i = 0; _i < 2; ++_i) \
        __builtin_amdgcn_global_load_lds((const unsigned*)((const char*)(gbase) + (voff)[_i]), (PG8_LAS unsigned*)(lds + (bufoff) + ldsw + _i * 8192), 16, 0, 0); } while (0)
#define PG8_LDA(dst, b, h) do { _Pragma("unroll") for (int m = 0; m < 4; ++m) _Pragma("unroll") for (int k = 0; k < 2; ++k) dst[m][k] = *(const PG8_LAS bf16x8*)(lds + PG8_SA(b, h) + aoff + m * 2048 + k * 1024); } while (0)
#define PG8_LDB(dst, b, h) do { _Pragma("unroll") for (int n = 0; n < 2; ++n) _Pragma("unroll") for (int k = 0; k < 2; ++k) dst[n][k] = *(const PG8_LAS bf16x8*)(lds + PG8_SB(b, h) + boff + n * 2048 + k * 1024); } while (0)
#define PG8_MMA(ai, bj, At, Bt) do { __builtin_amdgcn_s_setprio(1); _Pragma("unroll") for (int m = 0; m < 4; ++m) _Pragma("unroll") for (int n = 0; n < 2; ++n) _Pragma("unroll") for (int k = 0; k < 2; ++k) \
        acc[ai][bj][m][n] = __builtin_amdgcn_mfma_f32_16x16x32_bf16(Bt[n][k], At[m][k], acc[ai][bj][m][n], 0, 0, 0); __builtin_amdgcn_s_setprio(0); } while (0)
#define PG8_WAIT_V(n) asm volatile("s_waitcnt vmcnt(" #n ")" ::: "memory")
#define PG8_WAIT_L(n) asm volatile("s_waitcnt lgkmcnt(" #n ")" ::: "memory")
#define PG8_BAR __builtin_amdgcn_s_barrier()
#define PG8_SCHED __builtin_amdgcn_sched_barrier(0)
    Unit cur, nxt; int ui = 0;
    if (!S.next(0, cur)) return;
    f32x4 acc[2][2][4][2];
#pragma unroll
    for (int a = 0; a < 2; ++a)
#pragma unroll
        for (int b = 0; b < 2; ++b)
#pragma unroll
            for (int m = 0; m < 4; ++m)
#pragma unroll
                for (int n = 0; n < 2; ++n) acc[a][b][m][n] = (f32x4){0.f, 0.f, 0.f, 0.f};
    bf16x8 At[4][2], B0[2][2], B1[2][2];
    const char* cA = (const char*)g.A + (size_t)cur.pm * tstep; const char* cB = (const char*)g.Bt + (size_t)cur.pn * tstep;
    S.a_ready(cur);
    PG8_STAGE(PG8_SB(0, 0), cB, voffB); PG8_STAGE(PG8_SA(0, 0), cA, voffA); PG8_STAGE(PG8_SB(0, 1), cB + hstep, voffB); PG8_STAGE(PG8_SA(0, 1), cA + hstep, voffA);
    if (wr == 1) PG8_BAR;
    PG8_WAIT_V(4); PG8_BAR;
    PG8_STAGE(PG8_SB(1, 0), cB + kstep, voffB); PG8_STAGE(PG8_SA(1, 0), cA + kstep, voffA); PG8_STAGE(PG8_SB(1, 1), cB + hstep + kstep, voffB);
    PG8_WAIT_V(6); PG8_BAR;
    PG8_STAMP();
    for (;;) {
        const bool has_next = S.next(ui + 1, nxt);
        const char* nA = has_next ? (const char*)g.A + (size_t)nxt.pm * tstep : cA; const char* nB = has_next ? (const char*)g.Bt + (size_t)nxt.pn * tstep : cB;
        for (int t = 0; t < nt; t += 2) {
            const bool last = (t == nt - 2);
            const char* a1 = cA + (size_t)(t + 1) * kstep;
            const char* a2 = last ? nA : cA + (size_t)(t + 2) * kstep; const char* b2 = last ? nB : cB + (size_t)(t + 2) * kstep;
            const char* a3 = a2 + kstep; const char* b3 = b2 + kstep;
            if (last && has_next) S.a_ready(nxt);
            PG8_LDB(B0, 0, 0); PG8_SCHED; PG8_LDA(At, 0, 0); PG8_STAGE(PG8_SA(1, 1), a1 + hstep, voffA);
            PG8_WAIT_L(8); PG8_BAR; PG8_WAIT_L(0); PG8_MMA(0, 0, At, B0); PG8_BAR; PG8_SCHED;
            PG8_LDB(B1, 0, 1); PG8_STAGE(PG8_SB(0, 0), b2, voffB);
            PG8_BAR; PG8_WAIT_L(0); PG8_MMA(0, 1, At, B1); PG8_BAR;
            PG8_LDA(At, 0, 1); PG8_STAGE(PG8_SA(0, 0), a2, voffA);
            PG8_BAR; PG8_WAIT_L(0); PG8_MMA(1, 0, At, B0); PG8_BAR; PG8_SCHED;
            PG8_STAGE(PG8_SB(0, 1), b2 + hstep, voffB);
            PG8_WAIT_V(6); PG8_BAR; PG8_MMA(1, 1, At, B1); PG8_BAR;
            PG8_LDB(B0, 1, 0); PG8_SCHED; PG8_LDA(At, 1, 0); PG8_STAGE(PG8_SA(0, 1), a2 + hstep, voffA);
            PG8_WAIT_L(8); PG8_BAR; PG8_WAIT_L(0); PG8_MMA(0, 0, At, B0); PG8_BAR; PG8_SCHED;
            PG8_LDB(B1, 1, 1); PG8_STAGE(PG8_SB(1, 0), b3, voffB);
            PG8_BAR; PG8_WAIT_L(0); PG8_MMA(0, 1, At, B1); PG8_BAR;
            PG8_LDA(At, 1, 1); PG8_STAGE(PG8_SA(1, 0), a3, voffA);
            PG8_BAR; PG8_WAIT_L(0); PG8_MMA(1, 0, At, B0); PG8_BAR; PG8_SCHED;
            PG8_STAGE(PG8_SB(1, 1), b3 + hstep, voffB);
            PG8_WAIT_V(6); PG8_BAR; PG8_MMA(1, 1, At, B1); PG8_BAR;
        }
        PG8_STAMP();
        if constexpr (!Epi::AFTER_DRAIN) { E(acc, cur, wr, wc, fr, fq); S.done(cur); }
        PG8_STAMP();
        if (!has_next) break;
#pragma unroll
        for (int a = 0; a < 2; ++a)
#pragma unroll
            for (int b = 0; b < 2; ++b)
#pragma unroll
                for (int m = 0; m < 4; ++m)
#pragma unroll
                    for (int n = 0; n < 2; ++n) acc[a][b][m][n] = (f32x4){0.f, 0.f, 0.f, 0.f};
        cur = nxt; cA = nA; cB = nB; ++ui;
    }
    PG8_WAIT_V(0);
    if (wr == 0) PG8_BAR;
    PG8_BAR;
    if constexpr (Epi::AFTER_DRAIN) { E.fused(acc, cur, wr, wc, fr, fq, lds, wid, lane); S.done(cur); }
    PG8_STAMP();
    if (STAMP && wid == 0) { stamps[lane] = lane < nts ? (((unsigned long long)(unsigned)ts_hi << 32) | (unsigned)ts_lo) : 0ull;
        if (lane == 62) stamps[62] = rt_entry; if (lane == 63) stamps[63] = (unsigned long long)wall_clock64(); }
#undef PG8_STAMP
#undef PG8_SA
#undef PG8_SB
#undef PG8_STAGE
#undef PG8_LDA
#undef PG8_LDB
#undef PG8_MMA
#undef PG8_WAIT_V
#undef PG8_WAIT_L
#undef PG8_BAR
#undef PG8_SCHED
}
}

typedef unsigned short bf16_t;
typedef short bf16x8 __attribute__((ext_vector_type(8)));
typedef float f32x4 __attribute__((ext_vector_type(4)));
typedef float f32x16 __attribute__((ext_vector_type(16)));
#define LAS __attribute__((address_space(3)))
#define WAVE_SYNC() do { asm volatile("s_waitcnt lgkmcnt(0)" ::: "memory"); __builtin_amdgcn_wave_barrier(); } while (0)

constexpr int DM = 1024, NP = 16384, NSMP = 256, MR = 16640, SEQ = 4096, NB = 4, DB = 32, DS = 8, PAST = 16384;
constexpr int CIN = 6040, NPAD = 6144, CR = 1664;
constexpr int NTHR = 512;
constexpr size_t O_Y_P = 0, O_Y_S = 16777216, O_CMP_P = 17039360, O_CMP_S = 21233664, O_SEL_P = 21299200, O_SEL_S = 25493504,
                 O_WIN_P = 25559040, O_WIN_S = 26083328, O_WKV_P = 30277632, O_WKV_S = 30408704, O_SH_P = 31457280, O_SH_S = 31463936;

constexpr size_t ws_al(size_t x) { return (x + 255) & ~(size_t)255; }
constexpr size_t WS_bar = 0;
constexpr size_t WS_hb = WS_bar + ws_al(32768);
constexpr size_t WS_WinT = WS_hb + ws_al((size_t)MR * DM * 2);
constexpr size_t WS_WpaT = WS_WinT + ws_al((size_t)NPAD * DM * 2);
constexpr size_t WS_WpbT = WS_WpaT + ws_al((size_t)DM * 512 * 2);
constexpr size_t WS_WoutT = WS_WpbT + ws_al((size_t)DM * 512 * 2);
constexpr size_t WS_WgateT = WS_WoutT + ws_al((size_t)DM * DM * 2);
constexpr size_t WS_WprojT = WS_WgateT + ws_al((size_t)DM * DM * 2);
constexpr size_t WS_W1T = WS_WprojT + ws_al((size_t)DM * 256 * 2);
constexpr size_t WS_W2T = WS_W1T + ws_al((size_t)512 * 1024 * 2);
constexpr size_t WS_WupT = WS_W2T + ws_al((size_t)128 * 128 * 2);
constexpr size_t WS_AupT = WS_WupT + ws_al((size_t)512 * 64 * 2);
constexpr size_t WS_pb = WS_AupT + ws_al((size_t)512 * 64 * 2);
constexpr size_t WS_tabc = WS_pb + ws_al((size_t)MR * 256 * 2);
constexpr size_t WS_tabs = WS_tabc + ws_al((size_t)4104 * 32 * 4);
constexpr size_t WS_pt = WS_tabs + ws_al((size_t)4104 * 32 * 4);
constexpr size_t WS_qb = WS_pt + ws_al(256 * 4);
constexpr size_t WS_kb = WS_qb + ws_al((size_t)MR * 512 * 2);
constexpr size_t WS_vcr = WS_kb + ws_al((size_t)3 * NB * 2 * SEQ * 64 * 2);
constexpr size_t WS_vT = WS_vcr + ws_al((size_t)NB * 2 * SEQ * 64 * 2);
constexpr size_t WS_ag = WS_vT + ws_al((size_t)2 * NB * 2 * 64 * SEQ * 2);
constexpr size_t WS_rg = WS_ag + ws_al((size_t)MR * 512 * 2);
constexpr size_t WS_mg = WS_rg + ws_al((size_t)MR * 512 * 2);
constexpr size_t WS_gates = WS_mg + ws_al((size_t)MR * 2048 * 2);
constexpr size_t WS_rz = WS_gates + ws_al((size_t)MR * 32 * 4);
constexpr size_t WS_zs0 = WS_rz + ws_al((size_t)MR * CR * 2);
constexpr size_t WS_LHp = WS_zs0 + ws_al((size_t)33 * CR * 2);
constexpr size_t WS_LHs = WS_LHp + ws_al((size_t)2 * 2048 * 256 * 4);
constexpr size_t WS_cs = WS_LHs + ws_al((size_t)2 * 65536 * 256 * 4);
constexpr size_t WS_kc_p = WS_cs + ws_al((size_t)2 * 65536 * 1024 * 2);
constexpr size_t WS_vcT_p = WS_kc_p + ws_al((size_t)8 * 256 * 64 * 2);
constexpr size_t WS_kc_s = WS_vcT_p + ws_al((size_t)8 * 64 * 256 * 2);
constexpr size_t WS_vcT_s = WS_kc_s + ws_al((size_t)64 * 1024 * 64 * 2);
constexpr size_t WS_rw6 = WS_vcT_s + ws_al((size_t)64 * 64 * 1024 * 2);
constexpr int RW6_STRIDE = 896;
constexpr size_t WS_bonus = WS_rw6 + ws_al((size_t)MR * 8 * RW6_STRIDE);
constexpr size_t WS_ybuf = WS_bonus + ws_al((size_t)MR * 8 * 4);
constexpr size_t WS_oa = WS_ybuf + ws_al((size_t)MR * 512 * 4);
constexpr size_t WS_ob = WS_oa + ws_al((size_t)MR * 512 * 2);
constexpr size_t WS_mb = WS_ob + ws_al((size_t)MR * 512 * 2);
constexpr size_t WS_xg = WS_mb + ws_al((size_t)MR * DM * 2);
constexpr size_t WS_tmp = WS_xg + ws_al((size_t)MR * DM * 2);
constexpr size_t WS_x1 = WS_tmp + ws_al((size_t)MR * DM * 4);
constexpr size_t WS_ss1 = WS_x1 + ws_al((size_t)MR * DM * 4);
constexpr size_t WS_pp = WS_ss1 + ws_al((size_t)MR * 16 * 4);
constexpr size_t WS_TOTAL = WS_pp + ws_al((size_t)MR * DM * 4);

struct P {
    const float *x_prompt, *x_sample, *p_prompt, *p_sample, *cache_cmp, *cache_sel, *cache_win, *state_wkv, *state_shift;
    const int* page_table;
    const float *norm_g, *w_in, *cmp_pe, *cmp_w1, *cmp_b1, *cmp_w2, *cmp_b2, *w_pa, *mu, *w0, *w_up, *a0, *a_up, *k_k, *k_a, *r_k, *gn_g, *gn_b,
        *w_pb, *w_out, *ple_g, *w_gate, *w_proj, *final_g;
    float* out;
    unsigned char* ws;
    __host__ __device__ __forceinline__ unsigned* bar() const { return (unsigned*)(ws + WS_bar); }
    __host__ __device__ __forceinline__ float* ss_s() const { return (float*)(ws + WS_bar + 16384); }
    __host__ __device__ __forceinline__ bf16_t* hb() const { return (bf16_t*)(ws + WS_hb); }
    __host__ __device__ __forceinline__ bf16_t* WinT() const { return (bf16_t*)(ws + WS_WinT); }
    __host__ __device__ __forceinline__ bf16_t* WpaT() const { return (bf16_t*)(ws + WS_WpaT); }
    __host__ __device__ __forceinline__ bf16_t* WpbT() const { return (bf16_t*)(ws + WS_WpbT); }
    __host__ __device__ __forceinline__ bf16_t* WoutT() const { return (bf16_t*)(ws + WS_WoutT); }
    __host__ __device__ __forceinline__ bf16_t* WgateT() const { return (bf16_t*)(ws + WS_WgateT); }
    __host__ __device__ __forceinline__ bf16_t* WprojT() const { return (bf16_t*)(ws + WS_WprojT); }
    __host__ __device__ __forceinline__ bf16_t* W1T() const { return (bf16_t*)(ws + WS_W1T); }
    __host__ __device__ __forceinline__ bf16_t* W2T() const { return (bf16_t*)(ws + WS_W2T); }
    __host__ __device__ __forceinline__ bf16_t* WupT() const { return (bf16_t*)(ws + WS_WupT); }
    __host__ __device__ __forceinline__ bf16_t* AupT() const { return (bf16_t*)(ws + WS_AupT); }
    __host__ __device__ __forceinline__ bf16_t* pb() const { return (bf16_t*)(ws + WS_pb); }
    __host__ __device__ __forceinline__ float* tabc() const { return (float*)(ws + WS_tabc); }
    __host__ __device__ __forceinline__ float* tabs() const { return (float*)(ws + WS_tabs); }
    __host__ __device__ __forceinline__ float* pt() const { return (float*)(ws + WS_pt); }
    __host__ __device__ __forceinline__ bf16_t* qb() const { return (bf16_t*)(ws + WS_qb); }
    __host__ __device__ __forceinline__ bf16_t* kb() const { return (bf16_t*)(ws + WS_kb); }
    __host__ __device__ __forceinline__ bf16_t* vcr() const { return (bf16_t*)(ws + WS_vcr); }
    __host__ __device__ __forceinline__ bf16_t* vT() const { return (bf16_t*)(ws + WS_vT); }
    __host__ __device__ __forceinline__ bf16_t* ag() const { return (bf16_t*)(ws + WS_ag); }
    __host__ __device__ __forceinline__ bf16_t* rg() const { return (bf16_t*)(ws + WS_rg); }
    __host__ __device__ __forceinline__ bf16_t* mg() const { return (bf16_t*)(ws + WS_mg); }
    __host__ __device__ __forceinline__ float* gates() const { return (float*)(ws + WS_gates); }
    __host__ __device__ __forceinline__ bf16_t* rz() const { return (bf16_t*)(ws + WS_rz); }
    __host__ __device__ __forceinline__ bf16_t* zs0() const { return (bf16_t*)(ws + WS_zs0); }
    __host__ __device__ __forceinline__ bf16_t* LHp() const { return (bf16_t*)(ws + WS_LHp); }
    __host__ __device__ __forceinline__ bf16_t* LHs() const { return (bf16_t*)(ws + WS_LHs); }
    __host__ __device__ __forceinline__ bf16_t* cs() const { return (bf16_t*)(ws + WS_cs); }
    __host__ __device__ __forceinline__ bf16_t* kc_p() const { return (bf16_t*)(ws + WS_kc_p); }
    __host__ __device__ __forceinline__ bf16_t* vcT_p() const { return (bf16_t*)(ws + WS_vcT_p); }
    __host__ __device__ __forceinline__ bf16_t* kc_s() const { return (bf16_t*)(ws + WS_kc_s); }
    __host__ __device__ __forceinline__ bf16_t* vcT_s() const { return (bf16_t*)(ws + WS_vcT_s); }
    __host__ __device__ __forceinline__ unsigned char* rw6() const { return ws + WS_rw6; }
    __host__ __device__ __forceinline__ float* bonus() const { return (float*)(ws + WS_bonus); }
    __host__ __device__ __forceinline__ float* ybuf() const { return (float*)(ws + WS_ybuf); }
    __host__ __device__ __forceinline__ bf16_t* oa() const { return (bf16_t*)(ws + WS_oa); }
    __host__ __device__ __forceinline__ bf16_t* ob() const { return (bf16_t*)(ws + WS_ob); }
    __host__ __device__ __forceinline__ bf16_t* mb() const { return (bf16_t*)(ws + WS_mb); }
    __host__ __device__ __forceinline__ bf16_t* xg() const { return (bf16_t*)(ws + WS_xg); }
    __host__ __device__ __forceinline__ float* tmp() const { return (float*)(ws + WS_tmp); }
    __host__ __device__ __forceinline__ float* x1() const { return (float*)(ws + WS_x1); }
    __host__ __device__ __forceinline__ float* ss1() const { return (float*)(ws + WS_ss1); }
    __host__ __device__ __forceinline__ float* pp() const { return (float*)(ws + WS_pp); }
};


__device__ __forceinline__ float bf2f(bf16_t b) { return __uint_as_float(((unsigned)b) << 16); }
typedef __bf16 bf16v2_t __attribute__((ext_vector_type(2)));
typedef float f32x2_t __attribute__((ext_vector_type(2)));
__device__ __forceinline__ unsigned pk2(float lo, float hi) { const f32x2_t v = {lo, hi}; return __builtin_bit_cast(unsigned, __builtin_convertvector(v, bf16v2_t)); }
__device__ __forceinline__ bf16_t f2bf(float f) { return (bf16_t)(pk2(f, f) & 0xffffu); }
__device__ __forceinline__ float xsum16(float v) { const auto r = __builtin_amdgcn_permlane16_swap(__float_as_uint(v), __float_as_uint(v), false, false); return __uint_as_float(r[0]) + __uint_as_float(r[1]); }
__device__ __forceinline__ float xsum32(float v) { const auto r = __builtin_amdgcn_permlane32_swap(__float_as_uint(v), __float_as_uint(v), false, false); return __uint_as_float(r[0]) + __uint_as_float(r[1]); }
__device__ __forceinline__ float xmax32(float v) { const auto r = __builtin_amdgcn_permlane32_swap(__float_as_uint(v), __float_as_uint(v), false, false); return fmaxf(__uint_as_float(r[0]), __uint_as_float(r[1])); }
__device__ __forceinline__ float quad_sum(float v) {
    v += __builtin_bit_cast(float, __builtin_amdgcn_mov_dpp(__builtin_bit_cast(int, v), 0xB1, 0xF, 0xF, true));
    v += __builtin_bit_cast(float, __builtin_amdgcn_mov_dpp(__builtin_bit_cast(int, v), 0x4E, 0xF, 0xF, true));
    return v;
}
__device__ __forceinline__ float wave_sum(float v) {
    v += __builtin_bit_cast(float, __builtin_amdgcn_mov_dpp(__builtin_bit_cast(int, v), 0xB1, 0xF, 0xF, true));
    v += __builtin_bit_cast(float, __builtin_amdgcn_mov_dpp(__builtin_bit_cast(int, v), 0x4E, 0xF, 0xF, true));
    v += __builtin_bit_cast(float, __builtin_amdgcn_mov_dpp(__builtin_bit_cast(int, v), 0x141, 0xF, 0xF, true));
    v += __builtin_bit_cast(float, __builtin_amdgcn_mov_dpp(__builtin_bit_cast(int, v), 0x140, 0xF, 0xF, true));
    return xsum32(xsum16(v));
}
__device__ __forceinline__ float sigmoidf_(float x) { return 1.0f / (1.0f + __expf(-x)); }
__device__ __forceinline__ float siluf_(float x) { return x / (1.0f + __expf(-x)); }
__device__ __forceinline__ float sigmoid_fast(float x) { return __builtin_amdgcn_rcpf(1.0f + __expf(-x)); }
__device__ __forceinline__ float silu_fast(float x) { return x * __builtin_amdgcn_rcpf(1.0f + __expf(-x)); }

__device__ __forceinline__ int win_src_col(int np) {
    const int pn = np >> 8, p = np & 255;
    if (pn < 5) {
        const int bj = p >> 7, wc = (p >> 5) & 3, n = (p >> 4) & 1, fq = (p >> 2) & 3, e = p & 3;
        const int d = 32 * n + 16 * (wc & 1) + 4 * fq + e;
        if (pn < 2) { const int head = pn * 4 + bj * 2 + (wc >> 1); return head * 64 + d; }
        const int br = pn - 2, g = wc >> 1;
        return 512 + br * 256 + bj * 128 + g * 64 + d;
    }
    const int s = (p & 0xe0) + 8 * ((p >> 2) & 3) + 4 * ((p >> 4) & 1) + (p & 3);
    if (pn < 7) return 1304 + (pn - 5) * 256 + s;
    if (pn < 13) return 1816 + (pn - 7) * 256 + s;
    if (pn == 13) { if (s < 128) return 1816 + 1536 + s; if (s < 152) return 1280 + (s - 128); return -1; }
    if (pn < 16) return 3480 + (pn - 14) * 256 + s;
    return 3992 + (pn - 16) * 256 + s;
}

__device__ __forceinline__ int perm8(int np) { return (np & ~31) + 8 * ((np >> 2) & 3) + 4 * ((np >> 4) & 1) + (np & 3); }
template <class F>
__device__ __forceinline__ void transpose_cvt(bf16_t* dst, int Nd, int K, F f) {
    const int total = Nd * (K >> 3);
    for (int id = blockIdx.x * NTHR + threadIdx.x; id < total; id += gridDim.x * NTHR) {
        const int n = id % Nd, kc = id / Nd;
        float v[8];
#pragma unroll
        for (int j = 0; j < 8; ++j) v[j] = f(n, kc * 8 + j);
        uint4 w; w.x = pk2(v[0], v[1]); w.y = pk2(v[2], v[3]); w.z = pk2(v[4], v[5]); w.w = pk2(v[6], v[7]);
        *(uint4*)(dst + (size_t)n * K + kc * 8) = w;
    }
}

__device__ __forceinline__ void sincos_small(double r, float& s, float& c) {
    const double r2 = r * r;
    double sa = 1.0, ca = 1.0;
    double ts = 1.0, tc = 1.0; sa = 0.0; ca = 0.0;
#pragma unroll
    for (int k = 0; k < 16; ++k) {
        sa += ts; ca += tc;
        ts = -ts * r2 / (double)((2 * k + 2) * (2 * k + 3));
        tc = -tc * r2 / (double)((2 * k + 1) * (2 * k + 2));
    }
    s = (float)(sa * r); c = (float)ca;
}

__device__ __forceinline__ void ph_prep(const P& p) {
    const int tid = threadIdx.x, lane = tid & 63, wid = tid >> 6;
    const int gw = blockIdx.x * 8 + wid, nw = gridDim.x * 8;
    const int gt = blockIdx.x * NTHR + tid, nt = gridDim.x * NTHR;
    for (int row0 = gw; row0 < MR; row0 += 2 * nw) {
        float4 v[2][4]; float ss[2];
#pragma unroll
        for (int u = 0; u < 2; ++u) {
            const int row = row0 + u * nw < MR ? row0 + u * nw : row0;
            const float4* src = (const float4*)(row < NP ? p.x_prompt + (size_t)row * DM : p.x_sample + (size_t)(row - NP) * DM);
            ss[u] = 0.f;
#pragma unroll
            for (int i = 0; i < 4; ++i) { v[u][i] = src[lane + 64 * i]; ss[u] += v[u][i].x * v[u][i].x + v[u][i].y * v[u][i].y + v[u][i].z * v[u][i].z + v[u][i].w * v[u][i].w; }
        }
#pragma unroll
        for (int u = 0; u < 2; ++u) {
            const int row = row0 + u * nw;
            const float tot = wave_sum(ss[u]);
            const float rstd = rsqrtf(tot * (1.0f / DM) + 1e-6f);
            if (row < MR) {
#pragma unroll
                for (int i = 0; i < 4; ++i) {
                    const float4 g = ((const float4*)p.norm_g)[lane + 64 * i];
                    uint2 w; w.x = pk2(v[u][i].x * rstd * g.x, v[u][i].y * rstd * g.y); w.y = pk2(v[u][i].z * rstd * g.z, v[u][i].w * rstd * g.w);
                    *(uint2*)(p.hb() + (size_t)row * DM + 4 * (lane + 64 * i)) = w;
                }
            }
        }
    }
    { const float* w = p.w_in; transpose_cvt(p.WinT(), NPAD, DM, [=](int n, int k) { const int c = win_src_col(n); return c < 0 ? 0.f : w[(size_t)k * CIN + c]; }); }
    { const float* w = p.w_pa; transpose_cvt(p.WpaT(), DM, 512, [=](int n, int k) { return w[(size_t)k * DM + perm8(n)]; }); }
    { const float* w = p.w_pb; transpose_cvt(p.WpbT(), DM, 512, [=](int n, int k) { return w[(size_t)k * DM + perm8(n)]; }); }
    { const float* w = p.w_out; transpose_cvt(p.WoutT(), DM, DM, [=](int n, int k) { return w[(size_t)k * DM + perm8(n)]; }); }
    { const float* w = p.w_gate; transpose_cvt(p.WgateT(), DM, DM, [=](int n, int k) { return w[(size_t)k * DM + perm8(n)]; }); }
    { const float* w = p.w_proj; transpose_cvt(p.WprojT(), DM, 256, [=](int n, int k) { return w[(size_t)k * DM + perm8(n)]; }); }
    { const float* w = p.cmp_w1; transpose_cvt(p.W1T(), 512, 1024, [=](int n, int k) { const int kvi = n >> 8, nn = n & 255; return w[(size_t)kvi * 262144 + (size_t)((nn >> 7) * 1024 + k) * 128 + (nn & 127)]; }); }
    { const float* w = p.cmp_w2; transpose_cvt(p.W2T(), 128, 128, [=](int n, int k) { return w[(size_t)(n >> 6) * 8192 + (size_t)k * 64 + (n & 63)]; }); }
    { const float* w = p.w_up; transpose_cvt(p.WupT(), 512, 64, [=](int n, int k) { return w[(size_t)k * 512 + n]; }); }
    { const float* w = p.a_up; transpose_cvt(p.AupT(), 512, 64, [=](int n, int k) { return w[(size_t)k * 512 + n]; }); }
    for (int id = gt; id < 33 * CR; id += nt) p.zs0()[id] = id < CR ? (bf16_t)0 : f2bf(p.state_shift[id - CR]);
    for (int id = gt; id < MR * 64; id += nt) {
        const int row = id >> 6, c4 = id & 63;
        const float4 v = ((const float4*)(row < NP ? p.p_prompt + (size_t)row * 256 : p.p_sample + (size_t)(row - NP) * 256))[c4];
        uint2 w; w.x = pk2(v.x, v.y); w.y = pk2(v.z, v.w);
        *(uint2*)(p.pb() + (size_t)row * 256 + c4 * 4) = w;
    }
    for (int id = gt; id < 4104 * 32; id += nt) {
        const int pi = id >> 5, i = id & 31;
        const int pos = pi < 4096 ? pi : PAST + pi - 4096;
        const float inv = (float)exp(-(double)i * (9.210340371976184 / 32.0));
        const float ang = (float)pos * inv;
        const double x = (double)ang;
        const double k = rint(x * 0.15915494309189535);
        const double r = x - k * 6.283185307179586;
        float s, c; sincos_small(r, s, c);
        p.tabc()[id] = c; p.tabs()[id] = s;
    }
    for (int o = gw; o < 256; o += nw) {
        const int kvi = o >> 7, f = o & 127;
        float acc = 0.f;
        for (int jd = lane; jd < 2048; jd += 64) acc += p.cmp_pe[kvi * 2048 + jd] * p.cmp_w1[(size_t)kvi * 262144 + (size_t)jd * 128 + f];
        acc = wave_sum(acc);
        if (lane == 0) p.pt()[o] = acc + p.cmp_b1[o];
    }
    for (int id = gt; id < DB * 504 * 64; id += nt) {
        const int c4 = id & 63, j = (id >> 6) % 504, b = (id >> 6) / 504;
        ((float4*)(p.out + O_WIN_S))[((size_t)b * 512 + j) * 64 + c4] = ((const float4*)p.cache_win)[((size_t)b * 512 + j + 8) * 64 + c4];
    }
}
#define XB_TMO      128
#define XB_XCNT(j)  (256  + 64 * (j))
#define XB_XSUB(j)  (1280 + 64 * (j))
#define XB_XGEN(j)  (2304 + 64 * (j))
#define XB_TOP      3328
#define XB_TOPGEN   3392
#define XCD_BAR_WORDS 3456
#define XB_SPIN_CAP (1u << 18)

__device__ __forceinline__ unsigned xb_ld(unsigned* p)              { return __hip_atomic_load(p, __ATOMIC_RELAXED, __HIP_MEMORY_SCOPE_AGENT); }
__device__ __forceinline__ unsigned xb_add(unsigned* p, unsigned v) { return __hip_atomic_fetch_add(p, v, __ATOMIC_RELAXED, __HIP_MEMORY_SCOPE_AGENT); }
__device__ __forceinline__ unsigned xb_xcc_id() { return (unsigned)__builtin_amdgcn_s_getreg((3 << 11) | 20) & 0xFu; }
#define XB_SPIN(cond, bar) do { unsigned _sp = 0; while (cond) { __builtin_amdgcn_s_sleep(1); \
    if ((++_sp & 255u) == 0u) { if (xb_ld(&(bar)[XB_TMO])) break; if (_sp > XB_SPIN_CAP) { atomicAdd(&(bar)[XB_TMO], 1u); break; } } } } while (0)

struct XcdBarrier {
    unsigned* bar; unsigned x;
    volatile LAS unsigned* st;
};

__device__ __forceinline__ XcdBarrier xcd_barrier_post(unsigned* bar, volatile LAS unsigned* st) {
    XcdBarrier b; b.bar = bar; b.x = xb_xcc_id(); b.st = st;
    if (threadIdx.x == 0) (void)xb_add(&bar[XB_XCNT(b.x)], 1u);
    return b;
}
__device__ __forceinline__ void xcd_barrier_complete(unsigned* bar, unsigned x, unsigned& nloc, unsigned& nx) {
    const unsigned G = gridDim.x * gridDim.y * gridDim.z;
    unsigned sum, cnt, mine, sp = 0u;
    for (;;) {
        sum = 0u; cnt = 0u; mine = 0u;
#pragma unroll
        for (unsigned j = 0; j < 16; ++j) { const unsigned c = xb_ld(&bar[XB_XCNT(j)]); sum += c; cnt += (c > 0u) ? 1u : 0u; mine = (j == x) ? c : mine; }
        if (sum == G) break;
        __builtin_amdgcn_s_sleep(1);
        if ((++sp & 255u) == 0u) { if (xb_ld(&bar[XB_TMO])) break; if (sp > XB_SPIN_CAP) { atomicAdd(&bar[XB_TMO], 1u); break; } }
    }
    nloc = mine > 0u ? mine : 1u; nx = cnt > 0u ? cnt : 1u;
}

__device__ __forceinline__ void xcd_barrier(const XcdBarrier& b) {
    asm volatile("s_waitcnt vmcnt(0)" ::: "memory");
    __syncthreads();
    if (threadIdx.x == 0) {
        unsigned* bar = b.bar;
        __builtin_amdgcn_s_waitcnt(0);
        unsigned nloc = b.st[0], nx = b.st[1];
        if (nloc == 0u) { xcd_barrier_complete(bar, b.x, nloc, nx); b.st[0] = nloc; b.st[1] = nx; }
        const unsigned old = xb_add(&bar[XB_XSUB(b.x)], 1u);
        const unsigned gen = old / nloc;
        if (old + 1u == (gen + 1u) * nloc) {
            __builtin_amdgcn_fence(__ATOMIC_RELEASE, "agent");
            asm volatile("s_waitcnt vmcnt(0)" ::: "memory");
            const unsigned og = xb_add(&bar[XB_TOP], 1u);
            const unsigned tg = og / nx;
            if (og + 1u == (tg + 1u) * nx) xb_add(&bar[XB_TOPGEN], 1u);
            else XB_SPIN(xb_ld(&bar[XB_TOPGEN]) == tg, bar);
            __builtin_amdgcn_fence(__ATOMIC_ACQUIRE, "agent");
            xb_add(&bar[XB_XGEN(b.x)], 1u);
            asm volatile("s_waitcnt vmcnt(0)" ::: "memory");
        } else {
            XB_SPIN(xb_ld(&bar[XB_XGEN(b.x)]) == gen, bar);
            __builtin_amdgcn_fence(__ATOMIC_ACQUIRE, "agent");
            asm volatile("s_waitcnt vmcnt(0)" ::: "memory");
        }
    }
    __syncthreads();
}

using pg8::Unit;
typedef unsigned u32x2 __attribute__((ext_vector_type(2)));
typedef unsigned u32x4_t __attribute__((ext_vector_type(4)));
__device__ __forceinline__ f32x16 mfma32(bf16x8 a, bf16x8 b, f32x16 c) { return __builtin_amdgcn_mfma_f32_32x32x16_bf16(a, b, c, 0, 0, 0); }
__device__ __forceinline__ bf16x8 pack8(float a0, float a1, float a2, float a3, float a4, float a5, float a6, float a7) {
    union { uint4 u; bf16x8 v; } x; x.u.x = pk2(a0, a1); x.u.y = pk2(a2, a3); x.u.z = pk2(a4, a5); x.u.w = pk2(a6, a7); return x.v;
}
__device__ __forceinline__ f32x16 zero16() { f32x16 z; for (int i = 0; i < 16; ++i) z[i] = 0.f; return z; }


__device__ __forceinline__ void st_bf4(bf16_t* dst, f32x4 v) { uint2 w; w.x = pk2(v[0], v[1]); w.y = pk2(v[2], v[3]); *(uint2*)dst = w; }

constexpr float QSCALE = 0.125f * 1.4426950408889634f;
struct EpiIn {
    static constexpr bool PERM = false, AFTER_DRAIN = false;
    P p; int row0; int pn0;
    __device__ __forceinline__ void operator()(const f32x4 (&acc)[2][2][4][2], const Unit& u, int wr, int wc, int fr, int fq) const { body<0, 2, 0, 2>(acc, u, wr, wc, fr, fq); }
    template <int AI0, int AI1, int BJ0, int BJ1>
    __device__ __forceinline__ void body(const f32x4 (&acc)[2][2][4][2], const Unit& u, int wr, int wc, int fr, int fq) const {
        const int pn = pn0 + u.pn;
#pragma unroll
        for (int ai = AI0; ai < AI1; ++ai)
#pragma unroll
            for (int m = 0; m < 4; ++m) {
                const int row = row0 + u.pm * 256 + ai * 128 + wr * 64 + m * 16 + fr;
                if (pn < 5) {
                    const int pi = row < NP ? (row & (SEQ - 1)) : 4096 + ((row - NP) & 7);
                    const int d0 = 16 * (wc & 1) + 4 * fq;
                    const f32x4 cs = *(const f32x4*)(p.tabc() + pi * 32 + d0), sn = *(const f32x4*)(p.tabs() + pi * 32 + d0);
#pragma unroll
                    for (int bj = BJ0; bj < BJ1; ++bj) {
                        const f32x4 x1 = acc[ai][bj][m][0], x2 = acc[ai][bj][m][1];
                        if (pn < 2) {
                            const int head = pn * 4 + bj * 2 + (wc >> 1);
                            const f32x4 o1 = (x1 * cs - x2 * sn) * QSCALE, o2 = (x2 * cs + x1 * sn) * QSCALE;
                            bf16_t* q = p.qb() + (size_t)row * 512 + head * 64 + d0;
                            st_bf4(q, o1); st_bf4(q + 32, o2);
                        } else {
                            const int br = pn - 2, g = wc >> 1;
                            f32x4 o1, o2;
                            if (bj == 0) { o1 = x1 * cs - x2 * sn; o2 = x2 * cs + x1 * sn; } else { o1 = x1; o2 = x2; }
                            float* dst = nullptr;
                            if (row < NP) {
                                if (br == 0) dst = p.out + O_CMP_P + (size_t)row * 256;
                                else if (br == 1) dst = p.out + O_SEL_P + (size_t)row * 256;
                                else { const int s = row & (SEQ - 1); if (s >= SEQ - 512) dst = p.out + O_WIN_P + ((size_t)(row >> 12) * 512 + (s - (SEQ - 512))) * 256; }
                            } else {
                                const int rs = row - NP;
                                if (br == 0) dst = p.out + O_CMP_S + (size_t)rs * 256;
                                else if (br == 1) dst = p.out + O_SEL_S + (size_t)rs * 256;
                                else dst = p.out + O_WIN_S + ((size_t)(rs >> 3) * 512 + 504 + (rs & 7)) * 256;
                            }
                            if (dst) { dst += bj * 128 + g * 64 + d0; *(f32x4*)dst = o1; *(f32x4*)(dst + 32) = o2; }
                            if (row < NP) {
                                const int b = row >> 12, s = row & (SEQ - 1);
                                if (bj == 0) {
                                    bf16_t* k = p.kb() + ((size_t)((br * NB + b) * 2 + g) * SEQ + s) * 64 + d0;
                                    st_bf4(k, o1); st_bf4(k + 32, o2);
                                } else if (br == 0) {
                                    bf16_t* v = p.vcr() + ((size_t)(b * 2 + g) * SEQ + s) * 64 + d0;
                                    st_bf4(v, o1); st_bf4(v + 32, o2);
                                } else {
                                    bf16_t* v = p.vT() + ((size_t)(((br - 1) * NB + b) * 2 + g) * 64 + d0) * SEQ + s;
#pragma unroll
                                    for (int e = 0; e < 4; ++e) { v[(size_t)e * SEQ] = f2bf(o1[e]); v[(size_t)(32 + e) * SEQ] = f2bf(o2[e]); }
                                }
                            }
                        }
                    }
                } else {
#pragma unroll
                    for (int bj = BJ0; bj < BJ1; ++bj) {
                        const int c = bj * 128 + wc * 32 + fq * 8;
                        const f32x4 v0 = acc[ai][bj][m][0], v1 = acc[ai][bj][m][1];
                        auto st8 = [&](bf16_t* dst, const f32x4& a, const f32x4& b) { uint4 w; w.x = pk2(a[0], a[1]); w.y = pk2(a[2], a[3]); w.z = pk2(b[0], b[1]); w.w = pk2(b[2], b[3]); *(uint4*)dst = w; };
                        if (pn < 7 || (pn >= 14 && pn < 16)) {
                            f32x4 o0, o1; for (int e = 0; e < 4; ++e) { o0[e] = silu_fast(v0[e]); o1[e] = silu_fast(v1[e]); }
                            st8((pn < 7 ? p.ag() + (size_t)row * 512 + (pn - 5) * 256 : p.rg() + (size_t)row * 512 + (pn - 14) * 256) + c, o0, o1);
                        } else if (pn < 13) {
                            st8(p.rz() + (size_t)row * CR + (pn - 7) * 256 + c, v0, v1);
                        } else if (pn == 13) {
                            if (c < 128) st8(p.rz() + (size_t)row * CR + 1536 + c, v0, v1);
                            else if (c < 152) { f32x4 o0, o1; for (int e = 0; e < 4; ++e) { o0[e] = sigmoid_fast(v0[e]); o1[e] = sigmoid_fast(v1[e]); }
                                *(f32x4*)(p.gates() + (size_t)row * 32 + (c - 128)) = o0; *(f32x4*)(p.gates() + (size_t)row * 32 + (c - 128) + 4) = o1; }
                        } else {
                            f32x4 o0, o1; for (int e = 0; e < 4; ++e) { o0[e] = sigmoid_fast(v0[e]); o1[e] = sigmoid_fast(v1[e]); }
                            st8(p.mg() + (size_t)row * 2048 + (pn - 16) * 256 + c, o0, o1);
                        }
                    }
                }
            }
    }
};

template <int AI, int BJ>
__device__ __forceinline__ void inproj_sample_quadrant(const P& p, int pn, int wid, int lane) {
    const int wr = wid >> 2, wc = wid & 3, fr = lane & 15, fq = lane >> 4;
    f32x4 acc[2][2][4][2];
#pragma unroll
    for (int m = 0; m < 4; ++m)
#pragma unroll
        for (int n = 0; n < 2; ++n) acc[AI][BJ][m][n] = (f32x4){0.f, 0.f, 0.f, 0.f};
    const bf16_t* ap = p.hb() + (size_t)(NP + AI * 128 + wr * 64 + fr) * DM + 8 * fq;
    const bf16_t* bp = p.WinT() + (size_t)(pn * 256 + BJ * 128 + wc * 32 + fr) * DM + 8 * fq;
    bf16x8 a0[4][2], b0[2][2], a1[4][2], b1[2][2];
    auto ld = [&](bf16x8 (&a)[4][2], bf16x8 (&b)[2][2], int k0) {
#pragma unroll
        for (int i = 0; i < 2; ++i) {
#pragma unroll
            for (int m = 0; m < 4; ++m) a[m][i] = *(const bf16x8*)(ap + (size_t)m * 16 * DM + k0 + 32 * i);
#pragma unroll
            for (int n = 0; n < 2; ++n) b[n][i] = *(const bf16x8*)(bp + (size_t)n * 16 * DM + k0 + 32 * i);
        }
    };
    auto mma = [&](const bf16x8 (&a)[4][2], const bf16x8 (&b)[2][2]) {
#pragma unroll
        for (int i = 0; i < 2; ++i)
#pragma unroll
            for (int m = 0; m < 4; ++m)
#pragma unroll
                for (int n = 0; n < 2; ++n) acc[AI][BJ][m][n] = __builtin_amdgcn_mfma_f32_16x16x32_bf16(b[n][i], a[m][i], acc[AI][BJ][m][n], 0, 0, 0);
    };
    ld(a0, b0, 0);
#pragma unroll 1
    for (int k0 = 0; k0 < DM; k0 += 128) {
        ld(a1, b1, k0 + 64);
        mma(a0, b0);
        if (k0 + 128 < DM) ld(a0, b0, k0 + 128);
        mma(a1, b1);
    }
    EpiIn e; e.p = p; e.row0 = 0; e.pn0 = 0;
    Unit u; u.pm = NP / 256; u.pn = pn;
    e.template body<AI, AI + 1, BJ, BJ + 1>(acc, u, wr, wc, fr, fq);
}
__device__ __forceinline__ void ph_inproj_sample(const P& p) {
    if ((int)blockIdx.x >= 96) return;
    const int wid = threadIdx.x >> 6, lane = threadIdx.x & 63, pn = blockIdx.x >> 2;
    switch (blockIdx.x & 3) {
        case 0: inproj_sample_quadrant<0, 0>(p, pn, wid, lane); break;
        case 1: inproj_sample_quadrant<0, 1>(p, pn, wid, lane); break;
        case 2: inproj_sample_quadrant<1, 0>(p, pn, wid, lane); break;
        default: inproj_sample_quadrant<1, 1>(p, pn, wid, lane); break;
    }
}

struct EpiPlain {
    static constexpr bool PERM = false, AFTER_DRAIN = false;
    float* C; int ldc; int pad_;
    __device__ __forceinline__ void quad(int row, int c, f32x4 v) const { *(f32x4*)(C + (size_t)row * ldc + c) = v; }
    __device__ __forceinline__ void operator()(const f32x4 (&acc)[2][2][4][2], const Unit& u, int wr, int wc, int fr, int fq) const {
#pragma unroll
        for (int ai = 0; ai < 2; ++ai)
#pragma unroll
            for (int m = 0; m < 4; ++m) {
                float* rowp = C + (size_t)(u.pm * 256 + ai * 128 + wr * 64 + m * 16 + fr) * ldc + u.pn * 256 + wc * 32 + 8 * fq;
#pragma unroll
                for (int bj = 0; bj < 2; ++bj)
#pragma unroll
                    for (int n = 0; n < 2; ++n) *(f32x4*)(rowp + bj * 128 + n * 4) = acc[ai][bj][m][n];
            }
    }
};


struct EpiPlainBf {
    static constexpr bool PERM = false, AFTER_DRAIN = false;
    bf16_t* C; int ldc; int pad_;
    __device__ __forceinline__ void operator()(const f32x4 (&acc)[2][2][4][2], const Unit& u, int wr, int wc, int fr, int fq) const {
#pragma unroll
        for (int ai = 0; ai < 2; ++ai)
#pragma unroll
            for (int m = 0; m < 4; ++m) {
                bf16_t* rowp = C + (size_t)(u.pm * 256 + ai * 128 + wr * 64 + m * 16 + fr) * ldc + u.pn * 256 + wc * 32 + 4 * fq;
#pragma unroll
                for (int bj = 0; bj < 2; ++bj)
#pragma unroll
                    for (int n = 0; n < 2; ++n) st_bf4(rowp + bj * 128 + n * 16, acc[ai][bj][m][n]);
            }
    }
};

struct EpiYa {
    static constexpr bool PERM = false, AFTER_DRAIN = false;
    P p;
    __device__ __forceinline__ void quad(int row, int c, f32x4 v) const {
        const uint2 gw = *(const uint2*)(p.mg() + (size_t)row * 2048 + c);
        f32x4 g; g[0] = __uint_as_float(gw.x << 16); g[1] = __uint_as_float(gw.x & 0xffff0000u); g[2] = __uint_as_float(gw.y << 16); g[3] = __uint_as_float(gw.y & 0xffff0000u);
        *(f32x4*)(p.tmp() + (size_t)row * DM + c) = g * v;
    }
    __device__ __forceinline__ void operator()(const f32x4 (&acc)[2][2][4][2], const Unit& u, int wr, int wc, int fr, int fq) const {
#pragma unroll
        for (int ai = 0; ai < 2; ++ai)
#pragma unroll
            for (int m = 0; m < 4; ++m) {
                const int row = u.pm * 256 + ai * 128 + wr * 64 + m * 16 + fr;
#pragma unroll
                for (int bj = 0; bj < 2; ++bj)
#pragma unroll
                    for (int n = 0; n < 2; ++n) {
                        const int c = u.pn * 256 + bj * 128 + wc * 32 + fq * 8 + n * 4;
                        const uint2 gw = *(const uint2*)(p.mg() + (size_t)row * 2048 + c);
                        f32x4 g; g[0] = __uint_as_float(gw.x << 16); g[1] = __uint_as_float(gw.x & 0xffff0000u); g[2] = __uint_as_float(gw.y << 16); g[3] = __uint_as_float(gw.y & 0xffff0000u);
                        *(f32x4*)(p.tmp() + (size_t)row * DM + c) = g * acc[ai][bj][m][n];
                    }
            }
    }
};
struct EpiYb {
    static constexpr bool PERM = false, AFTER_DRAIN = false;
    P p;
    __device__ __forceinline__ void quad(int row, int c, f32x4 v) const {
        const uint2 gw = *(const uint2*)(p.mg() + (size_t)row * 2048 + 1024 + c);
        f32x4 g; g[0] = __uint_as_float(gw.x << 16); g[1] = __uint_as_float(gw.x & 0xffff0000u); g[2] = __uint_as_float(gw.y << 16); g[3] = __uint_as_float(gw.y & 0xffff0000u);
        st_bf4(p.mb() + (size_t)row * DM + c, *(const f32x4*)(p.tmp() + (size_t)row * DM + c) + g * v);
    }
    __device__ __forceinline__ void operator()(const f32x4 (&acc)[2][2][4][2], const Unit& u, int wr, int wc, int fr, int fq) const {
#pragma unroll
        for (int ai = 0; ai < 2; ++ai)
#pragma unroll
            for (int m = 0; m < 4; ++m) {
                const int row = u.pm * 256 + ai * 128 + wr * 64 + m * 16 + fr;
#pragma unroll
                for (int bj = 0; bj < 2; ++bj)
#pragma unroll
                    for (int n = 0; n < 2; ++n) {
                        const int c = u.pn * 256 + bj * 128 + wc * 32 + fq * 8 + n * 4;
                        const uint2 gw = *(const uint2*)(p.mg() + (size_t)row * 2048 + 1024 + c);
                        f32x4 g; g[0] = __uint_as_float(gw.x << 16); g[1] = __uint_as_float(gw.x & 0xffff0000u); g[2] = __uint_as_float(gw.y << 16); g[3] = __uint_as_float(gw.y & 0xffff0000u);
                        const f32x4 t = *(const f32x4*)(p.tmp() + (size_t)row * DM + c);
                        st_bf4(p.mb() + (size_t)row * DM + c, t + g * acc[ai][bj][m][n]);
                    }
            }
    }
};
struct EpiOut {
    static constexpr bool PERM = false, AFTER_DRAIN = false;
    P p;
    __device__ __forceinline__ void quad(int row, int c, f32x4 a) const {
        const float* xr = p.x_sample + (size_t)(row - NP) * DM;
        const f32x4 v = *(const f32x4*)(xr + c) + a;
        *(f32x4*)(p.x1() + (size_t)row * DM + c) = v;
        st_bf4(p.xg() + (size_t)row * DM + c, v * *(const f32x4*)(p.ple_g + c));
        atomicAdd(p.ss_s() + (row - NP), v[0] * v[0] + v[1] * v[1] + v[2] * v[2] + v[3] * v[3]);
    }
    __device__ __forceinline__ void operator()(const f32x4 (&acc)[2][2][4][2], const Unit& u, int wr, int wc, int fr, int fq) const {
#pragma unroll
        for (int ai = 0; ai < 2; ++ai)
#pragma unroll
            for (int m = 0; m < 4; ++m) {
                const int row = u.pm * 256 + ai * 128 + wr * 64 + m * 16 + fr;
                const float* xr = row < NP ? p.x_prompt + (size_t)row * DM : p.x_sample + (size_t)(row - NP) * DM;
                float ss = 0.f;
#pragma unroll
                for (int bj = 0; bj < 2; ++bj)
#pragma unroll
                    for (int n = 0; n < 2; ++n) {
                        const int c = u.pn * 256 + bj * 128 + wc * 32 + fq * 8 + n * 4;
                        const f32x4 v = *(const f32x4*)(xr + c) + acc[ai][bj][m][n];
                        *(f32x4*)(p.x1() + (size_t)row * DM + c) = v;
                        ss += v[0] * v[0] + v[1] * v[1] + v[2] * v[2] + v[3] * v[3];
                        st_bf4(p.xg() + (size_t)row * DM + c, v * *(const f32x4*)(p.ple_g + c));
                    }
                ss += __shfl_xor(ss, 16); ss += __shfl_xor(ss, 32);
                if (fq == 0) p.ss1()[(size_t)row * 16 + u.pn * 4 + wc] = ss;
            }
    }
};
struct EpiGate {
    static constexpr bool PERM = false, AFTER_DRAIN = false;
    P p;
    __device__ __forceinline__ void quad(int row, int c, f32x4 acc) const {
        const float rstd = rsqrtf(p.ss_s()[row - NP] * (1.0f / DM) + 1e-6f);
        const f32x4 a = acc * rstd;
        f32x4 g; for (int e = 0; e < 4; ++e) g[e] = sigmoidf_(a[e]);
        float* ppp = p.pp() + (size_t)row * DM + c;
        *(f32x4*)ppp = *(const f32x4*)(p.x1() + (size_t)row * DM + c) + g * *(const f32x4*)ppp;
    }
    __device__ __forceinline__ void operator()(const f32x4 (&acc)[2][2][4][2], const Unit& u, int wr, int wc, int fr, int fq) const {
#pragma unroll
        for (int ai = 0; ai < 2; ++ai)
#pragma unroll
            for (int m = 0; m < 4; ++m) {
                const int row = u.pm * 256 + ai * 128 + wr * 64 + m * 16 + fr;
                float ss = 0.f;
#pragma unroll
                for (int i = 0; i < 4; ++i) { const f32x4 t = *(const f32x4*)(p.ss1() + (size_t)row * 16 + i * 4); ss += (t[0] + t[1]) + (t[2] + t[3]); }
                const float rstd = rsqrtf(ss * (1.0f / DM) + 1e-6f);
#pragma unroll
                for (int bj = 0; bj < 2; ++bj)
#pragma unroll
                    for (int n = 0; n < 2; ++n) {
                        const int c = u.pn * 256 + bj * 128 + wc * 32 + fq * 8 + n * 4;
                        const f32x4 a = acc[ai][bj][m][n] * rstd;
                        f32x4 g; for (int e = 0; e < 4; ++e) g[e] = sigmoidf_(a[e]);
                        float* ppp = p.pp() + (size_t)row * DM + c;
                        *(f32x4*)ppp = *(const f32x4*)(p.x1() + (size_t)row * DM + c) + g * *(const f32x4*)ppp;
                    }
            }
    }
};

__device__ __forceinline__ void ph_final(const P& p) {
    const int tid = threadIdx.x, lane = tid & 63, wid = tid >> 6;
    const int nw = gridDim.x * 8;
    for (int row0 = blockIdx.x * 8 + wid; row0 < MR; row0 += 2 * nw) {
        float4 v[2][4]; float ss[2];
#pragma unroll
        for (int u = 0; u < 2; ++u) {
            const int row = row0 + u * nw < MR ? row0 + u * nw : row0;
            const float4* src = (const float4*)(p.pp() + (size_t)row * DM);
            ss[u] = 0.f;
#pragma unroll
            for (int i = 0; i < 4; ++i) { v[u][i] = src[lane + 64 * i]; ss[u] += v[u][i].x * v[u][i].x + v[u][i].y * v[u][i].y + v[u][i].z * v[u][i].z + v[u][i].w * v[u][i].w; }
        }
#pragma unroll
        for (int u = 0; u < 2; ++u) {
            const int row = row0 + u * nw;
            const float tot = wave_sum(ss[u]);
            const float rstd = rsqrtf(tot * (1.0f / DM) + 1e-6f);
            if (row < MR) {
                float4* dst = (float4*)(p.out + (row < NP ? O_Y_P + (size_t)row * DM : O_Y_S + (size_t)(row - NP) * DM));
#pragma unroll
                for (int i = 0; i < 4; ++i) {
                    const float4 g = ((const float4*)p.final_g)[lane + 64 * i];
                    float4 o; o.x = v[u][i].x * rstd * g.x; o.y = v[u][i].y * rstd * g.y; o.z = v[u][i].z * rstd * g.z; o.w = v[u][i].w * rstd * g.w;
                    dst[lane + 64 * i] = o;
                }
            }
        }
    }
}

typedef float f32x4v __attribute__((ext_vector_type(4)));
template <class Epi> __device__ __forceinline__ void small_gemm(const bf16_t* A, const bf16_t* Bt, int K, const Epi& E) {
    const int tid = threadIdx.x, lane = tid & 63, wid = tid >> 6, r16 = lane & 15, q4 = lane >> 4;
    for (int tile = blockIdx.x * 8 + wid; tile < 16 * 64; tile += gridDim.x * 8) {
        const int rt = tile & 15, ct = tile >> 4;
        const bf16_t* ap = A + (size_t)(NP + rt * 16 + r16) * K + 8 * q4;
        const bf16_t* bp = Bt + (size_t)(ct * 16 + r16) * K + 8 * q4;
        f32x4 acc = {0.f, 0.f, 0.f, 0.f};
#pragma unroll 1
        for (int k0 = 0; k0 < K; k0 += 256) {
            bf16x8 af[8], bf[8];
#pragma unroll
            for (int i = 0; i < 8; ++i) { af[i] = *(const bf16x8*)(ap + k0 + 32 * i); bf[i] = *(const bf16x8*)(bp + k0 + 32 * i); }
#pragma unroll
            for (int i = 0; i < 8; ++i) acc = __builtin_amdgcn_mfma_f32_16x16x32_bf16(bf[i], af[i], acc, 0, 0, 0);
        }
        E.quad(NP + rt * 16 + r16, (ct >> 1) * 32 + 8 * q4 + 4 * (ct & 1), acc);
    }
}

__device__ __forceinline__ f32x4 ld_bf4c(const bf16_t* q) { const uint2 w = *(const uint2*)q; f32x4 v; v[0] = __uint_as_float(w.x << 16); v[1] = __uint_as_float(w.x & 0xffff0000u); v[2] = __uint_as_float(w.y << 16); v[3] = __uint_as_float(w.y & 0xffff0000u); return v; }
__device__ __forceinline__ void compress2_tile(const P& p, const bf16_t* LH, int nbg, int nrows, int nblk, bf16_t* kc, bf16_t* vcT, int kvi, int bg, int tile, int lane, LAS unsigned char* wlds) {
    const int col = lane & 31, hb = lane >> 5;
    {
        const int i = tile * 32 + col;
        const bool live = i < nblk;
        const bf16_t* lbase = LH + ((size_t)kvi * nbg * nrows + (size_t)bg * nrows) * 256;
        const bf16_t* w2t = p.W2T() + (size_t)kvi * 64 * 128;
        LAS bf16_t* hs = (LAS bf16_t*)wlds;
        {
            const int rq = lane >> 4, c8 = lane & 15;
            const f32x4 pa = *(const f32x4*)(p.pt() + kvi * 128 + c8 * 8), pb = *(const f32x4*)(p.pt() + kvi * 128 + c8 * 8 + 4);
#pragma unroll
            for (int it = 0; it < 8; ++it) {
                const int rr = 4 * it + rq, gi = tile * 32 + rr;
                const bf16_t* rp = lbase + (size_t)(gi < nblk ? gi : 0) * 256 + c8 * 8;
                const uint4 lo = *(const uint4*)rp, hi = *(const uint4*)(rp + 256 + 128);
                float hv[8];
                const unsigned lw[4] = {lo.x, lo.y, lo.z, lo.w}, hw[4] = {hi.x, hi.y, hi.z, hi.w};
#pragma unroll
                for (int e = 0; e < 4; ++e) {
                    const float pe0 = e < 2 ? pa[2 * e] : pb[2 * e - 4], pe1 = e < 2 ? pa[2 * e + 1] : pb[2 * e - 3];
                    hv[2 * e] = siluf_(__uint_as_float(lw[e] << 16) + __uint_as_float(hw[e] << 16) + pe0);
                    hv[2 * e + 1] = siluf_(__uint_as_float(lw[e] & 0xffff0000u) + __uint_as_float(hw[e] & 0xffff0000u) + pe1);
                }
                *(LAS bf16x8*)(hs + rr * 136 + c8 * 8) = pack8(hv[0], hv[1], hv[2], hv[3], hv[4], hv[5], hv[6], hv[7]);
            }
        }
        WAVE_SYNC();
        f32x16 acc[2]; acc[0] = zero16(); acc[1] = zero16();
#pragma unroll
        for (int ks = 0; ks < 8; ++ks) {
            const int f = 16 * ks + 8 * hb;
            const bf16x8 hf = *(LAS const bf16x8*)(hs + col * 136 + f);
#pragma unroll
            for (int dt = 0; dt < 2; ++dt) {
                const bf16x8 wf = *(const bf16x8*)(w2t + (size_t)(32 * dt + col) * 128 + f);
                acc[dt] = (kvi == 0) ? mfma32(wf, hf, acc[dt]) : mfma32(hf, wf, acc[dt]);
            }
        }
        WAVE_SYNC();
        if (kvi == 0) {
            bf16_t* dst = kc + ((size_t)bg * nrows + i) * 64;
#pragma unroll
            for (int dt = 0; dt < 2; ++dt)
#pragma unroll
                for (int i4 = 0; i4 < 4; ++i4) {
                    const int d = 32 * dt + 8 * i4 + 4 * hb;
                    const f32x4 b2 = *(const f32x4*)(p.cmp_b2 + d);
                    f32x4 v; for (int e = 0; e < 4; ++e) v[e] = live ? acc[dt][4 * i4 + e] + b2[e] : 0.f;
                    st_bf4(dst + d, v);
                }
        } else {
#pragma unroll
            for (int dt = 0; dt < 2; ++dt) {
                const int d = 32 * dt + col;
                const float b2 = p.cmp_b2[64 + d];
                bf16_t* dst = vcT + ((size_t)bg * 64 + d) * nrows + tile * 32;
#pragma unroll
                for (int i4 = 0; i4 < 4; ++i4) {
                    const int r = 8 * i4 + 4 * hb;
                    f32x4 v; for (int e = 0; e < 4; ++e) v[e] = (tile * 32 + r + e) < nblk ? acc[dt][4 * i4 + e] + b2 : 0.f;
                    st_bf4(dst + r, v);
                }
            }
        }
    }
}

__device__ __forceinline__ void ph_compress2(const P& p, const bf16_t* LH, int nbg, int nrows, int nblk, bf16_t* kc, bf16_t* vcT, LAS unsigned char* lds) {
    const int tid = threadIdx.x, lane = tid & 63, wid = tid >> 6;
    const int ntile = nrows >> 5, total = 2 * nbg * ntile;
    for (int it = blockIdx.x * 8 + wid; it < total; it += gridDim.x * 8)
        compress2_tile(p, LH, nbg, nrows, nblk, kc, vcT, it / (ntile * nbg), (it / ntile) % nbg, it % ntile, lane, lds + wid * 8960);
}


__device__ __forceinline__ float dpp_row_sum16(float v) {
    v += __builtin_bit_cast(float, __builtin_amdgcn_mov_dpp(__builtin_bit_cast(int, v), 0xB1, 0xF, 0xF, true));
    v += __builtin_bit_cast(float, __builtin_amdgcn_mov_dpp(__builtin_bit_cast(int, v), 0x4E, 0xF, 0xF, true));
    v += __builtin_bit_cast(float, __builtin_amdgcn_mov_dpp(__builtin_bit_cast(int, v), 0x141, 0xF, 0xF, true));
    v += __builtin_bit_cast(float, __builtin_amdgcn_mov_dpp(__builtin_bit_cast(int, v), 0x140, 0xF, 0xF, true));
    return v;
}
__device__ __forceinline__ float tanh_fast(float x) { const float e = __expf(2.0f * x); return 1.0f - 2.0f / (e + 1.0f); }
__device__ __forceinline__ float half_sum32(float v) { return xsum16(dpp_row_sum16(v)); }
__device__ __forceinline__ const bf16_t* rwkv_prev_row(const P& p, int row) {
    if (row < NP) return (row & (SEQ - 1)) == 0 ? p.zs0() : p.rz() + (size_t)(row - 1) * CR;
    const int rs = row - NP;
    return (rs & 7) == 0 ? p.zs0() + (size_t)(1 + (rs >> 3)) * CR : p.rz() + (size_t)(row - 1) * CR;
}
__device__ __forceinline__ f32x4 ld_bf4(const bf16_t* q) { const uint2 w = *(const uint2*)q; f32x4 v; v[0] = __uint_as_float(w.x << 16); v[1] = __uint_as_float(w.x & 0xffff0000u); v[2] = __uint_as_float(w.y << 16); v[3] = __uint_as_float(w.y & 0xffff0000u); return v; }
__device__ __forceinline__ void ph_rwkv_prep(const P& p) {
    const int tid = threadIdx.x, lane = tid & 63, wid = tid >> 6, col = lane & 31, hb = lane >> 5;
    const int gw = blockIdx.x * 8 + wid, nw = gridDim.x * 8;
    for (int it = gw; it < NB + DB; it += nw) {
        const int row = it < NB ? it * SEQ + SEQ - 1 : NP + (it - NB) * 8 + 7;
        float* so = it < NB ? p.out + O_SH_P + (size_t)it * CR : p.out + O_SH_S + (size_t)(it - NB) * CR;
        const bf16_t* z = p.rz() + (size_t)row * CR;
        for (int i = lane; i < CR; i += 64) so[i] = bf2f(z[i]);
    }
    for (int rnd = 0; rnd < 3; ++rnd) {
        int it;
        if (rnd == 0) it = gw;
        else if ((int)blockIdx.x < 16) break;
        else if (rnd == 1) it = nw + (gw - 128);
        else { if (wid != 0 || (int)blockIdx.x >= 208) break; it = 2 * nw - 128 + ((int)blockIdx.x - 16); }
        if (it >= (MR / 32) * 8) break;
        const int h = it & 7, r0 = (it >> 3) * 32;
        bf16x8 Aw[4], Aa[4];
        {
            const int row = r0 + col;
            const bf16_t* z = p.rz() + (size_t)row * CR;
            const bf16_t* pv = rwkv_prev_row(p, row);
#pragma unroll
            for (int ks = 0; ks < 4; ++ks) {
                const int j0 = 16 * ks + 8 * hb;
                float tw[8], ta[8];
#pragma unroll
                for (int q = 0; q < 2; ++q) {
                    const f32x4 zw = ld_bf4(z + 1536 + j0 + 4 * q), za = ld_bf4(z + 1600 + j0 + 4 * q);
                    const f32x4 pw = ld_bf4(pv + 1536 + j0 + 4 * q), pa = ld_bf4(pv + 1600 + j0 + 4 * q);
                    const f32x4 mw = *(const f32x4*)(p.mu + 1536 + j0 + 4 * q), ma = *(const f32x4*)(p.mu + 1600 + j0 + 4 * q);
#pragma unroll
                    for (int e = 0; e < 4; ++e) { tw[4 * q + e] = tanh_fast(zw[e] + (pw[e] - zw[e]) * mw[e]); ta[4 * q + e] = za[e] + (pa[e] - za[e]) * ma[e]; }
                }
                Aw[ks] = pack8(tw[0], tw[1], tw[2], tw[3], tw[4], tw[5], tw[6], tw[7]);
                Aa[ks] = pack8(ta[0], ta[1], ta[2], ta[3], ta[4], ta[5], ta[6], ta[7]);
            }
        }
        f32x16 accw[2], acca[2];
#pragma unroll
        for (int ct = 0; ct < 2; ++ct) {
            accw[ct] = zero16(); acca[ct] = zero16();
            const size_t wo = (size_t)(h * 64 + 32 * ct + col) * 64 + 8 * hb;
#pragma unroll
            for (int ks = 0; ks < 4; ++ks) {
                accw[ct] = mfma32(Aw[ks], *(const bf16x8*)(p.WupT() + wo + 16 * ks), accw[ct]);
                acca[ct] = mfma32(Aa[ks], *(const bf16x8*)(p.AupT() + wo + 16 * ks), acca[ct]);
            }
        }
        float w0v[2], a0v[2], kkv[2], kav[2], rkv[2], mur[2], muk[2], muv[2];
#pragma unroll
        for (int ct = 0; ct < 2; ++ct) {
            const int c = h * 64 + 32 * ct + col;
            w0v[ct] = p.w0[c]; a0v[ct] = p.a0[c]; kkv[ct] = p.k_k[c]; kav[ct] = p.k_a[c]; rkv[ct] = p.r_k[c];
            mur[ct] = p.mu[c]; muk[ct] = p.mu[512 + c]; muv[ct] = p.mu[1024 + c];
        }
#pragma unroll
        for (int hf = 0; hf < 2; ++hf) {
        float zz[8][2][3], pz[2][2][3];
#pragma unroll
        for (int ii = 0; ii < 8; ++ii) {
            const int i = 8 * hf + ii;
            const bf16_t* z = p.rz() + (size_t)(r0 + (i & 3) + 8 * (i >> 2) + 4 * hb) * CR + h * 64 + col;
#pragma unroll
            for (int ct = 0; ct < 2; ++ct) { zz[ii][ct][0] = bf2f(z[32 * ct]); zz[ii][ct][1] = bf2f(z[512 + 32 * ct]); zz[ii][ct][2] = bf2f(z[1024 + 32 * ct]); }
        }
#pragma unroll
        for (int g2 = 0; g2 < 2; ++g2) {
            const bf16_t* pv = rwkv_prev_row(p, r0 + 8 * (2 * hf + g2) + 4 * hb) + h * 64 + col;
#pragma unroll
            for (int ct = 0; ct < 2; ++ct) { pz[g2][ct][0] = bf2f(pv[32 * ct]); pz[g2][ct][1] = bf2f(pv[512 + 32 * ct]); pz[g2][ct][2] = bf2f(pv[1024 + 32 * ct]); }
        }
#pragma unroll
        for (int ii = 0; ii < 8; ++ii) {
            const int i = 8 * hf + ii;
            const int row = r0 + (i & 3) + 8 * (i >> 2) + 4 * hb;
            float zr[2], zk[2], zv[2], dec[2], av[2], kkr[2], km[2];
            float n2 = 0.f, bon = 0.f;
#pragma unroll
            for (int ct = 0; ct < 2; ++ct) {
                const float z0 = zz[ii][ct][0], z1 = zz[ii][ct][1], z2 = zz[ii][ct][2];
                const int ip = ii > 0 ? ii - 1 : 0;
                const float p0 = (i & 3) ? zz[ip][ct][0] : pz[ii >> 2][ct][0], p1 = (i & 3) ? zz[ip][ct][1] : pz[ii >> 2][ct][1], p2 = (i & 3) ? zz[ip][ct][2] : pz[ii >> 2][ct][2];
                zr[ct] = z0 + (p0 - z0) * mur[ct]; zk[ct] = z1 + (p1 - z1) * muk[ct]; zv[ct] = z2 + (p2 - z2) * muv[ct];
                const float nx = -(w0v[ct] + accw[ct][i]);
                const float sp = fmaxf(nx, 0.f) + __logf(1.0f + __expf(-fabsf(nx)));
                dec[ct] = __expf(-__expf(-sp - 0.5f));
                av[ct] = sigmoidf_(a0v[ct] + acca[ct][i]);
                kkr[ct] = zk[ct] * kkv[ct];
                km[ct] = zk[ct] * (1.0f + (av[ct] - 1.0f) * kav[ct]);
                n2 += kkr[ct] * kkr[ct];
                bon += zr[ct] * km[ct] * rkv[ct];
            }
            n2 = half_sum32(n2); bon = half_sum32(bon);
            const float rn = 1.0f / fmaxf(sqrtf(n2), 1e-12f);
            unsigned char* o = p.rw6() + ((size_t)row * 8 + h) * RW6_STRIDE;
#pragma unroll
            for (int ct = 0; ct < 2; ++ct) {
                const float kk = kkr[ct] * rn;
                const int cl = 32 * ct + col;
                ((float*)o)[cl] = dec[ct];
                bf16_t* ob = (bf16_t*)(o + 256) + cl;
                ob[0] = f2bf(zr[ct]); ob[64] = f2bf(km[ct]); ob[128] = f2bf(zv[ct]); ob[192] = f2bf(kk); ob[256] = f2bf(kk * av[ct]);
            }
            if (col == 0) p.bonus()[(size_t)row * 8 + h] = bon;
        }
        }
    }
}

typedef float f32x2 __attribute__((ext_vector_type(2)));
__device__ __forceinline__ float dpp_row_sum(float v) {
    v += __builtin_bit_cast(float, __builtin_amdgcn_mov_dpp(__builtin_bit_cast(int, v), 0xB1, 0xF, 0xF, true));
    v += __builtin_bit_cast(float, __builtin_amdgcn_mov_dpp(__builtin_bit_cast(int, v), 0x4E, 0xF, 0xF, true));
    v += __builtin_bit_cast(float, __builtin_amdgcn_mov_dpp(__builtin_bit_cast(int, v), 0x141, 0xF, 0xF, true));
    v += __builtin_bit_cast(float, __builtin_amdgcn_mov_dpp(__builtin_bit_cast(int, v), 0x140, 0xF, 0xF, true));
    return v;
}
constexpr int SCAN_TC = 32;
template <int NROWS>
__device__ __forceinline__ void scan_item(const P& p, LAS float* lds, int row0, int T, int h, int half, const float* s0, float* sout) {
    const int tid = threadIdx.x, w = tid >> 6, lane = tid & 63, rl = lane >> 4, kq = lane & 15;
    const bool act = w * 4 < NROWS;
    const int vrow = half * NROWS + (act ? w * 4 : 0) + rl;
    f32x4 S;
    if (s0) S = *(const f32x4*)(s0 + vrow * 64 + kq * 4); else { S[0] = 0.f; S[1] = 0.f; S[2] = 0.f; S[3] = 0.f; }
    const unsigned char* src = p.rw6() + ((size_t)row0 * 8 + h) * RW6_STRIDE;
    const int nchunk = (T + SCAN_TC - 1) / SCAN_TC;
    u32x4_t stg[4];
    int ss[4], sc[4], sl[4];
#pragma unroll
    for (int i = 0; i < 4; ++i) {
        const int idx = i * 512 + tid; ss[i] = idx / 56; sc[i] = idx % 56;
        const int cb = sc[i] - 16, q = cb >> 3;
        sl[i] = sc[i] < 16 ? 64 + 4 * sc[i] : (q == 0 ? 0 : 64 + 64 * q) + 8 * (cb & 7);
    }
    auto put = [&](LAS float* b, int i) {
        LAS float* d = b + ss[i] * 384 + sl[i];
        if (sc[i] < 16) *(LAS u32x4_t*)d = stg[i];
        else {
            f32x4 lo, hi;
            lo[0] = __uint_as_float(stg[i][0] << 16); lo[1] = __uint_as_float(stg[i][0] & 0xffff0000u); lo[2] = __uint_as_float(stg[i][1] << 16); lo[3] = __uint_as_float(stg[i][1] & 0xffff0000u);
            hi[0] = __uint_as_float(stg[i][2] << 16); hi[1] = __uint_as_float(stg[i][2] & 0xffff0000u); hi[2] = __uint_as_float(stg[i][3] << 16); hi[3] = __uint_as_float(stg[i][3] & 0xffff0000u);
            *(LAS f32x4*)d = lo; *(LAS f32x4*)(d + 4) = hi;
        }
    };
    {
        const int ns = T < SCAN_TC ? T : SCAN_TC;
#pragma unroll
        for (int i = 0; i < 4; ++i) if (ss[i] < ns) { stg[i] = *(const u32x4_t*)(src + (size_t)ss[i] * (8 * RW6_STRIDE) + sc[i] * 16); put(lds, i); }
    }
    __syncthreads();
    for (int c = 0; c < nchunk; ++c) {
        const int t0 = c * SCAN_TC;
        const int ns = (T - t0) < SCAN_TC ? (T - t0) : SCAN_TC;
        const bool more = (c + 1) < nchunk;
        const int nns = more ? ((T - t0 - SCAN_TC) < SCAN_TC ? (T - t0 - SCAN_TC) : SCAN_TC) : 0;
        if (more) {
#pragma unroll
            for (int i = 0; i < 4; ++i) if (ss[i] < nns) stg[i] = *(const u32x4_t*)(src + (size_t)(t0 + SCAN_TC + ss[i]) * (8 * RW6_STRIDE) + sc[i] * 16);
        }
        LAS const float* buf = lds + (c & 1) * (SCAN_TC * 384);
        float* yo = p.ybuf() + (size_t)(row0 + t0) * 512 + h * 64 + vrow;
        if (act)
#pragma unroll 4
        for (int s = 0; s < ns; ++s) {
            LAS const float* bs = buf + s * 384 + kq * 4;
            const f32x4 r = *(LAS const f32x4*)(bs), d = *(LAS const f32x4*)(bs + 64), km = *(LAS const f32x4*)(bs + 128),
                        kk = *(LAS const f32x4*)(bs + 256), ka = *(LAS const f32x4*)(bs + 320);
            const float vv = buf[s * 384 + 192 + vrow];
            const f32x4 t1 = S * kk;
            float sa = dpp_row_sum((t1[0] + t1[1]) + (t1[2] + t1[3]));
            sa = -sa;
            S = S * d + ka * sa + km * vv;
            const f32x4 t2 = S * r;
            const float y = dpp_row_sum((t2[0] + t2[1]) + (t2[2] + t2[3]));
            if (kq == 0) yo[(size_t)s * 512] = y;
        }
        if (more) {
            LAS float* nb = lds + ((c + 1) & 1) * (SCAN_TC * 384);
#pragma unroll
            for (int i = 0; i < 4; ++i) if (ss[i] < nns) put(nb, i);
        }
        __syncthreads();
    }
    if (act) *(f32x4*)(sout + vrow * 64 + kq * 4) = S;
}
struct ScanVec { f32x4 r, d, km, kk, ka; float vv; };
__device__ __forceinline__ void scan_ld(ScanVec& v, LAS const float* bs, LAS const float* bv) {
    v.kk = *(LAS const f32x4*)(bs + 256); v.d = *(LAS const f32x4*)(bs + 64); v.ka = *(LAS const f32x4*)(bs + 320);
    v.km = *(LAS const f32x4*)(bs + 128); v.vv = *bv; v.r = *(LAS const f32x4*)(bs);
}
__device__ __forceinline__ float scan_step(f32x4& S, const ScanVec& v) {
    const f32x4 t1 = S * v.kk;
    const float sa = -dpp_row_sum((t1[0] + t1[2]) + (t1[1] + t1[3]));
    S = S * v.d + v.ka * sa + v.km * v.vv;
    const f32x4 t2 = S * v.r;
    return dpp_row_sum((t2[0] + t2[2]) + (t2[1] + t2[3]));
}
__device__ __forceinline__ void scan_prompt(const P& p, LAS float* lds, int row0, int h, int part, float* sout) {
    const int tid = threadIdx.x, w = tid >> 6, lane = tid & 63, rl = lane >> 4, kq = lane & 15;
    const bool act = w < 4;
    const int vrow = part * 16 + (act ? w * 4 : 0) + rl;
    f32x4 S;
    S[0] = 0.f; S[1] = 0.f; S[2] = 0.f; S[3] = 0.f;
    const unsigned char* src = p.rw6() + ((size_t)row0 * 8 + h) * RW6_STRIDE;
    constexpr int nchunk = SEQ / SCAN_TC;
    u32x4_t stg[4];
    int ss[4], sc[4], sl[4];
#pragma unroll
    for (int i = 0; i < 4; ++i) {
        const int idx = i * 512 + tid; ss[i] = idx / 56; sc[i] = idx % 56;
        const int cb = sc[i] - 16, q = cb >> 3;
        sl[i] = sc[i] < 16 ? 64 + 4 * sc[i] : (q == 0 ? 0 : 64 + 64 * q) + 8 * (cb & 7);
    }
    auto put = [&](LAS float* b, int i) {
        LAS float* d = b + ss[i] * 384 + sl[i];
        if (sc[i] < 16) *(LAS u32x4_t*)d = stg[i];
        else {
            f32x4 lo, hi;
            lo[0] = __uint_as_float(stg[i][0] << 16); lo[1] = __uint_as_float(stg[i][0] & 0xffff0000u); lo[2] = __uint_as_float(stg[i][1] << 16); lo[3] = __uint_as_float(stg[i][1] & 0xffff0000u);
            hi[0] = __uint_as_float(stg[i][2] << 16); hi[1] = __uint_as_float(stg[i][2] & 0xffff0000u); hi[2] = __uint_as_float(stg[i][3] << 16); hi[3] = __uint_as_float(stg[i][3] & 0xffff0000u);
            *(LAS f32x4*)d = lo; *(LAS f32x4*)(d + 4) = hi;
        }
    };
#pragma unroll
    for (int i = 0; i < 4; ++i) if (ss[i] < SCAN_TC) { stg[i] = *(const u32x4_t*)(src + (size_t)ss[i] * (8 * RW6_STRIDE) + sc[i] * 16); put(lds, i); }
    __syncthreads();
#pragma unroll 1
    for (int c = 0; c < nchunk; ++c) {
        const int t0 = c * SCAN_TC;
        const bool more = (c + 1) < nchunk;
        if (more) {
#pragma unroll
            for (int i = 0; i < 4; ++i) if (ss[i] < SCAN_TC) stg[i] = *(const u32x4_t*)(src + (size_t)(t0 + SCAN_TC + ss[i]) * (8 * RW6_STRIDE) + sc[i] * 16);
        }
        LAS const float* buf = lds + (c & 1) * (SCAN_TC * 384);
        if (act) {
            LAS const float* bk = buf + kq * 4;
            LAS const float* bv = buf + 192 + vrow;
            float* yo = p.ybuf() + (size_t)(row0 + t0 + kq) * 512 + h * 64 + vrow;
            ScanVec A, B;
            scan_ld(A, bk, bv);
            float ysel = 0.f;
#pragma unroll
            for (int s = 0; s < SCAN_TC; s += 2) {
                scan_ld(B, bk + (s + 1) * 384, bv + (s + 1) * 384);
                __builtin_amdgcn_sched_barrier(0);
                { const float y = scan_step(S, A); ysel = (kq == (s & 15)) ? y : ysel; }
                if (s + 2 < SCAN_TC) scan_ld(A, bk + (s + 2) * 384, bv + (s + 2) * 384);
                __builtin_amdgcn_sched_barrier(0);
                { const float y = scan_step(S, B); ysel = (kq == ((s + 1) & 15)) ? y : ysel; }
                if (((s + 1) & 15) == 15) yo[(size_t)(s >> 4) * 16 * 512] = ysel;
            }
        }
        if (more) {
            LAS float* nb = lds + ((c + 1) & 1) * (SCAN_TC * 384);
#pragma unroll
            for (int i = 0; i < 4; ++i) if (ss[i] < SCAN_TC) put(nb, i);
        }
        __syncthreads();
    }
    if (act) *(f32x4*)(sout + vrow * 64 + kq * 4) = S;
}
constexpr int NSCAN = 128;
__device__ __forceinline__ void ph_rwkv_scan(const P& p, LAS float* lds) {
    if ((int)blockIdx.x < NSCAN) {
        const int item = blockIdx.x >> 2, part = blockIdx.x & 3;
        scan_prompt(p, lds, (item >> 3) * SEQ, item & 7, part, p.out + O_WKV_P + (size_t)item * 4096);
    } else {
        const int nb = (int)gridDim.x - NSCAN;
        for (int hi = (int)blockIdx.x - NSCAN; hi < 512; hi += nb) {
            const int item = hi >> 1, half = hi & 1;
            scan_item<32>(p, lds, NP + (item >> 3) * 8, 8, item & 7, half, p.state_wkv + (size_t)item * 4096, p.out + O_WKV_S + (size_t)item * 4096);
        }
    }
}

__device__ __forceinline__ void ph_rwkv_post(const P& p) {
    const int tid = threadIdx.x, lane = tid & 63, wid = tid >> 6;
    const int stride = gridDim.x * 8;
    const int first = blockIdx.x * 8 + wid, c = (first & 7) * 64 + lane;
    const float gg = p.gn_g[c], gb = p.gn_b[c];
    for (int it0 = first; it0 < MR * 8; it0 += 4 * stride) {
        float y[4], bon[4], vv[4], rg[4];
#pragma unroll
        for (int u = 0; u < 4; ++u) {
            const int it = it0 + u * stride < MR * 8 ? it0 + u * stride : it0, row = it >> 3;
            y[u] = p.ybuf()[(size_t)row * 512 + c];
            bon[u] = p.bonus()[it];
            vv[u] = bf2f(((const bf16_t*)(p.rw6() + (size_t)it * RW6_STRIDE + 256))[128 + lane]);
            rg[u] = bf2f(p.rg()[(size_t)row * 512 + c]);
        }
#pragma unroll
        for (int u = 0; u < 4; ++u) {
            const int it = it0 + u * stride, row = it >> 3;
            const float s1 = wave_sum(y[u]), s2 = wave_sum(y[u] * y[u]);
            const float mean = s1 * (1.0f / 64.0f);
            const float var = fmaxf(s2 * (1.0f / 64.0f) - mean * mean, 0.f);
            const float dv = y[u] - mean;
            float yn = dv * rsqrtf(var + 64e-5f) * gg + gb;
            yn += bon[u] * vv[u];
            if (it < MR * 8) p.ob()[(size_t)row * 512 + c] = f2bf(yn * rg[u]);
        }
    }
}

__device__ __forceinline__ void ph_cmp_gemm_f32(const P& p, LAS unsigned char* lds) {
    using pg8::lds_byte;
    const int tid = threadIdx.x, wid = __builtin_amdgcn_readfirstlane(tid >> 6), lane = tid & 63, wr = wid >> 2, wc = wid & 3, fr = lane & 15, fq = lane >> 4;
    constexpr int HTB = 16384;
    const int arow_l = 4 * wid + (lane >> 4), acol = 4 * (lane & 15);
    const int swbase = lds_byte(arow_l, acol);
    LAS unsigned long long* rowoff = (LAS unsigned long long*)(lds + 131072);
    unsigned voffB[2];
#pragma unroll
    for (int i = 0; i < 2; ++i) { int R, C; pg8::stage_rc(tid * 16 + i * 8192, R, C); voffB[i] = (unsigned)(R * 1024 + C) * 2u; }
    const unsigned ldsw = (unsigned)wid * 1024u;
    const int aoff = lds_byte(wr * 64 + fr, fq * 8), boff = lds_byte(wc * 32 + fr, fq * 8);
    for (int unit = blockIdx.x; unit < 512; unit += gridDim.x) {
        const int kvi = unit >> 8, bg = (unit >> 2) & 63, c0 = (unit & 3) * 256, b = bg >> 1, g = bg & 1;
        __syncthreads();
        if (tid < 256) {
            const int chunk = c0 + tid;
            const int page = p.page_table[b * 128 + (chunk >> 3)];
            rowoff[tid] = ((unsigned long long)page * 128 + (chunk & 7) * 16) * 256 + kvi * 128 + g * 64;
        }
        const char* bbase = (const char*)(p.W1T() + (size_t)kvi * 256 * 1024);
        f32x4 acc[2][2][4][2];
#pragma unroll
        for (int a = 0; a < 2; ++a)
#pragma unroll
            for (int bb = 0; bb < 2; ++bb)
#pragma unroll
                for (int m = 0; m < 4; ++m)
#pragma unroll
                    for (int n = 0; n < 2; ++n) acc[a][bb][m][n] = (f32x4){0.f, 0.f, 0.f, 0.f};
        f32x4 ar[8];
        auto stage_b = [&](int st, int t) {
#pragma unroll
            for (int h = 0; h < 2; ++h)
#pragma unroll
                for (int i = 0; i < 2; ++i)
                    __builtin_amdgcn_global_load_lds((const unsigned*)(bbase + (size_t)h * 128 * 2048 + (size_t)t * 128 + voffB[i]),
                                                     (PG8_LAS unsigned*)(lds + st * 65536 + 32768 + h * HTB + ldsw + i * 8192), 16, 0, 0);
        };
        auto load_a = [&](int t) {
#pragma unroll
            for (int q = 0; q < 8; ++q) ar[q] = *(const f32x4*)(p.cache_cmp + rowoff[32 * q + arow_l] + (size_t)t * 256 + acol);
        };
        auto write_a = [&](int st) {
            LAS unsigned char* na = lds + st * 65536;
#pragma unroll
            for (int q = 0; q < 8; ++q) *(LAS u32x2*)(na + swbase + (q >> 2) * HTB + (q & 3) * 4096) = (u32x2){pk2(ar[q][0], ar[q][1]), pk2(ar[q][2], ar[q][3])};
        };
        __syncthreads();
        load_a(0);
        stage_b(0, 0);
        write_a(0);
        __syncthreads();
#pragma unroll 1
        for (int t = 0; t < 16; ++t) {
            const int cur = t & 1;
            if (t + 1 < 16) { load_a(t + 1); stage_b(cur ^ 1, t + 1); }
            LAS const unsigned char* sa = lds + cur * 65536;
            LAS const unsigned char* sb = sa + 32768;
#pragma unroll
            for (int ai = 0; ai < 2; ++ai)
#pragma unroll
                for (int bj = 0; bj < 2; ++bj) {
                    bf16x8 Bt[2][2];
#pragma unroll
                    for (int n = 0; n < 2; ++n)
#pragma unroll
                        for (int k = 0; k < 2; ++k) Bt[n][k] = *(LAS const bf16x8*)(sb + bj * HTB + boff + n * 2048 + k * 1024);
#pragma unroll
                    for (int m = 0; m < 4; ++m) {
                        const bf16x8 a0 = *(LAS const bf16x8*)(sa + ai * HTB + aoff + m * 2048), a1 = *(LAS const bf16x8*)(sa + ai * HTB + aoff + m * 2048 + 1024);
#pragma unroll
                        for (int n = 0; n < 2; ++n) {
                            acc[ai][bj][m][n] = __builtin_amdgcn_mfma_f32_16x16x32_bf16(Bt[n][0], a0, acc[ai][bj][m][n], 0, 0, 0);
                            acc[ai][bj][m][n] = __builtin_amdgcn_mfma_f32_16x16x32_bf16(Bt[n][1], a1, acc[ai][bj][m][n], 0, 0, 0);
                        }
                    }
                    __builtin_amdgcn_sched_barrier(0);
                }
            if (t + 1 < 16) write_a(cur ^ 1);
            __syncthreads();
        }
        EpiPlainBf e; e.C = p.LHs() + ((size_t)kvi * 65536 + (size_t)bg * 1024 + c0) * 256; e.ldc = 256; e.pad_ = 0;
        pg8::Unit u; u.pm = 0; u.pn = 0;
        e(acc, u, wr, wc, fr, fq);
    }
}

__device__ __forceinline__ float exp2_(float x) { return __builtin_amdgcn_exp2f(x); }
template <class OKF>
__device__ __forceinline__ void sm_stats(const f32x16& s, int hb, OKF ok, float& m, float& l) {
    float sv[16]; float tmax = -1e30f; unsigned okm = 0;
#pragma unroll
    for (int i = 0; i < 16; ++i) { const int kl = (i & 3) + 8 * (i >> 2) + 4 * hb; const bool k = ok(kl); okm |= (k ? 1u : 0u) << i; sv[i] = k ? s[i] : -1e30f; tmax = fmaxf(tmax, sv[i]); }
    tmax = fmaxf(tmax, __shfl_xor(tmax, 32));
    const float mn = fmaxf(m, tmax), alpha = exp2_(m - mn); m = mn;
    float ps = 0.f;
#pragma unroll
    for (int i = 0; i < 16; ++i) ps += ((okm >> i) & 1u) ? exp2_(sv[i] - mn) : 0.f;
    l = l * alpha + ps;
}
template <class OKF, class VF>
__device__ __forceinline__ void sm_pv(const f32x16& s, int hb, OKF ok, VF vf, float& m, float& l, f32x16 (&o)[2]) {
    float sv[16]; float tmax = -1e30f; unsigned okm = 0;
#pragma unroll
    for (int i = 0; i < 16; ++i) { const int kl = (i & 3) + 8 * (i >> 2) + 4 * hb; const bool k = ok(kl); okm |= (k ? 1u : 0u) << i; sv[i] = k ? s[i] : -1e30f; tmax = fmaxf(tmax, sv[i]); }
    tmax = fmaxf(tmax, __shfl_xor(tmax, 32));
    const float mn = fmaxf(m, tmax), alpha = exp2_(m - mn); m = mn;
    float pr[16]; float ps = 0.f;
#pragma unroll
    for (int i = 0; i < 16; ++i) { pr[i] = ((okm >> i) & 1u) ? exp2_(sv[i] - mn) : 0.f; ps += pr[i]; }
    l = l * alpha + ps;
    o[0] *= alpha; o[1] *= alpha;
#pragma unroll
    for (int s2 = 0; s2 < 2; ++s2) {
        const bf16x8 pb = pack8(pr[8 * s2 + 0], pr[8 * s2 + 1], pr[8 * s2 + 2], pr[8 * s2 + 3], pr[8 * s2 + 4], pr[8 * s2 + 5], pr[8 * s2 + 6], pr[8 * s2 + 7]);
#pragma unroll
        for (int dt = 0; dt < 2; ++dt) o[dt] = mfma32(vf(dt, s2), pb, o[dt]);
    }
}
template <class VF>
__device__ __forceinline__ void sm_pv_nomask(const f32x16& s, bool csel, VF vf, float& m, float& l, f32x16 (&o)[2]) {
    float tmax = fmaxf(fmaxf(s[0], s[1]), s[2]);
#pragma unroll
    for (int i = 3; i < 16; ++i) tmax = fmaxf(tmax, s[i]);
    tmax = csel ? tmax : -1e30f;
    tmax = fmaxf(tmax, __shfl_xor(tmax, 32));
    const float mn = fmaxf(m, tmax), alpha = exp2_(m - mn); m = mn;
    float pr[16]; float ps = 0.f;
#pragma unroll
    for (int i = 0; i < 16; ++i) { pr[i] = csel ? exp2_(s[i] - mn) : 0.f; ps += pr[i]; }
    l = l * alpha + ps;
    o[0] *= alpha; o[1] *= alpha;
#pragma unroll
    for (int s2 = 0; s2 < 2; ++s2) {
        const bf16x8 pb = pack8(pr[8 * s2 + 0], pr[8 * s2 + 1], pr[8 * s2 + 2], pr[8 * s2 + 3], pr[8 * s2 + 4], pr[8 * s2 + 5], pr[8 * s2 + 6], pr[8 * s2 + 7]);
#pragma unroll
        for (int dt = 0; dt < 2; ++dt) o[dt] = mfma32(vf(dt, s2), pb, o[dt]);
    }
}
template <class OKF, class VF>
__device__ __forceinline__ void cmp_pass2(const f32x16& s, int hb, OKF ok, VF vf, float m, float inv, f32x16 (&o)[2], LAS float* prow, bool writer) {
    float pr[16];
#pragma unroll
    for (int i = 0; i < 16; ++i) {
        const int kl = (i & 3) + 8 * (i >> 2) + 4 * hb;
        pr[i] = ok(kl) ? exp2_(s[i] - m) * inv : 0.f;
        float q = pr[i] + __shfl_xor(pr[i], 1); q += __shfl_xor(q, 2);
        if (writer) prow[kl] = q;
    }
#pragma unroll
    for (int s2 = 0; s2 < 2; ++s2) {
        const bf16x8 pb = pack8(pr[8 * s2 + 0], pr[8 * s2 + 1], pr[8 * s2 + 2], pr[8 * s2 + 3], pr[8 * s2 + 4], pr[8 * s2 + 5], pr[8 * s2 + 6], pr[8 * s2 + 7]);
#pragma unroll
        for (int dt = 0; dt < 2; ++dt) o[dt] = mfma32(vf(dt, s2), pb, o[dt]);
    }
}

__device__ __forceinline__ void attn_store(const P& p, const f32x16 (&of)[2], int qrow, int head, int hb, bool doit, bf16_t* oadst = nullptr) {
    if (!oadst) oadst = p.oa();
    if (!doit) return;
#pragma unroll
    for (int dt = 0; dt < 2; ++dt)
#pragma unroll
        for (int i4 = 0; i4 < 4; ++i4) {
            const int d = 32 * dt + 8 * i4 + 4 * hb;
            const size_t off = (size_t)qrow * 512 + head * 64 + d;
            const uint2 gw = *(const uint2*)(p.ag() + off);
            f32x4 v;
            v[0] = of[dt][4 * i4 + 0] * __uint_as_float(gw.x << 16); v[1] = of[dt][4 * i4 + 1] * __uint_as_float(gw.x & 0xffff0000u);
            v[2] = of[dt][4 * i4 + 2] * __uint_as_float(gw.y << 16); v[3] = of[dt][4 * i4 + 3] * __uint_as_float(gw.y & 0xffff0000u);
            st_bf4(oadst + off, v);
        }
}


__device__ __forceinline__ void of_put(LAS float* st, int lane, const f32x16 (&o)[2], float sc) {
#pragma unroll
    for (int dt = 0; dt < 2; ++dt)
#pragma unroll
        for (int i = 0; i < 16; ++i) st[(dt * 16 + i) * 64 + lane] = o[dt][i] * sc;
}
__device__ __forceinline__ void of_add(LAS float* st, int lane, const f32x16 (&o)[2], float sc) {
#pragma unroll
    for (int dt = 0; dt < 2; ++dt)
#pragma unroll
        for (int i = 0; i < 16; ++i) st[(dt * 16 + i) * 64 + lane] += o[dt][i] * sc;
}
__device__ __forceinline__ void of_get_add(LAS float* st, int lane, const f32x16 (&o)[2], float sc, f32x16 (&of)[2]) {
#pragma unroll
    for (int dt = 0; dt < 2; ++dt)
#pragma unroll
        for (int i = 0; i < 16; ++i) of[dt][i] = st[(dt * 16 + i) * 64 + lane] + o[dt][i] * sc;
}


constexpr int WL_STRIDE = 15360, KV_OFF = 8 * WL_STRIDE, KV_BUF = 17920, XB_OFF = KV_OFF + 2 * KV_BUF;

struct LoadBf16 {
    const bf16_t* kbase; const bf16_t* vbase; int ld; bool with_v; u32x4_t kr[2], vr[2];
    static constexpr int DEPTH = 2;
    __device__ __forceinline__ void load(int n, int slot) {
        const int tid = threadIdx.x, srow = tid >> 3, sch = tid & 7;
        const u32x4_t k = *(const u32x4_t*)(kbase + (size_t)(64 * n + srow) * 64 + sch * 8);
        u32x4_t v = k;
        if (with_v) v = *(const u32x4_t*)(vbase + (size_t)srow * ld + 64 * n + sch * 8);
        if (slot) { kr[1] = k; vr[1] = v; } else { kr[0] = k; vr[0] = v; }
    }
    __device__ __forceinline__ void store(LAS unsigned char* buf, int slot) const {
        const int tid = threadIdx.x, srow = tid >> 3, sch = tid & 7;
        const u32x4_t k = slot ? kr[1] : kr[0], v = slot ? vr[1] : vr[0];
        *(LAS u32x4_t*)(buf + srow * 144 + sch * 16) = k;
        if (with_v) { LAS u32x2* vp = (LAS u32x2*)(buf + 9216 + srow * 136 + sch * 16); vp[0] = (u32x2){v[0], v[1]}; vp[1] = (u32x2){v[2], v[3]}; }
    }
};
struct LoadWinF32 {
    const float* cw; const float* nw; f32x4 k0, k1, v0, v1;
    static constexpr int DEPTH = 1;
    __device__ __forceinline__ void load(int n, int) {
        const int tid = threadIdx.x, srow = tid >> 3, sch = tid & 7;
        const int j = 64 * n + srow;
        const float* r = j < 512 ? cw + (size_t)j * 256 : nw + (size_t)(j - 512 < 8 ? j - 512 : 7) * 256;
        k0 = *(const f32x4*)(r + sch * 8); k1 = *(const f32x4*)(r + sch * 8 + 4);
        v0 = *(const f32x4*)(r + 128 + sch * 8); v1 = *(const f32x4*)(r + 128 + sch * 8 + 4);
    }
    __device__ __forceinline__ void store(LAS unsigned char* buf, int) const {
        const int tid = threadIdx.x, srow = tid >> 3, sch = tid & 7;
        u32x4_t kw; kw[0] = pk2(k0[0], k0[1]); kw[1] = pk2(k0[2], k0[3]); kw[2] = pk2(k1[0], k1[1]); kw[3] = pk2(k1[2], k1[3]);
        *(LAS u32x4_t*)(buf + srow * 144 + sch * 16) = kw;
        LAS bf16_t* vb = (LAS bf16_t*)(buf + 9216) + (sch * 8) * 68 + srow;
#pragma unroll
        for (int e = 0; e < 4; ++e) { vb[e * 68] = f2bf(v0[e]); vb[(4 + e) * 68] = f2bf(v1[e]); }
    }
};

template <class LOADER, class NEXT, class ACTIVE, class BODY>
__device__ __forceinline__ void block_loop_g(LOADER ld, LAS unsigned char* kv, int first, NEXT next, ACTIVE active, BODY body) {
    if (first < 0) return;
    int n = first, cur = 0;
    if (LOADER::DEPTH == 2) {
        int nn = next(n), k = 0;
        ld.load(n, 0); ld.store(kv, 0);
        if (nn >= 0) ld.load(nn, 1);
        __syncthreads();
#pragma unroll 1
        for (;;) {
            const int nnn = nn >= 0 ? next(nn) : -1;
            if (nnn >= 0) ld.load(nnn, k & 1);
            if (active(n)) body(n, (LAS const bf16_t*)(kv + cur * KV_BUF), (LAS const bf16_t*)(kv + cur * KV_BUF + 9216));
            if (nn >= 0) ld.store(kv + (cur ^ 1) * KV_BUF, (k + 1) & 1);
            __syncthreads();
            if (nn < 0) break;
            cur ^= 1; n = nn; nn = nnn; ++k;
        }
    } else {
        ld.load(n, 0);
        ld.store(kv, 0);
        __syncthreads();
#pragma unroll 1
        for (;;) {
            const int nn = next(n);
            if (nn >= 0) ld.load(nn, 0);
            if (active(n)) body(n, (LAS const bf16_t*)(kv + cur * KV_BUF), (LAS const bf16_t*)(kv + cur * KV_BUF + 9216));
            if (nn >= 0) ld.store(kv + (cur ^ 1) * KV_BUF, 0);
            __syncthreads();
            if (nn < 0) break;
            cur ^= 1; n = nn;
        }
    }
}
template <bool WITH_V, class NEXT, class ACTIVE, class BODY>
__device__ __forceinline__ void block_loop(const bf16_t* kbase, const bf16_t* vbase, int ld, LAS unsigned char* kv, int first, NEXT next, ACTIVE active, BODY body) {
    LoadBf16 L; L.kbase = kbase; L.vbase = vbase; L.ld = ld; L.with_v = WITH_V;
    block_loop_g(L, kv, first, next, active, body);
}
__device__ __forceinline__ bf16x8 lds_kfrag(LAS const bf16_t* kb, int kt, int ks, int col, int hb) { return *(LAS const bf16x8*)(kb + (32 * kt + col) * 72 + 16 * ks + 8 * hb); }
__device__ __forceinline__ bf16x8 lds_vfrag(LAS const bf16_t* vb, int kt, int dt, int s2, int col, int hb) {
    LAS const bf16_t* ptr = vb + (32 * dt + col) * 68 + 32 * kt + 16 * s2 + 4 * hb;
    union { u32x4_t u; bf16x8 v; } x; const u32x2 a = *(LAS const u32x2*)ptr, c = *(LAS const u32x2*)(ptr + 8); x.u[0] = a[0]; x.u[1] = a[1]; x.u[2] = c[0]; x.u[3] = c[1]; return x.v;
}
__device__ __forceinline__ f32x16 lds_qk(const bf16x8 (&qf)[4], LAS const bf16_t* kb, int kt, int col, int hb) {
    f32x16 s = zero16();
#pragma unroll
    for (int ks = 0; ks < 4; ++ks) s = mfma32(lds_kfrag(kb, kt, ks, col, hb), qf[ks], s);
    return s;
}

__device__ __forceinline__ void attn_prompt_block(const P& p, int bg, int j, LAS unsigned char* lds) {
    int tid_l = threadIdx.x; asm volatile("" : "+v"(tid_l));
    const int tid = tid_l, lane = tid & 63, wid = __builtin_amdgcn_readfirstlane(tid >> 6);
    const int b = bg >> 1, g = bg & 1;
    const int col = lane & 31, hb = lane >> 5, tl = col >> 2, hh = col & 3;
    const int t0 = 64 * j + 8 * wid, qpos = t0 + tl, qrow = b * SEQ + qpos, head = g * 4 + hh;
    LAS unsigned char* wl = lds + wid * WL_STRIDE;
    LAS unsigned char* kv = lds + KV_OFF;
    LAS float* psum = (LAS float*)wl;
    LAS unsigned long long* msk = (LAS unsigned long long*)(wl + 8192);
    bf16x8 qf[4];
#pragma unroll
    for (int ks = 0; ks < 4; ++ks) qf[ks] = *(const bf16x8*)(p.qb() + (size_t)qrow * 512 + head * 64 + 16 * ks + 8 * hb);
    const float g0 = p.gates()[(size_t)qrow * 32 + head * 3 + 0], g1 = p.gates()[(size_t)qrow * 32 + head * 3 + 1], g2 = p.gates()[(size_t)qrow * 32 + head * 3 + 2];
    f32x16 oc[2]; oc[0] = zero16(); oc[1] = zero16();
    {
        const int cmb = 64 * j + 63 - 31;
        const int nbc = ((cmb >> 4) >> 6) + 1;
        const int cmw = t0 + 7 - 31;
        const int cmaxw = cmw >= 0 ? (cmw >> 4) : -1;
        const bf16_t* kc = p.kc_p() + (size_t)bg * 256 * 64;
        const bf16_t* vc = p.vcT_p() + (size_t)bg * 64 * 256;
        float m = -1e30f, l = 0.f;
        block_loop<false>(kc, vc, 256, kv, 0, [&](int n) { return n + 1 < nbc ? n + 1 : -1; }, [&](int n) { return cmaxw >= 64 * n; },
            [&](int n, LAS const bf16_t* kb, LAS const bf16_t* vb) {
#pragma unroll 1
                for (int kt = 0; kt < 2; ++kt) {
                    const f32x16 s = lds_qk(qf, kb, kt, col, hb);
                    sm_stats(s, hb, [&](int kl) { return 16 * (64 * n + 32 * kt + kl) + 31 <= qpos; }, m, l);
                }
            });
        l += __shfl_xor(l, 32);
        const float inv = l > 0.f ? 1.0f / l : 0.f;
#pragma unroll
        for (int i = 0; i < 32; ++i) psum[i * 64 + lane] = 0.f;
        WAVE_SYNC();
        block_loop<true>(kc, vc, 256, kv, 0, [&](int n) { return n + 1 < nbc ? n + 1 : -1; }, [&](int n) { return cmaxw >= 64 * n; },
            [&](int n, LAS const bf16_t* kb, LAS const bf16_t* vb) {
#pragma unroll 1
                for (int kt = 0; kt < 2; ++kt) {
                    const f32x16 s = lds_qk(qf, kb, kt, col, hb);
                    cmp_pass2(s, hb, [&](int kl) { return 16 * (64 * n + 32 * kt + kl) + 31 <= qpos; }, [&](int dt, int s2) { return lds_vfrag(vb, kt, dt, s2, col, hb); }, m, inv, oc,
                              psum + tl * 256 + 64 * n + 32 * kt, hh == 0);
                }
            });
    }
    WAVE_SYNC();
    unsigned long long umw = 0;
    for (int t2 = 0; t2 < 8; ++t2) {
        const int t = t0 + t2, cur = t >> 6, n = lane;
        float imp = 0.f;
#pragma unroll
        for (int c = -1; c < 4; ++c) { const int cc = 4 * n + c; if (cc >= 0) imp += psum[t2 * 256 + cc]; }
        if (n == 0 || n == cur || n == cur - 1) imp = 1e4f;
        if (n * 64 > t) imp = -1.0f;
        int rank = 0;
#pragma unroll
        for (int jj = 0; jj < 64; ++jj) {
            const float vj = __uint_as_float(__builtin_amdgcn_readlane(__float_as_uint(imp), jj));
            rank += (vj > imp || (vj == imp && jj < n)) ? 1 : 0;
        }
        const unsigned long long mk = __ballot(rank < 16);
        if (lane == 0) msk[t2] = mk;
        umw |= mk;
    }
    if (lane == 0) msk[8] = umw;
    __syncthreads();
    const unsigned long long mymask = msk[tl];
    unsigned long long umb = 0;
#pragma unroll
    for (int w2 = 0; w2 < 8; ++w2) umb |= *(LAS const unsigned long long*)(lds + w2 * WL_STRIDE + 8192 + 64);
    {
        const unsigned lo = __builtin_amdgcn_readfirstlane((unsigned)umb), hi = __builtin_amdgcn_readfirstlane((unsigned)(umb >> 32));
        umb = ((unsigned long long)hi << 32) | lo;
        if (j < 63) umb &= (2ull << j) - 1ull;
    }
    LAS float* ost = (LAS float*)wl;
    of_put(ost, lane, oc, g0);
    {
        const bf16_t* kbs = p.kb() + (size_t)((1 * NB + b) * 2 + g) * SEQ * 64;
        const bf16_t* vbs = p.vT() + (size_t)((0 * NB + b) * 2 + g) * 64 * SEQ;
        float m = -1e30f, l = 0.f; f32x16 o[2]; o[0] = zero16(); o[1] = zero16();
        block_loop<true>(kbs, vbs, SEQ, kv, umb ? (int)__builtin_ctzll(umb) : -1,
            [&](int n) { if (n >= 63) return -1; const unsigned long long rem = umb >> (n + 1); return rem ? n + 1 + (int)__builtin_ctzll(rem) : -1; },
            [&](int n) { return (bool)((umw >> n) & 1ull); },
            [&](int n, LAS const bf16_t* kb, LAS const bf16_t* vb) {
                const bool bsel = (mymask >> n) & 1ull;
#pragma unroll
                for (int kt = 0; kt < 2; ++kt) {
                    const int tok0 = 64 * n + 32 * kt;
                    const f32x16 s = lds_qk(qf, kb, kt, col, hb);
                    if (n < j) sm_pv_nomask(s, bsel, [&](int dt, int s2) { return lds_vfrag(vb, kt, dt, s2, col, hb); }, m, l, o);
                    else sm_pv(s, hb, [&](int kl) { return bsel && (tok0 + kl <= qpos); }, [&](int dt, int s2) { return lds_vfrag(vb, kt, dt, s2, col, hb); }, m, l, o);
                }
            });
        l += __shfl_xor(l, 32);
        const float sc = l > 0.f ? g1 / l : 0.f;
        of_add(ost, lane, o, sc);
    }
    {
        const bf16_t* kbw = p.kb() + (size_t)((2 * NB + b) * 2 + g) * SEQ * 64;
        const bf16_t* vbw = p.vT() + (size_t)((1 * NB + b) * 2 + g) * 64 * SEQ;
        float m = -1e30f, l = 0.f; f32x16 o[2]; o[0] = zero16(); o[1] = zero16();
        block_loop<true>(kbw, vbw, SEQ, kv, j > 8 ? j - 8 : 0, [&](int n) { return n < j ? n + 1 : -1; }, [&](int n) { return true; },
            [&](int n, LAS const bf16_t* kb, LAS const bf16_t* vb) {
#pragma unroll 1
                for (int kt = 0; kt < 2; ++kt) {
                    const int tok0 = 64 * n + 32 * kt;
                    const f32x16 s = lds_qk(qf, kb, kt, col, hb);
                    if (n < j && n > j - 8) sm_pv_nomask(s, true, [&](int dt, int s2) { return lds_vfrag(vb, kt, dt, s2, col, hb); }, m, l, o);
                    else sm_pv(s, hb, [&](int kl) { const int key = tok0 + kl; return key <= qpos && key + 511 >= qpos; }, [&](int dt, int s2) { return lds_vfrag(vb, kt, dt, s2, col, hb); }, m, l, o);
                }
            });
        l += __shfl_xor(l, 32);
        const float sc = l > 0.f ? g2 / l : 0.f;
        f32x16 of[2];
        of_get_add(ost, lane, o, sc, of);
        attn_store(p, of, qrow, head, hb, true);
    }
    __syncthreads();
}

__device__ __forceinline__ void attn_sample_block(const P& p, int bg, LAS unsigned char* lds) {
    int tid_l = threadIdx.x; asm volatile("" : "+v"(tid_l));
    const int tid = tid_l, lane = tid & 63, wid = __builtin_amdgcn_readfirstlane(tid >> 6);
    const int b = bg >> 1, g = bg & 1, t = wid;
    const int col = lane & 31, hb = lane >> 5, hh = col & 3;
    const int qrow = NP + b * 8 + t, head = g * 4 + hh;
    LAS unsigned char* wl = lds + wid * WL_STRIDE;
    LAS unsigned char* kv = lds + KV_OFF;
    bf16x8 qf[4];
#pragma unroll
    for (int ks = 0; ks < 4; ++ks) qf[ks] = *(const bf16x8*)(p.qb() + (size_t)qrow * 512 + head * 64 + 16 * ks + 8 * hb);
    LAS float* psum = (LAS float*)wl;
    LAS int* list = (LAS int*)(wl + 8256);
    LAS float* impl = (LAS float*)(wl + 8448);
    LAS bf16_t* vt = (LAS bf16_t*)(wl + 9728);
    const float g0 = p.gates()[(size_t)qrow * 32 + head * 3 + 0], g1 = p.gates()[(size_t)qrow * 32 + head * 3 + 1], g2 = p.gates()[(size_t)qrow * 32 + head * 3 + 2];
    f32x16 oc[2]; oc[0] = zero16(); oc[1] = zero16();
    {
        const bf16_t* kc = p.kc_s() + (size_t)bg * 1024 * 64;
        const bf16_t* vc = p.vcT_s() + (size_t)bg * 64 * 1024;
        float m = -1e30f, l = 0.f;
        block_loop<false>(kc, vc, 1024, kv, 0, [&](int n) { return n < 15 ? n + 1 : -1; }, [&](int n) { return true; },
            [&](int n, LAS const bf16_t* kb, LAS const bf16_t* vb) {
#pragma unroll 1
                for (int kt = 0; kt < 2; ++kt) {
                    const f32x16 s = lds_qk(qf, kb, kt, col, hb);
                    sm_stats(s, hb, [&](int kl) { return 64 * n + 32 * kt + kl <= 1022; }, m, l);
                }
            });
        l += __shfl_xor(l, 32);
        const float inv = l > 0.f ? 1.0f / l : 0.f;
        block_loop<true>(kc, vc, 1024, kv, 0, [&](int n) { return n < 15 ? n + 1 : -1; }, [&](int n) { return true; },
            [&](int n, LAS const bf16_t* kb, LAS const bf16_t* vb) {
#pragma unroll 1
                for (int kt = 0; kt < 2; ++kt) {
                    const f32x16 s = lds_qk(qf, kb, kt, col, hb);
                    cmp_pass2(s, hb, [&](int kl) { return 64 * n + 32 * kt + kl <= 1022; }, [&](int dt, int s2) { return lds_vfrag(vb, kt, dt, s2, col, hb); }, m, inv, oc,
                              psum + 64 * n + 32 * kt, col == 0);
                }
            });
    }
    WAVE_SYNC();
#pragma unroll
    for (int j = 0; j < 5; ++j) {
        const int n = lane + 64 * j;
        if (n <= 256) {
            float imp = 0.f;
            for (int c = -1; c < 4; ++c) { const int cc = 4 * n + c; if (cc >= 0 && cc <= 1022) imp += psum[cc]; }
            impl[n] = imp;
        }
    }
    WAVE_SYNC();
    {
        int base = 0;
#pragma unroll
        for (int j = 0; j < 4; ++j) {
            const int n = lane + 64 * j;
            const bool cand = n >= 1 && n <= 254;
            const float v = impl[n];
            int rank = 0;
            for (int q = 1; q <= 254; ++q) { const float vq = impl[q]; rank += (vq > v || (vq == v && q < n)) ? 1 : 0; }
            const bool sel = cand && rank < 13;
            const unsigned long long mk = __ballot(sel);
            if (sel) list[base + __popcll(mk & ((1ull << lane) - 1ull))] = n;
            base += __popcll(mk);
        }
        if (lane == 0) { list[13] = 0; list[14] = 255; list[15] = 256; }
    }
    WAVE_SYNC();
    if (lane < 16) {
        const int n = list[lane];
        list[16 + lane] = n < 256 ? p.page_table[b * 128 + (n >> 1)] * 128 + (n & 1) * 64 : -1;
    }
    WAVE_SYNC();
    LAS float* ost = (LAS float*)wl;
    of_put(ost, lane, oc, g0);
    {
        float m = -1e30f, l = 0.f; f32x16 o[2]; o[0] = zero16(); o[1] = zero16();
        const float* newrows = p.out + O_SEL_S + (size_t)(b * 8) * 256 + g * 64;
        auto rowptr = [&](int u) -> const float* {
            const int rb = __builtin_amdgcn_readfirstlane(list[16 + (u >> 1)]);
            return rb >= 0 ? p.cache_sel + ((size_t)rb + 32 * (u & 1) + col) * 256 + g * 64 : newrows + (size_t)(col < 8 ? col : 7) * 256;
        };
        f32x4 kA[4], kB[4];
        { const float* kr = rowptr(0) + 8 * hb;
#pragma unroll
          for (int ks = 0; ks < 4; ++ks) { kA[ks] = *(const f32x4*)(kr + 16 * ks); kB[ks] = *(const f32x4*)(kr + 16 * ks + 4); } }
#pragma unroll 1
        for (int u = 0; u < 31; ++u) {
            const bool isnew = __builtin_amdgcn_readfirstlane(list[16 + (u >> 1)]) < 0;
            const float* vr = rowptr(u) + 128 + 32 * hb;
            f32x4 vv[8];
#pragma unroll
            for (int j4 = 0; j4 < 8; ++j4) vv[j4] = *(const f32x4*)(vr + 4 * j4);
            f32x16 s = zero16();
#pragma unroll
            for (int ks = 0; ks < 4; ++ks) s = mfma32(pack8(kA[ks][0], kA[ks][1], kA[ks][2], kA[ks][3], kB[ks][0], kB[ks][1], kB[ks][2], kB[ks][3]), qf[ks], s);
            if (u + 1 < 31) { const float* kr = rowptr(u + 1) + 8 * hb;
#pragma unroll
                for (int ks = 0; ks < 4; ++ks) { kA[ks] = *(const f32x4*)(kr + 16 * ks); kB[ks] = *(const f32x4*)(kr + 16 * ks + 4); } }
#pragma unroll
            for (int j4 = 0; j4 < 8; ++j4)
#pragma unroll
                for (int e = 0; e < 4; ++e) vt[(32 * hb + 4 * j4 + e) * 40 + col] = f2bf(vv[j4][e]);
            WAVE_SYNC();
            sm_pv(s, hb, [&](int kl) { return !isnew || kl <= t; }, [&](int dt, int s2) {
                LAS const bf16_t* ptr = vt + (32 * dt + col) * 40 + 16 * s2 + 4 * hb;
                union { u32x4_t u4; bf16x8 v; } x; const u32x2 a = *(LAS const u32x2*)ptr, c = *(LAS const u32x2*)(ptr + 8); x.u4[0] = a[0]; x.u4[1] = a[1]; x.u4[2] = c[0]; x.u4[3] = c[1]; return x.v; }, m, l, o);
            WAVE_SYNC();
        }
        l += __shfl_xor(l, 32);
        const float sc = l > 0.f ? g1 / l : 0.f;
        of_add(ost, lane, o, sc);
    }
    {
        float m = -1e30f, l = 0.f; f32x16 o[2]; o[0] = zero16(); o[1] = zero16();
        LoadWinF32 L; L.cw = p.cache_win + (size_t)b * 512 * 256 + g * 64; L.nw = p.out + O_WIN_S + ((size_t)b * 512 + 504) * 256 + g * 64;
        block_loop_g(L, kv, 0, [&](int n) { return n < 8 ? n + 1 : -1; }, [&](int n) { return true; },
            [&](int n, LAS const bf16_t* kb, LAS const bf16_t* vb) {
#pragma unroll 1
                for (int kt = 0; kt < 2; ++kt) {
                    const int j0 = 64 * n + 32 * kt;
                    if (j0 >= 520) break;
                    const f32x16 s = lds_qk(qf, kb, kt, col, hb);
                    sm_pv(s, hb, [&](int kl) { const int j = j0 + kl; return j >= t + 1 && j <= 512 + t; }, [&](int dt, int s2) { return lds_vfrag(vb, kt, dt, s2, col, hb); }, m, l, o);
                }
            });
        l += __shfl_xor(l, 32);
        const float sc = l > 0.f ? g2 / l : 0.f;
        f32x16 of[2];
        of_get_add(ost, lane, o, sc, of);
        attn_store(p, of, qrow, head, hb, col < 4);
    }
    __syncthreads();
}

__device__ __forceinline__ void ph_attn(const P& p, LAS unsigned char* lds, int qsel = 0) {
    const int tid = threadIdx.x, lane = tid & 63, wid = tid >> 6;
    unsigned* ctr = p.bar() + 3584 + 64 * qsel;
    LAS unsigned* qslot = (LAS unsigned*)(lds + XB_OFF + 64);
    for (;;) {
        if (tid == 0) *qslot = __hip_atomic_fetch_add(ctr, 1u, __ATOMIC_RELAXED, __HIP_MEMORY_SCOPE_AGENT);
        __syncthreads();
        const unsigned q = __builtin_amdgcn_readfirstlane(*qslot);
        __syncthreads();
        if (q >= 64u + 512u) break;
        if (q < 64u) attn_sample_block(p, (int)q, lds);
        else { const int idx = (int)q - 64; attn_prompt_block(p, idx & 7, 63 - (idx >> 3), lds);
        }
    }
}


constexpr int LDS_BYTES = pg8::STAGE_BYTES;

constexpr int FUSED_LDS = XB_OFF + 256;

template <class Epi> __device__ __forceinline__ void run_gemm(LAS unsigned char* lds, const bf16_t* A, const bf16_t* Bt, int M, int N, int K, const Epi& E, int slot = -1) {
    pg8::Gemm g; g.A = A; g.Bt = Bt; g.M = M; g.N = N; g.K = K; g.pad_ = 0;
    pg8::StaticOrder S; S.init(M, N, (int)gridDim.x, slot >= 0 ? slot : (int)blockIdx.x);
    pg8::gemm_phase<Epi, pg8::StaticOrder, false>((PG8_LAS unsigned char*)lds, g, S, E, nullptr);
}

#define XBAR() xcd_barrier(bar)
__global__ __launch_bounds__(512, 2) void k_fused(P p) {
    extern __shared__ __attribute__((aligned(16))) unsigned char shm[];
    LAS unsigned char* lds = (LAS unsigned char*)shm;
    LAS unsigned* xb = (LAS unsigned*)(lds + XB_OFF);
    if (threadIdx.x == 0) { xb[0] = 0u; xb[1] = 0u; xb[2] = 0u; xb[3] = 0u; }
    __syncthreads();
    XcdBarrier bar = xcd_barrier_post(p.bar(), (volatile LAS unsigned*)xb);
    ph_prep(p);
    XBAR();
    ph_inproj_sample(p);
    { EpiIn e; e.p = p; e.row0 = 0; e.pn0 = 0; run_gemm(lds, p.hb(), p.WinT(), NP, NPAD, DM, e); }
    ph_cmp_gemm_f32(p, lds);
    XBAR();
    if ((int)blockIdx.x < 16) {
        const int kvi = blockIdx.x >> 3, bg = blockIdx.x & 7;
        EpiPlainBf e; e.C = p.LHp() + ((size_t)kvi * 2048 + (size_t)bg * 256) * 256; e.ldc = 256; e.pad_ = 0;
        run_gemm(lds, (kvi ? p.vcr() : p.kb()) + (size_t)bg * 256 * 1024, p.W1T() + (size_t)kvi * 256 * 1024, 256, 256, 1024, e, 0);
        __builtin_amdgcn_fence(__ATOMIC_RELEASE, "agent");
        asm volatile("s_waitcnt vmcnt(0)" ::: "memory");
        __syncthreads();
        __builtin_amdgcn_fence(__ATOMIC_ACQUIRE, "agent");
        asm volatile("s_waitcnt vmcnt(0)" ::: "memory");
        compress2_tile(p, p.LHp(), 8, 256, 255, p.kc_p(), p.vcT_p(), kvi, bg, threadIdx.x >> 6, threadIdx.x & 63, lds + (threadIdx.x >> 6) * 8960);
    }
    ph_rwkv_prep(p);
    ph_compress2(p, p.LHs(), 64, 1024, 1023, p.kc_s(), p.vcT_s(), lds);
    XBAR();
    ph_rwkv_scan(p, (LAS float*)lds);
    __syncthreads();
    ph_attn(p, lds);
    XBAR();
    ph_rwkv_post(p);
    { EpiYa e; e.p = p; small_gemm(p.oa(), p.WpaT(), 512, e); run_gemm(lds, p.oa(), p.WpaT(), NP, DM, 512, e); }
    XBAR();
    { EpiYb e; e.p = p; small_gemm(p.ob(), p.WpbT(), 512, e); run_gemm(lds, p.ob(), p.WpbT(), NP, DM, 512, e); }
    XBAR();
    { EpiOut e; e.p = p; small_gemm(p.mb(), p.WoutT(), DM, e); run_gemm(lds, p.mb(), p.WoutT(), NP, DM, DM, e); }
    { EpiPlain e; e.C = p.pp(); e.ldc = DM; e.pad_ = 0; small_gemm(p.pb(), p.WprojT(), 256, e); run_gemm(lds, p.pb(), p.WprojT(), NP, DM, 256, e); }
    XBAR();
    { EpiGate e; e.p = p; small_gemm(p.xg(), p.WgateT(), DM, e); run_gemm(lds, p.xg(), p.WgateT(), NP, DM, DM, e); }
    XBAR();
    ph_final(p);
}
extern "C" void kernel_launch(void* const* d_in, const int* in_sizes, int n_in, void* d_out, int out_size, void* d_ws, size_t ws_size, hipStream_t stream) {
    (void)in_sizes; (void)n_in; (void)out_size; (void)ws_size;
    P p{};
    p.x_prompt = (const float*)d_in[0]; p.x_sample = (const float*)d_in[1]; p.p_prompt = (const float*)d_in[2]; p.p_sample = (const float*)d_in[3];
    p.cache_cmp = (const float*)d_in[4]; p.cache_sel = (const float*)d_in[5]; p.cache_win = (const float*)d_in[6]; p.state_wkv = (const float*)d_in[7];
    p.state_shift = (const float*)d_in[8]; p.page_table = (const int*)d_in[9]; p.norm_g = (const float*)d_in[10]; p.w_in = (const float*)d_in[11];
    p.cmp_pe = (const float*)d_in[12]; p.cmp_w1 = (const float*)d_in[13]; p.cmp_b1 = (const float*)d_in[14]; p.cmp_w2 = (const float*)d_in[15]; p.cmp_b2 = (const float*)d_in[16];
    p.w_pa = (const float*)d_in[17]; p.mu = (const float*)d_in[18]; p.w0 = (const float*)d_in[19]; p.w_up = (const float*)d_in[20]; p.a0 = (const float*)d_in[21];
    p.a_up = (const float*)d_in[22]; p.k_k = (const float*)d_in[23]; p.k_a = (const float*)d_in[24]; p.r_k = (const float*)d_in[25]; p.gn_g = (const float*)d_in[26];
    p.gn_b = (const float*)d_in[27]; p.w_pb = (const float*)d_in[28]; p.w_out = (const float*)d_in[29]; p.ple_g = (const float*)d_in[30]; p.w_gate = (const float*)d_in[31];
    p.w_proj = (const float*)d_in[32]; p.final_g = (const float*)d_in[33];
    p.out = (float*)d_out;
    p.ws = (unsigned char*)d_ws;

    static int grid = 0;
    if (!grid) {
        int dev = 0, cus = 0, per_cu = 0;
        (void)hipGetDevice(&dev);
        (void)hipDeviceGetAttribute(&cus, hipDeviceAttributeMultiprocessorCount, dev);
        (void)hipFuncSetAttribute((const void*)k_fused, hipFuncAttributeMaxDynamicSharedMemorySize, FUSED_LDS);
        (void)hipOccupancyMaxActiveBlocksPerMultiprocessor(&per_cu, k_fused, 512, FUSED_LDS);
        grid = per_cu >= 1 ? cus : 0;
        if (grid > 256) grid = 256;
    }
    (void)hipMemsetAsync(p.bar(), 0, 32768, stream);
    if (grid > 0) hipLaunchKernelGGL(k_fused, dim3(grid), dim3(512), FUSED_LDS, stream, p);
}
```

```cpp
#include <hip/hip_runtime.h>
#include <stdint.h>
#include <stdio.h>
namespace pg8 {
#define PG8_LAS __attribute__((address_space(3)))
typedef unsigned short bf16_t;
typedef short bf16x8 __attribute__((ext_vector_type(8)));
typedef float f32x4 __attribute__((ext_vector_type(4)));
typedef unsigned u32x4 __attribute__((ext_vector_type(4)));
constexpr int BM = 256, BK = 64, HALF = 128, HTB = HALF * BK * 2  , STAGE_BYTES = 8 * HTB, NXCD = 8, WGM = 8;

__host__ __device__ __forceinline__ int lds_byte(int r, int c) { const int st = (r >> 4) * 2 + (c >> 5), rr = r & 15, cc = c & 31, ob = rr * 64 + cc * 2; return st * 1024 + (ob ^ (((ob >> 9) & 1) << 5)); }
__host__ __device__ __forceinline__ void stage_rc(int b, int& R, int& C) { const int st = b / 1024, sb = b % 1024, swz = sb ^ (((sb >> 9) & 1) << 5); R = (st >> 1) * 16 + swz / 64; C = (st & 1) * 32 + (swz % 64) / 2; }
__host__ __device__ __forceinline__ int perm32(int rho) { const int n = rho >> 4, i = rho & 15; return 8 * (i >> 2) + 4 * n + (i & 3); }

struct Unit { int pm, pn; };
struct Gemm { const bf16_t* A; const bf16_t* Bt; int M, N, K, pad_; };

struct StaticOrder {
    int nM, nN, nwg, G, c;
    __host__ __device__ void init(int M, int N, int G_, int c_) { nM = M / BM; nN = N / BM; nwg = nM * nN; G = G_; c = c_; }
    __host__ __device__ bool next(int i, Unit& u) const {
        const long L = (long)i * G + c; if (L >= nwg) return false;
        int wgid = (int)L; { const int q = nwg / NXCD, r = nwg % NXCD, xcd = wgid % NXCD, off = wgid / NXCD; wgid = (xcd < r ? xcd * (q + 1) : r * (q + 1) + (xcd - r) * q) + off; }
        const int nig = WGM * nN, gid = wgid / nig, fm = gid * WGM, gsz = (nM - fm) < WGM ? (nM - fm) : WGM;
        u.pm = fm + ((wgid % nig) % gsz); u.pn = (wgid % nig) / gsz; return true;
    }
    __device__ __forceinline__ void a_ready(const Unit&) const {}
    __device__ __forceinline__ void done(const Unit&) const {}
};
__device__ __forceinline__ unsigned cvt_pk_bf16(float lo, float hi) { unsigned r; asm volatile("v_cvt_pk_bf16_f32 %0, %1, %2" : "=v"(r) : "v"(lo), "v"(hi)); return r; }
typedef float f32x2 __attribute__((ext_vector_type(2)));
template <class Epi, class Sched, bool STAMP = false>
__device__ __forceinline__ void gemm_phase(PG8_LAS unsigned char* lds, const Gemm g, const Sched& S, const Epi& E, unsigned long long* stamps) {
    int tid_l = threadIdx.x; asm volatile("" : "+v"(tid_l));
    const int tid = tid_l, wid = __builtin_amdgcn_readfirstlane(tid >> 6), lane = tid & 63, wr = wid >> 2, wc = wid & 3, fr = lane & 15, fq = lane >> 4;
    const int K = g.K, nt = K / BK;
    int ts_lo = 0, ts_hi = 0, nts = 0; const unsigned long long rt_entry = STAMP ? (unsigned long long)wall_clock64() : 0ull;
#define PG8_STAMP() do { if (STAMP && wid == 0 && nts < 64) { const unsigned long long _c = (unsigned long long)clock64(); \
        ts_lo = (lane == nts) ? (int)(unsigned)_c : ts_lo; ts_hi = (lane == nts) ? (int)(unsigned)(_c >> 32) : ts_hi; ++nts; } } while (0)
    PG8_STAMP();
    unsigned voffA[2], voffB[2];
#pragma unroll
    for (int i = 0; i < 2; ++i) { int R, C; stage_rc(tid * 16 + i * 8192, R, C); const int Rb = Epi::PERM ? ((R & ~31) + perm32(R & 31)) : R;
        voffA[i] = (unsigned)(R * K + C) * 2u; voffB[i] = (unsigned)(Rb * K + C) * 2u; }
    const size_t kstep = (size_t)(BK * 2);
    const size_t hstep = (size_t)HALF * K * 2;
    const size_t tstep = 2 * hstep;
    const unsigned ldsw = (unsigned)wid * 1024u;
    const int aoff = lds_byte(wr * 64 + fr, fq * 8), boff = lds_byte(wc * 32 + fr, fq * 8);
#define PG8_SA(b, h) (((b) * 2 + (h)) * HTB)
#define PG8_SB(b, h) ((4 + (b) * 2 + (h)) * HTB)
#define PG8_STAGE(bufoff, gbase, voff) do { _Pragma("unroll") for (int _i = 0; _i < 2; ++_i) \
        __builtin_amdgcn_global_load_lds((const unsigned*)((const char*)(gbase) + (voff)[_i]), (PG8_LAS unsigned*)(lds + (bufoff) + ldsw + _i * 8192), 16, 0, 0); } while (0)
#define PG8_LDA(dst, b, h) do { _Pragma("unroll") for (int m = 0; m < 4; ++m) _Pragma("unroll") for (int k = 0; k < 2; ++k) dst[m][k] = *(const PG8_LAS bf16x8*)(lds + PG8_SA(b, h) + aoff + m * 2048 + k * 1024); } while (0)
#define PG8_LDB(dst, b, h) do { _Pragma("unroll") for (int n = 0; n < 2; ++n) _Pragma("unroll") for (int k = 0; k < 2; ++k) dst[n][k] = *(const PG8_LAS bf16x8*)(lds + PG8_SB(b, h) + boff + n * 2048 + k * 1024); } while (0)
#define PG8_MMA(ai, bj, At, Bt) do { __builtin_amdgcn_s_setprio(1); _Pragma("unroll") for (int m = 0; m < 4; ++m) _Pragma("unroll") for (int n = 0; n < 2; ++n) _Pragma("unroll") for (int k = 0; k < 2; ++k) \
        acc[ai][bj][m][n] = __builtin_amdgcn_mfma_f32_16x16x32_bf16(Bt[n][k], At[m][k], acc[ai][bj][m][n], 0, 0, 0); __builtin_amdgcn_s_setprio(0); } while (0)
#define PG8_WAIT_V(n) asm volatile("s_waitcnt vmcnt(" #n ")" ::: "memory")
#define PG8_WAIT_L(n) asm volatile("s_waitcnt lgkmcnt(" #n ")" ::: "memory")
#define PG8_BAR __builtin_amdgcn_s_barrier()
#define PG8_SCHED __builtin_amdgcn_sched_barrier(0)
    Unit cur, nxt; int ui = 0;
    if (!S.next(0, cur)) return;
    f32x4 acc[2][2][4][2];
#pragma unroll
    for (int a = 0; a < 2; ++a)
#pragma unroll
        for (int b = 0; b < 2; ++b)
#pragma unroll
            for (int m = 0; m < 4; ++m)
#pragma unroll
                for (int n = 0; n < 2; ++n) acc[a][b][m][n] = (f32x4){0.f, 0.f, 0.f, 0.f};
    bf16x8 At[4][2], B0[2][2], B1[2][2];
    const char* cA = (const char*)g.A + (size_t)cur.pm * tstep; const char* cB = (const char*)g.Bt + (size_t)cur.pn * tstep;
    S.a_ready(cur);
    PG8_STAGE(PG8_SB(0, 0), cB, voffB); PG8_STAGE(PG8_SA(0, 0), cA, voffA); PG8_STAGE(PG8_SB(0, 1), cB + hstep, voffB); PG8_STAGE(PG8_SA(0, 1), cA + hstep, voffA);
    if (wr == 1) PG8_BAR;
    PG8_WAIT_V(4); PG8_BAR;
    PG8_STAGE(PG8_SB(1, 0), cB + kstep, voffB); PG8_STAGE(PG8_SA(1, 0), cA + kstep, voffA); PG8_STAGE(PG8_SB(1, 1), cB + hstep + kstep, voffB);
    PG8_WAIT_V(6); PG8_BAR;
    PG8_STAMP();
    for (;;) {
        const bool has_next = S.next(ui + 1, nxt);
        const char* nA = has_next ? (const char*)g.A + (size_t)nxt.pm * tstep : cA; const char* nB = has_next ? (const char*)g.Bt + (size_t)nxt.pn * tstep : cB;
        for (int t = 0; t < nt; t += 2) {
            const bool last = (t == nt - 2);
            const char* a1 = cA + (size_t)(t + 1) * kstep;
            const char* a2 = last ? nA : cA + (size_t)(t + 2) * kstep; const char* b2 = last ? nB : cB + (size_t)(t + 2) * kstep;
            const char* a3 = a2 + kstep; const char* b3 = b2 + kstep;
            if (last && has_next) S.a_ready(nxt);
            PG8_LDB(B0, 0, 0); PG8_SCHED; PG8_LDA(At, 0, 0); PG8_STAGE(PG8_SA(1, 1), a1 + hstep, voffA);
            PG8_WAIT_L(8); PG8_BAR; PG8_WAIT_L(0); PG8_MMA(0, 0, At, B0); PG8_BAR; PG8_SCHED;
            PG8_LDB(B1, 0, 1); PG8_STAGE(PG8_SB(0, 0), b2, voffB);
            PG8_BAR; PG8_WAIT_L(0); PG8_MMA(0, 1, At, B1); PG8_BAR;
            PG8_LDA(At, 0, 1); PG8_STAGE(PG8_SA(0, 0), a2, voffA);
            PG8_BAR; PG8_WAIT_L(0); PG8_MMA(1, 0, At, B0); PG8_BAR; PG8_SCHED;
            PG8_STAGE(PG8_SB(0, 1), b2 + hstep, voffB);
            PG8_WAIT_V(6); PG8_BAR; PG8_MMA(1, 1, At, B1); PG8_BAR;
            PG8_LDB(B0, 1, 0); PG8_SCHED; PG8_LDA(At, 1, 0); PG8_STAGE(PG8_SA(0, 1), a2 + hstep, voffA);
            PG8_WAIT_L(8); PG8_BAR; PG8_WAIT_L(0); PG8_MMA(0, 0, At, B0); PG8_BAR; PG8_SCHED;
            PG8_LDB(B1, 1, 1); PG8_STAGE(PG8_SB(1, 0), b3, voffB);
            PG8_BAR; PG8_WAIT_L(0); PG8_MMA(0, 1, At, B1); PG8_BAR;
            PG8_LDA(At, 1, 1); PG8_STAGE(PG8_SA(1, 0), a3, voffA);
            PG8_BAR; PG8_WAIT_L(0); PG8_MMA(1, 0, At, B0); PG8_BAR; PG8_SCHED;
            PG8_STAGE(PG8_SB(1, 1), b3 + hstep, voffB);
            PG8_WAIT_V(6); PG8_BAR; PG8_MMA(1, 1, At, B1); PG8_BAR;
        }
        PG8_STAMP();
        if constexpr (!Epi::AFTER_DRAIN) { E(acc, cur, wr, wc, fr, fq); S.done(cur); }
        PG8_STAMP();
        if (!has_next) break;
#pragma unroll
        for (int a = 0; a < 2; ++a)
#pragma unroll
            for (int b = 0; b < 2; ++b)
#pragma unroll
                for (int m = 0; m < 4; ++m)
#pragma unroll
                    for (int n = 0; n < 2; ++n) acc[a][b][m][n] = (f32x4){0.f, 0.f, 0.f, 0.f};
        cur = nxt; cA = nA; cB = nB; ++ui;
    }
    PG8_WAIT_V(0);
    if (wr == 0) PG8_BAR;
    PG8_BAR;
    if constexpr (Epi::AFTER_DRAIN) { E.fused(acc, cur, wr, wc, fr, fq, lds, wid, lane); S.done(cur); }
    PG8_STAMP();
    if (STAMP && wid == 0) { stamps[lane] = lane < nts ? (((unsigned long long)(unsigned)ts_hi << 32) | (unsigned)ts_lo) : 0ull;
        if (lane == 62) stamps[62] = rt_entry; if (lane == 63) stamps[63] = (unsigned long long)wall_clock64(); }
#undef PG8_STAMP
#undef PG8_SA
#undef PG8_SB
#undef PG8_STAGE
#undef PG8_LDA
#undef PG8_LDB
#undef PG8_MMA
#undef PG8_WAIT_V
#undef PG8_WAIT_L
#undef PG8_BAR
#undef PG8_SCHED
}
}

typedef unsigned short bf16_t;
typedef short bf16x8 __attribute__((ext_vector_type(8)));
typedef float f32x4 __attribute__((ext_vector_type(4)));
typedef float f32x16 __attribute__((ext_vector_type(16)));
#define LAS __attribute__((address_space(3)))
#define WAVE_SYNC() do { asm volatile("s_waitcnt lgkmcnt(0)" ::: "memory"); __builtin_amdgcn_wave_barrier(); } while (0)

constexpr int DM = 1024, NP = 16384, NSMP = 256, MR = 16640, SEQ = 4096, NB = 4, DB = 32, DS = 8, PAST = 16384;
constexpr int CIN = 6040, NPAD = 6144, CR = 1664;
constexpr int NTHR = 512;
constexpr size_t O_Y_P = 0, O_Y_S = 16777216, O_CMP_P = 17039360, O_CMP_S = 21233664, O_SEL_P = 21299200, O_SEL_S = 25493504,
                 O_WIN_P = 25559040, O_WIN_S = 26083328, O_WKV_P = 30277632, O_WKV_S = 30408704, O_SH_P = 31457280, O_SH_S = 31463936;

constexpr size_t ws_al(size_t x) { return (x + 255) & ~(size_t)255; }
constexpr size_t WS_bar = 0;
constexpr size_t WS_hb = WS_bar + ws_al(32768);
constexpr size_t WS_WinT = WS_hb + ws_al((size_t)MR * DM * 2);
constexpr size_t WS_WpaT = WS_WinT + ws_al((size_t)NPAD * DM * 2);
constexpr size_t WS_WpbT = WS_WpaT + ws_al((size_t)DM * 512 * 2);
constexpr size_t WS_WoutT = WS_WpbT + ws_al((size_t)DM * 512 * 2);
constexpr size_t WS_WgateT = WS_WoutT + ws_al((size_t)DM * DM * 2);
constexpr size_t WS_WprojT = WS_WgateT + ws_al((size_t)DM * DM * 2);
constexpr size_t WS_W1T = WS_WprojT + ws_al((size_t)DM * 256 * 2);
constexpr size_t WS_W2T = WS_W1T + ws_al((size_t)512 * 1024 * 2);
constexpr size_t WS_WupT = WS_W2T + ws_al((size_t)128 * 128 * 2);
constexpr size_t WS_AupT = WS_WupT + ws_al((size_t)512 * 64 * 2);
constexpr size_t WS_pb = WS_AupT + ws_al((size_t)512 * 64 * 2);
constexpr size_t WS_tabc = WS_pb + ws_al((size_t)MR * 256 * 2);
constexpr size_t WS_tabs = WS_tabc + ws_al((size_t)4104 * 32 * 4);
constexpr size_t WS_pt = WS_tabs + ws_al((size_t)4104 * 32 * 4);
constexpr size_t WS_qb = WS_pt + ws_al(256 * 4);
constexpr size_t WS_kb = WS_qb + ws_al((size_t)MR * 512 * 2);
constexpr size_t WS_vcr = WS_kb + ws_al((size_t)3 * NB * 2 * SEQ * 64 * 2);
constexpr size_t WS_vT = WS_vcr + ws_al((size_t)NB * 2 * SEQ * 64 * 2);
constexpr size_t WS_ag = WS_vT + ws_al((size_t)2 * NB * 2 * 64 * SEQ * 2);
constexpr size_t WS_rg = WS_ag + ws_al((size_t)MR * 512 * 2);
constexpr size_t WS_mg = WS_rg + ws_al((size_t)MR * 512 * 2);
constexpr size_t WS_gates = WS_mg + ws_al((size_t)MR * 2048 * 2);
constexpr size_t WS_rz = WS_gates + ws_al((size_t)MR * 32 * 4);
constexpr size_t WS_zs0 = WS_rz + ws_al((size_t)MR * CR * 2);
constexpr size_t WS_LHp = WS_zs0 + ws_al((size_t)33 * CR * 2);
constexpr size_t WS_LHs = WS_LHp + ws_al((size_t)2 * 2048 * 256 * 4);
constexpr size_t WS_cs = WS_LHs + ws_al((size_t)2 * 65536 * 256 * 4);
constexpr size_t WS_kc_p = WS_cs + ws_al((size_t)2 * 65536 * 1024 * 2);
constexpr size_t WS_vcT_p = WS_kc_p + ws_al((size_t)8 * 256 * 64 * 2);
constexpr size_t WS_kc_s = WS_vcT_p + ws_al((size_t)8 * 64 * 256 * 2);
constexpr size_t WS_vcT_s = WS_kc_s + ws_al((size_t)64 * 1024 * 64 * 2);
constexpr size_t WS_rw6 = WS_vcT_s + ws_al((size_t)64 * 64 * 1024 * 2);
constexpr int RW6_STRIDE = 896;
constexpr size_t WS_bonus = WS_rw6 + ws_al((size_t)MR * 8 * RW6_STRIDE);
constexpr size_t WS_ybuf = WS_bonus + ws_al((size_t)MR * 8 * 4);
constexpr size_t WS_oa = WS_ybuf + ws_al((size_t)MR * 512 * 4);
constexpr size_t WS_ob = WS_oa + ws_al((size_t)MR * 512 * 2);
constexpr size_t WS_mb = WS_ob + ws_al((size_t)MR * 512 * 2);
constexpr size_t WS_xg = WS_mb + ws_al((size_t)MR * DM * 2);
constexpr size_t WS_tmp = WS_xg + ws_al((size_t)MR * DM * 2);
constexpr size_t WS_x1 = WS_tmp + ws_al((size_t)MR * DM * 4);
constexpr size_t WS_ss1 = WS_x1 + ws_al((size_t)MR * DM * 4);
constexpr size_t WS_pp = WS_ss1 + ws_al((size_t)MR * 16 * 4);
constexpr size_t WS_TOTAL = WS_pp + ws_al((size_t)MR * DM * 4);

struct P {
    const float *x_prompt, *x_sample, *p_prompt, *p_sample, *cache_cmp, *cache_sel, *cache_win, *state_wkv, *state_shift;
    const int* page_table;
    const float *norm_g, *w_in, *cmp_pe, *cmp_w1, *cmp_b1, *cmp_w2, *cmp_b2, *w_pa, *mu, *w0, *w_up, *a0, *a_up, *k_k, *k_a, *r_k, *gn_g, *gn_b,
        *w_pb, *w_out, *ple_g, *w_gate, *w_proj, *final_g;
    float* out;
    unsigned char* ws;
    __host__ __device__ __forceinline__ unsigned* bar() const { return (unsigned*)(ws + WS_bar); }
    __host__ __device__ __forceinline__ float* ss_s() const { return (float*)(ws + WS_bar + 16384); }
    __host__ __device__ __forceinline__ bf16_t* hb() const { return (bf16_t*)(ws + WS_hb); }
    __host__ __device__ __forceinline__ bf16_t* WinT() const { return (bf16_t*)(ws + WS_WinT); }
    __host__ __device__ __forceinline__ bf16_t* WpaT() const { return (bf16_t*)(ws + WS_WpaT); }
    __host__ __device__ __forceinline__ bf16_t* WpbT() const { return (bf16_t*)(ws + WS_WpbT); }
    __host__ __device__ __forceinline__ bf16_t* WoutT() const { return (bf16_t*)(ws + WS_WoutT); }
    __host__ __device__ __forceinline__ bf16_t* WgateT() const { return (bf16_t*)(ws + WS_WgateT); }
    __host__ __device__ __forceinline__ bf16_t* WprojT() const { return (bf16_t*)(ws + WS_WprojT); }
    __host__ __device__ __forceinline__ bf16_t* W1T() const { return (bf16_t*)(ws + WS_W1T); }
    __host__ __device__ __forceinline__ bf16_t* W2T() const { return (bf16_t*)(ws + WS_W2T); }
    __host__ __device__ __forceinline__ bf16_t* WupT() const { return (bf16_t*)(ws + WS_WupT); }
    __host__ __device__ __forceinline__ bf16_t* AupT() const { return (bf16_t*)(ws + WS_AupT); }
    __host__ __device__ __forceinline__ bf16_t* pb() const { return (bf16_t*)(ws + WS_pb); }
    __host__ __device__ __forceinline__ float* tabc() const { return (float*)(ws + WS_tabc); }
    __host__ __device__ __forceinline__ float* tabs() const { return (float*)(ws + WS_tabs); }
    __host__ __device__ __forceinline__ float* pt() const { return (float*)(ws + WS_pt); }
    __host__ __device__ __forceinline__ bf16_t* qb() const { return (bf16_t*)(ws + WS_qb); }
    __host__ __device__ __forceinline__ bf16_t* kb() const { return (bf16_t*)(ws + WS_kb); }
    __host__ __device__ __forceinline__ bf16_t* vcr() const { return (bf16_t*)(ws + WS_vcr); }
    __host__ __device__ __forceinline__ bf16_t* vT() const { return (bf16_t*)(ws + WS_vT); }
    __host__ __device__ __forceinline__ bf16_t* ag() const { return (bf16_t*)(ws + WS_ag); }
    __host__ __device__ __forceinline__ bf16_t* rg() const { return (bf16_t*)(ws + WS_rg); }
    __host__ __device__ __forceinline__ bf16_t* mg() const { return (bf16_t*)(ws + WS_mg); }
    __host__ __device__ __forceinline__ float* gates() const { return (float*)(ws + WS_gates); }
    __host__ __device__ __forceinline__ bf16_t* rz() const { return (bf16_t*)(ws + WS_rz); }
    __host__ __device__ __forceinline__ bf16_t* zs0() const { return (bf16_t*)(ws + WS_zs0); }
    __host__ __device__ __forceinline__ bf16_t* LHp() const { return (bf16_t*)(ws + WS_LHp); }
    __host__ __device__ __forceinline__ bf16_t* LHs() const { return (bf16_t*)(ws + WS_LHs); }
    __host__ __device__ __forceinline__ bf16_t* cs() const { return (bf16_t*)(ws + WS_cs); }
    __host__ __device__ __forceinline__ bf16_t* kc_p() const { return (bf16_t*)(ws + WS_kc_p); }
    __host__ __device__ __forceinline__ bf16_t* vcT_p() const { return (bf16_t*)(ws + WS_vcT_p); }
    __host__ __device__ __forceinline__ bf16_t* kc_s() const { return (bf16_t*)(ws + WS_kc_s); }
    __host__ __device__ __forceinline__ bf16_t* vcT_s() const { return (bf16_t*)(ws + WS_vcT_s); }
    __host__ __device__ __forceinline__ unsigned char* rw6() const { return ws + WS_rw6; }
    __host__ __device__ __forceinline__ float* bonus() const { return (float*)(ws + WS_bonus); }
    __host__ __device__ __forceinline__ float* ybuf() const { return (float*)(ws + WS_ybuf); }
    __host__ __device__ __forceinline__ bf16_t* oa() const { return (bf16_t*)(ws + WS_oa); }
    __host__ __device__ __forceinline__ bf16_t* ob() const { return (bf16_t*)(ws + WS_ob); }
    __host__ __device__ __forceinline__ bf16_t* mb() const { return (bf16_t*)(ws + WS_mb); }
    __host__ __device__ __forceinline__ bf16_t* xg() const { return (bf16_t*)(ws + WS_xg); }
    __host__ __device__ __forceinline__ float* tmp() const { return (float*)(ws + WS_tmp); }
    __host__ __device__ __forceinline__ float* x1() const { return (float*)(ws + WS_x1); }
    __host__ __device__ __forceinline__ float* ss1() const { return (float*)(ws + WS_ss1); }
    __host__ __device__ __forceinline__ float* pp() const { return (float*)(ws + WS_pp); }
};


__device__ __forceinline__ float bf2f(bf16_t b) { return __uint_as_float(((unsigned)b) << 16); }
typedef __bf16 bf16v2_t __attribute__((ext_vector_type(2)));
typedef float f32x2_t __attribute__((ext_vector_type(2)));
__device__ __forceinline__ unsigned pk2(float lo, float hi) { const f32x2_t v = {lo, hi}; return __builtin_bit_cast(unsigned, __builtin_convertvector(v, bf16v2_t)); }
__device__ __forceinline__ bf16_t f2bf(float f) { return (bf16_t)(pk2(f, f) & 0xffffu); }
__device__ __forceinline__ float xsum16(float v) { const auto r = __builtin_amdgcn_permlane16_swap(__float_as_uint(v), __float_as_uint(v), false, false); return __uint_as_float(r[0]) + __uint_as_float(r[1]); }
__device__ __forceinline__ float xsum32(float v) { const auto r = __builtin_amdgcn_permlane32_swap(__float_as_uint(v), __float_as_uint(v), false, false); return __uint_as_float(r[0]) + __uint_as_float(r[1]); }
__device__ __forceinline__ float xmax32(float v) { const auto r = __builtin_amdgcn_permlane32_swap(__float_as_uint(v), __float_as_uint(v), false, false); return fmaxf(__uint_as_float(r[0]), __uint_as_float(r[1])); }
__device__ __forceinline__ float quad_sum(float v) {
    v += __builtin_bit_cast(float, __builtin_amdgcn_mov_dpp(__builtin_bit_cast(int, v), 0xB1, 0xF, 0xF, true));
    v += __builtin_bit_cast(float, __builtin_amdgcn_mov_dpp(__builtin_bit_cast(int, v), 0x4E, 0xF, 0xF, true));
    return v;
}
__device__ __forceinline__ float wave_sum(float v) {
    v += __builtin_bit_cast(float, __builtin_amdgcn_mov_dpp(__builtin_bit_cast(int, v), 0xB1, 0xF, 0xF, true));
    v += __builtin_bit_cast(float, __builtin_amdgcn_mov_dpp(__builtin_bit_cast(int, v), 0x4E, 0xF, 0xF, true));
    v += __builtin_bit_cast(float, __builtin_amdgcn_mov_dpp(__builtin_bit_cast(int, v), 0x141, 0xF, 0xF, true));
    v += __builtin_bit_cast(float, __builtin_amdgcn_mov_dpp(__builtin_bit_cast(int, v), 0x140, 0xF, 0xF, true));
    return xsum32(xsum16(v));
}
__device__ __forceinline__ float sigmoidf_(float x) { return 1.0f / (1.0f + __expf(-x)); }
__device__ __forceinline__ float siluf_(float x) { return x / (1.0f + __expf(-x)); }
__device__ __forceinline__ float sigmoid_fast(float x) { return __builtin_amdgcn_rcpf(1.0f + __expf(-x)); }
__device__ __forceinline__ float silu_fast(float x) { return x * __builtin_amdgcn_rcpf(1.0f + __expf(-x)); }

__device__ __forceinline__ int win_src_col(int np) {
    const int pn = np >> 8, p = np & 255;
    if (pn < 5) {
        const int bj = p >> 7, wc = (p >> 5) & 3, n = (p >> 4) & 1, fq = (p >> 2) & 3, e = p & 3;
        const int d = 32 * n + 16 * (wc & 1) + 4 * fq + e;
        if (pn < 2) { const int head = pn * 4 + bj * 2 + (wc >> 1); return head * 64 + d; }
        const int br = pn - 2, g = wc >> 1;
        return 512 + br * 256 + bj * 128 + g * 64 + d;
    }
    const int s = (p & 0xe0) + 8 * ((p >> 2) & 3) + 4 * ((p >> 4) & 1) + (p & 3);
    if (pn < 7) return 1304 + (pn - 5) * 256 + s;
    if (pn < 13) return 1816 + (pn - 7) * 256 + s;
    if (pn == 13) { if (s < 128) return 1816 + 1536 + s; if (s < 152) return 1280 + (s - 128); return -1; }
    if (pn < 16) return 3480 + (pn - 14) * 256 + s;
    return 3992 + (pn - 16) * 256 + s;
}

__device__ __forceinline__ int perm8(int np) { return (np & ~31) + 8 * ((np >> 2) & 3) + 4 * ((np >> 4) & 1) + (np & 3); }
template <class F>
__device__ __forceinline__ void transpose_cvt(bf16_t* dst, int Nd, int K, F f) {
    const int total = Nd * (K >> 3);
    for (int id = blockIdx.x * NTHR + threadIdx.x; id < total; id += gridDim.x * NTHR) {
        const int n = id % Nd, kc = id / Nd;
        float v[8];
#pragma unroll
        for (int j = 0; j < 8; ++j) v[j] = f(n, kc * 8 + j);
        uint4 w; w.x = pk2(v[0], v[1]); w.y = pk2(v[2], v[3]); w.z = pk2(v[4], v[5]); w.w = pk2(v[6], v[7]);
        *(uint4*)(dst + (size_t)n * K + kc * 8) = w;
    }
}

__device__ __forceinline__ void sincos_small(double r, float& s, float& c) {
    const double r2 = r * r;
    double sa = 1.0, ca = 1.0;
    double ts = 1.0, tc = 1.0; sa = 0.0; ca = 0.0;
#pragma unroll
    for (int k = 0; k < 16; ++k) {
        sa += ts; ca += tc;
        ts = -ts * r2 / (double)((2 * k + 2) * (2 * k + 3));
        tc = -tc * r2 / (double)((2 * k + 1) * (2 * k + 2));
    }
    s = (float)(sa * r); c = (float)ca;
}

__device__ __forceinline__ void ph_prep(const P& p) {
    const int tid = threadIdx.x, lane = tid & 63, wid = tid >> 6;
    const int gw = blockIdx.x * 8 + wid, nw = gridDim.x * 8;
    const int gt = blockIdx.x * NTHR + tid, nt = gridDim.x * NTHR;
    for (int row0 = gw; row0 < MR; row0 += 2 * nw) {
        float4 v[2][4]; float ss[2];
#pragma unroll
        for (int u = 0; u < 2; ++u) {
            const int row = row0 + u * nw < MR ? row0 + u * nw : row0;
            const float4* src = (const float4*)(row < NP ? p.x_prompt + (size_t)row * DM : p.x_sample + (size_t)(row - NP) * DM);
            ss[u] = 0.f;
#pragma unroll
            for (int i = 0; i < 4; ++i) { v[u][i] = src[lane + 64 * i]; ss[u] += v[u][i].x * v[u][i].x + v[u][i].y * v[u][i].y + v[u][i].z * v[u][i].z + v[u][i].w * v[u][i].w; }
        }
#pragma unroll
        for (int u = 0; u < 2; ++u) {
            const int row = row0 + u * nw;
            const float tot = wave_sum(ss[u]);
            const float rstd = rsqrtf(tot * (1.0f / DM) + 1e-6f);
            if (row < MR) {
#pragma unroll
                for (int i = 0; i < 4; ++i) {
                    const float4 g = ((const float4*)p.norm_g)[lane + 64 * i];
                    uint2 w; w.x = pk2(v[u][i].x * rstd * g.x, v[u][i].y * rstd * g.y); w.y = pk2(v[u][i].z * rstd * g.z, v[u][i].w * rstd * g.w);
                    *(uint2*)(p.hb() + (size_t)row * DM + 4 * (lane + 64 * i)) = w;
                }
            }
        }
    }
    { const float* w = p.w_in; transpose_cvt(p.WinT(), NPAD, DM, [=](int n, int k) { const int c = win_src_col(n); return c < 0 ? 0.f : w[(size_t)k * CIN + c]; }); }
    { const float* w = p.w_pa; transpose_cvt(p.WpaT(), DM, 512, [=](int n, int k) { return w[(size_t)k * DM + perm8(n)]; }); }
    { const float* w = p.w_pb; transpose_cvt(p.WpbT(), DM, 512, [=](int n, int k) { return w[(size_t)k * DM + perm8(n)]; }); }
    { const float* w = p.w_out; transpose_cvt(p.WoutT(), DM, DM, [=](int n, int k) { return w[(size_t)k * DM + perm8(n)]; }); }
    { const float* w = p.w_gate; transpose_cvt(p.WgateT(), DM, DM, [=](int n, int k) { return w[(size_t)k * DM + perm8(n)]; }); }
    { const float* w = p.w_proj; transpose_cvt(p.WprojT(), DM, 256, [=](int n, int k) { return w[(size_t)k * DM + perm8(n)]; }); }
    { const float* w = p.cmp_w1; transpose_cvt(p.W1T(), 512, 1024, [=](int n, int k) { const int kvi = n >> 8, nn = n & 255; return w[(size_t)kvi * 262144 + (size_t)((nn >> 7) * 1024 + k) * 128 + (nn & 127)]; }); }
    { const float* w = p.cmp_w2; transpose_cvt(p.W2T(), 128, 128, [=](int n, int k) { return w[(size_t)(n >> 6) * 8192 + (size_t)k * 64 + (n & 63)]; }); }
    { const float* w = p.w_up; transpose_cvt(p.WupT(), 512, 64, [=](int n, int k) { return w[(size_t)k * 512 + n]; }); }
    { const float* w = p.a_up; transpose_cvt(p.AupT(), 512, 64, [=](int n, int k) { return w[(size_t)k * 512 + n]; }); }
    for (int id = gt; id < 33 * CR; id += nt) p.zs0()[id] = id < CR ? (bf16_t)0 : f2bf(p.state_shift[id - CR]);
    for (int id = gt; id < MR * 64; id += nt) {
        const int row = id >> 6, c4 = id & 63;
        const float4 v = ((const float4*)(row < NP ? p.p_prompt + (size_t)row * 256 : p.p_sample + (size_t)(row - NP) * 256))[c4];
        uint2 w; w.x = pk2(v.x, v.y); w.y = pk2(v.z, v.w);
        *(uint2*)(p.pb() + (size_t)row * 256 + c4 * 4) = w;
    }
    for (int id = gt; id < 4104 * 32; id += nt) {
        const int pi = id >> 5, i = id & 31;
        const int pos = pi < 4096 ? pi : PAST + pi - 4096;
        const float inv = (float)exp(-(double)i * (9.210340371976184 / 32.0));
        const float ang = (float)pos * inv;
        const double x = (double)ang;
        const double k = rint(x * 0.15915494309189535);
        const double r = x - k * 6.283185307179586;
        float s, c; sincos_small(r, s, c);
        p.tabc()[id] = c; p.tabs()[id] = s;
    }
    for (int o = gw; o < 256; o += nw) {
        const int kvi = o >> 7, f = o & 127;
        float acc = 0.f;
        for (int jd = lane; jd < 2048; jd += 64) acc += p.cmp_pe[kvi * 2048 + jd] * p.cmp_w1[(size_t)kvi * 262144 + (size_t)jd * 128 + f];
        acc = wave_sum(acc);
        if (lane == 0) p.pt()[o] = acc + p.cmp_b1[o];
    }
    for (int id = gt; id < DB * 504 * 64; id += nt) {
        const int c4 = id & 63, j = (id >> 6) % 504, b = (id >> 6) / 504;
        ((float4*)(p.out + O_WIN_S))[((size_t)b * 512 + j) * 64 + c4] = ((const float4*)p.cache_win)[((size_t)b * 512 + j + 8) * 64 + c4];
    }
}
#define XB_TMO      128
#define XB_XCNT(j)  (256  + 64 * (j))
#define XB_XSUB(j)  (1280 + 64 * (j))
#define XB_XGEN(j)  (2304 + 64 * (j))
#define XB_TOP      3328
#define XB_TOPGEN   3392
#define XCD_BAR_WORDS 3456
#define XB_SPIN_CAP (1u << 18)

__device__ __forceinline__ unsigned xb_ld(unsigned* p)              { return __hip_atomic_load(p, __ATOMIC_RELAXED, __HIP_MEMORY_SCOPE_AGENT); }
__device__ __forceinline__ unsigned xb_add(unsigned* p, unsigned v) { return __hip_atomic_fetch_add(p, v, __ATOMIC_RELAXED, __HIP_MEMORY_SCOPE_AGENT); }
__device__ __forceinline__ unsigned xb_xcc_id() { return (unsigned)__builtin_amdgcn_s_getreg((3 << 11) | 20) & 0xFu; }
#define XB_SPIN(cond, bar) do { unsigned _sp = 0; while (cond) { __builtin_amdgcn_s_sleep(1); \
    if ((++_sp & 255u) == 0u) { if (xb_ld(&(bar)[XB_TMO])) break; if (_sp > XB_SPIN_CAP) { atomicAdd(&(bar)[XB_TMO], 1u); break; } } } } while (0)

struct XcdBarrier {
    unsigned* bar; unsigned x;
    volatile LAS unsigned* st;
};

__device__ __forceinline__ XcdBarrier xcd_barrier_post(unsigned* bar, volatile LAS unsigned* st) {
    XcdBarrier b; b.bar = bar; b.x = xb_xcc_id(); b.st = st;
    if (threadIdx.x == 0) (void)xb_add(&bar[XB_XCNT(b.x)], 1u);
    return b;
}
__device__ __forceinline__ void xcd_barrier_complete(unsigned* bar, unsigned x, unsigned& nloc, unsigned& nx) {
    const unsigned G = gridDim.x * gridDim.y * gridDim.z;
    unsigned sum, cnt, mine, sp = 0u;
    for (;;) {
        sum = 0u; cnt = 0u; mine = 0u;
#pragma unroll
        for (unsigned j = 0; j < 16; ++j) { const unsigned c = xb_ld(&bar[XB_XCNT(j)]); sum += c; cnt += (c > 0u) ? 1u : 0u; mine = (j == x) ? c : mine; }
        if (sum == G) break;
        __builtin_amdgcn_s_sleep(1);
        if ((++sp & 255u) == 0u) { if (xb_ld(&bar[XB_TMO])) break; if (sp > XB_SPIN_CAP) { atomicAdd(&bar[XB_TMO], 1u); break; } }
    }
    nloc = mine > 0u ? mine : 1u; nx = cnt > 0u ? cnt : 1u;
}

__device__ __forceinline__ void xcd_barrier(const XcdBarrier& b) {
    asm volatile("s_waitcnt vmcnt(0)" ::: "memory");
    __syncthreads();
    if (threadIdx.x == 0) {
        unsigned* bar = b.bar;
        __builtin_amdgcn_s_waitcnt(0);
        unsigned nloc = b.st[0], nx = b.st[1];
        if (nloc == 0u) { xcd_barrier_complete(bar, b.x, nloc, nx); b.st[0] = nloc; b.st[1] = nx; }
        const unsigned old = xb_add(&bar[XB_XSUB(b.x)], 1u);
        const unsigned gen = old / nloc;
        if (old + 1u == (gen + 1u) * nloc) {
            __builtin_amdgcn_fence(__ATOMIC_RELEASE, "agent");
            asm volatile("s_waitcnt vmcnt(0)" ::: "memory");
            const unsigned og = xb_add(&bar[XB_TOP], 1u);
            const unsigned tg = og / nx;
            if (og + 1u == (tg + 1u) * nx) xb_add(&bar[XB_TOPGEN], 1u);
            else XB_SPIN(xb_ld(&bar[XB_TOPGEN]) == tg, bar);
            __builtin_amdgcn_fence(__ATOMIC_ACQUIRE, "agent");
            xb_add(&bar[XB_XGEN(b.x)], 1u);
            asm volatile("s_waitcnt vmcnt(0)" ::: "memory");
        } else {
            XB_SPIN(xb_ld(&bar[XB_XGEN(b.x)]) == gen, bar);
            __builtin_amdgcn_fence(__ATOMIC_ACQUIRE, "agent");
            asm volatile("s_waitcnt vmcnt(0)" ::: "memory");
        }
    }
    __syncthreads();
}

using pg8::Unit;
typedef unsigned u32x2 __attribute__((ext_vector_type(2)));
typedef unsigned u32x4_t __attribute__((ext_vector_type(4)));
__device__ __forceinline__ f32x16 mfma32(bf16x8 a, bf16x8 b, f32x16 c) { return __builtin_amdgcn_mfma_f32_32x32x16_bf16(a, b, c, 0, 0, 0); }
__device__ __forceinline__ bf16x8 pack8(float a0, float a1, float a2, float a3, float a4, float a5, float a6, float a7) {
    union { uint4 u; bf16x8 v; } x; x.u.x = pk2(a0, a1); x.u.y = pk2(a2, a3); x.u.z = pk2(a4, a5); x.u.w = pk2(a6, a7); return x.v;
}
__device__ __forceinline__ f32x16 zero16() { f32x16 z; for (int i = 0; i < 16; ++i) z[i] = 0.f; return z; }


__device__ __forceinline__ void st_bf4(bf16_t* dst, f32x4 v) { uint2 w; w.x = pk2(v[0], v[1]); w.y = pk2(v[2], v[3]); *(uint2*)dst = w; }

constexpr float QSCALE = 0.125f * 1.4426950408889634f;
struct EpiIn {
    static constexpr bool PERM = false, AFTER_DRAIN = false;
    P p; int row0; int pn0;
    __device__ __forceinline__ void operator()(const f32x4 (&acc)[2][2][4][2], const Unit& u, int wr, int wc, int fr, int fq) const { body<0, 2, 0, 2>(acc, u, wr, wc, fr, fq); }
    template <int AI0, int AI1, int BJ0, int BJ1>
    __device__ __forceinline__ void body(const f32x4 (&acc)[2][2][4][2], const Unit& u, int wr, int wc, int fr, int fq) const {
        const int pn = pn0 + u.pn;
#pragma unroll
        for (int ai = AI0; ai < AI1; ++ai)
#pragma unroll
            for (int m = 0; m < 4; ++m) {
                const int row = row0 + u.pm * 256 + ai * 128 + wr * 64 + m * 16 + fr;
                if (pn < 5) {
                    const int pi = row < NP ? (row & (SEQ - 1)) : 4096 + ((row - NP) & 7);
                    const int d0 = 16 * (wc & 1) + 4 * fq;
                    const f32x4 cs = *(const f32x4*)(p.tabc() + pi * 32 + d0), sn = *(const f32x4*)(p.tabs() + pi * 32 + d0);
#pragma unroll
                    for (int bj = BJ0; bj < BJ1; ++bj) {
                        const f32x4 x1 = acc[ai][bj][m][0], x2 = acc[ai][bj][m][1];
                        if (pn < 2) {
                            const int head = pn * 4 + bj * 2 + (wc >> 1);
                            const f32x4 o1 = (x1 * cs - x2 * sn) * QSCALE, o2 = (x2 * cs + x1 * sn) * QSCALE;
                            bf16_t* q = p.qb() + (size_t)row * 512 + head * 64 + d0;
                            st_bf4(q, o1); st_bf4(q + 32, o2);
                        } else {
                            const int br = pn - 2, g = wc >> 1;
                            f32x4 o1, o2;
                            if (bj == 0) { o1 = x1 * cs - x2 * sn; o2 = x2 * cs + x1 * sn; } else { o1 = x1; o2 = x2; }
                            float* dst = nullptr;
                            if (row < NP) {
                                if (br == 0) dst = p.out + O_CMP_P + (size_t)row * 256;
                                else if (br == 1) dst = p.out + O_SEL_P + (size_t)row * 256;
                                else { const int s = row & (SEQ - 1); if (s >= SEQ - 512) dst = p.out + O_WIN_P + ((size_t)(row >> 12) * 512 + (s - (SEQ - 512))) * 256; }
                            } else {
                                const int rs = row - NP;
                                if (br == 0) dst = p.out + O_CMP_S + (size_t)rs * 256;
                                else if (br == 1) dst = p.out + O_SEL_S + (size_t)rs * 256;
                                else dst = p.out + O_WIN_S + ((size_t)(rs >> 3) * 512 + 504 + (rs & 7)) * 256;
                            }
                            if (dst) { dst += bj * 128 + g * 64 + d0; *(f32x4*)dst = o1; *(f32x4*)(dst + 32) = o2; }
                            if (row < NP) {
                                const int b = row >> 12, s = row & (SEQ - 1);
                                if (bj == 0) {
                                    bf16_t* k = p.kb() + ((size_t)((br * NB + b) * 2 + g) * SEQ + s) * 64 + d0;
                                    st_bf4(k, o1); st_bf4(k + 32, o2);
                                } else if (br == 0) {
                                    bf16_t* v = p.vcr() + ((size_t)(b * 2 + g) * SEQ + s) * 64 + d0;
                                    st_bf4(v, o1); st_bf4(v + 32, o2);
                                } else {
                                    bf16_t* v = p.vT() + ((size_t)(((br - 1) * NB + b) * 2 + g) * 64 + d0) * SEQ + s;
#pragma unroll
                                    for (int e = 0; e < 4; ++e) { v[(size_t)e * SEQ] = f2bf(o1[e]); v[(size_t)(32 + e) * SEQ] = f2bf(o2[e]); }
                                }
                            }
                        }
                    }
                } else {
#pragma unroll
                    for (int bj = BJ0; bj < BJ1; ++bj) {
                        const int c = bj * 128 + wc * 32 + fq * 8;
                        const f32x4 v0 = acc[ai][bj][m][0], v1 = acc[ai][bj][m][1];
                        auto st8 = [&](bf16_t* dst, const f32x4& a, const f32x4& b) { uint4 w; w.x = pk2(a[0], a[1]); w.y = pk2(a[2], a[3]); w.z = pk2(b[0], b[1]); w.w = pk2(b[2], b[3]); *(uint4*)dst = w; };
                        if (pn < 7 || (pn >= 14 && pn < 16)) {
                            f32x4 o0, o1; for (int e = 0; e < 4; ++e) { o0[e] = silu_fast(v0[e]); o1[e] = silu_fast(v1[e]); }
                            st8((pn < 7 ? p.ag() + (size_t)row * 512 + (pn - 5) * 256 : p.rg() + (size_t)row * 512 + (pn - 14) * 256) + c, o0, o1);
                        } else if (pn < 13) {
                            st8(p.rz() + (size_t)row * CR + (pn - 7) * 256 + c, v0, v1);
                        } else if (pn == 13) {
                            if (c < 128) st8(p.rz() + (size_t)row * CR + 1536 + c, v0, v1);
                            else if (c < 152) { f32x4 o0, o1; for (int e = 0; e < 4; ++e) { o0[e] = sigmoid_fast(v0[e]); o1[e] = sigmoid_fast(v1[e]); }
                                *(f32x4*)(p.gates() + (size_t)row * 32 + (c - 128)) = o0; *(f32x4*)(p.gates() + (size_t)row * 32 + (c - 128) + 4) = o1; }
                        } else {
                            f32x4 o0, o1; for (int e = 0; e < 4; ++e) { o0[e] = sigmoid_fast(v0[e]); o1[e] = sigmoid_fast(v1[e]); }
                            st8(p.mg() + (size_t)row * 2048 + (pn - 16) * 256 + c, o0, o1);
                        }
                    }
                }
            }
    }
};

template <int AI, int BJ>
__device__ __forceinline__ void inproj_sample_quadrant(const P& p, int pn, int wid, int lane) {
    const int wr = wid >> 2, wc = wid & 3, fr = lane & 15, fq = lane >> 4;
    f32x4 acc[2][2][4][2];
#pragma unroll
    for (int m = 0; m < 4; ++m)
#pragma unroll
        for (int n = 0; n < 2; ++n) acc[AI][BJ][m][n] = (f32x4){0.f, 0.f, 0.f, 0.f};
    const bf16_t* ap = p.hb() + (size_t)(NP + AI * 128 + wr * 64 + fr) * DM + 8 * fq;
    const bf16_t* bp = p.WinT() + (size_t)(pn * 256 + BJ * 128 + wc * 32 + fr) * DM + 8 * fq;
    bf16x8 a0[4][2], b0[2][2], a1[4][2], b1[2][2];
    auto ld = [&](bf16x8 (&a)[4][2], bf16x8 (&b)[2][2], int k0) {
#pragma unroll
        for (int i = 0; i < 2; ++i) {
#pragma unroll
            for (int m = 0; m < 4; ++m) a[m][i] = *(const bf16x8*)(ap + (size_t)m * 16 * DM + k0 + 32 * i);
#pragma unroll
            for (int n = 0; n < 2; ++n) b[n][i] = *(const bf16x8*)(bp + (size_t)n * 16 * DM + k0 + 32 * i);
        }
    };
    auto mma = [&](const bf16x8 (&a)[4][2], const bf16x8 (&b)[2][2]) {
#pragma unroll
        for (int i = 0; i < 2; ++i)
#pragma unroll
            for (int m = 0; m < 4; ++m)
#pragma unroll
                for (int n = 0; n < 2; ++n) acc[AI][BJ][m][n] = __builtin_amdgcn_mfma_f32_16x16x32_bf16(b[n][i], a[m][i], acc[AI][BJ][m][n], 0, 0, 0);
    };
    ld(a0, b0, 0);
#pragma unroll 1
    for (int k0 = 0; k0 < DM; k0 += 128) {
        ld(a1, b1, k0 + 64);
        mma(a0, b0);
        if (k0 + 128 < DM) ld(a0, b0, k0 + 128);
        mma(a1, b1);
    }
    EpiIn e; e.p = p; e.row0 = 0; e.pn0 = 0;
    Unit u; u.pm = NP / 256; u.pn = pn;
    e.template body<AI, AI + 1, BJ, BJ + 1>(acc, u, wr, wc, fr, fq);
}
__device__ __forceinline__ void ph_inproj_sample(const P& p) {
    if ((int)blockIdx.x >= 96) return;
    const int wid = threadIdx.x >> 6, lane = threadIdx.x & 63, pn = blockIdx.x >> 2;
    switch (blockIdx.x & 3) {
        case 0: inproj_sample_quadrant<0, 0>(p, pn, wid, lane); break;
        case 1: inproj_sample_quadrant<0, 1>(p, pn, wid, lane); break;
        case 2: inproj_sample_quadrant<1, 0>(p, pn, wid, lane); break;
        default: inproj_sample_quadrant<1, 1>(p, pn, wid, lane); break;
    }
}

struct EpiPlain {
    static constexpr bool PERM = false, AFTER_DRAIN = false;
    float* C; int ldc; int pad_;
    __device__ __forceinline__ void quad(int row, int c, f32x4 v) const { *(f32x4*)(C + (size_t)row * ldc + c) = v; }
    __device__ __forceinline__ void operator()(const f32x4 (&acc)[2][2][4][2], const Unit& u, int wr, int wc, int fr, int fq) const {
#pragma unroll
        for (int ai = 0; ai < 2; ++ai)
#pragma unroll
            for (int m = 0; m < 4; ++m) {
                float* rowp = C + (size_t)(u.pm * 256 + ai * 128 + wr * 64 + m * 16 + fr) * ldc + u.pn * 256 + wc * 32 + 8 * fq;
#pragma unroll
                for (int bj = 0; bj < 2; ++bj)
#pragma unroll
                    for (int n = 0; n < 2; ++n) *(f32x4*)(rowp + bj * 128 + n * 4) = acc[ai][bj][m][n];
            }
    }
};


struct EpiPlainBf {
    static constexpr bool PERM = false, AFTER_DRAIN = false;
    bf16_t* C; int ldc; int pad_;
    __device__ __forceinline__ void operator()(const f32x4 (&acc)[2][2][4][2], const Unit& u, int wr, int wc, int fr, int fq) const {
#pragma unroll
        for (int ai = 0; ai < 2; ++ai)
#pragma unroll
            for (int m = 0; m < 4; ++m) {
                bf16_t* rowp = C + (size_t)(u.pm * 256 + ai * 128 + wr * 64 + m * 16 + fr) * ldc + u.pn * 256 + wc * 32 + 4 * fq;
#pragma unroll
                for (int bj = 0; bj < 2; ++bj)
#pragma unroll
                    for (int n = 0; n < 2; ++n) st_bf4(rowp + bj * 128 + n * 16, acc[ai][bj][m][n]);
            }
    }
};

struct EpiYa {
    static constexpr bool PERM = false, AFTER_DRAIN = false;
    P p;
    __device__ __forceinline__ void quad(int row, int c, f32x4 v) const {
        const uint2 gw = *(const uint2*)(p.mg() + (size_t)row * 2048 + c);
        f32x4 g; g[0] = __uint_as_float(gw.x << 16); g[1] = __uint_as_float(gw.x & 0xffff0000u); g[2] = __uint_as_float(gw.y << 16); g[3] = __uint_as_float(gw.y & 0xffff0000u);
        *(f32x4*)(p.tmp() + (size_t)row * DM + c) = g * v;
    }
    __device__ __forceinline__ void operator()(const f32x4 (&acc)[2][2][4][2], const Unit& u, int wr, int wc, int fr, int fq) const {
#pragma unroll
        for (int ai = 0; ai < 2; ++ai)
#pragma unroll
            for (int m = 0; m < 4; ++m) {
                const int row = u.pm * 256 + ai * 128 + wr * 64 + m * 16 + fr;
#pragma unroll
                for (int bj = 0; bj < 2; ++bj)
#pragma unroll
                    for (int n = 0; n < 2; ++n) {
                        const int c = u.pn * 256 + bj * 128 + wc * 32 + fq * 8 + n * 4;
                        const uint2 gw = *(const uint2*)(p.mg() + (size_t)row * 2048 + c);
                        f32x4 g; g[0] = __uint_as_float(gw.x << 16); g[1] = __uint_as_float(gw.x & 0xffff0000u); g[2] = __uint_as_float(gw.y << 16); g[3] = __uint_as_float(gw.y & 0xffff0000u);
                        *(f32x4*)(p.tmp() + (size_t)row * DM + c) = g * acc[ai][bj][m][n];
                    }
            }
    }
};
struct EpiYb {
    static constexpr bool PERM = false, AFTER_DRAIN = false;
    P p;
    __device__ __forceinline__ void quad(int row, int c, f32x4 v) const {
        const uint2 gw = *(const uint2*)(p.mg() + (size_t)row * 2048 + 1024 + c);
        f32x4 g; g[0] = __uint_as_float(gw.x << 16); g[1] = __uint_as_float(gw.x & 0xffff0000u); g[2] = __uint_as_float(gw.y << 16); g[3] = __uint_as_float(gw.y & 0xffff0000u);
        st_bf4(p.mb() + (size_t)row * DM + c, *(const f32x4*)(p.tmp() + (size_t)row * DM + c) + g * v);
    }
    __device__ __forceinline__ void operator()(const f32x4 (&acc)[2][2][4][2], const Unit& u, int wr, int wc, int fr, int fq) const {
#pragma unroll
        for (int ai = 0; ai < 2; ++ai)
#pragma unroll
            for (int m = 0; m < 4; ++m) {
                const int row = u.pm * 256 + ai * 128 + wr * 64 + m * 16 + fr;
#pragma unroll
                for (int bj = 0; bj < 2; ++bj)
#pragma unroll
                    for (int n = 0; n < 2; ++n) {
                        const int c = u.pn * 256 + bj * 128 + wc * 32 + fq * 8 + n * 4;
                        const uint2 gw = *(const uint2*)(p.mg() + (size_t)row * 2048 + 1024 + c);
                        f32x4 g; g[0] = __uint_as_float(gw.x << 16); g[1] = __uint_as_float(gw.x & 0xffff0000u); g[2] = __uint_as_float(gw.y << 16); g[3] = __uint_as_float(gw.y & 0xffff0000u);
                        const f32x4 t = *(const f32x4*)(p.tmp() + (size_t)row * DM + c);
                        st_bf4(p.mb() + (size_t)row * DM + c, t + g * acc[ai][bj][m][n]);
                    }
            }
    }
};
struct EpiOut {
    static constexpr bool PERM = false, AFTER_DRAIN = false;
    P p;
    __device__ __forceinline__ void quad(int row, int c, f32x4 a) const {
        const float* xr = p.x_sample + (size_t)(row - NP) * DM;
        const f32x4 v = *(const f32x4*)(xr + c) + a;
        *(f32x4*)(p.x1() + (size_t)row * DM + c) = v;
        st_bf4(p.xg() + (size_t)row * DM + c, v * *(const f32x4*)(p.ple_g + c));
        atomicAdd(p.ss_s() + (row - NP), v[0] * v[0] + v[1] * v[1] + v[2] * v[2] + v[3] * v[3]);
    }
    __device__ __forceinline__ void operator()(const f32x4 (&acc)[2][2][4][2], const Unit& u, int wr, int wc, int fr, int fq) const {
#pragma unroll
        for (int ai = 0; ai < 2; ++ai)
#pragma unroll
            for (int m = 0; m < 4; ++m) {
                const int row = u.pm * 256 + ai * 128 + wr * 64 + m * 16 + fr;
                const float* xr = row < NP ? p.x_prompt + (size_t)row * DM : p.x_sample + (size_t)(row - NP) * DM;
                float ss = 0.f;
#pragma unroll
                for (int bj = 0; bj < 2; ++bj)
#pragma unroll
                    for (int n = 0; n < 2; ++n) {
                        const int c = u.pn * 256 + bj * 128 + wc * 32 + fq * 8 + n * 4;
                        const f32x4 v = *(const f32x4*)(xr + c) + acc[ai][bj][m][n];
                        *(f32x4*)(p.x1() + (size_t)row * DM + c) = v;
                        ss += v[0] * v[0] + v[1] * v[1] + v[2] * v[2] + v[3] * v[3];
                        st_bf4(p.xg() + (size_t)row * DM + c, v * *(const f32x4*)(p.ple_g + c));
                    }
                ss += __shfl_xor(ss, 16); ss += __shfl_xor(ss, 32);
                if (fq == 0) p.ss1()[(size_t)row * 16 + u.pn * 4 + wc] = ss;
            }
    }
};
struct EpiGate {
    static constexpr bool PERM = false, AFTER_DRAIN = false;
    P p;
    __device__ __forceinline__ void quad(int row, int c, f32x4 acc) const {
        const float rstd = rsqrtf(p.ss_s()[row - NP] * (1.0f / DM) + 1e-6f);
        const f32x4 a = acc * rstd;
        f32x4 g; for (int e = 0; e < 4; ++e) g[e] = sigmoidf_(a[e]);
        float* ppp = p.pp() + (size_t)row * DM + c;
        *(f32x4*)ppp = *(const f32x4*)(p.x1() + (size_t)row * DM + c) + g * *(const f32x4*)ppp;
    }
    __device__ __forceinline__ void operator()(const f32x4 (&acc)[2][2][4][2], const Unit& u, int wr, int wc, int fr, int fq) const {
#pragma unroll
        for (int ai = 0; ai < 2; ++ai)
#pragma unroll
            for (int m = 0; m < 4; ++m) {
                const int row = u.pm * 256 + ai * 128 + wr * 64 + m * 16 + fr;
                float ss = 0.f;
#pragma unroll
                for (int i = 0; i < 4; ++i) { const f32x4 t = *(const f32x4*)(p.ss1() + (size_t)row * 16 + i * 4); ss += (t[0] + t[1]) + (t[2] + t[3]); }
                const float rstd = rsqrtf(ss * (1.0f / DM) + 1e-6f);
#pragma unroll
                for (int bj = 0; bj < 2; ++bj)
#pragma unroll
                    for (int n = 0; n < 2; ++n) {
                        const int c = u.pn * 256 + bj * 128 + wc * 32 + fq * 8 + n * 4;
                        const f32x4 a = acc[ai][bj][m][n] * rstd;
                        f32x4 g; for (int e = 0; e < 4; ++e) g[e] = sigmoidf_(a[e]);
                        float* ppp = p.pp() + (size_t)row * DM + c;
                        *(f32x4*)ppp = *(const f32x4*)(p.x1() + (size_t)row * DM + c) + g * *(const f32x4*)ppp;
                    }
            }
    }
};

__device__ __forceinline__ void ph_final(const P& p) {
    const int tid = threadIdx.x, lane = tid & 63, wid = tid >> 6;
    const int nw = gridDim.x * 8;
    for (int row0 = blockIdx.x * 8 + wid; row0 < MR; row0 += 2 * nw) {
        float4 v[2][4]; float ss[2];
#pragma unroll
        for (int u = 0; u < 2; ++u) {
            const int row = row0 + u * nw < MR ? row0 + u * nw : row0;
            const float4* src = (const float4*)(p.pp() + (size_t)row * DM);
            ss[u] = 0.f;
#pragma unroll
            for (int i = 0; i < 4; ++i) { v[u][i] = src[lane + 64 * i]; ss[u] += v[u][i].x * v[u][i].x + v[u][i].y * v[u][i].y + v[u][i].z * v[u][i].z + v[u][i].w * v[u][i].w; }
        }
#pragma unroll
        for (int u = 0; u < 2; ++u) {
            const int row = row0 + u * nw;
            const float tot = wave_sum(ss[u]);
            const float rstd = rsqrtf(tot * (1.0f / DM) + 1e-6f);
            if (row < MR) {
                float4* dst = (float4*)(p.out + (row < NP ? O_Y_P + (size_t)row * DM : O_Y_S + (size_t)(row - NP) * DM));
#pragma unroll
                for (int i = 0; i < 4; ++i) {
                    const float4 g = ((const float4*)p.final_g)[lane + 64 * i];
                    float4 o; o.x = v[u][i].x * rstd * g.x; o.y = v[u][i].y * rstd * g.y; o.z = v[u][i].z * rstd * g.z; o.w = v[u][i].w * rstd * g.w;
                    dst[lane + 64 * i] = o;
                }
            }
        }
    }
}

typedef float f32x4v __attribute__((ext_vector_type(4)));
template <class Epi> __device__ __forceinline__ void small_gemm(const bf16_t* A, const bf16_t* Bt, int K, const Epi& E) {
    const int tid = threadIdx.x, lane = tid & 63, wid = tid >> 6, r16 = lane & 15, q4 = lane >> 4;
    for (int tile = blockIdx.x * 8 + wid; tile < 16 * 64; tile += gridDim.x * 8) {
        const int rt = tile & 15, ct = tile >> 4;
        const bf16_t* ap = A + (size_t)(NP + rt * 16 + r16) * K + 8 * q4;
        const bf16_t* bp = Bt + (size_t)(ct * 16 + r16) * K + 8 * q4;
        f32x4 acc = {0.f, 0.f, 0.f, 0.f};
#pragma unroll 1
        for (int k0 = 0; k0 < K; k0 += 256) {
            bf16x8 af[8], bf[8];
#pragma unroll
            for (int i = 0; i < 8; ++i) { af[i] = *(const bf16x8*)(ap + k0 + 32 * i); bf[i] = *(const bf16x8*)(bp + k0 + 32 * i); }
#pragma unroll
            for (int i = 0; i < 8; ++i) acc = __builtin_amdgcn_mfma_f32_16x16x32_bf16(bf[i], af[i], acc, 0, 0, 0);
        }
        E.quad(NP + rt * 16 + r16, (ct >> 1) * 32 + 8 * q4 + 4 * (ct & 1), acc);
    }
}

__device__ __forceinline__ f32x4 ld_bf4c(const bf16_t* q) { const uint2 w = *(const uint2*)q; f32x4 v; v[0] = __uint_as_float(w.x << 16); v[1] = __uint_as_float(w.x & 0xffff0000u); v[2] = __uint_as_float(w.y << 16); v[3] = __uint_as_float(w.y & 0xffff0000u); return v; }
__device__ __forceinline__ void compress2_tile(const P& p, const bf16_t* LH, int nbg, int nrows, int nblk, bf16_t* kc, bf16_t* vcT, int kvi, int bg, int tile, int lane, LAS unsigned char* wlds) {
    const int col = lane & 31, hb = lane >> 5;
    {
        const int i = tile * 32 + col;
        const bool live = i < nblk;
        const bf16_t* lbase = LH + ((size_t)kvi * nbg * nrows + (size_t)bg * nrows) * 256;
        const bf16_t* w2t = p.W2T() + (size_t)kvi * 64 * 128;
        LAS bf16_t* hs = (LAS bf16_t*)wlds;
        {
            const int rq = lane >> 4, c8 = lane & 15;
            const f32x4 pa = *(const f32x4*)(p.pt() + kvi * 128 + c8 * 8), pb = *(const f32x4*)(p.pt() + kvi * 128 + c8 * 8 + 4);
#pragma unroll
            for (int it = 0; it < 8; ++it) {
                const int rr = 4 * it + rq, gi = tile * 32 + rr;
                const bf16_t* rp = lbase + (size_t)(gi < nblk ? gi : 0) * 256 + c8 * 8;
                const uint4 lo = *(const uint4*)rp, hi = *(const uint4*)(rp + 256 + 128);
                float hv[8];
                const unsigned lw[4] = {lo.x, lo.y, lo.z, lo.w}, hw[4] = {hi.x, hi.y, hi.z, hi.w};
#pragma unroll
                for (int e = 0; e < 4; ++e) {
                    const float pe0 = e < 2 ? pa[2 * e] : pb[2 * e - 4], pe1 = e < 2 ? pa[2 * e + 1] : pb[2 * e - 3];
                    hv[2 * e] = siluf_(__uint_as_float(lw[e] << 16) + __uint_as_float(hw[e] << 16) + pe0);
                    hv[2 * e + 1] = siluf_(__uint_as_float(lw[e] & 0xffff0000u) + __uint_as_float(hw[e] & 0xffff0000u) + pe1);
                }
                *(LAS bf16x8*)(hs + rr * 136 + c8 * 8) = pack8(hv[0], hv[1], hv[2], hv[3], hv[4], hv[5], hv[6], hv[7]);
            }
        }
        WAVE_SYNC();
        f32x16 acc[2]; acc[0] = zero16(); acc[1] = zero16();
#pragma unroll
        for (int ks = 0; ks < 8; ++ks) {
            const int f = 16 * ks + 8 * hb;
            const bf16x8 hf = *(LAS const bf16x8*)(hs + col * 136 + f);
#pragma unroll
            for (int dt = 0; dt < 2; ++dt) {
                const bf16x8 wf = *(const bf16x8*)(w2t + (size_t)(32 * dt + col) * 128 + f);
                acc[dt] = (kvi == 0) ? mfma32(wf, hf, acc[dt]) : mfma32(hf, wf, acc[dt]);
            }
        }
        WAVE_SYNC();
        if (kvi == 0) {
            bf16_t* dst = kc + ((size_t)bg * nrows + i) * 64;
#pragma unroll
            for (int dt = 0; dt < 2; ++dt)
#pragma unroll
                for (int i4 = 0; i4 < 4; ++i4) {
                    const int d = 32 * dt + 8 * i4 + 4 * hb;
                    const f32x4 b2 = *(const f32x4*)(p.cmp_b2 + d);
                    f32x4 v; for (int e = 0; e < 4; ++e) v[e] = live ? acc[dt][4 * i4 + e] + b2[e] : 0.f;
                    st_bf4(dst + d, v);
                }
        } else {
#pragma unroll
            for (int dt = 0; dt < 2; ++dt) {
                const int d = 32 * dt + col;
                const float b2 = p.cmp_b2[64 + d];
                bf16_t* dst = vcT + ((size_t)bg * 64 + d) * nrows + tile * 32;
#pragma unroll
                for (int i4 = 0; i4 < 4; ++i4) {
                    const int r = 8 * i4 + 4 * hb;
                    f32x4 v; for (int e = 0; e < 4; ++e) v[e] = (tile * 32 + r + e) < nblk ? acc[dt][4 * i4 + e] + b2 : 0.f;
                    st_bf4(dst + r, v);
                }
            }
        }
    }
}

__device__ __forceinline__ void ph_compress2(const P& p, const bf16_t* LH, int nbg, int nrows, int nblk, bf16_t* kc, bf16_t* vcT, LAS unsigned char* lds) {
    const int tid = threadIdx.x, lane = tid & 63, wid = tid >> 6;
    const int ntile = nrows >> 5, total = 2 * nbg * ntile;
    for (int it = blockIdx.x * 8 + wid; it < total; it += gridDim.x * 8)
        compress2_tile(p, LH, nbg, nrows, nblk, kc, vcT, it / (ntile * nbg), (it / ntile) % nbg, it % ntile, lane, lds + wid * 8960);
}


__device__ __forceinline__ float dpp_row_sum16(float v) {
    v += __builtin_bit_cast(float, __builtin_amdgcn_mov_dpp(__builtin_bit_cast(int, v), 0xB1, 0xF, 0xF, true));
    v += __builtin_bit_cast(float, __builtin_amdgcn_mov_dpp(__builtin_bit_cast(int, v), 0x4E, 0xF, 0xF, true));
    v += __builtin_bit_cast(float, __builtin_amdgcn_mov_dpp(__builtin_bit_cast(int, v), 0x141, 0xF, 0xF, true));
    v += __builtin_bit_cast(float, __builtin_amdgcn_mov_dpp(__builtin_bit_cast(int, v), 0x140, 0xF, 0xF, true));
    return v;
}
__device__ __forceinline__ float tanh_fast(float x) { const float e = __expf(2.0f * x); return 1.0f - 2.0f / (e + 1.0f); }
__device__ __forceinline__ float half_sum32(float v) { return xsum16(dpp_row_sum16(v)); }
__device__ __forceinline__ const bf16_t* rwkv_prev_row(const P& p, int row) {
    if (row < NP) return (row & (SEQ - 1)) == 0 ? p.zs0() : p.rz() + (size_t)(row - 1) * CR;
    const int rs = row - NP;
    return (rs & 7) == 0 ? p.zs0() + (size_t)(1 + (rs >> 3)) * CR : p.rz() + (size_t)(row - 1) * CR;
}
__device__ __forceinline__ f32x4 ld_bf4(const bf16_t* q) { const uint2 w = *(const uint2*)q; f32x4 v; v[0] = __uint_as_float(w.x << 16); v[1] = __uint_as_float(w.x & 0xffff0000u); v[2] = __uint_as_float(w.y << 16); v[3] = __uint_as_float(w.y & 0xffff0000u); return v; }
__device__ __forceinline__ void ph_rwkv_prep(const P& p) {
    const int tid = threadIdx.x, lane = tid & 63, wid = tid >> 6, col = lane & 31, hb = lane >> 5;
    const int gw = blockIdx.x * 8 + wid, nw = gridDim.x * 8;
    for (int it = gw; it < NB + DB; it += nw) {
        const int row = it < NB ? it * SEQ + SEQ - 1 : NP + (it - NB) * 8 + 7;
        float* so = it < NB ? p.out + O_SH_P + (size_t)it * CR : p.out + O_SH_S + (size_t)(it - NB) * CR;
        const bf16_t* z = p.rz() + (size_t)row * CR;
        for (int i = lane; i < CR; i += 64) so[i] = bf2f(z[i]);
    }
    for (int rnd = 0; rnd < 3; ++rnd) {
        int it;
        if (rnd == 0) it = gw;
        else if ((int)blockIdx.x < 16) break;
        else if (rnd == 1) it = nw + (gw - 128);
        else { if (wid != 0 || (int)blockIdx.x >= 208) break; it = 2 * nw - 128 + ((int)blockIdx.x - 16); }
        if (it >= (MR / 32) * 8) break;
        const int h = it & 7, r0 = (it >> 3) * 32;
        bf16x8 Aw[4], Aa[4];
        {
            const int row = r0 + col;
            const bf16_t* z = p.rz() + (size_t)row * CR;
            const bf16_t* pv = rwkv_prev_row(p, row);
#pragma unroll
            for (int ks = 0; ks < 4; ++ks) {
                const int j0 = 16 * ks + 8 * hb;
                float tw[8], ta[8];
#pragma unroll
                for (int q = 0; q < 2; ++q) {
                    const f32x4 zw = ld_bf4(z + 1536 + j0 + 4 * q), za = ld_bf4(z + 1600 + j0 + 4 * q);
                    const f32x4 pw = ld_bf4(pv + 1536 + j0 + 4 * q), pa = ld_bf4(pv + 1600 + j0 + 4 * q);
                    const f32x4 mw = *(const f32x4*)(p.mu + 1536 + j0 + 4 * q), ma = *(const f32x4*)(p.mu + 1600 + j0 + 4 * q);
#pragma unroll
                    for (int e = 0; e < 4; ++e) { tw[4 * q + e] = tanh_fast(zw[e] + (pw[e] - zw[e]) * mw[e]); ta[4 * q + e] = za[e] + (pa[e] - za[e]) * ma[e]; }
                }
                Aw[ks] = pack8(tw[0], tw[1], tw[2], tw[3], tw[4], tw[5], tw[6], tw[7]);
                Aa[ks] = pack8(ta[0], ta[1], ta[2], ta[3], ta[4], ta[5], ta[6], ta[7]);
            }
        }
        f32x16 accw[2], acca[2];
#pragma unroll
        for (int ct = 0; ct < 2; ++ct) {
            accw[ct] = zero16(); acca[ct] = zero16();
            const size_t wo = (size_t)(h * 64 + 32 * ct + col) * 64 + 8 * hb;
#pragma unroll
            for (int ks = 0; ks < 4; ++ks) {
                accw[ct] = mfma32(Aw[ks], *(const bf16x8*)(p.WupT() + wo + 16 * ks), accw[ct]);
                acca[ct] = mfma32(Aa[ks], *(const bf16x8*)(p.AupT() + wo + 16 * ks), acca[ct]);
            }
        }
        float w0v[2], a0v[2], kkv[2], kav[2], rkv[2], mur[2], muk[2], muv[2];
#pragma unroll
        for (int ct = 0; ct < 2; ++ct) {
            const int c = h * 64 + 32 * ct + col;
            w0v[ct] = p.w0[c]; a0v[ct] = p.a0[c]; kkv[ct] = p.k_k[c]; kav[ct] = p.k_a[c]; rkv[ct] = p.r_k[c];
            mur[ct] = p.mu[c]; muk[ct] = p.mu[512 + c]; muv[ct] = p.mu[1024 + c];
        }
#pragma unroll
        for (int hf = 0; hf < 2; ++hf) {
        float zz[8][2][3], pz[2][2][3];
#pragma unroll
        for (int ii = 0; ii < 8; ++ii) {
            const int i = 8 * hf + ii;
            const bf16_t* z = p.rz() + (size_t)(r0 + (i & 3) + 8 * (i >> 2) + 4 * hb) * CR + h * 64 + col;
#pragma unroll
            for (int ct = 0; ct < 2; ++ct) { zz[ii][ct][0] = bf2f(z[32 * ct]); zz[ii][ct][1] = bf2f(z[512 + 32 * ct]); zz[ii][ct][2] = bf2f(z[1024 + 32 * ct]); }
        }
#pragma unroll
        for (int g2 = 0; g2 < 2; ++g2) {
            const bf16_t* pv = rwkv_prev_row(p, r0 + 8 * (2 * hf + g2) + 4 * hb) + h * 64 + col;
#pragma unroll
            for (int ct = 0; ct < 2; ++ct) { pz[g2][ct][0] = bf2f(pv[32 * ct]); pz[g2][ct][1] = bf2f(pv[512 + 32 * ct]); pz[g2][ct][2] = bf2f(pv[1024 + 32 * ct]); }
        }
#pragma unroll
        for (int ii = 0; ii < 8; ++ii) {
            const int i = 8 * hf + ii;
            const int row = r0 + (i & 3) + 8 * (i >> 2) + 4 * hb;
            float zr[2], zk[2], zv[2], dec[2], av[2], kkr[2], km[2];
            float n2 = 0.f, bon = 0.f;
#pragma unroll
            for (int ct = 0; ct < 2; ++ct) {
                const float z0 = zz[ii][ct][0], z1 = zz[ii][ct][1], z2 = zz[ii][ct][2];
                const int ip = ii > 0 ? ii - 1 : 0;
                const float p0 = (i & 3) ? zz[ip][ct][0] : pz[ii >> 2][ct][0], p1 = (i & 3) ? zz[ip][ct][1] : pz[ii >> 2][ct][1], p2 = (i & 3) ? zz[ip][ct][2] : pz[ii >> 2][ct][2];
                zr[ct] = z0 + (p0 - z0) * mur[ct]; zk[ct] = z1 + (p1 - z1) * muk[ct]; zv[ct] = z2 + (p2 - z2) * muv[ct];
                const float nx = -(w0v[ct] + accw[ct][i]);
                const float sp = fmaxf(nx, 0.f) + __logf(1.0f + __expf(-fabsf(nx)));
                dec[ct] = __expf(-__expf(-sp - 0.5f));
                av[ct] = sigmoidf_(a0v[ct] + acca[ct][i]);
                kkr[ct] = zk[ct] * kkv[ct];
                km[ct] = zk[ct] * (1.0f + (av[ct] - 1.0f) * kav[ct]);
                n2 += kkr[ct] * kkr[ct];
                bon += zr[ct] * km[ct] * rkv[ct];
            }
            n2 = half_sum32(n2); bon = half_sum32(bon);
            const float rn = 1.0f / fmaxf(sqrtf(n2), 1e-12f);
            unsigned char* o = p.rw6() + ((size_t)row * 8 + h) * RW6_STRIDE;
#pragma unroll
            for (int ct = 0; ct < 2; ++ct) {
                const float kk = kkr[ct] * rn;
                const int cl = 32 * ct + col;
                ((float*)o)[cl] = dec[ct];
                bf16_t* ob = (bf16_t*)(o + 256) + cl;
                ob[0] = f2bf(zr[ct]); ob[64] = f2bf(km[ct]); ob[128] = f2bf(zv[ct]); ob[192] = f2bf(kk); ob[256] = f2bf(kk * av[ct]);
            }
            if (col == 0) p.bonus()[(size_t)row * 8 + h] = bon;
        }
        }
    }
}

typedef float f32x2 __attribute__((ext_vector_type(2)));
__device__ __forceinline__ float dpp_row_sum(float v) {
    v += __builtin_bit_cast(float, __builtin_amdgcn_mov_dpp(__builtin_bit_cast(int, v), 0xB1, 0xF, 0xF, true));
    v += __builtin_bit_cast(float, __builtin_amdgcn_mov_dpp(__builtin_bit_cast(int, v), 0x4E, 0xF, 0xF, true));
    v += __builtin_bit_cast(float, __builtin_amdgcn_mov_dpp(__builtin_bit_cast(int, v), 0x141, 0xF, 0xF, true));
    v += __builtin_bit_cast(float, __builtin_amdgcn_mov_dpp(__builtin_bit_cast(int, v), 0x140, 0xF, 0xF, true));
    return v;
}
constexpr int SCAN_TC = 32;
template <int NROWS>
__device__ __forceinline__ void scan_item(const P& p, LAS float* lds, int row0, int T, int h, int half, const float* s0, float* sout) {
    const int tid = threadIdx.x, w = tid >> 6, lane = tid & 63, rl = lane >> 4, kq = lane & 15;
    const bool act = w * 4 < NROWS;
    const int vrow = half * NROWS + (act ? w * 4 : 0) + rl;
    f32x4 S;
    if (s0) S = *(const f32x4*)(s0 + vrow * 64 + kq * 4); else { S[0] = 0.f; S[1] = 0.f; S[2] = 0.f; S[3] = 0.f; }
    const unsigned char* src = p.rw6() + ((size_t)row0 * 8 + h) * RW6_STRIDE;
    const int nchunk = (T + SCAN_TC - 1) / SCAN_TC;
    u32x4_t stg[4];
    int ss[4], sc[4], sl[4];
#pragma unroll
    for (int i = 0; i < 4; ++i) {
        const int idx = i * 512 + tid; ss[i] = idx / 56; sc[i] = idx % 56;
        const int cb = sc[i] - 16, q = cb >> 3;
        sl[i] = sc[i] < 16 ? 64 + 4 * sc[i] : (q == 0 ? 0 : 64 + 64 * q) + 8 * (cb & 7);
    }
    auto put = [&](LAS float* b, int i) {
        LAS float* d = b + ss[i] * 384 + sl[i];
        if (sc[i] < 16) *(LAS u32x4_t*)d = stg[i];
        else {
            f32x4 lo, hi;
            lo[0] = __uint_as_float(stg[i][0] << 16); lo[1] = __uint_as_float(stg[i][0] & 0xffff0000u); lo[2] = __uint_as_float(stg[i][1] << 16); lo[3] = __uint_as_float(stg[i][1] & 0xffff0000u);
            hi[0] = __uint_as_float(stg[i][2] << 16); hi[1] = __uint_as_float(stg[i][2] & 0xffff0000u); hi[2] = __uint_as_float(stg[i][3] << 16); hi[3] = __uint_as_float(stg[i][3] & 0xffff0000u);
            *(LAS f32x4*)d = lo; *(LAS f32x4*)(d + 4) = hi;
        }
    };
    {
        const int ns = T < SCAN_TC ? T : SCAN_TC;
#pragma unroll
        for (int i = 0; i < 4; ++i) if (ss[i] < ns) { stg[i] = *(const u32x4_t*)(src + (size_t)ss[i] * (8 * RW6_STRIDE) + sc[i] * 16); put(lds, i); }
    }
    __syncthreads();
    for (int c = 0; c < nchunk; ++c) {
        const int t0 = c * SCAN_TC;
        const int ns = (T - t0) < SCAN_TC ? (T - t0) : SCAN_TC;
        const bool more = (c + 1) < nchunk;
        const int nns = more ? ((T - t0 - SCAN_TC) < SCAN_TC ? (T - t0 - SCAN_TC) : SCAN_TC) : 0;
        if (more) {
#pragma unroll
            for (int i = 0; i < 4; ++i) if (ss[i] < nns) stg[i] = *(const u32x4_t*)(src + (size_t)(t0 + SCAN_TC + ss[i]) * (8 * RW6_STRIDE) + sc[i] * 16);
        }
        LAS const float* buf = lds + (c & 1) * (SCAN_TC * 384);
        float* yo = p.ybuf() + (size_t)(row0 + t0) * 512 + h * 64 + vrow;
        if (act)
#pragma unroll 4
        for (int s = 0; s < ns; ++s) {
            LAS const float* bs = buf + s * 384 + kq * 4;
            const f32x4 r = *(LAS const f32x4*)(bs), d = *(LAS const f32x4*)(bs + 64), km = *(LAS const f32x4*)(bs + 128),
                        kk = *(LAS const f32x4*)(bs + 256), ka = *(LAS const f32x4*)(bs + 320);
            const float vv = buf[s * 384 + 192 + vrow];
            const f32x4 t1 = S * kk;
            float sa = dpp_row_sum((t1[0] + t1[1]) + (t1[2] + t1[3]));
            sa = -sa;
            S = S * d + ka * sa + km * vv;
            const f32x4 t2 = S * r;
            const float y = dpp_row_sum((t2[0] + t2[1]) + (t2[2] + t2[3]));
            if (kq == 0) yo[(size_t)s * 512] = y;
        }
        if (more) {
            LAS float* nb = lds + ((c + 1) & 1) * (SCAN_TC * 384);
#pragma unroll
            for (int i = 0; i < 4; ++i) if (ss[i] < nns) put(nb, i);
        }
        __syncthreads();
    }
    if (act) *(f32x4*)(sout + vrow * 64 + kq * 4) = S;
}
struct ScanVec { f32x4 r, d, km, kk, ka; float vv; };
__device__ __forceinline__ void scan_ld(ScanVec& v, LAS const float* bs, LAS const float* bv) {
    v.kk = *(LAS const f32x4*)(bs + 256); v.d = *(LAS const f32x4*)(bs + 64); v.ka = *(LAS const f32x4*)(bs + 320);
    v.km = *(LAS const f32x4*)(bs + 128); v.vv = *bv; v.r = *(LAS const f32x4*)(bs);
}
__device__ __forceinline__ float scan_step(f32x4& S, const ScanVec& v) {
    const f32x4 t1 = S * v.kk;
    const float sa = -dpp_row_sum((t1[0] + t1[2]) + (t1[1] + t1[3]));
    S = S * v.d + v.ka * sa + v.km * v.vv;
    const f32x4 t2 = S * v.r;
    return dpp_row_sum((t2[0] + t2[2]) + (t2[1] + t2[3]));
}
__device__ __forceinline__ float scan_step_p(f32x4& S, const ScanVec& v) {
    const f32x4 t1 = S * v.kk;
    const float sa = -dpp_row_sum((t1[0] + t1[2]) + (t1[1] + t1[3]));
    S = S * v.d + v.ka * sa + v.km * v.vv;
    const f32x4 t2 = S * v.r;
    return (t2[0] + t2[2]) + (t2[1] + t2[3]);
}
constexpr int YP_STRIDE = 68;
struct ScanCarry { f32x4 P, ka, r; float sa, hu, ha; };
template <int CTRL> __device__ __forceinline__ float dpp_add_(float v) { return v + __builtin_bit_cast(float, __builtin_amdgcn_mov_dpp(__builtin_bit_cast(int, v), CTRL, 0xF, 0xF, true)); }
#define dpp_add(v, c) dpp_add_<c>(v)
#define SCAN_OPAQUE(x) asm("" : "+v"(x))
__device__ __forceinline__ float scan_step_la(ScanCarry& C, const ScanVec& v) {
    const f32x4 S = C.P + C.ka * C.sa;
    const f32x4 P = S * v.d + v.km * v.vv;
    float U = C.hu, al = C.ha;
    U = dpp_add(U, 0x141); al = dpp_add(al, 0x141); SCAN_OPAQUE(al);
    U = dpp_add(U, 0x140); al = dpp_add(al, 0x140); SCAN_OPAQUE(al);
    const float sa = -(U + C.sa * al);
    const f32x4 x = P * v.kk, z = v.ka * v.kk;
    float hu = (x[0] + x[2]) + (x[1] + x[3]), ha = (z[0] + z[2]) + (z[1] + z[3]);
    SCAN_OPAQUE(ha);
    hu = dpp_add(hu, 0xB1); ha = dpp_add(ha, 0xB1); SCAN_OPAQUE(ha);
    hu = dpp_add(hu, 0x4E); ha = dpp_add(ha, 0x4E);
    asm volatile("" : "+v"(hu), "+v"(ha));
    const f32x4 t2 = S * C.r;
    C.P = P; C.ka = v.ka; C.r = v.r; C.sa = sa; C.hu = hu; C.ha = ha;
    return (t2[0] + t2[2]) + (t2[1] + t2[3]);
}
template <int NROWS>
__device__ __forceinline__ void scan_prompt(const P& p, LAS float* lds, int row0, int h, int part, float* sout) {
    const int tid = threadIdx.x, w = tid >> 6, lane = tid & 63, rl = lane >> 4, kq = lane & 15;
    const bool act = w * 4 < NROWS;
    const int vrow = part * NROWS + (act ? w * 4 : 0) + rl;
    const unsigned char* src = p.rw6() + ((size_t)row0 * 8 + h) * RW6_STRIDE;
    constexpr int nchunk = SEQ / SCAN_TC;
    u32x4_t stg[4];
    int ss[4], sc[4], sl[4], sx[4];
#pragma unroll
    for (int i = 0; i < 4; ++i) {
        const int idx = i * 512 + tid; ss[i] = idx / 56; sc[i] = idx % 56;
        const int cb = sc[i] - 16, q = cb >> 3;
        sl[i] = sc[i] < 16 ? 64 + 4 * sc[i] : (q == 0 ? 0 : 64 + 64 * q) + 8 * (cb & 7);
        sx[i] = (sc[i] >= 16 && q == 3) ? 8 * RW6_STRIDE : 0;
    }
    auto put = [&](LAS float* b, int i) {
        LAS float* d = b + ss[i] * 384 + sl[i];
        if (sc[i] < 16) *(LAS u32x4_t*)d = stg[i];
        else {
            f32x4 lo, hi;
            lo[0] = __uint_as_float(stg[i][0] << 16); lo[1] = __uint_as_float(stg[i][0] & 0xffff0000u); lo[2] = __uint_as_float(stg[i][1] << 16); lo[3] = __uint_as_float(stg[i][1] & 0xffff0000u);
            hi[0] = __uint_as_float(stg[i][2] << 16); hi[1] = __uint_as_float(stg[i][2] & 0xffff0000u); hi[2] = __uint_as_float(stg[i][3] << 16); hi[3] = __uint_as_float(stg[i][3] & 0xffff0000u);
            *(LAS f32x4*)d = lo; *(LAS f32x4*)(d + 4) = hi;
        }
    };
#pragma unroll
    for (int i = 0; i < 4; ++i) if (ss[i] < SCAN_TC) { stg[i] = *(const u32x4_t*)(src + (size_t)ss[i] * (8 * RW6_STRIDE) + sc[i] * 16 + sx[i]); put(lds, i); }
    __syncthreads();
    ScanCarry C;
#pragma unroll
    for (int e = 0; e < 4; ++e) { C.P[e] = 0.f; C.ka[e] = 0.f; C.r[e] = 0.f; }
    C.sa = 0.f; C.hu = 0.f; C.ha = 0.f;
    LAS float* pw = lds + 2 * SCAN_TC * 384 + w * (16 * YP_STRIDE);
    LAS float* pwl = pw + lane;
    LAS const float* prd = pw + kq * YP_STRIDE + rl * 16;
    float* ybase = p.ybuf() + (size_t)(row0 + kq) * 512 + h * 64 + vrow;
    auto flush = [&](int tb) {
        const f32x4 a0 = *(LAS const f32x4*)(prd), a1 = *(LAS const f32x4*)(prd + 4), a2 = *(LAS const f32x4*)(prd + 8), a3 = *(LAS const f32x4*)(prd + 12);
        const f32x4 t = (a0 + a1) + (a2 + a3);
        ybase[(size_t)tb * 512] = (t[0] + t[2]) + (t[1] + t[3]);
    };
#pragma unroll 1
    for (int c = 0; c < nchunk; ++c) {
        const int t0 = c * SCAN_TC;
        const bool more = (c + 1) < nchunk;
        if (more) {
#pragma unroll
            for (int i = 0; i < 4; ++i) if (ss[i] < SCAN_TC) stg[i] = *(const u32x4_t*)(src + (size_t)(t0 + SCAN_TC + ss[i]) * (8 * RW6_STRIDE) + sc[i] * 16 + sx[i]);
        }
        LAS const float* buf = lds + (c & 1) * (SCAN_TC * 384);
        if (act) {
            LAS const float* bk = buf + kq * 4;
            LAS const float* bv = buf + 192 + vrow;
            ScanVec A, B;
            scan_ld(A, bk, bv);
#pragma unroll
            for (int s = 0; s < SCAN_TC; s += 2) {
                scan_ld(B, bk + (s + 1) * 384, bv + (s + 1) * 384);
                __builtin_amdgcn_sched_barrier(0);
                pwl[((s + 15) & 15) * YP_STRIDE] = scan_step_la(C, A);
                if (s == 0) { if (c > 0) flush(t0 - 16); }
                if (s == 16) flush(t0);
                if (s + 2 < SCAN_TC) scan_ld(A, bk + (s + 2) * 384, bv + (s + 2) * 384);
                __builtin_amdgcn_sched_barrier(0);
                pwl[(s & 15) * YP_STRIDE] = scan_step_la(C, B);
            }
        }
        if (more) {
            LAS float* nb = lds + ((c + 1) & 1) * (SCAN_TC * 384);
#pragma unroll
            for (int i = 0; i < 4; ++i) if (ss[i] < SCAN_TC) put(nb, i);
        }
        __syncthreads();
    }
    if (act) {
        const f32x4 S = C.P + C.ka * C.sa;
        const f32x4 t2 = S * C.r;
        pwl[15 * YP_STRIDE] = (t2[0] + t2[2]) + (t2[1] + t2[3]);
        flush(SEQ - 16);
        *(f32x4*)(sout + vrow * 64 + kq * 4) = S;
    }
}
constexpr int NSCAN = 128;
__device__ __forceinline__ void ph_rwkv_scan(const P& p, LAS float* lds) {
    if ((int)blockIdx.x < NSCAN) {
        const int item = blockIdx.x >> 2, part = blockIdx.x & 3;
        scan_prompt<16>(p, lds, (item >> 3) * SEQ, item & 7, part, p.out + O_WKV_P + (size_t)item * 4096);
    } else {
        const int nb = (int)gridDim.x - NSCAN;
        for (int hi = (int)blockIdx.x - NSCAN; hi < 512; hi += nb) {
            const int item = hi >> 1, half = hi & 1;
            scan_item<32>(p, lds, NP + (item >> 3) * 8, 8, item & 7, half, p.state_wkv + (size_t)item * 4096, p.out + O_WKV_S + (size_t)item * 4096);
        }
    }
}

__device__ __forceinline__ void ph_rwkv_post(const P& p) {
    const int tid = threadIdx.x, lane = tid & 63, wid = tid >> 6;
    const int stride = gridDim.x * 8;
    const int first = blockIdx.x * 8 + wid, c = (first & 7) * 64 + lane;
    const float gg = p.gn_g[c], gb = p.gn_b[c];
    for (int it0 = first; it0 < MR * 8; it0 += 4 * stride) {
        float y[4], bon[4], vv[4], rg[4];
#pragma unroll
        for (int u = 0; u < 4; ++u) {
            const int it = it0 + u * stride < MR * 8 ? it0 + u * stride : it0, row = it >> 3;
            y[u] = p.ybuf()[(size_t)row * 512 + c];
            bon[u] = p.bonus()[it];
            vv[u] = bf2f(((const bf16_t*)(p.rw6() + (size_t)it * RW6_STRIDE + 256))[128 + lane]);
            rg[u] = bf2f(p.rg()[(size_t)row * 512 + c]);
        }
#pragma unroll
        for (int u = 0; u < 4; ++u) {
            const int it = it0 + u * stride, row = it >> 3;
            const float s1 = wave_sum(y[u]), s2 = wave_sum(y[u] * y[u]);
            const float mean = s1 * (1.0f / 64.0f);
            const float var = fmaxf(s2 * (1.0f / 64.0f) - mean * mean, 0.f);
            const float dv = y[u] - mean;
            float yn = dv * rsqrtf(var + 64e-5f) * gg + gb;
            yn += bon[u] * vv[u];
            if (it < MR * 8) p.ob()[(size_t)row * 512 + c] = f2bf(yn * rg[u]);
        }
    }
}

__device__ __forceinline__ void ph_cmp_gemm_f32(const P& p, LAS unsigned char* lds) {
    using pg8::lds_byte;
    const int tid = threadIdx.x, wid = __builtin_amdgcn_readfirstlane(tid >> 6), lane = tid & 63, wr = wid >> 2, wc = wid & 3, fr = lane & 15, fq = lane >> 4;
    constexpr int HTB = 16384;
    const int arow_l = 4 * wid + (lane >> 4), acol = 4 * (lane & 15);
    const int swbase = lds_byte(arow_l, acol);
    LAS unsigned long long* rowoff = (LAS unsigned long long*)(lds + 131072);
    unsigned voffB[2];
#pragma unroll
    for (int i = 0; i < 2; ++i) { int R, C; pg8::stage_rc(tid * 16 + i * 8192, R, C); voffB[i] = (unsigned)(R * 1024 + C) * 2u; }
    const unsigned ldsw = (unsigned)wid * 1024u;
    const int aoff = lds_byte(wr * 64 + fr, fq * 8), boff = lds_byte(wc * 32 + fr, fq * 8);
    for (int unit = blockIdx.x; unit < 512; unit += gridDim.x) {
        const int kvi = unit >> 8, bg = (unit >> 2) & 63, c0 = (unit & 3) * 256, b = bg >> 1, g = bg & 1;
        __syncthreads();
        if (tid < 256) {
            const int chunk = c0 + tid;
            const int page = p.page_table[b * 128 + (chunk >> 3)];
            rowoff[tid] = ((unsigned long long)page * 128 + (chunk & 7) * 16) * 256 + kvi * 128 + g * 64;
        }
        const char* bbase = (const char*)(p.W1T() + (size_t)kvi * 256 * 1024);
        f32x4 acc[2][2][4][2];
#pragma unroll
        for (int a = 0; a < 2; ++a)
#pragma unroll
            for (int bb = 0; bb < 2; ++bb)
#pragma unroll
                for (int m = 0; m < 4; ++m)
#pragma unroll
                    for (int n = 0; n < 2; ++n) acc[a][bb][m][n] = (f32x4){0.f, 0.f, 0.f, 0.f};
        f32x4 ar[8];
        auto stage_b = [&](int st, int t) {
#pragma unroll
            for (int h = 0; h < 2; ++h)
#pragma unroll
                for (int i = 0; i < 2; ++i)
                    __builtin_amdgcn_global_load_lds((const unsigned*)(bbase + (size_t)h * 128 * 2048 + (size_t)t * 128 + voffB[i]),
                                                     (PG8_LAS unsigned*)(lds + st * 65536 + 32768 + h * HTB + ldsw + i * 8192), 16, 0, 0);
        };
        auto load_a = [&](int t) {
#pragma unroll
            for (int q = 0; q < 8; ++q) ar[q] = *(const f32x4*)(p.cache_cmp + rowoff[32 * q + arow_l] + (size_t)t * 256 + acol);
        };
        auto write_a = [&](int st) {
            LAS unsigned char* na = lds + st * 65536;
#pragma unroll
            for (int q = 0; q < 8; ++q) *(LAS u32x2*)(na + swbase + (q >> 2) * HTB + (q & 3) * 4096) = (u32x2){pk2(ar[q][0], ar[q][1]), pk2(ar[q][2], ar[q][3])};
        };
        __syncthreads();
        load_a(0);
        stage_b(0, 0);
        write_a(0);
        __syncthreads();
#pragma unroll 1
        for (int t = 0; t < 16; ++t) {
            const int cur = t & 1;
            if (t + 1 < 16) { load_a(t + 1); stage_b(cur ^ 1, t + 1); }
            LAS const unsigned char* sa = lds + cur * 65536;
            LAS const unsigned char* sb = sa + 32768;
#pragma unroll
            for (int ai = 0; ai < 2; ++ai)
#pragma unroll
                for (int bj = 0; bj < 2; ++bj) {
                    bf16x8 Bt[2][2];
#pragma unroll
                    for (int n = 0; n < 2; ++n)
#pragma unroll
                        for (int k = 0; k < 2; ++k) Bt[n][k] = *(LAS const bf16x8*)(sb + bj * HTB + boff + n * 2048 + k * 1024);
#pragma unroll
                    for (int m = 0; m < 4; ++m) {
                        const bf16x8 a0 = *(LAS const bf16x8*)(sa + ai * HTB + aoff + m * 2048), a1 = *(LAS const bf16x8*)(sa + ai * HTB + aoff + m * 2048 + 1024);
#pragma unroll
                        for (int n = 0; n < 2; ++n) {
                            acc[ai][bj][m][n] = __builtin_amdgcn_mfma_f32_16x16x32_bf16(Bt[n][0], a0, acc[ai][bj][m][n], 0, 0, 0);
                            acc[ai][bj][m][n] = __builtin_amdgcn_mfma_f32_16x16x32_bf16(Bt[n][1], a1, acc[ai][bj][m][n], 0, 0, 0);
                        }
                    }
                    __builtin_amdgcn_sched_barrier(0);
                }
            if (t + 1 < 16) write_a(cur ^ 1);
            __syncthreads();
        }
        EpiPlainBf e; e.C = p.LHs() + ((size_t)kvi * 65536 + (size_t)bg * 1024 + c0) * 256; e.ldc = 256; e.pad_ = 0;
        pg8::Unit u; u.pm = 0; u.pn = 0;
        e(acc, u, wr, wc, fr, fq);
    }
}

__device__ __forceinline__ float exp2_(float x) { return __builtin_amdgcn_exp2f(x); }
template <class OKF>
__device__ __forceinline__ void sm_stats(const f32x16& s, int hb, OKF ok, float& m, float& l) {
    float sv[16]; float tmax = -1e30f; unsigned okm = 0;
#pragma unroll
    for (int i = 0; i < 16; ++i) { const int kl = (i & 3) + 8 * (i >> 2) + 4 * hb; const bool k = ok(kl); okm |= (k ? 1u : 0u) << i; sv[i] = k ? s[i] : -1e30f; tmax = fmaxf(tmax, sv[i]); }
    tmax = fmaxf(tmax, __shfl_xor(tmax, 32));
    const float mn = fmaxf(m, tmax), alpha = exp2_(m - mn); m = mn;
    float ps = 0.f;
#pragma unroll
    for (int i = 0; i < 16; ++i) ps += ((okm >> i) & 1u) ? exp2_(sv[i] - mn) : 0.f;
    l = l * alpha + ps;
}
template <class OKF, class VF>
__device__ __forceinline__ void sm_pv(const f32x16& s, int hb, OKF ok, VF vf, float& m, float& l, f32x16 (&o)[2]) {
    float sv[16]; float tmax = -1e30f; unsigned okm = 0;
#pragma unroll
    for (int i = 0; i < 16; ++i) { const int kl = (i & 3) + 8 * (i >> 2) + 4 * hb; const bool k = ok(kl); okm |= (k ? 1u : 0u) << i; sv[i] = k ? s[i] : -1e30f; tmax = fmaxf(tmax, sv[i]); }
    tmax = fmaxf(tmax, __shfl_xor(tmax, 32));
    const float mn = fmaxf(m, tmax), alpha = exp2_(m - mn); m = mn;
    float pr[16]; float ps = 0.f;
#pragma unroll
    for (int i = 0; i < 16; ++i) { pr[i] = ((okm >> i) & 1u) ? exp2_(sv[i] - mn) : 0.f; ps += pr[i]; }
    l = l * alpha + ps;
    o[0] *= alpha; o[1] *= alpha;
#pragma unroll
    for (int s2 = 0; s2 < 2; ++s2) {
        const bf16x8 pb = pack8(pr[8 * s2 + 0], pr[8 * s2 + 1], pr[8 * s2 + 2], pr[8 * s2 + 3], pr[8 * s2 + 4], pr[8 * s2 + 5], pr[8 * s2 + 6], pr[8 * s2 + 7]);
#pragma unroll
        for (int dt = 0; dt < 2; ++dt) o[dt] = mfma32(vf(dt, s2), pb, o[dt]);
    }
}
template <class VF>
__device__ __forceinline__ void sm_pv_nomask(const f32x16& s, bool csel, VF vf, float& m, float& l, f32x16 (&o)[2]) {
    float tmax = fmaxf(fmaxf(s[0], s[1]), s[2]);
#pragma unroll
    for (int i = 3; i < 16; ++i) tmax = fmaxf(tmax, s[i]);
    tmax = csel ? tmax : -1e30f;
    tmax = fmaxf(tmax, __shfl_xor(tmax, 32));
    const float mn = fmaxf(m, tmax), alpha = exp2_(m - mn); m = mn;
    float pr[16]; float ps = 0.f;
#pragma unroll
    for (int i = 0; i < 16; ++i) { pr[i] = csel ? exp2_(s[i] - mn) : 0.f; ps += pr[i]; }
    l = l * alpha + ps;
    o[0] *= alpha; o[1] *= alpha;
#pragma unroll
    for (int s2 = 0; s2 < 2; ++s2) {
        const bf16x8 pb = pack8(pr[8 * s2 + 0], pr[8 * s2 + 1], pr[8 * s2 + 2], pr[8 * s2 + 3], pr[8 * s2 + 4], pr[8 * s2 + 5], pr[8 * s2 + 6], pr[8 * s2 + 7]);
#pragma unroll
        for (int dt = 0; dt < 2; ++dt) o[dt] = mfma32(vf(dt, s2), pb, o[dt]);
    }
}
template <class OKF, class VF>
__device__ __forceinline__ void cmp_pass2(const f32x16& s, int hb, OKF ok, VF vf, float m, float inv, f32x16 (&o)[2], LAS float* prow, bool writer) {
    float pr[16];
#pragma unroll
    for (int i = 0; i < 16; ++i) {
        const int kl = (i & 3) + 8 * (i >> 2) + 4 * hb;
        pr[i] = ok(kl) ? exp2_(s[i] - m) * inv : 0.f;
        float q = pr[i] + __shfl_xor(pr[i], 1); q += __shfl_xor(q, 2);
        if (writer) prow[kl] = q;
    }
#pragma unroll
    for (int s2 = 0; s2 < 2; ++s2) {
        const bf16x8 pb = pack8(pr[8 * s2 + 0], pr[8 * s2 + 1], pr[8 * s2 + 2], pr[8 * s2 + 3], pr[8 * s2 + 4], pr[8 * s2 + 5], pr[8 * s2 + 6], pr[8 * s2 + 7]);
#pragma unroll
        for (int dt = 0; dt < 2; ++dt) o[dt] = mfma32(vf(dt, s2), pb, o[dt]);
    }
}

__device__ __forceinline__ void attn_store(const P& p, const f32x16 (&of)[2], int qrow, int head, int hb, bool doit, bf16_t* oadst = nullptr) {
    if (!oadst) oadst = p.oa();
    if (!doit) return;
#pragma unroll
    for (int dt = 0; dt < 2; ++dt)
#pragma unroll
        for (int i4 = 0; i4 < 4; ++i4) {
            const int d = 32 * dt + 8 * i4 + 4 * hb;
            const size_t off = (size_t)qrow * 512 + head * 64 + d;
            const uint2 gw = *(const uint2*)(p.ag() + off);
            f32x4 v;
            v[0] = of[dt][4 * i4 + 0] * __uint_as_float(gw.x << 16); v[1] = of[dt][4 * i4 + 1] * __uint_as_float(gw.x & 0xffff0000u);
            v[2] = of[dt][4 * i4 + 2] * __uint_as_float(gw.y << 16); v[3] = of[dt][4 * i4 + 3] * __uint_as_float(gw.y & 0xffff0000u);
            st_bf4(oadst + off, v);
        }
}


__device__ __forceinline__ void of_put(LAS float* st, int lane, const f32x16 (&o)[2], float sc) {
#pragma unroll
    for (int dt = 0; dt < 2; ++dt)
#pragma unroll
        for (int i = 0; i < 16; ++i) st[(dt * 16 + i) * 64 + lane] = o[dt][i] * sc;
}
__device__ __forceinline__ void of_add(LAS float* st, int lane, const f32x16 (&o)[2], float sc) {
#pragma unroll
    for (int dt = 0; dt < 2; ++dt)
#pragma unroll
        for (int i = 0; i < 16; ++i) st[(dt * 16 + i) * 64 + lane] += o[dt][i] * sc;
}
__device__ __forceinline__ void of_get_add(LAS float* st, int lane, const f32x16 (&o)[2], float sc, f32x16 (&of)[2]) {
#pragma unroll
    for (int dt = 0; dt < 2; ++dt)
#pragma unroll
        for (int i = 0; i < 16; ++i) of[dt][i] = st[(dt * 16 + i) * 64 + lane] + o[dt][i] * sc;
}


constexpr int WL_STRIDE = 15360, KV_OFF = 8 * WL_STRIDE, KV_BUF = 17920, XB_OFF = KV_OFF + 2 * KV_BUF;

struct LoadBf16 {
    const bf16_t* kbase; const bf16_t* vbase; int ld; bool with_v; u32x4_t kr[2], vr[2];
    static constexpr int DEPTH = 2;
    __device__ __forceinline__ void load(int n, int slot) {
        const int tid = threadIdx.x, srow = tid >> 3, sch = tid & 7;
        const u32x4_t k = *(const u32x4_t*)(kbase + (size_t)(64 * n + srow) * 64 + sch * 8);
        u32x4_t v = k;
        if (with_v) v = *(const u32x4_t*)(vbase + (size_t)srow * ld + 64 * n + sch * 8);
        if (slot) { kr[1] = k; vr[1] = v; } else { kr[0] = k; vr[0] = v; }
    }
    __device__ __forceinline__ void store(LAS unsigned char* buf, int slot) const {
        const int tid = threadIdx.x, srow = tid >> 3, sch = tid & 7;
        const u32x4_t k = slot ? kr[1] : kr[0], v = slot ? vr[1] : vr[0];
        *(LAS u32x4_t*)(buf + srow * 144 + sch * 16) = k;
        if (with_v) { LAS u32x2* vp = (LAS u32x2*)(buf + 9216 + srow * 136 + sch * 16); vp[0] = (u32x2){v[0], v[1]}; vp[1] = (u32x2){v[2], v[3]}; }
    }
};
struct LoadWinF32 {
    const float* cw; const float* nw; f32x4 k0, k1, v0, v1;
    static constexpr int DEPTH = 1;
    __device__ __forceinline__ void load(int n, int) {
        const int tid = threadIdx.x, srow = tid >> 3, sch = tid & 7;
        const int j = 64 * n + srow;
        const float* r = j < 512 ? cw + (size_t)j * 256 : nw + (size_t)(j - 512 < 8 ? j - 512 : 7) * 256;
        k0 = *(const f32x4*)(r + sch * 8); k1 = *(const f32x4*)(r + sch * 8 + 4);
        v0 = *(const f32x4*)(r + 128 + sch * 8); v1 = *(const f32x4*)(r + 128 + sch * 8 + 4);
    }
    __device__ __forceinline__ void store(LAS unsigned char* buf, int) const {
        const int tid = threadIdx.x, srow = tid >> 3, sch = tid & 7;
        u32x4_t kw; kw[0] = pk2(k0[0], k0[1]); kw[1] = pk2(k0[2], k0[3]); kw[2] = pk2(k1[0], k1[1]); kw[3] = pk2(k1[2], k1[3]);
        *(LAS u32x4_t*)(buf + srow * 144 + sch * 16) = kw;
        LAS bf16_t* vb = (LAS bf16_t*)(buf + 9216) + (sch * 8) * 68 + srow;
#pragma unroll
        for (int e = 0; e < 4; ++e) { vb[e * 68] = f2bf(v0[e]); vb[(4 + e) * 68] = f2bf(v1[e]); }
    }
};

template <class LOADER, class NEXT, class ACTIVE, class BODY>
__device__ __forceinline__ void block_loop_g(LOADER ld, LAS unsigned char* kv, int first, NEXT next, ACTIVE active, BODY body) {
    if (first < 0) return;
    int n = first, cur = 0;
    if (LOADER::DEPTH == 2) {
        int nn = next(n), k = 0;
        ld.load(n, 0); ld.store(kv, 0);
        if (nn >= 0) ld.load(nn, 1);
        __syncthreads();
#pragma unroll 1
        for (;;) {
            const int nnn = nn >= 0 ? next(nn) : -1;
            if (nnn >= 0) ld.load(nnn, k & 1);
            if (active(n)) body(n, (LAS const bf16_t*)(kv + cur * KV_BUF), (LAS const bf16_t*)(kv + cur * KV_BUF + 9216));
            if (nn >= 0) ld.store(kv + (cur ^ 1) * KV_BUF, (k + 1) & 1);
            __syncthreads();
            if (nn < 0) break;
            cur ^= 1; n = nn; nn = nnn; ++k;
        }
    } else {
        ld.load(n, 0);
        ld.store(kv, 0);
        __syncthreads();
#pragma unroll 1
        for (;;) {
            const int nn = next(n);
            if (nn >= 0) ld.load(nn, 0);
            if (active(n)) body(n, (LAS const bf16_t*)(kv + cur * KV_BUF), (LAS const bf16_t*)(kv + cur * KV_BUF + 9216));
            if (nn >= 0) ld.store(kv + (cur ^ 1) * KV_BUF, 0);
            __syncthreads();
            if (nn < 0) break;
            cur ^= 1; n = nn;
        }
    }
}
template <bool WITH_V, class NEXT, class ACTIVE, class BODY>
__device__ __forceinline__ void block_loop(const bf16_t* kbase, const bf16_t* vbase, int ld, LAS unsigned char* kv, int first, NEXT next, ACTIVE active, BODY body) {
    LoadBf16 L; L.kbase = kbase; L.vbase = vbase; L.ld = ld; L.with_v = WITH_V;
    block_loop_g(L, kv, first, next, active, body);
}
__device__ __forceinline__ bf16x8 lds_kfrag(LAS const bf16_t* kb, int kt, int ks, int col, int hb) { return *(LAS const bf16x8*)(kb + (32 * kt + col) * 72 + 16 * ks + 8 * hb); }
__device__ __forceinline__ bf16x8 lds_vfrag(LAS const bf16_t* vb, int kt, int dt, int s2, int col, int hb) {
    LAS const bf16_t* ptr = vb + (32 * dt + col) * 68 + 32 * kt + 16 * s2 + 4 * hb;
    union { u32x4_t u; bf16x8 v; } x; const u32x2 a = *(LAS const u32x2*)ptr, c = *(LAS const u32x2*)(ptr + 8); x.u[0] = a[0]; x.u[1] = a[1]; x.u[2] = c[0]; x.u[3] = c[1]; return x.v;
}
__device__ __forceinline__ f32x16 lds_qk(const bf16x8 (&qf)[4], LAS const bf16_t* kb, int kt, int col, int hb) {
    f32x16 s = zero16();
#pragma unroll
    for (int ks = 0; ks < 4; ++ks) s = mfma32(lds_kfrag(kb, kt, ks, col, hb), qf[ks], s);
    return s;
}

__device__ __forceinline__ void attn_prompt_block(const P& p, int bg, int j, LAS unsigned char* lds) {
    int tid_l = threadIdx.x; asm volatile("" : "+v"(tid_l));
    const int tid = tid_l, lane = tid & 63, wid = __builtin_amdgcn_readfirstlane(tid >> 6);
    const int b = bg >> 1, g = bg & 1;
    const int col = lane & 31, hb = lane >> 5, tl = col >> 2, hh = col & 3;
    const int t0 = 64 * j + 8 * wid, qpos = t0 + tl, qrow = b * SEQ + qpos, head = g * 4 + hh;
    LAS unsigned char* wl = lds + wid * WL_STRIDE;
    LAS unsigned char* kv = lds + KV_OFF;
    LAS float* psum = (LAS float*)wl;
    LAS unsigned long long* msk = (LAS unsigned long long*)(wl + 8192);
    bf16x8 qf[4];
#pragma unroll
    for (int ks = 0; ks < 4; ++ks) qf[ks] = *(const bf16x8*)(p.qb() + (size_t)qrow * 512 + head * 64 + 16 * ks + 8 * hb);
    const float g0 = p.gates()[(size_t)qrow * 32 + head * 3 + 0], g1 = p.gates()[(size_t)qrow * 32 + head * 3 + 1], g2 = p.gates()[(size_t)qrow * 32 + head * 3 + 2];
    f32x16 oc[2]; oc[0] = zero16(); oc[1] = zero16();
    {
        const int cmb = 64 * j + 63 - 31;
        const int nbc = ((cmb >> 4) >> 6) + 1;
        const int cmw = t0 + 7 - 31;
        const int cmaxw = cmw >= 0 ? (cmw >> 4) : -1;
        const bf16_t* kc = p.kc_p() + (size_t)bg * 256 * 64;
        const bf16_t* vc = p.vcT_p() + (size_t)bg * 64 * 256;
        float m = -1e30f, l = 0.f;
        block_loop<false>(kc, vc, 256, kv, 0, [&](int n) { return n + 1 < nbc ? n + 1 : -1; }, [&](int n) { return cmaxw >= 64 * n; },
            [&](int n, LAS const bf16_t* kb, LAS const bf16_t* vb) {
#pragma unroll 1
                for (int kt = 0; kt < 2; ++kt) {
                    const f32x16 s = lds_qk(qf, kb, kt, col, hb);
                    sm_stats(s, hb, [&](int kl) { return 16 * (64 * n + 32 * kt + kl) + 31 <= qpos; }, m, l);
                }
            });
        l += __shfl_xor(l, 32);
        const float inv = l > 0.f ? 1.0f / l : 0.f;
#pragma unroll
        for (int i = 0; i < 32; ++i) psum[i * 64 + lane] = 0.f;
        WAVE_SYNC();
        block_loop<true>(kc, vc, 256, kv, 0, [&](int n) { return n + 1 < nbc ? n + 1 : -1; }, [&](int n) { return cmaxw >= 64 * n; },
            [&](int n, LAS const bf16_t* kb, LAS const bf16_t* vb) {
#pragma unroll 1
                for (int kt = 0; kt < 2; ++kt) {
                    const f32x16 s = lds_qk(qf, kb, kt, col, hb);
                    cmp_pass2(s, hb, [&](int kl) { return 16 * (64 * n + 32 * kt + kl) + 31 <= qpos; }, [&](int dt, int s2) { return lds_vfrag(vb, kt, dt, s2, col, hb); }, m, inv, oc,
                              psum + tl * 256 + 64 * n + 32 * kt, hh == 0);
                }
            });
    }
    WAVE_SYNC();
    unsigned long long umw = 0;
    for (int t2 = 0; t2 < 8; ++t2) {
        const int t = t0 + t2, cur = t >> 6, n = lane;
        float imp = 0.f;
#pragma unroll
        for (int c = -1; c < 4; ++c) { const int cc = 4 * n + c; if (cc >= 0) imp += psum[t2 * 256 + cc]; }
        if (n == 0 || n == cur || n == cur - 1) imp = 1e4f;
        if (n * 64 > t) imp = -1.0f;
        int rank = 0;
#pragma unroll
        for (int jj = 0; jj < 64; ++jj) {
            const float vj = __uint_as_float(__builtin_amdgcn_readlane(__float_as_uint(imp), jj));
            rank += (vj > imp || (vj == imp && jj < n)) ? 1 : 0;
        }
        const unsigned long long mk = __ballot(rank < 16);
        if (lane == 0) msk[t2] = mk;
        umw |= mk;
    }
    if (lane == 0) msk[8] = umw;
    __syncthreads();
    const unsigned long long mymask = msk[tl];
    unsigned long long umb = 0;
#pragma unroll
    for (int w2 = 0; w2 < 8; ++w2) umb |= *(LAS const unsigned long long*)(lds + w2 * WL_STRIDE + 8192 + 64);
    {
        const unsigned lo = __builtin_amdgcn_readfirstlane((unsigned)umb), hi = __builtin_amdgcn_readfirstlane((unsigned)(umb >> 32));
        umb = ((unsigned long long)hi << 32) | lo;
        if (j < 63) umb &= (2ull << j) - 1ull;
    }
    LAS float* ost = (LAS float*)wl;
    of_put(ost, lane, oc, g0);
    {
        const bf16_t* kbs = p.kb() + (size_t)((1 * NB + b) * 2 + g) * SEQ * 64;
        const bf16_t* vbs = p.vT() + (size_t)((0 * NB + b) * 2 + g) * 64 * SEQ;
        float m = -1e30f, l = 0.f; f32x16 o[2]; o[0] = zero16(); o[1] = zero16();
        block_loop<true>(kbs, vbs, SEQ, kv, umb ? (int)__builtin_ctzll(umb) : -1,
            [&](int n) { if (n >= 63) return -1; const unsigned long long rem = umb >> (n + 1); return rem ? n + 1 + (int)__builtin_ctzll(rem) : -1; },
            [&](int n) { return (bool)((umw >> n) & 1ull); },
            [&](int n, LAS const bf16_t* kb, LAS const bf16_t* vb) {
                const bool bsel = (mymask >> n) & 1ull;
#pragma unroll
                for (int kt = 0; kt < 2; ++kt) {
                    const int tok0 = 64 * n + 32 * kt;
                    const f32x16 s = lds_qk(qf, kb, kt, col, hb);
                    if (n < j) sm_pv_nomask(s, bsel, [&](int dt, int s2) { return lds_vfrag(vb, kt, dt, s2, col, hb); }, m, l, o);
                    else sm_pv(s, hb, [&](int kl) { return bsel && (tok0 + kl <= qpos); }, [&](int dt, int s2) { return lds_vfrag(vb, kt, dt, s2, col, hb); }, m, l, o);
                }
            });
        l += __shfl_xor(l, 32);
        const float sc = l > 0.f ? g1 / l : 0.f;
        of_add(ost, lane, o, sc);
    }
    {
        const bf16_t* kbw = p.kb() + (size_t)((2 * NB + b) * 2 + g) * SEQ * 64;
        const bf16_t* vbw = p.vT() + (size_t)((1 * NB + b) * 2 + g) * 64 * SEQ;
        float m = -1e30f, l = 0.f; f32x16 o[2]; o[0] = zero16(); o[1] = zero16();
        block_loop<true>(kbw, vbw, SEQ, kv, j > 8 ? j - 8 : 0, [&](int n) { return n < j ? n + 1 : -1; }, [&](int n) { return true; },
            [&](int n, LAS const bf16_t* kb, LAS const bf16_t* vb) {
#pragma unroll 1
                for (int kt = 0; kt < 2; ++kt) {
                    const int tok0 = 64 * n + 32 * kt;
                    const f32x16 s = lds_qk(qf, kb, kt, col, hb);
                    if (n < j && n > j - 8) sm_pv_nomask(s, true, [&](int dt, int s2) { return lds_vfrag(vb, kt, dt, s2, col, hb); }, m, l, o);
                    else sm_pv(s, hb, [&](int kl) { const int key = tok0 + kl; return key <= qpos && key + 511 >= qpos; }, [&](int dt, int s2) { return lds_vfrag(vb, kt, dt, s2, col, hb); }, m, l, o);
                }
            });
        l += __shfl_xor(l, 32);
        const float sc = l > 0.f ? g2 / l : 0.f;
        f32x16 of[2];
        of_get_add(ost, lane, o, sc, of);
        attn_store(p, of, qrow, head, hb, true);
    }
    __syncthreads();
}

__device__ __forceinline__ void attn_sample_block(const P& p, int bg, LAS unsigned char* lds) {
    int tid_l = threadIdx.x; asm volatile("" : "+v"(tid_l));
    const int tid = tid_l, lane = tid & 63, wid = __builtin_amdgcn_readfirstlane(tid >> 6);
    const int b = bg >> 1, g = bg & 1, t = wid;
    const int col = lane & 31, hb = lane >> 5, hh = col & 3;
    const int qrow = NP + b * 8 + t, head = g * 4 + hh;
    LAS unsigned char* wl = lds + wid * WL_STRIDE;
    LAS unsigned char* kv = lds + KV_OFF;
    bf16x8 qf[4];
#pragma unroll
    for (int ks = 0; ks < 4; ++ks) qf[ks] = *(const bf16x8*)(p.qb() + (size_t)qrow * 512 + head * 64 + 16 * ks + 8 * hb);
    LAS float* psum = (LAS float*)wl;
    LAS int* list = (LAS int*)(wl + 8256);
    LAS float* impl = (LAS float*)(wl + 8448);
    LAS bf16_t* vt = (LAS bf16_t*)(wl + 9728);
    const float g0 = p.gates()[(size_t)qrow * 32 + head * 3 + 0], g1 = p.gates()[(size_t)qrow * 32 + head * 3 + 1], g2 = p.gates()[(size_t)qrow * 32 + head * 3 + 2];
    f32x16 oc[2]; oc[0] = zero16(); oc[1] = zero16();
    {
        const bf16_t* kc = p.kc_s() + (size_t)bg * 1024 * 64;
        const bf16_t* vc = p.vcT_s() + (size_t)bg * 64 * 1024;
        float m = -1e30f, l = 0.f;
        block_loop<false>(kc, vc, 1024, kv, 0, [&](int n) { return n < 15 ? n + 1 : -1; }, [&](int n) { return true; },
            [&](int n, LAS const bf16_t* kb, LAS const bf16_t* vb) {
#pragma unroll 1
                for (int kt = 0; kt < 2; ++kt) {
                    const f32x16 s = lds_qk(qf, kb, kt, col, hb);
                    sm_stats(s, hb, [&](int kl) { return 64 * n + 32 * kt + kl <= 1022; }, m, l);
                }
            });
        l += __shfl_xor(l, 32);
        const float inv = l > 0.f ? 1.0f / l : 0.f;
        block_loop<true>(kc, vc, 1024, kv, 0, [&](int n) { return n < 15 ? n + 1 : -1; }, [&](int n) { return true; },
            [&](int n, LAS const bf16_t* kb, LAS const bf16_t* vb) {
#pragma unroll 1
                for (int kt = 0; kt < 2; ++kt) {
                    const f32x16 s = lds_qk(qf, kb, kt, col, hb);
                    cmp_pass2(s, hb, [&](int kl) { return 64 * n + 32 * kt + kl <= 1022; }, [&](int dt, int s2) { return lds_vfrag(vb, kt, dt, s2, col, hb); }, m, inv, oc,
                              psum + 64 * n + 32 * kt, col == 0);
                }
            });
    }
    WAVE_SYNC();
#pragma unroll
    for (int j = 0; j < 5; ++j) {
        const int n = lane + 64 * j;
        if (n <= 256) {
            float imp = 0.f;
            for (int c = -1; c < 4; ++c) { const int cc = 4 * n + c; if (cc >= 0 && cc <= 1022) imp += psum[cc]; }
            impl[n] = imp;
        }
    }
    WAVE_SYNC();
    {
        int base = 0;
#pragma unroll
        for (int j = 0; j < 4; ++j) {
            const int n = lane + 64 * j;
            const bool cand = n >= 1 && n <= 254;
            const float v = impl[n];
            int rank = 0;
            for (int q = 1; q <= 254; ++q) { const float vq = impl[q]; rank += (vq > v || (vq == v && q < n)) ? 1 : 0; }
            const bool sel = cand && rank < 13;
            const unsigned long long mk = __ballot(sel);
            if (sel) list[base + __popcll(mk & ((1ull << lane) - 1ull))] = n;
            base += __popcll(mk);
        }
        if (lane == 0) { list[13] = 0; list[14] = 255; list[15] = 256; }
    }
    WAVE_SYNC();
    if (lane < 16) {
        const int n = list[lane];
        list[16 + lane] = n < 256 ? p.page_table[b * 128 + (n >> 1)] * 128 + (n & 1) * 64 : -1;
    }
    WAVE_SYNC();
    LAS float* ost = (LAS float*)wl;
    of_put(ost, lane, oc, g0);
    {
        float m = -1e30f, l = 0.f; f32x16 o[2]; o[0] = zero16(); o[1] = zero16();
        const float* newrows = p.out + O_SEL_S + (size_t)(b * 8) * 256 + g * 64;
        auto rowptr = [&](int u) -> const float* {
            const int rb = __builtin_amdgcn_readfirstlane(list[16 + (u >> 1)]);
            return rb >= 0 ? p.cache_sel + ((size_t)rb + 32 * (u & 1) + col) * 256 + g * 64 : newrows + (size_t)(col < 8 ? col : 7) * 256;
        };
        f32x4 kA[4], kB[4];
        { const float* kr = rowptr(0) + 8 * hb;
#pragma unroll
          for (int ks = 0; ks < 4; ++ks) { kA[ks] = *(const f32x4*)(kr + 16 * ks); kB[ks] = *(const f32x4*)(kr + 16 * ks + 4); } }
#pragma unroll 1
        for (int u = 0; u < 31; ++u) {
            const bool isnew = __builtin_amdgcn_readfirstlane(list[16 + (u >> 1)]) < 0;
            const float* vr = rowptr(u) + 128 + 32 * hb;
            f32x4 vv[8];
#pragma unroll
            for (int j4 = 0; j4 < 8; ++j4) vv[j4] = *(const f32x4*)(vr + 4 * j4);
            f32x16 s = zero16();
#pragma unroll
            for (int ks = 0; ks < 4; ++ks) s = mfma32(pack8(kA[ks][0], kA[ks][1], kA[ks][2], kA[ks][3], kB[ks][0], kB[ks][1], kB[ks][2], kB[ks][3]), qf[ks], s);
            if (u + 1 < 31) { const float* kr = rowptr(u + 1) + 8 * hb;
#pragma unroll
                for (int ks = 0; ks < 4; ++ks) { kA[ks] = *(const f32x4*)(kr + 16 * ks); kB[ks] = *(const f32x4*)(kr + 16 * ks + 4); } }
#pragma unroll
            for (int j4 = 0; j4 < 8; ++j4)
#pragma unroll
                for (int e = 0; e < 4; ++e) vt[(32 * hb + 4 * j4 + e) * 40 + col] = f2bf(vv[j4][e]);
            WAVE_SYNC();
            sm_pv(s, hb, [&](int kl) { return !isnew || kl <= t; }, [&](int dt, int s2) {
                LAS const bf16_t* ptr = vt + (32 * dt + col) * 40 + 16 * s2 + 4 * hb;
                union { u32x4_t u4; bf16x8 v; } x; const u32x2 a = *(LAS const u32x2*)ptr, c = *(LAS const u32x2*)(ptr + 8); x.u4[0] = a[0]; x.u4[1] = a[1]; x.u4[2] = c[0]; x.u4[3] = c[1]; return x.v; }, m, l, o);
            WAVE_SYNC();
        }
        l += __shfl_xor(l, 32);
        const float sc = l > 0.f ? g1 / l : 0.f;
        of_add(ost, lane, o, sc);
    }
    {
        float m = -1e30f, l = 0.f; f32x16 o[2]; o[0] = zero16(); o[1] = zero16();
        LoadWinF32 L; L.cw = p.cache_win + (size_t)b * 512 * 256 + g * 64; L.nw = p.out + O_WIN_S + ((size_t)b * 512 + 504) * 256 + g * 64;
        block_loop_g(L, kv, 0, [&](int n) { return n < 8 ? n + 1 : -1; }, [&](int n) { return true; },
            [&](int n, LAS const bf16_t* kb, LAS const bf16_t* vb) {
#pragma unroll 1
                for (int kt = 0; kt < 2; ++kt) {
                    const int j0 = 64 * n + 32 * kt;
                    if (j0 >= 520) break;
                    const f32x16 s = lds_qk(qf, kb, kt, col, hb);
                    sm_pv(s, hb, [&](int kl) { const int j = j0 + kl; return j >= t + 1 && j <= 512 + t; }, [&](int dt, int s2) { return lds_vfrag(vb, kt, dt, s2, col, hb); }, m, l, o);
                }
            });
        l += __shfl_xor(l, 32);
        const float sc = l > 0.f ? g2 / l : 0.f;
        f32x16 of[2];
        of_get_add(ost, lane, o, sc, of);
        attn_store(p, of, qrow, head, hb, col < 4);
    }
    __syncthreads();
}

__device__ __forceinline__ void ph_attn(const P& p, LAS unsigned char* lds, int qsel = 0) {
    const int tid = threadIdx.x, lane = tid & 63, wid = tid >> 6;
    unsigned* ctr = p.bar() + 3584 + 64 * qsel;
    LAS unsigned* qslot = (LAS unsigned*)(lds + XB_OFF + 64);
    for (;;) {
        if (tid == 0) *qslot = __hip_atomic_fetch_add(ctr, 1u, __ATOMIC_RELAXED, __HIP_MEMORY_SCOPE_AGENT);
        __syncthreads();
        const unsigned q = __builtin_amdgcn_readfirstlane(*qslot);
        __syncthreads();
        if (q >= 64u + 512u) break;
        if (q < 64u) attn_sample_block(p, (int)q, lds);
        else { const int idx = (int)q - 64; attn_prompt_block(p, idx & 7, 63 - (idx >> 3), lds);
        }
    }
}


constexpr int LDS_BYTES = pg8::STAGE_BYTES;

constexpr int FUSED_LDS = XB_OFF + 256;

template <class Epi> __device__ __forceinline__ void run_gemm(LAS unsigned char* lds, const bf16_t* A, const bf16_t* Bt, int M, int N, int K, const Epi& E, int slot = -1) {
    pg8::Gemm g; g.A = A; g.Bt = Bt; g.M = M; g.N = N; g.K = K; g.pad_ = 0;
    pg8::StaticOrder S; S.init(M, N, (int)gridDim.x, slot >= 0 ? slot : (int)blockIdx.x);
    pg8::gemm_phase<Epi, pg8::StaticOrder, false>((PG8_LAS unsigned char*)lds, g, S, E, nullptr);
}

#define XBAR() xcd_barrier(bar)
__global__ __launch_bounds__(512, 2) void k_fused(P p) {
    extern __shared__ __attribute__((aligned(16))) unsigned char shm[];
    LAS unsigned char* lds = (LAS unsigned char*)shm;
    LAS unsigned* xb = (LAS unsigned*)(lds + XB_OFF);
    if (threadIdx.x == 0) { xb[0] = 0u; xb[1] = 0u; xb[2] = 0u; xb[3] = 0u; }
    __syncthreads();
    XcdBarrier bar = xcd_barrier_post(p.bar(), (volatile LAS unsigned*)xb);
    ph_prep(p);
    XBAR();
    ph_inproj_sample(p);
    { EpiIn e; e.p = p; e.row0 = 0; e.pn0 = 0; run_gemm(lds, p.hb(), p.WinT(), NP, NPAD, DM, e); }
    ph_cmp_gemm_f32(p, lds);
    XBAR();
    if ((int)blockIdx.x < 16) {
        const int kvi = blockIdx.x >> 3, bg = blockIdx.x & 7;
        EpiPlainBf e; e.C = p.LHp() + ((size_t)kvi * 2048 + (size_t)bg * 256) * 256; e.ldc = 256; e.pad_ = 0;
        run_gemm(lds, (kvi ? p.vcr() : p.kb()) + (size_t)bg * 256 * 1024, p.W1T() + (size_t)kvi * 256 * 1024, 256, 256, 1024, e, 0);
        __builtin_amdgcn_fence(__ATOMIC_RELEASE, "agent");
        asm volatile("s_waitcnt vmcnt(0)" ::: "memory");
        __syncthreads();
        __builtin_amdgcn_fence(__ATOMIC_ACQUIRE, "agent");
        asm volatile("s_waitcnt vmcnt(0)" ::: "memory");
        compress2_tile(p, p.LHp(), 8, 256, 255, p.kc_p(), p.vcT_p(), kvi, bg, threadIdx.x >> 6, threadIdx.x & 63, lds + (threadIdx.x >> 6) * 8960);
    }
    ph_rwkv_prep(p);
    ph_compress2(p, p.LHs(), 64, 1024, 1023, p.kc_s(), p.vcT_s(), lds);
    XBAR();
    ph_rwkv_scan(p, (LAS float*)lds);
    __syncthreads();
    ph_attn(p, lds);
    XBAR();
    ph_rwkv_post(p);
    { EpiYa e; e.p = p; small_gemm(p.oa(), p.WpaT(), 512, e); run_gemm(lds, p.oa(), p.WpaT(), NP, DM, 512, e); }
    XBAR();
    { EpiYb e; e.p = p; small_gemm(p.ob(), p.WpbT(), 512, e); run_gemm(lds, p.ob(), p.WpbT(), NP, DM, 512, e); }
    XBAR();
    { EpiOut e; e.p = p; small_gemm(p.mb(), p.WoutT(), DM, e); run_gemm(lds, p.mb(), p.WoutT(), NP, DM, DM, e); }
    { EpiPlain e; e.C = p.pp(); e.ldc = DM; e.pad_ = 0; small_gemm(p.pb(), p.WprojT(), 256, e); run_gemm(lds, p.pb(), p.WprojT(), NP, DM, 256, e); }
    XBAR();
    { EpiGate e; e.p = p; small_gemm(p.xg(), p.WgateT(), DM, e); run_gemm(lds, p.xg(), p.WgateT(), NP, DM, DM, e); }
    XBAR();
    ph_final(p);
}
extern "C" void kernel_launch(void* const* d_in, const int* in_sizes, int n_in, void* d_out, int out_size, void* d_ws, size_t ws_size, hipStream_t stream) {
    (void)in_sizes; (void)n_in; (void)out_size; (void)ws_size;
    P p{};
    p.x_prompt = (const float*)d_in[0]; p.x_sample = (const float*)d_in[1]; p.p_prompt = (const float*)d_in[2]; p.p_sample = (const float*)d_in[3];
    p.cache_cmp = (const float*)d_in[4]; p.cache_sel = (const float*)d_in[5]; p.cache_win = (const float*)d_in[6]; p.state_wkv = (const float*)d_in[7];
    p.state_shift = (const float*)d_in[8]; p.page_table = (const int*)d_in[9]; p.norm_g = (const float*)d_in[10]; p.w_in = (const float*)d_in[11];
    p.cmp_pe = (const float*)d_in[12]; p.cmp_w1 = (const float*)d_in[13]; p.cmp_b1 = (const float*)d_in[14]; p.cmp_w2 = (const float*)d_in[15]; p.cmp_b2 = (const float*)d_in[16];
    p.w_pa = (const float*)d_in[17]; p.mu = (const float*)d_in[18]; p.w0 = (const float*)d_in[19]; p.w_up = (const float*)d_in[20]; p.a0 = (const float*)d_in[21];
    p.a_up = (const float*)d_in[22]; p.k_k = (const float*)d_in[23]; p.k_a = (const float*)d_in[24]; p.r_k = (const float*)d_in[25]; p.gn_g = (const float*)d_in[26];
    p.gn_b = (const float*)d_in[27]; p.w_pb = (const float*)d_in[28]; p.w_out = (const float*)d_in[29]; p.ple_g = (const float*)d_in[30]; p.w_gate = (const float*)d_in[31];
    p.w_proj = (const float*)d_in[32]; p.final_g = (const float*)d_in[33];
    p.out = (float*)d_out;
    p.ws = (unsigned char*)d_ws;

    static int grid = 0;
    if (!grid) {
        int dev = 0, cus = 0, per_cu = 0;
        (void)hipGetDevice(&dev);
        (void)hipDeviceGetAttribute(&cus, hipDeviceAttributeMultiprocessorCount, dev);
        (void)hipFuncSetAttribute((const void*)k_fused, hipFuncAttributeMaxDynamicSharedMemorySize, FUSED_LDS);
        (void)hipOccupancyMaxActiveBlocksPerMultiprocessor(&per_cu, k_fused, 512, FUSED_LDS);
        grid = per_cu >= 1 ? cus : 0;
        if (grid > 256) grid = 256;
    }
    (void)hipMemsetAsync(p.bar(), 0, 32768, stream);
    if (grid > 0) hipLaunchKernelGGL(k_fused, dim3(grid), dim3(512), FUSED_LDS, stream, p);
}
```

```cpp
#include <hip/hip_runtime.h>
#include <stdint.h>
#include <stdio.h>
namespace pg8 {
#define PG8_LAS __attribute__((address_space(3)))
typedef unsigned short bf16_t;
typedef short bf16x8 __attribute__((ext_vector_type(8)));
typedef float f32x4 __attribute__((ext_vector_type(4)));
typedef unsigned u32x4 __attribute__((ext_vector_type(4)));
constexpr int BM = 256, BK = 64, HALF = 128, HTB = HALF * BK * 2  , STAGE_BYTES = 8 * HTB, NXCD = 8, WGM = 8;

__host__ __device__ __forceinline__ int lds_byte(int r, int c) { const int st = (r >> 4) * 2 + (c >> 5), rr = r & 15, cc = c & 31, ob = rr * 64 + cc * 2; return st * 1024 + (ob ^ (((ob >> 9) & 1) << 5)); }
__host__ __device__ __forceinline__ void stage_rc(int b, int& R, int& C) { const int st = b / 1024, sb = b % 1024, swz = sb ^ (((sb >> 9) & 1) << 5); R = (st >> 1) * 16 + swz / 64; C = (st & 1) * 32 + (swz % 64) / 2; }
__host__ __device__ __forceinline__ int perm32(int rho) { const int n = rho >> 4, i = rho & 15; return 8 * (i >> 2) + 4 * n + (i & 3); }

struct Unit { int pm, pn; };
struct Gemm { const bf16_t* A; const bf16_t* Bt; int M, N, K, pad_; };

struct StaticOrder {
    int nM, nN, nwg, G, c;
    __host__ __device__ void init(int M, int N, int G_, int c_) { nM = M / BM; nN = N / BM; nwg = nM * nN; G = G_; c = c_; }
    __host__ __device__ bool next(int i, Unit& u) const {
        const long L = (long)i * G + c; if (L >= nwg) return false;
        int wgid = (int)L; { const int q = nwg / NXCD, r = nwg % NXCD, xcd = wgid % NXCD, off = wgid / NXCD; wgid = (xcd < r ? xcd * (q + 1) : r * (q + 1) + (xcd - r) * q) + off; }
        const int nig = WGM * nN, gid = wgid / nig, fm = gid * WGM, gsz = (nM - fm) < WGM ? (nM - fm) : WGM;
        u.pm = fm + ((wgid % nig) % gsz); u.pn = (wgid % nig) / gsz; return true;
    }
    __device__ __forceinline__ void a_ready(const Unit&) const {}
    __device__ __forceinline__ void done(const Unit&) const {}
};
__device__ __forceinline__ unsigned cvt_pk_bf16(float lo, float hi) { unsigned r; asm volatile("v_cvt_pk_bf16_f32 %0, %1, %2" : "=v"(r) : "v"(lo), "v"(hi)); return r; }
typedef float f32x2 __attribute__((ext_vector_type(2)));
template <class Epi, class Sched, bool STAMP = false>
__device__ __forceinline__ void gemm_phase(PG8_LAS unsigned char* lds, const Gemm g, const Sched& S, const Epi& E, unsigned long long* stamps) {
    int tid_l = threadIdx.x; asm volatile("" : "+v"(tid_l));
    const int tid = tid_l, wid = __builtin_amdgcn_readfirstlane(tid >> 6), lane = tid & 63, wr = wid >> 2, wc = wid & 3, fr = lane & 15, fq = lane >> 4;
    const int K = g.K, nt = K / BK;
    int ts_lo = 0, ts_hi = 0, nts = 0; const unsigned long long rt_entry = STAMP ? (unsigned long long)wall_clock64() : 0ull;
#define PG8_STAMP() do { if (STAMP && wid == 0 && nts < 64) { const unsigned long long _c = (unsigned long long)clock64(); \
        ts_lo = (lane == nts) ? (int)(unsigned)_c : ts_lo; ts_hi = (lane == nts) ? (int)(unsigned)(_c >> 32) : ts_hi; ++nts; } } while (0)
    PG8_STAMP();
    unsigned voffA[2], voffB[2];
#pragma unroll
    for (int i = 0; i < 2; ++i) { int R, C; stage_rc(tid * 16 + i * 8192, R, C); const int Rb = Epi::PERM ? ((R & ~31) + perm32(R & 31)) : R;
        voffA[i] = (unsigned)(R * K + C) * 2u; voffB[i] = (unsigned)(Rb * K + C) * 2u; }
    const size_t kstep = (size_t)(BK * 2);
    const size_t hstep = (size_t)HALF * K * 2;
    const size_t tstep = 2 * hstep;
    const unsigned ldsw = (unsigned)wid * 1024u;
    const int aoff = lds_byte(wr * 64 + fr, fq * 8), boff = lds_byte(wc * 32 + fr, fq * 8);
#define PG8_SA(b, h) (((b) * 2 + (h)) * HTB)
#define PG8_SB(b, h) ((4 + (b) * 2 + (h)) * HTB)
#define PG8_STAGE(bufoff, gbase, voff) do { _Pragma("unroll") for (int _i = 0; _i < 2; ++_i) \
        __builtin_amdgcn_global_load_lds((const unsigned*)((const char*)(gbase) + (voff)[_i]), (PG8_LAS unsigned*)(lds + (bufoff) + ldsw + _i * 8192), 16, 0, 0); } while (0)
#define PG8_LDA(dst, b, h) do { _Pragma("unroll") for (int m = 0; m < 4; ++m) _Pragma("unroll") for (int k = 0; k < 2; ++k) dst[m][k] = *(const PG8_LAS bf16x8*)(lds + PG8_SA(b, h) + aoff + m * 2048 + k * 1024); } while (0)
#define PG8_LDB(dst, b, h) do { _Pragma("unroll") for (int n = 0; n < 2; ++n) _Pragma("unroll") for (int k = 0; k < 2; ++k) dst[n][k] = *(const PG8_LAS bf16x8*)(lds + PG8_SB(b, h) + boff + n * 2048 + k * 1024); } while (0)
#define PG8_MMA(ai, bj, At, Bt) do { __builtin_amdgcn_s_setprio(1); _Pragma("unroll") for (int m = 0; m < 4; ++m) _Pragma("unroll") for (int n = 0; n < 2; ++n) _Pragma("unroll") for (int k = 0; k < 2; ++k) \
        acc[ai][bj][m][n] = __builtin_amdgcn_mfma_f32_16x16x32_bf16(Bt[n][k], At[m][k], acc[ai][bj][m][n], 0, 0, 0); __builtin_amdgcn_s_setprio(0); } while (0)
#define PG8_WAIT_V(n) asm volatile("s_waitcnt vmcnt(" #n ")" ::: "memory")
#define PG8_WAIT_L(n) asm volatile("s_waitcnt lgkmcnt(" #n ")" ::: "memory")
#define PG8_BAR __builtin_amdgcn_s_barrier()
#define PG8_SCHED __builtin_amdgcn_sched_barrier(0)
    Unit cur, nxt; int ui = 0;
    if (!S.next(0, cur)) return;
    f32x4 acc[2][2][4][2];
#pragma unroll
    for (int a = 0; a < 2; ++a)
#pragma unroll
        for (int b = 0; b < 2; ++b)
#pragma unroll
            for (int m = 0; m < 4; ++m)
#pragma unroll
                for (int n = 0; n < 2; ++n) acc[a][b][m][n] = (f32x4){0.f, 0.f, 0.f, 0.f};
    bf16x8 At[4][2], B0[2][2], B1[2][2];
    const char* cA = (const char*)g.A + (size_t)cur.pm * tstep; const char* cB = (const char*)g.Bt + (size_t)cur.pn * tstep;
    S.a_ready(cur);
    PG8_STAGE(PG8_SB(0, 0), cB, voffB); PG8_STAGE(PG8_SA(0, 0), cA, voffA); PG8_STAGE(PG8_SB(0, 1), cB + hstep, voffB); PG8_STAGE(PG8_SA(0, 1), cA + hstep, voffA);
    if (wr == 1) PG8_BAR;
    PG8_WAIT_V(4); PG8_BAR;
    PG8_STAGE(PG8_SB(1, 0), cB + kstep, voffB); PG8_STAGE(PG8_SA(1, 0), cA + kstep, voffA); PG8_STAGE(PG8_SB(1, 1), cB + hstep + kstep, voffB);
    PG8_WAIT_V(6); PG8_BAR;
    PG8_STAMP();
    for (;;) {
        const bool has_next = S.next(ui + 1, nxt);
        const char* nA = has_next ? (const char*)g.A + (size_t)nxt.pm * tstep : cA; const char* nB = has_next ? (const char*)g.Bt + (size_t)nxt.pn * tstep : cB;
        for (int t = 0; t < nt; t += 2) {
            const bool last = (t == nt - 2);
            const char* a1 = cA + (size_t)(t + 1) * kstep;
            const char* a2 = last ? nA : cA + (size_t)(t + 2) * kstep; const char* b2 = last ? nB : cB + (size_t)(t + 2) * kstep;
            const char* a3 = a2 + kstep; const char* b3 = b2 + kstep;
            if (last && has_next) S.a_ready(nxt);
            PG8_LDB(B0, 0, 0); PG8_SCHED; PG8_LDA(At, 0, 0); PG8_STAGE(PG8_SA(1, 1), a1 + hstep, voffA);
            PG8_WAIT_L(8); PG8_BAR; PG8_WAIT_L(0); PG8_MMA(0, 0, At, B0); PG8_BAR; PG8_SCHED;
            PG8_LDB(B1, 0, 1); PG8_STAGE(PG8_SB(0, 0), b2, voffB);
            PG8_BAR; PG8_WAIT_L(0); PG8_MMA(0, 1, At, B1); PG8_BAR;
            PG8_LDA(At, 0, 1); PG8_STAGE(PG8_SA(0, 0), a2, voffA);
            PG8_BAR; PG8_WAIT_L(0); PG8_MMA(1, 0, At, B0); PG8_BAR; PG8_SCHED;
            PG8_STAGE(PG8_SB(0, 1), b2 + hstep, voffB);
            PG8_WAIT_V(6); PG8_BAR; PG8_MMA(1, 1, At, B1); PG8_BAR;
            PG8_LDB(B0, 1, 0); PG8_SCHED; PG8_LDA(At, 1, 0); PG8_STAGE(PG8_SA(0, 1), a2 + hstep, voffA);
            PG8_WAIT_L(8); PG8_BAR; PG8_WAIT_L(0); PG8_MMA(0, 0, At, B0); PG8_BAR; PG8_SCHED;
            PG8_LDB(B1, 1, 1); PG8_STAGE(PG8_SB(1, 0), b3, voffB);
            PG8_BAR; PG8_WAIT_L(0); PG8_MMA(0, 1, At, B1); PG8_BAR;
            PG8_LDA(At, 1, 1); PG8_STAGE(PG8_SA(1, 0), a3, voffA);
            PG8_BAR; PG8_WAIT_L(0); PG8_MMA(1, 0, At, B0); PG8_BAR; PG8_SCHED;
            PG8_STAGE(PG8_SB(1, 1), b3 + hstep, voffB);
            PG8_WAIT_V(6); PG8_BAR; PG8_MMA(1, 1, At, B1); PG8_BAR;
        }
        PG8_STAMP();
        if constexpr (!Epi::AFTER_DRAIN) { E(acc, cur, wr, wc, fr, fq); S.done(cur); }
        PG8_STAMP();
        if (!has_next) break;
#pragma unroll
        for (int a = 0; a < 2; ++a)
#pragma unroll
            for (int b = 0; b < 2; ++b)
#pragma unroll
                for (int m = 0; m < 4; ++m)
#pragma unroll
                    for (int n = 0; n < 2; ++n) acc[a][b][m][n] = (f32x4){0.f, 0.f, 0.f, 0.f};
        cur = nxt; cA = nA; cB = nB; ++ui;
    }
    PG8_WAIT_V(0);
    if (wr == 0) PG8_BAR;
    PG8_BAR;
    if constexpr (Epi::AFTER_DRAIN) { E.fused(acc, cur, wr, wc, fr, fq, lds, wid, lane); S.done(cur); }
    PG8_STAMP();
    if (STAMP && wid == 0) { stamps[lane] = lane < nts ? (((unsigned long long)(unsigned)ts_hi << 32) | (unsigned)ts_lo) : 0ull;
        if (lane == 62) stamps[62] = rt_entry; if (lane == 63) stamps[63] = (unsigned long long)wall_clock64(); }
#undef PG8_STAMP
#undef PG8_SA
#undef PG8_SB
#undef PG8_STAGE
#undef PG8_LDA
#undef PG8_LDB
#undef PG8_MMA
#undef PG8_WAIT_V
#undef PG8_WAIT_L
#undef PG8_BAR
#undef PG8_SCHED
}
}

typedef unsigned short bf16_t;
typedef short bf16x8 __attribute__((ext_vector_type(8)));
typedef float f32x4 __attribute__((ext_vector_type(4)));
typedef float f32x16 __attribute__((ext_vector_type(16)));
#define LAS __attribute__((address_space(3)))
#define WAVE_SYNC() do { asm volatile("s_waitcnt lgkmcnt(0)" ::: "memory"); __builtin_amdgcn_wave_barrier(); } while (0)

constexpr int DM = 1024, NP = 16384, NSMP = 256, MR = 16640, SEQ = 4096, NB = 4, DB = 32, DS = 8, PAST = 16384;
constexpr int CIN = 6040, NPAD = 6144, CR = 1664;
constexpr int NTHR = 512;
constexpr size_t O_Y_P = 0, O_Y_S = 16777216, O_CMP_P = 17039360, O_CMP_S = 21233664, O_SEL_P = 21299200, O_SEL_S = 25493504,
                 O_WIN_P = 25559040, O_WIN_S = 26083328, O_WKV_P = 30277632, O_WKV_S = 30408704, O_SH_P = 31457280, O_SH_S = 31463936;

constexpr size_t ws_al(size_t x) { return (x + 255) & ~(size_t)255; }
constexpr size_t WS_bar = 0;
constexpr size_t WS_hb = WS_bar + ws_al(32768);
constexpr size_t WS_WinT = WS_hb + ws_al((size_t)MR * DM * 2);
constexpr size_t WS_WpaT = WS_WinT + ws_al((size_t)NPAD * DM * 2);
constexpr size_t WS_WpbT = WS_WpaT + ws_al((size_t)DM * 512 * 2);
constexpr size_t WS_WoutT = WS_WpbT + ws_al((size_t)DM * 512 * 2);
constexpr size_t WS_WgateT = WS_WoutT + ws_al((size_t)DM * DM * 2);
constexpr size_t WS_WprojT = WS_WgateT + ws_al((size_t)DM * DM * 2);
constexpr size_t WS_W1T = WS_WprojT + ws_al((size_t)DM * 256 * 2);
constexpr size_t WS_W2T = WS_W1T + ws_al((size_t)512 * 1024 * 2);
constexpr size_t WS_WupT = WS_W2T + ws_al((size_t)128 * 128 * 2);
constexpr size_t WS_AupT = WS_WupT + ws_al((size_t)512 * 64 * 2);
constexpr size_t WS_pb = WS_AupT + ws_al((size_t)512 * 64 * 2);
constexpr size_t WS_tabc = WS_pb + ws_al((size_t)MR * 256 * 2);
constexpr size_t WS_tabs = WS_tabc + ws_al((size_t)4104 * 32 * 4);
constexpr size_t WS_pt = WS_tabs + ws_al((size_t)4104 * 32 * 4);
constexpr size_t WS_qb = WS_pt + ws_al(256 * 4);
constexpr size_t WS_kb = WS_qb + ws_al((size_t)MR * 512 * 2);
constexpr size_t WS_vcr = WS_kb + ws_al((size_t)3 * NB * 2 * SEQ * 64 * 2);
constexpr size_t WS_vT = WS_vcr + ws_al((size_t)NB * 2 * SEQ * 64 * 2);
constexpr size_t WS_ag = WS_vT + ws_al((size_t)2 * NB * 2 * 64 * SEQ * 2);
constexpr size_t WS_rg = WS_ag + ws_al((size_t)MR * 512 * 2);
constexpr size_t WS_mg = WS_rg + ws_al((size_t)MR * 512 * 2);
constexpr size_t WS_gates = WS_mg + ws_al((size_t)MR * 2048 * 2);
constexpr size_t WS_rz = WS_gates + ws_al((size_t)MR * 32 * 4);
constexpr size_t WS_zs0 = WS_rz + ws_al((size_t)MR * CR * 2);
constexpr size_t WS_LHp = WS_zs0 + ws_al((size_t)33 * CR * 2);
constexpr size_t WS_LHs = WS_LHp + ws_al((size_t)2 * 2048 * 256 * 4);
constexpr size_t WS_cs = WS_LHs + ws_al((size_t)2 * 65536 * 256 * 4);
constexpr size_t WS_kc_p = WS_cs + ws_al((size_t)2 * 65536 * 1024 * 2);
constexpr size_t WS_vcT_p = WS_kc_p + ws_al((size_t)8 * 256 * 64 * 2);
constexpr size_t WS_kc_s = WS_vcT_p + ws_al((size_t)8 * 64 * 256 * 2);
constexpr size_t WS_vcT_s = WS_kc_s + ws_al((size_t)64 * 1024 * 64 * 2);
constexpr size_t WS_rw6 = WS_vcT_s + ws_al((size_t)64 * 64 * 1024 * 2);
constexpr int RW6_STRIDE = 896;
constexpr size_t WS_bonus = WS_rw6 + ws_al((size_t)MR * 8 * RW6_STRIDE);
constexpr size_t WS_ybuf = WS_bonus + ws_al((size_t)MR * 8 * 4);
constexpr size_t WS_oa = WS_ybuf + ws_al((size_t)MR * 512 * 4);
constexpr size_t WS_ob = WS_oa + ws_al((size_t)MR * 512 * 2);
constexpr size_t WS_mb = WS_ob + ws_al((size_t)MR * 512 * 2);
constexpr size_t WS_xg = WS_mb + ws_al((size_t)MR * DM * 2);
constexpr size_t WS_tmp = WS_xg + ws_al((size_t)MR * DM * 2);
constexpr size_t WS_x1 = WS_tmp + ws_al((size_t)MR * DM * 4);
constexpr size_t WS_ss1 = WS_x1 + ws_al((size_t)MR * DM * 4);
constexpr size_t WS_pp = WS_ss1 + ws_al((size_t)MR * 16 * 4);
constexpr size_t WS_TOTAL = WS_pp + ws_al((size_t)MR * DM * 4);

struct P {
    const float *x_prompt, *x_sample, *p_prompt, *p_sample, *cache_cmp, *cache_sel, *cache_win, *state_wkv, *state_shift;
    const int* page_table;
    const float *norm_g, *w_in, *cmp_pe, *cmp_w1, *cmp_b1, *cmp_w2, *cmp_b2, *w_pa, *mu, *w0, *w_up, *a0, *a_up, *k_k, *k_a, *r_k, *gn_g, *gn_b,
        *w_pb, *w_out, *ple_g, *w_gate, *w_proj, *final_g;
    float* out;
    unsigned char* ws;
    __host__ __device__ __forceinline__ unsigned* bar() const { return (unsigned*)(ws + WS_bar); }
    __host__ __device__ __forceinline__ float* ss_s() const { return (float*)(ws + WS_bar + 16384); }
    __host__ __device__ __forceinline__ bf16_t* hb() const { return (bf16_t*)(ws + WS_hb); }
    __host__ __device__ __forceinline__ bf16_t* WinT() const { return (bf16_t*)(ws + WS_WinT); }
    __host__ __device__ __forceinline__ bf16_t* WpaT() const { return (bf16_t*)(ws + WS_WpaT); }
    __host__ __device__ __forceinline__ bf16_t* WpbT() const { return (bf16_t*)(ws + WS_WpbT); }
    __host__ __device__ __forceinline__ bf16_t* WoutT() const { return (bf16_t*)(ws + WS_WoutT); }
    __host__ __device__ __forceinline__ bf16_t* WgateT() const { return (bf16_t*)(ws + WS_WgateT); }
    __host__ __device__ __forceinline__ bf16_t* WprojT() const { return (bf16_t*)(ws + WS_WprojT); }
    __host__ __device__ __forceinline__ bf16_t* W1T() const { return (bf16_t*)(ws + WS_W1T); }
    __host__ __device__ __forceinline__ bf16_t* W2T() const { return (bf16_t*)(ws + WS_W2T); }
    __host__ __device__ __forceinline__ bf16_t* WupT() const { return (bf16_t*)(ws + WS_WupT); }
    __host__ __device__ __forceinline__ bf16_t* AupT() const { return (bf16_t*)(ws + WS_AupT); }
    __host__ __device__ __forceinline__ bf16_t* pb() const { return (bf16_t*)(ws + WS_pb); }
    __host__ __device__ __forceinline__ float* tabc() const { return (float*)(ws + WS_tabc); }
    __host__ __device__ __forceinline__ float* tabs() const { return (float*)(ws + WS_tabs); }
    __host__ __device__ __forceinline__ float* pt() const { return (float*)(ws + WS_pt); }
    __host__ __device__ __forceinline__ bf16_t* qb() const { return (bf16_t*)(ws + WS_qb); }
    __host__ __device__ __forceinline__ bf16_t* kb() const { return (bf16_t*)(ws + WS_kb); }
    __host__ __device__ __forceinline__ bf16_t* vcr() const { return (bf16_t*)(ws + WS_vcr); }
    __host__ __device__ __forceinline__ bf16_t* vT() const { return (bf16_t*)(ws + WS_vT); }
    __host__ __device__ __forceinline__ bf16_t* ag() const { return (bf16_t*)(ws + WS_ag); }
    __host__ __device__ __forceinline__ bf16_t* rg() const { return (bf16_t*)(ws + WS_rg); }
    __host__ __device__ __forceinline__ bf16_t* mg() const { return (bf16_t*)(ws + WS_mg); }
    __host__ __device__ __forceinline__ float* gates() const { return (float*)(ws + WS_gates); }
    __host__ __device__ __forceinline__ bf16_t* rz() const { return (bf16_t*)(ws + WS_rz); }
    __host__ __device__ __forceinline__ bf16_t* zs0() const { return (bf16_t*)(ws + WS_zs0); }
    __host__ __device__ __forceinline__ bf16_t* LHp() const { return (bf16_t*)(ws + WS_LHp); }
    __host__ __device__ __forceinline__ bf16_t* LHs() const { return (bf16_t*)(ws + WS_LHs); }
    __host__ __device__ __forceinline__ bf16_t* cs() const { return (bf16_t*)(ws + WS_cs); }
    __host__ __device__ __forceinline__ bf16_t* kc_p() const { return (bf16_t*)(ws + WS_kc_p); }
    __host__ __device__ __forceinline__ bf16_t* vcT_p() const { return (bf16_t*)(ws + WS_vcT_p); }
    __host__ __device__ __forceinline__ bf16_t* kc_s() const { return (bf16_t*)(ws + WS_kc_s); }
    __host__ __device__ __forceinline__ bf16_t* vcT_s() const { return (bf16_t*)(ws + WS_vcT_s); }
    __host__ __device__ __forceinline__ unsigned char* rw6() const { return ws + WS_rw6; }
    __host__ __device__ __forceinline__ float* bonus() const { return (float*)(ws + WS_bonus); }
    __host__ __device__ __forceinline__ float* ybuf() const { return (float*)(ws + WS_ybuf); }
    __host__ __device__ __forceinline__ bf16_t* oa() const { return (bf16_t*)(ws + WS_oa); }
    __host__ __device__ __forceinline__ bf16_t* ob() const { return (bf16_t*)(ws + WS_ob); }
    __host__ __device__ __forceinline__ bf16_t* mb() const { return (bf16_t*)(ws + WS_mb); }
    __host__ __device__ __forceinline__ bf16_t* xg() const { return (bf16_t*)(ws + WS_xg); }
    __host__ __device__ __forceinline__ float* tmp() const { return (float*)(ws + WS_tmp); }
    __host__ __device__ __forceinline__ float* x1() const { return (float*)(ws + WS_x1); }
    __host__ __device__ __forceinline__ float* ss1() const { return (float*)(ws + WS_ss1); }
    __host__ __device__ __forceinline__ float* pp() const { return (float*)(ws + WS_pp); }
};


__device__ __forceinline__ float bf2f(bf16_t b) { return __uint_as_float(((unsigned)b) << 16); }
typedef __bf16 bf16v2_t __attribute__((ext_vector_type(2)));
typedef float f32x2_t __attribute__((ext_vector_type(2)));
__device__ __forceinline__ unsigned pk2(float lo, float hi) { const f32x2_t v = {lo, hi}; return __builtin_bit_cast(unsigned, __builtin_convertvector(v, bf16v2_t)); }
__device__ __forceinline__ bf16_t f2bf(float f) { return (bf16_t)(pk2(f, f) & 0xffffu); }
__device__ __forceinline__ float xsum16(float v) { const auto r = __builtin_amdgcn_permlane16_swap(__float_as_uint(v), __float_as_uint(v), false, false); return __uint_as_float(r[0]) + __uint_as_float(r[1]); }
__device__ __forceinline__ float xsum32(float v) { const auto r = __builtin_amdgcn_permlane32_swap(__float_as_uint(v), __float_as_uint(v), false, false); return __uint_as_float(r[0]) + __uint_as_float(r[1]); }
__device__ __forceinline__ float xmax32(float v) { const auto r = __builtin_amdgcn_permlane32_swap(__float_as_uint(v), __float_as_uint(v), false, false); return fmaxf(__uint_as_float(r[0]), __uint_as_float(r[1])); }
__device__ __forceinline__ float quad_sum(float v) {
    v += __builtin_bit_cast(float, __builtin_amdgcn_mov_dpp(__builtin_bit_cast(int, v), 0xB1, 0xF, 0xF, true));
    v += __builtin_bit_cast(float, __builtin_amdgcn_mov_dpp(__builtin_bit_cast(int, v), 0x4E, 0xF, 0xF, true));
    return v;
}
__device__ __forceinline__ float wave_sum(float v) {
    v += __builtin_bit_cast(float, __builtin_amdgcn_mov_dpp(__builtin_bit_cast(int, v), 0xB1, 0xF, 0xF, true));
    v += __builtin_bit_cast(float, __builtin_amdgcn_mov_dpp(__builtin_bit_cast(int, v), 0x4E, 0xF, 0xF, true));
    v += __builtin_bit_cast(float, __builtin_amdgcn_mov_dpp(__builtin_bit_cast(int, v), 0x141, 0xF, 0xF, true));
    v += __builtin_bit_cast(float, __builtin_amdgcn_mov_dpp(__builtin_bit_cast(int, v), 0x140, 0xF, 0xF, true));
    return xsum32(xsum16(v));
}
__device__ __forceinline__ float sigmoidf_(float x) { return 1.0f / (1.0f + __expf(-x)); }
__device__ __forceinline__ float siluf_(float x) { return x / (1.0f + __expf(-x)); }
__device__ __forceinline__ float sigmoid_fast(float x) { return __builtin_amdgcn_rcpf(1.0f + __expf(-x)); }
__device__ __forceinline__ float silu_fast(float x) { return x * __builtin_amdgcn_rcpf(1.0f + __expf(-x)); }

__device__ __forceinline__ int win_src_col(int np) {
    const int pn = np >> 8, p = np & 255;
    if (pn < 5) {
        const int bj = p >> 7, wc = (p >> 5) & 3, n = (p >> 4) & 1, fq = (p >> 2) & 3, e = p & 3;
        const int d = 32 * n + 16 * (wc & 1) + 4 * fq + e;
        if (pn < 2) { const int head = pn * 4 + bj * 2 + (wc >> 1); return head * 64 + d; }
        const int br = pn - 2, g = wc >> 1;
        return 512 + br * 256 + bj * 128 + g * 64 + d;
    }
    const int s = (p & 0xe0) + 8 * ((p >> 2) & 3) + 4 * ((p >> 4) & 1) + (p & 3);
    if (pn < 7) return 1304 + (pn - 5) * 256 + s;
    if (pn < 13) return 1816 + (pn - 7) * 256 + s;
    if (pn == 13) { if (s < 128) return 1816 + 1536 + s; if (s < 152) return 1280 + (s - 128); return -1; }
    if (pn < 16) return 3480 + (pn - 14) * 256 + s;
    return 3992 + (pn - 16) * 256 + s;
}

__device__ __forceinline__ int perm8(int np) { return (np & ~31) + 8 * ((np >> 2) & 3) + 4 * ((np >> 4) & 1) + (np & 3); }
template <class F>
__device__ __forceinline__ void transpose_cvt(bf16_t* dst, int Nd, int K, F f) {
    const int total = Nd * (K >> 3);
    for (int id = blockIdx.x * NTHR + threadIdx.x; id < total; id += gridDim.x * NTHR) {
        const int n = id % Nd, kc = id / Nd;
        float v[8];
#pragma unroll
        for (int j = 0; j < 8; ++j) v[j] = f(n, kc * 8 + j);
        uint4 w; w.x = pk2(v[0], v[1]); w.y = pk2(v[2], v[3]); w.z = pk2(v[4], v[5]); w.w = pk2(v[6], v[7]);
        *(uint4*)(dst + (size_t)n * K + kc * 8) = w;
    }
}

__device__ __forceinline__ void sincos_small(double r, float& s, float& c) {
    const double r2 = r * r;
    double sa = 1.0, ca = 1.0;
    double ts = 1.0, tc = 1.0; sa = 0.0; ca = 0.0;
#pragma unroll
    for (int k = 0; k < 16; ++k) {
        sa += ts; ca += tc;
        ts = -ts * r2 / (double)((2 * k + 2) * (2 * k + 3));
        tc = -tc * r2 / (double)((2 * k + 1) * (2 * k + 2));
    }
    s = (float)(sa * r); c = (float)ca;
}

__device__ __forceinline__ void ph_prep(const P& p) {
    const int tid = threadIdx.x, lane = tid & 63, wid = tid >> 6;
    const int gw = blockIdx.x * 8 + wid, nw = gridDim.x * 8;
    const int gt = blockIdx.x * NTHR + tid, nt = gridDim.x * NTHR;
    for (int row0 = gw; row0 < MR; row0 += 2 * nw) {
        float4 v[2][4]; float ss[2];
#pragma unroll
        for (int u = 0; u < 2; ++u) {
            const int row = row0 + u * nw < MR ? row0 + u * nw : row0;
            const float4* src = (const float4*)(row < NP ? p.x_prompt + (size_t)row * DM : p.x_sample + (size_t)(row - NP) * DM);
            ss[u] = 0.f;
#pragma unroll
            for (int i = 0; i < 4; ++i) { v[u][i] = src[lane + 64 * i]; ss[u] += v[u][i].x * v[u][i].x + v[u][i].y * v[u][i].y + v[u][i].z * v[u][i].z + v[u][i].w * v[u][i].w; }
        }
#pragma unroll
        for (int u = 0; u < 2; ++u) {
            const int row = row0 + u * nw;
            const float tot = wave_sum(ss[u]);
            const float rstd = rsqrtf(tot * (1.0f / DM) + 1e-6f);
            if (row < MR) {
#pragma unroll
                for (int i = 0; i < 4; ++i) {
                    const float4 g = ((const float4*)p.norm_g)[lane + 64 * i];
                    uint2 w; w.x = pk2(v[u][i].x * rstd * g.x, v[u][i].y * rstd * g.y); w.y = pk2(v[u][i].z * rstd * g.z, v[u][i].w * rstd * g.w);
                    *(uint2*)(p.hb() + (size_t)row * DM + 4 * (lane + 64 * i)) = w;
                }
            }
        }
    }
    { const float* w = p.w_in; transpose_cvt(p.WinT(), NPAD, DM, [=](int n, int k) { const int c = win_src_col(n); return c < 0 ? 0.f : w[(size_t)k * CIN + c]; }); }
    { const float* w = p.w_pa; transpose_cvt(p.WpaT(), DM, 512, [=](int n, int k) { return w[(size_t)k * DM + perm8(n)]; }); }
    { const float* w = p.w_pb; transpose_cvt(p.WpbT(), DM, 512, [=](int n, int k) { return w[(size_t)k * DM + perm8(n)]; }); }
    { const float* w = p.w_out; transpose_cvt(p.WoutT(), DM, DM, [=](int n, int k) { return w[(size_t)k * DM + perm8(n)]; }); }
    { const float* w = p.w_gate; transpose_cvt(p.WgateT(), DM, DM, [=](int n, int k) { return w[(size_t)k * DM + perm8(n)]; }); }
    { const float* w = p.w_proj; transpose_cvt(p.WprojT(), DM, 256, [=](int n, int k) { return w[(size_t)k * DM + perm8(n)]; }); }
    { const float* w = p.cmp_w1; transpose_cvt(p.W1T(), 512, 1024, [=](int n, int k) { const int kvi = n >> 8, nn = n & 255; return w[(size_t)kvi * 262144 + (size_t)((nn >> 7) * 1024 + k) * 128 + (nn & 127)]; }); }
    { const float* w = p.cmp_w2; transpose_cvt(p.W2T(), 128, 128, [=](int n, int k) { return w[(size_t)(n >> 6) * 8192 + (size_t)k * 64 + (n & 63)]; }); }
    { const float* w = p.w_up; transpose_cvt(p.WupT(), 512, 64, [=](int n, int k) { return w[(size_t)k * 512 + n]; }); }
    { const float* w = p.a_up; transpose_cvt(p.AupT(), 512, 64, [=](int n, int k) { return w[(size_t)k * 512 + n]; }); }
    for (int id = gt; id < 33 * CR; id += nt) p.zs0()[id] = id < CR ? (bf16_t)0 : f2bf(p.state_shift[id - CR]);
    for (int id = gt; id < MR * 64; id += nt) {
        const int row = id >> 6, c4 = id & 63;
        const float4 v = ((const float4*)(row < NP ? p.p_prompt + (size_t)row * 256 : p.p_sample + (size_t)(row - NP) * 256))[c4];
        uint2 w; w.x = pk2(v.x, v.y); w.y = pk2(v.z, v.w);
        *(uint2*)(p.pb() + (size_t)row * 256 + c4 * 4) = w;
    }
    for (int id = gt; id < 4104 * 32; id += nt) {
        const int pi = id >> 5, i = id & 31;
        const int pos = pi < 4096 ? pi : PAST + pi - 4096;
        const float inv = (float)exp(-(double)i * (9.210340371976184 / 32.0));
        const float ang = (float)pos * inv;
        const double x = (double)ang;
        const double k = rint(x * 0.15915494309189535);
        const double r = x - k * 6.283185307179586;
        float s, c; sincos_small(r, s, c);
        p.tabc()[id] = c; p.tabs()[id] = s;
    }
    for (int o = gw; o < 256; o += nw) {
        const int kvi = o >> 7, f = o & 127;
        float acc = 0.f;
        for (int jd = lane; jd < 2048; jd += 64) acc += p.cmp_pe[kvi * 2048 + jd] * p.cmp_w1[(size_t)kvi * 262144 + (size_t)jd * 128 + f];
        acc = wave_sum(acc);
        if (lane == 0) p.pt()[o] = acc + p.cmp_b1[o];
    }
    for (int id = gt; id < DB * 504 * 64; id += nt) {
        const int c4 = id & 63, j = (id >> 6) % 504, b = (id >> 6) / 504;
        ((float4*)(p.out + O_WIN_S))[((size_t)b * 512 + j) * 64 + c4] = ((const float4*)p.cache_win)[((size_t)b * 512 + j + 8) * 64 + c4];
    }
}
#define XB_TMO      128
#define XB_XCNT(j)  (256  + 64 * (j))
#define XB_XSUB(j)  (1280 + 64 * (j))
#define XB_XGEN(j)  (2304 + 64 * (j))
#define XB_TOP      3328
#define XB_TOPGEN   3392
#define XCD_BAR_WORDS 3456
#define XB_SPIN_CAP (1u << 18)

__device__ __forceinline__ unsigned xb_ld(unsigned* p)              { return __hip_atomic_load(p, __ATOMIC_RELAXED, __HIP_MEMORY_SCOPE_AGENT); }
__device__ __forceinline__ unsigned xb_add(unsigned* p, unsigned v) { return __hip_atomic_fetch_add(p, v, __ATOMIC_RELAXED, __HIP_MEMORY_SCOPE_AGENT); }
__device__ __forceinline__ unsigned xb_xcc_id() { return (unsigned)__builtin_amdgcn_s_getreg((3 << 11) | 20) & 0xFu; }
#define XB_SPIN(cond, bar) do { unsigned _sp = 0; while (cond) { __builtin_amdgcn_s_sleep(1); \
    if ((++_sp & 255u) == 0u) { if (xb_ld(&(bar)[XB_TMO])) break; if (_sp > XB_SPIN_CAP) { atomicAdd(&(bar)[XB_TMO], 1u); break; } } } } while (0)

struct XcdBarrier {
    unsigned* bar; unsigned x;
    volatile LAS unsigned* st;
};

__device__ __forceinline__ XcdBarrier xcd_barrier_post(unsigned* bar, volatile LAS unsigned* st) {
    XcdBarrier b; b.bar = bar; b.x = xb_xcc_id(); b.st = st;
    if (threadIdx.x == 0) (void)xb_add(&bar[XB_XCNT(b.x)], 1u);
    return b;
}
__device__ __forceinline__ void xcd_barrier_complete(unsigned* bar, unsigned x, unsigned& nloc, unsigned& nx) {
    const unsigned G = gridDim.x * gridDim.y * gridDim.z;
    unsigned sum, cnt, mine, sp = 0u;
    for (;;) {
        sum = 0u; cnt = 0u; mine = 0u;
#pragma unroll
        for (unsigned j = 0; j < 16; ++j) { const unsigned c = xb_ld(&bar[XB_XCNT(j)]); sum += c; cnt += (c > 0u) ? 1u : 0u; mine = (j == x) ? c : mine; }
        if (sum == G) break;
        __builtin_amdgcn_s_sleep(1);
        if ((++sp & 255u) == 0u) { if (xb_ld(&bar[XB_TMO])) break; if (sp > XB_SPIN_CAP) { atomicAdd(&bar[XB_TMO], 1u); break; } }
    }
    nloc = mine > 0u ? mine : 1u; nx = cnt > 0u ? cnt : 1u;
}

__device__ __forceinline__ void xcd_barrier(const XcdBarrier& b) {
    asm volatile("s_waitcnt vmcnt(0)" ::: "memory");
    __syncthreads();
    if (threadIdx.x == 0) {
        unsigned* bar = b.bar;
        __builtin_amdgcn_s_waitcnt(0);
        unsigned nloc = b.st[0], nx = b.st[1];
        if (nloc == 0u) { xcd_barrier_complete(bar, b.x, nloc, nx); b.st[0] = nloc; b.st[1] = nx; }
        const unsigned old = xb_add(&bar[XB_XSUB(b.x)], 1u);
        const unsigned gen = old / nloc;
        if (old + 1u == (gen + 1u) * nloc) {
            __builtin_amdgcn_fence(__ATOMIC_RELEASE, "agent");
            asm volatile("s_waitcnt vmcnt(0)" ::: "memory");
            const unsigned og = xb_add(&bar[XB_TOP], 1u);
            const unsigned tg = og / nx;
            if (og + 1u == (tg + 1u) * nx) xb_add(&bar[XB_TOPGEN], 1u);
            else XB_SPIN(xb_ld(&bar[XB_TOPGEN]) == tg, bar);
            __builtin_amdgcn_fence(__ATOMIC_ACQUIRE, "agent");
            xb_add(&bar[XB_XGEN(b.x)], 1u);
            asm volatile("s_waitcnt vmcnt(0)" ::: "memory");
        } else {
            XB_SPIN(xb_ld(&bar[XB_XGEN(b.x)]) == gen, bar);
            __builtin_amdgcn_fence(__ATOMIC_ACQUIRE, "agent");
            asm volatile("s_waitcnt vmcnt(0)" ::: "memory");
        }
    }
    __syncthreads();
}

using pg8::Unit;
typedef unsigned u32x2 __attribute__((ext_vector_type(2)));
typedef unsigned u32x4_t __attribute__((ext_vector_type(4)));
__device__ __forceinline__ f32x16 mfma32(bf16x8 a, bf16x8 b, f32x16 c) { return __builtin_amdgcn_mfma_f32_32x32x16_bf16(a, b, c, 0, 0, 0); }
__device__ __forceinline__ bf16x8 pack8(float a0, float a1, float a2, float a3, float a4, float a5, float a6, float a7) {
    union { uint4 u; bf16x8 v; } x; x.u.x = pk2(a0, a1); x.u.y = pk2(a2, a3); x.u.z = pk2(a4, a5); x.u.w = pk2(a6, a7); return x.v;
}
__device__ __forceinline__ f32x16 zero16() { f32x16 z; for (int i = 0; i < 16; ++i) z[i] = 0.f; return z; }


__device__ __forceinline__ void st_bf4(bf16_t* dst, f32x4 v) { uint2 w; w.x = pk2(v[0], v[1]); w.y = pk2(v[2], v[3]); *(uint2*)dst = w; }

constexpr float QSCALE = 0.125f * 1.4426950408889634f;
struct EpiIn {
    static constexpr bool PERM = false, AFTER_DRAIN = false;
    P p; int row0; int pn0;
    __device__ __forceinline__ void operator()(const f32x4 (&acc)[2][2][4][2], const Unit& u, int wr, int wc, int fr, int fq) const { body<0, 2, 0, 2>(acc, u, wr, wc, fr, fq); }
    template <int AI0, int AI1, int BJ0, int BJ1>
    __device__ __forceinline__ void body(const f32x4 (&acc)[2][2][4][2], const Unit& u, int wr, int wc, int fr, int fq) const {
        const int pn = pn0 + u.pn;
#pragma unroll
        for (int ai = AI0; ai < AI1; ++ai)
#pragma unroll
            for (int m = 0; m < 4; ++m) {
                const int row = row0 + u.pm * 256 + ai * 128 + wr * 64 + m * 16 + fr;
                if (pn < 5) {
                    const int pi = row < NP ? (row & (SEQ - 1)) : 4096 + ((row - NP) & 7);
                    const int d0 = 16 * (wc & 1) + 4 * fq;
                    const f32x4 cs = *(const f32x4*)(p.tabc() + pi * 32 + d0), sn = *(const f32x4*)(p.tabs() + pi * 32 + d0);
#pragma unroll
                    for (int bj = BJ0; bj < BJ1; ++bj) {
                        const f32x4 x1 = acc[ai][bj][m][0], x2 = acc[ai][bj][m][1];
                        if (pn < 2) {
                            const int head = pn * 4 + bj * 2 + (wc >> 1);
                            const f32x4 o1 = (x1 * cs - x2 * sn) * QSCALE, o2 = (x2 * cs + x1 * sn) * QSCALE;
                            bf16_t* q = p.qb() + (size_t)row * 512 + head * 64 + d0;
                            st_bf4(q, o1); st_bf4(q + 32, o2);
                        } else {
                            const int br = pn - 2, g = wc >> 1;
                            f32x4 o1, o2;
                            if (bj == 0) { o1 = x1 * cs - x2 * sn; o2 = x2 * cs + x1 * sn; } else { o1 = x1; o2 = x2; }
                            float* dst = nullptr;
                            if (row < NP) {
                                if (br == 0) dst = p.out + O_CMP_P + (size_t)row * 256;
                                else if (br == 1) dst = p.out + O_SEL_P + (size_t)row * 256;
                                else { const int s = row & (SEQ - 1); if (s >= SEQ - 512) dst = p.out + O_WIN_P + ((size_t)(row >> 12) * 512 + (s - (SEQ - 512))) * 256; }
                            } else {
                                const int rs = row - NP;
                                if (br == 0) dst = p.out + O_CMP_S + (size_t)rs * 256;
                                else if (br == 1) dst = p.out + O_SEL_S + (size_t)rs * 256;
                                else dst = p.out + O_WIN_S + ((size_t)(rs >> 3) * 512 + 504 + (rs & 7)) * 256;
                            }
                            if (dst) { dst += bj * 128 + g * 64 + d0; *(f32x4*)dst = o1; *(f32x4*)(dst + 32) = o2; }
                            if (row < NP) {
                                const int b = row >> 12, s = row & (SEQ - 1);
                                if (bj == 0) {
                                    bf16_t* k = p.kb() + ((size_t)((br * NB + b) * 2 + g) * SEQ + s) * 64 + d0;
                                    st_bf4(k, o1); st_bf4(k + 32, o2);
                                } else if (br == 0) {
                                    bf16_t* v = p.vcr() + ((size_t)(b * 2 + g) * SEQ + s) * 64 + d0;
                                    st_bf4(v, o1); st_bf4(v + 32, o2);
                                } else {
                                    bf16_t* v = p.vT() + ((size_t)(((br - 1) * NB + b) * 2 + g) * 64 + d0) * SEQ + s;
#pragma unroll
                                    for (int e = 0; e < 4; ++e) { v[(size_t)e * SEQ] = f2bf(o1[e]); v[(size_t)(32 + e) * SEQ] = f2bf(o2[e]); }
                                }
                            }
                        }
                    }
                } else {
#pragma unroll
                    for (int bj = BJ0; bj < BJ1; ++bj) {
                        const int c = bj * 128 + wc * 32 + fq * 8;
                        const f32x4 v0 = acc[ai][bj][m][0], v1 = acc[ai][bj][m][1];
                        auto st8 = [&](bf16_t* dst, const f32x4& a, const f32x4& b) { uint4 w; w.x = pk2(a[0], a[1]); w.y = pk2(a[2], a[3]); w.z = pk2(b[0], b[1]); w.w = pk2(b[2], b[3]); *(uint4*)dst = w; };
                        if (pn < 7 || (pn >= 14 && pn < 16)) {
                            f32x4 o0, o1; for (int e = 0; e < 4; ++e) { o0[e] = silu_fast(v0[e]); o1[e] = silu_fast(v1[e]); }
                            st8((pn < 7 ? p.ag() + (size_t)row * 512 + (pn - 5) * 256 : p.rg() + (size_t)row * 512 + (pn - 14) * 256) + c, o0, o1);
                        } else if (pn < 13) {
                            st8(p.rz() + (size_t)row * CR + (pn - 7) * 256 + c, v0, v1);
                        } else if (pn == 13) {
                            if (c < 128) st8(p.rz() + (size_t)row * CR + 1536 + c, v0, v1);
                            else if (c < 152) { f32x4 o0, o1; for (int e = 0; e < 4; ++e) { o0[e] = sigmoid_fast(v0[e]); o1[e] = sigmoid_fast(v1[e]); }
                                *(f32x4*)(p.gates() + (size_t)row * 32 + (c - 128)) = o0; *(f32x4*)(p.gates() + (size_t)row * 32 + (c - 128) + 4) = o1; }
                        } else {
                            f32x4 o0, o1; for (int e = 0; e < 4; ++e) { o0[e] = sigmoid_fast(v0[e]); o1[e] = sigmoid_fast(v1[e]); }
                            st8(p.mg() + (size_t)row * 2048 + (pn - 16) * 256 + c, o0, o1);
                        }
                    }
                }
            }
    }
};

template <int AI, int BJ>
__device__ __forceinline__ void inproj_sample_quadrant(const P& p, int pn, int wid, int lane) {
    const int wr = wid >> 2, wc = wid & 3, fr = lane & 15, fq = lane >> 4;
    f32x4 acc[2][2][4][2];
#pragma unroll
    for (int m = 0; m < 4; ++m)
#pragma unroll
        for (int n = 0; n < 2; ++n) acc[AI][BJ][m][n] = (f32x4){0.f, 0.f, 0.f, 0.f};
    const bf16_t* ap = p.hb() + (size_t)(NP + AI * 128 + wr * 64 + fr) * DM + 8 * fq;
    const bf16_t* bp = p.WinT() + (size_t)(pn * 256 + BJ * 128 + wc * 32 + fr) * DM + 8 * fq;
    bf16x8 a0[4][2], b0[2][2], a1[4][2], b1[2][2];
    auto ld = [&](bf16x8 (&a)[4][2], bf16x8 (&b)[2][2], int k0) {
#pragma unroll
        for (int i = 0; i < 2; ++i) {
#pragma unroll
            for (int m = 0; m < 4; ++m) a[m][i] = *(const bf16x8*)(ap + (size_t)m * 16 * DM + k0 + 32 * i);
#pragma unroll
            for (int n = 0; n < 2; ++n) b[n][i] = *(const bf16x8*)(bp + (size_t)n * 16 * DM + k0 + 32 * i);
        }
    };
    auto mma = [&](const bf16x8 (&a)[4][2], const bf16x8 (&b)[2][2]) {
#pragma unroll
        for (int i = 0; i < 2; ++i)
#pragma unroll
            for (int m = 0; m < 4; ++m)
#pragma unroll
                for (int n = 0; n < 2; ++n) acc[AI][BJ][m][n] = __builtin_amdgcn_mfma_f32_16x16x32_bf16(b[n][i], a[m][i], acc[AI][BJ][m][n], 0, 0, 0);
    };
    ld(a0, b0, 0);
#pragma unroll 1
    for (int k0 = 0; k0 < DM; k0 += 128) {
        ld(a1, b1, k0 + 64);
        mma(a0, b0);
        if (k0 + 128 < DM) ld(a0, b0, k0 + 128);
        mma(a1, b1);
    }
    EpiIn e; e.p = p; e.row0 = 0; e.pn0 = 0;
    Unit u; u.pm = NP / 256; u.pn = pn;
    e.template body<AI, AI + 1, BJ, BJ + 1>(acc, u, wr, wc, fr, fq);
}
__device__ __forceinline__ void ph_inproj_sample(const P& p) {
    if ((int)blockIdx.x >= 96) return;
    const int wid = threadIdx.x >> 6, lane = threadIdx.x & 63, pn = blockIdx.x >> 2;
    switch (blockIdx.x & 3) {
        case 0: inproj_sample_quadrant<0, 0>(p, pn, wid, lane); break;
        case 1: inproj_sample_quadrant<0, 1>(p, pn, wid, lane); break;
        case 2: inproj_sample_quadrant<1, 0>(p, pn, wid, lane); break;
        default: inproj_sample_quadrant<1, 1>(p, pn, wid, lane); break;
    }
}

struct EpiPlain {
    static constexpr bool PERM = false, AFTER_DRAIN = false;
    float* C; int ldc; int pad_;
    __device__ __forceinline__ void quad(int row, int c, f32x4 v) const { *(f32x4*)(C + (size_t)row * ldc + c) = v; }
    __device__ __forceinline__ void operator()(const f32x4 (&acc)[2][2][4][2], const Unit& u, int wr, int wc, int fr, int fq) const {
#pragma unroll
        for (int ai = 0; ai < 2; ++ai)
#pragma unroll
            for (int m = 0; m < 4; ++m) {
                float* rowp = C + (size_t)(u.pm * 256 + ai * 128 + wr * 64 + m * 16 + fr) * ldc + u.pn * 256 + wc * 32 + 8 * fq;
#pragma unroll
                for (int bj = 0; bj < 2; ++bj)
#pragma unroll
                    for (int n = 0; n < 2; ++n) *(f32x4*)(rowp + bj * 128 + n * 4) = acc[ai][bj][m][n];
            }
    }
};


struct EpiPlainBf {
    static constexpr bool PERM = false, AFTER_DRAIN = false;
    bf16_t* C; int ldc; int pad_;
    __device__ __forceinline__ void operator()(const f32x4 (&acc)[2][2][4][2], const Unit& u, int wr, int wc, int fr, int fq) const {
#pragma unroll
        for (int ai = 0; ai < 2; ++ai)
#pragma unroll
            for (int m = 0; m < 4; ++m) {
                bf16_t* rowp = C + (size_t)(u.pm * 256 + ai * 128 + wr * 64 + m * 16 + fr) * ldc + u.pn * 256 + wc * 32 + 4 * fq;
#pragma unroll
                for (int bj = 0; bj < 2; ++bj)
#pragma unroll
                    for (int n = 0; n < 2; ++n) st_bf4(rowp + bj * 128 + n * 16, acc[ai][bj][m][n]);
            }
    }
};

struct EpiYa {
    static constexpr bool PERM = false, AFTER_DRAIN = false;
    P p;
    __device__ __forceinline__ void quad(int row, int c, f32x4 v) const {
        const uint2 gw = *(const uint2*)(p.mg() + (size_t)row * 2048 + c);
        f32x4 g; g[0] = __uint_as_float(gw.x << 16); g[1] = __uint_as_float(gw.x & 0xffff0000u); g[2] = __uint_as_float(gw.y << 16); g[3] = __uint_as_float(gw.y & 0xffff0000u);
        *(f32x4*)(p.tmp() + (size_t)row * DM + c) = g * v;
    }
    __device__ __forceinline__ void operator()(const f32x4 (&acc)[2][2][4][2], const Unit& u, int wr, int wc, int fr, int fq) const {
#pragma unroll
        for (int ai = 0; ai < 2; ++ai)
#pragma unroll
            for (int m = 0; m < 4; ++m) {
                const int row = u.pm * 256 + ai * 128 + wr * 64 + m * 16 + fr;
#pragma unroll
                for (int bj = 0; bj < 2; ++bj)
#pragma unroll
                    for (int n = 0; n < 2; ++n) {
                        const int c = u.pn * 256 + bj * 128 + wc * 32 + fq * 8 + n * 4;
                        const uint2 gw = *(const uint2*)(p.mg() + (size_t)row * 2048 + c);
                        f32x4 g; g[0] = __uint_as_float(gw.x << 16); g[1] = __uint_as_float(gw.x & 0xffff0000u); g[2] = __uint_as_float(gw.y << 16); g[3] = __uint_as_float(gw.y & 0xffff0000u);
                        *(f32x4*)(p.tmp() + (size_t)row * DM + c) = g * acc[ai][bj][m][n];
                    }
            }
    }
};
struct EpiYb {
    static constexpr bool PERM = false, AFTER_DRAIN = false;
    P p;
    __device__ __forceinline__ void quad(int row, int c, f32x4 v) const {
        const uint2 gw = *(const uint2*)(p.mg() + (size_t)row * 2048 + 1024 + c);
        f32x4 g; g[0] = __uint_as_float(gw.x << 16); g[1] = __uint_as_float(gw.x & 0xffff0000u); g[2] = __uint_as_float(gw.y << 16); g[3] = __uint_as_float(gw.y & 0xffff0000u);
        st_bf4(p.mb() + (size_t)row * DM + c, *(const f32x4*)(p.tmp() + (size_t)row * DM + c) + g * v);
    }
    __device__ __forceinline__ void operator()(const f32x4 (&acc)[2][2][4][2], const Unit& u, int wr, int wc, int fr, int fq) const {
#pragma unroll
        for (int ai = 0; ai < 2; ++ai)
#pragma unroll
            for (int m = 0; m < 4; ++m) {
                const int row = u.pm * 256 + ai * 128 + wr * 64 + m * 16 + fr;
#pragma unroll
                for (int bj = 0; bj < 2; ++bj)
#pragma unroll
                    for (int n = 0; n < 2; ++n) {
                        const int c = u.pn * 256 + bj * 128 + wc * 32 + fq * 8 + n * 4;
                        const uint2 gw = *(const uint2*)(p.mg() + (size_t)row * 2048 + 1024 + c);
                        f32x4 g; g[0] = __uint_as_float(gw.x << 16); g[1] = __uint_as_float(gw.x & 0xffff0000u); g[2] = __uint_as_float(gw.y << 16); g[3] = __uint_as_float(gw.y & 0xffff0000u);
                        const f32x4 t = *(const f32x4*)(p.tmp() + (size_t)row * DM + c);
                        st_bf4(p.mb() + (size_t)row * DM + c, t + g * acc[ai][bj][m][n]);
                    }
            }
    }
};
struct EpiOut {
    static constexpr bool PERM = false, AFTER_DRAIN = false;
    P p;
    __device__ __forceinline__ void quad(int row, int c, f32x4 a) const {
        const float* xr = p.x_sample + (size_t)(row - NP) * DM;
        const f32x4 v = *(const f32x4*)(xr + c) + a;
        *(f32x4*)(p.x1() + (size_t)row * DM + c) = v;
        st_bf4(p.xg() + (size_t)row * DM + c, v * *(const f32x4*)(p.ple_g + c));
        atomicAdd(p.ss_s() + (row - NP), v[0] * v[0] + v[1] * v[1] + v[2] * v[2] + v[3] * v[3]);
    }
    __device__ __forceinline__ void operator()(const f32x4 (&acc)[2][2][4][2], const Unit& u, int wr, int wc, int fr, int fq) const {
#pragma unroll
        for (int ai = 0; ai < 2; ++ai)
#pragma unroll
            for (int m = 0; m < 4; ++m) {
                const int row = u.pm * 256 + ai * 128 + wr * 64 + m * 16 + fr;
                const float* xr = row < NP ? p.x_prompt + (size_t)row * DM : p.x_sample + (size_t)(row - NP) * DM;
                float ss = 0.f;
#pragma unroll
                for (int bj = 0; bj < 2; ++bj)
#pragma unroll
                    for (int n = 0; n < 2; ++n) {
                        const int c = u.pn * 256 + bj * 128 + wc * 32 + fq * 8 + n * 4;
                        const f32x4 v = *(const f32x4*)(xr + c) + acc[ai][bj][m][n];
                        *(f32x4*)(p.x1() + (size_t)row * DM + c) = v;
                        ss += v[0] * v[0] + v[1] * v[1] + v[2] * v[2] + v[3] * v[3];
                        st_bf4(p.xg() + (size_t)row * DM + c, v * *(const f32x4*)(p.ple_g + c));
                    }
                ss += __shfl_xor(ss, 16); ss += __shfl_xor(ss, 32);
                if (fq == 0) p.ss1()[(size_t)row * 16 + u.pn * 4 + wc] = ss;
            }
    }
};
struct EpiGate {
    static constexpr bool PERM = false, AFTER_DRAIN = false;
    P p;
    __device__ __forceinline__ void quad(int row, int c, f32x4 acc) const {
        const float rstd = rsqrtf(p.ss_s()[row - NP] * (1.0f / DM) + 1e-6f);
        const f32x4 a = acc * rstd;
        f32x4 g; for (int e = 0; e < 4; ++e) g[e] = sigmoidf_(a[e]);
        float* ppp = p.pp() + (size_t)row * DM + c;
        *(f32x4*)ppp = *(const f32x4*)(p.x1() + (size_t)row * DM + c) + g * *(const f32x4*)ppp;
    }
    __device__ __forceinline__ void operator()(const f32x4 (&acc)[2][2][4][2], const Unit& u, int wr, int wc, int fr, int fq) const {
#pragma unroll
        for (int ai = 0; ai < 2; ++ai)
#pragma unroll
            for (int m = 0; m < 4; ++m) {
                const int row = u.pm * 256 + ai * 128 + wr * 64 + m * 16 + fr;
                float ss = 0.f;
#pragma unroll
                for (int i = 0; i < 4; ++i) { const f32x4 t = *(const f32x4*)(p.ss1() + (size_t)row * 16 + i * 4); ss += (t[0] + t[1]) + (t[2] + t[3]); }
                const float rstd = rsqrtf(ss * (1.0f / DM) + 1e-6f);
#pragma unroll
                for (int bj = 0; bj < 2; ++bj)
#pragma unroll
                    for (int n = 0; n < 2; ++n) {
                        const int c = u.pn * 256 + bj * 128 + wc * 32 + fq * 8 + n * 4;
                        const f32x4 a = acc[ai][bj][m][n] * rstd;
                        f32x4 g; for (int e = 0; e < 4; ++e) g[e] = sigmoidf_(a[e]);
                        float* ppp = p.pp() + (size_t)row * DM + c;
                        *(f32x4*)ppp = *(const f32x4*)(p.x1() + (size_t)row * DM + c) + g * *(const f32x4*)ppp;
                    }
            }
    }
};

__device__ __forceinline__ void ph_final(const P& p) {
    const int tid = threadIdx.x, lane = tid & 63, wid = tid >> 6;
    const int nw = gridDim.x * 8;
    for (int row0 = blockIdx.x * 8 + wid; row0 < MR; row0 += 2 * nw) {
        float4 v[2][4]; float ss[2];
#pragma unroll
        for (int u = 0; u < 2; ++u) {
            const int row = row0 + u * nw < MR ? row0 + u * nw : row0;
            const float4* src = (const float4*)(p.pp() + (size_t)row * DM);
            ss[u] = 0.f;
#pragma unroll
            for (int i = 0; i < 4; ++i) { v[u][i] = src[lane + 64 * i]; ss[u] += v[u][i].x * v[u][i].x + v[u][i].y * v[u][i].y + v[u][i].z * v[u][i].z + v[u][i].w * v[u][i].w; }
        }
#pragma unroll
        for (int u = 0; u < 2; ++u) {
            const int row = row0 + u * nw;
            const float tot = wave_sum(ss[u]);
            const float rstd = rsqrtf(tot * (1.0f / DM) + 1e-6f);
            if (row < MR) {
                float4* dst = (float4*)(p.out + (row < NP ? O_Y_P + (size_t)row * DM : O_Y_S + (size_t)(row - NP) * DM));
#pragma unroll
                for (int i = 0; i < 4; ++i) {
                    const float4 g = ((const float4*)p.final_g)[lane + 64 * i];
                    float4 o; o.x = v[u][i].x * rstd * g.x; o.y = v[u][i].y * rstd * g.y; o.z = v[u][i].z * rstd * g.z; o.w = v[u][i].w * rstd * g.w;
                    dst[lane + 64 * i] = o;
                }
            }
        }
    }
}

typedef float f32x4v __attribute__((ext_vector_type(4)));
template <class Epi> __device__ __forceinline__ void small_gemm(const bf16_t* A, const bf16_t* Bt, int K, const Epi& E) {
    const int tid = threadIdx.x, lane = tid & 63, wid = tid >> 6, r16 = lane & 15, q4 = lane >> 4;
    for (int tile = blockIdx.x * 8 + wid; tile < 16 * 64; tile += gridDim.x * 8) {
        const int rt = tile & 15, ct = tile >> 4;
        const bf16_t* ap = A + (size_t)(NP + rt * 16 + r16) * K + 8 * q4;
        const bf16_t* bp = Bt + (size_t)(ct * 16 + r16) * K + 8 * q4;
        f32x4 acc = {0.f, 0.f, 0.f, 0.f};
#pragma unroll 1
        for (int k0 = 0; k0 < K; k0 += 256) {
            bf16x8 af[8], bf[8];
#pragma unroll
            for (int i = 0; i < 8; ++i) { af[i] = *(const bf16x8*)(ap + k0 + 32 * i); bf[i] = *(const bf16x8*)(bp + k0 + 32 * i); }
#pragma unroll
            for (int i = 0; i < 8; ++i) acc = __builtin_amdgcn_mfma_f32_16x16x32_bf16(bf[i], af[i], acc, 0, 0, 0);
        }
        E.quad(NP + rt * 16 + r16, (ct >> 1) * 32 + 8 * q4 + 4 * (ct & 1), acc);
    }
}

__device__ __forceinline__ f32x4 ld_bf4c(const bf16_t* q) { const uint2 w = *(const uint2*)q; f32x4 v; v[0] = __uint_as_float(w.x << 16); v[1] = __uint_as_float(w.x & 0xffff0000u); v[2] = __uint_as_float(w.y << 16); v[3] = __uint_as_float(w.y & 0xffff0000u); return v; }
__device__ __forceinline__ void compress2_tile(const P& p, const bf16_t* LH, int nbg, int nrows, int nblk, bf16_t* kc, bf16_t* vcT, int kvi, int bg, int tile, int lane, LAS unsigned char* wlds) {
    const int col = lane & 31, hb = lane >> 5;
    {
        const int i = tile * 32 + col;
        const bool live = i < nblk;
        const bf16_t* lbase = LH + ((size_t)kvi * nbg * nrows + (size_t)bg * nrows) * 256;
        const bf16_t* w2t = p.W2T() + (size_t)kvi * 64 * 128;
        LAS bf16_t* hs = (LAS bf16_t*)wlds;
        {
            const int rq = lane >> 4, c8 = lane & 15;
            const f32x4 pa = *(const f32x4*)(p.pt() + kvi * 128 + c8 * 8), pb = *(const f32x4*)(p.pt() + kvi * 128 + c8 * 8 + 4);
#pragma unroll
            for (int it = 0; it < 8; ++it) {
                const int rr = 4 * it + rq, gi = tile * 32 + rr;
                const bf16_t* rp = lbase + (size_t)(gi < nblk ? gi : 0) * 256 + c8 * 8;
                const uint4 lo = *(const uint4*)rp, hi = *(const uint4*)(rp + 256 + 128);
                float hv[8];
                const unsigned lw[4] = {lo.x, lo.y, lo.z, lo.w}, hw[4] = {hi.x, hi.y, hi.z, hi.w};
#pragma unroll
                for (int e = 0; e < 4; ++e) {
                    const float pe0 = e < 2 ? pa[2 * e] : pb[2 * e - 4], pe1 = e < 2 ? pa[2 * e + 1] : pb[2 * e - 3];
                    hv[2 * e] = siluf_(__uint_as_float(lw[e] << 16) + __uint_as_float(hw[e] << 16) + pe0);
                    hv[2 * e + 1] = siluf_(__uint_as_float(lw[e] & 0xffff0000u) + __uint_as_float(hw[e] & 0xffff0000u) + pe1);
                }
                *(LAS bf16x8*)(hs + rr * 136 + c8 * 8) = pack8(hv[0], hv[1], hv[2], hv[3], hv[4], hv[5], hv[6], hv[7]);
            }
        }
        WAVE_SYNC();
        f32x16 acc[2]; acc[0] = zero16(); acc[1] = zero16();
#pragma unroll
        for (int ks = 0; ks < 8; ++ks) {
            const int f = 16 * ks + 8 * hb;
            const bf16x8 hf = *(LAS const bf16x8*)(hs + col * 136 + f);
#pragma unroll
            for (int dt = 0; dt < 2; ++dt) {
                const bf16x8 wf = *(const bf16x8*)(w2t + (size_t)(32 * dt + col) * 128 + f);
                acc[dt] = (kvi == 0) ? mfma32(wf, hf, acc[dt]) : mfma32(hf, wf, acc[dt]);
            }
        }
        WAVE_SYNC();
        if (kvi == 0) {
            bf16_t* dst = kc + ((size_t)bg * nrows + i) * 64;
#pragma unroll
            for (int dt = 0; dt < 2; ++dt)
#pragma unroll
                for (int i4 = 0; i4 < 4; ++i4) {
                    const int d = 32 * dt + 8 * i4 + 4 * hb;
                    const f32x4 b2 = *(const f32x4*)(p.cmp_b2 + d);
                    f32x4 v; for (int e = 0; e < 4; ++e) v[e] = live ? acc[dt][4 * i4 + e] + b2[e] : 0.f;
                    st_bf4(dst + d, v);
                }
        } else {
#pragma unroll
            for (int dt = 0; dt < 2; ++dt) {
                const int d = 32 * dt + col;
                const float b2 = p.cmp_b2[64 + d];
                bf16_t* dst = vcT + ((size_t)bg * 64 + d) * nrows + tile * 32;
#pragma unroll
                for (int i4 = 0; i4 < 4; ++i4) {
                    const int r = 8 * i4 + 4 * hb;
                    f32x4 v; for (int e = 0; e < 4; ++e) v[e] = (tile * 32 + r + e) < nblk ? acc[dt][4 * i4 + e] + b2 : 0.f;
                    st_bf4(dst + r, v);
                }
            }
        }
    }
}

__device__ __forceinline__ void ph_compress2(const P& p, const bf16_t* LH, int nbg, int nrows, int nblk, bf16_t* kc, bf16_t* vcT, LAS unsigned char* lds) {
    const int tid = threadIdx.x, lane = tid & 63, wid = tid >> 6;
    const int ntile = nrows >> 5, total = 2 * nbg * ntile;
    for (int it = blockIdx.x * 8 + wid; it < total; it += gridDim.x * 8)
        compress2_tile(p, LH, nbg, nrows, nblk, kc, vcT, it / (ntile * nbg), (it / ntile) % nbg, it % ntile, lane, lds + wid * 8960);
}


__device__ __forceinline__ float dpp_row_sum16(float v) {
    v += __builtin_bit_cast(float, __builtin_amdgcn_mov_dpp(__builtin_bit_cast(int, v), 0xB1, 0xF, 0xF, true));
    v += __builtin_bit_cast(float, __builtin_amdgcn_mov_dpp(__builtin_bit_cast(int, v), 0x4E, 0xF, 0xF, true));
    v += __builtin_bit_cast(float, __builtin_amdgcn_mov_dpp(__builtin_bit_cast(int, v), 0x141, 0xF, 0xF, true));
    v += __builtin_bit_cast(float, __builtin_amdgcn_mov_dpp(__builtin_bit_cast(int, v), 0x140, 0xF, 0xF, true));
    return v;
}
__device__ __forceinline__ float tanh_fast(float x) { const float e = __expf(2.0f * x); return 1.0f - 2.0f / (e + 1.0f); }
__device__ __forceinline__ float half_sum32(float v) { return xsum16(dpp_row_sum16(v)); }
__device__ __forceinline__ const bf16_t* rwkv_prev_row(const P& p, int row) {
    if (row < NP) return (row & (SEQ - 1)) == 0 ? p.zs0() : p.rz() + (size_t)(row - 1) * CR;
    const int rs = row - NP;
    return (rs & 7) == 0 ? p.zs0() + (size_t)(1 + (rs >> 3)) * CR : p.rz() + (size_t)(row - 1) * CR;
}
__device__ __forceinline__ f32x4 ld_bf4(const bf16_t* q) { const uint2 w = *(const uint2*)q; f32x4 v; v[0] = __uint_as_float(w.x << 16); v[1] = __uint_as_float(w.x & 0xffff0000u); v[2] = __uint_as_float(w.y << 16); v[3] = __uint_as_float(w.y & 0xffff0000u); return v; }
__device__ __forceinline__ void ph_rwkv_prep(const P& p) {
    const int tid = threadIdx.x, lane = tid & 63, wid = tid >> 6, col = lane & 31, hb = lane >> 5;
    const int gw = blockIdx.x * 8 + wid, nw = gridDim.x * 8;
    for (int it = gw; it < NB + DB; it += nw) {
        const int row = it < NB ? it * SEQ + SEQ - 1 : NP + (it - NB) * 8 + 7;
        float* so = it < NB ? p.out + O_SH_P + (size_t)it * CR : p.out + O_SH_S + (size_t)(it - NB) * CR;
        const bf16_t* z = p.rz() + (size_t)row * CR;
        for (int i = lane; i < CR; i += 64) so[i] = bf2f(z[i]);
    }
    for (int rnd = 0; rnd < 3; ++rnd) {
        int it;
        if (rnd == 0) it = gw;
        else if ((int)blockIdx.x < 16) break;
        else if (rnd == 1) it = nw + (gw - 128);
        else { if (wid != 0 || (int)blockIdx.x >= 208) break; it = 2 * nw - 128 + ((int)blockIdx.x - 16); }
        if (it >= (MR / 32) * 8) break;
        const int h = it & 7, r0 = (it >> 3) * 32;
        bf16x8 Aw[4], Aa[4];
        {
            const int row = r0 + col;
            const bf16_t* z = p.rz() + (size_t)row * CR;
            const bf16_t* pv = rwkv_prev_row(p, row);
#pragma unroll
            for (int ks = 0; ks < 4; ++ks) {
                const int j0 = 16 * ks + 8 * hb;
                float tw[8], ta[8];
#pragma unroll
                for (int q = 0; q < 2; ++q) {
                    const f32x4 zw = ld_bf4(z + 1536 + j0 + 4 * q), za = ld_bf4(z + 1600 + j0 + 4 * q);
                    const f32x4 pw = ld_bf4(pv + 1536 + j0 + 4 * q), pa = ld_bf4(pv + 1600 + j0 + 4 * q);
                    const f32x4 mw = *(const f32x4*)(p.mu + 1536 + j0 + 4 * q), ma = *(const f32x4*)(p.mu + 1600 + j0 + 4 * q);
#pragma unroll
                    for (int e = 0; e < 4; ++e) { tw[4 * q + e] = tanh_fast(zw[e] + (pw[e] - zw[e]) * mw[e]); ta[4 * q + e] = za[e] + (pa[e] - za[e]) * ma[e]; }
                }
                Aw[ks] = pack8(tw[0], tw[1], tw[2], tw[3], tw[4], tw[5], tw[6], tw[7]);
                Aa[ks] = pack8(ta[0], ta[1], ta[2], ta[3], ta[4], ta[5], ta[6], ta[7]);
            }
        }
        f32x16 accw[2], acca[2];
#pragma unroll
        for (int ct = 0; ct < 2; ++ct) {
            accw[ct] = zero16(); acca[ct] = zero16();
            const size_t wo = (size_t)(h * 64 + 32 * ct + col) * 64 + 8 * hb;
#pragma unroll
            for (int ks = 0; ks < 4; ++ks) {
                accw[ct] = mfma32(Aw[ks], *(const bf16x8*)(p.WupT() + wo + 16 * ks), accw[ct]);
                acca[ct] = mfma32(Aa[ks], *(const bf16x8*)(p.AupT() + wo + 16 * ks), acca[ct]);
            }
        }
        float w0v[2], a0v[2], kkv[2], kav[2], rkv[2], mur[2], muk[2], muv[2];
#pragma unroll
        for (int ct = 0; ct < 2; ++ct) {
            const int c = h * 64 + 32 * ct + col;
            w0v[ct] = p.w0[c]; a0v[ct] = p.a0[c]; kkv[ct] = p.k_k[c]; kav[ct] = p.k_a[c]; rkv[ct] = p.r_k[c];
            mur[ct] = p.mu[c]; muk[ct] = p.mu[512 + c]; muv[ct] = p.mu[1024 + c];
        }
#pragma unroll
        for (int hf = 0; hf < 2; ++hf) {
        float zz[8][2][3], pz[2][2][3];
#pragma unroll
        for (int ii = 0; ii < 8; ++ii) {
            const int i = 8 * hf + ii;
            const bf16_t* z = p.rz() + (size_t)(r0 + (i & 3) + 8 * (i >> 2) + 4 * hb) * CR + h * 64 + col;
#pragma unroll
            for (int ct = 0; ct < 2; ++ct) { zz[ii][ct][0] = bf2f(z[32 * ct]); zz[ii][ct][1] = bf2f(z[512 + 32 * ct]); zz[ii][ct][2] = bf2f(z[1024 + 32 * ct]); }
        }
#pragma unroll
        for (int g2 = 0; g2 < 2; ++g2) {
            const bf16_t* pv = rwkv_prev_row(p, r0 + 8 * (2 * hf + g2) + 4 * hb) + h * 64 + col;
#pragma unroll
            for (int ct = 0; ct < 2; ++ct) { pz[g2][ct][0] = bf2f(pv[32 * ct]); pz[g2][ct][1] = bf2f(pv[512 + 32 * ct]); pz[g2][ct][2] = bf2f(pv[1024 + 32 * ct]); }
        }
#pragma unroll
        for (int ii = 0; ii < 8; ++ii) {
            const int i = 8 * hf + ii;
            const int row = r0 + (i & 3) + 8 * (i >> 2) + 4 * hb;
            float zr[2], zk[2], zv[2], dec[2], av[2], kkr[2], km[2];
            float n2 = 0.f, bon = 0.f;
#pragma unroll
            for (int ct = 0; ct < 2; ++ct) {
                const float z0 = zz[ii][ct][0], z1 = zz[ii][ct][1], z2 = zz[ii][ct][2];
                const int ip = ii > 0 ? ii - 1 : 0;
                const float p0 = (i & 3) ? zz[ip][ct][0] : pz[ii >> 2][ct][0], p1 = (i & 3) ? zz[ip][ct][1] : pz[ii >> 2][ct][1], p2 = (i & 3) ? zz[ip][ct][2] : pz[ii >> 2][ct][2];
                zr[ct] = z0 + (p0 - z0) * mur[ct]; zk[ct] = z1 + (p1 - z1) * muk[ct]; zv[ct] = z2 + (p2 - z2) * muv[ct];
                const float nx = -(w0v[ct] + accw[ct][i]);
                const float sp = fmaxf(nx, 0.f) + __logf(1.0f + __expf(-fabsf(nx)));
                dec[ct] = __expf(-__expf(-sp - 0.5f));
                av[ct] = sigmoidf_(a0v[ct] + acca[ct][i]);
                kkr[ct] = zk[ct] * kkv[ct];
                km[ct] = zk[ct] * (1.0f + (av[ct] - 1.0f) * kav[ct]);
                n2 += kkr[ct] * kkr[ct];
                bon += zr[ct] * km[ct] * rkv[ct];
            }
            n2 = half_sum32(n2); bon = half_sum32(bon);
            const float rn = 1.0f / fmaxf(sqrtf(n2), 1e-12f);
            unsigned char* o = p.rw6() + ((size_t)row * 8 + h) * RW6_STRIDE;
#pragma unroll
            for (int ct = 0; ct < 2; ++ct) {
                const float kk = kkr[ct] * rn;
                const int cl = 32 * ct + col;
                ((float*)o)[cl] = dec[ct];
                bf16_t* ob = (bf16_t*)(o + 256) + cl;
                ob[0] = f2bf(zr[ct]); ob[64] = f2bf(km[ct]); ob[128] = f2bf(zv[ct]); ob[192] = f2bf(kk); ob[256] = f2bf(kk * av[ct]);
            }
            if (col == 0) p.bonus()[(size_t)row * 8 + h] = bon;
        }
        }
    }
}

typedef float f32x2 __attribute__((ext_vector_type(2)));
__device__ __forceinline__ float dpp_row_sum(float v) {
    v += __builtin_bit_cast(float, __builtin_amdgcn_mov_dpp(__builtin_bit_cast(int, v), 0xB1, 0xF, 0xF, true));
    v += __builtin_bit_cast(float, __builtin_amdgcn_mov_dpp(__builtin_bit_cast(int, v), 0x4E, 0xF, 0xF, true));
    v += __builtin_bit_cast(float, __builtin_amdgcn_mov_dpp(__builtin_bit_cast(int, v), 0x141, 0xF, 0xF, true));
    v += __builtin_bit_cast(float, __builtin_amdgcn_mov_dpp(__builtin_bit_cast(int, v), 0x140, 0xF, 0xF, true));
    return v;
}
constexpr int SCAN_TC = 32;
template <int NROWS>
__device__ __forceinline__ void scan_item(const P& p, LAS float* lds, int row0, int T, int h, int half, const float* s0, float* sout) {
    const int tid = threadIdx.x, w = tid >> 6, lane = tid & 63, rl = lane >> 4, kq = lane & 15;
    const bool act = w * 4 < NROWS;
    const int vrow = half * NROWS + (act ? w * 4 : 0) + rl;
    f32x4 S;
    if (s0) S = *(const f32x4*)(s0 + vrow * 64 + kq * 4); else { S[0] = 0.f; S[1] = 0.f; S[2] = 0.f; S[3] = 0.f; }
    const unsigned char* src = p.rw6() + ((size_t)row0 * 8 + h) * RW6_STRIDE;
    const int nchunk = (T + SCAN_TC - 1) / SCAN_TC;
    u32x4_t stg[4];
    int ss[4], sc[4], sl[4];
#pragma unroll
    for (int i = 0; i < 4; ++i) {
        const int idx = i * 512 + tid; ss[i] = idx / 56; sc[i] = idx % 56;
        const int cb = sc[i] - 16, q = cb >> 3;
        sl[i] = sc[i] < 16 ? 64 + 4 * sc[i] : (q == 0 ? 0 : 64 + 64 * q) + 8 * (cb & 7);
    }
    auto put = [&](LAS float* b, int i) {
        LAS float* d = b + ss[i] * 384 + sl[i];
        if (sc[i] < 16) *(LAS u32x4_t*)d = stg[i];
        else {
            f32x4 lo, hi;
            lo[0] = __uint_as_float(stg[i][0] << 16); lo[1] = __uint_as_float(stg[i][0] & 0xffff0000u); lo[2] = __uint_as_float(stg[i][1] << 16); lo[3] = __uint_as_float(stg[i][1] & 0xffff0000u);
            hi[0] = __uint_as_float(stg[i][2] << 16); hi[1] = __uint_as_float(stg[i][2] & 0xffff0000u); hi[2] = __uint_as_float(stg[i][3] << 16); hi[3] = __uint_as_float(stg[i][3] & 0xffff0000u);
            *(LAS f32x4*)d = lo; *(LAS f32x4*)(d + 4) = hi;
        }
    };
    {
        const int ns = T < SCAN_TC ? T : SCAN_TC;
#pragma unroll
        for (int i = 0; i < 4; ++i) if (ss[i] < ns) { stg[i] = *(const u32x4_t*)(src + (size_t)ss[i] * (8 * RW6_STRIDE) + sc[i] * 16); put(lds, i); }
    }
    __syncthreads();
    for (int c = 0; c < nchunk; ++c) {
        const int t0 = c * SCAN_TC;
        const int ns = (T - t0) < SCAN_TC ? (T - t0) : SCAN_TC;
        const bool more = (c + 1) < nchunk;
        const int nns = more ? ((T - t0 - SCAN_TC) < SCAN_TC ? (T - t0 - SCAN_TC) : SCAN_TC) : 0;
        if (more) {
#pragma unroll
            for (int i = 0; i < 4; ++i) if (ss[i] < nns) stg[i] = *(const u32x4_t*)(src + (size_t)(t0 + SCAN_TC + ss[i]) * (8 * RW6_STRIDE) + sc[i] * 16);
        }
        LAS const float* buf = lds + (c & 1) * (SCAN_TC * 384);
        float* yo = p.ybuf() + (size_t)(row0 + t0) * 512 + h * 64 + vrow;
        if (act)
#pragma unroll 4
        for (int s = 0; s < ns; ++s) {
            LAS const float* bs = buf + s * 384 + kq * 4;
            const f32x4 r = *(LAS const f32x4*)(bs), d = *(LAS const f32x4*)(bs + 64), km = *(LAS const f32x4*)(bs + 128),
                        kk = *(LAS const f32x4*)(bs + 256), ka = *(LAS const f32x4*)(bs + 320);
            const float vv = buf[s * 384 + 192 + vrow];
            const f32x4 t1 = S * kk;
            float sa = dpp_row_sum((t1[0] + t1[1]) + (t1[2] + t1[3]));
            sa = -sa;
            S = S * d + ka * sa + km * vv;
            const f32x4 t2 = S * r;
            const float y = dpp_row_sum((t2[0] + t2[1]) + (t2[2] + t2[3]));
            if (kq == 0) yo[(size_t)s * 512] = y;
        }
        if (more) {
            LAS float* nb = lds + ((c + 1) & 1) * (SCAN_TC * 384);
#pragma unroll
            for (int i = 0; i < 4; ++i) if (ss[i] < nns) put(nb, i);
        }
        __syncthreads();
    }
    if (act) *(f32x4*)(sout + vrow * 64 + kq * 4) = S;
}
struct ScanVec { f32x4 r, d, km, kk, ka; float vv; };
__device__ __forceinline__ void scan_ld(ScanVec& v, LAS const float* bs, LAS const float* bv) {
    v.kk = *(LAS const f32x4*)(bs + 256); v.d = *(LAS const f32x4*)(bs + 64); v.ka = *(LAS const f32x4*)(bs + 320);
    v.km = *(LAS const f32x4*)(bs + 128); v.vv = *bv; v.r = *(LAS const f32x4*)(bs);
}
__device__ __forceinline__ float scan_step(f32x4& S, const ScanVec& v) {
    const f32x4 t1 = S * v.kk;
    const float sa = -dpp_row_sum((t1[0] + t1[2]) + (t1[1] + t1[3]));
    S = S * v.d + v.ka * sa + v.km * v.vv;
    const f32x4 t2 = S * v.r;
    return dpp_row_sum((t2[0] + t2[2]) + (t2[1] + t2[3]));
}
__device__ __forceinline__ float scan_step_p(f32x4& S, const ScanVec& v) {
    const f32x4 t1 = S * v.kk;
    const float sa = -dpp_row_sum((t1[0] + t1[2]) + (t1[1] + t1[3]));
    S = S * v.d + v.ka * sa + v.km * v.vv;
    const f32x4 t2 = S * v.r;
    return (t2[0] + t2[2]) + (t2[1] + t2[3]);
}
constexpr int YP_STRIDE = 68;
struct ScanCarry { f32x4 P, ka, r; float sa, hu; };
template <int CTRL> __device__ __forceinline__ float dpp_add_(float v) { return v + __builtin_bit_cast(float, __builtin_amdgcn_mov_dpp(__builtin_bit_cast(int, v), CTRL, 0xF, 0xF, true)); }
#define dpp_add(v, c) dpp_add_<c>(v)
#define SCAN_OPAQUE(x) asm("" : "+v"(x))
struct ScanVecA { f32x4 r, d, km, kk, ka; float vv, al; };
__device__ __forceinline__ void scan_lda(ScanVecA& v, LAS const float* bs, LAS const float* bv, LAS const float* ba) {
    v.d = *(LAS const f32x4*)(bs + 64); v.km = *(LAS const f32x4*)(bs + 128); v.vv = *bv; v.al = *ba; v.kk = *(LAS const f32x4*)(bs + 256);
    v.ka = *(LAS const f32x4*)(bs + 320); v.r = *(LAS const f32x4*)(bs);
}
__device__ __forceinline__ float lane_dot4(const f32x4& a, const f32x4& b) {
    const f32x2 lo = {a[0] * b[0], a[1] * b[1]};
    const f32x2 s2 = {__builtin_fmaf(a[2], b[2], lo[0]), __builtin_fmaf(a[3], b[3], lo[1])};
    return s2[0] + s2[1];
}
__device__ __forceinline__ float scan_step_la(ScanCarry& C, const ScanVecA& v) {
    const f32x4 S = C.P + C.ka * C.sa;
    const f32x4 P = S * v.d + v.km * v.vv;
    float U = C.hu;
    U = dpp_add(U, 0x141);
    U = dpp_add(U, 0x140);
    const float sa = -(U + C.sa * v.al);
    float hu = lane_dot4(P, v.kk);
    hu = dpp_add(hu, 0xB1);
    hu = dpp_add(hu, 0x4E);
    asm volatile("" : "+v"(hu));
    const float yp = lane_dot4(S, C.r);
    C.P = P; C.ka = v.ka; C.r = v.r; C.sa = sa; C.hu = hu;
    return yp;
}
template <int NROWS>
__device__ __forceinline__ void scan_prompt(const P& p, LAS float* lds, int row0, int h, int part, float* sout) {
    const int tid = threadIdx.x, w = tid >> 6, lane = tid & 63, rl = lane >> 4, kq = lane & 15;
    const bool act = w * 4 < NROWS;
    const int vrow = part * NROWS + (act ? w * 4 : 0) + rl;
    const unsigned char* src = p.rw6() + ((size_t)row0 * 8 + h) * RW6_STRIDE;
    constexpr int nchunk = SEQ / SCAN_TC;
    u32x4_t stg[4];
    int ss[4], sc[4], sl[4], sx[4];
#pragma unroll
    for (int i = 0; i < 4; ++i) {
        const int idx = i * 512 + tid; ss[i] = idx / 56; sc[i] = idx % 56;
        const int cb = sc[i] - 16, q = cb >> 3;
        sl[i] = sc[i] < 16 ? 64 + 4 * sc[i] : (q == 0 ? 0 : 64 + 64 * q) + 8 * (cb & 7);
        sx[i] = (sc[i] >= 16 && q == 3) ? 8 * RW6_STRIDE : 0;
    }
    auto put = [&](LAS float* b, int i) {
        LAS float* d = b + ss[i] * 384 + sl[i];
        if (sc[i] < 16) *(LAS u32x4_t*)d = stg[i];
        else {
            f32x4 lo, hi;
            lo[0] = __uint_as_float(stg[i][0] << 16); lo[1] = __uint_as_float(stg[i][0] & 0xffff0000u); lo[2] = __uint_as_float(stg[i][1] << 16); lo[3] = __uint_as_float(stg[i][1] & 0xffff0000u);
            hi[0] = __uint_as_float(stg[i][2] << 16); hi[1] = __uint_as_float(stg[i][2] & 0xffff0000u); hi[2] = __uint_as_float(stg[i][3] << 16); hi[3] = __uint_as_float(stg[i][3] & 0xffff0000u);
            *(LAS f32x4*)d = lo; *(LAS f32x4*)(d + 4) = hi;
        }
    };
#pragma unroll
    for (int i = 0; i < 4; ++i) if (ss[i] < SCAN_TC) { stg[i] = *(const u32x4_t*)(src + (size_t)ss[i] * (8 * RW6_STRIDE) + sc[i] * 16 + sx[i]); put(lds, i); }
    ScanCarry C;
#pragma unroll
    for (int e = 0; e < 4; ++e) { C.P[e] = 0.f; C.ka[e] = 0.f; C.r[e] = 0.f; }
    C.sa = 0.f; C.hu = 0.f;
    LAS float* pw = lds + 2 * SCAN_TC * 384 + w * (16 * YP_STRIDE);
    LAS float* pwl = pw + lane;
    LAS const float* prd = pw + kq * YP_STRIDE + rl * 16;
    float* ybase = p.ybuf() + (size_t)(row0 + kq) * 512 + h * 64 + vrow;
    LAS float* alp = lds + 2 * SCAN_TC * 384 + 8 * (16 * YP_STRIDE);
    auto alpha_chunk = [&](int cc) {
        if (w >= 4) {
#pragma unroll
            for (int i = 0; i < 8; ++i) {
                const int s8 = (w - 4) * 8 + i, t = cc * SCAN_TC + s8;
                const unsigned char* rowp = src + (size_t)t * (8 * RW6_STRIDE);
                const float kkv = bf2f(((const bf16_t*)(rowp + 640))[lane]);
                const float kav = t > 0 ? bf2f(((const bf16_t*)(rowp - 8 * RW6_STRIDE + 768))[lane]) : 0.f;
                const float d = wave_sum(kav * kkv);
                if (lane == 0) alp[(cc & 1) * SCAN_TC + s8] = d;
            }
        }
    };
    alpha_chunk(0);
    __syncthreads();
    auto flush = [&](int tb) {
        const f32x4 a0 = *(LAS const f32x4*)(prd), a1 = *(LAS const f32x4*)(prd + 4), a2 = *(LAS const f32x4*)(prd + 8), a3 = *(LAS const f32x4*)(prd + 12);
        const f32x4 t = (a0 + a1) + (a2 + a3);
        ybase[(size_t)tb * 512] = (t[0] + t[2]) + (t[1] + t[3]);
    };
#pragma unroll 1
    for (int c = 0; c < nchunk; ++c) {
        const int t0 = c * SCAN_TC;
        const bool more = (c + 1) < nchunk;
        if (more) {
#pragma unroll
            for (int i = 0; i < 4; ++i) if (ss[i] < SCAN_TC) stg[i] = *(const u32x4_t*)(src + (size_t)(t0 + SCAN_TC + ss[i]) * (8 * RW6_STRIDE) + sc[i] * 16 + sx[i]);
        }
        if (more) alpha_chunk(c + 1);
        LAS const float* buf = lds + (c & 1) * (SCAN_TC * 384);
        if (act) {
            LAS const float* bk = buf + kq * 4;
            LAS const float* bv = buf + 192 + vrow;
            LAS const float* ba = alp + (c & 1) * SCAN_TC;
            ScanVecA A, B, D;
            scan_lda(A, bk, bv, ba); scan_lda(B, bk + 384, bv + 384, ba + 1); scan_lda(D, bk + 2 * 384, bv + 2 * 384, ba + 2);
#define STEPX(V, s) do { __builtin_amdgcn_sched_barrier(0); pwl[(((s) + 15) & 15) * YP_STRIDE] = scan_step_la(C, V);     \
                if ((s) == 0) { if (c > 0) flush(t0 - 16); } if ((s) == 16) flush(t0); \
                if ((s) + 3 < SCAN_TC) scan_lda(V, bk + ((s) + 3) * 384, bv + ((s) + 3) * 384, ba + (s) + 3); } while (0)
            STEPX(A, 0); STEPX(B, 1); STEPX(D, 2); STEPX(A, 3); STEPX(B, 4); STEPX(D, 5); STEPX(A, 6); STEPX(B, 7); STEPX(D, 8); STEPX(A, 9); STEPX(B, 10); STEPX(D, 11); STEPX(A, 12); STEPX(B, 13); STEPX(D, 14); STEPX(A, 15); STEPX(B, 16); STEPX(D, 17); STEPX(A, 18); STEPX(B, 19); STEPX(D, 20); STEPX(A, 21); STEPX(B, 22); STEPX(D, 23); STEPX(A, 24); STEPX(B, 25); STEPX(D, 26); STEPX(A, 27); STEPX(B, 28); STEPX(D, 29); STEPX(A, 30); STEPX(B, 31);
#undef STEPX
        }
        if (more) {
            LAS float* nb = lds + ((c + 1) & 1) * (SCAN_TC * 384);
#pragma unroll
            for (int i = 0; i < 4; ++i) if (ss[i] < SCAN_TC) put(nb, i);
        }
        __syncthreads();
    }
    if (act) {
        const f32x4 S = C.P + C.ka * C.sa;
        const f32x4 t2 = S * C.r;
        pwl[15 * YP_STRIDE] = (t2[0] + t2[2]) + (t2[1] + t2[3]);
        flush(SEQ - 16);
        *(f32x4*)(sout + vrow * 64 + kq * 4) = S;
    }
}
constexpr int NSCAN = 128;
__device__ __forceinline__ void ph_rwkv_scan(const P& p, LAS float* lds) {
    if ((int)blockIdx.x < NSCAN) {
        const int item = blockIdx.x >> 2, part = blockIdx.x & 3;
        scan_prompt<16>(p, lds, (item >> 3) * SEQ, item & 7, part, p.out + O_WKV_P + (size_t)item * 4096);
    } else {
        const int nb = (int)gridDim.x - NSCAN;
        for (int hi = (int)blockIdx.x - NSCAN; hi < 512; hi += nb) {
            const int item = hi >> 1, half = hi & 1;
            scan_item<32>(p, lds, NP + (item >> 3) * 8, 8, item & 7, half, p.state_wkv + (size_t)item * 4096, p.out + O_WKV_S + (size_t)item * 4096);
        }
    }
}

__device__ __forceinline__ void ph_rwkv_post(const P& p) {
    const int tid = threadIdx.x, lane = tid & 63, wid = tid >> 6;
    const int stride = gridDim.x * 8;
    const int first = blockIdx.x * 8 + wid, c = (first & 7) * 64 + lane;
    const float gg = p.gn_g[c], gb = p.gn_b[c];
    for (int it0 = first; it0 < MR * 8; it0 += 4 * stride) {
        float y[4], bon[4], vv[4], rg[4];
#pragma unroll
        for (int u = 0; u < 4; ++u) {
            const int it = it0 + u * stride < MR * 8 ? it0 + u * stride : it0, row = it >> 3;
            y[u] = p.ybuf()[(size_t)row * 512 + c];
            bon[u] = p.bonus()[it];
            vv[u] = bf2f(((const bf16_t*)(p.rw6() + (size_t)it * RW6_STRIDE + 256))[128 + lane]);
            rg[u] = bf2f(p.rg()[(size_t)row * 512 + c]);
        }
#pragma unroll
        for (int u = 0; u < 4; ++u) {
            const int it = it0 + u * stride, row = it >> 3;
            const float s1 = wave_sum(y[u]), s2 = wave_sum(y[u] * y[u]);
            const float mean = s1 * (1.0f / 64.0f);
            const float var = fmaxf(s2 * (1.0f / 64.0f) - mean * mean, 0.f);
            const float dv = y[u] - mean;
            float yn = dv * rsqrtf(var + 64e-5f) * gg + gb;
            yn += bon[u] * vv[u];
            if (it < MR * 8) p.ob()[(size_t)row * 512 + c] = f2bf(yn * rg[u]);
        }
    }
}

__device__ __forceinline__ void ph_cmp_gemm_f32(const P& p, LAS unsigned char* lds) {
    using pg8::lds_byte;
    const int tid = threadIdx.x, wid = __builtin_amdgcn_readfirstlane(tid >> 6), lane = tid & 63, wr = wid >> 2, wc = wid & 3, fr = lane & 15, fq = lane >> 4;
    constexpr int HTB = 16384;
    const int arow_l = 4 * wid + (lane >> 4), acol = 4 * (lane & 15);
    const int swbase = lds_byte(arow_l, acol);
    LAS unsigned long long* rowoff = (LAS unsigned long long*)(lds + 131072);
    unsigned voffB[2];
#pragma unroll
    for (int i = 0; i < 2; ++i) { int R, C; pg8::stage_rc(tid * 16 + i * 8192, R, C); voffB[i] = (unsigned)(R * 1024 + C) * 2u; }
    const unsigned ldsw = (unsigned)wid * 1024u;
    const int aoff = lds_byte(wr * 64 + fr, fq * 8), boff = lds_byte(wc * 32 + fr, fq * 8);
    for (int unit = blockIdx.x; unit < 512; unit += gridDim.x) {
        const int kvi = unit >> 8, bg = (unit >> 2) & 63, c0 = (unit & 3) * 256, b = bg >> 1, g = bg & 1;
        __syncthreads();
        if (tid < 256) {
            const int chunk = c0 + tid;
            const int page = p.page_table[b * 128 + (chunk >> 3)];
            rowoff[tid] = ((unsigned long long)page * 128 + (chunk & 7) * 16) * 256 + kvi * 128 + g * 64;
        }
        const char* bbase = (const char*)(p.W1T() + (size_t)kvi * 256 * 1024);
        f32x4 acc[2][2][4][2];
#pragma unroll
        for (int a = 0; a < 2; ++a)
#pragma unroll
            for (int bb = 0; bb < 2; ++bb)
#pragma unroll
                for (int m = 0; m < 4; ++m)
#pragma unroll
                    for (int n = 0; n < 2; ++n) acc[a][bb][m][n] = (f32x4){0.f, 0.f, 0.f, 0.f};
        f32x4 ar[8];
        auto stage_b = [&](int st, int t) {
#pragma unroll
            for (int h = 0; h < 2; ++h)
#pragma unroll
                for (int i = 0; i < 2; ++i)
                    __builtin_amdgcn_global_load_lds((const unsigned*)(bbase + (size_t)h * 128 * 2048 + (size_t)t * 128 + voffB[i]),
                                                     (PG8_LAS unsigned*)(lds + st * 65536 + 32768 + h * HTB + ldsw + i * 8192), 16, 0, 0);
        };
        auto load_a = [&](int t) {
#pragma unroll
            for (int q = 0; q < 8; ++q) ar[q] = *(const f32x4*)(p.cache_cmp + rowoff[32 * q + arow_l] + (size_t)t * 256 + acol);
        };
        auto write_a = [&](int st) {
            LAS unsigned char* na = lds + st * 65536;
#pragma unroll
            for (int q = 0; q < 8; ++q) *(LAS u32x2*)(na + swbase + (q >> 2) * HTB + (q & 3) * 4096) = (u32x2){pk2(ar[q][0], ar[q][1]), pk2(ar[q][2], ar[q][3])};
        };
        __syncthreads();
        load_a(0);
        stage_b(0, 0);
        write_a(0);
        __syncthreads();
#pragma unroll 1
        for (int t = 0; t < 16; ++t) {
            const int cur = t & 1;
            if (t + 1 < 16) { load_a(t + 1); stage_b(cur ^ 1, t + 1); }
            LAS const unsigned char* sa = lds + cur * 65536;
            LAS const unsigned char* sb = sa + 32768;
#pragma unroll
            for (int ai = 0; ai < 2; ++ai)
#pragma unroll
                for (int bj = 0; bj < 2; ++bj) {
                    bf16x8 Bt[2][2];
#pragma unroll
                    for (int n = 0; n < 2; ++n)
#pragma unroll
                        for (int k = 0; k < 2; ++k) Bt[n][k] = *(LAS const bf16x8*)(sb + bj * HTB + boff + n * 2048 + k * 1024);
#pragma unroll
                    for (int m = 0; m < 4; ++m) {
                        const bf16x8 a0 = *(LAS const bf16x8*)(sa + ai * HTB + aoff + m * 2048), a1 = *(LAS const bf16x8*)(sa + ai * HTB + aoff + m * 2048 + 1024);
#pragma unroll
                        for (int n = 0; n < 2; ++n) {
                            acc[ai][bj][m][n] = __builtin_amdgcn_mfma_f32_16x16x32_bf16(Bt[n][0], a0, acc[ai][bj][m][n], 0, 0, 0);
                            acc[ai][bj][m][n] = __builtin_amdgcn_mfma_f32_16x16x32_bf16(Bt[n][1], a1, acc[ai][bj][m][n], 0, 0, 0);
                        }
                    }
                    __builtin_amdgcn_sched_barrier(0);
                }
            if (t + 1 < 16) write_a(cur ^ 1);
            __syncthreads();
        }
        EpiPlainBf e; e.C = p.LHs() + ((size_t)kvi * 65536 + (size_t)bg * 1024 + c0) * 256; e.ldc = 256; e.pad_ = 0;
        pg8::Unit u; u.pm = 0; u.pn = 0;
        e(acc, u, wr, wc, fr, fq);
    }
}

__device__ __forceinline__ float exp2_(float x) { return __builtin_amdgcn_exp2f(x); }
template <class OKF>
__device__ __forceinline__ void sm_stats(const f32x16& s, int hb, OKF ok, float& m, float& l) {
    float sv[16]; float tmax = -1e30f; unsigned okm = 0;
#pragma unroll
    for (int i = 0; i < 16; ++i) { const int kl = (i & 3) + 8 * (i >> 2) + 4 * hb; const bool k = ok(kl); okm |= (k ? 1u : 0u) << i; sv[i] = k ? s[i] : -1e30f; tmax = fmaxf(tmax, sv[i]); }
    tmax = fmaxf(tmax, __shfl_xor(tmax, 32));
    const float mn = fmaxf(m, tmax), alpha = exp2_(m - mn); m = mn;
    float ps = 0.f;
#pragma unroll
    for (int i = 0; i < 16; ++i) ps += ((okm >> i) & 1u) ? exp2_(sv[i] - mn) : 0.f;
    l = l * alpha + ps;
}
template <class OKF, class VF>
__device__ __forceinline__ void sm_pv(const f32x16& s, int hb, OKF ok, VF vf, float& m, float& l, f32x16 (&o)[2]) {
    float sv[16]; float tmax = -1e30f; unsigned okm = 0;
#pragma unroll
    for (int i = 0; i < 16; ++i) { const int kl = (i & 3) + 8 * (i >> 2) + 4 * hb; const bool k = ok(kl); okm |= (k ? 1u : 0u) << i; sv[i] = k ? s[i] : -1e30f; tmax = fmaxf(tmax, sv[i]); }
    tmax = fmaxf(tmax, __shfl_xor(tmax, 32));
    const float mn = fmaxf(m, tmax), alpha = exp2_(m - mn); m = mn;
    float pr[16]; float ps = 0.f;
#pragma unroll
    for (int i = 0; i < 16; ++i) { pr[i] = ((okm >> i) & 1u) ? exp2_(sv[i] - mn) : 0.f; ps += pr[i]; }
    l = l * alpha + ps;
    o[0] *= alpha; o[1] *= alpha;
#pragma unroll
    for (int s2 = 0; s2 < 2; ++s2) {
        const bf16x8 pb = pack8(pr[8 * s2 + 0], pr[8 * s2 + 1], pr[8 * s2 + 2], pr[8 * s2 + 3], pr[8 * s2 + 4], pr[8 * s2 + 5], pr[8 * s2 + 6], pr[8 * s2 + 7]);
#pragma unroll
        for (int dt = 0; dt < 2; ++dt) o[dt] = mfma32(vf(dt, s2), pb, o[dt]);
    }
}
template <class VF>
__device__ __forceinline__ void sm_pv_nomask(const f32x16& s, bool csel, VF vf, float& m, float& l, f32x16 (&o)[2]) {
    float tmax = fmaxf(fmaxf(s[0], s[1]), s[2]);
#pragma unroll
    for (int i = 3; i < 16; ++i) tmax = fmaxf(tmax, s[i]);
    tmax = csel ? tmax : -1e30f;
    tmax = fmaxf(tmax, __shfl_xor(tmax, 32));
    const float mn = fmaxf(m, tmax), alpha = exp2_(m - mn); m = mn;
    float pr[16]; float ps = 0.f;
#pragma unroll
    for (int i = 0; i < 16; ++i) { pr[i] = csel ? exp2_(s[i] - mn) : 0.f; ps += pr[i]; }
    l = l * alpha + ps;
    o[0] *= alpha; o[1] *= alpha;
#pragma unroll
    for (int s2 = 0; s2 < 2; ++s2) {
        const bf16x8 pb = pack8(pr[8 * s2 + 0], pr[8 * s2 + 1], pr[8 * s2 + 2], pr[8 * s2 + 3], pr[8 * s2 + 4], pr[8 * s2 + 5], pr[8 * s2 + 6], pr[8 * s2 + 7]);
#pragma unroll
        for (int dt = 0; dt < 2; ++dt) o[dt] = mfma32(vf(dt, s2), pb, o[dt]);
    }
}
template <class OKF, class VF>
__device__ __forceinline__ void cmp_pass2(const f32x16& s, int hb, OKF ok, VF vf, float m, float inv, f32x16 (&o)[2], LAS float* prow, bool writer) {
    float pr[16];
#pragma unroll
    for (int i = 0; i < 16; ++i) {
        const int kl = (i & 3) + 8 * (i >> 2) + 4 * hb;
        pr[i] = ok(kl) ? exp2_(s[i] - m) * inv : 0.f;
        float q = pr[i] + __shfl_xor(pr[i], 1); q += __shfl_xor(q, 2);
        if (writer) prow[kl] = q;
    }
#pragma unroll
    for (int s2 = 0; s2 < 2; ++s2) {
        const bf16x8 pb = pack8(pr[8 * s2 + 0], pr[8 * s2 + 1], pr[8 * s2 + 2], pr[8 * s2 + 3], pr[8 * s2 + 4], pr[8 * s2 + 5], pr[8 * s2 + 6], pr[8 * s2 + 7]);
#pragma unroll
        for (int dt = 0; dt < 2; ++dt) o[dt] = mfma32(vf(dt, s2), pb, o[dt]);
    }
}

__device__ __forceinline__ void attn_store(const P& p, const f32x16 (&of)[2], int qrow, int head, int hb, bool doit, bf16_t* oadst = nullptr) {
    if (!oadst) oadst = p.oa();
    if (!doit) return;
#pragma unroll
    for (int dt = 0; dt < 2; ++dt)
#pragma unroll
        for (int i4 = 0; i4 < 4; ++i4) {
            const int d = 32 * dt + 8 * i4 + 4 * hb;
            const size_t off = (size_t)qrow * 512 + head * 64 + d;
            const uint2 gw = *(const uint2*)(p.ag() + off);
            f32x4 v;
            v[0] = of[dt][4 * i4 + 0] * __uint_as_float(gw.x << 16); v[1] = of[dt][4 * i4 + 1] * __uint_as_float(gw.x & 0xffff0000u);
            v[2] = of[dt][4 * i4 + 2] * __uint_as_float(gw.y << 16); v[3] = of[dt][4 * i4 + 3] * __uint_as_float(gw.y & 0xffff0000u);
            st_bf4(oadst + off, v);
        }
}


__device__ __forceinline__ void of_put(LAS float* st, int lane, const f32x16 (&o)[2], float sc) {
#pragma unroll
    for (int dt = 0; dt < 2; ++dt)
#pragma unroll
        for (int i = 0; i < 16; ++i) st[(dt * 16 + i) * 64 + lane] = o[dt][i] * sc;
}
__device__ __forceinline__ void of_add(LAS float* st, int lane, const f32x16 (&o)[2], float sc) {
#pragma unroll
    for (int dt = 0; dt < 2; ++dt)
#pragma unroll
        for (int i = 0; i < 16; ++i) st[(dt * 16 + i) * 64 + lane] += o[dt][i] * sc;
}
__device__ __forceinline__ void of_get_add(LAS float* st, int lane, const f32x16 (&o)[2], float sc, f32x16 (&of)[2]) {
#pragma unroll
    for (int dt = 0; dt < 2; ++dt)
#pragma unroll
        for (int i = 0; i < 16; ++i) of[dt][i] = st[(dt * 16 + i) * 64 + lane] + o[dt][i] * sc;
}


constexpr int WL_STRIDE = 15360, KV_OFF = 8 * WL_STRIDE, KV_BUF = 17920, XB_OFF = KV_OFF + 2 * KV_BUF;

struct LoadBf16 {
    const bf16_t* kbase; const bf16_t* vbase; int ld; bool with_v; u32x4_t kr[2], vr[2];
    static constexpr int DEPTH = 2;
    __device__ __forceinline__ void load(int n, int slot) {
        const int tid = threadIdx.x, srow = tid >> 3, sch = tid & 7;
        const u32x4_t k = *(const u32x4_t*)(kbase + (size_t)(64 * n + srow) * 64 + sch * 8);
        u32x4_t v = k;
        if (with_v) v = *(const u32x4_t*)(vbase + (size_t)srow * ld + 64 * n + sch * 8);
        if (slot) { kr[1] = k; vr[1] = v; } else { kr[0] = k; vr[0] = v; }
    }
    __device__ __forceinline__ void store(LAS unsigned char* buf, int slot) const {
        const int tid = threadIdx.x, srow = tid >> 3, sch = tid & 7;
        const u32x4_t k = slot ? kr[1] : kr[0], v = slot ? vr[1] : vr[0];
        *(LAS u32x4_t*)(buf + srow * 144 + sch * 16) = k;
        if (with_v) { LAS u32x2* vp = (LAS u32x2*)(buf + 9216 + srow * 136 + sch * 16); vp[0] = (u32x2){v[0], v[1]}; vp[1] = (u32x2){v[2], v[3]}; }
    }
};
struct LoadWinF32 {
    const float* cw; const float* nw; f32x4 k0, k1, v0, v1;
    static constexpr int DEPTH = 1;
    __device__ __forceinline__ void load(int n, int) {
        const int tid = threadIdx.x, srow = tid >> 3, sch = tid & 7;
        const int j = 64 * n + srow;
        const float* r = j < 512 ? cw + (size_t)j * 256 : nw + (size_t)(j - 512 < 8 ? j - 512 : 7) * 256;
        k0 = *(const f32x4*)(r + sch * 8); k1 = *(const f32x4*)(r + sch * 8 + 4);
        v0 = *(const f32x4*)(r + 128 + sch * 8); v1 = *(const f32x4*)(r + 128 + sch * 8 + 4);
    }
    __device__ __forceinline__ void store(LAS unsigned char* buf, int) const {
        const int tid = threadIdx.x, srow = tid >> 3, sch = tid & 7;
        u32x4_t kw; kw[0] = pk2(k0[0], k0[1]); kw[1] = pk2(k0[2], k0[3]); kw[2] = pk2(k1[0], k1[1]); kw[3] = pk2(k1[2], k1[3]);
        *(LAS u32x4_t*)(buf + srow * 144 + sch * 16) = kw;
        LAS bf16_t* vb = (LAS bf16_t*)(buf + 9216) + (sch * 8) * 68 + srow;
#pragma unroll
        for (int e = 0; e < 4; ++e) { vb[e * 68] = f2bf(v0[e]); vb[(4 + e) * 68] = f2bf(v1[e]); }
    }
};

template <class LOADER, class NEXT, class ACTIVE, class BODY>
__device__ __forceinline__ void block_loop_g(LOADER ld, LAS unsigned char* kv, int first, NEXT next, ACTIVE active, BODY body) {
    if (first < 0) return;
    int n = first, cur = 0;
    if (LOADER::DEPTH == 2) {
        int nn = next(n), k = 0;
        ld.load(n, 0); ld.store(kv, 0);
        if (nn >= 0) ld.load(nn, 1);
        __syncthreads();
#pragma unroll 1
        for (;;) {
            const int nnn = nn >= 0 ? next(nn) : -1;
            if (nnn >= 0) ld.load(nnn, k & 1);
            if (active(n)) body(n, (LAS const bf16_t*)(kv + cur * KV_BUF), (LAS const bf16_t*)(kv + cur * KV_BUF + 9216));
            if (nn >= 0) ld.store(kv + (cur ^ 1) * KV_BUF, (k + 1) & 1);
            __syncthreads();
            if (nn < 0) break;
            cur ^= 1; n = nn; nn = nnn; ++k;
        }
    } else {
        ld.load(n, 0);
        ld.store(kv, 0);
        __syncthreads();
#pragma unroll 1
        for (;;) {
            const int nn = next(n);
            if (nn >= 0) ld.load(nn, 0);
            if (active(n)) body(n, (LAS const bf16_t*)(kv + cur * KV_BUF), (LAS const bf16_t*)(kv + cur * KV_BUF + 9216));
            if (nn >= 0) ld.store(kv + (cur ^ 1) * KV_BUF, 0);
            __syncthreads();
            if (nn < 0) break;
            cur ^= 1; n = nn;
        }
    }
}
template <bool WITH_V, class NEXT, class ACTIVE, class BODY>
__device__ __forceinline__ void block_loop(const bf16_t* kbase, const bf16_t* vbase, int ld, LAS unsigned char* kv, int first, NEXT next, ACTIVE active, BODY body) {
    LoadBf16 L; L.kbase = kbase; L.vbase = vbase; L.ld = ld; L.with_v = WITH_V;
    block_loop_g(L, kv, first, next, active, body);
}
__device__ __forceinline__ bf16x8 lds_kfrag(LAS const bf16_t* kb, int kt, int ks, int col, int hb) { return *(LAS const bf16x8*)(kb + (32 * kt + col) * 72 + 16 * ks + 8 * hb); }
__device__ __forceinline__ bf16x8 lds_vfrag(LAS const bf16_t* vb, int kt, int dt, int s2, int col, int hb) {
    LAS const bf16_t* ptr = vb + (32 * dt + col) * 68 + 32 * kt + 16 * s2 + 4 * hb;
    union { u32x4_t u; bf16x8 v; } x; const u32x2 a = *(LAS const u32x2*)ptr, c = *(LAS const u32x2*)(ptr + 8); x.u[0] = a[0]; x.u[1] = a[1]; x.u[2] = c[0]; x.u[3] = c[1]; return x.v;
}
__device__ __forceinline__ f32x16 lds_qk(const bf16x8 (&qf)[4], LAS const bf16_t* kb, int kt, int col, int hb) {
    f32x16 s = zero16();
#pragma unroll
    for (int ks = 0; ks < 4; ++ks) s = mfma32(lds_kfrag(kb, kt, ks, col, hb), qf[ks], s);
    return s;
}

__device__ __forceinline__ void attn_prompt_block(const P& p, int bg, int j, LAS unsigned char* lds) {
    int tid_l = threadIdx.x; asm volatile("" : "+v"(tid_l));
    const int tid = tid_l, lane = tid & 63, wid = __builtin_amdgcn_readfirstlane(tid >> 6);
    const int b = bg >> 1, g = bg & 1;
    const int col = lane & 31, hb = lane >> 5, tl = col >> 2, hh = col & 3;
    const int t0 = 64 * j + 8 * wid, qpos = t0 + tl, qrow = b * SEQ + qpos, head = g * 4 + hh;
    LAS unsigned char* wl = lds + wid * WL_STRIDE;
    LAS unsigned char* kv = lds + KV_OFF;
    LAS float* psum = (LAS float*)wl;
    LAS unsigned long long* msk = (LAS unsigned long long*)(wl + 8192);
    bf16x8 qf[4];
#pragma unroll
    for (int ks = 0; ks < 4; ++ks) qf[ks] = *(const bf16x8*)(p.qb() + (size_t)qrow * 512 + head * 64 + 16 * ks + 8 * hb);
    const float g0 = p.gates()[(size_t)qrow * 32 + head * 3 + 0], g1 = p.gates()[(size_t)qrow * 32 + head * 3 + 1], g2 = p.gates()[(size_t)qrow * 32 + head * 3 + 2];
    f32x16 oc[2]; oc[0] = zero16(); oc[1] = zero16();
    {
        const int cmb = 64 * j + 63 - 31;
        const int nbc = ((cmb >> 4) >> 6) + 1;
        const int cmw = t0 + 7 - 31;
        const int cmaxw = cmw >= 0 ? (cmw >> 4) : -1;
        const bf16_t* kc = p.kc_p() + (size_t)bg * 256 * 64;
        const bf16_t* vc = p.vcT_p() + (size_t)bg * 64 * 256;
        float m = -1e30f, l = 0.f;
        block_loop<false>(kc, vc, 256, kv, 0, [&](int n) { return n + 1 < nbc ? n + 1 : -1; }, [&](int n) { return cmaxw >= 64 * n; },
            [&](int n, LAS const bf16_t* kb, LAS const bf16_t* vb) {
#pragma unroll 1
                for (int kt = 0; kt < 2; ++kt) {
                    const f32x16 s = lds_qk(qf, kb, kt, col, hb);
                    sm_stats(s, hb, [&](int kl) { return 16 * (64 * n + 32 * kt + kl) + 31 <= qpos; }, m, l);
                }
            });
        l += __shfl_xor(l, 32);
        const float inv = l > 0.f ? 1.0f / l : 0.f;
#pragma unroll
        for (int i = 0; i < 32; ++i) psum[i * 64 + lane] = 0.f;
        WAVE_SYNC();
        block_loop<true>(kc, vc, 256, kv, 0, [&](int n) { return n + 1 < nbc ? n + 1 : -1; }, [&](int n) { return cmaxw >= 64 * n; },
            [&](int n, LAS const bf16_t* kb, LAS const bf16_t* vb) {
#pragma unroll 1
                for (int kt = 0; kt < 2; ++kt) {
                    const f32x16 s = lds_qk(qf, kb, kt, col, hb);
                    cmp_pass2(s, hb, [&](int kl) { return 16 * (64 * n + 32 * kt + kl) + 31 <= qpos; }, [&](int dt, int s2) { return lds_vfrag(vb, kt, dt, s2, col, hb); }, m, inv, oc,
                              psum + tl * 256 + 64 * n + 32 * kt, hh == 0);
                }
            });
    }
    WAVE_SYNC();
    unsigned long long umw = 0;
    for (int t2 = 0; t2 < 8; ++t2) {
        const int t = t0 + t2, cur = t >> 6, n = lane;
        float imp = 0.f;
#pragma unroll
        for (int c = -1; c < 4; ++c) { const int cc = 4 * n + c; if (cc >= 0) imp += psum[t2 * 256 + cc]; }
        if (n == 0 || n == cur || n == cur - 1) imp = 1e4f;
        if (n * 64 > t) imp = -1.0f;
        int rank = 0;
#pragma unroll
        for (int jj = 0; jj < 64; ++jj) {
            const float vj = __uint_as_float(__builtin_amdgcn_readlane(__float_as_uint(imp), jj));
            rank += (vj > imp || (vj == imp && jj < n)) ? 1 : 0;
        }
        const unsigned long long mk = __ballot(rank < 16);
        if (lane == 0) msk[t2] = mk;
        umw |= mk;
    }
    if (lane == 0) msk[8] = umw;
    __syncthreads();
    const unsigned long long mymask = msk[tl];
    unsigned long long umb = 0;
#pragma unroll
    for (int w2 = 0; w2 < 8; ++w2) umb |= *(LAS const unsigned long long*)(lds + w2 * WL_STRIDE + 8192 + 64);
    {
        const unsigned lo = __builtin_amdgcn_readfirstlane((unsigned)umb), hi = __builtin_amdgcn_readfirstlane((unsigned)(umb >> 32));
        umb = ((unsigned long long)hi << 32) | lo;
        if (j < 63) umb &= (2ull << j) - 1ull;
    }
    LAS float* ost = (LAS float*)wl;
    of_put(ost, lane, oc, g0);
    {
        const bf16_t* kbs = p.kb() + (size_t)((1 * NB + b) * 2 + g) * SEQ * 64;
        const bf16_t* vbs = p.vT() + (size_t)((0 * NB + b) * 2 + g) * 64 * SEQ;
        float m = -1e30f, l = 0.f; f32x16 o[2]; o[0] = zero16(); o[1] = zero16();
        block_loop<true>(kbs, vbs, SEQ, kv, umb ? (int)__builtin_ctzll(umb) : -1,
            [&](int n) { if (n >= 63) return -1; const unsigned long long rem = umb >> (n + 1); return rem ? n + 1 + (int)__builtin_ctzll(rem) : -1; },
            [&](int n) { return (bool)((umw >> n) & 1ull); },
            [&](int n, LAS const bf16_t* kb, LAS const bf16_t* vb) {
                const bool bsel = (mymask >> n) & 1ull;
#pragma unroll
                for (int kt = 0; kt < 2; ++kt) {
                    const int tok0 = 64 * n + 32 * kt;
                    const f32x16 s = lds_qk(qf, kb, kt, col, hb);
                    if (n < j) sm_pv_nomask(s, bsel, [&](int dt, int s2) { return lds_vfrag(vb, kt, dt, s2, col, hb); }, m, l, o);
                    else sm_pv(s, hb, [&](int kl) { return bsel && (tok0 + kl <= qpos); }, [&](int dt, int s2) { return lds_vfrag(vb, kt, dt, s2, col, hb); }, m, l, o);
                }
            });
        l += __shfl_xor(l, 32);
        const float sc = l > 0.f ? g1 / l : 0.f;
        of_add(ost, lane, o, sc);
    }
    {
        const bf16_t* kbw = p.kb() + (size_t)((2 * NB + b) * 2 + g) * SEQ * 64;
        const bf16_t* vbw = p.vT() + (size_t)((1 * NB + b) * 2 + g) * 64 * SEQ;
        float m = -1e30f, l = 0.f; f32x16 o[2]; o[0] = zero16(); o[1] = zero16();
        block_loop<true>(kbw, vbw, SEQ, kv, j > 8 ? j - 8 : 0, [&](int n) { return n < j ? n + 1 : -1; }, [&](int n) { return true; },
            [&](int n, LAS const bf16_t* kb, LAS const bf16_t* vb) {
#pragma unroll 1
                for (int kt = 0; kt < 2; ++kt) {
                    const int tok0 = 64 * n + 32 * kt;
                    const f32x16 s = lds_qk(qf, kb, kt, col, hb);
                    if (n < j && n > j - 8) sm_pv_nomask(s, true, [&](int dt, int s2) { return lds_vfrag(vb, kt, dt, s2, col, hb); }, m, l, o);
                    else sm_pv(s, hb, [&](int kl) { const int key = tok0 + kl; return key <= qpos && key + 511 >= qpos; }, [&](int dt, int s2) { return lds_vfrag(vb, kt, dt, s2, col, hb); }, m, l, o);
                }
            });
        l += __shfl_xor(l, 32);
        const float sc = l > 0.f ? g2 / l : 0.f;
        f32x16 of[2];
        of_get_add(ost, lane, o, sc, of);
        attn_store(p, of, qrow, head, hb, true);
    }
    __syncthreads();
}

__device__ __forceinline__ void attn_sample_block(const P& p, int bg, LAS unsigned char* lds) {
    int tid_l = threadIdx.x; asm volatile("" : "+v"(tid_l));
    const int tid = tid_l, lane = tid & 63, wid = __builtin_amdgcn_readfirstlane(tid >> 6);
    const int b = bg >> 1, g = bg & 1, t = wid;
    const int col = lane & 31, hb = lane >> 5, hh = col & 3;
    const int qrow = NP + b * 8 + t, head = g * 4 + hh;
    LAS unsigned char* wl = lds + wid * WL_STRIDE;
    LAS unsigned char* kv = lds + KV_OFF;
    bf16x8 qf[4];
#pragma unroll
    for (int ks = 0; ks < 4; ++ks) qf[ks] = *(const bf16x8*)(p.qb() + (size_t)qrow * 512 + head * 64 + 16 * ks + 8 * hb);
    LAS float* psum = (LAS float*)wl;
    LAS int* list = (LAS int*)(wl + 8256);
    LAS float* impl = (LAS float*)(wl + 8448);
    LAS bf16_t* vt = (LAS bf16_t*)(wl + 9728);
    const float g0 = p.gates()[(size_t)qrow * 32 + head * 3 + 0], g1 = p.gates()[(size_t)qrow * 32 + head * 3 + 1], g2 = p.gates()[(size_t)qrow * 32 + head * 3 + 2];
    f32x16 oc[2]; oc[0] = zero16(); oc[1] = zero16();
    {
        const bf16_t* kc = p.kc_s() + (size_t)bg * 1024 * 64;
        const bf16_t* vc = p.vcT_s() + (size_t)bg * 64 * 1024;
        float m = -1e30f, l = 0.f;
        block_loop<false>(kc, vc, 1024, kv, 0, [&](int n) { return n < 15 ? n + 1 : -1; }, [&](int n) { return true; },
            [&](int n, LAS const bf16_t* kb, LAS const bf16_t* vb) {
#pragma unroll 1
                for (int kt = 0; kt < 2; ++kt) {
                    const f32x16 s = lds_qk(qf, kb, kt, col, hb);
                    sm_stats(s, hb, [&](int kl) { return 64 * n + 32 * kt + kl <= 1022; }, m, l);
                }
            });
        l += __shfl_xor(l, 32);
        const float inv = l > 0.f ? 1.0f / l : 0.f;
        block_loop<true>(kc, vc, 1024, kv, 0, [&](int n) { return n < 15 ? n + 1 : -1; }, [&](int n) { return true; },
            [&](int n, LAS const bf16_t* kb, LAS const bf16_t* vb) {
#pragma unroll 1
                for (int kt = 0; kt < 2; ++kt) {
                    const f32x16 s = lds_qk(qf, kb, kt, col, hb);
                    cmp_pass2(s, hb, [&](int kl) { return 64 * n + 32 * kt + kl <= 1022; }, [&](int dt, int s2) { return lds_vfrag(vb, kt, dt, s2, col, hb); }, m, inv, oc,
                              psum + 64 * n + 32 * kt, col == 0);
                }
            });
    }
    WAVE_SYNC();
#pragma unroll
    for (int j = 0; j < 5; ++j) {
        const int n = lane + 64 * j;
        if (n <= 256) {
            float imp = 0.f;
            for (int c = -1; c < 4; ++c) { const int cc = 4 * n + c; if (cc >= 0 && cc <= 1022) imp += psum[cc]; }
            impl[n] = imp;
        }
    }
    WAVE_SYNC();
    {
        int base = 0;
#pragma unroll
        for (int j = 0; j < 4; ++j) {
            const int n = lane + 64 * j;
            const bool cand = n >= 1 && n <= 254;
            const float v = impl[n];
            int rank = 0;
            for (int q = 1; q <= 254; ++q) { const float vq = impl[q]; rank += (vq > v || (vq == v && q < n)) ? 1 : 0; }
            const bool sel = cand && rank < 13;
            const unsigned long long mk = __ballot(sel);
            if (sel) list[base + __popcll(mk & ((1ull << lane) - 1ull))] = n;
            base += __popcll(mk);
        }
        if (lane == 0) { list[13] = 0; list[14] = 255; list[15] = 256; }
    }
    WAVE_SYNC();
    if (lane < 16) {
        const int n = list[lane];
        list[16 + lane] = n < 256 ? p.page_table[b * 128 + (n >> 1)] * 128 + (n & 1) * 64 : -1;
    }
    WAVE_SYNC();
    LAS float* ost = (LAS float*)wl;
    of_put(ost, lane, oc, g0);
    {
        float m = -1e30f, l = 0.f; f32x16 o[2]; o[0] = zero16(); o[1] = zero16();
        const float* newrows = p.out + O_SEL_S + (size_t)(b * 8) * 256 + g * 64;
        auto rowptr = [&](int u) -> const float* {
            const int rb = __builtin_amdgcn_readfirstlane(list[16 + (u >> 1)]);
            return rb >= 0 ? p.cache_sel + ((size_t)rb + 32 * (u & 1) + col) * 256 + g * 64 : newrows + (size_t)(col < 8 ? col : 7) * 256;
        };
        f32x4 kA[4], kB[4];
        { const float* kr = rowptr(0) + 8 * hb;
#pragma unroll
          for (int ks = 0; ks < 4; ++ks) { kA[ks] = *(const f32x4*)(kr + 16 * ks); kB[ks] = *(const f32x4*)(kr + 16 * ks + 4); } }
#pragma unroll 1
        for (int u = 0; u < 31; ++u) {
            const bool isnew = __builtin_amdgcn_readfirstlane(list[16 + (u >> 1)]) < 0;
            const float* vr = rowptr(u) + 128 + 32 * hb;
            f32x4 vv[8];
#pragma unroll
            for (int j4 = 0; j4 < 8; ++j4) vv[j4] = *(const f32x4*)(vr + 4 * j4);
            f32x16 s = zero16();
#pragma unroll
            for (int ks = 0; ks < 4; ++ks) s = mfma32(pack8(kA[ks][0], kA[ks][1], kA[ks][2], kA[ks][3], kB[ks][0], kB[ks][1], kB[ks][2], kB[ks][3]), qf[ks], s);
            if (u + 1 < 31) { const float* kr = rowptr(u + 1) + 8 * hb;
#pragma unroll
                for (int ks = 0; ks < 4; ++ks) { kA[ks] = *(const f32x4*)(kr + 16 * ks); kB[ks] = *(const f32x4*)(kr + 16 * ks + 4); } }
#pragma unroll
            for (int j4 = 0; j4 < 8; ++j4)
#pragma unroll
                for (int e = 0; e < 4; ++e) vt[(32 * hb + 4 * j4 + e) * 40 + col] = f2bf(vv[j4][e]);
            WAVE_SYNC();
            sm_pv(s, hb, [&](int kl) { return !isnew || kl <= t; }, [&](int dt, int s2) {
                LAS const bf16_t* ptr = vt + (32 * dt + col) * 40 + 16 * s2 + 4 * hb;
                union { u32x4_t u4; bf16x8 v; } x; const u32x2 a = *(LAS const u32x2*)ptr, c = *(LAS const u32x2*)(ptr + 8); x.u4[0] = a[0]; x.u4[1] = a[1]; x.u4[2] = c[0]; x.u4[3] = c[1]; return x.v; }, m, l, o);
            WAVE_SYNC();
        }
        l += __shfl_xor(l, 32);
        const float sc = l > 0.f ? g1 / l : 0.f;
        of_add(ost, lane, o, sc);
    }
    {
        float m = -1e30f, l = 0.f; f32x16 o[2]; o[0] = zero16(); o[1] = zero16();
        LoadWinF32 L; L.cw = p.cache_win + (size_t)b * 512 * 256 + g * 64; L.nw = p.out + O_WIN_S + ((size_t)b * 512 + 504) * 256 + g * 64;
        block_loop_g(L, kv, 0, [&](int n) { return n < 8 ? n + 1 : -1; }, [&](int n) { return true; },
            [&](int n, LAS const bf16_t* kb, LAS const bf16_t* vb) {
#pragma unroll 1
                for (int kt = 0; kt < 2; ++kt) {
                    const int j0 = 64 * n + 32 * kt;
                    if (j0 >= 520) break;
                    const f32x16 s = lds_qk(qf, kb, kt, col, hb);
                    sm_pv(s, hb, [&](int kl) { const int j = j0 + kl; return j >= t + 1 && j <= 512 + t; }, [&](int dt, int s2) { return lds_vfrag(vb, kt, dt, s2, col, hb); }, m, l, o);
                }
            });
        l += __shfl_xor(l, 32);
        const float sc = l > 0.f ? g2 / l : 0.f;
        f32x16 of[2];
        of_get_add(ost, lane, o, sc, of);
        attn_store(p, of, qrow, head, hb, col < 4);
    }
    __syncthreads();
}

__device__ __forceinline__ void ph_attn(const P& p, LAS unsigned char* lds, int qsel = 0) {
    const int tid = threadIdx.x, lane = tid & 63, wid = tid >> 6;
    unsigned* ctr = p.bar() + 3584 + 64 * qsel;
    LAS unsigned* qslot = (LAS unsigned*)(lds + XB_OFF + 64);
    for (;;) {
        if (tid == 0) *qslot = __hip_atomic_fetch_add(ctr, 1u, __ATOMIC_RELAXED, __HIP_MEMORY_SCOPE_AGENT);
        __syncthreads();
        const unsigned q = __builtin_amdgcn_readfirstlane(*qslot);
        __syncthreads();
        if (q >= 64u + 512u) break;
        if (q < 64u) attn_sample_block(p, (int)q, lds);
        else { const int idx = (int)q - 64; attn_prompt_block(p, idx & 7, 63 - (idx >> 3), lds);
        }
    }
}


constexpr int LDS_BYTES = pg8::STAGE_BYTES;

constexpr int FUSED_LDS = XB_OFF + 256;

template <class Epi> __device__ __forceinline__ void run_gemm(LAS unsigned char* lds, const bf16_t* A, const bf16_t* Bt, int M, int N, int K, const Epi& E, int slot = -1) {
    pg8::Gemm g; g.A = A; g.Bt = Bt; g.M = M; g.N = N; g.K = K; g.pad_ = 0;
    pg8::StaticOrder S; S.init(M, N, (int)gridDim.x, slot >= 0 ? slot : (int)blockIdx.x);
    pg8::gemm_phase<Epi, pg8::StaticOrder, false>((PG8_LAS unsigned char*)lds, g, S, E, nullptr);
}

#define XBAR() xcd_barrier(bar)
__global__ __launch_bounds__(512, 2) void k_fused(P p) {
    extern __shared__ __attribute__((aligned(16))) unsigned char shm[];
    LAS unsigned char* lds = (LAS unsigned char*)shm;
    LAS unsigned* xb = (LAS unsigned*)(lds + XB_OFF);
    if (threadIdx.x == 0) { xb[0] = 0u; xb[1] = 0u; xb[2] = 0u; xb[3] = 0u; }
    __syncthreads();
    XcdBarrier bar = xcd_barrier_post(p.bar(), (volatile LAS unsigned*)xb);
    ph_prep(p);
    XBAR();
    ph_inproj_sample(p);
    { EpiIn e; e.p = p; e.row0 = 0; e.pn0 = 0; run_gemm(lds, p.hb(), p.WinT(), NP, NPAD, DM, e); }
    ph_cmp_gemm_f32(p, lds);
    XBAR();
    if ((int)blockIdx.x < 16) {
        const int kvi = blockIdx.x >> 3, bg = blockIdx.x & 7;
        EpiPlainBf e; e.C = p.LHp() + ((size_t)kvi * 2048 + (size_t)bg * 256) * 256; e.ldc = 256; e.pad_ = 0;
        run_gemm(lds, (kvi ? p.vcr() : p.kb()) + (size_t)bg * 256 * 1024, p.W1T() + (size_t)kvi * 256 * 1024, 256, 256, 1024, e, 0);
        __builtin_amdgcn_fence(__ATOMIC_RELEASE, "agent");
        asm volatile("s_waitcnt vmcnt(0)" ::: "memory");
        __syncthreads();
        __builtin_amdgcn_fence(__ATOMIC_ACQUIRE, "agent");
        asm volatile("s_waitcnt vmcnt(0)" ::: "memory");
        compress2_tile(p, p.LHp(), 8, 256, 255, p.kc_p(), p.vcT_p(), kvi, bg, threadIdx.x >> 6, threadIdx.x & 63, lds + (threadIdx.x >> 6) * 8960);
    }
    ph_rwkv_prep(p);
    ph_compress2(p, p.LHs(), 64, 1024, 1023, p.kc_s(), p.vcT_s(), lds);
    XBAR();
    ph_rwkv_scan(p, (LAS float*)lds);
    __syncthreads();
    ph_attn(p, lds);
    XBAR();
    ph_rwkv_post(p);
    { EpiYa e; e.p = p; small_gemm(p.oa(), p.WpaT(), 512, e); run_gemm(lds, p.oa(), p.WpaT(), NP, DM, 512, e); }
    XBAR();
    { EpiYb e; e.p = p; small_gemm(p.ob(), p.WpbT(), 512, e); run_gemm(lds, p.ob(), p.WpbT(), NP, DM, 512, e); }
    XBAR();
    { EpiOut e; e.p = p; small_gemm(p.mb(), p.WoutT(), DM, e); run_gemm(lds, p.mb(), p.WoutT(), NP, DM, DM, e); }
    { EpiPlain e; e.C = p.pp(); e.ldc = DM; e.pad_ = 0; small_gemm(p.pb(), p.WprojT(), 256, e); run_gemm(lds, p.pb(), p.WprojT(), NP, DM, 256, e); }
    XBAR();
    { EpiGate e; e.p = p; small_gemm(p.xg(), p.WgateT(), DM, e); run_gemm(lds, p.xg(), p.WgateT(), NP, DM, DM, e); }
    XBAR();
    ph_final(p);
}
extern "C" void kernel_launch(void* const* d_in, const int* in_sizes, int n_in, void* d_out, int out_size, void* d_ws, size_t ws_size, hipStream_t stream) {
    (void)in_sizes; (void)n_in; (void)out_size; (void)ws_size;
    P p{};
    p.x_prompt = (const float*)d_in[0]; p.x_sample = (const float*)d_in[1]; p.p_prompt = (const float*)d_in[2]; p.p_sample = (const float*)d_in[3];
    p.cache_cmp = (const float*)d_in[4]; p.cache_sel = (const float*)d_in[5]; p.cache_win = (const float*)d_in[6]; p.state_wkv = (const float*)d_in[7];
    p.state_shift = (const float*)d_in[8]; p.page_table = (const int*)d_in[9]; p.norm_g = (const float*)d_in[10]; p.w_in = (const float*)d_in[11];
    p.cmp_pe = (const float*)d_in[12]; p.cmp_w1 = (const float*)d_in[13]; p.cmp_b1 = (const float*)d_in[14]; p.cmp_w2 = (const float*)d_in[15]; p.cmp_b2 = (const float*)d_in[16];
    p.w_pa = (const float*)d_in[17]; p.mu = (const float*)d_in[18]; p.w0 = (const float*)d_in[19]; p.w_up = (const float*)d_in[20]; p.a0 = (const float*)d_in[21];
    p.a_up = (const float*)d_in[22]; p.k_k = (const float*)d_in[23]; p.k_a = (const float*)d_in[24]; p.r_k = (const float*)d_in[25]; p.gn_g = (const float*)d_in[26];
    p.gn_b = (const float*)d_in[27]; p.w_pb = (const float*)d_in[28]; p.w_out = (const float*)d_in[29]; p.ple_g = (const float*)d_in[30]; p.w_gate = (const float*)d_in[31];
    p.w_proj = (const float*)d_in[32]; p.final_g = (const float*)d_in[33];
    p.out = (float*)d_out;
    p.ws = (unsigned char*)d_ws;

    static int grid = 0;
    if (!grid) {
        int dev = 0, cus = 0, per_cu = 0;
        (void)hipGetDevice(&dev);
        (void)hipDeviceGetAttribute(&cus, hipDeviceAttributeMultiprocessorCount, dev);
        (void)hipFuncSetAttribute((const void*)k_fused, hipFuncAttributeMaxDynamicSharedMemorySize, FUSED_LDS);
        (void)hipOccupancyMaxActiveBlocksPerMultiprocessor(&per_cu, k_fused, 512, FUSED_LDS);
        grid = per_cu >= 1 ? cus : 0;
        if (grid > 256) grid = 256;
    }
    (void)hipMemsetAsync(p.bar(), 0, 32768, stream);
    if (grid > 0) hipLaunchKernelGGL(k_fused, dim3(grid), dim3(512), FUSED_LDS, stream, p);
}
```

```cpp
#include <hip/hip_runtime.h>
#include <stdint.h>
#include <stdio.h>
namespace pg8 {
#define PG8_LAS __attribute__((address_space(3)))
typedef unsigned short bf16_t;
typedef short bf16x8 __attribute__((ext_vector_type(8)));
typedef float f32x4 __attribute__((ext_vector_type(4)));
typedef unsigned u32x4 __attribute__((ext_vector_type(4)));
constexpr int BM = 256, BK = 64, HALF = 128, HTB = HALF * BK * 2  , STAGE_BYTES = 8 * HTB, NXCD = 8, WGM = 8;

__host__ __device__ __forceinline__ int lds_byte(int r, int c) { const int st = (r >> 4) * 2 + (c >> 5), rr = r & 15, cc = c & 31, ob = rr * 64 + cc * 2; return st * 1024 + (ob ^ (((ob >> 9) & 1) << 5)); }
__host__ __device__ __forceinline__ void stage_rc(int b, int& R, int& C) { const int st = b / 1024, sb = b % 1024, swz = sb ^ (((sb >> 9) & 1) << 5); R = (st >> 1) * 16 + swz / 64; C = (st & 1) * 32 + (swz % 64) / 2; }
__host__ __device__ __forceinline__ int perm32(int rho) { const int n = rho >> 4, i = rho & 15; return 8 * (i >> 2) + 4 * n + (i & 3); }

struct Unit { int pm, pn; };
struct Gemm { const bf16_t* A; const bf16_t* Bt; int M, N, K, pad_; };

struct StaticOrder {
    int nM, nN, nwg, G, c;
    __host__ __device__ void init(int M, int N, int G_, int c_) { nM = M / BM; nN = N / BM; nwg = nM * nN; G = G_; c = c_; }
    __host__ __device__ bool next(int i, Unit& u) const {
        const long L = (long)i * G + c; if (L >= nwg) return false;
        int wgid = (int)L; { const int q = nwg / NXCD, r = nwg % NXCD, xcd = wgid % NXCD, off = wgid / NXCD; wgid = (xcd < r ? xcd * (q + 1) : r * (q + 1) + (xcd - r) * q) + off; }
        const int nig = WGM * nN, gid = wgid / nig, fm = gid * WGM, gsz = (nM - fm) < WGM ? (nM - fm) : WGM;
        u.pm = fm + ((wgid % nig) % gsz); u.pn = (wgid % nig) / gsz; return true;
    }
    __device__ __forceinline__ void a_ready(const Unit&) const {}
    __device__ __forceinline__ void done(const Unit&) const {}
};
__device__ __forceinline__ unsigned cvt_pk_bf16(float lo, float hi) { unsigned r; asm volatile("v_cvt_pk_bf16_f32 %0, %1, %2" : "=v"(r) : "v"(lo), "v"(hi)); return r; }
typedef float f32x2 __attribute__((ext_vector_type(2)));
template <class Epi, class Sched, bool STAMP = false>
__device__ __forceinline__ void gemm_phase(PG8_LAS unsigned char* lds, const Gemm g, const Sched& S, const Epi& E, unsigned long long* stamps) {
    int tid_l = threadIdx.x; asm volatile("" : "+v"(tid_l));
    const int tid = tid_l, wid = __builtin_amdgcn_readfirstlane(tid >> 6), lane = tid & 63, wr = wid >> 2, wc = wid & 3, fr = lane & 15, fq = lane >> 4;
    const int K = g.K, nt = K / BK;
    int ts_lo = 0, ts_hi = 0, nts = 0; const unsigned long long rt_entry = STAMP ? (unsigned long long)wall_clock64() : 0ull;
#define PG8_STAMP() do { if (STAMP && wid == 0 && nts < 64) { const unsigned long long _c = (unsigned long long)clock64(); \
        ts_lo = (lane == nts) ? (int)(unsigned)_c : ts_lo; ts_hi = (lane == nts) ? (int)(unsigned)(_c >> 32) : ts_hi; ++nts; } } while (0)
    PG8_STAMP();
    unsigned voffA[2], voffB[2];
#pragma unroll
    for (int i = 0; i < 2; ++i) { int R, C; stage_rc(tid * 16 + i * 8192, R, C); const int Rb = Epi::PERM ? ((R & ~31) + perm32(R & 31)) : R;
        voffA[i] = (unsigned)(R * K + C) * 2u; voffB[i] = (unsigned)(Rb * K + C) * 2u; }
    const size_t kstep = (size_t)(BK * 2);
    const size_t hstep = (size_t)HALF * K * 2;
    const size_t tstep = 2 * hstep;
    const unsigned ldsw = (unsigned)wid * 1024u;
    const int aoff = lds_byte(wr * 64 + fr, fq * 8), boff = lds_byte(wc * 32 + fr, fq * 8);
#define PG8_SA(b, h) (((b) * 2 + (h)) * HTB)
#define PG8_SB(b, h) ((4 + (b) * 2 + (h)) * HTB)
#define PG8_STAGE(bufoff, gbase, voff) do { _Pragma("unroll") for (int _i = 0; _i < 2; ++_i) \
        __builtin_amdgcn_global_load_lds((const unsigned*)((const char*)(gbase) + (voff)[_i]), (PG8_LAS unsigned*)(lds + (bufoff) + ldsw + _i * 8192), 16, 0, 0); } while (0)
#define PG8_LDA(dst, b, h) do { _Pragma("unroll") for (int m = 0; m < 4; ++m) _Pragma("unroll") for (int k = 0; k < 2; ++k) dst[m][k] = *(const PG8_LAS bf16x8*)(lds + PG8_SA(b, h) + aoff + m * 2048 + k * 1024); } while (0)
#define PG8_LDB(dst, b, h) do { _Pragma("unroll") for (int n = 0; n < 2; ++n) _Pragma("unroll") for (int k = 0; k < 2; ++k) dst[n][k] = *(const PG8_LAS bf16x8*)(lds + PG8_SB(b, h) + boff + n * 2048 + k * 1024); } while (0)
#define PG8_MMA(ai, bj, At, Bt) do { __builtin_amdgcn_s_setprio(1); _Pragma("unroll") for (int m = 0; m < 4; ++m) _Pragma("unroll") for (int n = 0; n < 2; ++n) _Pragma("unroll") for (int k = 0; k < 2; ++k) \
        acc[ai][bj][m][n] = __builtin_amdgcn_mfma_f32_16x16x32_bf16(Bt[n][k], At[m][k], acc[ai][bj][m][n], 0, 0, 0); __builtin_amdgcn_s_setprio(0); } while (0)
#define PG8_WAIT_V(n) asm volatile("s_waitcnt vmcnt(" #n ")" ::: "memory")
#define PG8_WAIT_L(n) asm volatile("s_waitcnt lgkmcnt(" #n ")" ::: "memory")
#define PG8_BAR __builtin_amdgcn_s_barrier()
#define PG8_SCHED __builtin_amdgcn_sched_barrier(0)
    Unit cur, nxt; int ui = 0;
    if (!S.next(0, cur)) return;
    f32x4 acc[2][2][4][2];
#pragma unroll
    for (int a = 0; a < 2; ++a)
#pragma unroll
        for (int b = 0; b < 2; ++b)
#pragma unroll
            for (int m = 0; m < 4; ++m)
#pragma unroll
                for (int n = 0; n < 2; ++n) acc[a][b][m][n] = (f32x4){0.f, 0.f, 0.f, 0.f};
    bf16x8 At[4][2], B0[2][2], B1[2][2];
    const char* cA = (const char*)g.A + (size_t)cur.pm * tstep; const char* cB = (const char*)g.Bt + (size_t)cur.pn * tstep;
    S.a_ready(cur);
    PG8_STAGE(PG8_SB(0, 0), cB, voffB); PG8_STAGE(PG8_SA(0, 0), cA, voffA); PG8_STAGE(PG8_SB(0, 1), cB + hstep, voffB); PG8_STAGE(PG8_SA(0, 1), cA + hstep, voffA);
    if (wr == 1) PG8_BAR;
    PG8_WAIT_V(4); PG8_BAR;
    PG8_STAGE(PG8_SB(1, 0), cB + kstep, voffB); PG8_STAGE(PG8_SA(1, 0), cA + kstep, voffA); PG8_STAGE(PG8_SB(1, 1), cB + hstep + kstep, voffB);
    PG8_WAIT_V(6); PG8_BAR;
    PG8_STAMP();
    for (;;) {
        const bool has_next = S.next(ui + 1, nxt);
        const char* nA = has_next ? (const char*)g.A + (size_t)nxt.pm * tstep : cA; const char* nB = has_next ? (const char*)g.Bt + (size_t)nxt.pn * tstep : cB;
        for (int t = 0; t < nt; t += 2) {
            const bool last = (t == nt - 2);
            const char* a1 = cA + (size_t)(t + 1) * kstep;
            const char* a2 = last ? nA : cA + (size_t)(t + 2) * kstep; const char* b2 = last ? nB : cB + (size_t)(t + 2) * kstep;
            const char* a3 = a2 + kstep; const char* b3 = b2 + kstep;
            if (last && has_next) S.a_ready(nxt);
            PG8_LDB(B0, 0, 0); PG8_SCHED; PG8_LDA(At, 0, 0); PG8_STAGE(PG8_SA(1, 1), a1 + hstep, voffA);
            PG8_WAIT_L(8); PG8_BAR; PG8_WAIT_L(0); PG8_MMA(0, 0, At, B0); PG8_BAR; PG8_SCHED;
            PG8_LDB(B1, 0, 1); PG8_STAGE(PG8_SB(0, 0), b2, voffB);
            PG8_BAR; PG8_WAIT_L(0); PG8_MMA(0, 1, At, B1); PG8_BAR;
            PG8_LDA(At, 0, 1); PG8_STAGE(PG8_SA(0, 0), a2, voffA);
            PG8_BAR; PG8_WAIT_L(0); PG8_MMA(1, 0, At, B0); PG8_BAR; PG8_SCHED;
            PG8_STAGE(PG8_SB(0, 1), b2 + hstep, voffB);
            PG8_WAIT_V(6); PG8_BAR; PG8_MMA(1, 1, At, B1); PG8_BAR;
            PG8_LDB(B0, 1, 0); PG8_SCHED; PG8_LDA(At, 1, 0); PG8_STAGE(PG8_SA(0, 1), a2 + hstep, voffA);
            PG8_WAIT_L(8); PG8_BAR; PG8_WAIT_L(0); PG8_MMA(0, 0, At, B0); PG8_BAR; PG8_SCHED;
            PG8_LDB(B1, 1, 1); PG8_STAGE(PG8_SB(1, 0), b3, voffB);
            PG8_BAR; PG8_WAIT_L(0); PG8_MMA(0, 1, At, B1); PG8_BAR;
            PG8_LDA(At, 1, 1); PG8_STAGE(PG8_SA(1, 0), a3, voffA);
            PG8_BAR; PG8_WAIT_L(0); PG8_MMA(1, 0, At, B0); PG8_BAR; PG8_SCHED;
            PG8_STAGE(PG8_SB(1, 1), b3 + hstep, voffB);
            PG8_WAIT_V(6); PG8_BAR; PG8_MMA(1, 1, At, B1); PG8_BAR;
        }
        PG8_STAMP();
        if constexpr (!Epi::AFTER_DRAIN) { E(acc, cur, wr, wc, fr, fq); S.done(cur); }
        PG8_STAMP();
        if (!has_next) break;
#pragma unroll
        for (int a = 0; a < 2; ++a)
#pragma unroll
            for (int b = 0; b < 2; ++b)
#pragma unroll
                for (int m = 0; m < 4; ++m)
#pragma unroll
                    for (int n = 0; n < 2; ++n) acc[a][b][m][n] = (f32x4){0.f, 0.f, 0.f, 0.f};
        cur = nxt; cA = nA; cB = nB; ++ui;
    }
    PG8_WAIT_V(0);
    if (wr == 0) PG8_BAR;
    PG8_BAR;
    if constexpr (Epi::AFTER_DRAIN) { E.fused(acc, cur, wr, wc, fr, fq, lds, wid, lane); S.done(cur); }
    PG8_STAMP();
    if (STAMP && wid == 0) { stamps[lane] = lane < nts ? (((unsigned long long)(unsigned)ts_hi << 32) | (unsigned)ts_lo) : 0ull;
        if (lane == 62) stamps[62] = rt_entry; if (lane == 63) stamps[63] = (unsigned long long)wall_clock64(); }
#undef PG8_STAMP
#undef PG8_SA
#undef PG8_SB
#undef PG8_STAGE
#undef PG8_LDA
#undef PG8_LDB
#undef PG8_MMA
#undef PG8_WAIT_V
#undef PG8_WAIT_L
#undef PG8_BAR
#undef PG8_SCHED
}
}

typedef unsigned short bf16_t;
typedef short bf16x8 __attribute__((ext_vector_type(8)));
typedef float f32x4 __attribute__((ext_vector_type(4)));
typedef float f32x16 __attribute__((ext_vector_type(16)));
#define LAS __attribute__((address_space(3)))
#define WAVE_SYNC() do { asm volatile("s_waitcnt lgkmcnt(0)" ::: "memory"); __builtin_amdgcn_wave_barrier(); } while (0)

constexpr int DM = 1024, NP = 16384, NSMP = 256, MR = 16640, SEQ = 4096, NB = 4, DB = 32, DS = 8, PAST = 16384;
constexpr int CIN = 6040, NPAD = 6144, CR = 1664;
constexpr int NTHR = 512;
constexpr size_t O_Y_P = 0, O_Y_S = 16777216, O_CMP_P = 17039360, O_CMP_S = 21233664, O_SEL_P = 21299200, O_SEL_S = 25493504,
                 O_WIN_P = 25559040, O_WIN_S = 26083328, O_WKV_P = 30277632, O_WKV_S = 30408704, O_SH_P = 31457280, O_SH_S = 31463936;

constexpr size_t ws_al(size_t x) { return (x + 255) & ~(size_t)255; }
constexpr size_t WS_bar = 0;
constexpr size_t WS_hb = WS_bar + ws_al(32768);
constexpr size_t WS_WinT = WS_hb + ws_al((size_t)MR * DM * 2);
constexpr size_t WS_WpaT = WS_WinT + ws_al((size_t)NPAD * DM * 2);
constexpr size_t WS_WpbT = WS_WpaT + ws_al((size_t)DM * 512 * 2);
constexpr size_t WS_WoutT = WS_WpbT + ws_al((size_t)DM * 512 * 2);
constexpr size_t WS_WgateT = WS_WoutT + ws_al((size_t)DM * DM * 2);
constexpr size_t WS_WprojT = WS_WgateT + ws_al((size_t)DM * DM * 2);
constexpr size_t WS_W1T = WS_WprojT + ws_al((size_t)DM * 256 * 2);
constexpr size_t WS_W2T = WS_W1T + ws_al((size_t)512 * 1024 * 2);
constexpr size_t WS_WupT = WS_W2T + ws_al((size_t)128 * 128 * 2);
constexpr size_t WS_AupT = WS_WupT + ws_al((size_t)512 * 64 * 2);
constexpr size_t WS_pb = WS_AupT + ws_al((size_t)512 * 64 * 2);
constexpr size_t WS_tabc = WS_pb + ws_al((size_t)MR * 256 * 2);
constexpr size_t WS_tabs = WS_tabc + ws_al((size_t)4104 * 32 * 4);
constexpr size_t WS_pt = WS_tabs + ws_al((size_t)4104 * 32 * 4);
constexpr size_t WS_qb = WS_pt + ws_al(256 * 4);
constexpr size_t WS_kb = WS_qb + ws_al((size_t)MR * 512 * 2);
constexpr size_t WS_vcr = WS_kb + ws_al((size_t)3 * NB * 2 * SEQ * 64 * 2);
constexpr size_t WS_vT = WS_vcr + ws_al((size_t)NB * 2 * SEQ * 64 * 2);
constexpr size_t WS_ag = WS_vT + ws_al((size_t)2 * NB * 2 * 64 * SEQ * 2);
constexpr size_t WS_rg = WS_ag + ws_al((size_t)MR * 512 * 2);
constexpr size_t WS_mg = WS_rg + ws_al((size_t)MR * 512 * 2);
constexpr size_t WS_gates = WS_mg + ws_al((size_t)MR * 2048 * 2);
constexpr size_t WS_rz = WS_gates + ws_al((size_t)MR * 32 * 4);
constexpr size_t WS_zs0 = WS_rz + ws_al((size_t)MR * CR * 2);
constexpr size_t WS_LHp = WS_zs0 + ws_al((size_t)33 * CR * 2);
constexpr size_t WS_LHs = WS_LHp + ws_al((size_t)2 * 2048 * 256 * 4);
constexpr size_t WS_cs = WS_LHs + ws_al((size_t)2 * 65536 * 256 * 4);
constexpr size_t WS_kc_p = WS_cs + ws_al((size_t)2 * 65536 * 1024 * 2);
constexpr size_t WS_vcT_p = WS_kc_p + ws_al((size_t)8 * 256 * 64 * 2);
constexpr size_t WS_kc_s = WS_vcT_p + ws_al((size_t)8 * 64 * 256 * 2);
constexpr size_t WS_vcT_s = WS_kc_s + ws_al((size_t)64 * 1024 * 64 * 2);
constexpr size_t WS_rw6 = WS_vcT_s + ws_al((size_t)64 * 64 * 1024 * 2);
constexpr int RW6_STRIDE = 896;
constexpr size_t WS_bonus = WS_rw6 + ws_al((size_t)MR * 8 * RW6_STRIDE);
constexpr size_t WS_ybuf = WS_bonus + ws_al((size_t)MR * 8 * 4);
constexpr size_t WS_oa = WS_ybuf + ws_al((size_t)MR * 512 * 4);
constexpr size_t WS_ob = WS_oa + ws_al((size_t)MR * 512 * 2);
constexpr size_t WS_mb = WS_ob + ws_al((size_t)MR * 512 * 2);
constexpr size_t WS_xg = WS_mb + ws_al((size_t)MR * DM * 2);
constexpr size_t WS_tmp = WS_xg + ws_al((size_t)MR * DM * 2);
constexpr size_t WS_x1 = WS_tmp + ws_al((size_t)MR * DM * 4);
constexpr size_t WS_ss1 = WS_x1 + ws_al((size_t)MR * DM * 4);
constexpr size_t WS_pp = WS_ss1 + ws_al((size_t)MR * 16 * 4);
constexpr size_t WS_TOTAL = WS_pp + ws_al((size_t)MR * DM * 4);

struct P {
    const float *x_prompt, *x_sample, *p_prompt, *p_sample, *cache_cmp, *cache_sel, *cache_win, *state_wkv, *state_shift;
    const int* page_table;
    const float *norm_g, *w_in, *cmp_pe, *cmp_w1, *cmp_b1, *cmp_w2, *cmp_b2, *w_pa, *mu, *w0, *w_up, *a0, *a_up, *k_k, *k_a, *r_k, *gn_g, *gn_b,
        *w_pb, *w_out, *ple_g, *w_gate, *w_proj, *final_g;
    float* out;
    unsigned char* ws;
    __host__ __device__ __forceinline__ unsigned* bar() const { return (unsigned*)(ws + WS_bar); }
    __host__ __device__ __forceinline__ float* ss_s() const { return (float*)(ws + WS_bar + 16384); }
    __host__ __device__ __forceinline__ bf16_t* hb() const { return (bf16_t*)(ws + WS_hb); }
    __host__ __device__ __forceinline__ bf16_t* WinT() const { return (bf16_t*)(ws + WS_WinT); }
    __host__ __device__ __forceinline__ bf16_t* WpaT() const { return (bf16_t*)(ws + WS_WpaT); }
    __host__ __device__ __forceinline__ bf16_t* WpbT() const { return (bf16_t*)(ws + WS_WpbT); }
    __host__ __device__ __forceinline__ bf16_t* WoutT() const { return (bf16_t*)(ws + WS_WoutT); }
    __host__ __device__ __forceinline__ bf16_t* WgateT() const { return (bf16_t*)(ws + WS_WgateT); }
    __host__ __device__ __forceinline__ bf16_t* WprojT() const { return (bf16_t*)(ws + WS_WprojT); }
    __host__ __device__ __forceinline__ bf16_t* W1T() const { return (bf16_t*)(ws + WS_W1T); }
    __host__ __device__ __forceinline__ bf16_t* W2T() const { return (bf16_t*)(ws + WS_W2T); }
    __host__ __device__ __forceinline__ bf16_t* WupT() const { return (bf16_t*)(ws + WS_WupT); }
    __host__ __device__ __forceinline__ bf16_t* AupT() const { return (bf16_t*)(ws + WS_AupT); }
    __host__ __device__ __forceinline__ bf16_t* pb() const { return (bf16_t*)(ws + WS_pb); }
    __host__ __device__ __forceinline__ float* tabc() const { return (float*)(ws + WS_tabc); }
    __host__ __device__ __forceinline__ float* tabs() const { return (float*)(ws + WS_tabs); }
    __host__ __device__ __forceinline__ float* pt() const { return (float*)(ws + WS_pt); }
    __host__ __device__ __forceinline__ bf16_t* qb() const { return (bf16_t*)(ws + WS_qb); }
    __host__ __device__ __forceinline__ bf16_t* kb() const { return (bf16_t*)(ws + WS_kb); }
    __host__ __device__ __forceinline__ bf16_t* vcr() const { return (bf16_t*)(ws + WS_vcr); }
    __host__ __device__ __forceinline__ bf16_t* vT() const { return (bf16_t*)(ws + WS_vT); }
    __host__ __device__ __forceinline__ bf16_t* ag() const { return (bf16_t*)(ws + WS_ag); }
    __host__ __device__ __forceinline__ bf16_t* rg() const { return (bf16_t*)(ws + WS_rg); }
    __host__ __device__ __forceinline__ bf16_t* mg() const { return (bf16_t*)(ws + WS_mg); }
    __host__ __device__ __forceinline__ float* gates() const { return (float*)(ws + WS_gates); }
    __host__ __device__ __forceinline__ bf16_t* rz() const { return (bf16_t*)(ws + WS_rz); }
    __host__ __device__ __forceinline__ bf16_t* zs0() const { return (bf16_t*)(ws + WS_zs0); }
    __host__ __device__ __forceinline__ bf16_t* LHp() const { return (bf16_t*)(ws + WS_LHp); }
    __host__ __device__ __forceinline__ bf16_t* LHs() const { return (bf16_t*)(ws + WS_LHs); }
    __host__ __device__ __forceinline__ bf16_t* cs() const { return (bf16_t*)(ws + WS_cs); }
    __host__ __device__ __forceinline__ bf16_t* kc_p() const { return (bf16_t*)(ws + WS_kc_p); }
    __host__ __device__ __forceinline__ bf16_t* vcT_p() const { return (bf16_t*)(ws + WS_vcT_p); }
    __host__ __device__ __forceinline__ bf16_t* kc_s() const { return (bf16_t*)(ws + WS_kc_s); }
    __host__ __device__ __forceinline__ bf16_t* vcT_s() const { return (bf16_t*)(ws + WS_vcT_s); }
    __host__ __device__ __forceinline__ unsigned char* rw6() const { return ws + WS_rw6; }
    __host__ __device__ __forceinline__ float* bonus() const { return (float*)(ws + WS_bonus); }
    __host__ __device__ __forceinline__ float* ybuf() const { return (float*)(ws + WS_ybuf); }
    __host__ __device__ __forceinline__ bf16_t* oa() const { return (bf16_t*)(ws + WS_oa); }
    __host__ __device__ __forceinline__ bf16_t* ob() const { return (bf16_t*)(ws + WS_ob); }
    __host__ __device__ __forceinline__ bf16_t* mb() const { return (bf16_t*)(ws + WS_mb); }
    __host__ __device__ __forceinline__ bf16_t* xg() const { return (bf16_t*)(ws + WS_xg); }
    __host__ __device__ __forceinline__ float* tmp() const { return (float*)(ws + WS_tmp); }
    __host__ __device__ __forceinline__ float* x1() const { return (float*)(ws + WS_x1); }
    __host__ __device__ __forceinline__ float* ss1() const { return (float*)(ws + WS_ss1); }
    __host__ __device__ __forceinline__ float* pp() const { return (float*)(ws + WS_pp); }
};


__device__ __forceinline__ float bf2f(bf16_t b) { return __uint_as_float(((unsigned)b) << 16); }
typedef __bf16 bf16v2_t __attribute__((ext_vector_type(2)));
typedef float f32x2_t __attribute__((ext_vector_type(2)));
__device__ __forceinline__ unsigned pk2(float lo, float hi) { const f32x2_t v = {lo, hi}; return __builtin_bit_cast(unsigned, __builtin_convertvector(v, bf16v2_t)); }
__device__ __forceinline__ bf16_t f2bf(float f) { return (bf16_t)(pk2(f, f) & 0xffffu); }
__device__ __forceinline__ float xsum16(float v) { const auto r = __builtin_amdgcn_permlane16_swap(__float_as_uint(v), __float_as_uint(v), false, false); return __uint_as_float(r[0]) + __uint_as_float(r[1]); }
__device__ __forceinline__ float xsum32(float v) { const auto r = __builtin_amdgcn_permlane32_swap(__float_as_uint(v), __float_as_uint(v), false, false); return __uint_as_float(r[0]) + __uint_as_float(r[1]); }
__device__ __forceinline__ float xmax32(float v) { const auto r = __builtin_amdgcn_permlane32_swap(__float_as_uint(v), __float_as_uint(v), false, false); return fmaxf(__uint_as_float(r[0]), __uint_as_float(r[1])); }
__device__ __forceinline__ float quad_sum(float v) {
    v += __builtin_bit_cast(float, __builtin_amdgcn_mov_dpp(__builtin_bit_cast(int, v), 0xB1, 0xF, 0xF, true));
    v += __builtin_bit_cast(float, __builtin_amdgcn_mov_dpp(__builtin_bit_cast(int, v), 0x4E, 0xF, 0xF, true));
    return v;
}
__device__ __forceinline__ float wave_sum(float v) {
    v += __builtin_bit_cast(float, __builtin_amdgcn_mov_dpp(__builtin_bit_cast(int, v), 0xB1, 0xF, 0xF, true));
    v += __builtin_bit_cast(float, __builtin_amdgcn_mov_dpp(__builtin_bit_cast(int, v), 0x4E, 0xF, 0xF, true));
    v += __builtin_bit_cast(float, __builtin_amdgcn_mov_dpp(__builtin_bit_cast(int, v), 0x141, 0xF, 0xF, true));
    v += __builtin_bit_cast(float, __builtin_amdgcn_mov_dpp(__builtin_bit_cast(int, v), 0x140, 0xF, 0xF, true));
    return xsum32(xsum16(v));
}
__device__ __forceinline__ float sigmoidf_(float x) { return 1.0f / (1.0f + __expf(-x)); }
__device__ __forceinline__ float siluf_(float x) { return x / (1.0f + __expf(-x)); }
__device__ __forceinline__ float sigmoid_fast(float x) { return __builtin_amdgcn_rcpf(1.0f + __expf(-x)); }
__device__ __forceinline__ float silu_fast(float x) { return x * __builtin_amdgcn_rcpf(1.0f + __expf(-x)); }

__device__ __forceinline__ int win_src_col(int np) {
    const int pn = np >> 8, p = np & 255;
    if (pn < 5) {
        const int bj = p >> 7, wc = (p >> 5) & 3, n = (p >> 4) & 1, fq = (p >> 2) & 3, e = p & 3;
        const int d = 32 * n + 16 * (wc & 1) + 4 * fq + e;
        if (pn < 2) { const int head = pn * 4 + bj * 2 + (wc >> 1); return head * 64 + d; }
        const int br = pn - 2, g = wc >> 1;
        return 512 + br * 256 + bj * 128 + g * 64 + d;
    }
    const int s = (p & 0xe0) + 8 * ((p >> 2) & 3) + 4 * ((p >> 4) & 1) + (p & 3);
    if (pn < 7) return 1304 + (pn - 5) * 256 + s;
    if (pn < 13) return 1816 + (pn - 7) * 256 + s;
    if (pn == 13) { if (s < 128) return 1816 + 1536 + s; if (s < 152) return 1280 + (s - 128); return -1; }
    if (pn < 16) return 3480 + (pn - 14) * 256 + s;
    return 3992 + (pn - 16) * 256 + s;
}

__device__ __forceinline__ int perm8(int np) { return (np & ~31) + 8 * ((np >> 2) & 3) + 4 * ((np >> 4) & 1) + (np & 3); }
template <class F>
__device__ __forceinline__ void transpose_cvt(bf16_t* dst, int Nd, int K, F f) {
    const int total = Nd * (K >> 3);
    for (int id = blockIdx.x * NTHR + threadIdx.x; id < total; id += gridDim.x * NTHR) {
        const int n = id % Nd, kc = id / Nd;
        float v[8];
#pragma unroll
        for (int j = 0; j < 8; ++j) v[j] = f(n, kc * 8 + j);
        uint4 w; w.x = pk2(v[0], v[1]); w.y = pk2(v[2], v[3]); w.z = pk2(v[4], v[5]); w.w = pk2(v[6], v[7]);
        *(uint4*)(dst + (size_t)n * K + kc * 8) = w;
    }
}

__device__ __forceinline__ void sincos_small(double r, float& s, float& c) {
    const double r2 = r * r;
    double sa = 1.0, ca = 1.0;
    double ts = 1.0, tc = 1.0; sa = 0.0; ca = 0.0;
#pragma unroll
    for (int k = 0; k < 16; ++k) {
        sa += ts; ca += tc;
        ts = -ts * r2 / (double)((2 * k + 2) * (2 * k + 3));
        tc = -tc * r2 / (double)((2 * k + 1) * (2 * k + 2));
    }
    s = (float)(sa * r); c = (float)ca;
}

__device__ __forceinline__ void ph_prep(const P& p) {
    const int tid = threadIdx.x, lane = tid & 63, wid = tid >> 6;
    const int gw = blockIdx.x * 8 + wid, nw = gridDim.x * 8;
    const int gt = blockIdx.x * NTHR + tid, nt = gridDim.x * NTHR;
    for (int row0 = gw; row0 < MR; row0 += 2 * nw) {
        float4 v[2][4]; float ss[2];
#pragma unroll
        for (int u = 0; u < 2; ++u) {
            const int row = row0 + u * nw < MR ? row0 + u * nw : row0;
            const float4* src = (const float4*)(row < NP ? p.x_prompt + (size_t)row * DM : p.x_sample + (size_t)(row - NP) * DM);
            ss[u] = 0.f;
#pragma unroll
            for (int i = 0; i < 4; ++i) { v[u][i] = src[lane + 64 * i]; ss[u] += v[u][i].x * v[u][i].x + v[u][i].y * v[u][i].y + v[u][i].z * v[u][i].z + v[u][i].w * v[u][i].w; }
        }
#pragma unroll
        for (int u = 0; u < 2; ++u) {
            const int row = row0 + u * nw;
            const float tot = wave_sum(ss[u]);
            const float rstd = rsqrtf(tot * (1.0f / DM) + 1e-6f);
            if (row < MR) {
#pragma unroll
                for (int i = 0; i < 4; ++i) {
                    const float4 g = ((const float4*)p.norm_g)[lane + 64 * i];
                    uint2 w; w.x = pk2(v[u][i].x * rstd * g.x, v[u][i].y * rstd * g.y); w.y = pk2(v[u][i].z * rstd * g.z, v[u][i].w * rstd * g.w);
                    *(uint2*)(p.hb() + (size_t)row * DM + 4 * (lane + 64 * i)) = w;
                }
            }
        }
    }
    { const float* w = p.w_in; transpose_cvt(p.WinT(), NPAD, DM, [=](int n, int k) { const int c = win_src_col(n); return c < 0 ? 0.f : w[(size_t)k * CIN + c]; }); }
    { const float* w = p.w_pa; transpose_cvt(p.WpaT(), DM, 512, [=](int n, int k) { return w[(size_t)k * DM + perm8(n)]; }); }
    { const float* w = p.w_pb; transpose_cvt(p.WpbT(), DM, 512, [=](int n, int k) { return w[(size_t)k * DM + perm8(n)]; }); }
    { const float* w = p.w_out; transpose_cvt(p.WoutT(), DM, DM, [=](int n, int k) { return w[(size_t)k * DM + perm8(n)]; }); }
    { const float* w = p.w_gate; transpose_cvt(p.WgateT(), DM, DM, [=](int n, int k) { return w[(size_t)k * DM + perm8(n)]; }); }
    { const float* w = p.w_proj; transpose_cvt(p.WprojT(), DM, 256, [=](int n, int k) { return w[(size_t)k * DM + perm8(n)]; }); }
    { const float* w = p.cmp_w1; transpose_cvt(p.W1T(), 512, 1024, [=](int n, int k) { const int kvi = n >> 8, nn = n & 255; return w[(size_t)kvi * 262144 + (size_t)((nn >> 7) * 1024 + k) * 128 + (nn & 127)]; }); }
    { const float* w = p.cmp_w2; transpose_cvt(p.W2T(), 128, 128, [=](int n, int k) { return w[(size_t)(n >> 6) * 8192 + (size_t)k * 64 + (n & 63)]; }); }
    { const float* w = p.w_up; transpose_cvt(p.WupT(), 512, 64, [=](int n, int k) { return w[(size_t)k * 512 + n]; }); }
    { const float* w = p.a_up; transpose_cvt(p.AupT(), 512, 64, [=](int n, int k) { return w[(size_t)k * 512 + n]; }); }
    for (int id = gt; id < 33 * CR; id += nt) p.zs0()[id] = id < CR ? (bf16_t)0 : f2bf(p.state_shift[id - CR]);
    for (int id = gt; id < MR * 64; id += nt) {
        const int row = id >> 6, c4 = id & 63;
        const float4 v = ((const float4*)(row < NP ? p.p_prompt + (size_t)row * 256 : p.p_sample + (size_t)(row - NP) * 256))[c4];
        uint2 w; w.x = pk2(v.x, v.y); w.y = pk2(v.z, v.w);
        *(uint2*)(p.pb() + (size_t)row * 256 + c4 * 4) = w;
    }
    for (int id = gt; id < 4104 * 32; id += nt) {
        const int pi = id >> 5, i = id & 31;
        const int pos = pi < 4096 ? pi : PAST + pi - 4096;
        const float inv = (float)exp(-(double)i * (9.210340371976184 / 32.0));
        const float ang = (float)pos * inv;
        const double x = (double)ang;
        const double k = rint(x * 0.15915494309189535);
        const double r = x - k * 6.283185307179586;
        float s, c; sincos_small(r, s, c);
        p.tabc()[id] = c; p.tabs()[id] = s;
    }
    for (int o = gw; o < 256; o += nw) {
        const int kvi = o >> 7, f = o & 127;
        float acc = 0.f;
        for (int jd = lane; jd < 2048; jd += 64) acc += p.cmp_pe[kvi * 2048 + jd] * p.cmp_w1[(size_t)kvi * 262144 + (size_t)jd * 128 + f];
        acc = wave_sum(acc);
        if (lane == 0) p.pt()[o] = acc + p.cmp_b1[o];
    }
    for (int id = gt; id < DB * 504 * 64; id += nt) {
        const int c4 = id & 63, j = (id >> 6) % 504, b = (id >> 6) / 504;
        ((float4*)(p.out + O_WIN_S))[((size_t)b * 512 + j) * 64 + c4] = ((const float4*)p.cache_win)[((size_t)b * 512 + j + 8) * 64 + c4];
    }
}
#define XB_TMO      128
#define XB_XCNT(j)  (256  + 64 * (j))
#define XB_XSUB(j)  (1280 + 64 * (j))
#define XB_XGEN(j)  (2304 + 64 * (j))
#define XB_TOP      3328
#define XB_TOPGEN   3392
#define XCD_BAR_WORDS 3456
#define XB_SPIN_CAP (1u << 18)

__device__ __forceinline__ unsigned xb_ld(unsigned* p)              { return __hip_atomic_load(p, __ATOMIC_RELAXED, __HIP_MEMORY_SCOPE_AGENT); }
__device__ __forceinline__ unsigned xb_add(unsigned* p, unsigned v) { return __hip_atomic_fetch_add(p, v, __ATOMIC_RELAXED, __HIP_MEMORY_SCOPE_AGENT); }
__device__ __forceinline__ unsigned xb_xcc_id() { return (unsigned)__builtin_amdgcn_s_getreg((3 << 11) | 20) & 0xFu; }
#define XB_SPIN(cond, bar) do { unsigned _sp = 0; while (cond) { __builtin_amdgcn_s_sleep(1); \
    if ((++_sp & 255u) == 0u) { if (xb_ld(&(bar)[XB_TMO])) break; if (_sp > XB_SPIN_CAP) { atomicAdd(&(bar)[XB_TMO], 1u); break; } } } } while (0)

struct XcdBarrier {
    unsigned* bar; unsigned x;
    volatile LAS unsigned* st;
};

__device__ __forceinline__ XcdBarrier xcd_barrier_post(unsigned* bar, volatile LAS unsigned* st) {
    XcdBarrier b; b.bar = bar; b.x = xb_xcc_id(); b.st = st;
    if (threadIdx.x == 0) (void)xb_add(&bar[XB_XCNT(b.x)], 1u);
    return b;
}
__device__ __forceinline__ void xcd_barrier_complete(unsigned* bar, unsigned x, unsigned& nloc, unsigned& nx) {
    const unsigned G = gridDim.x * gridDim.y * gridDim.z;
    unsigned sum, cnt, mine, sp = 0u;
    for (;;) {
        sum = 0u; cnt = 0u; mine = 0u;
#pragma unroll
        for (unsigned j = 0; j < 16; ++j) { const unsigned c = xb_ld(&bar[XB_XCNT(j)]); sum += c; cnt += (c > 0u) ? 1u : 0u; mine = (j == x) ? c : mine; }
        if (sum == G) break;
        __builtin_amdgcn_s_sleep(1);
        if ((++sp & 255u) == 0u) { if (xb_ld(&bar[XB_TMO])) break; if (sp > XB_SPIN_CAP) { atomicAdd(&bar[XB_TMO], 1u); break; } }
    }
    nloc = mine > 0u ? mine : 1u; nx = cnt > 0u ? cnt : 1u;
}

__device__ __forceinline__ void xcd_barrier(const XcdBarrier& b) {
    asm volatile("s_waitcnt vmcnt(0)" ::: "memory");
    __syncthreads();
    if (threadIdx.x == 0) {
        unsigned* bar = b.bar;
        __builtin_amdgcn_s_waitcnt(0);
        unsigned nloc = b.st[0], nx = b.st[1];
        if (nloc == 0u) { xcd_barrier_complete(bar, b.x, nloc, nx); b.st[0] = nloc; b.st[1] = nx; }
        const unsigned old = xb_add(&bar[XB_XSUB(b.x)], 1u);
        const unsigned gen = old / nloc;
        if (old + 1u == (gen + 1u) * nloc) {
            __builtin_amdgcn_fence(__ATOMIC_RELEASE, "agent");
            asm volatile("s_waitcnt vmcnt(0)" ::: "memory");
            const unsigned og = xb_add(&bar[XB_TOP], 1u);
            const unsigned tg = og / nx;
            if (og + 1u == (tg + 1u) * nx) xb_add(&bar[XB_TOPGEN], 1u);
            else XB_SPIN(xb_ld(&bar[XB_TOPGEN]) == tg, bar);
            __builtin_amdgcn_fence(__ATOMIC_ACQUIRE, "agent");
            xb_add(&bar[XB_XGEN(b.x)], 1u);
            asm volatile("s_waitcnt vmcnt(0)" ::: "memory");
        } else {
            XB_SPIN(xb_ld(&bar[XB_XGEN(b.x)]) == gen, bar);
            __builtin_amdgcn_fence(__ATOMIC_ACQUIRE, "agent");
            asm volatile("s_waitcnt vmcnt(0)" ::: "memory");
        }
    }
    __syncthreads();
}

using pg8::Unit;
typedef unsigned u32x2 __attribute__((ext_vector_type(2)));
typedef unsigned u32x4_t __attribute__((ext_vector_type(4)));
__device__ __forceinline__ f32x16 mfma32(bf16x8 a, bf16x8 b, f32x16 c) { return __builtin_amdgcn_mfma_f32_32x32x16_bf16(a, b, c, 0, 0, 0); }
__device__ __forceinline__ bf16x8 pack8(float a0, float a1, float a2, float a3, float a4, float a5, float a6, float a7) {
    union { uint4 u; bf16x8 v; } x; x.u.x = pk2(a0, a1); x.u.y = pk2(a2, a3); x.u.z = pk2(a4, a5); x.u.w = pk2(a6, a7); return x.v;
}
__device__ __forceinline__ f32x16 zero16() { f32x16 z; for (int i = 0; i < 16; ++i) z[i] = 0.f; return z; }


__device__ __forceinline__ void st_bf4(bf16_t* dst, f32x4 v) { uint2 w; w.x = pk2(v[0], v[1]); w.y = pk2(v[2], v[3]); *(uint2*)dst = w; }

constexpr float QSCALE = 0.125f * 1.4426950408889634f;
struct EpiIn {
    static constexpr bool PERM = false, AFTER_DRAIN = false;
    P p; int row0; int pn0;
    __device__ __forceinline__ void operator()(const f32x4 (&acc)[2][2][4][2], const Unit& u, int wr, int wc, int fr, int fq) const { body<0, 2, 0, 2>(acc, u, wr, wc, fr, fq); }
    template <int AI0, int AI1, int BJ0, int BJ1>
    __device__ __forceinline__ void body(const f32x4 (&acc)[2][2][4][2], const Unit& u, int wr, int wc, int fr, int fq) const {
        const int pn = pn0 + u.pn;
#pragma unroll
        for (int ai = AI0; ai < AI1; ++ai)
#pragma unroll
            for (int m = 0; m < 4; ++m) {
                const int row = row0 + u.pm * 256 + ai * 128 + wr * 64 + m * 16 + fr;
                if (pn < 5) {
                    const int pi = row < NP ? (row & (SEQ - 1)) : 4096 + ((row - NP) & 7);
                    const int d0 = 16 * (wc & 1) + 4 * fq;
                    const f32x4 cs = *(const f32x4*)(p.tabc() + pi * 32 + d0), sn = *(const f32x4*)(p.tabs() + pi * 32 + d0);
#pragma unroll
                    for (int bj = BJ0; bj < BJ1; ++bj) {
                        const f32x4 x1 = acc[ai][bj][m][0], x2 = acc[ai][bj][m][1];
                        if (pn < 2) {
                            const int head = pn * 4 + bj * 2 + (wc >> 1);
                            const f32x4 o1 = (x1 * cs - x2 * sn) * QSCALE, o2 = (x2 * cs + x1 * sn) * QSCALE;
                            bf16_t* q = p.qb() + (size_t)row * 512 + head * 64 + d0;
                            st_bf4(q, o1); st_bf4(q + 32, o2);
                        } else {
                            const int br = pn - 2, g = wc >> 1;
                            f32x4 o1, o2;
                            if (bj == 0) { o1 = x1 * cs - x2 * sn; o2 = x2 * cs + x1 * sn; } else { o1 = x1; o2 = x2; }
                            float* dst = nullptr;
                            if (row < NP) {
                                if (br == 0) dst = p.out + O_CMP_P + (size_t)row * 256;
                                else if (br == 1) dst = p.out + O_SEL_P + (size_t)row * 256;
                                else { const int s = row & (SEQ - 1); if (s >= SEQ - 512) dst = p.out + O_WIN_P + ((size_t)(row >> 12) * 512 + (s - (SEQ - 512))) * 256; }
                            } else {
                                const int rs = row - NP;
                                if (br == 0) dst = p.out + O_CMP_S + (size_t)rs * 256;
                                else if (br == 1) dst = p.out + O_SEL_S + (size_t)rs * 256;
                                else dst = p.out + O_WIN_S + ((size_t)(rs >> 3) * 512 + 504 + (rs & 7)) * 256;
                            }
                            if (dst) { dst += bj * 128 + g * 64 + d0; *(f32x4*)dst = o1; *(f32x4*)(dst + 32) = o2; }
                            if (row < NP) {
                                const int b = row >> 12, s = row & (SEQ - 1);
                                if (bj == 0) {
                                    bf16_t* k = p.kb() + ((size_t)((br * NB + b) * 2 + g) * SEQ + s) * 64 + d0;
                                    st_bf4(k, o1); st_bf4(k + 32, o2);
                                } else if (br == 0) {
                                    bf16_t* v = p.vcr() + ((size_t)(b * 2 + g) * SEQ + s) * 64 + d0;
                                    st_bf4(v, o1); st_bf4(v + 32, o2);
                                } else {
                                    bf16_t* v = p.vT() + ((size_t)(((br - 1) * NB + b) * 2 + g) * 64 + d0) * SEQ + s;
#pragma unroll
                                    for (int e = 0; e < 4; ++e) { v[(size_t)e * SEQ] = f2bf(o1[e]); v[(size_t)(32 + e) * SEQ] = f2bf(o2[e]); }
                                }
                            }
                        }
                    }
                } else {
#pragma unroll
                    for (int bj = BJ0; bj < BJ1; ++bj) {
                        const int c = bj * 128 + wc * 32 + fq * 8;
                        const f32x4 v0 = acc[ai][bj][m][0], v1 = acc[ai][bj][m][1];
                        auto st8 = [&](bf16_t* dst, const f32x4& a, const f32x4& b) { uint4 w; w.x = pk2(a[0], a[1]); w.y = pk2(a[2], a[3]); w.z = pk2(b[0], b[1]); w.w = pk2(b[2], b[3]); *(uint4*)dst = w; };
                        if (pn < 7 || (pn >= 14 && pn < 16)) {
                            f32x4 o0, o1; for (int e = 0; e < 4; ++e) { o0[e] = silu_fast(v0[e]); o1[e] = silu_fast(v1[e]); }
                            st8((pn < 7 ? p.ag() + (size_t)row * 512 + (pn - 5) * 256 : p.rg() + (size_t)row * 512 + (pn - 14) * 256) + c, o0, o1);
                        } else if (pn < 13) {
                            st8(p.rz() + (size_t)row * CR + (pn - 7) * 256 + c, v0, v1);
                        } else if (pn == 13) {
                            if (c < 128) st8(p.rz() + (size_t)row * CR + 1536 + c, v0, v1);
                            else if (c < 152) { f32x4 o0, o1; for (int e = 0; e < 4; ++e) { o0[e] = sigmoid_fast(v0[e]); o1[e] = sigmoid_fast(v1[e]); }
                                *(f32x4*)(p.gates() + (size_t)row * 32 + (c - 128)) = o0; *(f32x4*)(p.gates() + (size_t)row * 32 + (c - 128) + 4) = o1; }
                        } else {
                            f32x4 o0, o1; for (int e = 0; e < 4; ++e) { o0[e] = sigmoid_fast(v0[e]); o1[e] = sigmoid_fast(v1[e]); }
                            st8(p.mg() + (size_t)row * 2048 + (pn - 16) * 256 + c, o0, o1);
                        }
                    }
                }
            }
    }
};

template <int AI, int BJ>
__device__ __forceinline__ void inproj_sample_quadrant(const P& p, int pn, int wid, int lane) {
    const int wr = wid >> 2, wc = wid & 3, fr = lane & 15, fq = lane >> 4;
    f32x4 acc[2][2][4][2];
#pragma unroll
    for (int m = 0; m < 4; ++m)
#pragma unroll
        for (int n = 0; n < 2; ++n) acc[AI][BJ][m][n] = (f32x4){0.f, 0.f, 0.f, 0.f};
    const bf16_t* ap = p.hb() + (size_t)(NP + AI * 128 + wr * 64 + fr) * DM + 8 * fq;
    const bf16_t* bp = p.WinT() + (size_t)(pn * 256 + BJ * 128 + wc * 32 + fr) * DM + 8 * fq;
    bf16x8 a0[4][2], b0[2][2], a1[4][2], b1[2][2];
    auto ld = [&](bf16x8 (&a)[4][2], bf16x8 (&b)[2][2], int k0) {
#pragma unroll
        for (int i = 0; i < 2; ++i) {
#pragma unroll
            for (int m = 0; m < 4; ++m) a[m][i] = *(const bf16x8*)(ap + (size_t)m * 16 * DM + k0 + 32 * i);
#pragma unroll
            for (int n = 0; n < 2; ++n) b[n][i] = *(const bf16x8*)(bp + (size_t)n * 16 * DM + k0 + 32 * i);
        }
    };
    auto mma = [&](const bf16x8 (&a)[4][2], const bf16x8 (&b)[2][2]) {
#pragma unroll
        for (int i = 0; i < 2; ++i)
#pragma unroll
            for (int m = 0; m < 4; ++m)
#pragma unroll
                for (int n = 0; n < 2; ++n) acc[AI][BJ][m][n] = __builtin_amdgcn_mfma_f32_16x16x32_bf16(b[n][i], a[m][i], acc[AI][BJ][m][n], 0, 0, 0);
    };
    ld(a0, b0, 0);
#pragma unroll 1
    for (int k0 = 0; k0 < DM; k0 += 128) {
        ld(a1, b1, k0 + 64);
        mma(a0, b0);
        if (k0 + 128 < DM) ld(a0, b0, k0 + 128);
        mma(a1, b1);
    }
    EpiIn e; e.p = p; e.row0 = 0; e.pn0 = 0;
    Unit u; u.pm = NP / 256; u.pn = pn;
    e.template body<AI, AI + 1, BJ, BJ + 1>(acc, u, wr, wc, fr, fq);
}
__device__ __forceinline__ void ph_inproj_sample(const P& p) {
    if ((int)blockIdx.x >= 96) return;
    const int wid = threadIdx.x >> 6, lane = threadIdx.x & 63, pn = blockIdx.x >> 2;
    switch (blockIdx.x & 3) {
        case 0: inproj_sample_quadrant<0, 0>(p, pn, wid, lane); break;
        case 1: inproj_sample_quadrant<0, 1>(p, pn, wid, lane); break;
        case 2: inproj_sample_quadrant<1, 0>(p, pn, wid, lane); break;
        default: inproj_sample_quadrant<1, 1>(p, pn, wid, lane); break;
    }
}

struct EpiPlain {
    static constexpr bool PERM = false, AFTER_DRAIN = false;
    float* C; int ldc; int pad_;
    __device__ __forceinline__ void quad(int row, int c, f32x4 v) const { *(f32x4*)(C + (size_t)row * ldc + c) = v; }
    __device__ __forceinline__ void operator()(const f32x4 (&acc)[2][2][4][2], const Unit& u, int wr, int wc, int fr, int fq) const {
#pragma unroll
        for (int ai = 0; ai < 2; ++ai)
#pragma unroll
            for (int m = 0; m < 4; ++m) {
                float* rowp = C + (size_t)(u.pm * 256 + ai * 128 + wr * 64 + m * 16 + fr) * ldc + u.pn * 256 + wc * 32 + 8 * fq;
#pragma unroll
                for (int bj = 0; bj < 2; ++bj)
#pragma unroll
                    for (int n = 0; n < 2; ++n) *(f32x4*)(rowp + bj * 128 + n * 4) = acc[ai][bj][m][n];
            }
    }
};


struct EpiPlainBf {
    static constexpr bool PERM = false, AFTER_DRAIN = false;
    bf16_t* C; int ldc; int pad_;
    __device__ __forceinline__ void operator()(const f32x4 (&acc)[2][2][4][2], const Unit& u, int wr, int wc, int fr, int fq) const {
#pragma unroll
        for (int ai = 0; ai < 2; ++ai)
#pragma unroll
            for (int m = 0; m < 4; ++m) {
                bf16_t* rowp = C + (size_t)(u.pm * 256 + ai * 128 + wr * 64 + m * 16 + fr) * ldc + u.pn * 256 + wc * 32 + 4 * fq;
#pragma unroll
                for (int bj = 0; bj < 2; ++bj)
#pragma unroll
                    for (int n = 0; n < 2; ++n) st_bf4(rowp + bj * 128 + n * 16, acc[ai][bj][m][n]);
            }
    }
};

struct EpiYa {
    static constexpr bool PERM = false, AFTER_DRAIN = false;
    P p;
    __device__ __forceinline__ void quad(int row, int c, f32x4 v) const {
        const uint2 gw = *(const uint2*)(p.mg() + (size_t)row * 2048 + c);
        f32x4 g; g[0] = __uint_as_float(gw.x << 16); g[1] = __uint_as_float(gw.x & 0xffff0000u); g[2] = __uint_as_float(gw.y << 16); g[3] = __uint_as_float(gw.y & 0xffff0000u);
        *(f32x4*)(p.tmp() + (size_t)row * DM + c) = g * v;
    }
    __device__ __forceinline__ void operator()(const f32x4 (&acc)[2][2][4][2], const Unit& u, int wr, int wc, int fr, int fq) const {
#pragma unroll
        for (int ai = 0; ai < 2; ++ai)
#pragma unroll
            for (int m = 0; m < 4; ++m) {
                const int row = u.pm * 256 + ai * 128 + wr * 64 + m * 16 + fr;
#pragma unroll
                for (int bj = 0; bj < 2; ++bj)
#pragma unroll
                    for (int n = 0; n < 2; ++n) {
                        const int c = u.pn * 256 + bj * 128 + wc * 32 + fq * 8 + n * 4;
                        const uint2 gw = *(const uint2*)(p.mg() + (size_t)row * 2048 + c);
                        f32x4 g; g[0] = __uint_as_float(gw.x << 16); g[1] = __uint_as_float(gw.x & 0xffff0000u); g[2] = __uint_as_float(gw.y << 16); g[3] = __uint_as_float(gw.y & 0xffff0000u);
                        *(f32x4*)(p.tmp() + (size_t)row * DM + c) = g * acc[ai][bj][m][n];
                    }
            }
    }
};
struct EpiYb {
    static constexpr bool PERM = false, AFTER_DRAIN = false;
    P p;
    __device__ __forceinline__ void quad(int row, int c, f32x4 v) const {
        const uint2 gw = *(const uint2*)(p.mg() + (size_t)row * 2048 + 1024 + c);
        f32x4 g; g[0] = __uint_as_float(gw.x << 16); g[1] = __uint_as_float(gw.x & 0xffff0000u); g[2] = __uint_as_float(gw.y << 16); g[3] = __uint_as_float(gw.y & 0xffff0000u);
        st_bf4(p.mb() + (size_t)row * DM + c, *(const f32x4*)(p.tmp() + (size_t)row * DM + c) + g * v);
    }
    __device__ __forceinline__ void operator()(const f32x4 (&acc)[2][2][4][2], const Unit& u, int wr, int wc, int fr, int fq) const {
#pragma unroll
        for (int ai = 0; ai < 2; ++ai)
#pragma unroll
            for (int m = 0; m < 4; ++m) {
                const int row = u.pm * 256 + ai * 128 + wr * 64 + m * 16 + fr;
#pragma unroll
                for (int bj = 0; bj < 2; ++bj)
#pragma unroll
                    for (int n = 0; n < 2; ++n) {
                        const int c = u.pn * 256 + bj * 128 + wc * 32 + fq * 8 + n * 4;
                        const uint2 gw = *(const uint2*)(p.mg() + (size_t)row * 2048 + 1024 + c);
                        f32x4 g; g[0] = __uint_as_float(gw.x << 16); g[1] = __uint_as_float(gw.x & 0xffff0000u); g[2] = __uint_as_float(gw.y << 16); g[3] = __uint_as_float(gw.y & 0xffff0000u);
                        const f32x4 t = *(const f32x4*)(p.tmp() + (size_t)row * DM + c);
                        st_bf4(p.mb() + (size_t)row * DM + c, t + g * acc[ai][bj][m][n]);
                    }
            }
    }
};
struct EpiOut {
    static constexpr bool PERM = false, AFTER_DRAIN = false;
    P p;
    __device__ __forceinline__ void quad(int row, int c, f32x4 a) const {
        const float* xr = p.x_sample + (size_t)(row - NP) * DM;
        const f32x4 v = *(const f32x4*)(xr + c) + a;
        *(f32x4*)(p.x1() + (size_t)row * DM + c) = v;
        st_bf4(p.xg() + (size_t)row * DM + c, v * *(const f32x4*)(p.ple_g + c));
        atomicAdd(p.ss_s() + (row - NP), v[0] * v[0] + v[1] * v[1] + v[2] * v[2] + v[3] * v[3]);
    }
    __device__ __forceinline__ void operator()(const f32x4 (&acc)[2][2][4][2], const Unit& u, int wr, int wc, int fr, int fq) const {
#pragma unroll
        for (int ai = 0; ai < 2; ++ai)
#pragma unroll
            for (int m = 0; m < 4; ++m) {
                const int row = u.pm * 256 + ai * 128 + wr * 64 + m * 16 + fr;
                const float* xr = row < NP ? p.x_prompt + (size_t)row * DM : p.x_sample + (size_t)(row - NP) * DM;
                float ss = 0.f;
#pragma unroll
                for (int bj = 0; bj < 2; ++bj)
#pragma unroll
                    for (int n = 0; n < 2; ++n) {
                        const int c = u.pn * 256 + bj * 128 + wc * 32 + fq * 8 + n * 4;
                        const f32x4 v = *(const f32x4*)(xr + c) + acc[ai][bj][m][n];
                        *(f32x4*)(p.x1() + (size_t)row * DM + c) = v;
                        ss += v[0] * v[0] + v[1] * v[1] + v[2] * v[2] + v[3] * v[3];
                        st_bf4(p.xg() + (size_t)row * DM + c, v * *(const f32x4*)(p.ple_g + c));
                    }
                ss += __shfl_xor(ss, 16); ss += __shfl_xor(ss, 32);
                if (fq == 0) p.ss1()[(size_t)row * 16 + u.pn * 4 + wc] = ss;
            }
    }
};
struct EpiGate {
    static constexpr bool PERM = false, AFTER_DRAIN = false;
    P p;
    __device__ __forceinline__ void quad(int row, int c, f32x4 acc) const {
        const float rstd = rsqrtf(p.ss_s()[row - NP] * (1.0f / DM) + 1e-6f);
        const f32x4 a = acc * rstd;
        f32x4 g; for (int e = 0; e < 4; ++e) g[e] = sigmoidf_(a[e]);
        float* ppp = p.pp() + (size_t)row * DM + c;
        *(f32x4*)ppp = *(const f32x4*)(p.x1() + (size_t)row * DM + c) + g * *(const f32x4*)ppp;
    }
    __device__ __forceinline__ void operator()(const f32x4 (&acc)[2][2][4][2], const Unit& u, int wr, int wc, int fr, int fq) const {
#pragma unroll
        for (int ai = 0; ai < 2; ++ai)
#pragma unroll
            for (int m = 0; m < 4; ++m) {
                const int row = u.pm * 256 + ai * 128 + wr * 64 + m * 16 + fr;
                float ss = 0.f;
#pragma unroll
                for (int i = 0; i < 4; ++i) { const f32x4 t = *(const f32x4*)(p.ss1() + (size_t)row * 16 + i * 4); ss += (t[0] + t[1]) + (t[2] + t[3]); }
                const float rstd = rsqrtf(ss * (1.0f / DM) + 1e-6f);
#pragma unroll
                for (int bj = 0; bj < 2; ++bj)
#pragma unroll
                    for (int n = 0; n < 2; ++n) {
                        const int c = u.pn * 256 + bj * 128 + wc * 32 + fq * 8 + n * 4;
                        const f32x4 a = acc[ai][bj][m][n] * rstd;
                        f32x4 g; for (int e = 0; e < 4; ++e) g[e] = sigmoidf_(a[e]);
                        float* ppp = p.pp() + (size_t)row * DM + c;
                        *(f32x4*)ppp = *(const f32x4*)(p.x1() + (size_t)row * DM + c) + g * *(const f32x4*)ppp;
                    }
            }
    }
};

__device__ __forceinline__ void ph_final(const P& p) {
    const int tid = threadIdx.x, lane = tid & 63, wid = tid >> 6;
    const int nw = gridDim.x * 8;
    for (int row0 = blockIdx.x * 8 + wid; row0 < MR; row0 += 2 * nw) {
        float4 v[2][4]; float ss[2];
#pragma unroll
        for (int u = 0; u < 2; ++u) {
            const int row = row0 + u * nw < MR ? row0 + u * nw : row0;
            const float4* src = (const float4*)(p.pp() + (size_t)row * DM);
            ss[u] = 0.f;
#pragma unroll
            for (int i = 0; i < 4; ++i) { v[u][i] = src[lane + 64 * i]; ss[u] += v[u][i].x * v[u][i].x + v[u][i].y * v[u][i].y + v[u][i].z * v[u][i].z + v[u][i].w * v[u][i].w; }
        }
#pragma unroll
        for (int u = 0; u < 2; ++u) {
            const int row = row0 + u * nw;
            const float tot = wave_sum(ss[u]);
            const float rstd = rsqrtf(tot * (1.0f / DM) + 1e-6f);
            if (row < MR) {
                float4* dst = (float4*)(p.out + (row < NP ? O_Y_P + (size_t)row * DM : O_Y_S + (size_t)(row - NP) * DM));
#pragma unroll
                for (int i = 0; i < 4; ++i) {
                    const float4 g = ((const float4*)p.final_g)[lane + 64 * i];
                    float4 o; o.x = v[u][i].x * rstd * g.x; o.y = v[u][i].y * rstd * g.y; o.z = v[u][i].z * rstd * g.z; o.w = v[u][i].w * rstd * g.w;
                    dst[lane + 64 * i] = o;
                }
            }
        }
    }
}

typedef float f32x4v __attribute__((ext_vector_type(4)));
template <class Epi> __device__ __forceinline__ void small_gemm(const bf16_t* A, const bf16_t* Bt, int K, const Epi& E) {
    const int tid = threadIdx.x, lane = tid & 63, wid = tid >> 6, r16 = lane & 15, q4 = lane >> 4;
    for (int tile = blockIdx.x * 8 + wid; tile < 16 * 64; tile += gridDim.x * 8) {
        const int rt = tile & 15, ct = tile >> 4;
        const bf16_t* ap = A + (size_t)(NP + rt * 16 + r16) * K + 8 * q4;
        const bf16_t* bp = Bt + (size_t)(ct * 16 + r16) * K + 8 * q4;
        f32x4 acc = {0.f, 0.f, 0.f, 0.f};
#pragma unroll 1
        for (int k0 = 0; k0 < K; k0 += 256) {
            bf16x8 af[8], bf[8];
#pragma unroll
            for (int i = 0; i < 8; ++i) { af[i] = *(const bf16x8*)(ap + k0 + 32 * i); bf[i] = *(const bf16x8*)(bp + k0 + 32 * i); }
#pragma unroll
            for (int i = 0; i < 8; ++i) acc = __builtin_amdgcn_mfma_f32_16x16x32_bf16(bf[i], af[i], acc, 0, 0, 0);
        }
        E.quad(NP + rt * 16 + r16, (ct >> 1) * 32 + 8 * q4 + 4 * (ct & 1), acc);
    }
}

__device__ __forceinline__ f32x4 ld_bf4c(const bf16_t* q) { const uint2 w = *(const uint2*)q; f32x4 v; v[0] = __uint_as_float(w.x << 16); v[1] = __uint_as_float(w.x & 0xffff0000u); v[2] = __uint_as_float(w.y << 16); v[3] = __uint_as_float(w.y & 0xffff0000u); return v; }
__device__ __forceinline__ void compress2_tile(const P& p, const bf16_t* LH, int nbg, int nrows, int nblk, bf16_t* kc, bf16_t* vcT, int kvi, int bg, int tile, int lane, LAS unsigned char* wlds) {
    const int col = lane & 31, hb = lane >> 5;
    {
        const int i = tile * 32 + col;
        const bool live = i < nblk;
        const bf16_t* lbase = LH + ((size_t)kvi * nbg * nrows + (size_t)bg * nrows) * 256;
        const bf16_t* w2t = p.W2T() + (size_t)kvi * 64 * 128;
        LAS bf16_t* hs = (LAS bf16_t*)wlds;
        {
            const int rq = lane >> 4, c8 = lane & 15;
            const f32x4 pa = *(const f32x4*)(p.pt() + kvi * 128 + c8 * 8), pb = *(const f32x4*)(p.pt() + kvi * 128 + c8 * 8 + 4);
#pragma unroll
            for (int it = 0; it < 8; ++it) {
                const int rr = 4 * it + rq, gi = tile * 32 + rr;
                const bf16_t* rp = lbase + (size_t)(gi < nblk ? gi : 0) * 256 + c8 * 8;
                const uint4 lo = *(const uint4*)rp, hi = *(const uint4*)(rp + 256 + 128);
                float hv[8];
                const unsigned lw[4] = {lo.x, lo.y, lo.z, lo.w}, hw[4] = {hi.x, hi.y, hi.z, hi.w};
#pragma unroll
                for (int e = 0; e < 4; ++e) {
                    const float pe0 = e < 2 ? pa[2 * e] : pb[2 * e - 4], pe1 = e < 2 ? pa[2 * e + 1] : pb[2 * e - 3];
                    hv[2 * e] = siluf_(__uint_as_float(lw[e] << 16) + __uint_as_float(hw[e] << 16) + pe0);
                    hv[2 * e + 1] = siluf_(__uint_as_float(lw[e] & 0xffff0000u) + __uint_as_float(hw[e] & 0xffff0000u) + pe1);
                }
                *(LAS bf16x8*)(hs + rr * 136 + c8 * 8) = pack8(hv[0], hv[1], hv[2], hv[3], hv[4], hv[5], hv[6], hv[7]);
            }
        }
        WAVE_SYNC();
        f32x16 acc[2]; acc[0] = zero16(); acc[1] = zero16();
#pragma unroll
        for (int ks = 0; ks < 8; ++ks) {
            const int f = 16 * ks + 8 * hb;
            const bf16x8 hf = *(LAS const bf16x8*)(hs + col * 136 + f);
#pragma unroll
            for (int dt = 0; dt < 2; ++dt) {
                const bf16x8 wf = *(const bf16x8*)(w2t + (size_t)(32 * dt + col) * 128 + f);
                acc[dt] = (kvi == 0) ? mfma32(wf, hf, acc[dt]) : mfma32(hf, wf, acc[dt]);
            }
        }
        WAVE_SYNC();
        if (kvi == 0) {
            bf16_t* dst = kc + ((size_t)bg * nrows + i) * 64;
#pragma unroll
            for (int dt = 0; dt < 2; ++dt)
#pragma unroll
                for (int i4 = 0; i4 < 4; ++i4) {
                    const int d = 32 * dt + 8 * i4 + 4 * hb;
                    const f32x4 b2 = *(const f32x4*)(p.cmp_b2 + d);
                    f32x4 v; for (int e = 0; e < 4; ++e) v[e] = live ? acc[dt][4 * i4 + e] + b2[e] : 0.f;
                    st_bf4(dst + d, v);
                }
        } else {
#pragma unroll
            for (int dt = 0; dt < 2; ++dt) {
                const int d = 32 * dt + col;
                const float b2 = p.cmp_b2[64 + d];
                bf16_t* dst = vcT + ((size_t)bg * 64 + d) * nrows + tile * 32;
#pragma unroll
                for (int i4 = 0; i4 < 4; ++i4) {
                    const int r = 8 * i4 + 4 * hb;
                    f32x4 v; for (int e = 0; e < 4; ++e) v[e] = (tile * 32 + r + e) < nblk ? acc[dt][4 * i4 + e] + b2 : 0.f;
                    st_bf4(dst + r, v);
                }
            }
        }
    }
}

__device__ __forceinline__ void ph_compress2(const P& p, const bf16_t* LH, int nbg, int nrows, int nblk, bf16_t* kc, bf16_t* vcT, LAS unsigned char* lds) {
    const int tid = threadIdx.x, lane = tid & 63, wid = tid >> 6;
    const int ntile = nrows >> 5, total = 2 * nbg * ntile;
    for (int it = blockIdx.x * 8 + wid; it < total; it += gridDim.x * 8)
        compress2_tile(p, LH, nbg, nrows, nblk, kc, vcT, it / (ntile * nbg), (it / ntile) % nbg, it % ntile, lane, lds + wid * 8960);
}


__device__ __forceinline__ float dpp_row_sum16(float v) {
    v += __builtin_bit_cast(float, __builtin_amdgcn_mov_dpp(__builtin_bit_cast(int, v), 0xB1, 0xF, 0xF, true));
    v += __builtin_bit_cast(float, __builtin_amdgcn_mov_dpp(__builtin_bit_cast(int, v), 0x4E, 0xF, 0xF, true));
    v += __builtin_bit_cast(float, __builtin_amdgcn_mov_dpp(__builtin_bit_cast(int, v), 0x141, 0xF, 0xF, true));
    v += __builtin_bit_cast(float, __builtin_amdgcn_mov_dpp(__builtin_bit_cast(int, v), 0x140, 0xF, 0xF, true));
    return v;
}
__device__ __forceinline__ float tanh_fast(float x) { const float e = __expf(2.0f * x); return 1.0f - 2.0f / (e + 1.0f); }
__device__ __forceinline__ float half_sum32(float v) { return xsum16(dpp_row_sum16(v)); }
__device__ __forceinline__ const bf16_t* rwkv_prev_row(const P& p, int row) {
    if (row < NP) return (row & (SEQ - 1)) == 0 ? p.zs0() : p.rz() + (size_t)(row - 1) * CR;
    const int rs = row - NP;
    return (rs & 7) == 0 ? p.zs0() + (size_t)(1 + (rs >> 3)) * CR : p.rz() + (size_t)(row - 1) * CR;
}
__device__ __forceinline__ f32x4 ld_bf4(const bf16_t* q) { const uint2 w = *(const uint2*)q; f32x4 v; v[0] = __uint_as_float(w.x << 16); v[1] = __uint_as_float(w.x & 0xffff0000u); v[2] = __uint_as_float(w.y << 16); v[3] = __uint_as_float(w.y & 0xffff0000u); return v; }
__device__ __forceinline__ void ph_rwkv_prep(const P& p) {
    const int tid = threadIdx.x, lane = tid & 63, wid = tid >> 6, col = lane & 31, hb = lane >> 5;
    const int gw = blockIdx.x * 8 + wid, nw = gridDim.x * 8;
    for (int it = gw; it < NB + DB; it += nw) {
        const int row = it < NB ? it * SEQ + SEQ - 1 : NP + (it - NB) * 8 + 7;
        float* so = it < NB ? p.out + O_SH_P + (size_t)it * CR : p.out + O_SH_S + (size_t)(it - NB) * CR;
        const bf16_t* z = p.rz() + (size_t)row * CR;
        for (int i = lane; i < CR; i += 64) so[i] = bf2f(z[i]);
    }
    for (int rnd = 0; rnd < 3; ++rnd) {
        int it;
        if (rnd == 0) it = gw;
        else if ((int)blockIdx.x < 16) break;
        else if (rnd == 1) it = nw + (gw - 128);
        else { if (wid != 0 || (int)blockIdx.x >= 208) break; it = 2 * nw - 128 + ((int)blockIdx.x - 16); }
        if (it >= (MR / 32) * 8) break;
        const int h = it & 7, r0 = (it >> 3) * 32;
        bf16x8 Aw[4], Aa[4];
        {
            const int row = r0 + col;
            const bf16_t* z = p.rz() + (size_t)row * CR;
            const bf16_t* pv = rwkv_prev_row(p, row);
#pragma unroll
            for (int ks = 0; ks < 4; ++ks) {
                const int j0 = 16 * ks + 8 * hb;
                float tw[8], ta[8];
#pragma unroll
                for (int q = 0; q < 2; ++q) {
                    const f32x4 zw = ld_bf4(z + 1536 + j0 + 4 * q), za = ld_bf4(z + 1600 + j0 + 4 * q);
                    const f32x4 pw = ld_bf4(pv + 1536 + j0 + 4 * q), pa = ld_bf4(pv + 1600 + j0 + 4 * q);
                    const f32x4 mw = *(const f32x4*)(p.mu + 1536 + j0 + 4 * q), ma = *(const f32x4*)(p.mu + 1600 + j0 + 4 * q);
#pragma unroll
                    for (int e = 0; e < 4; ++e) { tw[4 * q + e] = tanh_fast(zw[e] + (pw[e] - zw[e]) * mw[e]); ta[4 * q + e] = za[e] + (pa[e] - za[e]) * ma[e]; }
                }
                Aw[ks] = pack8(tw[0], tw[1], tw[2], tw[3], tw[4], tw[5], tw[6], tw[7]);
                Aa[ks] = pack8(ta[0], ta[1], ta[2], ta[3], ta[4], ta[5], ta[6], ta[7]);
            }
        }
        f32x16 accw[2], acca[2];
#pragma unroll
        for (int ct = 0; ct < 2; ++ct) {
            accw[ct] = zero16(); acca[ct] = zero16();
            const size_t wo = (size_t)(h * 64 + 32 * ct + col) * 64 + 8 * hb;
#pragma unroll
            for (int ks = 0; ks < 4; ++ks) {
                accw[ct] = mfma32(Aw[ks], *(const bf16x8*)(p.WupT() + wo + 16 * ks), accw[ct]);
                acca[ct] = mfma32(Aa[ks], *(const bf16x8*)(p.AupT() + wo + 16 * ks), acca[ct]);
            }
        }
        float w0v[2], a0v[2], kkv[2], kav[2], rkv[2], mur[2], muk[2], muv[2];
#pragma unroll
        for (int ct = 0; ct < 2; ++ct) {
            const int c = h * 64 + 32 * ct + col;
            w0v[ct] = p.w0[c]; a0v[ct] = p.a0[c]; kkv[ct] = p.k_k[c]; kav[ct] = p.k_a[c]; rkv[ct] = p.r_k[c];
            mur[ct] = p.mu[c]; muk[ct] = p.mu[512 + c]; muv[ct] = p.mu[1024 + c];
        }
#pragma unroll
        for (int hf = 0; hf < 2; ++hf) {
        float zz[8][2][3], pz[2][2][3];
#pragma unroll
        for (int ii = 0; ii < 8; ++ii) {
            const int i = 8 * hf + ii;
            const bf16_t* z = p.rz() + (size_t)(r0 + (i & 3) + 8 * (i >> 2) + 4 * hb) * CR + h * 64 + col;
#pragma unroll
            for (int ct = 0; ct < 2; ++ct) { zz[ii][ct][0] = bf2f(z[32 * ct]); zz[ii][ct][1] = bf2f(z[512 + 32 * ct]); zz[ii][ct][2] = bf2f(z[1024 + 32 * ct]); }
        }
#pragma unroll
        for (int g2 = 0; g2 < 2; ++g2) {
            const bf16_t* pv = rwkv_prev_row(p, r0 + 8 * (2 * hf + g2) + 4 * hb) + h * 64 + col;
#pragma unroll
            for (int ct = 0; ct < 2; ++ct) { pz[g2][ct][0] = bf2f(pv[32 * ct]); pz[g2][ct][1] = bf2f(pv[512 + 32 * ct]); pz[g2][ct][2] = bf2f(pv[1024 + 32 * ct]); }
        }
#pragma unroll
        for (int ii = 0; ii < 8; ++ii) {
            const int i = 8 * hf + ii;
            const int row = r0 + (i & 3) + 8 * (i >> 2) + 4 * hb;
            float zr[2], zk[2], zv[2], dec[2], av[2], kkr[2], km[2];
            float n2 = 0.f, bon = 0.f;
#pragma unroll
            for (int ct = 0; ct < 2; ++ct) {
                const float z0 = zz[ii][ct][0], z1 = zz[ii][ct][1], z2 = zz[ii][ct][2];
                const int ip = ii > 0 ? ii - 1 : 0;
                const float p0 = (i & 3) ? zz[ip][ct][0] : pz[ii >> 2][ct][0], p1 = (i & 3) ? zz[ip][ct][1] : pz[ii >> 2][ct][1], p2 = (i & 3) ? zz[ip][ct][2] : pz[ii >> 2][ct][2];
                zr[ct] = z0 + (p0 - z0) * mur[ct]; zk[ct] = z1 + (p1 - z1) * muk[ct]; zv[ct] = z2 + (p2 - z2) * muv[ct];
                const float nx = -(w0v[ct] + accw[ct][i]);
                const float sp = fmaxf(nx, 0.f) + __logf(1.0f + __expf(-fabsf(nx)));
                dec[ct] = __expf(-__expf(-sp - 0.5f));
                av[ct] = sigmoidf_(a0v[ct] + acca[ct][i]);
                kkr[ct] = zk[ct] * kkv[ct];
                km[ct] = zk[ct] * (1.0f + (av[ct] - 1.0f) * kav[ct]);
                n2 += kkr[ct] * kkr[ct];
                bon += zr[ct] * km[ct] * rkv[ct];
            }
            n2 = half_sum32(n2); bon = half_sum32(bon);
            const float rn = 1.0f / fmaxf(sqrtf(n2), 1e-12f);
            unsigned char* o = p.rw6() + ((size_t)row * 8 + h) * RW6_STRIDE;
#pragma unroll
            for (int ct = 0; ct < 2; ++ct) {
                const float kk = kkr[ct] * rn;
                const int cl = 32 * ct + col;
                ((float*)o)[cl] = dec[ct];
                bf16_t* ob = (bf16_t*)(o + 256) + cl;
                ob[0] = f2bf(zr[ct]); ob[64] = f2bf(km[ct]); ob[128] = f2bf(zv[ct]); ob[192] = f2bf(kk); ob[256] = f2bf(kk * av[ct]);
            }
            if (col == 0) p.bonus()[(size_t)row * 8 + h] = bon;
        }
        }
    }
}

typedef float f32x2 __attribute__((ext_vector_type(2)));
__device__ __forceinline__ float dpp_row_sum(float v) {
    v += __builtin_bit_cast(float, __builtin_amdgcn_mov_dpp(__builtin_bit_cast(int, v), 0xB1, 0xF, 0xF, true));
    v += __builtin_bit_cast(float, __builtin_amdgcn_mov_dpp(__builtin_bit_cast(int, v), 0x4E, 0xF, 0xF, true));
    v += __builtin_bit_cast(float, __builtin_amdgcn_mov_dpp(__builtin_bit_cast(int, v), 0x141, 0xF, 0xF, true));
    v += __builtin_bit_cast(float, __builtin_amdgcn_mov_dpp(__builtin_bit_cast(int, v), 0x140, 0xF, 0xF, true));
    return v;
}
constexpr int SCAN_TC = 32;
template <int NROWS>
__device__ __forceinline__ void scan_item(const P& p, LAS float* lds, int row0, int T, int h, int half, const float* s0, float* sout) {
    const int tid = threadIdx.x, w = tid >> 6, lane = tid & 63, rl = lane >> 4, kq = lane & 15;
    const bool act = w * 4 < NROWS;
    const int vrow = half * NROWS + (act ? w * 4 : 0) + rl;
    f32x4 S;
    if (s0) S = *(const f32x4*)(s0 + vrow * 64 + kq * 4); else { S[0] = 0.f; S[1] = 0.f; S[2] = 0.f; S[3] = 0.f; }
    const unsigned char* src = p.rw6() + ((size_t)row0 * 8 + h) * RW6_STRIDE;
    const int nchunk = (T + SCAN_TC - 1) / SCAN_TC;
    u32x4_t stg[4];
    int ss[4], sc[4], sl[4];
#pragma unroll
    for (int i = 0; i < 4; ++i) {
        const int idx = i * 512 + tid; ss[i] = idx / 56; sc[i] = idx % 56;
        const int cb = sc[i] - 16, q = cb >> 3;
        sl[i] = sc[i] < 16 ? 64 + 4 * sc[i] : (q == 0 ? 0 : 64 + 64 * q) + 8 * (cb & 7);
    }
    auto put = [&](LAS float* b, int i) {
        LAS float* d = b + ss[i] * 384 + sl[i];
        if (sc[i] < 16) *(LAS u32x4_t*)d = stg[i];
        else {
            f32x4 lo, hi;
            lo[0] = __uint_as_float(stg[i][0] << 16); lo[1] = __uint_as_float(stg[i][0] & 0xffff0000u); lo[2] = __uint_as_float(stg[i][1] << 16); lo[3] = __uint_as_float(stg[i][1] & 0xffff0000u);
            hi[0] = __uint_as_float(stg[i][2] << 16); hi[1] = __uint_as_float(stg[i][2] & 0xffff0000u); hi[2] = __uint_as_float(stg[i][3] << 16); hi[3] = __uint_as_float(stg[i][3] & 0xffff0000u);
            *(LAS f32x4*)d = lo; *(LAS f32x4*)(d + 4) = hi;
        }
    };
    {
        const int ns = T < SCAN_TC ? T : SCAN_TC;
#pragma unroll
        for (int i = 0; i < 4; ++i) if (ss[i] < ns) { stg[i] = *(const u32x4_t*)(src + (size_t)ss[i] * (8 * RW6_STRIDE) + sc[i] * 16); put(lds, i); }
    }
    __syncthreads();
    for (int c = 0; c < nchunk; ++c) {
        const int t0 = c * SCAN_TC;
        const int ns = (T - t0) < SCAN_TC ? (T - t0) : SCAN_TC;
        const bool more = (c + 1) < nchunk;
        const int nns = more ? ((T - t0 - SCAN_TC) < SCAN_TC ? (T - t0 - SCAN_TC) : SCAN_TC) : 0;
        if (more) {
#pragma unroll
            for (int i = 0; i < 4; ++i) if (ss[i] < nns) stg[i] = *(const u32x4_t*)(src + (size_t)(t0 + SCAN_TC + ss[i]) * (8 * RW6_STRIDE) + sc[i] * 16);
        }
        LAS const float* buf = lds + (c & 1) * (SCAN_TC * 384);
        float* yo = p.ybuf() + (size_t)(row0 + t0) * 512 + h * 64 + vrow;
        if (act)
#pragma unroll 4
        for (int s = 0; s < ns; ++s) {
            LAS const float* bs = buf + s * 384 + kq * 4;
            const f32x4 r = *(LAS const f32x4*)(bs), d = *(LAS const f32x4*)(bs + 64), km = *(LAS const f32x4*)(bs + 128),
                        kk = *(LAS const f32x4*)(bs + 256), ka = *(LAS const f32x4*)(bs + 320);
            const float vv = buf[s * 384 + 192 + vrow];
            const f32x4 t1 = S * kk;
            float sa = dpp_row_sum((t1[0] + t1[1]) + (t1[2] + t1[3]));
            sa = -sa;
            S = S * d + ka * sa + km * vv;
            const f32x4 t2 = S * r;
            const float y = dpp_row_sum((t2[0] + t2[1]) + (t2[2] + t2[3]));
            if (kq == 0) yo[(size_t)s * 512] = y;
        }
        if (more) {
            LAS float* nb = lds + ((c + 1) & 1) * (SCAN_TC * 384);
#pragma unroll
            for (int i = 0; i < 4; ++i) if (ss[i] < nns) put(nb, i);
        }
        __syncthreads();
    }
    if (act) *(f32x4*)(sout + vrow * 64 + kq * 4) = S;
}
struct ScanVec { f32x4 r, d, km, kk, ka; float vv; };
__device__ __forceinline__ void scan_ld(ScanVec& v, LAS const float* bs, LAS const float* bv) {
    v.kk = *(LAS const f32x4*)(bs + 256); v.d = *(LAS const f32x4*)(bs + 64); v.ka = *(LAS const f32x4*)(bs + 320);
    v.km = *(LAS const f32x4*)(bs + 128); v.vv = *bv; v.r = *(LAS const f32x4*)(bs);
}
__device__ __forceinline__ float scan_step(f32x4& S, const ScanVec& v) {
    const f32x4 t1 = S * v.kk;
    const float sa = -dpp_row_sum((t1[0] + t1[2]) + (t1[1] + t1[3]));
    S = S * v.d + v.ka * sa + v.km * v.vv;
    const f32x4 t2 = S * v.r;
    return dpp_row_sum((t2[0] + t2[2]) + (t2[1] + t2[3]));
}
__device__ __forceinline__ float scan_step_p(f32x4& S, const ScanVec& v) {
    const f32x4 t1 = S * v.kk;
    const float sa = -dpp_row_sum((t1[0] + t1[2]) + (t1[1] + t1[3]));
    S = S * v.d + v.ka * sa + v.km * v.vv;
    const f32x4 t2 = S * v.r;
    return (t2[0] + t2[2]) + (t2[1] + t2[3]);
}
constexpr int YP_STRIDE = 68;
struct ScanCarry { f32x4 P, ka, r; float sa, hu; };
template <int CTRL> __device__ __forceinline__ float dpp_add_(float v) { return v + __builtin_bit_cast(float, __builtin_amdgcn_mov_dpp(__builtin_bit_cast(int, v), CTRL, 0xF, 0xF, true)); }
#define dpp_add(v, c) dpp_add_<c>(v)
#define SCAN_OPAQUE(x) asm("" : "+v"(x))
struct ScanVecA { f32x4 r, d, km, kk, ka; float vv, al; };
__device__ __forceinline__ void scan_lda(ScanVecA& v, LAS const float* bs, LAS const float* bv, LAS const float* ba) {
    v.d = *(LAS const f32x4*)(bs + 64); v.km = *(LAS const f32x4*)(bs + 128); v.vv = *bv; v.al = *ba; v.kk = *(LAS const f32x4*)(bs + 256);
    v.ka = *(LAS const f32x4*)(bs + 320); v.r = *(LAS const f32x4*)(bs);
}
__device__ __forceinline__ float lane_dot4(const f32x4& a, const f32x4& b) {
    const f32x2 lo = {a[0] * b[0], a[1] * b[1]};
    const f32x2 s2 = {__builtin_fmaf(a[2], b[2], lo[0]), __builtin_fmaf(a[3], b[3], lo[1])};
    return s2[0] + s2[1];
}
__device__ __forceinline__ float scan_step_la(ScanCarry& C, const ScanVecA& v) {
    const f32x4 S = C.P + C.ka * C.sa;
    const f32x4 P = S * v.d + v.km * v.vv;
    float U = C.hu;
    U = dpp_add(U, 0x141);
    U = dpp_add(U, 0x140);
    const float sa = -(U + C.sa * v.al);
    float hu = lane_dot4(P, v.kk);
    hu = dpp_add(hu, 0xB1);
    hu = dpp_add(hu, 0x4E);
    asm volatile("" : "+v"(hu));
    const float yp = lane_dot4(S, C.r);
    C.P = P; C.ka = v.ka; C.r = v.r; C.sa = sa; C.hu = hu;
    return yp;
}
template <int NROWS>
__device__ __forceinline__ void scan_prompt(const P& p, LAS float* lds, int row0, int h, int part, float* sout) {
    const int tid = threadIdx.x, w = tid >> 6, lane = tid & 63, rl = lane >> 4, kq = lane & 15;
    const unsigned char* src = p.rw6() + ((size_t)row0 * 8 + h) * RW6_STRIDE;
    constexpr int nchunk = SEQ / SCAN_TC;
    LAS float* alp = lds + 2 * SCAN_TC * 384 + 8 * (16 * YP_STRIDE);
    if (w >= 4) {
        const int hid = tid - 256;
        u32x4_t stA[7], stB[7];
        int ss[7], sc[7], sl[7], sx[7];
#pragma unroll
        for (int i = 0; i < 7; ++i) {
            const int idx = i * 256 + hid; ss[i] = idx / 56; sc[i] = idx % 56;
            const int cb = sc[i] - 16, q = cb >> 3;
            sl[i] = sc[i] < 16 ? 64 + 4 * sc[i] : (q == 0 ? 0 : 64 + 64 * q) + 8 * (cb & 7);
            sx[i] = (sc[i] >= 16 && q == 3) ? 8 * RW6_STRIDE : 0;
        }
        auto load = [&](u32x4_t (&st)[7], int cc) {
#pragma unroll
            for (int i = 0; i < 7; ++i) st[i] = *(const u32x4_t*)(src + (size_t)(cc * SCAN_TC + ss[i]) * (8 * RW6_STRIDE) + sc[i] * 16 + sx[i]);
        };
        auto put = [&](const u32x4_t (&st)[7], LAS float* b) {
#pragma unroll
            for (int i = 0; i < 7; ++i) {
                LAS float* d = b + ss[i] * 384 + sl[i];
                if (sc[i] < 16) *(LAS u32x4_t*)d = st[i];
                else {
                    f32x4 lo, hi;
                    lo[0] = __uint_as_float(st[i][0] << 16); lo[1] = __uint_as_float(st[i][0] & 0xffff0000u); lo[2] = __uint_as_float(st[i][1] << 16); lo[3] = __uint_as_float(st[i][1] & 0xffff0000u);
                    hi[0] = __uint_as_float(st[i][2] << 16); hi[1] = __uint_as_float(st[i][2] & 0xffff0000u); hi[2] = __uint_as_float(st[i][3] << 16); hi[3] = __uint_as_float(st[i][3] & 0xffff0000u);
                    *(LAS f32x4*)d = lo; *(LAS f32x4*)(d + 4) = hi;
                }
            }
        };
        auto alpha_chunk = [&](int cc) {
#pragma unroll
            for (int i = 0; i < 8; ++i) {
                const int s8 = (w - 4) * 8 + i, t = cc * SCAN_TC + s8;
                const unsigned char* rowp = src + (size_t)t * (8 * RW6_STRIDE);
                const float kkv = bf2f(((const bf16_t*)(rowp + 640))[lane]);
                const float kav = t > 0 ? bf2f(((const bf16_t*)(rowp - 8 * RW6_STRIDE + 768))[lane]) : 0.f;
                const float d = wave_sum(kav * kkv);
                if (lane == 0) alp[(cc & 1) * SCAN_TC + s8] = d;
            }
        };
        LAS float* buf0 = lds; LAS float* buf1 = lds + SCAN_TC * 384;
        load(stA, 0); load(stB, 1); alpha_chunk(0); put(stA, buf0);
        __syncthreads();
#pragma unroll 1
        for (int c = 0; c < nchunk; c += 2) {
            if (c + 2 < nchunk) load(stA, c + 2);
            alpha_chunk(c + 1); put(stB, buf1);
            __syncthreads();
            if (c + 3 < nchunk) load(stB, c + 3);
            if (c + 2 < nchunk) { alpha_chunk(c + 2); put(stA, buf0); }
            __syncthreads();
        }
        return;
    }
    const int vrow = part * NROWS + w * 4 + rl;
    ScanCarry C;
#pragma unroll
    for (int e = 0; e < 4; ++e) { C.P[e] = 0.f; C.ka[e] = 0.f; C.r[e] = 0.f; }
    C.sa = 0.f; C.hu = 0.f;
    LAS float* pw = lds + 2 * SCAN_TC * 384 + w * (16 * YP_STRIDE);
    LAS float* pwl = pw + lane;
    LAS const float* prd = pw + kq * YP_STRIDE + rl * 16;
    float* ybase = p.ybuf() + (size_t)(row0 + kq) * 512 + h * 64 + vrow;
    auto flush = [&](int tb) {
        const f32x4 a0 = *(LAS const f32x4*)(prd), a1 = *(LAS const f32x4*)(prd + 4), a2 = *(LAS const f32x4*)(prd + 8), a3 = *(LAS const f32x4*)(prd + 12);
        const f32x4 t = (a0 + a1) + (a2 + a3);
        ybase[(size_t)tb * 512] = (t[0] + t[2]) + (t[1] + t[3]);
    };
    __syncthreads();
#pragma unroll 1
    for (int c = 0; c < nchunk; ++c) {
        const int t0 = c * SCAN_TC;
        LAS const float* buf = lds + (c & 1) * (SCAN_TC * 384);
        LAS const float* bk = buf + kq * 4;
        LAS const float* bv = buf + 192 + vrow;
        LAS const float* ba = alp + (c & 1) * SCAN_TC;
        ScanVecA A, B, D;
        scan_lda(A, bk, bv, ba); scan_lda(B, bk + 384, bv + 384, ba + 1); scan_lda(D, bk + 2 * 384, bv + 2 * 384, ba + 2);
#define STEPX(V, s) do { __builtin_amdgcn_sched_barrier(0); pwl[(((s) + 15) & 15) * YP_STRIDE] = scan_step_la(C, V);     \
            if ((s) == 0) { if (c > 0) flush(t0 - 16); } if ((s) == 16) flush(t0); \
            if ((s) + 3 < SCAN_TC) scan_lda(V, bk + ((s) + 3) * 384, bv + ((s) + 3) * 384, ba + (s) + 3); } while (0)
        STEPX(A, 0); STEPX(B, 1); STEPX(D, 2); STEPX(A, 3); STEPX(B, 4); STEPX(D, 5); STEPX(A, 6); STEPX(B, 7); STEPX(D, 8); STEPX(A, 9); STEPX(B, 10); STEPX(D, 11); STEPX(A, 12); STEPX(B, 13); STEPX(D, 14); STEPX(A, 15); STEPX(B, 16); STEPX(D, 17); STEPX(A, 18); STEPX(B, 19); STEPX(D, 20); STEPX(A, 21); STEPX(B, 22); STEPX(D, 23); STEPX(A, 24); STEPX(B, 25); STEPX(D, 26); STEPX(A, 27); STEPX(B, 28); STEPX(D, 29); STEPX(A, 30); STEPX(B, 31);
#undef STEPX
        __syncthreads();
    }
    {
        const f32x4 S = C.P + C.ka * C.sa;
        pwl[15 * YP_STRIDE] = lane_dot4(S, C.r);
        flush(SEQ - 16);
        *(f32x4*)(sout + vrow * 64 + kq * 4) = S;
    }
}
constexpr int NSCAN = 128;
__device__ __forceinline__ void ph_rwkv_scan(const P& p, LAS float* lds) {
    if ((int)blockIdx.x < NSCAN) {
        const int item = blockIdx.x >> 2, part = blockIdx.x & 3;
        scan_prompt<16>(p, lds, (item >> 3) * SEQ, item & 7, part, p.out + O_WKV_P + (size_t)item * 4096);
    } else {
        const int nb = (int)gridDim.x - NSCAN;
        for (int hi = (int)blockIdx.x - NSCAN; hi < 512; hi += nb) {
            const int item = hi >> 1, half = hi & 1;
            scan_item<32>(p, lds, NP + (item >> 3) * 8, 8, item & 7, half, p.state_wkv + (size_t)item * 4096, p.out + O_WKV_S + (size_t)item * 4096);
        }
    }
}

__device__ __forceinline__ void ph_rwkv_post(const P& p) {
    const int tid = threadIdx.x, lane = tid & 63, wid = tid >> 6;
    const int stride = gridDim.x * 8;
    const int first = blockIdx.x * 8 + wid, c = (first & 7) * 64 + lane;
    const float gg = p.gn_g[c], gb = p.gn_b[c];
    for (int it0 = first; it0 < MR * 8; it0 += 4 * stride) {
        float y[4], bon[4], vv[4], rg[4];
#pragma unroll
        for (int u = 0; u < 4; ++u) {
            const int it = it0 + u * stride < MR * 8 ? it0 + u * stride : it0, row = it >> 3;
            y[u] = p.ybuf()[(size_t)row * 512 + c];
            bon[u] = p.bonus()[it];
            vv[u] = bf2f(((const bf16_t*)(p.rw6() + (size_t)it * RW6_STRIDE + 256))[128 + lane]);
            rg[u] = bf2f(p.rg()[(size_t)row * 512 + c]);
        }
#pragma unroll
        for (int u = 0; u < 4; ++u) {
            const int it = it0 + u * stride, row = it >> 3;
            const float s1 = wave_sum(y[u]), s2 = wave_sum(y[u] * y[u]);
            const float mean = s1 * (1.0f / 64.0f);
            const float var = fmaxf(s2 * (1.0f / 64.0f) - mean * mean, 0.f);
            const float dv = y[u] - mean;
            float yn = dv * rsqrtf(var + 64e-5f) * gg + gb;
            yn += bon[u] * vv[u];
            if (it < MR * 8) p.ob()[(size_t)row * 512 + c] = f2bf(yn * rg[u]);
        }
    }
}

__device__ __forceinline__ void ph_cmp_gemm_f32(const P& p, LAS unsigned char* lds) {
    using pg8::lds_byte;
    const int tid = threadIdx.x, wid = __builtin_amdgcn_readfirstlane(tid >> 6), lane = tid & 63, wr = wid >> 2, wc = wid & 3, fr = lane & 15, fq = lane >> 4;
    constexpr int HTB = 16384;
    const int arow_l = 4 * wid + (lane >> 4), acol = 4 * (lane & 15);
    const int swbase = lds_byte(arow_l, acol);
    LAS unsigned long long* rowoff = (LAS unsigned long long*)(lds + 131072);
    unsigned voffB[2];
#pragma unroll
    for (int i = 0; i < 2; ++i) { int R, C; pg8::stage_rc(tid * 16 + i * 8192, R, C); voffB[i] = (unsigned)(R * 1024 + C) * 2u; }
    const unsigned ldsw = (unsigned)wid * 1024u;
    const int aoff = lds_byte(wr * 64 + fr, fq * 8), boff = lds_byte(wc * 32 + fr, fq * 8);
    for (int unit = blockIdx.x; unit < 512; unit += gridDim.x) {
        const int kvi = unit >> 8, bg = (unit >> 2) & 63, c0 = (unit & 3) * 256, b = bg >> 1, g = bg & 1;
        __syncthreads();
        if (tid < 256) {
            const int chunk = c0 + tid;
            const int page = p.page_table[b * 128 + (chunk >> 3)];
            rowoff[tid] = ((unsigned long long)page * 128 + (chunk & 7) * 16) * 256 + kvi * 128 + g * 64;
        }
        const char* bbase = (const char*)(p.W1T() + (size_t)kvi * 256 * 1024);
        f32x4 acc[2][2][4][2];
#pragma unroll
        for (int a = 0; a < 2; ++a)
#pragma unroll
            for (int bb = 0; bb < 2; ++bb)
#pragma unroll
                for (int m = 0; m < 4; ++m)
#pragma unroll
                    for (int n = 0; n < 2; ++n) acc[a][bb][m][n] = (f32x4){0.f, 0.f, 0.f, 0.f};
        f32x4 ar[8];
        auto stage_b = [&](int st, int t) {
#pragma unroll
            for (int h = 0; h < 2; ++h)
#pragma unroll
                for (int i = 0; i < 2; ++i)
                    __builtin_amdgcn_global_load_lds((const unsigned*)(bbase + (size_t)h * 128 * 2048 + (size_t)t * 128 + voffB[i]),
                                                     (PG8_LAS unsigned*)(lds + st * 65536 + 32768 + h * HTB + ldsw + i * 8192), 16, 0, 0);
        };
        auto load_a = [&](int t) {
#pragma unroll
            for (int q = 0; q < 8; ++q) ar[q] = *(const f32x4*)(p.cache_cmp + rowoff[32 * q + arow_l] + (size_t)t * 256 + acol);
        };
        auto write_a = [&](int st) {
            LAS unsigned char* na = lds + st * 65536;
#pragma unroll
            for (int q = 0; q < 8; ++q) *(LAS u32x2*)(na + swbase + (q >> 2) * HTB + (q & 3) * 4096) = (u32x2){pk2(ar[q][0], ar[q][1]), pk2(ar[q][2], ar[q][3])};
        };
        __syncthreads();
        load_a(0);
        stage_b(0, 0);
        write_a(0);
        __syncthreads();
#pragma unroll 1
        for (int t = 0; t < 16; ++t) {
            const int cur = t & 1;
            if (t + 1 < 16) { load_a(t + 1); stage_b(cur ^ 1, t + 1); }
            LAS const unsigned char* sa = lds + cur * 65536;
            LAS const unsigned char* sb = sa + 32768;
#pragma unroll
            for (int ai = 0; ai < 2; ++ai)
#pragma unroll
                for (int bj = 0; bj < 2; ++bj) {
                    bf16x8 Bt[2][2];
#pragma unroll
                    for (int n = 0; n < 2; ++n)
#pragma unroll
                        for (int k = 0; k < 2; ++k) Bt[n][k] = *(LAS const bf16x8*)(sb + bj * HTB + boff + n * 2048 + k * 1024);
#pragma unroll
                    for (int m = 0; m < 4; ++m) {
                        const bf16x8 a0 = *(LAS const bf16x8*)(sa + ai * HTB + aoff + m * 2048), a1 = *(LAS const bf16x8*)(sa + ai * HTB + aoff + m * 2048 + 1024);
#pragma unroll
                        for (int n = 0; n < 2; ++n) {
                            acc[ai][bj][m][n] = __builtin_amdgcn_mfma_f32_16x16x32_bf16(Bt[n][0], a0, acc[ai][bj][m][n], 0, 0, 0);
                            acc[ai][bj][m][n] = __builtin_amdgcn_mfma_f32_16x16x32_bf16(Bt[n][1], a1, acc[ai][bj][m][n], 0, 0, 0);
                        }
                    }
                    __builtin_amdgcn_sched_barrier(0);
                }
            if (t + 1 < 16) write_a(cur ^ 1);
            __syncthreads();
        }
        EpiPlainBf e; e.C = p.LHs() + ((size_t)kvi * 65536 + (size_t)bg * 1024 + c0) * 256; e.ldc = 256; e.pad_ = 0;
        pg8::Unit u; u.pm = 0; u.pn = 0;
        e(acc, u, wr, wc, fr, fq);
    }
}

__device__ __forceinline__ float exp2_(float x) { return __builtin_amdgcn_exp2f(x); }
template <class OKF>
__device__ __forceinline__ void sm_stats(const f32x16& s, int hb, OKF ok, float& m, float& l) {
    float sv[16]; float tmax = -1e30f; unsigned okm = 0;
#pragma unroll
    for (int i = 0; i < 16; ++i) { const int kl = (i & 3) + 8 * (i >> 2) + 4 * hb; const bool k = ok(kl); okm |= (k ? 1u : 0u) << i; sv[i] = k ? s[i] : -1e30f; tmax = fmaxf(tmax, sv[i]); }
    tmax = fmaxf(tmax, __shfl_xor(tmax, 32));
    const float mn = fmaxf(m, tmax), alpha = exp2_(m - mn); m = mn;
    float ps = 0.f;
#pragma unroll
    for (int i = 0; i < 16; ++i) ps += ((okm >> i) & 1u) ? exp2_(sv[i] - mn) : 0.f;
    l = l * alpha + ps;
}
template <class OKF, class VF>
__device__ __forceinline__ void sm_pv(const f32x16& s, int hb, OKF ok, VF vf, float& m, float& l, f32x16 (&o)[2]) {
    float sv[16]; float tmax = -1e30f; unsigned okm = 0;
#pragma unroll
    for (int i = 0; i < 16; ++i) { const int kl = (i & 3) + 8 * (i >> 2) + 4 * hb; const bool k = ok(kl); okm |= (k ? 1u : 0u) << i; sv[i] = k ? s[i] : -1e30f; tmax = fmaxf(tmax, sv[i]); }
    tmax = fmaxf(tmax, __shfl_xor(tmax, 32));
    const float mn = fmaxf(m, tmax), alpha = exp2_(m - mn); m = mn;
    float pr[16]; float ps = 0.f;
#pragma unroll
    for (int i = 0; i < 16; ++i) { pr[i] = ((okm >> i) & 1u) ? exp2_(sv[i] - mn) : 0.f; ps += pr[i]; }
    l = l * alpha + ps;
    o[0] *= alpha; o[1] *= alpha;
#pragma unroll
    for (int s2 = 0; s2 < 2; ++s2) {
        const bf16x8 pb = pack8(pr[8 * s2 + 0], pr[8 * s2 + 1], pr[8 * s2 + 2], pr[8 * s2 + 3], pr[8 * s2 + 4], pr[8 * s2 + 5], pr[8 * s2 + 6], pr[8 * s2 + 7]);
#pragma unroll
        for (int dt = 0; dt < 2; ++dt) o[dt] = mfma32(vf(dt, s2), pb, o[dt]);
    }
}
template <class VF>
__device__ __forceinline__ void sm_pv_nomask(const f32x16& s, bool csel, VF vf, float& m, float& l, f32x16 (&o)[2]) {
    float tmax = fmaxf(fmaxf(s[0], s[1]), s[2]);
#pragma unroll
    for (int i = 3; i < 16; ++i) tmax = fmaxf(tmax, s[i]);
    tmax = csel ? tmax : -1e30f;
    tmax = fmaxf(tmax, __shfl_xor(tmax, 32));
    const float mn = fmaxf(m, tmax), alpha = exp2_(m - mn); m = mn;
    float pr[16]; float ps = 0.f;
#pragma unroll
    for (int i = 0; i < 16; ++i) { pr[i] = csel ? exp2_(s[i] - mn) : 0.f; ps += pr[i]; }
    l = l * alpha + ps;
    o[0] *= alpha; o[1] *= alpha;
#pragma unroll
    for (int s2 = 0; s2 < 2; ++s2) {
        const bf16x8 pb = pack8(pr[8 * s2 + 0], pr[8 * s2 + 1], pr[8 * s2 + 2], pr[8 * s2 + 3], pr[8 * s2 + 4], pr[8 * s2 + 5], pr[8 * s2 + 6], pr[8 * s2 + 7]);
#pragma unroll
        for (int dt = 0; dt < 2; ++dt) o[dt] = mfma32(vf(dt, s2), pb, o[dt]);
    }
}
template <class OKF, class VF>
__device__ __forceinline__ void cmp_pass2(const f32x16& s, int hb, OKF ok, VF vf, float m, float inv, f32x16 (&o)[2], LAS float* prow, bool writer) {
    float pr[16];
#pragma unroll
    for (int i = 0; i < 16; ++i) {
        const int kl = (i & 3) + 8 * (i >> 2) + 4 * hb;
        pr[i] = ok(kl) ? exp2_(s[i] - m) * inv : 0.f;
        float q = pr[i] + __shfl_xor(pr[i], 1); q += __shfl_xor(q, 2);
        if (writer) prow[kl] = q;
    }
#pragma unroll
    for (int s2 = 0; s2 < 2; ++s2) {
        const bf16x8 pb = pack8(pr[8 * s2 + 0], pr[8 * s2 + 1], pr[8 * s2 + 2], pr[8 * s2 + 3], pr[8 * s2 + 4], pr[8 * s2 + 5], pr[8 * s2 + 6], pr[8 * s2 + 7]);
#pragma unroll
        for (int dt = 0; dt < 2; ++dt) o[dt] = mfma32(vf(dt, s2), pb, o[dt]);
    }
}

__device__ __forceinline__ void attn_store(const P& p, const f32x16 (&of)[2], int qrow, int head, int hb, bool doit, bf16_t* oadst = nullptr) {
    if (!oadst) oadst = p.oa();
    if (!doit) return;
#pragma unroll
    for (int dt = 0; dt < 2; ++dt)
#pragma unroll
        for (int i4 = 0; i4 < 4; ++i4) {
            const int d = 32 * dt + 8 * i4 + 4 * hb;
            const size_t off = (size_t)qrow * 512 + head * 64 + d;
            const uint2 gw = *(const uint2*)(p.ag() + off);
            f32x4 v;
            v[0] = of[dt][4 * i4 + 0] * __uint_as_float(gw.x << 16); v[1] = of[dt][4 * i4 + 1] * __uint_as_float(gw.x & 0xffff0000u);
            v[2] = of[dt][4 * i4 + 2] * __uint_as_float(gw.y << 16); v[3] = of[dt][4 * i4 + 3] * __uint_as_float(gw.y & 0xffff0000u);
            st_bf4(oadst + off, v);
        }
}


__device__ __forceinline__ void of_put(LAS float* st, int lane, const f32x16 (&o)[2], float sc) {
#pragma unroll
    for (int dt = 0; dt < 2; ++dt)
#pragma unroll
        for (int i = 0; i < 16; ++i) st[(dt * 16 + i) * 64 + lane] = o[dt][i] * sc;
}
__device__ __forceinline__ void of_add(LAS float* st, int lane, const f32x16 (&o)[2], float sc) {
#pragma unroll
    for (int dt = 0; dt < 2; ++dt)
#pragma unroll
        for (int i = 0; i < 16; ++i) st[(dt * 16 + i) * 64 + lane] += o[dt][i] * sc;
}
__device__ __forceinline__ void of_get_add(LAS float* st, int lane, const f32x16 (&o)[2], float sc, f32x16 (&of)[2]) {
#pragma unroll
    for (int dt = 0; dt < 2; ++dt)
#pragma unroll
        for (int i = 0; i < 16; ++i) of[dt][i] = st[(dt * 16 + i) * 64 + lane] + o[dt][i] * sc;
}


constexpr int WL_STRIDE = 15360, KV_OFF = 8 * WL_STRIDE, KV_BUF = 17920, XB_OFF = KV_OFF + 2 * KV_BUF;

struct LoadBf16 {
    const bf16_t* kbase; const bf16_t* vbase; int ld; bool with_v; u32x4_t kr[2], vr[2];
    static constexpr int DEPTH = 2;
    __device__ __forceinline__ void load(int n, int slot) {
        const int tid = threadIdx.x, srow = tid >> 3, sch = tid & 7;
        const u32x4_t k = *(const u32x4_t*)(kbase + (size_t)(64 * n + srow) * 64 + sch * 8);
        u32x4_t v = k;
        if (with_v) v = *(const u32x4_t*)(vbase + (size_t)srow * ld + 64 * n + sch * 8);
        if (slot) { kr[1] = k; vr[1] = v; } else { kr[0] = k; vr[0] = v; }
    }
    __device__ __forceinline__ void store(LAS unsigned char* buf, int slot) const {
        const int tid = threadIdx.x, srow = tid >> 3, sch = tid & 7;
        const u32x4_t k = slot ? kr[1] : kr[0], v = slot ? vr[1] : vr[0];
        *(LAS u32x4_t*)(buf + srow * 144 + sch * 16) = k;
        if (with_v) { LAS u32x2* vp = (LAS u32x2*)(buf + 9216 + srow * 136 + sch * 16); vp[0] = (u32x2){v[0], v[1]}; vp[1] = (u32x2){v[2], v[3]}; }
    }
};
struct LoadWinF32 {
    const float* cw; const float* nw; f32x4 k0, k1, v0, v1;
    static constexpr int DEPTH = 1;
    __device__ __forceinline__ void load(int n, int) {
        const int tid = threadIdx.x, srow = tid >> 3, sch = tid & 7;
        const int j = 64 * n + srow;
        const float* r = j < 512 ? cw + (size_t)j * 256 : nw + (size_t)(j - 512 < 8 ? j - 512 : 7) * 256;
        k0 = *(const f32x4*)(r + sch * 8); k1 = *(const f32x4*)(r + sch * 8 + 4);
        v0 = *(const f32x4*)(r + 128 + sch * 8); v1 = *(const f32x4*)(r + 128 + sch * 8 + 4);
    }
    __device__ __forceinline__ void store(LAS unsigned char* buf, int) const {
        const int tid = threadIdx.x, srow = tid >> 3, sch = tid & 7;
        u32x4_t kw; kw[0] = pk2(k0[0], k0[1]); kw[1] = pk2(k0[2], k0[3]); kw[2] = pk2(k1[0], k1[1]); kw[3] = pk2(k1[2], k1[3]);
        *(LAS u32x4_t*)(buf + srow * 144 + sch * 16) = kw;
        LAS bf16_t* vb = (LAS bf16_t*)(buf + 9216) + (sch * 8) * 68 + srow;
#pragma unroll
        for (int e = 0; e < 4; ++e) { vb[e * 68] = f2bf(v0[e]); vb[(4 + e) * 68] = f2bf(v1[e]); }
    }
};

template <class LOADER, class NEXT, class ACTIVE, class BODY>
__device__ __forceinline__ void block_loop_g(LOADER ld, LAS unsigned char* kv, int first, NEXT next, ACTIVE active, BODY body) {
    if (first < 0) return;
    int n = first, cur = 0;
    if (LOADER::DEPTH == 2) {
        int nn = next(n), k = 0;
        ld.load(n, 0); ld.store(kv, 0);
        if (nn >= 0) ld.load(nn, 1);
        __syncthreads();
#pragma unroll 1
        for (;;) {
            const int nnn = nn >= 0 ? next(nn) : -1;
            if (nnn >= 0) ld.load(nnn, k & 1);
            if (active(n)) body(n, (LAS const bf16_t*)(kv + cur * KV_BUF), (LAS const bf16_t*)(kv + cur * KV_BUF + 9216));
            if (nn >= 0) ld.store(kv + (cur ^ 1) * KV_BUF, (k + 1) & 1);
            __syncthreads();
            if (nn < 0) break;
            cur ^= 1; n = nn; nn = nnn; ++k;
        }
    } else {
        ld.load(n, 0);
        ld.store(kv, 0);
        __syncthreads();
#pragma unroll 1
        for (;;) {
            const int nn = next(n);
            if (nn >= 0) ld.load(nn, 0);
            if (active(n)) body(n, (LAS const bf16_t*)(kv + cur * KV_BUF), (LAS const bf16_t*)(kv + cur * KV_BUF + 9216));
            if (nn >= 0) ld.store(kv + (cur ^ 1) * KV_BUF, 0);
            __syncthreads();
            if (nn < 0) break;
            cur ^= 1; n = nn;
        }
    }
}
template <bool WITH_V, class NEXT, class ACTIVE, class BODY>
__device__ __forceinline__ void block_loop(const bf16_t* kbase, const bf16_t* vbase, int ld, LAS unsigned char* kv, int first, NEXT next, ACTIVE active, BODY body) {
    LoadBf16 L; L.kbase = kbase; L.vbase = vbase; L.ld = ld; L.with_v = WITH_V;
    block_loop_g(L, kv, first, next, active, body);
}
__device__ __forceinline__ bf16x8 lds_kfrag(LAS const bf16_t* kb, int kt, int ks, int col, int hb) { return *(LAS const bf16x8*)(kb + (32 * kt + col) * 72 + 16 * ks + 8 * hb); }
__device__ __forceinline__ bf16x8 lds_vfrag(LAS const bf16_t* vb, int kt, int dt, int s2, int col, int hb) {
    LAS const bf16_t* ptr = vb + (32 * dt + col) * 68 + 32 * kt + 16 * s2 + 4 * hb;
    union { u32x4_t u; bf16x8 v; } x; const u32x2 a = *(LAS const u32x2*)ptr, c = *(LAS const u32x2*)(ptr + 8); x.u[0] = a[0]; x.u[1] = a[1]; x.u[2] = c[0]; x.u[3] = c[1]; return x.v;
}
__device__ __forceinline__ f32x16 lds_qk(const bf16x8 (&qf)[4], LAS const bf16_t* kb, int kt, int col, int hb) {
    f32x16 s = zero16();
#pragma unroll
    for (int ks = 0; ks < 4; ++ks) s = mfma32(lds_kfrag(kb, kt, ks, col, hb), qf[ks], s);
    return s;
}

__device__ __forceinline__ void attn_prompt_block(const P& p, int bg, int j, LAS unsigned char* lds) {
    int tid_l = threadIdx.x; asm volatile("" : "+v"(tid_l));
    const int tid = tid_l, lane = tid & 63, wid = __builtin_amdgcn_readfirstlane(tid >> 6);
    const int b = bg >> 1, g = bg & 1;
    const int col = lane & 31, hb = lane >> 5, tl = col >> 2, hh = col & 3;
    const int t0 = 64 * j + 8 * wid, qpos = t0 + tl, qrow = b * SEQ + qpos, head = g * 4 + hh;
    LAS unsigned char* wl = lds + wid * WL_STRIDE;
    LAS unsigned char* kv = lds + KV_OFF;
    LAS float* psum = (LAS float*)wl;
    LAS unsigned long long* msk = (LAS unsigned long long*)(wl + 8192);
    bf16x8 qf[4];
#pragma unroll
    for (int ks = 0; ks < 4; ++ks) qf[ks] = *(const bf16x8*)(p.qb() + (size_t)qrow * 512 + head * 64 + 16 * ks + 8 * hb);
    const float g0 = p.gates()[(size_t)qrow * 32 + head * 3 + 0], g1 = p.gates()[(size_t)qrow * 32 + head * 3 + 1], g2 = p.gates()[(size_t)qrow * 32 + head * 3 + 2];
    f32x16 oc[2]; oc[0] = zero16(); oc[1] = zero16();
    {
        const int cmb = 64 * j + 63 - 31;
        const int nbc = ((cmb >> 4) >> 6) + 1;
        const int cmw = t0 + 7 - 31;
        const int cmaxw = cmw >= 0 ? (cmw >> 4) : -1;
        const bf16_t* kc = p.kc_p() + (size_t)bg * 256 * 64;
        const bf16_t* vc = p.vcT_p() + (size_t)bg * 64 * 256;
        float m = -1e30f, l = 0.f;
        block_loop<false>(kc, vc, 256, kv, 0, [&](int n) { return n + 1 < nbc ? n + 1 : -1; }, [&](int n) { return cmaxw >= 64 * n; },
            [&](int n, LAS const bf16_t* kb, LAS const bf16_t* vb) {
#pragma unroll 1
                for (int kt = 0; kt < 2; ++kt) {
                    const f32x16 s = lds_qk(qf, kb, kt, col, hb);
                    sm_stats(s, hb, [&](int kl) { return 16 * (64 * n + 32 * kt + kl) + 31 <= qpos; }, m, l);
                }
            });
        l += __shfl_xor(l, 32);
        const float inv = l > 0.f ? 1.0f / l : 0.f;
#pragma unroll
        for (int i = 0; i < 32; ++i) psum[i * 64 + lane] = 0.f;
        WAVE_SYNC();
        block_loop<true>(kc, vc, 256, kv, 0, [&](int n) { return n + 1 < nbc ? n + 1 : -1; }, [&](int n) { return cmaxw >= 64 * n; },
            [&](int n, LAS const bf16_t* kb, LAS const bf16_t* vb) {
#pragma unroll 1
                for (int kt = 0; kt < 2; ++kt) {
                    const f32x16 s = lds_qk(qf, kb, kt, col, hb);
                    cmp_pass2(s, hb, [&](int kl) { return 16 * (64 * n + 32 * kt + kl) + 31 <= qpos; }, [&](int dt, int s2) { return lds_vfrag(vb, kt, dt, s2, col, hb); }, m, inv, oc,
                              psum + tl * 256 + 64 * n + 32 * kt, hh == 0);
                }
            });
    }
    WAVE_SYNC();
    unsigned long long umw = 0;
    for (int t2 = 0; t2 < 8; ++t2) {
        const int t = t0 + t2, cur = t >> 6, n = lane;
        float imp = 0.f;
#pragma unroll
        for (int c = -1; c < 4; ++c) { const int cc = 4 * n + c; if (cc >= 0) imp += psum[t2 * 256 + cc]; }
        if (n == 0 || n == cur || n == cur - 1) imp = 1e4f;
        if (n * 64 > t) imp = -1.0f;
        int rank = 0;
#pragma unroll
        for (int jj = 0; jj < 64; ++jj) {
            const float vj = __uint_as_float(__builtin_amdgcn_readlane(__float_as_uint(imp), jj));
            rank += (vj > imp || (vj == imp && jj < n)) ? 1 : 0;
        }
        const unsigned long long mk = __ballot(rank < 16);
        if (lane == 0) msk[t2] = mk;
        umw |= mk;
    }
    if (lane == 0) msk[8] = umw;
    __syncthreads();
    const unsigned long long mymask = msk[tl];
    unsigned long long umb = 0;
#pragma unroll
    for (int w2 = 0; w2 < 8; ++w2) umb |= *(LAS const unsigned long long*)(lds + w2 * WL_STRIDE + 8192 + 64);
    {
        const unsigned lo = __builtin_amdgcn_readfirstlane((unsigned)umb), hi = __builtin_amdgcn_readfirstlane((unsigned)(umb >> 32));
        umb = ((unsigned long long)hi << 32) | lo;
        if (j < 63) umb &= (2ull << j) - 1ull;
    }
    LAS float* ost = (LAS float*)wl;
    of_put(ost, lane, oc, g0);
    {
        const bf16_t* kbs = p.kb() + (size_t)((1 * NB + b) * 2 + g) * SEQ * 64;
        const bf16_t* vbs = p.vT() + (size_t)((0 * NB + b) * 2 + g) * 64 * SEQ;
        float m = -1e30f, l = 0.f; f32x16 o[2]; o[0] = zero16(); o[1] = zero16();
        block_loop<true>(kbs, vbs, SEQ, kv, umb ? (int)__builtin_ctzll(umb) : -1,
            [&](int n) { if (n >= 63) return -1; const unsigned long long rem = umb >> (n + 1); return rem ? n + 1 + (int)__builtin_ctzll(rem) : -1; },
            [&](int n) { return (bool)((umw >> n) & 1ull); },
            [&](int n, LAS const bf16_t* kb, LAS const bf16_t* vb) {
                const bool bsel = (mymask >> n) & 1ull;
#pragma unroll
                for (int kt = 0; kt < 2; ++kt) {
                    const int tok0 = 64 * n + 32 * kt;
                    const f32x16 s = lds_qk(qf, kb, kt, col, hb);
                    if (n < j) sm_pv_nomask(s, bsel, [&](int dt, int s2) { return lds_vfrag(vb, kt, dt, s2, col, hb); }, m, l, o);
                    else sm_pv(s, hb, [&](int kl) { return bsel && (tok0 + kl <= qpos); }, [&](int dt, int s2) { return lds_vfrag(vb, kt, dt, s2, col, hb); }, m, l, o);
                }
            });
        l += __shfl_xor(l, 32);
        const float sc = l > 0.f ? g1 / l : 0.f;
        of_add(ost, lane, o, sc);
    }
    {
        const bf16_t* kbw = p.kb() + (size_t)((2 * NB + b) * 2 + g) * SEQ * 64;
        const bf16_t* vbw = p.vT() + (size_t)((1 * NB + b) * 2 + g) * 64 * SEQ;
        float m = -1e30f, l = 0.f; f32x16 o[2]; o[0] = zero16(); o[1] = zero16();
        block_loop<true>(kbw, vbw, SEQ, kv, j > 8 ? j - 8 : 0, [&](int n) { return n < j ? n + 1 : -1; }, [&](int n) { return true; },
            [&](int n, LAS const bf16_t* kb, LAS const bf16_t* vb) {
#pragma unroll 1
                for (int kt = 0; kt < 2; ++kt) {
                    const int tok0 = 64 * n + 32 * kt;
                    const f32x16 s = lds_qk(qf, kb, kt, col, hb);
                    if (n < j && n > j - 8) sm_pv_nomask(s, true, [&](int dt, int s2) { return lds_vfrag(vb, kt, dt, s2, col, hb); }, m, l, o);
                    else sm_pv(s, hb, [&](int kl) { const int key = tok0 + kl; return key <= qpos && key + 511 >= qpos; }, [&](int dt, int s2) { return lds_vfrag(vb, kt, dt, s2, col, hb); }, m, l, o);
                }
            });
        l += __shfl_xor(l, 32);
        const float sc = l > 0.f ? g2 / l : 0.f;
        f32x16 of[2];
        of_get_add(ost, lane, o, sc, of);
        attn_store(p, of, qrow, head, hb, true);
    }
    __syncthreads();
}

__device__ __forceinline__ void attn_sample_block(const P& p, int bg, LAS unsigned char* lds) {
    int tid_l = threadIdx.x; asm volatile("" : "+v"(tid_l));
    const int tid = tid_l, lane = tid & 63, wid = __builtin_amdgcn_readfirstlane(tid >> 6);
    const int b = bg >> 1, g = bg & 1, t = wid;
    const int col = lane & 31, hb = lane >> 5, hh = col & 3;
    const int qrow = NP + b * 8 + t, head = g * 4 + hh;
    LAS unsigned char* wl = lds + wid * WL_STRIDE;
    LAS unsigned char* kv = lds + KV_OFF;
    bf16x8 qf[4];
#pragma unroll
    for (int ks = 0; ks < 4; ++ks) qf[ks] = *(const bf16x8*)(p.qb() + (size_t)qrow * 512 + head * 64 + 16 * ks + 8 * hb);
    LAS float* psum = (LAS float*)wl;
    LAS int* list = (LAS int*)(wl + 8256);
    LAS float* impl = (LAS float*)(wl + 8448);
    LAS bf16_t* vt = (LAS bf16_t*)(wl + 9728);
    const float g0 = p.gates()[(size_t)qrow * 32 + head * 3 + 0], g1 = p.gates()[(size_t)qrow * 32 + head * 3 + 1], g2 = p.gates()[(size_t)qrow * 32 + head * 3 + 2];
    f32x16 oc[2]; oc[0] = zero16(); oc[1] = zero16();
    {
        const bf16_t* kc = p.kc_s() + (size_t)bg * 1024 * 64;
        const bf16_t* vc = p.vcT_s() + (size_t)bg * 64 * 1024;
        float m = -1e30f, l = 0.f;
        block_loop<false>(kc, vc, 1024, kv, 0, [&](int n) { return n < 15 ? n + 1 : -1; }, [&](int n) { return true; },
            [&](int n, LAS const bf16_t* kb, LAS const bf16_t* vb) {
#pragma unroll 1
                for (int kt = 0; kt < 2; ++kt) {
                    const f32x16 s = lds_qk(qf, kb, kt, col, hb);
                    sm_stats(s, hb, [&](int kl) { return 64 * n + 32 * kt + kl <= 1022; }, m, l);
                }
            });
        l += __shfl_xor(l, 32);
        const float inv = l > 0.f ? 1.0f / l : 0.f;
        block_loop<true>(kc, vc, 1024, kv, 0, [&](int n) { return n < 15 ? n + 1 : -1; }, [&](int n) { return true; },
            [&](int n, LAS const bf16_t* kb, LAS const bf16_t* vb) {
#pragma unroll 1
                for (int kt = 0; kt < 2; ++kt) {
                    const f32x16 s = lds_qk(qf, kb, kt, col, hb);
                    cmp_pass2(s, hb, [&](int kl) { return 64 * n + 32 * kt + kl <= 1022; }, [&](int dt, int s2) { return lds_vfrag(vb, kt, dt, s2, col, hb); }, m, inv, oc,
                              psum + 64 * n + 32 * kt, col == 0);
                }
            });
    }
    WAVE_SYNC();
#pragma unroll
    for (int j = 0; j < 5; ++j) {
        const int n = lane + 64 * j;
        if (n <= 256) {
            float imp = 0.f;
            for (int c = -1; c < 4; ++c) { const int cc = 4 * n + c; if (cc >= 0 && cc <= 1022) imp += psum[cc]; }
            impl[n] = imp;
        }
    }
    WAVE_SYNC();
    {
        int base = 0;
#pragma unroll
        for (int j = 0; j < 4; ++j) {
            const int n = lane + 64 * j;
            const bool cand = n >= 1 && n <= 254;
            const float v = impl[n];
            int rank = 0;
            for (int q = 1; q <= 254; ++q) { const float vq = impl[q]; rank += (vq > v || (vq == v && q < n)) ? 1 : 0; }
            const bool sel = cand && rank < 13;
            const unsigned long long mk = __ballot(sel);
            if (sel) list[base + __popcll(mk & ((1ull << lane) - 1ull))] = n;
            base += __popcll(mk);
        }
        if (lane == 0) { list[13] = 0; list[14] = 255; list[15] = 256; }
    }
    WAVE_SYNC();
    if (lane < 16) {
        const int n = list[lane];
        list[16 + lane] = n < 256 ? p.page_table[b * 128 + (n >> 1)] * 128 + (n & 1) * 64 : -1;
    }
    WAVE_SYNC();
    LAS float* ost = (LAS float*)wl;
    of_put(ost, lane, oc, g0);
    {
        float m = -1e30f, l = 0.f; f32x16 o[2]; o[0] = zero16(); o[1] = zero16();
        const float* newrows = p.out + O_SEL_S + (size_t)(b * 8) * 256 + g * 64;
        auto rowptr = [&](int u) -> const float* {
            const int rb = __builtin_amdgcn_readfirstlane(list[16 + (u >> 1)]);
            return rb >= 0 ? p.cache_sel + ((size_t)rb + 32 * (u & 1) + col) * 256 + g * 64 : newrows + (size_t)(col < 8 ? col : 7) * 256;
        };
        f32x4 kA[4], kB[4];
        { const float* kr = rowptr(0) + 8 * hb;
#pragma unroll
          for (int ks = 0; ks < 4; ++ks) { kA[ks] = *(const f32x4*)(kr + 16 * ks); kB[ks] = *(const f32x4*)(kr + 16 * ks + 4); } }
#pragma unroll 1
        for (int u = 0; u < 31; ++u) {
            const bool isnew = __builtin_amdgcn_readfirstlane(list[16 + (u >> 1)]) < 0;
            const float* vr = rowptr(u) + 128 + 32 * hb;
            f32x4 vv[8];
#pragma unroll
            for (int j4 = 0; j4 < 8; ++j4) vv[j4] = *(const f32x4*)(vr + 4 * j4);
            f32x16 s = zero16();
#pragma unroll
            for (int ks = 0; ks < 4; ++ks) s = mfma32(pack8(kA[ks][0], kA[ks][1], kA[ks][2], kA[ks][3], kB[ks][0], kB[ks][1], kB[ks][2], kB[ks][3]), qf[ks], s);
            if (u + 1 < 31) { const float* kr = rowptr(u + 1) + 8 * hb;
#pragma unroll
                for (int ks = 0; ks < 4; ++ks) { kA[ks] = *(const f32x4*)(kr + 16 * ks); kB[ks] = *(const f32x4*)(kr + 16 * ks + 4); } }
#pragma unroll
            for (int j4 = 0; j4 < 8; ++j4)
#pragma unroll
                for (int e = 0; e < 4; ++e) vt[(32 * hb + 4 * j4 + e) * 40 + col] = f2bf(vv[j4][e]);
            WAVE_SYNC();
            sm_pv(s, hb, [&](int kl) { return !isnew || kl <= t; }, [&](int dt, int s2) {
                LAS const bf16_t* ptr = vt + (32 * dt + col) * 40 + 16 * s2 + 4 * hb;
                union { u32x4_t u4; bf16x8 v; } x; const u32x2 a = *(LAS const u32x2*)ptr, c = *(LAS const u32x2*)(ptr + 8); x.u4[0] = a[0]; x.u4[1] = a[1]; x.u4[2] = c[0]; x.u4[3] = c[1]; return x.v; }, m, l, o);
            WAVE_SYNC();
        }
        l += __shfl_xor(l, 32);
        const float sc = l > 0.f ? g1 / l : 0.f;
        of_add(ost, lane, o, sc);
    }
    {
        float m = -1e30f, l = 0.f; f32x16 o[2]; o[0] = zero16(); o[1] = zero16();
        LoadWinF32 L; L.cw = p.cache_win + (size_t)b * 512 * 256 + g * 64; L.nw = p.out + O_WIN_S + ((size_t)b * 512 + 504) * 256 + g * 64;
        block_loop_g(L, kv, 0, [&](int n) { return n < 8 ? n + 1 : -1; }, [&](int n) { return true; },
            [&](int n, LAS const bf16_t* kb, LAS const bf16_t* vb) {
#pragma unroll 1
                for (int kt = 0; kt < 2; ++kt) {
                    const int j0 = 64 * n + 32 * kt;
                    if (j0 >= 520) break;
                    const f32x16 s = lds_qk(qf, kb, kt, col, hb);
                    sm_pv(s, hb, [&](int kl) { const int j = j0 + kl; return j >= t + 1 && j <= 512 + t; }, [&](int dt, int s2) { return lds_vfrag(vb, kt, dt, s2, col, hb); }, m, l, o);
                }
            });
        l += __shfl_xor(l, 32);
        const float sc = l > 0.f ? g2 / l : 0.f;
        f32x16 of[2];
        of_get_add(ost, lane, o, sc, of);
        attn_store(p, of, qrow, head, hb, col < 4);
    }
    __syncthreads();
}

__device__ __forceinline__ void ph_attn(const P& p, LAS unsigned char* lds, int qsel = 0) {
    const int tid = threadIdx.x, lane = tid & 63, wid = tid >> 6;
    unsigned* ctr = p.bar() + 3584 + 64 * qsel;
    LAS unsigned* qslot = (LAS unsigned*)(lds + XB_OFF + 64);
    for (;;) {
        if (tid == 0) *qslot = __hip_atomic_fetch_add(ctr, 1u, __ATOMIC_RELAXED, __HIP_MEMORY_SCOPE_AGENT);
        __syncthreads();
        const unsigned q = __builtin_amdgcn_readfirstlane(*qslot);
        __syncthreads();
        if (q >= 64u + 512u) break;
        if (q < 64u) attn_sample_block(p, (int)q, lds);
        else { const int idx = (int)q - 64; attn_prompt_block(p, idx & 7, 63 - (idx >> 3), lds);
        }
    }
}


constexpr int LDS_BYTES = pg8::STAGE_BYTES;

constexpr int FUSED_LDS = XB_OFF + 256;

template <class Epi> __device__ __forceinline__ void run_gemm(LAS unsigned char* lds, const bf16_t* A, const bf16_t* Bt, int M, int N, int K, const Epi& E, int slot = -1) {
    pg8::Gemm g; g.A = A; g.Bt = Bt; g.M = M; g.N = N; g.K = K; g.pad_ = 0;
    pg8::StaticOrder S; S.init(M, N, (int)gridDim.x, slot >= 0 ? slot : (int)blockIdx.x);
    pg8::gemm_phase<Epi, pg8::StaticOrder, false>((PG8_LAS unsigned char*)lds, g, S, E, nullptr);
}

#define XBAR() xcd_barrier(bar)
__global__ __launch_bounds__(512, 2) void k_fused(P p) {
    extern __shared__ __attribute__((aligned(16))) unsigned char shm[];
    LAS unsigned char* lds = (LAS unsigned char*)shm;
    LAS unsigned* xb = (LAS unsigned*)(lds + XB_OFF);
    if (threadIdx.x == 0) { xb[0] = 0u; xb[1] = 0u; xb[2] = 0u; xb[3] = 0u; }
    __syncthreads();
    XcdBarrier bar = xcd_barrier_post(p.bar(), (volatile LAS unsigned*)xb);
    ph_prep(p);
    XBAR();
    ph_inproj_sample(p);
    { EpiIn e; e.p = p; e.row0 = 0; e.pn0 = 0; run_gemm(lds, p.hb(), p.WinT(), NP, NPAD, DM, e); }
    ph_cmp_gemm_f32(p, lds);
    XBAR();
    if ((int)blockIdx.x < 16) {
        const int kvi = blockIdx.x >> 3, bg = blockIdx.x & 7;
        EpiPlainBf e; e.C = p.LHp() + ((size_t)kvi * 2048 + (size_t)bg * 256) * 256; e.ldc = 256; e.pad_ = 0;
        run_gemm(lds, (kvi ? p.vcr() : p.kb()) + (size_t)bg * 256 * 1024, p.W1T() + (size_t)kvi * 256 * 1024, 256, 256, 1024, e, 0);
        __builtin_amdgcn_fence(__ATOMIC_RELEASE, "agent");
        asm volatile("s_waitcnt vmcnt(0)" ::: "memory");
        __syncthreads();
        __builtin_amdgcn_fence(__ATOMIC_ACQUIRE, "agent");
        asm volatile("s_waitcnt vmcnt(0)" ::: "memory");
        compress2_tile(p, p.LHp(), 8, 256, 255, p.kc_p(), p.vcT_p(), kvi, bg, threadIdx.x >> 6, threadIdx.x & 63, lds + (threadIdx.x >> 6) * 8960);
    }
    ph_rwkv_prep(p);
    ph_compress2(p, p.LHs(), 64, 1024, 1023, p.kc_s(), p.vcT_s(), lds);
    XBAR();
    ph_rwkv_scan(p, (LAS float*)lds);
    __syncthreads();
    ph_attn(p, lds);
    XBAR();
    ph_rwkv_post(p);
    { EpiYa e; e.p = p; small_gemm(p.oa(), p.WpaT(), 512, e); run_gemm(lds, p.oa(), p.WpaT(), NP, DM, 512, e); }
    XBAR();
    { EpiYb e; e.p = p; small_gemm(p.ob(), p.WpbT(), 512, e); run_gemm(lds, p.ob(), p.WpbT(), NP, DM, 512, e); }
    XBAR();
    { EpiOut e; e.p = p; small_gemm(p.mb(), p.WoutT(), DM, e); run_gemm(lds, p.mb(), p.WoutT(), NP, DM, DM, e); }
    { EpiPlain e; e.C = p.pp(); e.ldc = DM; e.pad_ = 0; small_gemm(p.pb(), p.WprojT(), 256, e); run_gemm(lds, p.pb(), p.WprojT(), NP, DM, 256, e); }
    XBAR();
    { EpiGate e; e.p = p; small_gemm(p.xg(), p.WgateT(), DM, e); run_gemm(lds, p.xg(), p.WgateT(), NP, DM, DM, e); }
    XBAR();
    ph_final(p);
}
extern "C" void kernel_launch(void* const* d_in, const int* in_sizes, int n_in, void* d_out, int out_size, void* d_ws, size_t ws_size, hipStream_t stream) {
    (void)in_sizes; (void)n_in; (void)out_size; (void)ws_size;
    P p{};
    p.x_prompt = (const float*)d_in[0]; p.x_sample = (const float*)d_in[1]; p.p_prompt = (const float*)d_in[2]; p.p_sample = (const float*)d_in[3];
    p.cache_cmp = (const float*)d_in[4]; p.cache_sel = (const float*)d_in[5]; p.cache_win = (const float*)d_in[6]; p.state_wkv = (const float*)d_in[7];
    p.state_shift = (const float*)d_in[8]; p.page_table = (const int*)d_in[9]; p.norm_g = (const float*)d_in[10]; p.w_in = (const float*)d_in[11];
    p.cmp_pe = (const float*)d_in[12]; p.cmp_w1 = (const float*)d_in[13]; p.cmp_b1 = (const float*)d_in[14]; p.cmp_w2 = (const float*)d_in[15]; p.cmp_b2 = (const float*)d_in[16];
    p.w_pa = (const float*)d_in[17]; p.mu = (const float*)d_in[18]; p.w0 = (const float*)d_in[19]; p.w_up = (const float*)d_in[20]; p.a0 = (const float*)d_in[21];
    p.a_up = (const float*)d_in[22]; p.k_k = (const float*)d_in[23]; p.k_a = (const float*)d_in[24]; p.r_k = (const float*)d_in[25]; p.gn_g = (const float*)d_in[26];
    p.gn_b = (const float*)d_in[27]; p.w_pb = (const float*)d_in[28]; p.w_out = (const float*)d_in[29]; p.ple_g = (const float*)d_in[30]; p.w_gate = (const float*)d_in[31];
    p.w_proj = (const float*)d_in[32]; p.final_g = (const float*)d_in[33];
    p.out = (float*)d_out;
    p.ws = (unsigned char*)d_ws;

    static int grid = 0;
    if (!grid) {
        int dev = 0, cus = 0, per_cu = 0;
        (void)hipGetDevice(&dev);
        (void)hipDeviceGetAttribute(&cus, hipDeviceAttributeMultiprocessorCount, dev);
        (void)hipFuncSetAttribute((const void*)k_fused, hipFuncAttributeMaxDynamicSharedMemorySize, FUSED_LDS);
        (void)hipOccupancyMaxActiveBlocksPerMultiprocessor(&per_cu, k_fused, 512, FUSED_LDS);
        grid = per_cu >= 1 ? cus : 0;
        if (grid > 256) grid = 256;
    }
    (void)hipMemsetAsync(p.bar(), 0, 32768, stream);
    if (grid > 0) hipLaunchKernelGGL(k_fused, dim3(grid), dim3(512), FUSED_LDS, stream, p);
}
```

```cpp
#include <hip/hip_runtime.h>
#include <stdint.h>
#include <stdio.h>
namespace pg8 {
#define PG8_LAS __attribute__((address_space(3)))
typedef unsigned short bf16_t;
typedef short bf16x8 __attribute__((ext_vector_type(8)));
typedef float f32x4 __attribute__((ext_vector_type(4)));
typedef unsigned u32x4 __attribute__((ext_vector_type(4)));
constexpr int BM = 256, BK = 64, HALF = 128, HTB = HALF * BK * 2  , STAGE_BYTES = 8 * HTB, NXCD = 8, WGM = 8;

__host__ __device__ __forceinline__ int lds_byte(int r, int c) { const int st = (r >> 4) * 2 + (c >> 5), rr = r & 15, cc = c & 31, ob = rr * 64 + cc * 2; return st * 1024 + (ob ^ (((ob >> 9) & 1) << 5)); }
__host__ __device__ __forceinline__ void stage_rc(int b, int& R, int& C) { const int st = b / 1024, sb = b % 1024, swz = sb ^ (((sb >> 9) & 1) << 5); R = (st >> 1) * 16 + swz / 64; C = (st & 1) * 32 + (swz % 64) / 2; }
__host__ __device__ __forceinline__ int perm32(int rho) { const int n = rho >> 4, i = rho & 15; return 8 * (i >> 2) + 4 * n + (i & 3); }

struct Unit { int pm, pn; };
struct Gemm { const bf16_t* A; const bf16_t* Bt; int M, N, K, pad_; };

struct StaticOrder {
    int nM, nN, nwg, G, c;
    __host__ __device__ void init(int M, int N, int G_, int c_) { nM = M / BM; nN = N / BM; nwg = nM * nN; G = G_; c = c_; }
    __host__ __device__ bool next(int i, Unit& u) const {
        const long L = (long)i * G + c; if (L >= nwg) return false;
        int wgid = (int)L; { const int q = nwg / NXCD, r = nwg % NXCD, xcd = wgid % NXCD, off = wgid / NXCD; wgid = (xcd < r ? xcd * (q + 1) : r * (q + 1) + (xcd - r) * q) + off; }
        const int nig = WGM * nN, gid = wgid / nig, fm = gid * WGM, gsz = (nM - fm) < WGM ? (nM - fm) : WGM;
        u.pm = fm + ((wgid % nig) % gsz); u.pn = (wgid % nig) / gsz; return true;
    }
    __device__ __forceinline__ void a_ready(const Unit&) const {}
    __device__ __forceinline__ void done(const Unit&) const {}
};
__device__ __forceinline__ unsigned cvt_pk_bf16(float lo, float hi) { unsigned r; asm volatile("v_cvt_pk_bf16_f32 %0, %1, %2" : "=v"(r) : "v"(lo), "v"(hi)); return r; }
typedef float f32x2 __attribute__((ext_vector_type(2)));
template <class Epi, class Sched, bool STAMP = false>
__device__ __forceinline__ void gemm_phase(PG8_LAS unsigned char* lds, const Gemm g, const Sched& S, const Epi& E, unsigned long long* stamps) {
    int tid_l = threadIdx.x; asm volatile("" : "+v"(tid_l));
    const int tid = tid_l, wid = __builtin_amdgcn_readfirstlane(tid >> 6), lane = tid & 63, wr = wid >> 2, wc = wid & 3, fr = lane & 15, fq = lane >> 4;
    const int K = g.K, nt = K / BK;
    int ts_lo = 0, ts_hi = 0, nts = 0; const unsigned long long rt_entry = STAMP ? (unsigned long long)wall_clock64() : 0ull;
#define PG8_STAMP() do { if (STAMP && wid == 0 && nts < 64) { const unsigned long long _c = (unsigned long long)clock64(); \
        ts_lo = (lane == nts) ? (int)(unsigned)_c : ts_lo; ts_hi = (lane == nts) ? (int)(unsigned)(_c >> 32) : ts_hi; ++nts; } } while (0)
    PG8_STAMP();
    unsigned voffA[2], voffB[2];
#pragma unroll
    for (int i = 0; i < 2; ++i) { int R, C; stage_rc(tid * 16 + i * 8192, R, C); const int Rb = Epi::PERM ? ((R & ~31) + perm32(R & 31)) : R;
        voffA[i] = (unsigned)(R * K + C) * 2u; voffB[i] = (unsigned)(Rb * K + C) * 2u; }
    const size_t kstep = (size_t)(BK * 2);
    const size_t hstep = (size_t)HALF * K * 2;
    const size_t tstep = 2 * hstep;
    const unsigned ldsw = (unsigned)wid * 1024u;
    const int aoff = lds_byte(wr * 64 + fr, fq * 8), boff = lds_byte(wc * 32 + fr, fq * 8);
#define PG8_SA(b, h) (((b) * 2 + (h)) * HTB)
#define PG8_SB(b, h) ((4 + (b) * 2 + (h)) * HTB)
#define PG8_STAGE(bufoff, gbase, voff) do { _Pragma("unroll") for (int _i = 0; _i < 2; ++_i) \
        __builtin_amdgcn_global_load_lds((const unsigned*)((const char*)(gbase) + (voff)[_i]), (PG8_LAS unsigned*)(lds + (bufoff) + ldsw + _i * 8192), 16, 0, 0); } while (0)
#define PG8_LDA(dst, b, h) do { _Pragma("unroll") for (int m = 0; m < 4; ++m) _Pragma("unroll") for (int k = 0; k < 2; ++k) dst[m][k] = *(const PG8_LAS bf16x8*)(lds + PG8_SA(b, h) + aoff + m * 2048 + k * 1024); } while (0)
#define PG8_LDB(dst, b, h) do { _Pragma("unroll") for (int n = 0; n < 2; ++n) _Pragma("unroll") for (int k = 0; k < 2; ++k) dst[n][k] = *(const PG8_LAS bf16x8*)(lds + PG8_SB(b, h) + boff + n * 2048 + k * 1024); } while (0)
#define PG8_MMA(ai, bj, At, Bt) do { __builtin_amdgcn_s_setprio(1); _Pragma("unroll") for (int m = 0; m < 4; ++m) _Pragma("unroll") for (int n = 0; n < 2; ++n) _Pragma("unroll") for (int k = 0; k < 2; ++k) \
        acc[ai][bj][m][n] = __builtin_amdgcn_mfma_f32_16x16x32_bf16(Bt[n][k], At[m][k], acc[ai][bj][m][n], 0, 0, 0); __builtin_amdgcn_s_setprio(0); } while (0)
#define PG8_WAIT_V(n) asm volatile("s_waitcnt vmcnt(" #n ")" ::: "memory")
#define PG8_WAIT_L(n) asm volatile("s_waitcnt lgkmcnt(" #n ")" ::: "memory")
#define PG8_BAR __builtin_amdgcn_s_barrier()
#define PG8_SCHED __builtin_amdgcn_sched_barrier(0)
    Unit cur, nxt; int ui = 0;
    if (!S.next(0, cur)) return;
    f32x4 acc[2][2][4][2];
#pragma unroll
    for (int a = 0; a < 2; ++a)
#pragma unroll
        for (int b = 0; b < 2; ++b)
#pragma unroll
            for (int m = 0; m < 4; ++m)
#pragma unroll
                for (int n = 0; n < 2; ++n) acc[a][b][m][n] = (f32x4){0.f, 0.f, 0.f, 0.f};
    bf16x8 At[4][2], B0[2][2], B1[2][2];
    const char* cA = (const char*)g.A + (size_t)cur.pm * tstep; const char* cB = (const char*)g.Bt + (size_t)cur.pn * tstep;
    S.a_ready(cur);
    PG8_STAGE(PG8_SB(0, 0), cB, voffB); PG8_STAGE(PG8_SA(0, 0), cA, voffA); PG8_STAGE(PG8_SB(0, 1), cB + hstep, voffB); PG8_STAGE(PG8_SA(0, 1), cA + hstep, voffA);
    if (wr == 1) PG8_BAR;
    PG8_WAIT_V(4); PG8_BAR;
    PG8_STAGE(PG8_SB(1, 0), cB + kstep, voffB); PG8_STAGE(PG8_SA(1, 0), cA + kstep, voffA); PG8_STAGE(PG8_SB(1, 1), cB + hstep + kstep, voffB);
    PG8_WAIT_V(6); PG8_BAR;
    PG8_STAMP();
    for (;;) {
        const bool has_next = S.next(ui + 1, nxt);
        const char* nA = has_next ? (const char*)g.A + (size_t)nxt.pm * tstep : cA; const char* nB = has_next ? (const char*)g.Bt + (size_t)nxt.pn * tstep : cB;
        for (int t = 0; t < nt; t += 2) {
            const bool last = (t == nt - 2);
            const char* a1 = cA + (size_t)(t + 1) * kstep;
            const char* a2 = last ? nA : cA + (size_t)(t + 2) * kstep; const char* b2 = last ? nB : cB + (size_t)(t + 2) * kstep;
            const char* a3 = a2 + kstep; const char* b3 = b2 + kstep;
            if (last && has_next) S.a_ready(nxt);
            PG8_LDB(B0, 0, 0); PG8_SCHED; PG8_LDA(At, 0, 0); PG8_STAGE(PG8_SA(1, 1), a1 + hstep, voffA);
            PG8_WAIT_L(8); PG8_BAR; PG8_WAIT_L(0); PG8_MMA(0, 0, At, B0); PG8_BAR; PG8_SCHED;
            PG8_LDB(B1, 0, 1); PG8_STAGE(PG8_SB(0, 0), b2, voffB);
            PG8_BAR; PG8_WAIT_L(0); PG8_MMA(0, 1, At, B1); PG8_BAR;
            PG8_LDA(At, 0, 1); PG8_STAGE(PG8_SA(0, 0), a2, voffA);
            PG8_BAR; PG8_WAIT_L(0); PG8_MMA(1, 0, At, B0); PG8_BAR; PG8_SCHED;
            PG8_STAGE(PG8_SB(0, 1), b2 + hstep, voffB);
            PG8_WAIT_V(6); PG8_BAR; PG8_MMA(1, 1, At, B1); PG8_BAR;
            PG8_LDB(B0, 1, 0); PG8_SCHED; PG8_LDA(At, 1, 0); PG8_STAGE(PG8_SA(0, 1), a2 + hstep, voffA);
            PG8_WAIT_L(8); PG8_BAR; PG8_WAIT_L(0); PG8_MMA(0, 0, At, B0); PG8_BAR; PG8_SCHED;
            PG8_LDB(B1, 1, 1); PG8_STAGE(PG8_SB(1, 0), b3, voffB);
            PG8_BAR; PG8_WAIT_L(0); PG8_MMA(0, 1, At, B1); PG8_BAR;
            PG8_LDA(At, 1, 1); PG8_STAGE(PG8_SA(1, 0), a3, voffA);
            PG8_BAR; PG8_WAIT_L(0); PG8_MMA(1, 0, At, B0); PG8_BAR; PG8_SCHED;
            PG8_STAGE(PG8_SB(1, 1), b3 + hstep, voffB);
            PG8_WAIT_V(6); PG8_BAR; PG8_MMA(1, 1, At, B1); PG8_BAR;
        }
        PG8_STAMP();
        if constexpr (!Epi::AFTER_DRAIN) { E(acc, cur, wr, wc, fr, fq); S.done(cur); }
        PG8_STAMP();
        if (!has_next) break;
#pragma unroll
        for (int a = 0; a < 2; ++a)
#pragma unroll
            for (int b = 0; b < 2; ++b)
#pragma unroll
                for (int m = 0; m < 4; ++m)
#pragma unroll
                    for (int n = 0; n < 2; ++n) acc[a][b][m][n] = (f32x4){0.f, 0.f, 0.f, 0.f};
        cur = nxt; cA = nA; cB = nB; ++ui;
    }
    PG8_WAIT_V(0);
    if (wr == 0) PG8_BAR;
    PG8_BAR;
    if constexpr (Epi::AFTER_DRAIN) { E.fused(acc, cur, wr, wc, fr, fq, lds, wid, lane); S.done(cur); }
    PG8_STAMP();
    if (STAMP && wid == 0) { stamps[lane] = lane < nts ? (((unsigned long long)(unsigned)ts_hi << 32) | (unsigned)ts_lo) : 0ull;
        if (lane == 62) stamps[62] = rt_entry; if (lane == 63) stamps[63] = (unsigned long long)wall_clock64(); }
#undef PG8_STAMP
#undef PG8_SA
#undef PG8_SB
#undef PG8_STAGE
#undef PG8_LDA
#undef PG8_LDB
#undef PG8_MMA
#undef PG8_WAIT_V
#undef PG8_WAIT_L
#undef PG8_BAR
#undef PG8_SCHED
}
}

typedef unsigned short bf16_t;
typedef short bf16x8 __attribute__((ext_vector_type(8)));
typedef float f32x4 __attribute__((ext_vector_type(4)));
typedef float f32x16 __attribute__((ext_vector_type(16)));
#define LAS __attribute__((address_space(3)))
#define WAVE_SYNC() do { asm volatile("s_waitcnt lgkmcnt(0)" ::: "memory"); __builtin_amdgcn_wave_barrier(); } while (0)

constexpr int DM = 1024, NP = 16384, NSMP = 256, MR = 16640, SEQ = 4096, NB = 4, DB = 32, DS = 8, PAST = 16384;
constexpr int CIN = 6040, NPAD = 6144, CR = 1664;
constexpr int NTHR = 512;
constexpr size_t O_Y_P = 0, O_Y_S = 16777216, O_CMP_P = 17039360, O_CMP_S = 21233664, O_SEL_P = 21299200, O_SEL_S = 25493504,
                 O_WIN_P = 25559040, O_WIN_S = 26083328, O_WKV_P = 30277632, O_WKV_S = 30408704, O_SH_P = 31457280, O_SH_S = 31463936;

constexpr size_t ws_al(size_t x) { return (x + 255) & ~(size_t)255; }
constexpr size_t WS_bar = 0;
constexpr size_t WS_hb = WS_bar + ws_al(32768);
constexpr size_t WS_WinT = WS_hb + ws_al((size_t)MR * DM * 2);
constexpr size_t WS_WpaT = WS_WinT + ws_al((size_t)NPAD * DM * 2);
constexpr size_t WS_WpbT = WS_WpaT + ws_al((size_t)DM * 512 * 2);
constexpr size_t WS_WoutT = WS_WpbT + ws_al((size_t)DM * 512 * 2);
constexpr size_t WS_WgateT = WS_WoutT + ws_al((size_t)DM * DM * 2);
constexpr size_t WS_WprojT = WS_WgateT + ws_al((size_t)DM * DM * 2);
constexpr size_t WS_W1T = WS_WprojT + ws_al((size_t)DM * 256 * 2);
constexpr size_t WS_W2T = WS_W1T + ws_al((size_t)512 * 1024 * 2);
constexpr size_t WS_WupT = WS_W2T + ws_al((size_t)128 * 128 * 2);
constexpr size_t WS_AupT = WS_WupT + ws_al((size_t)512 * 64 * 2);
constexpr size_t WS_pb = WS_AupT + ws_al((size_t)512 * 64 * 2);
constexpr size_t WS_tabc = WS_pb + ws_al((size_t)MR * 256 * 2);
constexpr size_t WS_tabs = WS_tabc + ws_al((size_t)4104 * 32 * 4);
constexpr size_t WS_pt = WS_tabs + ws_al((size_t)4104 * 32 * 4);
constexpr size_t WS_qb = WS_pt + ws_al(256 * 4);
constexpr size_t WS_kb = WS_qb + ws_al((size_t)MR * 512 * 2);
constexpr size_t WS_vcr = WS_kb + ws_al((size_t)3 * NB * 2 * SEQ * 64 * 2);
constexpr size_t WS_vT = WS_vcr + ws_al((size_t)NB * 2 * SEQ * 64 * 2);
constexpr size_t WS_ag = WS_vT + ws_al((size_t)2 * NB * 2 * 64 * SEQ * 2);
constexpr size_t WS_rg = WS_ag + ws_al((size_t)MR * 512 * 2);
constexpr size_t WS_mg = WS_rg + ws_al((size_t)MR * 512 * 2);
constexpr size_t WS_gates = WS_mg + ws_al((size_t)MR * 2048 * 2);
constexpr size_t WS_rz = WS_gates + ws_al((size_t)MR * 32 * 4);
constexpr size_t WS_zs0 = WS_rz + ws_al((size_t)MR * CR * 2);
constexpr size_t WS_LHp = WS_zs0 + ws_al((size_t)33 * CR * 2);
constexpr size_t WS_LHs = WS_LHp + ws_al((size_t)2 * 2048 * 256 * 4);
constexpr size_t WS_cs = WS_LHs + ws_al((size_t)2 * 65536 * 256 * 4);
constexpr size_t WS_kc_p = WS_cs + ws_al((size_t)2 * 65536 * 1024 * 2);
constexpr size_t WS_vcT_p = WS_kc_p + ws_al((size_t)8 * 256 * 64 * 2);
constexpr size_t WS_kc_s = WS_vcT_p + ws_al((size_t)8 * 64 * 256 * 2);
constexpr size_t WS_vcT_s = WS_kc_s + ws_al((size_t)64 * 1024 * 64 * 2);
constexpr size_t WS_rw6 = WS_vcT_s + ws_al((size_t)64 * 64 * 1024 * 2);
constexpr int RW6_STRIDE = 896;
constexpr size_t WS_bonus = WS_rw6 + ws_al((size_t)MR * 8 * RW6_STRIDE);
constexpr size_t WS_ybuf = WS_bonus + ws_al((size_t)MR * 8 * 4);
constexpr size_t WS_oa = WS_ybuf + ws_al((size_t)MR * 512 * 4);
constexpr size_t WS_ob = WS_oa + ws_al((size_t)MR * 512 * 2);
constexpr size_t WS_mb = WS_ob + ws_al((size_t)MR * 512 * 2);
constexpr size_t WS_xg = WS_mb + ws_al((size_t)MR * DM * 2);
constexpr size_t WS_tmp = WS_xg + ws_al((size_t)MR * DM * 2);
constexpr size_t WS_x1 = WS_tmp + ws_al((size_t)MR * DM * 4);
constexpr size_t WS_ss1 = WS_x1 + ws_al((size_t)MR * DM * 4);
constexpr size_t WS_pp = WS_ss1 + ws_al((size_t)MR * 16 * 4);
constexpr size_t WS_TOTAL = WS_pp + ws_al((size_t)MR * DM * 4);

struct P {
    const float *x_prompt, *x_sample, *p_prompt, *p_sample, *cache_cmp, *cache_sel, *cache_win, *state_wkv, *state_shift;
    const int* page_table;
    const float *norm_g, *w_in, *cmp_pe, *cmp_w1, *cmp_b1, *cmp_w2, *cmp_b2, *w_pa, *mu, *w0, *w_up, *a0, *a_up, *k_k, *k_a, *r_k, *gn_g, *gn_b,
        *w_pb, *w_out, *ple_g, *w_gate, *w_proj, *final_g;
    float* out;
    unsigned char* ws;
    __host__ __device__ __forceinline__ unsigned* bar() const { return (unsigned*)(ws + WS_bar); }
    __host__ __device__ __forceinline__ float* ss_s() const { return (float*)(ws + WS_bar + 16384); }
    __host__ __device__ __forceinline__ bf16_t* hb() const { return (bf16_t*)(ws + WS_hb); }
    __host__ __device__ __forceinline__ bf16_t* WinT() const { return (bf16_t*)(ws + WS_WinT); }
    __host__ __device__ __forceinline__ bf16_t* WpaT() const { return (bf16_t*)(ws + WS_WpaT); }
    __host__ __device__ __forceinline__ bf16_t* WpbT() const { return (bf16_t*)(ws + WS_WpbT); }
    __host__ __device__ __forceinline__ bf16_t* WoutT() const { return (bf16_t*)(ws + WS_WoutT); }
    __host__ __device__ __forceinline__ bf16_t* WgateT() const { return (bf16_t*)(ws + WS_WgateT); }
    __host__ __device__ __forceinline__ bf16_t* WprojT() const { return (bf16_t*)(ws + WS_WprojT); }
    __host__ __device__ __forceinline__ bf16_t* W1T() const { return (bf16_t*)(ws + WS_W1T); }
    __host__ __device__ __forceinline__ bf16_t* W2T() const { return (bf16_t*)(ws + WS_W2T); }
    __host__ __device__ __forceinline__ bf16_t* WupT() const { return (bf16_t*)(ws + WS_WupT); }
    __host__ __device__ __forceinline__ bf16_t* AupT() const { return (bf16_t*)(ws + WS_AupT); }
    __host__ __device__ __forceinline__ bf16_t* pb() const { return (bf16_t*)(ws + WS_pb); }
    __host__ __device__ __forceinline__ float* tabc() const { return (float*)(ws + WS_tabc); }
    __host__ __device__ __forceinline__ float* tabs() const { return (float*)(ws + WS_tabs); }
    __host__ __device__ __forceinline__ float* pt() const { return (float*)(ws + WS_pt); }
    __host__ __device__ __forceinline__ bf16_t* qb() const { return (bf16_t*)(ws + WS_qb); }
    __host__ __device__ __forceinline__ bf16_t* kb() const { return (bf16_t*)(ws + WS_kb); }
    __host__ __device__ __forceinline__ bf16_t* vcr() const { return (bf16_t*)(ws + WS_vcr); }
    __host__ __device__ __forceinline__ bf16_t* vT() const { return (bf16_t*)(ws + WS_vT); }
    __host__ __device__ __forceinline__ bf16_t* ag() const { return (bf16_t*)(ws + WS_ag); }
    __host__ __device__ __forceinline__ bf16_t* rg() const { return (bf16_t*)(ws + WS_rg); }
    __host__ __device__ __forceinline__ bf16_t* mg() const { return (bf16_t*)(ws + WS_mg); }
    __host__ __device__ __forceinline__ float* gates() const { return (float*)(ws + WS_gates); }
    __host__ __device__ __forceinline__ bf16_t* rz() const { return (bf16_t*)(ws + WS_rz); }
    __host__ __device__ __forceinline__ bf16_t* zs0() const { return (bf16_t*)(ws + WS_zs0); }
    __host__ __device__ __forceinline__ bf16_t* LHp() const { return (bf16_t*)(ws + WS_LHp); }
    __host__ __device__ __forceinline__ bf16_t* LHs() const { return (bf16_t*)(ws + WS_LHs); }
    __host__ __device__ __forceinline__ bf16_t* cs() const { return (bf16_t*)(ws + WS_cs); }
    __host__ __device__ __forceinline__ bf16_t* kc_p() const { return (bf16_t*)(ws + WS_kc_p); }
    __host__ __device__ __forceinline__ bf16_t* vcT_p() const { return (bf16_t*)(ws + WS_vcT_p); }
    __host__ __device__ __forceinline__ bf16_t* kc_s() const { return (bf16_t*)(ws + WS_kc_s); }
    __host__ __device__ __forceinline__ bf16_t* vcT_s() const { return (bf16_t*)(ws + WS_vcT_s); }
    __host__ __device__ __forceinline__ unsigned char* rw6() const { return ws + WS_rw6; }
    __host__ __device__ __forceinline__ float* bonus() const { return (float*)(ws + WS_bonus); }
    __host__ __device__ __forceinline__ float* ybuf() const { return (float*)(ws + WS_ybuf); }
    __host__ __device__ __forceinline__ bf16_t* oa() const { return (bf16_t*)(ws + WS_oa); }
    __host__ __device__ __forceinline__ bf16_t* ob() const { return (bf16_t*)(ws + WS_ob); }
    __host__ __device__ __forceinline__ bf16_t* mb() const { return (bf16_t*)(ws + WS_mb); }
    __host__ __device__ __forceinline__ bf16_t* xg() const { return (bf16_t*)(ws + WS_xg); }
    __host__ __device__ __forceinline__ float* tmp() const { return (float*)(ws + WS_tmp); }
    __host__ __device__ __forceinline__ float* x1() const { return (float*)(ws + WS_x1); }
    __host__ __device__ __forceinline__ float* ss1() const { return (float*)(ws + WS_ss1); }
    __host__ __device__ __forceinline__ float* pp() const { return (float*)(ws + WS_pp); }
};


__device__ __forceinline__ float bf2f(bf16_t b) { return __uint_as_float(((unsigned)b) << 16); }
typedef __bf16 bf16v2_t __attribute__((ext_vector_type(2)));
typedef float f32x2_t __attribute__((ext_vector_type(2)));
__device__ __forceinline__ unsigned pk2(float lo, float hi) { const f32x2_t v = {lo, hi}; return __builtin_bit_cast(unsigned, __builtin_convertvector(v, bf16v2_t)); }
__device__ __forceinline__ bf16_t f2bf(float f) { return (bf16_t)(pk2(f, f) & 0xffffu); }
__device__ __forceinline__ float xsum16(float v) { const auto r = __builtin_amdgcn_permlane16_swap(__float_as_uint(v), __float_as_uint(v), false, false); return __uint_as_float(r[0]) + __uint_as_float(r[1]); }
__device__ __forceinline__ float xsum32(float v) { const auto r = __builtin_amdgcn_permlane32_swap(__float_as_uint(v), __float_as_uint(v), false, false); return __uint_as_float(r[0]) + __uint_as_float(r[1]); }
__device__ __forceinline__ float xmax32(float v) { const auto r = __builtin_amdgcn_permlane32_swap(__float_as_uint(v), __float_as_uint(v), false, false); return fmaxf(__uint_as_float(r[0]), __uint_as_float(r[1])); }
__device__ __forceinline__ float quad_sum(float v) {
    v += __builtin_bit_cast(float, __builtin_amdgcn_mov_dpp(__builtin_bit_cast(int, v), 0xB1, 0xF, 0xF, true));
    v += __builtin_bit_cast(float, __builtin_amdgcn_mov_dpp(__builtin_bit_cast(int, v), 0x4E, 0xF, 0xF, true));
    return v;
}
__device__ __forceinline__ float wave_sum(float v) {
    v += __builtin_bit_cast(float, __builtin_amdgcn_mov_dpp(__builtin_bit_cast(int, v), 0xB1, 0xF, 0xF, true));
    v += __builtin_bit_cast(float, __builtin_amdgcn_mov_dpp(__builtin_bit_cast(int, v), 0x4E, 0xF, 0xF, true));
    v += __builtin_bit_cast(float, __builtin_amdgcn_mov_dpp(__builtin_bit_cast(int, v), 0x141, 0xF, 0xF, true));
    v += __builtin_bit_cast(float, __builtin_amdgcn_mov_dpp(__builtin_bit_cast(int, v), 0x140, 0xF, 0xF, true));
    return xsum32(xsum16(v));
}
__device__ __forceinline__ float sigmoidf_(float x) { return 1.0f / (1.0f + __expf(-x)); }
__device__ __forceinline__ float siluf_(float x) { return x / (1.0f + __expf(-x)); }
__device__ __forceinline__ float sigmoid_fast(float x) { return __builtin_amdgcn_rcpf(1.0f + __expf(-x)); }
__device__ __forceinline__ float silu_fast(float x) { return x * __builtin_amdgcn_rcpf(1.0f + __expf(-x)); }

__device__ __forceinline__ int win_src_col(int np) {
    const int pn = np >> 8, p = np & 255;
    if (pn < 5) {
        const int bj = p >> 7, wc = (p >> 5) & 3, n = (p >> 4) & 1, fq = (p >> 2) & 3, e = p & 3;
        const int d = 32 * n + 16 * (wc & 1) + 4 * fq + e;
        if (pn < 2) { const int head = pn * 4 + bj * 2 + (wc >> 1); return head * 64 + d; }
        const int br = pn - 2, g = wc >> 1;
        return 512 + br * 256 + bj * 128 + g * 64 + d;
    }
    const int s = (p & 0xe0) + 8 * ((p >> 2) & 3) + 4 * ((p >> 4) & 1) + (p & 3);
    if (pn < 7) return 1304 + (pn - 5) * 256 + s;
    if (pn < 13) return 1816 + (pn - 7) * 256 + s;
    if (pn == 13) { if (s < 128) return 1816 + 1536 + s; if (s < 152) return 1280 + (s - 128); return -1; }
    if (pn < 16) return 3480 + (pn - 14) * 256 + s;
    return 3992 + (pn - 16) * 256 + s;
}

__device__ __forceinline__ int perm8(int np) { return (np & ~31) + 8 * ((np >> 2) & 3) + 4 * ((np >> 4) & 1) + (np & 3); }
template <class F>
__device__ __forceinline__ void transpose_cvt(bf16_t* dst, int Nd, int K, F f) {
    const int total = Nd * (K >> 3);
    for (int id = blockIdx.x * NTHR + threadIdx.x; id < total; id += gridDim.x * NTHR) {
        const int n = id % Nd, kc = id / Nd;
        float v[8];
#pragma unroll
        for (int j = 0; j < 8; ++j) v[j] = f(n, kc * 8 + j);
        uint4 w; w.x = pk2(v[0], v[1]); w.y = pk2(v[2], v[3]); w.z = pk2(v[4], v[5]); w.w = pk2(v[6], v[7]);
        *(uint4*)(dst + (size_t)n * K + kc * 8) = w;
    }
}

__device__ __forceinline__ void sincos_small(double r, float& s, float& c) {
    const double r2 = r * r;
    double sa = 1.0, ca = 1.0;
    double ts = 1.0, tc = 1.0; sa = 0.0; ca = 0.0;
#pragma unroll
    for (int k = 0; k < 16; ++k) {
        sa += ts; ca += tc;
        ts = -ts * r2 / (double)((2 * k + 2) * (2 * k + 3));
        tc = -tc * r2 / (double)((2 * k + 1) * (2 * k + 2));
    }
    s = (float)(sa * r); c = (float)ca;
}

__device__ __forceinline__ void ph_prep(const P& p) {
    const int tid = threadIdx.x, lane = tid & 63, wid = tid >> 6;
    const int gw = blockIdx.x * 8 + wid, nw = gridDim.x * 8;
    const int gt = blockIdx.x * NTHR + tid, nt = gridDim.x * NTHR;
    for (int row0 = gw; row0 < MR; row0 += 2 * nw) {
        float4 v[2][4]; float ss[2];
#pragma unroll
        for (int u = 0; u < 2; ++u) {
            const int row = row0 + u * nw < MR ? row0 + u * nw : row0;
            const float4* src = (const float4*)(row < NP ? p.x_prompt + (size_t)row * DM : p.x_sample + (size_t)(row - NP) * DM);
            ss[u] = 0.f;
#pragma unroll
            for (int i = 0; i < 4; ++i) { v[u][i] = src[lane + 64 * i]; ss[u] += v[u][i].x * v[u][i].x + v[u][i].y * v[u][i].y + v[u][i].z * v[u][i].z + v[u][i].w * v[u][i].w; }
        }
#pragma unroll
        for (int u = 0; u < 2; ++u) {
            const int row = row0 + u * nw;
            const float tot = wave_sum(ss[u]);
            const float rstd = rsqrtf(tot * (1.0f / DM) + 1e-6f);
            if (row < MR) {
#pragma unroll
                for (int i = 0; i < 4; ++i) {
                    const float4 g = ((const float4*)p.norm_g)[lane + 64 * i];
                    uint2 w; w.x = pk2(v[u][i].x * rstd * g.x, v[u][i].y * rstd * g.y); w.y = pk2(v[u][i].z * rstd * g.z, v[u][i].w * rstd * g.w);
                    *(uint2*)(p.hb() + (size_t)row * DM + 4 * (lane + 64 * i)) = w;
                }
            }
        }
    }
    { const float* w = p.w_in; transpose_cvt(p.WinT(), NPAD, DM, [=](int n, int k) { const int c = win_src_col(n); return c < 0 ? 0.f : w[(size_t)k * CIN + c]; }); }
    { const float* w = p.w_pa; transpose_cvt(p.WpaT(), DM, 512, [=](int n, int k) { return w[(size_t)k * DM + perm8(n)]; }); }
    { const float* w = p.w_pb; transpose_cvt(p.WpbT(), DM, 512, [=](int n, int k) { return w[(size_t)k * DM + perm8(n)]; }); }
    { const float* w = p.w_out; transpose_cvt(p.WoutT(), DM, DM, [=](int n, int k) { return w[(size_t)k * DM + perm8(n)]; }); }
    { const float* w = p.w_gate; transpose_cvt(p.WgateT(), DM, DM, [=](int n, int k) { return w[(size_t)k * DM + perm8(n)]; }); }
    { const float* w = p.w_proj; transpose_cvt(p.WprojT(), DM, 256, [=](int n, int k) { return w[(size_t)k * DM + perm8(n)]; }); }
    { const float* w = p.cmp_w1; transpose_cvt(p.W1T(), 512, 1024, [=](int n, int k) { const int kvi = n >> 8, nn = n & 255; return w[(size_t)kvi * 262144 + (size_t)((nn >> 7) * 1024 + k) * 128 + (nn & 127)]; }); }
    { const float* w = p.cmp_w2; transpose_cvt(p.W2T(), 128, 128, [=](int n, int k) { return w[(size_t)(n >> 6) * 8192 + (size_t)k * 64 + (n & 63)]; }); }
    { const float* w = p.w_up; transpose_cvt(p.WupT(), 512, 64, [=](int n, int k) { return w[(size_t)k * 512 + n]; }); }
    { const float* w = p.a_up; transpose_cvt(p.AupT(), 512, 64, [=](int n, int k) { return w[(size_t)k * 512 + n]; }); }
    for (int id = gt; id < 33 * CR; id += nt) p.zs0()[id] = id < CR ? (bf16_t)0 : f2bf(p.state_shift[id - CR]);
    for (int id = gt; id < MR * 64; id += nt) {
        const int row = id >> 6, c4 = id & 63;
        const float4 v = ((const float4*)(row < NP ? p.p_prompt + (size_t)row * 256 : p.p_sample + (size_t)(row - NP) * 256))[c4];
        uint2 w; w.x = pk2(v.x, v.y); w.y = pk2(v.z, v.w);
        *(uint2*)(p.pb() + (size_t)row * 256 + c4 * 4) = w;
    }
    for (int id = gt; id < 4104 * 32; id += nt) {
        const int pi = id >> 5, i = id & 31;
        const int pos = pi < 4096 ? pi : PAST + pi - 4096;
        const float inv = (float)exp(-(double)i * (9.210340371976184 / 32.0));
        const float ang = (float)pos * inv;
        const double x = (double)ang;
        const double k = rint(x * 0.15915494309189535);
        const double r = x - k * 6.283185307179586;
        float s, c; sincos_small(r, s, c);
        p.tabc()[id] = c; p.tabs()[id] = s;
    }
    for (int o = gw; o < 256; o += nw) {
        const int kvi = o >> 7, f = o & 127;
        float acc = 0.f;
        for (int jd = lane; jd < 2048; jd += 64) acc += p.cmp_pe[kvi * 2048 + jd] * p.cmp_w1[(size_t)kvi * 262144 + (size_t)jd * 128 + f];
        acc = wave_sum(acc);
        if (lane == 0) p.pt()[o] = acc + p.cmp_b1[o];
    }
    for (int id = gt; id < DB * 504 * 64; id += nt) {
        const int c4 = id & 63, j = (id >> 6) % 504, b = (id >> 6) / 504;
        ((float4*)(p.out + O_WIN_S))[((size_t)b * 512 + j) * 64 + c4] = ((const float4*)p.cache_win)[((size_t)b * 512 + j + 8) * 64 + c4];
    }
}
#define XB_TMO      128
#define XB_XCNT(j)  (256  + 64 * (j))
#define XB_XSUB(j)  (1280 + 64 * (j))
#define XB_XGEN(j)  (2304 + 64 * (j))
#define XB_TOP      3328
#define XB_TOPGEN   3392
#define XCD_BAR_WORDS 3456
#define XB_SPIN_CAP (1u << 18)

__device__ __forceinline__ unsigned xb_ld(unsigned* p)              { return __hip_atomic_load(p, __ATOMIC_RELAXED, __HIP_MEMORY_SCOPE_AGENT); }
__device__ __forceinline__ unsigned xb_add(unsigned* p, unsigned v) { return __hip_atomic_fetch_add(p, v, __ATOMIC_RELAXED, __HIP_MEMORY_SCOPE_AGENT); }
__device__ __forceinline__ unsigned xb_xcc_id() { return (unsigned)__builtin_amdgcn_s_getreg((3 << 11) | 20) & 0xFu; }
#define XB_SPIN(cond, bar) do { unsigned _sp = 0; while (cond) { __builtin_amdgcn_s_sleep(1); \
    if ((++_sp & 255u) == 0u) { if (xb_ld(&(bar)[XB_TMO])) break; if (_sp > XB_SPIN_CAP) { atomicAdd(&(bar)[XB_TMO], 1u); break; } } } } while (0)

struct XcdBarrier {
    unsigned* bar; unsigned x;
    volatile LAS unsigned* st;
};

__device__ __forceinline__ XcdBarrier xcd_barrier_post(unsigned* bar, volatile LAS unsigned* st) {
    XcdBarrier b; b.bar = bar; b.x = xb_xcc_id(); b.st = st;
    if (threadIdx.x == 0) (void)xb_add(&bar[XB_XCNT(b.x)], 1u);
    return b;
}
__device__ __forceinline__ void xcd_barrier_complete(unsigned* bar, unsigned x, unsigned& nloc, unsigned& nx) {
    const unsigned G = gridDim.x * gridDim.y * gridDim.z;
    unsigned sum, cnt, mine, sp = 0u;
    for (;;) {
        sum = 0u; cnt = 0u; mine = 0u;
#pragma unroll
        for (unsigned j = 0; j < 16; ++j) { const unsigned c = xb_ld(&bar[XB_XCNT(j)]); sum += c; cnt += (c > 0u) ? 1u : 0u; mine = (j == x) ? c : mine; }
        if (sum == G) break;
        __builtin_amdgcn_s_sleep(1);
        if ((++sp & 255u) == 0u) { if (xb_ld(&bar[XB_TMO])) break; if (sp > XB_SPIN_CAP) { atomicAdd(&bar[XB_TMO], 1u); break; } }
    }
    nloc = mine > 0u ? mine : 1u; nx = cnt > 0u ? cnt : 1u;
}

__device__ __forceinline__ void xcd_barrier(const XcdBarrier& b) {
    asm volatile("s_waitcnt vmcnt(0)" ::: "memory");
    __syncthreads();
    if (threadIdx.x == 0) {
        unsigned* bar = b.bar;
        __builtin_amdgcn_s_waitcnt(0);
        unsigned nloc = b.st[0], nx = b.st[1];
        if (nloc == 0u) { xcd_barrier_complete(bar, b.x, nloc, nx); b.st[0] = nloc; b.st[1] = nx; }
        const unsigned old = xb_add(&bar[XB_XSUB(b.x)], 1u);
        const unsigned gen = old / nloc;
        if (old + 1u == (gen + 1u) * nloc) {
            __builtin_amdgcn_fence(__ATOMIC_RELEASE, "agent");
            asm volatile("s_waitcnt vmcnt(0)" ::: "memory");
            const unsigned og = xb_add(&bar[XB_TOP], 1u);
            const unsigned tg = og / nx;
            if (og + 1u == (tg + 1u) * nx) xb_add(&bar[XB_TOPGEN], 1u);
            else XB_SPIN(xb_ld(&bar[XB_TOPGEN]) == tg, bar);
            __builtin_amdgcn_fence(__ATOMIC_ACQUIRE, "agent");
            xb_add(&bar[XB_XGEN(b.x)], 1u);
            asm volatile("s_waitcnt vmcnt(0)" ::: "memory");
        } else {
            XB_SPIN(xb_ld(&bar[XB_XGEN(b.x)]) == gen, bar);
            __builtin_amdgcn_fence(__ATOMIC_ACQUIRE, "agent");
            asm volatile("s_waitcnt vmcnt(0)" ::: "memory");
        }
    }
    __syncthreads();
}

using pg8::Unit;
typedef unsigned u32x2 __attribute__((ext_vector_type(2)));
typedef unsigned u32x4_t __attribute__((ext_vector_type(4)));
__device__ __forceinline__ f32x16 mfma32(bf16x8 a, bf16x8 b, f32x16 c) { return __builtin_amdgcn_mfma_f32_32x32x16_bf16(a, b, c, 0, 0, 0); }
__device__ __forceinline__ bf16x8 pack8(float a0, float a1, float a2, float a3, float a4, float a5, float a6, float a7) {
    union { uint4 u; bf16x8 v; } x; x.u.x = pk2(a0, a1); x.u.y = pk2(a2, a3); x.u.z = pk2(a4, a5); x.u.w = pk2(a6, a7); return x.v;
}
__device__ __forceinline__ f32x16 zero16() { f32x16 z; for (int i = 0; i < 16; ++i) z[i] = 0.f; return z; }


__device__ __forceinline__ void st_bf4(bf16_t* dst, f32x4 v) { uint2 w; w.x = pk2(v[0], v[1]); w.y = pk2(v[2], v[3]); *(uint2*)dst = w; }

constexpr float QSCALE = 0.125f * 1.4426950408889634f;
struct EpiIn {
    static constexpr bool PERM = false, AFTER_DRAIN = false;
    P p; int row0; int pn0;
    __device__ __forceinline__ void operator()(const f32x4 (&acc)[2][2][4][2], const Unit& u, int wr, int wc, int fr, int fq) const { body<0, 2, 0, 2>(acc, u, wr, wc, fr, fq); }
    template <int AI0, int AI1, int BJ0, int BJ1>
    __device__ __forceinline__ void body(const f32x4 (&acc)[2][2][4][2], const Unit& u, int wr, int wc, int fr, int fq) const {
        const int pn = pn0 + u.pn;
#pragma unroll
        for (int ai = AI0; ai < AI1; ++ai)
#pragma unroll
            for (int m = 0; m < 4; ++m) {
                const int row = row0 + u.pm * 256 + ai * 128 + wr * 64 + m * 16 + fr;
                if (pn < 5) {
                    const int pi = row < NP ? (row & (SEQ - 1)) : 4096 + ((row - NP) & 7);
                    const int d0 = 16 * (wc & 1) + 4 * fq;
                    const f32x4 cs = *(const f32x4*)(p.tabc() + pi * 32 + d0), sn = *(const f32x4*)(p.tabs() + pi * 32 + d0);
#pragma unroll
                    for (int bj = BJ0; bj < BJ1; ++bj) {
                        const f32x4 x1 = acc[ai][bj][m][0], x2 = acc[ai][bj][m][1];
                        if (pn < 2) {
                            const int head = pn * 4 + bj * 2 + (wc >> 1);
                            const f32x4 o1 = (x1 * cs - x2 * sn) * QSCALE, o2 = (x2 * cs + x1 * sn) * QSCALE;
                            bf16_t* q = p.qb() + (size_t)row * 512 + head * 64 + d0;
                            st_bf4(q, o1); st_bf4(q + 32, o2);
                        } else {
                            const int br = pn - 2, g = wc >> 1;
                            f32x4 o1, o2;
                            if (bj == 0) { o1 = x1 * cs - x2 * sn; o2 = x2 * cs + x1 * sn; } else { o1 = x1; o2 = x2; }
                            float* dst = nullptr;
                            if (row < NP) {
                                if (br == 0) dst = p.out + O_CMP_P + (size_t)row * 256;
                                else if (br == 1) dst = p.out + O_SEL_P + (size_t)row * 256;
                                else { const int s = row & (SEQ - 1); if (s >= SEQ - 512) dst = p.out + O_WIN_P + ((size_t)(row >> 12) * 512 + (s - (SEQ - 512))) * 256; }
                            } else {
                                const int rs = row - NP;
                                if (br == 0) dst = p.out + O_CMP_S + (size_t)rs * 256;
                                else if (br == 1) dst = p.out + O_SEL_S + (size_t)rs * 256;
                                else dst = p.out + O_WIN_S + ((size_t)(rs >> 3) * 512 + 504 + (rs & 7)) * 256;
                            }
                            if (dst) { dst += bj * 128 + g * 64 + d0; *(f32x4*)dst = o1; *(f32x4*)(dst + 32) = o2; }
                            if (row < NP) {
                                const int b = row >> 12, s = row & (SEQ - 1);
                                if (bj == 0) {
                                    bf16_t* k = p.kb() + ((size_t)((br * NB + b) * 2 + g) * SEQ + s) * 64 + d0;
                                    st_bf4(k, o1); st_bf4(k + 32, o2);
                                } else if (br == 0) {
                                    bf16_t* v = p.vcr() + ((size_t)(b * 2 + g) * SEQ + s) * 64 + d0;
                                    st_bf4(v, o1); st_bf4(v + 32, o2);
                                } else {
                                    bf16_t* v = p.vT() + ((size_t)(((br - 1) * NB + b) * 2 + g) * 64 + d0) * SEQ + s;
#pragma unroll
                                    for (int e = 0; e < 4; ++e) { v[(size_t)e * SEQ] = f2bf(o1[e]); v[(size_t)(32 + e) * SEQ] = f2bf(o2[e]); }
                                }
                            }
                        }
                    }
                } else {
#pragma unroll
                    for (int bj = BJ0; bj < BJ1; ++bj) {
                        const int c = bj * 128 + wc * 32 + fq * 8;
                        const f32x4 v0 = acc[ai][bj][m][0], v1 = acc[ai][bj][m][1];
                        auto st8 = [&](bf16_t* dst, const f32x4& a, const f32x4& b) { uint4 w; w.x = pk2(a[0], a[1]); w.y = pk2(a[2], a[3]); w.z = pk2(b[0], b[1]); w.w = pk2(b[2], b[3]); *(uint4*)dst = w; };
                        if (pn < 7 || (pn >= 14 && pn < 16)) {
                            f32x4 o0, o1; for (int e = 0; e < 4; ++e) { o0[e] = silu_fast(v0[e]); o1[e] = silu_fast(v1[e]); }
                            st8((pn < 7 ? p.ag() + (size_t)row * 512 + (pn - 5) * 256 : p.rg() + (size_t)row * 512 + (pn - 14) * 256) + c, o0, o1);
                        } else if (pn < 13) {
                            st8(p.rz() + (size_t)row * CR + (pn - 7) * 256 + c, v0, v1);
                        } else if (pn == 13) {
                            if (c < 128) st8(p.rz() + (size_t)row * CR + 1536 + c, v0, v1);
                            else if (c < 152) { f32x4 o0, o1; for (int e = 0; e < 4; ++e) { o0[e] = sigmoid_fast(v0[e]); o1[e] = sigmoid_fast(v1[e]); }
                                *(f32x4*)(p.gates() + (size_t)row * 32 + (c - 128)) = o0; *(f32x4*)(p.gates() + (size_t)row * 32 + (c - 128) + 4) = o1; }
                        } else {
                            f32x4 o0, o1; for (int e = 0; e < 4; ++e) { o0[e] = sigmoid_fast(v0[e]); o1[e] = sigmoid_fast(v1[e]); }
                            st8(p.mg() + (size_t)row * 2048 + (pn - 16) * 256 + c, o0, o1);
                        }
                    }
                }
            }
    }
};

template <int AI, int BJ>
__device__ __forceinline__ void inproj_sample_quadrant(const P& p, int pn, int wid, int lane) {
    const int wr = wid >> 2, wc = wid & 3, fr = lane & 15, fq = lane >> 4;
    f32x4 acc[2][2][4][2];
#pragma unroll
    for (int m = 0; m < 4; ++m)
#pragma unroll
        for (int n = 0; n < 2; ++n) acc[AI][BJ][m][n] = (f32x4){0.f, 0.f, 0.f, 0.f};
    const bf16_t* ap = p.hb() + (size_t)(NP + AI * 128 + wr * 64 + fr) * DM + 8 * fq;
    const bf16_t* bp = p.WinT() + (size_t)(pn * 256 + BJ * 128 + wc * 32 + fr) * DM + 8 * fq;
    bf16x8 a0[4][2], b0[2][2], a1[4][2], b1[2][2];
    auto ld = [&](bf16x8 (&a)[4][2], bf16x8 (&b)[2][2], int k0) {
#pragma unroll
        for (int i = 0; i < 2; ++i) {
#pragma unroll
            for (int m = 0; m < 4; ++m) a[m][i] = *(const bf16x8*)(ap + (size_t)m * 16 * DM + k0 + 32 * i);
#pragma unroll
            for (int n = 0; n < 2; ++n) b[n][i] = *(const bf16x8*)(bp + (size_t)n * 16 * DM + k0 + 32 * i);
        }
    };
    auto mma = [&](const bf16x8 (&a)[4][2], const bf16x8 (&b)[2][2]) {
#pragma unroll
        for (int i = 0; i < 2; ++i)
#pragma unroll
            for (int m = 0; m < 4; ++m)
#pragma unroll
                for (int n = 0; n < 2; ++n) acc[AI][BJ][m][n] = __builtin_amdgcn_mfma_f32_16x16x32_bf16(b[n][i], a[m][i], acc[AI][BJ][m][n], 0, 0, 0);
    };
    ld(a0, b0, 0);
#pragma unroll 1
    for (int k0 = 0; k0 < DM; k0 += 128) {
        ld(a1, b1, k0 + 64);
        mma(a0, b0);
        if (k0 + 128 < DM) ld(a0, b0, k0 + 128);
        mma(a1, b1);
    }
    EpiIn e; e.p = p; e.row0 = 0; e.pn0 = 0;
    Unit u; u.pm = NP / 256; u.pn = pn;
    e.template body<AI, AI + 1, BJ, BJ + 1>(acc, u, wr, wc, fr, fq);
}
__device__ __forceinline__ void ph_inproj_sample(const P& p) {
    if ((int)blockIdx.x >= 96) return;
    const int wid = threadIdx.x >> 6, lane = threadIdx.x & 63, pn = blockIdx.x >> 2;
    switch (blockIdx.x & 3) {
        case 0: inproj_sample_quadrant<0, 0>(p, pn, wid, lane); break;
        case 1: inproj_sample_quadrant<0, 1>(p, pn, wid, lane); break;
        case 2: inproj_sample_quadrant<1, 0>(p, pn, wid, lane); break;
        default: inproj_sample_quadrant<1, 1>(p, pn, wid, lane); break;
    }
}

struct EpiPlain {
    static constexpr bool PERM = false, AFTER_DRAIN = false;
    float* C; int ldc; int pad_;
    __device__ __forceinline__ void quad(int row, int c, f32x4 v) const { *(f32x4*)(C + (size_t)row * ldc + c) = v; }
    __device__ __forceinline__ void operator()(const f32x4 (&acc)[2][2][4][2], const Unit& u, int wr, int wc, int fr, int fq) const {
#pragma unroll
        for (int ai = 0; ai < 2; ++ai)
#pragma unroll
            for (int m = 0; m < 4; ++m) {
                float* rowp = C + (size_t)(u.pm * 256 + ai * 128 + wr * 64 + m * 16 + fr) * ldc + u.pn * 256 + wc * 32 + 8 * fq;
#pragma unroll
                for (int bj = 0; bj < 2; ++bj)
#pragma unroll
                    for (int n = 0; n < 2; ++n) *(f32x4*)(rowp + bj * 128 + n * 4) = acc[ai][bj][m][n];
            }
    }
};


struct EpiPlainBf {
    static constexpr bool PERM = false, AFTER_DRAIN = false;
    bf16_t* C; int ldc; int pad_;
    __device__ __forceinline__ void operator()(const f32x4 (&acc)[2][2][4][2], const Unit& u, int wr, int wc, int fr, int fq) const {
#pragma unroll
        for (int ai = 0; ai < 2; ++ai)
#pragma unroll
            for (int m = 0; m < 4; ++m) {
                bf16_t* rowp = C + (size_t)(u.pm * 256 + ai * 128 + wr * 64 + m * 16 + fr) * ldc + u.pn * 256 + wc * 32 + 4 * fq;
#pragma unroll
                for (int bj = 0; bj < 2; ++bj)
#pragma unroll
                    for (int n = 0; n < 2; ++n) st_bf4(rowp + bj * 128 + n * 16, acc[ai][bj][m][n]);
            }
    }
};

struct EpiYa {
    static constexpr bool PERM = false, AFTER_DRAIN = false;
    P p;
    __device__ __forceinline__ void quad(int row, int c, f32x4 v) const {
        const uint2 gw = *(const uint2*)(p.mg() + (size_t)row * 2048 + c);
        f32x4 g; g[0] = __uint_as_float(gw.x << 16); g[1] = __uint_as_float(gw.x & 0xffff0000u); g[2] = __uint_as_float(gw.y << 16); g[3] = __uint_as_float(gw.y & 0xffff0000u);
        *(f32x4*)(p.tmp() + (size_t)row * DM + c) = g * v;
    }
    __device__ __forceinline__ void operator()(const f32x4 (&acc)[2][2][4][2], const Unit& u, int wr, int wc, int fr, int fq) const {
#pragma unroll
        for (int ai = 0; ai < 2; ++ai)
#pragma unroll
            for (int m = 0; m < 4; ++m) {
                const int row = u.pm * 256 + ai * 128 + wr * 64 + m * 16 + fr;
#pragma unroll
                for (int bj = 0; bj < 2; ++bj)
#pragma unroll
                    for (int n = 0; n < 2; ++n) {
                        const int c = u.pn * 256 + bj * 128 + wc * 32 + fq * 8 + n * 4;
                        const uint2 gw = *(const uint2*)(p.mg() + (size_t)row * 2048 + c);
                        f32x4 g; g[0] = __uint_as_float(gw.x << 16); g[1] = __uint_as_float(gw.x & 0xffff0000u); g[2] = __uint_as_float(gw.y << 16); g[3] = __uint_as_float(gw.y & 0xffff0000u);
                        *(f32x4*)(p.tmp() + (size_t)row * DM + c) = g * acc[ai][bj][m][n];
                    }
            }
    }
};
struct EpiYb {
    static constexpr bool PERM = false, AFTER_DRAIN = false;
    P p;
    __device__ __forceinline__ void quad(int row, int c, f32x4 v) const {
        const uint2 gw = *(const uint2*)(p.mg() + (size_t)row * 2048 + 1024 + c);
        f32x4 g; g[0] = __uint_as_float(gw.x << 16); g[1] = __uint_as_float(gw.x & 0xffff0000u); g[2] = __uint_as_float(gw.y << 16); g[3] = __uint_as_float(gw.y & 0xffff0000u);
        st_bf4(p.mb() + (size_t)row * DM + c, *(const f32x4*)(p.tmp() + (size_t)row * DM + c) + g * v);
    }
    __device__ __forceinline__ void operator()(const f32x4 (&acc)[2][2][4][2], const Unit& u, int wr, int wc, int fr, int fq) const {
#pragma unroll
        for (int ai = 0; ai < 2; ++ai)
#pragma unroll
            for (int m = 0; m < 4; ++m) {
                const int row = u.pm * 256 + ai * 128 + wr * 64 + m * 16 + fr;
#pragma unroll
                for (int bj = 0; bj < 2; ++bj)
#pragma unroll
                    for (int n = 0; n < 2; ++n) {
                        const int c = u.pn * 256 + bj * 128 + wc * 32 + fq * 8 + n * 4;
                        const uint2 gw = *(const uint2*)(p.mg() + (size_t)row * 2048 + 1024 + c);
                        f32x4 g; g[0] = __uint_as_float(gw.x << 16); g[1] = __uint_as_float(gw.x & 0xffff0000u); g[2] = __uint_as_float(gw.y << 16); g[3] = __uint_as_float(gw.y & 0xffff0000u);
                        const f32x4 t = *(const f32x4*)(p.tmp() + (size_t)row * DM + c);
                        st_bf4(p.mb() + (size_t)row * DM + c, t + g * acc[ai][bj][m][n]);
                    }
            }
    }
};
struct EpiOut {
    static constexpr bool PERM = false, AFTER_DRAIN = false;
    P p;
    __device__ __forceinline__ void quad(int row, int c, f32x4 a) const {
        const float* xr = p.x_sample + (size_t)(row - NP) * DM;
        const f32x4 v = *(const f32x4*)(xr + c) + a;
        *(f32x4*)(p.x1() + (size_t)row * DM + c) = v;
        st_bf4(p.xg() + (size_t)row * DM + c, v * *(const f32x4*)(p.ple_g + c));
        atomicAdd(p.ss_s() + (row - NP), v[0] * v[0] + v[1] * v[1] + v[2] * v[2] + v[3] * v[3]);
    }
    __device__ __forceinline__ void operator()(const f32x4 (&acc)[2][2][4][2], const Unit& u, int wr, int wc, int fr, int fq) const {
#pragma unroll
        for (int ai = 0; ai < 2; ++ai)
#pragma unroll
            for (int m = 0; m < 4; ++m) {
                const int row = u.pm * 256 + ai * 128 + wr * 64 + m * 16 + fr;
                const float* xr = row < NP ? p.x_prompt + (size_t)row * DM : p.x_sample + (size_t)(row - NP) * DM;
                float ss = 0.f;
#pragma unroll
                for (int bj = 0; bj < 2; ++bj)
#pragma unroll
                    for (int n = 0; n < 2; ++n) {
                        const int c = u.pn * 256 + bj * 128 + wc * 32 + fq * 8 + n * 4;
                        const f32x4 v = *(const f32x4*)(xr + c) + acc[ai][bj][m][n];
                        *(f32x4*)(p.x1() + (size_t)row * DM + c) = v;
                        ss += v[0] * v[0] + v[1] * v[1] + v[2] * v[2] + v[3] * v[3];
                        st_bf4(p.xg() + (size_t)row * DM + c, v * *(const f32x4*)(p.ple_g + c));
                    }
                ss += __shfl_xor(ss, 16); ss += __shfl_xor(ss, 32);
                if (fq == 0) p.ss1()[(size_t)row * 16 + u.pn * 4 + wc] = ss;
            }
    }
};
struct EpiGate {
    static constexpr bool PERM = false, AFTER_DRAIN = false;
    P p;
    __device__ __forceinline__ void quad(int row, int c, f32x4 acc) const {
        const float rstd = rsqrtf(p.ss_s()[row - NP] * (1.0f / DM) + 1e-6f);
        const f32x4 a = acc * rstd;
        f32x4 g; for (int e = 0; e < 4; ++e) g[e] = sigmoidf_(a[e]);
        float* ppp = p.pp() + (size_t)row * DM + c;
        *(f32x4*)ppp = *(const f32x4*)(p.x1() + (size_t)row * DM + c) + g * *(const f32x4*)ppp;
    }
    __device__ __forceinline__ void operator()(const f32x4 (&acc)[2][2][4][2], const Unit& u, int wr, int wc, int fr, int fq) const {
#pragma unroll
        for (int ai = 0; ai < 2; ++ai)
#pragma unroll
            for (int m = 0; m < 4; ++m) {
                const int row = u.pm * 256 + ai * 128 + wr * 64 + m * 16 + fr;
                float ss = 0.f;
#pragma unroll
                for (int i = 0; i < 4; ++i) { const f32x4 t = *(const f32x4*)(p.ss1() + (size_t)row * 16 + i * 4); ss += (t[0] + t[1]) + (t[2] + t[3]); }
                const float rstd = rsqrtf(ss * (1.0f / DM) + 1e-6f);
#pragma unroll
                for (int bj = 0; bj < 2; ++bj)
#pragma unroll
                    for (int n = 0; n < 2; ++n) {
                        const int c = u.pn * 256 + bj * 128 + wc * 32 + fq * 8 + n * 4;
                        const f32x4 a = acc[ai][bj][m][n] * rstd;
                        f32x4 g; for (int e = 0; e < 4; ++e) g[e] = sigmoidf_(a[e]);
                        float* ppp = p.pp() + (size_t)row * DM + c;
                        *(f32x4*)ppp = *(const f32x4*)(p.x1() + (size_t)row * DM + c) + g * *(const f32x4*)ppp;
                    }
            }
    }
};

__device__ __forceinline__ void ph_final(const P& p) {
    const int tid = threadIdx.x, lane = tid & 63, wid = tid >> 6;
    const int nw = gridDim.x * 8;
    for (int row0 = blockIdx.x * 8 + wid; row0 < MR; row0 += 2 * nw) {
        float4 v[2][4]; float ss[2];
#pragma unroll
        for (int u = 0; u < 2; ++u) {
            const int row = row0 + u * nw < MR ? row0 + u * nw : row0;
            const float4* src = (const float4*)(p.pp() + (size_t)row * DM);
            ss[u] = 0.f;
#pragma unroll
            for (int i = 0; i < 4; ++i) { v[u][i] = src[lane + 64 * i]; ss[u] += v[u][i].x * v[u][i].x + v[u][i].y * v[u][i].y + v[u][i].z * v[u][i].z + v[u][i].w * v[u][i].w; }
        }
#pragma unroll
        for (int u = 0; u < 2; ++u) {
            const int row = row0 + u * nw;
            const float tot = wave_sum(ss[u]);
            const float rstd = rsqrtf(tot * (1.0f / DM) + 1e-6f);
            if (row < MR) {
                float4* dst = (float4*)(p.out + (row < NP ? O_Y_P + (size_t)row * DM : O_Y_S + (size_t)(row - NP) * DM));
#pragma unroll
                for (int i = 0; i < 4; ++i) {
                    const float4 g = ((const float4*)p.final_g)[lane + 64 * i];
                    float4 o; o.x = v[u][i].x * rstd * g.x; o.y = v[u][i].y * rstd * g.y; o.z = v[u][i].z * rstd * g.z; o.w = v[u][i].w * rstd * g.w;
                    dst[lane + 64 * i] = o;
                }
            }
        }
    }
}

typedef float f32x4v __attribute__((ext_vector_type(4)));
template <class Epi> __device__ __forceinline__ void small_gemm(const bf16_t* A, const bf16_t* Bt, int K, const Epi& E) {
    const int tid = threadIdx.x, lane = tid & 63, wid = tid >> 6, r16 = lane & 15, q4 = lane >> 4;
    for (int tile = blockIdx.x * 8 + wid; tile < 16 * 64; tile += gridDim.x * 8) {
        const int rt = tile & 15, ct = tile >> 4;
        const bf16_t* ap = A + (size_t)(NP + rt * 16 + r16) * K + 8 * q4;
        const bf16_t* bp = Bt + (size_t)(ct * 16 + r16) * K + 8 * q4;
        f32x4 acc = {0.f, 0.f, 0.f, 0.f};
#pragma unroll 1
        for (int k0 = 0; k0 < K; k0 += 256) {
            bf16x8 af[8], bf[8];
#pragma unroll
            for (int i = 0; i < 8; ++i) { af[i] = *(const bf16x8*)(ap + k0 + 32 * i); bf[i] = *(const bf16x8*)(bp + k0 + 32 * i); }
#pragma unroll
            for (int i = 0; i < 8; ++i) acc = __builtin_amdgcn_mfma_f32_16x16x32_bf16(bf[i], af[i], acc, 0, 0, 0);
        }
        E.quad(NP + rt * 16 + r16, (ct >> 1) * 32 + 8 * q4 + 4 * (ct & 1), acc);
    }
}

__device__ __forceinline__ f32x4 ld_bf4c(const bf16_t* q) { const uint2 w = *(const uint2*)q; f32x4 v; v[0] = __uint_as_float(w.x << 16); v[1] = __uint_as_float(w.x & 0xffff0000u); v[2] = __uint_as_float(w.y << 16); v[3] = __uint_as_float(w.y & 0xffff0000u); return v; }
__device__ __forceinline__ void compress2_tile(const P& p, const bf16_t* LH, int nbg, int nrows, int nblk, bf16_t* kc, bf16_t* vcT, int kvi, int bg, int tile, int lane, LAS unsigned char* wlds) {
    const int col = lane & 31, hb = lane >> 5;
    {
        const int i = tile * 32 + col;
        const bool live = i < nblk;
        const bf16_t* lbase = LH + ((size_t)kvi * nbg * nrows + (size_t)bg * nrows) * 256;
        const bf16_t* w2t = p.W2T() + (size_t)kvi * 64 * 128;
        LAS bf16_t* hs = (LAS bf16_t*)wlds;
        {
            const int rq = lane >> 4, c8 = lane & 15;
            const f32x4 pa = *(const f32x4*)(p.pt() + kvi * 128 + c8 * 8), pb = *(const f32x4*)(p.pt() + kvi * 128 + c8 * 8 + 4);
#pragma unroll
            for (int it = 0; it < 8; ++it) {
                const int rr = 4 * it + rq, gi = tile * 32 + rr;
                const bf16_t* rp = lbase + (size_t)(gi < nblk ? gi : 0) * 256 + c8 * 8;
                const uint4 lo = *(const uint4*)rp, hi = *(const uint4*)(rp + 256 + 128);
                float hv[8];
                const unsigned lw[4] = {lo.x, lo.y, lo.z, lo.w}, hw[4] = {hi.x, hi.y, hi.z, hi.w};
#pragma unroll
                for (int e = 0; e < 4; ++e) {
                    const float pe0 = e < 2 ? pa[2 * e] : pb[2 * e - 4], pe1 = e < 2 ? pa[2 * e + 1] : pb[2 * e - 3];
                    hv[2 * e] = siluf_(__uint_as_float(lw[e] << 16) + __uint_as_float(hw[e] << 16) + pe0);
                    hv[2 * e + 1] = siluf_(__uint_as_float(lw[e] & 0xffff0000u) + __uint_as_float(hw[e] & 0xffff0000u) + pe1);
                }
                *(LAS bf16x8*)(hs + rr * 136 + c8 * 8) = pack8(hv[0], hv[1], hv[2], hv[3], hv[4], hv[5], hv[6], hv[7]);
            }
        }
        WAVE_SYNC();
        f32x16 acc[2]; acc[0] = zero16(); acc[1] = zero16();
#pragma unroll
        for (int ks = 0; ks < 8; ++ks) {
            const int f = 16 * ks + 8 * hb;
            const bf16x8 hf = *(LAS const bf16x8*)(hs + col * 136 + f);
#pragma unroll
            for (int dt = 0; dt < 2; ++dt) {
                const bf16x8 wf = *(const bf16x8*)(w2t + (size_t)(32 * dt + col) * 128 + f);
                acc[dt] = (kvi == 0) ? mfma32(wf, hf, acc[dt]) : mfma32(hf, wf, acc[dt]);
            }
        }
        WAVE_SYNC();
        if (kvi == 0) {
            bf16_t* dst = kc + ((size_t)bg * nrows + i) * 64;
#pragma unroll
            for (int dt = 0; dt < 2; ++dt)
#pragma unroll
                for (int i4 = 0; i4 < 4; ++i4) {
                    const int d = 32 * dt + 8 * i4 + 4 * hb;
                    const f32x4 b2 = *(const f32x4*)(p.cmp_b2 + d);
                    f32x4 v; for (int e = 0; e < 4; ++e) v[e] = live ? acc[dt][4 * i4 + e] + b2[e] : 0.f;
                    st_bf4(dst + d, v);
                }
        } else {
#pragma unroll
            for (int dt = 0; dt < 2; ++dt) {
                const int d = 32 * dt + col;
                const float b2 = p.cmp_b2[64 + d];
                bf16_t* dst = vcT + ((size_t)bg * 64 + d) * nrows + tile * 32;
#pragma unroll
                for (int i4 = 0; i4 < 4; ++i4) {
                    const int r = 8 * i4 + 4 * hb;
                    f32x4 v; for (int e = 0; e < 4; ++e) v[e] = (tile * 32 + r + e) < nblk ? acc[dt][4 * i4 + e] + b2 : 0.f;
                    st_bf4(dst + r, v);
                }
            }
        }
    }
}

__device__ __forceinline__ void ph_compress2(const P& p, const bf16_t* LH, int nbg, int nrows, int nblk, bf16_t* kc, bf16_t* vcT, LAS unsigned char* lds) {
    const int tid = threadIdx.x, lane = tid & 63, wid = tid >> 6;
    const int ntile = nrows >> 5, total = 2 * nbg * ntile;
    for (int it = blockIdx.x * 8 + wid; it < total; it += gridDim.x * 8)
        compress2_tile(p, LH, nbg, nrows, nblk, kc, vcT, it / (ntile * nbg), (it / ntile) % nbg, it % ntile, lane, lds + wid * 8960);
}


__device__ __forceinline__ float dpp_row_sum16(float v) {
    v += __builtin_bit_cast(float, __builtin_amdgcn_mov_dpp(__builtin_bit_cast(int, v), 0xB1, 0xF, 0xF, true));
    v += __builtin_bit_cast(float, __builtin_amdgcn_mov_dpp(__builtin_bit_cast(int, v), 0x4E, 0xF, 0xF, true));
    v += __builtin_bit_cast(float, __builtin_amdgcn_mov_dpp(__builtin_bit_cast(int, v), 0x141, 0xF, 0xF, true));
    v += __builtin_bit_cast(float, __builtin_amdgcn_mov_dpp(__builtin_bit_cast(int, v), 0x140, 0xF, 0xF, true));
    return v;
}
__device__ __forceinline__ float tanh_fast(float x) { const float e = __expf(2.0f * x); return 1.0f - 2.0f / (e + 1.0f); }
__device__ __forceinline__ float half_sum32(float v) { return xsum16(dpp_row_sum16(v)); }
__device__ __forceinline__ const bf16_t* rwkv_prev_row(const P& p, int row) {
    if (row < NP) return (row & (SEQ - 1)) == 0 ? p.zs0() : p.rz() + (size_t)(row - 1) * CR;
    const int rs = row - NP;
    return (rs & 7) == 0 ? p.zs0() + (size_t)(1 + (rs >> 3)) * CR : p.rz() + (size_t)(row - 1) * CR;
}
__device__ __forceinline__ f32x4 ld_bf4(const bf16_t* q) { const uint2 w = *(const uint2*)q; f32x4 v; v[0] = __uint_as_float(w.x << 16); v[1] = __uint_as_float(w.x & 0xffff0000u); v[2] = __uint_as_float(w.y << 16); v[3] = __uint_as_float(w.y & 0xffff0000u); return v; }
__device__ __forceinline__ void ph_rwkv_prep(const P& p) {
    const int tid = threadIdx.x, lane = tid & 63, wid = tid >> 6, col = lane & 31, hb = lane >> 5;
    const int gw = blockIdx.x * 8 + wid, nw = gridDim.x * 8;
    for (int it = gw; it < NB + DB; it += nw) {
        const int row = it < NB ? it * SEQ + SEQ - 1 : NP + (it - NB) * 8 + 7;
        float* so = it < NB ? p.out + O_SH_P + (size_t)it * CR : p.out + O_SH_S + (size_t)(it - NB) * CR;
        const bf16_t* z = p.rz() + (size_t)row * CR;
        for (int i = lane; i < CR; i += 64) so[i] = bf2f(z[i]);
    }
    for (int rnd = 0; rnd < 3; ++rnd) {
        int it;
        if (rnd == 0) it = gw;
        else if ((int)blockIdx.x < 16) break;
        else if (rnd == 1) it = nw + (gw - 128);
        else { if (wid != 0 || (int)blockIdx.x >= 208) break; it = 2 * nw - 128 + ((int)blockIdx.x - 16); }
        if (it >= (MR / 32) * 8) break;
        const int h = it & 7, r0 = (it >> 3) * 32;
        bf16x8 Aw[4], Aa[4];
        {
            const int row = r0 + col;
            const bf16_t* z = p.rz() + (size_t)row * CR;
            const bf16_t* pv = rwkv_prev_row(p, row);
#pragma unroll
            for (int ks = 0; ks < 4; ++ks) {
                const int j0 = 16 * ks + 8 * hb;
                float tw[8], ta[8];
#pragma unroll
                for (int q = 0; q < 2; ++q) {
                    const f32x4 zw = ld_bf4(z + 1536 + j0 + 4 * q), za = ld_bf4(z + 1600 + j0 + 4 * q);
                    const f32x4 pw = ld_bf4(pv + 1536 + j0 + 4 * q), pa = ld_bf4(pv + 1600 + j0 + 4 * q);
                    const f32x4 mw = *(const f32x4*)(p.mu + 1536 + j0 + 4 * q), ma = *(const f32x4*)(p.mu + 1600 + j0 + 4 * q);
#pragma unroll
                    for (int e = 0; e < 4; ++e) { tw[4 * q + e] = tanh_fast(zw[e] + (pw[e] - zw[e]) * mw[e]); ta[4 * q + e] = za[e] + (pa[e] - za[e]) * ma[e]; }
                }
                Aw[ks] = pack8(tw[0], tw[1], tw[2], tw[3], tw[4], tw[5], tw[6], tw[7]);
                Aa[ks] = pack8(ta[0], ta[1], ta[2], ta[3], ta[4], ta[5], ta[6], ta[7]);
            }
        }
        f32x16 accw[2], acca[2];
#pragma unroll
        for (int ct = 0; ct < 2; ++ct) {
            accw[ct] = zero16(); acca[ct] = zero16();
            const size_t wo = (size_t)(h * 64 + 32 * ct + col) * 64 + 8 * hb;
#pragma unroll
            for (int ks = 0; ks < 4; ++ks) {
                accw[ct] = mfma32(Aw[ks], *(const bf16x8*)(p.WupT() + wo + 16 * ks), accw[ct]);
                acca[ct] = mfma32(Aa[ks], *(const bf16x8*)(p.AupT() + wo + 16 * ks), acca[ct]);
            }
        }
        float w0v[2], a0v[2], kkv[2], kav[2], rkv[2], mur[2], muk[2], muv[2];
#pragma unroll
        for (int ct = 0; ct < 2; ++ct) {
            const int c = h * 64 + 32 * ct + col;
            w0v[ct] = p.w0[c]; a0v[ct] = p.a0[c]; kkv[ct] = p.k_k[c]; kav[ct] = p.k_a[c]; rkv[ct] = p.r_k[c];
            mur[ct] = p.mu[c]; muk[ct] = p.mu[512 + c]; muv[ct] = p.mu[1024 + c];
        }
#pragma unroll
        for (int hf = 0; hf < 2; ++hf) {
        float zz[8][2][3], pz[2][2][3];
#pragma unroll
        for (int ii = 0; ii < 8; ++ii) {
            const int i = 8 * hf + ii;
            const bf16_t* z = p.rz() + (size_t)(r0 + (i & 3) + 8 * (i >> 2) + 4 * hb) * CR + h * 64 + col;
#pragma unroll
            for (int ct = 0; ct < 2; ++ct) { zz[ii][ct][0] = bf2f(z[32 * ct]); zz[ii][ct][1] = bf2f(z[512 + 32 * ct]); zz[ii][ct][2] = bf2f(z[1024 + 32 * ct]); }
        }
#pragma unroll
        for (int g2 = 0; g2 < 2; ++g2) {
            const bf16_t* pv = rwkv_prev_row(p, r0 + 8 * (2 * hf + g2) + 4 * hb) + h * 64 + col;
#pragma unroll
            for (int ct = 0; ct < 2; ++ct) { pz[g2][ct][0] = bf2f(pv[32 * ct]); pz[g2][ct][1] = bf2f(pv[512 + 32 * ct]); pz[g2][ct][2] = bf2f(pv[1024 + 32 * ct]); }
        }
#pragma unroll
        for (int ii = 0; ii < 8; ++ii) {
            const int i = 8 * hf + ii;
            const int row = r0 + (i & 3) + 8 * (i >> 2) + 4 * hb;
            float zr[2], zk[2], zv[2], dec[2], av[2], kkr[2], km[2];
            float n2 = 0.f, bon = 0.f;
#pragma unroll
            for (int ct = 0; ct < 2; ++ct) {
                const float z0 = zz[ii][ct][0], z1 = zz[ii][ct][1], z2 = zz[ii][ct][2];
                const int ip = ii > 0 ? ii - 1 : 0;
                const float p0 = (i & 3) ? zz[ip][ct][0] : pz[ii >> 2][ct][0], p1 = (i & 3) ? zz[ip][ct][1] : pz[ii >> 2][ct][1], p2 = (i & 3) ? zz[ip][ct][2] : pz[ii >> 2][ct][2];
                zr[ct] = z0 + (p0 - z0) * mur[ct]; zk[ct] = z1 + (p1 - z1) * muk[ct]; zv[ct] = z2 + (p2 - z2) * muv[ct];
                const float nx = -(w0v[ct] + accw[ct][i]);
                const float sp = fmaxf(nx, 0.f) + __logf(1.0f + __expf(-fabsf(nx)));
                dec[ct] = __expf(-__expf(-sp - 0.5f));
                av[ct] = sigmoidf_(a0v[ct] + acca[ct][i]);
                kkr[ct] = zk[ct] * kkv[ct];
                km[ct] = zk[ct] * (1.0f + (av[ct] - 1.0f) * kav[ct]);
                n2 += kkr[ct] * kkr[ct];
                bon += zr[ct] * km[ct] * rkv[ct];
            }
            n2 = half_sum32(n2); bon = half_sum32(bon);
            const float rn = 1.0f / fmaxf(sqrtf(n2), 1e-12f);
            unsigned char* o = p.rw6() + ((size_t)row * 8 + h) * RW6_STRIDE;
#pragma unroll
            for (int ct = 0; ct < 2; ++ct) {
                const float kk = kkr[ct] * rn;
                const int cl = 32 * ct + col;
                ((float*)o)[cl] = dec[ct];
                bf16_t* ob = (bf16_t*)(o + 256) + cl;
                ob[0] = f2bf(zr[ct]); ob[64] = f2bf(km[ct]); ob[128] = f2bf(zv[ct]); ob[192] = f2bf(kk); ob[256] = f2bf(kk * av[ct]);
            }
            if (col == 0) p.bonus()[(size_t)row * 8 + h] = bon;
        }
        }
    }
}

typedef float f32x2 __attribute__((ext_vector_type(2)));
__device__ __forceinline__ float dpp_row_sum(float v) {
    v += __builtin_bit_cast(float, __builtin_amdgcn_mov_dpp(__builtin_bit_cast(int, v), 0xB1, 0xF, 0xF, true));
    v += __builtin_bit_cast(float, __builtin_amdgcn_mov_dpp(__builtin_bit_cast(int, v), 0x4E, 0xF, 0xF, true));
    v += __builtin_bit_cast(float, __builtin_amdgcn_mov_dpp(__builtin_bit_cast(int, v), 0x141, 0xF, 0xF, true));
    v += __builtin_bit_cast(float, __builtin_amdgcn_mov_dpp(__builtin_bit_cast(int, v), 0x140, 0xF, 0xF, true));
    return v;
}
constexpr int SCAN_TC = 32;
template <int NROWS>
__device__ __forceinline__ void scan_item(const P& p, LAS float* lds, int row0, int T, int h, int half, const float* s0, float* sout) {
    const int tid = threadIdx.x, w = tid >> 6, lane = tid & 63, rl = lane >> 4, kq = lane & 15;
    const bool act = w * 4 < NROWS;
    const int vrow = half * NROWS + (act ? w * 4 : 0) + rl;
    f32x4 S;
    if (s0) S = *(const f32x4*)(s0 + vrow * 64 + kq * 4); else { S[0] = 0.f; S[1] = 0.f; S[2] = 0.f; S[3] = 0.f; }
    const unsigned char* src = p.rw6() + ((size_t)row0 * 8 + h) * RW6_STRIDE;
    const int nchunk = (T + SCAN_TC - 1) / SCAN_TC;
    u32x4_t stg[4];
    int ss[4], sc[4], sl[4];
#pragma unroll
    for (int i = 0; i < 4; ++i) {
        const int idx = i * 512 + tid; ss[i] = idx / 56; sc[i] = idx % 56;
        const int cb = sc[i] - 16, q = cb >> 3;
        sl[i] = sc[i] < 16 ? 64 + 4 * sc[i] : (q == 0 ? 0 : 64 + 64 * q) + 8 * (cb & 7);
    }
    auto put = [&](LAS float* b, int i) {
        LAS float* d = b + ss[i] * 384 + sl[i];
        if (sc[i] < 16) *(LAS u32x4_t*)d = stg[i];
        else {
            f32x4 lo, hi;
            lo[0] = __uint_as_float(stg[i][0] << 16); lo[1] = __uint_as_float(stg[i][0] & 0xffff0000u); lo[2] = __uint_as_float(stg[i][1] << 16); lo[3] = __uint_as_float(stg[i][1] & 0xffff0000u);
            hi[0] = __uint_as_float(stg[i][2] << 16); hi[1] = __uint_as_float(stg[i][2] & 0xffff0000u); hi[2] = __uint_as_float(stg[i][3] << 16); hi[3] = __uint_as_float(stg[i][3] & 0xffff0000u);
            *(LAS f32x4*)d = lo; *(LAS f32x4*)(d + 4) = hi;
        }
    };
    {
        const int ns = T < SCAN_TC ? T : SCAN_TC;
#pragma unroll
        for (int i = 0; i < 4; ++i) if (ss[i] < ns) { stg[i] = *(const u32x4_t*)(src + (size_t)ss[i] * (8 * RW6_STRIDE) + sc[i] * 16); put(lds, i); }
    }
    __syncthreads();
    for (int c = 0; c < nchunk; ++c) {
        const int t0 = c * SCAN_TC;
        const int ns = (T - t0) < SCAN_TC ? (T - t0) : SCAN_TC;
        const bool more = (c + 1) < nchunk;
        const int nns = more ? ((T - t0 - SCAN_TC) < SCAN_TC ? (T - t0 - SCAN_TC) : SCAN_TC) : 0;
        if (more) {
#pragma unroll
            for (int i = 0; i < 4; ++i) if (ss[i] < nns) stg[i] = *(const u32x4_t*)(src + (size_t)(t0 + SCAN_TC + ss[i]) * (8 * RW6_STRIDE) + sc[i] * 16);
        }
        LAS const float* buf = lds + (c & 1) * (SCAN_TC * 384);
        float* yo = p.ybuf() + (size_t)(row0 + t0) * 512 + h * 64 + vrow;
        if (act)
#pragma unroll 4
        for (int s = 0; s < ns; ++s) {
            LAS const float* bs = buf + s * 384 + kq * 4;
            const f32x4 r = *(LAS const f32x4*)(bs), d = *(LAS const f32x4*)(bs + 64), km = *(LAS const f32x4*)(bs + 128),
                        kk = *(LAS const f32x4*)(bs + 256), ka = *(LAS const f32x4*)(bs + 320);
            const float vv = buf[s * 384 + 192 + vrow];
            const f32x4 t1 = S * kk;
            float sa = dpp_row_sum((t1[0] + t1[1]) + (t1[2] + t1[3]));
            sa = -sa;
            S = S * d + ka * sa + km * vv;
            const f32x4 t2 = S * r;
            const float y = dpp_row_sum((t2[0] + t2[1]) + (t2[2] + t2[3]));
            if (kq == 0) yo[(size_t)s * 512] = y;
        }
        if (more) {
            LAS float* nb = lds + ((c + 1) & 1) * (SCAN_TC * 384);
#pragma unroll
            for (int i = 0; i < 4; ++i) if (ss[i] < nns) put(nb, i);
        }
        __syncthreads();
    }
    if (act) *(f32x4*)(sout + vrow * 64 + kq * 4) = S;
}
struct ScanVec { f32x4 r, d, km, kk, ka; float vv; };
__device__ __forceinline__ void scan_ld(ScanVec& v, LAS const float* bs, LAS const float* bv) {
    v.kk = *(LAS const f32x4*)(bs + 256); v.d = *(LAS const f32x4*)(bs + 64); v.ka = *(LAS const f32x4*)(bs + 320);
    v.km = *(LAS const f32x4*)(bs + 128); v.vv = *bv; v.r = *(LAS const f32x4*)(bs);
}
__device__ __forceinline__ float scan_step(f32x4& S, const ScanVec& v) {
    const f32x4 t1 = S * v.kk;
    const float sa = -dpp_row_sum((t1[0] + t1[2]) + (t1[1] + t1[3]));
    S = S * v.d + v.ka * sa + v.km * v.vv;
    const f32x4 t2 = S * v.r;
    return dpp_row_sum((t2[0] + t2[2]) + (t2[1] + t2[3]));
}
__device__ __forceinline__ float scan_step_p(f32x4& S, const ScanVec& v) {
    const f32x4 t1 = S * v.kk;
    const float sa = -dpp_row_sum((t1[0] + t1[2]) + (t1[1] + t1[3]));
    S = S * v.d + v.ka * sa + v.km * v.vv;
    const f32x4 t2 = S * v.r;
    return (t2[0] + t2[2]) + (t2[1] + t2[3]);
}
constexpr int YP_STRIDE = 68;
struct ScanCarry { f32x4 P, ka, r; float sa, hu; };
template <int CTRL> __device__ __forceinline__ float dpp_add_(float v) { return v + __builtin_bit_cast(float, __builtin_amdgcn_mov_dpp(__builtin_bit_cast(int, v), CTRL, 0xF, 0xF, true)); }
#define dpp_add(v, c) dpp_add_<c>(v)
#define SCAN_OPAQUE(x) asm("" : "+v"(x))
struct ScanVecA { f32x4 r, d, km, kk, ka; float vv, al; };
__device__ __forceinline__ void scan_lda(ScanVecA& v, LAS const float* bs, LAS const float* bv, LAS const float* ba) {
    v.d = *(LAS const f32x4*)(bs + 64); v.km = *(LAS const f32x4*)(bs + 128); v.vv = *bv; v.al = *ba; v.kk = *(LAS const f32x4*)(bs + 256);
    v.ka = *(LAS const f32x4*)(bs + 320); v.r = *(LAS const f32x4*)(bs);
}
__device__ __forceinline__ float lane_dot4(const f32x4& a, const f32x4& b) {
    const f32x2 lo = {a[0] * b[0], a[1] * b[1]};
    const f32x2 s2 = {__builtin_fmaf(a[2], b[2], lo[0]), __builtin_fmaf(a[3], b[3], lo[1])};
    return s2[0] + s2[1];
}
__device__ __forceinline__ float scan_step_la(ScanCarry& C, const ScanVecA& v) {
    const f32x4 S = C.P + C.ka * C.sa;
    const f32x4 P = S * v.d + v.km * v.vv;
    float U = C.hu;
    U = dpp_add(U, 0x141);
    U = dpp_add(U, 0x140);
    const float sa = -(U + C.sa * v.al);
    float hu = lane_dot4(P, v.kk);
    hu = dpp_add(hu, 0xB1);
    hu = dpp_add(hu, 0x4E);
    asm volatile("" : "+v"(hu));
    const float yp = lane_dot4(S, C.r);
    C.P = P; C.ka = v.ka; C.r = v.r; C.sa = sa; C.hu = hu;
    return yp;
}
template <int NROWS>
__device__ __forceinline__ void scan_prompt(const P& p, LAS float* lds, int row0, int h, int part, float* sout) {
    const int tid = threadIdx.x, w = tid >> 6, lane = tid & 63, rl = lane >> 4, kq = lane & 15;
    const unsigned char* src = p.rw6() + ((size_t)row0 * 8 + h) * RW6_STRIDE;
    constexpr int nchunk = SEQ / SCAN_TC;
    LAS float* alp = lds + 2 * SCAN_TC * 384 + 8 * (16 * YP_STRIDE);
    if (w >= 4) {
        const int hid = tid - 256;
        u32x4_t stA[7], stB[7];
        int ss[7], sc[7], sl[7], sx[7];
#pragma unroll
        for (int i = 0; i < 7; ++i) {
            const int idx = i * 256 + hid; ss[i] = idx / 56; sc[i] = idx % 56;
            const int cb = sc[i] - 16, q = cb >> 3;
            sl[i] = sc[i] < 16 ? 64 + 4 * sc[i] : (q == 0 ? 0 : 64 + 64 * q) + 8 * (cb & 7);
            sx[i] = (sc[i] >= 16 && q == 3) ? 8 * RW6_STRIDE : 0;
        }
        auto load = [&](u32x4_t (&st)[7], int cc) {
#pragma unroll
            for (int i = 0; i < 7; ++i) st[i] = *(const u32x4_t*)(src + (size_t)(cc * SCAN_TC + ss[i]) * (8 * RW6_STRIDE) + sc[i] * 16 + sx[i]);
        };
        auto put = [&](const u32x4_t (&st)[7], LAS float* b) {
#pragma unroll
            for (int i = 0; i < 7; ++i) {
                LAS float* d = b + ss[i] * 384 + sl[i];
                if (sc[i] < 16) *(LAS u32x4_t*)d = st[i];
                else {
                    f32x4 lo, hi;
                    lo[0] = __uint_as_float(st[i][0] << 16); lo[1] = __uint_as_float(st[i][0] & 0xffff0000u); lo[2] = __uint_as_float(st[i][1] << 16); lo[3] = __uint_as_float(st[i][1] & 0xffff0000u);
                    hi[0] = __uint_as_float(st[i][2] << 16); hi[1] = __uint_as_float(st[i][2] & 0xffff0000u); hi[2] = __uint_as_float(st[i][3] << 16); hi[3] = __uint_as_float(st[i][3] & 0xffff0000u);
                    *(LAS f32x4*)d = lo; *(LAS f32x4*)(d + 4) = hi;
                }
            }
        };
        auto alpha_chunk = [&](int cc) {
#pragma unroll
            for (int i = 0; i < 8; ++i) {
                const int s8 = (w - 4) * 8 + i, t = cc * SCAN_TC + s8;
                const unsigned char* rowp = src + (size_t)t * (8 * RW6_STRIDE);
                const float kkv = bf2f(((const bf16_t*)(rowp + 640))[lane]);
                const float kav = t > 0 ? bf2f(((const bf16_t*)(rowp - 8 * RW6_STRIDE + 768))[lane]) : 0.f;
                const float d = wave_sum(kav * kkv);
                if (lane == 0) alp[(cc & 1) * SCAN_TC + s8] = d;
            }
        };
        LAS float* buf0 = lds; LAS float* buf1 = lds + SCAN_TC * 384;
        load(stA, 0); load(stB, 1); alpha_chunk(0); put(stA, buf0);
        __syncthreads();
#pragma unroll 1
        for (int c = 0; c < nchunk; c += 2) {
            if (c + 2 < nchunk) load(stA, c + 2);
            alpha_chunk(c + 1); put(stB, buf1);
            __syncthreads();
            if (c + 3 < nchunk) load(stB, c + 3);
            if (c + 2 < nchunk) { alpha_chunk(c + 2); put(stA, buf0); }
            __syncthreads();
        }
        return;
    }
    const int vrow = part * NROWS + w * 4 + rl;
    ScanCarry C;
#pragma unroll
    for (int e = 0; e < 4; ++e) { C.P[e] = 0.f; C.ka[e] = 0.f; C.r[e] = 0.f; }
    C.sa = 0.f; C.hu = 0.f;
    LAS float* pw = lds + 2 * SCAN_TC * 384 + w * (16 * YP_STRIDE);
    LAS float* pwl = pw + lane;
    LAS const float* prd = pw + kq * YP_STRIDE + rl * 16;
    float* ybase = p.ybuf() + (size_t)(row0 + kq) * 512 + h * 64 + vrow;
    auto flush = [&](int tb) {
        const f32x4 a0 = *(LAS const f32x4*)(prd), a1 = *(LAS const f32x4*)(prd + 4), a2 = *(LAS const f32x4*)(prd + 8), a3 = *(LAS const f32x4*)(prd + 12);
        const f32x4 t = (a0 + a1) + (a2 + a3);
        ybase[(size_t)tb * 512] = (t[0] + t[2]) + (t[1] + t[3]);
    };
    __syncthreads();
#pragma unroll 1
    for (int c = 0; c < nchunk; ++c) {
        const int t0 = c * SCAN_TC;
        LAS const float* buf = lds + (c & 1) * (SCAN_TC * 384);
        LAS const float* bk = buf + kq * 4;
        LAS const float* bv = buf + 192 + vrow;
        LAS const float* ba = alp + (c & 1) * SCAN_TC;
        ScanVecA A, B, D;
        scan_lda(A, bk, bv, ba); scan_lda(B, bk + 384, bv + 384, ba + 1); scan_lda(D, bk + 2 * 384, bv + 2 * 384, ba + 2);
#define STEPX(V, s) do { pwl[(((s) + 15) & 15) * YP_STRIDE] = scan_step_la(C, V);     \
            if ((s) == 0) { if (c > 0) flush(t0 - 16); } if ((s) == 16) flush(t0); \
            if ((s) + 3 < SCAN_TC) scan_lda(V, bk + ((s) + 3) * 384, bv + ((s) + 3) * 384, ba + (s) + 3); } while (0)
        STEPX(A, 0); STEPX(B, 1); STEPX(D, 2); STEPX(A, 3); STEPX(B, 4); STEPX(D, 5); STEPX(A, 6); STEPX(B, 7); STEPX(D, 8); STEPX(A, 9); STEPX(B, 10); STEPX(D, 11); STEPX(A, 12); STEPX(B, 13); STEPX(D, 14); STEPX(A, 15); STEPX(B, 16); STEPX(D, 17); STEPX(A, 18); STEPX(B, 19); STEPX(D, 20); STEPX(A, 21); STEPX(B, 22); STEPX(D, 23); STEPX(A, 24); STEPX(B, 25); STEPX(D, 26); STEPX(A, 27); STEPX(B, 28); STEPX(D, 29); STEPX(A, 30); STEPX(B, 31);
#undef STEPX
        __syncthreads();
    }
    {
        const f32x4 S = C.P + C.ka * C.sa;
        pwl[15 * YP_STRIDE] = lane_dot4(S, C.r);
        flush(SEQ - 16);
        *(f32x4*)(sout + vrow * 64 + kq * 4) = S;
    }
}
constexpr int NSCAN = 128;
__device__ __forceinline__ void ph_rwkv_scan(const P& p, LAS float* lds) {
    if ((int)blockIdx.x < NSCAN) {
        const int item = blockIdx.x >> 2, part = blockIdx.x & 3;
        scan_prompt<16>(p, lds, (item >> 3) * SEQ, item & 7, part, p.out + O_WKV_P + (size_t)item * 4096);
    } else {
        const int nb = (int)gridDim.x - NSCAN;
        for (int hi = (int)blockIdx.x - NSCAN; hi < 512; hi += nb) {
            const int item = hi >> 1, half = hi & 1;
            scan_item<32>(p, lds, NP + (item >> 3) * 8, 8, item & 7, half, p.state_wkv + (size_t)item * 4096, p.out + O_WKV_S + (size_t)item * 4096);
        }
    }
}

__device__ __forceinline__ void ph_rwkv_post(const P& p) {
    const int tid = threadIdx.x, lane = tid & 63, wid = tid >> 6;
    const int stride = gridDim.x * 8;
    const int first = blockIdx.x * 8 + wid, c = (first & 7) * 64 + lane;
    const float gg = p.gn_g[c], gb = p.gn_b[c];
    for (int it0 = first; it0 < MR * 8; it0 += 4 * stride) {
        float y[4], bon[4], vv[4], rg[4];
#pragma unroll
        for (int u = 0; u < 4; ++u) {
            const int it = it0 + u * stride < MR * 8 ? it0 + u * stride : it0, row = it >> 3;
            y[u] = p.ybuf()[(size_t)row * 512 + c];
            bon[u] = p.bonus()[it];
            vv[u] = bf2f(((const bf16_t*)(p.rw6() + (size_t)it * RW6_STRIDE + 256))[128 + lane]);
            rg[u] = bf2f(p.rg()[(size_t)row * 512 + c]);
        }
#pragma unroll
        for (int u = 0; u < 4; ++u) {
            const int it = it0 + u * stride, row = it >> 3;
            const float s1 = wave_sum(y[u]), s2 = wave_sum(y[u] * y[u]);
            const float mean = s1 * (1.0f / 64.0f);
            const float var = fmaxf(s2 * (1.0f / 64.0f) - mean * mean, 0.f);
            const float dv = y[u] - mean;
            float yn = dv * rsqrtf(var + 64e-5f) * gg + gb;
            yn += bon[u] * vv[u];
            if (it < MR * 8) p.ob()[(size_t)row * 512 + c] = f2bf(yn * rg[u]);
        }
    }
}

__device__ __forceinline__ void ph_cmp_gemm_f32(const P& p, LAS unsigned char* lds) {
    using pg8::lds_byte;
    const int tid = threadIdx.x, wid = __builtin_amdgcn_readfirstlane(tid >> 6), lane = tid & 63, wr = wid >> 2, wc = wid & 3, fr = lane & 15, fq = lane >> 4;
    constexpr int HTB = 16384;
    const int arow_l = 4 * wid + (lane >> 4), acol = 4 * (lane & 15);
    const int swbase = lds_byte(arow_l, acol);
    LAS unsigned long long* rowoff = (LAS unsigned long long*)(lds + 131072);
    unsigned voffB[2];
#pragma unroll
    for (int i = 0; i < 2; ++i) { int R, C; pg8::stage_rc(tid * 16 + i * 8192, R, C); voffB[i] = (unsigned)(R * 1024 + C) * 2u; }
    const unsigned ldsw = (unsigned)wid * 1024u;
    const int aoff = lds_byte(wr * 64 + fr, fq * 8), boff = lds_byte(wc * 32 + fr, fq * 8);
    for (int unit = blockIdx.x; unit < 512; unit += gridDim.x) {
        const int kvi = unit >> 8, bg = (unit >> 2) & 63, c0 = (unit & 3) * 256, b = bg >> 1, g = bg & 1;
        __syncthreads();
        if (tid < 256) {
            const int chunk = c0 + tid;
            const int page = p.page_table[b * 128 + (chunk >> 3)];
            rowoff[tid] = ((unsigned long long)page * 128 + (chunk & 7) * 16) * 256 + kvi * 128 + g * 64;
        }
        const char* bbase = (const char*)(p.W1T() + (size_t)kvi * 256 * 1024);
        f32x4 acc[2][2][4][2];
#pragma unroll
        for (int a = 0; a < 2; ++a)
#pragma unroll
            for (int bb = 0; bb < 2; ++bb)
#pragma unroll
                for (int m = 0; m < 4; ++m)
#pragma unroll
                    for (int n = 0; n < 2; ++n) acc[a][bb][m][n] = (f32x4){0.f, 0.f, 0.f, 0.f};
        f32x4 ar[8];
        auto stage_b = [&](int st, int t) {
#pragma unroll
            for (int h = 0; h < 2; ++h)
#pragma unroll
                for (int i = 0; i < 2; ++i)
                    __builtin_amdgcn_global_load_lds((const unsigned*)(bbase + (size_t)h * 128 * 2048 + (size_t)t * 128 + voffB[i]),
                                                     (PG8_LAS unsigned*)(lds + st * 65536 + 32768 + h * HTB + ldsw + i * 8192), 16, 0, 0);
        };
        auto load_a = [&](int t) {
#pragma unroll
            for (int q = 0; q < 8; ++q) ar[q] = *(const f32x4*)(p.cache_cmp + rowoff[32 * q + arow_l] + (size_t)t * 256 + acol);
        };
        auto write_a = [&](int st) {
            LAS unsigned char* na = lds + st * 65536;
#pragma unroll
            for (int q = 0; q < 8; ++q) *(LAS u32x2*)(na + swbase + (q >> 2) * HTB + (q & 3) * 4096) = (u32x2){pk2(ar[q][0], ar[q][1]), pk2(ar[q][2], ar[q][3])};
        };
        __syncthreads();
        load_a(0);
        stage_b(0, 0);
        write_a(0);
        __syncthreads();
#pragma unroll 1
        for (int t = 0; t < 16; ++t) {
            const int cur = t & 1;
            if (t + 1 < 16) { load_a(t + 1); stage_b(cur ^ 1, t + 1); }
            LAS const unsigned char* sa = lds + cur * 65536;
            LAS const unsigned char* sb = sa + 32768;
#pragma unroll
            for (int ai = 0; ai < 2; ++ai)
#pragma unroll
                for (int bj = 0; bj < 2; ++bj) {
                    bf16x8 Bt[2][2];
#pragma unroll
                    for (int n = 0; n < 2; ++n)
#pragma unroll
                        for (int k = 0; k < 2; ++k) Bt[n][k] = *(LAS const bf16x8*)(sb + bj * HTB + boff + n * 2048 + k * 1024);
#pragma unroll
                    for (int m = 0; m < 4; ++m) {
                        const bf16x8 a0 = *(LAS const bf16x8*)(sa + ai * HTB + aoff + m * 2048), a1 = *(LAS const bf16x8*)(sa + ai * HTB + aoff + m * 2048 + 1024);
#pragma unroll
                        for (int n = 0; n < 2; ++n) {
                            acc[ai][bj][m][n] = __builtin_amdgcn_mfma_f32_16x16x32_bf16(Bt[n][0], a0, acc[ai][bj][m][n], 0, 0, 0);
                            acc[ai][bj][m][n] = __builtin_amdgcn_mfma_f32_16x16x32_bf16(Bt[n][1], a1, acc[ai][bj][m][n], 0, 0, 0);
                        }
                    }
                    __builtin_amdgcn_sched_barrier(0);
                }
            if (t + 1 < 16) write_a(cur ^ 1);
            __syncthreads();
        }
        EpiPlainBf e; e.C = p.LHs() + ((size_t)kvi * 65536 + (size_t)bg * 1024 + c0) * 256; e.ldc = 256; e.pad_ = 0;
        pg8::Unit u; u.pm = 0; u.pn = 0;
        e(acc, u, wr, wc, fr, fq);
    }
}

__device__ __forceinline__ float exp2_(float x) { return __builtin_amdgcn_exp2f(x); }
template <class OKF>
__device__ __forceinline__ void sm_stats(const f32x16& s, int hb, OKF ok, float& m, float& l) {
    float sv[16]; float tmax = -1e30f; unsigned okm = 0;
#pragma unroll
    for (int i = 0; i < 16; ++i) { const int kl = (i & 3) + 8 * (i >> 2) + 4 * hb; const bool k = ok(kl); okm |= (k ? 1u : 0u) << i; sv[i] = k ? s[i] : -1e30f; tmax = fmaxf(tmax, sv[i]); }
    tmax = fmaxf(tmax, __shfl_xor(tmax, 32));
    const float mn = fmaxf(m, tmax), alpha = exp2_(m - mn); m = mn;
    float ps = 0.f;
#pragma unroll
    for (int i = 0; i < 16; ++i) ps += ((okm >> i) & 1u) ? exp2_(sv[i] - mn) : 0.f;
    l = l * alpha + ps;
}
template <class OKF, class VF>
__device__ __forceinline__ void sm_pv(const f32x16& s, int hb, OKF ok, VF vf, float& m, float& l, f32x16 (&o)[2]) {
    float sv[16]; float tmax = -1e30f; unsigned okm = 0;
#pragma unroll
    for (int i = 0; i < 16; ++i) { const int kl = (i & 3) + 8 * (i >> 2) + 4 * hb; const bool k = ok(kl); okm |= (k ? 1u : 0u) << i; sv[i] = k ? s[i] : -1e30f; tmax = fmaxf(tmax, sv[i]); }
    tmax = fmaxf(tmax, __shfl_xor(tmax, 32));
    const float mn = fmaxf(m, tmax), alpha = exp2_(m - mn); m = mn;
    float pr[16]; float ps = 0.f;
#pragma unroll
    for (int i = 0; i < 16; ++i) { pr[i] = ((okm >> i) & 1u) ? exp2_(sv[i] - mn) : 0.f; ps += pr[i]; }
    l = l * alpha + ps;
    o[0] *= alpha; o[1] *= alpha;
#pragma unroll
    for (int s2 = 0; s2 < 2; ++s2) {
        const bf16x8 pb = pack8(pr[8 * s2 + 0], pr[8 * s2 + 1], pr[8 * s2 + 2], pr[8 * s2 + 3], pr[8 * s2 + 4], pr[8 * s2 + 5], pr[8 * s2 + 6], pr[8 * s2 + 7]);
#pragma unroll
        for (int dt = 0; dt < 2; ++dt) o[dt] = mfma32(vf(dt, s2), pb, o[dt]);
    }
}
template <class VF>
__device__ __forceinline__ void sm_pv_nomask(const f32x16& s, bool csel, VF vf, float& m, float& l, f32x16 (&o)[2]) {
    float tmax = fmaxf(fmaxf(s[0], s[1]), s[2]);
#pragma unroll
    for (int i = 3; i < 16; ++i) tmax = fmaxf(tmax, s[i]);
    tmax = csel ? tmax : -1e30f;
    tmax = fmaxf(tmax, __shfl_xor(tmax, 32));
    const float mn = fmaxf(m, tmax), alpha = exp2_(m - mn); m = mn;
    float pr[16]; float ps = 0.f;
#pragma unroll
    for (int i = 0; i < 16; ++i) { pr[i] = csel ? exp2_(s[i] - mn) : 0.f; ps += pr[i]; }
    l = l * alpha + ps;
    o[0] *= alpha; o[1] *= alpha;
#pragma unroll
    for (int s2 = 0; s2 < 2; ++s2) {
        const bf16x8 pb = pack8(pr[8 * s2 + 0], pr[8 * s2 + 1], pr[8 * s2 + 2], pr[8 * s2 + 3], pr[8 * s2 + 4], pr[8 * s2 + 5], pr[8 * s2 + 6], pr[8 * s2 + 7]);
#pragma unroll
        for (int dt = 0; dt < 2; ++dt) o[dt] = mfma32(vf(dt, s2), pb, o[dt]);
    }
}
template <class OKF, class VF>
__device__ __forceinline__ void cmp_pass2(const f32x16& s, int hb, OKF ok, VF vf, float m, float inv, f32x16 (&o)[2], LAS float* prow, bool writer) {
    float pr[16];
#pragma unroll
    for (int i = 0; i < 16; ++i) {
        const int kl = (i & 3) + 8 * (i >> 2) + 4 * hb;
        pr[i] = ok(kl) ? exp2_(s[i] - m) * inv : 0.f;
        float q = pr[i] + __shfl_xor(pr[i], 1); q += __shfl_xor(q, 2);
        if (writer) prow[kl] = q;
    }
#pragma unroll
    for (int s2 = 0; s2 < 2; ++s2) {
        const bf16x8 pb = pack8(pr[8 * s2 + 0], pr[8 * s2 + 1], pr[8 * s2 + 2], pr[8 * s2 + 3], pr[8 * s2 + 4], pr[8 * s2 + 5], pr[8 * s2 + 6], pr[8 * s2 + 7]);
#pragma unroll
        for (int dt = 0; dt < 2; ++dt) o[dt] = mfma32(vf(dt, s2), pb, o[dt]);
    }
}

__device__ __forceinline__ void attn_store(const P& p, const f32x16 (&of)[2], int qrow, int head, int hb, bool doit, bf16_t* oadst = nullptr) {
    if (!oadst) oadst = p.oa();
    if (!doit) return;
#pragma unroll
    for (int dt = 0; dt < 2; ++dt)
#pragma unroll
        for (int i4 = 0; i4 < 4; ++i4) {
            const int d = 32 * dt + 8 * i4 + 4 * hb;
            const size_t off = (size_t)qrow * 512 + head * 64 + d;
            const uint2 gw = *(const uint2*)(p.ag() + off);
            f32x4 v;
            v[0] = of[dt][4 * i4 + 0] * __uint_as_float(gw.x << 16); v[1] = of[dt][4 * i4 + 1] * __uint_as_float(gw.x & 0xffff0000u);
            v[2] = of[dt][4 * i4 + 2] * __uint_as_float(gw.y << 16); v[3] = of[dt][4 * i4 + 3] * __uint_as_float(gw.y & 0xffff0000u);
            st_bf4(oadst + off, v);
        }
}


__device__ __forceinline__ void of_put(LAS float* st, int lane, const f32x16 (&o)[2], float sc) {
#pragma unroll
    for (int dt = 0; dt < 2; ++dt)
#pragma unroll
        for (int i = 0; i < 16; ++i) st[(dt * 16 + i) * 64 + lane] = o[dt][i] * sc;
}
__device__ __forceinline__ void of_add(LAS float* st, int lane, const f32x16 (&o)[2], float sc) {
#pragma unroll
    for (int dt = 0; dt < 2; ++dt)
#pragma unroll
        for (int i = 0; i < 16; ++i) st[(dt * 16 + i) * 64 + lane] += o[dt][i] * sc;
}
__device__ __forceinline__ void of_get_add(LAS float* st, int lane, const f32x16 (&o)[2], float sc, f32x16 (&of)[2]) {
#pragma unroll
    for (int dt = 0; dt < 2; ++dt)
#pragma unroll
        for (int i = 0; i < 16; ++i) of[dt][i] = st[(dt * 16 + i) * 64 + lane] + o[dt][i] * sc;
}


constexpr int WL_STRIDE = 15360, KV_OFF = 8 * WL_STRIDE, KV_BUF = 17920, XB_OFF = KV_OFF + 2 * KV_BUF;

struct LoadBf16 {
    const bf16_t* kbase; const bf16_t* vbase; int ld; bool with_v; u32x4_t kr[2], vr[2];
    static constexpr int DEPTH = 2;
    __device__ __forceinline__ void load(int n, int slot) {
        const int tid = threadIdx.x, srow = tid >> 3, sch = tid & 7;
        const u32x4_t k = *(const u32x4_t*)(kbase + (size_t)(64 * n + srow) * 64 + sch * 8);
        u32x4_t v = k;
        if (with_v) v = *(const u32x4_t*)(vbase + (size_t)srow * ld + 64 * n + sch * 8);
        if (slot) { kr[1] = k; vr[1] = v; } else { kr[0] = k; vr[0] = v; }
    }
    __device__ __forceinline__ void store(LAS unsigned char* buf, int slot) const {
        const int tid = threadIdx.x, srow = tid >> 3, sch = tid & 7;
        const u32x4_t k = slot ? kr[1] : kr[0], v = slot ? vr[1] : vr[0];
        *(LAS u32x4_t*)(buf + srow * 144 + sch * 16) = k;
        if (with_v) { LAS u32x2* vp = (LAS u32x2*)(buf + 9216 + srow * 136 + sch * 16); vp[0] = (u32x2){v[0], v[1]}; vp[1] = (u32x2){v[2], v[3]}; }
    }
};
struct LoadWinF32 {
    const float* cw; const float* nw; f32x4 k0, k1, v0, v1;
    static constexpr int DEPTH = 1;
    __device__ __forceinline__ void load(int n, int) {
        const int tid = threadIdx.x, srow = tid >> 3, sch = tid & 7;
        const int j = 64 * n + srow;
        const float* r = j < 512 ? cw + (size_t)j * 256 : nw + (size_t)(j - 512 < 8 ? j - 512 : 7) * 256;
        k0 = *(const f32x4*)(r + sch * 8); k1 = *(const f32x4*)(r + sch * 8 + 4);
        v0 = *(const f32x4*)(r + 128 + sch * 8); v1 = *(const f32x4*)(r + 128 + sch * 8 + 4);
    }
    __device__ __forceinline__ void store(LAS unsigned char* buf, int) const {
        const int tid = threadIdx.x, srow = tid >> 3, sch = tid & 7;
        u32x4_t kw; kw[0] = pk2(k0[0], k0[1]); kw[1] = pk2(k0[2], k0[3]); kw[2] = pk2(k1[0], k1[1]); kw[3] = pk2(k1[2], k1[3]);
        *(LAS u32x4_t*)(buf + srow * 144 + sch * 16) = kw;
        LAS bf16_t* vb = (LAS bf16_t*)(buf + 9216) + (sch * 8) * 68 + srow;
#pragma unroll
        for (int e = 0; e < 4; ++e) { vb[e * 68] = f2bf(v0[e]); vb[(4 + e) * 68] = f2bf(v1[e]); }
    }
};

template <class LOADER, class NEXT, class ACTIVE, class BODY>
__device__ __forceinline__ void block_loop_g(LOADER ld, LAS unsigned char* kv, int first, NEXT next, ACTIVE active, BODY body) {
    if (first < 0) return;
    int n = first, cur = 0;
    if (LOADER::DEPTH == 2) {
        int nn = next(n), k = 0;
        ld.load(n, 0); ld.store(kv, 0);
        if (nn >= 0) ld.load(nn, 1);
        __syncthreads();
#pragma unroll 1
        for (;;) {
            const int nnn = nn >= 0 ? next(nn) : -1;
            if (nnn >= 0) ld.load(nnn, k & 1);
            if (active(n)) body(n, (LAS const bf16_t*)(kv + cur * KV_BUF), (LAS const bf16_t*)(kv + cur * KV_BUF + 9216));
            if (nn >= 0) ld.store(kv + (cur ^ 1) * KV_BUF, (k + 1) & 1);
            __syncthreads();
            if (nn < 0) break;
            cur ^= 1; n = nn; nn = nnn; ++k;
        }
    } else {
        ld.load(n, 0);
        ld.store(kv, 0);
        __syncthreads();
#pragma unroll 1
        for (;;) {
            const int nn = next(n);
            if (nn >= 0) ld.load(nn, 0);
            if (active(n)) body(n, (LAS const bf16_t*)(kv + cur * KV_BUF), (LAS const bf16_t*)(kv + cur * KV_BUF + 9216));
            if (nn >= 0) ld.store(kv + (cur ^ 1) * KV_BUF, 0);
            __syncthreads();
            if (nn < 0) break;
            cur ^= 1; n = nn;
        }
    }
}
template <bool WITH_V, class NEXT, class ACTIVE, class BODY>
__device__ __forceinline__ void block_loop(const bf16_t* kbase, const bf16_t* vbase, int ld, LAS unsigned char* kv, int first, NEXT next, ACTIVE active, BODY body) {
    LoadBf16 L; L.kbase = kbase; L.vbase = vbase; L.ld = ld; L.with_v = WITH_V;
    block_loop_g(L, kv, first, next, active, body);
}
__device__ __forceinline__ bf16x8 lds_kfrag(LAS const bf16_t* kb, int kt, int ks, int col, int hb) { return *(LAS const bf16x8*)(kb + (32 * kt + col) * 72 + 16 * ks + 8 * hb); }
__device__ __forceinline__ bf16x8 lds_vfrag(LAS const bf16_t* vb, int kt, int dt, int s2, int col, int hb) {
    LAS const bf16_t* ptr = vb + (32 * dt + col) * 68 + 32 * kt + 16 * s2 + 4 * hb;
    union { u32x4_t u; bf16x8 v; } x; const u32x2 a = *(LAS const u32x2*)ptr, c = *(LAS const u32x2*)(ptr + 8); x.u[0] = a[0]; x.u[1] = a[1]; x.u[2] = c[0]; x.u[3] = c[1]; return x.v;
}
__device__ __forceinline__ f32x16 lds_qk(const bf16x8 (&qf)[4], LAS const bf16_t* kb, int kt, int col, int hb) {
    f32x16 s = zero16();
#pragma unroll
    for (int ks = 0; ks < 4; ++ks) s = mfma32(lds_kfrag(kb, kt, ks, col, hb), qf[ks], s);
    return s;
}

__device__ __forceinline__ void attn_prompt_block(const P& p, int bg, int j, LAS unsigned char* lds) {
    int tid_l = threadIdx.x; asm volatile("" : "+v"(tid_l));
    const int tid = tid_l, lane = tid & 63, wid = __builtin_amdgcn_readfirstlane(tid >> 6);
    const int b = bg >> 1, g = bg & 1;
    const int col = lane & 31, hb = lane >> 5, tl = col >> 2, hh = col & 3;
    const int t0 = 64 * j + 8 * wid, qpos = t0 + tl, qrow = b * SEQ + qpos, head = g * 4 + hh;
    LAS unsigned char* wl = lds + wid * WL_STRIDE;
    LAS unsigned char* kv = lds + KV_OFF;
    LAS float* psum = (LAS float*)wl;
    LAS unsigned long long* msk = (LAS unsigned long long*)(wl + 8192);
    bf16x8 qf[4];
#pragma unroll
    for (int ks = 0; ks < 4; ++ks) qf[ks] = *(const bf16x8*)(p.qb() + (size_t)qrow * 512 + head * 64 + 16 * ks + 8 * hb);
    const float g0 = p.gates()[(size_t)qrow * 32 + head * 3 + 0], g1 = p.gates()[(size_t)qrow * 32 + head * 3 + 1], g2 = p.gates()[(size_t)qrow * 32 + head * 3 + 2];
    f32x16 oc[2]; oc[0] = zero16(); oc[1] = zero16();
    {
        const int cmb = 64 * j + 63 - 31;
        const int nbc = ((cmb >> 4) >> 6) + 1;
        const int cmw = t0 + 7 - 31;
        const int cmaxw = cmw >= 0 ? (cmw >> 4) : -1;
        const bf16_t* kc = p.kc_p() + (size_t)bg * 256 * 64;
        const bf16_t* vc = p.vcT_p() + (size_t)bg * 64 * 256;
        float m = -1e30f, l = 0.f;
        block_loop<false>(kc, vc, 256, kv, 0, [&](int n) { return n + 1 < nbc ? n + 1 : -1; }, [&](int n) { return cmaxw >= 64 * n; },
            [&](int n, LAS const bf16_t* kb, LAS const bf16_t* vb) {
#pragma unroll 1
                for (int kt = 0; kt < 2; ++kt) {
                    const f32x16 s = lds_qk(qf, kb, kt, col, hb);
                    sm_stats(s, hb, [&](int kl) { return 16 * (64 * n + 32 * kt + kl) + 31 <= qpos; }, m, l);
                }
            });
        l += __shfl_xor(l, 32);
        const float inv = l > 0.f ? 1.0f / l : 0.f;
#pragma unroll
        for (int i = 0; i < 32; ++i) psum[i * 64 + lane] = 0.f;
        WAVE_SYNC();
        block_loop<true>(kc, vc, 256, kv, 0, [&](int n) { return n + 1 < nbc ? n + 1 : -1; }, [&](int n) { return cmaxw >= 64 * n; },
            [&](int n, LAS const bf16_t* kb, LAS const bf16_t* vb) {
#pragma unroll 1
                for (int kt = 0; kt < 2; ++kt) {
                    const f32x16 s = lds_qk(qf, kb, kt, col, hb);
                    cmp_pass2(s, hb, [&](int kl) { return 16 * (64 * n + 32 * kt + kl) + 31 <= qpos; }, [&](int dt, int s2) { return lds_vfrag(vb, kt, dt, s2, col, hb); }, m, inv, oc,
                              psum + tl * 256 + 64 * n + 32 * kt, hh == 0);
                }
            });
    }
    WAVE_SYNC();
    unsigned long long umw = 0;
    for (int t2 = 0; t2 < 8; ++t2) {
        const int t = t0 + t2, cur = t >> 6, n = lane;
        float imp = 0.f;
#pragma unroll
        for (int c = -1; c < 4; ++c) { const int cc = 4 * n + c; if (cc >= 0) imp += psum[t2 * 256 + cc]; }
        if (n == 0 || n == cur || n == cur - 1) imp = 1e4f;
        if (n * 64 > t) imp = -1.0f;
        int rank = 0;
#pragma unroll
        for (int jj = 0; jj < 64; ++jj) {
            const float vj = __uint_as_float(__builtin_amdgcn_readlane(__float_as_uint(imp), jj));
            rank += (vj > imp || (vj == imp && jj < n)) ? 1 : 0;
        }
        const unsigned long long mk = __ballot(rank < 16);
        if (lane == 0) msk[t2] = mk;
        umw |= mk;
    }
    if (lane == 0) msk[8] = umw;
    __syncthreads();
    const unsigned long long mymask = msk[tl];
    unsigned long long umb = 0;
#pragma unroll
    for (int w2 = 0; w2 < 8; ++w2) umb |= *(LAS const unsigned long long*)(lds + w2 * WL_STRIDE + 8192 + 64);
    {
        const unsigned lo = __builtin_amdgcn_readfirstlane((unsigned)umb), hi = __builtin_amdgcn_readfirstlane((unsigned)(umb >> 32));
        umb = ((unsigned long long)hi << 32) | lo;
        if (j < 63) umb &= (2ull << j) - 1ull;
    }
    LAS float* ost = (LAS float*)wl;
    of_put(ost, lane, oc, g0);
    {
        const bf16_t* kbs = p.kb() + (size_t)((1 * NB + b) * 2 + g) * SEQ * 64;
        const bf16_t* vbs = p.vT() + (size_t)((0 * NB + b) * 2 + g) * 64 * SEQ;
        float m = -1e30f, l = 0.f; f32x16 o[2]; o[0] = zero16(); o[1] = zero16();
        block_loop<true>(kbs, vbs, SEQ, kv, umb ? (int)__builtin_ctzll(umb) : -1,
            [&](int n) { if (n >= 63) return -1; const unsigned long long rem = umb >> (n + 1); return rem ? n + 1 + (int)__builtin_ctzll(rem) : -1; },
            [&](int n) { return (bool)((umw >> n) & 1ull); },
            [&](int n, LAS const bf16_t* kb, LAS const bf16_t* vb) {
                const bool bsel = (mymask >> n) & 1ull;
#pragma unroll
                for (int kt = 0; kt < 2; ++kt) {
                    const int tok0 = 64 * n + 32 * kt;
                    const f32x16 s = lds_qk(qf, kb, kt, col, hb);
                    if (n < j) sm_pv_nomask(s, bsel, [&](int dt, int s2) { return lds_vfrag(vb, kt, dt, s2, col, hb); }, m, l, o);
                    else sm_pv(s, hb, [&](int kl) { return bsel && (tok0 + kl <= qpos); }, [&](int dt, int s2) { return lds_vfrag(vb, kt, dt, s2, col, hb); }, m, l, o);
                }
            });
        l += __shfl_xor(l, 32);
        const float sc = l > 0.f ? g1 / l : 0.f;
        of_add(ost, lane, o, sc);
    }
    {
        const bf16_t* kbw = p.kb() + (size_t)((2 * NB + b) * 2 + g) * SEQ * 64;
        const bf16_t* vbw = p.vT() + (size_t)((1 * NB + b) * 2 + g) * 64 * SEQ;
        float m = -1e30f, l = 0.f; f32x16 o[2]; o[0] = zero16(); o[1] = zero16();
        block_loop<true>(kbw, vbw, SEQ, kv, j > 8 ? j - 8 : 0, [&](int n) { return n < j ? n + 1 : -1; }, [&](int n) { return true; },
            [&](int n, LAS const bf16_t* kb, LAS const bf16_t* vb) {
#pragma unroll 1
                for (int kt = 0; kt < 2; ++kt) {
                    const int tok0 = 64 * n + 32 * kt;
                    const f32x16 s = lds_qk(qf, kb, kt, col, hb);
                    if (n < j && n > j - 8) sm_pv_nomask(s, true, [&](int dt, int s2) { return lds_vfrag(vb, kt, dt, s2, col, hb); }, m, l, o);
                    else sm_pv(s, hb, [&](int kl) { const int key = tok0 + kl; return key <= qpos && key + 511 >= qpos; }, [&](int dt, int s2) { return lds_vfrag(vb, kt, dt, s2, col, hb); }, m, l, o);
                }
            });
        l += __shfl_xor(l, 32);
        const float sc = l > 0.f ? g2 / l : 0.f;
        f32x16 of[2];
        of_get_add(ost, lane, o, sc, of);
        attn_store(p, of, qrow, head, hb, true);
    }
    __syncthreads();
}

__device__ __forceinline__ void attn_sample_block(const P& p, int bg, LAS unsigned char* lds) {
    int tid_l = threadIdx.x; asm volatile("" : "+v"(tid_l));
    const int tid = tid_l, lane = tid & 63, wid = __builtin_amdgcn_readfirstlane(tid >> 6);
    const int b = bg >> 1, g = bg & 1, t = wid;
    const int col = lane & 31, hb = lane >> 5, hh = col & 3;
    const int qrow = NP + b * 8 + t, head = g * 4 + hh;
    LAS unsigned char* wl = lds + wid * WL_STRIDE;
    LAS unsigned char* kv = lds + KV_OFF;
    bf16x8 qf[4];
#pragma unroll
    for (int ks = 0; ks < 4; ++ks) qf[ks] = *(const bf16x8*)(p.qb() + (size_t)qrow * 512 + head * 64 + 16 * ks + 8 * hb);
    LAS float* psum = (LAS float*)wl;
    LAS int* list = (LAS int*)(wl + 8256);
    LAS float* impl = (LAS float*)(wl + 8448);
    LAS bf16_t* vt = (LAS bf16_t*)(wl + 9728);
    const float g0 = p.gates()[(size_t)qrow * 32 + head * 3 + 0], g1 = p.gates()[(size_t)qrow * 32 + head * 3 + 1], g2 = p.gates()[(size_t)qrow * 32 + head * 3 + 2];
    f32x16 oc[2]; oc[0] = zero16(); oc[1] = zero16();
    {
        const bf16_t* kc = p.kc_s() + (size_t)bg * 1024 * 64;
        const bf16_t* vc = p.vcT_s() + (size_t)bg * 64 * 1024;
        float m = -1e30f, l = 0.f;
        block_loop<false>(kc, vc, 1024, kv, 0, [&](int n) { return n < 15 ? n + 1 : -1; }, [&](int n) { return true; },
            [&](int n, LAS const bf16_t* kb, LAS const bf16_t* vb) {
#pragma unroll 1
                for (int kt = 0; kt < 2; ++kt) {
                    const f32x16 s = lds_qk(qf, kb, kt, col, hb);
                    sm_stats(s, hb, [&](int kl) { return 64 * n + 32 * kt + kl <= 1022; }, m, l);
                }
            });
        l += __shfl_xor(l, 32);
        const float inv = l > 0.f ? 1.0f / l : 0.f;
        block_loop<true>(kc, vc, 1024, kv, 0, [&](int n) { return n < 15 ? n + 1 : -1; }, [&](int n) { return true; },
            [&](int n, LAS const bf16_t* kb, LAS const bf16_t* vb) {
#pragma unroll 1
                for (int kt = 0; kt < 2; ++kt) {
                    const f32x16 s = lds_qk(qf, kb, kt, col, hb);
                    cmp_pass2(s, hb, [&](int kl) { return 64 * n + 32 * kt + kl <= 1022; }, [&](int dt, int s2) { return lds_vfrag(vb, kt, dt, s2, col, hb); }, m, inv, oc,
                              psum + 64 * n + 32 * kt, col == 0);
                }
            });
    }
    WAVE_SYNC();
#pragma unroll
    for (int j = 0; j < 5; ++j) {
        const int n = lane + 64 * j;
        if (n <= 256) {
            float imp = 0.f;
            for (int c = -1; c < 4; ++c) { const int cc = 4 * n + c; if (cc >= 0 && cc <= 1022) imp += psum[cc]; }
            impl[n] = imp;
        }
    }
    WAVE_SYNC();
    {
        int base = 0;
#pragma unroll
        for (int j = 0; j < 4; ++j) {
            const int n = lane + 64 * j;
            const bool cand = n >= 1 && n <= 254;
            const float v = impl[n];
            int rank = 0;
            for (int q = 1; q <= 254; ++q) { const float vq = impl[q]; rank += (vq > v || (vq == v && q < n)) ? 1 : 0; }
            const bool sel = cand && rank < 13;
            const unsigned long long mk = __ballot(sel);
            if (sel) list[base + __popcll(mk & ((1ull << lane) - 1ull))] = n;
            base += __popcll(mk);
        }
        if (lane == 0) { list[13] = 0; list[14] = 255; list[15] = 256; }
    }
    WAVE_SYNC();
    if (lane < 16) {
        const int n = list[lane];
        list[16 + lane] = n < 256 ? p.page_table[b * 128 + (n >> 1)] * 128 + (n & 1) * 64 : -1;
    }
    WAVE_SYNC();
    LAS float* ost = (LAS float*)wl;
    of_put(ost, lane, oc, g0);
    {
        float m = -1e30f, l = 0.f; f32x16 o[2]; o[0] = zero16(); o[1] = zero16();
        const float* newrows = p.out + O_SEL_S + (size_t)(b * 8) * 256 + g * 64;
        auto rowptr = [&](int u) -> const float* {
            const int rb = __builtin_amdgcn_readfirstlane(list[16 + (u >> 1)]);
            return rb >= 0 ? p.cache_sel + ((size_t)rb + 32 * (u & 1) + col) * 256 + g * 64 : newrows + (size_t)(col < 8 ? col : 7) * 256;
        };
        f32x4 kA[4], kB[4];
        { const float* kr = rowptr(0) + 8 * hb;
#pragma unroll
          for (int ks = 0; ks < 4; ++ks) { kA[ks] = *(const f32x4*)(kr + 16 * ks); kB[ks] = *(const f32x4*)(kr + 16 * ks + 4); } }
#pragma unroll 1
        for (int u = 0; u < 31; ++u) {
            const bool isnew = __builtin_amdgcn_readfirstlane(list[16 + (u >> 1)]) < 0;
            const float* vr = rowptr(u) + 128 + 32 * hb;
            f32x4 vv[8];
#pragma unroll
            for (int j4 = 0; j4 < 8; ++j4) vv[j4] = *(const f32x4*)(vr + 4 * j4);
            f32x16 s = zero16();
#pragma unroll
            for (int ks = 0; ks < 4; ++ks) s = mfma32(pack8(kA[ks][0], kA[ks][1], kA[ks][2], kA[ks][3], kB[ks][0], kB[ks][1], kB[ks][2], kB[ks][3]), qf[ks], s);
            if (u + 1 < 31) { const float* kr = rowptr(u + 1) + 8 * hb;
#pragma unroll
                for (int ks = 0; ks < 4; ++ks) { kA[ks] = *(const f32x4*)(kr + 16 * ks); kB[ks] = *(const f32x4*)(kr + 16 * ks + 4); } }
#pragma unroll
            for (int j4 = 0; j4 < 8; ++j4)
#pragma unroll
                for (int e = 0; e < 4; ++e) vt[(32 * hb + 4 * j4 + e) * 40 + col] = f2bf(vv[j4][e]);
            WAVE_SYNC();
            sm_pv(s, hb, [&](int kl) { return !isnew || kl <= t; }, [&](int dt, int s2) {
                LAS const bf16_t* ptr = vt + (32 * dt + col) * 40 + 16 * s2 + 4 * hb;
                union { u32x4_t u4; bf16x8 v; } x; const u32x2 a = *(LAS const u32x2*)ptr, c = *(LAS const u32x2*)(ptr + 8); x.u4[0] = a[0]; x.u4[1] = a[1]; x.u4[2] = c[0]; x.u4[3] = c[1]; return x.v; }, m, l, o);
            WAVE_SYNC();
        }
        l += __shfl_xor(l, 32);
        const float sc = l > 0.f ? g1 / l : 0.f;
        of_add(ost, lane, o, sc);
    }
    {
        float m = -1e30f, l = 0.f; f32x16 o[2]; o[0] = zero16(); o[1] = zero16();
        LoadWinF32 L; L.cw = p.cache_win + (size_t)b * 512 * 256 + g * 64; L.nw = p.out + O_WIN_S + ((size_t)b * 512 + 504) * 256 + g * 64;
        block_loop_g(L, kv, 0, [&](int n) { return n < 8 ? n + 1 : -1; }, [&](int n) { return true; },
            [&](int n, LAS const bf16_t* kb, LAS const bf16_t* vb) {
#pragma unroll 1
                for (int kt = 0; kt < 2; ++kt) {
                    const int j0 = 64 * n + 32 * kt;
                    if (j0 >= 520) break;
                    const f32x16 s = lds_qk(qf, kb, kt, col, hb);
                    sm_pv(s, hb, [&](int kl) { const int j = j0 + kl; return j >= t + 1 && j <= 512 + t; }, [&](int dt, int s2) { return lds_vfrag(vb, kt, dt, s2, col, hb); }, m, l, o);
                }
            });
        l += __shfl_xor(l, 32);
        const float sc = l > 0.f ? g2 / l : 0.f;
        f32x16 of[2];
        of_get_add(ost, lane, o, sc, of);
        attn_store(p, of, qrow, head, hb, col < 4);
    }
    __syncthreads();
}

__device__ __forceinline__ void ph_attn(const P& p, LAS unsigned char* lds, int qsel = 0) {
    const int tid = threadIdx.x, lane = tid & 63, wid = tid >> 6;
    unsigned* ctr = p.bar() + 3584 + 64 * qsel;
    LAS unsigned* qslot = (LAS unsigned*)(lds + XB_OFF + 64);
    for (;;) {
        if (tid == 0) *qslot = __hip_atomic_fetch_add(ctr, 1u, __ATOMIC_RELAXED, __HIP_MEMORY_SCOPE_AGENT);
        __syncthreads();
        const unsigned q = __builtin_amdgcn_readfirstlane(*qslot);
        __syncthreads();
        if (q >= 64u + 512u) break;
        if (q < 64u) attn_sample_block(p, (int)q, lds);
        else { const int idx = (int)q - 64; attn_prompt_block(p, idx & 7, 63 - (idx >> 3), lds);
        }
    }
}


constexpr int LDS_BYTES = pg8::STAGE_BYTES;

constexpr int FUSED_LDS = XB_OFF + 256;

template <class Epi> __device__ __forceinline__ void run_gemm(LAS unsigned char* lds, const bf16_t* A, const bf16_t* Bt, int M, int N, int K, const Epi& E, int slot = -1) {
    pg8::Gemm g; g.A = A; g.Bt = Bt; g.M = M; g.N = N; g.K = K; g.pad_ = 0;
    pg8::StaticOrder S; S.init(M, N, (int)gridDim.x, slot >= 0 ? slot : (int)blockIdx.x);
    pg8::gemm_phase<Epi, pg8::StaticOrder, false>((PG8_LAS unsigned char*)lds, g, S, E, nullptr);
}

#define XBAR() xcd_barrier(bar)
__global__ __launch_bounds__(512, 2) void k_fused(P p) {
    extern __shared__ __attribute__((aligned(16))) unsigned char shm[];
    LAS unsigned char* lds = (LAS unsigned char*)shm;
    LAS unsigned* xb = (LAS unsigned*)(lds + XB_OFF);
    if (threadIdx.x == 0) { xb[0] = 0u; xb[1] = 0u; xb[2] = 0u; xb[3] = 0u; }
    __syncthreads();
    XcdBarrier bar = xcd_barrier_post(p.bar(), (volatile LAS unsigned*)xb);
    ph_prep(p);
    XBAR();
    ph_inproj_sample(p);
    { EpiIn e; e.p = p; e.row0 = 0; e.pn0 = 0; run_gemm(lds, p.hb(), p.WinT(), NP, NPAD, DM, e); }
    ph_cmp_gemm_f32(p, lds);
    XBAR();
    if ((int)blockIdx.x < 16) {
        const int kvi = blockIdx.x >> 3, bg = blockIdx.x & 7;
        EpiPlainBf e; e.C = p.LHp() + ((size_t)kvi * 2048 + (size_t)bg * 256) * 256; e.ldc = 256; e.pad_ = 0;
        run_gemm(lds, (kvi ? p.vcr() : p.kb()) + (size_t)bg * 256 * 1024, p.W1T() + (size_t)kvi * 256 * 1024, 256, 256, 1024, e, 0);
        __builtin_amdgcn_fence(__ATOMIC_RELEASE, "agent");
        asm volatile("s_waitcnt vmcnt(0)" ::: "memory");
        __syncthreads();
        __builtin_amdgcn_fence(__ATOMIC_ACQUIRE, "agent");
        asm volatile("s_waitcnt vmcnt(0)" ::: "memory");
        compress2_tile(p, p.LHp(), 8, 256, 255, p.kc_p(), p.vcT_p(), kvi, bg, threadIdx.x >> 6, threadIdx.x & 63, lds + (threadIdx.x >> 6) * 8960);
    }
    ph_rwkv_prep(p);
    ph_compress2(p, p.LHs(), 64, 1024, 1023, p.kc_s(), p.vcT_s(), lds);
    XBAR();
    ph_rwkv_scan(p, (LAS float*)lds);
    __syncthreads();
    ph_attn(p, lds);
    XBAR();
    ph_rwkv_post(p);
    { EpiYa e; e.p = p; small_gemm(p.oa(), p.WpaT(), 512, e); run_gemm(lds, p.oa(), p.WpaT(), NP, DM, 512, e); }
    XBAR();
    { EpiYb e; e.p = p; small_gemm(p.ob(), p.WpbT(), 512, e); run_gemm(lds, p.ob(), p.WpbT(), NP, DM, 512, e); }
    XBAR();
    { EpiOut e; e.p = p; small_gemm(p.mb(), p.WoutT(), DM, e); run_gemm(lds, p.mb(), p.WoutT(), NP, DM, DM, e); }
    { EpiPlain e; e.C = p.pp(); e.ldc = DM; e.pad_ = 0; small_gemm(p.pb(), p.WprojT(), 256, e); run_gemm(lds, p.pb(), p.WprojT(), NP, DM, 256, e); }
    XBAR();
    { EpiGate e; e.p = p; small_gemm(p.xg(), p.WgateT(), DM, e); run_gemm(lds, p.xg(), p.WgateT(), NP, DM, DM, e); }
    XBAR();
    ph_final(p);
}
extern "C" void kernel_launch(void* const* d_in, const int* in_sizes, int n_in, void* d_out, int out_size, void* d_ws, size_t ws_size, hipStream_t stream) {
    (void)in_sizes; (void)n_in; (void)out_size; (void)ws_size;
    P p{};
    p.x_prompt = (const float*)d_in[0]; p.x_sample = (const float*)d_in[1]; p.p_prompt = (const float*)d_in[2]; p.p_sample = (const float*)d_in[3];
    p.cache_cmp = (const float*)d_in[4]; p.cache_sel = (const float*)d_in[5]; p.cache_win = (const float*)d_in[6]; p.state_wkv = (const float*)d_in[7];
    p.state_shift = (const float*)d_in[8]; p.page_table = (const int*)d_in[9]; p.norm_g = (const float*)d_in[10]; p.w_in = (const float*)d_in[11];
    p.cmp_pe = (const float*)d_in[12]; p.cmp_w1 = (const float*)d_in[13]; p.cmp_b1 = (const float*)d_in[14]; p.cmp_w2 = (const float*)d_in[15]; p.cmp_b2 = (const float*)d_in[16];
    p.w_pa = (const float*)d_in[17]; p.mu = (const float*)d_in[18]; p.w0 = (const float*)d_in[19]; p.w_up = (const float*)d_in[20]; p.a0 = (const float*)d_in[21];
    p.a_up = (const float*)d_in[22]; p.k_k = (const float*)d_in[23]; p.k_a = (const float*)d_in[24]; p.r_k = (const float*)d_in[25]; p.gn_g = (const float*)d_in[26];
    p.gn_b = (const float*)d_in[27]; p.w_pb = (const float*)d_in[28]; p.w_out = (const float*)d_in[29]; p.ple_g = (const float*)d_in[30]; p.w_gate = (const float*)d_in[31];
    p.w_proj = (const float*)d_in[32]; p.final_g = (const float*)d_in[33];
    p.out = (float*)d_out;
    p.ws = (unsigned char*)d_ws;

    static int grid = 0;
    if (!grid) {
        int dev = 0, cus = 0, per_cu = 0;
        (void)hipGetDevice(&dev);
        (void)hipDeviceGetAttribute(&cus, hipDeviceAttributeMultiprocessorCount, dev);
        (void)hipFuncSetAttribute((const void*)k_fused, hipFuncAttributeMaxDynamicSharedMemorySize, FUSED_LDS);
        (void)hipOccupancyMaxActiveBlocksPerMultiprocessor(&per_cu, k_fused, 512, FUSED_LDS);
        grid = per_cu >= 1 ? cus : 0;
        if (grid > 256) grid = 256;
    }
    (void)hipMemsetAsync(p.bar(), 0, 32768, stream);
    if (grid > 0) hipLaunchKernelGGL(k_fused, dim3(grid), dim3(512), FUSED_LDS, stream, p);
}
```
